# Optimizing an MI355X kernel written in HIP

```python
import jax
import jax.numpy as jnp
from jax import lax
import numpy as np

D_MODEL = 2048
BATCH = 4
SEQ = 2048
DEPTH = 2
DEC_BATCH = 128
DEC_SEQ = 1
PAST_LEN = 16384
PAGE_SIZE = 128

N_GROUPS = 4
G_WIDTH = D_MODEL // N_GROUPS
A_CONV = 3
RET_HEADS = 4
RET_DK = G_WIDTH // RET_HEADS
RET_DV = G_WIDTH // RET_HEADS
RET_CHUNK = 128
ROPE_BASE = 10000.0
RWKV_HEAD = 64
RWKV_HEADS = G_WIDTH // RWKV_HEAD
W_LORA = 64
A_LORA = 64
G_LORA = 128
SHIFT_W = 3 * G_WIDTH + W_LORA + A_LORA + G_LORA
RWKV_GN_EPS = 64e-5
D_CONV = 31
N_MEM = 256
XA_HEADS = 4
XA_HD = D_MODEL // XA_HEADS
D_FF = 4 * D_MODEL
A_COLS = 3 * G_WIDTH
B_COLS = 4 * G_WIDTH
C_COLS = SHIFT_W
D_COLS = 2 * G_WIDTH
P_IN = A_COLS + B_COLS + C_COLS + D_COLS
EPS = 1e-6

kernel_name = 'hybrid_parallel_groups_decoder_step'


def rmsnorm(x, g):
    xf = x.astype(jnp.float32)
    y = xf * lax.rsqrt(jnp.mean(xf * xf, axis=-1, keepdims=True) + EPS)
    return (y * g.astype(jnp.float32)).astype(x.dtype)


def layernorm_lastdim(x, eps):
    xf = x.astype(jnp.float32)
    mu = jnp.mean(xf, axis=-1, keepdims=True)
    var = jnp.mean(jnp.square(xf - mu), axis=-1, keepdims=True)
    return (xf - mu) * lax.rsqrt(var + eps)


def causal_dwconv(x_ext, w):
    return lax.conv_general_dilated(x_ext, w[:, None, :].astype(x_ext.dtype), window_strides=(1,), padding='VALID', dimension_numbers=('NWC', 'WIO', 'NWC'), feature_group_count=x_ext.shape[-1])


def rotary(x, pos):
    d = x.shape[-1]
    inv = ROPE_BASE ** (-jnp.arange(0, d, 2, dtype=jnp.float32) / d)
    ang = pos.astype(jnp.float32)[:, None] * inv[None, :]
    cos = jnp.cos(ang)[None, :, None, :]
    sin = jnp.sin(ang)[None, :, None, :]
    x1, x2 = jnp.split(x.astype(jnp.float32), 2, axis=-1)
    return jnp.concatenate([x1 * cos - x2 * sin, x2 * cos + x1 * sin], axis=-1)


def retention_log_decay():
    return jnp.log1p(-jnp.exp2(-5.0 - jnp.arange(RET_HEADS, dtype=jnp.float32)))


def retention_chunk(S, qkv, lg):
    q, k, v = qkv
    L = q.shape[1]
    idx = jnp.arange(L, dtype=jnp.float32)
    diff = idx[:, None] - idx[None, :]
    dmat = jnp.where(diff[None] >= 0, jnp.exp(lg[:, None, None] * jnp.maximum(diff, 0.0)[None]), 0.0)
    scores = jnp.einsum('bihd,bjhd->bhij', q, k) * dmat[None]
    inner = jnp.einsum('bhij,bjhe->bihe', scores, v)
    q_dec = jnp.exp(lg[None, :] * (idx[:, None] + 1.0))
    cross = jnp.einsum('bihd,bhde->bihe', q, S) * q_dec[None, :, :, None]
    k_dec = jnp.exp(lg[None, :] * (L - 1.0 - idx[:, None]))
    S_new = jnp.exp(lg * L)[None, :, None, None] * S + jnp.einsum('bjhd,bjhe->bhde', k * k_dec[None, :, :, None], v)
    return S_new, inner + cross


def retention(q, k, v, S0):
    B, L, H, _ = q.shape
    C = RET_CHUNK if L % RET_CHUNK == 0 else L
    n = L // C
    def to_chunks(t):
        return t.reshape(B, n, C, H, t.shape[-1]).swapaxes(0, 1)
    lg = retention_log_decay()
    S, out = lax.scan(lambda S, c: retention_chunk(S, c, lg), S0, (to_chunks(q), to_chunks(k), to_chunks(v)))
    return out.swapaxes(0, 1).reshape(B, L, H, -1), S


def wkv7_scan(S0, r, w, k, v, kk, a):
    def step(S, inp):
        r_t, w_t, k_t, v_t, kk_t, a_t = inp
        sa = jnp.einsum('bhij,bhj->bhi', S, -kk_t)
        S = S * w_t[:, :, None, :] + sa[..., None] * (kk_t * a_t)[:, :, None, :] + v_t[..., None] * k_t[:, :, None, :]
        return S, jnp.einsum('bhij,bhj->bhi', S, r_t)
    def tm(t):
        return jnp.moveaxis(t, 1, 0)
    S, out = lax.scan(step, S0, (tm(r), tm(w), tm(k), tm(v), tm(kk), tm(a)))
    return jnp.moveaxis(out, 0, 1), S


def token_mixers(h, st, p, pos0):
    st_a, st_ret, st_shift, st_wkv, st_d = st
    B, L, _ = h.shape
    f32 = jnp.float32
    dt = h.dtype
    proj = h @ p['w_in']
    pa, pb, pc, pd = jnp.split(proj, [A_COLS, A_COLS + B_COLS, A_COLS + B_COLS + C_COLS], axis=-1)

    a_b, a_c, a_h = jnp.split(pa, 3, axis=-1)
    u = a_c * a_h
    u_ext = jnp.concatenate([st_a.astype(u.dtype), u], axis=1)
    y_a = a_b * causal_dwconv(u_ext, p['conv_a_w'])
    new_a = u_ext[:, -(A_CONV - 1):]

    q, k, v, g = jnp.split(pb, 4, axis=-1)
    pos = pos0 + jnp.arange(L)
    q = rotary(q.reshape(B, L, RET_HEADS, RET_DK), pos)
    k = rotary(k.reshape(B, L, RET_HEADS, RET_DK), pos) * (RET_DK ** -0.5)
    v = v.reshape(B, L, RET_HEADS, RET_DV).astype(f32)
    o_b, new_ret = retention(q, k, v, st_ret.astype(f32))
    y_b = jax.nn.silu(g.astype(f32)) * layernorm_lastdim(o_b, EPS).reshape(B, L, G_WIDTH)

    prev = jnp.concatenate([st_shift[:, None, :].astype(pc.dtype), pc[:, :-1]], axis=1)
    xs = pc + (prev - pc) * p['mu_c']
    new_shift = pc[:, -1]
    r, kc, vc, wl, al, gl = jnp.split(xs, [G_WIDTH, 2 * G_WIDTH, 3 * G_WIDTH, 3 * G_WIDTH + W_LORA, 3 * G_WIDTH + W_LORA + A_LORA], axis=-1)
    w = -jax.nn.softplus(-(p['w0'] + jnp.tanh(wl) @ p['w2'])) - 0.5
    decay = jnp.exp(-jnp.exp(w.astype(f32)))
    a = jax.nn.sigmoid((p['a0'] + al @ p['a2']).astype(f32))
    gate = (jax.nn.sigmoid(gl) @ p['g2']).astype(f32)
    def hs(t):
        return t.astype(f32).reshape(B, L, RWKV_HEADS, RWKV_HEAD)
    kk = hs(kc * p['k_k'])
    kk = kk / jnp.maximum(jnp.sqrt(jnp.sum(kk * kk, axis=-1, keepdims=True)), 1e-12)
    a4 = hs(a)
    k4 = hs(kc.astype(f32) * (1.0 + (a - 1.0) * p['k_a'].astype(f32)))
    r4 = hs(r)
    v4 = hs(vc)
    o_c, new_wkv = wkv7_scan(st_wkv.astype(f32), r4, hs(decay), k4, v4, kk, a4)
    o_c = layernorm_lastdim(o_c, RWKV_GN_EPS).reshape(B, L, G_WIDTH) * p['lnx_g'].astype(f32) + p['lnx_b'].astype(f32)
    bonus = jnp.sum(r4 * k4 * p['r_k'].astype(f32).reshape(RWKV_HEADS, RWKV_HEAD), axis=-1, keepdims=True) * v4
    y_c = (o_c + bonus.reshape(B, L, G_WIDTH)) * gate

    d1, d2 = jnp.split(pd, 2, axis=-1)
    u_d = d1 * jax.nn.sigmoid(d2)
    ud_ext = jnp.concatenate([st_d.astype(u_d.dtype), u_d], axis=1)
    c = causal_dwconv(ud_ext, p['conv_d_w']) + p['conv_d_b']
    c = layernorm_lastdim(c, EPS) * p['ln_d_g'].astype(f32) + p['ln_d_b'].astype(f32)
    y_d = jax.nn.silu(c)
    new_d = ud_ext[:, -(D_CONV - 1):]

    y = jnp.concatenate([y_a.astype(dt), y_b.astype(dt), y_c.astype(dt), y_d.astype(dt)], axis=-1) @ p['w_out']
    new_st = (new_a.astype(st_a.dtype), new_ret.astype(st_ret.dtype), new_shift.astype(st_shift.dtype), new_wkv.astype(st_wkv.dtype), new_d.astype(st_d.dtype))
    return y, new_st


def memory_kv(mem, p):
    B, M, _ = mem.shape
    mn = rmsnorm(mem, p['g_mem'])
    mk = (mn @ p['wk_x']).reshape(B, M, XA_HEADS, XA_HD)
    mv = (mn @ p['wv_x']).reshape(B, M, XA_HEADS, XA_HD)
    return mk, mv


def cross_attention(h, mk, mv, p):
    B, L, _ = h.shape
    q = (h @ p['wq_x']).reshape(B, L, XA_HEADS, XA_HD)
    s = jnp.einsum('blhd,bmhd->bhlm', q.astype(jnp.float32), mk.astype(jnp.float32)) * (XA_HD ** -0.5)
    pr = jax.nn.softmax(s, axis=-1)
    o = jnp.einsum('bhlm,bmhd->blhd', pr, mv.astype(jnp.float32)).reshape(B, L, D_MODEL)
    return o.astype(h.dtype) @ p['wo_x']


def trunk_layer(x, mk, mv, st, p, pos0):
    y, new_st = token_mixers(rmsnorm(x, p['g_mix']), st, p, pos0)
    x = x + y
    x = x + cross_attention(rmsnorm(x, p['g_xa']), mk, mv, p)
    hm = rmsnorm(x, p['g_mlp'])
    x = x + jnp.square(jax.nn.relu(hm @ p['w_up'])) @ p['w_down']
    return x, new_st


def setup_inputs(seed: int = 0) -> dict:
    key = jax.random.key(seed)
    ks = iter(jax.random.split(key, 48))
    def nrm(shape, scale):
        return jax.random.normal(next(ks), shape, jnp.float32) * scale
    def unif(shape, lo, hi):
        return lo + (hi - lo) * jax.random.uniform(next(ks), shape, jnp.float32)
    G = G_WIDTH
    return {
        'x_prompt': nrm((BATCH, SEQ, D_MODEL), 1.0),
        'x_sample': nrm((DEC_BATCH, DEC_SEQ, D_MODEL), 1.0),
        'mem_prompt': nrm((BATCH, N_MEM, D_MODEL), 1.0),
        'state_conv_a': nrm((DEPTH, DEC_BATCH, A_CONV - 1, G), 1.0),
        'state_ret': nrm((DEPTH, DEC_BATCH, RET_HEADS, RET_DK, RET_DV), 1.0),
        'state_shift': nrm((DEPTH, DEC_BATCH, SHIFT_W), 1.0),
        'state_wkv': nrm((DEPTH, DEC_BATCH, RWKV_HEADS, RWKV_HEAD, RWKV_HEAD), 0.5),
        'state_conv_d': nrm((DEPTH, DEC_BATCH, D_CONV - 1, G), 1.0),
        'cache_mem_k': nrm((DEPTH, DEC_BATCH, N_MEM, XA_HEADS, XA_HD), 1.0),
        'cache_mem_v': nrm((DEPTH, DEC_BATCH, N_MEM, XA_HEADS, XA_HD), 1.0),
        'g_mix': 1.0 + nrm((DEPTH, D_MODEL), 0.02),
        'w_in': nrm((DEPTH, D_MODEL, P_IN), D_MODEL ** -0.5),
        'conv_a_w': nrm((DEPTH, A_CONV, G), A_CONV ** -0.5),
        'mu_c': unif((DEPTH, SHIFT_W), 0.0, 1.0),
        'w0': unif((DEPTH, G), -6.0, -1.0),
        'w2': nrm((DEPTH, W_LORA, G), 0.5 * W_LORA ** -0.5),
        'a0': nrm((DEPTH, G), 0.1),
        'a2': nrm((DEPTH, A_LORA, G), A_LORA ** -0.5),
        'g2': nrm((DEPTH, G_LORA, G), G_LORA ** -0.5),
        'k_k': 1.0 + nrm((DEPTH, G), 0.1),
        'k_a': 1.0 + nrm((DEPTH, G), 0.1),
        'r_k': nrm((DEPTH, G), 0.1),
        'lnx_g': 1.0 + nrm((DEPTH, G), 0.02),
        'lnx_b': nrm((DEPTH, G), 0.02),
        'conv_d_w': nrm((DEPTH, D_CONV, G), D_CONV ** -0.5),
        'conv_d_b': nrm((DEPTH, G), 0.02),
        'ln_d_g': 1.0 + nrm((DEPTH, G), 0.02),
        'ln_d_b': nrm((DEPTH, G), 0.02),
        'w_out': nrm((DEPTH, D_MODEL, D_MODEL), D_MODEL ** -0.5),
        'g_xa': 1.0 + nrm((DEPTH, D_MODEL), 0.02),
        'g_mem': 1.0 + nrm((DEPTH, D_MODEL), 0.02),
        'wq_x': nrm((DEPTH, D_MODEL, D_MODEL), D_MODEL ** -0.5),
        'wk_x': nrm((DEPTH, D_MODEL, D_MODEL), D_MODEL ** -0.5),
        'wv_x': nrm((DEPTH, D_MODEL, D_MODEL), D_MODEL ** -0.5),
        'wo_x': nrm((DEPTH, D_MODEL, D_MODEL), D_MODEL ** -0.5),
        'g_mlp': 1.0 + nrm((DEPTH, D_MODEL), 0.02),
        'w_up': nrm((DEPTH, D_MODEL, D_FF), D_MODEL ** -0.5),
        'w_down': nrm((DEPTH, D_FF, D_MODEL), D_FF ** -0.5),
        'g_final': 1.0 + nrm((D_MODEL,), 0.02),
    }


def reference(x_prompt, x_sample, mem_prompt, state_conv_a, state_ret, state_shift, state_wkv, state_conv_d, cache_mem_k, cache_mem_v, g_mix, w_in, conv_a_w, mu_c, w0, w2, a0, a2, g2, k_k, k_a, r_k, lnx_g, lnx_b, conv_d_w, conv_d_b, ln_d_g, ln_d_b, w_out, g_xa, g_mem, wq_x, wk_x, wv_x, wo_x, g_mlp, w_up, w_down, g_final):
    xp = x_prompt
    xs = x_sample
    Bp = x_prompt.shape[0]
    dt = x_prompt.dtype
    conv_a_p, conv_a_s, ret_p, ret_s, shift_p, shift_s = [], [], [], [], [], []
    wkv_p, wkv_s, conv_d_p, conv_d_s, mem_k_p, mem_v_p = [], [], [], [], [], []
    for l in range(DEPTH):
        p = {'g_mix': g_mix[l], 'w_in': w_in[l], 'conv_a_w': conv_a_w[l], 'mu_c': mu_c[l], 'w0': w0[l], 'w2': w2[l], 'a0': a0[l], 'a2': a2[l], 'g2': g2[l], 'k_k': k_k[l], 'k_a': k_a[l], 'r_k': r_k[l], 'lnx_g': lnx_g[l], 'lnx_b': lnx_b[l], 'conv_d_w': conv_d_w[l], 'conv_d_b': conv_d_b[l], 'ln_d_g': ln_d_g[l], 'ln_d_b': ln_d_b[l], 'w_out': w_out[l], 'g_xa': g_xa[l], 'g_mem': g_mem[l], 'wq_x': wq_x[l], 'wk_x': wk_x[l], 'wv_x': wv_x[l], 'wo_x': wo_x[l], 'g_mlp': g_mlp[l], 'w_up': w_up[l], 'w_down': w_down[l]}
        zero_st = (jnp.zeros((Bp, A_CONV - 1, G_WIDTH), dt), jnp.zeros((Bp, RET_HEADS, RET_DK, RET_DV), dt), jnp.zeros((Bp, SHIFT_W), dt), jnp.zeros((Bp, RWKV_HEADS, RWKV_HEAD, RWKV_HEAD), dt), jnp.zeros((Bp, D_CONV - 1, G_WIDTH), dt))
        mk_p, mv_p = memory_kv(mem_prompt, p)
        xp, st_p = trunk_layer(xp, mk_p, mv_p, zero_st, p, 0)
        st_in = (state_conv_a[l], state_ret[l], state_shift[l], state_wkv[l], state_conv_d[l])
        xs, st_s = trunk_layer(xs, cache_mem_k[l], cache_mem_v[l], st_in, p, PAST_LEN)
        conv_a_p.append(st_p[0]); conv_a_s.append(st_s[0])
        ret_p.append(st_p[1]); ret_s.append(st_s[1])
        shift_p.append(st_p[2]); shift_s.append(st_s[2])
        wkv_p.append(st_p[3]); wkv_s.append(st_s[3])
        conv_d_p.append(st_p[4]); conv_d_s.append(st_s[4])
        mem_k_p.append(mk_p); mem_v_p.append(mv_p)
    y_prompt = rmsnorm(xp, g_final)
    y_sample = rmsnorm(xs, g_final)
    return (y_prompt, y_sample, jnp.stack(conv_a_p), jnp.stack(conv_a_s), jnp.stack(ret_p), jnp.stack(ret_s), jnp.stack(shift_p), jnp.stack(shift_s), jnp.stack(wkv_p), jnp.stack(wkv_s), jnp.stack(conv_d_p), jnp.stack(conv_d_s), jnp.stack(mem_k_p), jnp.stack(mem_v_p))
```

```cpp
#include <hip/hip_runtime.h>
#include <cstdio>
#include <cstdint>
namespace pg8 {
#define PG8_LAS __attribute__((address_space(3)))
typedef unsigned short bf16_t;
typedef short bf16x8 __attribute__((ext_vector_type(8)));
typedef float f32x4 __attribute__((ext_vector_type(4)));
typedef unsigned u32x4 __attribute__((ext_vector_type(4)));
constexpr int BM = 256, BK = 64, HALF = 128, HTB = HALF * BK * 2  , STAGE_BYTES = 8 * HTB, NXCD = 8, WGM = 8;

__host__ __device__ __forceinline__ int lds_byte(int r, int c) { const int st = (r >> 4) * 2 + (c >> 5), rr = r & 15, cc = c & 31, ob = rr * 64 + cc * 2; return st * 1024 + (ob ^ (((ob >> 9) & 1) << 5)); }
__host__ __device__ __forceinline__ void stage_rc(int b, int& R, int& C) { const int st = b / 1024, sb = b % 1024, swz = sb ^ (((sb >> 9) & 1) << 5); R = (st >> 1) * 16 + swz / 64; C = (st & 1) * 32 + (swz % 64) / 2; }
__host__ __device__ __forceinline__ int perm32(int rho) { const int n = rho >> 4, i = rho & 15; return 8 * (i >> 2) + 4 * n + (i & 3); }

struct Unit { int pm, pn; };
struct Gemm { const bf16_t* A; const bf16_t* Bt; int M, N, K, lda, ldb; size_t ksb; };

struct StaticOrder {
    int nM, nN, nwg, G, c;
    __host__ __device__ void init(int M, int N, int G_, int c_) { nM = M / BM; nN = N / BM; nwg = nM * nN; G = G_; c = c_; }
    __host__ __device__ bool next(int i, Unit& u) const {
        const long L = (long)i * G + c; if (L >= nwg) return false;
        int wgid = (int)L; { const int q = nwg / NXCD, r = nwg % NXCD, xcd = wgid % NXCD, off = wgid / NXCD; wgid = (xcd < r ? xcd * (q + 1) : r * (q + 1) + (xcd - r) * q) + off; }
        const int nig = WGM * nN, gid = wgid / nig, fm = gid * WGM, gsz = (nM - fm) < WGM ? (nM - fm) : WGM;
        u.pm = fm + ((wgid % nig) % gsz); u.pn = (wgid % nig) / gsz; return true;
    }
    __device__ __forceinline__ void a_ready(const Unit&) const {}
    __device__ __forceinline__ void done(const Unit&) const {}
};

typedef float f32x2_cv __attribute__((ext_vector_type(2)));
typedef __bf16 bf16x2_cv __attribute__((ext_vector_type(2)));
__device__ __forceinline__ unsigned cvt_pk_bf16(float lo, float hi) { const f32x2_cv v = {lo, hi}; return __builtin_bit_cast(unsigned, __builtin_convertvector(v, bf16x2_cv)); }
typedef float f32x2 __attribute__((ext_vector_type(2)));
template <class Epi, class Sched, bool ALIGN_EPI = false, bool SP2 = false>
__device__ __forceinline__ void gemm_phase(PG8_LAS unsigned char* lds, const Gemm g, const Sched& S, const Epi& E, int tid_in) {
    int tid_ = tid_in; asm volatile("" : "+v"(tid_));
    const int tid = tid_, wid = __builtin_amdgcn_readfirstlane(tid >> 6), lane = tid & 63, wr = wid >> 2, wc = wid & 3, fr = lane & 15, fq = lane >> 4;
    const int K = g.K, nt = K / BK;
    unsigned voffA[2], voffB[2];
#pragma unroll
    for (int i = 0; i < 2; ++i) { int R, C; stage_rc(tid * 16 + i * 8192, R, C); const int Rb = Epi::PERM ? ((R & ~31) + perm32(R & 31)) : R;
        voffA[i] = (unsigned)(R * g.lda + C) * 2u; voffB[i] = (unsigned)(Rb * g.ldb + C) * 2u; }
    const size_t kstep = (size_t)(BK * 2), kstepB = g.ksb;
    const size_t hstepA = (size_t)HALF * g.lda * 2, hstepB = (size_t)HALF * g.ldb * 2;
    const size_t tstepA = 2 * hstepA, tstepB = 2 * hstepB;
    const unsigned ldsw = (unsigned)wid * 1024u;
    const int aoff = lds_byte(wr * 64 + fr, fq * 8), boff = lds_byte(wc * 32 + fr, fq * 8);
#define PG8_SA(b, h) (((b) * 2 + (h)) * HTB)
#define PG8_SB(b, h) ((4 + (b) * 2 + (h)) * HTB)
#define PG8_STAGE(bufoff, gbase, voff) do { _Pragma("unroll") for (int _i = 0; _i < 2; ++_i) \
        __builtin_amdgcn_global_load_lds((const unsigned*)((const char*)(gbase) + (voff)[_i]), (PG8_LAS unsigned*)(lds + (bufoff) + ldsw + _i * 8192), 16, 0, 0); } while (0)
#define PG8_LDA(dst, b, h) do { _Pragma("unroll") for (int m = 0; m < 4; ++m) _Pragma("unroll") for (int k = 0; k < 2; ++k) dst[m][k] = *(const PG8_LAS bf16x8*)(lds + PG8_SA(b, h) + aoff + m * 2048 + k * 1024); } while (0)
#define PG8_LDB(dst, b, h) do { _Pragma("unroll") for (int n = 0; n < 2; ++n) _Pragma("unroll") for (int k = 0; k < 2; ++k) dst[n][k] = *(const PG8_LAS bf16x8*)(lds + PG8_SB(b, h) + boff + n * 2048 + k * 1024); } while (0)
#define PG8_MMA(ai, bj, At, Bt) do { __builtin_amdgcn_s_setprio(1); _Pragma("unroll") for (int m = 0; m < 4; ++m) _Pragma("unroll") for (int n = 0; n < 2; ++n) _Pragma("unroll") for (int k = 0; k < 2; ++k) \
        acc[ai][bj][m][n] = __builtin_amdgcn_mfma_f32_16x16x32_bf16(Bt[n][k], At[m][k], acc[ai][bj][m][n], 0, 0, 0); __builtin_amdgcn_s_setprio(0); } while (0)
#define PG8_WAIT_V(n) asm volatile("s_waitcnt vmcnt(" #n ")" ::: "memory")
#define PG8_WAIT_L(n) asm volatile("s_waitcnt lgkmcnt(" #n ")" ::: "memory")
#define PG8_BAR __builtin_amdgcn_s_barrier()
#define PG8_SCHED __builtin_amdgcn_sched_barrier(0)
    Unit cur, nxt; int ui = 0;
    if (!S.next(0, cur)) return;
    f32x4 acc[2][2][4][2];
#pragma unroll
    for (int a = 0; a < 2; ++a)
#pragma unroll
        for (int b = 0; b < 2; ++b)
#pragma unroll
            for (int m = 0; m < 4; ++m)
#pragma unroll
                for (int n = 0; n < 2; ++n) acc[a][b][m][n] = (f32x4){0.f, 0.f, 0.f, 0.f};
    bf16x8 At[4][2], B0[2][2], B1[2][2];
    const char* cA = (const char*)g.A + (size_t)cur.pm * tstepA; const char* cB = (const char*)g.Bt + (size_t)cur.pn * tstepB;
    S.a_ready(cur);
    if constexpr (SP2) {
        PG8_STAGE(PG8_SB(0, 0), cB, voffB); PG8_STAGE(PG8_SB(0, 1), cB + hstepB, voffB); PG8_STAGE(PG8_SA(0, 0), cA, voffA); PG8_STAGE(PG8_SA(0, 1), cA + hstepA, voffA);
        if (wr == 1) PG8_BAR;
        PG8_WAIT_V(2); PG8_BAR;
        PG8_STAGE(PG8_SB(1, 0), cB + kstepB, voffB); PG8_STAGE(PG8_SA(1, 0), cA + kstep, voffA); PG8_STAGE(PG8_SB(1, 1), cB + hstepB + kstepB, voffB);
        PG8_WAIT_V(6); PG8_BAR;
    } else {
        PG8_STAGE(PG8_SB(0, 0), cB, voffB); PG8_STAGE(PG8_SA(0, 0), cA, voffA); PG8_STAGE(PG8_SB(0, 1), cB + hstepB, voffB); PG8_STAGE(PG8_SA(0, 1), cA + hstepA, voffA);
        if (wr == 1) PG8_BAR;
        PG8_WAIT_V(4); PG8_BAR;
        PG8_STAGE(PG8_SB(1, 0), cB + kstepB, voffB); PG8_STAGE(PG8_SA(1, 0), cA + kstep, voffA); PG8_STAGE(PG8_SB(1, 1), cB + hstepB + kstepB, voffB);
        PG8_WAIT_V(6); PG8_BAR;
    }
    for (;;) {
        const bool has_next = S.next(ui + 1, nxt);
        const char* nA = has_next ? (const char*)g.A + (size_t)nxt.pm * tstepA : cA; const char* nB = has_next ? (const char*)g.Bt + (size_t)nxt.pn * tstepB : cB;
        for (int t = 0; t < nt; t += 2) {
            const bool last = (t == nt - 2);
            const char* a1 = cA + (size_t)(t + 1) * kstep;
            const char* a2 = last ? nA : cA + (size_t)(t + 2) * kstep; const char* b2 = last ? nB : cB + (size_t)(t + 2) * kstepB;
            const char* a3 = a2 + kstep; const char* b3 = b2 + kstepB;
            if (last && has_next) S.a_ready(nxt);
            if constexpr (SP2) {
            PG8_LDB(B0, 0, 0); PG8_LDB(B1, 0, 1); PG8_SCHED; PG8_LDA(At, 0, 0); PG8_STAGE(PG8_SA(1, 1), a1 + hstepA, voffA);
            PG8_WAIT_V(8); PG8_WAIT_L(0); PG8_BAR; PG8_MMA(0, 0, At, B0); PG8_MMA(0, 1, At, B1); PG8_BAR; PG8_SCHED;
            PG8_LDA(At, 0, 1); PG8_STAGE(PG8_SB(0, 0), b2, voffB); PG8_STAGE(PG8_SB(0, 1), b2 + hstepB, voffB); PG8_STAGE(PG8_SA(0, 0), a2, voffA);
            PG8_WAIT_V(8); PG8_WAIT_L(0); PG8_BAR; PG8_MMA(1, 0, At, B0); PG8_MMA(1, 1, At, B1); PG8_BAR; PG8_SCHED;
            PG8_LDB(B0, 1, 0); PG8_LDB(B1, 1, 1); PG8_SCHED; PG8_LDA(At, 1, 0); PG8_STAGE(PG8_SA(0, 1), a2 + hstepA, voffA);
            PG8_WAIT_V(8); PG8_WAIT_L(0); PG8_BAR; PG8_MMA(0, 0, At, B0); PG8_MMA(0, 1, At, B1); PG8_BAR; PG8_SCHED;
            PG8_LDA(At, 1, 1); PG8_STAGE(PG8_SB(1, 0), b3, voffB); PG8_STAGE(PG8_SB(1, 1), b3 + hstepB, voffB); PG8_STAGE(PG8_SA(1, 0), a3, voffA);
            PG8_WAIT_V(8); PG8_WAIT_L(0); PG8_BAR; PG8_MMA(1, 0, At, B0); PG8_MMA(1, 1, At, B1); PG8_BAR; PG8_SCHED;
            } else {
            PG8_LDB(B0, 0, 0); PG8_SCHED; PG8_LDA(At, 0, 0); PG8_STAGE(PG8_SA(1, 1), a1 + hstepA, voffA);
            PG8_WAIT_L(8); PG8_BAR; PG8_WAIT_L(0); PG8_MMA(0, 0, At, B0); PG8_BAR; PG8_SCHED;
            PG8_LDB(B1, 0, 1); PG8_STAGE(PG8_SB(0, 0), b2, voffB);
            PG8_BAR; PG8_WAIT_L(0); PG8_MMA(0, 1, At, B1); PG8_BAR;
            PG8_LDA(At, 0, 1); PG8_STAGE(PG8_SA(0, 0), a2, voffA);
            PG8_BAR; PG8_WAIT_L(0); PG8_MMA(1, 0, At, B0); PG8_BAR; PG8_SCHED;
            PG8_STAGE(PG8_SB(0, 1), b2 + hstepB, voffB);
            PG8_WAIT_V(6); PG8_BAR; PG8_MMA(1, 1, At, B1); PG8_BAR;
            PG8_LDB(B0, 1, 0); PG8_SCHED; PG8_LDA(At, 1, 0); PG8_STAGE(PG8_SA(0, 1), a2 + hstepA, voffA);
            PG8_WAIT_L(8); PG8_BAR; PG8_WAIT_L(0); PG8_MMA(0, 0, At, B0); PG8_BAR; PG8_SCHED;
            PG8_LDB(B1, 1, 1); PG8_STAGE(PG8_SB(1, 0), b3, voffB);
            PG8_BAR; PG8_WAIT_L(0); PG8_MMA(0, 1, At, B1); PG8_BAR;
            PG8_LDA(At, 1, 1); PG8_STAGE(PG8_SA(1, 0), a3, voffA);
            PG8_BAR; PG8_WAIT_L(0); PG8_MMA(1, 0, At, B0); PG8_BAR; PG8_SCHED;
            PG8_STAGE(PG8_SB(1, 1), b3 + hstepB, voffB);
            PG8_WAIT_V(6); PG8_BAR; PG8_MMA(1, 1, At, B1); PG8_BAR;
            }
        }
        if constexpr (ALIGN_EPI) { if (wr == 0) PG8_BAR; }
        if constexpr (!Epi::AFTER_DRAIN) { E(acc, cur, wr, wc, fr, fq); S.done(cur); }
        if (!has_next) break;
#pragma unroll
        for (int a = 0; a < 2; ++a)
#pragma unroll
            for (int b = 0; b < 2; ++b)
#pragma unroll
                for (int m = 0; m < 4; ++m)
#pragma unroll
                    for (int n = 0; n < 2; ++n) acc[a][b][m][n] = (f32x4){0.f, 0.f, 0.f, 0.f};
        cur = nxt; cA = nA; cB = nB; ++ui;
        if constexpr (ALIGN_EPI) { if (wr == 1) PG8_BAR; }
    }
    PG8_WAIT_V(0);
    if constexpr (!ALIGN_EPI) { if (wr == 0) PG8_BAR; }
    PG8_BAR;
    if constexpr (Epi::AFTER_DRAIN) { E.fused(acc, cur, wr, wc, fr, fq, lds, wid, lane); S.done(cur); }
#undef PG8_SA
#undef PG8_SB
#undef PG8_STAGE
#undef PG8_LDA
#undef PG8_LDB
#undef PG8_MMA
#undef PG8_WAIT_V
#undef PG8_WAIT_L
#undef PG8_BAR
#undef PG8_SCHED
}
}

constexpr int DM = 2048, SEQ = 2048, NB = 4, NS = 128, DEPTH = 2;
constexpr int MP = NB * SEQ;
constexpr int MT = MP + NS;
constexpr int MPAD = MP + 256;
constexpr int PIN = 6400, DFF = 8192, NMEM = 256, MMEM = NB * NMEM;
constexpr int PB_ = 1536, PC_ = 3584, PD_ = 5376;
constexpr int SHW = 1792;
constexpr int LDU = 8192;
constexpr int NWAVES = 8;
constexpr int NIN = 39;

constexpr size_t O_YP = 0, O_YS = O_YP + (size_t)MP * DM, O_CAP = O_YS + (size_t)NS * DM, O_CAS = O_CAP + (size_t)DEPTH * NB * 2 * 512,
    O_RETP = O_CAS + (size_t)DEPTH * NS * 2 * 512, O_RETS = O_RETP + (size_t)DEPTH * NB * 4 * 128 * 128, O_SHP = O_RETS + (size_t)DEPTH * NS * 4 * 128 * 128,
    O_SHS = O_SHP + (size_t)DEPTH * NB * SHW, O_WKVP = O_SHS + (size_t)DEPTH * NS * SHW, O_WKVS = O_WKVP + (size_t)DEPTH * NB * 8 * 64 * 64,
    O_CDP = O_WKVS + (size_t)DEPTH * NS * 8 * 64 * 64, O_CDS = O_CDP + (size_t)DEPTH * NB * 30 * 512, O_MKP = O_CDS + (size_t)DEPTH * NS * 30 * 512,
    O_MVP = O_MKP + (size_t)DEPTH * MMEM * DM, O_END = O_MVP + (size_t)DEPTH * MMEM * DM;
static_assert(O_END == 56178688, "d_out size");

constexpr size_t MiB = 1u << 20;
constexpr size_t al256(size_t x) { return (x + 255) & ~(size_t)255; }
constexpr size_t WS_CTL = 0, CTL_ZERO_BYTES = 1 * MiB;
constexpr size_t WS_ROPE = 1 * MiB;
constexpr size_t SZ_WIN = (size_t)PIN * DM * 2, SZ_SQ = (size_t)DM * DM * 2, SZ_WUP = (size_t)DFF * DM * 2, SZ_WDN = (size_t)DM * LDU * 2;
constexpr size_t LW_IN = 0, LW_OUT = LW_IN + SZ_WIN, LW_Q = LW_OUT + SZ_SQ, LW_O = LW_Q + SZ_SQ, LW_UP = LW_O + SZ_SQ, LW_DN = LW_UP + SZ_WUP,
    LW_W2 = LW_DN + SZ_WDN, LW_A2 = LW_W2 + 512 * 64 * 2, LW_G2 = LW_A2 + 512 * 64 * 2, LW_STRIDE = LW_G2 + 512 * 128 * 2;
constexpr size_t WS_WL = 4 * MiB;
constexpr size_t WS_WKV = al256(WS_WL + 2 * LW_STRIDE);
constexpr size_t WS_XF = al256(WS_WKV + (size_t)8192 * DM * 2);
constexpr size_t WS_HN = al256(WS_XF + (size_t)MT * DM * 4);
constexpr size_t WS_MN = al256(WS_HN + (size_t)MPAD * DM * 2);
constexpr size_t WS_MK = al256(WS_MN + (size_t)MMEM * DM * 2);
constexpr size_t WS_MVT = al256(WS_MK + (size_t)2 * MMEM * DM * 2);
constexpr size_t WS_P = al256(WS_MVT + (size_t)2 * MMEM * DM * 2);
constexpr size_t WS_YC = al256(WS_P + (size_t)MPAD * PIN * 2);
constexpr size_t WS_Q = al256(WS_YC + (size_t)MT * DM * 2);
constexpr size_t WS_O = al256(WS_Q + (size_t)MT * DM * 2);
constexpr size_t WS_U = al256(WS_O + (size_t)MT * DM * 2);
constexpr size_t WS_RW = al256(WS_U + (size_t)MT * LDU * 2);
constexpr size_t WS_GATE = al256(WS_RW + (size_t)MT * 8 * 896);
constexpr size_t WS_OC = al256(WS_GATE + (size_t)MT * 512 * 4);
constexpr size_t WS_KVT = al256(WS_OC + (size_t)MT * 512 * 4);
constexpr size_t WS_SSQ = al256(WS_KVT + (size_t)16 * 16 * 128 * 128 * 4);
constexpr size_t WS_SPL = al256(WS_SSQ + (size_t)MP * 8 * 4);
constexpr size_t WS_STB = al256(WS_SPL + (size_t)2 * NS * DM * 4);
constexpr size_t WS_CK = al256(WS_STB + (size_t)16 * 16 * 128 * 128 * 2);
constexpr size_t WS_CP = al256(WS_CK + (size_t)4096 * 6912);
constexpr size_t WS_END = al256(WS_CP + (size_t)4096 * 4 * 3072);
static_assert(WS_END < (size_t)1700 * MiB, "d_ws map");
constexpr int CW_BAR = 4096;

constexpr int SCR_BYTES = 147456;
constexpr int MISC_OFF = SCR_BYTES;
constexpr int LDS_BYTES = SCR_BYTES + 1024;

#define GAS __attribute__((address_space(1)))
#define LAS __attribute__((address_space(3)))
typedef unsigned short bf16;
typedef unsigned v4u __attribute__((ext_vector_type(4)));
typedef unsigned v2u __attribute__((ext_vector_type(2)));
typedef float f32x4 __attribute__((ext_vector_type(4)));
typedef float f32x2 __attribute__((ext_vector_type(2)));
typedef short bf16x8 __attribute__((ext_vector_type(8)));
typedef short bf16x4 __attribute__((ext_vector_type(4)));
typedef GAS unsigned gu32;
#define RLX_AGENT __ATOMIC_RELAXED, __HIP_MEMORY_SCOPE_AGENT
#define LDS_WAIT() asm volatile("s_waitcnt lgkmcnt(0)" ::: "memory")
#define VM_WAIT() asm volatile("s_waitcnt vmcnt(0)" ::: "memory")
__device__ __forceinline__ unsigned pk2(float lo, float hi) { return pg8::cvt_pk_bf16(lo, hi); }
__device__ __forceinline__ float bflo(unsigned w) { return __uint_as_float(w << 16); }
__device__ __forceinline__ float bfhi(unsigned w) { return __uint_as_float(w & 0xffff0000u); }
__device__ __forceinline__ float bf1(bf16 h) { return __uint_as_float(((unsigned)h) << 16); }
__device__ __forceinline__ void unpack8(const v4u w, float (&f)[8]) { f[0] = bflo(w.x); f[1] = bfhi(w.x); f[2] = bflo(w.y); f[3] = bfhi(w.y); f[4] = bflo(w.z); f[5] = bfhi(w.z); f[6] = bflo(w.w); f[7] = bfhi(w.w); }
__device__ __forceinline__ void unpack4(const v2u w, float (&f)[4]) { f[0] = bflo(w.x); f[1] = bfhi(w.x); f[2] = bflo(w.y); f[3] = bfhi(w.y); }
__device__ __forceinline__ v4u pack8(const float (&f)[8]) { v4u w; w.x = pk2(f[0], f[1]); w.y = pk2(f[2], f[3]); w.z = pk2(f[4], f[5]); w.w = pk2(f[6], f[7]); return w; }
__device__ __forceinline__ float sigm(float x) { return 1.0f / (1.0f + __expf(-x)); }
__device__ __forceinline__ float wave_sum(float v) {
#pragma unroll
    for (int o = 1; o < 64; o <<= 1) v += __shfl_xor(v, o);
    return v;
}
__device__ __forceinline__ float wave_max(float v) {
#pragma unroll
    for (int o = 1; o < 64; o <<= 1) v = fmaxf(v, __shfl_xor(v, o));
    return v;
}
template <int CTRL> __device__ __forceinline__ float dpp_f(float v) { return __builtin_bit_cast(float, __builtin_amdgcn_update_dpp(0, __builtin_bit_cast(int, v), CTRL, 0xf, 0xf, false)); }
__device__ __forceinline__ f32x4 zero4() { f32x4 z = (f32x4){0.f, 0.f, 0.f, 0.f}; asm volatile("" : "+v"(z)); return z; }
__device__ __forceinline__ float rowsum16(float v) { v += dpp_f<0x128>(v); v += dpp_f<0x124>(v); v += dpp_f<0x122>(v); v += dpp_f<0x121>(v); return v; }

namespace pg8 {
template <int ACT> struct EpiBf16A {
    static constexpr bool PERM = true, AFTER_DRAIN = false;
    bf16_t* O; int ldc; const float* ssq;
    __device__ __forceinline__ void operator()(const f32x4 (&acc)[2][2][4][2], const Unit& u, int wr, int wc, int fr, int fq) const {
        const int row0 = u.pm * BM + wr * 64 + fr, col0 = u.pn * BM + wc * 32 + 8 * fq;
#pragma unroll
        for (int ai = 0; ai < 2; ++ai)
#pragma unroll
            for (int m = 0; m < 4; ++m) { bf16_t* rowp = O + (size_t)(row0 + ai * HALF + m * 16) * ldc + col0;
                const float rs = ssq ? 1.0f / sqrtf(ssq[row0 + ai * HALF + m * 16] * (1.0f / 2048.0f) + 1e-6f) : 1.0f;
#pragma unroll
                for (int bj = 0; bj < 2; ++bj) { f32x4 v0 = acc[ai][bj][m][0] * rs, v1 = acc[ai][bj][m][1] * rs;
                    if (ACT == 3) {
#pragma unroll
                        for (int j = 0; j < 4; ++j) { const float a = fmaxf(v0[j], 0.f), b = fmaxf(v1[j], 0.f); v0[j] = a * a; v1[j] = b * b; } }
                    u32x4 w; w.x = cvt_pk_bf16(v0[0], v0[1]); w.y = cvt_pk_bf16(v0[2], v0[3]); w.z = cvt_pk_bf16(v1[0], v1[1]); w.w = cvt_pk_bf16(v1[2], v1[3]);
                    *(u32x4*)(rowp + bj * HALF) = w; } }
    }
};
struct EpiRes {
    static constexpr bool PERM = false, AFTER_DRAIN = false;
    float* X; int ldc; float sc; const float* Xin;
    __device__ __forceinline__ void operator()(const f32x4 (&acc)[2][2][4][2], const Unit& u, int wr, int wc, int fr, int fq) const {
        const int row0 = u.pm * BM + wr * 64 + fr, col0 = u.pn * BM + wc * 32 + 4 * fq;
#pragma unroll
        for (int ai = 0; ai < 2; ++ai)
#pragma unroll
            for (int m = 0; m < 4; ++m) { float* rowp = X + (size_t)(row0 + ai * HALF + m * 16) * ldc + col0; const float* inp = Xin + (size_t)(row0 + ai * HALF + m * 16) * ldc + col0;
                f32x4 o[2][2];
#pragma unroll
                for (int bj = 0; bj < 2; ++bj)
#pragma unroll
                    for (int n = 0; n < 2; ++n) o[bj][n] = *(const f32x4*)(inp + bj * HALF + n * 16);
#pragma unroll
                for (int bj = 0; bj < 2; ++bj)
#pragma unroll
                    for (int n = 0; n < 2; ++n) *(f32x4*)(rowp + bj * HALF + n * 16) = o[bj][n] + acc[ai][bj][m][n] * sc; }
    }
};
struct EpiMemKV {
    static constexpr bool PERM = false, AFTER_DRAIN = false;
    float* outK; bf16_t* MKb; bf16_t* MVT;
    __device__ __forceinline__ void operator()(const f32x4 (&acc)[2][2][4][2], const Unit& u, int wr, int wc, int fr, int fq) const {
        const int cbase = u.pn * BM, lyr = cbase >> 12, cc = cbase & 4095; const bool isV = cc >= 2048; const int colt = cc & 2047;
        const int row0 = u.pm * BM + wr * 64 + fr, col0 = colt + wc * 32 + 4 * fq;
        float* outp = outK + (isV ? (size_t)(O_MVP - O_MKP) : (size_t)0);
#pragma unroll
        for (int ai = 0; ai < 2; ++ai)
#pragma unroll
            for (int m = 0; m < 4; ++m) { const int r = row0 + ai * HALF + m * 16;
#pragma unroll
                for (int bj = 0; bj < 2; ++bj)
#pragma unroll
                    for (int n = 0; n < 2; ++n) { const int col = col0 + bj * HALF + n * 16; const f32x4 v = acc[ai][bj][m][n];
                        *(f32x4*)(outp + ((size_t)lyr * 1024 + r) * 2048 + col) = v;
                        if (!isV) { unsigned lo = cvt_pk_bf16(v[0], v[1]), hi = cvt_pk_bf16(v[2], v[3]); *(unsigned long long*)(MKb + ((size_t)lyr * 1024 + r) * 2048 + col) = ((unsigned long long)hi << 32) | lo; }
                        else { const int b = r >> 8, j = r & 255, h = col >> 9, e = col & 511; bf16_t* tp = MVT + ((((size_t)lyr * 4 + b) * 4 + h) * 512 + e) * 256 + j;
                            const unsigned lo = cvt_pk_bf16(v[0], v[1]), hi = cvt_pk_bf16(v[2], v[3]);
                            tp[0] = (bf16_t)(lo & 0xffffu); tp[256] = (bf16_t)(lo >> 16); tp[512] = (bf16_t)(hi & 0xffffu); tp[768] = (bf16_t)(hi >> 16); } } }
    }
};
}

struct SEpiBf16 { bf16* O; int ldc; int act; const float* ssq;
    __device__ __forceinline__ void operator()(int row, int col0, f32x4 v, int) const {
        if (ssq) v = v * (1.0f / sqrtf(ssq[row] * (1.0f / 2048.0f) + 1e-6f));
        if (act == 3) {
#pragma unroll
            for (int j = 0; j < 4; ++j) { const float a = fmaxf(v[j], 0.f); v[j] = a * a; } }
        v2u w; w.x = pk2(v[0], v[1]); w.y = pk2(v[2], v[3]); *(v2u*)(O + (size_t)row * ldc + col0) = w; } };
struct SEpiRes { float* X; int ldc; float sc; const float* Xin;
    __device__ __forceinline__ void operator()(int row, int col0, f32x4 v, int) const { *(f32x4*)(X + (size_t)row * ldc + col0) = *(const f32x4*)(Xin + (size_t)row * ldc + col0) + v * sc; } };
struct SEpiPart { float* S; int ldc;
    __device__ __forceinline__ void operator()(int row, int col0, f32x4 v, int kp) const { *(f32x4*)(S + ((size_t)kp * NS + row) * ldc + col0) = v; } };
template <class F> __device__ __forceinline__ void sample_gemm(LAS unsigned char* lds, int tid_in, const bf16* A, int lda, const bf16* Bt, int ntot, int N, int K, int G, int bid, const F& epi, int nks = 1) {
    int tid_ = tid_in; asm volatile("" : "+v"(tid_));
    const int lane = tid_ & 63, wave = __builtin_amdgcn_readfirstlane(tid_ >> 6), fr = lane & 15, fq = lane >> 4;
    const int KS = (K / nks) >> 3, ncu = N / 16;
    LAS f32x4* red = (LAS f32x4*)lds;
    const unsigned voffa = (unsigned)(fr * lda + fq * 8) * 2u, voffb = (unsigned)(fr * 64 + fq * 8) * 2u;
    for (int uu = bid; uu < ncu * nks; uu += G) { const int kp = uu / ncu, u = uu - kp * ncu, kbeg = kp * (K / nks) + wave * KS;
        const char* bp = (const char*)(Bt + ((size_t)(kbeg >> 6) * ntot + u * 16) * 64);
        const char* ap = (const char*)(A + kbeg);
        f32x4 acc[8];
#pragma unroll
        for (int rt = 0; rt < 8; ++rt) acc[rt] = zero4();
        bf16x8 b0[2], a0[2][8], b1[2], a1[2][8];
#define SG_LOAD(bb, aa, kq) do { _Pragma("unroll") for (int s = 0; s < 2; ++s) { bb[s] = *(const bf16x8*)(bp + ((size_t)((kq) >> 6) * ntot * 64 + 32 * s) * 2 + voffb); \
            _Pragma("unroll") for (int rt = 0; rt < 8; ++rt) aa[s][rt] = *(const bf16x8*)(ap + ((size_t)rt * 16 * lda + (kq) + 32 * s) * 2 + voffa); } } while (0)
#define SG_MMA(bb, aa) do { _Pragma("unroll") for (int s = 0; s < 2; ++s) _Pragma("unroll") for (int rt = 0; rt < 8; ++rt) acc[rt] = __builtin_amdgcn_mfma_f32_16x16x32_bf16(bb[s], aa[s][rt], acc[rt], 0, 0, 0); } while (0)
        SG_LOAD(b0, a0, 0);
        for (int k0 = 0; k0 < KS; k0 += 128) {
            SG_LOAD(b1, a1, k0 + 64);
            SG_MMA(b0, a0);
            if (k0 + 128 < KS) SG_LOAD(b0, a0, k0 + 128);
            SG_MMA(b1, a1);
        }
#undef SG_LOAD
#undef SG_MMA
#pragma unroll
        for (int rt = 0; rt < 8; ++rt) red[(wave * 8 + rt) * 64 + lane] = acc[rt];
        __syncthreads();
        f32x4 sum = red[wave * 64 + lane];
#pragma unroll
        for (int ks = 1; ks < 8; ++ks) sum += red[(ks * 8 + wave) * 64 + lane];
        epi(wave * 16 + fr, u * 16 + 4 * fq, sum, kp);
        __syncthreads();
    }
}
#define XB_TMO      128
#define XB_XCNT(j)  (256  + 64 * (j))
#define XB_XSUB(j)  (1280 + 64 * (j))
#define XB_XGEN(j)  (2304 + 64 * (j))
#define XB_TOP      3328
#define XB_TOPGEN   3392
#define XCD_BAR_WORDS 3456
#define XB_SPIN_CAP (1u << 18)

__device__ __forceinline__ unsigned xb_ld(unsigned* p)              { return __hip_atomic_load(p, __ATOMIC_RELAXED, __HIP_MEMORY_SCOPE_AGENT); }
__device__ __forceinline__ unsigned xb_add(unsigned* p, unsigned v) { return __hip_atomic_fetch_add(p, v, __ATOMIC_RELAXED, __HIP_MEMORY_SCOPE_AGENT); }
__device__ __forceinline__ unsigned xb_xcc_id() { return (unsigned)__builtin_amdgcn_s_getreg((3 << 11) | 20) & 0xFu; }
#define XB_SPIN(cond, bar) do { unsigned _sp = 0; while (cond) { __builtin_amdgcn_s_sleep(1); \
    if ((++_sp & 255u) == 0u) { if (xb_ld(&(bar)[XB_TMO])) break; if (_sp > XB_SPIN_CAP) { atomicAdd(&(bar)[XB_TMO], 1u); break; } } } } while (0)

struct XcdBarrier {
    int wave;
    unsigned* bar; unsigned x;
    volatile LAS unsigned* st;
};

__device__ __forceinline__ XcdBarrier xcd_barrier_post(unsigned* bar, volatile LAS unsigned* st) {
    XcdBarrier b; b.bar = bar; b.x = xb_xcc_id(); b.st = st;
    if (threadIdx.x == 0) (void)xb_add(&bar[XB_XCNT(b.x)], 1u);
    return b;
}
__device__ __forceinline__ void xcd_barrier_complete(unsigned* bar, unsigned x, unsigned& nloc, unsigned& nx) {
    const unsigned G = gridDim.x * gridDim.y * gridDim.z;
    unsigned sum, cnt, mine, sp = 0u;
    for (;;) {
        sum = 0u; cnt = 0u; mine = 0u;
#pragma unroll
        for (unsigned j = 0; j < 16; ++j) { const unsigned c = xb_ld(&bar[XB_XCNT(j)]); sum += c; cnt += (c > 0u) ? 1u : 0u; mine = (j == x) ? c : mine; }
        if (sum == G) break;
        __builtin_amdgcn_s_sleep(1);
        if ((++sp & 255u) == 0u) { if (xb_ld(&bar[XB_TMO])) break; if (sp > XB_SPIN_CAP) { atomicAdd(&bar[XB_TMO], 1u); break; } }
    }
    nloc = mine > 0u ? mine : 1u; nx = cnt > 0u ? cnt : 1u;
}

__device__ __forceinline__ void xcd_barrier(const XcdBarrier& b) {
    asm volatile("s_waitcnt vmcnt(0)" ::: "memory");
    __syncthreads();
    unsigned xbz = 0u; asm volatile("" : "+v"(xbz));
    if (b.wave == 0 && __builtin_amdgcn_mbcnt_hi(~0u, __builtin_amdgcn_mbcnt_lo(~0u, xbz)) == 0u) {
        unsigned* bar = b.bar;
        __builtin_amdgcn_s_waitcnt(0);
        unsigned nloc = b.st[0], nx = b.st[1];
        if (nloc == 0u) { xcd_barrier_complete(bar, b.x, nloc, nx); b.st[0] = nloc; b.st[1] = nx; }
        const unsigned old = xb_add(&bar[XB_XSUB(b.x)], 1u);
        const unsigned gen = old / nloc;
        if (old + 1u == (gen + 1u) * nloc) {
            __builtin_amdgcn_fence(__ATOMIC_RELEASE, "agent");
            asm volatile("s_waitcnt vmcnt(0)" ::: "memory");
            const unsigned og = xb_add(&bar[XB_TOP], 1u);
            const unsigned tg = og / nx;
            if (og + 1u == (tg + 1u) * nx) xb_add(&bar[XB_TOPGEN], 1u);
            else XB_SPIN(xb_ld(&bar[XB_TOPGEN]) == tg, bar);
            __builtin_amdgcn_fence(__ATOMIC_ACQUIRE, "agent");
            xb_add(&bar[XB_XGEN(b.x)], 1u);
            asm volatile("s_waitcnt vmcnt(0)" ::: "memory");
        } else {
            XB_SPIN(xb_ld(&bar[XB_XGEN(b.x)]) == gen, bar);
            __builtin_amdgcn_fence(__ATOMIC_ACQUIRE, "agent");
            asm volatile("s_waitcnt vmcnt(0)" ::: "memory");
        }
    }
    __syncthreads();
}

struct Args { const float* in[NIN]; float* out; unsigned char* ws; int ph_lo, ph_hi; };
enum { I_XP = 0, I_XS, I_MEM, I_SCA, I_SRET, I_SSH, I_SWKV, I_SCD, I_CMK, I_CMV, I_GMIX, I_WIN, I_CAW, I_MU, I_W0, I_W2, I_A0, I_A2, I_G2, I_KK, I_KA, I_RK, I_LNXG, I_LNXB,
       I_CDW, I_CDB, I_LNDG, I_LNDB, I_WOUT, I_GXA, I_GMEM, I_WQ, I_WK, I_WV, I_WO, I_GMLP, I_WUP, I_WDN, I_GFIN };

struct Ctx { LAS unsigned char* lds; int tid, lane, wave, G, bid; };
typedef const GAS float* gcfp;
#define CAS __attribute__((address_space(4)))
struct Ax { const CAS gcfp* kp; float* out; unsigned char* ws;
    __device__ __forceinline__ const float* in(int i) const { return (const float*)kp[i]; } };
__device__ __forceinline__ Ax mk_ax() { const CAS gcfp* kp = (const CAS gcfp*)__builtin_amdgcn_kernarg_segment_ptr(); asm volatile("" : "+s"(kp)); Ax a; a.kp = kp;
    a.out = (float*)(GAS float*)kp[NIN]; a.ws = (unsigned char*)(GAS unsigned char*)kp[NIN + 1]; return a; }
__device__ __forceinline__ Ctx mk_ctx(LAS unsigned char* lds, int wave_s) { unsigned z = 0u; asm volatile("" : "+v"(z)); int t = wave_s * 64 + (int)__builtin_amdgcn_mbcnt_hi(~0u, __builtin_amdgcn_mbcnt_lo(~0u, z)); Ctx C; C.lds = lds; C.tid = t; C.lane = t & 63; C.wave = __builtin_amdgcn_readfirstlane(t >> 6); C.G = gridDim.x; C.bid = blockIdx.x; return C; }

__device__ __forceinline__ void p0_transpose_item(const float* W, int K, int N, bf16* WT, int ldk, int row_off, LAS float* scr, int item, int lane, const float* gain) {
    const int nblk = N / 64, kb = item / nblk, nb = item - kb * nblk, k0 = 64 * kb, n0 = 64 * nb;
    const int lr = lane >> 4, lc = (lane & 15) * 4;
#pragma unroll 8
    for (int i = 0; i < 16; ++i) { const int kk = 4 * i + lr; const float g = gain ? gain[k0 + kk] : 1.0f; const f32x4 v = *(const f32x4*)(W + (size_t)(k0 + kk) * N + n0 + lc);
        LAS float* d = scr + kk * 65 + lc; d[0] = v.x * g; d[1] = v.y * g; d[2] = v.z * g; d[3] = v.w * g; }
    LDS_WAIT(); asm volatile("" ::: "memory");
    const int c = lane & 7;
#pragma unroll
    for (int j = 0; j < 8; ++j) { const int n = (lane >> 3) + 8 * j; const LAS float* s = scr + (8 * c) * 65 + n;
        v4u o; o.x = pk2(s[0 * 65], s[1 * 65]); o.y = pk2(s[2 * 65], s[3 * 65]); o.z = pk2(s[4 * 65], s[5 * 65]); o.w = pk2(s[6 * 65], s[7 * 65]);
        if (ldk > 0) *(v4u*)(WT + (size_t)(row_off + n0 + n) * ldk + k0 + 8 * c) = o;
        else *(v4u*)(WT + ((size_t)kb * (size_t)(-ldk) + row_off + n0 + n) * 64 + 8 * c) = o; }
    LDS_WAIT(); asm volatile("" ::: "memory");
}
__device__ __forceinline__ void rms_row(const float* xrow, bf16* orow, float* xcopy, int lane) {
    const f32x4* xr = (const f32x4*)xrow + lane;
    f32x4 v[8]; float s = 0.f;
#pragma unroll
    for (int j = 0; j < 8; ++j) { v[j] = xr[64 * j]; s += (v[j].x * v[j].x + v[j].y * v[j].y) + (v[j].z * v[j].z + v[j].w * v[j].w); }
    const float rs = 1.0f / sqrtf(wave_sum(s) * (1.0f / DM) + 1e-6f);
    if (xcopy) {
#pragma unroll
        for (int j = 0; j < 8; ++j) ((f32x4*)xcopy + lane)[64 * j] = v[j]; }
    unsigned long long* o8 = (unsigned long long*)orow + lane;
#pragma unroll
    for (int j = 0; j < 8; ++j) o8[64 * j] = (unsigned long long)pk2(v[j].x * rs, v[j].y * rs) | ((unsigned long long)pk2(v[j].z * rs, v[j].w * rs) << 32);
}
__device__ __forceinline__ void rms_phase(const Ctx& C, const float* X, bf16* HN) {
    const int gw = C.bid * NWAVES + C.wave, NGW = C.G * NWAVES;
    f32x4 v[8], nx[8]; int m = gw;
    if (m < MT) { const f32x4* xr = (const f32x4*)(X + (size_t)m * DM) + C.lane;
#pragma unroll
        for (int j = 0; j < 8; ++j) v[j] = xr[64 * j]; }
    for (; m < MT; m += NGW) {
        const int mn = m + NGW;
        if (mn < MT) { const f32x4* xr = (const f32x4*)(X + (size_t)mn * DM) + C.lane;
#pragma unroll
            for (int j = 0; j < 8; ++j) nx[j] = xr[64 * j]; }
        float s = 0.f;
#pragma unroll
        for (int j = 0; j < 8; ++j) s += (v[j].x * v[j].x + v[j].y * v[j].y) + (v[j].z * v[j].z + v[j].w * v[j].w);
        const float rs = 1.0f / sqrtf(wave_sum(s) * (1.0f / DM) + 1e-6f);
        unsigned long long* o8 = (unsigned long long*)(HN + (size_t)m * DM) + C.lane;
#pragma unroll
        for (int j = 0; j < 8; ++j) o8[64 * j] = (unsigned long long)pk2(v[j].x * rs, v[j].y * rs) | ((unsigned long long)pk2(v[j].z * rs, v[j].w * rs) << 32);
#pragma unroll
        for (int j = 0; j < 8; ++j) v[j] = nx[j];
    }
}
__device__ __forceinline__ void fold_split_rows(const Ctx& C, float* X, const float* S) {
    const int gw = C.bid * NWAVES + C.wave, NGW = C.G * NWAVES;
    for (int r = gw; r < NS; r += NGW) { f32x4* xr = (f32x4*)(X + (size_t)(MP + r) * DM) + C.lane; const f32x4* s0 = (const f32x4*)(S + (size_t)r * DM) + C.lane; const f32x4* s1 = (const f32x4*)(S + (size_t)(NS + r) * DM) + C.lane;
#pragma unroll
        for (int j = 0; j < 8; ++j) xr[64 * j] = xr[64 * j] + (s0[64 * j] + s1[64 * j]); }
    asm volatile("s_waitcnt vmcnt(0)" ::: "memory");
}
__device__ __forceinline__ void final_norm_phase(const Ctx& C, const float* X, const float* g, float* out) {
    const int gw = C.bid * NWAVES + C.wave, NGW = C.G * NWAVES;
    for (int m = gw; m < MT; m += NGW) {
        const f32x4* xr = (const f32x4*)(X + (size_t)m * DM) + C.lane; const f32x4* gr = (const f32x4*)g + C.lane;
        f32x4 v[8]; float s = 0.f;
#pragma unroll
        for (int j = 0; j < 8; ++j) { v[j] = xr[64 * j]; s += (v[j].x * v[j].x + v[j].y * v[j].y) + (v[j].z * v[j].z + v[j].w * v[j].w); }
        const float rs = 1.0f / sqrtf(wave_sum(s) * (1.0f / DM) + 1e-6f);
        f32x4* orow = (f32x4*)(out + (size_t)m * DM) + C.lane;
#pragma unroll
        for (int j = 0; j < 8; ++j) orow[64 * j] = v[j] * rs * gr[64 * j];
    }
}
struct TDesc { const float* W; const float* gain; bf16* WT; int K, N, ldk, row_off, item; };
__device__ __forceinline__ TDesc p0_desc(const Ax& a, int it, int G) {
    constexpr int I_IN = 32 * 100, I_SQ = 32 * 32, I_UP = 32 * 128, I_DN = 128 * 32, I_L64 = 8, I_L128 = 16;
    constexpr int PER_LAYER = I_IN + 5 * I_SQ + I_UP + I_DN + 2 * I_L64 + I_L128;
    const int l = it / PER_LAYER; int r = it - l * PER_LAYER; unsigned char* wl = a.ws + WS_WL + (size_t)l * LW_STRIDE; bf16* wkv = (bf16*)(a.ws + WS_WKV);
    TDesc d; d.row_off = 0; d.gain = nullptr;
    if (r < I_IN) { d.W = a.in(I_WIN) + (size_t)l * DM * PIN; d.K = DM; d.N = PIN; d.WT = (bf16*)(wl + LW_IN); d.ldk = -PIN; d.gain = a.in(I_GMIX) + l * DM; d.item = r; return d; } r -= I_IN;
    if (r < I_SQ) { d.W = a.in(I_WOUT) + (size_t)l * DM * DM; d.K = DM; d.N = DM; d.WT = (bf16*)(wl + LW_OUT); d.ldk = -DM; d.item = r; return d; } r -= I_SQ;
    if (r < I_SQ) { d.W = a.in(I_WQ) + (size_t)l * DM * DM; d.K = DM; d.N = DM; d.WT = (bf16*)(wl + LW_Q); d.ldk = -DM; d.gain = a.in(I_GXA) + l * DM; d.item = r; return d; } r -= I_SQ;
    if (r < I_SQ) { d.W = a.in(I_WO) + (size_t)l * DM * DM; d.K = DM; d.N = DM; d.WT = (bf16*)(wl + LW_O); d.ldk = -DM; d.item = r; return d; } r -= I_SQ;
    if (r < I_SQ) { d.W = a.in(I_WK) + (size_t)l * DM * DM; d.K = DM; d.N = DM; d.WT = wkv; d.ldk = -8192; d.row_off = l * 4096; d.gain = a.in(I_GMEM) + l * DM; d.item = r; return d; } r -= I_SQ;
    if (r < I_SQ) { d.W = a.in(I_WV) + (size_t)l * DM * DM; d.K = DM; d.N = DM; d.WT = wkv; d.ldk = -8192; d.row_off = l * 4096 + 2048; d.gain = a.in(I_GMEM) + l * DM; d.item = r; return d; } r -= I_SQ;
    const bool late = (l + 1 == DEPTH) && G == 256;
    if (r < I_UP) { d.W = a.in(I_WUP) + (size_t)l * DM * DFF; d.K = DM; d.N = DFF; d.WT = (bf16*)(wl + LW_UP); d.ldk = -DFF; d.gain = a.in(I_GMLP) + l * DM; d.item = late ? -1 : r; return d; } r -= I_UP;
    if (r < I_DN) { d.W = a.in(I_WDN) + (size_t)l * DFF * DM; d.K = DFF; d.N = DM; d.WT = (bf16*)(wl + LW_DN); d.ldk = -DM; d.item = late ? -1 : r; return d; } r -= I_DN;
    if (r < I_L64) { d.W = a.in(I_W2) + (size_t)l * 64 * 512; d.K = 64; d.N = 512; d.WT = (bf16*)(wl + LW_W2); d.ldk = 64; d.item = r; return d; } r -= I_L64;
    if (r < I_L64) { d.W = a.in(I_A2) + (size_t)l * 64 * 512; d.K = 64; d.N = 512; d.WT = (bf16*)(wl + LW_A2); d.ldk = 64; d.item = r; return d; } r -= I_L64;
    d.W = a.in(I_G2) + (size_t)l * 128 * 512; d.K = 128; d.N = 512; d.WT = (bf16*)(wl + LW_G2); d.ldk = 128; d.item = r; return d;
}
__device__ __forceinline__ void p0_load(const TDesc& d, int lane, f32x4 (&v)[16], float (&g)[16]) {
    if (d.item < 0) return;
    const int nblk = d.N / 64, kb = d.item / nblk, nb = d.item - kb * nblk, k0 = 64 * kb, n0 = 64 * nb, lr = lane >> 4, lc = (lane & 15) * 4;
#pragma unroll
    for (int i = 0; i < 16; ++i) { const int kk = 4 * i + lr; g[i] = d.gain ? d.gain[k0 + kk] : 1.0f; v[i] = __builtin_nontemporal_load((const f32x4*)(d.W + (size_t)(k0 + kk) * d.N + n0 + lc)); }
}
__device__ __forceinline__ void p0_finish(const TDesc& d, LAS float* scr, int lane, const f32x4 (&v)[16], const float (&g)[16]) {
    if (d.item < 0) return;
    const int nblk = d.N / 64, kb = d.item / nblk, nb = d.item - kb * nblk, k0 = 64 * kb, n0 = 64 * nb, lr = lane >> 4, lc = (lane & 15) * 4;
#pragma unroll
    for (int i = 0; i < 16; ++i) { const int kk = 4 * i + lr; LAS float* p = scr + kk * 65 + lc; p[0] = v[i].x * g[i]; p[1] = v[i].y * g[i]; p[2] = v[i].z * g[i]; p[3] = v[i].w * g[i]; }
    LDS_WAIT(); asm volatile("" ::: "memory");
    const int c = lane & 7;
#pragma unroll
    for (int j = 0; j < 8; ++j) { const int n = (lane >> 3) + 8 * j; const LAS float* s = scr + (8 * c) * 65 + n;
        v4u o; o.x = pk2(s[0 * 65], s[1 * 65]); o.y = pk2(s[2 * 65], s[3 * 65]); o.z = pk2(s[4 * 65], s[5 * 65]); o.w = pk2(s[6 * 65], s[7 * 65]);
        if (d.ldk > 0) *(v4u*)(d.WT + (size_t)(d.row_off + n0 + n) * d.ldk + k0 + 8 * c) = o;
        else *(v4u*)(d.WT + ((size_t)kb * (size_t)(-d.ldk) + d.row_off + n0 + n) * 64 + 8 * c) = o; }
    LDS_WAIT(); asm volatile("" ::: "memory");
}
__device__ __forceinline__ void p0_prologue(const Ctx& C, const Ax& a) {
    LAS float* scr = (LAS float*)(C.lds + C.wave * 16640);
    const int gw = C.bid * NWAVES + C.wave, NGW = C.G * NWAVES;
    constexpr int I_IN = 32 * 100, I_SQ = 32 * 32, I_UP = 32 * 128, I_DN = 128 * 32, I_L64 = 8, I_L128 = 16;
    constexpr int PER_LAYER = I_IN + 5 * I_SQ + I_UP + I_DN + 2 * I_L64 + I_L128;
    TDesc cur = p0_desc(a, gw, C.G), nxt; f32x4 va[16], vb[16]; float ga[16], gb[16];
    const int NITEMS = DEPTH * PER_LAYER;
    if (gw < NITEMS) p0_load(cur, C.lane, va, ga);
    for (int it = gw; it < NITEMS; it += 2 * NGW) {
        const int it1 = it + NGW, it2 = it + 2 * NGW;
        if (it1 < NITEMS) { nxt = p0_desc(a, it1, C.G); p0_load(nxt, C.lane, vb, gb); }
        p0_finish(cur, scr, C.lane, va, ga);
        if (it1 < NITEMS) { if (it2 < NITEMS) { cur = p0_desc(a, it2, C.G); p0_load(cur, C.lane, va, ga); }
            p0_finish(nxt, scr, C.lane, vb, gb); }
    }
    { float* cs = (float*)(a.ws + WS_ROPE); const int gt = C.bid * (NWAVES * 64) + C.tid, NT = C.G * NWAVES * 64;
      for (int idx = gt; idx < 2049 * 64; idx += NT) { const int p = idx >> 6, i = idx & 63; const double pos = (p == 2048) ? 16384.0 : (double)p;
          const double inv = exp(-(double)i * (9.210340371976184 / 64.0)); double r = pos * inv; r -= 6.283185307179586 * rint(r * 0.15915494309189535);
          cs[2 * idx] = (float)cos(r); cs[2 * idx + 1] = (float)sin(r); } }
    float* XF = (float*)(a.ws + WS_XF); bf16* HN = (bf16*)(a.ws + WS_HN); bf16* MN = (bf16*)(a.ws + WS_MN);
    for (int m = gw; m < MT; m += NGW) { const float* src = (m < MP) ? a.in(I_XP) + (size_t)m * DM : a.in(I_XS) + (size_t)(m - MP) * DM; rms_row(src, HN + (size_t)m * DM, nullptr, C.lane); }
    for (int m = gw; m < MMEM; m += NGW) rms_row(a.in(I_MEM) + (size_t)m * DM, MN + (size_t)m * DM, nullptr, C.lane);
}

__device__ __forceinline__ void late_convert(const Ctx& C, const Ax& a, int l, int rank, int nrank) {
    LAS float* scr = (LAS float*)(C.lds + C.wave * 16640);
    unsigned char* wl = a.ws + WS_WL + (size_t)l * LW_STRIDE;
    constexpr int I_UP = 32 * 128, I_DN = 128 * 32;
    for (int it = rank * NWAVES + C.wave; it < I_UP + I_DN; it += nrank * NWAVES) {
        if (it < I_UP) p0_transpose_item(a.in(I_WUP) + (size_t)l * DM * DFF, DM, DFF, (bf16*)(wl + LW_UP), -DFF, 0, scr, it, C.lane, a.in(I_GMLP) + l * DM);
        else p0_transpose_item(a.in(I_WDN) + (size_t)l * DFF * DM, DFF, DM, (bf16*)(wl + LW_DN), -DM, 0, scr, it - I_UP, C.lane, nullptr); }
}
__device__ __forceinline__ void ad_prompt_item(const Ctx& C, const Ax& a, int l, int item) {
    const bf16* P = (const bf16*)(a.ws + WS_P); bf16* YC = (bf16*)(a.ws + WS_YC);
    const int b = item >> 6, t0 = (item & 63) * 32; const size_t rbase = (size_t)b * SEQ;
    LAS float* UD = (LAS float*)C.lds;
#pragma unroll 4
    for (int it = C.tid; it < 62 * 64; it += NWAVES * 64) { const int r = it >> 6, cc = it & 63, t = t0 - 30 + r;
        float u[8];
        if (t >= 0) { const bf16* pr = P + (rbase + t) * PIN + PD_ + cc * 8; float d1[8], d2[8]; unpack8(*(const v4u*)pr, d1); unpack8(*(const v4u*)(pr + 512), d2);
#pragma unroll
            for (int j = 0; j < 8; ++j) u[j] = d1[j] * sigm(d2[j]); }
        else {
#pragma unroll
            for (int j = 0; j < 8; ++j) u[j] = 0.f; }
        *(LAS f32x4*)(UD + r * 512 + cc * 8) = (f32x4){u[0], u[1], u[2], u[3]}; *(LAS f32x4*)(UD + r * 512 + cc * 8 + 4) = (f32x4){u[4], u[5], u[6], u[7]}; }
    { const float* cw = a.in(I_CAW) + (size_t)l * 3 * 512;
#pragma unroll 2
      for (int it = C.tid; it < 32 * 64; it += NWAVES * 64) { const int r = it >> 6, cc = it & 63, t = t0 + r; const bf16* pr = P + (rbase + t) * PIN + cc * 8;
        float ab[8], u0[8], u1[8], u2[8], x[8], y[8];
        unpack8(*(const v4u*)pr, ab); unpack8(*(const v4u*)(pr + 512), x); unpack8(*(const v4u*)(pr + 1024), y);
#pragma unroll
        for (int j = 0; j < 8; ++j) u2[j] = x[j] * y[j];
        if (t >= 1) { unpack8(*(const v4u*)(pr - PIN + 512), x); unpack8(*(const v4u*)(pr - PIN + 1024), y);
#pragma unroll
            for (int j = 0; j < 8; ++j) u1[j] = x[j] * y[j]; }
        else {
#pragma unroll
            for (int j = 0; j < 8; ++j) u1[j] = 0.f; }
        if (t >= 2) { unpack8(*(const v4u*)(pr - 2 * PIN + 512), x); unpack8(*(const v4u*)(pr - 2 * PIN + 1024), y);
#pragma unroll
            for (int j = 0; j < 8; ++j) u0[j] = x[j] * y[j]; }
        else {
#pragma unroll
            for (int j = 0; j < 8; ++j) u0[j] = 0.f; }
        float o[8];
#pragma unroll
        for (int j = 0; j < 8; ++j) { const int c = cc * 8 + j; o[j] = ab[j] * (cw[c] * u0[j] + cw[512 + c] * u1[j] + cw[1024 + c] * u2[j]); }
        *(v4u*)(YC + (rbase + t) * DM + cc * 8) = pack8(o);
        if (t >= SEQ - 2) { float* st = a.out + O_CAP + (((size_t)l * NB + b) * 2 + (t - (SEQ - 2))) * 512 + cc * 8; *(f32x4*)st = (f32x4){u2[0], u2[1], u2[2], u2[3]}; *(f32x4*)(st + 4) = (f32x4){u2[4], u2[5], u2[6], u2[7]}; } } }
    __syncthreads();
    const int c = C.tid;
    if (t0 == SEQ - 32) { float* st = a.out + O_CDP + ((size_t)l * NB + b) * 30 * 512 + c;
        for (int j = 0; j < 30; ++j) st[(size_t)j * 512] = UD[(32 + j) * 512 + c]; }
    float cv[32];
    { const float* cw = a.in(I_CDW) + (size_t)l * 31 * 512 + c; const float bias = a.in(I_CDB)[l * 512 + c];
#pragma unroll
      for (int hf = 0; hf < 2; ++hf) {
        float u[46];
#pragma unroll
        for (int r = 0; r < 46; ++r) u[r] = UD[(hf * 16 + r) * 512 + c];
#pragma unroll
        for (int t = 0; t < 16; ++t) cv[hf * 16 + t] = bias;
#pragma unroll
        for (int j = 0; j < 31; ++j) { const float w = cw[(size_t)j * 512];
#pragma unroll
            for (int t = 0; t < 16; ++t) cv[hf * 16 + t] += w * u[t + j]; }
        asm volatile("" ::: "memory"); } }
    __syncthreads();
#pragma unroll
    for (int t = 0; t < 32; ++t) UD[t * 512 + c] = cv[t];
    __syncthreads();
    { const float* lg = a.in(I_LNDG) + l * 512 + C.lane * 8; const float* lb = a.in(I_LNDB) + l * 512 + C.lane * 8;
      const f32x4 g0 = *(const f32x4*)lg, g1 = *(const f32x4*)(lg + 4), b0 = *(const f32x4*)lb, b1 = *(const f32x4*)(lb + 4);
#pragma unroll
      for (int q = 0; q < 4; ++q) { const int t = C.wave * 4 + q; const f32x4 x0 = *(LAS f32x4*)(UD + t * 512 + C.lane * 8), x1 = *(LAS f32x4*)(UD + t * 512 + C.lane * 8 + 4);
        const float mu = wave_sum((x0.x + x0.y) + (x0.z + x0.w) + (x1.x + x1.y) + (x1.z + x1.w)) * (1.0f / 512.0f);
        const f32x4 d0 = x0 - mu, d1 = x1 - mu;
        const float var = wave_sum((d0.x * d0.x + d0.y * d0.y) + (d0.z * d0.z + d0.w * d0.w) + (d1.x * d1.x + d1.y * d1.y) + (d1.z * d1.z + d1.w * d1.w)) * (1.0f / 512.0f);
        const float rstd = 1.0f / sqrtf(var + 1e-6f);
        const f32x4 y0 = d0 * rstd * g0 + b0, y1 = d1 * rstd * g1 + b1; float o[8];
        o[0] = y0.x * sigm(y0.x); o[1] = y0.y * sigm(y0.y); o[2] = y0.z * sigm(y0.z); o[3] = y0.w * sigm(y0.w);
        o[4] = y1.x * sigm(y1.x); o[5] = y1.y * sigm(y1.y); o[6] = y1.z * sigm(y1.z); o[7] = y1.w * sigm(y1.w);
        *(v4u*)(YC + (rbase + t0 + t) * DM + 1536 + C.lane * 8) = pack8(o); } }
    __syncthreads();
}
__device__ __forceinline__ void ad_sample_item(const Ctx& C, const Ax& a, int l, int n) {
    const bf16* P = (const bf16*)(a.ws + WS_P); bf16* YC = (bf16*)(a.ws + WS_YC);
    const int c = C.tid; const bf16* pr = P + (size_t)(MP + n) * PIN;
    LAS float* red = (LAS float*)C.lds;
    { const float* st = a.in(I_SCA) + (((size_t)l * NS + n) * 2) * 512 + c; const float s0 = st[0], s1 = st[512];
      const float ua = bf1(pr[512 + c]) * bf1(pr[1024 + c]); const float* cw = a.in(I_CAW) + (size_t)l * 3 * 512 + c;
      const float y = bf1(pr[c]) * (cw[0] * s0 + cw[512] * s1 + cw[1024] * ua);
      YC[(size_t)(MP + n) * DM + c] = (bf16)(pk2(y, 0.f) & 0xffffu);
      float* o = a.out + O_CAS + (((size_t)l * NS + n) * 2) * 512 + c; o[0] = s1; o[512] = ua; }
    const float* st = a.in(I_SCD) + (((size_t)l * NS + n) * 30) * 512 + c; const float* cw = a.in(I_CDW) + (size_t)l * 31 * 512 + c;
    const float ud = bf1(pr[PD_ + c]) * sigm(bf1(pr[PD_ + 512 + c]));
    float cv = a.in(I_CDB)[l * 512 + c] + cw[30 * 512] * ud;
    float* os = a.out + O_CDS + (((size_t)l * NS + n) * 30) * 512 + c;
#pragma unroll 6
    for (int j = 0; j < 30; ++j) { const float s = st[(size_t)j * 512]; cv += cw[(size_t)j * 512] * s; if (j > 0) os[(size_t)(j - 1) * 512] = s; }
    os[29 * 512] = ud;
    float s = wave_sum(cv); if (C.lane == 0) red[C.wave] = s; __syncthreads();
    float mu = 0.f;
#pragma unroll
    for (int w = 0; w < 8; ++w) mu += red[w];
    mu *= (1.0f / 512.0f); const float d = cv - mu;
    s = wave_sum(d * d); if (C.lane == 0) red[8 + C.wave] = s; __syncthreads();
    float var = 0.f;
#pragma unroll
    for (int w = 0; w < 8; ++w) var += red[8 + w];
    const float rstd = 1.0f / sqrtf(var * (1.0f / 512.0f) + 1e-6f);
    const float y = d * rstd * a.in(I_LNDG)[l * 512 + c] + a.in(I_LNDB)[l * 512 + c];
    YC[(size_t)(MP + n) * DM + 1536 + c] = (bf16)(pk2(y * sigm(y), 0.f) & 0xffffu);
    __syncthreads();
}

__device__ __forceinline__ void shift8(const bf16* cur, const bf16* prevb, const float* prevf, const float* mu, float (&xs)[8]) {
    float pc[8], pv[8]; unpack8(*(const v4u*)cur, pc);
    if (prevb) unpack8(*(const v4u*)prevb, pv);
    else if (prevf) { const f32x4 p0 = *(const f32x4*)prevf, p1 = *(const f32x4*)(prevf + 4); pv[0] = p0.x; pv[1] = p0.y; pv[2] = p0.z; pv[3] = p0.w; pv[4] = p1.x; pv[5] = p1.y; pv[6] = p1.z; pv[7] = p1.w; }
    else {
#pragma unroll
        for (int j = 0; j < 8; ++j) pv[j] = 0.f; }
    const f32x4 m0 = *(const f32x4*)mu, m1 = *(const f32x4*)(mu + 4); const float m[8] = {m0.x, m0.y, m0.z, m0.w, m1.x, m1.y, m1.z, m1.w};
#pragma unroll
    for (int j = 0; j < 8; ++j) xs[j] = pc[j] + (pv[j] - pc[j]) * m[j];
}
__device__ __forceinline__ void shift4(const bf16* cur, const bf16* prevb, const float* prevf, const float* mu, float (&xs)[4]) {
    float pc[4], pv[4]; unpack4(*(const v2u*)cur, pc);
    if (prevb) unpack4(*(const v2u*)prevb, pv);
    else if (prevf) { const f32x4 p0 = *(const f32x4*)prevf; pv[0] = p0.x; pv[1] = p0.y; pv[2] = p0.z; pv[3] = p0.w; }
    else { pv[0] = pv[1] = pv[2] = pv[3] = 0.f; }
    const f32x4 m0 = *(const f32x4*)mu;
    xs[0] = pc[0] + (pv[0] - pc[0]) * m0.x; xs[1] = pc[1] + (pv[1] - pc[1]) * m0.y; xs[2] = pc[2] + (pv[2] - pc[2]) * m0.z; xs[3] = pc[3] + (pv[3] - pc[3]) * m0.w;
}
constexpr int PTS = 1544;
__device__ __forceinline__ void shift4_lds(const LAS bf16* cur, const float* mu, float (&xs)[4]) {
    float pc[4], pv[4]; unpack4(*(const LAS v2u*)cur, pc); unpack4(*(const LAS v2u*)(cur - PTS), pv);
    const f32x4 m0 = *(const f32x4*)mu;
    xs[0] = pc[0] + (pv[0] - pc[0]) * m0.x; xs[1] = pc[1] + (pv[1] - pc[1]) * m0.y; xs[2] = pc[2] + (pv[2] - pc[2]) * m0.z; xs[3] = pc[3] + (pv[3] - pc[3]) * m0.w;
}
constexpr int RWB = 896, RW_KK = 256, RW_KB = 384, RW_K = 512, RW_R = 640, RW_V = 768;
__device__ __forceinline__ void rw_st4(unsigned char* rec, int off, int cl, const f32x4 v) { v2u w; w.x = pk2(v[0], v[1]); w.y = pk2(v[2], v[3]); *(v2u*)(rec + off + cl * 2) = w; }
__device__ __forceinline__ f32x4 rw_ld4(const unsigned char* rec, int off, int cl) { float f[4]; unpack4(*(const v2u*)(rec + off + cl * 2), f); return (f32x4){f[0], f[1], f[2], f[3]}; }
#ifndef DUP_SUB
#define DUP_SUB 0u
#endif
#define PREP_REP(k) for (int prep_rep_ = 0; prep_rep_ < 1 + (int)((DUP_SUB >> (k)) & 1u); ++prep_rep_)
__device__ __forceinline__ void rwkv_prep_item(const Ctx& C, const Ax& a, int l, int item) {
    const bf16* P = (const bf16*)(a.ws + WS_P); float* RW = (float*)(a.ws + WS_RW); float* GATE = (float*)(a.ws + WS_GATE);
    const bool smp = item >= 256; const int row0 = smp ? MP + (item - 256) * 32 : (item >> 6) * SEQ + (item & 63) * 32; const int t0 = smp ? 0 : (item & 63) * 32;
    const float* mu = a.in(I_MU) + (size_t)l * SHW; const float* sst = a.in(I_SSH) + (size_t)l * NS * SHW;
    LAS bf16* AW = (LAS bf16*)C.lds; LAS bf16* AA = AW + 32 * 72; LAS bf16* AG = AA + 32 * 72; LAS bf16* PT = AG + 32 * 136;
    for (int it = C.tid; it < 32 * 32; it += NWAVES * 64) { const int r = it >> 5, cc = it & 31, col = 1536 + cc * 8, row = row0 + r; const bf16* cur = P + (size_t)row * PIN + PC_ + col;
        float xs[8];
        if (smp) shift8(cur, nullptr, sst + (size_t)(row - MP) * SHW + col, mu + col, xs);
        else shift8(cur, (t0 + r > 0) ? cur - PIN : nullptr, nullptr, mu + col, xs);
        if (cc < 8) {
#pragma unroll
            for (int j = 0; j < 8; ++j) xs[j] = tanhf(xs[j]);
            *(LAS v4u*)(AW + r * 72 + cc * 8) = pack8(xs); }
        else if (cc < 16) *(LAS v4u*)(AA + r * 72 + (cc - 8) * 8) = pack8(xs);
        else {
#pragma unroll
            for (int j = 0; j < 8; ++j) xs[j] = sigm(xs[j]);
            *(LAS v4u*)(AG + r * 136 + (cc - 16) * 8) = pack8(xs); } }
    if (!smp) { for (int it = C.tid; it < 33 * 192; it += NWAVES * 64) { const int r = it / 192, cc = it - r * 192; v4u v = (v4u){0u, 0u, 0u, 0u};
            if (t0 + r > 0) v = *(const v4u*)(P + (size_t)(row0 + r - 1) * PIN + PC_ + cc * 8);
            *(LAS v4u*)(PT + r * PTS + cc * 8) = v; } }
    if (smp) { float* o = a.out + O_SHS + ((size_t)l * NS + (row0 - MP)) * SHW;
        for (int it = C.tid; it < 32 * 224; it += NWAVES * 64) { const int r = it / 224, cc = it % 224; float f[8]; unpack8(*(const v4u*)(P + (size_t)(row0 + r) * PIN + PC_ + cc * 8), f);
            float* op = o + (size_t)r * SHW + cc * 8; *(f32x4*)op = (f32x4){f[0], f[1], f[2], f[3]}; *(f32x4*)(op + 4) = (f32x4){f[4], f[5], f[6], f[7]}; } }
    else if (t0 == SEQ - 32) { float* o = a.out + O_SHP + ((size_t)l * NB + (item >> 6)) * SHW;
        for (int cc = C.tid; cc < 224; cc += NWAVES * 64) { float f[8]; unpack8(*(const v4u*)(P + (size_t)(row0 + 31) * PIN + PC_ + cc * 8), f);
            *(f32x4*)(o + cc * 8) = (f32x4){f[0], f[1], f[2], f[3]}; *(f32x4*)(o + cc * 8 + 4) = (f32x4){f[4], f[5], f[6], f[7]}; } }
    __syncthreads();
    const int h = C.wave, fr = C.lane & 15, fq = C.lane >> 4;
    const unsigned char* wl = a.ws + WS_WL + (size_t)l * LW_STRIDE;
    const bf16* W2t = (const bf16*)(wl + LW_W2); const bf16* A2t = (const bf16*)(wl + LW_A2); const bf16* G2t = (const bf16*)(wl + LW_G2);
    PREP_REP(23) { constexpr int tp = 0;
        f32x4 acc[4][2];
#pragma unroll
        for (int ct = 0; ct < 4; ++ct)
#pragma unroll
            for (int t2 = 0; t2 < 2; ++t2) acc[ct][t2] = zero4();
#pragma unroll
        for (int ks = 0; ks < 2; ++ks) { bf16x8 af[2], wf[4];
#pragma unroll
            for (int t2 = 0; t2 < 2; ++t2) af[t2] = *(const LAS bf16x8*)(AA + (tp * 32 + t2 * 16 + fr) * 72 + ks * 32 + fq * 8);
#pragma unroll
            for (int ct = 0; ct < 4; ++ct) wf[ct] = *(const bf16x8*)(A2t + (size_t)(h * 64 + ct * 16 + fr) * 64 + ks * 32 + fq * 8);
#pragma unroll
            for (int ct = 0; ct < 4; ++ct)
#pragma unroll
                for (int t2 = 0; t2 < 2; ++t2) acc[ct][t2] = __builtin_amdgcn_mfma_f32_16x16x32_bf16(wf[ct], af[t2], acc[ct][t2], 0, 0, 0); }
        const float* a0 = a.in(I_A0) + l * 512; const float* kkw = a.in(I_KK) + l * 512; const float* kaw = a.in(I_KA) + l * 512;
#pragma unroll
        for (int t2 = 0; t2 < 2; ++t2) { const int r = tp * 32 + t2 * 16 + fr, row = row0 + r; const bf16* prow = P + (size_t)row * PIN + PC_;
            const float* pf = smp ? sst + (size_t)(row - MP) * SHW : nullptr;
            float kkr[4][4], av[4][4], kc[4][4]; float ss = 0.f;
#pragma unroll
            for (int ct = 0; ct < 4; ++ct) { const int ch = h * 64 + ct * 16 + fq * 4; const f32x4 a0v = *(const f32x4*)(a0 + ch), kkv = *(const f32x4*)(kkw + ch);
                float xs[4]; if (smp) shift4(prow + 512 + ch, nullptr, pf + 512 + ch, mu + 512 + ch, xs); else shift4_lds(PT + (r + 1) * PTS + 512 + ch, mu + 512 + ch, xs);
#pragma unroll
                for (int j = 0; j < 4; ++j) { av[ct][j] = sigm(a0v[j] + acc[ct][t2][j]); kc[ct][j] = xs[j]; kkr[ct][j] = xs[j] * kkv[j]; ss += kkr[ct][j] * kkr[ct][j]; } }
            ss += __shfl_xor(ss, 16); ss += __shfl_xor(ss, 32);
            const float inv = 1.0f / fmaxf(sqrtf(ss), 1e-12f);
            unsigned char* rw = (unsigned char*)RW + ((size_t)row * 8 + h) * RWB;
#pragma unroll
            for (int ct = 0; ct < 4; ++ct) { const int ch = h * 64 + ct * 16 + fq * 4, cl = ct * 16 + fq * 4; const f32x4 kav = *(const f32x4*)(kaw + ch);
                f32x4 kk, kb, k4;
#pragma unroll
                for (int j = 0; j < 4; ++j) { kk[j] = kkr[ct][j] * inv; kb[j] = kk[j] * av[ct][j]; k4[j] = kc[ct][j] * (1.0f + (av[ct][j] - 1.0f) * kav[j]); }
                rw_st4(rw, RW_KK, cl, kk); rw_st4(rw, RW_KB, cl, kb); rw_st4(rw, RW_K, cl, k4);
                float xr[4], xv[4];
                if (smp) { shift4(prow + ch, nullptr, pf + ch, mu + ch, xr); shift4(prow + 1024 + ch, nullptr, pf + 1024 + ch, mu + 1024 + ch, xv); }
                else { shift4_lds(PT + (r + 1) * PTS + ch, mu + ch, xr); shift4_lds(PT + (r + 1) * PTS + 1024 + ch, mu + 1024 + ch, xv); }
                rw_st4(rw, RW_R, cl, (f32x4){xr[0], xr[1], xr[2], xr[3]}); rw_st4(rw, RW_V, cl, (f32x4){xv[0], xv[1], xv[2], xv[3]}); } }
    }
    PREP_REP(24) { constexpr int tp = 0;
        f32x4 acc[4][2];
#pragma unroll
        for (int ct = 0; ct < 4; ++ct)
#pragma unroll
            for (int t2 = 0; t2 < 2; ++t2) acc[ct][t2] = zero4();
#pragma unroll
        for (int ks = 0; ks < 2; ++ks) { bf16x8 af[2], wf[4];
#pragma unroll
            for (int t2 = 0; t2 < 2; ++t2) af[t2] = *(const LAS bf16x8*)(AW + (tp * 32 + t2 * 16 + fr) * 72 + ks * 32 + fq * 8);
#pragma unroll
            for (int ct = 0; ct < 4; ++ct) wf[ct] = *(const bf16x8*)(W2t + (size_t)(h * 64 + ct * 16 + fr) * 64 + ks * 32 + fq * 8);
#pragma unroll
            for (int ct = 0; ct < 4; ++ct)
#pragma unroll
                for (int t2 = 0; t2 < 2; ++t2) acc[ct][t2] = __builtin_amdgcn_mfma_f32_16x16x32_bf16(wf[ct], af[t2], acc[ct][t2], 0, 0, 0); }
        const float* w0 = a.in(I_W0) + l * 512;
#pragma unroll
        for (int t2 = 0; t2 < 2; ++t2) { const int row = row0 + tp * 32 + t2 * 16 + fr; float* rw = (float*)((unsigned char*)RW + ((size_t)row * 8 + h) * RWB);
#pragma unroll
            for (int ct = 0; ct < 4; ++ct) { const int ch = h * 64 + ct * 16 + fq * 4, cl = ct * 16 + fq * 4; const f32x4 w0v = *(const f32x4*)(w0 + ch); f32x4 d;
#pragma unroll
                for (int j = 0; j < 4; ++j) { const float z = -(w0v[j] + acc[ct][t2][j]); const float sp = fmaxf(z, 0.f) + __logf(1.0f + __expf(-fabsf(z))); const float w = -sp - 0.5f; d[j] = -__expf(w); }
                *(f32x4*)(rw + cl) = d; } }
    }
    PREP_REP(25) { constexpr int tp = 0;
        f32x4 acc[4][2];
#pragma unroll
        for (int ct = 0; ct < 4; ++ct)
#pragma unroll
            for (int t2 = 0; t2 < 2; ++t2) acc[ct][t2] = zero4();
#pragma unroll
        for (int ks = 0; ks < 4; ++ks) { bf16x8 af[2], wf[4];
#pragma unroll
            for (int t2 = 0; t2 < 2; ++t2) af[t2] = *(const LAS bf16x8*)(AG + (tp * 32 + t2 * 16 + fr) * 136 + ks * 32 + fq * 8);
#pragma unroll
            for (int ct = 0; ct < 4; ++ct) wf[ct] = *(const bf16x8*)(G2t + (size_t)(h * 64 + ct * 16 + fr) * 128 + ks * 32 + fq * 8);
#pragma unroll
            for (int ct = 0; ct < 4; ++ct)
#pragma unroll
                for (int t2 = 0; t2 < 2; ++t2) acc[ct][t2] = __builtin_amdgcn_mfma_f32_16x16x32_bf16(wf[ct], af[t2], acc[ct][t2], 0, 0, 0); }
#pragma unroll
        for (int t2 = 0; t2 < 2; ++t2) { const int row = row0 + tp * 32 + t2 * 16 + fr;
#pragma unroll
            for (int ct = 0; ct < 4; ++ct) *(f32x4*)(GATE + (size_t)row * 512 + h * 64 + ct * 16 + fq * 4) = acc[ct][t2]; }
    }
    __syncthreads();
}

#define PACK8(arr, o) ((v4u){pk2((arr)[(o)], (arr)[(o) + 1]), pk2((arr)[(o) + 2], (arr)[(o) + 3]), pk2((arr)[(o) + 4], (arr)[(o) + 5]), pk2((arr)[(o) + 6], (arr)[(o) + 7])})
constexpr int WK_LDS = 18432, WK_SHR = 6912, WK_PRV = 3072;
__device__ __forceinline__ f32x4 mfma16(bf16x4 a, bf16x4 b, f32x4 c) { return __builtin_amdgcn_mfma_f32_16x16x16bf16_1k(a, b, c, 0, 0, 0); }
__device__ __forceinline__ bf16 bfr1(float x) { return (bf16)(pk2(x, 0.f) & 0xffffu); }
__device__ __forceinline__ void wkv_chunk_witem(const Ctx& C, const Ax& a, int ci) {
    const float* RW = (const float*)(a.ws + WS_RW);
    unsigned char* CK = a.ws + WS_CK + (size_t)ci * WK_SHR; unsigned char* CP = a.ws + WS_CP + (size_t)ci * 4 * WK_PRV;
    const int bh = ci >> 7, c = ci & 127, b = bh >> 3, h = bh & 7, lane = C.lane, fr = lane & 15, fq = lane >> 4;
    LAS unsigned char* Lb = C.lds + C.wave * WK_LDS;
    LAS bf16* TA = (LAS bf16*)Lb; LAS bf16* TB = TA + 16 * 72; LAS bf16* TK = TB + 16 * 72; LAS bf16* TR = TK + 16 * 72; LAS bf16* VT = TR + 16 * 72;
    LAS float* M1 = (LAS float*)(Lb + 12288); LAS float* M2 = M1 + 320; LAS float* N1 = M2 + 320; LAS float* N2 = N1 + 320;
    LAS bf16* TG = TA; LAS bf16* PST = TK;
    const unsigned char* rw = (const unsigned char*)RW + (((size_t)b * SEQ + c * 16) * 8 + h) * RWB;
#define RWF(t) (*(const float*)(rw + (size_t)(t) * (8 * RWB) + lane * 4))
#define RWH(t, off) bf1(*(const bf16*)(rw + (size_t)(t) * (8 * RWB) + (off) + lane * 2))
    float lam[16]; { float run = 0.f;
#pragma unroll
      for (int t = 0; t < 16; ++t) { run += RWF(t); lam[t] = run; } }
    const float lamT = lam[15];
    ((float*)CK)[lane] = __expf(lamT);
    float Bp[16], Kp[16], al[16], ro[16];
    bf16* ATg = (bf16*)(CK + 256); bf16* OMg = (bf16*)(CK + 256 + 2304);
    float wkk[4], wbb[4], wkx[4], wrr[4], wvv[4];
#pragma unroll
    for (int t = 0; t < 4; ++t) { wkk[t] = RWH(t, RW_KK); wbb[t] = RWH(t, RW_KB); wkx[t] = RWH(t, RW_K); wrr[t] = RWH(t, RW_R); wvv[t] = RWH(t, RW_V); }
#pragma unroll
    for (int t = 0; t < 16; ++t) { const float kk = wkk[t & 3], bb = wbb[t & 3], kx = wkx[t & 3], rr = wrr[t & 3], vv = wvv[t & 3];
        if (t + 4 < 16) { wkk[t & 3] = RWH(t + 4, RW_KK); wbb[t & 3] = RWH(t + 4, RW_KB); wkx[t & 3] = RWH(t + 4, RW_K); wrr[t & 3] = RWH(t + 4, RW_R); wvv[t & 3] = RWH(t + 4, RW_V); }
        const float ein = __expf(-lam[t]), eprev = (t ? __expf(lam[t - 1]) : 1.0f), ecur = __expf(lam[t]), erest = __expf(lamT - lam[t]);
        al[t] = kk * eprev; ro[t] = rr * ecur; Bp[t] = bb * erest; Kp[t] = kx * erest;
        const bf16 ab = bfr1(al[t]);
        TA[t * 72 + lane] = ab; TB[t * 72 + lane] = bfr1(bb * ein); TK[t * 72 + lane] = bfr1(kx * ein); TR[t * 72 + lane] = bfr1(ro[t]); VT[lane * 24 + t] = bfr1(vv);
        ATg[t * 72 + lane] = ab;
        asm volatile("" ::: "memory"); __builtin_amdgcn_sched_barrier(0); }
    LDS_WAIT(); asm volatile("" ::: "memory");
    { f32x4 g1 = zero4(), g2 = zero4(), n1 = zero4(), n2 = zero4();
#pragma unroll
      for (int ks = 0; ks < 2; ++ks) { const int o = fr * 72 + ks * 32 + fq * 8;
        const bf16x8 bf_ = *(const LAS bf16x8*)(TB + o), kf_ = *(const LAS bf16x8*)(TK + o), af_ = *(const LAS bf16x8*)(TA + o), rf_ = *(const LAS bf16x8*)(TR + o);
        g1 = __builtin_amdgcn_mfma_f32_16x16x32_bf16(bf_, af_, g1, 0, 0, 0); g2 = __builtin_amdgcn_mfma_f32_16x16x32_bf16(kf_, af_, g2, 0, 0, 0);
        n1 = __builtin_amdgcn_mfma_f32_16x16x32_bf16(bf_, rf_, n1, 0, 0, 0); n2 = __builtin_amdgcn_mfma_f32_16x16x32_bf16(kf_, rf_, n2, 0, 0, 0); }
#pragma unroll
      for (int r = 0; r < 4; ++r) { const int s_ = 4 * fq + r, o = s_ * 20 + fr;
        M1[o] = (s_ < fr) ? g1[r] : 0.f; M2[o] = (s_ < fr) ? g2[r] : 0.f; N1[o] = (s_ <= fr) ? n1[r] : 0.f; N2[o] = (s_ <= fr) ? n2[r] : 0.f; } }
    LDS_WAIT(); asm volatile("" ::: "memory");
    __builtin_amdgcn_sched_barrier(0);
#pragma unroll
    for (int s_ = 14; s_ >= 0; --s_) { float m[16];
#pragma unroll
        for (int q = 0; q < 4; ++q) { const f32x4 v = *(const LAS f32x4*)(M1 + s_ * 20 + 4 * q); m[4 * q] = v.x; m[4 * q + 1] = v.y; m[4 * q + 2] = v.z; m[4 * q + 3] = v.w; }
        float acc = Bp[s_];
#pragma unroll
        for (int t = s_ + 1; t < 16; ++t) acc -= m[t] * Bp[t];
        asm volatile("" : "+v"(acc) :: "memory"); Bp[s_] = acc; __builtin_amdgcn_sched_barrier(0); }
#pragma unroll
    for (int s_ = 0; s_ < 15; ++s_) { float m[16];
#pragma unroll
        for (int q = 0; q < 4; ++q) { const f32x4 v = *(const LAS f32x4*)(M2 + s_ * 20 + 4 * q); m[4 * q] = v.x; m[4 * q + 1] = v.y; m[4 * q + 2] = v.z; m[4 * q + 3] = v.w; }
        float acc = Kp[s_];
#pragma unroll
        for (int t = s_ + 1; t < 16; ++t) acc -= m[t] * Bp[t];
        asm volatile("" : "+v"(acc) :: "memory"); Kp[s_] = acc; __builtin_amdgcn_sched_barrier(0); }
    __builtin_amdgcn_sched_barrier(0);
    { float ng[16];
#pragma unroll
      for (int t = 0; t < 16; ++t) ng[t] = -Bp[t];
      *(v4u*)(CK + 256 + 4608 + lane * 32) = PACK8(ng, 0); *(v4u*)(CK + 256 + 4608 + lane * 32 + 16) = PACK8(ng, 8); }
    *(LAS v4u*)(TG + lane * 24) = PACK8(Kp, 0); *(LAS v4u*)(TG + lane * 24 + 8) = PACK8(Kp, 8);
    __builtin_amdgcn_sched_barrier(0);
    { float hh[16], ps[16];
#pragma unroll
      for (int s_ = 0; s_ < 16; ++s_) { hh[s_] = N1[s_ * 20 + fr]; ps[s_] = N2[s_ * 20 + fr]; }
#pragma unroll
      for (int s_ = 14; s_ >= 0; --s_) { float m[16];
#pragma unroll
        for (int q = 0; q < 4; ++q) { const f32x4 v = *(const LAS f32x4*)(M1 + s_ * 20 + 4 * q); m[4 * q] = v.x; m[4 * q + 1] = v.y; m[4 * q + 2] = v.z; m[4 * q + 3] = v.w; }
        float acc = hh[s_];
#pragma unroll
        for (int u = s_ + 1; u < 16; ++u) acc -= m[u] * hh[u];
        asm volatile("" : "+v"(acc) :: "memory"); hh[s_] = acc; __builtin_amdgcn_sched_barrier(0); }
#pragma unroll
      for (int s_ = 0; s_ < 15; ++s_) { float m[16];
#pragma unroll
        for (int q = 0; q < 4; ++q) { const f32x4 v = *(const LAS f32x4*)(M2 + s_ * 20 + 4 * q); m[4 * q] = v.x; m[4 * q + 1] = v.y; m[4 * q + 2] = v.z; m[4 * q + 3] = v.w; }
        float acc = ps[s_];
#pragma unroll
        for (int u = s_ + 1; u < 16; ++u) acc -= m[u] * hh[u];
        asm volatile("" : "+v"(acc) :: "memory"); ps[s_] = acc; __builtin_amdgcn_sched_barrier(0); }
      LDS_WAIT(); asm volatile("" ::: "memory");
#pragma unroll
      for (int s_ = 0; s_ < 16; ++s_) N1[s_ * 20 + fr] = hh[s_];
      *(LAS v4u*)(PST + fr * 24) = PACK8(ps, 0); *(LAS v4u*)(PST + fr * 24 + 8) = PACK8(ps, 8); }
    LDS_WAIT(); asm volatile("" ::: "memory");
    __builtin_amdgcn_sched_barrier(0);
#pragma unroll
    for (int s_ = 0; s_ < 16; ++s_) { float m[16];
#pragma unroll
        for (int q = 0; q < 4; ++q) { const f32x4 v = *(const LAS f32x4*)(N1 + s_ * 20 + 4 * q); m[4 * q] = v.x; m[4 * q + 1] = v.y; m[4 * q + 2] = v.z; m[4 * q + 3] = v.w; }
#pragma unroll
        for (int t = s_; t < 16; ++t) ro[t] -= m[t] * al[s_];
        asm volatile("" ::: "memory"); __builtin_amdgcn_sched_barrier(0); }
#pragma unroll
    for (int t = 0; t < 16; ++t) OMg[t * 72 + lane] = bfr1(ro[t]);
    LDS_WAIT(); asm volatile("" ::: "memory");
    __builtin_amdgcn_sched_barrier(0);
    { bf16x4 vf[4];
#pragma unroll
      for (int it = 0; it < 4; ++it) vf[it] = *(const LAS bf16x4*)(VT + (it * 16 + fr) * 24 + fq * 4);
#pragma unroll
      for (int kt = 0; kt < 4; ++kt) { const bf16x4 gf = *(const LAS bf16x4*)(TG + (kt * 16 + fr) * 24 + fq * 4);
#pragma unroll
        for (int it = 0; it < 4; ++it) { const f32x4 d = mfma16(gf, vf[it], zero4()); v2u dw; dw.x = pk2(d[0], d[1]); dw.y = pk2(d[2], d[3]); *(v2u*)(CP + it * WK_PRV + kt * 512 + lane * 8) = dw; } }
      const bf16x4 pf = *(const LAS bf16x4*)(PST + fr * 24 + fq * 4);
#pragma unroll
      for (int it = 0; it < 4; ++it) { const f32x4 o = mfma16(pf, vf[it], zero4()); *(f32x4*)(CP + it * WK_PRV + 2048 + lane * 16) = o; } }
    LDS_WAIT(); asm volatile("" ::: "memory");
}
constexpr int WQ_CH = WK_PRV + WK_SHR, WQ_SLOT = 4 * WQ_CH, WQ_PCS = WQ_CH / 16, WQ_NWL = 4 * WQ_PCS / 64;
__device__ __forceinline__ void wkv_seq_chunk(const LAS unsigned char* sp, f32x4 (&acc)[4], float* orow, int lane, int fr, int fq) {
    const LAS unsigned char* sh = sp + WK_PRV;
    bf16x8 af[2], of[2]; bf16x4 gf[4]; f32x4 wt[4], dt[4];
#pragma unroll
    for (int s = 0; s < 2; ++s) { const LAS bf16* ap = (const LAS bf16*)(sh + 256) + fr * 72 + 32 * s + 4 * fq; const v2u lo = *(const LAS v2u*)ap, hi = *(const LAS v2u*)(ap + 16);
        af[s] = __builtin_bit_cast(bf16x8, (v4u){lo.x, lo.y, hi.x, hi.y});
        const LAS bf16* op = (const LAS bf16*)(sh + 256 + 2304) + fr * 72 + 32 * s + 4 * fq; const v2u lo2 = *(const LAS v2u*)op, hi2 = *(const LAS v2u*)(op + 16);
        of[s] = __builtin_bit_cast(bf16x8, (v4u){lo2.x, lo2.y, hi2.x, hi2.y}); }
#pragma unroll
    for (int kt = 0; kt < 4; ++kt) { gf[kt] = *(const LAS bf16x4*)((const LAS bf16*)(sh + 256 + 4608) + (kt * 16 + fr) * 16 + 4 * fq);
        wt[kt] = *(const LAS f32x4*)(sh + (16 * kt + 4 * fq) * 4); { float f_[4]; unpack4(*(const LAS v2u*)(sp + kt * 512 + lane * 8), f_); dt[kt] = (f32x4){f_[0], f_[1], f_[2], f_[3]}; } }
    const f32x4 ov = *(const LAS f32x4*)(sp + 2048 + lane * 16);
    bf16x8 sbf[2];
#pragma unroll
    for (int s = 0; s < 2; ++s) { v4u w; w.x = pk2(acc[2 * s][0], acc[2 * s][1]); w.y = pk2(acc[2 * s][2], acc[2 * s][3]); w.z = pk2(acc[2 * s + 1][0], acc[2 * s + 1][1]); w.w = pk2(acc[2 * s + 1][2], acc[2 * s + 1][3]);
        sbf[s] = __builtin_bit_cast(bf16x8, w); }
    f32x4 x = zero4();
    x = __builtin_amdgcn_mfma_f32_16x16x32_bf16(af[0], sbf[0], x, 0, 0, 0); x = __builtin_amdgcn_mfma_f32_16x16x32_bf16(af[1], sbf[1], x, 0, 0, 0);
    f32x4 o = __builtin_amdgcn_mfma_f32_16x16x32_bf16(of[0], sbf[0], ov, 0, 0, 0); o = __builtin_amdgcn_mfma_f32_16x16x32_bf16(of[1], sbf[1], o, 0, 0, 0);
    v2u xw; xw.x = pk2(x[0], x[1]); xw.y = pk2(x[2], x[3]); const bf16x4 xb = __builtin_bit_cast(bf16x4, xw);
#pragma unroll
    for (int kt = 0; kt < 4; ++kt) acc[kt] = mfma16(gf[kt], xb, acc[kt] * wt[kt] + dt[kt]);
    orow[0] = o[0]; orow[512] = o[1]; orow[1024] = o[2]; orow[1536] = o[3];
}
__device__ __forceinline__ void wkv_seq_item(const Ctx& C, const Ax& a, int l, int item) {
    const int bh = item >> 2, rg = item & 3, b = bh >> 3, h = bh & 7, lane = C.lane, fr = lane & 15, fq = lane >> 4;
    const unsigned char* CK = a.ws + WS_CK + (size_t)bh * 128 * WK_SHR; const unsigned char* CP = a.ws + WS_CP + ((size_t)bh * 128 * 4 + rg) * WK_PRV;
    float* OC = (float*)(a.ws + WS_OC) + ((size_t)b * SEQ) * 512 + h * 64 + rg * 16 + fr;
#define WQ_COMPUTE(blk) do { const LAS unsigned char* sbp = C.lds + ((blk) % 3) * WQ_SLOT; \
            _Pragma("unroll 2") for (int cq = 0; cq < 4; ++cq) wkv_seq_chunk(sbp + cq * WQ_CH, acc, OC + (size_t)(((blk) * 4 + cq) * 16 + 4 * fq) * 512, lane, fr, fq); } while (0)
    static_assert(4 * WQ_PCS == WQ_NWL * 64 && WQ_NWL > 35 && WQ_NWL <= 42 && 3 * WQ_SLOT <= SCR_BYTES, "ring geometry");
    if (C.wave == 0) {
        f32x4 acc[4];
#pragma unroll
        for (int kt = 0; kt < 4; ++kt) acc[kt] = zero4();
        __builtin_amdgcn_s_barrier(); asm volatile("" ::: "memory");
        for (int blk = 0; blk < 32; ++blk) { WQ_COMPUTE(blk); asm volatile("s_waitcnt lgkmcnt(0)" ::: "memory"); __builtin_amdgcn_s_barrier(); asm volatile("" ::: "memory"); }
        float* so = a.out + O_WKVP + ((((size_t)l * NB + b) * 8 + h) * 64 + rg * 16 + fr) * 64 + 4 * fq;
#pragma unroll
        for (int kt = 0; kt < 4; ++kt) *(f32x4*)(so + 16 * kt) = acc[kt];
    } else {
        const int w1 = C.wave - 1; const bool seven = (w1 + 35) < WQ_NWL;
        const unsigned char* wsb = a.ws; unsigned qoff[6], qstr[6];
#pragma unroll
        for (int i = 0; i < 6; ++i) { const int p = (w1 + 7 * i) * 64 + lane, cq = p / WQ_PCS, q = p - cq * WQ_PCS; const bool pr = q < WK_PRV / 16;
            qoff[i] = pr ? (unsigned)(WS_CP + ((size_t)bh * 128 * 4 + rg) * WK_PRV) + (unsigned)(cq * 4 * WK_PRV + q * 16) : (unsigned)(WS_CK + (size_t)bh * 128 * WK_SHR) + (unsigned)(cq * WK_SHR + (q - WK_PRV / 16) * 16);
            qstr[i] = pr ? (unsigned)(16 * WK_PRV) : (unsigned)(4 * WK_SHR); }
#define WQ_DMA(blk) do { _Pragma("unroll") for (int i = 0; i < 6; ++i) if (i < 5 || seven) \
            __builtin_amdgcn_global_load_lds((const unsigned*)(wsb + (qoff[i] + (unsigned)(blk) * qstr[i])), (LAS unsigned*)(C.lds + ((blk) % 3) * WQ_SLOT + (w1 + 7 * i) * 1024), 16, 0, 0); } while (0)
#define WQ_WAIT_OLDER() do { if (seven) asm volatile("s_waitcnt vmcnt(6)" ::: "memory"); else asm volatile("s_waitcnt vmcnt(5)" ::: "memory"); } while (0)
        WQ_DMA(0); WQ_DMA(1); WQ_WAIT_OLDER();
        __builtin_amdgcn_s_barrier(); asm volatile("" ::: "memory");
        for (int blk = 0; blk < 32; ++blk) {
            if (blk + 2 < 32) { WQ_DMA(blk + 2); WQ_WAIT_OLDER(); }
            else asm volatile("s_waitcnt vmcnt(0)" ::: "memory");
            __builtin_amdgcn_s_barrier(); asm volatile("" ::: "memory");
        }
#undef WQ_DMA
#undef WQ_WAIT_OLDER
    }
#undef WQ_COMPUTE
    __syncthreads();
}
__device__ __forceinline__ void rwkv_sample_witem(const Ctx& C, const Ax& a, int l, int witem) {
    const float* RW = (const float*)(a.ws + WS_RW); float* OC = (float*)(a.ws + WS_OC);
    const int n = witem >> 4, h = (witem >> 1) & 7, half = witem & 1, g = C.lane & 15, rq = C.lane >> 4;
    const unsigned char* p = (const unsigned char*)RW + ((size_t)(MP + n) * 8 + h) * RWB;
    const f32x4 lw4 = *(const f32x4*)(p + 16 * g), kk4 = rw_ld4(p, RW_KK, 4 * g), b4 = rw_ld4(p, RW_KB, 4 * g), k4 = rw_ld4(p, RW_K, 4 * g), r4 = rw_ld4(p, RW_R, 4 * g);
    const f32x4 w4 = (f32x4){__expf(lw4.x), __expf(lw4.y), __expf(lw4.z), __expf(lw4.w)};
    const float* sin_ = a.in(I_SWKV) + (((size_t)l * NS + n) * 8 + h) * 4096; float* sout = a.out + O_WKVS + (((size_t)l * NS + n) * 8 + h) * 4096;
#pragma unroll 4
    for (int it = 0; it < 8; ++it) { const int i = half * 32 + it * 4 + rq; const f32x4 S = __builtin_nontemporal_load((const f32x4*)(sin_ + i * 64 + 4 * g)); const float vi = bf1(*(const bf16*)(p + RW_V + i * 2));
        const float sa = -rowsum16((S.x * kk4.x + S.y * kk4.y) + (S.z * kk4.z + S.w * kk4.w));
        f32x4 T; T.x = S.x * w4.x + (sa * b4.x + vi * k4.x); T.y = S.y * w4.y + (sa * b4.y + vi * k4.y); T.z = S.z * w4.z + (sa * b4.z + vi * k4.z); T.w = S.w * w4.w + (sa * b4.w + vi * k4.w);
        const float o = rowsum16((T.x * r4.x + T.y * r4.y) + (T.z * r4.z + T.w * r4.w));
        __builtin_nontemporal_store(T, (f32x4*)(sout + i * 64 + 4 * g));
        if (g == 0) OC[(size_t)(MP + n) * 512 + h * 64 + i] = o; }
}
__device__ __forceinline__ void rwkv_post_phase(const Ctx& C, const Ax& a, int l) {
    const float* RW = (const float*)(a.ws + WS_RW); const float* OC = (const float*)(a.ws + WS_OC); const float* GATE = (const float*)(a.ws + WS_GATE); bf16* YC = (bf16*)(a.ws + WS_YC);
    const int gw = C.bid * NWAVES + C.wave, NGW = C.G * NWAVES, g = C.lane & 15, rq = C.lane >> 4;
    const float* lg = a.in(I_LNXG) + l * 512; const float* lb = a.in(I_LNXB) + l * 512; const float* rk = a.in(I_RK) + l * 512;
    for (int it = gw; it < MT * 8 / 4; it += NGW) { const int pair = it * 4 + rq, row = pair >> 3, h = pair & 7, ch = h * 64 + 4 * g;
        const f32x4 o = *(const f32x4*)(OC + (size_t)row * 512 + ch);
        const float mu = rowsum16((o.x + o.y) + (o.z + o.w)) * (1.0f / 64.0f); const f32x4 d = o - mu;
        const float var = rowsum16((d.x * d.x + d.y * d.y) + (d.z * d.z + d.w * d.w)) * (1.0f / 64.0f); const float rstd = 1.0f / sqrtf(var + 64e-5f);
        const unsigned char* rw = (const unsigned char*)RW + ((size_t)row * 8 + h) * RWB;
        const f32x4 k4 = rw_ld4(rw, RW_K, 4 * g), r4 = rw_ld4(rw, RW_R, 4 * g), v4 = rw_ld4(rw, RW_V, 4 * g), rkv = *(const f32x4*)(rk + ch), gv = *(const f32x4*)(GATE + (size_t)row * 512 + ch);
        const float bs = rowsum16((r4.x * k4.x * rkv.x + r4.y * k4.y * rkv.y) + (r4.z * k4.z * rkv.z + r4.w * k4.w * rkv.w));
        const f32x4 y = (d * rstd * *(const f32x4*)(lg + ch) + *(const f32x4*)(lb + ch) + bs * v4) * gv;
        v2u w; w.x = pk2(y.x, y.y); w.y = pk2(y.z, y.w); *(v2u*)(YC + (size_t)row * DM + 1024 + ch) = w; }
}

__device__ __forceinline__ float ret_lg(int h) { return log1pf(-exp2f(-5.0f - (float)h)); }
constexpr int RS = 136;
__device__ __forceinline__ void rot8(const bf16* src, const float* cs, int c8, float scale, float (&lo)[8], float (&hi)[8]) {
    float x1[8], x2[8]; unpack8(*(const v4u*)(src + c8 * 8), x1); unpack8(*(const v4u*)(src + 64 + c8 * 8), x2);
#pragma unroll
    for (int j = 0; j < 8; ++j) { const float co = cs[2 * (c8 * 8 + j)], si = cs[2 * (c8 * 8 + j) + 1]; lo[j] = (x1[j] * co - x2[j] * si) * scale; hi[j] = (x2[j] * co + x1[j] * si) * scale; }
}
__device__ __forceinline__ void ret_pass1_item(const Ctx& C, const Ax& a, int item) {
    const bf16* P = (const bf16*)(a.ws + WS_P); const float* CS = (const float*)(a.ws + WS_ROPE); float* KVT = (float*)(a.ws + WS_KVT);
    const int b = item >> 6, h = (item >> 4) & 3, c = item & 15; const size_t row0 = (size_t)b * SEQ + c * 128; const float lg = ret_lg(h);
    LAS bf16* KT = (LAS bf16*)C.lds; LAS bf16* VT = KT + 128 * RS;
    for (int it = C.tid; it < 128 * 8; it += NWAVES * 64) { const int tt = it & 127, c8 = it >> 7; float lo[8], hi[8];
        rot8(P + (row0 + tt) * PIN + PB_ + 512 + h * 128, CS + (size_t)(c * 128 + tt) * 128, c8, 0.08838834764831845f * __expf(lg * (float)(127 - tt)), lo, hi);
#pragma unroll
        for (int j = 0; j < 8; ++j) { KT[(c8 * 8 + j) * RS + tt] = (bf16)(pk2(lo[j], 0.f) & 0xffffu); KT[(64 + c8 * 8 + j) * RS + tt] = (bf16)(pk2(hi[j], 0.f) & 0xffffu); } }
    for (int it = C.tid; it < 128 * 16; it += NWAVES * 64) { const int tt = it & 127, c8 = it >> 7; const v4u w = *(const v4u*)(P + (row0 + tt) * PIN + PB_ + 1024 + h * 128 + c8 * 8);
        const unsigned ww[4] = {w.x, w.y, w.z, w.w};
#pragma unroll
        for (int j = 0; j < 4; ++j) { VT[(c8 * 8 + 2 * j) * RS + tt] = (bf16)(ww[j] & 0xffffu); VT[(c8 * 8 + 2 * j + 1) * RS + tt] = (bf16)(ww[j] >> 16); } }
    __syncthreads();
    const int fr = C.lane & 15, fq = C.lane >> 4, w = C.wave;
    f32x4 acc[8];
#pragma unroll
    for (int et = 0; et < 8; ++et) acc[et] = zero4();
#pragma unroll
    for (int ks = 0; ks < 4; ++ks) { const bf16x8 kf = *(const LAS bf16x8*)(KT + (16 * w + fr) * RS + ks * 32 + fq * 8);
#pragma unroll
        for (int et = 0; et < 8; ++et) { const bf16x8 vf = *(const LAS bf16x8*)(VT + (16 * et + fr) * RS + ks * 32 + fq * 8); acc[et] = __builtin_amdgcn_mfma_f32_16x16x32_bf16(kf, vf, acc[et], 0, 0, 0); } }
    float* o = KVT + (size_t)item * 16384;
#pragma unroll
    for (int et = 0; et < 8; ++et) *(f32x4*)(o + (size_t)(16 * et + fr) * 128 + 16 * w + 4 * fq) = acc[et];
    __syncthreads();
}
__device__ __forceinline__ void ret_prefix_phase(const Ctx& C, const Ax& a, int l) {
    const float* KVT = (const float*)(a.ws + WS_KVT); bf16* STB = (bf16*)(a.ws + WS_STB);
    const int gt = C.bid * (NWAVES * 64) + C.tid, NT = C.G * NWAVES * 64;
    for (int idx = gt; idx < 16 * 4096; idx += NT) { const int bh = idx >> 12, r = idx & 4095, e = r >> 5, d4 = (r & 31) * 4; const int h = bh & 3;
        const float g128 = __expf(ret_lg(h) * 128.0f); const size_t base = (size_t)bh * 16 * 16384 + e * 128 + d4;
        f32x4 kv[16];
#pragma unroll
        for (int c = 0; c < 16; ++c) kv[c] = *(const f32x4*)(KVT + base + (size_t)c * 16384);
        f32x4 S = zero4();
#pragma unroll
        for (int c = 0; c < 16; ++c) { v2u w; w.x = pk2(S.x, S.y); w.y = pk2(S.z, S.w); *(v2u*)(STB + base + (size_t)c * 16384) = w; S = S * g128 + kv[c]; }
        float* o = a.out + O_RETP + ((size_t)l * 16 + bh) * 16384 + e;
        o[(size_t)d4 * 128] = S.x; o[(size_t)(d4 + 1) * 128] = S.y; o[(size_t)(d4 + 2) * 128] = S.z; o[(size_t)(d4 + 3) * 128] = S.w; }
}
__device__ __forceinline__ void ret_pass2_item(const Ctx& C, const Ax& a, int l, int item) {
    const bf16* P = (const bf16*)(a.ws + WS_P); const float* CS = (const float*)(a.ws + WS_ROPE); bf16* YC = (bf16*)(a.ws + WS_YC);
    const int b = item >> 6, h = (item >> 4) & 3, c = item & 15; const size_t row0 = (size_t)b * SEQ + c * 128; const float lg = ret_lg(h);
    LAS bf16* QL = (LAS bf16*)C.lds; LAS bf16* KL = QL + 128 * RS; LAS bf16* VT = KL + 128 * RS; LAS bf16* ST = VT + 128 * RS;
    for (int it = C.tid; it < 128 * 8; it += NWAVES * 64) { const int tt = it & 127, c8 = it >> 7; float lo[8], hi[8]; const float* cs = CS + (size_t)(c * 128 + tt) * 128;
        rot8(P + (row0 + tt) * PIN + PB_ + h * 128, cs, c8, __expf(lg * (float)(tt + 1)), lo, hi);
        *(LAS v4u*)(QL + tt * RS + c8 * 8) = pack8(lo); *(LAS v4u*)(QL + tt * RS + 64 + c8 * 8) = pack8(hi);
        rot8(P + (row0 + tt) * PIN + PB_ + 512 + h * 128, cs, c8, 0.08838834764831845f * __expf(-lg * (float)(tt + 1)), lo, hi);
        *(LAS v4u*)(KL + tt * RS + c8 * 8) = pack8(lo); *(LAS v4u*)(KL + tt * RS + 64 + c8 * 8) = pack8(hi); }
    for (int it = C.tid; it < 128 * 16; it += NWAVES * 64) { const int tt = it & 127, c8 = it >> 7; const v4u w = *(const v4u*)(P + (row0 + tt) * PIN + PB_ + 1024 + h * 128 + c8 * 8);
        const unsigned ww[4] = {w.x, w.y, w.z, w.w};
#pragma unroll
        for (int j = 0; j < 4; ++j) { VT[(c8 * 8 + 2 * j) * RS + tt] = (bf16)(ww[j] & 0xffffu); VT[(c8 * 8 + 2 * j + 1) * RS + tt] = (bf16)(ww[j] >> 16); } }
    { const bf16* stb = (const bf16*)(a.ws + WS_STB) + (size_t)item * 16384;
      for (int it = C.tid; it < 128 * 16; it += NWAVES * 64) { const int e = it >> 4, dc = it & 15; *(LAS v4u*)(ST + e * RS + dc * 8) = *(const v4u*)(stb + e * 128 + dc * 8); } }
    __syncthreads();
    const int fr = C.lane & 15, fq = C.lane >> 4, w = C.wave, i0 = 16 * w;
    bf16x8 qf[4];
#pragma unroll
    for (int ks = 0; ks < 4; ++ks) qf[ks] = *(const LAS bf16x8*)(QL + (i0 + fr) * RS + ks * 32 + fq * 8);
    f32x4 sc[8];
#pragma unroll
    for (int jt = 0; jt < 8; ++jt) { sc[jt] = zero4();
        if (jt <= w) {
#pragma unroll
            for (int ks = 0; ks < 4; ++ks) { const bf16x8 kf = *(const LAS bf16x8*)(KL + (16 * jt + fr) * RS + ks * 32 + fq * 8); sc[jt] = __builtin_amdgcn_mfma_f32_16x16x32_bf16(kf, qf[ks], sc[jt], 0, 0, 0); }
            if (jt == w) {
#pragma unroll
                for (int r = 0; r < 4; ++r) if (4 * fq + r > fr) sc[jt][r] = 0.f; } } }
    __syncthreads();
    LAS bf16* PL = KL;
#pragma unroll
    for (int jt = 0; jt < 8; ++jt) { v2u pw; pw.x = pk2(sc[jt][0], sc[jt][1]); pw.y = pk2(sc[jt][2], sc[jt][3]); *(LAS v2u*)(PL + (i0 + fr) * RS + 16 * jt + 4 * fq) = pw; }
    LDS_WAIT(); asm volatile("" ::: "memory");
    f32x4 acc[8];
#pragma unroll
    for (int et = 0; et < 8; ++et) acc[et] = zero4();
#pragma unroll
    for (int ks = 0; ks < 4; ++ks) { if (2 * ks <= w) { const bf16x8 pf = *(const LAS bf16x8*)(PL + (i0 + fr) * RS + ks * 32 + fq * 8);
#pragma unroll
            for (int et = 0; et < 8; ++et) { const bf16x8 vf = *(const LAS bf16x8*)(VT + (16 * et + fr) * RS + ks * 32 + fq * 8); acc[et] = __builtin_amdgcn_mfma_f32_16x16x32_bf16(vf, pf, acc[et], 0, 0, 0); } } }
    if (c > 0) {
#pragma unroll
        for (int ks = 0; ks < 4; ++ks)
#pragma unroll
            for (int et = 0; et < 8; ++et) { const bf16x8 sf = *(const LAS bf16x8*)(ST + (16 * et + fr) * RS + ks * 32 + fq * 8); acc[et] = __builtin_amdgcn_mfma_f32_16x16x32_bf16(sf, qf[ks], acc[et], 0, 0, 0); } }
    float s = 0.f;
#pragma unroll
    for (int et = 0; et < 8; ++et) s += (acc[et][0] + acc[et][1]) + (acc[et][2] + acc[et][3]);
    s += __shfl_xor(s, 16); s += __shfl_xor(s, 32); const float mu = s * (1.0f / 128.0f);
    float q = 0.f;
#pragma unroll
    for (int et = 0; et < 8; ++et) { acc[et] = acc[et] - mu; q += (acc[et][0] * acc[et][0] + acc[et][1] * acc[et][1]) + (acc[et][2] * acc[et][2] + acc[et][3] * acc[et][3]); }
    q += __shfl_xor(q, 16); q += __shfl_xor(q, 32); const float rstd = 1.0f / sqrtf(q * (1.0f / 128.0f) + 1e-6f);
    const size_t row = row0 + i0 + fr;
#pragma unroll
    for (int et = 0; et < 8; ++et) { const int e = 16 * et + 4 * fq; float gg[4]; unpack4(*(const v2u*)(P + row * PIN + PB_ + 1536 + h * 128 + e), gg);
        v2u wv; wv.x = pk2(gg[0] * sigm(gg[0]) * acc[et][0] * rstd, gg[1] * sigm(gg[1]) * acc[et][1] * rstd); wv.y = pk2(gg[2] * sigm(gg[2]) * acc[et][2] * rstd, gg[3] * sigm(gg[3]) * acc[et][3] * rstd);
        *(v2u*)(YC + row * DM + 512 + h * 128 + e) = wv; }
    __syncthreads();
}
__device__ __forceinline__ void ret_sample_witem(const Ctx& C, const Ax& a, int l, int witem) {
    const bf16* P = (const bf16*)(a.ws + WS_P); const float* CS = (const float*)(a.ws + WS_ROPE) + (size_t)2048 * 128; bf16* YC = (bf16*)(a.ws + WS_YC);
    const int n = witem >> 2, h = witem & 3, lane = C.lane; const float gam = 1.0f - exp2f(-5.0f - (float)h);
    LAS float* qk = (LAS float*)(C.lds + C.wave * 1024);
    const bf16* pr = P + (size_t)(MP + n) * PIN + PB_ + h * 128;
    { const float co = CS[2 * lane], si = CS[2 * lane + 1]; const float q1 = bf1(pr[lane]), q2 = bf1(pr[64 + lane]), k1 = bf1(pr[512 + lane]), k2 = bf1(pr[512 + 64 + lane]);
      qk[lane] = q1 * co - q2 * si; qk[64 + lane] = q2 * co + q1 * si; qk[128 + lane] = (k1 * co - k2 * si) * 0.08838834764831845f; qk[192 + lane] = (k2 * co + k1 * si) * 0.08838834764831845f; }
    LDS_WAIT(); asm volatile("" ::: "memory");
    const float dotp = wave_sum(qk[lane] * qk[128 + lane] + qk[64 + lane] * qk[192 + lane]);
    const int half = lane >> 5, el = lane & 31;
    float vv[4]; unpack4(*(const v2u*)(pr + 1024 + 4 * el), vv); const f32x4 v4 = (f32x4){vv[0], vv[1], vv[2], vv[3]};
    const float* sin_ = a.in(I_SRET) + (((size_t)l * NS + n) * 4 + h) * 16384; float* sout = a.out + O_RETS + (((size_t)l * NS + n) * 4 + h) * 16384;
    f32x4 oa = zero4();
#pragma unroll 8
    for (int it = 0; it < 64; ++it) { const int d = 2 * it + half; const f32x4 S = __builtin_nontemporal_load((const f32x4*)(sin_ + (size_t)d * 128 + 4 * el)); const float qd = qk[d], kd = qk[128 + d];
        oa += qd * S; __builtin_nontemporal_store(gam * S + kd * v4, (f32x4*)(sout + (size_t)d * 128 + 4 * el)); }
    oa.x += __shfl_xor(oa.x, 32); oa.y += __shfl_xor(oa.y, 32); oa.z += __shfl_xor(oa.z, 32); oa.w += __shfl_xor(oa.w, 32);
    f32x4 o = gam * oa + dotp * v4;
    float s = (o.x + o.y) + (o.z + o.w);
#pragma unroll
    for (int m = 1; m < 32; m <<= 1) s += __shfl_xor(s, m);
    const float mu = s * (1.0f / 128.0f); o = o - mu; float q = (o.x * o.x + o.y * o.y) + (o.z * o.z + o.w * o.w);
#pragma unroll
    for (int m = 1; m < 32; m <<= 1) q += __shfl_xor(q, m);
    const float rstd = 1.0f / sqrtf(q * (1.0f / 128.0f) + 1e-6f);
    if (half == 0) { float gg[4]; unpack4(*(const v2u*)(pr + 1536 + 4 * el), gg);
        v2u wv; wv.x = pk2(gg[0] * sigm(gg[0]) * o.x * rstd, gg[1] * sigm(gg[1]) * o.y * rstd); wv.y = pk2(gg[2] * sigm(gg[2]) * o.z * rstd, gg[3] * sigm(gg[3]) * o.w * rstd);
        *(v2u*)(YC + (size_t)(MP + n) * DM + 512 + h * 128 + 4 * el) = wv; }
    LDS_WAIT(); asm volatile("" ::: "memory");
}

constexpr int XV_RS = 264;
__device__ __forceinline__ void xattn_prompt_unit(const Ctx& C, const Ax& a, int l, int unit) {
    const bf16* Q = (const bf16*)(a.ws + WS_Q); const bf16* MK = (const bf16*)(a.ws + WS_MK) + (size_t)l * MMEM * DM; const bf16* MVT = (const bf16*)(a.ws + WS_MVT) + (size_t)l * MMEM * DM; bf16* O = (bf16*)(a.ws + WS_O);
    const int b = unit >> 6, h = (unit >> 4) & 3, qt = unit & 15, fr = C.lane & 15, fq = C.lane >> 4;
    const size_t row = (size_t)b * SEQ + qt * 128 + C.wave * 16 + fr;
    LAS bf16* SB = (LAS bf16*)C.lds;
    v4u st[8];
    const bf16* kbase = MK + ((size_t)b * 256) * DM + h * 512; const bf16* vbase = MVT + (((size_t)b * 4 + h) * 512) * 256;
    unsigned kof[4], vof[8], sof[8];
#pragma unroll
    for (int i = 0; i < 8; ++i) { const int idx = C.tid + 512 * i, r = idx >> 5, c16 = idx & 31; vof[i] = (unsigned)(r * 256 + c16 * 8) * 2u; sof[i] = (unsigned)(r * XV_RS + c16 * 8) * 2u; if (i < 4) kof[i] = (unsigned)(r * DM + c16 * 8) * 2u; }
    const char* kb8 = (const char*)kbase; const char* vb8 = (const char*)vbase; LAS char* sb8 = (LAS char*)SB;
#define XK_LOAD(q) do { const char* pb_ = kb8 + ((size_t)(((q) & 3) * 64) * DM + ((q) >> 2) * 256) * 2; _Pragma("unroll") for (int i = 0; i < 4; ++i) st[i] = *(const v4u*)(pb_ + kof[i]); } while (0)
#define XK_STORE() do { _Pragma("unroll") for (int i = 0; i < 4; ++i) *(LAS v4u*)(sb8 + sof[i]) = st[i]; } while (0)
#define XV_LOAD(p) do { const char* pb_ = vb8 + (size_t)((p) * 128) * 256 * 2; _Pragma("unroll") for (int i = 0; i < 8; ++i) st[i] = *(const v4u*)(pb_ + vof[i]); } while (0)
#define XV_STORE() do { _Pragma("unroll") for (int i = 0; i < 8; ++i) *(LAS v4u*)(sb8 + sof[i]) = st[i]; } while (0)
    XK_LOAD(0);
    f32x4 sc[16];
#pragma unroll
    for (int jt = 0; jt < 16; ++jt) sc[jt] = zero4();
#pragma unroll
    for (int dh = 0; dh < 2; ++dh) {
        bf16x8 qf[8];
#pragma unroll
        for (int ks = 0; ks < 8; ++ks) qf[ks] = *(const bf16x8*)(Q + row * DM + h * 512 + dh * 256 + ks * 32 + fq * 8);
#pragma unroll
        for (int p = 0; p < 4; ++p) {
            __syncthreads(); XK_STORE(); __syncthreads();
            if (dh * 4 + p < 7) XK_LOAD(dh * 4 + p + 1); else XV_LOAD(0);
#pragma unroll
            for (int j4 = 0; j4 < 4; ++j4) {
#pragma unroll
                for (int ks = 0; ks < 8; ++ks) { const bf16x8 kf = *(const LAS bf16x8*)(SB + (j4 * 16 + fr) * XV_RS + ks * 32 + fq * 8); sc[p * 4 + j4] = __builtin_amdgcn_mfma_f32_16x16x32_bf16(kf, qf[ks], sc[p * 4 + j4], 0, 0, 0); }
                __builtin_amdgcn_sched_barrier(0); }
        }
    }
    float mx = -3.0e38f;
#pragma unroll
    for (int jt = 0; jt < 16; ++jt) mx = fmaxf(mx, fmaxf(fmaxf(sc[jt][0], sc[jt][1]), fmaxf(sc[jt][2], sc[jt][3])));
    mx = fmaxf(mx, __shfl_xor(mx, 16)); mx = fmaxf(mx, __shfl_xor(mx, 32));
    const float scale = 0.04419417382415922f; float sum = 0.f;
    bf16x8 pf[8];
#pragma unroll
    for (int s = 0; s < 8; ++s) { float p[8];
#pragma unroll
        for (int j = 0; j < 4; ++j) { p[j] = __expf((sc[2 * s][j] - mx) * scale); p[4 + j] = __expf((sc[2 * s + 1][j] - mx) * scale); }
        sum += ((p[0] + p[1]) + (p[2] + p[3])) + ((p[4] + p[5]) + (p[6] + p[7]));
        const v4u w = pack8(p); pf[s] = __builtin_bit_cast(bf16x8, w); }
    sum += __shfl_xor(sum, 16); sum += __shfl_xor(sum, 32); const float inv = 1.0f / sum;
#pragma unroll
    for (int p = 0; p < 4; ++p) {
        __syncthreads(); XV_STORE(); __syncthreads();
        if (p < 3) XV_LOAD(p + 1);
#pragma unroll
        for (int et = 0; et < 8; ++et) { f32x4 s4 = zero4(); const LAS bf16* vp = SB + (et * 16 + fr) * XV_RS + 4 * fq;
#pragma unroll
            for (int s = 0; s < 8; ++s) { const v2u lo = *(const LAS v2u*)(vp + 32 * s), hi = *(const LAS v2u*)(vp + 32 * s + 16); const v4u w = (v4u){lo.x, lo.y, hi.x, hi.y};
                s4 = __builtin_amdgcn_mfma_f32_16x16x32_bf16(__builtin_bit_cast(bf16x8, w), pf[s], s4, 0, 0, 0); }
            v2u w; w.x = pk2(s4[0] * inv, s4[1] * inv); w.y = pk2(s4[2] * inv, s4[3] * inv);
            *(v2u*)(O + row * DM + h * 512 + p * 128 + et * 16 + 4 * fq) = w;
            __builtin_amdgcn_sched_barrier(0); }
    }
    __syncthreads();
#undef XK_LOAD
#undef XK_STORE
#undef XV_LOAD
#undef XV_STORE
}
__device__ __forceinline__ void xattn_sample_item(const Ctx& C, const Ax& a, int l, int item) {
    const bf16* Q = (const bf16*)(a.ws + WS_Q); bf16* O = (bf16*)(a.ws + WS_O);
    const int n = item >> 2, h = item & 3, lane = C.lane, w = C.wave;
    LAS float* red = (LAS float*)C.lds; LAS float* part = red + 64;
    float q[8]; { const float* s0 = (const float*)(a.ws + WS_SPL) + (size_t)n * DM + h * 512 + 4 * lane; const float* s1 = s0 + (size_t)NS * DM;
                  const f32x4 a0 = *(const f32x4*)s0 + *(const f32x4*)s1, a1 = *(const f32x4*)(s0 + 256) + *(const f32x4*)(s1 + 256);
                  q[0] = a0.x; q[1] = a0.y; q[2] = a0.z; q[3] = a0.w; q[4] = a1.x; q[5] = a1.y; q[6] = a1.z; q[7] = a1.w; }
    const size_t base = ((((size_t)l * NS + n) * 256 + 32 * w) * 4 + h) * 512 + 4 * lane;
    const float* kp = a.in(I_CMK) + base; const float* vp = a.in(I_CMV) + base;
#define XS_LOAD(buf0, buf1, ptr, k8) do { _Pragma("unroll") for (int j = 0; j < 8; ++j) { buf0[j] = __builtin_nontemporal_load((const f32x4*)((ptr) + (size_t)((k8) * 8 + j) * 2048)); buf1[j] = __builtin_nontemporal_load((const f32x4*)((ptr) + (size_t)((k8) * 8 + j) * 2048 + 256)); } } while (0)
#define XS_DOT(buf0, buf1, k8) do { _Pragma("unroll") for (int j = 0; j < 8; ++j) { float d = (buf0[j].x * q[0] + buf0[j].y * q[1]) + (buf0[j].z * q[2] + buf0[j].w * q[3]) + (buf1[j].x * q[4] + buf1[j].y * q[5]) + (buf1[j].z * q[6] + buf1[j].w * q[7]); \
        d = rowsum16(d); d += __shfl_xor(d, 16); d += __shfl_xor(d, 32); if (lane == (k8) * 8 + j) myscore = d; } } while (0)
#define XS_ACC(buf0, buf1, k8) do { _Pragma("unroll") for (int j = 0; j < 8; ++j) { const float pj = __builtin_bit_cast(float, __builtin_amdgcn_readlane(__builtin_bit_cast(int, p), (k8) * 8 + j)); o0 += pj * buf0[j]; o1 += pj * buf1[j]; } } while (0)
    float myscore = 0.f;
    f32x4 xa0[8], xa1[8], xb0[8], xb1[8];
    XS_LOAD(xa0, xa1, kp, 0);
    XS_LOAD(xb0, xb1, kp, 1); XS_DOT(xa0, xa1, 0);
    XS_LOAD(xa0, xa1, kp, 2); XS_DOT(xb0, xb1, 1);
    XS_LOAD(xb0, xb1, kp, 3); XS_DOT(xa0, xa1, 2);
    XS_LOAD(xa0, xa1, vp, 0); XS_DOT(xb0, xb1, 3);
    const float scale = 0.04419417382415922f;
    float mx = wave_max(lane < 32 ? myscore : -3.0e38f); if (lane == 0) red[w] = mx; __syncthreads();
    mx = red[0];
#pragma unroll
    for (int i = 1; i < 8; ++i) mx = fmaxf(mx, red[i]);
    const float p = lane < 32 ? __expf((myscore - mx) * scale) : 0.f;
    const float ps = wave_sum(p); if (lane == 0) red[8 + w] = ps;
    f32x4 o0 = zero4(), o1 = zero4();
    XS_LOAD(xb0, xb1, vp, 1); XS_ACC(xa0, xa1, 0);
    XS_LOAD(xa0, xa1, vp, 2); XS_ACC(xb0, xb1, 1);
    XS_LOAD(xb0, xb1, vp, 3); XS_ACC(xa0, xa1, 2);
    XS_ACC(xb0, xb1, 3);
#undef XS_LOAD
#undef XS_DOT
#undef XS_ACC
    *(LAS f32x4*)(part + w * 512 + 4 * lane) = o0; *(LAS f32x4*)(part + w * 512 + 256 + 4 * lane) = o1;
    __syncthreads();
    float tot = 0.f;
#pragma unroll
    for (int i = 0; i < 8; ++i) tot += red[8 + i];
    { const int d = C.tid; float s = 0.f;
#pragma unroll
      for (int i = 0; i < 8; ++i) s += part[i * 512 + d];
      O[(size_t)(MP + n) * DM + h * 512 + d] = (bf16)(pk2(s / tot, 0.f) & 0xffffu); }
    __syncthreads();
}

#ifndef PHASE_MASK
#define PHASE_MASK 0xffffffffu
#endif
#define PM(k) ((PHASE_MASK >> (k)) & 1u)
#ifndef DUP_SUB
#define DUP_SUB 0u
#endif
#define REP(k) for (int rep_ = 0; rep_ < 1 + (int)((DUP_SUB >> (k)) & 1u); ++rep_)
#ifndef DUP_MASK
#define DUP_MASK 0
#endif
#ifndef MK_ONE_LAUNCH
#define MK_ONE_LAUNCH 1
#endif
constexpr int PH_PER_LAYER = 14, NPH = 1 + DEPTH * PH_PER_LAYER;
__global__ void __launch_bounds__(NWAVES * 64, 2) fwd_kernel(Args args) {
    extern __shared__ __attribute__((aligned(16))) unsigned char lds_raw[];
    LAS unsigned char* const lds = (LAS unsigned char*)lds_raw;
    const int wave_s = __builtin_amdgcn_readfirstlane((int)threadIdx.x >> 6);
    volatile LAS unsigned* MISC = (volatile LAS unsigned*)(lds + MISC_OFF);
    for (int u = threadIdx.x; u < (LDS_BYTES - MISC_OFF) / 4; u += NWAVES * 64) ((LAS unsigned*)(lds + MISC_OFF))[u] = 0u;
    __syncthreads();
    XcdBarrier bar; bar.bar = (unsigned*)(args.ws + WS_CTL) + CW_BAR; bar.x = 0; bar.st = nullptr;
    if (MK_ONE_LAUNCH) bar = xcd_barrier_post((unsigned*)(args.ws + WS_CTL) + CW_BAR, MISC + 8);
    bar.wave = wave_s;
    const int lo = args.ph_lo, hi = args.ph_hi;
#define IN(k) (lo <= (k) && (k) < hi)
#define SEAM(k) do { if (MK_ONE_LAUNCH && IN((k) + 1)) xcd_barrier(bar); } while (0)
#define SEAM2(k) do { if (MK_ONE_LAUNCH && IN((k) + 2)) xcd_barrier(bar); } while (0)
#define PHASE_CTX const Ctx C = mk_ctx(lds, wave_s); const Ax a = mk_ax(); unsigned char* const ws = a.ws; const int G = C.G, bid = C.bid; (void)ws; (void)G; (void)bid; \
    float* const XF = (float*)(ws + WS_XF); bf16* const HN = (bf16*)(ws + WS_HN); bf16* const PBUF = (bf16*)(ws + WS_P); bf16* const YC = (bf16*)(ws + WS_YC); bf16* const QB = (bf16*)(ws + WS_Q); \
    bf16* const OB = (bf16*)(ws + WS_O); bf16* const UB = (bf16*)(ws + WS_U); (void)XF; (void)HN; (void)PBUF; (void)YC; (void)QB; (void)OB; (void)UB

    if (IN(0)) { PHASE_CTX; if (PM(0)) p0_prologue(C, a); SEAM(0); }

    for (int l = 0; l < DEPTH; ++l) {
        const int pb = 1 + l * PH_PER_LAYER;
        if (IN(pb + 0)) { PHASE_CTX; const unsigned char* wl = ws + WS_WL + (size_t)l * LW_STRIDE;
            if (PM(1)) { pg8::Gemm g{HN, (const bf16*)(wl + LW_IN), MPAD, PIN, DM, DM, 64, (size_t)PIN * 128}; pg8::StaticOrder S; S.init(MPAD, PIN, G, bid); pg8::EpiBf16A<0> E{PBUF, PIN, nullptr};
              pg8::gemm_phase<pg8::EpiBf16A<0>, pg8::StaticOrder, true, true>(lds, g, S, E, C.tid); }
            if (l + 1 == DEPTH && DEPTH > 1) { const int nfull = (MPAD / 256) * (PIN / 256) - 3 * G; if (G == 256 && bid >= nfull) { __syncthreads(); late_convert(C, a, l, bid - nfull, G - nfull); } }
            if (PM(2) && l == 0) { pg8::Gemm g{(const bf16*)(ws + WS_MN), (const bf16*)(ws + WS_WKV), MMEM, 8192, DM, DM, 64, (size_t)8192 * 128}; pg8::StaticOrder S; S.init(MMEM, 8192, G, (bid + G - (64 % G)) % G);
              pg8::EpiMemKV E{a.out + O_MKP, (bf16*)(ws + WS_MK), (bf16*)(ws + WS_MVT)};
              pg8::gemm_phase<pg8::EpiMemKV, pg8::StaticOrder, true, true>(lds, g, S, E, C.tid); }
            SEAM(pb + 0);
        }
        if (IN(pb + 1)) { PHASE_CTX;
#ifdef DEBUG_P
            { const int gt = bid * 512 + C.tid, NT = G * 512;
              for (int idx = gt + (DEBUG_P == 2 ? MP * 2048 : 0); idx < (DEBUG_P == 1 ? MP : MT) * 2048; idx += NT) { const int row = idx >> 11, c = idx & 2047; const bf16* pr = PBUF + (size_t)row * PIN;
                  float s = bf1(pr[c]) + bf1(pr[c + 2048]) + bf1(pr[c + 4096]); if (c < 256) s += bf1(pr[c + 6144]); a.out[O_YP + idx] = s; } }
#endif
            if (PM(4)) REP(4) for (int it = bid; it < 256; it += G) ad_prompt_item(C, a, l, it);
            if (PM(5)) REP(5) for (int it = bid; it < 256; it += G) ret_pass1_item(C, a, it);
            if (PM(6)) REP(6) for (int it = bid; it < 256; it += G) rwkv_prep_item(C, a, l, it);
            if (PM(6)) for (int it = bid - 64; it >= 0 && it < 4; it += G) rwkv_prep_item(C, a, l, 256 + it);
            if (PM(7)) REP(7) for (int it = G - 1 - bid; it < NS; it += G) ad_sample_item(C, a, l, it);
            if (PM(8)) REP(8) for (int it = bid * NWAVES + C.wave; it < NS * 4; it += G * NWAVES) ret_sample_witem(C, a, l, it);
            __syncthreads();
            SEAM(pb + 1);
        }
        if (IN(pb + 2)) { PHASE_CTX;
            if (PM(9)) REP(9) for (int it = bid * NWAVES + C.wave; it < 4096; it += G * NWAVES) wkv_chunk_witem(C, a, it);
            if (PM(10)) REP(10) for (int it = bid * NWAVES + C.wave; it < NS * 16; it += G * NWAVES) rwkv_sample_witem(C, a, l, it);
            if (PM(11)) ret_prefix_phase(C, a, l);
            SEAM(pb + 2);
        }
        if (IN(pb + 3)) { PHASE_CTX; const int hg = G / 2;
            if (PM(22)) REP(22) for (int it = bid; it < 128; it += (bid < hg ? hg : 1 << 20)) wkv_seq_item(C, a, l, it);
            if (PM(11)) REP(11) if (bid >= hg || G < 2) for (int it = bid - hg; it < 256; it += G - hg) ret_pass2_item(C, a, l, it);
            SEAM(pb + 3);
        }
        if (IN(pb + 4)) { PHASE_CTX;
            if (PM(12)) REP(12) rwkv_post_phase(C, a, l);
            SEAM(pb + 4);
        }
        if (IN(pb + 5)) { PHASE_CTX; const unsigned char* wl = ws + WS_WL + (size_t)l * LW_STRIDE;
            pg8::Gemm g{YC, (const bf16*)(wl + LW_OUT), MP, DM, DM, DM, 64, (size_t)DM * 128}; pg8::StaticOrder S; S.init(MP, DM, G, bid); pg8::EpiRes E{XF, DM, ((DUP_MASK >> 5) & 1) ? 0.5f : 1.0f, (l == 0 && !((DUP_MASK >> 5) & 1)) ? a.in(I_XP) : (const float*)XF};
            if (PM(15)) pg8::gemm_phase<pg8::EpiRes, pg8::StaticOrder, true, true>(lds, g, S, E, C.tid);
            if (PM(20)) sample_gemm(lds, C.tid, YC + (size_t)MP * DM, DM, (const bf16*)(wl + LW_OUT), DM, DM, DM, G, bid, SEpiRes{XF + (size_t)MP * DM, DM, ((DUP_MASK >> 5) & 1) ? 0.5f : 1.0f, (l == 0 && !((DUP_MASK >> 5) & 1)) ? a.in(I_XS) : (const float*)(XF + (size_t)MP * DM)});
            SEAM(pb + 5);
        }
        if (IN(pb + 6)) { PHASE_CTX; if (PM(21)) REP(21) rms_phase(C, XF, HN); SEAM(pb + 6);
#ifdef XBAR_PROBE
            if (MK_ONE_LAUNCH) for (int i_ = 0; i_ < XBAR_PROBE; ++i_) xcd_barrier(bar);
#endif
        }
        if (IN(pb + 7)) { PHASE_CTX; const unsigned char* wl = ws + WS_WL + (size_t)l * LW_STRIDE;
            pg8::Gemm g{HN, (const bf16*)(wl + LW_Q), MP, DM, DM, DM, 64, (size_t)DM * 128}; pg8::StaticOrder S; S.init(MP, DM, G, bid); pg8::EpiBf16A<0> E{QB, DM, nullptr};
            if (PM(16)) REP(16) pg8::gemm_phase<pg8::EpiBf16A<0>, pg8::StaticOrder, true, true>(lds, g, S, E, C.tid);
            if (PM(20)) sample_gemm(lds, C.tid, HN + (size_t)MP * DM, DM, (const bf16*)(wl + LW_Q), DM, DM, DM, G, bid, SEpiPart{(float*)(ws + WS_SPL), DM}, 2);
            SEAM(pb + 7);
        }
        if (IN(pb + 8)) { PHASE_CTX;
            if (PM(13)) REP(13) for (int it = bid; it < 256; it += G) xattn_prompt_unit(C, a, l, it);
            if (PM(14)) REP(14) for (int it = bid; it < NS * 4; it += G) xattn_sample_item(C, a, l, it);
            SEAM(pb + 8);
        }
        if (IN(pb + 9)) { PHASE_CTX; const unsigned char* wl = ws + WS_WL + (size_t)l * LW_STRIDE;
            pg8::Gemm g{OB, (const bf16*)(wl + LW_O), MP, DM, DM, DM, 64, (size_t)DM * 128}; pg8::StaticOrder S; S.init(MP, DM, G, bid); pg8::EpiRes E{XF, DM, ((DUP_MASK >> 9) & 1) ? 0.5f : 1.0f, XF};
            if (PM(17)) pg8::gemm_phase<pg8::EpiRes, pg8::StaticOrder, true, true>(lds, g, S, E, C.tid);
            if (PM(20)) sample_gemm(lds, C.tid, OB + (size_t)MP * DM, DM, (const bf16*)(wl + LW_O), DM, DM, DM, G, bid, SEpiRes{XF + (size_t)MP * DM, DM, ((DUP_MASK >> 9) & 1) ? 0.5f : 1.0f, XF + (size_t)MP * DM});
            SEAM(pb + 9);
        }
        if (IN(pb + 10)) { PHASE_CTX; if (PM(21)) REP(21) rms_phase(C, XF, HN); SEAM(pb + 10); }
        if (IN(pb + 11)) { PHASE_CTX; const unsigned char* wl = ws + WS_WL + (size_t)l * LW_STRIDE;
            pg8::Gemm g{HN, (const bf16*)(wl + LW_UP), MP, DFF, DM, DM, 64, (size_t)DFF * 128}; pg8::StaticOrder S; S.init(MP, DFF, G, bid); pg8::EpiBf16A<3> E{UB, LDU, nullptr};
            if (PM(18)) REP(18) pg8::gemm_phase<pg8::EpiBf16A<3>, pg8::StaticOrder, true, true>(lds, g, S, E, C.tid);
            if (PM(20)) sample_gemm(lds, C.tid, HN + (size_t)MP * DM, DM, (const bf16*)(wl + LW_UP), DFF, DFF, DM, G, bid, SEpiBf16{UB + (size_t)MP * LDU, LDU, 3, nullptr});
            SEAM(pb + 11);
        }
        if (IN(pb + 12)) { PHASE_CTX; const unsigned char* wl = ws + WS_WL + (size_t)l * LW_STRIDE;
            pg8::Gemm g{UB, (const bf16*)(wl + LW_DN), MP, DM, DFF, LDU, 64, (size_t)DM * 128}; pg8::StaticOrder S; S.init(MP, DM, G, bid); pg8::EpiRes E{XF, DM, ((DUP_MASK >> 12) & 1) ? 0.5f : 1.0f, XF};
            if (PM(19)) pg8::gemm_phase<pg8::EpiRes, pg8::StaticOrder, true, true>(lds, g, S, E, C.tid);
            if (PM(20)) sample_gemm(lds, C.tid, UB + (size_t)MP * LDU, LDU, (const bf16*)(wl + LW_DN), DM, DM, DFF, G, bid, SEpiPart{(float*)(ws + WS_SPL), DM}, 2);
            SEAM(pb + 12);
        }
        if (IN(pb + 13)) { PHASE_CTX;
            fold_split_rows(C, XF, (const float*)(ws + WS_SPL));
            if (!PM(21)) {} else if (l + 1 < DEPTH) REP(21) rms_phase(C, XF, HN); else final_norm_phase(C, XF, a.in(I_GFIN), a.out + O_YP);
            SEAM(pb + 13);
        }
    }
#undef IN
#undef SEAM
#undef SEAM2
#undef PHASE_CTX
}

extern "C" void kernel_launch(void* const* d_in, const int* in_sizes, int n_in, void* d_out, int out_size, void* d_ws, size_t ws_size, hipStream_t stream) {
    static int grid = 0;
    if (grid == 0) {
        if (n_in != NIN || (size_t)out_size != O_END || ws_size < WS_END) { fprintf(stderr, "kernel_launch: unexpected shapes (n_in %d, out %d, ws %zu); nothing launched\n", n_in, out_size, ws_size); grid = -1; return; }
        int dev = 0, cus = 0, per_cu = 0;
        if (hipGetDevice(&dev) != hipSuccess || hipDeviceGetAttribute(&cus, hipDeviceAttributeMultiprocessorCount, dev) != hipSuccess) { grid = -1; return; }
        if (hipFuncSetAttribute((const void*)fwd_kernel, hipFuncAttributeMaxDynamicSharedMemorySize, LDS_BYTES) != hipSuccess) { fprintf(stderr, "kernel_launch: hipFuncSetAttribute failed\n"); grid = -1; return; }
        if (hipOccupancyMaxActiveBlocksPerMultiprocessor(&per_cu, (const void*)fwd_kernel, NWAVES * 64, LDS_BYTES) != hipSuccess || per_cu < 1) { fprintf(stderr, "kernel_launch: occupancy query reports %d\n", per_cu); }
        (void)hipGetLastError();
        grid = cus;
    }
    if (grid < 0) return;
    if (hipMemsetAsync((char*)d_ws + WS_CTL, 0, CTL_ZERO_BYTES, stream) != hipSuccess) return;
    Args a{};
    for (int i = 0; i < NIN; ++i) a.in[i] = (const float*)d_in[i];
    a.out = (float*)d_out; a.ws = (unsigned char*)d_ws;
#if MK_ONE_LAUNCH
    a.ph_lo = 0; a.ph_hi = NPH;
    hipLaunchKernelGGL(fwd_kernel, dim3(grid), dim3(NWAVES * 64), LDS_BYTES, stream, a);
#else
#ifndef NPH_RUN
#define NPH_RUN NPH
#endif
    for (int ph = 0; ph < NPH_RUN; ++ph) { a.ph_lo = ph; a.ph_hi = ph + 1; hipLaunchKernelGGL(fwd_kernel, dim3(grid), dim3(NWAVES * 64), LDS_BYTES, stream, a);
        const int dbit = (ph == 0) ? 13 : (ph - 1) % PH_PER_LAYER;
        if ((DUP_MASK >> dbit) & 1) hipLaunchKernelGGL(fwd_kernel, dim3(grid), dim3(NWAVES * 64), LDS_BYTES, stream, a); }
#endif
}
```

```cpp
#include <hip/hip_runtime.h>
#include <cstdio>
#include <cstdint>
namespace pg8 {
#define PG8_LAS __attribute__((address_space(3)))
typedef unsigned short bf16_t;
typedef short bf16x8 __attribute__((ext_vector_type(8)));
typedef float f32x4 __attribute__((ext_vector_type(4)));
typedef unsigned u32x4 __attribute__((ext_vector_type(4)));
constexpr int BM = 256, BK = 64, HALF = 128, HTB = HALF * BK * 2  , STAGE_BYTES = 8 * HTB, NXCD = 8, WGM = 8;

__host__ __device__ __forceinline__ int lds_byte(int r, int c) { const int st = (r >> 4) * 2 + (c >> 5), rr = r & 15, cc = c & 31, ob = rr * 64 + cc * 2; return st * 1024 + (ob ^ (((ob >> 9) & 1) << 5)); }
__host__ __device__ __forceinline__ void stage_rc(int b, int& R, int& C) { const int st = b / 1024, sb = b % 1024, swz = sb ^ (((sb >> 9) & 1) << 5); R = (st >> 1) * 16 + swz / 64; C = (st & 1) * 32 + (swz % 64) / 2; }
__host__ __device__ __forceinline__ int perm32(int rho) { const int n = rho >> 4, i = rho & 15; return 8 * (i >> 2) + 4 * n + (i & 3); }

struct Unit { int pm, pn; };
struct Gemm { const bf16_t* A; const bf16_t* Bt; int M, N, K, lda, ldb; size_t ksb; };

struct StaticOrder {
    int nM, nN, nwg, G, c;
    __host__ __device__ void init(int M, int N, int G_, int c_) { nM = M / BM; nN = N / BM; nwg = nM * nN; G = G_; c = c_; }
    __host__ __device__ bool next(int i, Unit& u) const {
        const long L = (long)i * G + c; if (L >= nwg) return false;
        int wgid = (int)L; { const int q = nwg / NXCD, r = nwg % NXCD, xcd = wgid % NXCD, off = wgid / NXCD; wgid = (xcd < r ? xcd * (q + 1) : r * (q + 1) + (xcd - r) * q) + off; }
        const int nig = WGM * nN, gid = wgid / nig, fm = gid * WGM, gsz = (nM - fm) < WGM ? (nM - fm) : WGM;
        u.pm = fm + ((wgid % nig) % gsz); u.pn = (wgid % nig) / gsz; return true;
    }
    __device__ __forceinline__ void a_ready(const Unit&) const {}
    __device__ __forceinline__ void done(const Unit&) const {}
};

typedef float f32x2_cv __attribute__((ext_vector_type(2)));
typedef __bf16 bf16x2_cv __attribute__((ext_vector_type(2)));
__device__ __forceinline__ unsigned cvt_pk_bf16(float lo, float hi) { const f32x2_cv v = {lo, hi}; return __builtin_bit_cast(unsigned, __builtin_convertvector(v, bf16x2_cv)); }
typedef float f32x2 __attribute__((ext_vector_type(2)));
template <class Epi, class Sched, bool ALIGN_EPI = false, bool SP2 = false>
__device__ __forceinline__ void gemm_phase(PG8_LAS unsigned char* lds, const Gemm g, const Sched& S, const Epi& E, int tid_in) {
    int tid_ = tid_in; asm volatile("" : "+v"(tid_));
    const int tid = tid_, wid = __builtin_amdgcn_readfirstlane(tid >> 6), lane = tid & 63, wr = wid >> 2, wc = wid & 3, fr = lane & 15, fq = lane >> 4;
    const int K = g.K, nt = K / BK;
    unsigned voffA[2], voffB[2];
#pragma unroll
    for (int i = 0; i < 2; ++i) { int R, C; stage_rc(tid * 16 + i * 8192, R, C); const int Rb = Epi::PERM ? ((R & ~31) + perm32(R & 31)) : R;
        voffA[i] = (unsigned)(R * g.lda + C) * 2u; voffB[i] = (unsigned)(Rb * g.ldb + C) * 2u; }
    const size_t kstep = (size_t)(BK * 2), kstepB = g.ksb;
    const size_t hstepA = (size_t)HALF * g.lda * 2, hstepB = (size_t)HALF * g.ldb * 2;
    const size_t tstepA = 2 * hstepA, tstepB = 2 * hstepB;
    const unsigned ldsw = (unsigned)wid * 1024u;
    const int aoff = lds_byte(wr * 64 + fr, fq * 8), boff = lds_byte(wc * 32 + fr, fq * 8);
#define PG8_SA(b, h) (((b) * 2 + (h)) * HTB)
#define PG8_SB(b, h) ((4 + (b) * 2 + (h)) * HTB)
#define PG8_STAGE(bufoff, gbase, voff) do { _Pragma("unroll") for (int _i = 0; _i < 2; ++_i) \
        __builtin_amdgcn_global_load_lds((const unsigned*)((const char*)(gbase) + (voff)[_i]), (PG8_LAS unsigned*)(lds + (bufoff) + ldsw + _i * 8192), 16, 0, 0); } while (0)
#define PG8_LDA(dst, b, h) do { _Pragma("unroll") for (int m = 0; m < 4; ++m) _Pragma("unroll") for (int k = 0; k < 2; ++k) dst[m][k] = *(const PG8_LAS bf16x8*)(lds + PG8_SA(b, h) + aoff + m * 2048 + k * 1024); } while (0)
#define PG8_LDB(dst, b, h) do { _Pragma("unroll") for (int n = 0; n < 2; ++n) _Pragma("unroll") for (int k = 0; k < 2; ++k) dst[n][k] = *(const PG8_LAS bf16x8*)(lds + PG8_SB(b, h) + boff + n * 2048 + k * 1024); } while (0)
#define PG8_MMA(ai, bj, At, Bt) do { __builtin_amdgcn_s_setprio(1); _Pragma("unroll") for (int m = 0; m < 4; ++m) _Pragma("unroll") for (int n = 0; n < 2; ++n) _Pragma("unroll") for (int k = 0; k < 2; ++k) \
        acc[ai][bj][m][n] = __builtin_amdgcn_mfma_f32_16x16x32_bf16(Bt[n][k], At[m][k], acc[ai][bj][m][n], 0, 0, 0); __builtin_amdgcn_s_setprio(0); } while (0)
#define PG8_WAIT_V(n) asm volatile("s_waitcnt vmcnt(" #n ")" ::: "memory")
#define PG8_WAIT_L(n) asm volatile("s_waitcnt lgkmcnt(" #n ")" ::: "memory")
#define PG8_BAR __builtin_amdgcn_s_barrier()
#define PG8_SCHED __builtin_amdgcn_sched_barrier(0)
    Unit cur, nxt; int ui = 0;
    if (!S.next(0, cur)) return;
    f32x4 acc[2][2][4][2];
#pragma unroll
    for (int a = 0; a < 2; ++a)
#pragma unroll
        for (int b = 0; b < 2; ++b)
#pragma unroll
            for (int m = 0; m < 4; ++m)
#pragma unroll
                for (int n = 0; n < 2; ++n) acc[a][b][m][n] = (f32x4){0.f, 0.f, 0.f, 0.f};
    bf16x8 At[4][2], B0[2][2], B1[2][2];
    const char* cA = (const char*)g.A + (size_t)cur.pm * tstepA; const char* cB = (const char*)g.Bt + (size_t)cur.pn * tstepB;
    S.a_ready(cur);
    if constexpr (SP2) {
        PG8_STAGE(PG8_SB(0, 0), cB, voffB); PG8_STAGE(PG8_SB(0, 1), cB + hstepB, voffB); PG8_STAGE(PG8_SA(0, 0), cA, voffA); PG8_STAGE(PG8_SA(0, 1), cA + hstepA, voffA);
        if (wr == 1) PG8_BAR;
        PG8_WAIT_V(2); PG8_BAR;
        PG8_STAGE(PG8_SB(1, 0), cB + kstepB, voffB); PG8_STAGE(PG8_SA(1, 0), cA + kstep, voffA); PG8_STAGE(PG8_SB(1, 1), cB + hstepB + kstepB, voffB);
        PG8_WAIT_V(6); PG8_BAR;
    } else {
        PG8_STAGE(PG8_SB(0, 0), cB, voffB); PG8_STAGE(PG8_SA(0, 0), cA, voffA); PG8_STAGE(PG8_SB(0, 1), cB + hstepB, voffB); PG8_STAGE(PG8_SA(0, 1), cA + hstepA, voffA);
        if (wr == 1) PG8_BAR;
        PG8_WAIT_V(4); PG8_BAR;
        PG8_STAGE(PG8_SB(1, 0), cB + kstepB, voffB); PG8_STAGE(PG8_SA(1, 0), cA + kstep, voffA); PG8_STAGE(PG8_SB(1, 1), cB + hstepB + kstepB, voffB);
        PG8_WAIT_V(6); PG8_BAR;
    }
    for (;;) {
        const bool has_next = S.next(ui + 1, nxt);
        const char* nA = has_next ? (const char*)g.A + (size_t)nxt.pm * tstepA : cA; const char* nB = has_next ? (const char*)g.Bt + (size_t)nxt.pn * tstepB : cB;
        for (int t = 0; t < nt; t += 2) {
            const bool last = (t == nt - 2);
            const char* a1 = cA + (size_t)(t + 1) * kstep;
            const char* a2 = last ? nA : cA + (size_t)(t + 2) * kstep; const char* b2 = last ? nB : cB + (size_t)(t + 2) * kstepB;
            const char* a3 = a2 + kstep; const char* b3 = b2 + kstepB;
            if (last && has_next) S.a_ready(nxt);
            if constexpr (SP2) {
            PG8_LDB(B0, 0, 0); PG8_LDB(B1, 0, 1); PG8_SCHED; PG8_LDA(At, 0, 0); PG8_STAGE(PG8_SA(1, 1), a1 + hstepA, voffA);
            PG8_WAIT_V(8); PG8_WAIT_L(0); PG8_BAR; PG8_MMA(0, 0, At, B0); PG8_MMA(0, 1, At, B1); PG8_BAR; PG8_SCHED;
            PG8_LDA(At, 0, 1); PG8_STAGE(PG8_SB(0, 0), b2, voffB); PG8_STAGE(PG8_SB(0, 1), b2 + hstepB, voffB); PG8_STAGE(PG8_SA(0, 0), a2, voffA);
            PG8_WAIT_V(8); PG8_WAIT_L(0); PG8_BAR; PG8_MMA(1, 0, At, B0); PG8_MMA(1, 1, At, B1); PG8_BAR; PG8_SCHED;
            PG8_LDB(B0, 1, 0); PG8_LDB(B1, 1, 1); PG8_SCHED; PG8_LDA(At, 1, 0); PG8_STAGE(PG8_SA(0, 1), a2 + hstepA, voffA);
            PG8_WAIT_V(8); PG8_WAIT_L(0); PG8_BAR; PG8_MMA(0, 0, At, B0); PG8_MMA(0, 1, At, B1); PG8_BAR; PG8_SCHED;
            PG8_LDA(At, 1, 1); PG8_STAGE(PG8_SB(1, 0), b3, voffB); PG8_STAGE(PG8_SB(1, 1), b3 + hstepB, voffB); PG8_STAGE(PG8_SA(1, 0), a3, voffA);
            PG8_WAIT_V(8); PG8_WAIT_L(0); PG8_BAR; PG8_MMA(1, 0, At, B0); PG8_MMA(1, 1, At, B1); PG8_BAR; PG8_SCHED;
            } else {
            PG8_LDB(B0, 0, 0); PG8_SCHED; PG8_LDA(At, 0, 0); PG8_STAGE(PG8_SA(1, 1), a1 + hstepA, voffA);
            PG8_WAIT_L(8); PG8_BAR; PG8_WAIT_L(0); PG8_MMA(0, 0, At, B0); PG8_BAR; PG8_SCHED;
            PG8_LDB(B1, 0, 1); PG8_STAGE(PG8_SB(0, 0), b2, voffB);
            PG8_BAR; PG8_WAIT_L(0); PG8_MMA(0, 1, At, B1); PG8_BAR;
            PG8_LDA(At, 0, 1); PG8_STAGE(PG8_SA(0, 0), a2, voffA);
            PG8_BAR; PG8_WAIT_L(0); PG8_MMA(1, 0, At, B0); PG8_BAR; PG8_SCHED;
            PG8_STAGE(PG8_SB(0, 1), b2 + hstepB, voffB);
            PG8_WAIT_V(6); PG8_BAR; PG8_MMA(1, 1, At, B1); PG8_BAR;
            PG8_LDB(B0, 1, 0); PG8_SCHED; PG8_LDA(At, 1, 0); PG8_STAGE(PG8_SA(0, 1), a2 + hstepA, voffA);
            PG8_WAIT_L(8); PG8_BAR; PG8_WAIT_L(0); PG8_MMA(0, 0, At, B0); PG8_BAR; PG8_SCHED;
            PG8_LDB(B1, 1, 1); PG8_STAGE(PG8_SB(1, 0), b3, voffB);
            PG8_BAR; PG8_WAIT_L(0); PG8_MMA(0, 1, At, B1); PG8_BAR;
            PG8_LDA(At, 1, 1); PG8_STAGE(PG8_SA(1, 0), a3, voffA);
            PG8_BAR; PG8_WAIT_L(0); PG8_MMA(1, 0, At, B0); PG8_BAR; PG8_SCHED;
            PG8_STAGE(PG8_SB(1, 1), b3 + hstepB, voffB);
            PG8_WAIT_V(6); PG8_BAR; PG8_MMA(1, 1, At, B1); PG8_BAR;
            }
        }
        if constexpr (ALIGN_EPI) { if (wr == 0) PG8_BAR; }
        if constexpr (!Epi::AFTER_DRAIN) { E(acc, cur, wr, wc, fr, fq); S.done(cur); }
        if (!has_next) break;
#pragma unroll
        for (int a = 0; a < 2; ++a)
#pragma unroll
            for (int b = 0; b < 2; ++b)
#pragma unroll
                for (int m = 0; m < 4; ++m)
#pragma unroll
                    for (int n = 0; n < 2; ++n) acc[a][b][m][n] = (f32x4){0.f, 0.f, 0.f, 0.f};
        cur = nxt; cA = nA; cB = nB; ++ui;
        if constexpr (ALIGN_EPI) { if (wr == 1) PG8_BAR; }
    }
    PG8_WAIT_V(0);
    if constexpr (!ALIGN_EPI) { if (wr == 0) PG8_BAR; }
    PG8_BAR;
    if constexpr (Epi::AFTER_DRAIN) { E.fused(acc, cur, wr, wc, fr, fq, lds, wid, lane); S.done(cur); }
#undef PG8_SA
#undef PG8_SB
#undef PG8_STAGE
#undef PG8_LDA
#undef PG8_LDB
#undef PG8_MMA
#undef PG8_WAIT_V
#undef PG8_WAIT_L
#undef PG8_BAR
#undef PG8_SCHED
}
}

constexpr int DM = 2048, SEQ = 2048, NB = 4, NS = 128, DEPTH = 2;
constexpr int MP = NB * SEQ;
constexpr int MT = MP + NS;
constexpr int MPAD = MP + 256;
constexpr int PIN = 6400, DFF = 8192, NMEM = 256, MMEM = NB * NMEM;
constexpr int PB_ = 1536, PC_ = 3584, PD_ = 5376;
constexpr int SHW = 1792;
constexpr int LDU = 8192;
constexpr int NWAVES = 8;
constexpr int NIN = 39;

constexpr size_t O_YP = 0, O_YS = O_YP + (size_t)MP * DM, O_CAP = O_YS + (size_t)NS * DM, O_CAS = O_CAP + (size_t)DEPTH * NB * 2 * 512,
    O_RETP = O_CAS + (size_t)DEPTH * NS * 2 * 512, O_RETS = O_RETP + (size_t)DEPTH * NB * 4 * 128 * 128, O_SHP = O_RETS + (size_t)DEPTH * NS * 4 * 128 * 128,
    O_SHS = O_SHP + (size_t)DEPTH * NB * SHW, O_WKVP = O_SHS + (size_t)DEPTH * NS * SHW, O_WKVS = O_WKVP + (size_t)DEPTH * NB * 8 * 64 * 64,
    O_CDP = O_WKVS + (size_t)DEPTH * NS * 8 * 64 * 64, O_CDS = O_CDP + (size_t)DEPTH * NB * 30 * 512, O_MKP = O_CDS + (size_t)DEPTH * NS * 30 * 512,
    O_MVP = O_MKP + (size_t)DEPTH * MMEM * DM, O_END = O_MVP + (size_t)DEPTH * MMEM * DM;
static_assert(O_END == 56178688, "d_out size");

constexpr size_t MiB = 1u << 20;
constexpr size_t al256(size_t x) { return (x + 255) & ~(size_t)255; }
constexpr size_t WS_CTL = 0, CTL_ZERO_BYTES = 1 * MiB;
constexpr size_t WS_ROPE = 1 * MiB;
constexpr size_t SZ_WIN = (size_t)PIN * DM * 2, SZ_SQ = (size_t)DM * DM * 2, SZ_WUP = (size_t)DFF * DM * 2, SZ_WDN = (size_t)DM * LDU * 2;
constexpr size_t LW_IN = 0, LW_OUT = LW_IN + SZ_WIN, LW_Q = LW_OUT + SZ_SQ, LW_O = LW_Q + SZ_SQ, LW_UP = LW_O + SZ_SQ, LW_DN = LW_UP + SZ_WUP,
    LW_W2 = LW_DN + SZ_WDN, LW_A2 = LW_W2 + 512 * 64 * 2, LW_G2 = LW_A2 + 512 * 64 * 2, LW_STRIDE = LW_G2 + 512 * 128 * 2;
constexpr size_t WS_WL = 4 * MiB;
constexpr size_t WS_WKV = al256(WS_WL + 2 * LW_STRIDE);
constexpr size_t WS_XF = al256(WS_WKV + (size_t)8192 * DM * 2);
constexpr size_t WS_HN = al256(WS_XF + (size_t)MT * DM * 4);
constexpr size_t WS_MN = al256(WS_HN + (size_t)MPAD * DM * 2);
constexpr size_t WS_MK = al256(WS_MN + (size_t)MMEM * DM * 2);
constexpr size_t WS_MVT = al256(WS_MK + (size_t)2 * MMEM * DM * 2);
constexpr size_t WS_P = al256(WS_MVT + (size_t)2 * MMEM * DM * 2);
constexpr size_t WS_YC = al256(WS_P + (size_t)MPAD * PIN * 2);
constexpr size_t WS_Q = al256(WS_YC + (size_t)MT * DM * 2);
constexpr size_t WS_O = al256(WS_Q + (size_t)MT * DM * 2);
constexpr size_t WS_U = al256(WS_O + (size_t)MT * DM * 2);
constexpr size_t WS_RW = al256(WS_U + (size_t)MT * LDU * 2);
constexpr size_t WS_GATE = al256(WS_RW + (size_t)MT * 8 * 896);
constexpr size_t WS_OC = al256(WS_GATE + (size_t)MT * 512 * 4);
constexpr size_t WS_KVT = al256(WS_OC + (size_t)MT * 512 * 4);
constexpr size_t WS_SSQ = al256(WS_KVT + (size_t)16 * 16 * 128 * 128 * 4);
constexpr size_t WS_SPL = al256(WS_SSQ + (size_t)MP * 8 * 4);
constexpr size_t WS_STB = al256(WS_SPL + (size_t)2 * NS * DM * 4);
constexpr size_t WS_CK = al256(WS_STB + (size_t)16 * 16 * 128 * 128 * 2);
constexpr size_t WS_CP = al256(WS_CK + (size_t)4096 * 6912);
constexpr size_t WS_END = al256(WS_CP + (size_t)4096 * 4 * 3072);
static_assert(WS_END < (size_t)1700 * MiB, "d_ws map");
constexpr int CW_BAR = 4096;

constexpr int SCR_BYTES = 147456;
constexpr int MISC_OFF = SCR_BYTES;
constexpr int LDS_BYTES = SCR_BYTES + 1024;

#define GAS __attribute__((address_space(1)))
#define LAS __attribute__((address_space(3)))
typedef unsigned short bf16;
typedef unsigned v4u __attribute__((ext_vector_type(4)));
typedef unsigned v2u __attribute__((ext_vector_type(2)));
typedef float f32x4 __attribute__((ext_vector_type(4)));
typedef float f32x2 __attribute__((ext_vector_type(2)));
typedef short bf16x8 __attribute__((ext_vector_type(8)));
typedef short bf16x4 __attribute__((ext_vector_type(4)));
typedef GAS unsigned gu32;
#define RLX_AGENT __ATOMIC_RELAXED, __HIP_MEMORY_SCOPE_AGENT
#define LDS_WAIT() asm volatile("s_waitcnt lgkmcnt(0)" ::: "memory")
#define VM_WAIT() asm volatile("s_waitcnt vmcnt(0)" ::: "memory")
__device__ __forceinline__ unsigned pk2(float lo, float hi) { return pg8::cvt_pk_bf16(lo, hi); }
__device__ __forceinline__ float bflo(unsigned w) { return __uint_as_float(w << 16); }
__device__ __forceinline__ float bfhi(unsigned w) { return __uint_as_float(w & 0xffff0000u); }
__device__ __forceinline__ float bf1(bf16 h) { return __uint_as_float(((unsigned)h) << 16); }
__device__ __forceinline__ void unpack8(const v4u w, float (&f)[8]) { f[0] = bflo(w.x); f[1] = bfhi(w.x); f[2] = bflo(w.y); f[3] = bfhi(w.y); f[4] = bflo(w.z); f[5] = bfhi(w.z); f[6] = bflo(w.w); f[7] = bfhi(w.w); }
__device__ __forceinline__ void unpack4(const v2u w, float (&f)[4]) { f[0] = bflo(w.x); f[1] = bfhi(w.x); f[2] = bflo(w.y); f[3] = bfhi(w.y); }
__device__ __forceinline__ v4u pack8(const float (&f)[8]) { v4u w; w.x = pk2(f[0], f[1]); w.y = pk2(f[2], f[3]); w.z = pk2(f[4], f[5]); w.w = pk2(f[6], f[7]); return w; }
__device__ __forceinline__ float sigm(float x) { return 1.0f / (1.0f + __expf(-x)); }
__device__ __forceinline__ float wave_sum(float v) {
#pragma unroll
    for (int o = 1; o < 64; o <<= 1) v += __shfl_xor(v, o);
    return v;
}
__device__ __forceinline__ float wave_max(float v) {
#pragma unroll
    for (int o = 1; o < 64; o <<= 1) v = fmaxf(v, __shfl_xor(v, o));
    return v;
}
template <int CTRL> __device__ __forceinline__ float dpp_f(float v) { return __builtin_bit_cast(float, __builtin_amdgcn_update_dpp(0, __builtin_bit_cast(int, v), CTRL, 0xf, 0xf, false)); }
__device__ __forceinline__ f32x4 zero4() { f32x4 z = (f32x4){0.f, 0.f, 0.f, 0.f}; asm volatile("" : "+v"(z)); return z; }
__device__ __forceinline__ float rowsum16(float v) { v += dpp_f<0x128>(v); v += dpp_f<0x124>(v); v += dpp_f<0x122>(v); v += dpp_f<0x121>(v); return v; }

namespace pg8 {
template <int ACT> struct EpiBf16A {
    static constexpr bool PERM = true, AFTER_DRAIN = false;
    bf16_t* O; int ldc; const float* ssq;
    __device__ __forceinline__ void operator()(const f32x4 (&acc)[2][2][4][2], const Unit& u, int wr, int wc, int fr, int fq) const {
        const int row0 = u.pm * BM + wr * 64 + fr, col0 = u.pn * BM + wc * 32 + 8 * fq;
#pragma unroll
        for (int ai = 0; ai < 2; ++ai)
#pragma unroll
            for (int m = 0; m < 4; ++m) { bf16_t* rowp = O + (size_t)(row0 + ai * HALF + m * 16) * ldc + col0;
                const float rs = ssq ? 1.0f / sqrtf(ssq[row0 + ai * HALF + m * 16] * (1.0f / 2048.0f) + 1e-6f) : 1.0f;
#pragma unroll
                for (int bj = 0; bj < 2; ++bj) { f32x4 v0 = acc[ai][bj][m][0] * rs, v1 = acc[ai][bj][m][1] * rs;
                    if (ACT == 3) {
#pragma unroll
                        for (int j = 0; j < 4; ++j) { const float a = fmaxf(v0[j], 0.f), b = fmaxf(v1[j], 0.f); v0[j] = a * a; v1[j] = b * b; } }
                    u32x4 w; w.x = cvt_pk_bf16(v0[0], v0[1]); w.y = cvt_pk_bf16(v0[2], v0[3]); w.z = cvt_pk_bf16(v1[0], v1[1]); w.w = cvt_pk_bf16(v1[2], v1[3]);
                    *(u32x4*)(rowp + bj * HALF) = w; } }
    }
};
struct EpiRes {
    static constexpr bool PERM = false, AFTER_DRAIN = false;
    float* X; int ldc; float sc; const float* Xin;
    __device__ __forceinline__ void operator()(const f32x4 (&acc)[2][2][4][2], const Unit& u, int wr, int wc, int fr, int fq) const {
        const int row0 = u.pm * BM + wr * 64 + fr, col0 = u.pn * BM + wc * 32 + 4 * fq;
#pragma unroll
        for (int ai = 0; ai < 2; ++ai)
#pragma unroll
            for (int m = 0; m < 4; ++m) { float* rowp = X + (size_t)(row0 + ai * HALF + m * 16) * ldc + col0; const float* inp = Xin + (size_t)(row0 + ai * HALF + m * 16) * ldc + col0;
                f32x4 o[2][2];
#pragma unroll
                for (int bj = 0; bj < 2; ++bj)
#pragma unroll
                    for (int n = 0; n < 2; ++n) o[bj][n] = *(const f32x4*)(inp + bj * HALF + n * 16);
#pragma unroll
                for (int bj = 0; bj < 2; ++bj)
#pragma unroll
                    for (int n = 0; n < 2; ++n) *(f32x4*)(rowp + bj * HALF + n * 16) = o[bj][n] + acc[ai][bj][m][n] * sc; }
    }
};
struct EpiMemKV {
    static constexpr bool PERM = false, AFTER_DRAIN = false;
    float* outK; bf16_t* MKb; bf16_t* MVT;
    __device__ __forceinline__ void operator()(const f32x4 (&acc)[2][2][4][2], const Unit& u, int wr, int wc, int fr, int fq) const {
        const int cbase = u.pn * BM, lyr = cbase >> 12, cc = cbase & 4095; const bool isV = cc >= 2048; const int colt = cc & 2047;
        const int row0 = u.pm * BM + wr * 64 + fr, col0 = colt + wc * 32 + 4 * fq;
        float* outp = outK + (isV ? (size_t)(O_MVP - O_MKP) : (size_t)0);
#pragma unroll
        for (int ai = 0; ai < 2; ++ai)
#pragma unroll
            for (int m = 0; m < 4; ++m) { const int r = row0 + ai * HALF + m * 16;
#pragma unroll
                for (int bj = 0; bj < 2; ++bj)
#pragma unroll
                    for (int n = 0; n < 2; ++n) { const int col = col0 + bj * HALF + n * 16; const f32x4 v = acc[ai][bj][m][n];
                        *(f32x4*)(outp + ((size_t)lyr * 1024 + r) * 2048 + col) = v;
                        if (!isV) { unsigned lo = cvt_pk_bf16(v[0], v[1]), hi = cvt_pk_bf16(v[2], v[3]); *(unsigned long long*)(MKb + ((size_t)lyr * 1024 + r) * 2048 + col) = ((unsigned long long)hi << 32) | lo; }
                        else { const int b = r >> 8, j = r & 255, h = col >> 9, e = col & 511; bf16_t* tp = MVT + ((((size_t)lyr * 4 + b) * 4 + h) * 512 + e) * 256 + j;
                            const unsigned lo = cvt_pk_bf16(v[0], v[1]), hi = cvt_pk_bf16(v[2], v[3]);
                            tp[0] = (bf16_t)(lo & 0xffffu); tp[256] = (bf16_t)(lo >> 16); tp[512] = (bf16_t)(hi & 0xffffu); tp[768] = (bf16_t)(hi >> 16); } } }
    }
};
}

struct SEpiBf16 { bf16* O; int ldc; int act; const float* ssq;
    __device__ __forceinline__ void operator()(int row, int col0, f32x4 v, int) const {
        if (ssq) v = v * (1.0f / sqrtf(ssq[row] * (1.0f / 2048.0f) + 1e-6f));
        if (act == 3) {
#pragma unroll
            for (int j = 0; j < 4; ++j) { const float a = fmaxf(v[j], 0.f); v[j] = a * a; } }
        v2u w; w.x = pk2(v[0], v[1]); w.y = pk2(v[2], v[3]); *(v2u*)(O + (size_t)row * ldc + col0) = w; } };
struct SEpiRes { float* X; int ldc; float sc; const float* Xin;
    __device__ __forceinline__ void operator()(int row, int col0, f32x4 v, int) const { *(f32x4*)(X + (size_t)row * ldc + col0) = *(const f32x4*)(Xin + (size_t)row * ldc + col0) + v * sc; } };
struct SEpiPart { float* S; int ldc;
    __device__ __forceinline__ void operator()(int row, int col0, f32x4 v, int kp) const { *(f32x4*)(S + ((size_t)kp * NS + row) * ldc + col0) = v; } };
template <class F> __device__ __forceinline__ void sample_gemm(LAS unsigned char* lds, int tid_in, const bf16* A, int lda, const bf16* Bt, int ntot, int N, int K, int G, int bid, const F& epi, int nks = 1) {
    int tid_ = tid_in; asm volatile("" : "+v"(tid_));
    const int lane = tid_ & 63, wave = __builtin_amdgcn_readfirstlane(tid_ >> 6), fr = lane & 15, fq = lane >> 4;
    const int KS = (K / nks) >> 3, ncu = N / 16;
    LAS f32x4* red = (LAS f32x4*)lds;
    const unsigned voffa = (unsigned)(fr * lda + fq * 8) * 2u, voffb = (unsigned)(fr * 64 + fq * 8) * 2u;
    for (int uu = bid; uu < ncu * nks; uu += G) { const int kp = uu / ncu, u = uu - kp * ncu, kbeg = kp * (K / nks) + wave * KS;
        const char* bp = (const char*)(Bt + ((size_t)(kbeg >> 6) * ntot + u * 16) * 64);
        const char* ap = (const char*)(A + kbeg);
        f32x4 acc[8];
#pragma unroll
        for (int rt = 0; rt < 8; ++rt) acc[rt] = zero4();
        bf16x8 b0[2], a0[2][8], b1[2], a1[2][8];
#define SG_LOAD(bb, aa, kq) do { _Pragma("unroll") for (int s = 0; s < 2; ++s) { bb[s] = *(const bf16x8*)(bp + ((size_t)((kq) >> 6) * ntot * 64 + 32 * s) * 2 + voffb); \
            _Pragma("unroll") for (int rt = 0; rt < 8; ++rt) aa[s][rt] = *(const bf16x8*)(ap + ((size_t)rt * 16 * lda + (kq) + 32 * s) * 2 + voffa); } } while (0)
#define SG_MMA(bb, aa) do { _Pragma("unroll") for (int s = 0; s < 2; ++s) _Pragma("unroll") for (int rt = 0; rt < 8; ++rt) acc[rt] = __builtin_amdgcn_mfma_f32_16x16x32_bf16(bb[s], aa[s][rt], acc[rt], 0, 0, 0); } while (0)
        SG_LOAD(b0, a0, 0);
        for (int k0 = 0; k0 < KS; k0 += 128) {
            SG_LOAD(b1, a1, k0 + 64);
            SG_MMA(b0, a0);
            if (k0 + 128 < KS) SG_LOAD(b0, a0, k0 + 128);
            SG_MMA(b1, a1);
        }
#undef SG_LOAD
#undef SG_MMA
#pragma unroll
        for (int rt = 0; rt < 8; ++rt) red[(wave * 8 + rt) * 64 + lane] = acc[rt];
        __syncthreads();
        f32x4 sum = red[wave * 64 + lane];
#pragma unroll
        for (int ks = 1; ks < 8; ++ks) sum += red[(ks * 8 + wave) * 64 + lane];
        epi(wave * 16 + fr, u * 16 + 4 * fq, sum, kp);
        __syncthreads();
    }
}
#define XB_TMO      128
#define XB_XCNT(j)  (256  + 64 * (j))
#define XB_XSUB(j)  (1280 + 64 * (j))
#define XB_XGEN(j)  (2304 + 64 * (j))
#define XB_TOP      3328
#define XB_TOPGEN   3392
#define XCD_BAR_WORDS 3456
#define XB_SPIN_CAP (1u << 18)

__device__ __forceinline__ unsigned xb_ld(unsigned* p)              { return __hip_atomic_load(p, __ATOMIC_RELAXED, __HIP_MEMORY_SCOPE_AGENT); }
__device__ __forceinline__ unsigned xb_add(unsigned* p, unsigned v) { return __hip_atomic_fetch_add(p, v, __ATOMIC_RELAXED, __HIP_MEMORY_SCOPE_AGENT); }
__device__ __forceinline__ unsigned xb_xcc_id() { return (unsigned)__builtin_amdgcn_s_getreg((3 << 11) | 20) & 0xFu; }
#define XB_SPIN(cond, bar) do { unsigned _sp = 0; while (cond) { __builtin_amdgcn_s_sleep(1); \
    if ((++_sp & 255u) == 0u) { if (xb_ld(&(bar)[XB_TMO])) break; if (_sp > XB_SPIN_CAP) { atomicAdd(&(bar)[XB_TMO], 1u); break; } } } } while (0)

struct XcdBarrier {
    int wave;
    unsigned* bar; unsigned x;
    volatile LAS unsigned* st;
};

__device__ __forceinline__ XcdBarrier xcd_barrier_post(unsigned* bar, volatile LAS unsigned* st) {
    XcdBarrier b; b.bar = bar; b.x = xb_xcc_id(); b.st = st;
    if (threadIdx.x == 0) (void)xb_add(&bar[XB_XCNT(b.x)], 1u);
    return b;
}
__device__ __forceinline__ void xcd_barrier_complete(unsigned* bar, unsigned x, unsigned& nloc, unsigned& nx) {
    const unsigned G = gridDim.x * gridDim.y * gridDim.z;
    unsigned sum, cnt, mine, sp = 0u;
    for (;;) {
        sum = 0u; cnt = 0u; mine = 0u;
#pragma unroll
        for (unsigned j = 0; j < 16; ++j) { const unsigned c = xb_ld(&bar[XB_XCNT(j)]); sum += c; cnt += (c > 0u) ? 1u : 0u; mine = (j == x) ? c : mine; }
        if (sum == G) break;
        __builtin_amdgcn_s_sleep(1);
        if ((++sp & 255u) == 0u) { if (xb_ld(&bar[XB_TMO])) break; if (sp > XB_SPIN_CAP) { atomicAdd(&bar[XB_TMO], 1u); break; } }
    }
    nloc = mine > 0u ? mine : 1u; nx = cnt > 0u ? cnt : 1u;
}

__device__ __forceinline__ void xcd_barrier(const XcdBarrier& b) {
    asm volatile("s_waitcnt vmcnt(0)" ::: "memory");
    __syncthreads();
    unsigned xbz = 0u; asm volatile("" : "+v"(xbz));
    if (b.wave == 0 && __builtin_amdgcn_mbcnt_hi(~0u, __builtin_amdgcn_mbcnt_lo(~0u, xbz)) == 0u) {
        unsigned* bar = b.bar;
        __builtin_amdgcn_s_waitcnt(0);
        unsigned nloc = b.st[0], nx = b.st[1];
        if (nloc == 0u) { xcd_barrier_complete(bar, b.x, nloc, nx); b.st[0] = nloc; b.st[1] = nx; }
        const unsigned old = xb_add(&bar[XB_XSUB(b.x)], 1u);
        const unsigned gen = old / nloc;
        if (old + 1u == (gen + 1u) * nloc) {
            __builtin_amdgcn_fence(__ATOMIC_RELEASE, "agent");
            asm volatile("s_waitcnt vmcnt(0)" ::: "memory");
            const unsigned og = xb_add(&bar[XB_TOP], 1u);
            const unsigned tg = og / nx;
            if (og + 1u == (tg + 1u) * nx) xb_add(&bar[XB_TOPGEN], 1u);
            else XB_SPIN(xb_ld(&bar[XB_TOPGEN]) == tg, bar);
            __builtin_amdgcn_fence(__ATOMIC_ACQUIRE, "agent");
            xb_add(&bar[XB_XGEN(b.x)], 1u);
            asm volatile("s_waitcnt vmcnt(0)" ::: "memory");
        } else {
            XB_SPIN(xb_ld(&bar[XB_XGEN(b.x)]) == gen, bar);
            __builtin_amdgcn_fence(__ATOMIC_ACQUIRE, "agent");
            asm volatile("s_waitcnt vmcnt(0)" ::: "memory");
        }
    }
    __syncthreads();
}

struct Args { const float* in[NIN]; float* out; unsigned char* ws; int ph_lo, ph_hi; };
enum { I_XP = 0, I_XS, I_MEM, I_SCA, I_SRET, I_SSH, I_SWKV, I_SCD, I_CMK, I_CMV, I_GMIX, I_WIN, I_CAW, I_MU, I_W0, I_W2, I_A0, I_A2, I_G2, I_KK, I_KA, I_RK, I_LNXG, I_LNXB,
       I_CDW, I_CDB, I_LNDG, I_LNDB, I_WOUT, I_GXA, I_GMEM, I_WQ, I_WK, I_WV, I_WO, I_GMLP, I_WUP, I_WDN, I_GFIN };

struct Ctx { LAS unsigned char* lds; int tid, lane, wave, G, bid; };
typedef const GAS float* gcfp;
#define CAS __attribute__((address_space(4)))
struct Ax { const CAS gcfp* kp; float* out; unsigned char* ws;
    __device__ __forceinline__ const float* in(int i) const { return (const float*)kp[i]; } };
__device__ __forceinline__ Ax mk_ax() { const CAS gcfp* kp = (const CAS gcfp*)__builtin_amdgcn_kernarg_segment_ptr(); asm volatile("" : "+s"(kp)); Ax a; a.kp = kp;
    a.out = (float*)(GAS float*)kp[NIN]; a.ws = (unsigned char*)(GAS unsigned char*)kp[NIN + 1]; return a; }
__device__ __forceinline__ Ctx mk_ctx(LAS unsigned char* lds, int wave_s) { unsigned z = 0u; asm volatile("" : "+v"(z)); int t = wave_s * 64 + (int)__builtin_amdgcn_mbcnt_hi(~0u, __builtin_amdgcn_mbcnt_lo(~0u, z)); Ctx C; C.lds = lds; C.tid = t; C.lane = t & 63; C.wave = __builtin_amdgcn_readfirstlane(t >> 6); C.G = gridDim.x; C.bid = blockIdx.x; return C; }

__device__ __forceinline__ void p0_transpose_item(const float* W, int K, int N, bf16* WT, int ldk, int row_off, LAS float* scr, int item, int lane, const float* gain) {
    const int nblk = N / 64, kb = item / nblk, nb = item - kb * nblk, k0 = 64 * kb, n0 = 64 * nb;
    const int lr = lane >> 4, lc = (lane & 15) * 4;
#pragma unroll 8
    for (int i = 0; i < 16; ++i) { const int kk = 4 * i + lr; const float g = gain ? gain[k0 + kk] : 1.0f; const f32x4 v = *(const f32x4*)(W + (size_t)(k0 + kk) * N + n0 + lc);
        LAS float* d = scr + kk * 65 + lc; d[0] = v.x * g; d[1] = v.y * g; d[2] = v.z * g; d[3] = v.w * g; }
    LDS_WAIT(); asm volatile("" ::: "memory");
    const int c = lane & 7;
#pragma unroll
    for (int j = 0; j < 8; ++j) { const int n = (lane >> 3) + 8 * j; const LAS float* s = scr + (8 * c) * 65 + n;
        v4u o; o.x = pk2(s[0 * 65], s[1 * 65]); o.y = pk2(s[2 * 65], s[3 * 65]); o.z = pk2(s[4 * 65], s[5 * 65]); o.w = pk2(s[6 * 65], s[7 * 65]);
        if (ldk > 0) *(v4u*)(WT + (size_t)(row_off + n0 + n) * ldk + k0 + 8 * c) = o;
        else *(v4u*)(WT + ((size_t)kb * (size_t)(-ldk) + row_off + n0 + n) * 64 + 8 * c) = o; }
    LDS_WAIT(); asm volatile("" ::: "memory");
}
__device__ __forceinline__ void rms_row(const float* xrow, bf16* orow, float* xcopy, int lane) {
    const f32x4* xr = (const f32x4*)xrow + lane;
    f32x4 v[8]; float s = 0.f;
#pragma unroll
    for (int j = 0; j < 8; ++j) { v[j] = xr[64 * j]; s += (v[j].x * v[j].x + v[j].y * v[j].y) + (v[j].z * v[j].z + v[j].w * v[j].w); }
    const float rs = 1.0f / sqrtf(wave_sum(s) * (1.0f / DM) + 1e-6f);
    if (xcopy) {
#pragma unroll
        for (int j = 0; j < 8; ++j) ((f32x4*)xcopy + lane)[64 * j] = v[j]; }
    unsigned long long* o8 = (unsigned long long*)orow + lane;
#pragma unroll
    for (int j = 0; j < 8; ++j) o8[64 * j] = (unsigned long long)pk2(v[j].x * rs, v[j].y * rs) | ((unsigned long long)pk2(v[j].z * rs, v[j].w * rs) << 32);
}
__device__ __forceinline__ void rms_phase(const Ctx& C, const float* X, bf16* HN) {
    const int gw = C.bid * NWAVES + C.wave, NGW = C.G * NWAVES;
    f32x4 v[8], nx[8]; int m = gw;
    if (m < MT) { const f32x4* xr = (const f32x4*)(X + (size_t)m * DM) + C.lane;
#pragma unroll
        for (int j = 0; j < 8; ++j) v[j] = xr[64 * j]; }
    for (; m < MT; m += NGW) {
        const int mn = m + NGW;
        if (mn < MT) { const f32x4* xr = (const f32x4*)(X + (size_t)mn * DM) + C.lane;
#pragma unroll
            for (int j = 0; j < 8; ++j) nx[j] = xr[64 * j]; }
        float s = 0.f;
#pragma unroll
        for (int j = 0; j < 8; ++j) s += (v[j].x * v[j].x + v[j].y * v[j].y) + (v[j].z * v[j].z + v[j].w * v[j].w);
        const float rs = 1.0f / sqrtf(wave_sum(s) * (1.0f / DM) + 1e-6f);
        unsigned long long* o8 = (unsigned long long*)(HN + (size_t)m * DM) + C.lane;
#pragma unroll
        for (int j = 0; j < 8; ++j) o8[64 * j] = (unsigned long long)pk2(v[j].x * rs, v[j].y * rs) | ((unsigned long long)pk2(v[j].z * rs, v[j].w * rs) << 32);
#pragma unroll
        for (int j = 0; j < 8; ++j) v[j] = nx[j];
    }
}
__device__ __forceinline__ void fold_split_rows(const Ctx& C, float* X, const float* S) {
    const int gw = C.bid * NWAVES + C.wave, NGW = C.G * NWAVES;
    for (int r = gw; r < NS; r += NGW) { f32x4* xr = (f32x4*)(X + (size_t)(MP + r) * DM) + C.lane; const f32x4* s0 = (const f32x4*)(S + (size_t)r * DM) + C.lane; const f32x4* s1 = (const f32x4*)(S + (size_t)(NS + r) * DM) + C.lane;
#pragma unroll
        for (int j = 0; j < 8; ++j) xr[64 * j] = xr[64 * j] + (s0[64 * j] + s1[64 * j]); }
    asm volatile("s_waitcnt vmcnt(0)" ::: "memory");
}
__device__ __forceinline__ void final_norm_phase(const Ctx& C, const float* X, const float* g, float* out) {
    const int gw = C.bid * NWAVES + C.wave, NGW = C.G * NWAVES;
    for (int m = gw; m < MT; m += NGW) {
        const f32x4* xr = (const f32x4*)(X + (size_t)m * DM) + C.lane; const f32x4* gr = (const f32x4*)g + C.lane;
        f32x4 v[8]; float s = 0.f;
#pragma unroll
        for (int j = 0; j < 8; ++j) { v[j] = xr[64 * j]; s += (v[j].x * v[j].x + v[j].y * v[j].y) + (v[j].z * v[j].z + v[j].w * v[j].w); }
        const float rs = 1.0f / sqrtf(wave_sum(s) * (1.0f / DM) + 1e-6f);
        f32x4* orow = (f32x4*)(out + (size_t)m * DM) + C.lane;
#pragma unroll
        for (int j = 0; j < 8; ++j) orow[64 * j] = v[j] * rs * gr[64 * j];
    }
}
struct TDesc { const float* W; const float* gain; bf16* WT; int K, N, ldk, row_off, item; };
__device__ __forceinline__ TDesc p0_desc(const Ax& a, int it, int G) {
    constexpr int I_IN = 32 * 100, I_SQ = 32 * 32, I_UP = 32 * 128, I_DN = 128 * 32, I_L64 = 8, I_L128 = 16;
    constexpr int PER_LAYER = I_IN + 5 * I_SQ + I_UP + I_DN + 2 * I_L64 + I_L128;
    const int l = it / PER_LAYER; int r = it - l * PER_LAYER; unsigned char* wl = a.ws + WS_WL + (size_t)l * LW_STRIDE; bf16* wkv = (bf16*)(a.ws + WS_WKV);
    TDesc d; d.row_off = 0; d.gain = nullptr;
    if (r < I_IN) { d.W = a.in(I_WIN) + (size_t)l * DM * PIN; d.K = DM; d.N = PIN; d.WT = (bf16*)(wl + LW_IN); d.ldk = -PIN; d.gain = a.in(I_GMIX) + l * DM; d.item = r; return d; } r -= I_IN;
    if (r < I_SQ) { d.W = a.in(I_WOUT) + (size_t)l * DM * DM; d.K = DM; d.N = DM; d.WT = (bf16*)(wl + LW_OUT); d.ldk = -DM; d.item = r; return d; } r -= I_SQ;
    if (r < I_SQ) { d.W = a.in(I_WQ) + (size_t)l * DM * DM; d.K = DM; d.N = DM; d.WT = (bf16*)(wl + LW_Q); d.ldk = -DM; d.gain = a.in(I_GXA) + l * DM; d.item = r; return d; } r -= I_SQ;
    if (r < I_SQ) { d.W = a.in(I_WO) + (size_t)l * DM * DM; d.K = DM; d.N = DM; d.WT = (bf16*)(wl + LW_O); d.ldk = -DM; d.item = r; return d; } r -= I_SQ;
    if (r < I_SQ) { d.W = a.in(I_WK) + (size_t)l * DM * DM; d.K = DM; d.N = DM; d.WT = wkv; d.ldk = -8192; d.row_off = l * 4096; d.gain = a.in(I_GMEM) + l * DM; d.item = r; return d; } r -= I_SQ;
    if (r < I_SQ) { d.W = a.in(I_WV) + (size_t)l * DM * DM; d.K = DM; d.N = DM; d.WT = wkv; d.ldk = -8192; d.row_off = l * 4096 + 2048; d.gain = a.in(I_GMEM) + l * DM; d.item = r; return d; } r -= I_SQ;
    const bool late = (l + 1 == DEPTH) && G == 256;
    if (r < I_UP) { d.W = a.in(I_WUP) + (size_t)l * DM * DFF; d.K = DM; d.N = DFF; d.WT = (bf16*)(wl + LW_UP); d.ldk = -DFF; d.gain = a.in(I_GMLP) + l * DM; d.item = late ? -1 : r; return d; } r -= I_UP;
    if (r < I_DN) { d.W = a.in(I_WDN) + (size_t)l * DFF * DM; d.K = DFF; d.N = DM; d.WT = (bf16*)(wl + LW_DN); d.ldk = -DM; d.item = late ? -1 : r; return d; } r -= I_DN;
    if (r < I_L64) { d.W = a.in(I_W2) + (size_t)l * 64 * 512; d.K = 64; d.N = 512; d.WT = (bf16*)(wl + LW_W2); d.ldk = 64; d.item = r; return d; } r -= I_L64;
    if (r < I_L64) { d.W = a.in(I_A2) + (size_t)l * 64 * 512; d.K = 64; d.N = 512; d.WT = (bf16*)(wl + LW_A2); d.ldk = 64; d.item = r; return d; } r -= I_L64;
    d.W = a.in(I_G2) + (size_t)l * 128 * 512; d.K = 128; d.N = 512; d.WT = (bf16*)(wl + LW_G2); d.ldk = 128; d.item = r; return d;
}
__device__ __forceinline__ void p0_load(const TDesc& d, int lane, f32x4 (&v)[16], float (&g)[16]) {
    if (d.item < 0) return;
    const int nblk = d.N / 64, kb = d.item / nblk, nb = d.item - kb * nblk, k0 = 64 * kb, n0 = 64 * nb, lr = lane >> 4, lc = (lane & 15) * 4;
#pragma unroll
    for (int i = 0; i < 16; ++i) { const int kk = 4 * i + lr; g[i] = d.gain ? d.gain[k0 + kk] : 1.0f; v[i] = __builtin_nontemporal_load((const f32x4*)(d.W + (size_t)(k0 + kk) * d.N + n0 + lc)); }
}
__device__ __forceinline__ void p0_finish(const TDesc& d, LAS float* scr, int lane, const f32x4 (&v)[16], const float (&g)[16]) {
    if (d.item < 0) return;
    const int nblk = d.N / 64, kb = d.item / nblk, nb = d.item - kb * nblk, k0 = 64 * kb, n0 = 64 * nb, lr = lane >> 4, lc = (lane & 15) * 4;
#pragma unroll
    for (int i = 0; i < 16; ++i) { const int kk = 4 * i + lr; LAS float* p = scr + kk * 65 + lc; p[0] = v[i].x * g[i]; p[1] = v[i].y * g[i]; p[2] = v[i].z * g[i]; p[3] = v[i].w * g[i]; }
    LDS_WAIT(); asm volatile("" ::: "memory");
    const int c = lane & 7;
#pragma unroll
    for (int j = 0; j < 8; ++j) { const int n = (lane >> 3) + 8 * j; const LAS float* s = scr + (8 * c) * 65 + n;
        v4u o; o.x = pk2(s[0 * 65], s[1 * 65]); o.y = pk2(s[2 * 65], s[3 * 65]); o.z = pk2(s[4 * 65], s[5 * 65]); o.w = pk2(s[6 * 65], s[7 * 65]);
        if (d.ldk > 0) *(v4u*)(d.WT + (size_t)(d.row_off + n0 + n) * d.ldk + k0 + 8 * c) = o;
        else *(v4u*)(d.WT + ((size_t)kb * (size_t)(-d.ldk) + d.row_off + n0 + n) * 64 + 8 * c) = o; }
    LDS_WAIT(); asm volatile("" ::: "memory");
}
__device__ __forceinline__ void p0_prologue(const Ctx& C, const Ax& a) {
    LAS float* scr = (LAS float*)(C.lds + C.wave * 16640);
    const int gw = C.bid * NWAVES + C.wave, NGW = C.G * NWAVES;
    constexpr int I_IN = 32 * 100, I_SQ = 32 * 32, I_UP = 32 * 128, I_DN = 128 * 32, I_L64 = 8, I_L128 = 16;
    constexpr int PER_LAYER = I_IN + 5 * I_SQ + I_UP + I_DN + 2 * I_L64 + I_L128;
    TDesc cur = p0_desc(a, gw, C.G), nxt; f32x4 va[16], vb[16]; float ga[16], gb[16];
    const int NITEMS = DEPTH * PER_LAYER;
    if (gw < NITEMS) p0_load(cur, C.lane, va, ga);
    for (int it = gw; it < NITEMS; it += 2 * NGW) {
        const int it1 = it + NGW, it2 = it + 2 * NGW;
        if (it1 < NITEMS) { nxt = p0_desc(a, it1, C.G); p0_load(nxt, C.lane, vb, gb); }
        p0_finish(cur, scr, C.lane, va, ga);
        if (it1 < NITEMS) { if (it2 < NITEMS) { cur = p0_desc(a, it2, C.G); p0_load(cur, C.lane, va, ga); }
            p0_finish(nxt, scr, C.lane, vb, gb); }
    }
    { float* cs = (float*)(a.ws + WS_ROPE); const int gt = C.bid * (NWAVES * 64) + C.tid, NT = C.G * NWAVES * 64;
      for (int idx = gt; idx < 2049 * 64; idx += NT) { const int p = idx >> 6, i = idx & 63; const double pos = (p == 2048) ? 16384.0 : (double)p;
          const double inv = exp(-(double)i * (9.210340371976184 / 64.0)); double r = pos * inv; r -= 6.283185307179586 * rint(r * 0.15915494309189535);
          cs[2 * idx] = (float)cos(r); cs[2 * idx + 1] = (float)sin(r); } }
    float* XF = (float*)(a.ws + WS_XF); bf16* HN = (bf16*)(a.ws + WS_HN); bf16* MN = (bf16*)(a.ws + WS_MN);
    for (int m = gw; m < MT; m += NGW) { const float* src = (m < MP) ? a.in(I_XP) + (size_t)m * DM : a.in(I_XS) + (size_t)(m - MP) * DM; rms_row(src, HN + (size_t)m * DM, nullptr, C.lane); }
    for (int m = gw; m < MMEM; m += NGW) rms_row(a.in(I_MEM) + (size_t)m * DM, MN + (size_t)m * DM, nullptr, C.lane);
}

__device__ __forceinline__ void late_convert(const Ctx& C, const Ax& a, int l, int rank, int nrank) {
    LAS float* scr = (LAS float*)(C.lds + C.wave * 16640);
    unsigned char* wl = a.ws + WS_WL + (size_t)l * LW_STRIDE;
    constexpr int I_UP = 32 * 128, I_DN = 128 * 32;
    for (int it = rank * NWAVES + C.wave; it < I_UP + I_DN; it += nrank * NWAVES) {
        if (it < I_UP) p0_transpose_item(a.in(I_WUP) + (size_t)l * DM * DFF, DM, DFF, (bf16*)(wl + LW_UP), -DFF, 0, scr, it, C.lane, a.in(I_GMLP) + l * DM);
        else p0_transpose_item(a.in(I_WDN) + (size_t)l * DFF * DM, DFF, DM, (bf16*)(wl + LW_DN), -DM, 0, scr, it - I_UP, C.lane, nullptr); }
}
__device__ __forceinline__ void ad_prompt_item(const Ctx& C, const Ax& a, int l, int item) {
    const bf16* P = (const bf16*)(a.ws + WS_P); bf16* YC = (bf16*)(a.ws + WS_YC);
    const int b = item >> 6, t0 = (item & 63) * 32; const size_t rbase = (size_t)b * SEQ;
    LAS float* UD = (LAS float*)C.lds;
#pragma unroll 4
    for (int it = C.tid; it < 62 * 64; it += NWAVES * 64) { const int r = it >> 6, cc = it & 63, t = t0 - 30 + r;
        float u[8];
        if (t >= 0) { const bf16* pr = P + (rbase + t) * PIN + PD_ + cc * 8; float d1[8], d2[8]; unpack8(*(const v4u*)pr, d1); unpack8(*(const v4u*)(pr + 512), d2);
#pragma unroll
            for (int j = 0; j < 8; ++j) u[j] = d1[j] * sigm(d2[j]); }
        else {
#pragma unroll
            for (int j = 0; j < 8; ++j) u[j] = 0.f; }
        *(LAS f32x4*)(UD + r * 512 + cc * 8) = (f32x4){u[0], u[1], u[2], u[3]}; *(LAS f32x4*)(UD + r * 512 + cc * 8 + 4) = (f32x4){u[4], u[5], u[6], u[7]}; }
    { const float* cw = a.in(I_CAW) + (size_t)l * 3 * 512;
#pragma unroll 2
      for (int it = C.tid; it < 32 * 64; it += NWAVES * 64) { const int r = it >> 6, cc = it & 63, t = t0 + r; const bf16* pr = P + (rbase + t) * PIN + cc * 8;
        float ab[8], u0[8], u1[8], u2[8], x[8], y[8];
        unpack8(*(const v4u*)pr, ab); unpack8(*(const v4u*)(pr + 512), x); unpack8(*(const v4u*)(pr + 1024), y);
#pragma unroll
        for (int j = 0; j < 8; ++j) u2[j] = x[j] * y[j];
        if (t >= 1) { unpack8(*(const v4u*)(pr - PIN + 512), x); unpack8(*(const v4u*)(pr - PIN + 1024), y);
#pragma unroll
            for (int j = 0; j < 8; ++j) u1[j] = x[j] * y[j]; }
        else {
#pragma unroll
            for (int j = 0; j < 8; ++j) u1[j] = 0.f; }
        if (t >= 2) { unpack8(*(const v4u*)(pr - 2 * PIN + 512), x); unpack8(*(const v4u*)(pr - 2 * PIN + 1024), y);
#pragma unroll
            for (int j = 0; j < 8; ++j) u0[j] = x[j] * y[j]; }
        else {
#pragma unroll
            for (int j = 0; j < 8; ++j) u0[j] = 0.f; }
        float o[8];
#pragma unroll
        for (int j = 0; j < 8; ++j) { const int c = cc * 8 + j; o[j] = ab[j] * (cw[c] * u0[j] + cw[512 + c] * u1[j] + cw[1024 + c] * u2[j]); }
        *(v4u*)(YC + (rbase + t) * DM + cc * 8) = pack8(o);
        if (t >= SEQ - 2) { float* st = a.out + O_CAP + (((size_t)l * NB + b) * 2 + (t - (SEQ - 2))) * 512 + cc * 8; *(f32x4*)st = (f32x4){u2[0], u2[1], u2[2], u2[3]}; *(f32x4*)(st + 4) = (f32x4){u2[4], u2[5], u2[6], u2[7]}; } } }
    __syncthreads();
    const int c = C.tid;
    if (t0 == SEQ - 32) { float* st = a.out + O_CDP + ((size_t)l * NB + b) * 30 * 512 + c;
        for (int j = 0; j < 30; ++j) st[(size_t)j * 512] = UD[(32 + j) * 512 + c]; }
    float cv[32];
    { const float* cw = a.in(I_CDW) + (size_t)l * 31 * 512 + c; const float bias = a.in(I_CDB)[l * 512 + c];
#pragma unroll
      for (int hf = 0; hf < 2; ++hf) {
        float u[46];
#pragma unroll
        for (int r = 0; r < 46; ++r) u[r] = UD[(hf * 16 + r) * 512 + c];
#pragma unroll
        for (int t = 0; t < 16; ++t) cv[hf * 16 + t] = bias;
#pragma unroll
        for (int j = 0; j < 31; ++j) { const float w = cw[(size_t)j * 512];
#pragma unroll
            for (int t = 0; t < 16; ++t) cv[hf * 16 + t] += w * u[t + j]; }
        asm volatile("" ::: "memory"); } }
    __syncthreads();
#pragma unroll
    for (int t = 0; t < 32; ++t) UD[t * 512 + c] = cv[t];
    __syncthreads();
    { const float* lg = a.in(I_LNDG) + l * 512 + C.lane * 8; const float* lb = a.in(I_LNDB) + l * 512 + C.lane * 8;
      const f32x4 g0 = *(const f32x4*)lg, g1 = *(const f32x4*)(lg + 4), b0 = *(const f32x4*)lb, b1 = *(const f32x4*)(lb + 4);
#pragma unroll
      for (int q = 0; q < 4; ++q) { const int t = C.wave * 4 + q; const f32x4 x0 = *(LAS f32x4*)(UD + t * 512 + C.lane * 8), x1 = *(LAS f32x4*)(UD + t * 512 + C.lane * 8 + 4);
        const float mu = wave_sum((x0.x + x0.y) + (x0.z + x0.w) + (x1.x + x1.y) + (x1.z + x1.w)) * (1.0f / 512.0f);
        const f32x4 d0 = x0 - mu, d1 = x1 - mu;
        const float var = wave_sum((d0.x * d0.x + d0.y * d0.y) + (d0.z * d0.z + d0.w * d0.w) + (d1.x * d1.x + d1.y * d1.y) + (d1.z * d1.z + d1.w * d1.w)) * (1.0f / 512.0f);
        const float rstd = 1.0f / sqrtf(var + 1e-6f);
        const f32x4 y0 = d0 * rstd * g0 + b0, y1 = d1 * rstd * g1 + b1; float o[8];
        o[0] = y0.x * sigm(y0.x); o[1] = y0.y * sigm(y0.y); o[2] = y0.z * sigm(y0.z); o[3] = y0.w * sigm(y0.w);
        o[4] = y1.x * sigm(y1.x); o[5] = y1.y * sigm(y1.y); o[6] = y1.z * sigm(y1.z); o[7] = y1.w * sigm(y1.w);
        *(v4u*)(YC + (rbase + t0 + t) * DM + 1536 + C.lane * 8) = pack8(o); } }
    __syncthreads();
}
__device__ __forceinline__ void ad_sample_item(const Ctx& C, const Ax& a, int l, int n) {
    const bf16* P = (const bf16*)(a.ws + WS_P); bf16* YC = (bf16*)(a.ws + WS_YC);
    const int c = C.tid; const bf16* pr = P + (size_t)(MP + n) * PIN;
    LAS float* red = (LAS float*)C.lds;
    { const float* st = a.in(I_SCA) + (((size_t)l * NS + n) * 2) * 512 + c; const float s0 = st[0], s1 = st[512];
      const float ua = bf1(pr[512 + c]) * bf1(pr[1024 + c]); const float* cw = a.in(I_CAW) + (size_t)l * 3 * 512 + c;
      const float y = bf1(pr[c]) * (cw[0] * s0 + cw[512] * s1 + cw[1024] * ua);
      YC[(size_t)(MP + n) * DM + c] = (bf16)(pk2(y, 0.f) & 0xffffu);
      float* o = a.out + O_CAS + (((size_t)l * NS + n) * 2) * 512 + c; o[0] = s1; o[512] = ua; }
    const float* st = a.in(I_SCD) + (((size_t)l * NS + n) * 30) * 512 + c; const float* cw = a.in(I_CDW) + (size_t)l * 31 * 512 + c;
    const float ud = bf1(pr[PD_ + c]) * sigm(bf1(pr[PD_ + 512 + c]));
    float cv = a.in(I_CDB)[l * 512 + c] + cw[30 * 512] * ud;
    float* os = a.out + O_CDS + (((size_t)l * NS + n) * 30) * 512 + c;
#pragma unroll 6
    for (int j = 0; j < 30; ++j) { const float s = st[(size_t)j * 512]; cv += cw[(size_t)j * 512] * s; if (j > 0) os[(size_t)(j - 1) * 512] = s; }
    os[29 * 512] = ud;
    float s = wave_sum(cv); if (C.lane == 0) red[C.wave] = s; __syncthreads();
    float mu = 0.f;
#pragma unroll
    for (int w = 0; w < 8; ++w) mu += red[w];
    mu *= (1.0f / 512.0f); const float d = cv - mu;
    s = wave_sum(d * d); if (C.lane == 0) red[8 + C.wave] = s; __syncthreads();
    float var = 0.f;
#pragma unroll
    for (int w = 0; w < 8; ++w) var += red[8 + w];
    const float rstd = 1.0f / sqrtf(var * (1.0f / 512.0f) + 1e-6f);
    const float y = d * rstd * a.in(I_LNDG)[l * 512 + c] + a.in(I_LNDB)[l * 512 + c];
    YC[(size_t)(MP + n) * DM + 1536 + c] = (bf16)(pk2(y * sigm(y), 0.f) & 0xffffu);
    __syncthreads();
}

__device__ __forceinline__ void shift8(const bf16* cur, const bf16* prevb, const float* prevf, const float* mu, float (&xs)[8]) {
    float pc[8], pv[8]; unpack8(*(const v4u*)cur, pc);
    if (prevb) unpack8(*(const v4u*)prevb, pv);
    else if (prevf) { const f32x4 p0 = *(const f32x4*)prevf, p1 = *(const f32x4*)(prevf + 4); pv[0] = p0.x; pv[1] = p0.y; pv[2] = p0.z; pv[3] = p0.w; pv[4] = p1.x; pv[5] = p1.y; pv[6] = p1.z; pv[7] = p1.w; }
    else {
#pragma unroll
        for (int j = 0; j < 8; ++j) pv[j] = 0.f; }
    const f32x4 m0 = *(const f32x4*)mu, m1 = *(const f32x4*)(mu + 4); const float m[8] = {m0.x, m0.y, m0.z, m0.w, m1.x, m1.y, m1.z, m1.w};
#pragma unroll
    for (int j = 0; j < 8; ++j) xs[j] = pc[j] + (pv[j] - pc[j]) * m[j];
}
__device__ __forceinline__ void shift4(const bf16* cur, const bf16* prevb, const float* prevf, const float* mu, float (&xs)[4]) {
    float pc[4], pv[4]; unpack4(*(const v2u*)cur, pc);
    if (prevb) unpack4(*(const v2u*)prevb, pv);
    else if (prevf) { const f32x4 p0 = *(const f32x4*)prevf; pv[0] = p0.x; pv[1] = p0.y; pv[2] = p0.z; pv[3] = p0.w; }
    else { pv[0] = pv[1] = pv[2] = pv[3] = 0.f; }
    const f32x4 m0 = *(const f32x4*)mu;
    xs[0] = pc[0] + (pv[0] - pc[0]) * m0.x; xs[1] = pc[1] + (pv[1] - pc[1]) * m0.y; xs[2] = pc[2] + (pv[2] - pc[2]) * m0.z; xs[3] = pc[3] + (pv[3] - pc[3]) * m0.w;
}
constexpr int PTS = 1544;
__device__ __forceinline__ void shift4_lds(const LAS bf16* cur, const float* mu, float (&xs)[4]) {
    float pc[4], pv[4]; unpack4(*(const LAS v2u*)cur, pc); unpack4(*(const LAS v2u*)(cur - PTS), pv);
    const f32x4 m0 = *(const f32x4*)mu;
    xs[0] = pc[0] + (pv[0] - pc[0]) * m0.x; xs[1] = pc[1] + (pv[1] - pc[1]) * m0.y; xs[2] = pc[2] + (pv[2] - pc[2]) * m0.z; xs[3] = pc[3] + (pv[3] - pc[3]) * m0.w;
}
constexpr int RWB = 896, RW_KK = 256, RW_KB = 384, RW_K = 512, RW_R = 640, RW_V = 768;
__device__ __forceinline__ void rw_st4(unsigned char* rec, int off, int cl, const f32x4 v) { v2u w; w.x = pk2(v[0], v[1]); w.y = pk2(v[2], v[3]); *(v2u*)(rec + off + cl * 2) = w; }
__device__ __forceinline__ f32x4 rw_ld4(const unsigned char* rec, int off, int cl) { float f[4]; unpack4(*(const v2u*)(rec + off + cl * 2), f); return (f32x4){f[0], f[1], f[2], f[3]}; }
#ifndef DUP_SUB
#define DUP_SUB 0u
#endif
#define PREP_REP(k) for (int prep_rep_ = 0; prep_rep_ < 1 + (int)((DUP_SUB >> (k)) & 1u); ++prep_rep_)
__device__ __forceinline__ void rwkv_prep_item(const Ctx& C, const Ax& a, int l, int item) {
    const bf16* P = (const bf16*)(a.ws + WS_P); float* RW = (float*)(a.ws + WS_RW); float* GATE = (float*)(a.ws + WS_GATE);
    const bool smp = item >= 256; const int row0 = smp ? MP + (item - 256) * 32 : (item >> 6) * SEQ + (item & 63) * 32; const int t0 = smp ? 0 : (item & 63) * 32;
    const float* mu = a.in(I_MU) + (size_t)l * SHW; const float* sst = a.in(I_SSH) + (size_t)l * NS * SHW;
    LAS bf16* AW = (LAS bf16*)C.lds; LAS bf16* AA = AW + 32 * 72; LAS bf16* AG = AA + 32 * 72; LAS bf16* PT = AG + 32 * 136;
    for (int it = C.tid; it < 32 * 32; it += NWAVES * 64) { const int r = it >> 5, cc = it & 31, col = 1536 + cc * 8, row = row0 + r; const bf16* cur = P + (size_t)row * PIN + PC_ + col;
        float xs[8];
        if (smp) shift8(cur, nullptr, sst + (size_t)(row - MP) * SHW + col, mu + col, xs);
        else shift8(cur, (t0 + r > 0) ? cur - PIN : nullptr, nullptr, mu + col, xs);
        if (cc < 8) {
#pragma unroll
            for (int j = 0; j < 8; ++j) xs[j] = tanhf(xs[j]);
            *(LAS v4u*)(AW + r * 72 + cc * 8) = pack8(xs); }
        else if (cc < 16) *(LAS v4u*)(AA + r * 72 + (cc - 8) * 8) = pack8(xs);
        else {
#pragma unroll
            for (int j = 0; j < 8; ++j) xs[j] = sigm(xs[j]);
            *(LAS v4u*)(AG + r * 136 + (cc - 16) * 8) = pack8(xs); } }
    if (!smp) { for (int it = C.tid; it < 33 * 192; it += NWAVES * 64) { const int r = it / 192, cc = it - r * 192; v4u v = (v4u){0u, 0u, 0u, 0u};
            if (t0 + r > 0) v = *(const v4u*)(P + (size_t)(row0 + r - 1) * PIN + PC_ + cc * 8);
            *(LAS v4u*)(PT + r * PTS + cc * 8) = v; } }
    if (smp) { float* o = a.out + O_SHS + ((size_t)l * NS + (row0 - MP)) * SHW;
        for (int it = C.tid; it < 32 * 224; it += NWAVES * 64) { const int r = it / 224, cc = it % 224; float f[8]; unpack8(*(const v4u*)(P + (size_t)(row0 + r) * PIN + PC_ + cc * 8), f);
            float* op = o + (size_t)r * SHW + cc * 8; *(f32x4*)op = (f32x4){f[0], f[1], f[2], f[3]}; *(f32x4*)(op + 4) = (f32x4){f[4], f[5], f[6], f[7]}; } }
    else if (t0 == SEQ - 32) { float* o = a.out + O_SHP + ((size_t)l * NB + (item >> 6)) * SHW;
        for (int cc = C.tid; cc < 224; cc += NWAVES * 64) { float f[8]; unpack8(*(const v4u*)(P + (size_t)(row0 + 31) * PIN + PC_ + cc * 8), f);
            *(f32x4*)(o + cc * 8) = (f32x4){f[0], f[1], f[2], f[3]}; *(f32x4*)(o + cc * 8 + 4) = (f32x4){f[4], f[5], f[6], f[7]}; } }
    __syncthreads();
    const int h = C.wave, fr = C.lane & 15, fq = C.lane >> 4;
    const unsigned char* wl = a.ws + WS_WL + (size_t)l * LW_STRIDE;
    const bf16* W2t = (const bf16*)(wl + LW_W2); const bf16* A2t = (const bf16*)(wl + LW_A2); const bf16* G2t = (const bf16*)(wl + LW_G2);
    PREP_REP(23) { constexpr int tp = 0;
        f32x4 acc[4][2];
#pragma unroll
        for (int ct = 0; ct < 4; ++ct)
#pragma unroll
            for (int t2 = 0; t2 < 2; ++t2) acc[ct][t2] = zero4();
#pragma unroll
        for (int ks = 0; ks < 2; ++ks) { bf16x8 af[2], wf[4];
#pragma unroll
            for (int t2 = 0; t2 < 2; ++t2) af[t2] = *(const LAS bf16x8*)(AA + (tp * 32 + t2 * 16 + fr) * 72 + ks * 32 + fq * 8);
#pragma unroll
            for (int ct = 0; ct < 4; ++ct) wf[ct] = *(const bf16x8*)(A2t + (size_t)(h * 64 + ct * 16 + fr) * 64 + ks * 32 + fq * 8);
#pragma unroll
            for (int ct = 0; ct < 4; ++ct)
#pragma unroll
                for (int t2 = 0; t2 < 2; ++t2) acc[ct][t2] = __builtin_amdgcn_mfma_f32_16x16x32_bf16(wf[ct], af[t2], acc[ct][t2], 0, 0, 0); }
        const float* a0 = a.in(I_A0) + l * 512; const float* kkw = a.in(I_KK) + l * 512; const float* kaw = a.in(I_KA) + l * 512;
#pragma unroll
        for (int t2 = 0; t2 < 2; ++t2) { const int r = tp * 32 + t2 * 16 + fr, row = row0 + r; const bf16* prow = P + (size_t)row * PIN + PC_;
            const float* pf = smp ? sst + (size_t)(row - MP) * SHW : nullptr;
            float kkr[4][4], av[4][4], kc[4][4]; float ss = 0.f;
#pragma unroll
            for (int ct = 0; ct < 4; ++ct) { const int ch = h * 64 + ct * 16 + fq * 4; const f32x4 a0v = *(const f32x4*)(a0 + ch), kkv = *(const f32x4*)(kkw + ch);
                float xs[4]; if (smp) shift4(prow + 512 + ch, nullptr, pf + 512 + ch, mu + 512 + ch, xs); else shift4_lds(PT + (r + 1) * PTS + 512 + ch, mu + 512 + ch, xs);
#pragma unroll
                for (int j = 0; j < 4; ++j) { av[ct][j] = sigm(a0v[j] + acc[ct][t2][j]); kc[ct][j] = xs[j]; kkr[ct][j] = xs[j] * kkv[j]; ss += kkr[ct][j] * kkr[ct][j]; } }
            ss += __shfl_xor(ss, 16); ss += __shfl_xor(ss, 32);
            const float inv = 1.0f / fmaxf(sqrtf(ss), 1e-12f);
            unsigned char* rw = (unsigned char*)RW + ((size_t)row * 8 + h) * RWB;
#pragma unroll
            for (int ct = 0; ct < 4; ++ct) { const int ch = h * 64 + ct * 16 + fq * 4, cl = ct * 16 + fq * 4; const f32x4 kav = *(const f32x4*)(kaw + ch);
                f32x4 kk, kb, k4;
#pragma unroll
                for (int j = 0; j < 4; ++j) { kk[j] = kkr[ct][j] * inv; kb[j] = kk[j] * av[ct][j]; k4[j] = kc[ct][j] * (1.0f + (av[ct][j] - 1.0f) * kav[j]); }
                rw_st4(rw, RW_KK, cl, kk); rw_st4(rw, RW_KB, cl, kb); rw_st4(rw, RW_K, cl, k4);
                float xr[4], xv[4];
                if (smp) { shift4(prow + ch, nullptr, pf + ch, mu + ch, xr); shift4(prow + 1024 + ch, nullptr, pf + 1024 + ch, mu + 1024 + ch, xv); }
                else { shift4_lds(PT + (r + 1) * PTS + ch, mu + ch, xr); shift4_lds(PT + (r + 1) * PTS + 1024 + ch, mu + 1024 + ch, xv); }
                rw_st4(rw, RW_R, cl, (f32x4){xr[0], xr[1], xr[2], xr[3]}); rw_st4(rw, RW_V, cl, (f32x4){xv[0], xv[1], xv[2], xv[3]}); } }
    }
    PREP_REP(24) { constexpr int tp = 0;
        f32x4 acc[4][2];
#pragma unroll
        for (int ct = 0; ct < 4; ++ct)
#pragma unroll
            for (int t2 = 0; t2 < 2; ++t2) acc[ct][t2] = zero4();
#pragma unroll
        for (int ks = 0; ks < 2; ++ks) { bf16x8 af[2], wf[4];
#pragma unroll
            for (int t2 = 0; t2 < 2; ++t2) af[t2] = *(const LAS bf16x8*)(AW + (tp * 32 + t2 * 16 + fr) * 72 + ks * 32 + fq * 8);
#pragma unroll
            for (int ct = 0; ct < 4; ++ct) wf[ct] = *(const bf16x8*)(W2t + (size_t)(h * 64 + ct * 16 + fr) * 64 + ks * 32 + fq * 8);
#pragma unroll
            for (int ct = 0; ct < 4; ++ct)
#pragma unroll
                for (int t2 = 0; t2 < 2; ++t2) acc[ct][t2] = __builtin_amdgcn_mfma_f32_16x16x32_bf16(wf[ct], af[t2], acc[ct][t2], 0, 0, 0); }
        const float* w0 = a.in(I_W0) + l * 512;
#pragma unroll
        for (int t2 = 0; t2 < 2; ++t2) { const int row = row0 + tp * 32 + t2 * 16 + fr; float* rw = (float*)((unsigned char*)RW + ((size_t)row * 8 + h) * RWB);
#pragma unroll
            for (int ct = 0; ct < 4; ++ct) { const int ch = h * 64 + ct * 16 + fq * 4, cl = ct * 16 + fq * 4; const f32x4 w0v = *(const f32x4*)(w0 + ch); f32x4 d;
#pragma unroll
                for (int j = 0; j < 4; ++j) { const float z = -(w0v[j] + acc[ct][t2][j]); const float sp = fmaxf(z, 0.f) + __logf(1.0f + __expf(-fabsf(z))); const float w = -sp - 0.5f; d[j] = -__expf(w); }
                *(f32x4*)(rw + cl) = d; } }
    }
    PREP_REP(25) { constexpr int tp = 0;
        f32x4 acc[4][2];
#pragma unroll
        for (int ct = 0; ct < 4; ++ct)
#pragma unroll
            for (int t2 = 0; t2 < 2; ++t2) acc[ct][t2] = zero4();
#pragma unroll
        for (int ks = 0; ks < 4; ++ks) { bf16x8 af[2], wf[4];
#pragma unroll
            for (int t2 = 0; t2 < 2; ++t2) af[t2] = *(const LAS bf16x8*)(AG + (tp * 32 + t2 * 16 + fr) * 136 + ks * 32 + fq * 8);
#pragma unroll
            for (int ct = 0; ct < 4; ++ct) wf[ct] = *(const bf16x8*)(G2t + (size_t)(h * 64 + ct * 16 + fr) * 128 + ks * 32 + fq * 8);
#pragma unroll
            for (int ct = 0; ct < 4; ++ct)
#pragma unroll
                for (int t2 = 0; t2 < 2; ++t2) acc[ct][t2] = __builtin_amdgcn_mfma_f32_16x16x32_bf16(wf[ct], af[t2], acc[ct][t2], 0, 0, 0); }
#pragma unroll
        for (int t2 = 0; t2 < 2; ++t2) { const int row = row0 + tp * 32 + t2 * 16 + fr;
#pragma unroll
            for (int ct = 0; ct < 4; ++ct) *(f32x4*)(GATE + (size_t)row * 512 + h * 64 + ct * 16 + fq * 4) = acc[ct][t2]; }
    }
    __syncthreads();
}

#define PACK8(arr, o) ((v4u){pk2((arr)[(o)], (arr)[(o) + 1]), pk2((arr)[(o) + 2], (arr)[(o) + 3]), pk2((arr)[(o) + 4], (arr)[(o) + 5]), pk2((arr)[(o) + 6], (arr)[(o) + 7])})
constexpr int WK_LDS = 18432, WK_SHR = 6912, WK_PRV = 3072;
__device__ __forceinline__ f32x4 mfma16(bf16x4 a, bf16x4 b, f32x4 c) { return __builtin_amdgcn_mfma_f32_16x16x16bf16_1k(a, b, c, 0, 0, 0); }
__device__ __forceinline__ bf16 bfr1(float x) { return (bf16)(pk2(x, 0.f) & 0xffffu); }
__device__ __forceinline__ void wkv_chunk_witem(const Ctx& C, const Ax& a, int ci) {
    const float* RW = (const float*)(a.ws + WS_RW);
    unsigned char* CK = a.ws + WS_CK + (size_t)ci * WK_SHR; unsigned char* CP = a.ws + WS_CP + (size_t)ci * 4 * WK_PRV;
    const int bh = ci >> 7, c = ci & 127, b = bh >> 3, h = bh & 7, lane = C.lane, fr = lane & 15, fq = lane >> 4;
    LAS unsigned char* Lb = C.lds + C.wave * WK_LDS;
    LAS bf16* TA = (LAS bf16*)Lb; LAS bf16* TB = TA + 16 * 72; LAS bf16* TK = TB + 16 * 72; LAS bf16* TR = TK + 16 * 72; LAS bf16* VT = TR + 16 * 72;
    LAS float* M1 = (LAS float*)(Lb + 12288); LAS float* M2 = M1 + 320; LAS float* N1 = M2 + 320; LAS float* N2 = N1 + 320;
    LAS bf16* TG = TA; LAS bf16* PST = TK;
    const unsigned char* rw = (const unsigned char*)RW + (((size_t)b * SEQ + c * 16) * 8 + h) * RWB;
#define RWF(t) (*(const float*)(rw + (size_t)(t) * (8 * RWB) + lane * 4))
#define RWH(t, off) bf1(*(const bf16*)(rw + (size_t)(t) * (8 * RWB) + (off) + lane * 2))
    float lam[16]; { float run = 0.f;
#pragma unroll
      for (int t = 0; t < 16; ++t) { run += RWF(t); lam[t] = run; } }
    const float lamT = lam[15];
    ((float*)CK)[lane] = __expf(lamT);
    float Bp[16], Kp[16], al[16], ro[16];
    bf16* ATg = (bf16*)(CK + 256); bf16* OMg = (bf16*)(CK + 256 + 2304);
    float wkk[4], wbb[4], wkx[4], wrr[4], wvv[4];
#pragma unroll
    for (int t = 0; t < 4; ++t) { wkk[t] = RWH(t, RW_KK); wbb[t] = RWH(t, RW_KB); wkx[t] = RWH(t, RW_K); wrr[t] = RWH(t, RW_R); wvv[t] = RWH(t, RW_V); }
#pragma unroll
    for (int t = 0; t < 16; ++t) { const float kk = wkk[t & 3], bb = wbb[t & 3], kx = wkx[t & 3], rr = wrr[t & 3], vv = wvv[t & 3];
        if (t + 4 < 16) { wkk[t & 3] = RWH(t + 4, RW_KK); wbb[t & 3] = RWH(t + 4, RW_KB); wkx[t & 3] = RWH(t + 4, RW_K); wrr[t & 3] = RWH(t + 4, RW_R); wvv[t & 3] = RWH(t + 4, RW_V); }
        const float ein = __expf(-lam[t]), eprev = (t ? __expf(lam[t - 1]) : 1.0f), ecur = __expf(lam[t]), erest = __expf(lamT - lam[t]);
        al[t] = kk * eprev; ro[t] = rr * ecur; Bp[t] = bb * erest; Kp[t] = kx * erest;
        const bf16 ab = bfr1(al[t]);
        TA[t * 72 + lane] = ab; TB[t * 72 + lane] = bfr1(bb * ein); TK[t * 72 + lane] = bfr1(kx * ein); TR[t * 72 + lane] = bfr1(ro[t]); VT[lane * 24 + t] = bfr1(vv);
        ATg[t * 72 + lane] = ab;
        asm volatile("" ::: "memory"); __builtin_amdgcn_sched_barrier(0); }
    LDS_WAIT(); asm volatile("" ::: "memory");
    { f32x4 g1 = zero4(), g2 = zero4(), n1 = zero4(), n2 = zero4();
#pragma unroll
      for (int ks = 0; ks < 2; ++ks) { const int o = fr * 72 + ks * 32 + fq * 8;
        const bf16x8 bf_ = *(const LAS bf16x8*)(TB + o), kf_ = *(const LAS bf16x8*)(TK + o), af_ = *(const LAS bf16x8*)(TA + o), rf_ = *(const LAS bf16x8*)(TR + o);
        g1 = __builtin_amdgcn_mfma_f32_16x16x32_bf16(bf_, af_, g1, 0, 0, 0); g2 = __builtin_amdgcn_mfma_f32_16x16x32_bf16(kf_, af_, g2, 0, 0, 0);
        n1 = __builtin_amdgcn_mfma_f32_16x16x32_bf16(bf_, rf_, n1, 0, 0, 0); n2 = __builtin_amdgcn_mfma_f32_16x16x32_bf16(kf_, rf_, n2, 0, 0, 0); }
#pragma unroll
      for (int r = 0; r < 4; ++r) { const int s_ = 4 * fq + r, o = s_ * 20 + fr;
        M1[o] = (s_ < fr) ? g1[r] : 0.f; M2[o] = (s_ < fr) ? g2[r] : 0.f; N1[o] = (s_ <= fr) ? n1[r] : 0.f; N2[o] = (s_ <= fr) ? n2[r] : 0.f; } }
    LDS_WAIT(); asm volatile("" ::: "memory");
    __builtin_amdgcn_sched_barrier(0);
#pragma unroll
    for (int s_ = 14; s_ >= 0; --s_) { float m[16];
#pragma unroll
        for (int q = 0; q < 4; ++q) { const f32x4 v = *(const LAS f32x4*)(M1 + s_ * 20 + 4 * q); m[4 * q] = v.x; m[4 * q + 1] = v.y; m[4 * q + 2] = v.z; m[4 * q + 3] = v.w; }
        float acc = Bp[s_];
#pragma unroll
        for (int t = s_ + 1; t < 16; ++t) acc -= m[t] * Bp[t];
        asm volatile("" : "+v"(acc) :: "memory"); Bp[s_] = acc; __builtin_amdgcn_sched_barrier(0); }
#pragma unroll
    for (int s_ = 0; s_ < 15; ++s_) { float m[16];
#pragma unroll
        for (int q = 0; q < 4; ++q) { const f32x4 v = *(const LAS f32x4*)(M2 + s_ * 20 + 4 * q); m[4 * q] = v.x; m[4 * q + 1] = v.y; m[4 * q + 2] = v.z; m[4 * q + 3] = v.w; }
        float acc = Kp[s_];
#pragma unroll
        for (int t = s_ + 1; t < 16; ++t) acc -= m[t] * Bp[t];
        asm volatile("" : "+v"(acc) :: "memory"); Kp[s_] = acc; __builtin_amdgcn_sched_barrier(0); }
    __builtin_amdgcn_sched_barrier(0);
    { float ng[16];
#pragma unroll
      for (int t = 0; t < 16; ++t) ng[t] = -Bp[t];
      *(v4u*)(CK + 256 + 4608 + lane * 32) = PACK8(ng, 0); *(v4u*)(CK + 256 + 4608 + lane * 32 + 16) = PACK8(ng, 8); }
    *(LAS v4u*)(TG + lane * 24) = PACK8(Kp, 0); *(LAS v4u*)(TG + lane * 24 + 8) = PACK8(Kp, 8);
    __builtin_amdgcn_sched_barrier(0);
    { float hh[16], ps[16];
#pragma unroll
      for (int s_ = 0; s_ < 16; ++s_) { hh[s_] = N1[s_ * 20 + fr]; ps[s_] = N2[s_ * 20 + fr]; }
#pragma unroll
      for (int s_ = 14; s_ >= 0; --s_) { float m[16];
#pragma unroll
        for (int q = 0; q < 4; ++q) { const f32x4 v = *(const LAS f32x4*)(M1 + s_ * 20 + 4 * q); m[4 * q] = v.x; m[4 * q + 1] = v.y; m[4 * q + 2] = v.z; m[4 * q + 3] = v.w; }
        float acc = hh[s_];
#pragma unroll
        for (int u = s_ + 1; u < 16; ++u) acc -= m[u] * hh[u];
        asm volatile("" : "+v"(acc) :: "memory"); hh[s_] = acc; __builtin_amdgcn_sched_barrier(0); }
#pragma unroll
      for (int s_ = 0; s_ < 15; ++s_) { float m[16];
#pragma unroll
        for (int q = 0; q < 4; ++q) { const f32x4 v = *(const LAS f32x4*)(M2 + s_ * 20 + 4 * q); m[4 * q] = v.x; m[4 * q + 1] = v.y; m[4 * q + 2] = v.z; m[4 * q + 3] = v.w; }
        float acc = ps[s_];
#pragma unroll
        for (int u = s_ + 1; u < 16; ++u) acc -= m[u] * hh[u];
        asm volatile("" : "+v"(acc) :: "memory"); ps[s_] = acc; __builtin_amdgcn_sched_barrier(0); }
      LDS_WAIT(); asm volatile("" ::: "memory");
#pragma unroll
      for (int s_ = 0; s_ < 16; ++s_) N1[s_ * 20 + fr] = hh[s_];
      *(LAS v4u*)(PST + fr * 24) = PACK8(ps, 0); *(LAS v4u*)(PST + fr * 24 + 8) = PACK8(ps, 8); }
    LDS_WAIT(); asm volatile("" ::: "memory");
    __builtin_amdgcn_sched_barrier(0);
#pragma unroll
    for (int s_ = 0; s_ < 16; ++s_) { float m[16];
#pragma unroll
        for (int q = 0; q < 4; ++q) { const f32x4 v = *(const LAS f32x4*)(N1 + s_ * 20 + 4 * q); m[4 * q] = v.x; m[4 * q + 1] = v.y; m[4 * q + 2] = v.z; m[4 * q + 3] = v.w; }
#pragma unroll
        for (int t = s_; t < 16; ++t) ro[t] -= m[t] * al[s_];
        asm volatile("" ::: "memory"); __builtin_amdgcn_sched_barrier(0); }
#pragma unroll
    for (int t = 0; t < 16; ++t) OMg[t * 72 + lane] = bfr1(ro[t]);
    LDS_WAIT(); asm volatile("" ::: "memory");
    __builtin_amdgcn_sched_barrier(0);
    { bf16x4 vf[4];
#pragma unroll
      for (int it = 0; it < 4; ++it) vf[it] = *(const LAS bf16x4*)(VT + (it * 16 + fr) * 24 + fq * 4);
#pragma unroll
      for (int kt = 0; kt < 4; ++kt) { const bf16x4 gf = *(const LAS bf16x4*)(TG + (kt * 16 + fr) * 24 + fq * 4);
#pragma unroll
        for (int it = 0; it < 4; ++it) { const f32x4 d = mfma16(gf, vf[it], zero4()); v2u dw; dw.x = pk2(d[0], d[1]); dw.y = pk2(d[2], d[3]); *(v2u*)(CP + it * WK_PRV + kt * 512 + lane * 8) = dw; } }
      const bf16x4 pf = *(const LAS bf16x4*)(PST + fr * 24 + fq * 4);
#pragma unroll
      for (int it = 0; it < 4; ++it) { const f32x4 o = mfma16(pf, vf[it], zero4()); *(f32x4*)(CP + it * WK_PRV + 2048 + lane * 16) = o; } }
    LDS_WAIT(); asm volatile("" ::: "memory");
}
constexpr int WQ_CH = WK_PRV + WK_SHR, WQ_SLOT = 4 * WQ_CH, WQ_PCS = WQ_CH / 16, WQ_NWL = 4 * WQ_PCS / 64;
__device__ __forceinline__ void wkv_seq_chunk(const LAS unsigned char* sp, f32x4 (&acc)[4], float* orow, int lane, int fr, int fq) {
    const LAS unsigned char* sh = sp + WK_PRV;
    bf16x8 af[2], of[2]; bf16x4 gf[4]; f32x4 wt[4], dt[4];
#pragma unroll
    for (int s = 0; s < 2; ++s) { const LAS bf16* ap = (const LAS bf16*)(sh + 256) + fr * 72 + 32 * s + 4 * fq; const v2u lo = *(const LAS v2u*)ap, hi = *(const LAS v2u*)(ap + 16);
        af[s] = __builtin_bit_cast(bf16x8, (v4u){lo.x, lo.y, hi.x, hi.y});
        const LAS bf16* op = (const LAS bf16*)(sh + 256 + 2304) + fr * 72 + 32 * s + 4 * fq; const v2u lo2 = *(const LAS v2u*)op, hi2 = *(const LAS v2u*)(op + 16);
        of[s] = __builtin_bit_cast(bf16x8, (v4u){lo2.x, lo2.y, hi2.x, hi2.y}); }
#pragma unroll
    for (int kt = 0; kt < 4; ++kt) { gf[kt] = *(const LAS bf16x4*)((const LAS bf16*)(sh + 256 + 4608) + (kt * 16 + fr) * 16 + 4 * fq);
        wt[kt] = *(const LAS f32x4*)(sh + (16 * kt + 4 * fq) * 4); { float f_[4]; unpack4(*(const LAS v2u*)(sp + kt * 512 + lane * 8), f_); dt[kt] = (f32x4){f_[0], f_[1], f_[2], f_[3]}; } }
    const f32x4 ov = *(const LAS f32x4*)(sp + 2048 + lane * 16);
    bf16x8 sbf[2];
#pragma unroll
    for (int s = 0; s < 2; ++s) { v4u w; w.x = pk2(acc[2 * s][0], acc[2 * s][1]); w.y = pk2(acc[2 * s][2], acc[2 * s][3]); w.z = pk2(acc[2 * s + 1][0], acc[2 * s + 1][1]); w.w = pk2(acc[2 * s + 1][2], acc[2 * s + 1][3]);
        sbf[s] = __builtin_bit_cast(bf16x8, w); }
    f32x4 x = zero4();
    x = __builtin_amdgcn_mfma_f32_16x16x32_bf16(af[0], sbf[0], x, 0, 0, 0); x = __builtin_amdgcn_mfma_f32_16x16x32_bf16(af[1], sbf[1], x, 0, 0, 0);
    f32x4 o = __builtin_amdgcn_mfma_f32_16x16x32_bf16(of[0], sbf[0], ov, 0, 0, 0); o = __builtin_amdgcn_mfma_f32_16x16x32_bf16(of[1], sbf[1], o, 0, 0, 0);
    v2u xw; xw.x = pk2(x[0], x[1]); xw.y = pk2(x[2], x[3]); const bf16x4 xb = __builtin_bit_cast(bf16x4, xw);
#pragma unroll
    for (int kt = 0; kt < 4; ++kt) acc[kt] = mfma16(gf[kt], xb, acc[kt] * wt[kt] + dt[kt]);
    orow[0] = o[0]; orow[512] = o[1]; orow[1024] = o[2]; orow[1536] = o[3];
}
__device__ __forceinline__ void wkv_seq_item(const Ctx& C, const Ax& a, int l, int item) {
    const int bh = item >> 2, rg = item & 3, b = bh >> 3, h = bh & 7, lane = C.lane, fr = lane & 15, fq = lane >> 4;
    const unsigned char* CK = a.ws + WS_CK + (size_t)bh * 128 * WK_SHR; const unsigned char* CP = a.ws + WS_CP + ((size_t)bh * 128 * 4 + rg) * WK_PRV;
    float* OC = (float*)(a.ws + WS_OC) + ((size_t)b * SEQ) * 512 + h * 64 + rg * 16 + fr;
#define WQ_COMPUTE(blk) do { const LAS unsigned char* sbp = C.lds + ((blk) % 3) * WQ_SLOT; \
            _Pragma("unroll 2") for (int cq = 0; cq < 4; ++cq) wkv_seq_chunk(sbp + cq * WQ_CH, acc, OC + (size_t)(((blk) * 4 + cq) * 16 + 4 * fq) * 512, lane, fr, fq); } while (0)
    static_assert(4 * WQ_PCS == WQ_NWL * 64 && WQ_NWL > 35 && WQ_NWL <= 42 && 3 * WQ_SLOT <= SCR_BYTES, "ring geometry");
    if (C.wave == 0) {
        f32x4 acc[4];
#pragma unroll
        for (int kt = 0; kt < 4; ++kt) acc[kt] = zero4();
        __builtin_amdgcn_s_barrier(); asm volatile("" ::: "memory");
        for (int blk = 0; blk < 32; ++blk) { WQ_COMPUTE(blk); asm volatile("s_waitcnt lgkmcnt(0)" ::: "memory"); __builtin_amdgcn_s_barrier(); asm volatile("" ::: "memory"); }
        float* so = a.out + O_WKVP + ((((size_t)l * NB + b) * 8 + h) * 64 + rg * 16 + fr) * 64 + 4 * fq;
#pragma unroll
        for (int kt = 0; kt < 4; ++kt) *(f32x4*)(so + 16 * kt) = acc[kt];
    } else {
        const int w1 = C.wave - 1; const bool seven = (w1 + 35) < WQ_NWL;
        const unsigned char* wsb = a.ws; unsigned qoff[6], qstr[6];
#pragma unroll
        for (int i = 0; i < 6; ++i) { const int p = (w1 + 7 * i) * 64 + lane, cq = p / WQ_PCS, q = p - cq * WQ_PCS; const bool pr = q < WK_PRV / 16;
            qoff[i] = pr ? (unsigned)(WS_CP + ((size_t)bh * 128 * 4 + rg) * WK_PRV) + (unsigned)(cq * 4 * WK_PRV + q * 16) : (unsigned)(WS_CK + (size_t)bh * 128 * WK_SHR) + (unsigned)(cq * WK_SHR + (q - WK_PRV / 16) * 16);
            qstr[i] = pr ? (unsigned)(16 * WK_PRV) : (unsigned)(4 * WK_SHR); }
#define WQ_DMA(blk) do { _Pragma("unroll") for (int i = 0; i < 6; ++i) if (i < 5 || seven) \
            __builtin_amdgcn_global_load_lds((const unsigned*)(wsb + (qoff[i] + (unsigned)(blk) * qstr[i])), (LAS unsigned*)(C.lds + ((blk) % 3) * WQ_SLOT + (w1 + 7 * i) * 1024), 16, 0, 0); } while (0)
#define WQ_WAIT_OLDER() do { if (seven) asm volatile("s_waitcnt vmcnt(6)" ::: "memory"); else asm volatile("s_waitcnt vmcnt(5)" ::: "memory"); } while (0)
        WQ_DMA(0); WQ_DMA(1); WQ_WAIT_OLDER();
        __builtin_amdgcn_s_barrier(); asm volatile("" ::: "memory");
        for (int blk = 0; blk < 32; ++blk) {
            if (blk + 2 < 32) { WQ_DMA(blk + 2); WQ_WAIT_OLDER(); }
            else asm volatile("s_waitcnt vmcnt(0)" ::: "memory");
            __builtin_amdgcn_s_barrier(); asm volatile("" ::: "memory");
        }
#undef WQ_DMA
#undef WQ_WAIT_OLDER
    }
#undef WQ_COMPUTE
    __syncthreads();
}
__device__ __forceinline__ void rwkv_sample_witem(const Ctx& C, const Ax& a, int l, int witem) {
    const float* RW = (const float*)(a.ws + WS_RW); float* OC = (float*)(a.ws + WS_OC);
    const int n = witem >> 4, h = (witem >> 1) & 7, half = witem & 1, g = C.lane & 15, rq = C.lane >> 4;
    const unsigned char* p = (const unsigned char*)RW + ((size_t)(MP + n) * 8 + h) * RWB;
    const f32x4 lw4 = *(const f32x4*)(p + 16 * g), kk4 = rw_ld4(p, RW_KK, 4 * g), b4 = rw_ld4(p, RW_KB, 4 * g), k4 = rw_ld4(p, RW_K, 4 * g), r4 = rw_ld4(p, RW_R, 4 * g);
    const f32x4 w4 = (f32x4){__expf(lw4.x), __expf(lw4.y), __expf(lw4.z), __expf(lw4.w)};
    const float* sin_ = a.in(I_SWKV) + (((size_t)l * NS + n) * 8 + h) * 4096; float* sout = a.out + O_WKVS + (((size_t)l * NS + n) * 8 + h) * 4096;
#pragma unroll 4
    for (int it = 0; it < 8; ++it) { const int i = half * 32 + it * 4 + rq; const f32x4 S = __builtin_nontemporal_load((const f32x4*)(sin_ + i * 64 + 4 * g)); const float vi = bf1(*(const bf16*)(p + RW_V + i * 2));
        const float sa = -rowsum16((S.x * kk4.x + S.y * kk4.y) + (S.z * kk4.z + S.w * kk4.w));
        f32x4 T; T.x = S.x * w4.x + (sa * b4.x + vi * k4.x); T.y = S.y * w4.y + (sa * b4.y + vi * k4.y); T.z = S.z * w4.z + (sa * b4.z + vi * k4.z); T.w = S.w * w4.w + (sa * b4.w + vi * k4.w);
        const float o = rowsum16((T.x * r4.x + T.y * r4.y) + (T.z * r4.z + T.w * r4.w));
        __builtin_nontemporal_store(T, (f32x4*)(sout + i * 64 + 4 * g));
        if (g == 0) OC[(size_t)(MP + n) * 512 + h * 64 + i] = o; }
}
__device__ __forceinline__ void rwkv_post_phase(const Ctx& C, const Ax& a, int l) {
    const float* RW = (const float*)(a.ws + WS_RW); const float* OC = (const float*)(a.ws + WS_OC); const float* GATE = (const float*)(a.ws + WS_GATE); bf16* YC = (bf16*)(a.ws + WS_YC);
    const int gw = C.bid * NWAVES + C.wave, NGW = C.G * NWAVES, g = C.lane & 15, rq = C.lane >> 4;
    const float* lg = a.in(I_LNXG) + l * 512; const float* lb = a.in(I_LNXB) + l * 512; const float* rk = a.in(I_RK) + l * 512;
    for (int it = gw; it < MT * 8 / 4; it += NGW) { const int pair = it * 4 + rq, row = pair >> 3, h = pair & 7, ch = h * 64 + 4 * g;
        const f32x4 o = *(const f32x4*)(OC + (size_t)row * 512 + ch);
        const float mu = rowsum16((o.x + o.y) + (o.z + o.w)) * (1.0f / 64.0f); const f32x4 d = o - mu;
        const float var = rowsum16((d.x * d.x + d.y * d.y) + (d.z * d.z + d.w * d.w)) * (1.0f / 64.0f); const float rstd = 1.0f / sqrtf(var + 64e-5f);
        const unsigned char* rw = (const unsigned char*)RW + ((size_t)row * 8 + h) * RWB;
        const f32x4 k4 = rw_ld4(rw, RW_K, 4 * g), r4 = rw_ld4(rw, RW_R, 4 * g), v4 = rw_ld4(rw, RW_V, 4 * g), rkv = *(const f32x4*)(rk + ch), gv = *(const f32x4*)(GATE + (size_t)row * 512 + ch);
        const float bs = rowsum16((r4.x * k4.x * rkv.x + r4.y * k4.y * rkv.y) + (r4.z * k4.z * rkv.z + r4.w * k4.w * rkv.w));
        const f32x4 y = (d * rstd * *(const f32x4*)(lg + ch) + *(const f32x4*)(lb + ch) + bs * v4) * gv;
        v2u w; w.x = pk2(y.x, y.y); w.y = pk2(y.z, y.w); *(v2u*)(YC + (size_t)row * DM + 1024 + ch) = w; }
}

__device__ __forceinline__ float ret_lg(int h) { return log1pf(-exp2f(-5.0f - (float)h)); }
constexpr int RS = 136;
__device__ __forceinline__ void rot8(const bf16* src, const float* cs, int c8, float scale, float (&lo)[8], float (&hi)[8]) {
    float x1[8], x2[8]; unpack8(*(const v4u*)(src + c8 * 8), x1); unpack8(*(const v4u*)(src + 64 + c8 * 8), x2);
    const f32x4* cp = (const f32x4*)(cs + 16 * c8); const f32x4 t0 = cp[0], t1 = cp[1], t2 = cp[2], t3 = cp[3];
    const float cc[8] = {t0.x, t0.z, t1.x, t1.z, t2.x, t2.z, t3.x, t3.z}, sn[8] = {t0.y, t0.w, t1.y, t1.w, t2.y, t2.w, t3.y, t3.w};
#pragma unroll
    for (int j = 0; j < 8; ++j) { lo[j] = (x1[j] * cc[j] - x2[j] * sn[j]) * scale; hi[j] = (x2[j] * cc[j] + x1[j] * sn[j]) * scale; }
}
__device__ __forceinline__ void ret_pass1_item(const Ctx& C, const Ax& a, int item) {
    const bf16* P = (const bf16*)(a.ws + WS_P); const float* CS = (const float*)(a.ws + WS_ROPE); float* KVT = (float*)(a.ws + WS_KVT);
    const int b = item >> 6, h = (item >> 4) & 3, c = item & 15; const size_t row0 = (size_t)b * SEQ + c * 128; const float lg = ret_lg(h);
    LAS bf16* KT = (LAS bf16*)C.lds; LAS bf16* VT = KT + 128 * RS;
    for (int it = C.tid; it < 128 * 8; it += NWAVES * 64) { const int tt = it & 127, c8 = it >> 7; float lo[8], hi[8];
        rot8(P + (row0 + tt) * PIN + PB_ + 512 + h * 128, CS + (size_t)(c * 128 + tt) * 128, c8, 0.08838834764831845f * __expf(lg * (float)(127 - tt)), lo, hi);
#pragma unroll
        for (int j = 0; j < 8; ++j) { KT[(c8 * 8 + j) * RS + tt] = (bf16)(pk2(lo[j], 0.f) & 0xffffu); KT[(64 + c8 * 8 + j) * RS + tt] = (bf16)(pk2(hi[j], 0.f) & 0xffffu); } }
    for (int it = C.tid; it < 128 * 16; it += NWAVES * 64) { const int tt = it & 127, c8 = it >> 7; const v4u w = *(const v4u*)(P + (row0 + tt) * PIN + PB_ + 1024 + h * 128 + c8 * 8);
        const unsigned ww[4] = {w.x, w.y, w.z, w.w};
#pragma unroll
        for (int j = 0; j < 4; ++j) { VT[(c8 * 8 + 2 * j) * RS + tt] = (bf16)(ww[j] & 0xffffu); VT[(c8 * 8 + 2 * j + 1) * RS + tt] = (bf16)(ww[j] >> 16); } }
    __syncthreads();
    const int fr = C.lane & 15, fq = C.lane >> 4, w = C.wave;
    f32x4 acc[8];
#pragma unroll
    for (int et = 0; et < 8; ++et) acc[et] = zero4();
#pragma unroll
    for (int ks = 0; ks < 4; ++ks) { const bf16x8 kf = *(const LAS bf16x8*)(KT + (16 * w + fr) * RS + ks * 32 + fq * 8);
#pragma unroll
        for (int et = 0; et < 8; ++et) { const bf16x8 vf = *(const LAS bf16x8*)(VT + (16 * et + fr) * RS + ks * 32 + fq * 8); acc[et] = __builtin_amdgcn_mfma_f32_16x16x32_bf16(kf, vf, acc[et], 0, 0, 0); } }
    float* o = KVT + (size_t)item * 16384;
#pragma unroll
    for (int et = 0; et < 8; ++et) *(f32x4*)(o + (size_t)(16 * et + fr) * 128 + 16 * w + 4 * fq) = acc[et];
    __syncthreads();
}
__device__ __forceinline__ void ret_prefix_phase(const Ctx& C, const Ax& a, int l) {
    const float* KVT = (const float*)(a.ws + WS_KVT); bf16* STB = (bf16*)(a.ws + WS_STB);
    const int gt = C.bid * (NWAVES * 64) + C.tid, NT = C.G * NWAVES * 64;
    for (int idx = gt; idx < 16 * 4096; idx += NT) { const int bh = idx >> 12, r = idx & 4095, e = r >> 5, d4 = (r & 31) * 4; const int h = bh & 3;
        const float g128 = __expf(ret_lg(h) * 128.0f); const size_t base = (size_t)bh * 16 * 16384 + e * 128 + d4;
        f32x4 kv[16];
#pragma unroll
        for (int c = 0; c < 16; ++c) kv[c] = *(const f32x4*)(KVT + base + (size_t)c * 16384);
        f32x4 S = zero4();
#pragma unroll
        for (int c = 0; c < 16; ++c) { v2u w; w.x = pk2(S.x, S.y); w.y = pk2(S.z, S.w); *(v2u*)(STB + base + (size_t)c * 16384) = w; S = S * g128 + kv[c]; }
        float* o = a.out + O_RETP + ((size_t)l * 16 + bh) * 16384 + e;
        o[(size_t)d4 * 128] = S.x; o[(size_t)(d4 + 1) * 128] = S.y; o[(size_t)(d4 + 2) * 128] = S.z; o[(size_t)(d4 + 3) * 128] = S.w; }
}
__device__ __forceinline__ void ret_pass2_item(const Ctx& C, const Ax& a, int l, int item) {
    const bf16* P = (const bf16*)(a.ws + WS_P); const float* CS = (const float*)(a.ws + WS_ROPE); bf16* YC = (bf16*)(a.ws + WS_YC);
    const int b = item >> 6, h = (item >> 4) & 3, c = item & 15; const size_t row0 = (size_t)b * SEQ + c * 128; const float lg = ret_lg(h);
    LAS bf16* QL = (LAS bf16*)C.lds; LAS bf16* KL = QL + 128 * RS; LAS bf16* VT = KL + 128 * RS; LAS bf16* ST = VT + 128 * RS;
    for (int it = C.tid; it < 128 * 8; it += NWAVES * 64) { const int tt = it & 127, c8 = it >> 7; float lo[8], hi[8]; const float* cs = CS + (size_t)(c * 128 + tt) * 128;
        rot8(P + (row0 + tt) * PIN + PB_ + h * 128, cs, c8, __expf(lg * (float)(tt + 1)), lo, hi);
        *(LAS v4u*)(QL + tt * RS + c8 * 8) = pack8(lo); *(LAS v4u*)(QL + tt * RS + 64 + c8 * 8) = pack8(hi);
        rot8(P + (row0 + tt) * PIN + PB_ + 512 + h * 128, cs, c8, 0.08838834764831845f * __expf(-lg * (float)(tt + 1)), lo, hi);
        *(LAS v4u*)(KL + tt * RS + c8 * 8) = pack8(lo); *(LAS v4u*)(KL + tt * RS + 64 + c8 * 8) = pack8(hi); }
    for (int it = C.tid; it < 128 * 16; it += NWAVES * 64) { const int tt = it & 127, c8 = it >> 7; const v4u w = *(const v4u*)(P + (row0 + tt) * PIN + PB_ + 1024 + h * 128 + c8 * 8);
        const unsigned ww[4] = {w.x, w.y, w.z, w.w};
#pragma unroll
        for (int j = 0; j < 4; ++j) { VT[(c8 * 8 + 2 * j) * RS + tt] = (bf16)(ww[j] & 0xffffu); VT[(c8 * 8 + 2 * j + 1) * RS + tt] = (bf16)(ww[j] >> 16); } }
    { const bf16* stb = (const bf16*)(a.ws + WS_STB) + (size_t)item * 16384;
      for (int it = C.tid; it < 128 * 16; it += NWAVES * 64) { const int e = it >> 4, dc = it & 15; *(LAS v4u*)(ST + e * RS + dc * 8) = *(const v4u*)(stb + e * 128 + dc * 8); } }
    __syncthreads();
    const int fr = C.lane & 15, fq = C.lane >> 4, w = C.wave, i0 = 16 * w;
    bf16x8 qf[4];
#pragma unroll
    for (int ks = 0; ks < 4; ++ks) qf[ks] = *(const LAS bf16x8*)(QL + (i0 + fr) * RS + ks * 32 + fq * 8);
    f32x4 sc[8];
#pragma unroll
    for (int jt = 0; jt < 8; ++jt) { sc[jt] = zero4();
        if (jt <= w) {
#pragma unroll
            for (int ks = 0; ks < 4; ++ks) { const bf16x8 kf = *(const LAS bf16x8*)(KL + (16 * jt + fr) * RS + ks * 32 + fq * 8); sc[jt] = __builtin_amdgcn_mfma_f32_16x16x32_bf16(kf, qf[ks], sc[jt], 0, 0, 0); }
            if (jt == w) {
#pragma unroll
                for (int r = 0; r < 4; ++r) if (4 * fq + r > fr) sc[jt][r] = 0.f; } } }
    __syncthreads();
    LAS bf16* PL = KL;
#pragma unroll
    for (int jt = 0; jt < 8; ++jt) { v2u pw; pw.x = pk2(sc[jt][0], sc[jt][1]); pw.y = pk2(sc[jt][2], sc[jt][3]); *(LAS v2u*)(PL + (i0 + fr) * RS + 16 * jt + 4 * fq) = pw; }
    LDS_WAIT(); asm volatile("" ::: "memory");
    f32x4 acc[8];
#pragma unroll
    for (int et = 0; et < 8; ++et) acc[et] = zero4();
#pragma unroll
    for (int ks = 0; ks < 4; ++ks) { if (2 * ks <= w) { const bf16x8 pf = *(const LAS bf16x8*)(PL + (i0 + fr) * RS + ks * 32 + fq * 8);
#pragma unroll
            for (int et = 0; et < 8; ++et) { const bf16x8 vf = *(const LAS bf16x8*)(VT + (16 * et + fr) * RS + ks * 32 + fq * 8); acc[et] = __builtin_amdgcn_mfma_f32_16x16x32_bf16(vf, pf, acc[et], 0, 0, 0); } } }
    if (c > 0) {
#pragma unroll
        for (int ks = 0; ks < 4; ++ks)
#pragma unroll
            for (int et = 0; et < 8; ++et) { const bf16x8 sf = *(const LAS bf16x8*)(ST + (16 * et + fr) * RS + ks * 32 + fq * 8); acc[et] = __builtin_amdgcn_mfma_f32_16x16x32_bf16(sf, qf[ks], acc[et], 0, 0, 0); } }
    float s = 0.f;
#pragma unroll
    for (int et = 0; et < 8; ++et) s += (acc[et][0] + acc[et][1]) + (acc[et][2] + acc[et][3]);
    s += __shfl_xor(s, 16); s += __shfl_xor(s, 32); const float mu = s * (1.0f / 128.0f);
    float q = 0.f;
#pragma unroll
    for (int et = 0; et < 8; ++et) { acc[et] = acc[et] - mu; q += (acc[et][0] * acc[et][0] + acc[et][1] * acc[et][1]) + (acc[et][2] * acc[et][2] + acc[et][3] * acc[et][3]); }
    q += __shfl_xor(q, 16); q += __shfl_xor(q, 32); const float rstd = 1.0f / sqrtf(q * (1.0f / 128.0f) + 1e-6f);
    const size_t row = row0 + i0 + fr;
#pragma unroll
    for (int et = 0; et < 8; ++et) { const int e = 16 * et + 4 * fq; float gg[4]; unpack4(*(const v2u*)(P + row * PIN + PB_ + 1536 + h * 128 + e), gg);
        v2u wv; wv.x = pk2(gg[0] * sigm(gg[0]) * acc[et][0] * rstd, gg[1] * sigm(gg[1]) * acc[et][1] * rstd); wv.y = pk2(gg[2] * sigm(gg[2]) * acc[et][2] * rstd, gg[3] * sigm(gg[3]) * acc[et][3] * rstd);
        *(v2u*)(YC + row * DM + 512 + h * 128 + e) = wv; }
    __syncthreads();
}
__device__ __forceinline__ void ret_sample_witem(const Ctx& C, const Ax& a, int l, int witem) {
    const bf16* P = (const bf16*)(a.ws + WS_P); const float* CS = (const float*)(a.ws + WS_ROPE) + (size_t)2048 * 128; bf16* YC = (bf16*)(a.ws + WS_YC);
    const int n = witem >> 2, h = witem & 3, lane = C.lane; const float gam = 1.0f - exp2f(-5.0f - (float)h);
    LAS float* qk = (LAS float*)(C.lds + C.wave * 1024);
    const bf16* pr = P + (size_t)(MP + n) * PIN + PB_ + h * 128;
    { const float co = CS[2 * lane], si = CS[2 * lane + 1]; const float q1 = bf1(pr[lane]), q2 = bf1(pr[64 + lane]), k1 = bf1(pr[512 + lane]), k2 = bf1(pr[512 + 64 + lane]);
      qk[lane] = q1 * co - q2 * si; qk[64 + lane] = q2 * co + q1 * si; qk[128 + lane] = (k1 * co - k2 * si) * 0.08838834764831845f; qk[192 + lane] = (k2 * co + k1 * si) * 0.08838834764831845f; }
    LDS_WAIT(); asm volatile("" ::: "memory");
    const float dotp = wave_sum(qk[lane] * qk[128 + lane] + qk[64 + lane] * qk[192 + lane]);
    const int half = lane >> 5, el = lane & 31;
    float vv[4]; unpack4(*(const v2u*)(pr + 1024 + 4 * el), vv); const f32x4 v4 = (f32x4){vv[0], vv[1], vv[2], vv[3]};
    const float* sin_ = a.in(I_SRET) + (((size_t)l * NS + n) * 4 + h) * 16384; float* sout = a.out + O_RETS + (((size_t)l * NS + n) * 4 + h) * 16384;
    f32x4 oa = zero4();
#pragma unroll 8
    for (int it = 0; it < 64; ++it) { const int d = 2 * it + half; const f32x4 S = __builtin_nontemporal_load((const f32x4*)(sin_ + (size_t)d * 128 + 4 * el)); const float qd = qk[d], kd = qk[128 + d];
        oa += qd * S; __builtin_nontemporal_store(gam * S + kd * v4, (f32x4*)(sout + (size_t)d * 128 + 4 * el)); }
    oa.x += __shfl_xor(oa.x, 32); oa.y += __shfl_xor(oa.y, 32); oa.z += __shfl_xor(oa.z, 32); oa.w += __shfl_xor(oa.w, 32);
    f32x4 o = gam * oa + dotp * v4;
    float s = (o.x + o.y) + (o.z + o.w);
#pragma unroll
    for (int m = 1; m < 32; m <<= 1) s += __shfl_xor(s, m);
    const float mu = s * (1.0f / 128.0f); o = o - mu; float q = (o.x * o.x + o.y * o.y) + (o.z * o.z + o.w * o.w);
#pragma unroll
    for (int m = 1; m < 32; m <<= 1) q += __shfl_xor(q, m);
    const float rstd = 1.0f / sqrtf(q * (1.0f / 128.0f) + 1e-6f);
    if (half == 0) { float gg[4]; unpack4(*(const v2u*)(pr + 1536 + 4 * el), gg);
        v2u wv; wv.x = pk2(gg[0] * sigm(gg[0]) * o.x * rstd, gg[1] * sigm(gg[1]) * o.y * rstd); wv.y = pk2(gg[2] * sigm(gg[2]) * o.z * rstd, gg[3] * sigm(gg[3]) * o.w * rstd);
        *(v2u*)(YC + (size_t)(MP + n) * DM + 512 + h * 128 + 4 * el) = wv; }
    LDS_WAIT(); asm volatile("" ::: "memory");
}

constexpr int XV_RS = 264;
__device__ __forceinline__ void xattn_prompt_unit(const Ctx& C, const Ax& a, int l, int unit) {
    const bf16* Q = (const bf16*)(a.ws + WS_Q); const bf16* MK = (const bf16*)(a.ws + WS_MK) + (size_t)l * MMEM * DM; const bf16* MVT = (const bf16*)(a.ws + WS_MVT) + (size_t)l * MMEM * DM; bf16* O = (bf16*)(a.ws + WS_O);
    const int b = unit >> 6, h = (unit >> 4) & 3, qt = unit & 15, fr = C.lane & 15, fq = C.lane >> 4;
    const size_t row = (size_t)b * SEQ + qt * 128 + C.wave * 16 + fr;
    LAS bf16* SB = (LAS bf16*)C.lds;
    v4u st[8];
    const bf16* kbase = MK + ((size_t)b * 256) * DM + h * 512; const bf16* vbase = MVT + (((size_t)b * 4 + h) * 512) * 256;
    unsigned kof[4], vof[8], sof[8];
#pragma unroll
    for (int i = 0; i < 8; ++i) { const int idx = C.tid + 512 * i, r = idx >> 5, c16 = idx & 31; vof[i] = (unsigned)(r * 256 + c16 * 8) * 2u; sof[i] = (unsigned)(r * XV_RS + c16 * 8) * 2u; if (i < 4) kof[i] = (unsigned)(r * DM + c16 * 8) * 2u; }
    const char* kb8 = (const char*)kbase; const char* vb8 = (const char*)vbase; LAS char* sb8 = (LAS char*)SB;
#define XK_LOAD(q) do { const char* pb_ = kb8 + ((size_t)(((q) & 3) * 64) * DM + ((q) >> 2) * 256) * 2; _Pragma("unroll") for (int i = 0; i < 4; ++i) st[i] = *(const v4u*)(pb_ + kof[i]); } while (0)
#define XK_STORE() do { _Pragma("unroll") for (int i = 0; i < 4; ++i) *(LAS v4u*)(sb8 + sof[i]) = st[i]; } while (0)
#define XV_LOAD(p) do { const char* pb_ = vb8 + (size_t)((p) * 128) * 256 * 2; _Pragma("unroll") for (int i = 0; i < 8; ++i) st[i] = *(const v4u*)(pb_ + vof[i]); } while (0)
#define XV_STORE() do { _Pragma("unroll") for (int i = 0; i < 8; ++i) *(LAS v4u*)(sb8 + sof[i]) = st[i]; } while (0)
    XK_LOAD(0);
    f32x4 sc[16];
#pragma unroll
    for (int jt = 0; jt < 16; ++jt) sc[jt] = zero4();
#pragma unroll
    for (int dh = 0; dh < 2; ++dh) {
        bf16x8 qf[8];
#pragma unroll
        for (int ks = 0; ks < 8; ++ks) qf[ks] = *(const bf16x8*)(Q + row * DM + h * 512 + dh * 256 + ks * 32 + fq * 8);
#pragma unroll
        for (int p = 0; p < 4; ++p) {
            __syncthreads(); XK_STORE(); __syncthreads();
            if (dh * 4 + p < 7) XK_LOAD(dh * 4 + p + 1); else XV_LOAD(0);
#pragma unroll
            for (int j4 = 0; j4 < 4; ++j4) {
#pragma unroll
                for (int ks = 0; ks < 8; ++ks) { const bf16x8 kf = *(const LAS bf16x8*)(SB + (j4 * 16 + fr) * XV_RS + ks * 32 + fq * 8); sc[p * 4 + j4] = __builtin_amdgcn_mfma_f32_16x16x32_bf16(kf, qf[ks], sc[p * 4 + j4], 0, 0, 0); }
                __builtin_amdgcn_sched_barrier(0); }
        }
    }
    float mx = -3.0e38f;
#pragma unroll
    for (int jt = 0; jt < 16; ++jt) mx = fmaxf(mx, fmaxf(fmaxf(sc[jt][0], sc[jt][1]), fmaxf(sc[jt][2], sc[jt][3])));
    mx = fmaxf(mx, __shfl_xor(mx, 16)); mx = fmaxf(mx, __shfl_xor(mx, 32));
    const float scale = 0.04419417382415922f; float sum = 0.f;
    bf16x8 pf[8];
#pragma unroll
    for (int s = 0; s < 8; ++s) { float p[8];
#pragma unroll
        for (int j = 0; j < 4; ++j) { p[j] = __expf((sc[2 * s][j] - mx) * scale); p[4 + j] = __expf((sc[2 * s + 1][j] - mx) * scale); }
        sum += ((p[0] + p[1]) + (p[2] + p[3])) + ((p[4] + p[5]) + (p[6] + p[7]));
        const v4u w = pack8(p); pf[s] = __builtin_bit_cast(bf16x8, w); }
    sum += __shfl_xor(sum, 16); sum += __shfl_xor(sum, 32); const float inv = 1.0f / sum;
#pragma unroll
    for (int p = 0; p < 4; ++p) {
        __syncthreads(); XV_STORE(); __syncthreads();
        if (p < 3) XV_LOAD(p + 1);
#pragma unroll
        for (int et = 0; et < 8; ++et) { f32x4 s4 = zero4(); const LAS bf16* vp = SB + (et * 16 + fr) * XV_RS + 4 * fq;
#pragma unroll
            for (int s = 0; s < 8; ++s) { const v2u lo = *(const LAS v2u*)(vp + 32 * s), hi = *(const LAS v2u*)(vp + 32 * s + 16); const v4u w = (v4u){lo.x, lo.y, hi.x, hi.y};
                s4 = __builtin_amdgcn_mfma_f32_16x16x32_bf16(__builtin_bit_cast(bf16x8, w), pf[s], s4, 0, 0, 0); }
            v2u w; w.x = pk2(s4[0] * inv, s4[1] * inv); w.y = pk2(s4[2] * inv, s4[3] * inv);
            *(v2u*)(O + row * DM + h * 512 + p * 128 + et * 16 + 4 * fq) = w;
            __builtin_amdgcn_sched_barrier(0); }
    }
    __syncthreads();
#undef XK_LOAD
#undef XK_STORE
#undef XV_LOAD
#undef XV_STORE
}
__device__ __forceinline__ void xattn_sample_item(const Ctx& C, const Ax& a, int l, int item) {
    const bf16* Q = (const bf16*)(a.ws + WS_Q); bf16* O = (bf16*)(a.ws + WS_O);
    const int n = item >> 2, h = item & 3, lane = C.lane, w = C.wave;
    LAS float* red = (LAS float*)C.lds; LAS float* part = red + 64;
    float q[8]; { const float* s0 = (const float*)(a.ws + WS_SPL) + (size_t)n * DM + h * 512 + 4 * lane; const float* s1 = s0 + (size_t)NS * DM;
                  const f32x4 a0 = *(const f32x4*)s0 + *(const f32x4*)s1, a1 = *(const f32x4*)(s0 + 256) + *(const f32x4*)(s1 + 256);
                  q[0] = a0.x; q[1] = a0.y; q[2] = a0.z; q[3] = a0.w; q[4] = a1.x; q[5] = a1.y; q[6] = a1.z; q[7] = a1.w; }
    const size_t base = ((((size_t)l * NS + n) * 256 + 32 * w) * 4 + h) * 512 + 4 * lane;
    const float* kp = a.in(I_CMK) + base; const float* vp = a.in(I_CMV) + base;
#define XS_LOAD(buf0, buf1, ptr, k8) do { _Pragma("unroll") for (int j = 0; j < 8; ++j) { buf0[j] = __builtin_nontemporal_load((const f32x4*)((ptr) + (size_t)((k8) * 8 + j) * 2048)); buf1[j] = __builtin_nontemporal_load((const f32x4*)((ptr) + (size_t)((k8) * 8 + j) * 2048 + 256)); } } while (0)
#define XS_DOT(buf0, buf1, k8) do { _Pragma("unroll") for (int j = 0; j < 8; ++j) { float d = (buf0[j].x * q[0] + buf0[j].y * q[1]) + (buf0[j].z * q[2] + buf0[j].w * q[3]) + (buf1[j].x * q[4] + buf1[j].y * q[5]) + (buf1[j].z * q[6] + buf1[j].w * q[7]); \
        d = rowsum16(d); d += __shfl_xor(d, 16); d += __shfl_xor(d, 32); if (lane == (k8) * 8 + j) myscore = d; } } while (0)
#define XS_ACC(buf0, buf1, k8) do { _Pragma("unroll") for (int j = 0; j < 8; ++j) { const float pj = __builtin_bit_cast(float, __builtin_amdgcn_readlane(__builtin_bit_cast(int, p), (k8) * 8 + j)); o0 += pj * buf0[j]; o1 += pj * buf1[j]; } } while (0)
    float myscore = 0.f;
    f32x4 xa0[8], xa1[8], xb0[8], xb1[8];
    XS_LOAD(xa0, xa1, kp, 0);
    XS_LOAD(xb0, xb1, kp, 1); XS_DOT(xa0, xa1, 0);
    XS_LOAD(xa0, xa1, kp, 2); XS_DOT(xb0, xb1, 1);
    XS_LOAD(xb0, xb1, kp, 3); XS_DOT(xa0, xa1, 2);
    XS_LOAD(xa0, xa1, vp, 0); XS_DOT(xb0, xb1, 3);
    const float scale = 0.04419417382415922f;
    float mx = wave_max(lane < 32 ? myscore : -3.0e38f); if (lane == 0) red[w] = mx; __syncthreads();
    mx = red[0];
#pragma unroll
    for (int i = 1; i < 8; ++i) mx = fmaxf(mx, red[i]);
    const float p = lane < 32 ? __expf((myscore - mx) * scale) : 0.f;
    const float ps = wave_sum(p); if (lane == 0) red[8 + w] = ps;
    f32x4 o0 = zero4(), o1 = zero4();
    XS_LOAD(xb0, xb1, vp, 1); XS_ACC(xa0, xa1, 0);
    XS_LOAD(xa0, xa1, vp, 2); XS_ACC(xb0, xb1, 1);
    XS_LOAD(xb0, xb1, vp, 3); XS_ACC(xa0, xa1, 2);
    XS_ACC(xb0, xb1, 3);
#undef XS_LOAD
#undef XS_DOT
#undef XS_ACC
    *(LAS f32x4*)(part + w * 512 + 4 * lane) = o0; *(LAS f32x4*)(part + w * 512 + 256 + 4 * lane) = o1;
    __syncthreads();
    float tot = 0.f;
#pragma unroll
    for (int i = 0; i < 8; ++i) tot += red[8 + i];
    { const int d = C.tid; float s = 0.f;
#pragma unroll
      for (int i = 0; i < 8; ++i) s += part[i * 512 + d];
      O[(size_t)(MP + n) * DM + h * 512 + d] = (bf16)(pk2(s / tot, 0.f) & 0xffffu); }
    __syncthreads();
}

#ifndef PHASE_MASK
#define PHASE_MASK 0xffffffffu
#endif
#define PM(k) ((PHASE_MASK >> (k)) & 1u)
#ifndef DUP_SUB
#define DUP_SUB 0u
#endif
#define REP(k) for (int rep_ = 0; rep_ < 1 + (int)((DUP_SUB >> (k)) & 1u); ++rep_)
#ifndef DUP_MASK
#define DUP_MASK 0
#endif
#ifndef MK_ONE_LAUNCH
#define MK_ONE_LAUNCH 1
#endif
constexpr int PH_PER_LAYER = 14, NPH = 1 + DEPTH * PH_PER_LAYER;
__global__ void __launch_bounds__(NWAVES * 64, 2) fwd_kernel(Args args) {
    extern __shared__ __attribute__((aligned(16))) unsigned char lds_raw[];
    LAS unsigned char* const lds = (LAS unsigned char*)lds_raw;
    const int wave_s = __builtin_amdgcn_readfirstlane((int)threadIdx.x >> 6);
    volatile LAS unsigned* MISC = (volatile LAS unsigned*)(lds + MISC_OFF);
    for (int u = threadIdx.x; u < (LDS_BYTES - MISC_OFF) / 4; u += NWAVES * 64) ((LAS unsigned*)(lds + MISC_OFF))[u] = 0u;
    __syncthreads();
    XcdBarrier bar; bar.bar = (unsigned*)(args.ws + WS_CTL) + CW_BAR; bar.x = 0; bar.st = nullptr;
    if (MK_ONE_LAUNCH) bar = xcd_barrier_post((unsigned*)(args.ws + WS_CTL) + CW_BAR, MISC + 8);
    bar.wave = wave_s;
    const int lo = args.ph_lo, hi = args.ph_hi;
#define IN(k) (lo <= (k) && (k) < hi)
#define SEAM(k) do { if (MK_ONE_LAUNCH && IN((k) + 1)) xcd_barrier(bar); } while (0)
#define SEAM2(k) do { if (MK_ONE_LAUNCH && IN((k) + 2)) xcd_barrier(bar); } while (0)
#define PHASE_CTX const Ctx C = mk_ctx(lds, wave_s); const Ax a = mk_ax(); unsigned char* const ws = a.ws; const int G = C.G, bid = C.bid; (void)ws; (void)G; (void)bid; \
    float* const XF = (float*)(ws + WS_XF); bf16* const HN = (bf16*)(ws + WS_HN); bf16* const PBUF = (bf16*)(ws + WS_P); bf16* const YC = (bf16*)(ws + WS_YC); bf16* const QB = (bf16*)(ws + WS_Q); \
    bf16* const OB = (bf16*)(ws + WS_O); bf16* const UB = (bf16*)(ws + WS_U); (void)XF; (void)HN; (void)PBUF; (void)YC; (void)QB; (void)OB; (void)UB

    if (IN(0)) { PHASE_CTX; if (PM(0)) p0_prologue(C, a); SEAM(0); }

    for (int l = 0; l < DEPTH; ++l) {
        const int pb = 1 + l * PH_PER_LAYER;
        if (IN(pb + 0)) { PHASE_CTX; const unsigned char* wl = ws + WS_WL + (size_t)l * LW_STRIDE;
            if (PM(1)) { pg8::Gemm g{HN, (const bf16*)(wl + LW_IN), MPAD, PIN, DM, DM, 64, (size_t)PIN * 128}; pg8::StaticOrder S; S.init(MPAD, PIN, G, bid); pg8::EpiBf16A<0> E{PBUF, PIN, nullptr};
              pg8::gemm_phase<pg8::EpiBf16A<0>, pg8::StaticOrder, true, true>(lds, g, S, E, C.tid); }
            if (l + 1 == DEPTH && DEPTH > 1) { const int nfull = (MPAD / 256) * (PIN / 256) - 3 * G; if (G == 256 && bid >= nfull) { __syncthreads(); late_convert(C, a, l, bid - nfull, G - nfull); } }
            if (PM(2) && l == 0) { pg8::Gemm g{(const bf16*)(ws + WS_MN), (const bf16*)(ws + WS_WKV), MMEM, 8192, DM, DM, 64, (size_t)8192 * 128}; pg8::StaticOrder S; S.init(MMEM, 8192, G, (bid + G - (64 % G)) % G);
              pg8::EpiMemKV E{a.out + O_MKP, (bf16*)(ws + WS_MK), (bf16*)(ws + WS_MVT)};
              pg8::gemm_phase<pg8::EpiMemKV, pg8::StaticOrder, true, true>(lds, g, S, E, C.tid); }
            SEAM(pb + 0);
        }
        if (IN(pb + 1)) { PHASE_CTX;
#ifdef DEBUG_P
            { const int gt = bid * 512 + C.tid, NT = G * 512;
              for (int idx = gt + (DEBUG_P == 2 ? MP * 2048 : 0); idx < (DEBUG_P == 1 ? MP : MT) * 2048; idx += NT) { const int row = idx >> 11, c = idx & 2047; const bf16* pr = PBUF + (size_t)row * PIN;
                  float s = bf1(pr[c]) + bf1(pr[c + 2048]) + bf1(pr[c + 4096]); if (c < 256) s += bf1(pr[c + 6144]); a.out[O_YP + idx] = s; } }
#endif
            if (PM(4)) REP(4) for (int it = bid; it < 256; it += G) ad_prompt_item(C, a, l, it);
            if (PM(5)) REP(5) for (int it = bid; it < 256; it += G) ret_pass1_item(C, a, it);
            if (PM(6)) REP(6) for (int it = bid; it < 256; it += G) rwkv_prep_item(C, a, l, it);
            if (PM(6)) for (int it = bid - 64; it >= 0 && it < 4; it += G) rwkv_prep_item(C, a, l, 256 + it);
            if (PM(7)) REP(7) for (int it = G - 1 - bid; it < NS; it += G) ad_sample_item(C, a, l, it);
            if (PM(8)) REP(8) for (int it = bid * NWAVES + C.wave; it < NS * 4; it += G * NWAVES) ret_sample_witem(C, a, l, it);
            __syncthreads();
            SEAM(pb + 1);
        }
        if (IN(pb + 2)) { PHASE_CTX;
            if (PM(9)) REP(9) for (int it = bid * NWAVES + C.wave; it < 4096; it += G * NWAVES) wkv_chunk_witem(C, a, it);
            if (PM(10)) REP(10) for (int it = bid * NWAVES + C.wave; it < NS * 16; it += G * NWAVES) rwkv_sample_witem(C, a, l, it);
            if (PM(11)) ret_prefix_phase(C, a, l);
            SEAM(pb + 2);
        }
        if (IN(pb + 3)) { PHASE_CTX; const int hg = G / 2;
            if (PM(22)) REP(22) for (int it = bid; it < 128; it += (bid < hg ? hg : 1 << 20)) wkv_seq_item(C, a, l, it);
            if (PM(11)) REP(11) if (bid >= hg || G < 2) for (int it = bid - hg; it < 256; it += G - hg) ret_pass2_item(C, a, l, it);
            SEAM(pb + 3);
        }
        if (IN(pb + 4)) { PHASE_CTX;
            if (PM(12)) REP(12) rwkv_post_phase(C, a, l);
            SEAM(pb + 4);
        }
        if (IN(pb + 5)) { PHASE_CTX; const unsigned char* wl = ws + WS_WL + (size_t)l * LW_STRIDE;
            pg8::Gemm g{YC, (const bf16*)(wl + LW_OUT), MP, DM, DM, DM, 64, (size_t)DM * 128}; pg8::StaticOrder S; S.init(MP, DM, G, bid); pg8::EpiRes E{XF, DM, ((DUP_MASK >> 5) & 1) ? 0.5f : 1.0f, (l == 0 && !((DUP_MASK >> 5) & 1)) ? a.in(I_XP) : (const float*)XF};
            if (PM(15)) pg8::gemm_phase<pg8::EpiRes, pg8::StaticOrder, true, true>(lds, g, S, E, C.tid);
            if (PM(20)) sample_gemm(lds, C.tid, YC + (size_t)MP * DM, DM, (const bf16*)(wl + LW_OUT), DM, DM, DM, G, bid, SEpiRes{XF + (size_t)MP * DM, DM, ((DUP_MASK >> 5) & 1) ? 0.5f : 1.0f, (l == 0 && !((DUP_MASK >> 5) & 1)) ? a.in(I_XS) : (const float*)(XF + (size_t)MP * DM)});
            SEAM(pb + 5);
        }
        if (IN(pb + 6)) { PHASE_CTX; if (PM(21)) REP(21) rms_phase(C, XF, HN); SEAM(pb + 6);
#ifdef XBAR_PROBE
            if (MK_ONE_LAUNCH) for (int i_ = 0; i_ < XBAR_PROBE; ++i_) xcd_barrier(bar);
#endif
        }
        if (IN(pb + 7)) { PHASE_CTX; const unsigned char* wl = ws + WS_WL + (size_t)l * LW_STRIDE;
            pg8::Gemm g{HN, (const bf16*)(wl + LW_Q), MP, DM, DM, DM, 64, (size_t)DM * 128}; pg8::StaticOrder S; S.init(MP, DM, G, bid); pg8::EpiBf16A<0> E{QB, DM, nullptr};
            if (PM(16)) REP(16) pg8::gemm_phase<pg8::EpiBf16A<0>, pg8::StaticOrder, true, true>(lds, g, S, E, C.tid);
            if (PM(20)) sample_gemm(lds, C.tid, HN + (size_t)MP * DM, DM, (const bf16*)(wl + LW_Q), DM, DM, DM, G, bid, SEpiPart{(float*)(ws + WS_SPL), DM}, 2);
            SEAM(pb + 7);
        }
        if (IN(pb + 8)) { PHASE_CTX;
            if ((bid >> 3) & 1) { if (PM(14)) REP(14) for (int it = bid; it < NS * 4; it += G) xattn_sample_item(C, a, l, it); }
            if (PM(13)) REP(13) for (int it = bid; it < 256; it += G) xattn_prompt_unit(C, a, l, it);
            if (!((bid >> 3) & 1)) { if (PM(14)) REP(14) for (int it = bid; it < NS * 4; it += G) xattn_sample_item(C, a, l, it); }
            SEAM(pb + 8);
        }
        if (IN(pb + 9)) { PHASE_CTX; const unsigned char* wl = ws + WS_WL + (size_t)l * LW_STRIDE;
            pg8::Gemm g{OB, (const bf16*)(wl + LW_O), MP, DM, DM, DM, 64, (size_t)DM * 128}; pg8::StaticOrder S; S.init(MP, DM, G, bid); pg8::EpiRes E{XF, DM, ((DUP_MASK >> 9) & 1) ? 0.5f : 1.0f, XF};
            if (PM(17)) pg8::gemm_phase<pg8::EpiRes, pg8::StaticOrder, true, true>(lds, g, S, E, C.tid);
            if (PM(20)) sample_gemm(lds, C.tid, OB + (size_t)MP * DM, DM, (const bf16*)(wl + LW_O), DM, DM, DM, G, bid, SEpiRes{XF + (size_t)MP * DM, DM, ((DUP_MASK >> 9) & 1) ? 0.5f : 1.0f, XF + (size_t)MP * DM});
            SEAM(pb + 9);
        }
        if (IN(pb + 10)) { PHASE_CTX; if (PM(21)) REP(21) rms_phase(C, XF, HN); SEAM(pb + 10); }
        if (IN(pb + 11)) { PHASE_CTX; const unsigned char* wl = ws + WS_WL + (size_t)l * LW_STRIDE;
            pg8::Gemm g{HN, (const bf16*)(wl + LW_UP), MP, DFF, DM, DM, 64, (size_t)DFF * 128}; pg8::StaticOrder S; S.init(MP, DFF, G, bid); pg8::EpiBf16A<3> E{UB, LDU, nullptr};
            if (PM(18)) REP(18) pg8::gemm_phase<pg8::EpiBf16A<3>, pg8::StaticOrder, true, true>(lds, g, S, E, C.tid);
            if (PM(20)) sample_gemm(lds, C.tid, HN + (size_t)MP * DM, DM, (const bf16*)(wl + LW_UP), DFF, DFF, DM, G, bid, SEpiBf16{UB + (size_t)MP * LDU, LDU, 3, nullptr});
            SEAM(pb + 11);
        }
        if (IN(pb + 12)) { PHASE_CTX; const unsigned char* wl = ws + WS_WL + (size_t)l * LW_STRIDE;
            pg8::Gemm g{UB, (const bf16*)(wl + LW_DN), MP, DM, DFF, LDU, 64, (size_t)DM * 128}; pg8::StaticOrder S; S.init(MP, DM, G, bid); pg8::EpiRes E{XF, DM, ((DUP_MASK >> 12) & 1) ? 0.5f : 1.0f, XF};
            if (PM(19)) pg8::gemm_phase<pg8::EpiRes, pg8::StaticOrder, true, true>(lds, g, S, E, C.tid);
            if (PM(20)) sample_gemm(lds, C.tid, UB + (size_t)MP * LDU, LDU, (const bf16*)(wl + LW_DN), DM, DM, DFF, G, bid, SEpiPart{(float*)(ws + WS_SPL), DM}, 2);
            SEAM(pb + 12);
        }
        if (IN(pb + 13)) { PHASE_CTX;
            fold_split_rows(C, XF, (const float*)(ws + WS_SPL));
            if (!PM(21)) {} else if (l + 1 < DEPTH) REP(21) rms_phase(C, XF, HN); else final_norm_phase(C, XF, a.in(I_GFIN), a.out + O_YP);
            SEAM(pb + 13);
        }
    }
#undef IN
#undef SEAM
#undef SEAM2
#undef PHASE_CTX
}

extern "C" void kernel_launch(void* const* d_in, const int* in_sizes, int n_in, void* d_out, int out_size, void* d_ws, size_t ws_size, hipStream_t stream) {
    static int grid = 0;
    if (grid == 0) {
        if (n_in != NIN || (size_t)out_size != O_END || ws_size < WS_END) { fprintf(stderr, "kernel_launch: unexpected shapes (n_in %d, out %d, ws %zu); nothing launched\n", n_in, out_size, ws_size); grid = -1; return; }
        int dev = 0, cus = 0, per_cu = 0;
        if (hipGetDevice(&dev) != hipSuccess || hipDeviceGetAttribute(&cus, hipDeviceAttributeMultiprocessorCount, dev) != hipSuccess) { grid = -1; return; }
        if (hipFuncSetAttribute((const void*)fwd_kernel, hipFuncAttributeMaxDynamicSharedMemorySize, LDS_BYTES) != hipSuccess) { fprintf(stderr, "kernel_launch: hipFuncSetAttribute failed\n"); grid = -1; return; }
        if (hipOccupancyMaxActiveBlocksPerMultiprocessor(&per_cu, (const void*)fwd_kernel, NWAVES * 64, LDS_BYTES) != hipSuccess || per_cu < 1) { fprintf(stderr, "kernel_launch: occupancy query reports %d\n", per_cu); }
        (void)hipGetLastError();
        grid = cus;
    }
    if (grid < 0) return;
    if (hipMemsetAsync((char*)d_ws + WS_CTL, 0, CTL_ZERO_BYTES, stream) != hipSuccess) return;
    Args a{};
    for (int i = 0; i < NIN; ++i) a.in[i] = (const float*)d_in[i];
    a.out = (float*)d_out; a.ws = (unsigned char*)d_ws;
#if MK_ONE_LAUNCH
    a.ph_lo = 0; a.ph_hi = NPH;
    hipLaunchKernelGGL(fwd_kernel, dim3(grid), dim3(NWAVES * 64), LDS_BYTES, stream, a);
#else
#ifndef NPH_RUN
#define NPH_RUN NPH
#endif
    for (int ph = 0; ph < NPH_RUN; ++ph) { a.ph_lo = ph; a.ph_hi = ph + 1; hipLaunchKernelGGL(fwd_kernel, dim3(grid), dim3(NWAVES * 64), LDS_BYTES, stream, a);
        const int dbit = (ph == 0) ? 13 : (ph - 1) % PH_PER_LAYER;
        if ((DUP_MASK >> dbit) & 1) hipLaunchKernelGGL(fwd_kernel, dim3(grid), dim3(NWAVES * 64), LDS_BYTES, stream, a); }
#endif
}
```

```cpp
#include <hip/hip_runtime.h>
#include <cstdio>
#include <cstdint>
namespace pg8 {
#define PG8_LAS __attribute__((address_space(3)))
typedef unsigned short bf16_t;
typedef short bf16x8 __attribute__((ext_vector_type(8)));
typedef float f32x4 __attribute__((ext_vector_type(4)));
typedef unsigned u32x4 __attribute__((ext_vector_type(4)));
constexpr int BM = 256, BK = 64, HALF = 128, HTB = HALF * BK * 2  , STAGE_BYTES = 8 * HTB, NXCD = 8, WGM = 8;

__host__ __device__ __forceinline__ int lds_byte(int r, int c) { const int st = (r >> 4) * 2 + (c >> 5), rr = r & 15, cc = c & 31, ob = rr * 64 + cc * 2; return st * 1024 + (ob ^ (((ob >> 9) & 1) << 5)); }
__host__ __device__ __forceinline__ void stage_rc(int b, int& R, int& C) { const int st = b / 1024, sb = b % 1024, swz = sb ^ (((sb >> 9) & 1) << 5); R = (st >> 1) * 16 + swz / 64; C = (st & 1) * 32 + (swz % 64) / 2; }
__host__ __device__ __forceinline__ int perm32(int rho) { const int n = rho >> 4, i = rho & 15; return 8 * (i >> 2) + 4 * n + (i & 3); }

struct Unit { int pm, pn; };
struct Gemm { const bf16_t* A; const bf16_t* Bt; int M, N, K, lda, ldb; size_t ksb; };

struct StaticOrder {
    int nM, nN, nwg, G, c;
    __host__ __device__ void init(int M, int N, int G_, int c_) { nM = M / BM; nN = N / BM; nwg = nM * nN; G = G_; c = c_; }
    __host__ __device__ bool next(int i, Unit& u) const {
        const long L = (long)i * G + c; if (L >= nwg) return false;
        int wgid = (int)L; { const int q = nwg / NXCD, r = nwg % NXCD, xcd = wgid % NXCD, off = wgid / NXCD; wgid = (xcd < r ? xcd * (q + 1) : r * (q + 1) + (xcd - r) * q) + off; }
        const int nig = WGM * nN, gid = wgid / nig, fm = gid * WGM, gsz = (nM - fm) < WGM ? (nM - fm) : WGM;
        u.pm = fm + ((wgid % nig) % gsz); u.pn = (wgid % nig) / gsz; return true;
    }
    __device__ __forceinline__ void a_ready(const Unit&) const {}
    __device__ __forceinline__ void done(const Unit&) const {}
};

typedef float f32x2_cv __attribute__((ext_vector_type(2)));
typedef __bf16 bf16x2_cv __attribute__((ext_vector_type(2)));
__device__ __forceinline__ unsigned cvt_pk_bf16(float lo, float hi) { const f32x2_cv v = {lo, hi}; return __builtin_bit_cast(unsigned, __builtin_convertvector(v, bf16x2_cv)); }
typedef float f32x2 __attribute__((ext_vector_type(2)));
template <class Epi, class Sched, bool ALIGN_EPI = false, bool SP2 = false>
__device__ __forceinline__ void gemm_phase(PG8_LAS unsigned char* lds, const Gemm g, const Sched& S, const Epi& E, int tid_in) {
    int tid_ = tid_in; asm volatile("" : "+v"(tid_));
    const int tid = tid_, wid = __builtin_amdgcn_readfirstlane(tid >> 6), lane = tid & 63, wr = wid >> 2, wc = wid & 3, fr = lane & 15, fq = lane >> 4;
    const int K = g.K, nt = K / BK;
    unsigned voffA[2], voffB[2];
#pragma unroll
    for (int i = 0; i < 2; ++i) { int R, C; stage_rc(tid * 16 + i * 8192, R, C); const int Rb = Epi::PERM ? ((R & ~31) + perm32(R & 31)) : R;
        voffA[i] = (unsigned)(R * g.lda + C) * 2u; voffB[i] = (unsigned)(Rb * g.ldb + C) * 2u; }
    const size_t kstep = (size_t)(BK * 2), kstepB = g.ksb;
    const size_t hstepA = (size_t)HALF * g.lda * 2, hstepB = (size_t)HALF * g.ldb * 2;
    const size_t tstepA = 2 * hstepA, tstepB = 2 * hstepB;
    const unsigned ldsw = (unsigned)wid * 1024u;
    const int aoff = lds_byte(wr * 64 + fr, fq * 8), boff = lds_byte(wc * 32 + fr, fq * 8);
#define PG8_SA(b, h) (((b) * 2 + (h)) * HTB)
#define PG8_SB(b, h) ((4 + (b) * 2 + (h)) * HTB)
#define PG8_STAGE(bufoff, gbase, voff) do { _Pragma("unroll") for (int _i = 0; _i < 2; ++_i) \
        __builtin_amdgcn_global_load_lds((const unsigned*)((const char*)(gbase) + (voff)[_i]), (PG8_LAS unsigned*)(lds + (bufoff) + ldsw + _i * 8192), 16, 0, 0); } while (0)
#define PG8_LDA(dst, b, h) do { _Pragma("unroll") for (int m = 0; m < 4; ++m) _Pragma("unroll") for (int k = 0; k < 2; ++k) dst[m][k] = *(const PG8_LAS bf16x8*)(lds + PG8_SA(b, h) + aoff + m * 2048 + k * 1024); } while (0)
#define PG8_LDB(dst, b, h) do { _Pragma("unroll") for (int n = 0; n < 2; ++n) _Pragma("unroll") for (int k = 0; k < 2; ++k) dst[n][k] = *(const PG8_LAS bf16x8*)(lds + PG8_SB(b, h) + boff + n * 2048 + k * 1024); } while (0)
#define PG8_MMA(ai, bj, At, Bt) do { __builtin_amdgcn_s_setprio(1); _Pragma("unroll") for (int m = 0; m < 4; ++m) _Pragma("unroll") for (int n = 0; n < 2; ++n) _Pragma("unroll") for (int k = 0; k < 2; ++k) \
        acc[ai][bj][m][n] = __builtin_amdgcn_mfma_f32_16x16x32_bf16(Bt[n][k], At[m][k], acc[ai][bj][m][n], 0, 0, 0); __builtin_amdgcn_s_setprio(0); } while (0)
#define PG8_WAIT_V(n) asm volatile("s_waitcnt vmcnt(" #n ")" ::: "memory")
#define PG8_WAIT_L(n) asm volatile("s_waitcnt lgkmcnt(" #n ")" ::: "memory")
#define PG8_BAR __builtin_amdgcn_s_barrier()
#define PG8_SCHED __builtin_amdgcn_sched_barrier(0)
    Unit cur, nxt; int ui = 0;
    if (!S.next(0, cur)) return;
    f32x4 acc[2][2][4][2];
#pragma unroll
    for (int a = 0; a < 2; ++a)
#pragma unroll
        for (int b = 0; b < 2; ++b)
#pragma unroll
            for (int m = 0; m < 4; ++m)
#pragma unroll
                for (int n = 0; n < 2; ++n) acc[a][b][m][n] = (f32x4){0.f, 0.f, 0.f, 0.f};
    bf16x8 At[4][2], B0[2][2], B1[2][2];
    const char* cA = (const char*)g.A + (size_t)cur.pm * tstepA; const char* cB = (const char*)g.Bt + (size_t)cur.pn * tstepB;
    S.a_ready(cur);
    if constexpr (SP2) {
        PG8_STAGE(PG8_SB(0, 0), cB, voffB); PG8_STAGE(PG8_SB(0, 1), cB + hstepB, voffB); PG8_STAGE(PG8_SA(0, 0), cA, voffA); PG8_STAGE(PG8_SA(0, 1), cA + hstepA, voffA);
        if (wr == 1) PG8_BAR;
        PG8_WAIT_V(2); PG8_BAR;
        PG8_STAGE(PG8_SB(1, 0), cB + kstepB, voffB); PG8_STAGE(PG8_SA(1, 0), cA + kstep, voffA); PG8_STAGE(PG8_SB(1, 1), cB + hstepB + kstepB, voffB);
        PG8_WAIT_V(6); PG8_BAR;
    } else {
        PG8_STAGE(PG8_SB(0, 0), cB, voffB); PG8_STAGE(PG8_SA(0, 0), cA, voffA); PG8_STAGE(PG8_SB(0, 1), cB + hstepB, voffB); PG8_STAGE(PG8_SA(0, 1), cA + hstepA, voffA);
        if (wr == 1) PG8_BAR;
        PG8_WAIT_V(4); PG8_BAR;
        PG8_STAGE(PG8_SB(1, 0), cB + kstepB, voffB); PG8_STAGE(PG8_SA(1, 0), cA + kstep, voffA); PG8_STAGE(PG8_SB(1, 1), cB + hstepB + kstepB, voffB);
        PG8_WAIT_V(6); PG8_BAR;
    }
    for (;;) {
        const bool has_next = S.next(ui + 1, nxt);
        const char* nA = has_next ? (const char*)g.A + (size_t)nxt.pm * tstepA : cA; const char* nB = has_next ? (const char*)g.Bt + (size_t)nxt.pn * tstepB : cB;
        for (int t = 0; t < nt; t += 2) {
            const bool last = (t == nt - 2);
            const char* a1 = cA + (size_t)(t + 1) * kstep;
            const char* a2 = last ? nA : cA + (size_t)(t + 2) * kstep; const char* b2 = last ? nB : cB + (size_t)(t + 2) * kstepB;
            const char* a3 = a2 + kstep; const char* b3 = b2 + kstepB;
            if (last && has_next) S.a_ready(nxt);
            if constexpr (SP2) {
            PG8_LDB(B0, 0, 0); PG8_LDB(B1, 0, 1); PG8_SCHED; PG8_LDA(At, 0, 0); PG8_STAGE(PG8_SA(1, 1), a1 + hstepA, voffA);
            PG8_WAIT_V(8); PG8_WAIT_L(0); PG8_BAR; PG8_MMA(0, 0, At, B0); PG8_MMA(0, 1, At, B1); PG8_BAR; PG8_SCHED;
            PG8_LDA(At, 0, 1); PG8_STAGE(PG8_SB(0, 0), b2, voffB); PG8_STAGE(PG8_SB(0, 1), b2 + hstepB, voffB); PG8_STAGE(PG8_SA(0, 0), a2, voffA);
            PG8_WAIT_V(8); PG8_WAIT_L(0); PG8_BAR; PG8_MMA(1, 0, At, B0); PG8_MMA(1, 1, At, B1); PG8_BAR; PG8_SCHED;
            PG8_LDB(B0, 1, 0); PG8_LDB(B1, 1, 1); PG8_SCHED; PG8_LDA(At, 1, 0); PG8_STAGE(PG8_SA(0, 1), a2 + hstepA, voffA);
            PG8_WAIT_V(8); PG8_WAIT_L(0); PG8_BAR; PG8_MMA(0, 0, At, B0); PG8_MMA(0, 1, At, B1); PG8_BAR; PG8_SCHED;
            PG8_LDA(At, 1, 1); PG8_STAGE(PG8_SB(1, 0), b3, voffB); PG8_STAGE(PG8_SB(1, 1), b3 + hstepB, voffB); PG8_STAGE(PG8_SA(1, 0), a3, voffA);
            PG8_WAIT_V(8); PG8_WAIT_L(0); PG8_BAR; PG8_MMA(1, 0, At, B0); PG8_MMA(1, 1, At, B1); PG8_BAR; PG8_SCHED;
            } else {
            PG8_LDB(B0, 0, 0); PG8_SCHED; PG8_LDA(At, 0, 0); PG8_STAGE(PG8_SA(1, 1), a1 + hstepA, voffA);
            PG8_WAIT_L(8); PG8_BAR; PG8_WAIT_L(0); PG8_MMA(0, 0, At, B0); PG8_BAR; PG8_SCHED;
            PG8_LDB(B1, 0, 1); PG8_STAGE(PG8_SB(0, 0), b2, voffB);
            PG8_BAR; PG8_WAIT_L(0); PG8_MMA(0, 1, At, B1); PG8_BAR;
            PG8_LDA(At, 0, 1); PG8_STAGE(PG8_SA(0, 0), a2, voffA);
            PG8_BAR; PG8_WAIT_L(0); PG8_MMA(1, 0, At, B0); PG8_BAR; PG8_SCHED;
            PG8_STAGE(PG8_SB(0, 1), b2 + hstepB, voffB);
            PG8_WAIT_V(6); PG8_BAR; PG8_MMA(1, 1, At, B1); PG8_BAR;
            PG8_LDB(B0, 1, 0); PG8_SCHED; PG8_LDA(At, 1, 0); PG8_STAGE(PG8_SA(0, 1), a2 + hstepA, voffA);
            PG8_WAIT_L(8); PG8_BAR; PG8_WAIT_L(0); PG8_MMA(0, 0, At, B0); PG8_BAR; PG8_SCHED;
            PG8_LDB(B1, 1, 1); PG8_STAGE(PG8_SB(1, 0), b3, voffB);
            PG8_BAR; PG8_WAIT_L(0); PG8_MMA(0, 1, At, B1); PG8_BAR;
            PG8_LDA(At, 1, 1); PG8_STAGE(PG8_SA(1, 0), a3, voffA);
            PG8_BAR; PG8_WAIT_L(0); PG8_MMA(1, 0, At, B0); PG8_BAR; PG8_SCHED;
            PG8_STAGE(PG8_SB(1, 1), b3 + hstepB, voffB);
            PG8_WAIT_V(6); PG8_BAR; PG8_MMA(1, 1, At, B1); PG8_BAR;
            }
        }
        if constexpr (ALIGN_EPI) { if (wr == 0) PG8_BAR; }
        if constexpr (!Epi::AFTER_DRAIN) { E(acc, cur, wr, wc, fr, fq); S.done(cur); }
        if (!has_next) break;
#pragma unroll
        for (int a = 0; a < 2; ++a)
#pragma unroll
            for (int b = 0; b < 2; ++b)
#pragma unroll
                for (int m = 0; m < 4; ++m)
#pragma unroll
                    for (int n = 0; n < 2; ++n) acc[a][b][m][n] = (f32x4){0.f, 0.f, 0.f, 0.f};
        cur = nxt; cA = nA; cB = nB; ++ui;
        if constexpr (ALIGN_EPI) { if (wr == 1) PG8_BAR; }
    }
    PG8_WAIT_V(0);
    if constexpr (!ALIGN_EPI) { if (wr == 0) PG8_BAR; }
    PG8_BAR;
    if constexpr (Epi::AFTER_DRAIN) { E.fused(acc, cur, wr, wc, fr, fq, lds, wid, lane); S.done(cur); }
#undef PG8_SA
#undef PG8_SB
#undef PG8_STAGE
#undef PG8_LDA
#undef PG8_LDB
#undef PG8_MMA
#undef PG8_WAIT_V
#undef PG8_WAIT_L
#undef PG8_BAR
#undef PG8_SCHED
}
}

constexpr int DM = 2048, SEQ = 2048, NB = 4, NS = 128, DEPTH = 2;
constexpr int MP = NB * SEQ;
constexpr int MT = MP + NS;
constexpr int MPAD = MP + 256;
constexpr int PIN = 6400, DFF = 8192, NMEM = 256, MMEM = NB * NMEM;
constexpr int PB_ = 1536, PC_ = 3584, PD_ = 5376;
constexpr int SHW = 1792;
constexpr int LDU = 8192;
constexpr int NWAVES = 8;
constexpr int NIN = 39;

constexpr size_t O_YP = 0, O_YS = O_YP + (size_t)MP * DM, O_CAP = O_YS + (size_t)NS * DM, O_CAS = O_CAP + (size_t)DEPTH * NB * 2 * 512,
    O_RETP = O_CAS + (size_t)DEPTH * NS * 2 * 512, O_RETS = O_RETP + (size_t)DEPTH * NB * 4 * 128 * 128, O_SHP = O_RETS + (size_t)DEPTH * NS * 4 * 128 * 128,
    O_SHS = O_SHP + (size_t)DEPTH * NB * SHW, O_WKVP = O_SHS + (size_t)DEPTH * NS * SHW, O_WKVS = O_WKVP + (size_t)DEPTH * NB * 8 * 64 * 64,
    O_CDP = O_WKVS + (size_t)DEPTH * NS * 8 * 64 * 64, O_CDS = O_CDP + (size_t)DEPTH * NB * 30 * 512, O_MKP = O_CDS + (size_t)DEPTH * NS * 30 * 512,
    O_MVP = O_MKP + (size_t)DEPTH * MMEM * DM, O_END = O_MVP + (size_t)DEPTH * MMEM * DM;
static_assert(O_END == 56178688, "d_out size");

constexpr size_t MiB = 1u << 20;
constexpr size_t al256(size_t x) { return (x + 255) & ~(size_t)255; }
constexpr size_t WS_CTL = 0, CTL_ZERO_BYTES = 1 * MiB;
constexpr size_t WS_ROPE = 1 * MiB;
constexpr size_t SZ_WIN = (size_t)PIN * DM * 2, SZ_SQ = (size_t)DM * DM * 2, SZ_WUP = (size_t)DFF * DM * 2, SZ_WDN = (size_t)DM * LDU * 2;
constexpr size_t LW_IN = 0, LW_OUT = LW_IN + SZ_WIN, LW_Q = LW_OUT + SZ_SQ, LW_O = LW_Q + SZ_SQ, LW_UP = LW_O + SZ_SQ, LW_DN = LW_UP + SZ_WUP,
    LW_W2 = LW_DN + SZ_WDN, LW_A2 = LW_W2 + 512 * 64 * 2, LW_G2 = LW_A2 + 512 * 64 * 2, LW_STRIDE = LW_G2 + 512 * 128 * 2;
constexpr size_t WS_WL = 4 * MiB;
constexpr size_t WS_WKV = al256(WS_WL + 2 * LW_STRIDE);
constexpr size_t WS_XF = al256(WS_WKV + (size_t)8192 * DM * 2);
constexpr size_t WS_HN = al256(WS_XF + (size_t)MT * DM * 4);
constexpr size_t WS_MN = al256(WS_HN + (size_t)MPAD * DM * 2);
constexpr size_t WS_MK = al256(WS_MN + (size_t)MMEM * DM * 2);
constexpr size_t WS_MVT = al256(WS_MK + (size_t)2 * MMEM * DM * 2);
constexpr size_t WS_P = al256(WS_MVT + (size_t)2 * MMEM * DM * 2);
constexpr size_t WS_YC = al256(WS_P + (size_t)MPAD * PIN * 2);
constexpr size_t WS_Q = al256(WS_YC + (size_t)MT * DM * 2);
constexpr size_t WS_O = al256(WS_Q + (size_t)MT * DM * 2);
constexpr size_t WS_U = al256(WS_O + (size_t)MT * DM * 2);
constexpr size_t WS_RW = al256(WS_U + (size_t)MT * LDU * 2);
constexpr size_t WS_GATE = al256(WS_RW + (size_t)MT * 8 * 896);
constexpr size_t WS_OC = al256(WS_GATE + (size_t)MT * 512 * 4);
constexpr size_t WS_KVT = al256(WS_OC + (size_t)MT * 512 * 4);
constexpr size_t WS_SSQ = al256(WS_KVT + (size_t)16 * 16 * 128 * 128 * 4);
constexpr size_t WS_SPL = al256(WS_SSQ + (size_t)MP * 8 * 4);
constexpr size_t WS_STB = al256(WS_SPL + (size_t)2 * NS * DM * 4);
constexpr size_t WS_CK = al256(WS_STB + (size_t)16 * 16 * 128 * 128 * 2);
constexpr size_t WS_CP = al256(WS_CK + (size_t)4096 * 6912);
constexpr size_t WS_END = al256(WS_CP + (size_t)4096 * 4 * 3072);
static_assert(WS_END < (size_t)1700 * MiB, "d_ws map");
constexpr int CW_BAR = 4096;

constexpr int SCR_BYTES = 147456;
constexpr int MISC_OFF = SCR_BYTES;
constexpr int LDS_BYTES = SCR_BYTES + 1024;

#define GAS __attribute__((address_space(1)))
#define LAS __attribute__((address_space(3)))
typedef unsigned short bf16;
typedef unsigned v4u __attribute__((ext_vector_type(4)));
typedef unsigned v2u __attribute__((ext_vector_type(2)));
typedef float f32x4 __attribute__((ext_vector_type(4)));
typedef float f32x2 __attribute__((ext_vector_type(2)));
typedef short bf16x8 __attribute__((ext_vector_type(8)));
typedef short bf16x4 __attribute__((ext_vector_type(4)));
typedef GAS unsigned gu32;
#define RLX_AGENT __ATOMIC_RELAXED, __HIP_MEMORY_SCOPE_AGENT
#define LDS_WAIT() asm volatile("s_waitcnt lgkmcnt(0)" ::: "memory")
#define VM_WAIT() asm volatile("s_waitcnt vmcnt(0)" ::: "memory")
__device__ __forceinline__ unsigned pk2(float lo, float hi) { return pg8::cvt_pk_bf16(lo, hi); }
__device__ __forceinline__ float bflo(unsigned w) { return __uint_as_float(w << 16); }
__device__ __forceinline__ float bfhi(unsigned w) { return __uint_as_float(w & 0xffff0000u); }
__device__ __forceinline__ float bf1(bf16 h) { return __uint_as_float(((unsigned)h) << 16); }
__device__ __forceinline__ void unpack8(const v4u w, float (&f)[8]) { f[0] = bflo(w.x); f[1] = bfhi(w.x); f[2] = bflo(w.y); f[3] = bfhi(w.y); f[4] = bflo(w.z); f[5] = bfhi(w.z); f[6] = bflo(w.w); f[7] = bfhi(w.w); }
__device__ __forceinline__ void unpack4(const v2u w, float (&f)[4]) { f[0] = bflo(w.x); f[1] = bfhi(w.x); f[2] = bflo(w.y); f[3] = bfhi(w.y); }
__device__ __forceinline__ v4u pack8(const float (&f)[8]) { v4u w; w.x = pk2(f[0], f[1]); w.y = pk2(f[2], f[3]); w.z = pk2(f[4], f[5]); w.w = pk2(f[6], f[7]); return w; }
__device__ __forceinline__ float sigm(float x) { return 1.0f / (1.0f + __expf(-x)); }
__device__ __forceinline__ float wave_sum(float v) {
#pragma unroll
    for (int o = 1; o < 64; o <<= 1) v += __shfl_xor(v, o);
    return v;
}
__device__ __forceinline__ float wave_max(float v) {
#pragma unroll
    for (int o = 1; o < 64; o <<= 1) v = fmaxf(v, __shfl_xor(v, o));
    return v;
}
template <int CTRL> __device__ __forceinline__ float dpp_f(float v) { return __builtin_bit_cast(float, __builtin_amdgcn_update_dpp(0, __builtin_bit_cast(int, v), CTRL, 0xf, 0xf, false)); }
__device__ __forceinline__ f32x4 zero4() { f32x4 z = (f32x4){0.f, 0.f, 0.f, 0.f}; asm volatile("" : "+v"(z)); return z; }
__device__ __forceinline__ float rowsum16(float v) { v += dpp_f<0x128>(v); v += dpp_f<0x124>(v); v += dpp_f<0x122>(v); v += dpp_f<0x121>(v); return v; }

namespace pg8 {
template <int ACT> struct EpiBf16A {
    static constexpr bool PERM = true, AFTER_DRAIN = false;
    bf16_t* O; int ldc; const float* ssq;
    __device__ __forceinline__ void operator()(const f32x4 (&acc)[2][2][4][2], const Unit& u, int wr, int wc, int fr, int fq) const {
        const int row0 = u.pm * BM + wr * 64 + fr, col0 = u.pn * BM + wc * 32 + 8 * fq;
#pragma unroll
        for (int ai = 0; ai < 2; ++ai)
#pragma unroll
            for (int m = 0; m < 4; ++m) { bf16_t* rowp = O + (size_t)(row0 + ai * HALF + m * 16) * ldc + col0;
                const float rs = ssq ? 1.0f / sqrtf(ssq[row0 + ai * HALF + m * 16] * (1.0f / 2048.0f) + 1e-6f) : 1.0f;
#pragma unroll
                for (int bj = 0; bj < 2; ++bj) { f32x4 v0 = acc[ai][bj][m][0] * rs, v1 = acc[ai][bj][m][1] * rs;
                    if (ACT == 3) {
#pragma unroll
                        for (int j = 0; j < 4; ++j) { const float a = fmaxf(v0[j], 0.f), b = fmaxf(v1[j], 0.f); v0[j] = a * a; v1[j] = b * b; } }
                    u32x4 w; w.x = cvt_pk_bf16(v0[0], v0[1]); w.y = cvt_pk_bf16(v0[2], v0[3]); w.z = cvt_pk_bf16(v1[0], v1[1]); w.w = cvt_pk_bf16(v1[2], v1[3]);
                    *(u32x4*)(rowp + bj * HALF) = w; } }
    }
};
struct EpiRes {
    static constexpr bool PERM = false, AFTER_DRAIN = false;
    float* X; int ldc; float sc; const float* Xin;
    __device__ __forceinline__ void operator()(const f32x4 (&acc)[2][2][4][2], const Unit& u, int wr, int wc, int fr, int fq) const {
        const int row0 = u.pm * BM + wr * 64 + fr, col0 = u.pn * BM + wc * 32 + 4 * fq;
#pragma unroll
        for (int ai = 0; ai < 2; ++ai)
#pragma unroll
            for (int m = 0; m < 4; ++m) { float* rowp = X + (size_t)(row0 + ai * HALF + m * 16) * ldc + col0; const float* inp = Xin + (size_t)(row0 + ai * HALF + m * 16) * ldc + col0;
                f32x4 o[2][2];
#pragma unroll
                for (int bj = 0; bj < 2; ++bj)
#pragma unroll
                    for (int n = 0; n < 2; ++n) o[bj][n] = *(const f32x4*)(inp + bj * HALF + n * 16);
#pragma unroll
                for (int bj = 0; bj < 2; ++bj)
#pragma unroll
                    for (int n = 0; n < 2; ++n) *(f32x4*)(rowp + bj * HALF + n * 16) = o[bj][n] + acc[ai][bj][m][n] * sc; }
    }
};
struct EpiMemKV {
    static constexpr bool PERM = false, AFTER_DRAIN = false;
    float* outK; bf16_t* MKb; bf16_t* MVT;
    __device__ __forceinline__ void operator()(const f32x4 (&acc)[2][2][4][2], const Unit& u, int wr, int wc, int fr, int fq) const {
        const int cbase = u.pn * BM, lyr = cbase >> 12, cc = cbase & 4095; const bool isV = cc >= 2048; const int colt = cc & 2047;
        const int row0 = u.pm * BM + wr * 64 + fr, col0 = colt + wc * 32 + 4 * fq;
        float* outp = outK + (isV ? (size_t)(O_MVP - O_MKP) : (size_t)0);
#pragma unroll
        for (int ai = 0; ai < 2; ++ai)
#pragma unroll
            for (int m = 0; m < 4; ++m) { const int r = row0 + ai * HALF + m * 16;
#pragma unroll
                for (int bj = 0; bj < 2; ++bj)
#pragma unroll
                    for (int n = 0; n < 2; ++n) { const int col = col0 + bj * HALF + n * 16; const f32x4 v = acc[ai][bj][m][n];
                        *(f32x4*)(outp + ((size_t)lyr * 1024 + r) * 2048 + col) = v;
                        if (!isV) { unsigned lo = cvt_pk_bf16(v[0], v[1]), hi = cvt_pk_bf16(v[2], v[3]); *(unsigned long long*)(MKb + ((size_t)lyr * 1024 + r) * 2048 + col) = ((unsigned long long)hi << 32) | lo; }
                        else { const int b = r >> 8, j = r & 255, h = col >> 9, e = col & 511; bf16_t* tp = MVT + ((((size_t)lyr * 4 + b) * 4 + h) * 512 + e) * 256 + j;
                            const unsigned lo = cvt_pk_bf16(v[0], v[1]), hi = cvt_pk_bf16(v[2], v[3]);
                            tp[0] = (bf16_t)(lo & 0xffffu); tp[256] = (bf16_t)(lo >> 16); tp[512] = (bf16_t)(hi & 0xffffu); tp[768] = (bf16_t)(hi >> 16); } } }
    }
};
}

struct SEpiBf16 { bf16* O; int ldc; int act; const float* ssq;
    __device__ __forceinline__ void operator()(int row, int col0, f32x4 v, int) const {
        if (ssq) v = v * (1.0f / sqrtf(ssq[row] * (1.0f / 2048.0f) + 1e-6f));
        if (act == 3) {
#pragma unroll
            for (int j = 0; j < 4; ++j) { const float a = fmaxf(v[j], 0.f); v[j] = a * a; } }
        v2u w; w.x = pk2(v[0], v[1]); w.y = pk2(v[2], v[3]); *(v2u*)(O + (size_t)row * ldc + col0) = w; } };
struct SEpiRes { float* X; int ldc; float sc; const float* Xin;
    __device__ __forceinline__ void operator()(int row, int col0, f32x4 v, int) const { *(f32x4*)(X + (size_t)row * ldc + col0) = *(const f32x4*)(Xin + (size_t)row * ldc + col0) + v * sc; } };
struct SEpiPart { float* S; int ldc;
    __device__ __forceinline__ void operator()(int row, int col0, f32x4 v, int kp) const { *(f32x4*)(S + ((size_t)kp * NS + row) * ldc + col0) = v; } };
template <class F> __device__ __forceinline__ void sample_gemm(LAS unsigned char* lds, int tid_in, const bf16* A, int lda, const bf16* Bt, int ntot, int N, int K, int G, int bid, const F& epi, int nks = 1) {
    int tid_ = tid_in; asm volatile("" : "+v"(tid_));
    const int lane = tid_ & 63, wave = __builtin_amdgcn_readfirstlane(tid_ >> 6), fr = lane & 15, fq = lane >> 4;
    const int KS = (K / nks) >> 3, ncu = N / 16;
    LAS f32x4* red = (LAS f32x4*)lds;
    const unsigned voffa = (unsigned)(fr * lda + fq * 8) * 2u, voffb = (unsigned)(fr * 64 + fq * 8) * 2u;
    for (int uu = bid; uu < ncu * nks; uu += G) { const int kp = uu / ncu, u = uu - kp * ncu, kbeg = kp * (K / nks) + wave * KS;
        const char* bp = (const char*)(Bt + ((size_t)(kbeg >> 6) * ntot + u * 16) * 64);
        const char* ap = (const char*)(A + kbeg);
        f32x4 acc[8];
#pragma unroll
        for (int rt = 0; rt < 8; ++rt) acc[rt] = zero4();
        bf16x8 b0[2], a0[2][8], b1[2], a1[2][8];
#define SG_LOAD(bb, aa, kq) do { _Pragma("unroll") for (int s = 0; s < 2; ++s) { bb[s] = *(const bf16x8*)(bp + ((size_t)((kq) >> 6) * ntot * 64 + 32 * s) * 2 + voffb); \
            _Pragma("unroll") for (int rt = 0; rt < 8; ++rt) aa[s][rt] = *(const bf16x8*)(ap + ((size_t)rt * 16 * lda + (kq) + 32 * s) * 2 + voffa); } } while (0)
#define SG_MMA(bb, aa) do { _Pragma("unroll") for (int s = 0; s < 2; ++s) _Pragma("unroll") for (int rt = 0; rt < 8; ++rt) acc[rt] = __builtin_amdgcn_mfma_f32_16x16x32_bf16(bb[s], aa[s][rt], acc[rt], 0, 0, 0); } while (0)
        SG_LOAD(b0, a0, 0);
        for (int k0 = 0; k0 < KS; k0 += 128) {
            SG_LOAD(b1, a1, k0 + 64);
            SG_MMA(b0, a0);
            if (k0 + 128 < KS) SG_LOAD(b0, a0, k0 + 128);
            SG_MMA(b1, a1);
        }
#undef SG_LOAD
#undef SG_MMA
#pragma unroll
        for (int rt = 0; rt < 8; ++rt) red[(wave * 8 + rt) * 64 + lane] = acc[rt];
        __syncthreads();
        f32x4 sum = red[wave * 64 + lane];
#pragma unroll
        for (int ks = 1; ks < 8; ++ks) sum += red[(ks * 8 + wave) * 64 + lane];
        epi(wave * 16 + fr, u * 16 + 4 * fq, sum, kp);
        __syncthreads();
    }
}
#define XB_TMO      128
#define XB_XCNT(j)  (256  + 64 * (j))
#define XB_XSUB(j)  (1280 + 64 * (j))
#define XB_XGEN(j)  (2304 + 64 * (j))
#define XB_TOP      3328
#define XB_TOPGEN   3392
#define XCD_BAR_WORDS 3456
#define XB_SPIN_CAP (1u << 18)

__device__ __forceinline__ unsigned xb_ld(unsigned* p)              { return __hip_atomic_load(p, __ATOMIC_RELAXED, __HIP_MEMORY_SCOPE_AGENT); }
__device__ __forceinline__ unsigned xb_add(unsigned* p, unsigned v) { return __hip_atomic_fetch_add(p, v, __ATOMIC_RELAXED, __HIP_MEMORY_SCOPE_AGENT); }
__device__ __forceinline__ unsigned xb_xcc_id() { return (unsigned)__builtin_amdgcn_s_getreg((3 << 11) | 20) & 0xFu; }
#define XB_SPIN(cond, bar) do { unsigned _sp = 0; while (cond) { __builtin_amdgcn_s_sleep(1); \
    if ((++_sp & 255u) == 0u) { if (xb_ld(&(bar)[XB_TMO])) break; if (_sp > XB_SPIN_CAP) { atomicAdd(&(bar)[XB_TMO], 1u); break; } } } } while (0)

struct XcdBarrier {
    int wave;
    unsigned* bar; unsigned x;
    volatile LAS unsigned* st;
};

__device__ __forceinline__ XcdBarrier xcd_barrier_post(unsigned* bar, volatile LAS unsigned* st) {
    XcdBarrier b; b.bar = bar; b.x = xb_xcc_id(); b.st = st;
    if (threadIdx.x == 0) (void)xb_add(&bar[XB_XCNT(b.x)], 1u);
    return b;
}
__device__ __forceinline__ void xcd_barrier_complete(unsigned* bar, unsigned x, unsigned& nloc, unsigned& nx) {
    const unsigned G = gridDim.x * gridDim.y * gridDim.z;
    unsigned sum, cnt, mine, sp = 0u;
    for (;;) {
        sum = 0u; cnt = 0u; mine = 0u;
#pragma unroll
        for (unsigned j = 0; j < 16; ++j) { const unsigned c = xb_ld(&bar[XB_XCNT(j)]); sum += c; cnt += (c > 0u) ? 1u : 0u; mine = (j == x) ? c : mine; }
        if (sum == G) break;
        __builtin_amdgcn_s_sleep(1);
        if ((++sp & 255u) == 0u) { if (xb_ld(&bar[XB_TMO])) break; if (sp > XB_SPIN_CAP) { atomicAdd(&bar[XB_TMO], 1u); break; } }
    }
    nloc = mine > 0u ? mine : 1u; nx = cnt > 0u ? cnt : 1u;
}

__device__ __forceinline__ void xcd_barrier(const XcdBarrier& b) {
    asm volatile("s_waitcnt vmcnt(0)" ::: "memory");
    __syncthreads();
    unsigned xbz = 0u; asm volatile("" : "+v"(xbz));
    if (b.wave == 0 && __builtin_amdgcn_mbcnt_hi(~0u, __builtin_amdgcn_mbcnt_lo(~0u, xbz)) == 0u) {
        unsigned* bar = b.bar;
        __builtin_amdgcn_s_waitcnt(0);
        unsigned nloc = b.st[0], nx = b.st[1];
        if (nloc == 0u) { xcd_barrier_complete(bar, b.x, nloc, nx); b.st[0] = nloc; b.st[1] = nx; }
        const unsigned old = xb_add(&bar[XB_XSUB(b.x)], 1u);
        const unsigned gen = old / nloc;
        if (old + 1u == (gen + 1u) * nloc) {
            __builtin_amdgcn_fence(__ATOMIC_RELEASE, "agent");
            asm volatile("s_waitcnt vmcnt(0)" ::: "memory");
            const unsigned og = xb_add(&bar[XB_TOP], 1u);
            const unsigned tg = og / nx;
            if (og + 1u == (tg + 1u) * nx) xb_add(&bar[XB_TOPGEN], 1u);
            else XB_SPIN(xb_ld(&bar[XB_TOPGEN]) == tg, bar);
            __builtin_amdgcn_fence(__ATOMIC_ACQUIRE, "agent");
            xb_add(&bar[XB_XGEN(b.x)], 1u);
            asm volatile("s_waitcnt vmcnt(0)" ::: "memory");
        } else {
            XB_SPIN(xb_ld(&bar[XB_XGEN(b.x)]) == gen, bar);
            __builtin_amdgcn_fence(__ATOMIC_ACQUIRE, "agent");
            asm volatile("s_waitcnt vmcnt(0)" ::: "memory");
        }
    }
    __syncthreads();
}

struct Args { const float* in[NIN]; float* out; unsigned char* ws; int ph_lo, ph_hi; };
enum { I_XP = 0, I_XS, I_MEM, I_SCA, I_SRET, I_SSH, I_SWKV, I_SCD, I_CMK, I_CMV, I_GMIX, I_WIN, I_CAW, I_MU, I_W0, I_W2, I_A0, I_A2, I_G2, I_KK, I_KA, I_RK, I_LNXG, I_LNXB,
       I_CDW, I_CDB, I_LNDG, I_LNDB, I_WOUT, I_GXA, I_GMEM, I_WQ, I_WK, I_WV, I_WO, I_GMLP, I_WUP, I_WDN, I_GFIN };

struct Ctx { LAS unsigned char* lds; int tid, lane, wave, G, bid; };
typedef const GAS float* gcfp;
#define CAS __attribute__((address_space(4)))
struct Ax { const CAS gcfp* kp; float* out; unsigned char* ws;
    __device__ __forceinline__ const float* in(int i) const { return (const float*)kp[i]; } };
__device__ __forceinline__ Ax mk_ax() { const CAS gcfp* kp = (const CAS gcfp*)__builtin_amdgcn_kernarg_segment_ptr(); asm volatile("" : "+s"(kp)); Ax a; a.kp = kp;
    a.out = (float*)(GAS float*)kp[NIN]; a.ws = (unsigned char*)(GAS unsigned char*)kp[NIN + 1]; return a; }
__device__ __forceinline__ Ctx mk_ctx(LAS unsigned char* lds, int wave_s) { unsigned z = 0u; asm volatile("" : "+v"(z)); int t = wave_s * 64 + (int)__builtin_amdgcn_mbcnt_hi(~0u, __builtin_amdgcn_mbcnt_lo(~0u, z)); Ctx C; C.lds = lds; C.tid = t; C.lane = t & 63; C.wave = __builtin_amdgcn_readfirstlane(t >> 6); C.G = gridDim.x; C.bid = blockIdx.x; return C; }

__device__ __forceinline__ void p0_transpose_item(const float* W, int K, int N, bf16* WT, int ldk, int row_off, LAS float* scr, int item, int lane, const float* gain) {
    const int nblk = N / 64, kb = item / nblk, nb = item - kb * nblk, k0 = 64 * kb, n0 = 64 * nb;
    const int lr = lane >> 4, lc = (lane & 15) * 4;
#pragma unroll 8
    for (int i = 0; i < 16; ++i) { const int kk = 4 * i + lr; const float g = gain ? gain[k0 + kk] : 1.0f; const f32x4 v = *(const f32x4*)(W + (size_t)(k0 + kk) * N + n0 + lc);
        LAS float* d = scr + kk * 65 + lc; d[0] = v.x * g; d[1] = v.y * g; d[2] = v.z * g; d[3] = v.w * g; }
    LDS_WAIT(); asm volatile("" ::: "memory");
    const int c = lane & 7;
#pragma unroll
    for (int j = 0; j < 8; ++j) { const int n = (lane >> 3) + 8 * j; const LAS float* s = scr + (8 * c) * 65 + n;
        v4u o; o.x = pk2(s[0 * 65], s[1 * 65]); o.y = pk2(s[2 * 65], s[3 * 65]); o.z = pk2(s[4 * 65], s[5 * 65]); o.w = pk2(s[6 * 65], s[7 * 65]);
        if (ldk > 0) *(v4u*)(WT + (size_t)(row_off + n0 + n) * ldk + k0 + 8 * c) = o;
        else *(v4u*)(WT + ((size_t)kb * (size_t)(-ldk) + row_off + n0 + n) * 64 + 8 * c) = o; }
    LDS_WAIT(); asm volatile("" ::: "memory");
}
__device__ __forceinline__ void rms_row(const float* xrow, bf16* orow, float* xcopy, int lane) {
    const f32x4* xr = (const f32x4*)xrow + lane;
    f32x4 v[8]; float s = 0.f;
#pragma unroll
    for (int j = 0; j < 8; ++j) { v[j] = xr[64 * j]; s += (v[j].x * v[j].x + v[j].y * v[j].y) + (v[j].z * v[j].z + v[j].w * v[j].w); }
    const float rs = 1.0f / sqrtf(wave_sum(s) * (1.0f / DM) + 1e-6f);
    if (xcopy) {
#pragma unroll
        for (int j = 0; j < 8; ++j) ((f32x4*)xcopy + lane)[64 * j] = v[j]; }
    unsigned long long* o8 = (unsigned long long*)orow + lane;
#pragma unroll
    for (int j = 0; j < 8; ++j) o8[64 * j] = (unsigned long long)pk2(v[j].x * rs, v[j].y * rs) | ((unsigned long long)pk2(v[j].z * rs, v[j].w * rs) << 32);
}
__device__ __forceinline__ void rms_phase(const Ctx& C, const float* X, bf16* HN) {
    const int gw = C.bid * NWAVES + C.wave, NGW = C.G * NWAVES;
    f32x4 v[8], nx[8]; int m = gw;
    if (m < MT) { const f32x4* xr = (const f32x4*)(X + (size_t)m * DM) + C.lane;
#pragma unroll
        for (int j = 0; j < 8; ++j) v[j] = xr[64 * j]; }
    for (; m < MT; m += NGW) {
        const int mn = m + NGW;
        if (mn < MT) { const f32x4* xr = (const f32x4*)(X + (size_t)mn * DM) + C.lane;
#pragma unroll
            for (int j = 0; j < 8; ++j) nx[j] = xr[64 * j]; }
        float s = 0.f;
#pragma unroll
        for (int j = 0; j < 8; ++j) s += (v[j].x * v[j].x + v[j].y * v[j].y) + (v[j].z * v[j].z + v[j].w * v[j].w);
        const float rs = 1.0f / sqrtf(wave_sum(s) * (1.0f / DM) + 1e-6f);
        unsigned long long* o8 = (unsigned long long*)(HN + (size_t)m * DM) + C.lane;
#pragma unroll
        for (int j = 0; j < 8; ++j) o8[64 * j] = (unsigned long long)pk2(v[j].x * rs, v[j].y * rs) | ((unsigned long long)pk2(v[j].z * rs, v[j].w * rs) << 32);
#pragma unroll
        for (int j = 0; j < 8; ++j) v[j] = nx[j];
    }
}
__device__ __forceinline__ void fold_split_rows(const Ctx& C, float* X, const float* S) {
    const int gw = C.bid * NWAVES + C.wave, NGW = C.G * NWAVES;
    for (int r = gw; r < NS; r += NGW) { f32x4* xr = (f32x4*)(X + (size_t)(MP + r) * DM) + C.lane; const f32x4* s0 = (const f32x4*)(S + (size_t)r * DM) + C.lane; const f32x4* s1 = (const f32x4*)(S + (size_t)(NS + r) * DM) + C.lane;
#pragma unroll
        for (int j = 0; j < 8; ++j) xr[64 * j] = xr[64 * j] + (s0[64 * j] + s1[64 * j]); }
    asm volatile("s_waitcnt vmcnt(0)" ::: "memory");
}
__device__ __forceinline__ void final_norm_phase(const Ctx& C, const float* X, const float* g, float* out) {
    const int gw = C.bid * NWAVES + C.wave, NGW = C.G * NWAVES;
    for (int m = gw; m < MT; m += NGW) {
        const f32x4* xr = (const f32x4*)(X + (size_t)m * DM) + C.lane; const f32x4* gr = (const f32x4*)g + C.lane;
        f32x4 v[8]; float s = 0.f;
#pragma unroll
        for (int j = 0; j < 8; ++j) { v[j] = xr[64 * j]; s += (v[j].x * v[j].x + v[j].y * v[j].y) + (v[j].z * v[j].z + v[j].w * v[j].w); }
        const float rs = 1.0f / sqrtf(wave_sum(s) * (1.0f / DM) + 1e-6f);
        f32x4* orow = (f32x4*)(out + (size_t)m * DM) + C.lane;
#pragma unroll
        for (int j = 0; j < 8; ++j) orow[64 * j] = v[j] * rs * gr[64 * j];
    }
}
#ifndef LATE_EXTRA
#define LATE_EXTRA 0
#endif
struct TDesc { const float* W; const float* gain; bf16* WT; int K, N, ldk, row_off, item; };
__device__ __forceinline__ TDesc p0_desc(const Ax& a, int it, int G) {
    constexpr int I_IN = 32 * 100, I_SQ = 32 * 32, I_UP = 32 * 128, I_DN = 128 * 32, I_L64 = 8, I_L128 = 16;
    constexpr int PER_LAYER = I_IN + 5 * I_SQ + I_UP + I_DN + 2 * I_L64 + I_L128;
    const int l = it / PER_LAYER; int r = it - l * PER_LAYER; unsigned char* wl = a.ws + WS_WL + (size_t)l * LW_STRIDE; bf16* wkv = (bf16*)(a.ws + WS_WKV);
    TDesc d; d.row_off = 0; d.gain = nullptr; const bool late = G == 256 && DEPTH == 2, late1 = late && l == 1 && LATE_EXTRA;
    if (r < I_IN) { d.W = a.in(I_WIN) + (size_t)l * DM * PIN; d.K = DM; d.N = PIN; d.WT = (bf16*)(wl + LW_IN); d.ldk = -PIN; d.gain = a.in(I_GMIX) + l * DM; d.item = r; return d; } r -= I_IN;
    if (r < I_SQ) { d.W = a.in(I_WOUT) + (size_t)l * DM * DM; d.K = DM; d.N = DM; d.WT = (bf16*)(wl + LW_OUT); d.ldk = -DM; d.item = late1 ? -1 : r; return d; } r -= I_SQ;
    if (r < I_SQ) { d.W = a.in(I_WQ) + (size_t)l * DM * DM; d.K = DM; d.N = DM; d.WT = (bf16*)(wl + LW_Q); d.ldk = -DM; d.gain = a.in(I_GXA) + l * DM; d.item = late1 ? -1 : r; return d; } r -= I_SQ;
    if (r < I_SQ) { d.W = a.in(I_WO) + (size_t)l * DM * DM; d.K = DM; d.N = DM; d.WT = (bf16*)(wl + LW_O); d.ldk = -DM; d.item = late1 ? -1 : r; return d; } r -= I_SQ;
    if (r < I_SQ) { d.W = a.in(I_WK) + (size_t)l * DM * DM; d.K = DM; d.N = DM; d.WT = wkv; d.ldk = -8192; d.row_off = l * 4096; d.gain = a.in(I_GMEM) + l * DM; d.item = late1 ? -1 : r; return d; } r -= I_SQ;
    if (r < I_SQ) { d.W = a.in(I_WV) + (size_t)l * DM * DM; d.K = DM; d.N = DM; d.WT = wkv; d.ldk = -8192; d.row_off = l * 4096 + 2048; d.gain = a.in(I_GMEM) + l * DM; d.item = late1 ? -1 : r; return d; } r -= I_SQ;
    if (r < I_UP) { d.W = a.in(I_WUP) + (size_t)l * DM * DFF; d.K = DM; d.N = DFF; d.WT = (bf16*)(wl + LW_UP); d.ldk = -DFF; d.gain = a.in(I_GMLP) + l * DM; d.item = late ? -1 : r; return d; } r -= I_UP;
    if (r < I_DN) { d.W = a.in(I_WDN) + (size_t)l * DFF * DM; d.K = DFF; d.N = DM; d.WT = (bf16*)(wl + LW_DN); d.ldk = -DM; d.item = late ? -1 : r; return d; } r -= I_DN;
    if (r < I_L64) { d.W = a.in(I_W2) + (size_t)l * 64 * 512; d.K = 64; d.N = 512; d.WT = (bf16*)(wl + LW_W2); d.ldk = 64; d.item = r; return d; } r -= I_L64;
    if (r < I_L64) { d.W = a.in(I_A2) + (size_t)l * 64 * 512; d.K = 64; d.N = 512; d.WT = (bf16*)(wl + LW_A2); d.ldk = 64; d.item = r; return d; } r -= I_L64;
    d.W = a.in(I_G2) + (size_t)l * 128 * 512; d.K = 128; d.N = 512; d.WT = (bf16*)(wl + LW_G2); d.ldk = 128; d.item = r; return d;
}
__device__ __forceinline__ void p0_load(const TDesc& d, int lane, f32x4 (&v)[16], float (&g)[16]) {
    if (d.item < 0) return;
    const int nblk = d.N / 64, kb = d.item / nblk, nb = d.item - kb * nblk, k0 = 64 * kb, n0 = 64 * nb, lr = lane >> 4, lc = (lane & 15) * 4;
#pragma unroll
    for (int i = 0; i < 16; ++i) { const int kk = 4 * i + lr; g[i] = d.gain ? d.gain[k0 + kk] : 1.0f; v[i] = __builtin_nontemporal_load((const f32x4*)(d.W + (size_t)(k0 + kk) * d.N + n0 + lc)); }
}
__device__ __forceinline__ void p0_finish(const TDesc& d, LAS float* scr, int lane, const f32x4 (&v)[16], const float (&g)[16]) {
    if (d.item < 0) return;
    const int nblk = d.N / 64, kb = d.item / nblk, nb = d.item - kb * nblk, k0 = 64 * kb, n0 = 64 * nb, lr = lane >> 4, lc = (lane & 15) * 4;
#pragma unroll
    for (int i = 0; i < 16; ++i) { const int kk = 4 * i + lr; LAS float* p = scr + kk * 65 + lc; p[0] = v[i].x * g[i]; p[1] = v[i].y * g[i]; p[2] = v[i].z * g[i]; p[3] = v[i].w * g[i]; }
    LDS_WAIT(); asm volatile("" ::: "memory");
    const int c = lane & 7;
#pragma unroll
    for (int j = 0; j < 8; ++j) { const int n = (lane >> 3) + 8 * j; const LAS float* s = scr + (8 * c) * 65 + n;
        v4u o; o.x = pk2(s[0 * 65], s[1 * 65]); o.y = pk2(s[2 * 65], s[3 * 65]); o.z = pk2(s[4 * 65], s[5 * 65]); o.w = pk2(s[6 * 65], s[7 * 65]);
        if (d.ldk > 0) *(v4u*)(d.WT + (size_t)(d.row_off + n0 + n) * d.ldk + k0 + 8 * c) = o;
        else *(v4u*)(d.WT + ((size_t)kb * (size_t)(-d.ldk) + d.row_off + n0 + n) * 64 + 8 * c) = o; }
    LDS_WAIT(); asm volatile("" ::: "memory");
}
__device__ __forceinline__ void p0_prologue(const Ctx& C, const Ax& a) {
    LAS float* scr = (LAS float*)(C.lds + C.wave * 16640);
    const int gw = C.bid * NWAVES + C.wave, NGW = C.G * NWAVES;
    constexpr int I_IN = 32 * 100, I_SQ = 32 * 32, I_UP = 32 * 128, I_DN = 128 * 32, I_L64 = 8, I_L128 = 16;
    constexpr int PER_LAYER = I_IN + 5 * I_SQ + I_UP + I_DN + 2 * I_L64 + I_L128;
    TDesc cur = p0_desc(a, gw, C.G), nxt; f32x4 va[16], vb[16]; float ga[16], gb[16];
    const int NITEMS = DEPTH * PER_LAYER;
    if (gw < NITEMS) p0_load(cur, C.lane, va, ga);
    for (int it = gw; it < NITEMS; it += 2 * NGW) {
        const int it1 = it + NGW, it2 = it + 2 * NGW;
        if (it1 < NITEMS) { nxt = p0_desc(a, it1, C.G); p0_load(nxt, C.lane, vb, gb); }
        p0_finish(cur, scr, C.lane, va, ga);
        if (it1 < NITEMS) { if (it2 < NITEMS) { cur = p0_desc(a, it2, C.G); p0_load(cur, C.lane, va, ga); }
            p0_finish(nxt, scr, C.lane, vb, gb); }
    }
    { float* cs = (float*)(a.ws + WS_ROPE); const int gt = C.bid * (NWAVES * 64) + C.tid, NT = C.G * NWAVES * 64;
      for (int idx = gt; idx < 2049 * 64; idx += NT) { const int p = idx >> 6, i = idx & 63; const double pos = (p == 2048) ? 16384.0 : (double)p;
          const double inv = exp(-(double)i * (9.210340371976184 / 64.0)); double r = pos * inv; r -= 6.283185307179586 * rint(r * 0.15915494309189535);
          cs[2 * idx] = (float)cos(r); cs[2 * idx + 1] = (float)sin(r); } }
    float* XF = (float*)(a.ws + WS_XF); bf16* HN = (bf16*)(a.ws + WS_HN); bf16* MN = (bf16*)(a.ws + WS_MN);
    for (int m = gw; m < MT; m += NGW) { const float* src = (m < MP) ? a.in(I_XP) + (size_t)m * DM : a.in(I_XS) + (size_t)(m - MP) * DM; rms_row(src, HN + (size_t)m * DM, nullptr, C.lane); }
    for (int m = gw; m < MMEM; m += NGW) rms_row(a.in(I_MEM) + (size_t)m * DM, MN + (size_t)m * DM, nullptr, C.lane);
}

__device__ __forceinline__ TDesc lc_desc(const Ax& a, int l, int it) {
    constexpr int I_UP = 32 * 128, I_DN = 128 * 32, I_SQ = 32 * 32;
    unsigned char* wl = a.ws + WS_WL + (size_t)l * LW_STRIDE; TDesc d; d.row_off = 0; d.gain = nullptr;
    if (it < I_UP) { d.W = a.in(I_WUP) + (size_t)l * DM * DFF; d.K = DM; d.N = DFF; d.WT = (bf16*)(wl + LW_UP); d.ldk = -DFF; d.gain = a.in(I_GMLP) + l * DM; d.item = it; return d; }
    int r = it - I_UP;
    if (r < I_DN) { d.W = a.in(I_WDN) + (size_t)l * DFF * DM; d.K = DFF; d.N = DM; d.WT = (bf16*)(wl + LW_DN); d.ldk = -DM; d.item = r; return d; } r -= I_DN;
    d.K = DM; d.N = DM; d.item = r & (I_SQ - 1); const int q = r >> 10;
    if (l == 0) { const int l1 = 1; d.W = a.in(q == 0 ? I_WK : I_WV) + (size_t)l1 * DM * DM; d.WT = (bf16*)(a.ws + WS_WKV); d.ldk = -8192; d.row_off = l1 * 4096 + q * 2048; d.gain = a.in(I_GMEM) + l1 * DM; return d; }
    d.ldk = -DM;
    if (q == 0) { d.W = a.in(I_WOUT) + (size_t)l * DM * DM; d.WT = (bf16*)(wl + LW_OUT); }
    else if (q == 1) { d.W = a.in(I_WQ) + (size_t)l * DM * DM; d.WT = (bf16*)(wl + LW_Q); d.gain = a.in(I_GXA) + l * DM; }
    else { d.W = a.in(I_WO) + (size_t)l * DM * DM; d.WT = (bf16*)(wl + LW_O); }
    return d;
}
__device__ __forceinline__ void late_convert(const Ctx& C, const Ax& a, int l, int rank, int nrank) {
    LAS float* scr = (LAS float*)(C.lds + C.wave * 16640);
    const int NITEMS = 32 * 128 + 128 * 32 + (LATE_EXTRA ? (l == 0 ? 2 : 3) * 1024 : 0);
    const int gw = rank * NWAVES + C.wave, NGW = nrank * NWAVES;
    TDesc cur, nxt; f32x4 va[16], vb[16]; float ga[16], gb[16];
    if (gw < NITEMS) { cur = lc_desc(a, l, gw); p0_load(cur, C.lane, va, ga); }
    for (int it = gw; it < NITEMS; it += 2 * NGW) {
        const int it1 = it + NGW, it2 = it + 2 * NGW;
        if (it1 < NITEMS) { nxt = lc_desc(a, l, it1); p0_load(nxt, C.lane, vb, gb); }
        p0_finish(cur, scr, C.lane, va, ga);
        if (it1 < NITEMS) { if (it2 < NITEMS) { cur = lc_desc(a, l, it2); p0_load(cur, C.lane, va, ga); }
            p0_finish(nxt, scr, C.lane, vb, gb); }
    }
}
__device__ __forceinline__ void ad_prompt_item(const Ctx& C, const Ax& a, int l, int item) {
    const bf16* P = (const bf16*)(a.ws + WS_P); bf16* YC = (bf16*)(a.ws + WS_YC);
    const int b = item >> 6, t0 = (item & 63) * 32; const size_t rbase = (size_t)b * SEQ;
    LAS float* UD = (LAS float*)C.lds;
#pragma unroll 4
    for (int it = C.tid; it < 62 * 64; it += NWAVES * 64) { const int r = it >> 6, cc = it & 63, t = t0 - 30 + r;
        float u[8];
        if (t >= 0) { const bf16* pr = P + (rbase + t) * PIN + PD_ + cc * 8; float d1[8], d2[8]; unpack8(*(const v4u*)pr, d1); unpack8(*(const v4u*)(pr + 512), d2);
#pragma unroll
            for (int j = 0; j < 8; ++j) u[j] = d1[j] * sigm(d2[j]); }
        else {
#pragma unroll
            for (int j = 0; j < 8; ++j) u[j] = 0.f; }
        *(LAS f32x4*)(UD + r * 512 + cc * 8) = (f32x4){u[0], u[1], u[2], u[3]}; *(LAS f32x4*)(UD + r * 512 + cc * 8 + 4) = (f32x4){u[4], u[5], u[6], u[7]}; }
    { const float* cw = a.in(I_CAW) + (size_t)l * 3 * 512;
#pragma unroll 2
      for (int it = C.tid; it < 32 * 64; it += NWAVES * 64) { const int r = it >> 6, cc = it & 63, t = t0 + r; const bf16* pr = P + (rbase + t) * PIN + cc * 8;
        float ab[8], u0[8], u1[8], u2[8], x[8], y[8];
        unpack8(*(const v4u*)pr, ab); unpack8(*(const v4u*)(pr + 512), x); unpack8(*(const v4u*)(pr + 1024), y);
#pragma unroll
        for (int j = 0; j < 8; ++j) u2[j] = x[j] * y[j];
        if (t >= 1) { unpack8(*(const v4u*)(pr - PIN + 512), x); unpack8(*(const v4u*)(pr - PIN + 1024), y);
#pragma unroll
            for (int j = 0; j < 8; ++j) u1[j] = x[j] * y[j]; }
        else {
#pragma unroll
            for (int j = 0; j < 8; ++j) u1[j] = 0.f; }
        if (t >= 2) { unpack8(*(const v4u*)(pr - 2 * PIN + 512), x); unpack8(*(const v4u*)(pr - 2 * PIN + 1024), y);
#pragma unroll
            for (int j = 0; j < 8; ++j) u0[j] = x[j] * y[j]; }
        else {
#pragma unroll
            for (int j = 0; j < 8; ++j) u0[j] = 0.f; }
        float o[8];
#pragma unroll
        for (int j = 0; j < 8; ++j) { const int c = cc * 8 + j; o[j] = ab[j] * (cw[c] * u0[j] + cw[512 + c] * u1[j] + cw[1024 + c] * u2[j]); }
        *(v4u*)(YC + (rbase + t) * DM + cc * 8) = pack8(o);
        if (t >= SEQ - 2) { float* st = a.out + O_CAP + (((size_t)l * NB + b) * 2 + (t - (SEQ - 2))) * 512 + cc * 8; *(f32x4*)st = (f32x4){u2[0], u2[1], u2[2], u2[3]}; *(f32x4*)(st + 4) = (f32x4){u2[4], u2[5], u2[6], u2[7]}; } } }
    __syncthreads();
    const int c = C.tid;
    if (t0 == SEQ - 32) { float* st = a.out + O_CDP + ((size_t)l * NB + b) * 30 * 512 + c;
        for (int j = 0; j < 30; ++j) st[(size_t)j * 512] = UD[(32 + j) * 512 + c]; }
    float cv[32];
    { const float* cw = a.in(I_CDW) + (size_t)l * 31 * 512 + c; const float bias = a.in(I_CDB)[l * 512 + c];
#pragma unroll
      for (int hf = 0; hf < 2; ++hf) {
        float u[46];
#pragma unroll
        for (int r = 0; r < 46; ++r) u[r] = UD[(hf * 16 + r) * 512 + c];
#pragma unroll
        for (int t = 0; t < 16; ++t) cv[hf * 16 + t] = bias;
#pragma unroll
        for (int j = 0; j < 31; ++j) { const float w = cw[(size_t)j * 512];
#pragma unroll
            for (int t = 0; t < 16; ++t) cv[hf * 16 + t] += w * u[t + j]; }
        asm volatile("" ::: "memory"); } }
    __syncthreads();
#pragma unroll
    for (int t = 0; t < 32; ++t) UD[t * 512 + c] = cv[t];
    __syncthreads();
    { const float* lg = a.in(I_LNDG) + l * 512 + C.lane * 8; const float* lb = a.in(I_LNDB) + l * 512 + C.lane * 8;
      const f32x4 g0 = *(const f32x4*)lg, g1 = *(const f32x4*)(lg + 4), b0 = *(const f32x4*)lb, b1 = *(const f32x4*)(lb + 4);
#pragma unroll
      for (int q = 0; q < 4; ++q) { const int t = C.wave * 4 + q; const f32x4 x0 = *(LAS f32x4*)(UD + t * 512 + C.lane * 8), x1 = *(LAS f32x4*)(UD + t * 512 + C.lane * 8 + 4);
        const float mu = wave_sum((x0.x + x0.y) + (x0.z + x0.w) + (x1.x + x1.y) + (x1.z + x1.w)) * (1.0f / 512.0f);
        const f32x4 d0 = x0 - mu, d1 = x1 - mu;
        const float var = wave_sum((d0.x * d0.x + d0.y * d0.y) + (d0.z * d0.z + d0.w * d0.w) + (d1.x * d1.x + d1.y * d1.y) + (d1.z * d1.z + d1.w * d1.w)) * (1.0f / 512.0f);
        const float rstd = 1.0f / sqrtf(var + 1e-6f);
        const f32x4 y0 = d0 * rstd * g0 + b0, y1 = d1 * rstd * g1 + b1; float o[8];
        o[0] = y0.x * sigm(y0.x); o[1] = y0.y * sigm(y0.y); o[2] = y0.z * sigm(y0.z); o[3] = y0.w * sigm(y0.w);
        o[4] = y1.x * sigm(y1.x); o[5] = y1.y * sigm(y1.y); o[6] = y1.z * sigm(y1.z); o[7] = y1.w * sigm(y1.w);
        *(v4u*)(YC + (rbase + t0 + t) * DM + 1536 + C.lane * 8) = pack8(o); } }
    __syncthreads();
}
__device__ __forceinline__ void ad_sample_item(const Ctx& C, const Ax& a, int l, int n) {
    const bf16* P = (const bf16*)(a.ws + WS_P); bf16* YC = (bf16*)(a.ws + WS_YC);
    const int c = C.tid; const bf16* pr = P + (size_t)(MP + n) * PIN;
    LAS float* red = (LAS float*)C.lds;
    { const float* st = a.in(I_SCA) + (((size_t)l * NS + n) * 2) * 512 + c; const float s0 = st[0], s1 = st[512];
      const float ua = bf1(pr[512 + c]) * bf1(pr[1024 + c]); const float* cw = a.in(I_CAW) + (size_t)l * 3 * 512 + c;
      const float y = bf1(pr[c]) * (cw[0] * s0 + cw[512] * s1 + cw[1024] * ua);
      YC[(size_t)(MP + n) * DM + c] = (bf16)(pk2(y, 0.f) & 0xffffu);
      float* o = a.out + O_CAS + (((size_t)l * NS + n) * 2) * 512 + c; o[0] = s1; o[512] = ua; }
    const float* st = a.in(I_SCD) + (((size_t)l * NS + n) * 30) * 512 + c; const float* cw = a.in(I_CDW) + (size_t)l * 31 * 512 + c;
    const float ud = bf1(pr[PD_ + c]) * sigm(bf1(pr[PD_ + 512 + c]));
    float cv = a.in(I_CDB)[l * 512 + c] + cw[30 * 512] * ud;
    float* os = a.out + O_CDS + (((size_t)l * NS + n) * 30) * 512 + c;
#pragma unroll 6
    for (int j = 0; j < 30; ++j) { const float s = st[(size_t)j * 512]; cv += cw[(size_t)j * 512] * s; if (j > 0) os[(size_t)(j - 1) * 512] = s; }
    os[29 * 512] = ud;
    float s = wave_sum(cv); if (C.lane == 0) red[C.wave] = s; __syncthreads();
    float mu = 0.f;
#pragma unroll
    for (int w = 0; w < 8; ++w) mu += red[w];
    mu *= (1.0f / 512.0f); const float d = cv - mu;
    s = wave_sum(d * d); if (C.lane == 0) red[8 + C.wave] = s; __syncthreads();
    float var = 0.f;
#pragma unroll
    for (int w = 0; w < 8; ++w) var += red[8 + w];
    const float rstd = 1.0f / sqrtf(var * (1.0f / 512.0f) + 1e-6f);
    const float y = d * rstd * a.in(I_LNDG)[l * 512 + c] + a.in(I_LNDB)[l * 512 + c];
    YC[(size_t)(MP + n) * DM + 1536 + c] = (bf16)(pk2(y * sigm(y), 0.f) & 0xffffu);
    __syncthreads();
}

__device__ __forceinline__ void shift8(const bf16* cur, const bf16* prevb, const float* prevf, const float* mu, float (&xs)[8]) {
    float pc[8], pv[8]; unpack8(*(const v4u*)cur, pc);
    if (prevb) unpack8(*(const v4u*)prevb, pv);
    else if (prevf) { const f32x4 p0 = *(const f32x4*)prevf, p1 = *(const f32x4*)(prevf + 4); pv[0] = p0.x; pv[1] = p0.y; pv[2] = p0.z; pv[3] = p0.w; pv[4] = p1.x; pv[5] = p1.y; pv[6] = p1.z; pv[7] = p1.w; }
    else {
#pragma unroll
        for (int j = 0; j < 8; ++j) pv[j] = 0.f; }
    const f32x4 m0 = *(const f32x4*)mu, m1 = *(const f32x4*)(mu + 4); const float m[8] = {m0.x, m0.y, m0.z, m0.w, m1.x, m1.y, m1.z, m1.w};
#pragma unroll
    for (int j = 0; j < 8; ++j) xs[j] = pc[j] + (pv[j] - pc[j]) * m[j];
}
__device__ __forceinline__ void shift4(const bf16* cur, const bf16* prevb, const float* prevf, const float* mu, float (&xs)[4]) {
    float pc[4], pv[4]; unpack4(*(const v2u*)cur, pc);
    if (prevb) unpack4(*(const v2u*)prevb, pv);
    else if (prevf) { const f32x4 p0 = *(const f32x4*)prevf; pv[0] = p0.x; pv[1] = p0.y; pv[2] = p0.z; pv[3] = p0.w; }
    else { pv[0] = pv[1] = pv[2] = pv[3] = 0.f; }
    const f32x4 m0 = *(const f32x4*)mu;
    xs[0] = pc[0] + (pv[0] - pc[0]) * m0.x; xs[1] = pc[1] + (pv[1] - pc[1]) * m0.y; xs[2] = pc[2] + (pv[2] - pc[2]) * m0.z; xs[3] = pc[3] + (pv[3] - pc[3]) * m0.w;
}
constexpr int PTS = 1544;
__device__ __forceinline__ void shift4_lds(const LAS bf16* cur, const float* mu, float (&xs)[4]) {
    float pc[4], pv[4]; unpack4(*(const LAS v2u*)cur, pc); unpack4(*(const LAS v2u*)(cur - PTS), pv);
    const f32x4 m0 = *(const f32x4*)mu;
    xs[0] = pc[0] + (pv[0] - pc[0]) * m0.x; xs[1] = pc[1] + (pv[1] - pc[1]) * m0.y; xs[2] = pc[2] + (pv[2] - pc[2]) * m0.z; xs[3] = pc[3] + (pv[3] - pc[3]) * m0.w;
}
constexpr int RWB = 896, RW_KK = 256, RW_KB = 384, RW_K = 512, RW_R = 640, RW_V = 768;
__device__ __forceinline__ void rw_st4(unsigned char* rec, int off, int cl, const f32x4 v) { v2u w; w.x = pk2(v[0], v[1]); w.y = pk2(v[2], v[3]); *(v2u*)(rec + off + cl * 2) = w; }
__device__ __forceinline__ f32x4 rw_ld4(const unsigned char* rec, int off, int cl) { float f[4]; unpack4(*(const v2u*)(rec + off + cl * 2), f); return (f32x4){f[0], f[1], f[2], f[3]}; }
#ifndef DUP_SUB
#define DUP_SUB 0u
#endif
#define PREP_REP(k) for (int prep_rep_ = 0; prep_rep_ < 1 + (int)((DUP_SUB >> (k)) & 1u); ++prep_rep_)
__device__ __forceinline__ void rwkv_prep_item(const Ctx& C, const Ax& a, int l, int item) {
    const bf16* P = (const bf16*)(a.ws + WS_P); float* RW = (float*)(a.ws + WS_RW); float* GATE = (float*)(a.ws + WS_GATE);
    const bool smp = item >= 256; const int row0 = smp ? MP + (item - 256) * 32 : (item >> 6) * SEQ + (item & 63) * 32; const int t0 = smp ? 0 : (item & 63) * 32;
    const float* mu = a.in(I_MU) + (size_t)l * SHW; const float* sst = a.in(I_SSH) + (size_t)l * NS * SHW;
    LAS bf16* AW = (LAS bf16*)C.lds; LAS bf16* AA = AW + 32 * 72; LAS bf16* AG = AA + 32 * 72; LAS bf16* PT = AG + 32 * 136;
    for (int it = C.tid; it < 32 * 32; it += NWAVES * 64) { const int r = it >> 5, cc = it & 31, col = 1536 + cc * 8, row = row0 + r; const bf16* cur = P + (size_t)row * PIN + PC_ + col;
        float xs[8];
        if (smp) shift8(cur, nullptr, sst + (size_t)(row - MP) * SHW + col, mu + col, xs);
        else shift8(cur, (t0 + r > 0) ? cur - PIN : nullptr, nullptr, mu + col, xs);
        if (cc < 8) {
#pragma unroll
            for (int j = 0; j < 8; ++j) xs[j] = tanhf(xs[j]);
            *(LAS v4u*)(AW + r * 72 + cc * 8) = pack8(xs); }
        else if (cc < 16) *(LAS v4u*)(AA + r * 72 + (cc - 8) * 8) = pack8(xs);
        else {
#pragma unroll
            for (int j = 0; j < 8; ++j) xs[j] = sigm(xs[j]);
            *(LAS v4u*)(AG + r * 136 + (cc - 16) * 8) = pack8(xs); } }
    if (!smp) { for (int it = C.tid; it < 33 * 192; it += NWAVES * 64) { const int r = it / 192, cc = it - r * 192; v4u v = (v4u){0u, 0u, 0u, 0u};
            if (t0 + r > 0) v = *(const v4u*)(P + (size_t)(row0 + r - 1) * PIN + PC_ + cc * 8);
            *(LAS v4u*)(PT + r * PTS + cc * 8) = v; } }
    if (smp) { float* o = a.out + O_SHS + ((size_t)l * NS + (row0 - MP)) * SHW;
        for (int it = C.tid; it < 32 * 224; it += NWAVES * 64) { const int r = it / 224, cc = it % 224; float f[8]; unpack8(*(const v4u*)(P + (size_t)(row0 + r) * PIN + PC_ + cc * 8), f);
            float* op = o + (size_t)r * SHW + cc * 8; *(f32x4*)op = (f32x4){f[0], f[1], f[2], f[3]}; *(f32x4*)(op + 4) = (f32x4){f[4], f[5], f[6], f[7]}; } }
    else if (t0 == SEQ - 32) { float* o = a.out + O_SHP + ((size_t)l * NB + (item >> 6)) * SHW;
        for (int cc = C.tid; cc < 224; cc += NWAVES * 64) { float f[8]; unpack8(*(const v4u*)(P + (size_t)(row0 + 31) * PIN + PC_ + cc * 8), f);
            *(f32x4*)(o + cc * 8) = (f32x4){f[0], f[1], f[2], f[3]}; *(f32x4*)(o + cc * 8 + 4) = (f32x4){f[4], f[5], f[6], f[7]}; } }
    __syncthreads();
    const int h = C.wave, fr = C.lane & 15, fq = C.lane >> 4;
    const unsigned char* wl = a.ws + WS_WL + (size_t)l * LW_STRIDE;
    const bf16* W2t = (const bf16*)(wl + LW_W2); const bf16* A2t = (const bf16*)(wl + LW_A2); const bf16* G2t = (const bf16*)(wl + LW_G2);
    PREP_REP(23) { constexpr int tp = 0;
        f32x4 acc[4][2];
#pragma unroll
        for (int ct = 0; ct < 4; ++ct)
#pragma unroll
            for (int t2 = 0; t2 < 2; ++t2) acc[ct][t2] = zero4();
#pragma unroll
        for (int ks = 0; ks < 2; ++ks) { bf16x8 af[2], wf[4];
#pragma unroll
            for (int t2 = 0; t2 < 2; ++t2) af[t2] = *(const LAS bf16x8*)(AA + (tp * 32 + t2 * 16 + fr) * 72 + ks * 32 + fq * 8);
#pragma unroll
            for (int ct = 0; ct < 4; ++ct) wf[ct] = *(const bf16x8*)(A2t + (size_t)(h * 64 + ct * 16 + fr) * 64 + ks * 32 + fq * 8);
#pragma unroll
            for (int ct = 0; ct < 4; ++ct)
#pragma unroll
                for (int t2 = 0; t2 < 2; ++t2) acc[ct][t2] = __builtin_amdgcn_mfma_f32_16x16x32_bf16(wf[ct], af[t2], acc[ct][t2], 0, 0, 0); }
        const float* a0 = a.in(I_A0) + l * 512; const float* kkw = a.in(I_KK) + l * 512; const float* kaw = a.in(I_KA) + l * 512;
#pragma unroll
        for (int t2 = 0; t2 < 2; ++t2) { const int r = tp * 32 + t2 * 16 + fr, row = row0 + r; const bf16* prow = P + (size_t)row * PIN + PC_;
            const float* pf = smp ? sst + (size_t)(row - MP) * SHW : nullptr;
            float kkr[4][4], av[4][4], kc[4][4]; float ss = 0.f;
#pragma unroll
            for (int ct = 0; ct < 4; ++ct) { const int ch = h * 64 + ct * 16 + fq * 4; const f32x4 a0v = *(const f32x4*)(a0 + ch), kkv = *(const f32x4*)(kkw + ch);
                float xs[4]; if (smp) shift4(prow + 512 + ch, nullptr, pf + 512 + ch, mu + 512 + ch, xs); else shift4_lds(PT + (r + 1) * PTS + 512 + ch, mu + 512 + ch, xs);
#pragma unroll
                for (int j = 0; j < 4; ++j) { av[ct][j] = sigm(a0v[j] + acc[ct][t2][j]); kc[ct][j] = xs[j]; kkr[ct][j] = xs[j] * kkv[j]; ss += kkr[ct][j] * kkr[ct][j]; } }
            ss += __shfl_xor(ss, 16); ss += __shfl_xor(ss, 32);
            const float inv = 1.0f / fmaxf(sqrtf(ss), 1e-12f);
            unsigned char* rw = (unsigned char*)RW + ((size_t)row * 8 + h) * RWB;
#pragma unroll
            for (int ct = 0; ct < 4; ++ct) { const int ch = h * 64 + ct * 16 + fq * 4, cl = ct * 16 + fq * 4; const f32x4 kav = *(const f32x4*)(kaw + ch);
                f32x4 kk, kb, k4;
#pragma unroll
                for (int j = 0; j < 4; ++j) { kk[j] = kkr[ct][j] * inv; kb[j] = kk[j] * av[ct][j]; k4[j] = kc[ct][j] * (1.0f + (av[ct][j] - 1.0f) * kav[j]); }
                rw_st4(rw, RW_KK, cl, kk); rw_st4(rw, RW_KB, cl, kb); rw_st4(rw, RW_K, cl, k4);
                float xr[4], xv[4];
                if (smp) { shift4(prow + ch, nullptr, pf + ch, mu + ch, xr); shift4(prow + 1024 + ch, nullptr, pf + 1024 + ch, mu + 1024 + ch, xv); }
                else { shift4_lds(PT + (r + 1) * PTS + ch, mu + ch, xr); shift4_lds(PT + (r + 1) * PTS + 1024 + ch, mu + 1024 + ch, xv); }
                rw_st4(rw, RW_R, cl, (f32x4){xr[0], xr[1], xr[2], xr[3]}); rw_st4(rw, RW_V, cl, (f32x4){xv[0], xv[1], xv[2], xv[3]}); } }
    }
    PREP_REP(24) { constexpr int tp = 0;
        f32x4 acc[4][2];
#pragma unroll
        for (int ct = 0; ct < 4; ++ct)
#pragma unroll
            for (int t2 = 0; t2 < 2; ++t2) acc[ct][t2] = zero4();
#pragma unroll
        for (int ks = 0; ks < 2; ++ks) { bf16x8 af[2], wf[4];
#pragma unroll
            for (int t2 = 0; t2 < 2; ++t2) af[t2] = *(const LAS bf16x8*)(AW + (tp * 32 + t2 * 16 + fr) * 72 + ks * 32 + fq * 8);
#pragma unroll
            for (int ct = 0; ct < 4; ++ct) wf[ct] = *(const bf16x8*)(W2t + (size_t)(h * 64 + ct * 16 + fr) * 64 + ks * 32 + fq * 8);
#pragma unroll
            for (int ct = 0; ct < 4; ++ct)
#pragma unroll
                for (int t2 = 0; t2 < 2; ++t2) acc[ct][t2] = __builtin_amdgcn_mfma_f32_16x16x32_bf16(wf[ct], af[t2], acc[ct][t2], 0, 0, 0); }
        const float* w0 = a.in(I_W0) + l * 512;
#pragma unroll
        for (int t2 = 0; t2 < 2; ++t2) { const int row = row0 + tp * 32 + t2 * 16 + fr; float* rw = (float*)((unsigned char*)RW + ((size_t)row * 8 + h) * RWB);
#pragma unroll
            for (int ct = 0; ct < 4; ++ct) { const int ch = h * 64 + ct * 16 + fq * 4, cl = ct * 16 + fq * 4; const f32x4 w0v = *(const f32x4*)(w0 + ch); f32x4 d;
#pragma unroll
                for (int j = 0; j < 4; ++j) { const float z = -(w0v[j] + acc[ct][t2][j]); const float sp = fmaxf(z, 0.f) + __logf(1.0f + __expf(-fabsf(z))); const float w = -sp - 0.5f; d[j] = -__expf(w); }
                *(f32x4*)(rw + cl) = d; } }
    }
    PREP_REP(25) { constexpr int tp = 0;
        f32x4 acc[4][2];
#pragma unroll
        for (int ct = 0; ct < 4; ++ct)
#pragma unroll
            for (int t2 = 0; t2 < 2; ++t2) acc[ct][t2] = zero4();
#pragma unroll
        for (int ks = 0; ks < 4; ++ks) { bf16x8 af[2], wf[4];
#pragma unroll
            for (int t2 = 0; t2 < 2; ++t2) af[t2] = *(const LAS bf16x8*)(AG + (tp * 32 + t2 * 16 + fr) * 136 + ks * 32 + fq * 8);
#pragma unroll
            for (int ct = 0; ct < 4; ++ct) wf[ct] = *(const bf16x8*)(G2t + (size_t)(h * 64 + ct * 16 + fr) * 128 + ks * 32 + fq * 8);
#pragma unroll
            for (int ct = 0; ct < 4; ++ct)
#pragma unroll
                for (int t2 = 0; t2 < 2; ++t2) acc[ct][t2] = __builtin_amdgcn_mfma_f32_16x16x32_bf16(wf[ct], af[t2], acc[ct][t2], 0, 0, 0); }
#pragma unroll
        for (int t2 = 0; t2 < 2; ++t2) { const int row = row0 + tp * 32 + t2 * 16 + fr;
#pragma unroll
            for (int ct = 0; ct < 4; ++ct) *(f32x4*)(GATE + (size_t)row * 512 + h * 64 + ct * 16 + fq * 4) = acc[ct][t2]; }
    }
    __syncthreads();
}

#define PACK8(arr, o) ((v4u){pk2((arr)[(o)], (arr)[(o) + 1]), pk2((arr)[(o) + 2], (arr)[(o) + 3]), pk2((arr)[(o) + 4], (arr)[(o) + 5]), pk2((arr)[(o) + 6], (arr)[(o) + 7])})
constexpr int WK_LDS = 18432, WK_SHR = 6912, WK_PRV = 3072;
__device__ __forceinline__ f32x4 mfma16(bf16x4 a, bf16x4 b, f32x4 c) { return __builtin_amdgcn_mfma_f32_16x16x16bf16_1k(a, b, c, 0, 0, 0); }
__device__ __forceinline__ bf16 bfr1(float x) { return (bf16)(pk2(x, 0.f) & 0xffffu); }
__device__ __forceinline__ void wkv_chunk_witem(const Ctx& C, const Ax& a, int ci) {
    const float* RW = (const float*)(a.ws + WS_RW);
    unsigned char* CK = a.ws + WS_CK + (size_t)ci * WK_SHR; unsigned char* CP = a.ws + WS_CP + (size_t)ci * 4 * WK_PRV;
    const int bh = ci >> 7, c = ci & 127, b = bh >> 3, h = bh & 7, lane = C.lane, fr = lane & 15, fq = lane >> 4;
    LAS unsigned char* Lb = C.lds + C.wave * WK_LDS;
    LAS bf16* TA = (LAS bf16*)Lb; LAS bf16* TB = TA + 16 * 72; LAS bf16* TK = TB + 16 * 72; LAS bf16* TR = TK + 16 * 72; LAS bf16* VT = TR + 16 * 72;
    LAS float* M1 = (LAS float*)(Lb + 12288); LAS float* M2 = M1 + 320; LAS float* N1 = M2 + 320; LAS float* N2 = N1 + 320;
    LAS bf16* TG = TA; LAS bf16* PST = TK;
    const unsigned char* rw = (const unsigned char*)RW + (((size_t)b * SEQ + c * 16) * 8 + h) * RWB;
#define RWF(t) (*(const float*)(rw + (size_t)(t) * (8 * RWB) + lane * 4))
#define RWH(t, off) bf1(*(const bf16*)(rw + (size_t)(t) * (8 * RWB) + (off) + lane * 2))
    float lam[16]; { float run = 0.f;
#pragma unroll
      for (int t = 0; t < 16; ++t) { run += RWF(t); lam[t] = run; } }
    const float lamT = lam[15];
    ((float*)CK)[lane] = __expf(lamT);
    float Bp[16], Kp[16], al[16], ro[16];
    bf16* ATg = (bf16*)(CK + 256); bf16* OMg = (bf16*)(CK + 256 + 2304);
    float wkk[4], wbb[4], wkx[4], wrr[4], wvv[4];
#pragma unroll
    for (int t = 0; t < 4; ++t) { wkk[t] = RWH(t, RW_KK); wbb[t] = RWH(t, RW_KB); wkx[t] = RWH(t, RW_K); wrr[t] = RWH(t, RW_R); wvv[t] = RWH(t, RW_V); }
#pragma unroll
    for (int t = 0; t < 16; ++t) { const float kk = wkk[t & 3], bb = wbb[t & 3], kx = wkx[t & 3], rr = wrr[t & 3], vv = wvv[t & 3];
        if (t + 4 < 16) { wkk[t & 3] = RWH(t + 4, RW_KK); wbb[t & 3] = RWH(t + 4, RW_KB); wkx[t & 3] = RWH(t + 4, RW_K); wrr[t & 3] = RWH(t + 4, RW_R); wvv[t & 3] = RWH(t + 4, RW_V); }
        const float ein = __expf(-lam[t]), eprev = (t ? __expf(lam[t - 1]) : 1.0f), ecur = __expf(lam[t]), erest = __expf(lamT - lam[t]);
        al[t] = kk * eprev; ro[t] = rr * ecur; Bp[t] = bb * erest; Kp[t] = kx * erest;
        const bf16 ab = bfr1(al[t]);
        TA[t * 72 + lane] = ab; TB[t * 72 + lane] = bfr1(bb * ein); TK[t * 72 + lane] = bfr1(kx * ein); TR[t * 72 + lane] = bfr1(ro[t]); VT[lane * 24 + t] = bfr1(vv);
        ATg[t * 72 + lane] = ab;
        asm volatile("" ::: "memory"); __builtin_amdgcn_sched_barrier(0); }
    LDS_WAIT(); asm volatile("" ::: "memory");
    { f32x4 g1 = zero4(), g2 = zero4(), n1 = zero4(), n2 = zero4();
#pragma unroll
      for (int ks = 0; ks < 2; ++ks) { const int o = fr * 72 + ks * 32 + fq * 8;
        const bf16x8 bf_ = *(const LAS bf16x8*)(TB + o), kf_ = *(const LAS bf16x8*)(TK + o), af_ = *(const LAS bf16x8*)(TA + o), rf_ = *(const LAS bf16x8*)(TR + o);
        g1 = __builtin_amdgcn_mfma_f32_16x16x32_bf16(bf_, af_, g1, 0, 0, 0); g2 = __builtin_amdgcn_mfma_f32_16x16x32_bf16(kf_, af_, g2, 0, 0, 0);
        n1 = __builtin_amdgcn_mfma_f32_16x16x32_bf16(bf_, rf_, n1, 0, 0, 0); n2 = __builtin_amdgcn_mfma_f32_16x16x32_bf16(kf_, rf_, n2, 0, 0, 0); }
#pragma unroll
      for (int r = 0; r < 4; ++r) { const int s_ = 4 * fq + r, o = s_ * 20 + fr;
        M1[o] = (s_ < fr) ? g1[r] : 0.f; M2[o] = (s_ < fr) ? g2[r] : 0.f; N1[o] = (s_ <= fr) ? n1[r] : 0.f; N2[o] = (s_ <= fr) ? n2[r] : 0.f; } }
    LDS_WAIT(); asm volatile("" ::: "memory");
    __builtin_amdgcn_sched_barrier(0);
#pragma unroll
    for (int s_ = 14; s_ >= 0; --s_) { float m[16];
#pragma unroll
        for (int q = 0; q < 4; ++q) { const f32x4 v = *(const LAS f32x4*)(M1 + s_ * 20 + 4 * q); m[4 * q] = v.x; m[4 * q + 1] = v.y; m[4 * q + 2] = v.z; m[4 * q + 3] = v.w; }
        float acc = Bp[s_];
#pragma unroll
        for (int t = s_ + 1; t < 16; ++t) acc -= m[t] * Bp[t];
        asm volatile("" : "+v"(acc) :: "memory"); Bp[s_] = acc; __builtin_amdgcn_sched_barrier(0); }
#pragma unroll
    for (int s_ = 0; s_ < 15; ++s_) { float m[16];
#pragma unroll
        for (int q = 0; q < 4; ++q) { const f32x4 v = *(const LAS f32x4*)(M2 + s_ * 20 + 4 * q); m[4 * q] = v.x; m[4 * q + 1] = v.y; m[4 * q + 2] = v.z; m[4 * q + 3] = v.w; }
        float acc = Kp[s_];
#pragma unroll
        for (int t = s_ + 1; t < 16; ++t) acc -= m[t] * Bp[t];
        asm volatile("" : "+v"(acc) :: "memory"); Kp[s_] = acc; __builtin_amdgcn_sched_barrier(0); }
    __builtin_amdgcn_sched_barrier(0);
    { float ng[16];
#pragma unroll
      for (int t = 0; t < 16; ++t) ng[t] = -Bp[t];
      *(v4u*)(CK + 256 + 4608 + lane * 32) = PACK8(ng, 0); *(v4u*)(CK + 256 + 4608 + lane * 32 + 16) = PACK8(ng, 8); }
    *(LAS v4u*)(TG + lane * 24) = PACK8(Kp, 0); *(LAS v4u*)(TG + lane * 24 + 8) = PACK8(Kp, 8);
    __builtin_amdgcn_sched_barrier(0);
    { float hh[16], ps[16];
#pragma unroll
      for (int s_ = 0; s_ < 16; ++s_) { hh[s_] = N1[s_ * 20 + fr]; ps[s_] = N2[s_ * 20 + fr]; }
#pragma unroll
      for (int s_ = 14; s_ >= 0; --s_) { float m[16];
#pragma unroll
        for (int q = 0; q < 4; ++q) { const f32x4 v = *(const LAS f32x4*)(M1 + s_ * 20 + 4 * q); m[4 * q] = v.x; m[4 * q + 1] = v.y; m[4 * q + 2] = v.z; m[4 * q + 3] = v.w; }
        float acc = hh[s_];
#pragma unroll
        for (int u = s_ + 1; u < 16; ++u) acc -= m[u] * hh[u];
        asm volatile("" : "+v"(acc) :: "memory"); hh[s_] = acc; __builtin_amdgcn_sched_barrier(0); }
#pragma unroll
      for (int s_ = 0; s_ < 15; ++s_) { float m[16];
#pragma unroll
        for (int q = 0; q < 4; ++q) { const f32x4 v = *(const LAS f32x4*)(M2 + s_ * 20 + 4 * q); m[4 * q] = v.x; m[4 * q + 1] = v.y; m[4 * q + 2] = v.z; m[4 * q + 3] = v.w; }
        float acc = ps[s_];
#pragma unroll
        for (int u = s_ + 1; u < 16; ++u) acc -= m[u] * hh[u];
        asm volatile("" : "+v"(acc) :: "memory"); ps[s_] = acc; __builtin_amdgcn_sched_barrier(0); }
      LDS_WAIT(); asm volatile("" ::: "memory");
#pragma unroll
      for (int s_ = 0; s_ < 16; ++s_) N1[s_ * 20 + fr] = hh[s_];
      *(LAS v4u*)(PST + fr * 24) = PACK8(ps, 0); *(LAS v4u*)(PST + fr * 24 + 8) = PACK8(ps, 8); }
    LDS_WAIT(); asm volatile("" ::: "memory");
    __builtin_amdgcn_sched_barrier(0);
#pragma unroll
    for (int s_ = 0; s_ < 16; ++s_) { float m[16];
#pragma unroll
        for (int q = 0; q < 4; ++q) { const f32x4 v = *(const LAS f32x4*)(N1 + s_ * 20 + 4 * q); m[4 * q] = v.x; m[4 * q + 1] = v.y; m[4 * q + 2] = v.z; m[4 * q + 3] = v.w; }
#pragma unroll
        for (int t = s_; t < 16; ++t) ro[t] -= m[t] * al[s_];
        asm volatile("" ::: "memory"); __builtin_amdgcn_sched_barrier(0); }
#pragma unroll
    for (int t = 0; t < 16; ++t) OMg[t * 72 + lane] = bfr1(ro[t]);
    LDS_WAIT(); asm volatile("" ::: "memory");
    __builtin_amdgcn_sched_barrier(0);
    { bf16x4 vf[4];
#pragma unroll
      for (int it = 0; it < 4; ++it) vf[it] = *(const LAS bf16x4*)(VT + (it * 16 + fr) * 24 + fq * 4);
#pragma unroll
      for (int kt = 0; kt < 4; ++kt) { const bf16x4 gf = *(const LAS bf16x4*)(TG + (kt * 16 + fr) * 24 + fq * 4);
#pragma unroll
        for (int it = 0; it < 4; ++it) { const f32x4 d = mfma16(gf, vf[it], zero4()); v2u dw; dw.x = pk2(d[0], d[1]); dw.y = pk2(d[2], d[3]); *(v2u*)(CP + it * WK_PRV + kt * 512 + lane * 8) = dw; } }
      const bf16x4 pf = *(const LAS bf16x4*)(PST + fr * 24 + fq * 4);
#pragma unroll
      for (int it = 0; it < 4; ++it) { const f32x4 o = mfma16(pf, vf[it], zero4()); *(f32x4*)(CP + it * WK_PRV + 2048 + lane * 16) = o; } }
    LDS_WAIT(); asm volatile("" ::: "memory");
}
constexpr int WQ_CH = WK_PRV + WK_SHR, WQ_SLOT = 4 * WQ_CH, WQ_PCS = WQ_CH / 16, WQ_NWL = 4 * WQ_PCS / 64;
__device__ __forceinline__ void wkv_seq_chunk(const LAS unsigned char* sp, f32x4 (&acc)[4], float* orow, int lane, int fr, int fq) {
    const LAS unsigned char* sh = sp + WK_PRV;
    bf16x8 af[2], of[2]; bf16x4 gf[4]; f32x4 wt[4], dt[4];
#pragma unroll
    for (int s = 0; s < 2; ++s) { const LAS bf16* ap = (const LAS bf16*)(sh + 256) + fr * 72 + 32 * s + 4 * fq; const v2u lo = *(const LAS v2u*)ap, hi = *(const LAS v2u*)(ap + 16);
        af[s] = __builtin_bit_cast(bf16x8, (v4u){lo.x, lo.y, hi.x, hi.y});
        const LAS bf16* op = (const LAS bf16*)(sh + 256 + 2304) + fr * 72 + 32 * s + 4 * fq; const v2u lo2 = *(const LAS v2u*)op, hi2 = *(const LAS v2u*)(op + 16);
        of[s] = __builtin_bit_cast(bf16x8, (v4u){lo2.x, lo2.y, hi2.x, hi2.y}); }
#pragma unroll
    for (int kt = 0; kt < 4; ++kt) { gf[kt] = *(const LAS bf16x4*)((const LAS bf16*)(sh + 256 + 4608) + (kt * 16 + fr) * 16 + 4 * fq);
        wt[kt] = *(const LAS f32x4*)(sh + (16 * kt + 4 * fq) * 4); { float f_[4]; unpack4(*(const LAS v2u*)(sp + kt * 512 + lane * 8), f_); dt[kt] = (f32x4){f_[0], f_[1], f_[2], f_[3]}; } }
    const f32x4 ov = *(const LAS f32x4*)(sp + 2048 + lane * 16);
    bf16x8 sbf[2];
#pragma unroll
    for (int s = 0; s < 2; ++s) { v4u w; w.x = pk2(acc[2 * s][0], acc[2 * s][1]); w.y = pk2(acc[2 * s][2], acc[2 * s][3]); w.z = pk2(acc[2 * s + 1][0], acc[2 * s + 1][1]); w.w = pk2(acc[2 * s + 1][2], acc[2 * s + 1][3]);
        sbf[s] = __builtin_bit_cast(bf16x8, w); }
    f32x4 x = zero4();
    x = __builtin_amdgcn_mfma_f32_16x16x32_bf16(af[0], sbf[0], x, 0, 0, 0); x = __builtin_amdgcn_mfma_f32_16x16x32_bf16(af[1], sbf[1], x, 0, 0, 0);
    f32x4 o = __builtin_amdgcn_mfma_f32_16x16x32_bf16(of[0], sbf[0], ov, 0, 0, 0); o = __builtin_amdgcn_mfma_f32_16x16x32_bf16(of[1], sbf[1], o, 0, 0, 0);
    v2u xw; xw.x = pk2(x[0], x[1]); xw.y = pk2(x[2], x[3]); const bf16x4 xb = __builtin_bit_cast(bf16x4, xw);
#pragma unroll
    for (int kt = 0; kt < 4; ++kt) acc[kt] = mfma16(gf[kt], xb, acc[kt] * wt[kt] + dt[kt]);
    orow[0] = o[0]; orow[512] = o[1]; orow[1024] = o[2]; orow[1536] = o[3];
}
__device__ __forceinline__ void wkv_seq_item(const Ctx& C, const Ax& a, int l, int item) {
    const int bh = item >> 2, rg = item & 3, b = bh >> 3, h = bh & 7, lane = C.lane, fr = lane & 15, fq = lane >> 4;
    const unsigned char* CK = a.ws + WS_CK + (size_t)bh * 128 * WK_SHR; const unsigned char* CP = a.ws + WS_CP + ((size_t)bh * 128 * 4 + rg) * WK_PRV;
    float* OC = (float*)(a.ws + WS_OC) + ((size_t)b * SEQ) * 512 + h * 64 + rg * 16 + fr;
#define WQ_COMPUTE(blk) do { const LAS unsigned char* sbp = C.lds + ((blk) % 3) * WQ_SLOT; \
            _Pragma("unroll 2") for (int cq = 0; cq < 4; ++cq) wkv_seq_chunk(sbp + cq * WQ_CH, acc, OC + (size_t)(((blk) * 4 + cq) * 16 + 4 * fq) * 512, lane, fr, fq); } while (0)
    static_assert(4 * WQ_PCS == WQ_NWL * 64 && WQ_NWL > 35 && WQ_NWL <= 42 && 3 * WQ_SLOT <= SCR_BYTES, "ring geometry");
    if (C.wave == 0) {
        f32x4 acc[4];
#pragma unroll
        for (int kt = 0; kt < 4; ++kt) acc[kt] = zero4();
        __builtin_amdgcn_s_barrier(); asm volatile("" ::: "memory");
        for (int blk = 0; blk < 32; ++blk) { WQ_COMPUTE(blk); asm volatile("s_waitcnt lgkmcnt(0)" ::: "memory"); __builtin_amdgcn_s_barrier(); asm volatile("" ::: "memory"); }
        float* so = a.out + O_WKVP + ((((size_t)l * NB + b) * 8 + h) * 64 + rg * 16 + fr) * 64 + 4 * fq;
#pragma unroll
        for (int kt = 0; kt < 4; ++kt) *(f32x4*)(so + 16 * kt) = acc[kt];
    } else {
        const int w1 = C.wave - 1; const bool seven = (w1 + 35) < WQ_NWL;
        const unsigned char* wsb = a.ws; unsigned qoff[6], qstr[6];
#pragma unroll
        for (int i = 0; i < 6; ++i) { const int p = (w1 + 7 * i) * 64 + lane, cq = p / WQ_PCS, q = p - cq * WQ_PCS; const bool pr = q < WK_PRV / 16;
            qoff[i] = pr ? (unsigned)(WS_CP + ((size_t)bh * 128 * 4 + rg) * WK_PRV) + (unsigned)(cq * 4 * WK_PRV + q * 16) : (unsigned)(WS_CK + (size_t)bh * 128 * WK_SHR) + (unsigned)(cq * WK_SHR + (q - WK_PRV / 16) * 16);
            qstr[i] = pr ? (unsigned)(16 * WK_PRV) : (unsigned)(4 * WK_SHR); }
#define WQ_DMA(blk) do { _Pragma("unroll") for (int i = 0; i < 6; ++i) if (i < 5 || seven) \
            __builtin_amdgcn_global_load_lds((const unsigned*)(wsb + (qoff[i] + (unsigned)(blk) * qstr[i])), (LAS unsigned*)(C.lds + ((blk) % 3) * WQ_SLOT + (w1 + 7 * i) * 1024), 16, 0, 0); } while (0)
#define WQ_WAIT_OLDER() do { if (seven) asm volatile("s_waitcnt vmcnt(6)" ::: "memory"); else asm volatile("s_waitcnt vmcnt(5)" ::: "memory"); } while (0)
        WQ_DMA(0); WQ_DMA(1); WQ_WAIT_OLDER();
        __builtin_amdgcn_s_barrier(); asm volatile("" ::: "memory");
        for (int blk = 0; blk < 32; ++blk) {
            if (blk + 2 < 32) { WQ_DMA(blk + 2); WQ_WAIT_OLDER(); }
            else asm volatile("s_waitcnt vmcnt(0)" ::: "memory");
            __builtin_amdgcn_s_barrier(); asm volatile("" ::: "memory");
        }
#undef WQ_DMA
#undef WQ_WAIT_OLDER
    }
#undef WQ_COMPUTE
    __syncthreads();
}
__device__ __forceinline__ void rwkv_sample_witem(const Ctx& C, const Ax& a, int l, int witem) {
    const float* RW = (const float*)(a.ws + WS_RW); float* OC = (float*)(a.ws + WS_OC);
    const int n = witem >> 4, h = (witem >> 1) & 7, half = witem & 1, g = C.lane & 15, rq = C.lane >> 4;
    const unsigned char* p = (const unsigned char*)RW + ((size_t)(MP + n) * 8 + h) * RWB;
    const f32x4 lw4 = *(const f32x4*)(p + 16 * g), kk4 = rw_ld4(p, RW_KK, 4 * g), b4 = rw_ld4(p, RW_KB, 4 * g), k4 = rw_ld4(p, RW_K, 4 * g), r4 = rw_ld4(p, RW_R, 4 * g);
    const f32x4 w4 = (f32x4){__expf(lw4.x), __expf(lw4.y), __expf(lw4.z), __expf(lw4.w)};
    const float* sin_ = a.in(I_SWKV) + (((size_t)l * NS + n) * 8 + h) * 4096; float* sout = a.out + O_WKVS + (((size_t)l * NS + n) * 8 + h) * 4096;
#pragma unroll 4
    for (int it = 0; it < 8; ++it) { const int i = half * 32 + it * 4 + rq; const f32x4 S = __builtin_nontemporal_load((const f32x4*)(sin_ + i * 64 + 4 * g)); const float vi = bf1(*(const bf16*)(p + RW_V + i * 2));
        const float sa = -rowsum16((S.x * kk4.x + S.y * kk4.y) + (S.z * kk4.z + S.w * kk4.w));
        f32x4 T; T.x = S.x * w4.x + (sa * b4.x + vi * k4.x); T.y = S.y * w4.y + (sa * b4.y + vi * k4.y); T.z = S.z * w4.z + (sa * b4.z + vi * k4.z); T.w = S.w * w4.w + (sa * b4.w + vi * k4.w);
        const float o = rowsum16((T.x * r4.x + T.y * r4.y) + (T.z * r4.z + T.w * r4.w));
        __builtin_nontemporal_store(T, (f32x4*)(sout + i * 64 + 4 * g));
        if (g == 0) OC[(size_t)(MP + n) * 512 + h * 64 + i] = o; }
}
__device__ __forceinline__ void rwkv_post_phase(const Ctx& C, const Ax& a, int l) {
    const float* RW = (const float*)(a.ws + WS_RW); const float* OC = (const float*)(a.ws + WS_OC); const float* GATE = (const float*)(a.ws + WS_GATE); bf16* YC = (bf16*)(a.ws + WS_YC);
    const int gw = C.bid * NWAVES + C.wave, NGW = C.G * NWAVES, g = C.lane & 15, rq = C.lane >> 4;
    const float* lg = a.in(I_LNXG) + l * 512; const float* lb = a.in(I_LNXB) + l * 512; const float* rk = a.in(I_RK) + l * 512;
    for (int it = gw; it < MT * 8 / 4; it += NGW) { const int pair = it * 4 + rq, row = pair >> 3, h = pair & 7, ch = h * 64 + 4 * g;
        const f32x4 o = *(const f32x4*)(OC + (size_t)row * 512 + ch);
        const float mu = rowsum16((o.x + o.y) + (o.z + o.w)) * (1.0f / 64.0f); const f32x4 d = o - mu;
        const float var = rowsum16((d.x * d.x + d.y * d.y) + (d.z * d.z + d.w * d.w)) * (1.0f / 64.0f); const float rstd = 1.0f / sqrtf(var + 64e-5f);
        const unsigned char* rw = (const unsigned char*)RW + ((size_t)row * 8 + h) * RWB;
        const f32x4 k4 = rw_ld4(rw, RW_K, 4 * g), r4 = rw_ld4(rw, RW_R, 4 * g), v4 = rw_ld4(rw, RW_V, 4 * g), rkv = *(const f32x4*)(rk + ch), gv = *(const f32x4*)(GATE + (size_t)row * 512 + ch);
        const float bs = rowsum16((r4.x * k4.x * rkv.x + r4.y * k4.y * rkv.y) + (r4.z * k4.z * rkv.z + r4.w * k4.w * rkv.w));
        const f32x4 y = (d * rstd * *(const f32x4*)(lg + ch) + *(const f32x4*)(lb + ch) + bs * v4) * gv;
        v2u w; w.x = pk2(y.x, y.y); w.y = pk2(y.z, y.w); *(v2u*)(YC + (size_t)row * DM + 1024 + ch) = w; }
}

__device__ __forceinline__ float ret_lg(int h) { return log1pf(-exp2f(-5.0f - (float)h)); }
constexpr int RS = 136;
__device__ __forceinline__ void rot8(const bf16* src, const float* cs, int c8, float scale, float (&lo)[8], float (&hi)[8]) {
    float x1[8], x2[8]; unpack8(*(const v4u*)(src + c8 * 8), x1); unpack8(*(const v4u*)(src + 64 + c8 * 8), x2);
    const f32x4* cp = (const f32x4*)(cs + 16 * c8); const f32x4 t0 = cp[0], t1 = cp[1], t2 = cp[2], t3 = cp[3];
    const float cc[8] = {t0.x, t0.z, t1.x, t1.z, t2.x, t2.z, t3.x, t3.z}, sn[8] = {t0.y, t0.w, t1.y, t1.w, t2.y, t2.w, t3.y, t3.w};
#pragma unroll
    for (int j = 0; j < 8; ++j) { lo[j] = (x1[j] * cc[j] - x2[j] * sn[j]) * scale; hi[j] = (x2[j] * cc[j] + x1[j] * sn[j]) * scale; }
}
__device__ __forceinline__ void ret_pass1_item(const Ctx& C, const Ax& a, int item) {
    const bf16* P = (const bf16*)(a.ws + WS_P); const float* CS = (const float*)(a.ws + WS_ROPE); float* KVT = (float*)(a.ws + WS_KVT);
    const int b = item >> 6, h = (item >> 4) & 3, c = item & 15; const size_t row0 = (size_t)b * SEQ + c * 128; const float lg = ret_lg(h);
    LAS bf16* KT = (LAS bf16*)C.lds; LAS bf16* VT = KT + 128 * RS;
    for (int it = C.tid; it < 128 * 8; it += NWAVES * 64) { const int tt = it & 127, c8 = it >> 7; float lo[8], hi[8];
        rot8(P + (row0 + tt) * PIN + PB_ + 512 + h * 128, CS + (size_t)(c * 128 + tt) * 128, c8, 0.08838834764831845f * __expf(lg * (float)(127 - tt)), lo, hi);
#pragma unroll
        for (int j = 0; j < 8; ++j) { KT[(c8 * 8 + j) * RS + tt] = (bf16)(pk2(lo[j], 0.f) & 0xffffu); KT[(64 + c8 * 8 + j) * RS + tt] = (bf16)(pk2(hi[j], 0.f) & 0xffffu); } }
    for (int it = C.tid; it < 128 * 16; it += NWAVES * 64) { const int tt = it & 127, c8 = it >> 7; const v4u w = *(const v4u*)(P + (row0 + tt) * PIN + PB_ + 1024 + h * 128 + c8 * 8);
        const unsigned ww[4] = {w.x, w.y, w.z, w.w};
#pragma unroll
        for (int j = 0; j < 4; ++j) { VT[(c8 * 8 + 2 * j) * RS + tt] = (bf16)(ww[j] & 0xffffu); VT[(c8 * 8 + 2 * j + 1) * RS + tt] = (bf16)(ww[j] >> 16); } }
    __syncthreads();
    const int fr = C.lane & 15, fq = C.lane >> 4, w = C.wave;
    f32x4 acc[8];
#pragma unroll
    for (int et = 0; et < 8; ++et) acc[et] = zero4();
#pragma unroll
    for (int ks = 0; ks < 4; ++ks) { const bf16x8 kf = *(const LAS bf16x8*)(KT + (16 * w + fr) * RS + ks * 32 + fq * 8);
#pragma unroll
        for (int et = 0; et < 8; ++et) { const bf16x8 vf = *(const LAS bf16x8*)(VT + (16 * et + fr) * RS + ks * 32 + fq * 8); acc[et] = __builtin_amdgcn_mfma_f32_16x16x32_bf16(kf, vf, acc[et], 0, 0, 0); } }
    float* o = KVT + (size_t)item * 16384;
#pragma unroll
    for (int et = 0; et < 8; ++et) *(f32x4*)(o + (size_t)(16 * et + fr) * 128 + 16 * w + 4 * fq) = acc[et];
    __syncthreads();
}
__device__ __forceinline__ void ret_prefix_phase(const Ctx& C, const Ax& a, int l) {
    const float* KVT = (const float*)(a.ws + WS_KVT); bf16* STB = (bf16*)(a.ws + WS_STB);
    const int gt = C.bid * (NWAVES * 64) + C.tid, NT = C.G * NWAVES * 64;
    for (int idx = gt; idx < 16 * 4096; idx += NT) { const int bh = idx >> 12, r = idx & 4095, e = r >> 5, d4 = (r & 31) * 4; const int h = bh & 3;
        const float g128 = __expf(ret_lg(h) * 128.0f); const size_t base = (size_t)bh * 16 * 16384 + e * 128 + d4;
        f32x4 kv[16];
#pragma unroll
        for (int c = 0; c < 16; ++c) kv[c] = *(const f32x4*)(KVT + base + (size_t)c * 16384);
        f32x4 S = zero4();
#pragma unroll
        for (int c = 0; c < 16; ++c) { v2u w; w.x = pk2(S.x, S.y); w.y = pk2(S.z, S.w); *(v2u*)(STB + base + (size_t)c * 16384) = w; S = S * g128 + kv[c]; }
        float* o = a.out + O_RETP + ((size_t)l * 16 + bh) * 16384 + e;
        o[(size_t)d4 * 128] = S.x; o[(size_t)(d4 + 1) * 128] = S.y; o[(size_t)(d4 + 2) * 128] = S.z; o[(size_t)(d4 + 3) * 128] = S.w; }
}
__device__ __forceinline__ void ret_pass2_item(const Ctx& C, const Ax& a, int l, int item) {
    const bf16* P = (const bf16*)(a.ws + WS_P); const float* CS = (const float*)(a.ws + WS_ROPE); bf16* YC = (bf16*)(a.ws + WS_YC);
    const int b = item >> 6, h = (item >> 4) & 3, c = item & 15; const size_t row0 = (size_t)b * SEQ + c * 128; const float lg = ret_lg(h);
    LAS bf16* QL = (LAS bf16*)C.lds; LAS bf16* KL = QL + 128 * RS; LAS bf16* VT = KL + 128 * RS; LAS bf16* ST = VT + 128 * RS;
    for (int it = C.tid; it < 128 * 8; it += NWAVES * 64) { const int tt = it & 127, c8 = it >> 7; float lo[8], hi[8]; const float* cs = CS + (size_t)(c * 128 + tt) * 128;
        rot8(P + (row0 + tt) * PIN + PB_ + h * 128, cs, c8, __expf(lg * (float)(tt + 1)), lo, hi);
        *(LAS v4u*)(QL + tt * RS + c8 * 8) = pack8(lo); *(LAS v4u*)(QL + tt * RS + 64 + c8 * 8) = pack8(hi);
        rot8(P + (row0 + tt) * PIN + PB_ + 512 + h * 128, cs, c8, 0.08838834764831845f * __expf(-lg * (float)(tt + 1)), lo, hi);
        *(LAS v4u*)(KL + tt * RS + c8 * 8) = pack8(lo); *(LAS v4u*)(KL + tt * RS + 64 + c8 * 8) = pack8(hi); }
    for (int it = C.tid; it < 128 * 16; it += NWAVES * 64) { const int tt = it & 127, c8 = it >> 7; const v4u w = *(const v4u*)(P + (row0 + tt) * PIN + PB_ + 1024 + h * 128 + c8 * 8);
        const unsigned ww[4] = {w.x, w.y, w.z, w.w};
#pragma unroll
        for (int j = 0; j < 4; ++j) { VT[(c8 * 8 + 2 * j) * RS + tt] = (bf16)(ww[j] & 0xffffu); VT[(c8 * 8 + 2 * j + 1) * RS + tt] = (bf16)(ww[j] >> 16); } }
    { const bf16* stb = (const bf16*)(a.ws + WS_STB) + (size_t)item * 16384;
      for (int it = C.tid; it < 128 * 16; it += NWAVES * 64) { const int e = it >> 4, dc = it & 15; *(LAS v4u*)(ST + e * RS + dc * 8) = *(const v4u*)(stb + e * 128 + dc * 8); } }
    __syncthreads();
    const int fr = C.lane & 15, fq = C.lane >> 4, w = C.wave, i0 = 16 * w;
    bf16x8 qf[4];
#pragma unroll
    for (int ks = 0; ks < 4; ++ks) qf[ks] = *(const LAS bf16x8*)(QL + (i0 + fr) * RS + ks * 32 + fq * 8);
    f32x4 sc[8];
#pragma unroll
    for (int jt = 0; jt < 8; ++jt) { sc[jt] = zero4();
        if (jt <= w) {
#pragma unroll
            for (int ks = 0; ks < 4; ++ks) { const bf16x8 kf = *(const LAS bf16x8*)(KL + (16 * jt + fr) * RS + ks * 32 + fq * 8); sc[jt] = __builtin_amdgcn_mfma_f32_16x16x32_bf16(kf, qf[ks], sc[jt], 0, 0, 0); }
            if (jt == w) {
#pragma unroll
                for (int r = 0; r < 4; ++r) if (4 * fq + r > fr) sc[jt][r] = 0.f; } } }
    __syncthreads();
    LAS bf16* PL = KL;
#pragma unroll
    for (int jt = 0; jt < 8; ++jt) { v2u pw; pw.x = pk2(sc[jt][0], sc[jt][1]); pw.y = pk2(sc[jt][2], sc[jt][3]); *(LAS v2u*)(PL + (i0 + fr) * RS + 16 * jt + 4 * fq) = pw; }
    LDS_WAIT(); asm volatile("" ::: "memory");
    f32x4 acc[8];
#pragma unroll
    for (int et = 0; et < 8; ++et) acc[et] = zero4();
#pragma unroll
    for (int ks = 0; ks < 4; ++ks) { if (2 * ks <= w) { const bf16x8 pf = *(const LAS bf16x8*)(PL + (i0 + fr) * RS + ks * 32 + fq * 8);
#pragma unroll
            for (int et = 0; et < 8; ++et) { const bf16x8 vf = *(const LAS bf16x8*)(VT + (16 * et + fr) * RS + ks * 32 + fq * 8); acc[et] = __builtin_amdgcn_mfma_f32_16x16x32_bf16(vf, pf, acc[et], 0, 0, 0); } } }
    if (c > 0) {
#pragma unroll
        for (int ks = 0; ks < 4; ++ks)
#pragma unroll
            for (int et = 0; et < 8; ++et) { const bf16x8 sf = *(const LAS bf16x8*)(ST + (16 * et + fr) * RS + ks * 32 + fq * 8); acc[et] = __builtin_amdgcn_mfma_f32_16x16x32_bf16(sf, qf[ks], acc[et], 0, 0, 0); } }
    float s = 0.f;
#pragma unroll
    for (int et = 0; et < 8; ++et) s += (acc[et][0] + acc[et][1]) + (acc[et][2] + acc[et][3]);
    s += __shfl_xor(s, 16); s += __shfl_xor(s, 32); const float mu = s * (1.0f / 128.0f);
    float q = 0.f;
#pragma unroll
    for (int et = 0; et < 8; ++et) { acc[et] = acc[et] - mu; q += (acc[et][0] * acc[et][0] + acc[et][1] * acc[et][1]) + (acc[et][2] * acc[et][2] + acc[et][3] * acc[et][3]); }
    q += __shfl_xor(q, 16); q += __shfl_xor(q, 32); const float rstd = 1.0f / sqrtf(q * (1.0f / 128.0f) + 1e-6f);
    const size_t row = row0 + i0 + fr;
#pragma unroll
    for (int et = 0; et < 8; ++et) { const int e = 16 * et + 4 * fq; float gg[4]; unpack4(*(const v2u*)(P + row * PIN + PB_ + 1536 + h * 128 + e), gg);
        v2u wv; wv.x = pk2(gg[0] * sigm(gg[0]) * acc[et][0] * rstd, gg[1] * sigm(gg[1]) * acc[et][1] * rstd); wv.y = pk2(gg[2] * sigm(gg[2]) * acc[et][2] * rstd, gg[3] * sigm(gg[3]) * acc[et][3] * rstd);
        *(v2u*)(YC + row * DM + 512 + h * 128 + e) = wv; }
    __syncthreads();
}
__device__ __forceinline__ void ret_sample_witem(const Ctx& C, const Ax& a, int l, int witem) {
    const bf16* P = (const bf16*)(a.ws + WS_P); const float* CS = (const float*)(a.ws + WS_ROPE) + (size_t)2048 * 128; bf16* YC = (bf16*)(a.ws + WS_YC);
    const int n = witem >> 2, h = witem & 3, lane = C.lane; const float gam = 1.0f - exp2f(-5.0f - (float)h);
    LAS float* qk = (LAS float*)(C.lds + C.wave * 1024);
    const bf16* pr = P + (size_t)(MP + n) * PIN + PB_ + h * 128;
    { const float co = CS[2 * lane], si = CS[2 * lane + 1]; const float q1 = bf1(pr[lane]), q2 = bf1(pr[64 + lane]), k1 = bf1(pr[512 + lane]), k2 = bf1(pr[512 + 64 + lane]);
      qk[lane] = q1 * co - q2 * si; qk[64 + lane] = q2 * co + q1 * si; qk[128 + lane] = (k1 * co - k2 * si) * 0.08838834764831845f; qk[192 + lane] = (k2 * co + k1 * si) * 0.08838834764831845f; }
    LDS_WAIT(); asm volatile("" ::: "memory");
    const float dotp = wave_sum(qk[lane] * qk[128 + lane] + qk[64 + lane] * qk[192 + lane]);
    const int half = lane >> 5, el = lane & 31;
    float vv[4]; unpack4(*(const v2u*)(pr + 1024 + 4 * el), vv); const f32x4 v4 = (f32x4){vv[0], vv[1], vv[2], vv[3]};
    const float* sin_ = a.in(I_SRET) + (((size_t)l * NS + n) * 4 + h) * 16384; float* sout = a.out + O_RETS + (((size_t)l * NS + n) * 4 + h) * 16384;
    f32x4 oa = zero4();
#pragma unroll 8
    for (int it = 0; it < 64; ++it) { const int d = 2 * it + half; const f32x4 S = __builtin_nontemporal_load((const f32x4*)(sin_ + (size_t)d * 128 + 4 * el)); const float qd = qk[d], kd = qk[128 + d];
        oa += qd * S; __builtin_nontemporal_store(gam * S + kd * v4, (f32x4*)(sout + (size_t)d * 128 + 4 * el)); }
    oa.x += __shfl_xor(oa.x, 32); oa.y += __shfl_xor(oa.y, 32); oa.z += __shfl_xor(oa.z, 32); oa.w += __shfl_xor(oa.w, 32);
    f32x4 o = gam * oa + dotp * v4;
    float s = (o.x + o.y) + (o.z + o.w);
#pragma unroll
    for (int m = 1; m < 32; m <<= 1) s += __shfl_xor(s, m);
    const float mu = s * (1.0f / 128.0f); o = o - mu; float q = (o.x * o.x + o.y * o.y) + (o.z * o.z + o.w * o.w);
#pragma unroll
    for (int m = 1; m < 32; m <<= 1) q += __shfl_xor(q, m);
    const float rstd = 1.0f / sqrtf(q * (1.0f / 128.0f) + 1e-6f);
    if (half == 0) { float gg[4]; unpack4(*(const v2u*)(pr + 1536 + 4 * el), gg);
        v2u wv; wv.x = pk2(gg[0] * sigm(gg[0]) * o.x * rstd, gg[1] * sigm(gg[1]) * o.y * rstd); wv.y = pk2(gg[2] * sigm(gg[2]) * o.z * rstd, gg[3] * sigm(gg[3]) * o.w * rstd);
        *(v2u*)(YC + (size_t)(MP + n) * DM + 512 + h * 128 + 4 * el) = wv; }
    LDS_WAIT(); asm volatile("" ::: "memory");
}

constexpr int XV_RS = 264;
__device__ __forceinline__ void xattn_prompt_unit(const Ctx& C, const Ax& a, int l, int unit) {
    const bf16* Q = (const bf16*)(a.ws + WS_Q); const bf16* MK = (const bf16*)(a.ws + WS_MK) + (size_t)l * MMEM * DM; const bf16* MVT = (const bf16*)(a.ws + WS_MVT) + (size_t)l * MMEM * DM; bf16* O = (bf16*)(a.ws + WS_O);
    const int b = unit >> 6, h = (unit >> 4) & 3, qt = unit & 15, fr = C.lane & 15, fq = C.lane >> 4;
    const size_t row = (size_t)b * SEQ + qt * 128 + C.wave * 16 + fr;
    LAS bf16* SB = (LAS bf16*)C.lds;
    v4u st[8];
    const bf16* kbase = MK + ((size_t)b * 256) * DM + h * 512; const bf16* vbase = MVT + (((size_t)b * 4 + h) * 512) * 256;
    unsigned kof[4], vof[8], sof[8];
#pragma unroll
    for (int i = 0; i < 8; ++i) { const int idx = C.tid + 512 * i, r = idx >> 5, c16 = idx & 31; vof[i] = (unsigned)(r * 256 + c16 * 8) * 2u; sof[i] = (unsigned)(r * XV_RS + c16 * 8) * 2u; if (i < 4) kof[i] = (unsigned)(r * DM + c16 * 8) * 2u; }
    const char* kb8 = (const char*)kbase; const char* vb8 = (const char*)vbase; LAS char* sb8 = (LAS char*)SB;
#define XK_LOAD(q) do { const char* pb_ = kb8 + ((size_t)(((q) & 3) * 64) * DM + ((q) >> 2) * 256) * 2; _Pragma("unroll") for (int i = 0; i < 4; ++i) st[i] = *(const v4u*)(pb_ + kof[i]); } while (0)
#define XK_STORE() do { _Pragma("unroll") for (int i = 0; i < 4; ++i) *(LAS v4u*)(sb8 + sof[i]) = st[i]; } while (0)
#define XV_LOAD(p) do { const char* pb_ = vb8 + (size_t)((p) * 128) * 256 * 2; _Pragma("unroll") for (int i = 0; i < 8; ++i) st[i] = *(const v4u*)(pb_ + vof[i]); } while (0)
#define XV_STORE() do { _Pragma("unroll") for (int i = 0; i < 8; ++i) *(LAS v4u*)(sb8 + sof[i]) = st[i]; } while (0)
    XK_LOAD(0);
    f32x4 sc[16];
#pragma unroll
    for (int jt = 0; jt < 16; ++jt) sc[jt] = zero4();
#pragma unroll
    for (int dh = 0; dh < 2; ++dh) {
        bf16x8 qf[8];
#pragma unroll
        for (int ks = 0; ks < 8; ++ks) qf[ks] = *(const bf16x8*)(Q + row * DM + h * 512 + dh * 256 + ks * 32 + fq * 8);
#pragma unroll
        for (int p = 0; p < 4; ++p) {
            __syncthreads(); XK_STORE(); __syncthreads();
            if (dh * 4 + p < 7) XK_LOAD(dh * 4 + p + 1); else XV_LOAD(0);
#pragma unroll
            for (int j4 = 0; j4 < 4; ++j4) {
#pragma unroll
                for (int ks = 0; ks < 8; ++ks) { const bf16x8 kf = *(const LAS bf16x8*)(SB + (j4 * 16 + fr) * XV_RS + ks * 32 + fq * 8); sc[p * 4 + j4] = __builtin_amdgcn_mfma_f32_16x16x32_bf16(kf, qf[ks], sc[p * 4 + j4], 0, 0, 0); }
                __builtin_amdgcn_sched_barrier(0); }
        }
    }
    float mx = -3.0e38f;
#pragma unroll
    for (int jt = 0; jt < 16; ++jt) mx = fmaxf(mx, fmaxf(fmaxf(sc[jt][0], sc[jt][1]), fmaxf(sc[jt][2], sc[jt][3])));
    mx = fmaxf(mx, __shfl_xor(mx, 16)); mx = fmaxf(mx, __shfl_xor(mx, 32));
    const float scale = 0.04419417382415922f; float sum = 0.f;
    bf16x8 pf[8];
#pragma unroll
    for (int s = 0; s < 8; ++s) { float p[8];
#pragma unroll
        for (int j = 0; j < 4; ++j) { p[j] = __expf((sc[2 * s][j] - mx) * scale); p[4 + j] = __expf((sc[2 * s + 1][j] - mx) * scale); }
        sum += ((p[0] + p[1]) + (p[2] + p[3])) + ((p[4] + p[5]) + (p[6] + p[7]));
        const v4u w = pack8(p); pf[s] = __builtin_bit_cast(bf16x8, w); }
    sum += __shfl_xor(sum, 16); sum += __shfl_xor(sum, 32); const float inv = 1.0f / sum;
#pragma unroll
    for (int p = 0; p < 4; ++p) {
        __syncthreads(); XV_STORE(); __syncthreads();
        if (p < 3) XV_LOAD(p + 1);
#pragma unroll
        for (int et = 0; et < 8; ++et) { f32x4 s4 = zero4(); const LAS bf16* vp = SB + (et * 16 + fr) * XV_RS + 4 * fq;
#pragma unroll
            for (int s = 0; s < 8; ++s) { const v2u lo = *(const LAS v2u*)(vp + 32 * s), hi = *(const LAS v2u*)(vp + 32 * s + 16); const v4u w = (v4u){lo.x, lo.y, hi.x, hi.y};
                s4 = __builtin_amdgcn_mfma_f32_16x16x32_bf16(__builtin_bit_cast(bf16x8, w), pf[s], s4, 0, 0, 0); }
            v2u w; w.x = pk2(s4[0] * inv, s4[1] * inv); w.y = pk2(s4[2] * inv, s4[3] * inv);
            *(v2u*)(O + row * DM + h * 512 + p * 128 + et * 16 + 4 * fq) = w;
            __builtin_amdgcn_sched_barrier(0); }
    }
    __syncthreads();
#undef XK_LOAD
#undef XK_STORE
#undef XV_LOAD
#undef XV_STORE
}
__device__ __forceinline__ void xattn_sample_item(const Ctx& C, const Ax& a, int l, int item) {
    const bf16* Q = (const bf16*)(a.ws + WS_Q); bf16* O = (bf16*)(a.ws + WS_O);
    const int n = item >> 2, h = item & 3, lane = C.lane, w = C.wave;
    LAS float* red = (LAS float*)C.lds; LAS float* part = red + 64;
    float q[8]; { const float* s0 = (const float*)(a.ws + WS_SPL) + (size_t)n * DM + h * 512 + 4 * lane; const float* s1 = s0 + (size_t)NS * DM;
                  const f32x4 a0 = *(const f32x4*)s0 + *(const f32x4*)s1, a1 = *(const f32x4*)(s0 + 256) + *(const f32x4*)(s1 + 256);
                  q[0] = a0.x; q[1] = a0.y; q[2] = a0.z; q[3] = a0.w; q[4] = a1.x; q[5] = a1.y; q[6] = a1.z; q[7] = a1.w; }
    const size_t base = ((((size_t)l * NS + n) * 256 + 32 * w) * 4 + h) * 512 + 4 * lane;
    const float* kp = a.in(I_CMK) + base; const float* vp = a.in(I_CMV) + base;
#define XS_LOAD(buf0, buf1, ptr, k8) do { _Pragma("unroll") for (int j = 0; j < 8; ++j) { buf0[j] = __builtin_nontemporal_load((const f32x4*)((ptr) + (size_t)((k8) * 8 + j) * 2048)); buf1[j] = __builtin_nontemporal_load((const f32x4*)((ptr) + (size_t)((k8) * 8 + j) * 2048 + 256)); } } while (0)
#define XS_DOT(buf0, buf1, k8) do { _Pragma("unroll") for (int j = 0; j < 8; ++j) { float d = (buf0[j].x * q[0] + buf0[j].y * q[1]) + (buf0[j].z * q[2] + buf0[j].w * q[3]) + (buf1[j].x * q[4] + buf1[j].y * q[5]) + (buf1[j].z * q[6] + buf1[j].w * q[7]); \
        d = rowsum16(d); d += __shfl_xor(d, 16); d += __shfl_xor(d, 32); if (lane == (k8) * 8 + j) myscore = d; } } while (0)
#define XS_ACC(buf0, buf1, k8) do { _Pragma("unroll") for (int j = 0; j < 8; ++j) { const float pj = __builtin_bit_cast(float, __builtin_amdgcn_readlane(__builtin_bit_cast(int, p), (k8) * 8 + j)); o0 += pj * buf0[j]; o1 += pj * buf1[j]; } } while (0)
    float myscore = 0.f;
    f32x4 xa0[8], xa1[8], xb0[8], xb1[8];
    XS_LOAD(xa0, xa1, kp, 0);
    XS_LOAD(xb0, xb1, kp, 1); XS_DOT(xa0, xa1, 0);
    XS_LOAD(xa0, xa1, kp, 2); XS_DOT(xb0, xb1, 1);
    XS_LOAD(xb0, xb1, kp, 3); XS_DOT(xa0, xa1, 2);
    XS_LOAD(xa0, xa1, vp, 0); XS_DOT(xb0, xb1, 3);
    const float scale = 0.04419417382415922f;
    float mx = wave_max(lane < 32 ? myscore : -3.0e38f); if (lane == 0) red[w] = mx; __syncthreads();
    mx = red[0];
#pragma unroll
    for (int i = 1; i < 8; ++i) mx = fmaxf(mx, red[i]);
    const float p = lane < 32 ? __expf((myscore - mx) * scale) : 0.f;
    const float ps = wave_sum(p); if (lane == 0) red[8 + w] = ps;
    f32x4 o0 = zero4(), o1 = zero4();
    XS_LOAD(xb0, xb1, vp, 1); XS_ACC(xa0, xa1, 0);
    XS_LOAD(xa0, xa1, vp, 2); XS_ACC(xb0, xb1, 1);
    XS_LOAD(xb0, xb1, vp, 3); XS_ACC(xa0, xa1, 2);
    XS_ACC(xb0, xb1, 3);
#undef XS_LOAD
#undef XS_DOT
#undef XS_ACC
    *(LAS f32x4*)(part + w * 512 + 4 * lane) = o0; *(LAS f32x4*)(part + w * 512 + 256 + 4 * lane) = o1;
    __syncthreads();
    float tot = 0.f;
#pragma unroll
    for (int i = 0; i < 8; ++i) tot += red[8 + i];
    { const int d = C.tid; float s = 0.f;
#pragma unroll
      for (int i = 0; i < 8; ++i) s += part[i * 512 + d];
      O[(size_t)(MP + n) * DM + h * 512 + d] = (bf16)(pk2(s / tot, 0.f) & 0xffffu); }
    __syncthreads();
}

#ifndef PHASE_MASK
#define PHASE_MASK 0xffffffffu
#endif
#define PM(k) ((PHASE_MASK >> (k)) & 1u)
#ifndef DUP_SUB
#define DUP_SUB 0u
#endif
#define REP(k) for (int rep_ = 0; rep_ < 1 + (int)((DUP_SUB >> (k)) & 1u); ++rep_)
#ifndef DUP_MASK
#define DUP_MASK 0
#endif
#ifndef MK_ONE_LAUNCH
#define MK_ONE_LAUNCH 1
#endif
constexpr int PH_PER_LAYER = 14, NPH = 1 + DEPTH * PH_PER_LAYER;
__global__ void __launch_bounds__(NWAVES * 64, 2) fwd_kernel(Args args) {
    extern __shared__ __attribute__((aligned(16))) unsigned char lds_raw[];
    LAS unsigned char* const lds = (LAS unsigned char*)lds_raw;
    const int wave_s = __builtin_amdgcn_readfirstlane((int)threadIdx.x >> 6);
    volatile LAS unsigned* MISC = (volatile LAS unsigned*)(lds + MISC_OFF);
    for (int u = threadIdx.x; u < (LDS_BYTES - MISC_OFF) / 4; u += NWAVES * 64) ((LAS unsigned*)(lds + MISC_OFF))[u] = 0u;
    __syncthreads();
    XcdBarrier bar; bar.bar = (unsigned*)(args.ws + WS_CTL) + CW_BAR; bar.x = 0; bar.st = nullptr;
    if (MK_ONE_LAUNCH) bar = xcd_barrier_post((unsigned*)(args.ws + WS_CTL) + CW_BAR, MISC + 8);
    bar.wave = wave_s;
    const int lo = args.ph_lo, hi = args.ph_hi;
#define IN(k) (lo <= (k) && (k) < hi)
#define SEAM(k) do { if (MK_ONE_LAUNCH && IN((k) + 1)) xcd_barrier(bar); } while (0)
#define SEAM2(k) do { if (MK_ONE_LAUNCH && IN((k) + 2)) xcd_barrier(bar); } while (0)
#define PHASE_CTX const Ctx C = mk_ctx(lds, wave_s); const Ax a = mk_ax(); unsigned char* const ws = a.ws; const int G = C.G, bid = C.bid; (void)ws; (void)G; (void)bid; \
    float* const XF = (float*)(ws + WS_XF); bf16* const HN = (bf16*)(ws + WS_HN); bf16* const PBUF = (bf16*)(ws + WS_P); bf16* const YC = (bf16*)(ws + WS_YC); bf16* const QB = (bf16*)(ws + WS_Q); \
    bf16* const OB = (bf16*)(ws + WS_O); bf16* const UB = (bf16*)(ws + WS_U); (void)XF; (void)HN; (void)PBUF; (void)YC; (void)QB; (void)OB; (void)UB

    if (IN(0)) { PHASE_CTX; if (PM(0)) p0_prologue(C, a); SEAM(0); }

    for (int l = 0; l < DEPTH; ++l) {
        const int pb = 1 + l * PH_PER_LAYER;
        if (IN(pb + 0)) { PHASE_CTX; const unsigned char* wl = ws + WS_WL + (size_t)l * LW_STRIDE;
            if (PM(1)) { pg8::Gemm g{HN, (const bf16*)(wl + LW_IN), MPAD, PIN, DM, DM, 64, (size_t)PIN * 128}; pg8::StaticOrder S; S.init(MPAD, PIN, G, bid); pg8::EpiBf16A<0> E{PBUF, PIN, nullptr};
              pg8::gemm_phase<pg8::EpiBf16A<0>, pg8::StaticOrder, true, true>(lds, g, S, E, C.tid); }
            if (G == 256) { const int nfull = (MPAD / 256) * (PIN / 256) - 3 * G;
                if ((bid >= nfull && bid < 64) || bid >= 128) { __syncthreads(); late_convert(C, a, l, bid < 64 ? bid - nfull : bid - 128 + (64 - nfull), (64 - nfull) + (G - 128)); } }
            if (PM(2)) { pg8::Gemm g{(const bf16*)(ws + WS_MN), (const bf16*)(ws + WS_WKV) + (size_t)l * 4096 * 64, MMEM, 4096, DM, DM, 64, (size_t)8192 * 128}; pg8::StaticOrder S; S.init(MMEM, 4096, G, (bid + G - (64 % G)) % G);
              pg8::EpiMemKV E{a.out + O_MKP + (size_t)l * MMEM * DM, (bf16*)(ws + WS_MK) + (size_t)l * MMEM * DM, (bf16*)(ws + WS_MVT) + (size_t)l * MMEM * DM};
              pg8::gemm_phase<pg8::EpiMemKV, pg8::StaticOrder, true, true>(lds, g, S, E, C.tid); }
            SEAM(pb + 0);
        }
        if (IN(pb + 1)) { PHASE_CTX;
#ifdef DEBUG_P
            { const int gt = bid * 512 + C.tid, NT = G * 512;
              for (int idx = gt + (DEBUG_P == 2 ? MP * 2048 : 0); idx < (DEBUG_P == 1 ? MP : MT) * 2048; idx += NT) { const int row = idx >> 11, c = idx & 2047; const bf16* pr = PBUF + (size_t)row * PIN;
                  float s = bf1(pr[c]) + bf1(pr[c + 2048]) + bf1(pr[c + 4096]); if (c < 256) s += bf1(pr[c + 6144]); a.out[O_YP + idx] = s; } }
#endif
            if ((bid >> 3) & 1) { if (PM(8)) REP(8) for (int it = bid * NWAVES + C.wave; it < NS * 4; it += G * NWAVES) ret_sample_witem(C, a, l, it); __syncthreads(); }
            if (PM(4)) REP(4) for (int it = bid; it < 256; it += G) ad_prompt_item(C, a, l, it);
            if (PM(5)) REP(5) for (int it = bid; it < 256; it += G) ret_pass1_item(C, a, it);
            if (PM(6)) REP(6) for (int it = bid; it < 256; it += G) rwkv_prep_item(C, a, l, it);
            if (PM(6)) for (int it = bid - 64; it >= 0 && it < 4; it += G) rwkv_prep_item(C, a, l, 256 + it);
            if (PM(7)) REP(7) for (int it = G - 1 - bid; it < NS; it += G) ad_sample_item(C, a, l, it);
            if (!((bid >> 3) & 1)) { if (PM(8)) REP(8) for (int it = bid * NWAVES + C.wave; it < NS * 4; it += G * NWAVES) ret_sample_witem(C, a, l, it); }
            __syncthreads();
            SEAM(pb + 1);
        }
        if (IN(pb + 2)) { PHASE_CTX;
            if ((bid >> 3) & 1) { if (PM(10)) REP(10) for (int it = bid * NWAVES + C.wave; it < NS * 16; it += G * NWAVES) rwkv_sample_witem(C, a, l, it); }
            if (PM(9)) REP(9) for (int it = bid * NWAVES + C.wave; it < 4096; it += G * NWAVES) wkv_chunk_witem(C, a, it);
            if (!((bid >> 3) & 1)) { if (PM(10)) REP(10) for (int it = bid * NWAVES + C.wave; it < NS * 16; it += G * NWAVES) rwkv_sample_witem(C, a, l, it); }
            if (PM(11)) ret_prefix_phase(C, a, l);
            SEAM(pb + 2);
        }
        if (IN(pb + 3)) { PHASE_CTX; const int hg = G / 2;
            if (PM(22)) REP(22) for (int it = bid; it < 128; it += (bid < hg ? hg : 1 << 20)) wkv_seq_item(C, a, l, it);
            if (PM(11)) REP(11) if (bid >= hg || G < 2) for (int it = bid - hg; it < 256; it += G - hg) ret_pass2_item(C, a, l, it);
            SEAM(pb + 3);
        }
        if (IN(pb + 4)) { PHASE_CTX;
            if (PM(12)) REP(12) rwkv_post_phase(C, a, l);
            SEAM(pb + 4);
        }
        if (IN(pb + 5)) { PHASE_CTX; const unsigned char* wl = ws + WS_WL + (size_t)l * LW_STRIDE;
            pg8::Gemm g{YC, (const bf16*)(wl + LW_OUT), MP, DM, DM, DM, 64, (size_t)DM * 128}; pg8::StaticOrder S; S.init(MP, DM, G, bid); pg8::EpiRes E{XF, DM, ((DUP_MASK >> 5) & 1) ? 0.5f : 1.0f, (l == 0 && !((DUP_MASK >> 5) & 1)) ? a.in(I_XP) : (const float*)XF};
            if (PM(15)) pg8::gemm_phase<pg8::EpiRes, pg8::StaticOrder, true, true>(lds, g, S, E, C.tid);
            if (PM(20)) sample_gemm(lds, C.tid, YC + (size_t)MP * DM, DM, (const bf16*)(wl + LW_OUT), DM, DM, DM, G, bid, SEpiRes{XF + (size_t)MP * DM, DM, ((DUP_MASK >> 5) & 1) ? 0.5f : 1.0f, (l == 0 && !((DUP_MASK >> 5) & 1)) ? a.in(I_XS) : (const float*)(XF + (size_t)MP * DM)});
            SEAM(pb + 5);
        }
        if (IN(pb + 6)) { PHASE_CTX; if (PM(21)) REP(21) rms_phase(C, XF, HN); SEAM(pb + 6);
#ifdef XBAR_PROBE
            if (MK_ONE_LAUNCH) for (int i_ = 0; i_ < XBAR_PROBE; ++i_) xcd_barrier(bar);
#endif
        }
        if (IN(pb + 7)) { PHASE_CTX; const unsigned char* wl = ws + WS_WL + (size_t)l * LW_STRIDE;
            pg8::Gemm g{HN, (const bf16*)(wl + LW_Q), MP, DM, DM, DM, 64, (size_t)DM * 128}; pg8::StaticOrder S; S.init(MP, DM, G, bid); pg8::EpiBf16A<0> E{QB, DM, nullptr};
            if (PM(16)) REP(16) pg8::gemm_phase<pg8::EpiBf16A<0>, pg8::StaticOrder, true, true>(lds, g, S, E, C.tid);
            if (PM(20)) sample_gemm(lds, C.tid, HN + (size_t)MP * DM, DM, (const bf16*)(wl + LW_Q), DM, DM, DM, G, bid, SEpiPart{(float*)(ws + WS_SPL), DM}, 2);
            SEAM(pb + 7);
        }
        if (IN(pb + 8)) { PHASE_CTX;
            { const int g3 = (bid >> 3) % 3;
              if (g3 == 0) { if (PM(13)) REP(13) for (int it = bid; it < 256; it += G) xattn_prompt_unit(C, a, l, it); }
              if (PM(14)) REP(14) for (int it = bid; it < NS * 4; it += 2 * G) xattn_sample_item(C, a, l, it);
              if (g3 == 1) { if (PM(13)) REP(13) for (int it = bid; it < 256; it += G) xattn_prompt_unit(C, a, l, it); }
              if (PM(14)) REP(14) for (int it = bid + G; it < NS * 4; it += 2 * G) xattn_sample_item(C, a, l, it);
              if (g3 == 2) { if (PM(13)) REP(13) for (int it = bid; it < 256; it += G) xattn_prompt_unit(C, a, l, it); } }
            SEAM(pb + 8);
        }
        if (IN(pb + 9)) { PHASE_CTX; const unsigned char* wl = ws + WS_WL + (size_t)l * LW_STRIDE;
            pg8::Gemm g{OB, (const bf16*)(wl + LW_O), MP, DM, DM, DM, 64, (size_t)DM * 128}; pg8::StaticOrder S; S.init(MP, DM, G, bid); pg8::EpiRes E{XF, DM, ((DUP_MASK >> 9) & 1) ? 0.5f : 1.0f, XF};
            if (PM(17)) pg8::gemm_phase<pg8::EpiRes, pg8::StaticOrder, true, true>(lds, g, S, E, C.tid);
            if (PM(20)) sample_gemm(lds, C.tid, OB + (size_t)MP * DM, DM, (const bf16*)(wl + LW_O), DM, DM, DM, G, bid, SEpiRes{XF + (size_t)MP * DM, DM, ((DUP_MASK >> 9) & 1) ? 0.5f : 1.0f, XF + (size_t)MP * DM});
            SEAM(pb + 9);
        }
        if (IN(pb + 10)) { PHASE_CTX; if (PM(21)) REP(21) rms_phase(C, XF, HN); SEAM(pb + 10); }
        if (IN(pb + 11)) { PHASE_CTX; const unsigned char* wl = ws + WS_WL + (size_t)l * LW_STRIDE;
            pg8::Gemm g{HN, (const bf16*)(wl + LW_UP), MP, DFF, DM, DM, 64, (size_t)DFF * 128}; pg8::StaticOrder S; S.init(MP, DFF, G, bid); pg8::EpiBf16A<3> E{UB, LDU, nullptr};
            if (PM(18)) REP(18) pg8::gemm_phase<pg8::EpiBf16A<3>, pg8::StaticOrder, true, true>(lds, g, S, E, C.tid);
            if (PM(20)) sample_gemm(lds, C.tid, HN + (size_t)MP * DM, DM, (const bf16*)(wl + LW_UP), DFF, DFF, DM, G, bid, SEpiBf16{UB + (size_t)MP * LDU, LDU, 3, nullptr});
            SEAM(pb + 11);
        }
        if (IN(pb + 12)) { PHASE_CTX; const unsigned char* wl = ws + WS_WL + (size_t)l * LW_STRIDE;
            pg8::Gemm g{UB, (const bf16*)(wl + LW_DN), MP, DM, DFF, LDU, 64, (size_t)DM * 128}; pg8::StaticOrder S; S.init(MP, DM, G, bid); pg8::EpiRes E{XF, DM, ((DUP_MASK >> 12) & 1) ? 0.5f : 1.0f, XF};
            if (PM(19)) pg8::gemm_phase<pg8::EpiRes, pg8::StaticOrder, true, true>(lds, g, S, E, C.tid);
            if (PM(20)) sample_gemm(lds, C.tid, UB + (size_t)MP * LDU, LDU, (const bf16*)(wl + LW_DN), DM, DM, DFF, G, bid, SEpiPart{(float*)(ws + WS_SPL), DM}, 2);
            SEAM(pb + 12);
        }
        if (IN(pb + 13)) { PHASE_CTX;
            fold_split_rows(C, XF, (const float*)(ws + WS_SPL));
            if (!PM(21)) {} else if (l + 1 < DEPTH) REP(21) rms_phase(C, XF, HN); else final_norm_phase(C, XF, a.in(I_GFIN), a.out + O_YP);
            SEAM(pb + 13);
        }
    }
#undef IN
#undef SEAM
#undef SEAM2
#undef PHASE_CTX
}

extern "C" void kernel_launch(void* const* d_in, const int* in_sizes, int n_in, void* d_out, int out_size, void* d_ws, size_t ws_size, hipStream_t stream) {
    static int grid = 0;
    if (grid == 0) {
        if (n_in != NIN || (size_t)out_size != O_END || ws_size < WS_END) { fprintf(stderr, "kernel_launch: unexpected shapes (n_in %d, out %d, ws %zu); nothing launched\n", n_in, out_size, ws_size); grid = -1; return; }
        int dev = 0, cus = 0, per_cu = 0;
        if (hipGetDevice(&dev) != hipSuccess || hipDeviceGetAttribute(&cus, hipDeviceAttributeMultiprocessorCount, dev) != hipSuccess) { grid = -1; return; }
        if (hipFuncSetAttribute((const void*)fwd_kernel, hipFuncAttributeMaxDynamicSharedMemorySize, LDS_BYTES) != hipSuccess) { fprintf(stderr, "kernel_launch: hipFuncSetAttribute failed\n"); grid = -1; return; }
        if (hipOccupancyMaxActiveBlocksPerMultiprocessor(&per_cu, (const void*)fwd_kernel, NWAVES * 64, LDS_BYTES) != hipSuccess || per_cu < 1) { fprintf(stderr, "kernel_launch: occupancy query reports %d\n", per_cu); }
        (void)hipGetLastError();
        grid = cus;
    }
    if (grid < 0) return;
    if (hipMemsetAsync((char*)d_ws + WS_CTL, 0, CTL_ZERO_BYTES, stream) != hipSuccess) return;
    Args a{};
    for (int i = 0; i < NIN; ++i) a.in[i] = (const float*)d_in[i];
    a.out = (float*)d_out; a.ws = (unsigned char*)d_ws;
#if MK_ONE_LAUNCH
    a.ph_lo = 0; a.ph_hi = NPH;
    hipLaunchKernelGGL(fwd_kernel, dim3(grid), dim3(NWAVES * 64), LDS_BYTES, stream, a);
#else
#ifndef NPH_RUN
#define NPH_RUN NPH
#endif
    for (int ph = 0; ph < NPH_RUN; ++ph) { a.ph_lo = ph; a.ph_hi = ph + 1; hipLaunchKernelGGL(fwd_kernel, dim3(grid), dim3(NWAVES * 64), LDS_BYTES, stream, a);
        const int dbit = (ph == 0) ? 13 : (ph - 1) % PH_PER_LAYER;
        if ((DUP_MASK >> dbit) & 1) hipLaunchKernelGGL(fwd_kernel, dim3(grid), dim3(NWAVES * 64), LDS_BYTES, stream, a); }
#endif
}
```

```cpp
#include <hip/hip_runtime.h>
#include <cstdio>
#include <cstdint>
namespace pg8 {
#define PG8_LAS __attribute__((address_space(3)))
typedef unsigned short bf16_t;
typedef short bf16x8 __attribute__((ext_vector_type(8)));
typedef float f32x4 __attribute__((ext_vector_type(4)));
typedef unsigned u32x4 __attribute__((ext_vector_type(4)));
constexpr int BM = 256, BK = 64, HALF = 128, HTB = HALF * BK * 2  , STAGE_BYTES = 8 * HTB, NXCD = 8, WGM = 8;

__host__ __device__ __forceinline__ int lds_byte(int r, int c) { const int st = (r >> 4) * 2 + (c >> 5), rr = r & 15, cc = c & 31, ob = rr * 64 + cc * 2; return st * 1024 + (ob ^ (((ob >> 9) & 1) << 5)); }
__host__ __device__ __forceinline__ void stage_rc(int b, int& R, int& C) { const int st = b / 1024, sb = b % 1024, swz = sb ^ (((sb >> 9) & 1) << 5); R = (st >> 1) * 16 + swz / 64; C = (st & 1) * 32 + (swz % 64) / 2; }
__host__ __device__ __forceinline__ int perm32(int rho) { const int n = rho >> 4, i = rho & 15; return 8 * (i >> 2) + 4 * n + (i & 3); }

struct Unit { int pm, pn; };
struct Gemm { const bf16_t* A; const bf16_t* Bt; int M, N, K, lda, ldb; size_t ksb; };

struct StaticOrder {
    int nM, nN, nwg, G, c;
    __host__ __device__ void init(int M, int N, int G_, int c_) { nM = M / BM; nN = N / BM; nwg = nM * nN; G = G_; c = c_; }
    __host__ __device__ bool next(int i, Unit& u) const {
        const long L = (long)i * G + c; if (L >= nwg) return false;
        int wgid = (int)L; { const int q = nwg / NXCD, r = nwg % NXCD, xcd = wgid % NXCD, off = wgid / NXCD; wgid = (xcd < r ? xcd * (q + 1) : r * (q + 1) + (xcd - r) * q) + off; }
        const int nig = WGM * nN, gid = wgid / nig, fm = gid * WGM, gsz = (nM - fm) < WGM ? (nM - fm) : WGM;
        u.pm = fm + ((wgid % nig) % gsz); u.pn = (wgid % nig) / gsz; return true;
    }
    __device__ __forceinline__ void a_ready(const Unit&) const {}
    __device__ __forceinline__ void done(const Unit&) const {}
};

typedef float f32x2_cv __attribute__((ext_vector_type(2)));
typedef __bf16 bf16x2_cv __attribute__((ext_vector_type(2)));
__device__ __forceinline__ unsigned cvt_pk_bf16(float lo, float hi) { const f32x2_cv v = {lo, hi}; return __builtin_bit_cast(unsigned, __builtin_convertvector(v, bf16x2_cv)); }
typedef float f32x2 __attribute__((ext_vector_type(2)));
template <class Epi, class Sched, bool ALIGN_EPI = false, bool SP2 = false>
__device__ __forceinline__ void gemm_phase(PG8_LAS unsigned char* lds, const Gemm g, const Sched& S, const Epi& E, int tid_in) {
    int tid_ = tid_in; asm volatile("" : "+v"(tid_));
    const int tid = tid_, wid = __builtin_amdgcn_readfirstlane(tid >> 6), lane = tid & 63, wr = wid >> 2, wc = wid & 3, fr = lane & 15, fq = lane >> 4;
    const int K = g.K, nt = K / BK;
    unsigned voffA[2], voffB[2];
#pragma unroll
    for (int i = 0; i < 2; ++i) { int R, C; stage_rc(tid * 16 + i * 8192, R, C); const int Rb = Epi::PERM ? ((R & ~31) + perm32(R & 31)) : R;
        voffA[i] = (unsigned)(R * g.lda + C) * 2u; voffB[i] = (unsigned)(Rb * g.ldb + C) * 2u; }
    const size_t kstep = (size_t)(BK * 2), kstepB = g.ksb;
    const size_t hstepA = (size_t)HALF * g.lda * 2, hstepB = (size_t)HALF * g.ldb * 2;
    const size_t tstepA = 2 * hstepA, tstepB = 2 * hstepB;
    const unsigned ldsw = (unsigned)wid * 1024u;
    const int aoff = lds_byte(wr * 64 + fr, fq * 8), boff = lds_byte(wc * 32 + fr, fq * 8);
#define PG8_SA(b, h) (((b) * 2 + (h)) * HTB)
#define PG8_SB(b, h) ((4 + (b) * 2 + (h)) * HTB)
#define PG8_STAGE(bufoff, gbase, voff) do { _Pragma("unroll") for (int _i = 0; _i < 2; ++_i) \
        __builtin_amdgcn_global_load_lds((const unsigned*)((const char*)(gbase) + (voff)[_i]), (PG8_LAS unsigned*)(lds + (bufoff) + ldsw + _i * 8192), 16, 0, 0); } while (0)
#define PG8_LDA(dst, b, h) do { _Pragma("unroll") for (int m = 0; m < 4; ++m) _Pragma("unroll") for (int k = 0; k < 2; ++k) dst[m][k] = *(const PG8_LAS bf16x8*)(lds + PG8_SA(b, h) + aoff + m * 2048 + k * 1024); } while (0)
#define PG8_LDB(dst, b, h) do { _Pragma("unroll") for (int n = 0; n < 2; ++n) _Pragma("unroll") for (int k = 0; k < 2; ++k) dst[n][k] = *(const PG8_LAS bf16x8*)(lds + PG8_SB(b, h) + boff + n * 2048 + k * 1024); } while (0)
#define PG8_MMA(ai, bj, At, Bt) do { __builtin_amdgcn_s_setprio(1); _Pragma("unroll") for (int m = 0; m < 4; ++m) _Pragma("unroll") for (int n = 0; n < 2; ++n) _Pragma("unroll") for (int k = 0; k < 2; ++k) \
        acc[ai][bj][m][n] = __builtin_amdgcn_mfma_f32_16x16x32_bf16(Bt[n][k], At[m][k], acc[ai][bj][m][n], 0, 0, 0); __builtin_amdgcn_s_setprio(0); } while (0)
#define PG8_WAIT_V(n) asm volatile("s_waitcnt vmcnt(" #n ")" ::: "memory")
#define PG8_WAIT_L(n) asm volatile("s_waitcnt lgkmcnt(" #n ")" ::: "memory")
#define PG8_BAR __builtin_amdgcn_s_barrier()
#define PG8_SCHED __builtin_amdgcn_sched_barrier(0)
    Unit cur, nxt; int ui = 0;
    if (!S.next(0, cur)) return;
    f32x4 acc[2][2][4][2];
#pragma unroll
    for (int a = 0; a < 2; ++a)
#pragma unroll
        for (int b = 0; b < 2; ++b)
#pragma unroll
            for (int m = 0; m < 4; ++m)
#pragma unroll
                for (int n = 0; n < 2; ++n) acc[a][b][m][n] = (f32x4){0.f, 0.f, 0.f, 0.f};
    bf16x8 At[4][2], B0[2][2], B1[2][2];
    const char* cA = (const char*)g.A + (size_t)cur.pm * tstepA; const char* cB = (const char*)g.Bt + (size_t)cur.pn * tstepB;
    S.a_ready(cur);
    if constexpr (SP2) {
        PG8_STAGE(PG8_SB(0, 0), cB, voffB); PG8_STAGE(PG8_SB(0, 1), cB + hstepB, voffB); PG8_STAGE(PG8_SA(0, 0), cA, voffA); PG8_STAGE(PG8_SA(0, 1), cA + hstepA, voffA);
        if (wr == 1) PG8_BAR;
        PG8_WAIT_V(2); PG8_BAR;
        PG8_STAGE(PG8_SB(1, 0), cB + kstepB, voffB); PG8_STAGE(PG8_SA(1, 0), cA + kstep, voffA); PG8_STAGE(PG8_SB(1, 1), cB + hstepB + kstepB, voffB);
        PG8_WAIT_V(6); PG8_BAR;
    } else {
        PG8_STAGE(PG8_SB(0, 0), cB, voffB); PG8_STAGE(PG8_SA(0, 0), cA, voffA); PG8_STAGE(PG8_SB(0, 1), cB + hstepB, voffB); PG8_STAGE(PG8_SA(0, 1), cA + hstepA, voffA);
        if (wr == 1) PG8_BAR;
        PG8_WAIT_V(4); PG8_BAR;
        PG8_STAGE(PG8_SB(1, 0), cB + kstepB, voffB); PG8_STAGE(PG8_SA(1, 0), cA + kstep, voffA); PG8_STAGE(PG8_SB(1, 1), cB + hstepB + kstepB, voffB);
        PG8_WAIT_V(6); PG8_BAR;
    }
    for (;;) {
        const bool has_next = S.next(ui + 1, nxt);
        const char* nA = has_next ? (const char*)g.A + (size_t)nxt.pm * tstepA : cA; const char* nB = has_next ? (const char*)g.Bt + (size_t)nxt.pn * tstepB : cB;
        for (int t = 0; t < nt; t += 2) {
            const bool last = (t == nt - 2);
            const char* a1 = cA + (size_t)(t + 1) * kstep;
            const char* a2 = last ? nA : cA + (size_t)(t + 2) * kstep; const char* b2 = last ? nB : cB + (size_t)(t + 2) * kstepB;
            const char* a3 = a2 + kstep; const char* b3 = b2 + kstepB;
            if (last && has_next) S.a_ready(nxt);
            if constexpr (SP2) {
            PG8_LDB(B0, 0, 0); PG8_LDB(B1, 0, 1); PG8_SCHED; PG8_LDA(At, 0, 0); PG8_STAGE(PG8_SA(1, 1), a1 + hstepA, voffA);
            PG8_WAIT_V(8); PG8_WAIT_L(0); PG8_BAR; PG8_MMA(0, 0, At, B0); PG8_MMA(0, 1, At, B1); PG8_BAR; PG8_SCHED;
            PG8_LDA(At, 0, 1); PG8_STAGE(PG8_SB(0, 0), b2, voffB); PG8_STAGE(PG8_SB(0, 1), b2 + hstepB, voffB); PG8_STAGE(PG8_SA(0, 0), a2, voffA);
            PG8_WAIT_V(8); PG8_WAIT_L(0); PG8_BAR; PG8_MMA(1, 0, At, B0); PG8_MMA(1, 1, At, B1); PG8_BAR; PG8_SCHED;
            PG8_LDB(B0, 1, 0); PG8_LDB(B1, 1, 1); PG8_SCHED; PG8_LDA(At, 1, 0); PG8_STAGE(PG8_SA(0, 1), a2 + hstepA, voffA);
            PG8_WAIT_V(8); PG8_WAIT_L(0); PG8_BAR; PG8_MMA(0, 0, At, B0); PG8_MMA(0, 1, At, B1); PG8_BAR; PG8_SCHED;
            PG8_LDA(At, 1, 1); PG8_STAGE(PG8_SB(1, 0), b3, voffB); PG8_STAGE(PG8_SB(1, 1), b3 + hstepB, voffB); PG8_STAGE(PG8_SA(1, 0), a3, voffA);
            PG8_WAIT_V(8); PG8_WAIT_L(0); PG8_BAR; PG8_MMA(1, 0, At, B0); PG8_MMA(1, 1, At, B1); PG8_BAR; PG8_SCHED;
            } else {
            PG8_LDB(B0, 0, 0); PG8_SCHED; PG8_LDA(At, 0, 0); PG8_STAGE(PG8_SA(1, 1), a1 + hstepA, voffA);
            PG8_WAIT_L(8); PG8_BAR; PG8_WAIT_L(0); PG8_MMA(0, 0, At, B0); PG8_BAR; PG8_SCHED;
            PG8_LDB(B1, 0, 1); PG8_STAGE(PG8_SB(0, 0), b2, voffB);
            PG8_BAR; PG8_WAIT_L(0); PG8_MMA(0, 1, At, B1); PG8_BAR;
            PG8_LDA(At, 0, 1); PG8_STAGE(PG8_SA(0, 0), a2, voffA);
            PG8_BAR; PG8_WAIT_L(0); PG8_MMA(1, 0, At, B0); PG8_BAR; PG8_SCHED;
            PG8_STAGE(PG8_SB(0, 1), b2 + hstepB, voffB);
            PG8_WAIT_V(6); PG8_BAR; PG8_MMA(1, 1, At, B1); PG8_BAR;
            PG8_LDB(B0, 1, 0); PG8_SCHED; PG8_LDA(At, 1, 0); PG8_STAGE(PG8_SA(0, 1), a2 + hstepA, voffA);
            PG8_WAIT_L(8); PG8_BAR; PG8_WAIT_L(0); PG8_MMA(0, 0, At, B0); PG8_BAR; PG8_SCHED;
            PG8_LDB(B1, 1, 1); PG8_STAGE(PG8_SB(1, 0), b3, voffB);
            PG8_BAR; PG8_WAIT_L(0); PG8_MMA(0, 1, At, B1); PG8_BAR;
            PG8_LDA(At, 1, 1); PG8_STAGE(PG8_SA(1, 0), a3, voffA);
            PG8_BAR; PG8_WAIT_L(0); PG8_MMA(1, 0, At, B0); PG8_BAR; PG8_SCHED;
            PG8_STAGE(PG8_SB(1, 1), b3 + hstepB, voffB);
            PG8_WAIT_V(6); PG8_BAR; PG8_MMA(1, 1, At, B1); PG8_BAR;
            }
        }
        if constexpr (ALIGN_EPI) { if (wr == 0) PG8_BAR; }
        if constexpr (!Epi::AFTER_DRAIN) { E(acc, cur, wr, wc, fr, fq); S.done(cur); }
        if (!has_next) break;
#pragma unroll
        for (int a = 0; a < 2; ++a)
#pragma unroll
            for (int b = 0; b < 2; ++b)
#pragma unroll
                for (int m = 0; m < 4; ++m)
#pragma unroll
                    for (int n = 0; n < 2; ++n) acc[a][b][m][n] = (f32x4){0.f, 0.f, 0.f, 0.f};
        cur = nxt; cA = nA; cB = nB; ++ui;
        if constexpr (ALIGN_EPI) { if (wr == 1) PG8_BAR; }
    }
    PG8_WAIT_V(0);
    if constexpr (!ALIGN_EPI) { if (wr == 0) PG8_BAR; }
    PG8_BAR;
    if constexpr (Epi::AFTER_DRAIN) { E.fused(acc, cur, wr, wc, fr, fq, lds, wid, lane); S.done(cur); }
#undef PG8_SA
#undef PG8_SB
#undef PG8_STAGE
#undef PG8_LDA
#undef PG8_LDB
#undef PG8_MMA
#undef PG8_WAIT_V
#undef PG8_WAIT_L
#undef PG8_BAR
#undef PG8_SCHED
}
}

constexpr int DM = 2048, SEQ = 2048, NB = 4, NS = 128, DEPTH = 2;
constexpr int MP = NB * SEQ;
constexpr int MT = MP + NS;
constexpr int MPAD = MP + 256;
constexpr int PIN = 6400, DFF = 8192, NMEM = 256, MMEM = NB * NMEM;
constexpr int PB_ = 1536, PC_ = 3584, PD_ = 5376;
constexpr int SHW = 1792;
constexpr int LDU = 8192;
constexpr int NWAVES = 8;
constexpr int NIN = 39;

constexpr size_t O_YP = 0, O_YS = O_YP + (size_t)MP * DM, O_CAP = O_YS + (size_t)NS * DM, O_CAS = O_CAP + (size_t)DEPTH * NB * 2 * 512,
    O_RETP = O_CAS + (size_t)DEPTH * NS * 2 * 512, O_RETS = O_RETP + (size_t)DEPTH * NB * 4 * 128 * 128, O_SHP = O_RETS + (size_t)DEPTH * NS * 4 * 128 * 128,
    O_SHS = O_SHP + (size_t)DEPTH * NB * SHW, O_WKVP = O_SHS + (size_t)DEPTH * NS * SHW, O_WKVS = O_WKVP + (size_t)DEPTH * NB * 8 * 64 * 64,
    O_CDP = O_WKVS + (size_t)DEPTH * NS * 8 * 64 * 64, O_CDS = O_CDP + (size_t)DEPTH * NB * 30 * 512, O_MKP = O_CDS + (size_t)DEPTH * NS * 30 * 512,
    O_MVP = O_MKP + (size_t)DEPTH * MMEM * DM, O_END = O_MVP + (size_t)DEPTH * MMEM * DM;
static_assert(O_END == 56178688, "d_out size");

constexpr size_t MiB = 1u << 20;
constexpr size_t al256(size_t x) { return (x + 255) & ~(size_t)255; }
constexpr size_t WS_CTL = 0, CTL_ZERO_BYTES = 1 * MiB;
constexpr size_t WS_ROPE = 1 * MiB;
constexpr size_t SZ_WIN = (size_t)PIN * DM * 2, SZ_SQ = (size_t)DM * DM * 2, SZ_WUP = (size_t)DFF * DM * 2, SZ_WDN = (size_t)DM * LDU * 2;
constexpr size_t LW_IN = 0, LW_OUT = LW_IN + SZ_WIN, LW_Q = LW_OUT + SZ_SQ, LW_O = LW_Q + SZ_SQ, LW_UP = LW_O + SZ_SQ, LW_DN = LW_UP + SZ_WUP,
    LW_W2 = LW_DN + SZ_WDN, LW_A2 = LW_W2 + 512 * 64 * 2, LW_G2 = LW_A2 + 512 * 64 * 2, LW_STRIDE = LW_G2 + 512 * 128 * 2;
constexpr size_t WS_WL = 4 * MiB;
constexpr size_t WS_WKV = al256(WS_WL + 2 * LW_STRIDE);
constexpr size_t WS_XF = al256(WS_WKV + (size_t)8192 * DM * 2);
constexpr size_t WS_HN = al256(WS_XF + (size_t)MT * DM * 4);
constexpr size_t WS_MN = al256(WS_HN + (size_t)MPAD * DM * 2);
constexpr size_t WS_MK = al256(WS_MN + (size_t)MMEM * DM * 2);
constexpr size_t WS_MVT = al256(WS_MK + (size_t)2 * MMEM * DM * 2);
constexpr size_t WS_P = al256(WS_MVT + (size_t)2 * MMEM * DM * 2);
constexpr size_t WS_YC = al256(WS_P + (size_t)MPAD * PIN * 2);
constexpr size_t WS_Q = al256(WS_YC + (size_t)MT * DM * 2);
constexpr size_t WS_O = al256(WS_Q + (size_t)MT * DM * 2);
constexpr size_t WS_U = al256(WS_O + (size_t)MT * DM * 2);
constexpr size_t WS_RW = al256(WS_U + (size_t)MT * LDU * 2);
constexpr size_t WS_GATE = al256(WS_RW + (size_t)MT * 8 * 896);
constexpr size_t WS_OC = al256(WS_GATE + (size_t)MT * 512 * 4);
constexpr size_t WS_KVT = al256(WS_OC + (size_t)MT * 512 * 4);
constexpr size_t WS_SSQ = al256(WS_KVT + (size_t)16 * 16 * 128 * 128 * 4);
constexpr size_t WS_SPL = al256(WS_SSQ + (size_t)MP * 8 * 4);
constexpr size_t WS_STB = al256(WS_SPL + (size_t)2 * NS * DM * 4);
constexpr size_t WS_CK = al256(WS_STB + (size_t)16 * 16 * 128 * 128 * 2);
constexpr size_t WS_CP = al256(WS_CK + (size_t)4096 * 6912);
constexpr int DMS = DM + 128, LDUS = LDU + 128;
constexpr size_t WS_HNS = al256(WS_CP + (size_t)4096 * 4 * 3072);
constexpr size_t WS_OS = al256(WS_HNS + (size_t)NS * DMS * 2);
constexpr size_t WS_US = al256(WS_OS + (size_t)NS * DMS * 2);
constexpr size_t WS_END = al256(WS_US + (size_t)NS * LDUS * 2);
static_assert(WS_END < (size_t)1700 * MiB, "d_ws map");
constexpr int CW_BAR = 4096;

constexpr int SCR_BYTES = 147456;
constexpr int MISC_OFF = SCR_BYTES;
constexpr int LDS_BYTES = SCR_BYTES + 1024;

#define GAS __attribute__((address_space(1)))
#define LAS __attribute__((address_space(3)))
typedef unsigned short bf16;
typedef unsigned v4u __attribute__((ext_vector_type(4)));
typedef unsigned v2u __attribute__((ext_vector_type(2)));
typedef float f32x4 __attribute__((ext_vector_type(4)));
typedef float f32x2 __attribute__((ext_vector_type(2)));
typedef short bf16x8 __attribute__((ext_vector_type(8)));
typedef short bf16x4 __attribute__((ext_vector_type(4)));
typedef GAS unsigned gu32;
#define RLX_AGENT __ATOMIC_RELAXED, __HIP_MEMORY_SCOPE_AGENT
#define LDS_WAIT() asm volatile("s_waitcnt lgkmcnt(0)" ::: "memory")
#define VM_WAIT() asm volatile("s_waitcnt vmcnt(0)" ::: "memory")
__device__ __forceinline__ unsigned pk2(float lo, float hi) { return pg8::cvt_pk_bf16(lo, hi); }
__device__ __forceinline__ float bflo(unsigned w) { return __uint_as_float(w << 16); }
__device__ __forceinline__ float bfhi(unsigned w) { return __uint_as_float(w & 0xffff0000u); }
__device__ __forceinline__ float bf1(bf16 h) { return __uint_as_float(((unsigned)h) << 16); }
__device__ __forceinline__ void unpack8(const v4u w, float (&f)[8]) { f[0] = bflo(w.x); f[1] = bfhi(w.x); f[2] = bflo(w.y); f[3] = bfhi(w.y); f[4] = bflo(w.z); f[5] = bfhi(w.z); f[6] = bflo(w.w); f[7] = bfhi(w.w); }
__device__ __forceinline__ void unpack4(const v2u w, float (&f)[4]) { f[0] = bflo(w.x); f[1] = bfhi(w.x); f[2] = bflo(w.y); f[3] = bfhi(w.y); }
__device__ __forceinline__ v4u pack8(const float (&f)[8]) { v4u w; w.x = pk2(f[0], f[1]); w.y = pk2(f[2], f[3]); w.z = pk2(f[4], f[5]); w.w = pk2(f[6], f[7]); return w; }
__device__ __forceinline__ float sigm(float x) { return 1.0f / (1.0f + __expf(-x)); }
__device__ __forceinline__ float wave_sum(float v) {
#pragma unroll
    for (int o = 1; o < 64; o <<= 1) v += __shfl_xor(v, o);
    return v;
}
__device__ __forceinline__ float wave_max(float v) {
#pragma unroll
    for (int o = 1; o < 64; o <<= 1) v = fmaxf(v, __shfl_xor(v, o));
    return v;
}
template <int CTRL> __device__ __forceinline__ float dpp_f(float v) { return __builtin_bit_cast(float, __builtin_amdgcn_update_dpp(0, __builtin_bit_cast(int, v), CTRL, 0xf, 0xf, false)); }
__device__ __forceinline__ f32x4 zero4() { f32x4 z = (f32x4){0.f, 0.f, 0.f, 0.f}; asm volatile("" : "+v"(z)); return z; }
__device__ __forceinline__ float rowsum16(float v) { v += dpp_f<0x128>(v); v += dpp_f<0x124>(v); v += dpp_f<0x122>(v); v += dpp_f<0x121>(v); return v; }

namespace pg8 {
template <int ACT> struct EpiBf16A {
    static constexpr bool PERM = true, AFTER_DRAIN = false;
    bf16_t* O; int ldc; const float* ssq;
    __device__ __forceinline__ void operator()(const f32x4 (&acc)[2][2][4][2], const Unit& u, int wr, int wc, int fr, int fq) const {
        const int row0 = u.pm * BM + wr * 64 + fr, col0 = u.pn * BM + wc * 32 + 8 * fq;
#pragma unroll
        for (int ai = 0; ai < 2; ++ai)
#pragma unroll
            for (int m = 0; m < 4; ++m) { bf16_t* rowp = O + (size_t)(row0 + ai * HALF + m * 16) * ldc + col0;
                const float rs = ssq ? 1.0f / sqrtf(ssq[row0 + ai * HALF + m * 16] * (1.0f / 2048.0f) + 1e-6f) : 1.0f;
#pragma unroll
                for (int bj = 0; bj < 2; ++bj) { f32x4 v0 = acc[ai][bj][m][0] * rs, v1 = acc[ai][bj][m][1] * rs;
                    if (ACT == 3) {
#pragma unroll
                        for (int j = 0; j < 4; ++j) { const float a = fmaxf(v0[j], 0.f), b = fmaxf(v1[j], 0.f); v0[j] = a * a; v1[j] = b * b; } }
                    u32x4 w; w.x = cvt_pk_bf16(v0[0], v0[1]); w.y = cvt_pk_bf16(v0[2], v0[3]); w.z = cvt_pk_bf16(v1[0], v1[1]); w.w = cvt_pk_bf16(v1[2], v1[3]);
                    *(u32x4*)(rowp + bj * HALF) = w; } }
    }
};
struct EpiRes {
    static constexpr bool PERM = false, AFTER_DRAIN = false;
    float* X; int ldc; float sc; const float* Xin;
    __device__ __forceinline__ void operator()(const f32x4 (&acc)[2][2][4][2], const Unit& u, int wr, int wc, int fr, int fq) const {
        const int row0 = u.pm * BM + wr * 64 + fr, col0 = u.pn * BM + wc * 32 + 4 * fq;
#pragma unroll
        for (int ai = 0; ai < 2; ++ai)
#pragma unroll
            for (int m = 0; m < 4; ++m) { float* rowp = X + (size_t)(row0 + ai * HALF + m * 16) * ldc + col0; const float* inp = Xin + (size_t)(row0 + ai * HALF + m * 16) * ldc + col0;
                f32x4 o[2][2];
#pragma unroll
                for (int bj = 0; bj < 2; ++bj)
#pragma unroll
                    for (int n = 0; n < 2; ++n) o[bj][n] = *(const f32x4*)(inp + bj * HALF + n * 16);
#pragma unroll
                for (int bj = 0; bj < 2; ++bj)
#pragma unroll
                    for (int n = 0; n < 2; ++n) *(f32x4*)(rowp + bj * HALF + n * 16) = o[bj][n] + acc[ai][bj][m][n] * sc; }
    }
};
struct EpiMemKV {
    static constexpr bool PERM = false, AFTER_DRAIN = false;
    float* outK; bf16_t* MKb; bf16_t* MVT;
    __device__ __forceinline__ void operator()(const f32x4 (&acc)[2][2][4][2], const Unit& u, int wr, int wc, int fr, int fq) const {
        const int cbase = u.pn * BM, lyr = cbase >> 12, cc = cbase & 4095; const bool isV = cc >= 2048; const int colt = cc & 2047;
        const int row0 = u.pm * BM + wr * 64 + fr, col0 = colt + wc * 32 + 4 * fq;
        float* outp = outK + (isV ? (size_t)(O_MVP - O_MKP) : (size_t)0);
#pragma unroll
        for (int ai = 0; ai < 2; ++ai)
#pragma unroll
            for (int m = 0; m < 4; ++m) { const int r = row0 + ai * HALF + m * 16;
#pragma unroll
                for (int bj = 0; bj < 2; ++bj)
#pragma unroll
                    for (int n = 0; n < 2; ++n) { const int col = col0 + bj * HALF + n * 16; const f32x4 v = acc[ai][bj][m][n];
                        *(f32x4*)(outp + ((size_t)lyr * 1024 + r) * 2048 + col) = v;
                        if (!isV) { unsigned lo = cvt_pk_bf16(v[0], v[1]), hi = cvt_pk_bf16(v[2], v[3]); *(unsigned long long*)(MKb + ((size_t)lyr * 1024 + r) * 2048 + col) = ((unsigned long long)hi << 32) | lo; }
                        else { const int b = r >> 8, j = r & 255, h = col >> 9, e = col & 511; bf16_t* tp = MVT + ((((size_t)lyr * 4 + b) * 4 + h) * 512 + e) * 256 + j;
                            const unsigned lo = cvt_pk_bf16(v[0], v[1]), hi = cvt_pk_bf16(v[2], v[3]);
                            tp[0] = (bf16_t)(lo & 0xffffu); tp[256] = (bf16_t)(lo >> 16); tp[512] = (bf16_t)(hi & 0xffffu); tp[768] = (bf16_t)(hi >> 16); } } }
    }
};
}

struct SEpiBf16 { bf16* O; int ldc; int act; const float* ssq;
    __device__ __forceinline__ void operator()(int row, int col0, f32x4 v, int) const {
        if (ssq) v = v * (1.0f / sqrtf(ssq[row] * (1.0f / 2048.0f) + 1e-6f));
        if (act == 3) {
#pragma unroll
            for (int j = 0; j < 4; ++j) { const float a = fmaxf(v[j], 0.f); v[j] = a * a; } }
        v2u w; w.x = pk2(v[0], v[1]); w.y = pk2(v[2], v[3]); *(v2u*)(O + (size_t)row * ldc + col0) = w; } };
struct SEpiRes { float* X; int ldc; float sc; const float* Xin;
    __device__ __forceinline__ void operator()(int row, int col0, f32x4 v, int) const { *(f32x4*)(X + (size_t)row * ldc + col0) = *(const f32x4*)(Xin + (size_t)row * ldc + col0) + v * sc; } };
struct SEpiPart { float* S; int ldc;
    __device__ __forceinline__ void operator()(int row, int col0, f32x4 v, int kp) const { *(f32x4*)(S + ((size_t)kp * NS + row) * ldc + col0) = v; } };
template <class F> __device__ __forceinline__ void sample_gemm(LAS unsigned char* lds, int tid_in, const bf16* A, int lda, const bf16* Bt, int ntot, int N, int K, int G, int bid, const F& epi, int nks = 1) {
    int tid_ = tid_in; asm volatile("" : "+v"(tid_));
    const int lane = tid_ & 63, wave = __builtin_amdgcn_readfirstlane(tid_ >> 6), fr = lane & 15, fq = lane >> 4;
    const int KS = (K / nks) >> 3, ncu = N / 16;
    LAS f32x4* red = (LAS f32x4*)lds;
    const unsigned voffa = (unsigned)(fr * lda + fq * 8) * 2u, voffb = (unsigned)(fr * 64 + fq * 8) * 2u;
    for (int uu = bid; uu < ncu * nks; uu += G) { const int kp = uu / ncu, u = uu - kp * ncu, kbeg = kp * (K / nks) + wave * KS;
        const char* bp = (const char*)(Bt + ((size_t)(kbeg >> 6) * ntot + u * 16) * 64);
        const char* ap = (const char*)(A + kbeg);
        f32x4 acc[8];
#pragma unroll
        for (int rt = 0; rt < 8; ++rt) acc[rt] = zero4();
        bf16x8 b0[2], a0[2][8], b1[2], a1[2][8];
#define SG_LOAD(bb, aa, kq) do { _Pragma("unroll") for (int s = 0; s < 2; ++s) { bb[s] = *(const bf16x8*)(bp + ((size_t)((kq) >> 6) * ntot * 64 + 32 * s) * 2 + voffb); \
            _Pragma("unroll") for (int rt = 0; rt < 8; ++rt) aa[s][rt] = *(const bf16x8*)(ap + ((size_t)rt * 16 * lda + (kq) + 32 * s) * 2 + voffa); } } while (0)
#define SG_MMA(bb, aa) do { _Pragma("unroll") for (int s = 0; s < 2; ++s) _Pragma("unroll") for (int rt = 0; rt < 8; ++rt) acc[rt] = __builtin_amdgcn_mfma_f32_16x16x32_bf16(bb[s], aa[s][rt], acc[rt], 0, 0, 0); } while (0)
        SG_LOAD(b0, a0, 0);
        for (int k0 = 0; k0 < KS; k0 += 128) {
            __builtin_amdgcn_sched_barrier(0);
            SG_LOAD(b1, a1, k0 + 64);
            __builtin_amdgcn_sched_barrier(0);
            SG_MMA(b0, a0);
            __builtin_amdgcn_sched_barrier(0);
            if (k0 + 128 < KS) SG_LOAD(b0, a0, k0 + 128);
            __builtin_amdgcn_sched_barrier(0);
            SG_MMA(b1, a1);
        }
        __builtin_amdgcn_sched_barrier(0);
#undef SG_LOAD
#undef SG_MMA
#pragma unroll
        for (int rt = 0; rt < 8; ++rt) red[(wave * 8 + rt) * 64 + lane] = acc[rt];
        __syncthreads();
        f32x4 sum = red[wave * 64 + lane];
#pragma unroll
        for (int ks = 1; ks < 8; ++ks) sum += red[(ks * 8 + wave) * 64 + lane];
        epi(wave * 16 + fr, u * 16 + 4 * fq, sum, kp);
        __syncthreads();
    }
}
#define XB_TMO      128
#define XB_XCNT(j)  (256  + 64 * (j))
#define XB_XSUB(j)  (1280 + 64 * (j))
#define XB_XGEN(j)  (2304 + 64 * (j))
#define XB_TOP      3328
#define XB_TOPGEN   3392
#define XCD_BAR_WORDS 3456
#define XB_SPIN_CAP (1u << 18)

__device__ __forceinline__ unsigned xb_ld(unsigned* p)              { return __hip_atomic_load(p, __ATOMIC_RELAXED, __HIP_MEMORY_SCOPE_AGENT); }
__device__ __forceinline__ unsigned xb_add(unsigned* p, unsigned v) { return __hip_atomic_fetch_add(p, v, __ATOMIC_RELAXED, __HIP_MEMORY_SCOPE_AGENT); }
__device__ __forceinline__ unsigned xb_xcc_id() { return (unsigned)__builtin_amdgcn_s_getreg((3 << 11) | 20) & 0xFu; }
#define XB_SPIN(cond, bar) do { unsigned _sp = 0; while (cond) { __builtin_amdgcn_s_sleep(1); \
    if ((++_sp & 255u) == 0u) { if (xb_ld(&(bar)[XB_TMO])) break; if (_sp > XB_SPIN_CAP) { atomicAdd(&(bar)[XB_TMO], 1u); break; } } } } while (0)

struct XcdBarrier {
    int wave;
    unsigned* bar; unsigned x;
    volatile LAS unsigned* st;
};

__device__ __forceinline__ XcdBarrier xcd_barrier_post(unsigned* bar, volatile LAS unsigned* st) {
    XcdBarrier b; b.bar = bar; b.x = xb_xcc_id(); b.st = st;
    if (threadIdx.x == 0) (void)xb_add(&bar[XB_XCNT(b.x)], 1u);
    return b;
}
__device__ __forceinline__ void xcd_barrier_complete(unsigned* bar, unsigned x, unsigned& nloc, unsigned& nx) {
    const unsigned G = gridDim.x * gridDim.y * gridDim.z;
    unsigned sum, cnt, mine, sp = 0u;
    for (;;) {
        sum = 0u; cnt = 0u; mine = 0u;
#pragma unroll
        for (unsigned j = 0; j < 16; ++j) { const unsigned c = xb_ld(&bar[XB_XCNT(j)]); sum += c; cnt += (c > 0u) ? 1u : 0u; mine = (j == x) ? c : mine; }
        if (sum == G) break;
        __builtin_amdgcn_s_sleep(1);
        if ((++sp & 255u) == 0u) { if (xb_ld(&bar[XB_TMO])) break; if (sp > XB_SPIN_CAP) { atomicAdd(&bar[XB_TMO], 1u); break; } }
    }
    nloc = mine > 0u ? mine : 1u; nx = cnt > 0u ? cnt : 1u;
}

__device__ __forceinline__ void xcd_barrier(const XcdBarrier& b) {
    asm volatile("s_waitcnt vmcnt(0)" ::: "memory");
    __syncthreads();
    unsigned xbz = 0u; asm volatile("" : "+v"(xbz));
    if (b.wave == 0 && __builtin_amdgcn_mbcnt_hi(~0u, __builtin_amdgcn_mbcnt_lo(~0u, xbz)) == 0u) {
        unsigned* bar = b.bar;
        __builtin_amdgcn_s_waitcnt(0);
        unsigned nloc = b.st[0], nx = b.st[1];
        if (nloc == 0u) { xcd_barrier_complete(bar, b.x, nloc, nx); b.st[0] = nloc; b.st[1] = nx; }
        const unsigned old = xb_add(&bar[XB_XSUB(b.x)], 1u);
        const unsigned gen = old / nloc;
        if (old + 1u == (gen + 1u) * nloc) {
            __builtin_amdgcn_fence(__ATOMIC_RELEASE, "agent");
            asm volatile("s_waitcnt vmcnt(0)" ::: "memory");
            const unsigned og = xb_add(&bar[XB_TOP], 1u);
            const unsigned tg = og / nx;
            if (og + 1u == (tg + 1u) * nx) xb_add(&bar[XB_TOPGEN], 1u);
            else XB_SPIN(xb_ld(&bar[XB_TOPGEN]) == tg, bar);
            __builtin_amdgcn_fence(__ATOMIC_ACQUIRE, "agent");
            xb_add(&bar[XB_XGEN(b.x)], 1u);
            asm volatile("s_waitcnt vmcnt(0)" ::: "memory");
        } else {
            XB_SPIN(xb_ld(&bar[XB_XGEN(b.x)]) == gen, bar);
            __builtin_amdgcn_fence(__ATOMIC_ACQUIRE, "agent");
            asm volatile("s_waitcnt vmcnt(0)" ::: "memory");
        }
    }
    __syncthreads();
}

struct Args { const float* in[NIN]; float* out; unsigned char* ws; int ph_lo, ph_hi; };
enum { I_XP = 0, I_XS, I_MEM, I_SCA, I_SRET, I_SSH, I_SWKV, I_SCD, I_CMK, I_CMV, I_GMIX, I_WIN, I_CAW, I_MU, I_W0, I_W2, I_A0, I_A2, I_G2, I_KK, I_KA, I_RK, I_LNXG, I_LNXB,
       I_CDW, I_CDB, I_LNDG, I_LNDB, I_WOUT, I_GXA, I_GMEM, I_WQ, I_WK, I_WV, I_WO, I_GMLP, I_WUP, I_WDN, I_GFIN };

struct Ctx { LAS unsigned char* lds; int tid, lane, wave, G, bid; };
typedef const GAS float* gcfp;
#define CAS __attribute__((address_space(4)))
struct Ax { const CAS gcfp* kp; float* out; unsigned char* ws;
    __device__ __forceinline__ const float* in(int i) const { return (const float*)kp[i]; } };
__device__ __forceinline__ Ax mk_ax() { const CAS gcfp* kp = (const CAS gcfp*)__builtin_amdgcn_kernarg_segment_ptr(); asm volatile("" : "+s"(kp)); Ax a; a.kp = kp;
    a.out = (float*)(GAS float*)kp[NIN]; a.ws = (unsigned char*)(GAS unsigned char*)kp[NIN + 1]; return a; }
__device__ __forceinline__ Ctx mk_ctx(LAS unsigned char* lds, int wave_s) { unsigned z = 0u; asm volatile("" : "+v"(z)); int t = wave_s * 64 + (int)__builtin_amdgcn_mbcnt_hi(~0u, __builtin_amdgcn_mbcnt_lo(~0u, z)); Ctx C; C.lds = lds; C.tid = t; C.lane = t & 63; C.wave = __builtin_amdgcn_readfirstlane(t >> 6); C.G = gridDim.x; C.bid = blockIdx.x; return C; }

__device__ __forceinline__ void p0_transpose_item(const float* W, int K, int N, bf16* WT, int ldk, int row_off, LAS float* scr, int item, int lane, const float* gain) {
    const int nblk = N / 64, kb = item / nblk, nb = item - kb * nblk, k0 = 64 * kb, n0 = 64 * nb;
    const int lr = lane >> 4, lc = (lane & 15) * 4;
#pragma unroll 8
    for (int i = 0; i < 16; ++i) { const int kk = 4 * i + lr; const float g = gain ? gain[k0 + kk] : 1.0f; const f32x4 v = *(const f32x4*)(W + (size_t)(k0 + kk) * N + n0 + lc);
        LAS float* d = scr + kk * 65 + lc; d[0] = v.x * g; d[1] = v.y * g; d[2] = v.z * g; d[3] = v.w * g; }
    LDS_WAIT(); asm volatile("" ::: "memory");
    const int c = lane & 7;
#pragma unroll
    for (int j = 0; j < 8; ++j) { const int n = (lane >> 3) + 8 * j; const LAS float* s = scr + (8 * c) * 65 + n;
        v4u o; o.x = pk2(s[0 * 65], s[1 * 65]); o.y = pk2(s[2 * 65], s[3 * 65]); o.z = pk2(s[4 * 65], s[5 * 65]); o.w = pk2(s[6 * 65], s[7 * 65]);
        if (ldk > 0) *(v4u*)(WT + (size_t)(row_off + n0 + n) * ldk + k0 + 8 * c) = o;
        else *(v4u*)(WT + ((size_t)kb * (size_t)(-ldk) + row_off + n0 + n) * 64 + 8 * c) = o; }
    LDS_WAIT(); asm volatile("" ::: "memory");
}
__device__ __forceinline__ void rms_row(const float* xrow, bf16* orow, float* xcopy, int lane) {
    const f32x4* xr = (const f32x4*)xrow + lane;
    f32x4 v[8]; float s = 0.f;
#pragma unroll
    for (int j = 0; j < 8; ++j) { v[j] = xr[64 * j]; s += (v[j].x * v[j].x + v[j].y * v[j].y) + (v[j].z * v[j].z + v[j].w * v[j].w); }
    const float rs = 1.0f / sqrtf(wave_sum(s) * (1.0f / DM) + 1e-6f);
    if (xcopy) {
#pragma unroll
        for (int j = 0; j < 8; ++j) ((f32x4*)xcopy + lane)[64 * j] = v[j]; }
    unsigned long long* o8 = (unsigned long long*)orow + lane;
#pragma unroll
    for (int j = 0; j < 8; ++j) o8[64 * j] = (unsigned long long)pk2(v[j].x * rs, v[j].y * rs) | ((unsigned long long)pk2(v[j].z * rs, v[j].w * rs) << 32);
}
__device__ __forceinline__ void rms_phase(const Ctx& C, const float* X, bf16* HN, bf16* HNS) {
    const int gw = C.bid * NWAVES + C.wave, NGW = C.G * NWAVES;
    f32x4 v[8], nx[8]; int m = gw;
    if (m < MT) { const f32x4* xr = (const f32x4*)(X + (size_t)m * DM) + C.lane;
#pragma unroll
        for (int j = 0; j < 8; ++j) v[j] = xr[64 * j]; }
    for (; m < MT; m += NGW) {
        const int mn = m + NGW;
        if (mn < MT) { const f32x4* xr = (const f32x4*)(X + (size_t)mn * DM) + C.lane;
#pragma unroll
            for (int j = 0; j < 8; ++j) nx[j] = xr[64 * j]; }
        float s = 0.f;
#pragma unroll
        for (int j = 0; j < 8; ++j) s += (v[j].x * v[j].x + v[j].y * v[j].y) + (v[j].z * v[j].z + v[j].w * v[j].w);
        const float rs = 1.0f / sqrtf(wave_sum(s) * (1.0f / DM) + 1e-6f);
        unsigned long long* o8 = (unsigned long long*)((HNS && m >= MP) ? HNS + (size_t)(m - MP) * DMS : HN + (size_t)m * DM) + C.lane;
#pragma unroll
        for (int j = 0; j < 8; ++j) o8[64 * j] = (unsigned long long)pk2(v[j].x * rs, v[j].y * rs) | ((unsigned long long)pk2(v[j].z * rs, v[j].w * rs) << 32);
#pragma unroll
        for (int j = 0; j < 8; ++j) v[j] = nx[j];
    }
}
__device__ __forceinline__ void fold_split_rows(const Ctx& C, float* X, const float* S) {
    const int gw = C.bid * NWAVES + C.wave, NGW = C.G * NWAVES;
    for (int r = gw; r < NS; r += NGW) { f32x4* xr = (f32x4*)(X + (size_t)(MP + r) * DM) + C.lane; const f32x4* s0 = (const f32x4*)(S + (size_t)r * DM) + C.lane; const f32x4* s1 = (const f32x4*)(S + (size_t)(NS + r) * DM) + C.lane;
#pragma unroll
        for (int j = 0; j < 8; ++j) xr[64 * j] = xr[64 * j] + (s0[64 * j] + s1[64 * j]); }
    asm volatile("s_waitcnt vmcnt(0)" ::: "memory");
}
__device__ __forceinline__ void final_norm_phase(const Ctx& C, const float* X, const float* g, float* out) {
    const int gw = C.bid * NWAVES + C.wave, NGW = C.G * NWAVES;
    for (int m = gw; m < MT; m += NGW) {
        const f32x4* xr = (const f32x4*)(X + (size_t)m * DM) + C.lane; const f32x4* gr = (const f32x4*)g + C.lane;
        f32x4 v[8]; float s = 0.f;
#pragma unroll
        for (int j = 0; j < 8; ++j) { v[j] = xr[64 * j]; s += (v[j].x * v[j].x + v[j].y * v[j].y) + (v[j].z * v[j].z + v[j].w * v[j].w); }
        const float rs = 1.0f / sqrtf(wave_sum(s) * (1.0f / DM) + 1e-6f);
        f32x4* orow = (f32x4*)(out + (size_t)m * DM) + C.lane;
#pragma unroll
        for (int j = 0; j < 8; ++j) orow[64 * j] = v[j] * rs * gr[64 * j];
    }
}
#ifndef LATE_EXTRA
#define LATE_EXTRA 0
#endif
struct TDesc { const float* W; const float* gain; bf16* WT; int K, N, ldk, row_off, item; };
__device__ __forceinline__ TDesc p0_desc(const Ax& a, int it, int G) {
    constexpr int I_IN = 32 * 100, I_SQ = 32 * 32, I_UP = 32 * 128, I_DN = 128 * 32, I_L64 = 8, I_L128 = 16;
    constexpr int PER_LAYER = I_IN + 5 * I_SQ + I_UP + I_DN + 2 * I_L64 + I_L128;
    const int l = it / PER_LAYER; int r = it - l * PER_LAYER; unsigned char* wl = a.ws + WS_WL + (size_t)l * LW_STRIDE; bf16* wkv = (bf16*)(a.ws + WS_WKV);
    TDesc d; d.row_off = 0; d.gain = nullptr; const bool late = G == 256 && DEPTH == 2, late1 = late && l == 1 && LATE_EXTRA;
    if (r < I_IN) { d.W = a.in(I_WIN) + (size_t)l * DM * PIN; d.K = DM; d.N = PIN; d.WT = (bf16*)(wl + LW_IN); d.ldk = -PIN; d.gain = a.in(I_GMIX) + l * DM; d.item = r; return d; } r -= I_IN;
    if (r < I_SQ) { d.W = a.in(I_WOUT) + (size_t)l * DM * DM; d.K = DM; d.N = DM; d.WT = (bf16*)(wl + LW_OUT); d.ldk = -DM; d.item = late1 ? -1 : r; return d; } r -= I_SQ;
    if (r < I_SQ) { d.W = a.in(I_WQ) + (size_t)l * DM * DM; d.K = DM; d.N = DM; d.WT = (bf16*)(wl + LW_Q); d.ldk = -DM; d.gain = a.in(I_GXA) + l * DM; d.item = late1 ? -1 : r; return d; } r -= I_SQ;
    if (r < I_SQ) { d.W = a.in(I_WO) + (size_t)l * DM * DM; d.K = DM; d.N = DM; d.WT = (bf16*)(wl + LW_O); d.ldk = -DM; d.item = late1 ? -1 : r; return d; } r -= I_SQ;
    if (r < I_SQ) { d.W = a.in(I_WK) + (size_t)l * DM * DM; d.K = DM; d.N = DM; d.WT = wkv; d.ldk = -8192; d.row_off = l * 4096; d.gain = a.in(I_GMEM) + l * DM; d.item = late1 ? -1 : r; return d; } r -= I_SQ;
    if (r < I_SQ) { d.W = a.in(I_WV) + (size_t)l * DM * DM; d.K = DM; d.N = DM; d.WT = wkv; d.ldk = -8192; d.row_off = l * 4096 + 2048; d.gain = a.in(I_GMEM) + l * DM; d.item = late1 ? -1 : r; return d; } r -= I_SQ;
    if (r < I_UP) { d.W = a.in(I_WUP) + (size_t)l * DM * DFF; d.K = DM; d.N = DFF; d.WT = (bf16*)(wl + LW_UP); d.ldk = -DFF; d.gain = a.in(I_GMLP) + l * DM; d.item = late ? -1 : r; return d; } r -= I_UP;
    if (r < I_DN) { d.W = a.in(I_WDN) + (size_t)l * DFF * DM; d.K = DFF; d.N = DM; d.WT = (bf16*)(wl + LW_DN); d.ldk = -DM; d.item = late ? -1 : r; return d; } r -= I_DN;
    if (r < I_L64) { d.W = a.in(I_W2) + (size_t)l * 64 * 512; d.K = 64; d.N = 512; d.WT = (bf16*)(wl + LW_W2); d.ldk = 64; d.item = r; return d; } r -= I_L64;
    if (r < I_L64) { d.W = a.in(I_A2) + (size_t)l * 64 * 512; d.K = 64; d.N = 512; d.WT = (bf16*)(wl + LW_A2); d.ldk = 64; d.item = r; return d; } r -= I_L64;
    d.W = a.in(I_G2) + (size_t)l * 128 * 512; d.K = 128; d.N = 512; d.WT = (bf16*)(wl + LW_G2); d.ldk = 128; d.item = r; return d;
}
__device__ __forceinline__ void p0_load(const TDesc& d, int lane, f32x4 (&v)[16], float (&g)[16]) {
    if (d.item < 0) return;
    const int nblk = d.N / 64, kb = d.item / nblk, nb = d.item - kb * nblk, k0 = 64 * kb, n0 = 64 * nb, lr = lane >> 4, lc = (lane & 15) * 4;
#pragma unroll
    for (int i = 0; i < 16; ++i) { const int kk = 4 * i + lr; g[i] = d.gain ? d.gain[k0 + kk] : 1.0f; v[i] = __builtin_nontemporal_load((const f32x4*)(d.W + (size_t)(k0 + kk) * d.N + n0 + lc)); }
}
__device__ __forceinline__ void p0_finish(const TDesc& d, LAS float* scr, int lane, const f32x4 (&v)[16], const float (&g)[16]) {
    if (d.item < 0) return;
    const int nblk = d.N / 64, kb = d.item / nblk, nb = d.item - kb * nblk, k0 = 64 * kb, n0 = 64 * nb, lr = lane >> 4, lc = (lane & 15) * 4;
#pragma unroll
    for (int i = 0; i < 16; ++i) { const int kk = 4 * i + lr; LAS float* p = scr + kk * 65 + lc; p[0] = v[i].x * g[i]; p[1] = v[i].y * g[i]; p[2] = v[i].z * g[i]; p[3] = v[i].w * g[i]; }
    LDS_WAIT(); asm volatile("" ::: "memory");
    const int c = lane & 7;
#pragma unroll
    for (int j = 0; j < 8; ++j) { const int n = (lane >> 3) + 8 * j; const LAS float* s = scr + (8 * c) * 65 + n;
        v4u o; o.x = pk2(s[0 * 65], s[1 * 65]); o.y = pk2(s[2 * 65], s[3 * 65]); o.z = pk2(s[4 * 65], s[5 * 65]); o.w = pk2(s[6 * 65], s[7 * 65]);
        if (d.ldk > 0) *(v4u*)(d.WT + (size_t)(d.row_off + n0 + n) * d.ldk + k0 + 8 * c) = o;
        else *(v4u*)(d.WT + ((size_t)kb * (size_t)(-d.ldk) + d.row_off + n0 + n) * 64 + 8 * c) = o; }
    LDS_WAIT(); asm volatile("" ::: "memory");
}
__device__ __forceinline__ void p0_prologue(const Ctx& C, const Ax& a) {
    LAS float* scr = (LAS float*)(C.lds + C.wave * 16640);
    const int gw = C.bid * NWAVES + C.wave, NGW = C.G * NWAVES;
    constexpr int I_IN = 32 * 100, I_SQ = 32 * 32, I_UP = 32 * 128, I_DN = 128 * 32, I_L64 = 8, I_L128 = 16;
    constexpr int PER_LAYER = I_IN + 5 * I_SQ + I_UP + I_DN + 2 * I_L64 + I_L128;
    TDesc cur = p0_desc(a, gw, C.G), nxt; f32x4 va[16], vb[16]; float ga[16], gb[16];
    const int NITEMS = DEPTH * PER_LAYER;
    if (gw < NITEMS) p0_load(cur, C.lane, va, ga);
    for (int it = gw; it < NITEMS; it += 2 * NGW) {
        const int it1 = it + NGW, it2 = it + 2 * NGW;
        if (it1 < NITEMS) { nxt = p0_desc(a, it1, C.G); p0_load(nxt, C.lane, vb, gb); }
        p0_finish(cur, scr, C.lane, va, ga);
        if (it1 < NITEMS) { if (it2 < NITEMS) { cur = p0_desc(a, it2, C.G); p0_load(cur, C.lane, va, ga); }
            p0_finish(nxt, scr, C.lane, vb, gb); }
    }
    { float* cs = (float*)(a.ws + WS_ROPE); const int gt = C.bid * (NWAVES * 64) + C.tid, NT = C.G * NWAVES * 64;
      for (int idx = gt; idx < 2049 * 64; idx += NT) { const int p = idx >> 6, i = idx & 63; const double pos = (p == 2048) ? 16384.0 : (double)p;
          const double inv = exp(-(double)i * (9.210340371976184 / 64.0)); double r = pos * inv; r -= 6.283185307179586 * rint(r * 0.15915494309189535);
          cs[2 * idx] = (float)cos(r); cs[2 * idx + 1] = (float)sin(r); } }
    float* XF = (float*)(a.ws + WS_XF); bf16* HN = (bf16*)(a.ws + WS_HN); bf16* MN = (bf16*)(a.ws + WS_MN);
    for (int m = gw; m < MT; m += NGW) { const float* src = (m < MP) ? a.in(I_XP) + (size_t)m * DM : a.in(I_XS) + (size_t)(m - MP) * DM; rms_row(src, HN + (size_t)m * DM, nullptr, C.lane); }
    for (int m = gw; m < MMEM; m += NGW) rms_row(a.in(I_MEM) + (size_t)m * DM, MN + (size_t)m * DM, nullptr, C.lane);
}

__device__ __forceinline__ TDesc lc_desc(const Ax& a, int l, int it) {
    constexpr int I_UP = 32 * 128, I_DN = 128 * 32, I_SQ = 32 * 32;
    unsigned char* wl = a.ws + WS_WL + (size_t)l * LW_STRIDE; TDesc d; d.row_off = 0; d.gain = nullptr;
    if (it < I_UP) { d.W = a.in(I_WUP) + (size_t)l * DM * DFF; d.K = DM; d.N = DFF; d.WT = (bf16*)(wl + LW_UP); d.ldk = -DFF; d.gain = a.in(I_GMLP) + l * DM; d.item = it; return d; }
    int r = it - I_UP;
    if (r < I_DN) { d.W = a.in(I_WDN) + (size_t)l * DFF * DM; d.K = DFF; d.N = DM; d.WT = (bf16*)(wl + LW_DN); d.ldk = -DM; d.item = r; return d; } r -= I_DN;
    d.K = DM; d.N = DM; d.item = r & (I_SQ - 1); const int q = r >> 10;
    if (l == 0) { const int l1 = 1; d.W = a.in(q == 0 ? I_WK : I_WV) + (size_t)l1 * DM * DM; d.WT = (bf16*)(a.ws + WS_WKV); d.ldk = -8192; d.row_off = l1 * 4096 + q * 2048; d.gain = a.in(I_GMEM) + l1 * DM; return d; }
    d.ldk = -DM;
    if (q == 0) { d.W = a.in(I_WOUT) + (size_t)l * DM * DM; d.WT = (bf16*)(wl + LW_OUT); }
    else if (q == 1) { d.W = a.in(I_WQ) + (size_t)l * DM * DM; d.WT = (bf16*)(wl + LW_Q); d.gain = a.in(I_GXA) + l * DM; }
    else { d.W = a.in(I_WO) + (size_t)l * DM * DM; d.WT = (bf16*)(wl + LW_O); }
    return d;
}
__device__ __forceinline__ void late_convert(const Ctx& C, const Ax& a, int l, int rank, int nrank) {
    LAS float* scr = (LAS float*)(C.lds + C.wave * 16640);
    const int NITEMS = 32 * 128 + 128 * 32 + (LATE_EXTRA ? (l == 0 ? 2 : 3) * 1024 : 0);
    const int gw = rank * NWAVES + C.wave, NGW = nrank * NWAVES;
    TDesc cur, nxt; f32x4 va[16], vb[16]; float ga[16], gb[16];
    if (gw < NITEMS) { cur = lc_desc(a, l, gw); p0_load(cur, C.lane, va, ga); }
    for (int it = gw; it < NITEMS; it += 2 * NGW) {
        const int it1 = it + NGW, it2 = it + 2 * NGW;
        if (it1 < NITEMS) { nxt = lc_desc(a, l, it1); p0_load(nxt, C.lane, vb, gb); }
        p0_finish(cur, scr, C.lane, va, ga);
        if (it1 < NITEMS) { if (it2 < NITEMS) { cur = lc_desc(a, l, it2); p0_load(cur, C.lane, va, ga); }
            p0_finish(nxt, scr, C.lane, vb, gb); }
    }
}
__device__ __forceinline__ void ad_prompt_item(const Ctx& C, const Ax& a, int l, int item) {
    const bf16* P = (const bf16*)(a.ws + WS_P); bf16* YC = (bf16*)(a.ws + WS_YC);
    const int b = item >> 6, t0 = (item & 63) * 32; const size_t rbase = (size_t)b * SEQ;
    LAS float* UD = (LAS float*)C.lds;
#pragma unroll 4
    for (int it = C.tid; it < 62 * 64; it += NWAVES * 64) { const int r = it >> 6, cc = it & 63, t = t0 - 30 + r;
        float u[8];
        if (t >= 0) { const bf16* pr = P + (rbase + t) * PIN + PD_ + cc * 8; float d1[8], d2[8]; unpack8(*(const v4u*)pr, d1); unpack8(*(const v4u*)(pr + 512), d2);
#pragma unroll
            for (int j = 0; j < 8; ++j) u[j] = d1[j] * sigm(d2[j]); }
        else {
#pragma unroll
            for (int j = 0; j < 8; ++j) u[j] = 0.f; }
        *(LAS f32x4*)(UD + r * 512 + cc * 8) = (f32x4){u[0], u[1], u[2], u[3]}; *(LAS f32x4*)(UD + r * 512 + cc * 8 + 4) = (f32x4){u[4], u[5], u[6], u[7]}; }
    { const float* cw = a.in(I_CAW) + (size_t)l * 3 * 512;
#pragma unroll 2
      for (int it = C.tid; it < 32 * 64; it += NWAVES * 64) { const int r = it >> 6, cc = it & 63, t = t0 + r; const bf16* pr = P + (rbase + t) * PIN + cc * 8;
        float ab[8], u0[8], u1[8], u2[8], x[8], y[8];
        unpack8(*(const v4u*)pr, ab); unpack8(*(const v4u*)(pr + 512), x); unpack8(*(const v4u*)(pr + 1024), y);
#pragma unroll
        for (int j = 0; j < 8; ++j) u2[j] = x[j] * y[j];
        if (t >= 1) { unpack8(*(const v4u*)(pr - PIN + 512), x); unpack8(*(const v4u*)(pr - PIN + 1024), y);
#pragma unroll
            for (int j = 0; j < 8; ++j) u1[j] = x[j] * y[j]; }
        else {
#pragma unroll
            for (int j = 0; j < 8; ++j) u1[j] = 0.f; }
        if (t >= 2) { unpack8(*(const v4u*)(pr - 2 * PIN + 512), x); unpack8(*(const v4u*)(pr - 2 * PIN + 1024), y);
#pragma unroll
            for (int j = 0; j < 8; ++j) u0[j] = x[j] * y[j]; }
        else {
#pragma unroll
            for (int j = 0; j < 8; ++j) u0[j] = 0.f; }
        float o[8];
#pragma unroll
        for (int j = 0; j < 8; ++j) { const int c = cc * 8 + j; o[j] = ab[j] * (cw[c] * u0[j] + cw[512 + c] * u1[j] + cw[1024 + c] * u2[j]); }
        *(v4u*)(YC + (rbase + t) * DM + cc * 8) = pack8(o);
        if (t >= SEQ - 2) { float* st = a.out + O_CAP + (((size_t)l * NB + b) * 2 + (t - (SEQ - 2))) * 512 + cc * 8; *(f32x4*)st = (f32x4){u2[0], u2[1], u2[2], u2[3]}; *(f32x4*)(st + 4) = (f32x4){u2[4], u2[5], u2[6], u2[7]}; } } }
    __syncthreads();
    const int c = C.tid;
    if (t0 == SEQ - 32) { float* st = a.out + O_CDP + ((size_t)l * NB + b) * 30 * 512 + c;
        for (int j = 0; j < 30; ++j) st[(size_t)j * 512] = UD[(32 + j) * 512 + c]; }
    float cv[32];
    { const float* cw = a.in(I_CDW) + (size_t)l * 31 * 512 + c; const float bias = a.in(I_CDB)[l * 512 + c];
#pragma unroll
      for (int hf = 0; hf < 2; ++hf) {
        float u[46];
#pragma unroll
        for (int r = 0; r < 46; ++r) u[r] = UD[(hf * 16 + r) * 512 + c];
#pragma unroll
        for (int t = 0; t < 16; ++t) cv[hf * 16 + t] = bias;
#pragma unroll
        for (int j = 0; j < 31; ++j) { const float w = cw[(size_t)j * 512];
#pragma unroll
            for (int t = 0; t < 16; ++t) cv[hf * 16 + t] += w * u[t + j]; }
        asm volatile("" ::: "memory"); } }
    __syncthreads();
#pragma unroll
    for (int t = 0; t < 32; ++t) UD[t * 512 + c] = cv[t];
    __syncthreads();
    { const float* lg = a.in(I_LNDG) + l * 512 + C.lane * 8; const float* lb = a.in(I_LNDB) + l * 512 + C.lane * 8;
      const f32x4 g0 = *(const f32x4*)lg, g1 = *(const f32x4*)(lg + 4), b0 = *(const f32x4*)lb, b1 = *(const f32x4*)(lb + 4);
#pragma unroll
      for (int q = 0; q < 4; ++q) { const int t = C.wave * 4 + q; const f32x4 x0 = *(LAS f32x4*)(UD + t * 512 + C.lane * 8), x1 = *(LAS f32x4*)(UD + t * 512 + C.lane * 8 + 4);
        const float mu = wave_sum((x0.x + x0.y) + (x0.z + x0.w) + (x1.x + x1.y) + (x1.z + x1.w)) * (1.0f / 512.0f);
        const f32x4 d0 = x0 - mu, d1 = x1 - mu;
        const float var = wave_sum((d0.x * d0.x + d0.y * d0.y) + (d0.z * d0.z + d0.w * d0.w) + (d1.x * d1.x + d1.y * d1.y) + (d1.z * d1.z + d1.w * d1.w)) * (1.0f / 512.0f);
        const float rstd = 1.0f / sqrtf(var + 1e-6f);
        const f32x4 y0 = d0 * rstd * g0 + b0, y1 = d1 * rstd * g1 + b1; float o[8];
        o[0] = y0.x * sigm(y0.x); o[1] = y0.y * sigm(y0.y); o[2] = y0.z * sigm(y0.z); o[3] = y0.w * sigm(y0.w);
        o[4] = y1.x * sigm(y1.x); o[5] = y1.y * sigm(y1.y); o[6] = y1.z * sigm(y1.z); o[7] = y1.w * sigm(y1.w);
        *(v4u*)(YC + (rbase + t0 + t) * DM + 1536 + C.lane * 8) = pack8(o); } }
    __syncthreads();
}
__device__ __forceinline__ void ad_sample_item(const Ctx& C, const Ax& a, int l, int n) {
    const bf16* P = (const bf16*)(a.ws + WS_P); bf16* YC = (bf16*)(a.ws + WS_YC);
    const int c = C.tid; const bf16* pr = P + (size_t)(MP + n) * PIN;
    LAS float* red = (LAS float*)C.lds;
    { const float* st = a.in(I_SCA) + (((size_t)l * NS + n) * 2) * 512 + c; const float s0 = st[0], s1 = st[512];
      const float ua = bf1(pr[512 + c]) * bf1(pr[1024 + c]); const float* cw = a.in(I_CAW) + (size_t)l * 3 * 512 + c;
      const float y = bf1(pr[c]) * (cw[0] * s0 + cw[512] * s1 + cw[1024] * ua);
      YC[(size_t)(MP + n) * DM + c] = (bf16)(pk2(y, 0.f) & 0xffffu);
      float* o = a.out + O_CAS + (((size_t)l * NS + n) * 2) * 512 + c; o[0] = s1; o[512] = ua; }
    const float* st = a.in(I_SCD) + (((size_t)l * NS + n) * 30) * 512 + c; const float* cw = a.in(I_CDW) + (size_t)l * 31 * 512 + c;
    const float ud = bf1(pr[PD_ + c]) * sigm(bf1(pr[PD_ + 512 + c]));
    float cv = a.in(I_CDB)[l * 512 + c] + cw[30 * 512] * ud;
    float* os = a.out + O_CDS + (((size_t)l * NS + n) * 30) * 512 + c;
#pragma unroll 6
    for (int j = 0; j < 30; ++j) { const float s = st[(size_t)j * 512]; cv += cw[(size_t)j * 512] * s; if (j > 0) os[(size_t)(j - 1) * 512] = s; }
    os[29 * 512] = ud;
    float s = wave_sum(cv); if (C.lane == 0) red[C.wave] = s; __syncthreads();
    float mu = 0.f;
#pragma unroll
    for (int w = 0; w < 8; ++w) mu += red[w];
    mu *= (1.0f / 512.0f); const float d = cv - mu;
    s = wave_sum(d * d); if (C.lane == 0) red[8 + C.wave] = s; __syncthreads();
    float var = 0.f;
#pragma unroll
    for (int w = 0; w < 8; ++w) var += red[8 + w];
    const float rstd = 1.0f / sqrtf(var * (1.0f / 512.0f) + 1e-6f);
    const float y = d * rstd * a.in(I_LNDG)[l * 512 + c] + a.in(I_LNDB)[l * 512 + c];
    YC[(size_t)(MP + n) * DM + 1536 + c] = (bf16)(pk2(y * sigm(y), 0.f) & 0xffffu);
    __syncthreads();
}

__device__ __forceinline__ void shift8(const bf16* cur, const bf16* prevb, const float* prevf, const float* mu, float (&xs)[8]) {
    float pc[8], pv[8]; unpack8(*(const v4u*)cur, pc);
    if (prevb) unpack8(*(const v4u*)prevb, pv);
    else if (prevf) { const f32x4 p0 = *(const f32x4*)prevf, p1 = *(const f32x4*)(prevf + 4); pv[0] = p0.x; pv[1] = p0.y; pv[2] = p0.z; pv[3] = p0.w; pv[4] = p1.x; pv[5] = p1.y; pv[6] = p1.z; pv[7] = p1.w; }
    else {
#pragma unroll
        for (int j = 0; j < 8; ++j) pv[j] = 0.f; }
    const f32x4 m0 = *(const f32x4*)mu, m1 = *(const f32x4*)(mu + 4); const float m[8] = {m0.x, m0.y, m0.z, m0.w, m1.x, m1.y, m1.z, m1.w};
#pragma unroll
    for (int j = 0; j < 8; ++j) xs[j] = pc[j] + (pv[j] - pc[j]) * m[j];
}
__device__ __forceinline__ void shift4(const bf16* cur, const bf16* prevb, const float* prevf, const float* mu, float (&xs)[4]) {
    float pc[4], pv[4]; unpack4(*(const v2u*)cur, pc);
    if (prevb) unpack4(*(const v2u*)prevb, pv);
    else if (prevf) { const f32x4 p0 = *(const f32x4*)prevf; pv[0] = p0.x; pv[1] = p0.y; pv[2] = p0.z; pv[3] = p0.w; }
    else { pv[0] = pv[1] = pv[2] = pv[3] = 0.f; }
    const f32x4 m0 = *(const f32x4*)mu;
    xs[0] = pc[0] + (pv[0] - pc[0]) * m0.x; xs[1] = pc[1] + (pv[1] - pc[1]) * m0.y; xs[2] = pc[2] + (pv[2] - pc[2]) * m0.z; xs[3] = pc[3] + (pv[3] - pc[3]) * m0.w;
}
constexpr int PTS = 1544;
__device__ __forceinline__ void shift4_lds(const LAS bf16* cur, const float* mu, float (&xs)[4]) {
    float pc[4], pv[4]; unpack4(*(const LAS v2u*)cur, pc); unpack4(*(const LAS v2u*)(cur - PTS), pv);
    const f32x4 m0 = *(const f32x4*)mu;
    xs[0] = pc[0] + (pv[0] - pc[0]) * m0.x; xs[1] = pc[1] + (pv[1] - pc[1]) * m0.y; xs[2] = pc[2] + (pv[2] - pc[2]) * m0.z; xs[3] = pc[3] + (pv[3] - pc[3]) * m0.w;
}
constexpr int RWB = 896, RW_KK = 256, RW_KB = 384, RW_K = 512, RW_R = 640, RW_V = 768;
__device__ __forceinline__ void rw_st4(unsigned char* rec, int off, int cl, const f32x4 v) { v2u w; w.x = pk2(v[0], v[1]); w.y = pk2(v[2], v[3]); *(v2u*)(rec + off + cl * 2) = w; }
__device__ __forceinline__ f32x4 rw_ld4(const unsigned char* rec, int off, int cl) { float f[4]; unpack4(*(const v2u*)(rec + off + cl * 2), f); return (f32x4){f[0], f[1], f[2], f[3]}; }
#ifndef DUP_SUB
#define DUP_SUB 0u
#endif
#define PREP_REP(k) for (int prep_rep_ = 0; prep_rep_ < 1 + (int)((DUP_SUB >> (k)) & 1u); ++prep_rep_)
__device__ __forceinline__ void rwkv_prep_item(const Ctx& C, const Ax& a, int l, int item) {
    const bf16* P = (const bf16*)(a.ws + WS_P); float* RW = (float*)(a.ws + WS_RW); float* GATE = (float*)(a.ws + WS_GATE);
    const bool smp = item >= 256; const int row0 = smp ? MP + (item - 256) * 32 : (item >> 6) * SEQ + (item & 63) * 32; const int t0 = smp ? 0 : (item & 63) * 32;
    const float* mu = a.in(I_MU) + (size_t)l * SHW; const float* sst = a.in(I_SSH) + (size_t)l * NS * SHW;
    LAS bf16* AW = (LAS bf16*)C.lds; LAS bf16* AA = AW + 32 * 72; LAS bf16* AG = AA + 32 * 72; LAS bf16* PT = AG + 32 * 136;
    for (int it = C.tid; it < 32 * 32; it += NWAVES * 64) { const int r = it >> 5, cc = it & 31, col = 1536 + cc * 8, row = row0 + r; const bf16* cur = P + (size_t)row * PIN + PC_ + col;
        float xs[8];
        if (smp) shift8(cur, nullptr, sst + (size_t)(row - MP) * SHW + col, mu + col, xs);
        else shift8(cur, (t0 + r > 0) ? cur - PIN : nullptr, nullptr, mu + col, xs);
        if (cc < 8) {
#pragma unroll
            for (int j = 0; j < 8; ++j) xs[j] = tanhf(xs[j]);
            *(LAS v4u*)(AW + r * 72 + cc * 8) = pack8(xs); }
        else if (cc < 16) *(LAS v4u*)(AA + r * 72 + (cc - 8) * 8) = pack8(xs);
        else {
#pragma unroll
            for (int j = 0; j < 8; ++j) xs[j] = sigm(xs[j]);
            *(LAS v4u*)(AG + r * 136 + (cc - 16) * 8) = pack8(xs); } }
    if (!smp) { for (int it = C.tid; it < 33 * 192; it += NWAVES * 64) { const int r = it / 192, cc = it - r * 192; v4u v = (v4u){0u, 0u, 0u, 0u};
            if (t0 + r > 0) v = *(const v4u*)(P + (size_t)(row0 + r - 1) * PIN + PC_ + cc * 8);
            *(LAS v4u*)(PT + r * PTS + cc * 8) = v; } }
    if (smp) { float* o = a.out + O_SHS + ((size_t)l * NS + (row0 - MP)) * SHW;
        for (int it = C.tid; it < 32 * 224; it += NWAVES * 64) { const int r = it / 224, cc = it % 224; float f[8]; unpack8(*(const v4u*)(P + (size_t)(row0 + r) * PIN + PC_ + cc * 8), f);
            float* op = o + (size_t)r * SHW + cc * 8; *(f32x4*)op = (f32x4){f[0], f[1], f[2], f[3]}; *(f32x4*)(op + 4) = (f32x4){f[4], f[5], f[6], f[7]}; } }
    else if (t0 == SEQ - 32) { float* o = a.out + O_SHP + ((size_t)l * NB + (item >> 6)) * SHW;
        for (int cc = C.tid; cc < 224; cc += NWAVES * 64) { float f[8]; unpack8(*(const v4u*)(P + (size_t)(row0 + 31) * PIN + PC_ + cc * 8), f);
            *(f32x4*)(o + cc * 8) = (f32x4){f[0], f[1], f[2], f[3]}; *(f32x4*)(o + cc * 8 + 4) = (f32x4){f[4], f[5], f[6], f[7]}; } }
    __syncthreads();
    const int h = C.wave, fr = C.lane & 15, fq = C.lane >> 4;
    const unsigned char* wl = a.ws + WS_WL + (size_t)l * LW_STRIDE;
    const bf16* W2t = (const bf16*)(wl + LW_W2); const bf16* A2t = (const bf16*)(wl + LW_A2); const bf16* G2t = (const bf16*)(wl + LW_G2);
    PREP_REP(23) { constexpr int tp = 0;
        f32x4 acc[4][2];
#pragma unroll
        for (int ct = 0; ct < 4; ++ct)
#pragma unroll
            for (int t2 = 0; t2 < 2; ++t2) acc[ct][t2] = zero4();
#pragma unroll
        for (int ks = 0; ks < 2; ++ks) { bf16x8 af[2], wf[4];
#pragma unroll
            for (int t2 = 0; t2 < 2; ++t2) af[t2] = *(const LAS bf16x8*)(AA + (tp * 32 + t2 * 16 + fr) * 72 + ks * 32 + fq * 8);
#pragma unroll
            for (int ct = 0; ct < 4; ++ct) wf[ct] = *(const bf16x8*)(A2t + (size_t)(h * 64 + ct * 16 + fr) * 64 + ks * 32 + fq * 8);
#pragma unroll
            for (int ct = 0; ct < 4; ++ct)
#pragma unroll
                for (int t2 = 0; t2 < 2; ++t2) acc[ct][t2] = __builtin_amdgcn_mfma_f32_16x16x32_bf16(wf[ct], af[t2], acc[ct][t2], 0, 0, 0); }
        const float* a0 = a.in(I_A0) + l * 512; const float* kkw = a.in(I_KK) + l * 512; const float* kaw = a.in(I_KA) + l * 512;
#pragma unroll
        for (int t2 = 0; t2 < 2; ++t2) { const int r = tp * 32 + t2 * 16 + fr, row = row0 + r; const bf16* prow = P + (size_t)row * PIN + PC_;
            const float* pf = smp ? sst + (size_t)(row - MP) * SHW : nullptr;
            float kkr[4][4], av[4][4], kc[4][4]; float ss = 0.f;
#pragma unroll
            for (int ct = 0; ct < 4; ++ct) { const int ch = h * 64 + ct * 16 + fq * 4; const f32x4 a0v = *(const f32x4*)(a0 + ch), kkv = *(const f32x4*)(kkw + ch);
                float xs[4]; if (smp) shift4(prow + 512 + ch, nullptr, pf + 512 + ch, mu + 512 + ch, xs); else shift4_lds(PT + (r + 1) * PTS + 512 + ch, mu + 512 + ch, xs);
#pragma unroll
                for (int j = 0; j < 4; ++j) { av[ct][j] = sigm(a0v[j] + acc[ct][t2][j]); kc[ct][j] = xs[j]; kkr[ct][j] = xs[j] * kkv[j]; ss += kkr[ct][j] * kkr[ct][j]; } }
            ss += __shfl_xor(ss, 16); ss += __shfl_xor(ss, 32);
            const float inv = 1.0f / fmaxf(sqrtf(ss), 1e-12f);
            unsigned char* rw = (unsigned char*)RW + ((size_t)row * 8 + h) * RWB;
#pragma unroll
            for (int ct = 0; ct < 4; ++ct) { const int ch = h * 64 + ct * 16 + fq * 4, cl = ct * 16 + fq * 4; const f32x4 kav = *(const f32x4*)(kaw + ch);
                f32x4 kk, kb, k4;
#pragma unroll
                for (int j = 0; j < 4; ++j) { kk[j] = kkr[ct][j] * inv; kb[j] = kk[j] * av[ct][j]; k4[j] = kc[ct][j] * (1.0f + (av[ct][j] - 1.0f) * kav[j]); }
                rw_st4(rw, RW_KK, cl, kk); rw_st4(rw, RW_KB, cl, kb); rw_st4(rw, RW_K, cl, k4);
                float xr[4], xv[4];
                if (smp) { shift4(prow + ch, nullptr, pf + ch, mu + ch, xr); shift4(prow + 1024 + ch, nullptr, pf + 1024 + ch, mu + 1024 + ch, xv); }
                else { shift4_lds(PT + (r + 1) * PTS + ch, mu + ch, xr); shift4_lds(PT + (r + 1) * PTS + 1024 + ch, mu + 1024 + ch, xv); }
                rw_st4(rw, RW_R, cl, (f32x4){xr[0], xr[1], xr[2], xr[3]}); rw_st4(rw, RW_V, cl, (f32x4){xv[0], xv[1], xv[2], xv[3]}); } }
    }
    PREP_REP(24) { constexpr int tp = 0;
        f32x4 acc[4][2];
#pragma unroll
        for (int ct = 0; ct < 4; ++ct)
#pragma unroll
            for (int t2 = 0; t2 < 2; ++t2) acc[ct][t2] = zero4();
#pragma unroll
        for (int ks = 0; ks < 2; ++ks) { bf16x8 af[2], wf[4];
#pragma unroll
            for (int t2 = 0; t2 < 2; ++t2) af[t2] = *(const LAS bf16x8*)(AW + (tp * 32 + t2 * 16 + fr) * 72 + ks * 32 + fq * 8);
#pragma unroll
            for (int ct = 0; ct < 4; ++ct) wf[ct] = *(const bf16x8*)(W2t + (size_t)(h * 64 + ct * 16 + fr) * 64 + ks * 32 + fq * 8);
#pragma unroll
            for (int ct = 0; ct < 4; ++ct)
#pragma unroll
                for (int t2 = 0; t2 < 2; ++t2) acc[ct][t2] = __builtin_amdgcn_mfma_f32_16x16x32_bf16(wf[ct], af[t2], acc[ct][t2], 0, 0, 0); }
        const float* w0 = a.in(I_W0) + l * 512;
#pragma unroll
        for (int t2 = 0; t2 < 2; ++t2) { const int row = row0 + tp * 32 + t2 * 16 + fr; float* rw = (float*)((unsigned char*)RW + ((size_t)row * 8 + h) * RWB);
#pragma unroll
            for (int ct = 0; ct < 4; ++ct) { const int ch = h * 64 + ct * 16 + fq * 4, cl = ct * 16 + fq * 4; const f32x4 w0v = *(const f32x4*)(w0 + ch); f32x4 d;
#pragma unroll
                for (int j = 0; j < 4; ++j) { const float z = -(w0v[j] + acc[ct][t2][j]); const float sp = fmaxf(z, 0.f) + __logf(1.0f + __expf(-fabsf(z))); const float w = -sp - 0.5f; d[j] = -__expf(w); }
                *(f32x4*)(rw + cl) = d; } }
    }
    PREP_REP(25) { constexpr int tp = 0;
        f32x4 acc[4][2];
#pragma unroll
        for (int ct = 0; ct < 4; ++ct)
#pragma unroll
            for (int t2 = 0; t2 < 2; ++t2) acc[ct][t2] = zero4();
#pragma unroll
        for (int ks = 0; ks < 4; ++ks) { bf16x8 af[2], wf[4];
#pragma unroll
            for (int t2 = 0; t2 < 2; ++t2) af[t2] = *(const LAS bf16x8*)(AG + (tp * 32 + t2 * 16 + fr) * 136 + ks * 32 + fq * 8);
#pragma unroll
            for (int ct = 0; ct < 4; ++ct) wf[ct] = *(const bf16x8*)(G2t + (size_t)(h * 64 + ct * 16 + fr) * 128 + ks * 32 + fq * 8);
#pragma unroll
            for (int ct = 0; ct < 4; ++ct)
#pragma unroll
                for (int t2 = 0; t2 < 2; ++t2) acc[ct][t2] = __builtin_amdgcn_mfma_f32_16x16x32_bf16(wf[ct], af[t2], acc[ct][t2], 0, 0, 0); }
#pragma unroll
        for (int t2 = 0; t2 < 2; ++t2) { const int row = row0 + tp * 32 + t2 * 16 + fr;
#pragma unroll
            for (int ct = 0; ct < 4; ++ct) *(f32x4*)(GATE + (size_t)row * 512 + h * 64 + ct * 16 + fq * 4) = acc[ct][t2]; }
    }
    __syncthreads();
}

#define PACK8(arr, o) ((v4u){pk2((arr)[(o)], (arr)[(o) + 1]), pk2((arr)[(o) + 2], (arr)[(o) + 3]), pk2((arr)[(o) + 4], (arr)[(o) + 5]), pk2((arr)[(o) + 6], (arr)[(o) + 7])})
constexpr int WK_LDS = 18432, WK_SHR = 6912, WK_PRV = 3072;
__device__ __forceinline__ f32x4 mfma16(bf16x4 a, bf16x4 b, f32x4 c) { return __builtin_amdgcn_mfma_f32_16x16x16bf16_1k(a, b, c, 0, 0, 0); }
__device__ __forceinline__ bf16 bfr1(float x) { return (bf16)(pk2(x, 0.f) & 0xffffu); }
__device__ __forceinline__ void wkv_chunk_witem(const Ctx& C, const Ax& a, int ci) {
    const float* RW = (const float*)(a.ws + WS_RW);
    unsigned char* CK = a.ws + WS_CK + (size_t)ci * WK_SHR; unsigned char* CP = a.ws + WS_CP + (size_t)ci * 4 * WK_PRV;
    const int bh = ci >> 7, c = ci & 127, b = bh >> 3, h = bh & 7, lane = C.lane, fr = lane & 15, fq = lane >> 4;
    LAS unsigned char* Lb = C.lds + C.wave * WK_LDS;
    LAS bf16* TA = (LAS bf16*)Lb; LAS bf16* TB = TA + 16 * 72; LAS bf16* TK = TB + 16 * 72; LAS bf16* TR = TK + 16 * 72; LAS bf16* VT = TR + 16 * 72;
    LAS float* M1 = (LAS float*)(Lb + 12288); LAS float* M2 = M1 + 320; LAS float* N1 = M2 + 320; LAS float* N2 = N1 + 320;
    LAS bf16* TG = TA; LAS bf16* PST = TK;
    const unsigned char* rw = (const unsigned char*)RW + (((size_t)b * SEQ + c * 16) * 8 + h) * RWB;
#define RWF(t) (*(const float*)(rw + (size_t)(t) * (8 * RWB) + lane * 4))
#define RWH(t, off) bf1(*(const bf16*)(rw + (size_t)(t) * (8 * RWB) + (off) + lane * 2))
    float lam[16]; { float run = 0.f;
#pragma unroll
      for (int t = 0; t < 16; ++t) { run += RWF(t); lam[t] = run; } }
    const float lamT = lam[15];
    ((float*)CK)[lane] = __expf(lamT);
    float Bp[16], Kp[16], al[16], ro[16];
    bf16* ATg = (bf16*)(CK + 256); bf16* OMg = (bf16*)(CK + 256 + 2304);
    float wkk[4], wbb[4], wkx[4], wrr[4], wvv[4];
#pragma unroll
    for (int t = 0; t < 4; ++t) { wkk[t] = RWH(t, RW_KK); wbb[t] = RWH(t, RW_KB); wkx[t] = RWH(t, RW_K); wrr[t] = RWH(t, RW_R); wvv[t] = RWH(t, RW_V); }
#pragma unroll
    for (int t = 0; t < 16; ++t) { const float kk = wkk[t & 3], bb = wbb[t & 3], kx = wkx[t & 3], rr = wrr[t & 3], vv = wvv[t & 3];
        if (t + 4 < 16) { wkk[t & 3] = RWH(t + 4, RW_KK); wbb[t & 3] = RWH(t + 4, RW_KB); wkx[t & 3] = RWH(t + 4, RW_K); wrr[t & 3] = RWH(t + 4, RW_R); wvv[t & 3] = RWH(t + 4, RW_V); }
        const float ein = __expf(-lam[t]), eprev = (t ? __expf(lam[t - 1]) : 1.0f), ecur = __expf(lam[t]), erest = __expf(lamT - lam[t]);
        al[t] = kk * eprev; ro[t] = rr * ecur; Bp[t] = bb * erest; Kp[t] = kx * erest;
        const bf16 ab = bfr1(al[t]);
        TA[t * 72 + lane] = ab; TB[t * 72 + lane] = bfr1(bb * ein); TK[t * 72 + lane] = bfr1(kx * ein); TR[t * 72 + lane] = bfr1(ro[t]); VT[lane * 24 + t] = bfr1(vv);
        ATg[t * 72 + lane] = ab;
        asm volatile("" ::: "memory"); __builtin_amdgcn_sched_barrier(0); }
    LDS_WAIT(); asm volatile("" ::: "memory");
    { f32x4 g1 = zero4(), g2 = zero4(), n1 = zero4(), n2 = zero4();
#pragma unroll
      for (int ks = 0; ks < 2; ++ks) { const int o = fr * 72 + ks * 32 + fq * 8;
        const bf16x8 bf_ = *(const LAS bf16x8*)(TB + o), kf_ = *(const LAS bf16x8*)(TK + o), af_ = *(const LAS bf16x8*)(TA + o), rf_ = *(const LAS bf16x8*)(TR + o);
        g1 = __builtin_amdgcn_mfma_f32_16x16x32_bf16(bf_, af_, g1, 0, 0, 0); g2 = __builtin_amdgcn_mfma_f32_16x16x32_bf16(kf_, af_, g2, 0, 0, 0);
        n1 = __builtin_amdgcn_mfma_f32_16x16x32_bf16(bf_, rf_, n1, 0, 0, 0); n2 = __builtin_amdgcn_mfma_f32_16x16x32_bf16(kf_, rf_, n2, 0, 0, 0); }
#pragma unroll
      for (int r = 0; r < 4; ++r) { const int s_ = 4 * fq + r, o = s_ * 20 + fr;
        M1[o] = (s_ < fr) ? g1[r] : 0.f; M2[o] = (s_ < fr) ? g2[r] : 0.f; N1[o] = (s_ <= fr) ? n1[r] : 0.f; N2[o] = (s_ <= fr) ? n2[r] : 0.f; } }
    LDS_WAIT(); asm volatile("" ::: "memory");
    __builtin_amdgcn_sched_barrier(0);
#pragma unroll
    for (int s_ = 14; s_ >= 0; --s_) { float m[16];
#pragma unroll
        for (int q = 0; q < 4; ++q) { const f32x4 v = *(const LAS f32x4*)(M1 + s_ * 20 + 4 * q); m[4 * q] = v.x; m[4 * q + 1] = v.y; m[4 * q + 2] = v.z; m[4 * q + 3] = v.w; }
        float acc = Bp[s_];
#pragma unroll
        for (int t = s_ + 1; t < 16; ++t) acc -= m[t] * Bp[t];
        asm volatile("" : "+v"(acc) :: "memory"); Bp[s_] = acc; __builtin_amdgcn_sched_barrier(0); }
#pragma unroll
    for (int s_ = 0; s_ < 15; ++s_) { float m[16];
#pragma unroll
        for (int q = 0; q < 4; ++q) { const f32x4 v = *(const LAS f32x4*)(M2 + s_ * 20 + 4 * q); m[4 * q] = v.x; m[4 * q + 1] = v.y; m[4 * q + 2] = v.z; m[4 * q + 3] = v.w; }
        float acc = Kp[s_];
#pragma unroll
        for (int t = s_ + 1; t < 16; ++t) acc -= m[t] * Bp[t];
        asm volatile("" : "+v"(acc) :: "memory"); Kp[s_] = acc; __builtin_amdgcn_sched_barrier(0); }
    __builtin_amdgcn_sched_barrier(0);
    { float ng[16];
#pragma unroll
      for (int t = 0; t < 16; ++t) ng[t] = -Bp[t];
      *(v4u*)(CK + 256 + 4608 + lane * 32) = PACK8(ng, 0); *(v4u*)(CK + 256 + 4608 + lane * 32 + 16) = PACK8(ng, 8); }
    *(LAS v4u*)(TG + lane * 24) = PACK8(Kp, 0); *(LAS v4u*)(TG + lane * 24 + 8) = PACK8(Kp, 8);
    __builtin_amdgcn_sched_barrier(0);
    { float hh[16], ps[16];
#pragma unroll
      for (int s_ = 0; s_ < 16; ++s_) { hh[s_] = N1[s_ * 20 + fr]; ps[s_] = N2[s_ * 20 + fr]; }
#pragma unroll
      for (int s_ = 14; s_ >= 0; --s_) { float m[16];
#pragma unroll
        for (int q = 0; q < 4; ++q) { const f32x4 v = *(const LAS f32x4*)(M1 + s_ * 20 + 4 * q); m[4 * q] = v.x; m[4 * q + 1] = v.y; m[4 * q + 2] = v.z; m[4 * q + 3] = v.w; }
        float acc = hh[s_];
#pragma unroll
        for (int u = s_ + 1; u < 16; ++u) acc -= m[u] * hh[u];
        asm volatile("" : "+v"(acc) :: "memory"); hh[s_] = acc; __builtin_amdgcn_sched_barrier(0); }
#pragma unroll
      for (int s_ = 0; s_ < 15; ++s_) { float m[16];
#pragma unroll
        for (int q = 0; q < 4; ++q) { const f32x4 v = *(const LAS f32x4*)(M2 + s_ * 20 + 4 * q); m[4 * q] = v.x; m[4 * q + 1] = v.y; m[4 * q + 2] = v.z; m[4 * q + 3] = v.w; }
        float acc = ps[s_];
#pragma unroll
        for (int u = s_ + 1; u < 16; ++u) acc -= m[u] * hh[u];
        asm volatile("" : "+v"(acc) :: "memory"); ps[s_] = acc; __builtin_amdgcn_sched_barrier(0); }
      LDS_WAIT(); asm volatile("" ::: "memory");
#pragma unroll
      for (int s_ = 0; s_ < 16; ++s_) N1[s_ * 20 + fr] = hh[s_];
      *(LAS v4u*)(PST + fr * 24) = PACK8(ps, 0); *(LAS v4u*)(PST + fr * 24 + 8) = PACK8(ps, 8); }
    LDS_WAIT(); asm volatile("" ::: "memory");
    __builtin_amdgcn_sched_barrier(0);
#pragma unroll
    for (int s_ = 0; s_ < 16; ++s_) { float m[16];
#pragma unroll
        for (int q = 0; q < 4; ++q) { const f32x4 v = *(const LAS f32x4*)(N1 + s_ * 20 + 4 * q); m[4 * q] = v.x; m[4 * q + 1] = v.y; m[4 * q + 2] = v.z; m[4 * q + 3] = v.w; }
#pragma unroll
        for (int t = s_; t < 16; ++t) ro[t] -= m[t] * al[s_];
        asm volatile("" ::: "memory"); __builtin_amdgcn_sched_barrier(0); }
#pragma unroll
    for (int t = 0; t < 16; ++t) OMg[t * 72 + lane] = bfr1(ro[t]);
    LDS_WAIT(); asm volatile("" ::: "memory");
    __builtin_amdgcn_sched_barrier(0);
    { bf16x4 vf[4];
#pragma unroll
      for (int it = 0; it < 4; ++it) vf[it] = *(const LAS bf16x4*)(VT + (it * 16 + fr) * 24 + fq * 4);
#pragma unroll
      for (int kt = 0; kt < 4; ++kt) { const bf16x4 gf = *(const LAS bf16x4*)(TG + (kt * 16 + fr) * 24 + fq * 4);
#pragma unroll
        for (int it = 0; it < 4; ++it) { const f32x4 d = mfma16(gf, vf[it], zero4()); v2u dw; dw.x = pk2(d[0], d[1]); dw.y = pk2(d[2], d[3]); *(v2u*)(CP + it * WK_PRV + kt * 512 + lane * 8) = dw; } }
      const bf16x4 pf = *(const LAS bf16x4*)(PST + fr * 24 + fq * 4);
#pragma unroll
      for (int it = 0; it < 4; ++it) { const f32x4 o = mfma16(pf, vf[it], zero4()); *(f32x4*)(CP + it * WK_PRV + 2048 + lane * 16) = o; } }
    LDS_WAIT(); asm volatile("" ::: "memory");
}
constexpr int WQ_CH = WK_PRV + WK_SHR, WQ_SLOT = 4 * WQ_CH, WQ_PCS = WQ_CH / 16, WQ_NWL = 4 * WQ_PCS / 64;
__device__ __forceinline__ void wkv_seq_chunk(const LAS unsigned char* sp, f32x4 (&acc)[4], float* orow, int lane, int fr, int fq) {
    const LAS unsigned char* sh = sp + WK_PRV;
    bf16x8 af[2], of[2]; bf16x4 gf[4]; f32x4 wt[4], dt[4];
#pragma unroll
    for (int s = 0; s < 2; ++s) { const LAS bf16* ap = (const LAS bf16*)(sh + 256) + fr * 72 + 32 * s + 4 * fq; const v2u lo = *(const LAS v2u*)ap, hi = *(const LAS v2u*)(ap + 16);
        af[s] = __builtin_bit_cast(bf16x8, (v4u){lo.x, lo.y, hi.x, hi.y});
        const LAS bf16* op = (const LAS bf16*)(sh + 256 + 2304) + fr * 72 + 32 * s + 4 * fq; const v2u lo2 = *(const LAS v2u*)op, hi2 = *(const LAS v2u*)(op + 16);
        of[s] = __builtin_bit_cast(bf16x8, (v4u){lo2.x, lo2.y, hi2.x, hi2.y}); }
#pragma unroll
    for (int kt = 0; kt < 4; ++kt) { gf[kt] = *(const LAS bf16x4*)((const LAS bf16*)(sh + 256 + 4608) + (kt * 16 + fr) * 16 + 4 * fq);
        wt[kt] = *(const LAS f32x4*)(sh + (16 * kt + 4 * fq) * 4); { float f_[4]; unpack4(*(const LAS v2u*)(sp + kt * 512 + lane * 8), f_); dt[kt] = (f32x4){f_[0], f_[1], f_[2], f_[3]}; } }
    const f32x4 ov = *(const LAS f32x4*)(sp + 2048 + lane * 16);
    bf16x8 sbf[2];
#pragma unroll
    for (int s = 0; s < 2; ++s) { v4u w; w.x = pk2(acc[2 * s][0], acc[2 * s][1]); w.y = pk2(acc[2 * s][2], acc[2 * s][3]); w.z = pk2(acc[2 * s + 1][0], acc[2 * s + 1][1]); w.w = pk2(acc[2 * s + 1][2], acc[2 * s + 1][3]);
        sbf[s] = __builtin_bit_cast(bf16x8, w); }
    f32x4 x = zero4();
    x = __builtin_amdgcn_mfma_f32_16x16x32_bf16(af[0], sbf[0], x, 0, 0, 0); x = __builtin_amdgcn_mfma_f32_16x16x32_bf16(af[1], sbf[1], x, 0, 0, 0);
    f32x4 o = __builtin_amdgcn_mfma_f32_16x16x32_bf16(of[0], sbf[0], ov, 0, 0, 0); o = __builtin_amdgcn_mfma_f32_16x16x32_bf16(of[1], sbf[1], o, 0, 0, 0);
    v2u xw; xw.x = pk2(x[0], x[1]); xw.y = pk2(x[2], x[3]); const bf16x4 xb = __builtin_bit_cast(bf16x4, xw);
#pragma unroll
    for (int kt = 0; kt < 4; ++kt) acc[kt] = mfma16(gf[kt], xb, acc[kt] * wt[kt] + dt[kt]);
    orow[0] = o[0]; orow[512] = o[1]; orow[1024] = o[2]; orow[1536] = o[3];
}
__device__ __forceinline__ void wkv_seq_item(const Ctx& C, const Ax& a, int l, int item) {
    const int bh = item >> 2, rg = item & 3, b = bh >> 3, h = bh & 7, lane = C.lane, fr = lane & 15, fq = lane >> 4;
    const unsigned char* CK = a.ws + WS_CK + (size_t)bh * 128 * WK_SHR; const unsigned char* CP = a.ws + WS_CP + ((size_t)bh * 128 * 4 + rg) * WK_PRV;
    float* OC = (float*)(a.ws + WS_OC) + ((size_t)b * SEQ) * 512 + h * 64 + rg * 16 + fr;
#define WQ_COMPUTE(blk) do { const LAS unsigned char* sbp = C.lds + ((blk) % 3) * WQ_SLOT; \
            _Pragma("unroll 2") for (int cq = 0; cq < 4; ++cq) wkv_seq_chunk(sbp + cq * WQ_CH, acc, OC + (size_t)(((blk) * 4 + cq) * 16 + 4 * fq) * 512, lane, fr, fq); } while (0)
    static_assert(4 * WQ_PCS == WQ_NWL * 64 && WQ_NWL > 35 && WQ_NWL <= 42 && 3 * WQ_SLOT <= SCR_BYTES, "ring geometry");
    if (C.wave == 0) {
        f32x4 acc[4];
#pragma unroll
        for (int kt = 0; kt < 4; ++kt) acc[kt] = zero4();
        __builtin_amdgcn_s_barrier(); asm volatile("" ::: "memory");
        for (int blk = 0; blk < 32; ++blk) { WQ_COMPUTE(blk); asm volatile("s_waitcnt lgkmcnt(0)" ::: "memory"); __builtin_amdgcn_s_barrier(); asm volatile("" ::: "memory"); }
        float* so = a.out + O_WKVP + ((((size_t)l * NB + b) * 8 + h) * 64 + rg * 16 + fr) * 64 + 4 * fq;
#pragma unroll
        for (int kt = 0; kt < 4; ++kt) *(f32x4*)(so + 16 * kt) = acc[kt];
    } else {
        const int w1 = C.wave - 1; const bool seven = (w1 + 35) < WQ_NWL;
        const unsigned char* wsb = a.ws; unsigned qoff[6], qstr[6];
#pragma unroll
        for (int i = 0; i < 6; ++i) { const int p = (w1 + 7 * i) * 64 + lane, cq = p / WQ_PCS, q = p - cq * WQ_PCS; const bool pr = q < WK_PRV / 16;
            qoff[i] = pr ? (unsigned)(WS_CP + ((size_t)bh * 128 * 4 + rg) * WK_PRV) + (unsigned)(cq * 4 * WK_PRV + q * 16) : (unsigned)(WS_CK + (size_t)bh * 128 * WK_SHR) + (unsigned)(cq * WK_SHR + (q - WK_PRV / 16) * 16);
            qstr[i] = pr ? (unsigned)(16 * WK_PRV) : (unsigned)(4 * WK_SHR); }
#define WQ_DMA(blk) do { _Pragma("unroll") for (int i = 0; i < 6; ++i) if (i < 5 || seven) \
            __builtin_amdgcn_global_load_lds((const unsigned*)(wsb + (qoff[i] + (unsigned)(blk) * qstr[i])), (LAS unsigned*)(C.lds + ((blk) % 3) * WQ_SLOT + (w1 + 7 * i) * 1024), 16, 0, 0); } while (0)
#define WQ_WAIT_OLDER() do { if (seven) asm volatile("s_waitcnt vmcnt(6)" ::: "memory"); else asm volatile("s_waitcnt vmcnt(5)" ::: "memory"); } while (0)
        WQ_DMA(0); WQ_DMA(1); WQ_WAIT_OLDER();
        __builtin_amdgcn_s_barrier(); asm volatile("" ::: "memory");
        for (int blk = 0; blk < 32; ++blk) {
            if (blk + 2 < 32) { WQ_DMA(blk + 2); WQ_WAIT_OLDER(); }
            else asm volatile("s_waitcnt vmcnt(0)" ::: "memory");
            __builtin_amdgcn_s_barrier(); asm volatile("" ::: "memory");
        }
#undef WQ_DMA
#undef WQ_WAIT_OLDER
    }
#undef WQ_COMPUTE
    __syncthreads();
}
__device__ __forceinline__ void rwkv_sample_witem(const Ctx& C, const Ax& a, int l, int witem) {
    const float* RW = (const float*)(a.ws + WS_RW); float* OC = (float*)(a.ws + WS_OC);
    const int n = witem >> 4, h = (witem >> 1) & 7, half = witem & 1, g = C.lane & 15, rq = C.lane >> 4;
    const unsigned char* p = (const unsigned char*)RW + ((size_t)(MP + n) * 8 + h) * RWB;
    const f32x4 lw4 = *(const f32x4*)(p + 16 * g), kk4 = rw_ld4(p, RW_KK, 4 * g), b4 = rw_ld4(p, RW_KB, 4 * g), k4 = rw_ld4(p, RW_K, 4 * g), r4 = rw_ld4(p, RW_R, 4 * g);
    const f32x4 w4 = (f32x4){__expf(lw4.x), __expf(lw4.y), __expf(lw4.z), __expf(lw4.w)};
    const float* sin_ = a.in(I_SWKV) + (((size_t)l * NS + n) * 8 + h) * 4096; float* sout = a.out + O_WKVS + (((size_t)l * NS + n) * 8 + h) * 4096;
#pragma unroll 4
    for (int it = 0; it < 8; ++it) { const int i = half * 32 + it * 4 + rq; const f32x4 S = __builtin_nontemporal_load((const f32x4*)(sin_ + i * 64 + 4 * g)); const float vi = bf1(*(const bf16*)(p + RW_V + i * 2));
        const float sa = -rowsum16((S.x * kk4.x + S.y * kk4.y) + (S.z * kk4.z + S.w * kk4.w));
        f32x4 T; T.x = S.x * w4.x + (sa * b4.x + vi * k4.x); T.y = S.y * w4.y + (sa * b4.y + vi * k4.y); T.z = S.z * w4.z + (sa * b4.z + vi * k4.z); T.w = S.w * w4.w + (sa * b4.w + vi * k4.w);
        const float o = rowsum16((T.x * r4.x + T.y * r4.y) + (T.z * r4.z + T.w * r4.w));
        __builtin_nontemporal_store(T, (f32x4*)(sout + i * 64 + 4 * g));
        if (g == 0) OC[(size_t)(MP + n) * 512 + h * 64 + i] = o; }
}
__device__ __forceinline__ void rwkv_post_phase(const Ctx& C, const Ax& a, int l) {
    const float* RW = (const float*)(a.ws + WS_RW); const float* OC = (const float*)(a.ws + WS_OC); const float* GATE = (const float*)(a.ws + WS_GATE); bf16* YC = (bf16*)(a.ws + WS_YC);
    const int gw = C.bid * NWAVES + C.wave, NGW = C.G * NWAVES, g = C.lane & 15, rq = C.lane >> 4;
    const float* lg = a.in(I_LNXG) + l * 512; const float* lb = a.in(I_LNXB) + l * 512; const float* rk = a.in(I_RK) + l * 512;
    for (int it = gw; it < MT * 8 / 4; it += NGW) { const int pair = it * 4 + rq, row = pair >> 3, h = pair & 7, ch = h * 64 + 4 * g;
        const f32x4 o = *(const f32x4*)(OC + (size_t)row * 512 + ch);
        const float mu = rowsum16((o.x + o.y) + (o.z + o.w)) * (1.0f / 64.0f); const f32x4 d = o - mu;
        const float var = rowsum16((d.x * d.x + d.y * d.y) + (d.z * d.z + d.w * d.w)) * (1.0f / 64.0f); const float rstd = 1.0f / sqrtf(var + 64e-5f);
        const unsigned char* rw = (const unsigned char*)RW + ((size_t)row * 8 + h) * RWB;
        const f32x4 k4 = rw_ld4(rw, RW_K, 4 * g), r4 = rw_ld4(rw, RW_R, 4 * g), v4 = rw_ld4(rw, RW_V, 4 * g), rkv = *(const f32x4*)(rk + ch), gv = *(const f32x4*)(GATE + (size_t)row * 512 + ch);
        const float bs = rowsum16((r4.x * k4.x * rkv.x + r4.y * k4.y * rkv.y) + (r4.z * k4.z * rkv.z + r4.w * k4.w * rkv.w));
        const f32x4 y = (d * rstd * *(const f32x4*)(lg + ch) + *(const f32x4*)(lb + ch) + bs * v4) * gv;
        v2u w; w.x = pk2(y.x, y.y); w.y = pk2(y.z, y.w); *(v2u*)(YC + (size_t)row * DM + 1024 + ch) = w; }
}

__device__ __forceinline__ float ret_lg(int h) { return log1pf(-exp2f(-5.0f - (float)h)); }
constexpr int RS = 136;
__device__ __forceinline__ void rot8(const bf16* src, const float* cs, int c8, float scale, float (&lo)[8], float (&hi)[8]) {
    float x1[8], x2[8]; unpack8(*(const v4u*)(src + c8 * 8), x1); unpack8(*(const v4u*)(src + 64 + c8 * 8), x2);
    const f32x4* cp = (const f32x4*)(cs + 16 * c8); const f32x4 t0 = cp[0], t1 = cp[1], t2 = cp[2], t3 = cp[3];
    const float cc[8] = {t0.x, t0.z, t1.x, t1.z, t2.x, t2.z, t3.x, t3.z}, sn[8] = {t0.y, t0.w, t1.y, t1.w, t2.y, t2.w, t3.y, t3.w};
#pragma unroll
    for (int j = 0; j < 8; ++j) { lo[j] = (x1[j] * cc[j] - x2[j] * sn[j]) * scale; hi[j] = (x2[j] * cc[j] + x1[j] * sn[j]) * scale; }
}
__device__ __forceinline__ void ret_pass1_item(const Ctx& C, const Ax& a, int item) {
    const bf16* P = (const bf16*)(a.ws + WS_P); const float* CS = (const float*)(a.ws + WS_ROPE); float* KVT = (float*)(a.ws + WS_KVT);
    const int b = item >> 6, h = (item >> 4) & 3, c = item & 15; const size_t row0 = (size_t)b * SEQ + c * 128; const float lg = ret_lg(h);
    LAS bf16* KT = (LAS bf16*)C.lds; LAS bf16* VT = KT + 128 * RS;
    for (int it = C.tid; it < 128 * 8; it += NWAVES * 64) { const int tt = it & 127, c8 = it >> 7; float lo[8], hi[8];
        rot8(P + (row0 + tt) * PIN + PB_ + 512 + h * 128, CS + (size_t)(c * 128 + tt) * 128, c8, 0.08838834764831845f * __expf(lg * (float)(127 - tt)), lo, hi);
#pragma unroll
        for (int j = 0; j < 8; ++j) { KT[(c8 * 8 + j) * RS + tt] = (bf16)(pk2(lo[j], 0.f) & 0xffffu); KT[(64 + c8 * 8 + j) * RS + tt] = (bf16)(pk2(hi[j], 0.f) & 0xffffu); } }
    for (int it = C.tid; it < 128 * 16; it += NWAVES * 64) { const int tt = it & 127, c8 = it >> 7; const v4u w = *(const v4u*)(P + (row0 + tt) * PIN + PB_ + 1024 + h * 128 + c8 * 8);
        const unsigned ww[4] = {w.x, w.y, w.z, w.w};
#pragma unroll
        for (int j = 0; j < 4; ++j) { VT[(c8 * 8 + 2 * j) * RS + tt] = (bf16)(ww[j] & 0xffffu); VT[(c8 * 8 + 2 * j + 1) * RS + tt] = (bf16)(ww[j] >> 16); } }
    __syncthreads();
    const int fr = C.lane & 15, fq = C.lane >> 4, w = C.wave;
    f32x4 acc[8];
#pragma unroll
    for (int et = 0; et < 8; ++et) acc[et] = zero4();
#pragma unroll
    for (int ks = 0; ks < 4; ++ks) { const bf16x8 kf = *(const LAS bf16x8*)(KT + (16 * w + fr) * RS + ks * 32 + fq * 8);
#pragma unroll
        for (int et = 0; et < 8; ++et) { const bf16x8 vf = *(const LAS bf16x8*)(VT + (16 * et + fr) * RS + ks * 32 + fq * 8); acc[et] = __builtin_amdgcn_mfma_f32_16x16x32_bf16(kf, vf, acc[et], 0, 0, 0); } }
    float* o = KVT + (size_t)item * 16384;
#pragma unroll
    for (int et = 0; et < 8; ++et) *(f32x4*)(o + (size_t)(16 * et + fr) * 128 + 16 * w + 4 * fq) = acc[et];
    __syncthreads();
}
__device__ __forceinline__ void ret_prefix_phase(const Ctx& C, const Ax& a, int l) {
    const float* KVT = (const float*)(a.ws + WS_KVT); bf16* STB = (bf16*)(a.ws + WS_STB);
    const int gt = C.bid * (NWAVES * 64) + C.tid, NT = C.G * NWAVES * 64;
    for (int idx = gt; idx < 16 * 4096; idx += NT) { const int bh = idx >> 12, r = idx & 4095, e = r >> 5, d4 = (r & 31) * 4; const int h = bh & 3;
        const float g128 = __expf(ret_lg(h) * 128.0f); const size_t base = (size_t)bh * 16 * 16384 + e * 128 + d4;
        f32x4 kv[16];
#pragma unroll
        for (int c = 0; c < 16; ++c) kv[c] = *(const f32x4*)(KVT + base + (size_t)c * 16384);
        f32x4 S = zero4();
#pragma unroll
        for (int c = 0; c < 16; ++c) { v2u w; w.x = pk2(S.x, S.y); w.y = pk2(S.z, S.w); *(v2u*)(STB + base + (size_t)c * 16384) = w; S = S * g128 + kv[c]; }
        float* o = a.out + O_RETP + ((size_t)l * 16 + bh) * 16384 + e;
        o[(size_t)d4 * 128] = S.x; o[(size_t)(d4 + 1) * 128] = S.y; o[(size_t)(d4 + 2) * 128] = S.z; o[(size_t)(d4 + 3) * 128] = S.w; }
}
__device__ __forceinline__ void ret_pass2_item(const Ctx& C, const Ax& a, int l, int item) {
    const bf16* P = (const bf16*)(a.ws + WS_P); const float* CS = (const float*)(a.ws + WS_ROPE); bf16* YC = (bf16*)(a.ws + WS_YC);
    const int b = item >> 6, h = (item >> 4) & 3, c = item & 15; const size_t row0 = (size_t)b * SEQ + c * 128; const float lg = ret_lg(h);
    LAS bf16* QL = (LAS bf16*)C.lds; LAS bf16* KL = QL + 128 * RS; LAS bf16* VT = KL + 128 * RS; LAS bf16* ST = VT + 128 * RS;
    for (int it = C.tid; it < 128 * 8; it += NWAVES * 64) { const int tt = it & 127, c8 = it >> 7; float lo[8], hi[8]; const float* cs = CS + (size_t)(c * 128 + tt) * 128;
        rot8(P + (row0 + tt) * PIN + PB_ + h * 128, cs, c8, __expf(lg * (float)(tt + 1)), lo, hi);
        *(LAS v4u*)(QL + tt * RS + c8 * 8) = pack8(lo); *(LAS v4u*)(QL + tt * RS + 64 + c8 * 8) = pack8(hi);
        rot8(P + (row0 + tt) * PIN + PB_ + 512 + h * 128, cs, c8, 0.08838834764831845f * __expf(-lg * (float)(tt + 1)), lo, hi);
        *(LAS v4u*)(KL + tt * RS + c8 * 8) = pack8(lo); *(LAS v4u*)(KL + tt * RS + 64 + c8 * 8) = pack8(hi); }
    for (int it = C.tid; it < 128 * 16; it += NWAVES * 64) { const int tt = it & 127, c8 = it >> 7; const v4u w = *(const v4u*)(P + (row0 + tt) * PIN + PB_ + 1024 + h * 128 + c8 * 8);
        const unsigned ww[4] = {w.x, w.y, w.z, w.w};
#pragma unroll
        for (int j = 0; j < 4; ++j) { VT[(c8 * 8 + 2 * j) * RS + tt] = (bf16)(ww[j] & 0xffffu); VT[(c8 * 8 + 2 * j + 1) * RS + tt] = (bf16)(ww[j] >> 16); } }
    { const bf16* stb = (const bf16*)(a.ws + WS_STB) + (size_t)item * 16384;
      for (int it = C.tid; it < 128 * 16; it += NWAVES * 64) { const int e = it >> 4, dc = it & 15; *(LAS v4u*)(ST + e * RS + dc * 8) = *(const v4u*)(stb + e * 128 + dc * 8); } }
    __syncthreads();
    const int fr = C.lane & 15, fq = C.lane >> 4, w = C.wave, i0 = 16 * w;
    bf16x8 qf[4];
#pragma unroll
    for (int ks = 0; ks < 4; ++ks) qf[ks] = *(const LAS bf16x8*)(QL + (i0 + fr) * RS + ks * 32 + fq * 8);
    f32x4 sc[8];
#pragma unroll
    for (int jt = 0; jt < 8; ++jt) { sc[jt] = zero4();
        if (jt <= w) {
#pragma unroll
            for (int ks = 0; ks < 4; ++ks) { const bf16x8 kf = *(const LAS bf16x8*)(KL + (16 * jt + fr) * RS + ks * 32 + fq * 8); sc[jt] = __builtin_amdgcn_mfma_f32_16x16x32_bf16(kf, qf[ks], sc[jt], 0, 0, 0); }
            if (jt == w) {
#pragma unroll
                for (int r = 0; r < 4; ++r) if (4 * fq + r > fr) sc[jt][r] = 0.f; } } }
    __syncthreads();
    LAS bf16* PL = KL;
#pragma unroll
    for (int jt = 0; jt < 8; ++jt) { v2u pw; pw.x = pk2(sc[jt][0], sc[jt][1]); pw.y = pk2(sc[jt][2], sc[jt][3]); *(LAS v2u*)(PL + (i0 + fr) * RS + 16 * jt + 4 * fq) = pw; }
    LDS_WAIT(); asm volatile("" ::: "memory");
    f32x4 acc[8];
#pragma unroll
    for (int et = 0; et < 8; ++et) acc[et] = zero4();
#pragma unroll
    for (int ks = 0; ks < 4; ++ks) { if (2 * ks <= w) { const bf16x8 pf = *(const LAS bf16x8*)(PL + (i0 + fr) * RS + ks * 32 + fq * 8);
#pragma unroll
            for (int et = 0; et < 8; ++et) { const bf16x8 vf = *(const LAS bf16x8*)(VT + (16 * et + fr) * RS + ks * 32 + fq * 8); acc[et] = __builtin_amdgcn_mfma_f32_16x16x32_bf16(vf, pf, acc[et], 0, 0, 0); } } }
    if (c > 0) {
#pragma unroll
        for (int ks = 0; ks < 4; ++ks)
#pragma unroll
            for (int et = 0; et < 8; ++et) { const bf16x8 sf = *(const LAS bf16x8*)(ST + (16 * et + fr) * RS + ks * 32 + fq * 8); acc[et] = __builtin_amdgcn_mfma_f32_16x16x32_bf16(sf, qf[ks], acc[et], 0, 0, 0); } }
    float s = 0.f;
#pragma unroll
    for (int et = 0; et < 8; ++et) s += (acc[et][0] + acc[et][1]) + (acc[et][2] + acc[et][3]);
    s += __shfl_xor(s, 16); s += __shfl_xor(s, 32); const float mu = s * (1.0f / 128.0f);
    float q = 0.f;
#pragma unroll
    for (int et = 0; et < 8; ++et) { acc[et] = acc[et] - mu; q += (acc[et][0] * acc[et][0] + acc[et][1] * acc[et][1]) + (acc[et][2] * acc[et][2] + acc[et][3] * acc[et][3]); }
    q += __shfl_xor(q, 16); q += __shfl_xor(q, 32); const float rstd = 1.0f / sqrtf(q * (1.0f / 128.0f) + 1e-6f);
    const size_t row = row0 + i0 + fr;
#pragma unroll
    for (int et = 0; et < 8; ++et) { const int e = 16 * et + 4 * fq; float gg[4]; unpack4(*(const v2u*)(P + row * PIN + PB_ + 1536 + h * 128 + e), gg);
        v2u wv; wv.x = pk2(gg[0] * sigm(gg[0]) * acc[et][0] * rstd, gg[1] * sigm(gg[1]) * acc[et][1] * rstd); wv.y = pk2(gg[2] * sigm(gg[2]) * acc[et][2] * rstd, gg[3] * sigm(gg[3]) * acc[et][3] * rstd);
        *(v2u*)(YC + row * DM + 512 + h * 128 + e) = wv; }
    __syncthreads();
}
__device__ __forceinline__ void ret_sample_witem(const Ctx& C, const Ax& a, int l, int witem) {
    const bf16* P = (const bf16*)(a.ws + WS_P); const float* CS = (const float*)(a.ws + WS_ROPE) + (size_t)2048 * 128; bf16* YC = (bf16*)(a.ws + WS_YC);
    const int n = witem >> 2, h = witem & 3, lane = C.lane; const float gam = 1.0f - exp2f(-5.0f - (float)h);
    LAS float* qk = (LAS float*)(C.lds + C.wave * 1024);
    const bf16* pr = P + (size_t)(MP + n) * PIN + PB_ + h * 128;
    { const float co = CS[2 * lane], si = CS[2 * lane + 1]; const float q1 = bf1(pr[lane]), q2 = bf1(pr[64 + lane]), k1 = bf1(pr[512 + lane]), k2 = bf1(pr[512 + 64 + lane]);
      qk[lane] = q1 * co - q2 * si; qk[64 + lane] = q2 * co + q1 * si; qk[128 + lane] = (k1 * co - k2 * si) * 0.08838834764831845f; qk[192 + lane] = (k2 * co + k1 * si) * 0.08838834764831845f; }
    LDS_WAIT(); asm volatile("" ::: "memory");
    const float dotp = wave_sum(qk[lane] * qk[128 + lane] + qk[64 + lane] * qk[192 + lane]);
    const int half = lane >> 5, el = lane & 31;
    float vv[4]; unpack4(*(const v2u*)(pr + 1024 + 4 * el), vv); const f32x4 v4 = (f32x4){vv[0], vv[1], vv[2], vv[3]};
    const float* sin_ = a.in(I_SRET) + (((size_t)l * NS + n) * 4 + h) * 16384; float* sout = a.out + O_RETS + (((size_t)l * NS + n) * 4 + h) * 16384;
    f32x4 oa = zero4();
#pragma unroll 8
    for (int it = 0; it < 64; ++it) { const int d = 2 * it + half; const f32x4 S = __builtin_nontemporal_load((const f32x4*)(sin_ + (size_t)d * 128 + 4 * el)); const float qd = qk[d], kd = qk[128 + d];
        oa += qd * S; __builtin_nontemporal_store(gam * S + kd * v4, (f32x4*)(sout + (size_t)d * 128 + 4 * el)); }
    oa.x += __shfl_xor(oa.x, 32); oa.y += __shfl_xor(oa.y, 32); oa.z += __shfl_xor(oa.z, 32); oa.w += __shfl_xor(oa.w, 32);
    f32x4 o = gam * oa + dotp * v4;
    float s = (o.x + o.y) + (o.z + o.w);
#pragma unroll
    for (int m = 1; m < 32; m <<= 1) s += __shfl_xor(s, m);
    const float mu = s * (1.0f / 128.0f); o = o - mu; float q = (o.x * o.x + o.y * o.y) + (o.z * o.z + o.w * o.w);
#pragma unroll
    for (int m = 1; m < 32; m <<= 1) q += __shfl_xor(q, m);
    const float rstd = 1.0f / sqrtf(q * (1.0f / 128.0f) + 1e-6f);
    if (half == 0) { float gg[4]; unpack4(*(const v2u*)(pr + 1536 + 4 * el), gg);
        v2u wv; wv.x = pk2(gg[0] * sigm(gg[0]) * o.x * rstd, gg[1] * sigm(gg[1]) * o.y * rstd); wv.y = pk2(gg[2] * sigm(gg[2]) * o.z * rstd, gg[3] * sigm(gg[3]) * o.w * rstd);
        *(v2u*)(YC + (size_t)(MP + n) * DM + 512 + h * 128 + 4 * el) = wv; }
    LDS_WAIT(); asm volatile("" ::: "memory");
}

constexpr int XV_RS = 264;
__device__ __forceinline__ void xattn_prompt_unit(const Ctx& C, const Ax& a, int l, int unit) {
    const bf16* Q = (const bf16*)(a.ws + WS_Q); const bf16* MK = (const bf16*)(a.ws + WS_MK) + (size_t)l * MMEM * DM; const bf16* MVT = (const bf16*)(a.ws + WS_MVT) + (size_t)l * MMEM * DM; bf16* O = (bf16*)(a.ws + WS_O);
    const int b = unit >> 6, h = (unit >> 4) & 3, qt = unit & 15, fr = C.lane & 15, fq = C.lane >> 4;
    const size_t row = (size_t)b * SEQ + qt * 128 + C.wave * 16 + fr;
    LAS bf16* SB = (LAS bf16*)C.lds;
    v4u st[8];
    const bf16* kbase = MK + ((size_t)b * 256) * DM + h * 512; const bf16* vbase = MVT + (((size_t)b * 4 + h) * 512) * 256;
    unsigned kof[4], vof[8], sof[8];
#pragma unroll
    for (int i = 0; i < 8; ++i) { const int idx = C.tid + 512 * i, r = idx >> 5, c16 = idx & 31; vof[i] = (unsigned)(r * 256 + c16 * 8) * 2u; sof[i] = (unsigned)(r * XV_RS + c16 * 8) * 2u; if (i < 4) kof[i] = (unsigned)(r * DM + c16 * 8) * 2u; }
    const char* kb8 = (const char*)kbase; const char* vb8 = (const char*)vbase; LAS char* sb8 = (LAS char*)SB;
#define XK_LOAD(q) do { const char* pb_ = kb8 + ((size_t)(((q) & 3) * 64) * DM + ((q) >> 2) * 256) * 2; _Pragma("unroll") for (int i = 0; i < 4; ++i) st[i] = *(const v4u*)(pb_ + kof[i]); } while (0)
#define XK_STORE() do { _Pragma("unroll") for (int i = 0; i < 4; ++i) *(LAS v4u*)(sb8 + sof[i]) = st[i]; } while (0)
#define XV_LOAD(p) do { const char* pb_ = vb8 + (size_t)((p) * 128) * 256 * 2; _Pragma("unroll") for (int i = 0; i < 8; ++i) st[i] = *(const v4u*)(pb_ + vof[i]); } while (0)
#define XV_STORE() do { _Pragma("unroll") for (int i = 0; i < 8; ++i) *(LAS v4u*)(sb8 + sof[i]) = st[i]; } while (0)
    XK_LOAD(0);
    f32x4 sc[16];
#pragma unroll
    for (int jt = 0; jt < 16; ++jt) sc[jt] = zero4();
#pragma unroll
    for (int dh = 0; dh < 2; ++dh) {
        bf16x8 qf[8];
#pragma unroll
        for (int ks = 0; ks < 8; ++ks) qf[ks] = *(const bf16x8*)(Q + row * DM + h * 512 + dh * 256 + ks * 32 + fq * 8);
#pragma unroll
        for (int p = 0; p < 4; ++p) {
            __syncthreads(); XK_STORE(); __syncthreads();
            if (dh * 4 + p < 7) XK_LOAD(dh * 4 + p + 1); else XV_LOAD(0);
#pragma unroll
            for (int j4 = 0; j4 < 4; ++j4) {
#pragma unroll
                for (int ks = 0; ks < 8; ++ks) { const bf16x8 kf = *(const LAS bf16x8*)(SB + (j4 * 16 + fr) * XV_RS + ks * 32 + fq * 8); sc[p * 4 + j4] = __builtin_amdgcn_mfma_f32_16x16x32_bf16(kf, qf[ks], sc[p * 4 + j4], 0, 0, 0); }
                __builtin_amdgcn_sched_barrier(0); }
        }
    }
    float mx = -3.0e38f;
#pragma unroll
    for (int jt = 0; jt < 16; ++jt) mx = fmaxf(mx, fmaxf(fmaxf(sc[jt][0], sc[jt][1]), fmaxf(sc[jt][2], sc[jt][3])));
    mx = fmaxf(mx, __shfl_xor(mx, 16)); mx = fmaxf(mx, __shfl_xor(mx, 32));
    const float scale = 0.04419417382415922f; float sum = 0.f;
    bf16x8 pf[8];
#pragma unroll
    for (int s = 0; s < 8; ++s) { float p[8];
#pragma unroll
        for (int j = 0; j < 4; ++j) { p[j] = __expf((sc[2 * s][j] - mx) * scale); p[4 + j] = __expf((sc[2 * s + 1][j] - mx) * scale); }
        sum += ((p[0] + p[1]) + (p[2] + p[3])) + ((p[4] + p[5]) + (p[6] + p[7]));
        const v4u w = pack8(p); pf[s] = __builtin_bit_cast(bf16x8, w); }
    sum += __shfl_xor(sum, 16); sum += __shfl_xor(sum, 32); const float inv = 1.0f / sum;
#pragma unroll
    for (int p = 0; p < 4; ++p) {
        __syncthreads(); XV_STORE(); __syncthreads();
        if (p < 3) XV_LOAD(p + 1);
#pragma unroll
        for (int et = 0; et < 8; ++et) { f32x4 s4 = zero4(); const LAS bf16* vp = SB + (et * 16 + fr) * XV_RS + 4 * fq;
#pragma unroll
            for (int s = 0; s < 8; ++s) { const v2u lo = *(const LAS v2u*)(vp + 32 * s), hi = *(const LAS v2u*)(vp + 32 * s + 16); const v4u w = (v4u){lo.x, lo.y, hi.x, hi.y};
                s4 = __builtin_amdgcn_mfma_f32_16x16x32_bf16(__builtin_bit_cast(bf16x8, w), pf[s], s4, 0, 0, 0); }
            v2u w; w.x = pk2(s4[0] * inv, s4[1] * inv); w.y = pk2(s4[2] * inv, s4[3] * inv);
            *(v2u*)(O + row * DM + h * 512 + p * 128 + et * 16 + 4 * fq) = w;
            __builtin_amdgcn_sched_barrier(0); }
    }
    __syncthreads();
#undef XK_LOAD
#undef XK_STORE
#undef XV_LOAD
#undef XV_STORE
}
__device__ __forceinline__ void xattn_sample_item(const Ctx& C, const Ax& a, int l, int item) {
    bf16* O = (bf16*)(a.ws + WS_OS);
    const int n = item >> 2, h = item & 3, lane = C.lane, w = C.wave;
    LAS float* red = (LAS float*)C.lds; LAS float* part = red + 64;
    float q[8]; { const float* s0 = (const float*)(a.ws + WS_SPL) + (size_t)n * DM + h * 512 + 4 * lane; const float* s1 = s0 + (size_t)NS * DM;
                  const f32x4 a0 = *(const f32x4*)s0 + *(const f32x4*)s1, a1 = *(const f32x4*)(s0 + 256) + *(const f32x4*)(s1 + 256);
                  q[0] = a0.x; q[1] = a0.y; q[2] = a0.z; q[3] = a0.w; q[4] = a1.x; q[5] = a1.y; q[6] = a1.z; q[7] = a1.w; }
    const size_t base = ((((size_t)l * NS + n) * 256 + 32 * w) * 4 + h) * 512 + 4 * lane;
    const float* kp = a.in(I_CMK) + base; const float* vp = a.in(I_CMV) + base;
#define XS_LOAD(buf0, buf1, ptr, k8) do { _Pragma("unroll") for (int j = 0; j < 8; ++j) { buf0[j] = __builtin_nontemporal_load((const f32x4*)((ptr) + (size_t)((k8) * 8 + j) * 2048)); buf1[j] = __builtin_nontemporal_load((const f32x4*)((ptr) + (size_t)((k8) * 8 + j) * 2048 + 256)); } } while (0)
#define XS_DOT(buf0, buf1, k8) do { _Pragma("unroll") for (int j = 0; j < 8; ++j) { float d = (buf0[j].x * q[0] + buf0[j].y * q[1]) + (buf0[j].z * q[2] + buf0[j].w * q[3]) + (buf1[j].x * q[4] + buf1[j].y * q[5]) + (buf1[j].z * q[6] + buf1[j].w * q[7]); \
        d = rowsum16(d); d += __shfl_xor(d, 16); d += __shfl_xor(d, 32); if (lane == (k8) * 8 + j) myscore = d; } } while (0)
#define XS_ACC(buf0, buf1, k8) do { _Pragma("unroll") for (int j = 0; j < 8; ++j) { const float pj = __builtin_bit_cast(float, __builtin_amdgcn_readlane(__builtin_bit_cast(int, p), (k8) * 8 + j)); o0 += pj * buf0[j]; o1 += pj * buf1[j]; } } while (0)
    float myscore = 0.f;
    f32x4 xa0[8], xa1[8], xb0[8], xb1[8];
    XS_LOAD(xa0, xa1, kp, 0);
    XS_LOAD(xb0, xb1, kp, 1); XS_DOT(xa0, xa1, 0);
    XS_LOAD(xa0, xa1, kp, 2); XS_DOT(xb0, xb1, 1);
    XS_LOAD(xb0, xb1, kp, 3); XS_DOT(xa0, xa1, 2);
    XS_LOAD(xa0, xa1, vp, 0); XS_DOT(xb0, xb1, 3);
    const float scale = 0.04419417382415922f;
    float mx = wave_max(lane < 32 ? myscore : -3.0e38f); if (lane == 0) red[w] = mx; __syncthreads();
    mx = red[0];
#pragma unroll
    for (int i = 1; i < 8; ++i) mx = fmaxf(mx, red[i]);
    const float p = lane < 32 ? __expf((myscore - mx) * scale) : 0.f;
    const float ps = wave_sum(p); if (lane == 0) red[8 + w] = ps;
    f32x4 o0 = zero4(), o1 = zero4();
    XS_LOAD(xb0, xb1, vp, 1); XS_ACC(xa0, xa1, 0);
    XS_LOAD(xa0, xa1, vp, 2); XS_ACC(xb0, xb1, 1);
    XS_LOAD(xb0, xb1, vp, 3); XS_ACC(xa0, xa1, 2);
    XS_ACC(xb0, xb1, 3);
#undef XS_LOAD
#undef XS_DOT
#undef XS_ACC
    *(LAS f32x4*)(part + w * 512 + 4 * lane) = o0; *(LAS f32x4*)(part + w * 512 + 256 + 4 * lane) = o1;
    __syncthreads();
    float tot = 0.f;
#pragma unroll
    for (int i = 0; i < 8; ++i) tot += red[8 + i];
    { const int d = C.tid; float s = 0.f;
#pragma unroll
      for (int i = 0; i < 8; ++i) s += part[i * 512 + d];
      O[(size_t)n * DMS + h * 512 + d] = (bf16)(pk2(s / tot, 0.f) & 0xffffu); }
    __syncthreads();
}

#ifndef PHASE_MASK
#define PHASE_MASK 0xffffffffu
#endif
#define PM(k) ((PHASE_MASK >> (k)) & 1u)
#ifndef DUP_SUB
#define DUP_SUB 0u
#endif
#define REP(k) for (int rep_ = 0; rep_ < 1 + (int)((DUP_SUB >> (k)) & 1u); ++rep_)
#ifndef DUP_MASK
#define DUP_MASK 0
#endif
#ifndef MK_ONE_LAUNCH
#define MK_ONE_LAUNCH 1
#endif
constexpr int PH_PER_LAYER = 14, NPH = 1 + DEPTH * PH_PER_LAYER;
__global__ void __launch_bounds__(NWAVES * 64, 2) fwd_kernel(Args args) {
    extern __shared__ __attribute__((aligned(16))) unsigned char lds_raw[];
    LAS unsigned char* const lds = (LAS unsigned char*)lds_raw;
    const int wave_s = __builtin_amdgcn_readfirstlane((int)threadIdx.x >> 6);
    volatile LAS unsigned* MISC = (volatile LAS unsigned*)(lds + MISC_OFF);
    for (int u = threadIdx.x; u < (LDS_BYTES - MISC_OFF) / 4; u += NWAVES * 64) ((LAS unsigned*)(lds + MISC_OFF))[u] = 0u;
    __syncthreads();
    XcdBarrier bar; bar.bar = (unsigned*)(args.ws + WS_CTL) + CW_BAR; bar.x = 0; bar.st = nullptr;
    if (MK_ONE_LAUNCH) bar = xcd_barrier_post((unsigned*)(args.ws + WS_CTL) + CW_BAR, MISC + 8);
    bar.wave = wave_s;
    const int lo = args.ph_lo, hi = args.ph_hi;
#define IN(k) (lo <= (k) && (k) < hi)
#define SEAM(k) do { if (MK_ONE_LAUNCH && IN((k) + 1)) xcd_barrier(bar); } while (0)
#define SEAM2(k) do { if (MK_ONE_LAUNCH && IN((k) + 2)) xcd_barrier(bar); } while (0)
#define PHASE_CTX const Ctx C = mk_ctx(lds, wave_s); const Ax a = mk_ax(); unsigned char* const ws = a.ws; const int G = C.G, bid = C.bid; (void)ws; (void)G; (void)bid; \
    float* const XF = (float*)(ws + WS_XF); bf16* const HN = (bf16*)(ws + WS_HN); bf16* const PBUF = (bf16*)(ws + WS_P); bf16* const YC = (bf16*)(ws + WS_YC); bf16* const QB = (bf16*)(ws + WS_Q); \
    bf16* const OB = (bf16*)(ws + WS_O); bf16* const UB = (bf16*)(ws + WS_U); (void)XF; (void)HN; (void)PBUF; (void)YC; (void)QB; (void)OB; (void)UB

    if (IN(0)) { PHASE_CTX; if (PM(0)) p0_prologue(C, a); SEAM(0); }

    for (int l = 0; l < DEPTH; ++l) {
        const int pb = 1 + l * PH_PER_LAYER;
        if (IN(pb + 0)) { PHASE_CTX; const unsigned char* wl = ws + WS_WL + (size_t)l * LW_STRIDE;
            if (PM(1)) { pg8::Gemm g{HN, (const bf16*)(wl + LW_IN), MPAD, PIN, DM, DM, 64, (size_t)PIN * 128}; pg8::StaticOrder S; S.init(MPAD, PIN, G, bid); pg8::EpiBf16A<0> E{PBUF, PIN, nullptr};
              pg8::gemm_phase<pg8::EpiBf16A<0>, pg8::StaticOrder, true, true>(lds, g, S, E, C.tid); }
            if (G == 256) { const int nfull = (MPAD / 256) * (PIN / 256) - 3 * G;
                if ((bid >= nfull && bid < 64) || bid >= 128) { __syncthreads(); late_convert(C, a, l, bid < 64 ? bid - nfull : bid - 128 + (64 - nfull), (64 - nfull) + (G - 128)); } }
            if (PM(2)) { pg8::Gemm g{(const bf16*)(ws + WS_MN), (const bf16*)(ws + WS_WKV) + (size_t)l * 4096 * 64, MMEM, 4096, DM, DM, 64, (size_t)8192 * 128}; pg8::StaticOrder S; S.init(MMEM, 4096, G, (bid + G - (64 % G)) % G);
              pg8::EpiMemKV E{a.out + O_MKP + (size_t)l * MMEM * DM, (bf16*)(ws + WS_MK) + (size_t)l * MMEM * DM, (bf16*)(ws + WS_MVT) + (size_t)l * MMEM * DM};
              pg8::gemm_phase<pg8::EpiMemKV, pg8::StaticOrder, true, true>(lds, g, S, E, C.tid); }
            SEAM(pb + 0);
        }
        if (IN(pb + 1)) { PHASE_CTX;
#ifdef DEBUG_P
            { const int gt = bid * 512 + C.tid, NT = G * 512;
              for (int idx = gt + (DEBUG_P == 2 ? MP * 2048 : 0); idx < (DEBUG_P == 1 ? MP : MT) * 2048; idx += NT) { const int row = idx >> 11, c = idx & 2047; const bf16* pr = PBUF + (size_t)row * PIN;
                  float s = bf1(pr[c]) + bf1(pr[c + 2048]) + bf1(pr[c + 4096]); if (c < 256) s += bf1(pr[c + 6144]); a.out[O_YP + idx] = s; } }
#endif
            if ((bid >> 3) & 1) { if (PM(8)) REP(8) for (int it = bid * NWAVES + C.wave; it < NS * 4; it += G * NWAVES) ret_sample_witem(C, a, l, it); __syncthreads(); }
            if (PM(4)) REP(4) for (int it = bid; it < 256; it += G) ad_prompt_item(C, a, l, it);
            if (PM(5)) REP(5) for (int it = bid; it < 256; it += G) ret_pass1_item(C, a, it);
            if (PM(6)) REP(6) for (int it = bid; it < 256; it += G) rwkv_prep_item(C, a, l, it);
            if (PM(6)) for (int it = bid - 64; it >= 0 && it < 4; it += G) rwkv_prep_item(C, a, l, 256 + it);
            if (PM(7)) REP(7) for (int it = G - 1 - bid; it < NS; it += G) ad_sample_item(C, a, l, it);
            if (!((bid >> 3) & 1)) { if (PM(8)) REP(8) for (int it = bid * NWAVES + C.wave; it < NS * 4; it += G * NWAVES) ret_sample_witem(C, a, l, it); }
            __syncthreads();
            SEAM(pb + 1);
        }
        if (IN(pb + 2)) { PHASE_CTX;
            if ((bid >> 3) & 1) { if (PM(10)) REP(10) for (int it = bid * NWAVES + C.wave; it < NS * 16; it += G * NWAVES) rwkv_sample_witem(C, a, l, it); }
            if (PM(9)) REP(9) for (int it = bid * NWAVES + C.wave; it < 4096; it += G * NWAVES) wkv_chunk_witem(C, a, it);
            if (!((bid >> 3) & 1)) { if (PM(10)) REP(10) for (int it = bid * NWAVES + C.wave; it < NS * 16; it += G * NWAVES) rwkv_sample_witem(C, a, l, it); }
            if (PM(11)) ret_prefix_phase(C, a, l);
            SEAM(pb + 2);
        }
        if (IN(pb + 3)) { PHASE_CTX; const int hg = G / 2;
            if (PM(22)) REP(22) for (int it = bid; it < 128; it += (bid < hg ? hg : 1 << 20)) wkv_seq_item(C, a, l, it);
            if (PM(11)) REP(11) if (bid >= hg || G < 2) for (int it = bid - hg; it < 256; it += G - hg) ret_pass2_item(C, a, l, it);
            SEAM(pb + 3);
        }
        if (IN(pb + 4)) { PHASE_CTX;
            if (PM(12)) REP(12) rwkv_post_phase(C, a, l);
            SEAM(pb + 4);
        }
        if (IN(pb + 5)) { PHASE_CTX; const unsigned char* wl = ws + WS_WL + (size_t)l * LW_STRIDE;
            pg8::Gemm g{YC, (const bf16*)(wl + LW_OUT), MP, DM, DM, DM, 64, (size_t)DM * 128}; pg8::StaticOrder S; S.init(MP, DM, G, bid); pg8::EpiRes E{XF, DM, ((DUP_MASK >> 5) & 1) ? 0.5f : 1.0f, (l == 0 && !((DUP_MASK >> 5) & 1)) ? a.in(I_XP) : (const float*)XF};
            if (PM(15)) pg8::gemm_phase<pg8::EpiRes, pg8::StaticOrder, true, true>(lds, g, S, E, C.tid);
            if (PM(20)) sample_gemm(lds, C.tid, YC + (size_t)MP * DM, DM, (const bf16*)(wl + LW_OUT), DM, DM, DM, G, bid, SEpiRes{XF + (size_t)MP * DM, DM, ((DUP_MASK >> 5) & 1) ? 0.5f : 1.0f, (l == 0 && !((DUP_MASK >> 5) & 1)) ? a.in(I_XS) : (const float*)(XF + (size_t)MP * DM)});
            SEAM(pb + 5);
        }
        if (IN(pb + 6)) { PHASE_CTX; if (PM(21)) REP(21) rms_phase(C, XF, HN, (bf16*)(ws + WS_HNS)); SEAM(pb + 6);
#ifdef XBAR_PROBE
            if (MK_ONE_LAUNCH) for (int i_ = 0; i_ < XBAR_PROBE; ++i_) xcd_barrier(bar);
#endif
        }
        if (IN(pb + 7)) { PHASE_CTX; const unsigned char* wl = ws + WS_WL + (size_t)l * LW_STRIDE;
            pg8::Gemm g{HN, (const bf16*)(wl + LW_Q), MP, DM, DM, DM, 64, (size_t)DM * 128}; pg8::StaticOrder S; S.init(MP, DM, G, bid); pg8::EpiBf16A<0> E{QB, DM, nullptr};
            if (PM(16)) REP(16) pg8::gemm_phase<pg8::EpiBf16A<0>, pg8::StaticOrder, true, true>(lds, g, S, E, C.tid);
            if (PM(20)) { sample_gemm(lds, C.tid, (const bf16*)(ws + WS_HNS), DMS, (const bf16*)(wl + LW_Q), DM, DM, DM, G, bid, SEpiPart{(float*)(ws + WS_SPL), DM}, 2); if ((DUP_SUB >> 24) & 1u) { const Ctx C2 = mk_ctx(lds, wave_s); sample_gemm(lds, C2.tid, (const bf16*)(ws + WS_HNS), DMS, (const bf16*)(wl + LW_Q), DM, DM, DM, G, bid, SEpiPart{(float*)(ws + WS_SPL), DM}, 2); } }
            SEAM(pb + 7);
        }
        if (IN(pb + 8)) { PHASE_CTX;
            { const int g3 = (bid >> 3) % 3;
              if (g3 == 0) { if (PM(13)) REP(13) for (int it = bid; it < 256; it += G) xattn_prompt_unit(C, a, l, it); }
              if (PM(14)) REP(14) for (int it = bid; it < NS * 4; it += 2 * G) xattn_sample_item(C, a, l, it);
              if (g3 == 1) { if (PM(13)) REP(13) for (int it = bid; it < 256; it += G) xattn_prompt_unit(C, a, l, it); }
              if (PM(14)) REP(14) for (int it = bid + G; it < NS * 4; it += 2 * G) xattn_sample_item(C, a, l, it);
              if (g3 == 2) { if (PM(13)) REP(13) for (int it = bid; it < 256; it += G) xattn_prompt_unit(C, a, l, it); } }
            SEAM(pb + 8);
        }
        if (IN(pb + 9)) { PHASE_CTX; const unsigned char* wl = ws + WS_WL + (size_t)l * LW_STRIDE;
            pg8::Gemm g{OB, (const bf16*)(wl + LW_O), MP, DM, DM, DM, 64, (size_t)DM * 128}; pg8::StaticOrder S; S.init(MP, DM, G, bid); pg8::EpiRes E{XF, DM, ((DUP_MASK >> 9) & 1) ? 0.5f : 1.0f, XF};
            if (PM(17)) pg8::gemm_phase<pg8::EpiRes, pg8::StaticOrder, true, true>(lds, g, S, E, C.tid);
            if (PM(20)) sample_gemm(lds, C.tid, (const bf16*)(ws + WS_OS), DMS, (const bf16*)(wl + LW_O), DM, DM, DM, G, bid, SEpiRes{XF + (size_t)MP * DM, DM, ((DUP_MASK >> 9) & 1) ? 0.5f : 1.0f, XF + (size_t)MP * DM});
            SEAM(pb + 9);
        }
        if (IN(pb + 10)) { PHASE_CTX; if (PM(21)) REP(21) rms_phase(C, XF, HN, (bf16*)(ws + WS_HNS)); SEAM(pb + 10); }
        if (IN(pb + 11)) { PHASE_CTX; const unsigned char* wl = ws + WS_WL + (size_t)l * LW_STRIDE;
            pg8::Gemm g{HN, (const bf16*)(wl + LW_UP), MP, DFF, DM, DM, 64, (size_t)DFF * 128}; pg8::StaticOrder S; S.init(MP, DFF, G, bid); pg8::EpiBf16A<3> E{UB, LDU, nullptr};
            if (PM(18)) REP(18) pg8::gemm_phase<pg8::EpiBf16A<3>, pg8::StaticOrder, true, true>(lds, g, S, E, C.tid);
            if (PM(20)) { sample_gemm(lds, C.tid, (const bf16*)(ws + WS_HNS), DMS, (const bf16*)(wl + LW_UP), DFF, DFF, DM, G, bid, SEpiBf16{(bf16*)(ws + WS_US), LDUS, 3, nullptr}); if ((DUP_SUB >> 23) & 1u) { const Ctx C2 = mk_ctx(lds, wave_s); sample_gemm(lds, C2.tid, (const bf16*)(ws + WS_HNS), DMS, (const bf16*)(wl + LW_UP), DFF, DFF, DM, G, bid, SEpiBf16{(bf16*)(ws + WS_US), LDUS, 3, nullptr}); } }
            SEAM(pb + 11);
        }
        if (IN(pb + 12)) { PHASE_CTX; const unsigned char* wl = ws + WS_WL + (size_t)l * LW_STRIDE;
            pg8::Gemm g{UB, (const bf16*)(wl + LW_DN), MP, DM, DFF, LDU, 64, (size_t)DM * 128}; pg8::StaticOrder S; S.init(MP, DM, G, bid); pg8::EpiRes E{XF, DM, ((DUP_MASK >> 12) & 1) ? 0.5f : 1.0f, XF};
            if (PM(19)) pg8::gemm_phase<pg8::EpiRes, pg8::StaticOrder, true, true>(lds, g, S, E, C.tid);
            if (PM(20)) { sample_gemm(lds, C.tid, (const bf16*)(ws + WS_US), LDUS, (const bf16*)(wl + LW_DN), DM, DM, DFF, G, bid, SEpiPart{(float*)(ws + WS_SPL), DM}, 2); if ((DUP_SUB >> 25) & 1u) { const Ctx C2 = mk_ctx(lds, wave_s); sample_gemm(lds, C2.tid, (const bf16*)(ws + WS_US), LDUS, (const bf16*)(wl + LW_DN), DM, DM, DFF, G, bid, SEpiPart{(float*)(ws + WS_SPL), DM}, 2); } }
            SEAM(pb + 12);
        }
        if (IN(pb + 13)) { PHASE_CTX;
            fold_split_rows(C, XF, (const float*)(ws + WS_SPL));
            if (!PM(21)) {} else if (l + 1 < DEPTH) REP(21) rms_phase(C, XF, HN, nullptr); else final_norm_phase(C, XF, a.in(I_GFIN), a.out + O_YP);
            SEAM(pb + 13);
        }
    }
#undef IN
#undef SEAM
#undef SEAM2
#undef PHASE_CTX
}

extern "C" void kernel_launch(void* const* d_in, const int* in_sizes, int n_in, void* d_out, int out_size, void* d_ws, size_t ws_size, hipStream_t stream) {
    static int grid = 0;
    if (grid == 0) {
        if (n_in != NIN || (size_t)out_size != O_END || ws_size < WS_END) { fprintf(stderr, "kernel_launch: unexpected shapes (n_in %d, out %d, ws %zu); nothing launched\n", n_in, out_size, ws_size); grid = -1; return; }
        int dev = 0, cus = 0, per_cu = 0;
        if (hipGetDevice(&dev) != hipSuccess || hipDeviceGetAttribute(&cus, hipDeviceAttributeMultiprocessorCount, dev) != hipSuccess) { grid = -1; return; }
        if (hipFuncSetAttribute((const void*)fwd_kernel, hipFuncAttributeMaxDynamicSharedMemorySize, LDS_BYTES) != hipSuccess) { fprintf(stderr, "kernel_launch: hipFuncSetAttribute failed\n"); grid = -1; return; }
        if (hipOccupancyMaxActiveBlocksPerMultiprocessor(&per_cu, (const void*)fwd_kernel, NWAVES * 64, LDS_BYTES) != hipSuccess || per_cu < 1) { fprintf(stderr, "kernel_launch: occupancy query reports %d\n", per_cu); }
        (void)hipGetLastError();
        grid = cus;
    }
    if (grid < 0) return;
    if (hipMemsetAsync((char*)d_ws + WS_CTL, 0, CTL_ZERO_BYTES, stream) != hipSuccess) return;
    Args a{};
    for (int i = 0; i < NIN; ++i) a.in[i] = (const float*)d_in[i];
    a.out = (float*)d_out; a.ws = (unsigned char*)d_ws;
#if MK_ONE_LAUNCH
    a.ph_lo = 0; a.ph_hi = NPH;
    hipLaunchKernelGGL(fwd_kernel, dim3(grid), dim3(NWAVES * 64), LDS_BYTES, stream, a);
#else
#ifndef NPH_RUN
#define NPH_RUN NPH
#endif
    for (int ph = 0; ph < NPH_RUN; ++ph) { a.ph_lo = ph; a.ph_hi = ph + 1; hipLaunchKernelGGL(fwd_kernel, dim3(grid), dim3(NWAVES * 64), LDS_BYTES, stream, a);
        const int dbit = (ph == 0) ? 13 : (ph - 1) % PH_PER_LAYER;
        if ((DUP_MASK >> dbit) & 1) hipLaunchKernelGGL(fwd_kernel, dim3(grid), dim3(NWAVES * 64), LDS_BYTES, stream, a); }
#endif
}
```

```cpp
#include <hip/hip_runtime.h>
#include <cstdio>
#include <cstdint>
namespace pg8 {
#define PG8_LAS __attribute__((address_space(3)))
typedef unsigned short bf16_t;
typedef short bf16x8 __attribute__((ext_vector_type(8)));
typedef float f32x4 __attribute__((ext_vector_type(4)));
typedef unsigned u32x4 __attribute__((ext_vector_type(4)));
constexpr int BM = 256, BK = 64, HALF = 128, HTB = HALF * BK * 2  , STAGE_BYTES = 8 * HTB, NXCD = 8, WGM = 8;

__host__ __device__ __forceinline__ int lds_byte(int r, int c) { const int st = (r >> 4) * 2 + (c >> 5), rr = r & 15, cc = c & 31, ob = rr * 64 + cc * 2; return st * 1024 + (ob ^ (((ob >> 9) & 1) << 5)); }
__host__ __device__ __forceinline__ void stage_rc(int b, int& R, int& C) { const int st = b / 1024, sb = b % 1024, swz = sb ^ (((sb >> 9) & 1) << 5); R = (st >> 1) * 16 + swz / 64; C = (st & 1) * 32 + (swz % 64) / 2; }
__host__ __device__ __forceinline__ int perm32(int rho) { const int n = rho >> 4, i = rho & 15; return 8 * (i >> 2) + 4 * n + (i & 3); }

struct Unit { int pm, pn; };
struct Gemm { const bf16_t* A; const bf16_t* Bt; int M, N, K, lda, ldb; size_t ksb; };

struct StaticOrder {
    int nM, nN, nwg, G, c;
    __host__ __device__ void init(int M, int N, int G_, int c_) { nM = M / BM; nN = N / BM; nwg = nM * nN; G = G_; c = c_; }
    __host__ __device__ bool next(int i, Unit& u) const {
        const long L = (long)i * G + c; if (L >= nwg) return false;
        int wgid = (int)L; { const int q = nwg / NXCD, r = nwg % NXCD, xcd = wgid % NXCD, off = wgid / NXCD; wgid = (xcd < r ? xcd * (q + 1) : r * (q + 1) + (xcd - r) * q) + off; }
        const int nig = WGM * nN, gid = wgid / nig, fm = gid * WGM, gsz = (nM - fm) < WGM ? (nM - fm) : WGM;
        u.pm = fm + ((wgid % nig) % gsz); u.pn = (wgid % nig) / gsz; return true;
    }
    __device__ __forceinline__ void a_ready(const Unit&) const {}
    __device__ __forceinline__ void done(const Unit&) const {}
};

typedef float f32x2_cv __attribute__((ext_vector_type(2)));
typedef __bf16 bf16x2_cv __attribute__((ext_vector_type(2)));
__device__ __forceinline__ unsigned cvt_pk_bf16(float lo, float hi) { const f32x2_cv v = {lo, hi}; return __builtin_bit_cast(unsigned, __builtin_convertvector(v, bf16x2_cv)); }
typedef float f32x2 __attribute__((ext_vector_type(2)));
template <class Epi, class Sched, bool ALIGN_EPI = false, bool SP2 = false>
__device__ __forceinline__ void gemm_phase(PG8_LAS unsigned char* lds, const Gemm g, const Sched& S, const Epi& E, int tid_in) {
    int tid_ = tid_in; asm volatile("" : "+v"(tid_));
    const int tid = tid_, wid = __builtin_amdgcn_readfirstlane(tid >> 6), lane = tid & 63, wr = wid >> 2, wc = wid & 3, fr = lane & 15, fq = lane >> 4;
    const int K = g.K, nt = K / BK;
    unsigned voffA[2], voffB[2];
#pragma unroll
    for (int i = 0; i < 2; ++i) { int R, C; stage_rc(tid * 16 + i * 8192, R, C); const int Rb = Epi::PERM ? ((R & ~31) + perm32(R & 31)) : R;
        voffA[i] = (unsigned)(R * g.lda + C) * 2u; voffB[i] = (unsigned)(Rb * g.ldb + C) * 2u; }
    const size_t kstep = (size_t)(BK * 2), kstepB = g.ksb;
    const size_t hstepA = (size_t)HALF * g.lda * 2, hstepB = (size_t)HALF * g.ldb * 2;
    const size_t tstepA = 2 * hstepA, tstepB = 2 * hstepB;
    const unsigned ldsw = (unsigned)wid * 1024u;
    const int aoff = lds_byte(wr * 64 + fr, fq * 8), boff = lds_byte(wc * 32 + fr, fq * 8);
#define PG8_SA(b, h) (((b) * 2 + (h)) * HTB)
#define PG8_SB(b, h) ((4 + (b) * 2 + (h)) * HTB)
#define PG8_STAGE(bufoff, gbase, voff) do { _Pragma("unroll") for (int _i = 0; _i < 2; ++_i) \
        __builtin_amdgcn_global_load_lds((const unsigned*)((const char*)(gbase) + (voff)[_i]), (PG8_LAS unsigned*)(lds + (bufoff) + ldsw + _i * 8192), 16, 0, 0); } while (0)
#define PG8_LDA(dst, b, h) do { _Pragma("unroll") for (int m = 0; m < 4; ++m) _Pragma("unroll") for (int k = 0; k < 2; ++k) dst[m][k] = *(const PG8_LAS bf16x8*)(lds + PG8_SA(b, h) + aoff + m * 2048 + k * 1024); } while (0)
#define PG8_LDB(dst, b, h) do { _Pragma("unroll") for (int n = 0; n < 2; ++n) _Pragma("unroll") for (int k = 0; k < 2; ++k) dst[n][k] = *(const PG8_LAS bf16x8*)(lds + PG8_SB(b, h) + boff + n * 2048 + k * 1024); } while (0)
#define PG8_MMA(ai, bj, At, Bt) do { __builtin_amdgcn_s_setprio(1); _Pragma("unroll") for (int m = 0; m < 4; ++m) _Pragma("unroll") for (int n = 0; n < 2; ++n) _Pragma("unroll") for (int k = 0; k < 2; ++k) \
        acc[ai][bj][m][n] = __builtin_amdgcn_mfma_f32_16x16x32_bf16(Bt[n][k], At[m][k], acc[ai][bj][m][n], 0, 0, 0); __builtin_amdgcn_s_setprio(0); } while (0)
#define PG8_WAIT_V(n) asm volatile("s_waitcnt vmcnt(" #n ")" ::: "memory")
#define PG8_WAIT_L(n) asm volatile("s_waitcnt lgkmcnt(" #n ")" ::: "memory")
#define PG8_BAR __builtin_amdgcn_s_barrier()
#define PG8_SCHED __builtin_amdgcn_sched_barrier(0)
    Unit cur, nxt; int ui = 0;
    if (!S.next(0, cur)) return;
    f32x4 acc[2][2][4][2];
#pragma unroll
    for (int a = 0; a < 2; ++a)
#pragma unroll
        for (int b = 0; b < 2; ++b)
#pragma unroll
            for (int m = 0; m < 4; ++m)
#pragma unroll
                for (int n = 0; n < 2; ++n) acc[a][b][m][n] = (f32x4){0.f, 0.f, 0.f, 0.f};
    bf16x8 At[4][2], B0[2][2], B1[2][2];
    const char* cA = (const char*)g.A + (size_t)cur.pm * tstepA; const char* cB = (const char*)g.Bt + (size_t)cur.pn * tstepB;
    S.a_ready(cur);
    if constexpr (SP2) {
        PG8_STAGE(PG8_SB(0, 0), cB, voffB); PG8_STAGE(PG8_SB(0, 1), cB + hstepB, voffB); PG8_STAGE(PG8_SA(0, 0), cA, voffA); PG8_STAGE(PG8_SA(0, 1), cA + hstepA, voffA);
        if (wr == 1) PG8_BAR;
        PG8_WAIT_V(2); PG8_BAR;
        PG8_STAGE(PG8_SB(1, 0), cB + kstepB, voffB); PG8_STAGE(PG8_SA(1, 0), cA + kstep, voffA); PG8_STAGE(PG8_SB(1, 1), cB + hstepB + kstepB, voffB);
        PG8_WAIT_V(6); PG8_BAR;
    } else {
        PG8_STAGE(PG8_SB(0, 0), cB, voffB); PG8_STAGE(PG8_SA(0, 0), cA, voffA); PG8_STAGE(PG8_SB(0, 1), cB + hstepB, voffB); PG8_STAGE(PG8_SA(0, 1), cA + hstepA, voffA);
        if (wr == 1) PG8_BAR;
        PG8_WAIT_V(4); PG8_BAR;
        PG8_STAGE(PG8_SB(1, 0), cB + kstepB, voffB); PG8_STAGE(PG8_SA(1, 0), cA + kstep, voffA); PG8_STAGE(PG8_SB(1, 1), cB + hstepB + kstepB, voffB);
        PG8_WAIT_V(6); PG8_BAR;
    }
    for (;;) {
        const bool has_next = S.next(ui + 1, nxt);
        const char* nA = has_next ? (const char*)g.A + (size_t)nxt.pm * tstepA : cA; const char* nB = has_next ? (const char*)g.Bt + (size_t)nxt.pn * tstepB : cB;
        for (int t = 0; t < nt; t += 2) {
            const bool last = (t == nt - 2);
            const char* a1 = cA + (size_t)(t + 1) * kstep;
            const char* a2 = last ? nA : cA + (size_t)(t + 2) * kstep; const char* b2 = last ? nB : cB + (size_t)(t + 2) * kstepB;
            const char* a3 = a2 + kstep; const char* b3 = b2 + kstepB;
            if (last && has_next) S.a_ready(nxt);
            if constexpr (SP2) {
            PG8_LDB(B0, 0, 0); PG8_LDB(B1, 0, 1); PG8_SCHED; PG8_LDA(At, 0, 0); PG8_STAGE(PG8_SA(1, 1), a1 + hstepA, voffA);
            PG8_WAIT_V(8); PG8_WAIT_L(0); PG8_BAR; PG8_MMA(0, 0, At, B0); PG8_MMA(0, 1, At, B1); PG8_BAR; PG8_SCHED;
            PG8_LDA(At, 0, 1); PG8_STAGE(PG8_SB(0, 0), b2, voffB); PG8_STAGE(PG8_SB(0, 1), b2 + hstepB, voffB); PG8_STAGE(PG8_SA(0, 0), a2, voffA);
            PG8_WAIT_V(8); PG8_WAIT_L(0); PG8_BAR; PG8_MMA(1, 0, At, B0); PG8_MMA(1, 1, At, B1); PG8_BAR; PG8_SCHED;
            PG8_LDB(B0, 1, 0); PG8_LDB(B1, 1, 1); PG8_SCHED; PG8_LDA(At, 1, 0); PG8_STAGE(PG8_SA(0, 1), a2 + hstepA, voffA);
            PG8_WAIT_V(8); PG8_WAIT_L(0); PG8_BAR; PG8_MMA(0, 0, At, B0); PG8_MMA(0, 1, At, B1); PG8_BAR; PG8_SCHED;
            PG8_LDA(At, 1, 1); PG8_STAGE(PG8_SB(1, 0), b3, voffB); PG8_STAGE(PG8_SB(1, 1), b3 + hstepB, voffB); PG8_STAGE(PG8_SA(1, 0), a3, voffA);
            PG8_WAIT_V(8); PG8_WAIT_L(0); PG8_BAR; PG8_MMA(1, 0, At, B0); PG8_MMA(1, 1, At, B1); PG8_BAR; PG8_SCHED;
            } else {
            PG8_LDB(B0, 0, 0); PG8_SCHED; PG8_LDA(At, 0, 0); PG8_STAGE(PG8_SA(1, 1), a1 + hstepA, voffA);
            PG8_WAIT_L(8); PG8_BAR; PG8_WAIT_L(0); PG8_MMA(0, 0, At, B0); PG8_BAR; PG8_SCHED;
            PG8_LDB(B1, 0, 1); PG8_STAGE(PG8_SB(0, 0), b2, voffB);
            PG8_BAR; PG8_WAIT_L(0); PG8_MMA(0, 1, At, B1); PG8_BAR;
            PG8_LDA(At, 0, 1); PG8_STAGE(PG8_SA(0, 0), a2, voffA);
            PG8_BAR; PG8_WAIT_L(0); PG8_MMA(1, 0, At, B0); PG8_BAR; PG8_SCHED;
            PG8_STAGE(PG8_SB(0, 1), b2 + hstepB, voffB);
            PG8_WAIT_V(6); PG8_BAR; PG8_MMA(1, 1, At, B1); PG8_BAR;
            PG8_LDB(B0, 1, 0); PG8_SCHED; PG8_LDA(At, 1, 0); PG8_STAGE(PG8_SA(0, 1), a2 + hstepA, voffA);
            PG8_WAIT_L(8); PG8_BAR; PG8_WAIT_L(0); PG8_MMA(0, 0, At, B0); PG8_BAR; PG8_SCHED;
            PG8_LDB(B1, 1, 1); PG8_STAGE(PG8_SB(1, 0), b3, voffB);
            PG8_BAR; PG8_WAIT_L(0); PG8_MMA(0, 1, At, B1); PG8_BAR;
            PG8_LDA(At, 1, 1); PG8_STAGE(PG8_SA(1, 0), a3, voffA);
            PG8_BAR; PG8_WAIT_L(0); PG8_MMA(1, 0, At, B0); PG8_BAR; PG8_SCHED;
            PG8_STAGE(PG8_SB(1, 1), b3 + hstepB, voffB);
            PG8_WAIT_V(6); PG8_BAR; PG8_MMA(1, 1, At, B1); PG8_BAR;
            }
        }
        if constexpr (ALIGN_EPI) { if (wr == 0) PG8_BAR; }
        if constexpr (!Epi::AFTER_DRAIN) { E(acc, cur, wr, wc, fr, fq); S.done(cur); }
        if (!has_next) break;
#pragma unroll
        for (int a = 0; a < 2; ++a)
#pragma unroll
            for (int b = 0; b < 2; ++b)
#pragma unroll
                for (int m = 0; m < 4; ++m)
#pragma unroll
                    for (int n = 0; n < 2; ++n) acc[a][b][m][n] = (f32x4){0.f, 0.f, 0.f, 0.f};
        cur = nxt; cA = nA; cB = nB; ++ui;
        if constexpr (ALIGN_EPI) { if (wr == 1) PG8_BAR; }
    }
    PG8_WAIT_V(0);
    if constexpr (!ALIGN_EPI) { if (wr == 0) PG8_BAR; }
    PG8_BAR;
    if constexpr (Epi::AFTER_DRAIN) { E.fused(acc, cur, wr, wc, fr, fq, lds, wid, lane); S.done(cur); }
#undef PG8_SA
#undef PG8_SB
#undef PG8_STAGE
#undef PG8_LDA
#undef PG8_LDB
#undef PG8_MMA
#undef PG8_WAIT_V
#undef PG8_WAIT_L
#undef PG8_BAR
#undef PG8_SCHED
}
}

constexpr int DM = 2048, SEQ = 2048, NB = 4, NS = 128, DEPTH = 2;
constexpr int MP = NB * SEQ;
constexpr int MT = MP + NS;
constexpr int MPAD = MP + 256;
constexpr int PIN = 6400, DFF = 8192, NMEM = 256, MMEM = NB * NMEM;
constexpr int PB_ = 1536, PC_ = 3584, PD_ = 5376;
constexpr int SHW = 1792;
constexpr int LDU = 8192;
constexpr int NWAVES = 8;
constexpr int NIN = 39;

constexpr size_t O_YP = 0, O_YS = O_YP + (size_t)MP * DM, O_CAP = O_YS + (size_t)NS * DM, O_CAS = O_CAP + (size_t)DEPTH * NB * 2 * 512,
    O_RETP = O_CAS + (size_t)DEPTH * NS * 2 * 512, O_RETS = O_RETP + (size_t)DEPTH * NB * 4 * 128 * 128, O_SHP = O_RETS + (size_t)DEPTH * NS * 4 * 128 * 128,
    O_SHS = O_SHP + (size_t)DEPTH * NB * SHW, O_WKVP = O_SHS + (size_t)DEPTH * NS * SHW, O_WKVS = O_WKVP + (size_t)DEPTH * NB * 8 * 64 * 64,
    O_CDP = O_WKVS + (size_t)DEPTH * NS * 8 * 64 * 64, O_CDS = O_CDP + (size_t)DEPTH * NB * 30 * 512, O_MKP = O_CDS + (size_t)DEPTH * NS * 30 * 512,
    O_MVP = O_MKP + (size_t)DEPTH * MMEM * DM, O_END = O_MVP + (size_t)DEPTH * MMEM * DM;
static_assert(O_END == 56178688, "d_out size");

constexpr size_t MiB = 1u << 20;
constexpr size_t al256(size_t x) { return (x + 255) & ~(size_t)255; }
constexpr size_t WS_CTL = 0, CTL_ZERO_BYTES = 1 * MiB;
constexpr size_t WS_ROPE = 1 * MiB;
constexpr size_t SZ_WIN = (size_t)PIN * DM * 2, SZ_SQ = (size_t)DM * DM * 2, SZ_WUP = (size_t)DFF * DM * 2, SZ_WDN = (size_t)DM * LDU * 2;
constexpr size_t LW_IN = 0, LW_OUT = LW_IN + SZ_WIN, LW_Q = LW_OUT + SZ_SQ, LW_O = LW_Q + SZ_SQ, LW_UP = LW_O + SZ_SQ, LW_DN = LW_UP + SZ_WUP,
    LW_W2 = LW_DN + SZ_WDN, LW_A2 = LW_W2 + 512 * 64 * 2, LW_G2 = LW_A2 + 512 * 64 * 2, LW_STRIDE = LW_G2 + 512 * 128 * 2;
constexpr size_t WS_WL = 4 * MiB;
constexpr size_t WS_WKV = al256(WS_WL + 2 * LW_STRIDE);
constexpr size_t WS_XF = al256(WS_WKV + (size_t)8192 * DM * 2);
constexpr size_t WS_HN = al256(WS_XF + (size_t)MT * DM * 4);
constexpr size_t WS_MN = al256(WS_HN + (size_t)MPAD * DM * 2);
constexpr size_t WS_MK = al256(WS_MN + (size_t)MMEM * DM * 2);
constexpr size_t WS_MVT = al256(WS_MK + (size_t)2 * MMEM * DM * 2);
constexpr size_t WS_P = al256(WS_MVT + (size_t)2 * MMEM * DM * 2);
constexpr size_t WS_YC = al256(WS_P + (size_t)MPAD * PIN * 2);
constexpr size_t WS_Q = al256(WS_YC + (size_t)MT * DM * 2);
constexpr size_t WS_O = al256(WS_Q + (size_t)MT * DM * 2);
constexpr size_t WS_U = al256(WS_O + (size_t)MT * DM * 2);
constexpr size_t WS_RW = al256(WS_U + (size_t)MT * LDU * 2);
constexpr size_t WS_GATE = al256(WS_RW + (size_t)MT * 8 * 896);
constexpr size_t WS_OC = al256(WS_GATE + (size_t)MT * 512 * 4);
constexpr size_t WS_KVT = al256(WS_OC + (size_t)MT * 512 * 4);
constexpr size_t WS_SSQ = al256(WS_KVT + (size_t)16 * 16 * 128 * 128 * 4);
constexpr size_t WS_SPL = al256(WS_SSQ + (size_t)MP * 8 * 4);
constexpr size_t WS_STB = al256(WS_SPL + (size_t)2 * NS * DM * 4);
constexpr size_t WS_CK = al256(WS_STB + (size_t)16 * 16 * 128 * 128 * 2);
constexpr size_t WS_CP = al256(WS_CK + (size_t)4096 * 6912);
constexpr int DMS = DM + 128, LDUS = LDU + 128;
constexpr size_t WS_HNS = al256(WS_CP + (size_t)4096 * 4 * 3072);
constexpr size_t WS_OS = al256(WS_HNS + (size_t)NS * DMS * 2);
constexpr size_t WS_US = al256(WS_OS + (size_t)NS * DMS * 2);
constexpr size_t WS_END = al256(WS_US + (size_t)NS * LDUS * 2);
static_assert(WS_END < (size_t)1700 * MiB, "d_ws map");
constexpr int CW_BAR = 4096;

constexpr int SCR_BYTES = 147456;
constexpr int MISC_OFF = SCR_BYTES;
constexpr int LDS_BYTES = SCR_BYTES + 1024;

#define GAS __attribute__((address_space(1)))
#define LAS __attribute__((address_space(3)))
typedef unsigned short bf16;
typedef unsigned v4u __attribute__((ext_vector_type(4)));
typedef unsigned v2u __attribute__((ext_vector_type(2)));
typedef float f32x4 __attribute__((ext_vector_type(4)));
typedef float f32x2 __attribute__((ext_vector_type(2)));
typedef short bf16x8 __attribute__((ext_vector_type(8)));
typedef short bf16x4 __attribute__((ext_vector_type(4)));
typedef GAS unsigned gu32;
#define RLX_AGENT __ATOMIC_RELAXED, __HIP_MEMORY_SCOPE_AGENT
#define LDS_WAIT() asm volatile("s_waitcnt lgkmcnt(0)" ::: "memory")
#define VM_WAIT() asm volatile("s_waitcnt vmcnt(0)" ::: "memory")
__device__ __forceinline__ unsigned pk2(float lo, float hi) { return pg8::cvt_pk_bf16(lo, hi); }
__device__ __forceinline__ float bflo(unsigned w) { return __uint_as_float(w << 16); }
__device__ __forceinline__ float bfhi(unsigned w) { return __uint_as_float(w & 0xffff0000u); }
__device__ __forceinline__ float bf1(bf16 h) { return __uint_as_float(((unsigned)h) << 16); }
__device__ __forceinline__ void unpack8(const v4u w, float (&f)[8]) { f[0] = bflo(w.x); f[1] = bfhi(w.x); f[2] = bflo(w.y); f[3] = bfhi(w.y); f[4] = bflo(w.z); f[5] = bfhi(w.z); f[6] = bflo(w.w); f[7] = bfhi(w.w); }
__device__ __forceinline__ void unpack4(const v2u w, float (&f)[4]) { f[0] = bflo(w.x); f[1] = bfhi(w.x); f[2] = bflo(w.y); f[3] = bfhi(w.y); }
__device__ __forceinline__ v4u pack8(const float (&f)[8]) { v4u w; w.x = pk2(f[0], f[1]); w.y = pk2(f[2], f[3]); w.z = pk2(f[4], f[5]); w.w = pk2(f[6], f[7]); return w; }
__device__ __forceinline__ float sigm(float x) { return 1.0f / (1.0f + __expf(-x)); }
__device__ __forceinline__ float wave_sum(float v) {
#pragma unroll
    for (int o = 1; o < 64; o <<= 1) v += __shfl_xor(v, o);
    return v;
}
__device__ __forceinline__ float wave_max(float v) {
#pragma unroll
    for (int o = 1; o < 64; o <<= 1) v = fmaxf(v, __shfl_xor(v, o));
    return v;
}
template <int CTRL> __device__ __forceinline__ float dpp_f(float v) { return __builtin_bit_cast(float, __builtin_amdgcn_update_dpp(0, __builtin_bit_cast(int, v), CTRL, 0xf, 0xf, false)); }
__device__ __forceinline__ f32x4 zero4() { float z0, z1, z2, z3; asm volatile("v_mov_b32 %0, 0\n\tv_mov_b32 %1, 0\n\tv_mov_b32 %2, 0\n\tv_mov_b32 %3, 0\n\ts_nop 1" : "=v"(z0), "=v"(z1), "=v"(z2), "=v"(z3)); return (f32x4){z0, z1, z2, z3}; }
__device__ __forceinline__ float rowsum16(float v) { v += dpp_f<0x128>(v); v += dpp_f<0x124>(v); v += dpp_f<0x122>(v); v += dpp_f<0x121>(v); return v; }

namespace pg8 {
template <int ACT> struct EpiBf16A {
    static constexpr bool PERM = true, AFTER_DRAIN = false;
    bf16_t* O; int ldc; const float* ssq;
    __device__ __forceinline__ void operator()(const f32x4 (&acc)[2][2][4][2], const Unit& u, int wr, int wc, int fr, int fq) const {
        const int row0 = u.pm * BM + wr * 64 + fr, col0 = u.pn * BM + wc * 32 + 8 * fq;
#pragma unroll
        for (int ai = 0; ai < 2; ++ai)
#pragma unroll
            for (int m = 0; m < 4; ++m) { bf16_t* rowp = O + (size_t)(row0 + ai * HALF + m * 16) * ldc + col0;
                const float rs = ssq ? 1.0f / sqrtf(ssq[row0 + ai * HALF + m * 16] * (1.0f / 2048.0f) + 1e-6f) : 1.0f;
#pragma unroll
                for (int bj = 0; bj < 2; ++bj) { f32x4 v0 = acc[ai][bj][m][0] * rs, v1 = acc[ai][bj][m][1] * rs;
                    if (ACT == 3) {
#pragma unroll
                        for (int j = 0; j < 4; ++j) { const float a = fmaxf(v0[j], 0.f), b = fmaxf(v1[j], 0.f); v0[j] = a * a; v1[j] = b * b; } }
                    u32x4 w; w.x = cvt_pk_bf16(v0[0], v0[1]); w.y = cvt_pk_bf16(v0[2], v0[3]); w.z = cvt_pk_bf16(v1[0], v1[1]); w.w = cvt_pk_bf16(v1[2], v1[3]);
                    *(u32x4*)(rowp + bj * HALF) = w; } }
    }
};
struct EpiRes {
    static constexpr bool PERM = false, AFTER_DRAIN = false;
    float* X; int ldc; float sc; const float* Xin;
    __device__ __forceinline__ void operator()(const f32x4 (&acc)[2][2][4][2], const Unit& u, int wr, int wc, int fr, int fq) const {
        const int row0 = u.pm * BM + wr * 64 + fr, col0 = u.pn * BM + wc * 32 + 4 * fq;
#pragma unroll
        for (int ai = 0; ai < 2; ++ai)
#pragma unroll
            for (int m = 0; m < 4; ++m) { float* rowp = X + (size_t)(row0 + ai * HALF + m * 16) * ldc + col0; const float* inp = Xin + (size_t)(row0 + ai * HALF + m * 16) * ldc + col0;
                f32x4 o[2][2];
#pragma unroll
                for (int bj = 0; bj < 2; ++bj)
#pragma unroll
                    for (int n = 0; n < 2; ++n) o[bj][n] = *(const f32x4*)(inp + bj * HALF + n * 16);
#pragma unroll
                for (int bj = 0; bj < 2; ++bj)
#pragma unroll
                    for (int n = 0; n < 2; ++n) *(f32x4*)(rowp + bj * HALF + n * 16) = o[bj][n] + acc[ai][bj][m][n] * sc; }
    }
};
struct EpiMemKV {
    static constexpr bool PERM = false, AFTER_DRAIN = false;
    float* outK; bf16_t* MKb; bf16_t* MVT;
    __device__ __forceinline__ void operator()(const f32x4 (&acc)[2][2][4][2], const Unit& u, int wr, int wc, int fr, int fq) const {
        const int cbase = u.pn * BM, lyr = cbase >> 12, cc = cbase & 4095; const bool isV = cc >= 2048; const int colt = cc & 2047;
        const int row0 = u.pm * BM + wr * 64 + fr, col0 = colt + wc * 32 + 4 * fq;
        float* outp = outK + (isV ? (size_t)(O_MVP - O_MKP) : (size_t)0);
#pragma unroll
        for (int ai = 0; ai < 2; ++ai)
#pragma unroll
            for (int m = 0; m < 4; ++m) { const int r = row0 + ai * HALF + m * 16;
#pragma unroll
                for (int bj = 0; bj < 2; ++bj)
#pragma unroll
                    for (int n = 0; n < 2; ++n) { const int col = col0 + bj * HALF + n * 16; const f32x4 v = acc[ai][bj][m][n];
                        *(f32x4*)(outp + ((size_t)lyr * 1024 + r) * 2048 + col) = v;
                        if (!isV) { unsigned lo = cvt_pk_bf16(v[0], v[1]), hi = cvt_pk_bf16(v[2], v[3]); *(unsigned long long*)(MKb + ((size_t)lyr * 1024 + r) * 2048 + col) = ((unsigned long long)hi << 32) | lo; }
                        else { const int b = r >> 8, j = r & 255, h = col >> 9, e = col & 511; bf16_t* tp = MVT + ((((size_t)lyr * 4 + b) * 4 + h) * 512 + e) * 256 + j;
                            const unsigned lo = cvt_pk_bf16(v[0], v[1]), hi = cvt_pk_bf16(v[2], v[3]);
                            tp[0] = (bf16_t)(lo & 0xffffu); tp[256] = (bf16_t)(lo >> 16); tp[512] = (bf16_t)(hi & 0xffffu); tp[768] = (bf16_t)(hi >> 16); } } }
    }
};
}

struct SEpiBf16 { bf16* O; int ldc; int act; const float* ssq;
    __device__ __forceinline__ void operator()(int row, int col0, f32x4 v, int) const {
        if (ssq) v = v * (1.0f / sqrtf(ssq[row] * (1.0f / 2048.0f) + 1e-6f));
        if (act == 3) {
#pragma unroll
            for (int j = 0; j < 4; ++j) { const float a = fmaxf(v[j], 0.f); v[j] = a * a; } }
        v2u w; w.x = pk2(v[0], v[1]); w.y = pk2(v[2], v[3]); *(v2u*)(O + (size_t)row * ldc + col0) = w; } };
struct SEpiRes { float* X; int ldc; float sc; const float* Xin;
    __device__ __forceinline__ void operator()(int row, int col0, f32x4 v, int) const { *(f32x4*)(X + (size_t)row * ldc + col0) = *(const f32x4*)(Xin + (size_t)row * ldc + col0) + v * sc; } };
struct SEpiPart { float* S; int ldc;
    __device__ __forceinline__ void operator()(int row, int col0, f32x4 v, int kp) const { *(f32x4*)(S + ((size_t)kp * NS + row) * ldc + col0) = v; } };
template <class F> __device__ __forceinline__ void sample_gemm(LAS unsigned char* lds, int tid_in, const bf16* A, int lda, const bf16* Bt, int ntot, int N, int K, int G, int bid, const F& epi, int nks = 1) {
    int tid_ = tid_in; asm volatile("" : "+v"(tid_));
    const int lane = tid_ & 63, wave = __builtin_amdgcn_readfirstlane(tid_ >> 6), fr = lane & 15, fq = lane >> 4;
    const int KS = (K / nks) >> 3, ncu = N / 16;
    LAS f32x4* red = (LAS f32x4*)lds;
    const unsigned voffa = (unsigned)(fr * lda + fq * 8) * 2u, voffb = (unsigned)(fr * 64 + fq * 8) * 2u;
    for (int uu = bid; uu < ncu * nks; uu += G) { const int kp = uu / ncu, u = uu - kp * ncu, kbeg = kp * (K / nks) + wave * KS;
        const char* bp = (const char*)(Bt + ((size_t)(kbeg >> 6) * ntot + u * 16) * 64);
        const char* ap = (const char*)(A + kbeg);
        f32x4 acc[8];
#pragma unroll
        for (int rt = 0; rt < 8; ++rt) acc[rt] = zero4();
        bf16x8 b0[2], a0[2][8], b1[2], a1[2][8];
#define SG_LOAD(bb, aa, kq) do { _Pragma("unroll") for (int s = 0; s < 2; ++s) { bb[s] = *(const bf16x8*)(bp + ((size_t)((kq) >> 6) * ntot * 64 + 32 * s) * 2 + voffb); \
            _Pragma("unroll") for (int rt = 0; rt < 8; ++rt) aa[s][rt] = *(const bf16x8*)(ap + ((size_t)rt * 16 * lda + (kq) + 32 * s) * 2 + voffa); } } while (0)
#define SG_MMA(bb, aa) do { _Pragma("unroll") for (int s = 0; s < 2; ++s) _Pragma("unroll") for (int rt = 0; rt < 8; ++rt) acc[rt] = __builtin_amdgcn_mfma_f32_16x16x32_bf16(bb[s], aa[s][rt], acc[rt], 0, 0, 0); } while (0)
        SG_LOAD(b0, a0, 0);
        for (int k0 = 0; k0 < KS; k0 += 128) {
            __builtin_amdgcn_sched_barrier(0);
            SG_LOAD(b1, a1, k0 + 64);
            __builtin_amdgcn_sched_barrier(0);
            SG_MMA(b0, a0);
            __builtin_amdgcn_sched_barrier(0);
            if (k0 + 128 < KS) SG_LOAD(b0, a0, k0 + 128);
            __builtin_amdgcn_sched_barrier(0);
            SG_MMA(b1, a1);
        }
        __builtin_amdgcn_sched_barrier(0);
#undef SG_LOAD
#undef SG_MMA
#pragma unroll
        for (int rt = 0; rt < 8; ++rt) red[(wave * 8 + rt) * 64 + lane] = acc[rt];
        __syncthreads();
        f32x4 sum = red[wave * 64 + lane];
#pragma unroll
        for (int ks = 1; ks < 8; ++ks) sum += red[(ks * 8 + wave) * 64 + lane];
        epi(wave * 16 + fr, u * 16 + 4 * fq, sum, kp);
        __syncthreads();
    }
}
#define XB_TMO      128
#define XB_XCNT(j)  (256  + 64 * (j))
#define XB_XSUB(j)  (1280 + 64 * (j))
#define XB_XGEN(j)  (2304 + 64 * (j))
#define XB_TOP      3328
#define XB_TOPGEN   3392
#define XCD_BAR_WORDS 3456
#define XB_SPIN_CAP (1u << 18)

__device__ __forceinline__ unsigned xb_ld(unsigned* p)              { return __hip_atomic_load(p, __ATOMIC_RELAXED, __HIP_MEMORY_SCOPE_AGENT); }
__device__ __forceinline__ unsigned xb_add(unsigned* p, unsigned v) { return __hip_atomic_fetch_add(p, v, __ATOMIC_RELAXED, __HIP_MEMORY_SCOPE_AGENT); }
__device__ __forceinline__ unsigned xb_xcc_id() { return (unsigned)__builtin_amdgcn_s_getreg((3 << 11) | 20) & 0xFu; }
#define XB_SPIN(cond, bar) do { unsigned _sp = 0; while (cond) { __builtin_amdgcn_s_sleep(1); \
    if ((++_sp & 255u) == 0u) { if (xb_ld(&(bar)[XB_TMO])) break; if (_sp > XB_SPIN_CAP) { atomicAdd(&(bar)[XB_TMO], 1u); break; } } } } while (0)

struct XcdBarrier {
    int wave;
    unsigned* bar; unsigned x;
    volatile LAS unsigned* st;
};

__device__ __forceinline__ XcdBarrier xcd_barrier_post(unsigned* bar, volatile LAS unsigned* st) {
    XcdBarrier b; b.bar = bar; b.x = xb_xcc_id(); b.st = st;
    if (threadIdx.x == 0) (void)xb_add(&bar[XB_XCNT(b.x)], 1u);
    return b;
}
__device__ __forceinline__ void xcd_barrier_complete(unsigned* bar, unsigned x, unsigned& nloc, unsigned& nx) {
    const unsigned G = gridDim.x * gridDim.y * gridDim.z;
    unsigned sum, cnt, mine, sp = 0u;
    for (;;) {
        sum = 0u; cnt = 0u; mine = 0u;
#pragma unroll
        for (unsigned j = 0; j < 16; ++j) { const unsigned c = xb_ld(&bar[XB_XCNT(j)]); sum += c; cnt += (c > 0u) ? 1u : 0u; mine = (j == x) ? c : mine; }
        if (sum == G) break;
        __builtin_amdgcn_s_sleep(1);
        if ((++sp & 255u) == 0u) { if (xb_ld(&bar[XB_TMO])) break; if (sp > XB_SPIN_CAP) { atomicAdd(&bar[XB_TMO], 1u); break; } }
    }
    nloc = mine > 0u ? mine : 1u; nx = cnt > 0u ? cnt : 1u;
}

__device__ __forceinline__ void xcd_barrier(const XcdBarrier& b) {
    asm volatile("s_waitcnt vmcnt(0)" ::: "memory");
    __syncthreads();
    unsigned xbz = 0u; asm volatile("" : "+v"(xbz));
    if (b.wave == 0 && __builtin_amdgcn_mbcnt_hi(~0u, __builtin_amdgcn_mbcnt_lo(~0u, xbz)) == 0u) {
        unsigned* bar = b.bar;
        __builtin_amdgcn_s_waitcnt(0);
        unsigned nloc = b.st[0], nx = b.st[1];
        if (nloc == 0u) { xcd_barrier_complete(bar, b.x, nloc, nx); b.st[0] = nloc; b.st[1] = nx; }
        const unsigned old = xb_add(&bar[XB_XSUB(b.x)], 1u);
        const unsigned gen = old / nloc;
        if (old + 1u == (gen + 1u) * nloc) {
            __builtin_amdgcn_fence(__ATOMIC_RELEASE, "agent");
            asm volatile("s_waitcnt vmcnt(0)" ::: "memory");
            const unsigned og = xb_add(&bar[XB_TOP], 1u);
            const unsigned tg = og / nx;
            if (og + 1u == (tg + 1u) * nx) xb_add(&bar[XB_TOPGEN], 1u);
            else XB_SPIN(xb_ld(&bar[XB_TOPGEN]) == tg, bar);
            __builtin_amdgcn_fence(__ATOMIC_ACQUIRE, "agent");
            xb_add(&bar[XB_XGEN(b.x)], 1u);
            asm volatile("s_waitcnt vmcnt(0)" ::: "memory");
        } else {
            XB_SPIN(xb_ld(&bar[XB_XGEN(b.x)]) == gen, bar);
            __builtin_amdgcn_fence(__ATOMIC_ACQUIRE, "agent");
            asm volatile("s_waitcnt vmcnt(0)" ::: "memory");
        }
    }
    __syncthreads();
}

struct Args { const float* in[NIN]; float* out; unsigned char* ws; int ph_lo, ph_hi; };
enum { I_XP = 0, I_XS, I_MEM, I_SCA, I_SRET, I_SSH, I_SWKV, I_SCD, I_CMK, I_CMV, I_GMIX, I_WIN, I_CAW, I_MU, I_W0, I_W2, I_A0, I_A2, I_G2, I_KK, I_KA, I_RK, I_LNXG, I_LNXB,
       I_CDW, I_CDB, I_LNDG, I_LNDB, I_WOUT, I_GXA, I_GMEM, I_WQ, I_WK, I_WV, I_WO, I_GMLP, I_WUP, I_WDN, I_GFIN };

struct Ctx { LAS unsigned char* lds; int tid, lane, wave, G, bid; };
typedef const GAS float* gcfp;
#define CAS __attribute__((address_space(4)))
struct Ax { const CAS gcfp* kp; float* out; unsigned char* ws;
    __device__ __forceinline__ const float* in(int i) const { return (const float*)kp[i]; } };
__device__ __forceinline__ Ax mk_ax() { const CAS gcfp* kp = (const CAS gcfp*)__builtin_amdgcn_kernarg_segment_ptr(); asm volatile("" : "+s"(kp)); Ax a; a.kp = kp;
    a.out = (float*)(GAS float*)kp[NIN]; a.ws = (unsigned char*)(GAS unsigned char*)kp[NIN + 1]; return a; }
__device__ __forceinline__ Ctx mk_ctx(LAS unsigned char* lds, int wave_s) { unsigned z = 0u; asm volatile("" : "+v"(z)); int t = wave_s * 64 + (int)__builtin_amdgcn_mbcnt_hi(~0u, __builtin_amdgcn_mbcnt_lo(~0u, z)); Ctx C; C.lds = lds; C.tid = t; C.lane = t & 63; C.wave = __builtin_amdgcn_readfirstlane(t >> 6); C.G = gridDim.x; C.bid = blockIdx.x; return C; }

__device__ __forceinline__ void p0_transpose_item(const float* W, int K, int N, bf16* WT, int ldk, int row_off, LAS float* scr, int item, int lane, const float* gain) {
    const int nblk = N / 64, kb = item / nblk, nb = item - kb * nblk, k0 = 64 * kb, n0 = 64 * nb;
    const int lr = lane >> 4, lc = (lane & 15) * 4;
#pragma unroll 8
    for (int i = 0; i < 16; ++i) { const int kk = 4 * i + lr; const float g = gain ? gain[k0 + kk] : 1.0f; const f32x4 v = *(const f32x4*)(W + (size_t)(k0 + kk) * N + n0 + lc);
        LAS float* d = scr + kk * 65 + lc; d[0] = v.x * g; d[1] = v.y * g; d[2] = v.z * g; d[3] = v.w * g; }
    LDS_WAIT(); asm volatile("" ::: "memory");
    const int c = lane & 7;
#pragma unroll
    for (int j = 0; j < 8; ++j) { const int n = (lane >> 3) + 8 * j; const LAS float* s = scr + (8 * c) * 65 + n;
        v4u o; o.x = pk2(s[0 * 65], s[1 * 65]); o.y = pk2(s[2 * 65], s[3 * 65]); o.z = pk2(s[4 * 65], s[5 * 65]); o.w = pk2(s[6 * 65], s[7 * 65]);
        if (ldk > 0) *(v4u*)(WT + (size_t)(row_off + n0 + n) * ldk + k0 + 8 * c) = o;
        else *(v4u*)(WT + ((size_t)kb * (size_t)(-ldk) + row_off + n0 + n) * 64 + 8 * c) = o; }
    LDS_WAIT(); asm volatile("" ::: "memory");
}
__device__ __forceinline__ void rms_row(const float* xrow, bf16* orow, float* xcopy, int lane) {
    const f32x4* xr = (const f32x4*)xrow + lane;
    f32x4 v[8]; float s = 0.f;
#pragma unroll
    for (int j = 0; j < 8; ++j) { v[j] = xr[64 * j]; s += (v[j].x * v[j].x + v[j].y * v[j].y) + (v[j].z * v[j].z + v[j].w * v[j].w); }
    const float rs = 1.0f / sqrtf(wave_sum(s) * (1.0f / DM) + 1e-6f);
    if (xcopy) {
#pragma unroll
        for (int j = 0; j < 8; ++j) ((f32x4*)xcopy + lane)[64 * j] = v[j]; }
    unsigned long long* o8 = (unsigned long long*)orow + lane;
#pragma unroll
    for (int j = 0; j < 8; ++j) o8[64 * j] = (unsigned long long)pk2(v[j].x * rs, v[j].y * rs) | ((unsigned long long)pk2(v[j].z * rs, v[j].w * rs) << 32);
}
__device__ __forceinline__ void rms_phase(const Ctx& C, const float* X, bf16* HN, bf16* HNS) {
    const int gw = C.bid * NWAVES + C.wave, NGW = C.G * NWAVES;
    f32x4 v[8], nx[8]; int m = gw;
    if (m < MT) { const f32x4* xr = (const f32x4*)(X + (size_t)m * DM) + C.lane;
#pragma unroll
        for (int j = 0; j < 8; ++j) v[j] = xr[64 * j]; }
    for (; m < MT; m += NGW) {
        const int mn = m + NGW;
        if (mn < MT) { const f32x4* xr = (const f32x4*)(X + (size_t)mn * DM) + C.lane;
#pragma unroll
            for (int j = 0; j < 8; ++j) nx[j] = xr[64 * j]; }
        float s = 0.f;
#pragma unroll
        for (int j = 0; j < 8; ++j) s += (v[j].x * v[j].x + v[j].y * v[j].y) + (v[j].z * v[j].z + v[j].w * v[j].w);
        const float rs = 1.0f / sqrtf(wave_sum(s) * (1.0f / DM) + 1e-6f);
        unsigned long long* o8 = (unsigned long long*)((HNS && m >= MP) ? HNS + (size_t)(m - MP) * DMS : HN + (size_t)m * DM) + C.lane;
#pragma unroll
        for (int j = 0; j < 8; ++j) o8[64 * j] = (unsigned long long)pk2(v[j].x * rs, v[j].y * rs) | ((unsigned long long)pk2(v[j].z * rs, v[j].w * rs) << 32);
#pragma unroll
        for (int j = 0; j < 8; ++j) v[j] = nx[j];
    }
}
__device__ __forceinline__ void fold_split_rows(const Ctx& C, float* X, const float* S) {
    const int gw = C.bid * NWAVES + C.wave, NGW = C.G * NWAVES;
    for (int r = gw; r < NS; r += NGW) { f32x4* xr = (f32x4*)(X + (size_t)(MP + r) * DM) + C.lane; const f32x4* s0 = (const f32x4*)(S + (size_t)r * DM) + C.lane; const f32x4* s1 = (const f32x4*)(S + (size_t)(NS + r) * DM) + C.lane;
#pragma unroll
        for (int j = 0; j < 8; ++j) xr[64 * j] = xr[64 * j] + (s0[64 * j] + s1[64 * j]); }
    asm volatile("s_waitcnt vmcnt(0)" ::: "memory");
}
__device__ __forceinline__ void final_norm_phase(const Ctx& C, const float* X, const float* g, float* out) {
    const int gw = C.bid * NWAVES + C.wave, NGW = C.G * NWAVES;
    for (int m = gw; m < MT; m += NGW) {
        const f32x4* xr = (const f32x4*)(X + (size_t)m * DM) + C.lane; const f32x4* gr = (const f32x4*)g + C.lane;
        f32x4 v[8]; float s = 0.f;
#pragma unroll
        for (int j = 0; j < 8; ++j) { v[j] = xr[64 * j]; s += (v[j].x * v[j].x + v[j].y * v[j].y) + (v[j].z * v[j].z + v[j].w * v[j].w); }
        const float rs = 1.0f / sqrtf(wave_sum(s) * (1.0f / DM) + 1e-6f);
        f32x4* orow = (f32x4*)(out + (size_t)m * DM) + C.lane;
#pragma unroll
        for (int j = 0; j < 8; ++j) orow[64 * j] = v[j] * rs * gr[64 * j];
    }
}
#ifndef LATE_EXTRA
#define LATE_EXTRA 0
#endif
struct TDesc { const float* W; const float* gain; bf16* WT; int K, N, ldk, row_off, item; };
__device__ __forceinline__ TDesc p0_desc(const Ax& a, int it, int G) {
    constexpr int I_IN = 32 * 100, I_SQ = 32 * 32, I_UP = 32 * 128, I_DN = 128 * 32, I_L64 = 8, I_L128 = 16;
    constexpr int PER_LAYER = I_IN + 5 * I_SQ + I_UP + I_DN + 2 * I_L64 + I_L128;
    const int l = it / PER_LAYER; int r = it - l * PER_LAYER; unsigned char* wl = a.ws + WS_WL + (size_t)l * LW_STRIDE; bf16* wkv = (bf16*)(a.ws + WS_WKV);
    TDesc d; d.row_off = 0; d.gain = nullptr; const bool late = G == 256 && DEPTH == 2, late1 = late && l == 1 && LATE_EXTRA;
    if (r < I_IN) { d.W = a.in(I_WIN) + (size_t)l * DM * PIN; d.K = DM; d.N = PIN; d.WT = (bf16*)(wl + LW_IN); d.ldk = -PIN; d.gain = a.in(I_GMIX) + l * DM; d.item = r; return d; } r -= I_IN;
    if (r < I_SQ) { d.W = a.in(I_WOUT) + (size_t)l * DM * DM; d.K = DM; d.N = DM; d.WT = (bf16*)(wl + LW_OUT); d.ldk = -DM; d.item = late1 ? -1 : r; return d; } r -= I_SQ;
    if (r < I_SQ) { d.W = a.in(I_WQ) + (size_t)l * DM * DM; d.K = DM; d.N = DM; d.WT = (bf16*)(wl + LW_Q); d.ldk = -DM; d.gain = a.in(I_GXA) + l * DM; d.item = late1 ? -1 : r; return d; } r -= I_SQ;
    if (r < I_SQ) { d.W = a.in(I_WO) + (size_t)l * DM * DM; d.K = DM; d.N = DM; d.WT = (bf16*)(wl + LW_O); d.ldk = -DM; d.item = late1 ? -1 : r; return d; } r -= I_SQ;
    if (r < I_SQ) { d.W = a.in(I_WK) + (size_t)l * DM * DM; d.K = DM; d.N = DM; d.WT = wkv; d.ldk = -8192; d.row_off = l * 4096; d.gain = a.in(I_GMEM) + l * DM; d.item = late1 ? -1 : r; return d; } r -= I_SQ;
    if (r < I_SQ) { d.W = a.in(I_WV) + (size_t)l * DM * DM; d.K = DM; d.N = DM; d.WT = wkv; d.ldk = -8192; d.row_off = l * 4096 + 2048; d.gain = a.in(I_GMEM) + l * DM; d.item = late1 ? -1 : r; return d; } r -= I_SQ;
    if (r < I_UP) { d.W = a.in(I_WUP) + (size_t)l * DM * DFF; d.K = DM; d.N = DFF; d.WT = (bf16*)(wl + LW_UP); d.ldk = -DFF; d.gain = a.in(I_GMLP) + l * DM; d.item = late ? -1 : r; return d; } r -= I_UP;
    if (r < I_DN) { d.W = a.in(I_WDN) + (size_t)l * DFF * DM; d.K = DFF; d.N = DM; d.WT = (bf16*)(wl + LW_DN); d.ldk = -DM; d.item = late ? -1 : r; return d; } r -= I_DN;
    if (r < I_L64) { d.W = a.in(I_W2) + (size_t)l * 64 * 512; d.K = 64; d.N = 512; d.WT = (bf16*)(wl + LW_W2); d.ldk = 64; d.item = r; return d; } r -= I_L64;
    if (r < I_L64) { d.W = a.in(I_A2) + (size_t)l * 64 * 512; d.K = 64; d.N = 512; d.WT = (bf16*)(wl + LW_A2); d.ldk = 64; d.item = r; return d; } r -= I_L64;
    d.W = a.in(I_G2) + (size_t)l * 128 * 512; d.K = 128; d.N = 512; d.WT = (bf16*)(wl + LW_G2); d.ldk = 128; d.item = r; return d;
}
__device__ __forceinline__ void p0_load(const TDesc& d, int lane, f32x4 (&v)[16], float (&g)[16]) {
    if (d.item < 0) return;
    const int nblk = d.N / 64, kb = d.item / nblk, nb = d.item - kb * nblk, k0 = 64 * kb, n0 = 64 * nb, lr = lane >> 4, lc = (lane & 15) * 4;
#pragma unroll
    for (int i = 0; i < 16; ++i) { const int kk = 4 * i + lr; g[i] = d.gain ? d.gain[k0 + kk] : 1.0f; v[i] = __builtin_nontemporal_load((const f32x4*)(d.W + (size_t)(k0 + kk) * d.N + n0 + lc)); }
}
__device__ __forceinline__ void p0_finish(const TDesc& d, LAS float* scr, int lane, const f32x4 (&v)[16], const float (&g)[16]) {
    if (d.item < 0) return;
    const int nblk = d.N / 64, kb = d.item / nblk, nb = d.item - kb * nblk, k0 = 64 * kb, n0 = 64 * nb, lr = lane >> 4, lc = (lane & 15) * 4;
#pragma unroll
    for (int i = 0; i < 16; ++i) { const int kk = 4 * i + lr; LAS float* p = scr + kk * 65 + lc; p[0] = v[i].x * g[i]; p[1] = v[i].y * g[i]; p[2] = v[i].z * g[i]; p[3] = v[i].w * g[i]; }
    LDS_WAIT(); asm volatile("" ::: "memory");
    const int c = lane & 7;
#pragma unroll
    for (int j = 0; j < 8; ++j) { const int n = (lane >> 3) + 8 * j; const LAS float* s = scr + (8 * c) * 65 + n;
        v4u o; o.x = pk2(s[0 * 65], s[1 * 65]); o.y = pk2(s[2 * 65], s[3 * 65]); o.z = pk2(s[4 * 65], s[5 * 65]); o.w = pk2(s[6 * 65], s[7 * 65]);
        if (d.ldk > 0) *(v4u*)(d.WT + (size_t)(d.row_off + n0 + n) * d.ldk + k0 + 8 * c) = o;
        else *(v4u*)(d.WT + ((size_t)kb * (size_t)(-d.ldk) + d.row_off + n0 + n) * 64 + 8 * c) = o; }
    LDS_WAIT(); asm volatile("" ::: "memory");
}
__device__ __forceinline__ void p0_prologue(const Ctx& C, const Ax& a) {
    LAS float* scr = (LAS float*)(C.lds + C.wave * 16640);
    const int gw = C.bid * NWAVES + C.wave, NGW = C.G * NWAVES;
    constexpr int I_IN = 32 * 100, I_SQ = 32 * 32, I_UP = 32 * 128, I_DN = 128 * 32, I_L64 = 8, I_L128 = 16;
    constexpr int PER_LAYER = I_IN + 5 * I_SQ + I_UP + I_DN + 2 * I_L64 + I_L128;
    TDesc cur = p0_desc(a, gw, C.G), nxt; f32x4 va[16], vb[16]; float ga[16], gb[16];
    const int NITEMS = DEPTH * PER_LAYER;
    if (gw < NITEMS) p0_load(cur, C.lane, va, ga);
    for (int it = gw; it < NITEMS; it += 2 * NGW) {
        const int it1 = it + NGW, it2 = it + 2 * NGW;
        if (it1 < NITEMS) { nxt = p0_desc(a, it1, C.G); p0_load(nxt, C.lane, vb, gb); }
        p0_finish(cur, scr, C.lane, va, ga);
        if (it1 < NITEMS) { if (it2 < NITEMS) { cur = p0_desc(a, it2, C.G); p0_load(cur, C.lane, va, ga); }
            p0_finish(nxt, scr, C.lane, vb, gb); }
    }
    { float* cs = (float*)(a.ws + WS_ROPE); const int gt = C.bid * (NWAVES * 64) + C.tid, NT = C.G * NWAVES * 64;
      for (int idx = gt; idx < 2049 * 64; idx += NT) { const int p = idx >> 6, i = idx & 63; const double pos = (p == 2048) ? 16384.0 : (double)p;
          const double inv = exp(-(double)i * (9.210340371976184 / 64.0)); double r = pos * inv; r -= 6.283185307179586 * rint(r * 0.15915494309189535);
          cs[2 * idx] = (float)cos(r); cs[2 * idx + 1] = (float)sin(r); } }
    float* XF = (float*)(a.ws + WS_XF); bf16* HN = (bf16*)(a.ws + WS_HN); bf16* MN = (bf16*)(a.ws + WS_MN);
    for (int m = gw; m < MT; m += NGW) { const float* src = (m < MP) ? a.in(I_XP) + (size_t)m * DM : a.in(I_XS) + (size_t)(m - MP) * DM; rms_row(src, HN + (size_t)m * DM, nullptr, C.lane); }
    for (int m = gw; m < MMEM; m += NGW) rms_row(a.in(I_MEM) + (size_t)m * DM, MN + (size_t)m * DM, nullptr, C.lane);
}

__device__ __forceinline__ TDesc lc_desc(const Ax& a, int l, int it) {
    constexpr int I_UP = 32 * 128, I_DN = 128 * 32, I_SQ = 32 * 32;
    unsigned char* wl = a.ws + WS_WL + (size_t)l * LW_STRIDE; TDesc d; d.row_off = 0; d.gain = nullptr;
    if (it < I_UP) { d.W = a.in(I_WUP) + (size_t)l * DM * DFF; d.K = DM; d.N = DFF; d.WT = (bf16*)(wl + LW_UP); d.ldk = -DFF; d.gain = a.in(I_GMLP) + l * DM; d.item = it; return d; }
    int r = it - I_UP;
    if (r < I_DN) { d.W = a.in(I_WDN) + (size_t)l * DFF * DM; d.K = DFF; d.N = DM; d.WT = (bf16*)(wl + LW_DN); d.ldk = -DM; d.item = r; return d; } r -= I_DN;
    d.K = DM; d.N = DM; d.item = r & (I_SQ - 1); const int q = r >> 10;
    if (l == 0) { const int l1 = 1; d.W = a.in(q == 0 ? I_WK : I_WV) + (size_t)l1 * DM * DM; d.WT = (bf16*)(a.ws + WS_WKV); d.ldk = -8192; d.row_off = l1 * 4096 + q * 2048; d.gain = a.in(I_GMEM) + l1 * DM; return d; }
    d.ldk = -DM;
    if (q == 0) { d.W = a.in(I_WOUT) + (size_t)l * DM * DM; d.WT = (bf16*)(wl + LW_OUT); }
    else if (q == 1) { d.W = a.in(I_WQ) + (size_t)l * DM * DM; d.WT = (bf16*)(wl + LW_Q); d.gain = a.in(I_GXA) + l * DM; }
    else { d.W = a.in(I_WO) + (size_t)l * DM * DM; d.WT = (bf16*)(wl + LW_O); }
    return d;
}
__device__ __forceinline__ void late_convert(const Ctx& C, const Ax& a, int l, int rank, int nrank) {
    LAS float* scr = (LAS float*)(C.lds + C.wave * 16640);
    const int NITEMS = 32 * 128 + 128 * 32 + (LATE_EXTRA ? (l == 0 ? 2 : 3) * 1024 : 0);
    const int gw = rank * NWAVES + C.wave, NGW = nrank * NWAVES;
    TDesc cur, nxt; f32x4 va[16], vb[16]; float ga[16], gb[16];
    if (gw < NITEMS) { cur = lc_desc(a, l, gw); p0_load(cur, C.lane, va, ga); }
    for (int it = gw; it < NITEMS; it += 2 * NGW) {
        const int it1 = it + NGW, it2 = it + 2 * NGW;
        if (it1 < NITEMS) { nxt = lc_desc(a, l, it1); p0_load(nxt, C.lane, vb, gb); }
        p0_finish(cur, scr, C.lane, va, ga);
        if (it1 < NITEMS) { if (it2 < NITEMS) { cur = lc_desc(a, l, it2); p0_load(cur, C.lane, va, ga); }
            p0_finish(nxt, scr, C.lane, vb, gb); }
    }
}
__device__ __forceinline__ void ad_prompt_item(const Ctx& C, const Ax& a, int l, int item) {
    const bf16* P = (const bf16*)(a.ws + WS_P); bf16* YC = (bf16*)(a.ws + WS_YC);
    const int b = item >> 6, t0 = (item & 63) * 32; const size_t rbase = (size_t)b * SEQ;
    LAS float* UD = (LAS float*)C.lds;
#pragma unroll 4
    for (int it = C.tid; it < 62 * 64; it += NWAVES * 64) { const int r = it >> 6, cc = it & 63, t = t0 - 30 + r;
        float u[8];
        if (t >= 0) { const bf16* pr = P + (rbase + t) * PIN + PD_ + cc * 8; float d1[8], d2[8]; unpack8(*(const v4u*)pr, d1); unpack8(*(const v4u*)(pr + 512), d2);
#pragma unroll
            for (int j = 0; j < 8; ++j) u[j] = d1[j] * sigm(d2[j]); }
        else {
#pragma unroll
            for (int j = 0; j < 8; ++j) u[j] = 0.f; }
        *(LAS f32x4*)(UD + r * 512 + cc * 8) = (f32x4){u[0], u[1], u[2], u[3]}; *(LAS f32x4*)(UD + r * 512 + cc * 8 + 4) = (f32x4){u[4], u[5], u[6], u[7]}; }
    { const float* cw = a.in(I_CAW) + (size_t)l * 3 * 512;
#pragma unroll 2
      for (int it = C.tid; it < 32 * 64; it += NWAVES * 64) { const int r = it >> 6, cc = it & 63, t = t0 + r; const bf16* pr = P + (rbase + t) * PIN + cc * 8;
        float ab[8], u0[8], u1[8], u2[8], x[8], y[8];
        unpack8(*(const v4u*)pr, ab); unpack8(*(const v4u*)(pr + 512), x); unpack8(*(const v4u*)(pr + 1024), y);
#pragma unroll
        for (int j = 0; j < 8; ++j) u2[j] = x[j] * y[j];
        if (t >= 1) { unpack8(*(const v4u*)(pr - PIN + 512), x); unpack8(*(const v4u*)(pr - PIN + 1024), y);
#pragma unroll
            for (int j = 0; j < 8; ++j) u1[j] = x[j] * y[j]; }
        else {
#pragma unroll
            for (int j = 0; j < 8; ++j) u1[j] = 0.f; }
        if (t >= 2) { unpack8(*(const v4u*)(pr - 2 * PIN + 512), x); unpack8(*(const v4u*)(pr - 2 * PIN + 1024), y);
#pragma unroll
            for (int j = 0; j < 8; ++j) u0[j] = x[j] * y[j]; }
        else {
#pragma unroll
            for (int j = 0; j < 8; ++j) u0[j] = 0.f; }
        float o[8];
#pragma unroll
        for (int j = 0; j < 8; ++j) { const int c = cc * 8 + j; o[j] = ab[j] * (cw[c] * u0[j] + cw[512 + c] * u1[j] + cw[1024 + c] * u2[j]); }
        *(v4u*)(YC + (rbase + t) * DM + cc * 8) = pack8(o);
        if (t >= SEQ - 2) { float* st = a.out + O_CAP + (((size_t)l * NB + b) * 2 + (t - (SEQ - 2))) * 512 + cc * 8; *(f32x4*)st = (f32x4){u2[0], u2[1], u2[2], u2[3]}; *(f32x4*)(st + 4) = (f32x4){u2[4], u2[5], u2[6], u2[7]}; } } }
    __syncthreads();
    const int c = C.tid;
    if (t0 == SEQ - 32) { float* st = a.out + O_CDP + ((size_t)l * NB + b) * 30 * 512 + c;
        for (int j = 0; j < 30; ++j) st[(size_t)j * 512] = UD[(32 + j) * 512 + c]; }
    float cv[32];
    { const char* cwb = (const char*)(a.in(I_CDW) + (size_t)l * 31 * 512); const unsigned cof = (unsigned)c * 4u; const float bias = a.in(I_CDB)[l * 512 + c];
      float wt[31];
#pragma unroll
      for (int j = 0; j < 31; ++j) wt[j] = *(const float*)(cwb + (cof + (unsigned)j * 2048u));
      __builtin_amdgcn_sched_barrier(0);
#pragma unroll
      for (int t = 0; t < 32; ++t) cv[t] = bias;
#pragma unroll
      for (int r = 0; r < 62; ++r) { const float ur = UD[r * 512 + c];
#pragma unroll
          for (int t = 0; t < 32; ++t) { const int j = r - t; if (j >= 0 && j < 31) cv[t] += wt[j] * ur; } } }
    __syncthreads();
#pragma unroll
    for (int t = 0; t < 32; ++t) UD[t * 512 + c] = cv[t];
    __syncthreads();
    { const float* lg = a.in(I_LNDG) + l * 512 + C.lane * 8; const float* lb = a.in(I_LNDB) + l * 512 + C.lane * 8;
      const f32x4 g0 = *(const f32x4*)lg, g1 = *(const f32x4*)(lg + 4), b0 = *(const f32x4*)lb, b1 = *(const f32x4*)(lb + 4);
#pragma unroll
      for (int q = 0; q < 4; ++q) { const int t = C.wave * 4 + q; const f32x4 x0 = *(LAS f32x4*)(UD + t * 512 + C.lane * 8), x1 = *(LAS f32x4*)(UD + t * 512 + C.lane * 8 + 4);
        const float mu = wave_sum((x0.x + x0.y) + (x0.z + x0.w) + (x1.x + x1.y) + (x1.z + x1.w)) * (1.0f / 512.0f);
        const f32x4 d0 = x0 - mu, d1 = x1 - mu;
        const float var = wave_sum((d0.x * d0.x + d0.y * d0.y) + (d0.z * d0.z + d0.w * d0.w) + (d1.x * d1.x + d1.y * d1.y) + (d1.z * d1.z + d1.w * d1.w)) * (1.0f / 512.0f);
        const float rstd = 1.0f / sqrtf(var + 1e-6f);
        const f32x4 y0 = d0 * rstd * g0 + b0, y1 = d1 * rstd * g1 + b1; float o[8];
        o[0] = y0.x * sigm(y0.x); o[1] = y0.y * sigm(y0.y); o[2] = y0.z * sigm(y0.z); o[3] = y0.w * sigm(y0.w);
        o[4] = y1.x * sigm(y1.x); o[5] = y1.y * sigm(y1.y); o[6] = y1.z * sigm(y1.z); o[7] = y1.w * sigm(y1.w);
        *(v4u*)(YC + (rbase + t0 + t) * DM + 1536 + C.lane * 8) = pack8(o); } }
    __syncthreads();
}
__device__ __forceinline__ void ad_sample_item(const Ctx& C, const Ax& a, int l, int n) {
    const bf16* P = (const bf16*)(a.ws + WS_P); bf16* YC = (bf16*)(a.ws + WS_YC);
    const int c = C.tid; const bf16* pr = P + (size_t)(MP + n) * PIN;
    LAS float* red = (LAS float*)C.lds;
    { const float* st = a.in(I_SCA) + (((size_t)l * NS + n) * 2) * 512 + c; const float s0 = st[0], s1 = st[512];
      const float ua = bf1(pr[512 + c]) * bf1(pr[1024 + c]); const float* cw = a.in(I_CAW) + (size_t)l * 3 * 512 + c;
      const float y = bf1(pr[c]) * (cw[0] * s0 + cw[512] * s1 + cw[1024] * ua);
      YC[(size_t)(MP + n) * DM + c] = (bf16)(pk2(y, 0.f) & 0xffffu);
      float* o = a.out + O_CAS + (((size_t)l * NS + n) * 2) * 512 + c; o[0] = s1; o[512] = ua; }
    const float* st = a.in(I_SCD) + (((size_t)l * NS + n) * 30) * 512 + c; const float* cw = a.in(I_CDW) + (size_t)l * 31 * 512 + c;
    const float ud = bf1(pr[PD_ + c]) * sigm(bf1(pr[PD_ + 512 + c]));
    float cv = a.in(I_CDB)[l * 512 + c] + cw[30 * 512] * ud;
    float* os = a.out + O_CDS + (((size_t)l * NS + n) * 30) * 512 + c;
#pragma unroll 6
    for (int j = 0; j < 30; ++j) { const float s = st[(size_t)j * 512]; cv += cw[(size_t)j * 512] * s; if (j > 0) os[(size_t)(j - 1) * 512] = s; }
    os[29 * 512] = ud;
    float s = wave_sum(cv); if (C.lane == 0) red[C.wave] = s; __syncthreads();
    float mu = 0.f;
#pragma unroll
    for (int w = 0; w < 8; ++w) mu += red[w];
    mu *= (1.0f / 512.0f); const float d = cv - mu;
    s = wave_sum(d * d); if (C.lane == 0) red[8 + C.wave] = s; __syncthreads();
    float var = 0.f;
#pragma unroll
    for (int w = 0; w < 8; ++w) var += red[8 + w];
    const float rstd = 1.0f / sqrtf(var * (1.0f / 512.0f) + 1e-6f);
    const float y = d * rstd * a.in(I_LNDG)[l * 512 + c] + a.in(I_LNDB)[l * 512 + c];
    YC[(size_t)(MP + n) * DM + 1536 + c] = (bf16)(pk2(y * sigm(y), 0.f) & 0xffffu);
    __syncthreads();
}

__device__ __forceinline__ void shift8(const bf16* cur, const bf16* prevb, const float* prevf, const float* mu, float (&xs)[8]) {
    float pc[8], pv[8]; unpack8(*(const v4u*)cur, pc);
    if (prevb) unpack8(*(const v4u*)prevb, pv);
    else if (prevf) { const f32x4 p0 = *(const f32x4*)prevf, p1 = *(const f32x4*)(prevf + 4); pv[0] = p0.x; pv[1] = p0.y; pv[2] = p0.z; pv[3] = p0.w; pv[4] = p1.x; pv[5] = p1.y; pv[6] = p1.z; pv[7] = p1.w; }
    else {
#pragma unroll
        for (int j = 0; j < 8; ++j) pv[j] = 0.f; }
    const f32x4 m0 = *(const f32x4*)mu, m1 = *(const f32x4*)(mu + 4); const float m[8] = {m0.x, m0.y, m0.z, m0.w, m1.x, m1.y, m1.z, m1.w};
#pragma unroll
    for (int j = 0; j < 8; ++j) xs[j] = pc[j] + (pv[j] - pc[j]) * m[j];
}
__device__ __forceinline__ void shift4(const bf16* cur, const bf16* prevb, const float* prevf, const float* mu, float (&xs)[4]) {
    float pc[4], pv[4]; unpack4(*(const v2u*)cur, pc);
    if (prevb) unpack4(*(const v2u*)prevb, pv);
    else if (prevf) { const f32x4 p0 = *(const f32x4*)prevf; pv[0] = p0.x; pv[1] = p0.y; pv[2] = p0.z; pv[3] = p0.w; }
    else { pv[0] = pv[1] = pv[2] = pv[3] = 0.f; }
    const f32x4 m0 = *(const f32x4*)mu;
    xs[0] = pc[0] + (pv[0] - pc[0]) * m0.x; xs[1] = pc[1] + (pv[1] - pc[1]) * m0.y; xs[2] = pc[2] + (pv[2] - pc[2]) * m0.z; xs[3] = pc[3] + (pv[3] - pc[3]) * m0.w;
}
constexpr int PTS = 1544;
__device__ __forceinline__ void shift4_lds(const LAS bf16* cur, const float* mu, float (&xs)[4]) {
    float pc[4], pv[4]; unpack4(*(const LAS v2u*)cur, pc); unpack4(*(const LAS v2u*)(cur - PTS), pv);
    const f32x4 m0 = *(const f32x4*)mu;
    xs[0] = pc[0] + (pv[0] - pc[0]) * m0.x; xs[1] = pc[1] + (pv[1] - pc[1]) * m0.y; xs[2] = pc[2] + (pv[2] - pc[2]) * m0.z; xs[3] = pc[3] + (pv[3] - pc[3]) * m0.w;
}
constexpr int RWB = 896, RW_KK = 256, RW_KB = 384, RW_K = 512, RW_R = 640, RW_V = 768;
__device__ __forceinline__ void rw_st4(unsigned char* rec, int off, int cl, const f32x4 v) { v2u w; w.x = pk2(v[0], v[1]); w.y = pk2(v[2], v[3]); *(v2u*)(rec + off + cl * 2) = w; }
__device__ __forceinline__ f32x4 rw_ld4(const unsigned char* rec, int off, int cl) { float f[4]; unpack4(*(const v2u*)(rec + off + cl * 2), f); return (f32x4){f[0], f[1], f[2], f[3]}; }
#ifndef DUP_SUB
#define DUP_SUB 0u
#endif
#define PREP_REP(k) for (int prep_rep_ = 0; prep_rep_ < 1 + (int)((DUP_SUB >> (k)) & 1u); ++prep_rep_)
__device__ __forceinline__ void rwkv_prep_item(const Ctx& C, const Ax& a, int l, int item) {
    const bf16* P = (const bf16*)(a.ws + WS_P); float* RW = (float*)(a.ws + WS_RW); float* GATE = (float*)(a.ws + WS_GATE);
    const bool smp = item >= 256; const int row0 = smp ? MP + (item - 256) * 32 : (item >> 6) * SEQ + (item & 63) * 32; const int t0 = smp ? 0 : (item & 63) * 32;
    const float* mu = a.in(I_MU) + (size_t)l * SHW; const float* sst = a.in(I_SSH) + (size_t)l * NS * SHW;
    LAS bf16* AW = (LAS bf16*)C.lds; LAS bf16* AA = AW + 32 * 72; LAS bf16* AG = AA + 32 * 72; LAS bf16* PT = AG + 32 * 136;
    for (int it = C.tid; it < 32 * 32; it += NWAVES * 64) { const int r = it >> 5, cc = it & 31, col = 1536 + cc * 8, row = row0 + r; const bf16* cur = P + (size_t)row * PIN + PC_ + col;
        float xs[8];
        if (smp) shift8(cur, nullptr, sst + (size_t)(row - MP) * SHW + col, mu + col, xs);
        else shift8(cur, (t0 + r > 0) ? cur - PIN : nullptr, nullptr, mu + col, xs);
        if (cc < 8) {
#pragma unroll
            for (int j = 0; j < 8; ++j) xs[j] = tanhf(xs[j]);
            *(LAS v4u*)(AW + r * 72 + cc * 8) = pack8(xs); }
        else if (cc < 16) *(LAS v4u*)(AA + r * 72 + (cc - 8) * 8) = pack8(xs);
        else {
#pragma unroll
            for (int j = 0; j < 8; ++j) xs[j] = sigm(xs[j]);
            *(LAS v4u*)(AG + r * 136 + (cc - 16) * 8) = pack8(xs); } }
    if (!smp) { for (int it = C.tid; it < 33 * 192; it += NWAVES * 64) { const int r = it / 192, cc = it - r * 192; v4u v = (v4u){0u, 0u, 0u, 0u};
            if (t0 + r > 0) v = *(const v4u*)(P + (size_t)(row0 + r - 1) * PIN + PC_ + cc * 8);
            *(LAS v4u*)(PT + r * PTS + cc * 8) = v; } }
    if (smp) { float* o = a.out + O_SHS + ((size_t)l * NS + (row0 - MP)) * SHW;
        for (int it = C.tid; it < 32 * 224; it += NWAVES * 64) { const int r = it / 224, cc = it % 224; float f[8]; unpack8(*(const v4u*)(P + (size_t)(row0 + r) * PIN + PC_ + cc * 8), f);
            float* op = o + (size_t)r * SHW + cc * 8; *(f32x4*)op = (f32x4){f[0], f[1], f[2], f[3]}; *(f32x4*)(op + 4) = (f32x4){f[4], f[5], f[6], f[7]}; } }
    else if (t0 == SEQ - 32) { float* o = a.out + O_SHP + ((size_t)l * NB + (item >> 6)) * SHW;
        for (int cc = C.tid; cc < 224; cc += NWAVES * 64) { float f[8]; unpack8(*(const v4u*)(P + (size_t)(row0 + 31) * PIN + PC_ + cc * 8), f);
            *(f32x4*)(o + cc * 8) = (f32x4){f[0], f[1], f[2], f[3]}; *(f32x4*)(o + cc * 8 + 4) = (f32x4){f[4], f[5], f[6], f[7]}; } }
    __syncthreads();
    const int h = C.wave, fr = C.lane & 15, fq = C.lane >> 4;
    const unsigned char* wl = a.ws + WS_WL + (size_t)l * LW_STRIDE;
    const bf16* W2t = (const bf16*)(wl + LW_W2); const bf16* A2t = (const bf16*)(wl + LW_A2); const bf16* G2t = (const bf16*)(wl + LW_G2);
    PREP_REP(23) { constexpr int tp = 0;
        f32x4 acc[4][2];
#pragma unroll
        for (int ct = 0; ct < 4; ++ct)
#pragma unroll
            for (int t2 = 0; t2 < 2; ++t2) acc[ct][t2] = zero4();
#pragma unroll
        for (int ks = 0; ks < 2; ++ks) { bf16x8 af[2], wf[4];
#pragma unroll
            for (int t2 = 0; t2 < 2; ++t2) af[t2] = *(const LAS bf16x8*)(AA + (tp * 32 + t2 * 16 + fr) * 72 + ks * 32 + fq * 8);
#pragma unroll
            for (int ct = 0; ct < 4; ++ct) wf[ct] = *(const bf16x8*)(A2t + (size_t)(h * 64 + ct * 16 + fr) * 64 + ks * 32 + fq * 8);
#pragma unroll
            for (int ct = 0; ct < 4; ++ct)
#pragma unroll
                for (int t2 = 0; t2 < 2; ++t2) acc[ct][t2] = __builtin_amdgcn_mfma_f32_16x16x32_bf16(wf[ct], af[t2], acc[ct][t2], 0, 0, 0); }
        const float* a0 = a.in(I_A0) + l * 512; const float* kkw = a.in(I_KK) + l * 512; const float* kaw = a.in(I_KA) + l * 512;
#pragma unroll
        for (int t2 = 0; t2 < 2; ++t2) { const int r = tp * 32 + t2 * 16 + fr, row = row0 + r; const bf16* prow = P + (size_t)row * PIN + PC_;
            const float* pf = smp ? sst + (size_t)(row - MP) * SHW : nullptr;
            float kkr[4][4], av[4][4], kc[4][4]; float ss = 0.f;
#pragma unroll
            for (int ct = 0; ct < 4; ++ct) { const int ch = h * 64 + ct * 16 + fq * 4; const f32x4 a0v = *(const f32x4*)(a0 + ch), kkv = *(const f32x4*)(kkw + ch);
                float xs[4]; if (smp) shift4(prow + 512 + ch, nullptr, pf + 512 + ch, mu + 512 + ch, xs); else shift4_lds(PT + (r + 1) * PTS + 512 + ch, mu + 512 + ch, xs);
#pragma unroll
                for (int j = 0; j < 4; ++j) { av[ct][j] = sigm(a0v[j] + acc[ct][t2][j]); kc[ct][j] = xs[j]; kkr[ct][j] = xs[j] * kkv[j]; ss += kkr[ct][j] * kkr[ct][j]; } }
            ss += __shfl_xor(ss, 16); ss += __shfl_xor(ss, 32);
            const float inv = 1.0f / fmaxf(sqrtf(ss), 1e-12f);
            unsigned char* rw = (unsigned char*)RW + ((size_t)row * 8 + h) * RWB;
#pragma unroll
            for (int ct = 0; ct < 4; ++ct) { const int ch = h * 64 + ct * 16 + fq * 4, cl = ct * 16 + fq * 4; const f32x4 kav = *(const f32x4*)(kaw + ch);
                f32x4 kk, kb, k4;
#pragma unroll
                for (int j = 0; j < 4; ++j) { kk[j] = kkr[ct][j] * inv; kb[j] = kk[j] * av[ct][j]; k4[j] = kc[ct][j] * (1.0f + (av[ct][j] - 1.0f) * kav[j]); }
                rw_st4(rw, RW_KK, cl, kk); rw_st4(rw, RW_KB, cl, kb); rw_st4(rw, RW_K, cl, k4);
                float xr[4], xv[4];
                if (smp) { shift4(prow + ch, nullptr, pf + ch, mu + ch, xr); shift4(prow + 1024 + ch, nullptr, pf + 1024 + ch, mu + 1024 + ch, xv); }
                else { shift4_lds(PT + (r + 1) * PTS + ch, mu + ch, xr); shift4_lds(PT + (r + 1) * PTS + 1024 + ch, mu + 1024 + ch, xv); }
                rw_st4(rw, RW_R, cl, (f32x4){xr[0], xr[1], xr[2], xr[3]}); rw_st4(rw, RW_V, cl, (f32x4){xv[0], xv[1], xv[2], xv[3]}); } }
    }
    PREP_REP(24) { constexpr int tp = 0;
        f32x4 acc[4][2];
#pragma unroll
        for (int ct = 0; ct < 4; ++ct)
#pragma unroll
            for (int t2 = 0; t2 < 2; ++t2) acc[ct][t2] = zero4();
#pragma unroll
        for (int ks = 0; ks < 2; ++ks) { bf16x8 af[2], wf[4];
#pragma unroll
            for (int t2 = 0; t2 < 2; ++t2) af[t2] = *(const LAS bf16x8*)(AW + (tp * 32 + t2 * 16 + fr) * 72 + ks * 32 + fq * 8);
#pragma unroll
            for (int ct = 0; ct < 4; ++ct) wf[ct] = *(const bf16x8*)(W2t + (size_t)(h * 64 + ct * 16 + fr) * 64 + ks * 32 + fq * 8);
#pragma unroll
            for (int ct = 0; ct < 4; ++ct)
#pragma unroll
                for (int t2 = 0; t2 < 2; ++t2) acc[ct][t2] = __builtin_amdgcn_mfma_f32_16x16x32_bf16(wf[ct], af[t2], acc[ct][t2], 0, 0, 0); }
        const float* w0 = a.in(I_W0) + l * 512;
#pragma unroll
        for (int t2 = 0; t2 < 2; ++t2) { const int row = row0 + tp * 32 + t2 * 16 + fr; float* rw = (float*)((unsigned char*)RW + ((size_t)row * 8 + h) * RWB);
#pragma unroll
            for (int ct = 0; ct < 4; ++ct) { const int ch = h * 64 + ct * 16 + fq * 4, cl = ct * 16 + fq * 4; const f32x4 w0v = *(const f32x4*)(w0 + ch); f32x4 d;
#pragma unroll
                for (int j = 0; j < 4; ++j) { const float z = -(w0v[j] + acc[ct][t2][j]); const float sp = fmaxf(z, 0.f) + __logf(1.0f + __expf(-fabsf(z))); const float w = -sp - 0.5f; d[j] = -__expf(w); }
                *(f32x4*)(rw + cl) = d; } }
    }
    PREP_REP(25) { constexpr int tp = 0;
        f32x4 acc[4][2];
#pragma unroll
        for (int ct = 0; ct < 4; ++ct)
#pragma unroll
            for (int t2 = 0; t2 < 2; ++t2) acc[ct][t2] = zero4();
#pragma unroll
        for (int ks = 0; ks < 4; ++ks) { bf16x8 af[2], wf[4];
#pragma unroll
            for (int t2 = 0; t2 < 2; ++t2) af[t2] = *(const LAS bf16x8*)(AG + (tp * 32 + t2 * 16 + fr) * 136 + ks * 32 + fq * 8);
#pragma unroll
            for (int ct = 0; ct < 4; ++ct) wf[ct] = *(const bf16x8*)(G2t + (size_t)(h * 64 + ct * 16 + fr) * 128 + ks * 32 + fq * 8);
#pragma unroll
            for (int ct = 0; ct < 4; ++ct)
#pragma unroll
                for (int t2 = 0; t2 < 2; ++t2) acc[ct][t2] = __builtin_amdgcn_mfma_f32_16x16x32_bf16(wf[ct], af[t2], acc[ct][t2], 0, 0, 0); }
#pragma unroll
        for (int t2 = 0; t2 < 2; ++t2) { const int row = row0 + tp * 32 + t2 * 16 + fr;
#pragma unroll
            for (int ct = 0; ct < 4; ++ct) *(f32x4*)(GATE + (size_t)row * 512 + h * 64 + ct * 16 + fq * 4) = acc[ct][t2]; }
    }
    __syncthreads();
}

#define PACK8(arr, o) ((v4u){pk2((arr)[(o)], (arr)[(o) + 1]), pk2((arr)[(o) + 2], (arr)[(o) + 3]), pk2((arr)[(o) + 4], (arr)[(o) + 5]), pk2((arr)[(o) + 6], (arr)[(o) + 7])})
constexpr int WK_LDS = 18432, WK_SHR = 6912, WK_PRV = 3072;
__device__ __forceinline__ f32x4 mfma16(bf16x4 a, bf16x4 b, f32x4 c) { return __builtin_amdgcn_mfma_f32_16x16x16bf16_1k(a, b, c, 0, 0, 0); }
__device__ __forceinline__ bf16 bfr1(float x) { return (bf16)(pk2(x, 0.f) & 0xffffu); }
__device__ __forceinline__ void wkv_chunk_witem(const Ctx& C, const Ax& a, int ci) {
    const float* RW = (const float*)(a.ws + WS_RW);
    unsigned char* CK = a.ws + WS_CK + (size_t)ci * WK_SHR; unsigned char* CP = a.ws + WS_CP + (size_t)ci * 4 * WK_PRV;
    const int bh = ci >> 7, c = ci & 127, b = bh >> 3, h = bh & 7, lane = C.lane, fr = lane & 15, fq = lane >> 4;
    LAS unsigned char* Lb = C.lds + C.wave * WK_LDS;
    LAS bf16* TA = (LAS bf16*)Lb; LAS bf16* TB = TA + 16 * 72; LAS bf16* TK = TB + 16 * 72; LAS bf16* TR = TK + 16 * 72; LAS bf16* VT = TR + 16 * 72;
    LAS float* M1 = (LAS float*)(Lb + 12288); LAS float* M2 = M1 + 320; LAS float* N1 = M2 + 320; LAS float* N2 = N1 + 320;
    LAS bf16* TG = TA; LAS bf16* PST = TK;
    const unsigned char* rw = (const unsigned char*)RW + (((size_t)b * SEQ + c * 16) * 8 + h) * RWB;
#define RWF(t) (*(const float*)(rw + (size_t)(t) * (8 * RWB) + lane * 4))
#define RWH(t, off) bf1(*(const bf16*)(rw + (size_t)(t) * (8 * RWB) + (off) + lane * 2))
    float lam[16];
#pragma unroll
    for (int t = 0; t < 16; ++t) lam[t] = RWF(t);
    __builtin_amdgcn_sched_barrier(0);
#pragma unroll
    for (int t = 1; t < 16; ++t) lam[t] += lam[t - 1];
    const float lamT = lam[15];
    ((float*)CK)[lane] = __expf(lamT);
    float Bp[16], Kp[16], al[16], ro[16];
    bf16* ATg = (bf16*)(CK + 256); bf16* OMg = (bf16*)(CK + 256 + 2304);
#define RWR(t, off) (*(const bf16*)(rw + (size_t)(t) * (8 * RWB) + (off) + lane * 2))
    bf16 wkk[4], wbb[4], wkx[4], wrr[4], wvv[4];
#pragma unroll
    for (int t = 0; t < 4; ++t) { wkk[t] = RWR(t, RW_KK); wbb[t] = RWR(t, RW_KB); wkx[t] = RWR(t, RW_K); wrr[t] = RWR(t, RW_R); wvv[t] = RWR(t, RW_V); }
    __builtin_amdgcn_sched_barrier(0);
#pragma unroll
    for (int t = 0; t < 16; ++t) { const float kk = bf1(wkk[t & 3]), bb = bf1(wbb[t & 3]), kx = bf1(wkx[t & 3]), rr = bf1(wrr[t & 3]), vv = bf1(wvv[t & 3]);
        if (t + 4 < 16) { wkk[t & 3] = RWR(t + 4, RW_KK); wbb[t & 3] = RWR(t + 4, RW_KB); wkx[t & 3] = RWR(t + 4, RW_K); wrr[t & 3] = RWR(t + 4, RW_R); wvv[t & 3] = RWR(t + 4, RW_V); }
        const float ein = __expf(-lam[t]), eprev = (t ? __expf(lam[t - 1]) : 1.0f), ecur = __expf(lam[t]), erest = __expf(lamT - lam[t]);
        al[t] = kk * eprev; ro[t] = rr * ecur; Bp[t] = bb * erest; Kp[t] = kx * erest;
        const bf16 ab = bfr1(al[t]);
        TA[t * 72 + lane] = ab; TB[t * 72 + lane] = bfr1(bb * ein); TK[t * 72 + lane] = bfr1(kx * ein); TR[t * 72 + lane] = bfr1(ro[t]); VT[lane * 24 + t] = bfr1(vv);
        ATg[t * 72 + lane] = ab;
        asm volatile("" ::: "memory"); __builtin_amdgcn_sched_barrier(0); }
    LDS_WAIT(); asm volatile("" ::: "memory");
    { f32x4 g1 = zero4(), g2 = zero4(), n1 = zero4(), n2 = zero4();
#pragma unroll
      for (int ks = 0; ks < 2; ++ks) { const int o = fr * 72 + ks * 32 + fq * 8;
        const bf16x8 bf_ = *(const LAS bf16x8*)(TB + o), kf_ = *(const LAS bf16x8*)(TK + o), af_ = *(const LAS bf16x8*)(TA + o), rf_ = *(const LAS bf16x8*)(TR + o);
        g1 = __builtin_amdgcn_mfma_f32_16x16x32_bf16(bf_, af_, g1, 0, 0, 0); g2 = __builtin_amdgcn_mfma_f32_16x16x32_bf16(kf_, af_, g2, 0, 0, 0);
        n1 = __builtin_amdgcn_mfma_f32_16x16x32_bf16(bf_, rf_, n1, 0, 0, 0); n2 = __builtin_amdgcn_mfma_f32_16x16x32_bf16(kf_, rf_, n2, 0, 0, 0); }
#pragma unroll
      for (int r = 0; r < 4; ++r) { const int s_ = 4 * fq + r, o = s_ * 20 + fr;
        M1[o] = (s_ < fr) ? g1[r] : 0.f; M2[o] = (s_ < fr) ? g2[r] : 0.f; N1[o] = (s_ <= fr) ? n1[r] : 0.f; N2[o] = (s_ <= fr) ? n2[r] : 0.f; } }
    LDS_WAIT(); asm volatile("" ::: "memory");
    __builtin_amdgcn_sched_barrier(0);
#pragma unroll
    for (int s_ = 14; s_ >= 0; --s_) { float m[16];
#pragma unroll
        for (int q = 0; q < 4; ++q) { const f32x4 v = *(const LAS f32x4*)(M1 + s_ * 20 + 4 * q); m[4 * q] = v.x; m[4 * q + 1] = v.y; m[4 * q + 2] = v.z; m[4 * q + 3] = v.w; }
        float acc = Bp[s_];
#pragma unroll
        for (int t = s_ + 1; t < 16; ++t) acc -= m[t] * Bp[t];
        asm volatile("" : "+v"(acc) :: "memory"); Bp[s_] = acc; __builtin_amdgcn_sched_barrier(0); }
#pragma unroll
    for (int s_ = 0; s_ < 15; ++s_) { float m[16];
#pragma unroll
        for (int q = 0; q < 4; ++q) { const f32x4 v = *(const LAS f32x4*)(M2 + s_ * 20 + 4 * q); m[4 * q] = v.x; m[4 * q + 1] = v.y; m[4 * q + 2] = v.z; m[4 * q + 3] = v.w; }
        float acc = Kp[s_];
#pragma unroll
        for (int t = s_ + 1; t < 16; ++t) acc -= m[t] * Bp[t];
        asm volatile("" : "+v"(acc) :: "memory"); Kp[s_] = acc; __builtin_amdgcn_sched_barrier(0); }
    __builtin_amdgcn_sched_barrier(0);
    { float ng[16];
#pragma unroll
      for (int t = 0; t < 16; ++t) ng[t] = -Bp[t];
      *(v4u*)(CK + 256 + 4608 + lane * 32) = PACK8(ng, 0); *(v4u*)(CK + 256 + 4608 + lane * 32 + 16) = PACK8(ng, 8); }
    *(LAS v4u*)(TG + lane * 24) = PACK8(Kp, 0); *(LAS v4u*)(TG + lane * 24 + 8) = PACK8(Kp, 8);
    __builtin_amdgcn_sched_barrier(0);
    { float hh[16], ps[16];
#pragma unroll
      for (int s_ = 0; s_ < 16; ++s_) { hh[s_] = N1[s_ * 20 + fr]; ps[s_] = N2[s_ * 20 + fr]; }
#pragma unroll
      for (int s_ = 14; s_ >= 0; --s_) { float m[16];
#pragma unroll
        for (int q = 0; q < 4; ++q) { const f32x4 v = *(const LAS f32x4*)(M1 + s_ * 20 + 4 * q); m[4 * q] = v.x; m[4 * q + 1] = v.y; m[4 * q + 2] = v.z; m[4 * q + 3] = v.w; }
        float acc = hh[s_];
#pragma unroll
        for (int u = s_ + 1; u < 16; ++u) acc -= m[u] * hh[u];
        asm volatile("" : "+v"(acc) :: "memory"); hh[s_] = acc; __builtin_amdgcn_sched_barrier(0); }
#pragma unroll
      for (int s_ = 0; s_ < 15; ++s_) { float m[16];
#pragma unroll
        for (int q = 0; q < 4; ++q) { const f32x4 v = *(const LAS f32x4*)(M2 + s_ * 20 + 4 * q); m[4 * q] = v.x; m[4 * q + 1] = v.y; m[4 * q + 2] = v.z; m[4 * q + 3] = v.w; }
        float acc = ps[s_];
#pragma unroll
        for (int u = s_ + 1; u < 16; ++u) acc -= m[u] * hh[u];
        asm volatile("" : "+v"(acc) :: "memory"); ps[s_] = acc; __builtin_amdgcn_sched_barrier(0); }
      LDS_WAIT(); asm volatile("" ::: "memory");
#pragma unroll
      for (int s_ = 0; s_ < 16; ++s_) N1[s_ * 20 + fr] = hh[s_];
      *(LAS v4u*)(PST + fr * 24) = PACK8(ps, 0); *(LAS v4u*)(PST + fr * 24 + 8) = PACK8(ps, 8); }
    LDS_WAIT(); asm volatile("" ::: "memory");
    __builtin_amdgcn_sched_barrier(0);
#pragma unroll
    for (int s_ = 0; s_ < 16; ++s_) { float m[16];
#pragma unroll
        for (int q = 0; q < 4; ++q) { const f32x4 v = *(const LAS f32x4*)(N1 + s_ * 20 + 4 * q); m[4 * q] = v.x; m[4 * q + 1] = v.y; m[4 * q + 2] = v.z; m[4 * q + 3] = v.w; }
#pragma unroll
        for (int t = s_; t < 16; ++t) ro[t] -= m[t] * al[s_];
        asm volatile("" ::: "memory"); __builtin_amdgcn_sched_barrier(0); }
#pragma unroll
    for (int t = 0; t < 16; ++t) OMg[t * 72 + lane] = bfr1(ro[t]);
    LDS_WAIT(); asm volatile("" ::: "memory");
    __builtin_amdgcn_sched_barrier(0);
    { bf16x4 vf[4];
#pragma unroll
      for (int it = 0; it < 4; ++it) vf[it] = *(const LAS bf16x4*)(VT + (it * 16 + fr) * 24 + fq * 4);
#pragma unroll
      for (int kt = 0; kt < 4; ++kt) { const bf16x4 gf = *(const LAS bf16x4*)(TG + (kt * 16 + fr) * 24 + fq * 4);
#pragma unroll
        for (int it = 0; it < 4; ++it) { const f32x4 d = mfma16(gf, vf[it], zero4()); v2u dw; dw.x = pk2(d[0], d[1]); dw.y = pk2(d[2], d[3]); *(v2u*)(CP + it * WK_PRV + kt * 512 + lane * 8) = dw; } }
      const bf16x4 pf = *(const LAS bf16x4*)(PST + fr * 24 + fq * 4);
#pragma unroll
      for (int it = 0; it < 4; ++it) { const f32x4 o = mfma16(pf, vf[it], zero4()); *(f32x4*)(CP + it * WK_PRV + 2048 + lane * 16) = o; } }
    LDS_WAIT(); asm volatile("" ::: "memory");
}
constexpr int WQ_CH = WK_PRV + WK_SHR, WQ_SLOT = 4 * WQ_CH, WQ_PCS = WQ_CH / 16, WQ_NWL = 4 * WQ_PCS / 64;
__device__ __forceinline__ void wkv_seq_chunk(const LAS unsigned char* sp, f32x4 (&acc)[4], float* orow, int lane, int fr, int fq) {
    const LAS unsigned char* sh = sp + WK_PRV;
    bf16x8 af[2], of[2]; bf16x4 gf[4]; f32x4 wt[4], dt[4];
#pragma unroll
    for (int s = 0; s < 2; ++s) { const LAS bf16* ap = (const LAS bf16*)(sh + 256) + fr * 72 + 32 * s + 4 * fq; const v2u lo = *(const LAS v2u*)ap, hi = *(const LAS v2u*)(ap + 16);
        af[s] = __builtin_bit_cast(bf16x8, (v4u){lo.x, lo.y, hi.x, hi.y});
        const LAS bf16* op = (const LAS bf16*)(sh + 256 + 2304) + fr * 72 + 32 * s + 4 * fq; const v2u lo2 = *(const LAS v2u*)op, hi2 = *(const LAS v2u*)(op + 16);
        of[s] = __builtin_bit_cast(bf16x8, (v4u){lo2.x, lo2.y, hi2.x, hi2.y}); }
#pragma unroll
    for (int kt = 0; kt < 4; ++kt) { gf[kt] = *(const LAS bf16x4*)((const LAS bf16*)(sh + 256 + 4608) + (kt * 16 + fr) * 16 + 4 * fq);
        wt[kt] = *(const LAS f32x4*)(sh + (16 * kt + 4 * fq) * 4); { float f_[4]; unpack4(*(const LAS v2u*)(sp + kt * 512 + lane * 8), f_); dt[kt] = (f32x4){f_[0], f_[1], f_[2], f_[3]}; } }
    const f32x4 ov = *(const LAS f32x4*)(sp + 2048 + lane * 16);
    bf16x8 sbf[2];
#pragma unroll
    for (int s = 0; s < 2; ++s) { v4u w; w.x = pk2(acc[2 * s][0], acc[2 * s][1]); w.y = pk2(acc[2 * s][2], acc[2 * s][3]); w.z = pk2(acc[2 * s + 1][0], acc[2 * s + 1][1]); w.w = pk2(acc[2 * s + 1][2], acc[2 * s + 1][3]);
        sbf[s] = __builtin_bit_cast(bf16x8, w); }
    f32x4 x = zero4();
    x = __builtin_amdgcn_mfma_f32_16x16x32_bf16(af[0], sbf[0], x, 0, 0, 0); x = __builtin_amdgcn_mfma_f32_16x16x32_bf16(af[1], sbf[1], x, 0, 0, 0);
    f32x4 o = __builtin_amdgcn_mfma_f32_16x16x32_bf16(of[0], sbf[0], ov, 0, 0, 0); o = __builtin_amdgcn_mfma_f32_16x16x32_bf16(of[1], sbf[1], o, 0, 0, 0);
    v2u xw; xw.x = pk2(x[0], x[1]); xw.y = pk2(x[2], x[3]); const bf16x4 xb = __builtin_bit_cast(bf16x4, xw);
#pragma unroll
    for (int kt = 0; kt < 4; ++kt) acc[kt] = mfma16(gf[kt], xb, acc[kt] * wt[kt] + dt[kt]);
    orow[0] = o[0]; orow[512] = o[1]; orow[1024] = o[2]; orow[1536] = o[3];
}
__device__ __forceinline__ void wkv_seq_item(const Ctx& C, const Ax& a, int l, int item) {
    const int bh = item >> 2, rg = item & 3, b = bh >> 3, h = bh & 7, lane = C.lane, fr = lane & 15, fq = lane >> 4;
    const unsigned char* CK = a.ws + WS_CK + (size_t)bh * 128 * WK_SHR; const unsigned char* CP = a.ws + WS_CP + ((size_t)bh * 128 * 4 + rg) * WK_PRV;
    float* OC = (float*)(a.ws + WS_OC) + ((size_t)b * SEQ) * 512 + h * 64 + rg * 16 + fr;
#define WQ_COMPUTE(blk) do { const LAS unsigned char* sbp = C.lds + ((blk) % 3) * WQ_SLOT; \
            _Pragma("unroll 2") for (int cq = 0; cq < 4; ++cq) wkv_seq_chunk(sbp + cq * WQ_CH, acc, OC + (size_t)(((blk) * 4 + cq) * 16 + 4 * fq) * 512, lane, fr, fq); } while (0)
    static_assert(4 * WQ_PCS == WQ_NWL * 64 && WQ_NWL > 35 && WQ_NWL <= 42 && 3 * WQ_SLOT <= SCR_BYTES, "ring geometry");
    if (C.wave == 0) {
        f32x4 acc[4];
#pragma unroll
        for (int kt = 0; kt < 4; ++kt) acc[kt] = zero4();
        __builtin_amdgcn_s_barrier(); asm volatile("" ::: "memory");
        for (int blk = 0; blk < 32; ++blk) { WQ_COMPUTE(blk); asm volatile("s_waitcnt lgkmcnt(0)" ::: "memory"); __builtin_amdgcn_s_barrier(); asm volatile("" ::: "memory"); }
        float* so = a.out + O_WKVP + ((((size_t)l * NB + b) * 8 + h) * 64 + rg * 16 + fr) * 64 + 4 * fq;
#pragma unroll
        for (int kt = 0; kt < 4; ++kt) *(f32x4*)(so + 16 * kt) = acc[kt];
    } else {
        const int w1 = C.wave - 1; const bool seven = (w1 + 35) < WQ_NWL;
        const unsigned char* wsb = a.ws; unsigned qoff[6], qstr[6];
#pragma unroll
        for (int i = 0; i < 6; ++i) { const int p = (w1 + 7 * i) * 64 + lane, cq = p / WQ_PCS, q = p - cq * WQ_PCS; const bool pr = q < WK_PRV / 16;
            qoff[i] = pr ? (unsigned)(WS_CP + ((size_t)bh * 128 * 4 + rg) * WK_PRV) + (unsigned)(cq * 4 * WK_PRV + q * 16) : (unsigned)(WS_CK + (size_t)bh * 128 * WK_SHR) + (unsigned)(cq * WK_SHR + (q - WK_PRV / 16) * 16);
            qstr[i] = pr ? (unsigned)(16 * WK_PRV) : (unsigned)(4 * WK_SHR); }
#define WQ_DMA(blk) do { _Pragma("unroll") for (int i = 0; i < 6; ++i) if (i < 5 || seven) \
            __builtin_amdgcn_global_load_lds((const unsigned*)(wsb + (qoff[i] + (unsigned)(blk) * qstr[i])), (LAS unsigned*)(C.lds + ((blk) % 3) * WQ_SLOT + (w1 + 7 * i) * 1024), 16, 0, 0); } while (0)
#define WQ_WAIT_OLDER() do { if (seven) asm volatile("s_waitcnt vmcnt(6)" ::: "memory"); else asm volatile("s_waitcnt vmcnt(5)" ::: "memory"); } while (0)
        WQ_DMA(0); WQ_DMA(1); WQ_WAIT_OLDER();
        __builtin_amdgcn_s_barrier(); asm volatile("" ::: "memory");
        for (int blk = 0; blk < 32; ++blk) {
            if (blk + 2 < 32) { WQ_DMA(blk + 2); WQ_WAIT_OLDER(); }
            else asm volatile("s_waitcnt vmcnt(0)" ::: "memory");
            __builtin_amdgcn_s_barrier(); asm volatile("" ::: "memory");
        }
#undef WQ_DMA
#undef WQ_WAIT_OLDER
    }
#undef WQ_COMPUTE
    __syncthreads();
}
__device__ __forceinline__ void rwkv_sample_witem(const Ctx& C, const Ax& a, int l, int witem) {
    const float* RW = (const float*)(a.ws + WS_RW); float* OC = (float*)(a.ws + WS_OC);
    const int n = witem >> 4, h = (witem >> 1) & 7, half = witem & 1, g = C.lane & 15, rq = C.lane >> 4;
    const unsigned char* p = (const unsigned char*)RW + ((size_t)(MP + n) * 8 + h) * RWB;
    const f32x4 lw4 = *(const f32x4*)(p + 16 * g), kk4 = rw_ld4(p, RW_KK, 4 * g), b4 = rw_ld4(p, RW_KB, 4 * g), k4 = rw_ld4(p, RW_K, 4 * g), r4 = rw_ld4(p, RW_R, 4 * g);
    const f32x4 w4 = (f32x4){__expf(lw4.x), __expf(lw4.y), __expf(lw4.z), __expf(lw4.w)};
    const float* sin_ = a.in(I_SWKV) + (((size_t)l * NS + n) * 8 + h) * 4096; float* sout = a.out + O_WKVS + (((size_t)l * NS + n) * 8 + h) * 4096;
#pragma unroll 4
    for (int it = 0; it < 8; ++it) { const int i = half * 32 + it * 4 + rq; const f32x4 S = __builtin_nontemporal_load((const f32x4*)(sin_ + i * 64 + 4 * g)); const float vi = bf1(*(const bf16*)(p + RW_V + i * 2));
        const float sa = -rowsum16((S.x * kk4.x + S.y * kk4.y) + (S.z * kk4.z + S.w * kk4.w));
        f32x4 T; T.x = S.x * w4.x + (sa * b4.x + vi * k4.x); T.y = S.y * w4.y + (sa * b4.y + vi * k4.y); T.z = S.z * w4.z + (sa * b4.z + vi * k4.z); T.w = S.w * w4.w + (sa * b4.w + vi * k4.w);
        const float o = rowsum16((T.x * r4.x + T.y * r4.y) + (T.z * r4.z + T.w * r4.w));
        __builtin_nontemporal_store(T, (f32x4*)(sout + i * 64 + 4 * g));
        if (g == 0) OC[(size_t)(MP + n) * 512 + h * 64 + i] = o; }
}
__device__ __forceinline__ void rwkv_post_phase(const Ctx& C, const Ax& a, int l) {
    const float* RW = (const float*)(a.ws + WS_RW); const float* OC = (const float*)(a.ws + WS_OC); const float* GATE = (const float*)(a.ws + WS_GATE); bf16* YC = (bf16*)(a.ws + WS_YC);
    const int gw = C.bid * NWAVES + C.wave, NGW = C.G * NWAVES, g = C.lane & 15, rq = C.lane >> 4;
    const float* lg = a.in(I_LNXG) + l * 512; const float* lb = a.in(I_LNXB) + l * 512; const float* rk = a.in(I_RK) + l * 512;
    for (int it = gw; it < MT * 8 / 4; it += NGW) { const int pair = it * 4 + rq, row = pair >> 3, h = pair & 7, ch = h * 64 + 4 * g;
        const f32x4 o = *(const f32x4*)(OC + (size_t)row * 512 + ch);
        const float mu = rowsum16((o.x + o.y) + (o.z + o.w)) * (1.0f / 64.0f); const f32x4 d = o - mu;
        const float var = rowsum16((d.x * d.x + d.y * d.y) + (d.z * d.z + d.w * d.w)) * (1.0f / 64.0f); const float rstd = 1.0f / sqrtf(var + 64e-5f);
        const unsigned char* rw = (const unsigned char*)RW + ((size_t)row * 8 + h) * RWB;
        const f32x4 k4 = rw_ld4(rw, RW_K, 4 * g), r4 = rw_ld4(rw, RW_R, 4 * g), v4 = rw_ld4(rw, RW_V, 4 * g), rkv = *(const f32x4*)(rk + ch), gv = *(const f32x4*)(GATE + (size_t)row * 512 + ch);
        const float bs = rowsum16((r4.x * k4.x * rkv.x + r4.y * k4.y * rkv.y) + (r4.z * k4.z * rkv.z + r4.w * k4.w * rkv.w));
        const f32x4 y = (d * rstd * *(const f32x4*)(lg + ch) + *(const f32x4*)(lb + ch) + bs * v4) * gv;
        v2u w; w.x = pk2(y.x, y.y); w.y = pk2(y.z, y.w); *(v2u*)(YC + (size_t)row * DM + 1024 + ch) = w; }
}

__device__ __forceinline__ float ret_lg(int h) { return log1pf(-exp2f(-5.0f - (float)h)); }
constexpr int RS = 136;
__device__ __forceinline__ void rot8(const bf16* src, const float* cs, int c8, float scale, float (&lo)[8], float (&hi)[8]) {
    float x1[8], x2[8]; unpack8(*(const v4u*)(src + c8 * 8), x1); unpack8(*(const v4u*)(src + 64 + c8 * 8), x2);
    const f32x4* cp = (const f32x4*)(cs + 16 * c8); const f32x4 t0 = cp[0], t1 = cp[1], t2 = cp[2], t3 = cp[3];
    const float cc[8] = {t0.x, t0.z, t1.x, t1.z, t2.x, t2.z, t3.x, t3.z}, sn[8] = {t0.y, t0.w, t1.y, t1.w, t2.y, t2.w, t3.y, t3.w};
#pragma unroll
    for (int j = 0; j < 8; ++j) { lo[j] = (x1[j] * cc[j] - x2[j] * sn[j]) * scale; hi[j] = (x2[j] * cc[j] + x1[j] * sn[j]) * scale; }
}
__device__ __forceinline__ void ret_pass1_item(const Ctx& C, const Ax& a, int item) {
    const bf16* P = (const bf16*)(a.ws + WS_P); const float* CS = (const float*)(a.ws + WS_ROPE); float* KVT = (float*)(a.ws + WS_KVT);
    const int b = item >> 6, h = (item >> 4) & 3, c = item & 15; const size_t row0 = (size_t)b * SEQ + c * 128; const float lg = ret_lg(h);
    LAS bf16* KT = (LAS bf16*)C.lds; LAS bf16* VT = KT + 128 * RS;
    for (int it = C.tid; it < 128 * 8; it += NWAVES * 64) { const int tt = it & 127, c8 = it >> 7; float lo[8], hi[8];
        rot8(P + (row0 + tt) * PIN + PB_ + 512 + h * 128, CS + (size_t)(c * 128 + tt) * 128, c8, 0.08838834764831845f * __expf(lg * (float)(127 - tt)), lo, hi);
#pragma unroll
        for (int j = 0; j < 8; ++j) { KT[(c8 * 8 + j) * RS + tt] = (bf16)(pk2(lo[j], 0.f) & 0xffffu); KT[(64 + c8 * 8 + j) * RS + tt] = (bf16)(pk2(hi[j], 0.f) & 0xffffu); } }
    for (int it = C.tid; it < 128 * 16; it += NWAVES * 64) { const int tt = it & 127, c8 = it >> 7; const v4u w = *(const v4u*)(P + (row0 + tt) * PIN + PB_ + 1024 + h * 128 + c8 * 8);
        const unsigned ww[4] = {w.x, w.y, w.z, w.w};
#pragma unroll
        for (int j = 0; j < 4; ++j) { VT[(c8 * 8 + 2 * j) * RS + tt] = (bf16)(ww[j] & 0xffffu); VT[(c8 * 8 + 2 * j + 1) * RS + tt] = (bf16)(ww[j] >> 16); } }
    __syncthreads();
    const int fr = C.lane & 15, fq = C.lane >> 4, w = C.wave;
    f32x4 acc[8];
#pragma unroll
    for (int et = 0; et < 8; ++et) acc[et] = zero4();
#pragma unroll
    for (int ks = 0; ks < 4; ++ks) { const bf16x8 kf = *(const LAS bf16x8*)(KT + (16 * w + fr) * RS + ks * 32 + fq * 8);
#pragma unroll
        for (int et = 0; et < 8; ++et) { const bf16x8 vf = *(const LAS bf16x8*)(VT + (16 * et + fr) * RS + ks * 32 + fq * 8); acc[et] = __builtin_amdgcn_mfma_f32_16x16x32_bf16(kf, vf, acc[et], 0, 0, 0); } }
    float* o = KVT + (size_t)item * 16384;
#pragma unroll
    for (int et = 0; et < 8; ++et) *(f32x4*)(o + (size_t)(16 * et + fr) * 128 + 16 * w + 4 * fq) = acc[et];
    __syncthreads();
}
__device__ __forceinline__ void ret_prefix_phase(const Ctx& C, const Ax& a, int l) {
    const float* KVT = (const float*)(a.ws + WS_KVT); bf16* STB = (bf16*)(a.ws + WS_STB);
    const int gt = C.bid * (NWAVES * 64) + C.tid, NT = C.G * NWAVES * 64;
    for (int idx = gt; idx < 16 * 4096; idx += NT) { const int bh = idx >> 12, r = idx & 4095, e = r >> 5, d4 = (r & 31) * 4; const int h = bh & 3;
        const float g128 = __expf(ret_lg(h) * 128.0f); const size_t base = (size_t)bh * 16 * 16384 + e * 128 + d4;
        f32x4 kv[16];
#pragma unroll
        for (int c = 0; c < 16; ++c) kv[c] = *(const f32x4*)(KVT + base + (size_t)c * 16384);
        f32x4 S = zero4();
#pragma unroll
        for (int c = 0; c < 16; ++c) { v2u w; w.x = pk2(S.x, S.y); w.y = pk2(S.z, S.w); *(v2u*)(STB + base + (size_t)c * 16384) = w; S = S * g128 + kv[c]; }
        float* o = a.out + O_RETP + ((size_t)l * 16 + bh) * 16384 + e;
        o[(size_t)d4 * 128] = S.x; o[(size_t)(d4 + 1) * 128] = S.y; o[(size_t)(d4 + 2) * 128] = S.z; o[(size_t)(d4 + 3) * 128] = S.w; }
}
__device__ __forceinline__ void ret_pass2_item(const Ctx& C, const Ax& a, int l, int item) {
    const bf16* P = (const bf16*)(a.ws + WS_P); const float* CS = (const float*)(a.ws + WS_ROPE); bf16* YC = (bf16*)(a.ws + WS_YC);
    const int b = item >> 6, h = (item >> 4) & 3, c = item & 15; const size_t row0 = (size_t)b * SEQ + c * 128; const float lg = ret_lg(h);
    LAS bf16* QL = (LAS bf16*)C.lds; LAS bf16* KL = QL + 128 * RS; LAS bf16* VT = KL + 128 * RS; LAS bf16* ST = VT + 128 * RS;
    for (int it = C.tid; it < 128 * 8; it += NWAVES * 64) { const int tt = it & 127, c8 = it >> 7; float lo[8], hi[8]; const float* cs = CS + (size_t)(c * 128 + tt) * 128;
        rot8(P + (row0 + tt) * PIN + PB_ + h * 128, cs, c8, __expf(lg * (float)(tt + 1)), lo, hi);
        *(LAS v4u*)(QL + tt * RS + c8 * 8) = pack8(lo); *(LAS v4u*)(QL + tt * RS + 64 + c8 * 8) = pack8(hi);
        rot8(P + (row0 + tt) * PIN + PB_ + 512 + h * 128, cs, c8, 0.08838834764831845f * __expf(-lg * (float)(tt + 1)), lo, hi);
        *(LAS v4u*)(KL + tt * RS + c8 * 8) = pack8(lo); *(LAS v4u*)(KL + tt * RS + 64 + c8 * 8) = pack8(hi); }
    for (int it = C.tid; it < 128 * 16; it += NWAVES * 64) { const int tt = it & 127, c8 = it >> 7; const v4u w = *(const v4u*)(P + (row0 + tt) * PIN + PB_ + 1024 + h * 128 + c8 * 8);
        const unsigned ww[4] = {w.x, w.y, w.z, w.w};
#pragma unroll
        for (int j = 0; j < 4; ++j) { VT[(c8 * 8 + 2 * j) * RS + tt] = (bf16)(ww[j] & 0xffffu); VT[(c8 * 8 + 2 * j + 1) * RS + tt] = (bf16)(ww[j] >> 16); } }
    { const bf16* stb = (const bf16*)(a.ws + WS_STB) + (size_t)item * 16384;
      for (int it = C.tid; it < 128 * 16; it += NWAVES * 64) { const int e = it >> 4, dc = it & 15; *(LAS v4u*)(ST + e * RS + dc * 8) = *(const v4u*)(stb + e * 128 + dc * 8); } }
    __syncthreads();
    const int fr = C.lane & 15, fq = C.lane >> 4, w = C.wave, i0 = 16 * w;
    bf16x8 qf[4];
#pragma unroll
    for (int ks = 0; ks < 4; ++ks) qf[ks] = *(const LAS bf16x8*)(QL + (i0 + fr) * RS + ks * 32 + fq * 8);
    f32x4 sc[8];
#pragma unroll
    for (int jt = 0; jt < 8; ++jt) { sc[jt] = zero4();
        if (jt <= w) {
#pragma unroll
            for (int ks = 0; ks < 4; ++ks) { const bf16x8 kf = *(const LAS bf16x8*)(KL + (16 * jt + fr) * RS + ks * 32 + fq * 8); sc[jt] = __builtin_amdgcn_mfma_f32_16x16x32_bf16(kf, qf[ks], sc[jt], 0, 0, 0); }
            if (jt == w) {
#pragma unroll
                for (int r = 0; r < 4; ++r) if (4 * fq + r > fr) sc[jt][r] = 0.f; } } }
    __syncthreads();
    LAS bf16* PL = KL;
#pragma unroll
    for (int jt = 0; jt < 8; ++jt) { v2u pw; pw.x = pk2(sc[jt][0], sc[jt][1]); pw.y = pk2(sc[jt][2], sc[jt][3]); *(LAS v2u*)(PL + (i0 + fr) * RS + 16 * jt + 4 * fq) = pw; }
    LDS_WAIT(); asm volatile("" ::: "memory");
    f32x4 acc[8];
#pragma unroll
    for (int et = 0; et < 8; ++et) acc[et] = zero4();
#pragma unroll
    for (int ks = 0; ks < 4; ++ks) { if (2 * ks <= w) { const bf16x8 pf = *(const LAS bf16x8*)(PL + (i0 + fr) * RS + ks * 32 + fq * 8);
#pragma unroll
            for (int et = 0; et < 8; ++et) { const bf16x8 vf = *(const LAS bf16x8*)(VT + (16 * et + fr) * RS + ks * 32 + fq * 8); acc[et] = __builtin_amdgcn_mfma_f32_16x16x32_bf16(vf, pf, acc[et], 0, 0, 0); } } }
    if (c > 0) {
#pragma unroll
        for (int ks = 0; ks < 4; ++ks)
#pragma unroll
            for (int et = 0; et < 8; ++et) { const bf16x8 sf = *(const LAS bf16x8*)(ST + (16 * et + fr) * RS + ks * 32 + fq * 8); acc[et] = __builtin_amdgcn_mfma_f32_16x16x32_bf16(sf, qf[ks], acc[et], 0, 0, 0); } }
    float s = 0.f;
#pragma unroll
    for (int et = 0; et < 8; ++et) s += (acc[et][0] + acc[et][1]) + (acc[et][2] + acc[et][3]);
    s += __shfl_xor(s, 16); s += __shfl_xor(s, 32); const float mu = s * (1.0f / 128.0f);
    float q = 0.f;
#pragma unroll
    for (int et = 0; et < 8; ++et) { acc[et] = acc[et] - mu; q += (acc[et][0] * acc[et][0] + acc[et][1] * acc[et][1]) + (acc[et][2] * acc[et][2] + acc[et][3] * acc[et][3]); }
    q += __shfl_xor(q, 16); q += __shfl_xor(q, 32); const float rstd = 1.0f / sqrtf(q * (1.0f / 128.0f) + 1e-6f);
    const size_t row = row0 + i0 + fr;
#pragma unroll
    for (int et = 0; et < 8; ++et) { const int e = 16 * et + 4 * fq; float gg[4]; unpack4(*(const v2u*)(P + row * PIN + PB_ + 1536 + h * 128 + e), gg);
        v2u wv; wv.x = pk2(gg[0] * sigm(gg[0]) * acc[et][0] * rstd, gg[1] * sigm(gg[1]) * acc[et][1] * rstd); wv.y = pk2(gg[2] * sigm(gg[2]) * acc[et][2] * rstd, gg[3] * sigm(gg[3]) * acc[et][3] * rstd);
        *(v2u*)(YC + row * DM + 512 + h * 128 + e) = wv; }
    __syncthreads();
}
__device__ __forceinline__ void ret_sample_witem(const Ctx& C, const Ax& a, int l, int witem) {
    const bf16* P = (const bf16*)(a.ws + WS_P); const float* CS = (const float*)(a.ws + WS_ROPE) + (size_t)2048 * 128; bf16* YC = (bf16*)(a.ws + WS_YC);
    const int n = witem >> 2, h = witem & 3, lane = C.lane; const float gam = 1.0f - exp2f(-5.0f - (float)h);
    LAS float* qk = (LAS float*)(C.lds + C.wave * 1024);
    const bf16* pr = P + (size_t)(MP + n) * PIN + PB_ + h * 128;
    { const float co = CS[2 * lane], si = CS[2 * lane + 1]; const float q1 = bf1(pr[lane]), q2 = bf1(pr[64 + lane]), k1 = bf1(pr[512 + lane]), k2 = bf1(pr[512 + 64 + lane]);
      qk[lane] = q1 * co - q2 * si; qk[64 + lane] = q2 * co + q1 * si; qk[128 + lane] = (k1 * co - k2 * si) * 0.08838834764831845f; qk[192 + lane] = (k2 * co + k1 * si) * 0.08838834764831845f; }
    LDS_WAIT(); asm volatile("" ::: "memory");
    const float dotp = wave_sum(qk[lane] * qk[128 + lane] + qk[64 + lane] * qk[192 + lane]);
    const int half = lane >> 5, el = lane & 31;
    float vv[4]; unpack4(*(const v2u*)(pr + 1024 + 4 * el), vv); const f32x4 v4 = (f32x4){vv[0], vv[1], vv[2], vv[3]};
    const float* sin_ = a.in(I_SRET) + (((size_t)l * NS + n) * 4 + h) * 16384; float* sout = a.out + O_RETS + (((size_t)l * NS + n) * 4 + h) * 16384;
    f32x4 oa = zero4();
#pragma unroll 8
    for (int it = 0; it < 64; ++it) { const int d = 2 * it + half; const f32x4 S = __builtin_nontemporal_load((const f32x4*)(sin_ + (size_t)d * 128 + 4 * el)); const float qd = qk[d], kd = qk[128 + d];
        oa += qd * S; __builtin_nontemporal_store(gam * S + kd * v4, (f32x4*)(sout + (size_t)d * 128 + 4 * el)); }
    oa.x += __shfl_xor(oa.x, 32); oa.y += __shfl_xor(oa.y, 32); oa.z += __shfl_xor(oa.z, 32); oa.w += __shfl_xor(oa.w, 32);
    f32x4 o = gam * oa + dotp * v4;
    float s = (o.x + o.y) + (o.z + o.w);
#pragma unroll
    for (int m = 1; m < 32; m <<= 1) s += __shfl_xor(s, m);
    const float mu = s * (1.0f / 128.0f); o = o - mu; float q = (o.x * o.x + o.y * o.y) + (o.z * o.z + o.w * o.w);
#pragma unroll
    for (int m = 1; m < 32; m <<= 1) q += __shfl_xor(q, m);
    const float rstd = 1.0f / sqrtf(q * (1.0f / 128.0f) + 1e-6f);
    if (half == 0) { float gg[4]; unpack4(*(const v2u*)(pr + 1536 + 4 * el), gg);
        v2u wv; wv.x = pk2(gg[0] * sigm(gg[0]) * o.x * rstd, gg[1] * sigm(gg[1]) * o.y * rstd); wv.y = pk2(gg[2] * sigm(gg[2]) * o.z * rstd, gg[3] * sigm(gg[3]) * o.w * rstd);
        *(v2u*)(YC + (size_t)(MP + n) * DM + 512 + h * 128 + 4 * el) = wv; }
    LDS_WAIT(); asm volatile("" ::: "memory");
}

constexpr int XV_RS = 264;
__device__ __forceinline__ void xattn_prompt_unit(const Ctx& C, const Ax& a, int l, int unit) {
    const bf16* Q = (const bf16*)(a.ws + WS_Q); const bf16* MK = (const bf16*)(a.ws + WS_MK) + (size_t)l * MMEM * DM; const bf16* MVT = (const bf16*)(a.ws + WS_MVT) + (size_t)l * MMEM * DM; bf16* O = (bf16*)(a.ws + WS_O);
    const int b = unit >> 6, h = (unit >> 4) & 3, qt = unit & 15, fr = C.lane & 15, fq = C.lane >> 4;
    const size_t row = (size_t)b * SEQ + qt * 128 + C.wave * 16 + fr;
    LAS bf16* SB = (LAS bf16*)C.lds;
    v4u st[8];
    const bf16* kbase = MK + ((size_t)b * 256) * DM + h * 512; const bf16* vbase = MVT + (((size_t)b * 4 + h) * 512) * 256;
    unsigned kof[4], vof[8], sof[8];
#pragma unroll
    for (int i = 0; i < 8; ++i) { const int idx = C.tid + 512 * i, r = idx >> 5, c16 = idx & 31; vof[i] = (unsigned)(r * 256 + c16 * 8) * 2u; sof[i] = (unsigned)(r * XV_RS + c16 * 8) * 2u; if (i < 4) kof[i] = (unsigned)(r * DM + c16 * 8) * 2u; }
    const char* kb8 = (const char*)kbase; const char* vb8 = (const char*)vbase; LAS char* sb8 = (LAS char*)SB;
#define XK_LOAD(q) do { const char* pb_ = kb8 + ((size_t)(((q) & 3) * 64) * DM + ((q) >> 2) * 256) * 2; _Pragma("unroll") for (int i = 0; i < 4; ++i) st[i] = *(const v4u*)(pb_ + kof[i]); } while (0)
#define XK_STORE() do { _Pragma("unroll") for (int i = 0; i < 4; ++i) *(LAS v4u*)(sb8 + sof[i]) = st[i]; } while (0)
#define XV_LOAD(p) do { const char* pb_ = vb8 + (size_t)((p) * 128) * 256 * 2; _Pragma("unroll") for (int i = 0; i < 8; ++i) st[i] = *(const v4u*)(pb_ + vof[i]); } while (0)
#define XV_STORE() do { _Pragma("unroll") for (int i = 0; i < 8; ++i) *(LAS v4u*)(sb8 + sof[i]) = st[i]; } while (0)
    XK_LOAD(0);
    f32x4 sc[16];
#pragma unroll
    for (int jt = 0; jt < 16; ++jt) sc[jt] = zero4();
#pragma unroll
    for (int dh = 0; dh < 2; ++dh) {
        bf16x8 qf[8];
#pragma unroll
        for (int ks = 0; ks < 8; ++ks) qf[ks] = *(const bf16x8*)(Q + row * DM + h * 512 + dh * 256 + ks * 32 + fq * 8);
#pragma unroll
        for (int p = 0; p < 4; ++p) {
            __syncthreads(); XK_STORE(); __syncthreads();
            if (dh * 4 + p < 7) XK_LOAD(dh * 4 + p + 1); else XV_LOAD(0);
#pragma unroll
            for (int j4 = 0; j4 < 4; ++j4) {
#pragma unroll
                for (int ks = 0; ks < 8; ++ks) { const bf16x8 kf = *(const LAS bf16x8*)(SB + (j4 * 16 + fr) * XV_RS + ks * 32 + fq * 8); sc[p * 4 + j4] = __builtin_amdgcn_mfma_f32_16x16x32_bf16(kf, qf[ks], sc[p * 4 + j4], 0, 0, 0); }
                __builtin_amdgcn_sched_barrier(0); }
        }
    }
    float mx = -3.0e38f;
#pragma unroll
    for (int jt = 0; jt < 16; ++jt) mx = fmaxf(mx, fmaxf(fmaxf(sc[jt][0], sc[jt][1]), fmaxf(sc[jt][2], sc[jt][3])));
    mx = fmaxf(mx, __shfl_xor(mx, 16)); mx = fmaxf(mx, __shfl_xor(mx, 32));
    const float scale = 0.04419417382415922f; float sum = 0.f;
    bf16x8 pf[8];
#pragma unroll
    for (int s = 0; s < 8; ++s) { float p[8];
#pragma unroll
        for (int j = 0; j < 4; ++j) { p[j] = __expf((sc[2 * s][j] - mx) * scale); p[4 + j] = __expf((sc[2 * s + 1][j] - mx) * scale); }
        sum += ((p[0] + p[1]) + (p[2] + p[3])) + ((p[4] + p[5]) + (p[6] + p[7]));
        const v4u w = pack8(p); pf[s] = __builtin_bit_cast(bf16x8, w); }
    sum += __shfl_xor(sum, 16); sum += __shfl_xor(sum, 32); const float inv = 1.0f / sum;
#pragma unroll
    for (int p = 0; p < 4; ++p) {
        __syncthreads(); XV_STORE(); __syncthreads();
        if (p < 3) XV_LOAD(p + 1);
#pragma unroll
        for (int et = 0; et < 8; ++et) { f32x4 s4 = zero4(); const LAS bf16* vp = SB + (et * 16 + fr) * XV_RS + 4 * fq;
#pragma unroll
            for (int s = 0; s < 8; ++s) { const v2u lo = *(const LAS v2u*)(vp + 32 * s), hi = *(const LAS v2u*)(vp + 32 * s + 16); const v4u w = (v4u){lo.x, lo.y, hi.x, hi.y};
                s4 = __builtin_amdgcn_mfma_f32_16x16x32_bf16(__builtin_bit_cast(bf16x8, w), pf[s], s4, 0, 0, 0); }
            v2u w; w.x = pk2(s4[0] * inv, s4[1] * inv); w.y = pk2(s4[2] * inv, s4[3] * inv);
            *(v2u*)(O + row * DM + h * 512 + p * 128 + et * 16 + 4 * fq) = w;
            __builtin_amdgcn_sched_barrier(0); }
    }
    __syncthreads();
#undef XK_LOAD
#undef XK_STORE
#undef XV_LOAD
#undef XV_STORE
}
__device__ __forceinline__ void xattn_sample_item(const Ctx& C, const Ax& a, int l, int item) {
    bf16* O = (bf16*)(a.ws + WS_OS);
    const int n = item >> 2, h = item & 3, lane = C.lane, w = C.wave;
    LAS float* red = (LAS float*)C.lds; LAS float* part = red + 64;
    float q[8]; { const float* s0 = (const float*)(a.ws + WS_SPL) + (size_t)n * DM + h * 512 + 4 * lane; const float* s1 = s0 + (size_t)NS * DM;
                  const f32x4 a0 = *(const f32x4*)s0 + *(const f32x4*)s1, a1 = *(const f32x4*)(s0 + 256) + *(const f32x4*)(s1 + 256);
                  q[0] = a0.x; q[1] = a0.y; q[2] = a0.z; q[3] = a0.w; q[4] = a1.x; q[5] = a1.y; q[6] = a1.z; q[7] = a1.w; }
    const size_t base = ((((size_t)l * NS + n) * 256 + 32 * w) * 4 + h) * 512 + 4 * lane;
    const float* kp = a.in(I_CMK) + base; const float* vp = a.in(I_CMV) + base;
#define XS_LOAD(buf0, buf1, ptr, k8) do { _Pragma("unroll") for (int j = 0; j < 8; ++j) { buf0[j] = __builtin_nontemporal_load((const f32x4*)((ptr) + (size_t)((k8) * 8 + j) * 2048)); buf1[j] = __builtin_nontemporal_load((const f32x4*)((ptr) + (size_t)((k8) * 8 + j) * 2048 + 256)); } } while (0)
#define XS_DOT(buf0, buf1, k8) do { _Pragma("unroll") for (int j = 0; j < 8; ++j) { float d = (buf0[j].x * q[0] + buf0[j].y * q[1]) + (buf0[j].z * q[2] + buf0[j].w * q[3]) + (buf1[j].x * q[4] + buf1[j].y * q[5]) + (buf1[j].z * q[6] + buf1[j].w * q[7]); \
        d = rowsum16(d); d += __shfl_xor(d, 16); d += __shfl_xor(d, 32); if (lane == (k8) * 8 + j) myscore = d; } } while (0)
#define XS_ACC(buf0, buf1, k8) do { _Pragma("unroll") for (int j = 0; j < 8; ++j) { const float pj = __builtin_bit_cast(float, __builtin_amdgcn_readlane(__builtin_bit_cast(int, p), (k8) * 8 + j)); o0 += pj * buf0[j]; o1 += pj * buf1[j]; } } while (0)
    float myscore = 0.f;
    f32x4 xa0[8], xa1[8], xb0[8], xb1[8];
    XS_LOAD(xa0, xa1, kp, 0);
    XS_LOAD(xb0, xb1, kp, 1); XS_DOT(xa0, xa1, 0);
    XS_LOAD(xa0, xa1, kp, 2); XS_DOT(xb0, xb1, 1);
    XS_LOAD(xb0, xb1, kp, 3); XS_DOT(xa0, xa1, 2);
    XS_LOAD(xa0, xa1, vp, 0); XS_DOT(xb0, xb1, 3);
    const float scale = 0.04419417382415922f;
    float mx = wave_max(lane < 32 ? myscore : -3.0e38f); if (lane == 0) red[w] = mx; __syncthreads();
    mx = red[0];
#pragma unroll
    for (int i = 1; i < 8; ++i) mx = fmaxf(mx, red[i]);
    const float p = lane < 32 ? __expf((myscore - mx) * scale) : 0.f;
    const float ps = wave_sum(p); if (lane == 0) red[8 + w] = ps;
    f32x4 o0 = zero4(), o1 = zero4();
    XS_LOAD(xb0, xb1, vp, 1); XS_ACC(xa0, xa1, 0);
    XS_LOAD(xa0, xa1, vp, 2); XS_ACC(xb0, xb1, 1);
    XS_LOAD(xb0, xb1, vp, 3); XS_ACC(xa0, xa1, 2);
    XS_ACC(xb0, xb1, 3);
#undef XS_LOAD
#undef XS_DOT
#undef XS_ACC
    *(LAS f32x4*)(part + w * 512 + 4 * lane) = o0; *(LAS f32x4*)(part + w * 512 + 256 + 4 * lane) = o1;
    __syncthreads();
    float tot = 0.f;
#pragma unroll
    for (int i = 0; i < 8; ++i) tot += red[8 + i];
    { const int d = C.tid; float s = 0.f;
#pragma unroll
      for (int i = 0; i < 8; ++i) s += part[i * 512 + d];
      O[(size_t)n * DMS + h * 512 + d] = (bf16)(pk2(s / tot, 0.f) & 0xffffu); }
    __syncthreads();
}

#ifndef PHASE_MASK
#define PHASE_MASK 0xffffffffu
#endif
#define PM(k) ((PHASE_MASK >> (k)) & 1u)
#ifndef DUP_SUB
#define DUP_SUB 0u
#endif
#define REP(k) for (int rep_ = 0; rep_ < 1 + (int)((DUP_SUB >> (k)) & 1u); ++rep_)
#ifndef DUP_MASK
#define DUP_MASK 0
#endif
#ifndef MK_ONE_LAUNCH
#define MK_ONE_LAUNCH 1
#endif
constexpr int PH_PER_LAYER = 14, NPH = 1 + DEPTH * PH_PER_LAYER;
__global__ void __launch_bounds__(NWAVES * 64, 2) fwd_kernel(Args args) {
    extern __shared__ __attribute__((aligned(16))) unsigned char lds_raw[];
    LAS unsigned char* const lds = (LAS unsigned char*)lds_raw;
    const int wave_s = __builtin_amdgcn_readfirstlane((int)threadIdx.x >> 6);
    volatile LAS unsigned* MISC = (volatile LAS unsigned*)(lds + MISC_OFF);
    for (int u = threadIdx.x; u < (LDS_BYTES - MISC_OFF) / 4; u += NWAVES * 64) ((LAS unsigned*)(lds + MISC_OFF))[u] = 0u;
    __syncthreads();
    XcdBarrier bar; bar.bar = (unsigned*)(args.ws + WS_CTL) + CW_BAR; bar.x = 0; bar.st = nullptr;
    if (MK_ONE_LAUNCH) bar = xcd_barrier_post((unsigned*)(args.ws + WS_CTL) + CW_BAR, MISC + 8);
    bar.wave = wave_s;
    const int lo = args.ph_lo, hi = args.ph_hi;
#define IN(k) (lo <= (k) && (k) < hi)
#define SEAM(k) do { if (MK_ONE_LAUNCH && IN((k) + 1)) xcd_barrier(bar); } while (0)
#define SEAM2(k) do { if (MK_ONE_LAUNCH && IN((k) + 2)) xcd_barrier(bar); } while (0)
#define PHASE_CTX const Ctx C = mk_ctx(lds, wave_s); const Ax a = mk_ax(); unsigned char* const ws = a.ws; const int G = C.G, bid = C.bid; (void)ws; (void)G; (void)bid; \
    float* const XF = (float*)(ws + WS_XF); bf16* const HN = (bf16*)(ws + WS_HN); bf16* const PBUF = (bf16*)(ws + WS_P); bf16* const YC = (bf16*)(ws + WS_YC); bf16* const QB = (bf16*)(ws + WS_Q); \
    bf16* const OB = (bf16*)(ws + WS_O); bf16* const UB = (bf16*)(ws + WS_U); (void)XF; (void)HN; (void)PBUF; (void)YC; (void)QB; (void)OB; (void)UB

    if (IN(0)) { PHASE_CTX; if (PM(0)) p0_prologue(C, a); SEAM(0); }

    for (int l = 0; l < DEPTH; ++l) {
        const int pb = 1 + l * PH_PER_LAYER;
        if (IN(pb + 0)) { PHASE_CTX; const unsigned char* wl = ws + WS_WL + (size_t)l * LW_STRIDE;
            if (PM(1)) { pg8::Gemm g{HN, (const bf16*)(wl + LW_IN), MPAD, PIN, DM, DM, 64, (size_t)PIN * 128}; pg8::StaticOrder S; S.init(MPAD, PIN, G, bid); pg8::EpiBf16A<0> E{PBUF, PIN, nullptr};
              pg8::gemm_phase<pg8::EpiBf16A<0>, pg8::StaticOrder, true, true>(lds, g, S, E, C.tid); }
            if (G == 256) { const int nfull = (MPAD / 256) * (PIN / 256) - 3 * G;
                if ((bid >= nfull && bid < 64) || bid >= 128) { __syncthreads(); late_convert(C, a, l, bid < 64 ? bid - nfull : bid - 128 + (64 - nfull), (64 - nfull) + (G - 128)); } }
            if (PM(2)) { pg8::Gemm g{(const bf16*)(ws + WS_MN), (const bf16*)(ws + WS_WKV) + (size_t)l * 4096 * 64, MMEM, 4096, DM, DM, 64, (size_t)8192 * 128}; pg8::StaticOrder S; S.init(MMEM, 4096, G, (bid + G - (64 % G)) % G);
              pg8::EpiMemKV E{a.out + O_MKP + (size_t)l * MMEM * DM, (bf16*)(ws + WS_MK) + (size_t)l * MMEM * DM, (bf16*)(ws + WS_MVT) + (size_t)l * MMEM * DM};
              pg8::gemm_phase<pg8::EpiMemKV, pg8::StaticOrder, true, true>(lds, g, S, E, C.tid); }
            SEAM(pb + 0);
        }
        if (IN(pb + 1)) { PHASE_CTX;
#ifdef DEBUG_P
            { const int gt = bid * 512 + C.tid, NT = G * 512;
              for (int idx = gt + (DEBUG_P == 2 ? MP * 2048 : 0); idx < (DEBUG_P == 1 ? MP : MT) * 2048; idx += NT) { const int row = idx >> 11, c = idx & 2047; const bf16* pr = PBUF + (size_t)row * PIN;
                  float s = bf1(pr[c]) + bf1(pr[c + 2048]) + bf1(pr[c + 4096]); if (c < 256) s += bf1(pr[c + 6144]); a.out[O_YP + idx] = s; } }
#endif
            if ((bid >> 3) & 1) { if (PM(8)) REP(8) for (int it = bid * NWAVES + C.wave; it < NS * 4; it += G * NWAVES) ret_sample_witem(C, a, l, it); __syncthreads(); }
            if (PM(4)) REP(4) for (int it = bid; it < 256; it += G) ad_prompt_item(C, a, l, it);
            if (PM(5)) REP(5) for (int it = bid; it < 256; it += G) ret_pass1_item(C, a, it);
            if (PM(6)) REP(6) for (int it = bid; it < 256; it += G) rwkv_prep_item(C, a, l, it);
            if (PM(6)) for (int it = bid - 64; it >= 0 && it < 4; it += G) rwkv_prep_item(C, a, l, 256 + it);
            if (PM(7)) REP(7) for (int it = G - 1 - bid; it < NS; it += G) ad_sample_item(C, a, l, it);
            if (!((bid >> 3) & 1)) { if (PM(8)) REP(8) for (int it = bid * NWAVES + C.wave; it < NS * 4; it += G * NWAVES) ret_sample_witem(C, a, l, it); }
            __syncthreads();
            SEAM(pb + 1);
        }
        if (IN(pb + 2)) { PHASE_CTX;
            if ((bid >> 3) & 1) { if (PM(10)) REP(10) for (int it = bid * NWAVES + C.wave; it < NS * 16; it += G * NWAVES) rwkv_sample_witem(C, a, l, it); }
            if (PM(9)) REP(9) for (int it = bid * NWAVES + C.wave; it < 4096; it += G * NWAVES) wkv_chunk_witem(C, a, it);
            if (!((bid >> 3) & 1)) { if (PM(10)) REP(10) for (int it = bid * NWAVES + C.wave; it < NS * 16; it += G * NWAVES) rwkv_sample_witem(C, a, l, it); }
            if (PM(11)) ret_prefix_phase(C, a, l);
            SEAM(pb + 2);
        }
        if (IN(pb + 3)) { PHASE_CTX; const int hg = G / 2;
            if (PM(22)) REP(22) for (int it = bid; it < 128; it += (bid < hg ? hg : 1 << 20)) wkv_seq_item(C, a, l, it);
            if (PM(11)) REP(11) if (bid >= hg || G < 2) for (int it = bid - hg; it < 256; it += G - hg) ret_pass2_item(C, a, l, it);
            SEAM(pb + 3);
        }
        if (IN(pb + 4)) { PHASE_CTX;
            if (PM(12)) REP(12) rwkv_post_phase(C, a, l);
            SEAM(pb + 4);
        }
        if (IN(pb + 5)) { PHASE_CTX; const unsigned char* wl = ws + WS_WL + (size_t)l * LW_STRIDE;
            pg8::Gemm g{YC, (const bf16*)(wl + LW_OUT), MP, DM, DM, DM, 64, (size_t)DM * 128}; pg8::StaticOrder S; S.init(MP, DM, G, bid); pg8::EpiRes E{XF, DM, ((DUP_MASK >> 5) & 1) ? 0.5f : 1.0f, (l == 0 && !((DUP_MASK >> 5) & 1)) ? a.in(I_XP) : (const float*)XF};
            if (PM(15)) pg8::gemm_phase<pg8::EpiRes, pg8::StaticOrder, true, true>(lds, g, S, E, C.tid);
            if (PM(20)) sample_gemm(lds, C.tid, YC + (size_t)MP * DM, DM, (const bf16*)(wl + LW_OUT), DM, DM, DM, G, bid, SEpiRes{XF + (size_t)MP * DM, DM, ((DUP_MASK >> 5) & 1) ? 0.5f : 1.0f, (l == 0 && !((DUP_MASK >> 5) & 1)) ? a.in(I_XS) : (const float*)(XF + (size_t)MP * DM)});
            SEAM(pb + 5);
        }
        if (IN(pb + 6)) { PHASE_CTX; if (PM(21)) REP(21) rms_phase(C, XF, HN, (bf16*)(ws + WS_HNS)); SEAM(pb + 6);
#ifdef XBAR_PROBE
            if (MK_ONE_LAUNCH) for (int i_ = 0; i_ < XBAR_PROBE; ++i_) xcd_barrier(bar);
#endif
        }
        if (IN(pb + 7)) { PHASE_CTX; const unsigned char* wl = ws + WS_WL + (size_t)l * LW_STRIDE;
            pg8::Gemm g{HN, (const bf16*)(wl + LW_Q), MP, DM, DM, DM, 64, (size_t)DM * 128}; pg8::StaticOrder S; S.init(MP, DM, G, bid); pg8::EpiBf16A<0> E{QB, DM, nullptr};
            if (PM(16)) REP(16) pg8::gemm_phase<pg8::EpiBf16A<0>, pg8::StaticOrder, true, true>(lds, g, S, E, C.tid);
            if (PM(20)) { sample_gemm(lds, C.tid, (const bf16*)(ws + WS_HNS), DMS, (const bf16*)(wl + LW_Q), DM, DM, DM, G, bid, SEpiPart{(float*)(ws + WS_SPL), DM}, 2); if ((DUP_SUB >> 24) & 1u) { const Ctx C2 = mk_ctx(lds, wave_s); sample_gemm(lds, C2.tid, (const bf16*)(ws + WS_HNS), DMS, (const bf16*)(wl + LW_Q), DM, DM, DM, G, bid, SEpiPart{(float*)(ws + WS_SPL), DM}, 2); } }
            SEAM(pb + 7);
        }
        if (IN(pb + 8)) { PHASE_CTX;
            { const int g3 = (bid >> 3) % 3;
              if (g3 == 0) { if (PM(13)) REP(13) for (int it = bid; it < 256; it += G) xattn_prompt_unit(C, a, l, it); }
              if (PM(14)) REP(14) for (int it = bid; it < NS * 4; it += 2 * G) xattn_sample_item(C, a, l, it);
              if (g3 == 1) { if (PM(13)) REP(13) for (int it = bid; it < 256; it += G) xattn_prompt_unit(C, a, l, it); }
              if (PM(14)) REP(14) for (int it = bid + G; it < NS * 4; it += 2 * G) xattn_sample_item(C, a, l, it);
              if (g3 == 2) { if (PM(13)) REP(13) for (int it = bid; it < 256; it += G) xattn_prompt_unit(C, a, l, it); } }
            SEAM(pb + 8);
        }
        if (IN(pb + 9)) { PHASE_CTX; const unsigned char* wl = ws + WS_WL + (size_t)l * LW_STRIDE;
            pg8::Gemm g{OB, (const bf16*)(wl + LW_O), MP, DM, DM, DM, 64, (size_t)DM * 128}; pg8::StaticOrder S; S.init(MP, DM, G, bid); pg8::EpiRes E{XF, DM, ((DUP_MASK >> 9) & 1) ? 0.5f : 1.0f, XF};
            if (PM(17)) pg8::gemm_phase<pg8::EpiRes, pg8::StaticOrder, true, true>(lds, g, S, E, C.tid);
            if (PM(20)) sample_gemm(lds, C.tid, (const bf16*)(ws + WS_OS), DMS, (const bf16*)(wl + LW_O), DM, DM, DM, G, bid, SEpiRes{XF + (size_t)MP * DM, DM, ((DUP_MASK >> 9) & 1) ? 0.5f : 1.0f, XF + (size_t)MP * DM});
            SEAM(pb + 9);
        }
        if (IN(pb + 10)) { PHASE_CTX; if (PM(21)) REP(21) rms_phase(C, XF, HN, (bf16*)(ws + WS_HNS)); SEAM(pb + 10); }
        if (IN(pb + 11)) { PHASE_CTX; const unsigned char* wl = ws + WS_WL + (size_t)l * LW_STRIDE;
            pg8::Gemm g{HN, (const bf16*)(wl + LW_UP), MP, DFF, DM, DM, 64, (size_t)DFF * 128}; pg8::StaticOrder S; S.init(MP, DFF, G, bid); pg8::EpiBf16A<3> E{UB, LDU, nullptr};
            if (PM(18)) REP(18) pg8::gemm_phase<pg8::EpiBf16A<3>, pg8::StaticOrder, true, true>(lds, g, S, E, C.tid);
            if (PM(20)) { sample_gemm(lds, C.tid, (const bf16*)(ws + WS_HNS), DMS, (const bf16*)(wl + LW_UP), DFF, DFF, DM, G, bid, SEpiBf16{(bf16*)(ws + WS_US), LDUS, 3, nullptr}); if ((DUP_SUB >> 23) & 1u) { const Ctx C2 = mk_ctx(lds, wave_s); sample_gemm(lds, C2.tid, (const bf16*)(ws + WS_HNS), DMS, (const bf16*)(wl + LW_UP), DFF, DFF, DM, G, bid, SEpiBf16{(bf16*)(ws + WS_US), LDUS, 3, nullptr}); } }
            SEAM(pb + 11);
        }
        if (IN(pb + 12)) { PHASE_CTX; const unsigned char* wl = ws + WS_WL + (size_t)l * LW_STRIDE;
            pg8::Gemm g{UB, (const bf16*)(wl + LW_DN), MP, DM, DFF, LDU, 64, (size_t)DM * 128}; pg8::StaticOrder S; S.init(MP, DM, G, bid); pg8::EpiRes E{XF, DM, ((DUP_MASK >> 12) & 1) ? 0.5f : 1.0f, XF};
            if (PM(19)) pg8::gemm_phase<pg8::EpiRes, pg8::StaticOrder, true, true>(lds, g, S, E, C.tid);
            if (PM(20)) { sample_gemm(lds, C.tid, (const bf16*)(ws + WS_US), LDUS, (const bf16*)(wl + LW_DN), DM, DM, DFF, G, bid, SEpiPart{(float*)(ws + WS_SPL), DM}, 2); if ((DUP_SUB >> 25) & 1u) { const Ctx C2 = mk_ctx(lds, wave_s); sample_gemm(lds, C2.tid, (const bf16*)(ws + WS_US), LDUS, (const bf16*)(wl + LW_DN), DM, DM, DFF, G, bid, SEpiPart{(float*)(ws + WS_SPL), DM}, 2); } }
            SEAM(pb + 12);
        }
        if (IN(pb + 13)) { PHASE_CTX;
            fold_split_rows(C, XF, (const float*)(ws + WS_SPL));
            if (!PM(21)) {} else if (l + 1 < DEPTH) REP(21) rms_phase(C, XF, HN, nullptr); else final_norm_phase(C, XF, a.in(I_GFIN), a.out + O_YP);
            SEAM(pb + 13);
        }
    }
#undef IN
#undef SEAM
#undef SEAM2
#undef PHASE_CTX
}

extern "C" void kernel_launch(void* const* d_in, const int* in_sizes, int n_in, void* d_out, int out_size, void* d_ws, size_t ws_size, hipStream_t stream) {
    static int grid = 0;
    if (grid == 0) {
        if (n_in != NIN || (size_t)out_size != O_END || ws_size < WS_END) { fprintf(stderr, "kernel_launch: unexpected shapes (n_in %d, out %d, ws %zu); nothing launched\n", n_in, out_size, ws_size); grid = -1; return; }
        int dev = 0, cus = 0, per_cu = 0;
        if (hipGetDevice(&dev) != hipSuccess || hipDeviceGetAttribute(&cus, hipDeviceAttributeMultiprocessorCount, dev) != hipSuccess) { grid = -1; return; }
        if (hipFuncSetAttribute((const void*)fwd_kernel, hipFuncAttributeMaxDynamicSharedMemorySize, LDS_BYTES) != hipSuccess) { fprintf(stderr, "kernel_launch: hipFuncSetAttribute failed\n"); grid = -1; return; }
        if (hipOccupancyMaxActiveBlocksPerMultiprocessor(&per_cu, (const void*)fwd_kernel, NWAVES * 64, LDS_BYTES) != hipSuccess || per_cu < 1) { fprintf(stderr, "kernel_launch: occupancy query reports %d\n", per_cu); }
        (void)hipGetLastError();
        grid = cus;
    }
    if (grid < 0) return;
    if (hipMemsetAsync((char*)d_ws + WS_CTL, 0, CTL_ZERO_BYTES, stream) != hipSuccess) return;
    Args a{};
    for (int i = 0; i < NIN; ++i) a.in[i] = (const float*)d_in[i];
    a.out = (float*)d_out; a.ws = (unsigned char*)d_ws;
#if MK_ONE_LAUNCH
    a.ph_lo = 0; a.ph_hi = NPH;
    hipLaunchKernelGGL(fwd_kernel, dim3(grid), dim3(NWAVES * 64), LDS_BYTES, stream, a);
#else
#ifndef NPH_RUN
#define NPH_RUN NPH
#endif
    for (int ph = 0; ph < NPH_RUN; ++ph) { a.ph_lo = ph; a.ph_hi = ph + 1; hipLaunchKernelGGL(fwd_kernel, dim3(grid), dim3(NWAVES * 64), LDS_BYTES, stream, a);
        const int dbit = (ph == 0) ? 13 : (ph - 1) % PH_PER_LAYER;
        if ((DUP_MASK >> dbit) & 1) hipLaunchKernelGGL(fwd_kernel, dim3(grid), dim3(NWAVES * 64), LDS_BYTES, stream, a); }
#endif
}
```

```cpp
#include <hip/hip_runtime.h>
#include <cstdio>
#include <cstdint>
namespace pg8 {
#define PG8_LAS __attribute__((address_space(3)))
typedef unsigned short bf16_t;
typedef short bf16x8 __attribute__((ext_vector_type(8)));
typedef float f32x4 __attribute__((ext_vector_type(4)));
typedef unsigned u32x4 __attribute__((ext_vector_type(4)));
constexpr int BM = 256, BK = 64, HALF = 128, HTB = HALF * BK * 2  , STAGE_BYTES = 8 * HTB, NXCD = 8, WGM = 8;

__host__ __device__ __forceinline__ int lds_byte(int r, int c) { const int st = (r >> 4) * 2 + (c >> 5), rr = r & 15, cc = c & 31, ob = rr * 64 + cc * 2; return st * 1024 + (ob ^ (((ob >> 9) & 1) << 5)); }
__host__ __device__ __forceinline__ void stage_rc(int b, int& R, int& C) { const int st = b / 1024, sb = b % 1024, swz = sb ^ (((sb >> 9) & 1) << 5); R = (st >> 1) * 16 + swz / 64; C = (st & 1) * 32 + (swz % 64) / 2; }
__host__ __device__ __forceinline__ int perm32(int rho) { const int n = rho >> 4, i = rho & 15; return 8 * (i >> 2) + 4 * n + (i & 3); }

struct Unit { int pm, pn; };
struct Gemm { const bf16_t* A; const bf16_t* Bt; int M, N, K, lda, ldb; size_t ksb; };

struct StaticOrder {
    int nM, nN, nwg, G, c;
    __host__ __device__ void init(int M, int N, int G_, int c_) { nM = M / BM; nN = N / BM; nwg = nM * nN; G = G_; c = c_; }
    __host__ __device__ bool next(int i, Unit& u) const {
        const long L = (long)i * G + c; if (L >= nwg) return false;
        int wgid = (int)L; { const int q = nwg / NXCD, r = nwg % NXCD, xcd = wgid % NXCD, off = wgid / NXCD; wgid = (xcd < r ? xcd * (q + 1) : r * (q + 1) + (xcd - r) * q) + off; }
        const int nig = WGM * nN, gid = wgid / nig, fm = gid * WGM, gsz = (nM - fm) < WGM ? (nM - fm) : WGM;
        u.pm = fm + ((wgid % nig) % gsz); u.pn = (wgid % nig) / gsz; return true;
    }
    __device__ __forceinline__ void a_ready(const Unit&) const {}
    __device__ __forceinline__ void done(const Unit&) const {}
};

typedef float f32x2_cv __attribute__((ext_vector_type(2)));
typedef __bf16 bf16x2_cv __attribute__((ext_vector_type(2)));
__device__ __forceinline__ unsigned cvt_pk_bf16(float lo, float hi) { const f32x2_cv v = {lo, hi}; return __builtin_bit_cast(unsigned, __builtin_convertvector(v, bf16x2_cv)); }
typedef float f32x2 __attribute__((ext_vector_type(2)));
template <class Epi, class Sched, bool ALIGN_EPI = false, bool SP2 = false>
__device__ __forceinline__ void gemm_phase(PG8_LAS unsigned char* lds, const Gemm g, const Sched& S, const Epi& E, int tid_in) {
    int tid_ = tid_in; asm volatile("" : "+v"(tid_));
    const int tid = tid_, wid = __builtin_amdgcn_readfirstlane(tid >> 6), lane = tid & 63, wr = wid >> 2, wc = wid & 3, fr = lane & 15, fq = lane >> 4;
    const int K = g.K, nt = K / BK;
    unsigned voffA[2], voffB[2];
#pragma unroll
    for (int i = 0; i < 2; ++i) { int R, C; stage_rc(tid * 16 + i * 8192, R, C); const int Rb = Epi::PERM ? ((R & ~31) + perm32(R & 31)) : R;
        voffA[i] = (unsigned)(R * g.lda + C) * 2u; voffB[i] = (unsigned)(Rb * g.ldb + C) * 2u; }
    const size_t kstep = (size_t)(BK * 2), kstepB = g.ksb;
    const size_t hstepA = (size_t)HALF * g.lda * 2, hstepB = (size_t)HALF * g.ldb * 2;
    const size_t tstepA = 2 * hstepA, tstepB = 2 * hstepB;
    const unsigned ldsw = (unsigned)wid * 1024u;
    const int aoff = lds_byte(wr * 64 + fr, fq * 8), boff = lds_byte(wc * 32 + fr, fq * 8);
#define PG8_SA(b, h) (((b) * 2 + (h)) * HTB)
#define PG8_SB(b, h) ((4 + (b) * 2 + (h)) * HTB)
#define PG8_STAGE(bufoff, gbase, voff) do { _Pragma("unroll") for (int _i = 0; _i < 2; ++_i) \
        __builtin_amdgcn_global_load_lds((const unsigned*)((const char*)(gbase) + (voff)[_i]), (PG8_LAS unsigned*)(lds + (bufoff) + ldsw + _i * 8192), 16, 0, 0); } while (0)
#define PG8_LDA(dst, b, h) do { _Pragma("unroll") for (int m = 0; m < 4; ++m) _Pragma("unroll") for (int k = 0; k < 2; ++k) dst[m][k] = *(const PG8_LAS bf16x8*)(lds + PG8_SA(b, h) + aoff + m * 2048 + k * 1024); } while (0)
#define PG8_LDB(dst, b, h) do { _Pragma("unroll") for (int n = 0; n < 2; ++n) _Pragma("unroll") for (int k = 0; k < 2; ++k) dst[n][k] = *(const PG8_LAS bf16x8*)(lds + PG8_SB(b, h) + boff + n * 2048 + k * 1024); } while (0)
#define PG8_MMA(ai, bj, At, Bt) do { __builtin_amdgcn_s_setprio(1); _Pragma("unroll") for (int m = 0; m < 4; ++m) _Pragma("unroll") for (int n = 0; n < 2; ++n) _Pragma("unroll") for (int k = 0; k < 2; ++k) \
        acc[ai][bj][m][n] = __builtin_amdgcn_mfma_f32_16x16x32_bf16(Bt[n][k], At[m][k], acc[ai][bj][m][n], 0, 0, 0); __builtin_amdgcn_s_setprio(0); } while (0)
#define PG8_WAIT_V(n) asm volatile("s_waitcnt vmcnt(" #n ")" ::: "memory")
#define PG8_WAIT_L(n) asm volatile("s_waitcnt lgkmcnt(" #n ")" ::: "memory")
#define PG8_BAR __builtin_amdgcn_s_barrier()
#define PG8_SCHED __builtin_amdgcn_sched_barrier(0)
    Unit cur, nxt; int ui = 0;
    if (!S.next(0, cur)) return;
    f32x4 acc[2][2][4][2];
#pragma unroll
    for (int a = 0; a < 2; ++a)
#pragma unroll
        for (int b = 0; b < 2; ++b)
#pragma unroll
            for (int m = 0; m < 4; ++m)
#pragma unroll
                for (int n = 0; n < 2; ++n) acc[a][b][m][n] = (f32x4){0.f, 0.f, 0.f, 0.f};
    bf16x8 At[4][2], B0[2][2], B1[2][2];
    const char* cA = (const char*)g.A + (size_t)cur.pm * tstepA; const char* cB = (const char*)g.Bt + (size_t)cur.pn * tstepB;
    S.a_ready(cur);
    if constexpr (SP2) {
        PG8_STAGE(PG8_SB(0, 0), cB, voffB); PG8_STAGE(PG8_SB(0, 1), cB + hstepB, voffB); PG8_STAGE(PG8_SA(0, 0), cA, voffA); PG8_STAGE(PG8_SA(0, 1), cA + hstepA, voffA);
        if (wr == 1) PG8_BAR;
        PG8_WAIT_V(2); PG8_BAR;
        PG8_STAGE(PG8_SB(1, 0), cB + kstepB, voffB); PG8_STAGE(PG8_SA(1, 0), cA + kstep, voffA); PG8_STAGE(PG8_SB(1, 1), cB + hstepB + kstepB, voffB);
        PG8_WAIT_V(6); PG8_BAR;
    } else {
        PG8_STAGE(PG8_SB(0, 0), cB, voffB); PG8_STAGE(PG8_SA(0, 0), cA, voffA); PG8_STAGE(PG8_SB(0, 1), cB + hstepB, voffB); PG8_STAGE(PG8_SA(0, 1), cA + hstepA, voffA);
        if (wr == 1) PG8_BAR;
        PG8_WAIT_V(4); PG8_BAR;
        PG8_STAGE(PG8_SB(1, 0), cB + kstepB, voffB); PG8_STAGE(PG8_SA(1, 0), cA + kstep, voffA); PG8_STAGE(PG8_SB(1, 1), cB + hstepB + kstepB, voffB);
        PG8_WAIT_V(6); PG8_BAR;
    }
    for (;;) {
        const bool has_next = S.next(ui + 1, nxt);
        const char* nA = has_next ? (const char*)g.A + (size_t)nxt.pm * tstepA : cA; const char* nB = has_next ? (const char*)g.Bt + (size_t)nxt.pn * tstepB : cB;
        for (int t = 0; t < nt; t += 2) {
            const bool last = (t == nt - 2);
            const char* a1 = cA + (size_t)(t + 1) * kstep;
            const char* a2 = last ? nA : cA + (size_t)(t + 2) * kstep; const char* b2 = last ? nB : cB + (size_t)(t + 2) * kstepB;
            const char* a3 = a2 + kstep; const char* b3 = b2 + kstepB;
            if (last && has_next) S.a_ready(nxt);
            if constexpr (SP2) {
            PG8_LDB(B0, 0, 0); PG8_LDB(B1, 0, 1); PG8_SCHED; PG8_LDA(At, 0, 0); PG8_STAGE(PG8_SA(1, 1), a1 + hstepA, voffA);
            PG8_WAIT_V(8); PG8_WAIT_L(0); PG8_BAR; PG8_MMA(0, 0, At, B0); PG8_MMA(0, 1, At, B1); PG8_BAR; PG8_SCHED;
            PG8_LDA(At, 0, 1); PG8_STAGE(PG8_SB(0, 0), b2, voffB); PG8_STAGE(PG8_SB(0, 1), b2 + hstepB, voffB); PG8_STAGE(PG8_SA(0, 0), a2, voffA);
            PG8_WAIT_V(8); PG8_WAIT_L(0); PG8_BAR; PG8_MMA(1, 0, At, B0); PG8_MMA(1, 1, At, B1); PG8_BAR; PG8_SCHED;
            PG8_LDB(B0, 1, 0); PG8_LDB(B1, 1, 1); PG8_SCHED; PG8_LDA(At, 1, 0); PG8_STAGE(PG8_SA(0, 1), a2 + hstepA, voffA);
            PG8_WAIT_V(8); PG8_WAIT_L(0); PG8_BAR; PG8_MMA(0, 0, At, B0); PG8_MMA(0, 1, At, B1); PG8_BAR; PG8_SCHED;
            PG8_LDA(At, 1, 1); PG8_STAGE(PG8_SB(1, 0), b3, voffB); PG8_STAGE(PG8_SB(1, 1), b3 + hstepB, voffB); PG8_STAGE(PG8_SA(1, 0), a3, voffA);
            PG8_WAIT_V(8); PG8_WAIT_L(0); PG8_BAR; PG8_MMA(1, 0, At, B0); PG8_MMA(1, 1, At, B1); PG8_BAR; PG8_SCHED;
            } else {
            PG8_LDB(B0, 0, 0); PG8_SCHED; PG8_LDA(At, 0, 0); PG8_STAGE(PG8_SA(1, 1), a1 + hstepA, voffA);
            PG8_WAIT_L(8); PG8_BAR; PG8_WAIT_L(0); PG8_MMA(0, 0, At, B0); PG8_BAR; PG8_SCHED;
            PG8_LDB(B1, 0, 1); PG8_STAGE(PG8_SB(0, 0), b2, voffB);
            PG8_BAR; PG8_WAIT_L(0); PG8_MMA(0, 1, At, B1); PG8_BAR;
            PG8_LDA(At, 0, 1); PG8_STAGE(PG8_SA(0, 0), a2, voffA);
            PG8_BAR; PG8_WAIT_L(0); PG8_MMA(1, 0, At, B0); PG8_BAR; PG8_SCHED;
            PG8_STAGE(PG8_SB(0, 1), b2 + hstepB, voffB);
            PG8_WAIT_V(6); PG8_BAR; PG8_MMA(1, 1, At, B1); PG8_BAR;
            PG8_LDB(B0, 1, 0); PG8_SCHED; PG8_LDA(At, 1, 0); PG8_STAGE(PG8_SA(0, 1), a2 + hstepA, voffA);
            PG8_WAIT_L(8); PG8_BAR; PG8_WAIT_L(0); PG8_MMA(0, 0, At, B0); PG8_BAR; PG8_SCHED;
            PG8_LDB(B1, 1, 1); PG8_STAGE(PG8_SB(1, 0), b3, voffB);
            PG8_BAR; PG8_WAIT_L(0); PG8_MMA(0, 1, At, B1); PG8_BAR;
            PG8_LDA(At, 1, 1); PG8_STAGE(PG8_SA(1, 0), a3, voffA);
            PG8_BAR; PG8_WAIT_L(0); PG8_MMA(1, 0, At, B0); PG8_BAR; PG8_SCHED;
            PG8_STAGE(PG8_SB(1, 1), b3 + hstepB, voffB);
            PG8_WAIT_V(6); PG8_BAR; PG8_MMA(1, 1, At, B1); PG8_BAR;
            }
        }
        if constexpr (ALIGN_EPI) { if (wr == 0) PG8_BAR; }
        if constexpr (!Epi::AFTER_DRAIN) { E(acc, cur, wr, wc, fr, fq); S.done(cur); }
        if (!has_next) break;
#pragma unroll
        for (int a = 0; a < 2; ++a)
#pragma unroll
            for (int b = 0; b < 2; ++b)
#pragma unroll
                for (int m = 0; m < 4; ++m)
#pragma unroll
                    for (int n = 0; n < 2; ++n) acc[a][b][m][n] = (f32x4){0.f, 0.f, 0.f, 0.f};
        cur = nxt; cA = nA; cB = nB; ++ui;
        if constexpr (ALIGN_EPI) { if (wr == 1) PG8_BAR; }
    }
    PG8_WAIT_V(0);
    if constexpr (!ALIGN_EPI) { if (wr == 0) PG8_BAR; }
    PG8_BAR;
    if constexpr (Epi::AFTER_DRAIN) { E.fused(acc, cur, wr, wc, fr, fq, lds, wid, lane); S.done(cur); }
#undef PG8_SA
#undef PG8_SB
#undef PG8_STAGE
#undef PG8_LDA
#undef PG8_LDB
#undef PG8_MMA
#undef PG8_WAIT_V
#undef PG8_WAIT_L
#undef PG8_BAR
#undef PG8_SCHED
}
}

constexpr int DM = 2048, SEQ = 2048, NB = 4, NS = 128, DEPTH = 2;
constexpr int MP = NB * SEQ;
constexpr int MT = MP + NS;
constexpr int MPAD = MP + 256;
constexpr int PIN = 6400, DFF = 8192, NMEM = 256, MMEM = NB * NMEM;
constexpr int PB_ = 1536, PC_ = 3584, PD_ = 5376;
constexpr int SHW = 1792;
constexpr int LDU = 8192;
constexpr int NWAVES = 8;
constexpr int NIN = 39;

constexpr size_t O_YP = 0, O_YS = O_YP + (size_t)MP * DM, O_CAP = O_YS + (size_t)NS * DM, O_CAS = O_CAP + (size_t)DEPTH * NB * 2 * 512,
    O_RETP = O_CAS + (size_t)DEPTH * NS * 2 * 512, O_RETS = O_RETP + (size_t)DEPTH * NB * 4 * 128 * 128, O_SHP = O_RETS + (size_t)DEPTH * NS * 4 * 128 * 128,
    O_SHS = O_SHP + (size_t)DEPTH * NB * SHW, O_WKVP = O_SHS + (size_t)DEPTH * NS * SHW, O_WKVS = O_WKVP + (size_t)DEPTH * NB * 8 * 64 * 64,
    O_CDP = O_WKVS + (size_t)DEPTH * NS * 8 * 64 * 64, O_CDS = O_CDP + (size_t)DEPTH * NB * 30 * 512, O_MKP = O_CDS + (size_t)DEPTH * NS * 30 * 512,
    O_MVP = O_MKP + (size_t)DEPTH * MMEM * DM, O_END = O_MVP + (size_t)DEPTH * MMEM * DM;
static_assert(O_END == 56178688, "d_out size");

constexpr size_t MiB = 1u << 20;
constexpr size_t al256(size_t x) { return (x + 255) & ~(size_t)255; }
constexpr size_t WS_CTL = 0, CTL_ZERO_BYTES = 1 * MiB;
constexpr size_t WS_ROPE = 1 * MiB;
constexpr size_t SZ_WIN = (size_t)PIN * DM * 2, SZ_SQ = (size_t)DM * DM * 2, SZ_WUP = (size_t)DFF * DM * 2, SZ_WDN = (size_t)DM * LDU * 2;
constexpr size_t LW_IN = 0, LW_OUT = LW_IN + SZ_WIN, LW_Q = LW_OUT + SZ_SQ, LW_O = LW_Q + SZ_SQ, LW_UP = LW_O + SZ_SQ, LW_DN = LW_UP + SZ_WUP,
    LW_W2 = LW_DN + SZ_WDN, LW_A2 = LW_W2 + 512 * 64 * 2, LW_G2 = LW_A2 + 512 * 64 * 2, LW_STRIDE = LW_G2 + 512 * 128 * 2;
constexpr size_t WS_WL = 4 * MiB;
constexpr size_t WS_WKV = al256(WS_WL + 2 * LW_STRIDE);
constexpr size_t WS_XF = al256(WS_WKV + (size_t)8192 * DM * 2);
constexpr size_t WS_HN = al256(WS_XF + (size_t)MT * DM * 4);
constexpr size_t WS_MN = al256(WS_HN + (size_t)MPAD * DM * 2);
constexpr size_t WS_MK = al256(WS_MN + (size_t)MMEM * DM * 2);
constexpr size_t WS_MVT = al256(WS_MK + (size_t)2 * MMEM * DM * 2);
constexpr size_t WS_P = al256(WS_MVT + (size_t)2 * MMEM * DM * 2);
constexpr size_t WS_YC = al256(WS_P + (size_t)MPAD * PIN * 2);
constexpr size_t WS_Q = al256(WS_YC + (size_t)MT * DM * 2);
constexpr size_t WS_O = al256(WS_Q + (size_t)MT * DM * 2);
constexpr size_t WS_U = al256(WS_O + (size_t)MT * DM * 2);
constexpr size_t WS_RW = al256(WS_U + (size_t)MT * LDU * 2);
constexpr size_t WS_GATE = al256(WS_RW + (size_t)MT * 8 * 896);
constexpr size_t WS_OC = al256(WS_GATE + (size_t)MT * 512 * 4);
constexpr size_t WS_KVT = al256(WS_OC + (size_t)MT * 512 * 4);
constexpr size_t WS_SSQ = al256(WS_KVT + (size_t)16 * 16 * 128 * 128 * 4);
constexpr size_t WS_SPL = al256(WS_SSQ + (size_t)MP * 8 * 4);
constexpr size_t WS_STB = al256(WS_SPL + (size_t)2 * NS * DM * 4);
constexpr size_t WS_CK = al256(WS_STB + (size_t)16 * 16 * 128 * 128 * 2);
constexpr size_t WS_CP = al256(WS_CK + (size_t)4096 * 6912);
constexpr int DMS = DM + 128, LDUS = LDU + 128;
constexpr size_t WS_HNS = al256(WS_CP + (size_t)4096 * 4 * 3072);
constexpr size_t WS_OS = al256(WS_HNS + (size_t)NS * DMS * 2);
constexpr size_t WS_US = al256(WS_OS + (size_t)NS * DMS * 2);
constexpr size_t WS_END = al256(WS_US + (size_t)NS * LDUS * 2);
static_assert(WS_END < (size_t)1700 * MiB, "d_ws map");
constexpr int CW_BAR = 4096;

constexpr int SCR_BYTES = 147456;
constexpr int MISC_OFF = SCR_BYTES;
constexpr int LDS_BYTES = SCR_BYTES + 1024;

#define GAS __attribute__((address_space(1)))
#define LAS __attribute__((address_space(3)))
typedef unsigned short bf16;
typedef unsigned v4u __attribute__((ext_vector_type(4)));
typedef unsigned v2u __attribute__((ext_vector_type(2)));
typedef float f32x4 __attribute__((ext_vector_type(4)));
typedef float f32x2 __attribute__((ext_vector_type(2)));
typedef short bf16x8 __attribute__((ext_vector_type(8)));
typedef short bf16x4 __attribute__((ext_vector_type(4)));
typedef GAS unsigned gu32;
#define RLX_AGENT __ATOMIC_RELAXED, __HIP_MEMORY_SCOPE_AGENT
#define LDS_WAIT() asm volatile("s_waitcnt lgkmcnt(0)" ::: "memory")
#define VM_WAIT() asm volatile("s_waitcnt vmcnt(0)" ::: "memory")
__device__ __forceinline__ unsigned pk2(float lo, float hi) { return pg8::cvt_pk_bf16(lo, hi); }
__device__ __forceinline__ float bflo(unsigned w) { return __uint_as_float(w << 16); }
__device__ __forceinline__ float bfhi(unsigned w) { return __uint_as_float(w & 0xffff0000u); }
__device__ __forceinline__ float bf1(bf16 h) { return __uint_as_float(((unsigned)h) << 16); }
__device__ __forceinline__ void unpack8(const v4u w, float (&f)[8]) { f[0] = bflo(w.x); f[1] = bfhi(w.x); f[2] = bflo(w.y); f[3] = bfhi(w.y); f[4] = bflo(w.z); f[5] = bfhi(w.z); f[6] = bflo(w.w); f[7] = bfhi(w.w); }
__device__ __forceinline__ void unpack4(const v2u w, float (&f)[4]) { f[0] = bflo(w.x); f[1] = bfhi(w.x); f[2] = bflo(w.y); f[3] = bfhi(w.y); }
__device__ __forceinline__ v4u pack8(const float (&f)[8]) { v4u w; w.x = pk2(f[0], f[1]); w.y = pk2(f[2], f[3]); w.z = pk2(f[4], f[5]); w.w = pk2(f[6], f[7]); return w; }
__device__ __forceinline__ float sigm(float x) { return 1.0f / (1.0f + __expf(-x)); }
__device__ __forceinline__ float wave_sum(float v) {
#pragma unroll
    for (int o = 1; o < 64; o <<= 1) v += __shfl_xor(v, o);
    return v;
}
__device__ __forceinline__ float wave_max(float v) {
#pragma unroll
    for (int o = 1; o < 64; o <<= 1) v = fmaxf(v, __shfl_xor(v, o));
    return v;
}
template <int CTRL> __device__ __forceinline__ float dpp_f(float v) { return __builtin_bit_cast(float, __builtin_amdgcn_update_dpp(0, __builtin_bit_cast(int, v), CTRL, 0xf, 0xf, false)); }
__device__ __forceinline__ f32x4 zero4() { float z0, z1, z2, z3; asm volatile("v_mov_b32 %0, 0\n\tv_mov_b32 %1, 0\n\tv_mov_b32 %2, 0\n\tv_mov_b32 %3, 0\n\ts_nop 1" : "=v"(z0), "=v"(z1), "=v"(z2), "=v"(z3)); return (f32x4){z0, z1, z2, z3}; }
__device__ __forceinline__ float rowsum16(float v) { v += dpp_f<0x128>(v); v += dpp_f<0x124>(v); v += dpp_f<0x122>(v); v += dpp_f<0x121>(v); return v; }

namespace pg8 {
template <int ACT> struct EpiBf16A {
    static constexpr bool PERM = true, AFTER_DRAIN = false;
    bf16_t* O; int ldc; const float* ssq;
    __device__ __forceinline__ void operator()(const f32x4 (&acc)[2][2][4][2], const Unit& u, int wr, int wc, int fr, int fq) const {
        const int row0 = u.pm * BM + wr * 64 + fr, col0 = u.pn * BM + wc * 32 + 8 * fq;
#pragma unroll
        for (int ai = 0; ai < 2; ++ai)
#pragma unroll
            for (int m = 0; m < 4; ++m) { bf16_t* rowp = O + (size_t)(row0 + ai * HALF + m * 16) * ldc + col0;
                const float rs = ssq ? 1.0f / sqrtf(ssq[row0 + ai * HALF + m * 16] * (1.0f / 2048.0f) + 1e-6f) : 1.0f;
#pragma unroll
                for (int bj = 0; bj < 2; ++bj) { f32x4 v0 = acc[ai][bj][m][0] * rs, v1 = acc[ai][bj][m][1] * rs;
                    if (ACT == 3) {
#pragma unroll
                        for (int j = 0; j < 4; ++j) { const float a = fmaxf(v0[j], 0.f), b = fmaxf(v1[j], 0.f); v0[j] = a * a; v1[j] = b * b; } }
                    u32x4 w; w.x = cvt_pk_bf16(v0[0], v0[1]); w.y = cvt_pk_bf16(v0[2], v0[3]); w.z = cvt_pk_bf16(v1[0], v1[1]); w.w = cvt_pk_bf16(v1[2], v1[3]);
                    *(u32x4*)(rowp + bj * HALF) = w; } }
    }
};
struct EpiRes {
    static constexpr bool PERM = false, AFTER_DRAIN = false;
    float* X; int ldc; float sc; const float* Xin;
    __device__ __forceinline__ void operator()(const f32x4 (&acc)[2][2][4][2], const Unit& u, int wr, int wc, int fr, int fq) const {
        const int row0 = u.pm * BM + wr * 64 + fr, col0 = u.pn * BM + wc * 32 + 4 * fq;
#pragma unroll
        for (int ai = 0; ai < 2; ++ai)
#pragma unroll
            for (int m = 0; m < 4; ++m) { float* rowp = X + (size_t)(row0 + ai * HALF + m * 16) * ldc + col0; const float* inp = Xin + (size_t)(row0 + ai * HALF + m * 16) * ldc + col0;
                f32x4 o[2][2];
#pragma unroll
                for (int bj = 0; bj < 2; ++bj)
#pragma unroll
                    for (int n = 0; n < 2; ++n) o[bj][n] = *(const f32x4*)(inp + bj * HALF + n * 16);
#pragma unroll
                for (int bj = 0; bj < 2; ++bj)
#pragma unroll
                    for (int n = 0; n < 2; ++n) *(f32x4*)(rowp + bj * HALF + n * 16) = o[bj][n] + acc[ai][bj][m][n] * sc; }
    }
};
struct EpiMemKV {
    static constexpr bool PERM = false, AFTER_DRAIN = false;
    float* outK; bf16_t* MKb; bf16_t* MVT;
    __device__ __forceinline__ void operator()(const f32x4 (&acc)[2][2][4][2], const Unit& u, int wr, int wc, int fr, int fq) const {
        const int cbase = u.pn * BM, lyr = cbase >> 12, cc = cbase & 4095; const bool isV = cc >= 2048; const int colt = cc & 2047;
        const int row0 = u.pm * BM + wr * 64 + fr, col0 = colt + wc * 32 + 4 * fq;
        float* outp = outK + (isV ? (size_t)(O_MVP - O_MKP) : (size_t)0);
#pragma unroll
        for (int ai = 0; ai < 2; ++ai)
#pragma unroll
            for (int m = 0; m < 4; ++m) { const int r = row0 + ai * HALF + m * 16;
#pragma unroll
                for (int bj = 0; bj < 2; ++bj)
#pragma unroll
                    for (int n = 0; n < 2; ++n) { const int col = col0 + bj * HALF + n * 16; const f32x4 v = acc[ai][bj][m][n];
                        *(f32x4*)(outp + ((size_t)lyr * 1024 + r) * 2048 + col) = v;
                        if (!isV) { unsigned lo = cvt_pk_bf16(v[0], v[1]), hi = cvt_pk_bf16(v[2], v[3]); *(unsigned long long*)(MKb + ((size_t)lyr * 1024 + r) * 2048 + col) = ((unsigned long long)hi << 32) | lo; }
                        else { const int b = r >> 8, j = r & 255, h = col >> 9, e = col & 511; bf16_t* tp = MVT + ((((size_t)lyr * 4 + b) * 4 + h) * 512 + e) * 256 + j;
                            const unsigned lo = cvt_pk_bf16(v[0], v[1]), hi = cvt_pk_bf16(v[2], v[3]);
                            tp[0] = (bf16_t)(lo & 0xffffu); tp[256] = (bf16_t)(lo >> 16); tp[512] = (bf16_t)(hi & 0xffffu); tp[768] = (bf16_t)(hi >> 16); } } }
    }
};
}

struct SEpiBf16 { bf16* O; int ldc; int act; const float* ssq;
    __device__ __forceinline__ void operator()(int row, int col0, f32x4 v, int) const {
        if (ssq) v = v * (1.0f / sqrtf(ssq[row] * (1.0f / 2048.0f) + 1e-6f));
        if (act == 3) {
#pragma unroll
            for (int j = 0; j < 4; ++j) { const float a = fmaxf(v[j], 0.f); v[j] = a * a; } }
        v2u w; w.x = pk2(v[0], v[1]); w.y = pk2(v[2], v[3]); *(v2u*)(O + (size_t)row * ldc + col0) = w; } };
struct SEpiRes { float* X; int ldc; float sc; const float* Xin;
    __device__ __forceinline__ void operator()(int row, int col0, f32x4 v, int) const { *(f32x4*)(X + (size_t)row * ldc + col0) = *(const f32x4*)(Xin + (size_t)row * ldc + col0) + v * sc; } };
struct SEpiPart { float* S; int ldc;
    __device__ __forceinline__ void operator()(int row, int col0, f32x4 v, int kp) const { *(f32x4*)(S + ((size_t)kp * NS + row) * ldc + col0) = v; } };
template <class F> __device__ __forceinline__ void sample_gemm(LAS unsigned char* lds, int tid_in, const bf16* A, int lda, const bf16* Bt, int ntot, int N, int K, int G, int bid, const F& epi, int nks = 1) {
    int tid_ = tid_in; asm volatile("" : "+v"(tid_));
    const int lane = tid_ & 63, wave = __builtin_amdgcn_readfirstlane(tid_ >> 6), fr = lane & 15, fq = lane >> 4;
    const int KS = (K / nks) >> 3, ncu = N / 16;
    LAS f32x4* red = (LAS f32x4*)lds;
    const unsigned voffa = (unsigned)(fr * lda + fq * 8) * 2u, voffb = (unsigned)(fr * 64 + fq * 8) * 2u;
    for (int uu = bid; uu < ncu * nks; uu += G) { const int kp = uu / ncu, u = uu - kp * ncu, kbeg = kp * (K / nks) + wave * KS;
        const char* bp = (const char*)(Bt + ((size_t)(kbeg >> 6) * ntot + u * 16) * 64);
        const char* ap = (const char*)(A + kbeg);
        f32x4 acc[8];
#pragma unroll
        for (int rt = 0; rt < 8; ++rt) acc[rt] = zero4();
        bf16x8 b0[2], a0[2][8], b1[2], a1[2][8];
#define SG_LOAD(bb, aa, kq) do { _Pragma("unroll") for (int s = 0; s < 2; ++s) { bb[s] = *(const bf16x8*)(bp + ((size_t)((kq) >> 6) * ntot * 64 + 32 * s) * 2 + voffb); \
            _Pragma("unroll") for (int rt = 0; rt < 8; ++rt) aa[s][rt] = *(const bf16x8*)(ap + ((size_t)rt * 16 * lda + (kq) + 32 * s) * 2 + voffa); } } while (0)
#define SG_MMA(bb, aa) do { _Pragma("unroll") for (int s = 0; s < 2; ++s) _Pragma("unroll") for (int rt = 0; rt < 8; ++rt) acc[rt] = __builtin_amdgcn_mfma_f32_16x16x32_bf16(bb[s], aa[s][rt], acc[rt], 0, 0, 0); } while (0)
        SG_LOAD(b0, a0, 0);
        for (int k0 = 0; k0 < KS; k0 += 128) {
            __builtin_amdgcn_sched_barrier(0);
            SG_LOAD(b1, a1, k0 + 64);
            __builtin_amdgcn_sched_barrier(0);
            SG_MMA(b0, a0);
            __builtin_amdgcn_sched_barrier(0);
            if (k0 + 128 < KS) SG_LOAD(b0, a0, k0 + 128);
            __builtin_amdgcn_sched_barrier(0);
            SG_MMA(b1, a1);
        }
        __builtin_amdgcn_sched_barrier(0);
#undef SG_LOAD
#undef SG_MMA
#pragma unroll
        for (int rt = 0; rt < 8; ++rt) red[(wave * 8 + rt) * 64 + lane] = acc[rt];
        __syncthreads();
        f32x4 sum = red[wave * 64 + lane];
#pragma unroll
        for (int ks = 1; ks < 8; ++ks) sum += red[(ks * 8 + wave) * 64 + lane];
        epi(wave * 16 + fr, u * 16 + 4 * fq, sum, kp);
        __syncthreads();
    }
}
#define XB_TMO      128
#define XB_XCNT(j)  (256  + 64 * (j))
#define XB_XSUB(j)  (1280 + 64 * (j))
#define XB_XGEN(j)  (2304 + 64 * (j))
#define XB_TOP      3328
#define XB_TOPGEN   3392
#define XCD_BAR_WORDS 3456
#define XB_SPIN_CAP (1u << 18)

__device__ __forceinline__ unsigned xb_ld(unsigned* p)              { return __hip_atomic_load(p, __ATOMIC_RELAXED, __HIP_MEMORY_SCOPE_AGENT); }
__device__ __forceinline__ unsigned xb_add(unsigned* p, unsigned v) { return __hip_atomic_fetch_add(p, v, __ATOMIC_RELAXED, __HIP_MEMORY_SCOPE_AGENT); }
__device__ __forceinline__ unsigned xb_xcc_id() { return (unsigned)__builtin_amdgcn_s_getreg((3 << 11) | 20) & 0xFu; }
#define XB_SPIN(cond, bar) do { unsigned _sp = 0; while (cond) { __builtin_amdgcn_s_sleep(1); \
    if ((++_sp & 255u) == 0u) { if (xb_ld(&(bar)[XB_TMO])) break; if (_sp > XB_SPIN_CAP) { atomicAdd(&(bar)[XB_TMO], 1u); break; } } } } while (0)

struct XcdBarrier {
    int wave;
    unsigned* bar; unsigned x;
    volatile LAS unsigned* st;
};

__device__ __forceinline__ XcdBarrier xcd_barrier_post(unsigned* bar, volatile LAS unsigned* st) {
    XcdBarrier b; b.bar = bar; b.x = xb_xcc_id(); b.st = st;
    if (threadIdx.x == 0) (void)xb_add(&bar[XB_XCNT(b.x)], 1u);
    return b;
}
__device__ __forceinline__ void xcd_barrier_complete(unsigned* bar, unsigned x, unsigned& nloc, unsigned& nx) {
    const unsigned G = gridDim.x * gridDim.y * gridDim.z;
    unsigned sum, cnt, mine, sp = 0u;
    for (;;) {
        sum = 0u; cnt = 0u; mine = 0u;
#pragma unroll
        for (unsigned j = 0; j < 16; ++j) { const unsigned c = xb_ld(&bar[XB_XCNT(j)]); sum += c; cnt += (c > 0u) ? 1u : 0u; mine = (j == x) ? c : mine; }
        if (sum == G) break;
        __builtin_amdgcn_s_sleep(1);
        if ((++sp & 255u) == 0u) { if (xb_ld(&bar[XB_TMO])) break; if (sp > XB_SPIN_CAP) { atomicAdd(&bar[XB_TMO], 1u); break; } }
    }
    nloc = mine > 0u ? mine : 1u; nx = cnt > 0u ? cnt : 1u;
}

__device__ __forceinline__ void xcd_barrier(const XcdBarrier& b) {
    asm volatile("s_waitcnt vmcnt(0)" ::: "memory");
    __syncthreads();
    unsigned xbz = 0u; asm volatile("" : "+v"(xbz));
    if (b.wave == 0 && __builtin_amdgcn_mbcnt_hi(~0u, __builtin_amdgcn_mbcnt_lo(~0u, xbz)) == 0u) {
        unsigned* bar = b.bar;
        __builtin_amdgcn_s_waitcnt(0);
        unsigned nloc = b.st[0], nx = b.st[1];
        if (nloc == 0u) { xcd_barrier_complete(bar, b.x, nloc, nx); b.st[0] = nloc; b.st[1] = nx; }
        const unsigned old = xb_add(&bar[XB_XSUB(b.x)], 1u);
        const unsigned gen = old / nloc;
        if (old + 1u == (gen + 1u) * nloc) {
            __builtin_amdgcn_fence(__ATOMIC_RELEASE, "agent");
            asm volatile("s_waitcnt vmcnt(0)" ::: "memory");
            const unsigned og = xb_add(&bar[XB_TOP], 1u);
            const unsigned tg = og / nx;
            if (og + 1u == (tg + 1u) * nx) xb_add(&bar[XB_TOPGEN], 1u);
            else XB_SPIN(xb_ld(&bar[XB_TOPGEN]) == tg, bar);
            __builtin_amdgcn_fence(__ATOMIC_ACQUIRE, "agent");
            xb_add(&bar[XB_XGEN(b.x)], 1u);
            asm volatile("s_waitcnt vmcnt(0)" ::: "memory");
        } else {
            XB_SPIN(xb_ld(&bar[XB_XGEN(b.x)]) == gen, bar);
            __builtin_amdgcn_fence(__ATOMIC_ACQUIRE, "agent");
            asm volatile("s_waitcnt vmcnt(0)" ::: "memory");
        }
    }
    __syncthreads();
}

struct Args { const float* in[NIN]; float* out; unsigned char* ws; int ph_lo, ph_hi; };
enum { I_XP = 0, I_XS, I_MEM, I_SCA, I_SRET, I_SSH, I_SWKV, I_SCD, I_CMK, I_CMV, I_GMIX, I_WIN, I_CAW, I_MU, I_W0, I_W2, I_A0, I_A2, I_G2, I_KK, I_KA, I_RK, I_LNXG, I_LNXB,
       I_CDW, I_CDB, I_LNDG, I_LNDB, I_WOUT, I_GXA, I_GMEM, I_WQ, I_WK, I_WV, I_WO, I_GMLP, I_WUP, I_WDN, I_GFIN };

struct Ctx { LAS unsigned char* lds; int tid, lane, wave, G, bid; };
typedef const GAS float* gcfp;
#define CAS __attribute__((address_space(4)))
struct Ax { const CAS gcfp* kp; float* out; unsigned char* ws;
    __device__ __forceinline__ const float* in(int i) const { return (const float*)kp[i]; } };
__device__ __forceinline__ Ax mk_ax() { const CAS gcfp* kp = (const CAS gcfp*)__builtin_amdgcn_kernarg_segment_ptr(); asm volatile("" : "+s"(kp)); Ax a; a.kp = kp;
    a.out = (float*)(GAS float*)kp[NIN]; a.ws = (unsigned char*)(GAS unsigned char*)kp[NIN + 1]; return a; }
__device__ __forceinline__ Ctx mk_ctx(LAS unsigned char* lds, int wave_s) { unsigned z = 0u; asm volatile("" : "+v"(z)); int t = wave_s * 64 + (int)__builtin_amdgcn_mbcnt_hi(~0u, __builtin_amdgcn_mbcnt_lo(~0u, z)); Ctx C; C.lds = lds; C.tid = t; C.lane = t & 63; C.wave = __builtin_amdgcn_readfirstlane(t >> 6); C.G = gridDim.x; C.bid = blockIdx.x; return C; }

__device__ __forceinline__ void p0_transpose_item(const float* W, int K, int N, bf16* WT, int ldk, int row_off, LAS float* scr, int item, int lane, const float* gain) {
    const int nblk = N / 64, kb = item / nblk, nb = item - kb * nblk, k0 = 64 * kb, n0 = 64 * nb;
    const int lr = lane >> 4, lc = (lane & 15) * 4;
#pragma unroll 8
    for (int i = 0; i < 16; ++i) { const int kk = 4 * i + lr; const float g = gain ? gain[k0 + kk] : 1.0f; const f32x4 v = *(const f32x4*)(W + (size_t)(k0 + kk) * N + n0 + lc);
        LAS float* d = scr + kk * 65 + lc; d[0] = v.x * g; d[1] = v.y * g; d[2] = v.z * g; d[3] = v.w * g; }
    LDS_WAIT(); asm volatile("" ::: "memory");
    const int c = lane & 7;
#pragma unroll
    for (int j = 0; j < 8; ++j) { const int n = (lane >> 3) + 8 * j; const LAS float* s = scr + (8 * c) * 65 + n;
        v4u o; o.x = pk2(s[0 * 65], s[1 * 65]); o.y = pk2(s[2 * 65], s[3 * 65]); o.z = pk2(s[4 * 65], s[5 * 65]); o.w = pk2(s[6 * 65], s[7 * 65]);
        if (ldk > 0) *(v4u*)(WT + (size_t)(row_off + n0 + n) * ldk + k0 + 8 * c) = o;
        else *(v4u*)(WT + ((size_t)kb * (size_t)(-ldk) + row_off + n0 + n) * 64 + 8 * c) = o; }
    LDS_WAIT(); asm volatile("" ::: "memory");
}
__device__ __forceinline__ void rms_row(const float* xrow, bf16* orow, float* xcopy, int lane) {
    const f32x4* xr = (const f32x4*)xrow + lane;
    f32x4 v[8]; float s = 0.f;
#pragma unroll
    for (int j = 0; j < 8; ++j) { v[j] = xr[64 * j]; s += (v[j].x * v[j].x + v[j].y * v[j].y) + (v[j].z * v[j].z + v[j].w * v[j].w); }
    const float rs = 1.0f / sqrtf(wave_sum(s) * (1.0f / DM) + 1e-6f);
    if (xcopy) {
#pragma unroll
        for (int j = 0; j < 8; ++j) ((f32x4*)xcopy + lane)[64 * j] = v[j]; }
    unsigned long long* o8 = (unsigned long long*)orow + lane;
#pragma unroll
    for (int j = 0; j < 8; ++j) o8[64 * j] = (unsigned long long)pk2(v[j].x * rs, v[j].y * rs) | ((unsigned long long)pk2(v[j].z * rs, v[j].w * rs) << 32);
}
__device__ __forceinline__ void rms_phase(const Ctx& C, const float* X, bf16* HN, bf16* HNS) {
    const int gw = C.bid * NWAVES + C.wave, NGW = C.G * NWAVES;
    f32x4 v[8], nx[8]; int m = gw;
    if (m < MT) { const f32x4* xr = (const f32x4*)(X + (size_t)m * DM) + C.lane;
#pragma unroll
        for (int j = 0; j < 8; ++j) v[j] = xr[64 * j]; }
    for (; m < MT; m += NGW) {
        const int mn = m + NGW;
        if (mn < MT) { const f32x4* xr = (const f32x4*)(X + (size_t)mn * DM) + C.lane;
#pragma unroll
            for (int j = 0; j < 8; ++j) nx[j] = xr[64 * j]; }
        float s = 0.f;
#pragma unroll
        for (int j = 0; j < 8; ++j) s += (v[j].x * v[j].x + v[j].y * v[j].y) + (v[j].z * v[j].z + v[j].w * v[j].w);
        const float rs = 1.0f / sqrtf(wave_sum(s) * (1.0f / DM) + 1e-6f);
        unsigned long long* o8 = (unsigned long long*)((HNS && m >= MP) ? HNS + (size_t)(m - MP) * DMS : HN + (size_t)m * DM) + C.lane;
#pragma unroll
        for (int j = 0; j < 8; ++j) o8[64 * j] = (unsigned long long)pk2(v[j].x * rs, v[j].y * rs) | ((unsigned long long)pk2(v[j].z * rs, v[j].w * rs) << 32);
#pragma unroll
        for (int j = 0; j < 8; ++j) v[j] = nx[j];
    }
}
__device__ __forceinline__ void fold_split_rows(const Ctx& C, float* X, const float* S) {
    const int gw = C.bid * NWAVES + C.wave, NGW = C.G * NWAVES;
    for (int r = gw; r < NS; r += NGW) { f32x4* xr = (f32x4*)(X + (size_t)(MP + r) * DM) + C.lane; const f32x4* s0 = (const f32x4*)(S + (size_t)r * DM) + C.lane; const f32x4* s1 = (const f32x4*)(S + (size_t)(NS + r) * DM) + C.lane;
#pragma unroll
        for (int j = 0; j < 8; ++j) xr[64 * j] = xr[64 * j] + (s0[64 * j] + s1[64 * j]); }
    asm volatile("s_waitcnt vmcnt(0)" ::: "memory");
}
__device__ __forceinline__ void final_norm_phase(const Ctx& C, const float* X, const float* g, float* out) {
    const int gw = C.bid * NWAVES + C.wave, NGW = C.G * NWAVES;
    for (int m = gw; m < MT; m += NGW) {
        const f32x4* xr = (const f32x4*)(X + (size_t)m * DM) + C.lane; const f32x4* gr = (const f32x4*)g + C.lane;
        f32x4 v[8]; float s = 0.f;
#pragma unroll
        for (int j = 0; j < 8; ++j) { v[j] = xr[64 * j]; s += (v[j].x * v[j].x + v[j].y * v[j].y) + (v[j].z * v[j].z + v[j].w * v[j].w); }
        const float rs = 1.0f / sqrtf(wave_sum(s) * (1.0f / DM) + 1e-6f);
        f32x4* orow = (f32x4*)(out + (size_t)m * DM) + C.lane;
#pragma unroll
        for (int j = 0; j < 8; ++j) orow[64 * j] = v[j] * rs * gr[64 * j];
    }
}
#ifndef LATE_EXTRA
#define LATE_EXTRA 0
#endif
struct TDesc { const float* W; const float* gain; bf16* WT; int K, N, ldk, row_off, item; };
__device__ __forceinline__ TDesc p0_desc(const Ax& a, int it, int G) {
    constexpr int I_IN = 32 * 100, I_SQ = 32 * 32, I_UP = 32 * 128, I_DN = 128 * 32, I_L64 = 8, I_L128 = 16;
    constexpr int PER_LAYER = I_IN + 5 * I_SQ + I_UP + I_DN + 2 * I_L64 + I_L128;
    const int l = it / PER_LAYER; int r = it - l * PER_LAYER; unsigned char* wl = a.ws + WS_WL + (size_t)l * LW_STRIDE; bf16* wkv = (bf16*)(a.ws + WS_WKV);
    TDesc d; d.row_off = 0; d.gain = nullptr; const bool late = G == 256 && DEPTH == 2, late1 = late && l == 1 && LATE_EXTRA;
    if (r < I_IN) { d.W = a.in(I_WIN) + (size_t)l * DM * PIN; d.K = DM; d.N = PIN; d.WT = (bf16*)(wl + LW_IN); d.ldk = -PIN; d.gain = a.in(I_GMIX) + l * DM; d.item = r; return d; } r -= I_IN;
    if (r < I_SQ) { d.W = a.in(I_WOUT) + (size_t)l * DM * DM; d.K = DM; d.N = DM; d.WT = (bf16*)(wl + LW_OUT); d.ldk = -DM; d.item = late1 ? -1 : r; return d; } r -= I_SQ;
    if (r < I_SQ) { d.W = a.in(I_WQ) + (size_t)l * DM * DM; d.K = DM; d.N = DM; d.WT = (bf16*)(wl + LW_Q); d.ldk = -DM; d.gain = a.in(I_GXA) + l * DM; d.item = late1 ? -1 : r; return d; } r -= I_SQ;
    if (r < I_SQ) { d.W = a.in(I_WO) + (size_t)l * DM * DM; d.K = DM; d.N = DM; d.WT = (bf16*)(wl + LW_O); d.ldk = -DM; d.item = late1 ? -1 : r; return d; } r -= I_SQ;
    if (r < I_SQ) { d.W = a.in(I_WK) + (size_t)l * DM * DM; d.K = DM; d.N = DM; d.WT = wkv; d.ldk = -8192; d.row_off = l * 4096; d.gain = a.in(I_GMEM) + l * DM; d.item = late1 ? -1 : r; return d; } r -= I_SQ;
    if (r < I_SQ) { d.W = a.in(I_WV) + (size_t)l * DM * DM; d.K = DM; d.N = DM; d.WT = wkv; d.ldk = -8192; d.row_off = l * 4096 + 2048; d.gain = a.in(I_GMEM) + l * DM; d.item = late1 ? -1 : r; return d; } r -= I_SQ;
    if (r < I_UP) { d.W = a.in(I_WUP) + (size_t)l * DM * DFF; d.K = DM; d.N = DFF; d.WT = (bf16*)(wl + LW_UP); d.ldk = -DFF; d.gain = a.in(I_GMLP) + l * DM; d.item = late ? -1 : r; return d; } r -= I_UP;
    if (r < I_DN) { d.W = a.in(I_WDN) + (size_t)l * DFF * DM; d.K = DFF; d.N = DM; d.WT = (bf16*)(wl + LW_DN); d.ldk = -DM; d.item = late ? -1 : r; return d; } r -= I_DN;
    if (r < I_L64) { d.W = a.in(I_W2) + (size_t)l * 64 * 512; d.K = 64; d.N = 512; d.WT = (bf16*)(wl + LW_W2); d.ldk = 64; d.item = r; return d; } r -= I_L64;
    if (r < I_L64) { d.W = a.in(I_A2) + (size_t)l * 64 * 512; d.K = 64; d.N = 512; d.WT = (bf16*)(wl + LW_A2); d.ldk = 64; d.item = r; return d; } r -= I_L64;
    d.W = a.in(I_G2) + (size_t)l * 128 * 512; d.K = 128; d.N = 512; d.WT = (bf16*)(wl + LW_G2); d.ldk = 128; d.item = r; return d;
}
__device__ __forceinline__ void p0_load(const TDesc& d, int lane, f32x4 (&v)[16], float (&g)[16]) {
    if (d.item < 0) return;
    const int nblk = d.N / 64, kb = d.item / nblk, nb = d.item - kb * nblk, k0 = 64 * kb, n0 = 64 * nb, lr = lane >> 4, lc = (lane & 15) * 4;
#pragma unroll
    for (int i = 0; i < 16; ++i) { const int kk = 4 * i + lr; g[i] = d.gain ? d.gain[k0 + kk] : 1.0f; v[i] = __builtin_nontemporal_load((const f32x4*)(d.W + (size_t)(k0 + kk) * d.N + n0 + lc)); }
}
__device__ __forceinline__ void p0_finish(const TDesc& d, LAS float* scr, int lane, const f32x4 (&v)[16], const float (&g)[16]) {
    if (d.item < 0) return;
    const int nblk = d.N / 64, kb = d.item / nblk, nb = d.item - kb * nblk, k0 = 64 * kb, n0 = 64 * nb, lr = lane >> 4, lc = (lane & 15) * 4;
#pragma unroll
    for (int i = 0; i < 16; ++i) { const int kk = 4 * i + lr; LAS float* p = scr + kk * 65 + lc; p[0] = v[i].x * g[i]; p[1] = v[i].y * g[i]; p[2] = v[i].z * g[i]; p[3] = v[i].w * g[i]; }
    LDS_WAIT(); asm volatile("" ::: "memory");
    const int c = lane & 7;
#pragma unroll
    for (int j = 0; j < 8; ++j) { const int n = (lane >> 3) + 8 * j; const LAS float* s = scr + (8 * c) * 65 + n;
        v4u o; o.x = pk2(s[0 * 65], s[1 * 65]); o.y = pk2(s[2 * 65], s[3 * 65]); o.z = pk2(s[4 * 65], s[5 * 65]); o.w = pk2(s[6 * 65], s[7 * 65]);
        if (d.ldk > 0) *(v4u*)(d.WT + (size_t)(d.row_off + n0 + n) * d.ldk + k0 + 8 * c) = o;
        else *(v4u*)(d.WT + ((size_t)kb * (size_t)(-d.ldk) + d.row_off + n0 + n) * 64 + 8 * c) = o; }
    LDS_WAIT(); asm volatile("" ::: "memory");
}
__device__ __forceinline__ void p0_prologue(const Ctx& C, const Ax& a) {
    LAS float* scr = (LAS float*)(C.lds + C.wave * 16640);
    const int gw = C.bid * NWAVES + C.wave, NGW = C.G * NWAVES;
    constexpr int I_IN = 32 * 100, I_SQ = 32 * 32, I_UP = 32 * 128, I_DN = 128 * 32, I_L64 = 8, I_L128 = 16;
    constexpr int PER_LAYER = I_IN + 5 * I_SQ + I_UP + I_DN + 2 * I_L64 + I_L128;
    TDesc cur = p0_desc(a, gw, C.G), nxt; f32x4 va[16], vb[16]; float ga[16], gb[16];
    const int NITEMS = DEPTH * PER_LAYER;
    if (gw < NITEMS) p0_load(cur, C.lane, va, ga);
    for (int it = gw; it < NITEMS; it += 2 * NGW) {
        const int it1 = it + NGW, it2 = it + 2 * NGW;
        if (it1 < NITEMS) { nxt = p0_desc(a, it1, C.G); p0_load(nxt, C.lane, vb, gb); }
        p0_finish(cur, scr, C.lane, va, ga);
        if (it1 < NITEMS) { if (it2 < NITEMS) { cur = p0_desc(a, it2, C.G); p0_load(cur, C.lane, va, ga); }
            p0_finish(nxt, scr, C.lane, vb, gb); }
    }
    { float* cs = (float*)(a.ws + WS_ROPE); const int gt = C.bid * (NWAVES * 64) + C.tid, NT = C.G * NWAVES * 64;
      for (int idx = gt; idx < 2049 * 64; idx += NT) { const int p = idx >> 6, i = idx & 63; const double pos = (p == 2048) ? 16384.0 : (double)p;
          const double inv = exp(-(double)i * (9.210340371976184 / 64.0)); double r = pos * inv; r -= 6.283185307179586 * rint(r * 0.15915494309189535);
          cs[2 * idx] = (float)cos(r); cs[2 * idx + 1] = (float)sin(r); } }
    float* XF = (float*)(a.ws + WS_XF); bf16* HN = (bf16*)(a.ws + WS_HN); bf16* MN = (bf16*)(a.ws + WS_MN);
    for (int m = gw; m < MT; m += NGW) { const float* src = (m < MP) ? a.in(I_XP) + (size_t)m * DM : a.in(I_XS) + (size_t)(m - MP) * DM; rms_row(src, HN + (size_t)m * DM, nullptr, C.lane); }
    for (int m = gw; m < MMEM; m += NGW) rms_row(a.in(I_MEM) + (size_t)m * DM, MN + (size_t)m * DM, nullptr, C.lane);
}

__device__ __forceinline__ TDesc lc_desc(const Ax& a, int l, int it) {
    constexpr int I_UP = 32 * 128, I_DN = 128 * 32, I_SQ = 32 * 32;
    unsigned char* wl = a.ws + WS_WL + (size_t)l * LW_STRIDE; TDesc d; d.row_off = 0; d.gain = nullptr;
    if (it < I_UP) { d.W = a.in(I_WUP) + (size_t)l * DM * DFF; d.K = DM; d.N = DFF; d.WT = (bf16*)(wl + LW_UP); d.ldk = -DFF; d.gain = a.in(I_GMLP) + l * DM; d.item = it; return d; }
    int r = it - I_UP;
    if (r < I_DN) { d.W = a.in(I_WDN) + (size_t)l * DFF * DM; d.K = DFF; d.N = DM; d.WT = (bf16*)(wl + LW_DN); d.ldk = -DM; d.item = r; return d; } r -= I_DN;
    d.K = DM; d.N = DM; d.item = r & (I_SQ - 1); const int q = r >> 10;
    if (l == 0) { const int l1 = 1; d.W = a.in(q == 0 ? I_WK : I_WV) + (size_t)l1 * DM * DM; d.WT = (bf16*)(a.ws + WS_WKV); d.ldk = -8192; d.row_off = l1 * 4096 + q * 2048; d.gain = a.in(I_GMEM) + l1 * DM; return d; }
    d.ldk = -DM;
    if (q == 0) { d.W = a.in(I_WOUT) + (size_t)l * DM * DM; d.WT = (bf16*)(wl + LW_OUT); }
    else if (q == 1) { d.W = a.in(I_WQ) + (size_t)l * DM * DM; d.WT = (bf16*)(wl + LW_Q); d.gain = a.in(I_GXA) + l * DM; }
    else { d.W = a.in(I_WO) + (size_t)l * DM * DM; d.WT = (bf16*)(wl + LW_O); }
    return d;
}
__device__ __forceinline__ void late_convert(const Ctx& C, const Ax& a, int l, int rank, int nrank) {
    LAS float* scr = (LAS float*)(C.lds + C.wave * 16640);
    const int NITEMS = 32 * 128 + 128 * 32 + (LATE_EXTRA ? (l == 0 ? 2 : 3) * 1024 : 0);
    const int gw = rank * NWAVES + C.wave, NGW = nrank * NWAVES;
    TDesc cur, nxt; f32x4 va[16], vb[16]; float ga[16], gb[16];
    if (gw < NITEMS) { cur = lc_desc(a, l, gw); p0_load(cur, C.lane, va, ga); }
    for (int it = gw; it < NITEMS; it += 2 * NGW) {
        const int it1 = it + NGW, it2 = it + 2 * NGW;
        if (it1 < NITEMS) { nxt = lc_desc(a, l, it1); p0_load(nxt, C.lane, vb, gb); }
        p0_finish(cur, scr, C.lane, va, ga);
        if (it1 < NITEMS) { if (it2 < NITEMS) { cur = lc_desc(a, l, it2); p0_load(cur, C.lane, va, ga); }
            p0_finish(nxt, scr, C.lane, vb, gb); }
    }
}
__device__ __forceinline__ void ad_prompt_item(const Ctx& C, const Ax& a, int l, int item) {
    const bf16* P = (const bf16*)(a.ws + WS_P); bf16* YC = (bf16*)(a.ws + WS_YC);
    const int b = item >> 6, t0 = (item & 63) * 32; const size_t rbase = (size_t)b * SEQ;
    LAS float* UD = (LAS float*)C.lds;
    { v4u r1[8], r2[8];
#pragma unroll
      for (int u = 0; u < 8; ++u) { const int it = C.tid + u * (NWAVES * 64), r = it >> 6, cc = it & 63, t = t0 - 30 + r; r1[u] = (v4u){0u, 0u, 0u, 0u}; r2[u] = r1[u];
        if (it < 62 * 64 && t >= 0) { const bf16* pr = P + (rbase + t) * PIN + PD_ + cc * 8; r1[u] = *(const v4u*)pr; r2[u] = *(const v4u*)(pr + 512); } }
      __builtin_amdgcn_sched_barrier(0);
#pragma unroll
      for (int u = 0; u < 8; ++u) { const int it = C.tid + u * (NWAVES * 64), r = it >> 6, cc = it & 63;
        if (it < 62 * 64) { float d1[8], d2[8], uu[8]; unpack8(r1[u], d1); unpack8(r2[u], d2);
#pragma unroll
            for (int j = 0; j < 8; ++j) uu[j] = d1[j] * sigm(d2[j]);
            *(LAS f32x4*)(UD + r * 512 + cc * 8) = (f32x4){uu[0], uu[1], uu[2], uu[3]}; *(LAS f32x4*)(UD + r * 512 + cc * 8 + 4) = (f32x4){uu[4], uu[5], uu[6], uu[7]}; } } }
    __builtin_amdgcn_sched_barrier(0);
    { const int cc = C.tid & 63; const float* cw = a.in(I_CAW) + (size_t)l * 3 * 512 + cc * 8;
      const f32x4 w0a = *(const f32x4*)cw, w0b = *(const f32x4*)(cw + 4), w1a = *(const f32x4*)(cw + 512), w1b = *(const f32x4*)(cw + 516), w2a = *(const f32x4*)(cw + 1024), w2b = *(const f32x4*)(cw + 1028);
      const float k0[8] = {w0a.x, w0a.y, w0a.z, w0a.w, w0b.x, w0b.y, w0b.z, w0b.w}, k1[8] = {w1a.x, w1a.y, w1a.z, w1a.w, w1b.x, w1b.y, w1b.z, w1b.w}, k2[8] = {w2a.x, w2a.y, w2a.z, w2a.w, w2b.x, w2b.y, w2b.z, w2b.w};
#pragma unroll
      for (int hb = 0; hb < 2; ++hb) { v4u q[2][7];
#pragma unroll
        for (int u = 0; u < 2; ++u) { const int r = (C.tid >> 6) + (hb * 2 + u) * NWAVES, t = t0 + r; const bf16* pr = P + (rbase + t) * PIN + cc * 8;
#pragma unroll
            for (int z = 0; z < 7; ++z) q[u][z] = (v4u){0u, 0u, 0u, 0u};
            q[u][0] = *(const v4u*)pr; q[u][1] = *(const v4u*)(pr + 512); q[u][2] = *(const v4u*)(pr + 1024);
            if (t >= 1) { q[u][3] = *(const v4u*)(pr - PIN + 512); q[u][4] = *(const v4u*)(pr - PIN + 1024); }
            if (t >= 2) { q[u][5] = *(const v4u*)(pr - 2 * PIN + 512); q[u][6] = *(const v4u*)(pr - 2 * PIN + 1024); } }
        __builtin_amdgcn_sched_barrier(0);
#pragma unroll
        for (int u = 0; u < 2; ++u) { const int r = (C.tid >> 6) + (hb * 2 + u) * NWAVES, t = t0 + r;
            float ab[8], u0[8], u1[8], u2[8], x[8], y[8];
            unpack8(q[u][0], ab); unpack8(q[u][1], x); unpack8(q[u][2], y);
#pragma unroll
            for (int j = 0; j < 8; ++j) u2[j] = x[j] * y[j];
            unpack8(q[u][3], x); unpack8(q[u][4], y);
#pragma unroll
            for (int j = 0; j < 8; ++j) u1[j] = x[j] * y[j];
            unpack8(q[u][5], x); unpack8(q[u][6], y);
#pragma unroll
            for (int j = 0; j < 8; ++j) u0[j] = x[j] * y[j];
            float o[8];
#pragma unroll
            for (int j = 0; j < 8; ++j) o[j] = ab[j] * (k0[j] * u0[j] + k1[j] * u1[j] + k2[j] * u2[j]);
            *(v4u*)(YC + (rbase + t) * DM + cc * 8) = pack8(o);
            if (t >= SEQ - 2) { float* st = a.out + O_CAP + (((size_t)l * NB + b) * 2 + (t - (SEQ - 2))) * 512 + cc * 8; *(f32x4*)st = (f32x4){u2[0], u2[1], u2[2], u2[3]}; *(f32x4*)(st + 4) = (f32x4){u2[4], u2[5], u2[6], u2[7]}; } }
        __builtin_amdgcn_sched_barrier(0); } }
    __syncthreads();
    const int c = C.tid;
    if (t0 == SEQ - 32) { float* st = a.out + O_CDP + ((size_t)l * NB + b) * 30 * 512 + c;
        for (int j = 0; j < 30; ++j) st[(size_t)j * 512] = UD[(32 + j) * 512 + c]; }
    float cv[32];
    { const char* cwb = (const char*)(a.in(I_CDW) + (size_t)l * 31 * 512); const unsigned cof = (unsigned)c * 4u; const float bias = a.in(I_CDB)[l * 512 + c];
      float wt[31];
#pragma unroll
      for (int j = 0; j < 31; ++j) wt[j] = *(const float*)(cwb + (cof + (unsigned)j * 2048u));
      __builtin_amdgcn_sched_barrier(0);
#pragma unroll
      for (int t = 0; t < 32; ++t) cv[t] = bias;
#pragma unroll
      for (int r = 0; r < 62; ++r) { const float ur = UD[r * 512 + c];
#pragma unroll
          for (int t = 0; t < 32; ++t) { const int j = r - t; if (j >= 0 && j < 31) cv[t] += wt[j] * ur; } } }
    __syncthreads();
#pragma unroll
    for (int t = 0; t < 32; ++t) UD[t * 512 + c] = cv[t];
    __syncthreads();
    { const float* lg = a.in(I_LNDG) + l * 512 + C.lane * 8; const float* lb = a.in(I_LNDB) + l * 512 + C.lane * 8;
      const f32x4 g0 = *(const f32x4*)lg, g1 = *(const f32x4*)(lg + 4), b0 = *(const f32x4*)lb, b1 = *(const f32x4*)(lb + 4);
#pragma unroll
      for (int q = 0; q < 4; ++q) { const int t = C.wave * 4 + q; const f32x4 x0 = *(LAS f32x4*)(UD + t * 512 + C.lane * 8), x1 = *(LAS f32x4*)(UD + t * 512 + C.lane * 8 + 4);
        const float mu = wave_sum((x0.x + x0.y) + (x0.z + x0.w) + (x1.x + x1.y) + (x1.z + x1.w)) * (1.0f / 512.0f);
        const f32x4 d0 = x0 - mu, d1 = x1 - mu;
        const float var = wave_sum((d0.x * d0.x + d0.y * d0.y) + (d0.z * d0.z + d0.w * d0.w) + (d1.x * d1.x + d1.y * d1.y) + (d1.z * d1.z + d1.w * d1.w)) * (1.0f / 512.0f);
        const float rstd = 1.0f / sqrtf(var + 1e-6f);
        const f32x4 y0 = d0 * rstd * g0 + b0, y1 = d1 * rstd * g1 + b1; float o[8];
        o[0] = y0.x * sigm(y0.x); o[1] = y0.y * sigm(y0.y); o[2] = y0.z * sigm(y0.z); o[3] = y0.w * sigm(y0.w);
        o[4] = y1.x * sigm(y1.x); o[5] = y1.y * sigm(y1.y); o[6] = y1.z * sigm(y1.z); o[7] = y1.w * sigm(y1.w);
        *(v4u*)(YC + (rbase + t0 + t) * DM + 1536 + C.lane * 8) = pack8(o); } }
    __syncthreads();
}
__device__ __forceinline__ void ad_sample_item(const Ctx& C, const Ax& a, int l, int n) {
    const bf16* P = (const bf16*)(a.ws + WS_P); bf16* YC = (bf16*)(a.ws + WS_YC);
    const int c = C.tid; const bf16* pr = P + (size_t)(MP + n) * PIN;
    LAS float* red = (LAS float*)C.lds;
    { const float* st = a.in(I_SCA) + (((size_t)l * NS + n) * 2) * 512 + c; const float s0 = st[0], s1 = st[512];
      const float ua = bf1(pr[512 + c]) * bf1(pr[1024 + c]); const float* cw = a.in(I_CAW) + (size_t)l * 3 * 512 + c;
      const float y = bf1(pr[c]) * (cw[0] * s0 + cw[512] * s1 + cw[1024] * ua);
      YC[(size_t)(MP + n) * DM + c] = (bf16)(pk2(y, 0.f) & 0xffffu);
      float* o = a.out + O_CAS + (((size_t)l * NS + n) * 2) * 512 + c; o[0] = s1; o[512] = ua; }
    const float* st = a.in(I_SCD) + (((size_t)l * NS + n) * 30) * 512 + c; const float* cw = a.in(I_CDW) + (size_t)l * 31 * 512 + c;
    const float ud = bf1(pr[PD_ + c]) * sigm(bf1(pr[PD_ + 512 + c]));
    float cv = a.in(I_CDB)[l * 512 + c] + cw[30 * 512] * ud;
    float* os = a.out + O_CDS + (((size_t)l * NS + n) * 30) * 512 + c;
#pragma unroll 6
    for (int j = 0; j < 30; ++j) { const float s = st[(size_t)j * 512]; cv += cw[(size_t)j * 512] * s; if (j > 0) os[(size_t)(j - 1) * 512] = s; }
    os[29 * 512] = ud;
    float s = wave_sum(cv); if (C.lane == 0) red[C.wave] = s; __syncthreads();
    float mu = 0.f;
#pragma unroll
    for (int w = 0; w < 8; ++w) mu += red[w];
    mu *= (1.0f / 512.0f); const float d = cv - mu;
    s = wave_sum(d * d); if (C.lane == 0) red[8 + C.wave] = s; __syncthreads();
    float var = 0.f;
#pragma unroll
    for (int w = 0; w < 8; ++w) var += red[8 + w];
    const float rstd = 1.0f / sqrtf(var * (1.0f / 512.0f) + 1e-6f);
    const float y = d * rstd * a.in(I_LNDG)[l * 512 + c] + a.in(I_LNDB)[l * 512 + c];
    YC[(size_t)(MP + n) * DM + 1536 + c] = (bf16)(pk2(y * sigm(y), 0.f) & 0xffffu);
    __syncthreads();
}

__device__ __forceinline__ void shift8(const bf16* cur, const bf16* prevb, const float* prevf, const float* mu, float (&xs)[8]) {
    float pc[8], pv[8]; unpack8(*(const v4u*)cur, pc);
    if (prevb) unpack8(*(const v4u*)prevb, pv);
    else if (prevf) { const f32x4 p0 = *(const f32x4*)prevf, p1 = *(const f32x4*)(prevf + 4); pv[0] = p0.x; pv[1] = p0.y; pv[2] = p0.z; pv[3] = p0.w; pv[4] = p1.x; pv[5] = p1.y; pv[6] = p1.z; pv[7] = p1.w; }
    else {
#pragma unroll
        for (int j = 0; j < 8; ++j) pv[j] = 0.f; }
    const f32x4 m0 = *(const f32x4*)mu, m1 = *(const f32x4*)(mu + 4); const float m[8] = {m0.x, m0.y, m0.z, m0.w, m1.x, m1.y, m1.z, m1.w};
#pragma unroll
    for (int j = 0; j < 8; ++j) xs[j] = pc[j] + (pv[j] - pc[j]) * m[j];
}
__device__ __forceinline__ void shift4(const bf16* cur, const bf16* prevb, const float* prevf, const float* mu, float (&xs)[4]) {
    float pc[4], pv[4]; unpack4(*(const v2u*)cur, pc);
    if (prevb) unpack4(*(const v2u*)prevb, pv);
    else if (prevf) { const f32x4 p0 = *(const f32x4*)prevf; pv[0] = p0.x; pv[1] = p0.y; pv[2] = p0.z; pv[3] = p0.w; }
    else { pv[0] = pv[1] = pv[2] = pv[3] = 0.f; }
    const f32x4 m0 = *(const f32x4*)mu;
    xs[0] = pc[0] + (pv[0] - pc[0]) * m0.x; xs[1] = pc[1] + (pv[1] - pc[1]) * m0.y; xs[2] = pc[2] + (pv[2] - pc[2]) * m0.z; xs[3] = pc[3] + (pv[3] - pc[3]) * m0.w;
}
constexpr int PTS = 1544;
__device__ __forceinline__ void shift4_lds(const LAS bf16* cur, const float* mu, float (&xs)[4]) {
    float pc[4], pv[4]; unpack4(*(const LAS v2u*)cur, pc); unpack4(*(const LAS v2u*)(cur - PTS), pv);
    const f32x4 m0 = *(const f32x4*)mu;
    xs[0] = pc[0] + (pv[0] - pc[0]) * m0.x; xs[1] = pc[1] + (pv[1] - pc[1]) * m0.y; xs[2] = pc[2] + (pv[2] - pc[2]) * m0.z; xs[3] = pc[3] + (pv[3] - pc[3]) * m0.w;
}
constexpr int RWB = 896, RW_KK = 256, RW_KB = 384, RW_K = 512, RW_R = 640, RW_V = 768;
__device__ __forceinline__ void rw_st4(unsigned char* rec, int off, int cl, const f32x4 v) { v2u w; w.x = pk2(v[0], v[1]); w.y = pk2(v[2], v[3]); *(v2u*)(rec + off + cl * 2) = w; }
__device__ __forceinline__ f32x4 rw_ld4(const unsigned char* rec, int off, int cl) { float f[4]; unpack4(*(const v2u*)(rec + off + cl * 2), f); return (f32x4){f[0], f[1], f[2], f[3]}; }
#ifndef DUP_SUB
#define DUP_SUB 0u
#endif
#define PREP_REP(k) for (int prep_rep_ = 0; prep_rep_ < 1 + (int)((DUP_SUB >> (k)) & 1u); ++prep_rep_)
__device__ __forceinline__ void rwkv_prep_item(const Ctx& C, const Ax& a, int l, int item) {
    const bf16* P = (const bf16*)(a.ws + WS_P); float* RW = (float*)(a.ws + WS_RW); float* GATE = (float*)(a.ws + WS_GATE);
    const bool smp = item >= 256; const int row0 = smp ? MP + (item - 256) * 32 : (item >> 6) * SEQ + (item & 63) * 32; const int t0 = smp ? 0 : (item & 63) * 32;
    const float* mu = a.in(I_MU) + (size_t)l * SHW; const float* sst = a.in(I_SSH) + (size_t)l * NS * SHW;
    LAS bf16* AW = (LAS bf16*)C.lds; LAS bf16* AA = AW + 32 * 72; LAS bf16* AG = AA + 32 * 72; LAS bf16* PT = AG + 32 * 136;
    for (int it = C.tid; it < 32 * 32; it += NWAVES * 64) { const int r = it >> 5, cc = it & 31, col = 1536 + cc * 8, row = row0 + r; const bf16* cur = P + (size_t)row * PIN + PC_ + col;
        float xs[8];
        if (smp) shift8(cur, nullptr, sst + (size_t)(row - MP) * SHW + col, mu + col, xs);
        else shift8(cur, (t0 + r > 0) ? cur - PIN : nullptr, nullptr, mu + col, xs);
        if (cc < 8) {
#pragma unroll
            for (int j = 0; j < 8; ++j) xs[j] = tanhf(xs[j]);
            *(LAS v4u*)(AW + r * 72 + cc * 8) = pack8(xs); }
        else if (cc < 16) *(LAS v4u*)(AA + r * 72 + (cc - 8) * 8) = pack8(xs);
        else {
#pragma unroll
            for (int j = 0; j < 8; ++j) xs[j] = sigm(xs[j]);
            *(LAS v4u*)(AG + r * 136 + (cc - 16) * 8) = pack8(xs); } }
    if (!smp) { for (int it = C.tid; it < 33 * 192; it += NWAVES * 64) { const int r = it / 192, cc = it - r * 192; v4u v = (v4u){0u, 0u, 0u, 0u};
            if (t0 + r > 0) v = *(const v4u*)(P + (size_t)(row0 + r - 1) * PIN + PC_ + cc * 8);
            *(LAS v4u*)(PT + r * PTS + cc * 8) = v; } }
    if (smp) { float* o = a.out + O_SHS + ((size_t)l * NS + (row0 - MP)) * SHW;
        for (int it = C.tid; it < 32 * 224; it += NWAVES * 64) { const int r = it / 224, cc = it % 224; float f[8]; unpack8(*(const v4u*)(P + (size_t)(row0 + r) * PIN + PC_ + cc * 8), f);
            float* op = o + (size_t)r * SHW + cc * 8; *(f32x4*)op = (f32x4){f[0], f[1], f[2], f[3]}; *(f32x4*)(op + 4) = (f32x4){f[4], f[5], f[6], f[7]}; } }
    else if (t0 == SEQ - 32) { float* o = a.out + O_SHP + ((size_t)l * NB + (item >> 6)) * SHW;
        for (int cc = C.tid; cc < 224; cc += NWAVES * 64) { float f[8]; unpack8(*(const v4u*)(P + (size_t)(row0 + 31) * PIN + PC_ + cc * 8), f);
            *(f32x4*)(o + cc * 8) = (f32x4){f[0], f[1], f[2], f[3]}; *(f32x4*)(o + cc * 8 + 4) = (f32x4){f[4], f[5], f[6], f[7]}; } }
    __syncthreads();
    const int h = C.wave, fr = C.lane & 15, fq = C.lane >> 4;
    const unsigned char* wl = a.ws + WS_WL + (size_t)l * LW_STRIDE;
    const bf16* W2t = (const bf16*)(wl + LW_W2); const bf16* A2t = (const bf16*)(wl + LW_A2); const bf16* G2t = (const bf16*)(wl + LW_G2);
    PREP_REP(23) { constexpr int tp = 0;
        f32x4 acc[4][2];
#pragma unroll
        for (int ct = 0; ct < 4; ++ct)
#pragma unroll
            for (int t2 = 0; t2 < 2; ++t2) acc[ct][t2] = zero4();
#pragma unroll
        for (int ks = 0; ks < 2; ++ks) { bf16x8 af[2], wf[4];
#pragma unroll
            for (int t2 = 0; t2 < 2; ++t2) af[t2] = *(const LAS bf16x8*)(AA + (tp * 32 + t2 * 16 + fr) * 72 + ks * 32 + fq * 8);
#pragma unroll
            for (int ct = 0; ct < 4; ++ct) wf[ct] = *(const bf16x8*)(A2t + (size_t)(h * 64 + ct * 16 + fr) * 64 + ks * 32 + fq * 8);
#pragma unroll
            for (int ct = 0; ct < 4; ++ct)
#pragma unroll
                for (int t2 = 0; t2 < 2; ++t2) acc[ct][t2] = __builtin_amdgcn_mfma_f32_16x16x32_bf16(wf[ct], af[t2], acc[ct][t2], 0, 0, 0); }
        const float* a0 = a.in(I_A0) + l * 512; const float* kkw = a.in(I_KK) + l * 512; const float* kaw = a.in(I_KA) + l * 512;
#pragma unroll
        for (int t2 = 0; t2 < 2; ++t2) { const int r = tp * 32 + t2 * 16 + fr, row = row0 + r; const bf16* prow = P + (size_t)row * PIN + PC_;
            const float* pf = smp ? sst + (size_t)(row - MP) * SHW : nullptr;
            float kkr[4][4], av[4][4], kc[4][4]; float ss = 0.f;
#pragma unroll
            for (int ct = 0; ct < 4; ++ct) { const int ch = h * 64 + ct * 16 + fq * 4; const f32x4 a0v = *(const f32x4*)(a0 + ch), kkv = *(const f32x4*)(kkw + ch);
                float xs[4]; if (smp) shift4(prow + 512 + ch, nullptr, pf + 512 + ch, mu + 512 + ch, xs); else shift4_lds(PT + (r + 1) * PTS + 512 + ch, mu + 512 + ch, xs);
#pragma unroll
                for (int j = 0; j < 4; ++j) { av[ct][j] = sigm(a0v[j] + acc[ct][t2][j]); kc[ct][j] = xs[j]; kkr[ct][j] = xs[j] * kkv[j]; ss += kkr[ct][j] * kkr[ct][j]; } }
            ss += __shfl_xor(ss, 16); ss += __shfl_xor(ss, 32);
            const float inv = 1.0f / fmaxf(sqrtf(ss), 1e-12f);
            unsigned char* rw = (unsigned char*)RW + ((size_t)row * 8 + h) * RWB;
#pragma unroll
            for (int ct = 0; ct < 4; ++ct) { const int ch = h * 64 + ct * 16 + fq * 4, cl = ct * 16 + fq * 4; const f32x4 kav = *(const f32x4*)(kaw + ch);
                f32x4 kk, kb, k4;
#pragma unroll
                for (int j = 0; j < 4; ++j) { kk[j] = kkr[ct][j] * inv; kb[j] = kk[j] * av[ct][j]; k4[j] = kc[ct][j] * (1.0f + (av[ct][j] - 1.0f) * kav[j]); }
                rw_st4(rw, RW_KK, cl, kk); rw_st4(rw, RW_KB, cl, kb); rw_st4(rw, RW_K, cl, k4);
                float xr[4], xv[4];
                if (smp) { shift4(prow + ch, nullptr, pf + ch, mu + ch, xr); shift4(prow + 1024 + ch, nullptr, pf + 1024 + ch, mu + 1024 + ch, xv); }
                else { shift4_lds(PT + (r + 1) * PTS + ch, mu + ch, xr); shift4_lds(PT + (r + 1) * PTS + 1024 + ch, mu + 1024 + ch, xv); }
                rw_st4(rw, RW_R, cl, (f32x4){xr[0], xr[1], xr[2], xr[3]}); rw_st4(rw, RW_V, cl, (f32x4){xv[0], xv[1], xv[2], xv[3]}); } }
    }
    PREP_REP(24) { constexpr int tp = 0;
        f32x4 acc[4][2];
#pragma unroll
        for (int ct = 0; ct < 4; ++ct)
#pragma unroll
            for (int t2 = 0; t2 < 2; ++t2) acc[ct][t2] = zero4();
#pragma unroll
        for (int ks = 0; ks < 2; ++ks) { bf16x8 af[2], wf[4];
#pragma unroll
            for (int t2 = 0; t2 < 2; ++t2) af[t2] = *(const LAS bf16x8*)(AW + (tp * 32 + t2 * 16 + fr) * 72 + ks * 32 + fq * 8);
#pragma unroll
            for (int ct = 0; ct < 4; ++ct) wf[ct] = *(const bf16x8*)(W2t + (size_t)(h * 64 + ct * 16 + fr) * 64 + ks * 32 + fq * 8);
#pragma unroll
            for (int ct = 0; ct < 4; ++ct)
#pragma unroll
                for (int t2 = 0; t2 < 2; ++t2) acc[ct][t2] = __builtin_amdgcn_mfma_f32_16x16x32_bf16(wf[ct], af[t2], acc[ct][t2], 0, 0, 0); }
        const float* w0 = a.in(I_W0) + l * 512;
#pragma unroll
        for (int t2 = 0; t2 < 2; ++t2) { const int row = row0 + tp * 32 + t2 * 16 + fr; float* rw = (float*)((unsigned char*)RW + ((size_t)row * 8 + h) * RWB);
#pragma unroll
            for (int ct = 0; ct < 4; ++ct) { const int ch = h * 64 + ct * 16 + fq * 4, cl = ct * 16 + fq * 4; const f32x4 w0v = *(const f32x4*)(w0 + ch); f32x4 d;
#pragma unroll
                for (int j = 0; j < 4; ++j) { const float z = -(w0v[j] + acc[ct][t2][j]); const float sp = fmaxf(z, 0.f) + __logf(1.0f + __expf(-fabsf(z))); const float w = -sp - 0.5f; d[j] = -__expf(w); }
                *(f32x4*)(rw + cl) = d; } }
    }
    PREP_REP(25) { constexpr int tp = 0;
        f32x4 acc[4][2];
#pragma unroll
        for (int ct = 0; ct < 4; ++ct)
#pragma unroll
            for (int t2 = 0; t2 < 2; ++t2) acc[ct][t2] = zero4();
#pragma unroll
        for (int ks = 0; ks < 4; ++ks) { bf16x8 af[2], wf[4];
#pragma unroll
            for (int t2 = 0; t2 < 2; ++t2) af[t2] = *(const LAS bf16x8*)(AG + (tp * 32 + t2 * 16 + fr) * 136 + ks * 32 + fq * 8);
#pragma unroll
            for (int ct = 0; ct < 4; ++ct) wf[ct] = *(const bf16x8*)(G2t + (size_t)(h * 64 + ct * 16 + fr) * 128 + ks * 32 + fq * 8);
#pragma unroll
            for (int ct = 0; ct < 4; ++ct)
#pragma unroll
                for (int t2 = 0; t2 < 2; ++t2) acc[ct][t2] = __builtin_amdgcn_mfma_f32_16x16x32_bf16(wf[ct], af[t2], acc[ct][t2], 0, 0, 0); }
#pragma unroll
        for (int t2 = 0; t2 < 2; ++t2) { const int row = row0 + tp * 32 + t2 * 16 + fr;
#pragma unroll
            for (int ct = 0; ct < 4; ++ct) *(f32x4*)(GATE + (size_t)row * 512 + h * 64 + ct * 16 + fq * 4) = acc[ct][t2]; }
    }
    __syncthreads();
}

#define PACK8(arr, o) ((v4u){pk2((arr)[(o)], (arr)[(o) + 1]), pk2((arr)[(o) + 2], (arr)[(o) + 3]), pk2((arr)[(o) + 4], (arr)[(o) + 5]), pk2((arr)[(o) + 6], (arr)[(o) + 7])})
constexpr int WK_LDS = 18432, WK_SHR = 6912, WK_PRV = 3072;
__device__ __forceinline__ f32x4 mfma16(bf16x4 a, bf16x4 b, f32x4 c) { return __builtin_amdgcn_mfma_f32_16x16x16bf16_1k(a, b, c, 0, 0, 0); }
__device__ __forceinline__ bf16 bfr1(float x) { return (bf16)(pk2(x, 0.f) & 0xffffu); }
__device__ __forceinline__ void wkv_chunk_witem(const Ctx& C, const Ax& a, int ci) {
    const float* RW = (const float*)(a.ws + WS_RW);
    unsigned char* CK = a.ws + WS_CK + (size_t)ci * WK_SHR; unsigned char* CP = a.ws + WS_CP + (size_t)ci * 4 * WK_PRV;
    const int bh = ci >> 7, c = ci & 127, b = bh >> 3, h = bh & 7, lane = C.lane, fr = lane & 15, fq = lane >> 4;
    LAS unsigned char* Lb = C.lds + C.wave * WK_LDS;
    LAS bf16* TA = (LAS bf16*)Lb; LAS bf16* TB = TA + 16 * 72; LAS bf16* TK = TB + 16 * 72; LAS bf16* TR = TK + 16 * 72; LAS bf16* VT = TR + 16 * 72;
    LAS float* M1 = (LAS float*)(Lb + 12288); LAS float* M2 = M1 + 320; LAS float* N1 = M2 + 320; LAS float* N2 = N1 + 320;
    LAS bf16* TG = TA; LAS bf16* PST = TK;
    const unsigned char* rw = (const unsigned char*)RW + (((size_t)b * SEQ + c * 16) * 8 + h) * RWB;
#define RWF(t) (*(const float*)(rw + (size_t)(t) * (8 * RWB) + lane * 4))
#define RWH(t, off) bf1(*(const bf16*)(rw + (size_t)(t) * (8 * RWB) + (off) + lane * 2))
    float lam[16];
#pragma unroll
    for (int t = 0; t < 16; ++t) lam[t] = RWF(t);
    __builtin_amdgcn_sched_barrier(0);
#pragma unroll
    for (int t = 1; t < 16; ++t) lam[t] += lam[t - 1];
    const float lamT = lam[15];
    ((float*)CK)[lane] = __expf(lamT);
    float Bp[16], Kp[16], al[16], ro[16];
    bf16* ATg = (bf16*)(CK + 256); bf16* OMg = (bf16*)(CK + 256 + 2304);
#define RWR(t, off) (*(const bf16*)(rw + (size_t)(t) * (8 * RWB) + (off) + lane * 2))
    bf16 wkk[4], wbb[4], wkx[4], wrr[4], wvv[4];
#pragma unroll
    for (int t = 0; t < 4; ++t) { wkk[t] = RWR(t, RW_KK); wbb[t] = RWR(t, RW_KB); wkx[t] = RWR(t, RW_K); wrr[t] = RWR(t, RW_R); wvv[t] = RWR(t, RW_V); }
    __builtin_amdgcn_sched_barrier(0);
#pragma unroll
    for (int t = 0; t < 16; ++t) { const float kk = bf1(wkk[t & 3]), bb = bf1(wbb[t & 3]), kx = bf1(wkx[t & 3]), rr = bf1(wrr[t & 3]), vv = bf1(wvv[t & 3]);
        if (t + 4 < 16) { wkk[t & 3] = RWR(t + 4, RW_KK); wbb[t & 3] = RWR(t + 4, RW_KB); wkx[t & 3] = RWR(t + 4, RW_K); wrr[t & 3] = RWR(t + 4, RW_R); wvv[t & 3] = RWR(t + 4, RW_V); }
        const float ein = __expf(-lam[t]), eprev = (t ? __expf(lam[t - 1]) : 1.0f), ecur = __expf(lam[t]), erest = __expf(lamT - lam[t]);
        al[t] = kk * eprev; ro[t] = rr * ecur; Bp[t] = bb * erest; Kp[t] = kx * erest;
        const bf16 ab = bfr1(al[t]);
        TA[t * 72 + lane] = ab; TB[t * 72 + lane] = bfr1(bb * ein); TK[t * 72 + lane] = bfr1(kx * ein); TR[t * 72 + lane] = bfr1(ro[t]); VT[lane * 24 + t] = bfr1(vv);
        ATg[t * 72 + lane] = ab;
        asm volatile("" ::: "memory"); __builtin_amdgcn_sched_barrier(0); }
    LDS_WAIT(); asm volatile("" ::: "memory");
    { f32x4 g1 = zero4(), g2 = zero4(), n1 = zero4(), n2 = zero4();
#pragma unroll
      for (int ks = 0; ks < 2; ++ks) { const int o = fr * 72 + ks * 32 + fq * 8;
        const bf16x8 bf_ = *(const LAS bf16x8*)(TB + o), kf_ = *(const LAS bf16x8*)(TK + o), af_ = *(const LAS bf16x8*)(TA + o), rf_ = *(const LAS bf16x8*)(TR + o);
        g1 = __builtin_amdgcn_mfma_f32_16x16x32_bf16(bf_, af_, g1, 0, 0, 0); g2 = __builtin_amdgcn_mfma_f32_16x16x32_bf16(kf_, af_, g2, 0, 0, 0);
        n1 = __builtin_amdgcn_mfma_f32_16x16x32_bf16(bf_, rf_, n1, 0, 0, 0); n2 = __builtin_amdgcn_mfma_f32_16x16x32_bf16(kf_, rf_, n2, 0, 0, 0); }
#pragma unroll
      for (int r = 0; r < 4; ++r) { const int s_ = 4 * fq + r, o = s_ * 20 + fr;
        M1[o] = (s_ < fr) ? g1[r] : 0.f; M2[o] = (s_ < fr) ? g2[r] : 0.f; N1[o] = (s_ <= fr) ? n1[r] : 0.f; N2[o] = (s_ <= fr) ? n2[r] : 0.f; } }
    LDS_WAIT(); asm volatile("" ::: "memory");
    __builtin_amdgcn_sched_barrier(0);
#pragma unroll
    for (int s_ = 14; s_ >= 0; --s_) { float m[16];
#pragma unroll
        for (int q = 0; q < 4; ++q) { const f32x4 v = *(const LAS f32x4*)(M1 + s_ * 20 + 4 * q); m[4 * q] = v.x; m[4 * q + 1] = v.y; m[4 * q + 2] = v.z; m[4 * q + 3] = v.w; }
        float acc = Bp[s_];
#pragma unroll
        for (int t = s_ + 1; t < 16; ++t) acc -= m[t] * Bp[t];
        asm volatile("" : "+v"(acc) :: "memory"); Bp[s_] = acc; __builtin_amdgcn_sched_barrier(0); }
#pragma unroll
    for (int s_ = 0; s_ < 15; ++s_) { float m[16];
#pragma unroll
        for (int q = 0; q < 4; ++q) { const f32x4 v = *(const LAS f32x4*)(M2 + s_ * 20 + 4 * q); m[4 * q] = v.x; m[4 * q + 1] = v.y; m[4 * q + 2] = v.z; m[4 * q + 3] = v.w; }
        float acc = Kp[s_];
#pragma unroll
        for (int t = s_ + 1; t < 16; ++t) acc -= m[t] * Bp[t];
        asm volatile("" : "+v"(acc) :: "memory"); Kp[s_] = acc; __builtin_amdgcn_sched_barrier(0); }
    __builtin_amdgcn_sched_barrier(0);
    { float ng[16];
#pragma unroll
      for (int t = 0; t < 16; ++t) ng[t] = -Bp[t];
      *(v4u*)(CK + 256 + 4608 + lane * 32) = PACK8(ng, 0); *(v4u*)(CK + 256 + 4608 + lane * 32 + 16) = PACK8(ng, 8); }
    *(LAS v4u*)(TG + lane * 24) = PACK8(Kp, 0); *(LAS v4u*)(TG + lane * 24 + 8) = PACK8(Kp, 8);
    __builtin_amdgcn_sched_barrier(0);
    { float hh[16], ps[16];
#pragma unroll
      for (int s_ = 0; s_ < 16; ++s_) { hh[s_] = N1[s_ * 20 + fr]; ps[s_] = N2[s_ * 20 + fr]; }
#pragma unroll
      for (int s_ = 14; s_ >= 0; --s_) { float m[16];
#pragma unroll
        for (int q = 0; q < 4; ++q) { const f32x4 v = *(const LAS f32x4*)(M1 + s_ * 20 + 4 * q); m[4 * q] = v.x; m[4 * q + 1] = v.y; m[4 * q + 2] = v.z; m[4 * q + 3] = v.w; }
        float acc = hh[s_];
#pragma unroll
        for (int u = s_ + 1; u < 16; ++u) acc -= m[u] * hh[u];
        asm volatile("" : "+v"(acc) :: "memory"); hh[s_] = acc; __builtin_amdgcn_sched_barrier(0); }
#pragma unroll
      for (int s_ = 0; s_ < 15; ++s_) { float m[16];
#pragma unroll
        for (int q = 0; q < 4; ++q) { const f32x4 v = *(const LAS f32x4*)(M2 + s_ * 20 + 4 * q); m[4 * q] = v.x; m[4 * q + 1] = v.y; m[4 * q + 2] = v.z; m[4 * q + 3] = v.w; }
        float acc = ps[s_];
#pragma unroll
        for (int u = s_ + 1; u < 16; ++u) acc -= m[u] * hh[u];
        asm volatile("" : "+v"(acc) :: "memory"); ps[s_] = acc; __builtin_amdgcn_sched_barrier(0); }
      LDS_WAIT(); asm volatile("" ::: "memory");
#pragma unroll
      for (int s_ = 0; s_ < 16; ++s_) N1[s_ * 20 + fr] = hh[s_];
      *(LAS v4u*)(PST + fr * 24) = PACK8(ps, 0); *(LAS v4u*)(PST + fr * 24 + 8) = PACK8(ps, 8); }
    LDS_WAIT(); asm volatile("" ::: "memory");
    __builtin_amdgcn_sched_barrier(0);
#pragma unroll
    for (int s_ = 0; s_ < 16; ++s_) { float m[16];
#pragma unroll
        for (int q = 0; q < 4; ++q) { const f32x4 v = *(const LAS f32x4*)(N1 + s_ * 20 + 4 * q); m[4 * q] = v.x; m[4 * q + 1] = v.y; m[4 * q + 2] = v.z; m[4 * q + 3] = v.w; }
#pragma unroll
        for (int t = s_; t < 16; ++t) ro[t] -= m[t] * al[s_];
        asm volatile("" ::: "memory"); __builtin_amdgcn_sched_barrier(0); }
#pragma unroll
    for (int t = 0; t < 16; ++t) OMg[t * 72 + lane] = bfr1(ro[t]);
    LDS_WAIT(); asm volatile("" ::: "memory");
    __builtin_amdgcn_sched_barrier(0);
    { bf16x4 vf[4];
#pragma unroll
      for (int it = 0; it < 4; ++it) vf[it] = *(const LAS bf16x4*)(VT + (it * 16 + fr) * 24 + fq * 4);
#pragma unroll
      for (int kt = 0; kt < 4; ++kt) { const bf16x4 gf = *(const LAS bf16x4*)(TG + (kt * 16 + fr) * 24 + fq * 4);
#pragma unroll
        for (int it = 0; it < 4; ++it) { const f32x4 d = mfma16(gf, vf[it], zero4()); v2u dw; dw.x = pk2(d[0], d[1]); dw.y = pk2(d[2], d[3]); *(v2u*)(CP + it * WK_PRV + kt * 512 + lane * 8) = dw; } }
      const bf16x4 pf = *(const LAS bf16x4*)(PST + fr * 24 + fq * 4);
#pragma unroll
      for (int it = 0; it < 4; ++it) { const f32x4 o = mfma16(pf, vf[it], zero4()); *(f32x4*)(CP + it * WK_PRV + 2048 + lane * 16) = o; } }
    LDS_WAIT(); asm volatile("" ::: "memory");
}
constexpr int WQ_CH = WK_PRV + WK_SHR, WQ_SLOT = 4 * WQ_CH, WQ_PCS = WQ_CH / 16, WQ_NWL = 4 * WQ_PCS / 64;
__device__ __forceinline__ void wkv_seq_chunk(const LAS unsigned char* sp, f32x4 (&acc)[4], float* orow, int lane, int fr, int fq) {
    const LAS unsigned char* sh = sp + WK_PRV;
    bf16x8 af[2], of[2]; bf16x4 gf[4]; f32x4 wt[4], dt[4];
#pragma unroll
    for (int s = 0; s < 2; ++s) { const LAS bf16* ap = (const LAS bf16*)(sh + 256) + fr * 72 + 32 * s + 4 * fq; const v2u lo = *(const LAS v2u*)ap, hi = *(const LAS v2u*)(ap + 16);
        af[s] = __builtin_bit_cast(bf16x8, (v4u){lo.x, lo.y, hi.x, hi.y});
        const LAS bf16* op = (const LAS bf16*)(sh + 256 + 2304) + fr * 72 + 32 * s + 4 * fq; const v2u lo2 = *(const LAS v2u*)op, hi2 = *(const LAS v2u*)(op + 16);
        of[s] = __builtin_bit_cast(bf16x8, (v4u){lo2.x, lo2.y, hi2.x, hi2.y}); }
#pragma unroll
    for (int kt = 0; kt < 4; ++kt) { gf[kt] = *(const LAS bf16x4*)((const LAS bf16*)(sh + 256 + 4608) + (kt * 16 + fr) * 16 + 4 * fq);
        wt[kt] = *(const LAS f32x4*)(sh + (16 * kt + 4 * fq) * 4); { float f_[4]; unpack4(*(const LAS v2u*)(sp + kt * 512 + lane * 8), f_); dt[kt] = (f32x4){f_[0], f_[1], f_[2], f_[3]}; } }
    const f32x4 ov = *(const LAS f32x4*)(sp + 2048 + lane * 16);
    bf16x8 sbf[2];
#pragma unroll
    for (int s = 0; s < 2; ++s) { v4u w; w.x = pk2(acc[2 * s][0], acc[2 * s][1]); w.y = pk2(acc[2 * s][2], acc[2 * s][3]); w.z = pk2(acc[2 * s + 1][0], acc[2 * s + 1][1]); w.w = pk2(acc[2 * s + 1][2], acc[2 * s + 1][3]);
        sbf[s] = __builtin_bit_cast(bf16x8, w); }
    f32x4 x = zero4();
    x = __builtin_amdgcn_mfma_f32_16x16x32_bf16(af[0], sbf[0], x, 0, 0, 0); x = __builtin_amdgcn_mfma_f32_16x16x32_bf16(af[1], sbf[1], x, 0, 0, 0);
    f32x4 o = __builtin_amdgcn_mfma_f32_16x16x32_bf16(of[0], sbf[0], ov, 0, 0, 0); o = __builtin_amdgcn_mfma_f32_16x16x32_bf16(of[1], sbf[1], o, 0, 0, 0);
    v2u xw; xw.x = pk2(x[0], x[1]); xw.y = pk2(x[2], x[3]); const bf16x4 xb = __builtin_bit_cast(bf16x4, xw);
#pragma unroll
    for (int kt = 0; kt < 4; ++kt) acc[kt] = mfma16(gf[kt], xb, acc[kt] * wt[kt] + dt[kt]);
    orow[0] = o[0]; orow[512] = o[1]; orow[1024] = o[2]; orow[1536] = o[3];
}
__device__ __forceinline__ void wkv_seq_item(const Ctx& C, const Ax& a, int l, int item) {
    const int bh = item >> 2, rg = item & 3, b = bh >> 3, h = bh & 7, lane = C.lane, fr = lane & 15, fq = lane >> 4;
    const unsigned char* CK = a.ws + WS_CK + (size_t)bh * 128 * WK_SHR; const unsigned char* CP = a.ws + WS_CP + ((size_t)bh * 128 * 4 + rg) * WK_PRV;
    float* OC = (float*)(a.ws + WS_OC) + ((size_t)b * SEQ) * 512 + h * 64 + rg * 16 + fr;
#define WQ_COMPUTE(blk) do { const LAS unsigned char* sbp = C.lds + ((blk) % 3) * WQ_SLOT; \
            _Pragma("unroll 2") for (int cq = 0; cq < 4; ++cq) wkv_seq_chunk(sbp + cq * WQ_CH, acc, OC + (size_t)(((blk) * 4 + cq) * 16 + 4 * fq) * 512, lane, fr, fq); } while (0)
    static_assert(4 * WQ_PCS == WQ_NWL * 64 && WQ_NWL > 35 && WQ_NWL <= 42 && 3 * WQ_SLOT <= SCR_BYTES, "ring geometry");
    if (C.wave == 0) {
        f32x4 acc[4];
#pragma unroll
        for (int kt = 0; kt < 4; ++kt) acc[kt] = zero4();
        __builtin_amdgcn_s_barrier(); asm volatile("" ::: "memory");
        for (int blk = 0; blk < 32; ++blk) { WQ_COMPUTE(blk); asm volatile("s_waitcnt lgkmcnt(0)" ::: "memory"); __builtin_amdgcn_s_barrier(); asm volatile("" ::: "memory"); }
        float* so = a.out + O_WKVP + ((((size_t)l * NB + b) * 8 + h) * 64 + rg * 16 + fr) * 64 + 4 * fq;
#pragma unroll
        for (int kt = 0; kt < 4; ++kt) *(f32x4*)(so + 16 * kt) = acc[kt];
    } else {
        const int w1 = C.wave - 1; const bool seven = (w1 + 35) < WQ_NWL;
        const unsigned char* wsb = a.ws; unsigned qoff[6], qstr[6];
#pragma unroll
        for (int i = 0; i < 6; ++i) { const int p = (w1 + 7 * i) * 64 + lane, cq = p / WQ_PCS, q = p - cq * WQ_PCS; const bool pr = q < WK_PRV / 16;
            qoff[i] = pr ? (unsigned)(WS_CP + ((size_t)bh * 128 * 4 + rg) * WK_PRV) + (unsigned)(cq * 4 * WK_PRV + q * 16) : (unsigned)(WS_CK + (size_t)bh * 128 * WK_SHR) + (unsigned)(cq * WK_SHR + (q - WK_PRV / 16) * 16);
            qstr[i] = pr ? (unsigned)(16 * WK_PRV) : (unsigned)(4 * WK_SHR); }
#define WQ_DMA(blk) do { _Pragma("unroll") for (int i = 0; i < 6; ++i) if (i < 5 || seven) \
            __builtin_amdgcn_global_load_lds((const unsigned*)(wsb + (qoff[i] + (unsigned)(blk) * qstr[i])), (LAS unsigned*)(C.lds + ((blk) % 3) * WQ_SLOT + (w1 + 7 * i) * 1024), 16, 0, 0); } while (0)
#define WQ_WAIT_OLDER() do { if (seven) asm volatile("s_waitcnt vmcnt(6)" ::: "memory"); else asm volatile("s_waitcnt vmcnt(5)" ::: "memory"); } while (0)
        WQ_DMA(0); WQ_DMA(1); WQ_WAIT_OLDER();
        __builtin_amdgcn_s_barrier(); asm volatile("" ::: "memory");
        for (int blk = 0; blk < 32; ++blk) {
            if (blk + 2 < 32) { WQ_DMA(blk + 2); WQ_WAIT_OLDER(); }
            else asm volatile("s_waitcnt vmcnt(0)" ::: "memory");
            __builtin_amdgcn_s_barrier(); asm volatile("" ::: "memory");
        }
#undef WQ_DMA
#undef WQ_WAIT_OLDER
    }
#undef WQ_COMPUTE
    __syncthreads();
}
__device__ __forceinline__ void rwkv_sample_witem(const Ctx& C, const Ax& a, int l, int witem) {
    const float* RW = (const float*)(a.ws + WS_RW); float* OC = (float*)(a.ws + WS_OC);
    const int n = witem >> 4, h = (witem >> 1) & 7, half = witem & 1, g = C.lane & 15, rq = C.lane >> 4;
    const unsigned char* p = (const unsigned char*)RW + ((size_t)(MP + n) * 8 + h) * RWB;
    const f32x4 lw4 = *(const f32x4*)(p + 16 * g), kk4 = rw_ld4(p, RW_KK, 4 * g), b4 = rw_ld4(p, RW_KB, 4 * g), k4 = rw_ld4(p, RW_K, 4 * g), r4 = rw_ld4(p, RW_R, 4 * g);
    const f32x4 w4 = (f32x4){__expf(lw4.x), __expf(lw4.y), __expf(lw4.z), __expf(lw4.w)};
    const float* sin_ = a.in(I_SWKV) + (((size_t)l * NS + n) * 8 + h) * 4096; float* sout = a.out + O_WKVS + (((size_t)l * NS + n) * 8 + h) * 4096;
#pragma unroll 4
    for (int it = 0; it < 8; ++it) { const int i = half * 32 + it * 4 + rq; const f32x4 S = __builtin_nontemporal_load((const f32x4*)(sin_ + i * 64 + 4 * g)); const float vi = bf1(*(const bf16*)(p + RW_V + i * 2));
        const float sa = -rowsum16((S.x * kk4.x + S.y * kk4.y) + (S.z * kk4.z + S.w * kk4.w));
        f32x4 T; T.x = S.x * w4.x + (sa * b4.x + vi * k4.x); T.y = S.y * w4.y + (sa * b4.y + vi * k4.y); T.z = S.z * w4.z + (sa * b4.z + vi * k4.z); T.w = S.w * w4.w + (sa * b4.w + vi * k4.w);
        const float o = rowsum16((T.x * r4.x + T.y * r4.y) + (T.z * r4.z + T.w * r4.w));
        __builtin_nontemporal_store(T, (f32x4*)(sout + i * 64 + 4 * g));
        if (g == 0) OC[(size_t)(MP + n) * 512 + h * 64 + i] = o; }
}
__device__ __forceinline__ void rwkv_post_phase(const Ctx& C, const Ax& a, int l) {
    const float* RW = (const float*)(a.ws + WS_RW); const float* OC = (const float*)(a.ws + WS_OC); const float* GATE = (const float*)(a.ws + WS_GATE); bf16* YC = (bf16*)(a.ws + WS_YC);
    const int gw = C.bid * NWAVES + C.wave, NGW = C.G * NWAVES, g = C.lane & 15, rq = C.lane >> 4;
    const float* lg = a.in(I_LNXG) + l * 512; const float* lb = a.in(I_LNXB) + l * 512; const float* rk = a.in(I_RK) + l * 512;
    const int h = (gw * 4 + rq) & 7, ch = h * 64 + 4 * g;
    const f32x4 rkv = *(const f32x4*)(rk + ch), lgv = *(const f32x4*)(lg + ch), lbv = *(const f32x4*)(lb + ch);
    constexpr int NIT = MT * 8 / 4;
    for (int it0 = gw; it0 < NIT; it0 += 3 * NGW) {
        f32x4 po[3], pg[3]; v2u pk[3], pr[3], pv[3];
#pragma unroll
        for (int u = 0; u < 3; ++u) { const int it = it0 + u * NGW; if (it < NIT) { const int row = (it * 4 + rq) >> 3; const unsigned char* rw = (const unsigned char*)RW + ((size_t)row * 8 + h) * RWB + 8 * g;
            po[u] = *(const f32x4*)(OC + (size_t)row * 512 + ch); pg[u] = *(const f32x4*)(GATE + (size_t)row * 512 + ch);
            pk[u] = *(const v2u*)(rw + RW_K); pr[u] = *(const v2u*)(rw + RW_R); pv[u] = *(const v2u*)(rw + RW_V); } }
        __builtin_amdgcn_sched_barrier(0);
#pragma unroll
        for (int u = 0; u < 3; ++u) { const int it = it0 + u * NGW; if (it < NIT) { const int row = (it * 4 + rq) >> 3; const f32x4 o = po[u];
            const float mu = rowsum16((o.x + o.y) + (o.z + o.w)) * (1.0f / 64.0f); const f32x4 d = o - mu;
            const float var = rowsum16((d.x * d.x + d.y * d.y) + (d.z * d.z + d.w * d.w)) * (1.0f / 64.0f); const float rstd = 1.0f / sqrtf(var + 64e-5f);
            float kf[4], rf[4], vf[4]; unpack4(pk[u], kf); unpack4(pr[u], rf); unpack4(pv[u], vf);
            const float bs = rowsum16((rf[0] * kf[0] * rkv.x + rf[1] * kf[1] * rkv.y) + (rf[2] * kf[2] * rkv.z + rf[3] * kf[3] * rkv.w));
            const f32x4 v4 = (f32x4){vf[0], vf[1], vf[2], vf[3]};
            const f32x4 y = (d * rstd * lgv + lbv + bs * v4) * pg[u];
            v2u w; w.x = pk2(y.x, y.y); w.y = pk2(y.z, y.w); *(v2u*)(YC + (size_t)row * DM + 1024 + ch) = w; } }
        __builtin_amdgcn_sched_barrier(0);
    }
}

__device__ __forceinline__ float ret_lg(int h) { return log1pf(-exp2f(-5.0f - (float)h)); }
constexpr int RS = 136;
__device__ __forceinline__ void rot8(const bf16* src, const float* cs, int c8, float scale, float (&lo)[8], float (&hi)[8]) {
    float x1[8], x2[8]; unpack8(*(const v4u*)(src + c8 * 8), x1); unpack8(*(const v4u*)(src + 64 + c8 * 8), x2);
    const f32x4* cp = (const f32x4*)(cs + 16 * c8); const f32x4 t0 = cp[0], t1 = cp[1], t2 = cp[2], t3 = cp[3];
    const float cc[8] = {t0.x, t0.z, t1.x, t1.z, t2.x, t2.z, t3.x, t3.z}, sn[8] = {t0.y, t0.w, t1.y, t1.w, t2.y, t2.w, t3.y, t3.w};
#pragma unroll
    for (int j = 0; j < 8; ++j) { lo[j] = (x1[j] * cc[j] - x2[j] * sn[j]) * scale; hi[j] = (x2[j] * cc[j] + x1[j] * sn[j]) * scale; }
}
struct RotX { v4u a, b; }; struct RotT { f32x4 t0, t1, t2, t3; };
__device__ __forceinline__ RotX rot_ldx(const bf16* src, int c8) { RotX r; r.a = *(const v4u*)(src + c8 * 8); r.b = *(const v4u*)(src + 64 + c8 * 8); return r; }
__device__ __forceinline__ RotT rot_ldt(const float* cs, int c8) { const f32x4* cp = (const f32x4*)(cs + 16 * c8); RotT r; r.t0 = cp[0]; r.t1 = cp[1]; r.t2 = cp[2]; r.t3 = cp[3]; return r; }
__device__ __forceinline__ void rot_ap(const RotX& x, const RotT& t, float scale, float (&lo)[8], float (&hi)[8]) {
    float x1[8], x2[8]; unpack8(x.a, x1); unpack8(x.b, x2);
    const float cc[8] = {t.t0.x, t.t0.z, t.t1.x, t.t1.z, t.t2.x, t.t2.z, t.t3.x, t.t3.z}, sn[8] = {t.t0.y, t.t0.w, t.t1.y, t.t1.w, t.t2.y, t.t2.w, t.t3.y, t.t3.w};
#pragma unroll
    for (int j = 0; j < 8; ++j) { lo[j] = (x1[j] * cc[j] - x2[j] * sn[j]) * scale; hi[j] = (x2[j] * cc[j] + x1[j] * sn[j]) * scale; }
}
__device__ __forceinline__ void ret_pass1_item(const Ctx& C, const Ax& a, int item) {
    const bf16* P = (const bf16*)(a.ws + WS_P); const float* CS = (const float*)(a.ws + WS_ROPE); float* KVT = (float*)(a.ws + WS_KVT);
    const int b = item >> 6, h = (item >> 4) & 3, c = item & 15; const size_t row0 = (size_t)b * SEQ + c * 128; const float lg = ret_lg(h);
    LAS bf16* KT = (LAS bf16*)C.lds; LAS bf16* VT = KT + 128 * RS;
    { RotX kx[2]; RotT kt[2]; v4u vw[4];
#pragma unroll
      for (int u = 0; u < 2; ++u) { const int it = C.tid + u * (NWAVES * 64), tt = it & 127, c8 = it >> 7; kx[u] = rot_ldx(P + (row0 + tt) * PIN + PB_ + 512 + h * 128, c8); kt[u] = rot_ldt(CS + (size_t)(c * 128 + tt) * 128, c8); }
#pragma unroll
      for (int u = 0; u < 4; ++u) { const int it = C.tid + u * (NWAVES * 64), tt = it & 127, c8 = it >> 7; vw[u] = *(const v4u*)(P + (row0 + tt) * PIN + PB_ + 1024 + h * 128 + c8 * 8); }
      __builtin_amdgcn_sched_barrier(0);
#pragma unroll
      for (int u = 0; u < 2; ++u) { const int it = C.tid + u * (NWAVES * 64), tt = it & 127, c8 = it >> 7; float lo[8], hi[8];
        rot_ap(kx[u], kt[u], 0.08838834764831845f * __expf(lg * (float)(127 - tt)), lo, hi);
#pragma unroll
        for (int j = 0; j < 8; ++j) { KT[(c8 * 8 + j) * RS + tt] = (bf16)(pk2(lo[j], 0.f) & 0xffffu); KT[(64 + c8 * 8 + j) * RS + tt] = (bf16)(pk2(hi[j], 0.f) & 0xffffu); } }
#pragma unroll
      for (int u = 0; u < 4; ++u) { const int it = C.tid + u * (NWAVES * 64), tt = it & 127, c8 = it >> 7; const unsigned ww[4] = {vw[u].x, vw[u].y, vw[u].z, vw[u].w};
#pragma unroll
        for (int j = 0; j < 4; ++j) { VT[(c8 * 8 + 2 * j) * RS + tt] = (bf16)(ww[j] & 0xffffu); VT[(c8 * 8 + 2 * j + 1) * RS + tt] = (bf16)(ww[j] >> 16); } } }
    __syncthreads();
    const int fr = C.lane & 15, fq = C.lane >> 4, w = C.wave;
    f32x4 acc[8];
#pragma unroll
    for (int et = 0; et < 8; ++et) acc[et] = zero4();
#pragma unroll
    for (int ks = 0; ks < 4; ++ks) { const bf16x8 kf = *(const LAS bf16x8*)(KT + (16 * w + fr) * RS + ks * 32 + fq * 8);
#pragma unroll
        for (int et = 0; et < 8; ++et) { const bf16x8 vf = *(const LAS bf16x8*)(VT + (16 * et + fr) * RS + ks * 32 + fq * 8); acc[et] = __builtin_amdgcn_mfma_f32_16x16x32_bf16(kf, vf, acc[et], 0, 0, 0); } }
    float* o = KVT + (size_t)item * 16384;
#pragma unroll
    for (int et = 0; et < 8; ++et) *(f32x4*)(o + (size_t)(16 * et + fr) * 128 + 16 * w + 4 * fq) = acc[et];
    __syncthreads();
}
__device__ __forceinline__ void ret_prefix_phase(const Ctx& C, const Ax& a, int l) {
    const float* KVT = (const float*)(a.ws + WS_KVT); bf16* STB = (bf16*)(a.ws + WS_STB);
    const int gt = C.bid * (NWAVES * 64) + C.tid, NT = C.G * NWAVES * 64;
    for (int idx = gt; idx < 16 * 4096; idx += NT) { const int bh = idx >> 12, r = idx & 4095, e = r >> 5, d4 = (r & 31) * 4; const int h = bh & 3;
        const float g128 = __expf(ret_lg(h) * 128.0f); const size_t base = (size_t)bh * 16 * 16384 + e * 128 + d4;
        f32x4 kv[16];
#pragma unroll
        for (int c = 0; c < 16; ++c) kv[c] = *(const f32x4*)(KVT + base + (size_t)c * 16384);
        f32x4 S = zero4();
#pragma unroll
        for (int c = 0; c < 16; ++c) { v2u w; w.x = pk2(S.x, S.y); w.y = pk2(S.z, S.w); *(v2u*)(STB + base + (size_t)c * 16384) = w; S = S * g128 + kv[c]; }
        float* o = a.out + O_RETP + ((size_t)l * 16 + bh) * 16384 + e;
        o[(size_t)d4 * 128] = S.x; o[(size_t)(d4 + 1) * 128] = S.y; o[(size_t)(d4 + 2) * 128] = S.z; o[(size_t)(d4 + 3) * 128] = S.w; }
}
__device__ __forceinline__ void ret_pass2_item(const Ctx& C, const Ax& a, int l, int item) {
    const bf16* P = (const bf16*)(a.ws + WS_P); const float* CS = (const float*)(a.ws + WS_ROPE); bf16* YC = (bf16*)(a.ws + WS_YC);
    const int b = item >> 6, h = (item >> 4) & 3, c = item & 15; const size_t row0 = (size_t)b * SEQ + c * 128; const float lg = ret_lg(h);
    LAS bf16* QL = (LAS bf16*)C.lds; LAS bf16* KL = QL + 128 * RS; LAS bf16* VT = KL + 128 * RS; LAS bf16* ST = VT + 128 * RS;
    { RotX qx[2], kx[2]; RotT kt[2]; v4u vw[4], sw[4]; const bf16* stb = (const bf16*)(a.ws + WS_STB) + (size_t)item * 16384;
#pragma unroll
      for (int u = 0; u < 2; ++u) { const int it = C.tid + u * (NWAVES * 64), tt = it & 127, c8 = it >> 7; const bf16* pr = P + (row0 + tt) * PIN + PB_ + h * 128;
        qx[u] = rot_ldx(pr, c8); kx[u] = rot_ldx(pr + 512, c8); kt[u] = rot_ldt(CS + (size_t)(c * 128 + tt) * 128, c8); }
#pragma unroll
      for (int u = 0; u < 4; ++u) { const int it = C.tid + u * (NWAVES * 64), tt = it & 127, c8 = it >> 7; vw[u] = *(const v4u*)(P + (row0 + tt) * PIN + PB_ + 1024 + h * 128 + c8 * 8);
        sw[u] = *(const v4u*)(stb + (it >> 4) * 128 + (it & 15) * 8); }
      __builtin_amdgcn_sched_barrier(0);
#pragma unroll
      for (int u = 0; u < 2; ++u) { const int it = C.tid + u * (NWAVES * 64), tt = it & 127, c8 = it >> 7; float lo[8], hi[8];
        rot_ap(qx[u], kt[u], __expf(lg * (float)(tt + 1)), lo, hi);
        *(LAS v4u*)(QL + tt * RS + c8 * 8) = pack8(lo); *(LAS v4u*)(QL + tt * RS + 64 + c8 * 8) = pack8(hi);
        rot_ap(kx[u], kt[u], 0.08838834764831845f * __expf(-lg * (float)(tt + 1)), lo, hi);
        *(LAS v4u*)(KL + tt * RS + c8 * 8) = pack8(lo); *(LAS v4u*)(KL + tt * RS + 64 + c8 * 8) = pack8(hi); }
#pragma unroll
      for (int u = 0; u < 4; ++u) { const int it = C.tid + u * (NWAVES * 64), tt = it & 127, c8 = it >> 7; const unsigned ww[4] = {vw[u].x, vw[u].y, vw[u].z, vw[u].w};
#pragma unroll
        for (int j = 0; j < 4; ++j) { VT[(c8 * 8 + 2 * j) * RS + tt] = (bf16)(ww[j] & 0xffffu); VT[(c8 * 8 + 2 * j + 1) * RS + tt] = (bf16)(ww[j] >> 16); }
        *(LAS v4u*)(ST + (it >> 4) * RS + (it & 15) * 8) = sw[u]; } }
    __syncthreads();
    const int fr = C.lane & 15, fq = C.lane >> 4, w = C.wave, i0 = 16 * w;
    bf16x8 qf[4];
#pragma unroll
    for (int ks = 0; ks < 4; ++ks) qf[ks] = *(const LAS bf16x8*)(QL + (i0 + fr) * RS + ks * 32 + fq * 8);
    f32x4 sc[8];
#pragma unroll
    for (int jt = 0; jt < 8; ++jt) { sc[jt] = zero4();
        if (jt <= w) {
#pragma unroll
            for (int ks = 0; ks < 4; ++ks) { const bf16x8 kf = *(const LAS bf16x8*)(KL + (16 * jt + fr) * RS + ks * 32 + fq * 8); sc[jt] = __builtin_amdgcn_mfma_f32_16x16x32_bf16(kf, qf[ks], sc[jt], 0, 0, 0); }
            if (jt == w) {
#pragma unroll
                for (int r = 0; r < 4; ++r) if (4 * fq + r > fr) sc[jt][r] = 0.f; } } }
    __syncthreads();
    LAS bf16* PL = KL;
#pragma unroll
    for (int jt = 0; jt < 8; ++jt) { v2u pw; pw.x = pk2(sc[jt][0], sc[jt][1]); pw.y = pk2(sc[jt][2], sc[jt][3]); *(LAS v2u*)(PL + (i0 + fr) * RS + 16 * jt + 4 * fq) = pw; }
    LDS_WAIT(); asm volatile("" ::: "memory");
    f32x4 acc[8];
#pragma unroll
    for (int et = 0; et < 8; ++et) acc[et] = zero4();
#pragma unroll
    for (int ks = 0; ks < 4; ++ks) { if (2 * ks <= w) { const bf16x8 pf = *(const LAS bf16x8*)(PL + (i0 + fr) * RS + ks * 32 + fq * 8);
#pragma unroll
            for (int et = 0; et < 8; ++et) { const bf16x8 vf = *(const LAS bf16x8*)(VT + (16 * et + fr) * RS + ks * 32 + fq * 8); acc[et] = __builtin_amdgcn_mfma_f32_16x16x32_bf16(vf, pf, acc[et], 0, 0, 0); } } }
    if (c > 0) {
#pragma unroll
        for (int ks = 0; ks < 4; ++ks)
#pragma unroll
            for (int et = 0; et < 8; ++et) { const bf16x8 sf = *(const LAS bf16x8*)(ST + (16 * et + fr) * RS + ks * 32 + fq * 8); acc[et] = __builtin_amdgcn_mfma_f32_16x16x32_bf16(sf, qf[ks], acc[et], 0, 0, 0); } }
    float s = 0.f;
#pragma unroll
    for (int et = 0; et < 8; ++et) s += (acc[et][0] + acc[et][1]) + (acc[et][2] + acc[et][3]);
    s += __shfl_xor(s, 16); s += __shfl_xor(s, 32); const float mu = s * (1.0f / 128.0f);
    float q = 0.f;
#pragma unroll
    for (int et = 0; et < 8; ++et) { acc[et] = acc[et] - mu; q += (acc[et][0] * acc[et][0] + acc[et][1] * acc[et][1]) + (acc[et][2] * acc[et][2] + acc[et][3] * acc[et][3]); }
    q += __shfl_xor(q, 16); q += __shfl_xor(q, 32); const float rstd = 1.0f / sqrtf(q * (1.0f / 128.0f) + 1e-6f);
    const size_t row = row0 + i0 + fr;
#pragma unroll
    for (int et = 0; et < 8; ++et) { const int e = 16 * et + 4 * fq; float gg[4]; unpack4(*(const v2u*)(P + row * PIN + PB_ + 1536 + h * 128 + e), gg);
        v2u wv; wv.x = pk2(gg[0] * sigm(gg[0]) * acc[et][0] * rstd, gg[1] * sigm(gg[1]) * acc[et][1] * rstd); wv.y = pk2(gg[2] * sigm(gg[2]) * acc[et][2] * rstd, gg[3] * sigm(gg[3]) * acc[et][3] * rstd);
        *(v2u*)(YC + row * DM + 512 + h * 128 + e) = wv; }
    __syncthreads();
}
__device__ __forceinline__ void ret_sample_witem(const Ctx& C, const Ax& a, int l, int witem) {
    const bf16* P = (const bf16*)(a.ws + WS_P); const float* CS = (const float*)(a.ws + WS_ROPE) + (size_t)2048 * 128; bf16* YC = (bf16*)(a.ws + WS_YC);
    const int n = witem >> 2, h = witem & 3, lane = C.lane; const float gam = 1.0f - exp2f(-5.0f - (float)h);
    LAS float* qk = (LAS float*)(C.lds + C.wave * 1024);
    const bf16* pr = P + (size_t)(MP + n) * PIN + PB_ + h * 128;
    { const float co = CS[2 * lane], si = CS[2 * lane + 1]; const float q1 = bf1(pr[lane]), q2 = bf1(pr[64 + lane]), k1 = bf1(pr[512 + lane]), k2 = bf1(pr[512 + 64 + lane]);
      qk[lane] = q1 * co - q2 * si; qk[64 + lane] = q2 * co + q1 * si; qk[128 + lane] = (k1 * co - k2 * si) * 0.08838834764831845f; qk[192 + lane] = (k2 * co + k1 * si) * 0.08838834764831845f; }
    LDS_WAIT(); asm volatile("" ::: "memory");
    const float dotp = wave_sum(qk[lane] * qk[128 + lane] + qk[64 + lane] * qk[192 + lane]);
    const int half = lane >> 5, el = lane & 31;
    float vv[4]; unpack4(*(const v2u*)(pr + 1024 + 4 * el), vv); const f32x4 v4 = (f32x4){vv[0], vv[1], vv[2], vv[3]};
    const float* sin_ = a.in(I_SRET) + (((size_t)l * NS + n) * 4 + h) * 16384; float* sout = a.out + O_RETS + (((size_t)l * NS + n) * 4 + h) * 16384;
    f32x4 oa = zero4();
#pragma unroll 8
    for (int it = 0; it < 64; ++it) { const int d = 2 * it + half; const f32x4 S = __builtin_nontemporal_load((const f32x4*)(sin_ + (size_t)d * 128 + 4 * el)); const float qd = qk[d], kd = qk[128 + d];
        oa += qd * S; __builtin_nontemporal_store(gam * S + kd * v4, (f32x4*)(sout + (size_t)d * 128 + 4 * el)); }
    oa.x += __shfl_xor(oa.x, 32); oa.y += __shfl_xor(oa.y, 32); oa.z += __shfl_xor(oa.z, 32); oa.w += __shfl_xor(oa.w, 32);
    f32x4 o = gam * oa + dotp * v4;
    float s = (o.x + o.y) + (o.z + o.w);
#pragma unroll
    for (int m = 1; m < 32; m <<= 1) s += __shfl_xor(s, m);
    const float mu = s * (1.0f / 128.0f); o = o - mu; float q = (o.x * o.x + o.y * o.y) + (o.z * o.z + o.w * o.w);
#pragma unroll
    for (int m = 1; m < 32; m <<= 1) q += __shfl_xor(q, m);
    const float rstd = 1.0f / sqrtf(q * (1.0f / 128.0f) + 1e-6f);
    if (half == 0) { float gg[4]; unpack4(*(const v2u*)(pr + 1536 + 4 * el), gg);
        v2u wv; wv.x = pk2(gg[0] * sigm(gg[0]) * o.x * rstd, gg[1] * sigm(gg[1]) * o.y * rstd); wv.y = pk2(gg[2] * sigm(gg[2]) * o.z * rstd, gg[3] * sigm(gg[3]) * o.w * rstd);
        *(v2u*)(YC + (size_t)(MP + n) * DM + 512 + h * 128 + 4 * el) = wv; }
    LDS_WAIT(); asm volatile("" ::: "memory");
}

constexpr int XV_RS = 264;
__device__ __forceinline__ void xattn_prompt_unit(const Ctx& C, const Ax& a, int l, int unit) {
    const bf16* Q = (const bf16*)(a.ws + WS_Q); const bf16* MK = (const bf16*)(a.ws + WS_MK) + (size_t)l * MMEM * DM; const bf16* MVT = (const bf16*)(a.ws + WS_MVT) + (size_t)l * MMEM * DM; bf16* O = (bf16*)(a.ws + WS_O);
    const int b = unit >> 6, h = (unit >> 4) & 3, qt = unit & 15, fr = C.lane & 15, fq = C.lane >> 4;
    const size_t row = (size_t)b * SEQ + qt * 128 + C.wave * 16 + fr;
    LAS bf16* SB = (LAS bf16*)C.lds;
    v4u st[8];
    const bf16* kbase = MK + ((size_t)b * 256) * DM + h * 512; const bf16* vbase = MVT + (((size_t)b * 4 + h) * 512) * 256;
    unsigned kof[4], vof[8], sof[8];
#pragma unroll
    for (int i = 0; i < 8; ++i) { const int idx = C.tid + 512 * i, r = idx >> 5, c16 = idx & 31; vof[i] = (unsigned)(r * 256 + c16 * 8) * 2u; sof[i] = (unsigned)(r * XV_RS + c16 * 8) * 2u; if (i < 4) kof[i] = (unsigned)(r * DM + c16 * 8) * 2u; }
    const char* kb8 = (const char*)kbase; const char* vb8 = (const char*)vbase; LAS char* sb8 = (LAS char*)SB;
#define XK_LOAD(q) do { const char* pb_ = kb8 + ((size_t)(((q) & 3) * 64) * DM + ((q) >> 2) * 256) * 2; _Pragma("unroll") for (int i = 0; i < 4; ++i) st[i] = *(const v4u*)(pb_ + kof[i]); } while (0)
#define XK_STORE() do { _Pragma("unroll") for (int i = 0; i < 4; ++i) *(LAS v4u*)(sb8 + sof[i]) = st[i]; } while (0)
#define XV_LOAD(p) do { const char* pb_ = vb8 + (size_t)((p) * 128) * 256 * 2; _Pragma("unroll") for (int i = 0; i < 8; ++i) st[i] = *(const v4u*)(pb_ + vof[i]); } while (0)
#define XV_STORE() do { _Pragma("unroll") for (int i = 0; i < 8; ++i) *(LAS v4u*)(sb8 + sof[i]) = st[i]; } while (0)
    XK_LOAD(0);
    f32x4 sc[16];
#pragma unroll
    for (int jt = 0; jt < 16; ++jt) sc[jt] = zero4();
#pragma unroll
    for (int dh = 0; dh < 2; ++dh) {
        bf16x8 qf[8];
#pragma unroll
        for (int ks = 0; ks < 8; ++ks) qf[ks] = *(const bf16x8*)(Q + row * DM + h * 512 + dh * 256 + ks * 32 + fq * 8);
#pragma unroll
        for (int p = 0; p < 4; ++p) {
            __syncthreads(); XK_STORE(); __syncthreads();
            if (dh * 4 + p < 7) XK_LOAD(dh * 4 + p + 1); else XV_LOAD(0);
#pragma unroll
            for (int j4 = 0; j4 < 4; ++j4) {
#pragma unroll
                for (int ks = 0; ks < 8; ++ks) { const bf16x8 kf = *(const LAS bf16x8*)(SB + (j4 * 16 + fr) * XV_RS + ks * 32 + fq * 8); sc[p * 4 + j4] = __builtin_amdgcn_mfma_f32_16x16x32_bf16(kf, qf[ks], sc[p * 4 + j4], 0, 0, 0); }
                __builtin_amdgcn_sched_barrier(0); }
        }
    }
    float mx = -3.0e38f;
#pragma unroll
    for (int jt = 0; jt < 16; ++jt) mx = fmaxf(mx, fmaxf(fmaxf(sc[jt][0], sc[jt][1]), fmaxf(sc[jt][2], sc[jt][3])));
    mx = fmaxf(mx, __shfl_xor(mx, 16)); mx = fmaxf(mx, __shfl_xor(mx, 32));
    const float scale = 0.04419417382415922f; float sum = 0.f;
    bf16x8 pf[8];
#pragma unroll
    for (int s = 0; s < 8; ++s) { float p[8];
#pragma unroll
        for (int j = 0; j < 4; ++j) { p[j] = __expf((sc[2 * s][j] - mx) * scale); p[4 + j] = __expf((sc[2 * s + 1][j] - mx) * scale); }
        sum += ((p[0] + p[1]) + (p[2] + p[3])) + ((p[4] + p[5]) + (p[6] + p[7]));
        const v4u w = pack8(p); pf[s] = __builtin_bit_cast(bf16x8, w); }
    sum += __shfl_xor(sum, 16); sum += __shfl_xor(sum, 32); const float inv = 1.0f / sum;
#pragma unroll
    for (int p = 0; p < 4; ++p) {
        __syncthreads(); XV_STORE(); __syncthreads();
        if (p < 3) XV_LOAD(p + 1);
#pragma unroll
        for (int et = 0; et < 8; ++et) { f32x4 s4 = zero4(); const LAS bf16* vp = SB + (et * 16 + fr) * XV_RS + 4 * fq;
#pragma unroll
            for (int s = 0; s < 8; ++s) { const v2u lo = *(const LAS v2u*)(vp + 32 * s), hi = *(const LAS v2u*)(vp + 32 * s + 16); const v4u w = (v4u){lo.x, lo.y, hi.x, hi.y};
                s4 = __builtin_amdgcn_mfma_f32_16x16x32_bf16(__builtin_bit_cast(bf16x8, w), pf[s], s4, 0, 0, 0); }
            v2u w; w.x = pk2(s4[0] * inv, s4[1] * inv); w.y = pk2(s4[2] * inv, s4[3] * inv);
            *(v2u*)(O + row * DM + h * 512 + p * 128 + et * 16 + 4 * fq) = w;
            __builtin_amdgcn_sched_barrier(0); }
    }
    __syncthreads();
#undef XK_LOAD
#undef XK_STORE
#undef XV_LOAD
#undef XV_STORE
}
__device__ __forceinline__ void xattn_sample_item(const Ctx& C, const Ax& a, int l, int item) {
    bf16* O = (bf16*)(a.ws + WS_OS);
    const int n = item >> 2, h = item & 3, lane = C.lane, w = C.wave;
    LAS float* red = (LAS float*)C.lds; LAS float* part = red + 64;
    float q[8]; { const float* s0 = (const float*)(a.ws + WS_SPL) + (size_t)n * DM + h * 512 + 4 * lane; const float* s1 = s0 + (size_t)NS * DM;
                  const f32x4 a0 = *(const f32x4*)s0 + *(const f32x4*)s1, a1 = *(const f32x4*)(s0 + 256) + *(const f32x4*)(s1 + 256);
                  q[0] = a0.x; q[1] = a0.y; q[2] = a0.z; q[3] = a0.w; q[4] = a1.x; q[5] = a1.y; q[6] = a1.z; q[7] = a1.w; }
    const size_t base = ((((size_t)l * NS + n) * 256 + 32 * w) * 4 + h) * 512 + 4 * lane;
    const float* kp = a.in(I_CMK) + base; const float* vp = a.in(I_CMV) + base;
#define XS_LOAD(buf0, buf1, ptr, k8) do { _Pragma("unroll") for (int j = 0; j < 8; ++j) { buf0[j] = __builtin_nontemporal_load((const f32x4*)((ptr) + (size_t)((k8) * 8 + j) * 2048)); buf1[j] = __builtin_nontemporal_load((const f32x4*)((ptr) + (size_t)((k8) * 8 + j) * 2048 + 256)); } } while (0)
#define XS_DOT(buf0, buf1, k8) do { _Pragma("unroll") for (int j = 0; j < 8; ++j) { float d = (buf0[j].x * q[0] + buf0[j].y * q[1]) + (buf0[j].z * q[2] + buf0[j].w * q[3]) + (buf1[j].x * q[4] + buf1[j].y * q[5]) + (buf1[j].z * q[6] + buf1[j].w * q[7]); \
        d = rowsum16(d); d += __shfl_xor(d, 16); d += __shfl_xor(d, 32); if (lane == (k8) * 8 + j) myscore = d; } } while (0)
#define XS_ACC(buf0, buf1, k8) do { _Pragma("unroll") for (int j = 0; j < 8; ++j) { const float pj = __builtin_bit_cast(float, __builtin_amdgcn_readlane(__builtin_bit_cast(int, p), (k8) * 8 + j)); o0 += pj * buf0[j]; o1 += pj * buf1[j]; } } while (0)
    float myscore = 0.f;
    f32x4 xa0[8], xa1[8], xb0[8], xb1[8];
    XS_LOAD(xa0, xa1, kp, 0);
    XS_LOAD(xb0, xb1, kp, 1); XS_DOT(xa0, xa1, 0);
    XS_LOAD(xa0, xa1, kp, 2); XS_DOT(xb0, xb1, 1);
    XS_LOAD(xb0, xb1, kp, 3); XS_DOT(xa0, xa1, 2);
    XS_LOAD(xa0, xa1, vp, 0); XS_DOT(xb0, xb1, 3);
    const float scale = 0.04419417382415922f;
    float mx = wave_max(lane < 32 ? myscore : -3.0e38f); if (lane == 0) red[w] = mx; __syncthreads();
    mx = red[0];
#pragma unroll
    for (int i = 1; i < 8; ++i) mx = fmaxf(mx, red[i]);
    const float p = lane < 32 ? __expf((myscore - mx) * scale) : 0.f;
    const float ps = wave_sum(p); if (lane == 0) red[8 + w] = ps;
    f32x4 o0 = zero4(), o1 = zero4();
    XS_LOAD(xb0, xb1, vp, 1); XS_ACC(xa0, xa1, 0);
    XS_LOAD(xa0, xa1, vp, 2); XS_ACC(xb0, xb1, 1);
    XS_LOAD(xb0, xb1, vp, 3); XS_ACC(xa0, xa1, 2);
    XS_ACC(xb0, xb1, 3);
#undef XS_LOAD
#undef XS_DOT
#undef XS_ACC
    *(LAS f32x4*)(part + w * 512 + 4 * lane) = o0; *(LAS f32x4*)(part + w * 512 + 256 + 4 * lane) = o1;
    __syncthreads();
    float tot = 0.f;
#pragma unroll
    for (int i = 0; i < 8; ++i) tot += red[8 + i];
    { const int d = C.tid; float s = 0.f;
#pragma unroll
      for (int i = 0; i < 8; ++i) s += part[i * 512 + d];
      O[(size_t)n * DMS + h * 512 + d] = (bf16)(pk2(s / tot, 0.f) & 0xffffu); }
    __syncthreads();
}

#ifndef PHASE_MASK
#define PHASE_MASK 0xffffffffu
#endif
#define PM(k) ((PHASE_MASK >> (k)) & 1u)
#ifndef DUP_SUB
#define DUP_SUB 0u
#endif
#define REP(k) for (int rep_ = 0; rep_ < 1 + (int)((DUP_SUB >> (k)) & 1u); ++rep_)
#ifndef DUP_MASK
#define DUP_MASK 0
#endif
#ifndef MK_ONE_LAUNCH
#define MK_ONE_LAUNCH 1
#endif
constexpr int PH_PER_LAYER = 14, NPH = 1 + DEPTH * PH_PER_LAYER;
__global__ void __launch_bounds__(NWAVES * 64, 2) fwd_kernel(Args args) {
    extern __shared__ __attribute__((aligned(16))) unsigned char lds_raw[];
    LAS unsigned char* const lds = (LAS unsigned char*)lds_raw;
    const int wave_s = __builtin_amdgcn_readfirstlane((int)threadIdx.x >> 6);
    volatile LAS unsigned* MISC = (volatile LAS unsigned*)(lds + MISC_OFF);
    for (int u = threadIdx.x; u < (LDS_BYTES - MISC_OFF) / 4; u += NWAVES * 64) ((LAS unsigned*)(lds + MISC_OFF))[u] = 0u;
    __syncthreads();
    XcdBarrier bar; bar.bar = (unsigned*)(args.ws + WS_CTL) + CW_BAR; bar.x = 0; bar.st = nullptr;
    if (MK_ONE_LAUNCH) bar = xcd_barrier_post((unsigned*)(args.ws + WS_CTL) + CW_BAR, MISC + 8);
    bar.wave = wave_s;
    const int lo = args.ph_lo, hi = args.ph_hi;
#define IN(k) (lo <= (k) && (k) < hi)
#define SEAM(k) do { if (MK_ONE_LAUNCH && IN((k) + 1)) xcd_barrier(bar); } while (0)
#define SEAM2(k) do { if (MK_ONE_LAUNCH && IN((k) + 2)) xcd_barrier(bar); } while (0)
#define PHASE_CTX const Ctx C = mk_ctx(lds, wave_s); const Ax a = mk_ax(); unsigned char* const ws = a.ws; const int G = C.G, bid = C.bid; (void)ws; (void)G; (void)bid; \
    float* const XF = (float*)(ws + WS_XF); bf16* const HN = (bf16*)(ws + WS_HN); bf16* const PBUF = (bf16*)(ws + WS_P); bf16* const YC = (bf16*)(ws + WS_YC); bf16* const QB = (bf16*)(ws + WS_Q); \
    bf16* const OB = (bf16*)(ws + WS_O); bf16* const UB = (bf16*)(ws + WS_U); (void)XF; (void)HN; (void)PBUF; (void)YC; (void)QB; (void)OB; (void)UB

    if (IN(0)) { PHASE_CTX; if (PM(0)) p0_prologue(C, a); SEAM(0); }

    for (int l = 0; l < DEPTH; ++l) {
        const int pb = 1 + l * PH_PER_LAYER;
        if (IN(pb + 0)) { PHASE_CTX; const unsigned char* wl = ws + WS_WL + (size_t)l * LW_STRIDE;
            if (PM(1)) { pg8::Gemm g{HN, (const bf16*)(wl + LW_IN), MPAD, PIN, DM, DM, 64, (size_t)PIN * 128}; pg8::StaticOrder S; S.init(MPAD, PIN, G, bid); pg8::EpiBf16A<0> E{PBUF, PIN, nullptr};
              pg8::gemm_phase<pg8::EpiBf16A<0>, pg8::StaticOrder, true, true>(lds, g, S, E, C.tid); }
            if (G == 256) { const int nfull = (MPAD / 256) * (PIN / 256) - 3 * G;
                if ((bid >= nfull && bid < 64) || bid >= 128) { __syncthreads(); late_convert(C, a, l, bid < 64 ? bid - nfull : bid - 128 + (64 - nfull), (64 - nfull) + (G - 128)); } }
            if (PM(2)) { pg8::Gemm g{(const bf16*)(ws + WS_MN), (const bf16*)(ws + WS_WKV) + (size_t)l * 4096 * 64, MMEM, 4096, DM, DM, 64, (size_t)8192 * 128}; pg8::StaticOrder S; S.init(MMEM, 4096, G, (bid + G - (64 % G)) % G);
              pg8::EpiMemKV E{a.out + O_MKP + (size_t)l * MMEM * DM, (bf16*)(ws + WS_MK) + (size_t)l * MMEM * DM, (bf16*)(ws + WS_MVT) + (size_t)l * MMEM * DM};
              pg8::gemm_phase<pg8::EpiMemKV, pg8::StaticOrder, true, true>(lds, g, S, E, C.tid); }
            SEAM(pb + 0);
        }
        if (IN(pb + 1)) { PHASE_CTX;
#ifdef DEBUG_P
            { const int gt = bid * 512 + C.tid, NT = G * 512;
              for (int idx = gt + (DEBUG_P == 2 ? MP * 2048 : 0); idx < (DEBUG_P == 1 ? MP : MT) * 2048; idx += NT) { const int row = idx >> 11, c = idx & 2047; const bf16* pr = PBUF + (size_t)row * PIN;
                  float s = bf1(pr[c]) + bf1(pr[c + 2048]) + bf1(pr[c + 4096]); if (c < 256) s += bf1(pr[c + 6144]); a.out[O_YP + idx] = s; } }
#endif
            if ((bid >> 3) & 1) { if (PM(8)) REP(8) for (int it = bid * NWAVES + C.wave; it < NS * 4; it += G * NWAVES) ret_sample_witem(C, a, l, it); __syncthreads(); }
            if (PM(4)) REP(4) for (int it = bid; it < 256; it += G) ad_prompt_item(C, a, l, it);
            if (PM(5)) REP(5) for (int it = bid; it < 256; it += G) ret_pass1_item(C, a, it);
            if (PM(6)) REP(6) for (int it = bid; it < 256; it += G) rwkv_prep_item(C, a, l, it);
            if (PM(6)) for (int it = bid - 64; it >= 0 && it < 4; it += G) rwkv_prep_item(C, a, l, 256 + it);
            if (PM(7)) REP(7) for (int it = G - 1 - bid; it < NS; it += G) ad_sample_item(C, a, l, it);
            if (!((bid >> 3) & 1)) { if (PM(8)) REP(8) for (int it = bid * NWAVES + C.wave; it < NS * 4; it += G * NWAVES) ret_sample_witem(C, a, l, it); }
            __syncthreads();
            SEAM(pb + 1);
        }
        if (IN(pb + 2)) { PHASE_CTX;
            if ((bid >> 3) & 1) { if (PM(10)) REP(10) for (int it = bid * NWAVES + C.wave; it < NS * 16; it += G * NWAVES) rwkv_sample_witem(C, a, l, it); }
            if (PM(9)) REP(9) for (int it = bid * NWAVES + C.wave; it < 4096; it += G * NWAVES) wkv_chunk_witem(C, a, it);
            if (!((bid >> 3) & 1)) { if (PM(10)) REP(10) for (int it = bid * NWAVES + C.wave; it < NS * 16; it += G * NWAVES) rwkv_sample_witem(C, a, l, it); }
            if (PM(11)) ret_prefix_phase(C, a, l);
            SEAM(pb + 2);
        }
        if (IN(pb + 3)) { PHASE_CTX; const int hg = G / 2;
            if (PM(22)) REP(22) for (int it = bid; it < 128; it += (bid < hg ? hg : 1 << 20)) wkv_seq_item(C, a, l, it);
            if (PM(11)) REP(11) if (bid >= hg || G < 2) for (int it = bid - hg; it < 256; it += G - hg) ret_pass2_item(C, a, l, it);
            SEAM(pb + 3);
        }
        if (IN(pb + 4)) { PHASE_CTX;
            if (PM(12)) REP(12) rwkv_post_phase(C, a, l);
            SEAM(pb + 4);
        }
        if (IN(pb + 5)) { PHASE_CTX; const unsigned char* wl = ws + WS_WL + (size_t)l * LW_STRIDE;
            pg8::Gemm g{YC, (const bf16*)(wl + LW_OUT), MP, DM, DM, DM, 64, (size_t)DM * 128}; pg8::StaticOrder S; S.init(MP, DM, G, bid); pg8::EpiRes E{XF, DM, ((DUP_MASK >> 5) & 1) ? 0.5f : 1.0f, (l == 0 && !((DUP_MASK >> 5) & 1)) ? a.in(I_XP) : (const float*)XF};
            if (PM(15)) pg8::gemm_phase<pg8::EpiRes, pg8::StaticOrder, true, true>(lds, g, S, E, C.tid);
            if (PM(20)) sample_gemm(lds, C.tid, YC + (size_t)MP * DM, DM, (const bf16*)(wl + LW_OUT), DM, DM, DM, G, bid, SEpiRes{XF + (size_t)MP * DM, DM, ((DUP_MASK >> 5) & 1) ? 0.5f : 1.0f, (l == 0 && !((DUP_MASK >> 5) & 1)) ? a.in(I_XS) : (const float*)(XF + (size_t)MP * DM)});
            SEAM(pb + 5);
        }
        if (IN(pb + 6)) { PHASE_CTX; if (PM(21)) REP(21) rms_phase(C, XF, HN, (bf16*)(ws + WS_HNS)); SEAM(pb + 6);
#ifdef XBAR_PROBE
            if (MK_ONE_LAUNCH) for (int i_ = 0; i_ < XBAR_PROBE; ++i_) xcd_barrier(bar);
#endif
        }
        if (IN(pb + 7)) { PHASE_CTX; const unsigned char* wl = ws + WS_WL + (size_t)l * LW_STRIDE;
            pg8::Gemm g{HN, (const bf16*)(wl + LW_Q), MP, DM, DM, DM, 64, (size_t)DM * 128}; pg8::StaticOrder S; S.init(MP, DM, G, bid); pg8::EpiBf16A<0> E{QB, DM, nullptr};
            if (PM(16)) REP(16) pg8::gemm_phase<pg8::EpiBf16A<0>, pg8::StaticOrder, true, true>(lds, g, S, E, C.tid);
            if (PM(20)) { sample_gemm(lds, C.tid, (const bf16*)(ws + WS_HNS), DMS, (const bf16*)(wl + LW_Q), DM, DM, DM, G, bid, SEpiPart{(float*)(ws + WS_SPL), DM}, 2); if ((DUP_SUB >> 24) & 1u) { const Ctx C2 = mk_ctx(lds, wave_s); sample_gemm(lds, C2.tid, (const bf16*)(ws + WS_HNS), DMS, (const bf16*)(wl + LW_Q), DM, DM, DM, G, bid, SEpiPart{(float*)(ws + WS_SPL), DM}, 2); } }
            SEAM(pb + 7);
        }
        if (IN(pb + 8)) { PHASE_CTX;
            { const int g3 = (bid >> 3) % 3;
              if (g3 == 0) { if (PM(13)) REP(13) for (int it = bid; it < 256; it += G) xattn_prompt_unit(C, a, l, it); }
              if (PM(14)) REP(14) for (int it = bid; it < NS * 4; it += 2 * G) xattn_sample_item(C, a, l, it);
              if (g3 == 1) { if (PM(13)) REP(13) for (int it = bid; it < 256; it += G) xattn_prompt_unit(C, a, l, it); }
              if (PM(14)) REP(14) for (int it = bid + G; it < NS * 4; it += 2 * G) xattn_sample_item(C, a, l, it);
              if (g3 == 2) { if (PM(13)) REP(13) for (int it = bid; it < 256; it += G) xattn_prompt_unit(C, a, l, it); } }
            SEAM(pb + 8);
        }
        if (IN(pb + 9)) { PHASE_CTX; const unsigned char* wl = ws + WS_WL + (size_t)l * LW_STRIDE;
            pg8::Gemm g{OB, (const bf16*)(wl + LW_O), MP, DM, DM, DM, 64, (size_t)DM * 128}; pg8::StaticOrder S; S.init(MP, DM, G, bid); pg8::EpiRes E{XF, DM, ((DUP_MASK >> 9) & 1) ? 0.5f : 1.0f, XF};
            if (PM(17)) pg8::gemm_phase<pg8::EpiRes, pg8::StaticOrder, true, true>(lds, g, S, E, C.tid);
            if (PM(20)) sample_gemm(lds, C.tid, (const bf16*)(ws + WS_OS), DMS, (const bf16*)(wl + LW_O), DM, DM, DM, G, bid, SEpiRes{XF + (size_t)MP * DM, DM, ((DUP_MASK >> 9) & 1) ? 0.5f : 1.0f, XF + (size_t)MP * DM});
            SEAM(pb + 9);
        }
        if (IN(pb + 10)) { PHASE_CTX; if (PM(21)) REP(21) rms_phase(C, XF, HN, (bf16*)(ws + WS_HNS)); SEAM(pb + 10); }
        if (IN(pb + 11)) { PHASE_CTX; const unsigned char* wl = ws + WS_WL + (size_t)l * LW_STRIDE;
            pg8::Gemm g{HN, (const bf16*)(wl + LW_UP), MP, DFF, DM, DM, 64, (size_t)DFF * 128}; pg8::StaticOrder S; S.init(MP, DFF, G, bid); pg8::EpiBf16A<3> E{UB, LDU, nullptr};
            if (PM(18)) REP(18) pg8::gemm_phase<pg8::EpiBf16A<3>, pg8::StaticOrder, true, true>(lds, g, S, E, C.tid);
            if (PM(20)) { sample_gemm(lds, C.tid, (const bf16*)(ws + WS_HNS), DMS, (const bf16*)(wl + LW_UP), DFF, DFF, DM, G, bid, SEpiBf16{(bf16*)(ws + WS_US), LDUS, 3, nullptr}); if ((DUP_SUB >> 23) & 1u) { const Ctx C2 = mk_ctx(lds, wave_s); sample_gemm(lds, C2.tid, (const bf16*)(ws + WS_HNS), DMS, (const bf16*)(wl + LW_UP), DFF, DFF, DM, G, bid, SEpiBf16{(bf16*)(ws + WS_US), LDUS, 3, nullptr}); } }
            SEAM(pb + 11);
        }
        if (IN(pb + 12)) { PHASE_CTX; const unsigned char* wl = ws + WS_WL + (size_t)l * LW_STRIDE;
            pg8::Gemm g{UB, (const bf16*)(wl + LW_DN), MP, DM, DFF, LDU, 64, (size_t)DM * 128}; pg8::StaticOrder S; S.init(MP, DM, G, bid); pg8::EpiRes E{XF, DM, ((DUP_MASK >> 12) & 1) ? 0.5f : 1.0f, XF};
            if (PM(19)) pg8::gemm_phase<pg8::EpiRes, pg8::StaticOrder, true, true>(lds, g, S, E, C.tid);
            if (PM(20)) { sample_gemm(lds, C.tid, (const bf16*)(ws + WS_US), LDUS, (const bf16*)(wl + LW_DN), DM, DM, DFF, G, bid, SEpiPart{(float*)(ws + WS_SPL), DM}, 2); if ((DUP_SUB >> 25) & 1u) { const Ctx C2 = mk_ctx(lds, wave_s); sample_gemm(lds, C2.tid, (const bf16*)(ws + WS_US), LDUS, (const bf16*)(wl + LW_DN), DM, DM, DFF, G, bid, SEpiPart{(float*)(ws + WS_SPL), DM}, 2); } }
            SEAM(pb + 12);
        }
        if (IN(pb + 13)) { PHASE_CTX;
            fold_split_rows(C, XF, (const float*)(ws + WS_SPL));
            if (!PM(21)) {} else if (l + 1 < DEPTH) REP(21) rms_phase(C, XF, HN, nullptr); else final_norm_phase(C, XF, a.in(I_GFIN), a.out + O_YP);
            SEAM(pb + 13);
        }
    }
#undef IN
#undef SEAM
#undef SEAM2
#undef PHASE_CTX
}

extern "C" void kernel_launch(void* const* d_in, const int* in_sizes, int n_in, void* d_out, int out_size, void* d_ws, size_t ws_size, hipStream_t stream) {
    static int grid = 0;
    if (grid == 0) {
        if (n_in != NIN || (size_t)out_size != O_END || ws_size < WS_END) { fprintf(stderr, "kernel_launch: unexpected shapes (n_in %d, out %d, ws %zu); nothing launched\n", n_in, out_size, ws_size); grid = -1; return; }
        int dev = 0, cus = 0, per_cu = 0;
        if (hipGetDevice(&dev) != hipSuccess || hipDeviceGetAttribute(&cus, hipDeviceAttributeMultiprocessorCount, dev) != hipSuccess) { grid = -1; return; }
        if (hipFuncSetAttribute((const void*)fwd_kernel, hipFuncAttributeMaxDynamicSharedMemorySize, LDS_BYTES) != hipSuccess) { fprintf(stderr, "kernel_launch: hipFuncSetAttribute failed\n"); grid = -1; return; }
        if (hipOccupancyMaxActiveBlocksPerMultiprocessor(&per_cu, (const void*)fwd_kernel, NWAVES * 64, LDS_BYTES) != hipSuccess || per_cu < 1) { fprintf(stderr, "kernel_launch: occupancy query reports %d\n", per_cu); }
        (void)hipGetLastError();
        grid = cus;
    }
    if (grid < 0) return;
    if (hipMemsetAsync((char*)d_ws + WS_CTL, 0, CTL_ZERO_BYTES, stream) != hipSuccess) return;
    Args a{};
    for (int i = 0; i < NIN; ++i) a.in[i] = (const float*)d_in[i];
    a.out = (float*)d_out; a.ws = (unsigned char*)d_ws;
#if MK_ONE_LAUNCH
    a.ph_lo = 0; a.ph_hi = NPH;
    hipLaunchKernelGGL(fwd_kernel, dim3(grid), dim3(NWAVES * 64), LDS_BYTES, stream, a);
#else
#ifndef NPH_RUN
#define NPH_RUN NPH
#endif
    for (int ph = 0; ph < NPH_RUN; ++ph) { a.ph_lo = ph; a.ph_hi = ph + 1; hipLaunchKernelGGL(fwd_kernel, dim3(grid), dim3(NWAVES * 64), LDS_BYTES, stream, a);
        const int dbit = (ph == 0) ? 13 : (ph - 1) % PH_PER_LAYER;
        if ((DUP_MASK >> dbit) & 1) hipLaunchKernelGGL(fwd_kernel, dim3(grid), dim3(NWAVES * 64), LDS_BYTES, stream, a); }
#endif
}
```

```cpp
#include <hip/hip_runtime.h>
#include <cstdio>
#include <cstdint>
namespace pg8 {
#define PG8_LAS __attribute__((address_space(3)))
typedef unsigned short bf16_t;
typedef short bf16x8 __attribute__((ext_vector_type(8)));
typedef float f32x4 __attribute__((ext_vector_type(4)));
typedef unsigned u32x4 __attribute__((ext_vector_type(4)));
constexpr int BM = 256, BK = 64, HALF = 128, HTB = HALF * BK * 2  , STAGE_BYTES = 8 * HTB, NXCD = 8, WGM = 8;

__host__ __device__ __forceinline__ int lds_byte(int r, int c) { const int st = (r >> 4) * 2 + (c >> 5), rr = r & 15, cc = c & 31, ob = rr * 64 + cc * 2; return st * 1024 + (ob ^ (((ob >> 9) & 1) << 5)); }
__host__ __device__ __forceinline__ void stage_rc(int b, int& R, int& C) { const int st = b / 1024, sb = b % 1024, swz = sb ^ (((sb >> 9) & 1) << 5); R = (st >> 1) * 16 + swz / 64; C = (st & 1) * 32 + (swz % 64) / 2; }
__host__ __device__ __forceinline__ int perm32(int rho) { const int n = rho >> 4, i = rho & 15; return 8 * (i >> 2) + 4 * n + (i & 3); }

struct Unit { int pm, pn; };
struct Gemm { const bf16_t* A; const bf16_t* Bt; int M, N, K, lda, ldb; size_t ksb; };

struct StaticOrder {
    int nM, nN, nwg, G, c;
    __host__ __device__ void init(int M, int N, int G_, int c_) { nM = M / BM; nN = N / BM; nwg = nM * nN; G = G_; c = c_; }
    __host__ __device__ bool next(int i, Unit& u) const {
        const long L = (long)i * G + c; if (L >= nwg) return false;
        int wgid = (int)L; { const int q = nwg / NXCD, r = nwg % NXCD, xcd = wgid % NXCD, off = wgid / NXCD; wgid = (xcd < r ? xcd * (q + 1) : r * (q + 1) + (xcd - r) * q) + off; }
        const int nig = WGM * nN, gid = wgid / nig, fm = gid * WGM, gsz = (nM - fm) < WGM ? (nM - fm) : WGM;
        u.pm = fm + ((wgid % nig) % gsz); u.pn = (wgid % nig) / gsz; return true;
    }
    __device__ __forceinline__ void a_ready(const Unit&) const {}
    __device__ __forceinline__ void done(const Unit&) const {}
};

typedef float f32x2_cv __attribute__((ext_vector_type(2)));
typedef __bf16 bf16x2_cv __attribute__((ext_vector_type(2)));
__device__ __forceinline__ unsigned cvt_pk_bf16(float lo, float hi) { const f32x2_cv v = {lo, hi}; return __builtin_bit_cast(unsigned, __builtin_convertvector(v, bf16x2_cv)); }
typedef float f32x2 __attribute__((ext_vector_type(2)));
template <class Epi, class Sched, bool ALIGN_EPI = false, bool SP2 = false>
__device__ __forceinline__ void gemm_phase(PG8_LAS unsigned char* lds, const Gemm g, const Sched& S, const Epi& E, int tid_in) {
    int tid_ = tid_in; asm volatile("" : "+v"(tid_));
    const int tid = tid_, wid = __builtin_amdgcn_readfirstlane(tid >> 6), lane = tid & 63, wr = wid >> 2, wc = wid & 3, fr = lane & 15, fq = lane >> 4;
    const int K = g.K, nt = K / BK;
    unsigned voffA[2], voffB[2];
#pragma unroll
    for (int i = 0; i < 2; ++i) { int R, C; stage_rc(tid * 16 + i * 8192, R, C); const int Rb = Epi::PERM ? ((R & ~31) + perm32(R & 31)) : R;
        voffA[i] = (unsigned)(R * g.lda + C) * 2u; voffB[i] = (unsigned)(Rb * g.ldb + C) * 2u; }
    const size_t kstep = (size_t)(BK * 2), kstepB = g.ksb;
    const size_t hstepA = (size_t)HALF * g.lda * 2, hstepB = (size_t)HALF * g.ldb * 2;
    const size_t tstepA = 2 * hstepA, tstepB = 2 * hstepB;
    const unsigned ldsw = (unsigned)wid * 1024u;
    const int aoff = lds_byte(wr * 64 + fr, fq * 8), boff = lds_byte(wc * 32 + fr, fq * 8);
#define PG8_SA(b, h) (((b) * 2 + (h)) * HTB)
#define PG8_SB(b, h) ((4 + (b) * 2 + (h)) * HTB)
#define PG8_STAGE(bufoff, gbase, voff) do { _Pragma("unroll") for (int _i = 0; _i < 2; ++_i) \
        __builtin_amdgcn_global_load_lds((const unsigned*)((const char*)(gbase) + (voff)[_i]), (PG8_LAS unsigned*)(lds + (bufoff) + ldsw + _i * 8192), 16, 0, 0); } while (0)
#define PG8_LDA(dst, b, h) do { _Pragma("unroll") for (int m = 0; m < 4; ++m) _Pragma("unroll") for (int k = 0; k < 2; ++k) dst[m][k] = *(const PG8_LAS bf16x8*)(lds + PG8_SA(b, h) + aoff + m * 2048 + k * 1024); } while (0)
#define PG8_LDB(dst, b, h) do { _Pragma("unroll") for (int n = 0; n < 2; ++n) _Pragma("unroll") for (int k = 0; k < 2; ++k) dst[n][k] = *(const PG8_LAS bf16x8*)(lds + PG8_SB(b, h) + boff + n * 2048 + k * 1024); } while (0)
#define PG8_MMA(ai, bj, At, Bt) do { __builtin_amdgcn_s_setprio(1); _Pragma("unroll") for (int m = 0; m < 4; ++m) _Pragma("unroll") for (int n = 0; n < 2; ++n) _Pragma("unroll") for (int k = 0; k < 2; ++k) \
        acc[ai][bj][m][n] = __builtin_amdgcn_mfma_f32_16x16x32_bf16(Bt[n][k], At[m][k], acc[ai][bj][m][n], 0, 0, 0); __builtin_amdgcn_s_setprio(0); } while (0)
#define PG8_WAIT_V(n) asm volatile("s_waitcnt vmcnt(" #n ")" ::: "memory")
#define PG8_WAIT_L(n) asm volatile("s_waitcnt lgkmcnt(" #n ")" ::: "memory")
#define PG8_BAR __builtin_amdgcn_s_barrier()
#define PG8_SCHED __builtin_amdgcn_sched_barrier(0)
    Unit cur, nxt; int ui = 0;
    if (!S.next(0, cur)) return;
    f32x4 acc[2][2][4][2];
#pragma unroll
    for (int a = 0; a < 2; ++a)
#pragma unroll
        for (int b = 0; b < 2; ++b)
#pragma unroll
            for (int m = 0; m < 4; ++m)
#pragma unroll
                for (int n = 0; n < 2; ++n) acc[a][b][m][n] = (f32x4){0.f, 0.f, 0.f, 0.f};
    bf16x8 At[4][2], B0[2][2], B1[2][2];
    const char* cA = (const char*)g.A + (size_t)cur.pm * tstepA; const char* cB = (const char*)g.Bt + (size_t)cur.pn * tstepB;
    S.a_ready(cur);
    if constexpr (SP2) {
        PG8_STAGE(PG8_SB(0, 0), cB, voffB); PG8_STAGE(PG8_SB(0, 1), cB + hstepB, voffB); PG8_STAGE(PG8_SA(0, 0), cA, voffA); PG8_STAGE(PG8_SA(0, 1), cA + hstepA, voffA);
        if (wr == 1) PG8_BAR;
        PG8_WAIT_V(2); PG8_BAR;
        PG8_STAGE(PG8_SB(1, 0), cB + kstepB, voffB); PG8_STAGE(PG8_SA(1, 0), cA + kstep, voffA); PG8_STAGE(PG8_SB(1, 1), cB + hstepB + kstepB, voffB);
        PG8_WAIT_V(6); PG8_BAR;
    } else {
        PG8_STAGE(PG8_SB(0, 0), cB, voffB); PG8_STAGE(PG8_SA(0, 0), cA, voffA); PG8_STAGE(PG8_SB(0, 1), cB + hstepB, voffB); PG8_STAGE(PG8_SA(0, 1), cA + hstepA, voffA);
        if (wr == 1) PG8_BAR;
        PG8_WAIT_V(4); PG8_BAR;
        PG8_STAGE(PG8_SB(1, 0), cB + kstepB, voffB); PG8_STAGE(PG8_SA(1, 0), cA + kstep, voffA); PG8_STAGE(PG8_SB(1, 1), cB + hstepB + kstepB, voffB);
        PG8_WAIT_V(6); PG8_BAR;
    }
    for (;;) {
        const bool has_next = S.next(ui + 1, nxt);
        const char* nA = has_next ? (const char*)g.A + (size_t)nxt.pm * tstepA : cA; const char* nB = has_next ? (const char*)g.Bt + (size_t)nxt.pn * tstepB : cB;
        for (int t = 0; t < nt; t += 2) {
            const bool last = (t == nt - 2);
            const char* a1 = cA + (size_t)(t + 1) * kstep;
            const char* a2 = last ? nA : cA + (size_t)(t + 2) * kstep; const char* b2 = last ? nB : cB + (size_t)(t + 2) * kstepB;
            const char* a3 = a2 + kstep; const char* b3 = b2 + kstepB;
            if (last && has_next) S.a_ready(nxt);
            if constexpr (SP2) {
            PG8_LDB(B0, 0, 0); PG8_LDB(B1, 0, 1); PG8_SCHED; PG8_LDA(At, 0, 0); PG8_STAGE(PG8_SA(1, 1), a1 + hstepA, voffA);
            PG8_WAIT_V(8); PG8_WAIT_L(0); PG8_BAR; PG8_MMA(0, 0, At, B0); PG8_MMA(0, 1, At, B1); PG8_BAR; PG8_SCHED;
            PG8_LDA(At, 0, 1); PG8_STAGE(PG8_SB(0, 0), b2, voffB); PG8_STAGE(PG8_SB(0, 1), b2 + hstepB, voffB); PG8_STAGE(PG8_SA(0, 0), a2, voffA);
            PG8_WAIT_V(8); PG8_WAIT_L(0); PG8_BAR; PG8_MMA(1, 0, At, B0); PG8_MMA(1, 1, At, B1); PG8_BAR; PG8_SCHED;
            PG8_LDB(B0, 1, 0); PG8_LDB(B1, 1, 1); PG8_SCHED; PG8_LDA(At, 1, 0); PG8_STAGE(PG8_SA(0, 1), a2 + hstepA, voffA);
            PG8_WAIT_V(8); PG8_WAIT_L(0); PG8_BAR; PG8_MMA(0, 0, At, B0); PG8_MMA(0, 1, At, B1); PG8_BAR; PG8_SCHED;
            PG8_LDA(At, 1, 1); PG8_STAGE(PG8_SB(1, 0), b3, voffB); PG8_STAGE(PG8_SB(1, 1), b3 + hstepB, voffB); PG8_STAGE(PG8_SA(1, 0), a3, voffA);
            PG8_WAIT_V(8); PG8_WAIT_L(0); PG8_BAR; PG8_MMA(1, 0, At, B0); PG8_MMA(1, 1, At, B1); PG8_BAR; PG8_SCHED;
            } else {
            PG8_LDB(B0, 0, 0); PG8_SCHED; PG8_LDA(At, 0, 0); PG8_STAGE(PG8_SA(1, 1), a1 + hstepA, voffA);
            PG8_WAIT_L(8); PG8_BAR; PG8_WAIT_L(0); PG8_MMA(0, 0, At, B0); PG8_BAR; PG8_SCHED;
            PG8_LDB(B1, 0, 1); PG8_STAGE(PG8_SB(0, 0), b2, voffB);
            PG8_BAR; PG8_WAIT_L(0); PG8_MMA(0, 1, At, B1); PG8_BAR;
            PG8_LDA(At, 0, 1); PG8_STAGE(PG8_SA(0, 0), a2, voffA);
            PG8_BAR; PG8_WAIT_L(0); PG8_MMA(1, 0, At, B0); PG8_BAR; PG8_SCHED;
            PG8_STAGE(PG8_SB(0, 1), b2 + hstepB, voffB);
            PG8_WAIT_V(6); PG8_BAR; PG8_MMA(1, 1, At, B1); PG8_BAR;
            PG8_LDB(B0, 1, 0); PG8_SCHED; PG8_LDA(At, 1, 0); PG8_STAGE(PG8_SA(0, 1), a2 + hstepA, voffA);
            PG8_WAIT_L(8); PG8_BAR; PG8_WAIT_L(0); PG8_MMA(0, 0, At, B0); PG8_BAR; PG8_SCHED;
            PG8_LDB(B1, 1, 1); PG8_STAGE(PG8_SB(1, 0), b3, voffB);
            PG8_BAR; PG8_WAIT_L(0); PG8_MMA(0, 1, At, B1); PG8_BAR;
            PG8_LDA(At, 1, 1); PG8_STAGE(PG8_SA(1, 0), a3, voffA);
            PG8_BAR; PG8_WAIT_L(0); PG8_MMA(1, 0, At, B0); PG8_BAR; PG8_SCHED;
            PG8_STAGE(PG8_SB(1, 1), b3 + hstepB, voffB);
            PG8_WAIT_V(6); PG8_BAR; PG8_MMA(1, 1, At, B1); PG8_BAR;
            }
        }
        if constexpr (ALIGN_EPI) { if (wr == 0) PG8_BAR; }
        if constexpr (!Epi::AFTER_DRAIN) { E(acc, cur, wr, wc, fr, fq); S.done(cur); }
        if (!has_next) break;
#pragma unroll
        for (int a = 0; a < 2; ++a)
#pragma unroll
            for (int b = 0; b < 2; ++b)
#pragma unroll
                for (int m = 0; m < 4; ++m)
#pragma unroll
                    for (int n = 0; n < 2; ++n) acc[a][b][m][n] = (f32x4){0.f, 0.f, 0.f, 0.f};
        cur = nxt; cA = nA; cB = nB; ++ui;
        if constexpr (ALIGN_EPI) { if (wr == 1) PG8_BAR; }
    }
    PG8_WAIT_V(0);
    if constexpr (!ALIGN_EPI) { if (wr == 0) PG8_BAR; }
    PG8_BAR;
    if constexpr (Epi::AFTER_DRAIN) { E.fused(acc, cur, wr, wc, fr, fq, lds, wid, lane); S.done(cur); }
#undef PG8_SA
#undef PG8_SB
#undef PG8_STAGE
#undef PG8_LDA
#undef PG8_LDB
#undef PG8_MMA
#undef PG8_WAIT_V
#undef PG8_WAIT_L
#undef PG8_BAR
#undef PG8_SCHED
}
}

constexpr int DM = 2048, SEQ = 2048, NB = 4, NS = 128, DEPTH = 2;
constexpr int MP = NB * SEQ;
constexpr int MT = MP + NS;
constexpr int MPAD = MP + 256;
constexpr int PIN = 6400, DFF = 8192, NMEM = 256, MMEM = NB * NMEM;
constexpr int PB_ = 1536, PC_ = 3584, PD_ = 5376;
constexpr int SHW = 1792;
constexpr int LDU = 8192;
constexpr int NWAVES = 8;
constexpr int NIN = 39;

constexpr size_t O_YP = 0, O_YS = O_YP + (size_t)MP * DM, O_CAP = O_YS + (size_t)NS * DM, O_CAS = O_CAP + (size_t)DEPTH * NB * 2 * 512,
    O_RETP = O_CAS + (size_t)DEPTH * NS * 2 * 512, O_RETS = O_RETP + (size_t)DEPTH * NB * 4 * 128 * 128, O_SHP = O_RETS + (size_t)DEPTH * NS * 4 * 128 * 128,
    O_SHS = O_SHP + (size_t)DEPTH * NB * SHW, O_WKVP = O_SHS + (size_t)DEPTH * NS * SHW, O_WKVS = O_WKVP + (size_t)DEPTH * NB * 8 * 64 * 64,
    O_CDP = O_WKVS + (size_t)DEPTH * NS * 8 * 64 * 64, O_CDS = O_CDP + (size_t)DEPTH * NB * 30 * 512, O_MKP = O_CDS + (size_t)DEPTH * NS * 30 * 512,
    O_MVP = O_MKP + (size_t)DEPTH * MMEM * DM, O_END = O_MVP + (size_t)DEPTH * MMEM * DM;
static_assert(O_END == 56178688, "d_out size");

constexpr size_t MiB = 1u << 20;
constexpr size_t al256(size_t x) { return (x + 255) & ~(size_t)255; }
constexpr size_t WS_CTL = 0, CTL_ZERO_BYTES = 1 * MiB;
constexpr size_t WS_ROPE = 1 * MiB;
constexpr size_t SZ_WIN = (size_t)PIN * DM * 2, SZ_SQ = (size_t)DM * DM * 2, SZ_WUP = (size_t)DFF * DM * 2, SZ_WDN = (size_t)DM * LDU * 2;
constexpr size_t LW_IN = 0, LW_OUT = LW_IN + SZ_WIN, LW_Q = LW_OUT + SZ_SQ, LW_O = LW_Q + SZ_SQ, LW_UP = LW_O + SZ_SQ, LW_DN = LW_UP + SZ_WUP,
    LW_W2 = LW_DN + SZ_WDN, LW_A2 = LW_W2 + 512 * 64 * 2, LW_G2 = LW_A2 + 512 * 64 * 2, LW_STRIDE = LW_G2 + 512 * 128 * 2;
constexpr size_t WS_WL = 4 * MiB;
constexpr size_t WS_WKV = al256(WS_WL + 2 * LW_STRIDE);
constexpr size_t WS_XF = al256(WS_WKV + (size_t)8192 * DM * 2);
constexpr size_t WS_HN = al256(WS_XF + (size_t)MT * DM * 4);
constexpr size_t WS_MN = al256(WS_HN + (size_t)MPAD * DM * 2);
constexpr size_t WS_MK = al256(WS_MN + (size_t)MMEM * DM * 2);
constexpr size_t WS_MVT = al256(WS_MK + (size_t)2 * MMEM * DM * 2);
constexpr size_t WS_P = al256(WS_MVT + (size_t)2 * MMEM * DM * 2);
constexpr size_t WS_YC = al256(WS_P + (size_t)MPAD * PIN * 2);
constexpr size_t WS_Q = al256(WS_YC + (size_t)MT * DM * 2);
constexpr size_t WS_O = al256(WS_Q + (size_t)MT * DM * 2);
constexpr size_t WS_U = al256(WS_O + (size_t)MT * DM * 2);
constexpr size_t WS_RW = al256(WS_U + (size_t)MT * LDU * 2);
constexpr size_t WS_GATE = al256(WS_RW + (size_t)MT * 8 * 896);
constexpr size_t WS_OC = al256(WS_GATE + (size_t)MT * 512 * 4);
constexpr size_t WS_KVT = al256(WS_OC + (size_t)MT * 512 * 4);
constexpr size_t WS_SSQ = al256(WS_KVT + (size_t)16 * 16 * 128 * 128 * 4);
constexpr size_t WS_SPL = al256(WS_SSQ + (size_t)MP * 8 * 4);
constexpr size_t WS_STB = al256(WS_SPL + (size_t)2 * NS * DM * 4);
constexpr size_t WS_CK = al256(WS_STB + (size_t)16 * 16 * 128 * 128 * 2);
constexpr size_t WS_CP = al256(WS_CK + (size_t)4096 * 6912);
constexpr int DMS = DM + 128, LDUS = LDU + 128;
constexpr size_t WS_HNS = al256(WS_CP + (size_t)4096 * 4 * 3072);
constexpr size_t WS_OS = al256(WS_HNS + (size_t)NS * DMS * 2);
constexpr size_t WS_US = al256(WS_OS + (size_t)NS * DMS * 2);
constexpr size_t WS_END = al256(WS_US + (size_t)NS * LDUS * 2);
static_assert(WS_END < (size_t)1700 * MiB, "d_ws map");
constexpr int CW_BAR = 4096;

constexpr int SCR_BYTES = 147456;
constexpr int MISC_OFF = SCR_BYTES;
constexpr int LDS_BYTES = SCR_BYTES + 1024;

#define GAS __attribute__((address_space(1)))
#define LAS __attribute__((address_space(3)))
typedef unsigned short bf16;
typedef unsigned v4u __attribute__((ext_vector_type(4)));
typedef unsigned v2u __attribute__((ext_vector_type(2)));
typedef float f32x4 __attribute__((ext_vector_type(4)));
typedef float f32x2 __attribute__((ext_vector_type(2)));
typedef short bf16x8 __attribute__((ext_vector_type(8)));
typedef short bf16x4 __attribute__((ext_vector_type(4)));
typedef GAS unsigned gu32;
#define RLX_AGENT __ATOMIC_RELAXED, __HIP_MEMORY_SCOPE_AGENT
#define LDS_WAIT() asm volatile("s_waitcnt lgkmcnt(0)" ::: "memory")
#define VM_WAIT() asm volatile("s_waitcnt vmcnt(0)" ::: "memory")
__device__ __forceinline__ unsigned pk2(float lo, float hi) { return pg8::cvt_pk_bf16(lo, hi); }
__device__ __forceinline__ float bflo(unsigned w) { return __uint_as_float(w << 16); }
__device__ __forceinline__ float bfhi(unsigned w) { return __uint_as_float(w & 0xffff0000u); }
__device__ __forceinline__ float bf1(bf16 h) { return __uint_as_float(((unsigned)h) << 16); }
__device__ __forceinline__ void unpack8(const v4u w, float (&f)[8]) { f[0] = bflo(w.x); f[1] = bfhi(w.x); f[2] = bflo(w.y); f[3] = bfhi(w.y); f[4] = bflo(w.z); f[5] = bfhi(w.z); f[6] = bflo(w.w); f[7] = bfhi(w.w); }
__device__ __forceinline__ void unpack4(const v2u w, float (&f)[4]) { f[0] = bflo(w.x); f[1] = bfhi(w.x); f[2] = bflo(w.y); f[3] = bfhi(w.y); }
__device__ __forceinline__ v4u pack8(const float (&f)[8]) { v4u w; w.x = pk2(f[0], f[1]); w.y = pk2(f[2], f[3]); w.z = pk2(f[4], f[5]); w.w = pk2(f[6], f[7]); return w; }
__device__ __forceinline__ float sigm(float x) { return 1.0f / (1.0f + __expf(-x)); }
__device__ __forceinline__ float wave_sum(float v) {
#pragma unroll
    for (int o = 1; o < 64; o <<= 1) v += __shfl_xor(v, o);
    return v;
}
__device__ __forceinline__ float wave_max(float v) {
#pragma unroll
    for (int o = 1; o < 64; o <<= 1) v = fmaxf(v, __shfl_xor(v, o));
    return v;
}
template <int CTRL> __device__ __forceinline__ float dpp_f(float v) { return __builtin_bit_cast(float, __builtin_amdgcn_update_dpp(0, __builtin_bit_cast(int, v), CTRL, 0xf, 0xf, false)); }
__device__ __forceinline__ f32x4 zero4() { float z0, z1, z2, z3; asm volatile("v_mov_b32 %0, 0\n\tv_mov_b32 %1, 0\n\tv_mov_b32 %2, 0\n\tv_mov_b32 %3, 0\n\ts_nop 1" : "=v"(z0), "=v"(z1), "=v"(z2), "=v"(z3)); return (f32x4){z0, z1, z2, z3}; }
__device__ __forceinline__ float rowsum16(float v) { v += dpp_f<0x128>(v); v += dpp_f<0x124>(v); v += dpp_f<0x122>(v); v += dpp_f<0x121>(v); return v; }

namespace pg8 {
template <int ACT> struct EpiBf16A {
    static constexpr bool PERM = true, AFTER_DRAIN = false;
    bf16_t* O; int ldc; const float* ssq;
    __device__ __forceinline__ void operator()(const f32x4 (&acc)[2][2][4][2], const Unit& u, int wr, int wc, int fr, int fq) const {
        const int row0 = u.pm * BM + wr * 64 + fr, col0 = u.pn * BM + wc * 32 + 8 * fq;
#pragma unroll
        for (int ai = 0; ai < 2; ++ai)
#pragma unroll
            for (int m = 0; m < 4; ++m) { bf16_t* rowp = O + (size_t)(row0 + ai * HALF + m * 16) * ldc + col0;
                const float rs = ssq ? 1.0f / sqrtf(ssq[row0 + ai * HALF + m * 16] * (1.0f / 2048.0f) + 1e-6f) : 1.0f;
#pragma unroll
                for (int bj = 0; bj < 2; ++bj) { f32x4 v0 = acc[ai][bj][m][0] * rs, v1 = acc[ai][bj][m][1] * rs;
                    if (ACT == 3) {
#pragma unroll
                        for (int j = 0; j < 4; ++j) { const float a = fmaxf(v0[j], 0.f), b = fmaxf(v1[j], 0.f); v0[j] = a * a; v1[j] = b * b; } }
                    u32x4 w; w.x = cvt_pk_bf16(v0[0], v0[1]); w.y = cvt_pk_bf16(v0[2], v0[3]); w.z = cvt_pk_bf16(v1[0], v1[1]); w.w = cvt_pk_bf16(v1[2], v1[3]);
                    *(u32x4*)(rowp + bj * HALF) = w; } }
    }
};
struct EpiRes {
    static constexpr bool PERM = false, AFTER_DRAIN = false;
    float* X; int ldc; float sc; const float* Xin;
    __device__ __forceinline__ void operator()(const f32x4 (&acc)[2][2][4][2], const Unit& u, int wr, int wc, int fr, int fq) const {
        const int row0 = u.pm * BM + wr * 64 + fr, col0 = u.pn * BM + wc * 32 + 4 * fq;
#pragma unroll
        for (int ai = 0; ai < 2; ++ai)
#pragma unroll
            for (int m = 0; m < 4; ++m) { float* rowp = X + (size_t)(row0 + ai * HALF + m * 16) * ldc + col0; const float* inp = Xin + (size_t)(row0 + ai * HALF + m * 16) * ldc + col0;
                f32x4 o[2][2];
#pragma unroll
                for (int bj = 0; bj < 2; ++bj)
#pragma unroll
                    for (int n = 0; n < 2; ++n) o[bj][n] = *(const f32x4*)(inp + bj * HALF + n * 16);
#pragma unroll
                for (int bj = 0; bj < 2; ++bj)
#pragma unroll
                    for (int n = 0; n < 2; ++n) *(f32x4*)(rowp + bj * HALF + n * 16) = o[bj][n] + acc[ai][bj][m][n] * sc; }
    }
};
struct EpiMemKV {
    static constexpr bool PERM = false, AFTER_DRAIN = false;
    float* outK; bf16_t* MKb; bf16_t* MVT;
    __device__ __forceinline__ void operator()(const f32x4 (&acc)[2][2][4][2], const Unit& u, int wr, int wc, int fr, int fq) const {
        const int cbase = u.pn * BM, lyr = cbase >> 12, cc = cbase & 4095; const bool isV = cc >= 2048; const int colt = cc & 2047;
        const int row0 = u.pm * BM + wr * 64 + fr, col0 = colt + wc * 32 + 4 * fq;
        float* outp = outK + (isV ? (size_t)(O_MVP - O_MKP) : (size_t)0);
#pragma unroll
        for (int ai = 0; ai < 2; ++ai)
#pragma unroll
            for (int m = 0; m < 4; ++m) { const int r = row0 + ai * HALF + m * 16;
#pragma unroll
                for (int bj = 0; bj < 2; ++bj)
#pragma unroll
                    for (int n = 0; n < 2; ++n) { const int col = col0 + bj * HALF + n * 16; const f32x4 v = acc[ai][bj][m][n];
                        *(f32x4*)(outp + ((size_t)lyr * 1024 + r) * 2048 + col) = v;
                        if (!isV) { unsigned lo = cvt_pk_bf16(v[0], v[1]), hi = cvt_pk_bf16(v[2], v[3]); *(unsigned long long*)(MKb + ((size_t)lyr * 1024 + r) * 2048 + col) = ((unsigned long long)hi << 32) | lo; }
                        else { const int b = r >> 8, j = r & 255, h = col >> 9, e = col & 511; bf16_t* tp = MVT + ((((size_t)lyr * 4 + b) * 4 + h) * 512 + e) * 256 + j;
                            const unsigned lo = cvt_pk_bf16(v[0], v[1]), hi = cvt_pk_bf16(v[2], v[3]);
                            tp[0] = (bf16_t)(lo & 0xffffu); tp[256] = (bf16_t)(lo >> 16); tp[512] = (bf16_t)(hi & 0xffffu); tp[768] = (bf16_t)(hi >> 16); } } }
    }
};
}

struct SEpiBf16 { bf16* O; int ldc; int act; const float* ssq;
    __device__ __forceinline__ void operator()(int row, int col0, f32x4 v, int) const {
        if (ssq) v = v * (1.0f / sqrtf(ssq[row] * (1.0f / 2048.0f) + 1e-6f));
        if (act == 3) {
#pragma unroll
            for (int j = 0; j < 4; ++j) { const float a = fmaxf(v[j], 0.f); v[j] = a * a; } }
        v2u w; w.x = pk2(v[0], v[1]); w.y = pk2(v[2], v[3]); *(v2u*)(O + (size_t)row * ldc + col0) = w; } };
struct SEpiRes { float* X; int ldc; float sc; const float* Xin;
    __device__ __forceinline__ void operator()(int row, int col0, f32x4 v, int) const { *(f32x4*)(X + (size_t)row * ldc + col0) = *(const f32x4*)(Xin + (size_t)row * ldc + col0) + v * sc; } };
struct SEpiPart { float* S; int ldc;
    __device__ __forceinline__ void operator()(int row, int col0, f32x4 v, int kp) const { *(f32x4*)(S + ((size_t)kp * NS + row) * ldc + col0) = v; } };
template <class F> __device__ __forceinline__ void sample_gemm(LAS unsigned char* lds, int tid_in, const bf16* A, int lda, const bf16* Bt, int ntot, int N, int K, int G, int bid, const F& epi, int nks = 1) {
    int tid_ = tid_in; asm volatile("" : "+v"(tid_));
    const int lane = tid_ & 63, wave = __builtin_amdgcn_readfirstlane(tid_ >> 6), fr = lane & 15, fq = lane >> 4;
    const int KS = (K / nks) >> 3, ncu = N / 16;
    LAS f32x4* red = (LAS f32x4*)lds;
    const unsigned voffa = (unsigned)(fr * lda + fq * 8) * 2u, voffb = (unsigned)(fr * 64 + fq * 8) * 2u;
    for (int uu = bid; uu < ncu * nks; uu += G) { const int kp = uu / ncu, u = uu - kp * ncu, kbeg = kp * (K / nks) + wave * KS;
        const char* bp = (const char*)(Bt + ((size_t)(kbeg >> 6) * ntot + u * 16) * 64);
        const char* ap = (const char*)(A + kbeg);
        f32x4 acc[8];
#pragma unroll
        for (int rt = 0; rt < 8; ++rt) acc[rt] = zero4();
        bf16x8 b0[2], a0[2][8], b1[2], a1[2][8];
#define SG_LOAD(bb, aa, kq) do { _Pragma("unroll") for (int s = 0; s < 2; ++s) { bb[s] = *(const bf16x8*)(bp + ((size_t)((kq) >> 6) * ntot * 64 + 32 * s) * 2 + voffb); \
            _Pragma("unroll") for (int rt = 0; rt < 8; ++rt) aa[s][rt] = *(const bf16x8*)(ap + ((size_t)rt * 16 * lda + (kq) + 32 * s) * 2 + voffa); } } while (0)
#define SG_MMA(bb, aa) do { _Pragma("unroll") for (int s = 0; s < 2; ++s) _Pragma("unroll") for (int rt = 0; rt < 8; ++rt) acc[rt] = __builtin_amdgcn_mfma_f32_16x16x32_bf16(bb[s], aa[s][rt], acc[rt], 0, 0, 0); } while (0)
        SG_LOAD(b0, a0, 0);
        for (int k0 = 0; k0 < KS; k0 += 128) {
            __builtin_amdgcn_sched_barrier(0);
            SG_LOAD(b1, a1, k0 + 64);
            __builtin_amdgcn_sched_barrier(0);
            SG_MMA(b0, a0);
            __builtin_amdgcn_sched_barrier(0);
            if (k0 + 128 < KS) SG_LOAD(b0, a0, k0 + 128);
            __builtin_amdgcn_sched_barrier(0);
            SG_MMA(b1, a1);
        }
        __builtin_amdgcn_sched_barrier(0);
#undef SG_LOAD
#undef SG_MMA
#pragma unroll
        for (int rt = 0; rt < 8; ++rt) red[(wave * 8 + rt) * 64 + lane] = acc[rt];
        __syncthreads();
        f32x4 sum = red[wave * 64 + lane];
#pragma unroll
        for (int ks = 1; ks < 8; ++ks) sum += red[(ks * 8 + wave) * 64 + lane];
        epi(wave * 16 + fr, u * 16 + 4 * fq, sum, kp);
        __syncthreads();
    }
}
#define XB_TMO      128
#define XB_XCNT(j)  (256  + 64 * (j))
#define XB_XSUB(j)  (1280 + 64 * (j))
#define XB_XGEN(j)  (2304 + 64 * (j))
#define XB_TOP      3328
#define XB_TOPGEN   3392
#define XCD_BAR_WORDS 3456
#define XB_SPIN_CAP (1u << 18)

__device__ __forceinline__ unsigned xb_ld(unsigned* p)              { return __hip_atomic_load(p, __ATOMIC_RELAXED, __HIP_MEMORY_SCOPE_AGENT); }
__device__ __forceinline__ unsigned xb_add(unsigned* p, unsigned v) { return __hip_atomic_fetch_add(p, v, __ATOMIC_RELAXED, __HIP_MEMORY_SCOPE_AGENT); }
__device__ __forceinline__ unsigned xb_xcc_id() { return (unsigned)__builtin_amdgcn_s_getreg((3 << 11) | 20) & 0xFu; }
#define XB_SPIN(cond, bar) do { unsigned _sp = 0; while (cond) { __builtin_amdgcn_s_sleep(1); \
    if ((++_sp & 255u) == 0u) { if (xb_ld(&(bar)[XB_TMO])) break; if (_sp > XB_SPIN_CAP) { atomicAdd(&(bar)[XB_TMO], 1u); break; } } } } while (0)

struct XcdBarrier {
    int wave;
    unsigned* bar; unsigned x;
    volatile LAS unsigned* st;
};

__device__ __forceinline__ XcdBarrier xcd_barrier_post(unsigned* bar, volatile LAS unsigned* st) {
    XcdBarrier b; b.bar = bar; b.x = xb_xcc_id(); b.st = st;
    if (threadIdx.x == 0) (void)xb_add(&bar[XB_XCNT(b.x)], 1u);
    return b;
}
__device__ __forceinline__ void xcd_barrier_complete(unsigned* bar, unsigned x, unsigned& nloc, unsigned& nx) {
    const unsigned G = gridDim.x * gridDim.y * gridDim.z;
    unsigned sum, cnt, mine, sp = 0u;
    for (;;) {
        sum = 0u; cnt = 0u; mine = 0u;
#pragma unroll
        for (unsigned j = 0; j < 16; ++j) { const unsigned c = xb_ld(&bar[XB_XCNT(j)]); sum += c; cnt += (c > 0u) ? 1u : 0u; mine = (j == x) ? c : mine; }
        if (sum == G) break;
        __builtin_amdgcn_s_sleep(1);
        if ((++sp & 255u) == 0u) { if (xb_ld(&bar[XB_TMO])) break; if (sp > XB_SPIN_CAP) { atomicAdd(&bar[XB_TMO], 1u); break; } }
    }
    nloc = mine > 0u ? mine : 1u; nx = cnt > 0u ? cnt : 1u;
}

__device__ __forceinline__ void xcd_barrier(const XcdBarrier& b) {
    asm volatile("s_waitcnt vmcnt(0)" ::: "memory");
    __syncthreads();
    unsigned xbz = 0u; asm volatile("" : "+v"(xbz));
    if (b.wave == 0 && __builtin_amdgcn_mbcnt_hi(~0u, __builtin_amdgcn_mbcnt_lo(~0u, xbz)) == 0u) {
        unsigned* bar = b.bar;
        __builtin_amdgcn_s_waitcnt(0);
        unsigned nloc = b.st[0], nx = b.st[1];
        if (nloc == 0u) { xcd_barrier_complete(bar, b.x, nloc, nx); b.st[0] = nloc; b.st[1] = nx; }
        const unsigned old = xb_add(&bar[XB_XSUB(b.x)], 1u);
        const unsigned gen = old / nloc;
        if (old + 1u == (gen + 1u) * nloc) {
            __builtin_amdgcn_fence(__ATOMIC_RELEASE, "agent");
            asm volatile("s_waitcnt vmcnt(0)" ::: "memory");
            const unsigned og = xb_add(&bar[XB_TOP], 1u);
            const unsigned tg = og / nx;
            if (og + 1u == (tg + 1u) * nx) xb_add(&bar[XB_TOPGEN], 1u);
            else XB_SPIN(xb_ld(&bar[XB_TOPGEN]) == tg, bar);
            __builtin_amdgcn_fence(__ATOMIC_ACQUIRE, "agent");
            xb_add(&bar[XB_XGEN(b.x)], 1u);
            asm volatile("s_waitcnt vmcnt(0)" ::: "memory");
        } else {
            XB_SPIN(xb_ld(&bar[XB_XGEN(b.x)]) == gen, bar);
            __builtin_amdgcn_fence(__ATOMIC_ACQUIRE, "agent");
            asm volatile("s_waitcnt vmcnt(0)" ::: "memory");
        }
    }
    __syncthreads();
}

struct Args { const float* in[NIN]; float* out; unsigned char* ws; int ph_lo, ph_hi; };
enum { I_XP = 0, I_XS, I_MEM, I_SCA, I_SRET, I_SSH, I_SWKV, I_SCD, I_CMK, I_CMV, I_GMIX, I_WIN, I_CAW, I_MU, I_W0, I_W2, I_A0, I_A2, I_G2, I_KK, I_KA, I_RK, I_LNXG, I_LNXB,
       I_CDW, I_CDB, I_LNDG, I_LNDB, I_WOUT, I_GXA, I_GMEM, I_WQ, I_WK, I_WV, I_WO, I_GMLP, I_WUP, I_WDN, I_GFIN };

struct Ctx { LAS unsigned char* lds; int tid, lane, wave, G, bid; };
typedef const GAS float* gcfp;
#define CAS __attribute__((address_space(4)))
struct Ax { const CAS gcfp* kp; float* out; unsigned char* ws;
    __device__ __forceinline__ const float* in(int i) const { return (const float*)kp[i]; } };
__device__ __forceinline__ Ax mk_ax() { const CAS gcfp* kp = (const CAS gcfp*)__builtin_amdgcn_kernarg_segment_ptr(); asm volatile("" : "+s"(kp)); Ax a; a.kp = kp;
    a.out = (float*)(GAS float*)kp[NIN]; a.ws = (unsigned char*)(GAS unsigned char*)kp[NIN + 1]; return a; }
__device__ __forceinline__ Ctx mk_ctx(LAS unsigned char* lds, int wave_s) { unsigned z = 0u; asm volatile("" : "+v"(z)); int t = wave_s * 64 + (int)__builtin_amdgcn_mbcnt_hi(~0u, __builtin_amdgcn_mbcnt_lo(~0u, z)); Ctx C; C.lds = lds; C.tid = t; C.lane = t & 63; C.wave = __builtin_amdgcn_readfirstlane(t >> 6); C.G = gridDim.x; C.bid = blockIdx.x; return C; }

__device__ __forceinline__ void p0_transpose_item(const float* W, int K, int N, bf16* WT, int ldk, int row_off, LAS float* scr, int item, int lane, const float* gain) {
    const int nblk = N / 64, kb = item / nblk, nb = item - kb * nblk, k0 = 64 * kb, n0 = 64 * nb;
    const int lr = lane >> 4, lc = (lane & 15) * 4;
#pragma unroll 8
    for (int i = 0; i < 16; ++i) { const int kk = 4 * i + lr; const float g = gain ? gain[k0 + kk] : 1.0f; const f32x4 v = *(const f32x4*)(W + (size_t)(k0 + kk) * N + n0 + lc);
        LAS float* d = scr + kk * 65 + lc; d[0] = v.x * g; d[1] = v.y * g; d[2] = v.z * g; d[3] = v.w * g; }
    LDS_WAIT(); asm volatile("" ::: "memory");
    const int c = lane & 7;
#pragma unroll
    for (int j = 0; j < 8; ++j) { const int n = (lane >> 3) + 8 * j; const LAS float* s = scr + (8 * c) * 65 + n;
        v4u o; o.x = pk2(s[0 * 65], s[1 * 65]); o.y = pk2(s[2 * 65], s[3 * 65]); o.z = pk2(s[4 * 65], s[5 * 65]); o.w = pk2(s[6 * 65], s[7 * 65]);
        if (ldk > 0) *(v4u*)(WT + (size_t)(row_off + n0 + n) * ldk + k0 + 8 * c) = o;
        else *(v4u*)(WT + ((size_t)kb * (size_t)(-ldk) + row_off + n0 + n) * 64 + 8 * c) = o; }
    LDS_WAIT(); asm volatile("" ::: "memory");
}
__device__ __forceinline__ void rms_row(const float* xrow, bf16* orow, float* xcopy, int lane) {
    const f32x4* xr = (const f32x4*)xrow + lane;
    f32x4 v[8]; float s = 0.f;
#pragma unroll
    for (int j = 0; j < 8; ++j) { v[j] = xr[64 * j]; s += (v[j].x * v[j].x + v[j].y * v[j].y) + (v[j].z * v[j].z + v[j].w * v[j].w); }
    const float rs = 1.0f / sqrtf(wave_sum(s) * (1.0f / DM) + 1e-6f);
    if (xcopy) {
#pragma unroll
        for (int j = 0; j < 8; ++j) ((f32x4*)xcopy + lane)[64 * j] = v[j]; }
    unsigned long long* o8 = (unsigned long long*)orow + lane;
#pragma unroll
    for (int j = 0; j < 8; ++j) o8[64 * j] = (unsigned long long)pk2(v[j].x * rs, v[j].y * rs) | ((unsigned long long)pk2(v[j].z * rs, v[j].w * rs) << 32);
}
__device__ __forceinline__ void rms_phase(const Ctx& C, const float* X, bf16* HN, bf16* HNS) {
    const int gw = C.bid * NWAVES + C.wave, NGW = C.G * NWAVES;
    f32x4 v[8], nx[8]; int m = gw;
    if (m < MT) { const f32x4* xr = (const f32x4*)(X + (size_t)m * DM) + C.lane;
#pragma unroll
        for (int j = 0; j < 8; ++j) v[j] = xr[64 * j]; }
    for (; m < MT; m += NGW) {
        const int mn = m + NGW;
        if (mn < MT) { const f32x4* xr = (const f32x4*)(X + (size_t)mn * DM) + C.lane;
#pragma unroll
            for (int j = 0; j < 8; ++j) nx[j] = xr[64 * j]; }
        float s = 0.f;
#pragma unroll
        for (int j = 0; j < 8; ++j) s += (v[j].x * v[j].x + v[j].y * v[j].y) + (v[j].z * v[j].z + v[j].w * v[j].w);
        const float rs = 1.0f / sqrtf(wave_sum(s) * (1.0f / DM) + 1e-6f);
        unsigned long long* o8 = (unsigned long long*)((HNS && m >= MP) ? HNS + (size_t)(m - MP) * DMS : HN + (size_t)m * DM) + C.lane;
#pragma unroll
        for (int j = 0; j < 8; ++j) o8[64 * j] = (unsigned long long)pk2(v[j].x * rs, v[j].y * rs) | ((unsigned long long)pk2(v[j].z * rs, v[j].w * rs) << 32);
#pragma unroll
        for (int j = 0; j < 8; ++j) v[j] = nx[j];
    }
}
__device__ __forceinline__ void fold_split_rows(const Ctx& C, float* X, const float* S) {
    const int gw = C.bid * NWAVES + C.wave, NGW = C.G * NWAVES;
    for (int r = gw; r < NS; r += NGW) { f32x4* xr = (f32x4*)(X + (size_t)(MP + r) * DM) + C.lane; const f32x4* s0 = (const f32x4*)(S + (size_t)r * DM) + C.lane; const f32x4* s1 = (const f32x4*)(S + (size_t)(NS + r) * DM) + C.lane;
#pragma unroll
        for (int j = 0; j < 8; ++j) xr[64 * j] = xr[64 * j] + (s0[64 * j] + s1[64 * j]); }
    asm volatile("s_waitcnt vmcnt(0)" ::: "memory");
}
__device__ __forceinline__ void final_norm_phase(const Ctx& C, const float* X, const float* g, float* out) {
    const int gw = C.bid * NWAVES + C.wave, NGW = C.G * NWAVES;
    for (int m = gw; m < MT; m += NGW) {
        const f32x4* xr = (const f32x4*)(X + (size_t)m * DM) + C.lane; const f32x4* gr = (const f32x4*)g + C.lane;
        f32x4 v[8]; float s = 0.f;
#pragma unroll
        for (int j = 0; j < 8; ++j) { v[j] = xr[64 * j]; s += (v[j].x * v[j].x + v[j].y * v[j].y) + (v[j].z * v[j].z + v[j].w * v[j].w); }
        const float rs = 1.0f / sqrtf(wave_sum(s) * (1.0f / DM) + 1e-6f);
        f32x4* orow = (f32x4*)(out + (size_t)m * DM) + C.lane;
#pragma unroll
        for (int j = 0; j < 8; ++j) orow[64 * j] = v[j] * rs * gr[64 * j];
    }
}
#ifndef LATE_EXTRA
#define LATE_EXTRA 0
#endif
struct TDesc { const float* W; const float* gain; bf16* WT; int K, N, ldk, row_off, item; };
__device__ __forceinline__ TDesc p0_desc(const Ax& a, int it, int G) {
    constexpr int I_IN = 32 * 100, I_SQ = 32 * 32, I_UP = 32 * 128, I_DN = 128 * 32, I_L64 = 8, I_L128 = 16;
    constexpr int PER_LAYER = I_IN + 5 * I_SQ + I_UP + I_DN + 2 * I_L64 + I_L128;
    const int l = it / PER_LAYER; int r = it - l * PER_LAYER; unsigned char* wl = a.ws + WS_WL + (size_t)l * LW_STRIDE; bf16* wkv = (bf16*)(a.ws + WS_WKV);
    TDesc d; d.row_off = 0; d.gain = nullptr; const bool late = G == 256 && DEPTH == 2, late1 = late && l == 1 && LATE_EXTRA;
    if (r < I_IN) { d.W = a.in(I_WIN) + (size_t)l * DM * PIN; d.K = DM; d.N = PIN; d.WT = (bf16*)(wl + LW_IN); d.ldk = -PIN; d.gain = a.in(I_GMIX) + l * DM; d.item = r; return d; } r -= I_IN;
    if (r < I_SQ) { d.W = a.in(I_WOUT) + (size_t)l * DM * DM; d.K = DM; d.N = DM; d.WT = (bf16*)(wl + LW_OUT); d.ldk = -DM; d.item = late1 ? -1 : r; return d; } r -= I_SQ;
    if (r < I_SQ) { d.W = a.in(I_WQ) + (size_t)l * DM * DM; d.K = DM; d.N = DM; d.WT = (bf16*)(wl + LW_Q); d.ldk = -DM; d.gain = a.in(I_GXA) + l * DM; d.item = late1 ? -1 : r; return d; } r -= I_SQ;
    if (r < I_SQ) { d.W = a.in(I_WO) + (size_t)l * DM * DM; d.K = DM; d.N = DM; d.WT = (bf16*)(wl + LW_O); d.ldk = -DM; d.item = late1 ? -1 : r; return d; } r -= I_SQ;
    if (r < I_SQ) { d.W = a.in(I_WK) + (size_t)l * DM * DM; d.K = DM; d.N = DM; d.WT = wkv; d.ldk = -8192; d.row_off = l * 4096; d.gain = a.in(I_GMEM) + l * DM; d.item = late1 ? -1 : r; return d; } r -= I_SQ;
    if (r < I_SQ) { d.W = a.in(I_WV) + (size_t)l * DM * DM; d.K = DM; d.N = DM; d.WT = wkv; d.ldk = -8192; d.row_off = l * 4096 + 2048; d.gain = a.in(I_GMEM) + l * DM; d.item = late1 ? -1 : r; return d; } r -= I_SQ;
    if (r < I_UP) { d.W = a.in(I_WUP) + (size_t)l * DM * DFF; d.K = DM; d.N = DFF; d.WT = (bf16*)(wl + LW_UP); d.ldk = -DFF; d.gain = a.in(I_GMLP) + l * DM; d.item = late ? -1 : r; return d; } r -= I_UP;
    if (r < I_DN) { d.W = a.in(I_WDN) + (size_t)l * DFF * DM; d.K = DFF; d.N = DM; d.WT = (bf16*)(wl + LW_DN); d.ldk = -DM; d.item = late ? -1 : r; return d; } r -= I_DN;
    if (r < I_L64) { d.W = a.in(I_W2) + (size_t)l * 64 * 512; d.K = 64; d.N = 512; d.WT = (bf16*)(wl + LW_W2); d.ldk = 64; d.item = r; return d; } r -= I_L64;
    if (r < I_L64) { d.W = a.in(I_A2) + (size_t)l * 64 * 512; d.K = 64; d.N = 512; d.WT = (bf16*)(wl + LW_A2); d.ldk = 64; d.item = r; return d; } r -= I_L64;
    d.W = a.in(I_G2) + (size_t)l * 128 * 512; d.K = 128; d.N = 512; d.WT = (bf16*)(wl + LW_G2); d.ldk = 128; d.item = r; return d;
}
__device__ __forceinline__ void p0_load(const TDesc& d, int lane, f32x4 (&v)[16], float (&g)[16]) {
    if (d.item < 0) return;
    const int nblk = d.N / 64, kb = d.item / nblk, nb = d.item - kb * nblk, k0 = 64 * kb, n0 = 64 * nb, lr = lane >> 4, lc = (lane & 15) * 4;
#pragma unroll
    for (int i = 0; i < 16; ++i) { const int kk = 4 * i + lr; g[i] = d.gain ? d.gain[k0 + kk] : 1.0f; v[i] = __builtin_nontemporal_load((const f32x4*)(d.W + (size_t)(k0 + kk) * d.N + n0 + lc)); }
}
__device__ __forceinline__ void p0_finish(const TDesc& d, LAS float* scr, int lane, const f32x4 (&v)[16], const float (&g)[16]) {
    if (d.item < 0) return;
    const int nblk = d.N / 64, kb = d.item / nblk, nb = d.item - kb * nblk, k0 = 64 * kb, n0 = 64 * nb, lr = lane >> 4, lc = (lane & 15) * 4;
#pragma unroll
    for (int i = 0; i < 16; ++i) { const int kk = 4 * i + lr; LAS float* p = scr + kk * 65 + lc; p[0] = v[i].x * g[i]; p[1] = v[i].y * g[i]; p[2] = v[i].z * g[i]; p[3] = v[i].w * g[i]; }
    LDS_WAIT(); asm volatile("" ::: "memory");
    const int c = lane & 7;
#pragma unroll
    for (int j = 0; j < 8; ++j) { const int n = (lane >> 3) + 8 * j; const LAS float* s = scr + (8 * c) * 65 + n;
        v4u o; o.x = pk2(s[0 * 65], s[1 * 65]); o.y = pk2(s[2 * 65], s[3 * 65]); o.z = pk2(s[4 * 65], s[5 * 65]); o.w = pk2(s[6 * 65], s[7 * 65]);
        if (d.ldk > 0) *(v4u*)(d.WT + (size_t)(d.row_off + n0 + n) * d.ldk + k0 + 8 * c) = o;
        else *(v4u*)(d.WT + ((size_t)kb * (size_t)(-d.ldk) + d.row_off + n0 + n) * 64 + 8 * c) = o; }
    LDS_WAIT(); asm volatile("" ::: "memory");
}
__device__ __forceinline__ void p0_prologue(const Ctx& C, const Ax& a) {
    LAS float* scr = (LAS float*)(C.lds + C.wave * 16640);
    const int gw = C.bid * NWAVES + C.wave, NGW = C.G * NWAVES;
    constexpr int I_IN = 32 * 100, I_SQ = 32 * 32, I_UP = 32 * 128, I_DN = 128 * 32, I_L64 = 8, I_L128 = 16;
    constexpr int PER_LAYER = I_IN + 5 * I_SQ + I_UP + I_DN + 2 * I_L64 + I_L128;
    TDesc cur = p0_desc(a, gw, C.G), nxt; f32x4 va[16], vb[16]; float ga[16], gb[16];
    const int NITEMS = DEPTH * PER_LAYER;
    if (gw < NITEMS) p0_load(cur, C.lane, va, ga);
    for (int it = gw; it < NITEMS; it += 2 * NGW) {
        const int it1 = it + NGW, it2 = it + 2 * NGW;
        if (it1 < NITEMS) { nxt = p0_desc(a, it1, C.G); p0_load(nxt, C.lane, vb, gb); }
        p0_finish(cur, scr, C.lane, va, ga);
        if (it1 < NITEMS) { if (it2 < NITEMS) { cur = p0_desc(a, it2, C.G); p0_load(cur, C.lane, va, ga); }
            p0_finish(nxt, scr, C.lane, vb, gb); }
    }
    { float* cs = (float*)(a.ws + WS_ROPE); const int gt = C.bid * (NWAVES * 64) + C.tid, NT = C.G * NWAVES * 64;
      for (int idx = gt; idx < 2049 * 64; idx += NT) { const int p = idx >> 6, i = idx & 63; const double pos = (p == 2048) ? 16384.0 : (double)p;
          const double inv = exp(-(double)i * (9.210340371976184 / 64.0)); double r = pos * inv; r -= 6.283185307179586 * rint(r * 0.15915494309189535);
          cs[2 * idx] = (float)cos(r); cs[2 * idx + 1] = (float)sin(r); } }
    float* XF = (float*)(a.ws + WS_XF); bf16* HN = (bf16*)(a.ws + WS_HN); bf16* MN = (bf16*)(a.ws + WS_MN);
    for (int m = gw; m < MT; m += NGW) { const float* src = (m < MP) ? a.in(I_XP) + (size_t)m * DM : a.in(I_XS) + (size_t)(m - MP) * DM; rms_row(src, HN + (size_t)m * DM, nullptr, C.lane); }
    for (int m = gw; m < MMEM; m += NGW) rms_row(a.in(I_MEM) + (size_t)m * DM, MN + (size_t)m * DM, nullptr, C.lane);
}

__device__ __forceinline__ TDesc lc_desc(const Ax& a, int l, int it) {
    constexpr int I_UP = 32 * 128, I_DN = 128 * 32, I_SQ = 32 * 32;
    unsigned char* wl = a.ws + WS_WL + (size_t)l * LW_STRIDE; TDesc d; d.row_off = 0; d.gain = nullptr;
    if (it < I_UP) { d.W = a.in(I_WUP) + (size_t)l * DM * DFF; d.K = DM; d.N = DFF; d.WT = (bf16*)(wl + LW_UP); d.ldk = -DFF; d.gain = a.in(I_GMLP) + l * DM; d.item = it; return d; }
    int r = it - I_UP;
    if (r < I_DN) { d.W = a.in(I_WDN) + (size_t)l * DFF * DM; d.K = DFF; d.N = DM; d.WT = (bf16*)(wl + LW_DN); d.ldk = -DM; d.item = r; return d; } r -= I_DN;
    d.K = DM; d.N = DM; d.item = r & (I_SQ - 1); const int q = r >> 10;
    if (l == 0) { const int l1 = 1; d.W = a.in(q == 0 ? I_WK : I_WV) + (size_t)l1 * DM * DM; d.WT = (bf16*)(a.ws + WS_WKV); d.ldk = -8192; d.row_off = l1 * 4096 + q * 2048; d.gain = a.in(I_GMEM) + l1 * DM; return d; }
    d.ldk = -DM;
    if (q == 0) { d.W = a.in(I_WOUT) + (size_t)l * DM * DM; d.WT = (bf16*)(wl + LW_OUT); }
    else if (q == 1) { d.W = a.in(I_WQ) + (size_t)l * DM * DM; d.WT = (bf16*)(wl + LW_Q); d.gain = a.in(I_GXA) + l * DM; }
    else { d.W = a.in(I_WO) + (size_t)l * DM * DM; d.WT = (bf16*)(wl + LW_O); }
    return d;
}
__device__ __forceinline__ void late_convert(const Ctx& C, const Ax& a, int l, int rank, int nrank) {
    LAS float* scr = (LAS float*)(C.lds + C.wave * 16640);
    const int NITEMS = 32 * 128 + 128 * 32 + (LATE_EXTRA ? (l == 0 ? 2 : 3) * 1024 : 0);
    const int gw = rank * NWAVES + C.wave, NGW = nrank * NWAVES;
    TDesc cur, nxt; f32x4 va[16], vb[16]; float ga[16], gb[16];
    if (gw < NITEMS) { cur = lc_desc(a, l, gw); p0_load(cur, C.lane, va, ga); }
    for (int it = gw; it < NITEMS; it += 2 * NGW) {
        const int it1 = it + NGW, it2 = it + 2 * NGW;
        if (it1 < NITEMS) { nxt = lc_desc(a, l, it1); p0_load(nxt, C.lane, vb, gb); }
        p0_finish(cur, scr, C.lane, va, ga);
        if (it1 < NITEMS) { if (it2 < NITEMS) { cur = lc_desc(a, l, it2); p0_load(cur, C.lane, va, ga); }
            p0_finish(nxt, scr, C.lane, vb, gb); }
    }
}
__device__ __forceinline__ void ad_prompt_item(const Ctx& C, const Ax& a, int l, int item) {
    const bf16* P = (const bf16*)(a.ws + WS_P); bf16* YC = (bf16*)(a.ws + WS_YC);
    const int b = item >> 6, t0 = (item & 63) * 32; const size_t rbase = (size_t)b * SEQ;
    LAS float* UD = (LAS float*)C.lds;
    { v4u r1[8], r2[8];
#pragma unroll
      for (int u = 0; u < 8; ++u) { const int it = C.tid + u * (NWAVES * 64), r = it >> 6, cc = it & 63, t = t0 - 30 + r; r1[u] = (v4u){0u, 0u, 0u, 0u}; r2[u] = r1[u];
        if (it < 62 * 64 && t >= 0) { const bf16* pr = P + (rbase + t) * PIN + PD_ + cc * 8; r1[u] = *(const v4u*)pr; r2[u] = *(const v4u*)(pr + 512); } }
      __builtin_amdgcn_sched_barrier(0);
#pragma unroll
      for (int u = 0; u < 8; ++u) { const int it = C.tid + u * (NWAVES * 64), r = it >> 6, cc = it & 63;
        if (it < 62 * 64) { float d1[8], d2[8], uu[8]; unpack8(r1[u], d1); unpack8(r2[u], d2);
#pragma unroll
            for (int j = 0; j < 8; ++j) uu[j] = d1[j] * sigm(d2[j]);
            *(LAS f32x4*)(UD + r * 512 + cc * 8) = (f32x4){uu[0], uu[1], uu[2], uu[3]}; *(LAS f32x4*)(UD + r * 512 + cc * 8 + 4) = (f32x4){uu[4], uu[5], uu[6], uu[7]}; } } }
    __builtin_amdgcn_sched_barrier(0);
    { const int cc = C.tid & 63; const float* cw = a.in(I_CAW) + (size_t)l * 3 * 512 + cc * 8;
      const f32x4 w0a = *(const f32x4*)cw, w0b = *(const f32x4*)(cw + 4), w1a = *(const f32x4*)(cw + 512), w1b = *(const f32x4*)(cw + 516), w2a = *(const f32x4*)(cw + 1024), w2b = *(const f32x4*)(cw + 1028);
      const float k0[8] = {w0a.x, w0a.y, w0a.z, w0a.w, w0b.x, w0b.y, w0b.z, w0b.w}, k1[8] = {w1a.x, w1a.y, w1a.z, w1a.w, w1b.x, w1b.y, w1b.z, w1b.w}, k2[8] = {w2a.x, w2a.y, w2a.z, w2a.w, w2b.x, w2b.y, w2b.z, w2b.w};
#pragma unroll
      for (int hb = 0; hb < 2; ++hb) { v4u q[2][7];
#pragma unroll
        for (int u = 0; u < 2; ++u) { const int r = (C.tid >> 6) + (hb * 2 + u) * NWAVES, t = t0 + r; const bf16* pr = P + (rbase + t) * PIN + cc * 8;
#pragma unroll
            for (int z = 0; z < 7; ++z) q[u][z] = (v4u){0u, 0u, 0u, 0u};
            q[u][0] = *(const v4u*)pr; q[u][1] = *(const v4u*)(pr + 512); q[u][2] = *(const v4u*)(pr + 1024);
            if (t >= 1) { q[u][3] = *(const v4u*)(pr - PIN + 512); q[u][4] = *(const v4u*)(pr - PIN + 1024); }
            if (t >= 2) { q[u][5] = *(const v4u*)(pr - 2 * PIN + 512); q[u][6] = *(const v4u*)(pr - 2 * PIN + 1024); } }
        __builtin_amdgcn_sched_barrier(0);
#pragma unroll
        for (int u = 0; u < 2; ++u) { const int r = (C.tid >> 6) + (hb * 2 + u) * NWAVES, t = t0 + r;
            float ab[8], u0[8], u1[8], u2[8], x[8], y[8];
            unpack8(q[u][0], ab); unpack8(q[u][1], x); unpack8(q[u][2], y);
#pragma unroll
            for (int j = 0; j < 8; ++j) u2[j] = x[j] * y[j];
            unpack8(q[u][3], x); unpack8(q[u][4], y);
#pragma unroll
            for (int j = 0; j < 8; ++j) u1[j] = x[j] * y[j];
            unpack8(q[u][5], x); unpack8(q[u][6], y);
#pragma unroll
            for (int j = 0; j < 8; ++j) u0[j] = x[j] * y[j];
            float o[8];
#pragma unroll
            for (int j = 0; j < 8; ++j) o[j] = ab[j] * (k0[j] * u0[j] + k1[j] * u1[j] + k2[j] * u2[j]);
            *(v4u*)(YC + (rbase + t) * DM + cc * 8) = pack8(o);
            if (t >= SEQ - 2) { float* st = a.out + O_CAP + (((size_t)l * NB + b) * 2 + (t - (SEQ - 2))) * 512 + cc * 8; *(f32x4*)st = (f32x4){u2[0], u2[1], u2[2], u2[3]}; *(f32x4*)(st + 4) = (f32x4){u2[4], u2[5], u2[6], u2[7]}; } }
        __builtin_amdgcn_sched_barrier(0); } }
    __syncthreads();
    const int c = C.tid;
    if (t0 == SEQ - 32) { float* st = a.out + O_CDP + ((size_t)l * NB + b) * 30 * 512 + c;
        for (int j = 0; j < 30; ++j) st[(size_t)j * 512] = UD[(32 + j) * 512 + c]; }
    float cv[32];
    { const char* cwb = (const char*)(a.in(I_CDW) + (size_t)l * 31 * 512); const unsigned cof = (unsigned)c * 4u; const float bias = a.in(I_CDB)[l * 512 + c];
      float wt[31];
#pragma unroll
      for (int j = 0; j < 31; ++j) wt[j] = *(const float*)(cwb + (cof + (unsigned)j * 2048u));
      __builtin_amdgcn_sched_barrier(0);
#pragma unroll
      for (int t = 0; t < 32; ++t) cv[t] = bias;
#pragma unroll
      for (int r = 0; r < 62; ++r) { const float ur = UD[r * 512 + c];
#pragma unroll
          for (int t = 0; t < 32; ++t) { const int j = r - t; if (j >= 0 && j < 31) cv[t] += wt[j] * ur; } } }
    __syncthreads();
#pragma unroll
    for (int t = 0; t < 32; ++t) UD[t * 512 + c] = cv[t];
    __syncthreads();
    { const float* lg = a.in(I_LNDG) + l * 512 + C.lane * 8; const float* lb = a.in(I_LNDB) + l * 512 + C.lane * 8;
      const f32x4 g0 = *(const f32x4*)lg, g1 = *(const f32x4*)(lg + 4), b0 = *(const f32x4*)lb, b1 = *(const f32x4*)(lb + 4);
#pragma unroll
      for (int q = 0; q < 4; ++q) { const int t = C.wave * 4 + q; const f32x4 x0 = *(LAS f32x4*)(UD + t * 512 + C.lane * 8), x1 = *(LAS f32x4*)(UD + t * 512 + C.lane * 8 + 4);
        const float mu = wave_sum((x0.x + x0.y) + (x0.z + x0.w) + (x1.x + x1.y) + (x1.z + x1.w)) * (1.0f / 512.0f);
        const f32x4 d0 = x0 - mu, d1 = x1 - mu;
        const float var = wave_sum((d0.x * d0.x + d0.y * d0.y) + (d0.z * d0.z + d0.w * d0.w) + (d1.x * d1.x + d1.y * d1.y) + (d1.z * d1.z + d1.w * d1.w)) * (1.0f / 512.0f);
        const float rstd = 1.0f / sqrtf(var + 1e-6f);
        const f32x4 y0 = d0 * rstd * g0 + b0, y1 = d1 * rstd * g1 + b1; float o[8];
        o[0] = y0.x * sigm(y0.x); o[1] = y0.y * sigm(y0.y); o[2] = y0.z * sigm(y0.z); o[3] = y0.w * sigm(y0.w);
        o[4] = y1.x * sigm(y1.x); o[5] = y1.y * sigm(y1.y); o[6] = y1.z * sigm(y1.z); o[7] = y1.w * sigm(y1.w);
        *(v4u*)(YC + (rbase + t0 + t) * DM + 1536 + C.lane * 8) = pack8(o); } }
    __syncthreads();
}
__device__ __forceinline__ void ad_sample_item(const Ctx& C, const Ax& a, int l, int n) {
    const bf16* P = (const bf16*)(a.ws + WS_P); bf16* YC = (bf16*)(a.ws + WS_YC);
    const int c = C.tid; const bf16* pr = P + (size_t)(MP + n) * PIN;
    LAS float* red = (LAS float*)C.lds;
    { const float* st = a.in(I_SCA) + (((size_t)l * NS + n) * 2) * 512 + c; const float s0 = st[0], s1 = st[512];
      const float ua = bf1(pr[512 + c]) * bf1(pr[1024 + c]); const float* cw = a.in(I_CAW) + (size_t)l * 3 * 512 + c;
      const float y = bf1(pr[c]) * (cw[0] * s0 + cw[512] * s1 + cw[1024] * ua);
      YC[(size_t)(MP + n) * DM + c] = (bf16)(pk2(y, 0.f) & 0xffffu);
      float* o = a.out + O_CAS + (((size_t)l * NS + n) * 2) * 512 + c; o[0] = s1; o[512] = ua; }
    const float* st = a.in(I_SCD) + (((size_t)l * NS + n) * 30) * 512 + c; const float* cw = a.in(I_CDW) + (size_t)l * 31 * 512 + c;
    const float ud = bf1(pr[PD_ + c]) * sigm(bf1(pr[PD_ + 512 + c]));
    float cv = a.in(I_CDB)[l * 512 + c] + cw[30 * 512] * ud;
    float* os = a.out + O_CDS + (((size_t)l * NS + n) * 30) * 512 + c;
#pragma unroll 6
    for (int j = 0; j < 30; ++j) { const float s = st[(size_t)j * 512]; cv += cw[(size_t)j * 512] * s; if (j > 0) os[(size_t)(j - 1) * 512] = s; }
    os[29 * 512] = ud;
    float s = wave_sum(cv); if (C.lane == 0) red[C.wave] = s; __syncthreads();
    float mu = 0.f;
#pragma unroll
    for (int w = 0; w < 8; ++w) mu += red[w];
    mu *= (1.0f / 512.0f); const float d = cv - mu;
    s = wave_sum(d * d); if (C.lane == 0) red[8 + C.wave] = s; __syncthreads();
    float var = 0.f;
#pragma unroll
    for (int w = 0; w < 8; ++w) var += red[8 + w];
    const float rstd = 1.0f / sqrtf(var * (1.0f / 512.0f) + 1e-6f);
    const float y = d * rstd * a.in(I_LNDG)[l * 512 + c] + a.in(I_LNDB)[l * 512 + c];
    YC[(size_t)(MP + n) * DM + 1536 + c] = (bf16)(pk2(y * sigm(y), 0.f) & 0xffffu);
    __syncthreads();
}

__device__ __forceinline__ void shift8(const bf16* cur, const bf16* prevb, const float* prevf, const float* mu, float (&xs)[8]) {
    float pc[8], pv[8]; unpack8(*(const v4u*)cur, pc);
    if (prevb) unpack8(*(const v4u*)prevb, pv);
    else if (prevf) { const f32x4 p0 = *(const f32x4*)prevf, p1 = *(const f32x4*)(prevf + 4); pv[0] = p0.x; pv[1] = p0.y; pv[2] = p0.z; pv[3] = p0.w; pv[4] = p1.x; pv[5] = p1.y; pv[6] = p1.z; pv[7] = p1.w; }
    else {
#pragma unroll
        for (int j = 0; j < 8; ++j) pv[j] = 0.f; }
    const f32x4 m0 = *(const f32x4*)mu, m1 = *(const f32x4*)(mu + 4); const float m[8] = {m0.x, m0.y, m0.z, m0.w, m1.x, m1.y, m1.z, m1.w};
#pragma unroll
    for (int j = 0; j < 8; ++j) xs[j] = pc[j] + (pv[j] - pc[j]) * m[j];
}
__device__ __forceinline__ void shift4(const bf16* cur, const bf16* prevb, const float* prevf, const float* mu, float (&xs)[4]) {
    float pc[4], pv[4]; unpack4(*(const v2u*)cur, pc);
    if (prevb) unpack4(*(const v2u*)prevb, pv);
    else if (prevf) { const f32x4 p0 = *(const f32x4*)prevf; pv[0] = p0.x; pv[1] = p0.y; pv[2] = p0.z; pv[3] = p0.w; }
    else { pv[0] = pv[1] = pv[2] = pv[3] = 0.f; }
    const f32x4 m0 = *(const f32x4*)mu;
    xs[0] = pc[0] + (pv[0] - pc[0]) * m0.x; xs[1] = pc[1] + (pv[1] - pc[1]) * m0.y; xs[2] = pc[2] + (pv[2] - pc[2]) * m0.z; xs[3] = pc[3] + (pv[3] - pc[3]) * m0.w;
}
constexpr int PTS = 1544;
__device__ __forceinline__ void shift4_lds(const LAS bf16* cur, const float* mu, float (&xs)[4]) {
    float pc[4], pv[4]; unpack4(*(const LAS v2u*)cur, pc); unpack4(*(const LAS v2u*)(cur - PTS), pv);
    const f32x4 m0 = *(const f32x4*)mu;
    xs[0] = pc[0] + (pv[0] - pc[0]) * m0.x; xs[1] = pc[1] + (pv[1] - pc[1]) * m0.y; xs[2] = pc[2] + (pv[2] - pc[2]) * m0.z; xs[3] = pc[3] + (pv[3] - pc[3]) * m0.w;
}
constexpr int RWB = 896, RW_KK = 256, RW_KB = 384, RW_K = 512, RW_R = 640, RW_V = 768;
__device__ __forceinline__ void rw_st4(unsigned char* rec, int off, int cl, const f32x4 v) { v2u w; w.x = pk2(v[0], v[1]); w.y = pk2(v[2], v[3]); *(v2u*)(rec + off + cl * 2) = w; }
__device__ __forceinline__ f32x4 rw_ld4(const unsigned char* rec, int off, int cl) { float f[4]; unpack4(*(const v2u*)(rec + off + cl * 2), f); return (f32x4){f[0], f[1], f[2], f[3]}; }
#ifndef DUP_SUB
#define DUP_SUB 0u
#endif
#define PREP_REP(k) for (int prep_rep_ = 0; prep_rep_ < 1 + (int)((DUP_SUB >> (k)) & 1u); ++prep_rep_)
__device__ __forceinline__ void rwkv_prep_item(const Ctx& C, const Ax& a, int l, int item, int t2sel = -1) {
    const bf16* P = (const bf16*)(a.ws + WS_P); float* RW = (float*)(a.ws + WS_RW); float* GATE = (float*)(a.ws + WS_GATE);
    const bool smp = item >= 256; const int row0 = smp ? MP + (item - 256) * 32 : (item >> 6) * SEQ + (item & 63) * 32; const int t0 = smp ? 0 : (item & 63) * 32;
    const float* mu = a.in(I_MU) + (size_t)l * SHW; const float* sst = a.in(I_SSH) + (size_t)l * NS * SHW;
    LAS bf16* AW = (LAS bf16*)C.lds; LAS bf16* AA = AW + 32 * 72; LAS bf16* AG = AA + 32 * 72; LAS bf16* PT = AG + 32 * 136;
    for (int it = C.tid; it < 32 * 32; it += NWAVES * 64) { const int r = it >> 5, cc = it & 31, col = 1536 + cc * 8, row = row0 + r; const bf16* cur = P + (size_t)row * PIN + PC_ + col;
        float xs[8];
        if (smp) shift8(cur, nullptr, sst + (size_t)(row - MP) * SHW + col, mu + col, xs);
        else shift8(cur, (t0 + r > 0) ? cur - PIN : nullptr, nullptr, mu + col, xs);
        if (cc < 8) {
#pragma unroll
            for (int j = 0; j < 8; ++j) xs[j] = tanhf(xs[j]);
            *(LAS v4u*)(AW + r * 72 + cc * 8) = pack8(xs); }
        else if (cc < 16) *(LAS v4u*)(AA + r * 72 + (cc - 8) * 8) = pack8(xs);
        else {
#pragma unroll
            for (int j = 0; j < 8; ++j) xs[j] = sigm(xs[j]);
            *(LAS v4u*)(AG + r * 136 + (cc - 16) * 8) = pack8(xs); } }
    if (!smp) { for (int it = C.tid; it < 33 * 192; it += NWAVES * 64) { const int r = it / 192, cc = it - r * 192; v4u v = (v4u){0u, 0u, 0u, 0u};
            if (t0 + r > 0) v = *(const v4u*)(P + (size_t)(row0 + r - 1) * PIN + PC_ + cc * 8);
            *(LAS v4u*)(PT + r * PTS + cc * 8) = v; } }
    if (smp) { float* o = a.out + O_SHS + ((size_t)l * NS + (row0 - MP)) * SHW;
        for (int it = C.tid + (t2sel > 0 ? 16 * 224 : 0); it < (t2sel == 0 ? 16 : 32) * 224; it += NWAVES * 64) { const int r = it / 224, cc = it % 224; float f[8]; unpack8(*(const v4u*)(P + (size_t)(row0 + r) * PIN + PC_ + cc * 8), f);
            float* op = o + (size_t)r * SHW + cc * 8; *(f32x4*)op = (f32x4){f[0], f[1], f[2], f[3]}; *(f32x4*)(op + 4) = (f32x4){f[4], f[5], f[6], f[7]}; } }
    else if (t0 == SEQ - 32) { float* o = a.out + O_SHP + ((size_t)l * NB + (item >> 6)) * SHW;
        for (int cc = C.tid; cc < 224; cc += NWAVES * 64) { float f[8]; unpack8(*(const v4u*)(P + (size_t)(row0 + 31) * PIN + PC_ + cc * 8), f);
            *(f32x4*)(o + cc * 8) = (f32x4){f[0], f[1], f[2], f[3]}; *(f32x4*)(o + cc * 8 + 4) = (f32x4){f[4], f[5], f[6], f[7]}; } }
    __syncthreads();
    const int h = C.wave, fr = C.lane & 15, fq = C.lane >> 4;
    const unsigned char* wl = a.ws + WS_WL + (size_t)l * LW_STRIDE;
    const bf16* W2t = (const bf16*)(wl + LW_W2); const bf16* A2t = (const bf16*)(wl + LW_A2); const bf16* G2t = (const bf16*)(wl + LW_G2);
    PREP_REP(23) { constexpr int tp = 0;
        f32x4 acc[4][2];
#pragma unroll
        for (int ct = 0; ct < 4; ++ct)
#pragma unroll
            for (int t2 = 0; t2 < 2; ++t2) acc[ct][t2] = zero4();
#pragma unroll
        for (int ks = 0; ks < 2; ++ks) { bf16x8 af[2], wf[4];
#pragma unroll
            for (int t2 = 0; t2 < 2; ++t2) af[t2] = *(const LAS bf16x8*)(AA + (tp * 32 + t2 * 16 + fr) * 72 + ks * 32 + fq * 8);
#pragma unroll
            for (int ct = 0; ct < 4; ++ct) wf[ct] = *(const bf16x8*)(A2t + (size_t)(h * 64 + ct * 16 + fr) * 64 + ks * 32 + fq * 8);
#pragma unroll
            for (int ct = 0; ct < 4; ++ct)
#pragma unroll
                for (int t2 = 0; t2 < 2; ++t2) acc[ct][t2] = __builtin_amdgcn_mfma_f32_16x16x32_bf16(wf[ct], af[t2], acc[ct][t2], 0, 0, 0); }
        const float* a0 = a.in(I_A0) + l * 512; const float* kkw = a.in(I_KK) + l * 512; const float* kaw = a.in(I_KA) + l * 512;
#pragma unroll
        for (int t2 = 0; t2 < 2; ++t2) { if (t2sel >= 0 && t2 != t2sel) continue; const int r = tp * 32 + t2 * 16 + fr, row = row0 + r; const bf16* prow = P + (size_t)row * PIN + PC_;
            const float* pf = smp ? sst + (size_t)(row - MP) * SHW : nullptr;
            float kkr[4][4], av[4][4], kc[4][4]; float ss = 0.f;
#pragma unroll
            for (int ct = 0; ct < 4; ++ct) { const int ch = h * 64 + ct * 16 + fq * 4; const f32x4 a0v = *(const f32x4*)(a0 + ch), kkv = *(const f32x4*)(kkw + ch);
                float xs[4]; if (smp) shift4(prow + 512 + ch, nullptr, pf + 512 + ch, mu + 512 + ch, xs); else shift4_lds(PT + (r + 1) * PTS + 512 + ch, mu + 512 + ch, xs);
#pragma unroll
                for (int j = 0; j < 4; ++j) { av[ct][j] = sigm(a0v[j] + acc[ct][t2][j]); kc[ct][j] = xs[j]; kkr[ct][j] = xs[j] * kkv[j]; ss += kkr[ct][j] * kkr[ct][j]; } }
            ss += __shfl_xor(ss, 16); ss += __shfl_xor(ss, 32);
            const float inv = 1.0f / fmaxf(sqrtf(ss), 1e-12f);
            unsigned char* rw = (unsigned char*)RW + ((size_t)row * 8 + h) * RWB;
#pragma unroll
            for (int ct = 0; ct < 4; ++ct) { const int ch = h * 64 + ct * 16 + fq * 4, cl = ct * 16 + fq * 4; const f32x4 kav = *(const f32x4*)(kaw + ch);
                f32x4 kk, kb, k4;
#pragma unroll
                for (int j = 0; j < 4; ++j) { kk[j] = kkr[ct][j] * inv; kb[j] = kk[j] * av[ct][j]; k4[j] = kc[ct][j] * (1.0f + (av[ct][j] - 1.0f) * kav[j]); }
                rw_st4(rw, RW_KK, cl, kk); rw_st4(rw, RW_KB, cl, kb); rw_st4(rw, RW_K, cl, k4);
                float xr[4], xv[4];
                if (smp) { shift4(prow + ch, nullptr, pf + ch, mu + ch, xr); shift4(prow + 1024 + ch, nullptr, pf + 1024 + ch, mu + 1024 + ch, xv); }
                else { shift4_lds(PT + (r + 1) * PTS + ch, mu + ch, xr); shift4_lds(PT + (r + 1) * PTS + 1024 + ch, mu + 1024 + ch, xv); }
                rw_st4(rw, RW_R, cl, (f32x4){xr[0], xr[1], xr[2], xr[3]}); rw_st4(rw, RW_V, cl, (f32x4){xv[0], xv[1], xv[2], xv[3]}); } }
    }
    PREP_REP(24) { constexpr int tp = 0;
        f32x4 acc[4][2];
#pragma unroll
        for (int ct = 0; ct < 4; ++ct)
#pragma unroll
            for (int t2 = 0; t2 < 2; ++t2) acc[ct][t2] = zero4();
#pragma unroll
        for (int ks = 0; ks < 2; ++ks) { bf16x8 af[2], wf[4];
#pragma unroll
            for (int t2 = 0; t2 < 2; ++t2) af[t2] = *(const LAS bf16x8*)(AW + (tp * 32 + t2 * 16 + fr) * 72 + ks * 32 + fq * 8);
#pragma unroll
            for (int ct = 0; ct < 4; ++ct) wf[ct] = *(const bf16x8*)(W2t + (size_t)(h * 64 + ct * 16 + fr) * 64 + ks * 32 + fq * 8);
#pragma unroll
            for (int ct = 0; ct < 4; ++ct)
#pragma unroll
                for (int t2 = 0; t2 < 2; ++t2) acc[ct][t2] = __builtin_amdgcn_mfma_f32_16x16x32_bf16(wf[ct], af[t2], acc[ct][t2], 0, 0, 0); }
        const float* w0 = a.in(I_W0) + l * 512;
#pragma unroll
        for (int t2 = 0; t2 < 2; ++t2) { if (t2sel >= 0 && t2 != t2sel) continue; const int row = row0 + tp * 32 + t2 * 16 + fr; float* rw = (float*)((unsigned char*)RW + ((size_t)row * 8 + h) * RWB);
#pragma unroll
            for (int ct = 0; ct < 4; ++ct) { const int ch = h * 64 + ct * 16 + fq * 4, cl = ct * 16 + fq * 4; const f32x4 w0v = *(const f32x4*)(w0 + ch); f32x4 d;
#pragma unroll
                for (int j = 0; j < 4; ++j) { const float z = -(w0v[j] + acc[ct][t2][j]); const float sp = fmaxf(z, 0.f) + __logf(1.0f + __expf(-fabsf(z))); const float w = -sp - 0.5f; d[j] = -__expf(w); }
                *(f32x4*)(rw + cl) = d; } }
    }
    PREP_REP(25) { constexpr int tp = 0;
        f32x4 acc[4][2];
#pragma unroll
        for (int ct = 0; ct < 4; ++ct)
#pragma unroll
            for (int t2 = 0; t2 < 2; ++t2) acc[ct][t2] = zero4();
#pragma unroll
        for (int ks = 0; ks < 4; ++ks) { bf16x8 af[2], wf[4];
#pragma unroll
            for (int t2 = 0; t2 < 2; ++t2) af[t2] = *(const LAS bf16x8*)(AG + (tp * 32 + t2 * 16 + fr) * 136 + ks * 32 + fq * 8);
#pragma unroll
            for (int ct = 0; ct < 4; ++ct) wf[ct] = *(const bf16x8*)(G2t + (size_t)(h * 64 + ct * 16 + fr) * 128 + ks * 32 + fq * 8);
#pragma unroll
            for (int ct = 0; ct < 4; ++ct)
#pragma unroll
                for (int t2 = 0; t2 < 2; ++t2) acc[ct][t2] = __builtin_amdgcn_mfma_f32_16x16x32_bf16(wf[ct], af[t2], acc[ct][t2], 0, 0, 0); }
#pragma unroll
        for (int t2 = 0; t2 < 2; ++t2) { if (t2sel >= 0 && t2 != t2sel) continue; const int row = row0 + tp * 32 + t2 * 16 + fr;
#pragma unroll
            for (int ct = 0; ct < 4; ++ct) *(f32x4*)(GATE + (size_t)row * 512 + h * 64 + ct * 16 + fq * 4) = acc[ct][t2]; }
    }
    __syncthreads();
}

#define PACK8(arr, o) ((v4u){pk2((arr)[(o)], (arr)[(o) + 1]), pk2((arr)[(o) + 2], (arr)[(o) + 3]), pk2((arr)[(o) + 4], (arr)[(o) + 5]), pk2((arr)[(o) + 6], (arr)[(o) + 7])})
constexpr int WK_LDS = 18432, WK_SHR = 6912, WK_PRV = 3072;
__device__ __forceinline__ f32x4 mfma16(bf16x4 a, bf16x4 b, f32x4 c) { return __builtin_amdgcn_mfma_f32_16x16x16bf16_1k(a, b, c, 0, 0, 0); }
__device__ __forceinline__ bf16 bfr1(float x) { return (bf16)(pk2(x, 0.f) & 0xffffu); }
__device__ __forceinline__ void wkv_chunk_witem(const Ctx& C, const Ax& a, int ci) {
    const float* RW = (const float*)(a.ws + WS_RW);
    unsigned char* CK = a.ws + WS_CK + (size_t)ci * WK_SHR; unsigned char* CP = a.ws + WS_CP + (size_t)ci * 4 * WK_PRV;
    const int bh = ci >> 7, c = ci & 127, b = bh >> 3, h = bh & 7, lane = C.lane, fr = lane & 15, fq = lane >> 4;
    LAS unsigned char* Lb = C.lds + C.wave * WK_LDS;
    LAS bf16* TA = (LAS bf16*)Lb; LAS bf16* TB = TA + 16 * 72; LAS bf16* TK = TB + 16 * 72; LAS bf16* TR = TK + 16 * 72; LAS bf16* VT = TR + 16 * 72;
    LAS float* M1 = (LAS float*)(Lb + 12288); LAS float* M2 = M1 + 320; LAS float* N1 = M2 + 320; LAS float* N2 = N1 + 320;
    LAS bf16* TG = TA; LAS bf16* PST = TK;
    const unsigned char* rw = (const unsigned char*)RW + (((size_t)b * SEQ + c * 16) * 8 + h) * RWB;
#define RWF(t) (*(const float*)(rw + (size_t)(t) * (8 * RWB) + lane * 4))
#define RWH(t, off) bf1(*(const bf16*)(rw + (size_t)(t) * (8 * RWB) + (off) + lane * 2))
    float lam[16];
#pragma unroll
    for (int t = 0; t < 16; ++t) lam[t] = RWF(t);
    __builtin_amdgcn_sched_barrier(0);
#pragma unroll
    for (int t = 1; t < 16; ++t) lam[t] += lam[t - 1];
    const float lamT = lam[15];
    ((float*)CK)[lane] = __expf(lamT);
    float Bp[16], Kp[16], al[16], ro[16];
    bf16* ATg = (bf16*)(CK + 256); bf16* OMg = (bf16*)(CK + 256 + 2304);
#define RWR(t, off) (*(const bf16*)(rw + (size_t)(t) * (8 * RWB) + (off) + lane * 2))
    bf16 wkk[4], wbb[4], wkx[4], wrr[4], wvv[4];
#pragma unroll
    for (int t = 0; t < 4; ++t) { wkk[t] = RWR(t, RW_KK); wbb[t] = RWR(t, RW_KB); wkx[t] = RWR(t, RW_K); wrr[t] = RWR(t, RW_R); wvv[t] = RWR(t, RW_V); }
    __builtin_amdgcn_sched_barrier(0);
#pragma unroll
    for (int t = 0; t < 16; ++t) { const float kk = bf1(wkk[t & 3]), bb = bf1(wbb[t & 3]), kx = bf1(wkx[t & 3]), rr = bf1(wrr[t & 3]), vv = bf1(wvv[t & 3]);
        if (t + 4 < 16) { wkk[t & 3] = RWR(t + 4, RW_KK); wbb[t & 3] = RWR(t + 4, RW_KB); wkx[t & 3] = RWR(t + 4, RW_K); wrr[t & 3] = RWR(t + 4, RW_R); wvv[t & 3] = RWR(t + 4, RW_V); }
        const float ein = __expf(-lam[t]), eprev = (t ? __expf(lam[t - 1]) : 1.0f), ecur = __expf(lam[t]), erest = __expf(lamT - lam[t]);
        al[t] = kk * eprev; ro[t] = rr * ecur; Bp[t] = bb * erest; Kp[t] = kx * erest;
        const bf16 ab = bfr1(al[t]);
        TA[t * 72 + lane] = ab; TB[t * 72 + lane] = bfr1(bb * ein); TK[t * 72 + lane] = bfr1(kx * ein); TR[t * 72 + lane] = bfr1(ro[t]); VT[lane * 24 + t] = bfr1(vv);
        ATg[t * 72 + lane] = ab;
        asm volatile("" ::: "memory"); __builtin_amdgcn_sched_barrier(0); }
    LDS_WAIT(); asm volatile("" ::: "memory");
    { f32x4 g1 = zero4(), g2 = zero4(), n1 = zero4(), n2 = zero4();
#pragma unroll
      for (int ks = 0; ks < 2; ++ks) { const int o = fr * 72 + ks * 32 + fq * 8;
        const bf16x8 bf_ = *(const LAS bf16x8*)(TB + o), kf_ = *(const LAS bf16x8*)(TK + o), af_ = *(const LAS bf16x8*)(TA + o), rf_ = *(const LAS bf16x8*)(TR + o);
        g1 = __builtin_amdgcn_mfma_f32_16x16x32_bf16(bf_, af_, g1, 0, 0, 0); g2 = __builtin_amdgcn_mfma_f32_16x16x32_bf16(kf_, af_, g2, 0, 0, 0);
        n1 = __builtin_amdgcn_mfma_f32_16x16x32_bf16(bf_, rf_, n1, 0, 0, 0); n2 = __builtin_amdgcn_mfma_f32_16x16x32_bf16(kf_, rf_, n2, 0, 0, 0); }
#pragma unroll
      for (int r = 0; r < 4; ++r) { const int s_ = 4 * fq + r, o = s_ * 20 + fr;
        M1[o] = (s_ < fr) ? g1[r] : 0.f; M2[o] = (s_ < fr) ? g2[r] : 0.f; N1[o] = (s_ <= fr) ? n1[r] : 0.f; N2[o] = (s_ <= fr) ? n2[r] : 0.f; } }
    LDS_WAIT(); asm volatile("" ::: "memory");
    __builtin_amdgcn_sched_barrier(0);
#pragma unroll
    for (int s_ = 14; s_ >= 0; --s_) { float m[16];
#pragma unroll
        for (int q = 0; q < 4; ++q) { const f32x4 v = *(const LAS f32x4*)(M1 + s_ * 20 + 4 * q); m[4 * q] = v.x; m[4 * q + 1] = v.y; m[4 * q + 2] = v.z; m[4 * q + 3] = v.w; }
        float acc = Bp[s_];
#pragma unroll
        for (int t = s_ + 1; t < 16; ++t) acc -= m[t] * Bp[t];
        asm volatile("" : "+v"(acc) :: "memory"); Bp[s_] = acc; __builtin_amdgcn_sched_barrier(0); }
#pragma unroll
    for (int s_ = 0; s_ < 15; ++s_) { float m[16];
#pragma unroll
        for (int q = 0; q < 4; ++q) { const f32x4 v = *(const LAS f32x4*)(M2 + s_ * 20 + 4 * q); m[4 * q] = v.x; m[4 * q + 1] = v.y; m[4 * q + 2] = v.z; m[4 * q + 3] = v.w; }
        float acc = Kp[s_];
#pragma unroll
        for (int t = s_ + 1; t < 16; ++t) acc -= m[t] * Bp[t];
        asm volatile("" : "+v"(acc) :: "memory"); Kp[s_] = acc; __builtin_amdgcn_sched_barrier(0); }
    __builtin_amdgcn_sched_barrier(0);
    { float ng[16];
#pragma unroll
      for (int t = 0; t < 16; ++t) ng[t] = -Bp[t];
      *(v4u*)(CK + 256 + 4608 + lane * 32) = PACK8(ng, 0); *(v4u*)(CK + 256 + 4608 + lane * 32 + 16) = PACK8(ng, 8); }
    *(LAS v4u*)(TG + lane * 24) = PACK8(Kp, 0); *(LAS v4u*)(TG + lane * 24 + 8) = PACK8(Kp, 8);
    __builtin_amdgcn_sched_barrier(0);
    { float hh[16], ps[16];
#pragma unroll
      for (int s_ = 0; s_ < 16; ++s_) { hh[s_] = N1[s_ * 20 + fr]; ps[s_] = N2[s_ * 20 + fr]; }
#pragma unroll
      for (int s_ = 14; s_ >= 0; --s_) { float m[16];
#pragma unroll
        for (int q = 0; q < 4; ++q) { const f32x4 v = *(const LAS f32x4*)(M1 + s_ * 20 + 4 * q); m[4 * q] = v.x; m[4 * q + 1] = v.y; m[4 * q + 2] = v.z; m[4 * q + 3] = v.w; }
        float acc = hh[s_];
#pragma unroll
        for (int u = s_ + 1; u < 16; ++u) acc -= m[u] * hh[u];
        asm volatile("" : "+v"(acc) :: "memory"); hh[s_] = acc; __builtin_amdgcn_sched_barrier(0); }
#pragma unroll
      for (int s_ = 0; s_ < 15; ++s_) { float m[16];
#pragma unroll
        for (int q = 0; q < 4; ++q) { const f32x4 v = *(const LAS f32x4*)(M2 + s_ * 20 + 4 * q); m[4 * q] = v.x; m[4 * q + 1] = v.y; m[4 * q + 2] = v.z; m[4 * q + 3] = v.w; }
        float acc = ps[s_];
#pragma unroll
        for (int u = s_ + 1; u < 16; ++u) acc -= m[u] * hh[u];
        asm volatile("" : "+v"(acc) :: "memory"); ps[s_] = acc; __builtin_amdgcn_sched_barrier(0); }
      LDS_WAIT(); asm volatile("" ::: "memory");
#pragma unroll
      for (int s_ = 0; s_ < 16; ++s_) N1[s_ * 20 + fr] = hh[s_];
      *(LAS v4u*)(PST + fr * 24) = PACK8(ps, 0); *(LAS v4u*)(PST + fr * 24 + 8) = PACK8(ps, 8); }
    LDS_WAIT(); asm volatile("" ::: "memory");
    __builtin_amdgcn_sched_barrier(0);
#pragma unroll
    for (int s_ = 0; s_ < 16; ++s_) { float m[16];
#pragma unroll
        for (int q = 0; q < 4; ++q) { const f32x4 v = *(const LAS f32x4*)(N1 + s_ * 20 + 4 * q); m[4 * q] = v.x; m[4 * q + 1] = v.y; m[4 * q + 2] = v.z; m[4 * q + 3] = v.w; }
#pragma unroll
        for (int t = s_; t < 16; ++t) ro[t] -= m[t] * al[s_];
        asm volatile("" ::: "memory"); __builtin_amdgcn_sched_barrier(0); }
#pragma unroll
    for (int t = 0; t < 16; ++t) OMg[t * 72 + lane] = bfr1(ro[t]);
    LDS_WAIT(); asm volatile("" ::: "memory");
    __builtin_amdgcn_sched_barrier(0);
    { bf16x4 vf[4];
#pragma unroll
      for (int it = 0; it < 4; ++it) vf[it] = *(const LAS bf16x4*)(VT + (it * 16 + fr) * 24 + fq * 4);
#pragma unroll
      for (int kt = 0; kt < 4; ++kt) { const bf16x4 gf = *(const LAS bf16x4*)(TG + (kt * 16 + fr) * 24 + fq * 4);
#pragma unroll
        for (int it = 0; it < 4; ++it) { const f32x4 d = mfma16(gf, vf[it], zero4()); v2u dw; dw.x = pk2(d[0], d[1]); dw.y = pk2(d[2], d[3]); *(v2u*)(CP + it * WK_PRV + kt * 512 + lane * 8) = dw; } }
      const bf16x4 pf = *(const LAS bf16x4*)(PST + fr * 24 + fq * 4);
#pragma unroll
      for (int it = 0; it < 4; ++it) { const f32x4 o = mfma16(pf, vf[it], zero4()); *(f32x4*)(CP + it * WK_PRV + 2048 + lane * 16) = o; } }
    LDS_WAIT(); asm volatile("" ::: "memory");
}
constexpr int WQ_CH = WK_PRV + WK_SHR, WQ_SLOT = 4 * WQ_CH, WQ_PCS = WQ_CH / 16, WQ_NWL = 4 * WQ_PCS / 64;
__device__ __forceinline__ void wkv_seq_chunk(const LAS unsigned char* sp, f32x4 (&acc)[4], float* orow, int lane, int fr, int fq) {
    const LAS unsigned char* sh = sp + WK_PRV;
    bf16x8 af[2], of[2]; bf16x4 gf[4]; f32x4 wt[4], dt[4];
#pragma unroll
    for (int s = 0; s < 2; ++s) { const LAS bf16* ap = (const LAS bf16*)(sh + 256) + fr * 72 + 32 * s + 4 * fq; const v2u lo = *(const LAS v2u*)ap, hi = *(const LAS v2u*)(ap + 16);
        af[s] = __builtin_bit_cast(bf16x8, (v4u){lo.x, lo.y, hi.x, hi.y});
        const LAS bf16* op = (const LAS bf16*)(sh + 256 + 2304) + fr * 72 + 32 * s + 4 * fq; const v2u lo2 = *(const LAS v2u*)op, hi2 = *(const LAS v2u*)(op + 16);
        of[s] = __builtin_bit_cast(bf16x8, (v4u){lo2.x, lo2.y, hi2.x, hi2.y}); }
#pragma unroll
    for (int kt = 0; kt < 4; ++kt) { gf[kt] = *(const LAS bf16x4*)((const LAS bf16*)(sh + 256 + 4608) + (kt * 16 + fr) * 16 + 4 * fq);
        wt[kt] = *(const LAS f32x4*)(sh + (16 * kt + 4 * fq) * 4); { float f_[4]; unpack4(*(const LAS v2u*)(sp + kt * 512 + lane * 8), f_); dt[kt] = (f32x4){f_[0], f_[1], f_[2], f_[3]}; } }
    const f32x4 ov = *(const LAS f32x4*)(sp + 2048 + lane * 16);
    bf16x8 sbf[2];
#pragma unroll
    for (int s = 0; s < 2; ++s) { v4u w; w.x = pk2(acc[2 * s][0], acc[2 * s][1]); w.y = pk2(acc[2 * s][2], acc[2 * s][3]); w.z = pk2(acc[2 * s + 1][0], acc[2 * s + 1][1]); w.w = pk2(acc[2 * s + 1][2], acc[2 * s + 1][3]);
        sbf[s] = __builtin_bit_cast(bf16x8, w); }
    f32x4 x = zero4();
    x = __builtin_amdgcn_mfma_f32_16x16x32_bf16(af[0], sbf[0], x, 0, 0, 0); x = __builtin_amdgcn_mfma_f32_16x16x32_bf16(af[1], sbf[1], x, 0, 0, 0);
    f32x4 o = __builtin_amdgcn_mfma_f32_16x16x32_bf16(of[0], sbf[0], ov, 0, 0, 0); o = __builtin_amdgcn_mfma_f32_16x16x32_bf16(of[1], sbf[1], o, 0, 0, 0);
    v2u xw; xw.x = pk2(x[0], x[1]); xw.y = pk2(x[2], x[3]); const bf16x4 xb = __builtin_bit_cast(bf16x4, xw);
#pragma unroll
    for (int kt = 0; kt < 4; ++kt) acc[kt] = mfma16(gf[kt], xb, acc[kt] * wt[kt] + dt[kt]);
    orow[0] = o[0]; orow[512] = o[1]; orow[1024] = o[2]; orow[1536] = o[3];
}
__device__ __forceinline__ void wkv_seq_item(const Ctx& C, const Ax& a, int l, int item) {
    const int bh = item >> 2, rg = item & 3, b = bh >> 3, h = bh & 7, lane = C.lane, fr = lane & 15, fq = lane >> 4;
    const unsigned char* CK = a.ws + WS_CK + (size_t)bh * 128 * WK_SHR; const unsigned char* CP = a.ws + WS_CP + ((size_t)bh * 128 * 4 + rg) * WK_PRV;
    float* OC = (float*)(a.ws + WS_OC) + ((size_t)b * SEQ) * 512 + h * 64 + rg * 16 + fr;
#define WQ_COMPUTE(blk) do { const LAS unsigned char* sbp = C.lds + ((blk) % 3) * WQ_SLOT; \
            _Pragma("unroll 2") for (int cq = 0; cq < 4; ++cq) wkv_seq_chunk(sbp + cq * WQ_CH, acc, OC + (size_t)(((blk) * 4 + cq) * 16 + 4 * fq) * 512, lane, fr, fq); } while (0)
    static_assert(4 * WQ_PCS == WQ_NWL * 64 && WQ_NWL > 35 && WQ_NWL <= 42 && 3 * WQ_SLOT <= SCR_BYTES, "ring geometry");
    if (C.wave == 0) {
        f32x4 acc[4];
#pragma unroll
        for (int kt = 0; kt < 4; ++kt) acc[kt] = zero4();
        __builtin_amdgcn_s_barrier(); asm volatile("" ::: "memory");
        for (int blk = 0; blk < 32; ++blk) { WQ_COMPUTE(blk); asm volatile("s_waitcnt lgkmcnt(0)" ::: "memory"); __builtin_amdgcn_s_barrier(); asm volatile("" ::: "memory"); }
        float* so = a.out + O_WKVP + ((((size_t)l * NB + b) * 8 + h) * 64 + rg * 16 + fr) * 64 + 4 * fq;
#pragma unroll
        for (int kt = 0; kt < 4; ++kt) *(f32x4*)(so + 16 * kt) = acc[kt];
    } else {
        const int w1 = C.wave - 1; const bool seven = (w1 + 35) < WQ_NWL;
        const unsigned char* wsb = a.ws; unsigned qoff[6], qstr[6];
#pragma unroll
        for (int i = 0; i < 6; ++i) { const int p = (w1 + 7 * i) * 64 + lane, cq = p / WQ_PCS, q = p - cq * WQ_PCS; const bool pr = q < WK_PRV / 16;
            qoff[i] = pr ? (unsigned)(WS_CP + ((size_t)bh * 128 * 4 + rg) * WK_PRV) + (unsigned)(cq * 4 * WK_PRV + q * 16) : (unsigned)(WS_CK + (size_t)bh * 128 * WK_SHR) + (unsigned)(cq * WK_SHR + (q - WK_PRV / 16) * 16);
            qstr[i] = pr ? (unsigned)(16 * WK_PRV) : (unsigned)(4 * WK_SHR); }
#define WQ_DMA(blk) do { _Pragma("unroll") for (int i = 0; i < 6; ++i) if (i < 5 || seven) \
            __builtin_amdgcn_global_load_lds((const unsigned*)(wsb + (qoff[i] + (unsigned)(blk) * qstr[i])), (LAS unsigned*)(C.lds + ((blk) % 3) * WQ_SLOT + (w1 + 7 * i) * 1024), 16, 0, 0); } while (0)
#define WQ_WAIT_OLDER() do { if (seven) asm volatile("s_waitcnt vmcnt(6)" ::: "memory"); else asm volatile("s_waitcnt vmcnt(5)" ::: "memory"); } while (0)
        WQ_DMA(0); WQ_DMA(1); WQ_WAIT_OLDER();
        __builtin_amdgcn_s_barrier(); asm volatile("" ::: "memory");
        for (int blk = 0; blk < 32; ++blk) {
            if (blk + 2 < 32) { WQ_DMA(blk + 2); WQ_WAIT_OLDER(); }
            else asm volatile("s_waitcnt vmcnt(0)" ::: "memory");
            __builtin_amdgcn_s_barrier(); asm volatile("" ::: "memory");
        }
#undef WQ_DMA
#undef WQ_WAIT_OLDER
    }
#undef WQ_COMPUTE
    __syncthreads();
}
__device__ __forceinline__ void rwkv_sample_witem(const Ctx& C, const Ax& a, int l, int witem) {
    const float* RW = (const float*)(a.ws + WS_RW); float* OC = (float*)(a.ws + WS_OC);
    const int n = witem >> 4, h = (witem >> 1) & 7, half = witem & 1, g = C.lane & 15, rq = C.lane >> 4;
    const unsigned char* p = (const unsigned char*)RW + ((size_t)(MP + n) * 8 + h) * RWB;
    const f32x4 lw4 = *(const f32x4*)(p + 16 * g), kk4 = rw_ld4(p, RW_KK, 4 * g), b4 = rw_ld4(p, RW_KB, 4 * g), k4 = rw_ld4(p, RW_K, 4 * g), r4 = rw_ld4(p, RW_R, 4 * g);
    const f32x4 w4 = (f32x4){__expf(lw4.x), __expf(lw4.y), __expf(lw4.z), __expf(lw4.w)};
    const float* sin_ = a.in(I_SWKV) + (((size_t)l * NS + n) * 8 + h) * 4096; float* sout = a.out + O_WKVS + (((size_t)l * NS + n) * 8 + h) * 4096;
#pragma unroll 4
    for (int it = 0; it < 8; ++it) { const int i = half * 32 + it * 4 + rq; const f32x4 S = __builtin_nontemporal_load((const f32x4*)(sin_ + i * 64 + 4 * g)); const float vi = bf1(*(const bf16*)(p + RW_V + i * 2));
        const float sa = -rowsum16((S.x * kk4.x + S.y * kk4.y) + (S.z * kk4.z + S.w * kk4.w));
        f32x4 T; T.x = S.x * w4.x + (sa * b4.x + vi * k4.x); T.y = S.y * w4.y + (sa * b4.y + vi * k4.y); T.z = S.z * w4.z + (sa * b4.z + vi * k4.z); T.w = S.w * w4.w + (sa * b4.w + vi * k4.w);
        const float o = rowsum16((T.x * r4.x + T.y * r4.y) + (T.z * r4.z + T.w * r4.w));
        __builtin_nontemporal_store(T, (f32x4*)(sout + i * 64 + 4 * g));
        if (g == 0) OC[(size_t)(MP + n) * 512 + h * 64 + i] = o; }
}
__device__ __forceinline__ void rwkv_post_phase(const Ctx& C, const Ax& a, int l) {
    const float* RW = (const float*)(a.ws + WS_RW); const float* OC = (const float*)(a.ws + WS_OC); const float* GATE = (const float*)(a.ws + WS_GATE); bf16* YC = (bf16*)(a.ws + WS_YC);
    const int gw = C.bid * NWAVES + C.wave, NGW = C.G * NWAVES, g = C.lane & 15, rq = C.lane >> 4;
    const float* lg = a.in(I_LNXG) + l * 512; const float* lb = a.in(I_LNXB) + l * 512; const float* rk = a.in(I_RK) + l * 512;
    const int h = (gw * 4 + rq) & 7, ch = h * 64 + 4 * g;
    const f32x4 rkv = *(const f32x4*)(rk + ch), lgv = *(const f32x4*)(lg + ch), lbv = *(const f32x4*)(lb + ch);
    constexpr int NIT = MT * 8 / 4;
    for (int it0 = gw; it0 < NIT; it0 += 3 * NGW) {
        f32x4 po[3], pg[3]; v2u pk[3], pr[3], pv[3];
#pragma unroll
        for (int u = 0; u < 3; ++u) { const int it = it0 + u * NGW; if (it < NIT) { const int row = (it * 4 + rq) >> 3; const unsigned char* rw = (const unsigned char*)RW + ((size_t)row * 8 + h) * RWB + 8 * g;
            po[u] = *(const f32x4*)(OC + (size_t)row * 512 + ch); pg[u] = *(const f32x4*)(GATE + (size_t)row * 512 + ch);
            pk[u] = *(const v2u*)(rw + RW_K); pr[u] = *(const v2u*)(rw + RW_R); pv[u] = *(const v2u*)(rw + RW_V); } }
        __builtin_amdgcn_sched_barrier(0);
#pragma unroll
        for (int u = 0; u < 3; ++u) { const int it = it0 + u * NGW; if (it < NIT) { const int row = (it * 4 + rq) >> 3; const f32x4 o = po[u];
            const float mu = rowsum16((o.x + o.y) + (o.z + o.w)) * (1.0f / 64.0f); const f32x4 d = o - mu;
            const float var = rowsum16((d.x * d.x + d.y * d.y) + (d.z * d.z + d.w * d.w)) * (1.0f / 64.0f); const float rstd = 1.0f / sqrtf(var + 64e-5f);
            float kf[4], rf[4], vf[4]; unpack4(pk[u], kf); unpack4(pr[u], rf); unpack4(pv[u], vf);
            const float bs = rowsum16((rf[0] * kf[0] * rkv.x + rf[1] * kf[1] * rkv.y) + (rf[2] * kf[2] * rkv.z + rf[3] * kf[3] * rkv.w));
            const f32x4 v4 = (f32x4){vf[0], vf[1], vf[2], vf[3]};
            const f32x4 y = (d * rstd * lgv + lbv + bs * v4) * pg[u];
            v2u w; w.x = pk2(y.x, y.y); w.y = pk2(y.z, y.w); *(v2u*)(YC + (size_t)row * DM + 1024 + ch) = w; } }
        __builtin_amdgcn_sched_barrier(0);
    }
}

__device__ __forceinline__ float ret_lg(int h) { return log1pf(-exp2f(-5.0f - (float)h)); }
constexpr int RS = 136;
__device__ __forceinline__ void rot8(const bf16* src, const float* cs, int c8, float scale, float (&lo)[8], float (&hi)[8]) {
    float x1[8], x2[8]; unpack8(*(const v4u*)(src + c8 * 8), x1); unpack8(*(const v4u*)(src + 64 + c8 * 8), x2);
    const f32x4* cp = (const f32x4*)(cs + 16 * c8); const f32x4 t0 = cp[0], t1 = cp[1], t2 = cp[2], t3 = cp[3];
    const float cc[8] = {t0.x, t0.z, t1.x, t1.z, t2.x, t2.z, t3.x, t3.z}, sn[8] = {t0.y, t0.w, t1.y, t1.w, t2.y, t2.w, t3.y, t3.w};
#pragma unroll
    for (int j = 0; j < 8; ++j) { lo[j] = (x1[j] * cc[j] - x2[j] * sn[j]) * scale; hi[j] = (x2[j] * cc[j] + x1[j] * sn[j]) * scale; }
}
struct RotX { v4u a, b; }; struct RotT { f32x4 t0, t1, t2, t3; };
__device__ __forceinline__ RotX rot_ldx(const bf16* src, int c8) { RotX r; r.a = *(const v4u*)(src + c8 * 8); r.b = *(const v4u*)(src + 64 + c8 * 8); return r; }
__device__ __forceinline__ RotT rot_ldt(const float* cs, int c8) { const f32x4* cp = (const f32x4*)(cs + 16 * c8); RotT r; r.t0 = cp[0]; r.t1 = cp[1]; r.t2 = cp[2]; r.t3 = cp[3]; return r; }
__device__ __forceinline__ void rot_ap(const RotX& x, const RotT& t, float scale, float (&lo)[8], float (&hi)[8]) {
    float x1[8], x2[8]; unpack8(x.a, x1); unpack8(x.b, x2);
    const float cc[8] = {t.t0.x, t.t0.z, t.t1.x, t.t1.z, t.t2.x, t.t2.z, t.t3.x, t.t3.z}, sn[8] = {t.t0.y, t.t0.w, t.t1.y, t.t1.w, t.t2.y, t.t2.w, t.t3.y, t.t3.w};
#pragma unroll
    for (int j = 0; j < 8; ++j) { lo[j] = (x1[j] * cc[j] - x2[j] * sn[j]) * scale; hi[j] = (x2[j] * cc[j] + x1[j] * sn[j]) * scale; }
}
__device__ __forceinline__ void ret_pass1_item(const Ctx& C, const Ax& a, int item) {
    const bf16* P = (const bf16*)(a.ws + WS_P); const float* CS = (const float*)(a.ws + WS_ROPE); float* KVT = (float*)(a.ws + WS_KVT);
    const int b = item >> 6, h = (item >> 4) & 3, c = item & 15; const size_t row0 = (size_t)b * SEQ + c * 128; const float lg = ret_lg(h);
    LAS bf16* KT = (LAS bf16*)C.lds; LAS bf16* VT = KT + 128 * RS;
    { RotX kx[2]; RotT kt[2]; v4u vw[4];
#pragma unroll
      for (int u = 0; u < 2; ++u) { const int it = C.tid + u * (NWAVES * 64), tt = it & 127, c8 = it >> 7; kx[u] = rot_ldx(P + (row0 + tt) * PIN + PB_ + 512 + h * 128, c8); kt[u] = rot_ldt(CS + (size_t)(c * 128 + tt) * 128, c8); }
#pragma unroll
      for (int u = 0; u < 4; ++u) { const int it = C.tid + u * (NWAVES * 64), tt = it & 127, c8 = it >> 7; vw[u] = *(const v4u*)(P + (row0 + tt) * PIN + PB_ + 1024 + h * 128 + c8 * 8); }
      __builtin_amdgcn_sched_barrier(0);
#pragma unroll
      for (int u = 0; u < 2; ++u) { const int it = C.tid + u * (NWAVES * 64), tt = it & 127, c8 = it >> 7; float lo[8], hi[8];
        rot_ap(kx[u], kt[u], 0.08838834764831845f * __expf(lg * (float)(127 - tt)), lo, hi);
#pragma unroll
        for (int j = 0; j < 8; ++j) { KT[(c8 * 8 + j) * RS + tt] = (bf16)(pk2(lo[j], 0.f) & 0xffffu); KT[(64 + c8 * 8 + j) * RS + tt] = (bf16)(pk2(hi[j], 0.f) & 0xffffu); } }
#pragma unroll
      for (int u = 0; u < 4; ++u) { const int it = C.tid + u * (NWAVES * 64), tt = it & 127, c8 = it >> 7; const unsigned ww[4] = {vw[u].x, vw[u].y, vw[u].z, vw[u].w};
#pragma unroll
        for (int j = 0; j < 4; ++j) { VT[(c8 * 8 + 2 * j) * RS + tt] = (bf16)(ww[j] & 0xffffu); VT[(c8 * 8 + 2 * j + 1) * RS + tt] = (bf16)(ww[j] >> 16); } } }
    __syncthreads();
    const int fr = C.lane & 15, fq = C.lane >> 4, w = C.wave;
    f32x4 acc[8];
#pragma unroll
    for (int et = 0; et < 8; ++et) acc[et] = zero4();
#pragma unroll
    for (int ks = 0; ks < 4; ++ks) { const bf16x8 kf = *(const LAS bf16x8*)(KT + (16 * w + fr) * RS + ks * 32 + fq * 8);
#pragma unroll
        for (int et = 0; et < 8; ++et) { const bf16x8 vf = *(const LAS bf16x8*)(VT + (16 * et + fr) * RS + ks * 32 + fq * 8); acc[et] = __builtin_amdgcn_mfma_f32_16x16x32_bf16(kf, vf, acc[et], 0, 0, 0); } }
    float* o = KVT + (size_t)item * 16384;
#pragma unroll
    for (int et = 0; et < 8; ++et) *(f32x4*)(o + (size_t)(16 * et + fr) * 128 + 16 * w + 4 * fq) = acc[et];
    __syncthreads();
}
__device__ __forceinline__ void ret_prefix_phase(const Ctx& C, const Ax& a, int l) {
    const float* KVT = (const float*)(a.ws + WS_KVT); bf16* STB = (bf16*)(a.ws + WS_STB);
    const int gt = C.bid * (NWAVES * 64) + C.tid, NT = C.G * NWAVES * 64;
    for (int idx = gt; idx < 16 * 4096; idx += NT) { const int bh = idx >> 12, r = idx & 4095, e = r >> 5, d4 = (r & 31) * 4; const int h = bh & 3;
        const float g128 = __expf(ret_lg(h) * 128.0f); const size_t base = (size_t)bh * 16 * 16384 + e * 128 + d4;
        f32x4 kv[16];
#pragma unroll
        for (int c = 0; c < 16; ++c) kv[c] = *(const f32x4*)(KVT + base + (size_t)c * 16384);
        f32x4 S = zero4();
#pragma unroll
        for (int c = 0; c < 16; ++c) { v2u w; w.x = pk2(S.x, S.y); w.y = pk2(S.z, S.w); *(v2u*)(STB + base + (size_t)c * 16384) = w; S = S * g128 + kv[c]; }
        float* o = a.out + O_RETP + ((size_t)l * 16 + bh) * 16384 + e;
        o[(size_t)d4 * 128] = S.x; o[(size_t)(d4 + 1) * 128] = S.y; o[(size_t)(d4 + 2) * 128] = S.z; o[(size_t)(d4 + 3) * 128] = S.w; }
}
__device__ __forceinline__ void ret_pass2_item(const Ctx& C, const Ax& a, int l, int item) {
    const bf16* P = (const bf16*)(a.ws + WS_P); const float* CS = (const float*)(a.ws + WS_ROPE); bf16* YC = (bf16*)(a.ws + WS_YC);
    const int b = item >> 6, h = (item >> 4) & 3, c = item & 15; const size_t row0 = (size_t)b * SEQ + c * 128; const float lg = ret_lg(h);
    LAS bf16* QL = (LAS bf16*)C.lds; LAS bf16* KL = QL + 128 * RS; LAS bf16* VT = KL + 128 * RS; LAS bf16* ST = VT + 128 * RS;
    { RotX qx[2], kx[2]; RotT kt[2]; v4u vw[4], sw[4]; const bf16* stb = (const bf16*)(a.ws + WS_STB) + (size_t)item * 16384;
#pragma unroll
      for (int u = 0; u < 2; ++u) { const int it = C.tid + u * (NWAVES * 64), tt = it & 127, c8 = it >> 7; const bf16* pr = P + (row0 + tt) * PIN + PB_ + h * 128;
        qx[u] = rot_ldx(pr, c8); kx[u] = rot_ldx(pr + 512, c8); kt[u] = rot_ldt(CS + (size_t)(c * 128 + tt) * 128, c8); }
#pragma unroll
      for (int u = 0; u < 4; ++u) { const int it = C.tid + u * (NWAVES * 64), tt = it & 127, c8 = it >> 7; vw[u] = *(const v4u*)(P + (row0 + tt) * PIN + PB_ + 1024 + h * 128 + c8 * 8);
        sw[u] = *(const v4u*)(stb + (it >> 4) * 128 + (it & 15) * 8); }
      __builtin_amdgcn_sched_barrier(0);
#pragma unroll
      for (int u = 0; u < 2; ++u) { const int it = C.tid + u * (NWAVES * 64), tt = it & 127, c8 = it >> 7; float lo[8], hi[8];
        rot_ap(qx[u], kt[u], __expf(lg * (float)(tt + 1)), lo, hi);
        *(LAS v4u*)(QL + tt * RS + c8 * 8) = pack8(lo); *(LAS v4u*)(QL + tt * RS + 64 + c8 * 8) = pack8(hi);
        rot_ap(kx[u], kt[u], 0.08838834764831845f * __expf(-lg * (float)(tt + 1)), lo, hi);
        *(LAS v4u*)(KL + tt * RS + c8 * 8) = pack8(lo); *(LAS v4u*)(KL + tt * RS + 64 + c8 * 8) = pack8(hi); }
#pragma unroll
      for (int u = 0; u < 4; ++u) { const int it = C.tid + u * (NWAVES * 64), tt = it & 127, c8 = it >> 7; const unsigned ww[4] = {vw[u].x, vw[u].y, vw[u].z, vw[u].w};
#pragma unroll
        for (int j = 0; j < 4; ++j) { VT[(c8 * 8 + 2 * j) * RS + tt] = (bf16)(ww[j] & 0xffffu); VT[(c8 * 8 + 2 * j + 1) * RS + tt] = (bf16)(ww[j] >> 16); }
        *(LAS v4u*)(ST + (it >> 4) * RS + (it & 15) * 8) = sw[u]; } }
    __syncthreads();
    const int fr = C.lane & 15, fq = C.lane >> 4, w = C.wave, i0 = 16 * w;
    bf16x8 qf[4];
#pragma unroll
    for (int ks = 0; ks < 4; ++ks) qf[ks] = *(const LAS bf16x8*)(QL + (i0 + fr) * RS + ks * 32 + fq * 8);
    f32x4 sc[8];
#pragma unroll
    for (int jt = 0; jt < 8; ++jt) { sc[jt] = zero4();
        if (jt <= w) {
#pragma unroll
            for (int ks = 0; ks < 4; ++ks) { const bf16x8 kf = *(const LAS bf16x8*)(KL + (16 * jt + fr) * RS + ks * 32 + fq * 8); sc[jt] = __builtin_amdgcn_mfma_f32_16x16x32_bf16(kf, qf[ks], sc[jt], 0, 0, 0); }
            if (jt == w) {
#pragma unroll
                for (int r = 0; r < 4; ++r) if (4 * fq + r > fr) sc[jt][r] = 0.f; } } }
    __syncthreads();
    LAS bf16* PL = KL;
#pragma unroll
    for (int jt = 0; jt < 8; ++jt) { v2u pw; pw.x = pk2(sc[jt][0], sc[jt][1]); pw.y = pk2(sc[jt][2], sc[jt][3]); *(LAS v2u*)(PL + (i0 + fr) * RS + 16 * jt + 4 * fq) = pw; }
    LDS_WAIT(); asm volatile("" ::: "memory");
    f32x4 acc[8];
#pragma unroll
    for (int et = 0; et < 8; ++et) acc[et] = zero4();
#pragma unroll
    for (int ks = 0; ks < 4; ++ks) { if (2 * ks <= w) { const bf16x8 pf = *(const LAS bf16x8*)(PL + (i0 + fr) * RS + ks * 32 + fq * 8);
#pragma unroll
            for (int et = 0; et < 8; ++et) { const bf16x8 vf = *(const LAS bf16x8*)(VT + (16 * et + fr) * RS + ks * 32 + fq * 8); acc[et] = __builtin_amdgcn_mfma_f32_16x16x32_bf16(vf, pf, acc[et], 0, 0, 0); } } }
    if (c > 0) {
#pragma unroll
        for (int ks = 0; ks < 4; ++ks)
#pragma unroll
            for (int et = 0; et < 8; ++et) { const bf16x8 sf = *(const LAS bf16x8*)(ST + (16 * et + fr) * RS + ks * 32 + fq * 8); acc[et] = __builtin_amdgcn_mfma_f32_16x16x32_bf16(sf, qf[ks], acc[et], 0, 0, 0); } }
    float s = 0.f;
#pragma unroll
    for (int et = 0; et < 8; ++et) s += (acc[et][0] + acc[et][1]) + (acc[et][2] + acc[et][3]);
    s += __shfl_xor(s, 16); s += __shfl_xor(s, 32); const float mu = s * (1.0f / 128.0f);
    float q = 0.f;
#pragma unroll
    for (int et = 0; et < 8; ++et) { acc[et] = acc[et] - mu; q += (acc[et][0] * acc[et][0] + acc[et][1] * acc[et][1]) + (acc[et][2] * acc[et][2] + acc[et][3] * acc[et][3]); }
    q += __shfl_xor(q, 16); q += __shfl_xor(q, 32); const float rstd = 1.0f / sqrtf(q * (1.0f / 128.0f) + 1e-6f);
    const size_t row = row0 + i0 + fr;
#pragma unroll
    for (int et = 0; et < 8; ++et) { const int e = 16 * et + 4 * fq; float gg[4]; unpack4(*(const v2u*)(P + row * PIN + PB_ + 1536 + h * 128 + e), gg);
        v2u wv; wv.x = pk2(gg[0] * sigm(gg[0]) * acc[et][0] * rstd, gg[1] * sigm(gg[1]) * acc[et][1] * rstd); wv.y = pk2(gg[2] * sigm(gg[2]) * acc[et][2] * rstd, gg[3] * sigm(gg[3]) * acc[et][3] * rstd);
        *(v2u*)(YC + row * DM + 512 + h * 128 + e) = wv; }
    __syncthreads();
}
__device__ __forceinline__ void ret_sample_witem(const Ctx& C, const Ax& a, int l, int witem) {
    const bf16* P = (const bf16*)(a.ws + WS_P); const float* CS = (const float*)(a.ws + WS_ROPE) + (size_t)2048 * 128; bf16* YC = (bf16*)(a.ws + WS_YC);
    const int n = witem >> 2, h = witem & 3, lane = C.lane; const float gam = 1.0f - exp2f(-5.0f - (float)h);
    LAS float* qk = (LAS float*)(C.lds + C.wave * 1024);
    const bf16* pr = P + (size_t)(MP + n) * PIN + PB_ + h * 128;
    { const float co = CS[2 * lane], si = CS[2 * lane + 1]; const float q1 = bf1(pr[lane]), q2 = bf1(pr[64 + lane]), k1 = bf1(pr[512 + lane]), k2 = bf1(pr[512 + 64 + lane]);
      qk[lane] = q1 * co - q2 * si; qk[64 + lane] = q2 * co + q1 * si; qk[128 + lane] = (k1 * co - k2 * si) * 0.08838834764831845f; qk[192 + lane] = (k2 * co + k1 * si) * 0.08838834764831845f; }
    LDS_WAIT(); asm volatile("" ::: "memory");
    const float dotp = wave_sum(qk[lane] * qk[128 + lane] + qk[64 + lane] * qk[192 + lane]);
    const int half = lane >> 5, el = lane & 31;
    float vv[4]; unpack4(*(const v2u*)(pr + 1024 + 4 * el), vv); const f32x4 v4 = (f32x4){vv[0], vv[1], vv[2], vv[3]};
    const float* sin_ = a.in(I_SRET) + (((size_t)l * NS + n) * 4 + h) * 16384; float* sout = a.out + O_RETS + (((size_t)l * NS + n) * 4 + h) * 16384;
    f32x4 oa = zero4();
#pragma unroll 8
    for (int it = 0; it < 64; ++it) { const int d = 2 * it + half; const f32x4 S = __builtin_nontemporal_load((const f32x4*)(sin_ + (size_t)d * 128 + 4 * el)); const float qd = qk[d], kd = qk[128 + d];
        oa += qd * S; __builtin_nontemporal_store(gam * S + kd * v4, (f32x4*)(sout + (size_t)d * 128 + 4 * el)); }
    oa.x += __shfl_xor(oa.x, 32); oa.y += __shfl_xor(oa.y, 32); oa.z += __shfl_xor(oa.z, 32); oa.w += __shfl_xor(oa.w, 32);
    f32x4 o = gam * oa + dotp * v4;
    float s = (o.x + o.y) + (o.z + o.w);
#pragma unroll
    for (int m = 1; m < 32; m <<= 1) s += __shfl_xor(s, m);
    const float mu = s * (1.0f / 128.0f); o = o - mu; float q = (o.x * o.x + o.y * o.y) + (o.z * o.z + o.w * o.w);
#pragma unroll
    for (int m = 1; m < 32; m <<= 1) q += __shfl_xor(q, m);
    const float rstd = 1.0f / sqrtf(q * (1.0f / 128.0f) + 1e-6f);
    if (half == 0) { float gg[4]; unpack4(*(const v2u*)(pr + 1536 + 4 * el), gg);
        v2u wv; wv.x = pk2(gg[0] * sigm(gg[0]) * o.x * rstd, gg[1] * sigm(gg[1]) * o.y * rstd); wv.y = pk2(gg[2] * sigm(gg[2]) * o.z * rstd, gg[3] * sigm(gg[3]) * o.w * rstd);
        *(v2u*)(YC + (size_t)(MP + n) * DM + 512 + h * 128 + 4 * el) = wv; }
    LDS_WAIT(); asm volatile("" ::: "memory");
}

constexpr int XV_RS = 264;
__device__ __forceinline__ void xattn_prompt_unit(const Ctx& C, const Ax& a, int l, int unit) {
    const bf16* Q = (const bf16*)(a.ws + WS_Q); const bf16* MK = (const bf16*)(a.ws + WS_MK) + (size_t)l * MMEM * DM; const bf16* MVT = (const bf16*)(a.ws + WS_MVT) + (size_t)l * MMEM * DM; bf16* O = (bf16*)(a.ws + WS_O);
    const int b = unit >> 6, h = (unit >> 4) & 3, qt = unit & 15, fr = C.lane & 15, fq = C.lane >> 4;
    const size_t row = (size_t)b * SEQ + qt * 128 + C.wave * 16 + fr;
    LAS bf16* SB = (LAS bf16*)C.lds;
    v4u st[8];
    const bf16* kbase = MK + ((size_t)b * 256) * DM + h * 512; const bf16* vbase = MVT + (((size_t)b * 4 + h) * 512) * 256;
    unsigned kof[4], vof[8], sof[8];
#pragma unroll
    for (int i = 0; i < 8; ++i) { const int idx = C.tid + 512 * i, r = idx >> 5, c16 = idx & 31; vof[i] = (unsigned)(r * 256 + c16 * 8) * 2u; sof[i] = (unsigned)(r * XV_RS + c16 * 8) * 2u; if (i < 4) kof[i] = (unsigned)(r * DM + c16 * 8) * 2u; }
    const char* kb8 = (const char*)kbase; const char* vb8 = (const char*)vbase; LAS char* sb8 = (LAS char*)SB;
#define XK_LOAD(q) do { const char* pb_ = kb8 + ((size_t)(((q) & 3) * 64) * DM + ((q) >> 2) * 256) * 2; _Pragma("unroll") for (int i = 0; i < 4; ++i) st[i] = *(const v4u*)(pb_ + kof[i]); } while (0)
#define XK_STORE() do { _Pragma("unroll") for (int i = 0; i < 4; ++i) *(LAS v4u*)(sb8 + sof[i]) = st[i]; } while (0)
#define XV_LOAD(p) do { const char* pb_ = vb8 + (size_t)((p) * 128) * 256 * 2; _Pragma("unroll") for (int i = 0; i < 8; ++i) st[i] = *(const v4u*)(pb_ + vof[i]); } while (0)
#define XV_STORE() do { _Pragma("unroll") for (int i = 0; i < 8; ++i) *(LAS v4u*)(sb8 + sof[i]) = st[i]; } while (0)
    XK_LOAD(0);
    f32x4 sc[16];
#pragma unroll
    for (int jt = 0; jt < 16; ++jt) sc[jt] = zero4();
#pragma unroll
    for (int dh = 0; dh < 2; ++dh) {
        bf16x8 qf[8];
#pragma unroll
        for (int ks = 0; ks < 8; ++ks) qf[ks] = *(const bf16x8*)(Q + row * DM + h * 512 + dh * 256 + ks * 32 + fq * 8);
#pragma unroll
        for (int p = 0; p < 4; ++p) {
            __syncthreads(); XK_STORE(); __syncthreads();
            if (dh * 4 + p < 7) XK_LOAD(dh * 4 + p + 1); else XV_LOAD(0);
#pragma unroll
            for (int j4 = 0; j4 < 4; ++j4) {
#pragma unroll
                for (int ks = 0; ks < 8; ++ks) { const bf16x8 kf = *(const LAS bf16x8*)(SB + (j4 * 16 + fr) * XV_RS + ks * 32 + fq * 8); sc[p * 4 + j4] = __builtin_amdgcn_mfma_f32_16x16x32_bf16(kf, qf[ks], sc[p * 4 + j4], 0, 0, 0); }
                __builtin_amdgcn_sched_barrier(0); }
        }
    }
    float mx = -3.0e38f;
#pragma unroll
    for (int jt = 0; jt < 16; ++jt) mx = fmaxf(mx, fmaxf(fmaxf(sc[jt][0], sc[jt][1]), fmaxf(sc[jt][2], sc[jt][3])));
    mx = fmaxf(mx, __shfl_xor(mx, 16)); mx = fmaxf(mx, __shfl_xor(mx, 32));
    const float scale = 0.04419417382415922f; float sum = 0.f;
    bf16x8 pf[8];
#pragma unroll
    for (int s = 0; s < 8; ++s) { float p[8];
#pragma unroll
        for (int j = 0; j < 4; ++j) { p[j] = __expf((sc[2 * s][j] - mx) * scale); p[4 + j] = __expf((sc[2 * s + 1][j] - mx) * scale); }
        sum += ((p[0] + p[1]) + (p[2] + p[3])) + ((p[4] + p[5]) + (p[6] + p[7]));
        const v4u w = pack8(p); pf[s] = __builtin_bit_cast(bf16x8, w); }
    sum += __shfl_xor(sum, 16); sum += __shfl_xor(sum, 32); const float inv = 1.0f / sum;
#pragma unroll
    for (int p = 0; p < 4; ++p) {
        __syncthreads(); XV_STORE(); __syncthreads();
        if (p < 3) XV_LOAD(p + 1);
#pragma unroll
        for (int et = 0; et < 8; ++et) { f32x4 s4 = zero4(); const LAS bf16* vp = SB + (et * 16 + fr) * XV_RS + 4 * fq;
#pragma unroll
            for (int s = 0; s < 8; ++s) { const v2u lo = *(const LAS v2u*)(vp + 32 * s), hi = *(const LAS v2u*)(vp + 32 * s + 16); const v4u w = (v4u){lo.x, lo.y, hi.x, hi.y};
                s4 = __builtin_amdgcn_mfma_f32_16x16x32_bf16(__builtin_bit_cast(bf16x8, w), pf[s], s4, 0, 0, 0); }
            v2u w; w.x = pk2(s4[0] * inv, s4[1] * inv); w.y = pk2(s4[2] * inv, s4[3] * inv);
            *(v2u*)(O + row * DM + h * 512 + p * 128 + et * 16 + 4 * fq) = w;
            __builtin_amdgcn_sched_barrier(0); }
    }
    __syncthreads();
#undef XK_LOAD
#undef XK_STORE
#undef XV_LOAD
#undef XV_STORE
}
__device__ __forceinline__ void xattn_sample_item(const Ctx& C, const Ax& a, int l, int item) {
    bf16* O = (bf16*)(a.ws + WS_OS);
    const int n = item >> 2, h = item & 3, lane = C.lane, w = C.wave;
    LAS float* red = (LAS float*)C.lds; LAS float* part = red + 64;
    float q[8]; { const float* s0 = (const float*)(a.ws + WS_SPL) + (size_t)n * DM + h * 512 + 4 * lane; const float* s1 = s0 + (size_t)NS * DM;
                  const f32x4 a0 = *(const f32x4*)s0 + *(const f32x4*)s1, a1 = *(const f32x4*)(s0 + 256) + *(const f32x4*)(s1 + 256);
                  q[0] = a0.x; q[1] = a0.y; q[2] = a0.z; q[3] = a0.w; q[4] = a1.x; q[5] = a1.y; q[6] = a1.z; q[7] = a1.w; }
    const size_t base = ((((size_t)l * NS + n) * 256 + 32 * w) * 4 + h) * 512 + 4 * lane;
    const float* kp = a.in(I_CMK) + base; const float* vp = a.in(I_CMV) + base;
#define XS_LOAD(buf0, buf1, ptr, k8) do { _Pragma("unroll") for (int j = 0; j < 8; ++j) { buf0[j] = __builtin_nontemporal_load((const f32x4*)((ptr) + (size_t)((k8) * 8 + j) * 2048)); buf1[j] = __builtin_nontemporal_load((const f32x4*)((ptr) + (size_t)((k8) * 8 + j) * 2048 + 256)); } } while (0)
#define XS_DOT(buf0, buf1, k8) do { _Pragma("unroll") for (int j = 0; j < 8; ++j) { float d = (buf0[j].x * q[0] + buf0[j].y * q[1]) + (buf0[j].z * q[2] + buf0[j].w * q[3]) + (buf1[j].x * q[4] + buf1[j].y * q[5]) + (buf1[j].z * q[6] + buf1[j].w * q[7]); \
        d = rowsum16(d); d += __shfl_xor(d, 16); d += __shfl_xor(d, 32); if (lane == (k8) * 8 + j) myscore = d; } } while (0)
#define XS_ACC(buf0, buf1, k8) do { _Pragma("unroll") for (int j = 0; j < 8; ++j) { const float pj = __builtin_bit_cast(float, __builtin_amdgcn_readlane(__builtin_bit_cast(int, p), (k8) * 8 + j)); o0 += pj * buf0[j]; o1 += pj * buf1[j]; } } while (0)
    float myscore = 0.f;
    f32x4 xa0[8], xa1[8], xb0[8], xb1[8];
    XS_LOAD(xa0, xa1, kp, 0);
    XS_LOAD(xb0, xb1, kp, 1); XS_DOT(xa0, xa1, 0);
    XS_LOAD(xa0, xa1, kp, 2); XS_DOT(xb0, xb1, 1);
    XS_LOAD(xb0, xb1, kp, 3); XS_DOT(xa0, xa1, 2);
    XS_LOAD(xa0, xa1, vp, 0); XS_DOT(xb0, xb1, 3);
    const float scale = 0.04419417382415922f;
    float mx = wave_max(lane < 32 ? myscore : -3.0e38f); if (lane == 0) red[w] = mx; __syncthreads();
    mx = red[0];
#pragma unroll
    for (int i = 1; i < 8; ++i) mx = fmaxf(mx, red[i]);
    const float p = lane < 32 ? __expf((myscore - mx) * scale) : 0.f;
    const float ps = wave_sum(p); if (lane == 0) red[8 + w] = ps;
    f32x4 o0 = zero4(), o1 = zero4();
    XS_LOAD(xb0, xb1, vp, 1); XS_ACC(xa0, xa1, 0);
    XS_LOAD(xa0, xa1, vp, 2); XS_ACC(xb0, xb1, 1);
    XS_LOAD(xb0, xb1, vp, 3); XS_ACC(xa0, xa1, 2);
    XS_ACC(xb0, xb1, 3);
#undef XS_LOAD
#undef XS_DOT
#undef XS_ACC
    *(LAS f32x4*)(part + w * 512 + 4 * lane) = o0; *(LAS f32x4*)(part + w * 512 + 256 + 4 * lane) = o1;
    __syncthreads();
    float tot = 0.f;
#pragma unroll
    for (int i = 0; i < 8; ++i) tot += red[8 + i];
    { const int d = C.tid; float s = 0.f;
#pragma unroll
      for (int i = 0; i < 8; ++i) s += part[i * 512 + d];
      O[(size_t)n * DMS + h * 512 + d] = (bf16)(pk2(s / tot, 0.f) & 0xffffu); }
    __syncthreads();
}

#ifndef PHASE_MASK
#define PHASE_MASK 0xffffffffu
#endif
#define PM(k) ((PHASE_MASK >> (k)) & 1u)
#ifndef DUP_SUB
#define DUP_SUB 0u
#endif
#define REP(k) for (int rep_ = 0; rep_ < 1 + (int)((DUP_SUB >> (k)) & 1u); ++rep_)
#ifndef DUP_MASK
#define DUP_MASK 0
#endif
#ifndef MK_ONE_LAUNCH
#define MK_ONE_LAUNCH 1
#endif
constexpr int PH_PER_LAYER = 14, NPH = 1 + DEPTH * PH_PER_LAYER;
__global__ void __launch_bounds__(NWAVES * 64, 2) fwd_kernel(Args args) {
    extern __shared__ __attribute__((aligned(16))) unsigned char lds_raw[];
    LAS unsigned char* const lds = (LAS unsigned char*)lds_raw;
    const int wave_s = __builtin_amdgcn_readfirstlane((int)threadIdx.x >> 6);
    volatile LAS unsigned* MISC = (volatile LAS unsigned*)(lds + MISC_OFF);
    for (int u = threadIdx.x; u < (LDS_BYTES - MISC_OFF) / 4; u += NWAVES * 64) ((LAS unsigned*)(lds + MISC_OFF))[u] = 0u;
    __syncthreads();
    XcdBarrier bar; bar.bar = (unsigned*)(args.ws + WS_CTL) + CW_BAR; bar.x = 0; bar.st = nullptr;
    if (MK_ONE_LAUNCH) bar = xcd_barrier_post((unsigned*)(args.ws + WS_CTL) + CW_BAR, MISC + 8);
    bar.wave = wave_s;
    const int lo = args.ph_lo, hi = args.ph_hi;
#define IN(k) (lo <= (k) && (k) < hi)
#define SEAM(k) do { if (MK_ONE_LAUNCH && IN((k) + 1)) xcd_barrier(bar); } while (0)
#define SEAM2(k) do { if (MK_ONE_LAUNCH && IN((k) + 2)) xcd_barrier(bar); } while (0)
#define PHASE_CTX const Ctx C = mk_ctx(lds, wave_s); const Ax a = mk_ax(); unsigned char* const ws = a.ws; const int G = C.G, bid = C.bid; (void)ws; (void)G; (void)bid; \
    float* const XF = (float*)(ws + WS_XF); bf16* const HN = (bf16*)(ws + WS_HN); bf16* const PBUF = (bf16*)(ws + WS_P); bf16* const YC = (bf16*)(ws + WS_YC); bf16* const QB = (bf16*)(ws + WS_Q); \
    bf16* const OB = (bf16*)(ws + WS_O); bf16* const UB = (bf16*)(ws + WS_U); (void)XF; (void)HN; (void)PBUF; (void)YC; (void)QB; (void)OB; (void)UB

    if (IN(0)) { PHASE_CTX; if (PM(0)) p0_prologue(C, a); SEAM(0); }

    for (int l = 0; l < DEPTH; ++l) {
        const int pb = 1 + l * PH_PER_LAYER;
        if (IN(pb + 0)) { PHASE_CTX; const unsigned char* wl = ws + WS_WL + (size_t)l * LW_STRIDE;
            if (PM(1)) { pg8::Gemm g{HN, (const bf16*)(wl + LW_IN), MPAD, PIN, DM, DM, 64, (size_t)PIN * 128}; pg8::StaticOrder S; S.init(MPAD, PIN, G, bid); pg8::EpiBf16A<0> E{PBUF, PIN, nullptr};
              pg8::gemm_phase<pg8::EpiBf16A<0>, pg8::StaticOrder, true, true>(lds, g, S, E, C.tid); }
            if (G == 256) { const int nfull = (MPAD / 256) * (PIN / 256) - 3 * G;
                if ((bid >= nfull && bid < 64) || bid >= 128) { __syncthreads(); late_convert(C, a, l, bid < 64 ? bid - nfull : bid - 128 + (64 - nfull), (64 - nfull) + (G - 128)); } }
            if (PM(2)) { pg8::Gemm g{(const bf16*)(ws + WS_MN), (const bf16*)(ws + WS_WKV) + (size_t)l * 4096 * 64, MMEM, 4096, DM, DM, 64, (size_t)8192 * 128}; pg8::StaticOrder S; S.init(MMEM, 4096, G, (bid + G - (64 % G)) % G);
              pg8::EpiMemKV E{a.out + O_MKP + (size_t)l * MMEM * DM, (bf16*)(ws + WS_MK) + (size_t)l * MMEM * DM, (bf16*)(ws + WS_MVT) + (size_t)l * MMEM * DM};
              pg8::gemm_phase<pg8::EpiMemKV, pg8::StaticOrder, true, true>(lds, g, S, E, C.tid); }
            SEAM(pb + 0);
        }
        if (IN(pb + 1)) { PHASE_CTX;
#ifdef DEBUG_P
            { const int gt = bid * 512 + C.tid, NT = G * 512;
              for (int idx = gt + (DEBUG_P == 2 ? MP * 2048 : 0); idx < (DEBUG_P == 1 ? MP : MT) * 2048; idx += NT) { const int row = idx >> 11, c = idx & 2047; const bf16* pr = PBUF + (size_t)row * PIN;
                  float s = bf1(pr[c]) + bf1(pr[c + 2048]) + bf1(pr[c + 4096]); if (c < 256) s += bf1(pr[c + 6144]); a.out[O_YP + idx] = s; } }
#endif
            if ((bid >> 3) & 1) { if (PM(8)) REP(8) for (int it = bid * NWAVES + C.wave; it < NS * 4; it += G * NWAVES) ret_sample_witem(C, a, l, it); __syncthreads(); }
            if (PM(4)) REP(4) for (int it = bid; it < 256; it += G) ad_prompt_item(C, a, l, it);
            if (PM(5)) REP(5) for (int it = bid; it < 256; it += G) ret_pass1_item(C, a, it);
            if (PM(6)) REP(6) for (int it = bid; it < 256; it += G) rwkv_prep_item(C, a, l, it);
            if (PM(6)) for (int it = bid - 64; it >= 0 && it < 8; it += G) rwkv_prep_item(C, a, l, 256 + (it >> 1), it & 1);
            if (PM(7)) REP(7) for (int it = G - 1 - bid; it < NS; it += G) ad_sample_item(C, a, l, it);
            if (!((bid >> 3) & 1)) { if (PM(8)) REP(8) for (int it = bid * NWAVES + C.wave; it < NS * 4; it += G * NWAVES) ret_sample_witem(C, a, l, it); }
            __syncthreads();
            SEAM(pb + 1);
        }
        if (IN(pb + 2)) { PHASE_CTX;
            if ((bid >> 3) & 1) { if (PM(10)) REP(10) for (int it = bid * NWAVES + C.wave; it < NS * 16; it += G * NWAVES) rwkv_sample_witem(C, a, l, it); }
            if (PM(9)) REP(9) for (int it = bid * NWAVES + C.wave; it < 4096; it += G * NWAVES) wkv_chunk_witem(C, a, it);
            if (!((bid >> 3) & 1)) { if (PM(10)) REP(10) for (int it = bid * NWAVES + C.wave; it < NS * 16; it += G * NWAVES) rwkv_sample_witem(C, a, l, it); }
            if (PM(11)) ret_prefix_phase(C, a, l);
            SEAM(pb + 2);
        }
        if (IN(pb + 3)) { PHASE_CTX; const int hg = G / 2;
            if (PM(22)) REP(22) for (int it = bid; it < 128; it += (bid < hg ? hg : 1 << 20)) wkv_seq_item(C, a, l, it);
            if (PM(11)) REP(11) if (bid >= hg || G < 2) for (int it = bid - hg; it < 256; it += G - hg) ret_pass2_item(C, a, l, it);
            SEAM(pb + 3);
        }
        if (IN(pb + 4)) { PHASE_CTX;
            if (PM(12)) REP(12) rwkv_post_phase(C, a, l);
            SEAM(pb + 4);
        }
        if (IN(pb + 5)) { PHASE_CTX; const unsigned char* wl = ws + WS_WL + (size_t)l * LW_STRIDE;
            pg8::Gemm g{YC, (const bf16*)(wl + LW_OUT), MP, DM, DM, DM, 64, (size_t)DM * 128}; pg8::StaticOrder S; S.init(MP, DM, G, bid); pg8::EpiRes E{XF, DM, ((DUP_MASK >> 5) & 1) ? 0.5f : 1.0f, (l == 0 && !((DUP_MASK >> 5) & 1)) ? a.in(I_XP) : (const float*)XF};
            if (PM(15)) pg8::gemm_phase<pg8::EpiRes, pg8::StaticOrder, true, true>(lds, g, S, E, C.tid);
            if (PM(20)) sample_gemm(lds, C.tid, YC + (size_t)MP * DM, DM, (const bf16*)(wl + LW_OUT), DM, DM, DM, G, bid, SEpiRes{XF + (size_t)MP * DM, DM, ((DUP_MASK >> 5) & 1) ? 0.5f : 1.0f, (l == 0 && !((DUP_MASK >> 5) & 1)) ? a.in(I_XS) : (const float*)(XF + (size_t)MP * DM)});
            SEAM(pb + 5);
        }
        if (IN(pb + 6)) { PHASE_CTX; if (PM(21)) REP(21) rms_phase(C, XF, HN, (bf16*)(ws + WS_HNS)); SEAM(pb + 6);
#ifdef XBAR_PROBE
            if (MK_ONE_LAUNCH) for (int i_ = 0; i_ < XBAR_PROBE; ++i_) xcd_barrier(bar);
#endif
        }
        if (IN(pb + 7)) { PHASE_CTX; const unsigned char* wl = ws + WS_WL + (size_t)l * LW_STRIDE;
            pg8::Gemm g{HN, (const bf16*)(wl + LW_Q), MP, DM, DM, DM, 64, (size_t)DM * 128}; pg8::StaticOrder S; S.init(MP, DM, G, bid); pg8::EpiBf16A<0> E{QB, DM, nullptr};
            if (PM(16)) REP(16) pg8::gemm_phase<pg8::EpiBf16A<0>, pg8::StaticOrder, true, true>(lds, g, S, E, C.tid);
            if (PM(20)) { sample_gemm(lds, C.tid, (const bf16*)(ws + WS_HNS), DMS, (const bf16*)(wl + LW_Q), DM, DM, DM, G, bid, SEpiPart{(float*)(ws + WS_SPL), DM}, 2); if ((DUP_SUB >> 24) & 1u) { const Ctx C2 = mk_ctx(lds, wave_s); sample_gemm(lds, C2.tid, (const bf16*)(ws + WS_HNS), DMS, (const bf16*)(wl + LW_Q), DM, DM, DM, G, bid, SEpiPart{(float*)(ws + WS_SPL), DM}, 2); } }
            SEAM(pb + 7);
        }
        if (IN(pb + 8)) { PHASE_CTX;
            { const int g3 = (bid >> 3) % 3;
              if (g3 == 0) { if (PM(13)) REP(13) for (int it = bid; it < 256; it += G) xattn_prompt_unit(C, a, l, it); }
              if (PM(14)) REP(14) for (int it = bid; it < NS * 4; it += 2 * G) xattn_sample_item(C, a, l, it);
              if (g3 == 1) { if (PM(13)) REP(13) for (int it = bid; it < 256; it += G) xattn_prompt_unit(C, a, l, it); }
              if (PM(14)) REP(14) for (int it = bid + G; it < NS * 4; it += 2 * G) xattn_sample_item(C, a, l, it);
              if (g3 == 2) { if (PM(13)) REP(13) for (int it = bid; it < 256; it += G) xattn_prompt_unit(C, a, l, it); } }
            SEAM(pb + 8);
        }
        if (IN(pb + 9)) { PHASE_CTX; const unsigned char* wl = ws + WS_WL + (size_t)l * LW_STRIDE;
            pg8::Gemm g{OB, (const bf16*)(wl + LW_O), MP, DM, DM, DM, 64, (size_t)DM * 128}; pg8::StaticOrder S; S.init(MP, DM, G, bid); pg8::EpiRes E{XF, DM, ((DUP_MASK >> 9) & 1) ? 0.5f : 1.0f, XF};
            if (PM(17)) pg8::gemm_phase<pg8::EpiRes, pg8::StaticOrder, true, true>(lds, g, S, E, C.tid);
            if (PM(20)) sample_gemm(lds, C.tid, (const bf16*)(ws + WS_OS), DMS, (const bf16*)(wl + LW_O), DM, DM, DM, G, bid, SEpiRes{XF + (size_t)MP * DM, DM, ((DUP_MASK >> 9) & 1) ? 0.5f : 1.0f, XF + (size_t)MP * DM});
            SEAM(pb + 9);
        }
        if (IN(pb + 10)) { PHASE_CTX; if (PM(21)) REP(21) rms_phase(C, XF, HN, (bf16*)(ws + WS_HNS)); SEAM(pb + 10); }
        if (IN(pb + 11)) { PHASE_CTX; const unsigned char* wl = ws + WS_WL + (size_t)l * LW_STRIDE;
            pg8::Gemm g{HN, (const bf16*)(wl + LW_UP), MP, DFF, DM, DM, 64, (size_t)DFF * 128}; pg8::StaticOrder S; S.init(MP, DFF, G, bid); pg8::EpiBf16A<3> E{UB, LDU, nullptr};
            if (PM(18)) REP(18) pg8::gemm_phase<pg8::EpiBf16A<3>, pg8::StaticOrder, true, true>(lds, g, S, E, C.tid);
            if (PM(20)) { sample_gemm(lds, C.tid, (const bf16*)(ws + WS_HNS), DMS, (const bf16*)(wl + LW_UP), DFF, DFF, DM, G, bid, SEpiBf16{(bf16*)(ws + WS_US), LDUS, 3, nullptr}); if ((DUP_SUB >> 23) & 1u) { const Ctx C2 = mk_ctx(lds, wave_s); sample_gemm(lds, C2.tid, (const bf16*)(ws + WS_HNS), DMS, (const bf16*)(wl + LW_UP), DFF, DFF, DM, G, bid, SEpiBf16{(bf16*)(ws + WS_US), LDUS, 3, nullptr}); } }
            SEAM(pb + 11);
        }
        if (IN(pb + 12)) { PHASE_CTX; const unsigned char* wl = ws + WS_WL + (size_t)l * LW_STRIDE;
            pg8::Gemm g{UB, (const bf16*)(wl + LW_DN), MP, DM, DFF, LDU, 64, (size_t)DM * 128}; pg8::StaticOrder S; S.init(MP, DM, G, bid); pg8::EpiRes E{XF, DM, ((DUP_MASK >> 12) & 1) ? 0.5f : 1.0f, XF};
            if (PM(19)) pg8::gemm_phase<pg8::EpiRes, pg8::StaticOrder, true, true>(lds, g, S, E, C.tid);
            if (PM(20)) { sample_gemm(lds, C.tid, (const bf16*)(ws + WS_US), LDUS, (const bf16*)(wl + LW_DN), DM, DM, DFF, G, bid, SEpiPart{(float*)(ws + WS_SPL), DM}, 2); if ((DUP_SUB >> 25) & 1u) { const Ctx C2 = mk_ctx(lds, wave_s); sample_gemm(lds, C2.tid, (const bf16*)(ws + WS_US), LDUS, (const bf16*)(wl + LW_DN), DM, DM, DFF, G, bid, SEpiPart{(float*)(ws + WS_SPL), DM}, 2); } }
            SEAM(pb + 12);
        }
        if (IN(pb + 13)) { PHASE_CTX;
            fold_split_rows(C, XF, (const float*)(ws + WS_SPL));
            if (!PM(21)) {} else if (l + 1 < DEPTH) REP(21) rms_phase(C, XF, HN, nullptr); else final_norm_phase(C, XF, a.in(I_GFIN), a.out + O_YP);
            SEAM(pb + 13);
        }
    }
#undef IN
#undef SEAM
#undef SEAM2
#undef PHASE_CTX
}

extern "C" void kernel_launch(void* const* d_in, const int* in_sizes, int n_in, void* d_out, int out_size, void* d_ws, size_t ws_size, hipStream_t stream) {
    static int grid = 0;
    if (grid == 0) {
        if (n_in != NIN || (size_t)out_size != O_END || ws_size < WS_END) { fprintf(stderr, "kernel_launch: unexpected shapes (n_in %d, out %d, ws %zu); nothing launched\n", n_in, out_size, ws_size); grid = -1; return; }
        int dev = 0, cus = 0, per_cu = 0;
        if (hipGetDevice(&dev) != hipSuccess || hipDeviceGetAttribute(&cus, hipDeviceAttributeMultiprocessorCount, dev) != hipSuccess) { grid = -1; return; }
        if (hipFuncSetAttribute((const void*)fwd_kernel, hipFuncAttributeMaxDynamicSharedMemorySize, LDS_BYTES) != hipSuccess) { fprintf(stderr, "kernel_launch: hipFuncSetAttribute failed\n"); grid = -1; return; }
        if (hipOccupancyMaxActiveBlocksPerMultiprocessor(&per_cu, (const void*)fwd_kernel, NWAVES * 64, LDS_BYTES) != hipSuccess || per_cu < 1) { fprintf(stderr, "kernel_launch: occupancy query reports %d\n", per_cu); }
        (void)hipGetLastError();
        grid = cus;
    }
    if (grid < 0) return;
    if (hipMemsetAsync((char*)d_ws + WS_CTL, 0, CTL_ZERO_BYTES, stream) != hipSuccess) return;
    Args a{};
    for (int i = 0; i < NIN; ++i) a.in[i] = (const float*)d_in[i];
    a.out = (float*)d_out; a.ws = (unsigned char*)d_ws;
#if MK_ONE_LAUNCH
    a.ph_lo = 0; a.ph_hi = NPH;
    hipLaunchKernelGGL(fwd_kernel, dim3(grid), dim3(NWAVES * 64), LDS_BYTES, stream, a);
#else
#ifndef NPH_RUN
#define NPH_RUN NPH
#endif
    for (int ph = 0; ph < NPH_RUN; ++ph) { a.ph_lo = ph; a.ph_hi = ph + 1; hipLaunchKernelGGL(fwd_kernel, dim3(grid), dim3(NWAVES * 64), LDS_BYTES, stream, a);
        const int dbit = (ph == 0) ? 13 : (ph - 1) % PH_PER_LAYER;
        if ((DUP_MASK >> dbit) & 1) hipLaunchKernelGGL(fwd_kernel, dim3(grid), dim3(NWAVES * 64), LDS_BYTES, stream, a); }
#endif
}
```

```cpp
#include <hip/hip_runtime.h>
#include <cstdio>
#include <cstdint>
namespace pg8 {
#define PG8_LAS __attribute__((address_space(3)))
typedef unsigned short bf16_t;
typedef short bf16x8 __attribute__((ext_vector_type(8)));
typedef float f32x4 __attribute__((ext_vector_type(4)));
typedef unsigned u32x4 __attribute__((ext_vector_type(4)));
constexpr int BM = 256, BK = 64, HALF = 128, HTB = HALF * BK * 2  , STAGE_BYTES = 8 * HTB, NXCD = 8, WGM = 8;

__host__ __device__ __forceinline__ int lds_byte(int r, int c) { const int st = (r >> 4) * 2 + (c >> 5), rr = r & 15, cc = c & 31, ob = rr * 64 + cc * 2; return st * 1024 + (ob ^ (((ob >> 9) & 1) << 5)); }
__host__ __device__ __forceinline__ void stage_rc(int b, int& R, int& C) { const int st = b / 1024, sb = b % 1024, swz = sb ^ (((sb >> 9) & 1) << 5); R = (st >> 1) * 16 + swz / 64; C = (st & 1) * 32 + (swz % 64) / 2; }
__host__ __device__ __forceinline__ int perm32(int rho) { const int n = rho >> 4, i = rho & 15; return 8 * (i >> 2) + 4 * n + (i & 3); }

struct Unit { int pm, pn; };
struct Gemm { const bf16_t* A; const bf16_t* Bt; int M, N, K, lda, ldb; size_t ksb; };

struct StaticOrder {
    int nM, nN, nwg, G, c;
    __host__ __device__ void init(int M, int N, int G_, int c_) { nM = M / BM; nN = N / BM; nwg = nM * nN; G = G_; c = c_; }
    __host__ __device__ bool next(int i, Unit& u) const {
        const long L = (long)i * G + c; if (L >= nwg) return false;
        int wgid = (int)L; { const int q = nwg / NXCD, r = nwg % NXCD, xcd = wgid % NXCD, off = wgid / NXCD; wgid = (xcd < r ? xcd * (q + 1) : r * (q + 1) + (xcd - r) * q) + off; }
        const int nig = WGM * nN, gid = wgid / nig, fm = gid * WGM, gsz = (nM - fm) < WGM ? (nM - fm) : WGM;
        u.pm = fm + ((wgid % nig) % gsz); u.pn = (wgid % nig) / gsz; return true;
    }
    __device__ __forceinline__ void a_ready(const Unit&) const {}
    __device__ __forceinline__ void done(const Unit&) const {}
};

typedef float f32x2_cv __attribute__((ext_vector_type(2)));
typedef __bf16 bf16x2_cv __attribute__((ext_vector_type(2)));
__device__ __forceinline__ unsigned cvt_pk_bf16(float lo, float hi) { const f32x2_cv v = {lo, hi}; return __builtin_bit_cast(unsigned, __builtin_convertvector(v, bf16x2_cv)); }
typedef float f32x2 __attribute__((ext_vector_type(2)));
template <class Epi, class Sched, bool ALIGN_EPI = false, bool SP2 = false>
__device__ __forceinline__ void gemm_phase(PG8_LAS unsigned char* lds, const Gemm g, const Sched& S, const Epi& E, int tid_in) {
    int tid_ = tid_in; asm volatile("" : "+v"(tid_));
    const int tid = tid_, wid = __builtin_amdgcn_readfirstlane(tid >> 6), lane = tid & 63, wr = wid >> 2, wc = wid & 3, fr = lane & 15, fq = lane >> 4;
    const int K = g.K, nt = K / BK;
    unsigned voffA[2], voffB[2];
#pragma unroll
    for (int i = 0; i < 2; ++i) { int R, C; stage_rc(tid * 16 + i * 8192, R, C); const int Rb = Epi::PERM ? ((R & ~31) + perm32(R & 31)) : R;
        voffA[i] = (unsigned)(R * g.lda + C) * 2u; voffB[i] = (unsigned)(Rb * g.ldb + C) * 2u; }
    const size_t kstep = (size_t)(BK * 2), kstepB = g.ksb;
    const size_t hstepA = (size_t)HALF * g.lda * 2, hstepB = (size_t)HALF * g.ldb * 2;
    const size_t tstepA = 2 * hstepA, tstepB = 2 * hstepB;
    const unsigned ldsw = (unsigned)wid * 1024u;
    const int aoff = lds_byte(wr * 64 + fr, fq * 8), boff = lds_byte(wc * 32 + fr, fq * 8);
#define PG8_SA(b, h) (((b) * 2 + (h)) * HTB)
#define PG8_SB(b, h) ((4 + (b) * 2 + (h)) * HTB)
#define PG8_STAGE(bufoff, gbase, voff) do { _Pragma("unroll") for (int _i = 0; _i < 2; ++_i) \
        __builtin_amdgcn_global_load_lds((const unsigned*)((const char*)(gbase) + (voff)[_i]), (PG8_LAS unsigned*)(lds + (bufoff) + ldsw + _i * 8192), 16, 0, 0); } while (0)
#define PG8_LDA(dst, b, h) do { _Pragma("unroll") for (int m = 0; m < 4; ++m) _Pragma("unroll") for (int k = 0; k < 2; ++k) dst[m][k] = *(const PG8_LAS bf16x8*)(lds + PG8_SA(b, h) + aoff + m * 2048 + k * 1024); } while (0)
#define PG8_LDB(dst, b, h) do { _Pragma("unroll") for (int n = 0; n < 2; ++n) _Pragma("unroll") for (int k = 0; k < 2; ++k) dst[n][k] = *(const PG8_LAS bf16x8*)(lds + PG8_SB(b, h) + boff + n * 2048 + k * 1024); } while (0)
#define PG8_MMA(ai, bj, At, Bt) do { __builtin_amdgcn_s_setprio(1); _Pragma("unroll") for (int m = 0; m < 4; ++m) _Pragma("unroll") for (int n = 0; n < 2; ++n) _Pragma("unroll") for (int k = 0; k < 2; ++k) \
        acc[ai][bj][m][n] = __builtin_amdgcn_mfma_f32_16x16x32_bf16(Bt[n][k], At[m][k], acc[ai][bj][m][n], 0, 0, 0); __builtin_amdgcn_s_setprio(0); } while (0)
#define PG8_WAIT_V(n) asm volatile("s_waitcnt vmcnt(" #n ")" ::: "memory")
#define PG8_WAIT_L(n) asm volatile("s_waitcnt lgkmcnt(" #n ")" ::: "memory")
#define PG8_BAR __builtin_amdgcn_s_barrier()
#define PG8_SCHED __builtin_amdgcn_sched_barrier(0)
    Unit cur, nxt; int ui = 0;
    if (!S.next(0, cur)) return;
    f32x4 acc[2][2][4][2];
#pragma unroll
    for (int a = 0; a < 2; ++a)
#pragma unroll
        for (int b = 0; b < 2; ++b)
#pragma unroll
            for (int m = 0; m < 4; ++m)
#pragma unroll
                for (int n = 0; n < 2; ++n) acc[a][b][m][n] = (f32x4){0.f, 0.f, 0.f, 0.f};
    bf16x8 At[4][2], B0[2][2], B1[2][2];
    const char* cA = (const char*)g.A + (size_t)cur.pm * tstepA; const char* cB = (const char*)g.Bt + (size_t)cur.pn * tstepB;
    S.a_ready(cur);
    if constexpr (SP2) {
        PG8_STAGE(PG8_SB(0, 0), cB, voffB); PG8_STAGE(PG8_SB(0, 1), cB + hstepB, voffB); PG8_STAGE(PG8_SA(0, 0), cA, voffA); PG8_STAGE(PG8_SA(0, 1), cA + hstepA, voffA);
        if (wr == 1) PG8_BAR;
        PG8_WAIT_V(2); PG8_BAR;
        PG8_STAGE(PG8_SB(1, 0), cB + kstepB, voffB); PG8_STAGE(PG8_SA(1, 0), cA + kstep, voffA); PG8_STAGE(PG8_SB(1, 1), cB + hstepB + kstepB, voffB);
        PG8_WAIT_V(6); PG8_BAR;
    } else {
        PG8_STAGE(PG8_SB(0, 0), cB, voffB); PG8_STAGE(PG8_SA(0, 0), cA, voffA); PG8_STAGE(PG8_SB(0, 1), cB + hstepB, voffB); PG8_STAGE(PG8_SA(0, 1), cA + hstepA, voffA);
        if (wr == 1) PG8_BAR;
        PG8_WAIT_V(4); PG8_BAR;
        PG8_STAGE(PG8_SB(1, 0), cB + kstepB, voffB); PG8_STAGE(PG8_SA(1, 0), cA + kstep, voffA); PG8_STAGE(PG8_SB(1, 1), cB + hstepB + kstepB, voffB);
        PG8_WAIT_V(6); PG8_BAR;
    }
    for (;;) {
        const bool has_next = S.next(ui + 1, nxt);
        const char* nA = has_next ? (const char*)g.A + (size_t)nxt.pm * tstepA : cA; const char* nB = has_next ? (const char*)g.Bt + (size_t)nxt.pn * tstepB : cB;
        for (int t = 0; t < nt; t += 2) {
            const bool last = (t == nt - 2);
            const char* a1 = cA + (size_t)(t + 1) * kstep;
            const char* a2 = last ? nA : cA + (size_t)(t + 2) * kstep; const char* b2 = last ? nB : cB + (size_t)(t + 2) * kstepB;
            const char* a3 = a2 + kstep; const char* b3 = b2 + kstepB;
            if (last && has_next) S.a_ready(nxt);
            if constexpr (SP2) {
            PG8_LDB(B0, 0, 0); PG8_LDB(B1, 0, 1); PG8_SCHED; PG8_LDA(At, 0, 0); PG8_STAGE(PG8_SA(1, 1), a1 + hstepA, voffA);
            PG8_WAIT_V(8); PG8_WAIT_L(0); PG8_BAR; PG8_MMA(0, 0, At, B0); PG8_MMA(0, 1, At, B1); PG8_BAR; PG8_SCHED;
            PG8_LDA(At, 0, 1); PG8_STAGE(PG8_SB(0, 0), b2, voffB); PG8_STAGE(PG8_SB(0, 1), b2 + hstepB, voffB); PG8_STAGE(PG8_SA(0, 0), a2, voffA);
            PG8_WAIT_V(8); PG8_WAIT_L(0); PG8_BAR; PG8_MMA(1, 0, At, B0); PG8_MMA(1, 1, At, B1); PG8_BAR; PG8_SCHED;
            PG8_LDB(B0, 1, 0); PG8_LDB(B1, 1, 1); PG8_SCHED; PG8_LDA(At, 1, 0); PG8_STAGE(PG8_SA(0, 1), a2 + hstepA, voffA);
            PG8_WAIT_V(8); PG8_WAIT_L(0); PG8_BAR; PG8_MMA(0, 0, At, B0); PG8_MMA(0, 1, At, B1); PG8_BAR; PG8_SCHED;
            PG8_LDA(At, 1, 1); PG8_STAGE(PG8_SB(1, 0), b3, voffB); PG8_STAGE(PG8_SB(1, 1), b3 + hstepB, voffB); PG8_STAGE(PG8_SA(1, 0), a3, voffA);
            PG8_WAIT_V(8); PG8_WAIT_L(0); PG8_BAR; PG8_MMA(1, 0, At, B0); PG8_MMA(1, 1, At, B1); PG8_BAR; PG8_SCHED;
            } else {
            PG8_LDB(B0, 0, 0); PG8_SCHED; PG8_LDA(At, 0, 0); PG8_STAGE(PG8_SA(1, 1), a1 + hstepA, voffA);
            PG8_WAIT_L(8); PG8_BAR; PG8_WAIT_L(0); PG8_MMA(0, 0, At, B0); PG8_BAR; PG8_SCHED;
            PG8_LDB(B1, 0, 1); PG8_STAGE(PG8_SB(0, 0), b2, voffB);
            PG8_BAR; PG8_WAIT_L(0); PG8_MMA(0, 1, At, B1); PG8_BAR;
            PG8_LDA(At, 0, 1); PG8_STAGE(PG8_SA(0, 0), a2, voffA);
            PG8_BAR; PG8_WAIT_L(0); PG8_MMA(1, 0, At, B0); PG8_BAR; PG8_SCHED;
            PG8_STAGE(PG8_SB(0, 1), b2 + hstepB, voffB);
            PG8_WAIT_V(6); PG8_BAR; PG8_MMA(1, 1, At, B1); PG8_BAR;
            PG8_LDB(B0, 1, 0); PG8_SCHED; PG8_LDA(At, 1, 0); PG8_STAGE(PG8_SA(0, 1), a2 + hstepA, voffA);
            PG8_WAIT_L(8); PG8_BAR; PG8_WAIT_L(0); PG8_MMA(0, 0, At, B0); PG8_BAR; PG8_SCHED;
            PG8_LDB(B1, 1, 1); PG8_STAGE(PG8_SB(1, 0), b3, voffB);
            PG8_BAR; PG8_WAIT_L(0); PG8_MMA(0, 1, At, B1); PG8_BAR;
            PG8_LDA(At, 1, 1); PG8_STAGE(PG8_SA(1, 0), a3, voffA);
            PG8_BAR; PG8_WAIT_L(0); PG8_MMA(1, 0, At, B0); PG8_BAR; PG8_SCHED;
            PG8_STAGE(PG8_SB(1, 1), b3 + hstepB, voffB);
            PG8_WAIT_V(6); PG8_BAR; PG8_MMA(1, 1, At, B1); PG8_BAR;
            }
        }
        if constexpr (ALIGN_EPI) { if (wr == 0) PG8_BAR; }
        if constexpr (!Epi::AFTER_DRAIN) { E(acc, cur, wr, wc, fr, fq); S.done(cur); }
        if (!has_next) break;
#pragma unroll
        for (int a = 0; a < 2; ++a)
#pragma unroll
            for (int b = 0; b < 2; ++b)
#pragma unroll
                for (int m = 0; m < 4; ++m)
#pragma unroll
                    for (int n = 0; n < 2; ++n) acc[a][b][m][n] = (f32x4){0.f, 0.f, 0.f, 0.f};
        cur = nxt; cA = nA; cB = nB; ++ui;
        if constexpr (ALIGN_EPI) { if (wr == 1) PG8_BAR; }
    }
    PG8_WAIT_V(0);
    if constexpr (!ALIGN_EPI) { if (wr == 0) PG8_BAR; }
    PG8_BAR;
    if constexpr (Epi::AFTER_DRAIN) { E.fused(acc, cur, wr, wc, fr, fq, lds, wid, lane); S.done(cur); }
#undef PG8_SA
#undef PG8_SB
#undef PG8_STAGE
#undef PG8_LDA
#undef PG8_LDB
#undef PG8_MMA
#undef PG8_WAIT_V
#undef PG8_WAIT_L
#undef PG8_BAR
#undef PG8_SCHED
}
}

constexpr int DM = 2048, SEQ = 2048, NB = 4, NS = 128, DEPTH = 2;
constexpr int MP = NB * SEQ;
constexpr int MT = MP + NS;
constexpr int MPAD = MP + 256;
constexpr int PIN = 6400, DFF = 8192, NMEM = 256, MMEM = NB * NMEM;
constexpr int PB_ = 1536, PC_ = 3584, PD_ = 5376;
constexpr int SHW = 1792;
constexpr int LDU = 8192;
constexpr int NWAVES = 8;
constexpr int NIN = 39;

constexpr size_t O_YP = 0, O_YS = O_YP + (size_t)MP * DM, O_CAP = O_YS + (size_t)NS * DM, O_CAS = O_CAP + (size_t)DEPTH * NB * 2 * 512,
    O_RETP = O_CAS + (size_t)DEPTH * NS * 2 * 512, O_RETS = O_RETP + (size_t)DEPTH * NB * 4 * 128 * 128, O_SHP = O_RETS + (size_t)DEPTH * NS * 4 * 128 * 128,
    O_SHS = O_SHP + (size_t)DEPTH * NB * SHW, O_WKVP = O_SHS + (size_t)DEPTH * NS * SHW, O_WKVS = O_WKVP + (size_t)DEPTH * NB * 8 * 64 * 64,
    O_CDP = O_WKVS + (size_t)DEPTH * NS * 8 * 64 * 64, O_CDS = O_CDP + (size_t)DEPTH * NB * 30 * 512, O_MKP = O_CDS + (size_t)DEPTH * NS * 30 * 512,
    O_MVP = O_MKP + (size_t)DEPTH * MMEM * DM, O_END = O_MVP + (size_t)DEPTH * MMEM * DM;
static_assert(O_END == 56178688, "d_out size");

constexpr size_t MiB = 1u << 20;
constexpr size_t al256(size_t x) { return (x + 255) & ~(size_t)255; }
constexpr size_t WS_CTL = 0, CTL_ZERO_BYTES = 1 * MiB;
constexpr size_t WS_ROPE = 1 * MiB;
constexpr size_t SZ_WIN = (size_t)PIN * DM * 2, SZ_SQ = (size_t)DM * DM * 2, SZ_WUP = (size_t)DFF * DM * 2, SZ_WDN = (size_t)DM * LDU * 2;
constexpr size_t LW_IN = 0, LW_OUT = LW_IN + SZ_WIN, LW_Q = LW_OUT + SZ_SQ, LW_O = LW_Q + SZ_SQ, LW_UP = LW_O + SZ_SQ, LW_DN = LW_UP + SZ_WUP,
    LW_W2 = LW_DN + SZ_WDN, LW_A2 = LW_W2 + 512 * 64 * 2, LW_G2 = LW_A2 + 512 * 64 * 2, LW_STRIDE = LW_G2 + 512 * 128 * 2;
constexpr size_t WS_WL = 4 * MiB;
constexpr size_t WS_WKV = al256(WS_WL + 2 * LW_STRIDE);
constexpr size_t WS_XF = al256(WS_WKV + (size_t)8192 * DM * 2);
constexpr size_t WS_HN = al256(WS_XF + (size_t)MT * DM * 4);
constexpr size_t WS_MN = al256(WS_HN + (size_t)MPAD * DM * 2);
constexpr size_t WS_MK = al256(WS_MN + (size_t)MMEM * DM * 2);
constexpr size_t WS_MVT = al256(WS_MK + (size_t)2 * MMEM * DM * 2);
constexpr size_t WS_P = al256(WS_MVT + (size_t)2 * MMEM * DM * 2);
constexpr size_t WS_YC = al256(WS_P + (size_t)MPAD * PIN * 2);
constexpr size_t WS_Q = al256(WS_YC + (size_t)MT * DM * 2);
constexpr size_t WS_O = al256(WS_Q + (size_t)MT * DM * 2);
constexpr size_t WS_U = al256(WS_O + (size_t)MT * DM * 2);
constexpr size_t WS_RW = al256(WS_U + (size_t)MT * LDU * 2);
constexpr size_t WS_GATE = al256(WS_RW + (size_t)MT * 8 * 896);
constexpr size_t WS_OC = al256(WS_GATE + (size_t)MT * 512 * 4);
constexpr size_t WS_KVT = al256(WS_OC + (size_t)MT * 512 * 4);
constexpr size_t WS_SSQ = al256(WS_KVT + (size_t)16 * 16 * 128 * 128 * 4);
constexpr size_t WS_SPL = al256(WS_SSQ + (size_t)MP * 8 * 4);
constexpr size_t WS_STB = al256(WS_SPL + (size_t)2 * NS * DM * 4);
constexpr size_t WS_CK = al256(WS_STB + (size_t)16 * 16 * 128 * 128 * 2);
constexpr size_t WS_CP = al256(WS_CK + (size_t)4096 * 6912);
constexpr int DMS = DM + 128, LDUS = LDU + 128;
constexpr size_t WS_HNS = al256(WS_CP + (size_t)4096 * 4 * 3072);
constexpr size_t WS_OS = al256(WS_HNS + (size_t)NS * DMS * 2);
constexpr size_t WS_US = al256(WS_OS + (size_t)NS * DMS * 2);
constexpr size_t WS_END = al256(WS_US + (size_t)NS * LDUS * 2);
static_assert(WS_END < (size_t)1700 * MiB, "d_ws map");
constexpr int CW_BAR = 4096;

constexpr int SCR_BYTES = 147456;
constexpr int MISC_OFF = SCR_BYTES;
constexpr int LDS_BYTES = SCR_BYTES + 1024;

#define GAS __attribute__((address_space(1)))
#define LAS __attribute__((address_space(3)))
typedef unsigned short bf16;
typedef unsigned v4u __attribute__((ext_vector_type(4)));
typedef unsigned v2u __attribute__((ext_vector_type(2)));
typedef float f32x4 __attribute__((ext_vector_type(4)));
typedef float f32x2 __attribute__((ext_vector_type(2)));
typedef short bf16x8 __attribute__((ext_vector_type(8)));
typedef short bf16x4 __attribute__((ext_vector_type(4)));
typedef GAS unsigned gu32;
#define RLX_AGENT __ATOMIC_RELAXED, __HIP_MEMORY_SCOPE_AGENT
#define LDS_WAIT() asm volatile("s_waitcnt lgkmcnt(0)" ::: "memory")
#define VM_WAIT() asm volatile("s_waitcnt vmcnt(0)" ::: "memory")
__device__ __forceinline__ unsigned pk2(float lo, float hi) { return pg8::cvt_pk_bf16(lo, hi); }
__device__ __forceinline__ float bflo(unsigned w) { return __uint_as_float(w << 16); }
__device__ __forceinline__ float bfhi(unsigned w) { return __uint_as_float(w & 0xffff0000u); }
__device__ __forceinline__ float bf1(bf16 h) { return __uint_as_float(((unsigned)h) << 16); }
__device__ __forceinline__ void unpack8(const v4u w, float (&f)[8]) { f[0] = bflo(w.x); f[1] = bfhi(w.x); f[2] = bflo(w.y); f[3] = bfhi(w.y); f[4] = bflo(w.z); f[5] = bfhi(w.z); f[6] = bflo(w.w); f[7] = bfhi(w.w); }
__device__ __forceinline__ void unpack4(const v2u w, float (&f)[4]) { f[0] = bflo(w.x); f[1] = bfhi(w.x); f[2] = bflo(w.y); f[3] = bfhi(w.y); }
__device__ __forceinline__ v4u pack8(const float (&f)[8]) { v4u w; w.x = pk2(f[0], f[1]); w.y = pk2(f[2], f[3]); w.z = pk2(f[4], f[5]); w.w = pk2(f[6], f[7]); return w; }
__device__ __forceinline__ float sigm(float x) { return 1.0f / (1.0f + __expf(-x)); }
__device__ __forceinline__ float wave_sum(float v) {
#pragma unroll
    for (int o = 1; o < 64; o <<= 1) v += __shfl_xor(v, o);
    return v;
}
__device__ __forceinline__ float wave_max(float v) {
#pragma unroll
    for (int o = 1; o < 64; o <<= 1) v = fmaxf(v, __shfl_xor(v, o));
    return v;
}
template <int CTRL> __device__ __forceinline__ float dpp_f(float v) { return __builtin_bit_cast(float, __builtin_amdgcn_update_dpp(0, __builtin_bit_cast(int, v), CTRL, 0xf, 0xf, false)); }
__device__ __forceinline__ f32x4 zero4() { float z0, z1, z2, z3; asm volatile("v_mov_b32 %0, 0\n\tv_mov_b32 %1, 0\n\tv_mov_b32 %2, 0\n\tv_mov_b32 %3, 0\n\ts_nop 1" : "=v"(z0), "=v"(z1), "=v"(z2), "=v"(z3)); return (f32x4){z0, z1, z2, z3}; }
__device__ __forceinline__ float rowsum16(float v) { v += dpp_f<0x128>(v); v += dpp_f<0x124>(v); v += dpp_f<0x122>(v); v += dpp_f<0x121>(v); return v; }

namespace pg8 {
template <int ACT> struct EpiBf16A {
    static constexpr bool PERM = true, AFTER_DRAIN = false;
    bf16_t* O; int ldc; const float* ssq;
    __device__ __forceinline__ void operator()(const f32x4 (&acc)[2][2][4][2], const Unit& u, int wr, int wc, int fr, int fq) const {
        const int row0 = u.pm * BM + wr * 64 + fr, col0 = u.pn * BM + wc * 32 + 8 * fq;
#pragma unroll
        for (int ai = 0; ai < 2; ++ai)
#pragma unroll
            for (int m = 0; m < 4; ++m) { bf16_t* rowp = O + (size_t)(row0 + ai * HALF + m * 16) * ldc + col0;
                const float rs = ssq ? 1.0f / sqrtf(ssq[row0 + ai * HALF + m * 16] * (1.0f / 2048.0f) + 1e-6f) : 1.0f;
#pragma unroll
                for (int bj = 0; bj < 2; ++bj) { f32x4 v0 = acc[ai][bj][m][0] * rs, v1 = acc[ai][bj][m][1] * rs;
                    if (ACT == 3) {
#pragma unroll
                        for (int j = 0; j < 4; ++j) { const float a = fmaxf(v0[j], 0.f), b = fmaxf(v1[j], 0.f); v0[j] = a * a; v1[j] = b * b; } }
                    u32x4 w; w.x = cvt_pk_bf16(v0[0], v0[1]); w.y = cvt_pk_bf16(v0[2], v0[3]); w.z = cvt_pk_bf16(v1[0], v1[1]); w.w = cvt_pk_bf16(v1[2], v1[3]);
                    *(u32x4*)(rowp + bj * HALF) = w; } }
    }
};
struct EpiRes {
    static constexpr bool PERM = false, AFTER_DRAIN = false;
    float* X; int ldc; float sc; const float* Xin;
    __device__ __forceinline__ void operator()(const f32x4 (&acc)[2][2][4][2], const Unit& u, int wr, int wc, int fr, int fq) const {
        const int row0 = u.pm * BM + wr * 64 + fr, col0 = u.pn * BM + wc * 32 + 4 * fq;
#pragma unroll
        for (int ai = 0; ai < 2; ++ai)
#pragma unroll
            for (int m = 0; m < 4; ++m) { float* rowp = X + (size_t)(row0 + ai * HALF + m * 16) * ldc + col0; const float* inp = Xin + (size_t)(row0 + ai * HALF + m * 16) * ldc + col0;
                f32x4 o[2][2];
#pragma unroll
                for (int bj = 0; bj < 2; ++bj)
#pragma unroll
                    for (int n = 0; n < 2; ++n) o[bj][n] = *(const f32x4*)(inp + bj * HALF + n * 16);
#pragma unroll
                for (int bj = 0; bj < 2; ++bj)
#pragma unroll
                    for (int n = 0; n < 2; ++n) *(f32x4*)(rowp + bj * HALF + n * 16) = o[bj][n] + acc[ai][bj][m][n] * sc; }
    }
};
struct EpiMemKV {
    static constexpr bool PERM = false, AFTER_DRAIN = false;
    float* outK; bf16_t* MKb; bf16_t* MVT;
    __device__ __forceinline__ void operator()(const f32x4 (&acc)[2][2][4][2], const Unit& u, int wr, int wc, int fr, int fq) const {
        const int cbase = u.pn * BM, lyr = cbase >> 12, cc = cbase & 4095; const bool isV = cc >= 2048; const int colt = cc & 2047;
        const int row0 = u.pm * BM + wr * 64 + fr, col0 = colt + wc * 32 + 4 * fq;
        float* outp = outK + (isV ? (size_t)(O_MVP - O_MKP) : (size_t)0);
#pragma unroll
        for (int ai = 0; ai < 2; ++ai)
#pragma unroll
            for (int m = 0; m < 4; ++m) { const int r = row0 + ai * HALF + m * 16;
#pragma unroll
                for (int bj = 0; bj < 2; ++bj)
#pragma unroll
                    for (int n = 0; n < 2; ++n) { const int col = col0 + bj * HALF + n * 16; const f32x4 v = acc[ai][bj][m][n];
                        *(f32x4*)(outp + ((size_t)lyr * 1024 + r) * 2048 + col) = v;
                        if (!isV) { unsigned lo = cvt_pk_bf16(v[0], v[1]), hi = cvt_pk_bf16(v[2], v[3]); *(unsigned long long*)(MKb + ((size_t)lyr * 1024 + r) * 2048 + col) = ((unsigned long long)hi << 32) | lo; }
                        else { const int b = r >> 8, j = r & 255, h = col >> 9, e = col & 511; bf16_t* tp = MVT + ((((size_t)lyr * 4 + b) * 4 + h) * 512 + e) * 256 + j;
                            const unsigned lo = cvt_pk_bf16(v[0], v[1]), hi = cvt_pk_bf16(v[2], v[3]);
                            tp[0] = (bf16_t)(lo & 0xffffu); tp[256] = (bf16_t)(lo >> 16); tp[512] = (bf16_t)(hi & 0xffffu); tp[768] = (bf16_t)(hi >> 16); } } }
    }
};
}

struct SEpiBf16 { bf16* O; int ldc; int act; const float* ssq;
    __device__ __forceinline__ void operator()(int row, int col0, f32x4 v, int) const {
        if (ssq) v = v * (1.0f / sqrtf(ssq[row] * (1.0f / 2048.0f) + 1e-6f));
        if (act == 3) {
#pragma unroll
            for (int j = 0; j < 4; ++j) { const float a = fmaxf(v[j], 0.f); v[j] = a * a; } }
        v2u w; w.x = pk2(v[0], v[1]); w.y = pk2(v[2], v[3]); *(v2u*)(O + (size_t)row * ldc + col0) = w; } };
struct SEpiRes { float* X; int ldc; float sc; const float* Xin;
    __device__ __forceinline__ void operator()(int row, int col0, f32x4 v, int) const { *(f32x4*)(X + (size_t)row * ldc + col0) = *(const f32x4*)(Xin + (size_t)row * ldc + col0) + v * sc; } };
struct SEpiPart { float* S; int ldc;
    __device__ __forceinline__ void operator()(int row, int col0, f32x4 v, int kp) const { *(f32x4*)(S + ((size_t)kp * NS + row) * ldc + col0) = v; } };
template <class F> __device__ __forceinline__ void sample_gemm(LAS unsigned char* lds, int tid_in, const bf16* A, int lda, const bf16* Bt, int ntot, int N, int K, int G, int bid, const F& epi, int nks = 1) {
    int tid_ = tid_in; asm volatile("" : "+v"(tid_));
    const int lane = tid_ & 63, wave = __builtin_amdgcn_readfirstlane(tid_ >> 6), fr = lane & 15, fq = lane >> 4;
    const int KS = (K / nks) >> 3, ncu = N / 16;
    LAS f32x4* red = (LAS f32x4*)lds;
    const unsigned voffa = (unsigned)(fr * lda + fq * 8) * 2u, voffb = (unsigned)(fr * 64 + fq * 8) * 2u;
    for (int uu = bid; uu < ncu * nks; uu += G) { const int kp = uu / ncu, u = uu - kp * ncu, kbeg = kp * (K / nks) + wave * KS;
        const char* bp = (const char*)(Bt + ((size_t)(kbeg >> 6) * ntot + u * 16) * 64);
        const char* ap = (const char*)(A + kbeg);
        f32x4 acc[8];
#pragma unroll
        for (int rt = 0; rt < 8; ++rt) acc[rt] = zero4();
        bf16x8 b0[2], a0[2][8], b1[2], a1[2][8];
#define SG_LOAD(bb, aa, kq) do { _Pragma("unroll") for (int s = 0; s < 2; ++s) { bb[s] = *(const bf16x8*)(bp + ((size_t)((kq) >> 6) * ntot * 64 + 32 * s) * 2 + voffb); \
            _Pragma("unroll") for (int rt = 0; rt < 8; ++rt) aa[s][rt] = *(const bf16x8*)(ap + ((size_t)rt * 16 * lda + (kq) + 32 * s) * 2 + voffa); } } while (0)
#define SG_MMA(bb, aa) do { _Pragma("unroll") for (int s = 0; s < 2; ++s) _Pragma("unroll") for (int rt = 0; rt < 8; ++rt) acc[rt] = __builtin_amdgcn_mfma_f32_16x16x32_bf16(bb[s], aa[s][rt], acc[rt], 0, 0, 0); } while (0)
        SG_LOAD(b0, a0, 0);
        for (int k0 = 0; k0 < KS; k0 += 128) {
            __builtin_amdgcn_sched_barrier(0);
            SG_LOAD(b1, a1, k0 + 64);
            __builtin_amdgcn_sched_barrier(0);
            SG_MMA(b0, a0);
            __builtin_amdgcn_sched_barrier(0);
            if (k0 + 128 < KS) SG_LOAD(b0, a0, k0 + 128);
            __builtin_amdgcn_sched_barrier(0);
            SG_MMA(b1, a1);
        }
        __builtin_amdgcn_sched_barrier(0);
#undef SG_LOAD
#undef SG_MMA
#pragma unroll
        for (int rt = 0; rt < 8; ++rt) red[(wave * 8 + rt) * 64 + lane] = acc[rt];
        __syncthreads();
        f32x4 sum = red[wave * 64 + lane];
#pragma unroll
        for (int ks = 1; ks < 8; ++ks) sum += red[(ks * 8 + wave) * 64 + lane];
        epi(wave * 16 + fr, u * 16 + 4 * fq, sum, kp);
        __syncthreads();
    }
}
#define XB_TMO      128
#define XB_XCNT(j)  (256  + 64 * (j))
#define XB_XSUB(j)  (1280 + 64 * (j))
#define XB_XGEN(j)  (2304 + 64 * (j))
#define XB_TOP      3328
#define XB_TOPGEN   3392
#define XCD_BAR_WORDS 3456
#define XB_SPIN_CAP (1u << 18)

__device__ __forceinline__ unsigned xb_ld(unsigned* p)              { return __hip_atomic_load(p, __ATOMIC_RELAXED, __HIP_MEMORY_SCOPE_AGENT); }
__device__ __forceinline__ unsigned xb_add(unsigned* p, unsigned v) { return __hip_atomic_fetch_add(p, v, __ATOMIC_RELAXED, __HIP_MEMORY_SCOPE_AGENT); }
__device__ __forceinline__ unsigned xb_xcc_id() { return (unsigned)__builtin_amdgcn_s_getreg((3 << 11) | 20) & 0xFu; }
#define XB_SPIN(cond, bar) do { unsigned _sp = 0; while (cond) { __builtin_amdgcn_s_sleep(1); \
    if ((++_sp & 255u) == 0u) { if (xb_ld(&(bar)[XB_TMO])) break; if (_sp > XB_SPIN_CAP) { atomicAdd(&(bar)[XB_TMO], 1u); break; } } } } while (0)

struct XcdBarrier {
    int wave;
    unsigned* bar; unsigned x;
    volatile LAS unsigned* st;
};

__device__ __forceinline__ XcdBarrier xcd_barrier_post(unsigned* bar, volatile LAS unsigned* st) {
    XcdBarrier b; b.bar = bar; b.x = xb_xcc_id(); b.st = st;
    if (threadIdx.x == 0) (void)xb_add(&bar[XB_XCNT(b.x)], 1u);
    return b;
}
__device__ __forceinline__ void xcd_barrier_complete(unsigned* bar, unsigned x, unsigned& nloc, unsigned& nx) {
    const unsigned G = gridDim.x * gridDim.y * gridDim.z;
    unsigned sum, cnt, mine, sp = 0u;
    for (;;) {
        sum = 0u; cnt = 0u; mine = 0u;
#pragma unroll
        for (unsigned j = 0; j < 16; ++j) { const unsigned c = xb_ld(&bar[XB_XCNT(j)]); sum += c; cnt += (c > 0u) ? 1u : 0u; mine = (j == x) ? c : mine; }
        if (sum == G) break;
        __builtin_amdgcn_s_sleep(1);
        if ((++sp & 255u) == 0u) { if (xb_ld(&bar[XB_TMO])) break; if (sp > XB_SPIN_CAP) { atomicAdd(&bar[XB_TMO], 1u); break; } }
    }
    nloc = mine > 0u ? mine : 1u; nx = cnt > 0u ? cnt : 1u;
}

__device__ __forceinline__ void xcd_barrier(const XcdBarrier& b) {
    asm volatile("s_waitcnt vmcnt(0)" ::: "memory");
    __syncthreads();
    unsigned xbz = 0u; asm volatile("" : "+v"(xbz));
    if (b.wave == 0 && __builtin_amdgcn_mbcnt_hi(~0u, __builtin_amdgcn_mbcnt_lo(~0u, xbz)) == 0u) {
        unsigned* bar = b.bar;
        __builtin_amdgcn_s_waitcnt(0);
        unsigned nloc = b.st[0], nx = b.st[1];
        if (nloc == 0u) { xcd_barrier_complete(bar, b.x, nloc, nx); b.st[0] = nloc; b.st[1] = nx; }
        const unsigned old = xb_add(&bar[XB_XSUB(b.x)], 1u);
        const unsigned gen = old / nloc;
        if (old + 1u == (gen + 1u) * nloc) {
            __builtin_amdgcn_fence(__ATOMIC_RELEASE, "agent");
            asm volatile("s_waitcnt vmcnt(0)" ::: "memory");
            const unsigned og = xb_add(&bar[XB_TOP], 1u);
            const unsigned tg = og / nx;
            if (og + 1u == (tg + 1u) * nx) xb_add(&bar[XB_TOPGEN], 1u);
            else XB_SPIN(xb_ld(&bar[XB_TOPGEN]) == tg, bar);
            __builtin_amdgcn_fence(__ATOMIC_ACQUIRE, "agent");
            xb_add(&bar[XB_XGEN(b.x)], 1u);
            asm volatile("s_waitcnt vmcnt(0)" ::: "memory");
        } else {
            XB_SPIN(xb_ld(&bar[XB_XGEN(b.x)]) == gen, bar);
            __builtin_amdgcn_fence(__ATOMIC_ACQUIRE, "agent");
            asm volatile("s_waitcnt vmcnt(0)" ::: "memory");
        }
    }
    __syncthreads();
}

struct Args { const float* in[NIN]; float* out; unsigned char* ws; int ph_lo, ph_hi; };
enum { I_XP = 0, I_XS, I_MEM, I_SCA, I_SRET, I_SSH, I_SWKV, I_SCD, I_CMK, I_CMV, I_GMIX, I_WIN, I_CAW, I_MU, I_W0, I_W2, I_A0, I_A2, I_G2, I_KK, I_KA, I_RK, I_LNXG, I_LNXB,
       I_CDW, I_CDB, I_LNDG, I_LNDB, I_WOUT, I_GXA, I_GMEM, I_WQ, I_WK, I_WV, I_WO, I_GMLP, I_WUP, I_WDN, I_GFIN };

struct Ctx { LAS unsigned char* lds; int tid, lane, wave, G, bid; };
typedef const GAS float* gcfp;
#define CAS __attribute__((address_space(4)))
struct Ax { const CAS gcfp* kp; float* out; unsigned char* ws;
    __device__ __forceinline__ const float* in(int i) const { return (const float*)kp[i]; } };
__device__ __forceinline__ Ax mk_ax() { const CAS gcfp* kp = (const CAS gcfp*)__builtin_amdgcn_kernarg_segment_ptr(); asm volatile("" : "+s"(kp)); Ax a; a.kp = kp;
    a.out = (float*)(GAS float*)kp[NIN]; a.ws = (unsigned char*)(GAS unsigned char*)kp[NIN + 1]; return a; }
__device__ __forceinline__ Ctx mk_ctx(LAS unsigned char* lds, int wave_s) { unsigned z = 0u; asm volatile("" : "+v"(z)); int t = wave_s * 64 + (int)__builtin_amdgcn_mbcnt_hi(~0u, __builtin_amdgcn_mbcnt_lo(~0u, z)); Ctx C; C.lds = lds; C.tid = t; C.lane = t & 63; C.wave = __builtin_amdgcn_readfirstlane(t >> 6); C.G = gridDim.x; C.bid = blockIdx.x; return C; }

__device__ __forceinline__ void p0_transpose_item(const float* W, int K, int N, bf16* WT, int ldk, int row_off, LAS float* scr, int item, int lane, const float* gain) {
    const int nblk = N / 64, kb = item / nblk, nb = item - kb * nblk, k0 = 64 * kb, n0 = 64 * nb;
    const int lr = lane >> 4, lc = (lane & 15) * 4;
#pragma unroll 8
    for (int i = 0; i < 16; ++i) { const int kk = 4 * i + lr; const float g = gain ? gain[k0 + kk] : 1.0f; const f32x4 v = *(const f32x4*)(W + (size_t)(k0 + kk) * N + n0 + lc);
        LAS float* d = scr + kk * 65 + lc; d[0] = v.x * g; d[1] = v.y * g; d[2] = v.z * g; d[3] = v.w * g; }
    LDS_WAIT(); asm volatile("" ::: "memory");
    const int c = lane & 7;
#pragma unroll
    for (int j = 0; j < 8; ++j) { const int n = (lane >> 3) + 8 * j; const LAS float* s = scr + (8 * c) * 65 + n;
        v4u o; o.x = pk2(s[0 * 65], s[1 * 65]); o.y = pk2(s[2 * 65], s[3 * 65]); o.z = pk2(s[4 * 65], s[5 * 65]); o.w = pk2(s[6 * 65], s[7 * 65]);
        if (ldk > 0) *(v4u*)(WT + (size_t)(row_off + n0 + n) * ldk + k0 + 8 * c) = o;
        else *(v4u*)(WT + ((size_t)kb * (size_t)(-ldk) + row_off + n0 + n) * 64 + 8 * c) = o; }
    LDS_WAIT(); asm volatile("" ::: "memory");
}
__device__ __forceinline__ void rms_row(const float* xrow, bf16* orow, float* xcopy, int lane) {
    const f32x4* xr = (const f32x4*)xrow + lane;
    f32x4 v[8]; float s = 0.f;
#pragma unroll
    for (int j = 0; j < 8; ++j) { v[j] = xr[64 * j]; s += (v[j].x * v[j].x + v[j].y * v[j].y) + (v[j].z * v[j].z + v[j].w * v[j].w); }
    const float rs = 1.0f / sqrtf(wave_sum(s) * (1.0f / DM) + 1e-6f);
    if (xcopy) {
#pragma unroll
        for (int j = 0; j < 8; ++j) ((f32x4*)xcopy + lane)[64 * j] = v[j]; }
    unsigned long long* o8 = (unsigned long long*)orow + lane;
#pragma unroll
    for (int j = 0; j < 8; ++j) o8[64 * j] = (unsigned long long)pk2(v[j].x * rs, v[j].y * rs) | ((unsigned long long)pk2(v[j].z * rs, v[j].w * rs) << 32);
}
__device__ __forceinline__ void rms_phase(const Ctx& C, const float* X, bf16* HN, bf16* HNS) {
    const int gw = C.bid * NWAVES + C.wave, NGW = C.G * NWAVES;
    f32x4 v[8], nx[8]; int m = gw;
    if (m < MT) { const f32x4* xr = (const f32x4*)(X + (size_t)m * DM) + C.lane;
#pragma unroll
        for (int j = 0; j < 8; ++j) v[j] = xr[64 * j]; }
    for (; m < MT; m += NGW) {
        const int mn = m + NGW;
        if (mn < MT) { const f32x4* xr = (const f32x4*)(X + (size_t)mn * DM) + C.lane;
#pragma unroll
            for (int j = 0; j < 8; ++j) nx[j] = xr[64 * j]; }
        float s = 0.f;
#pragma unroll
        for (int j = 0; j < 8; ++j) s += (v[j].x * v[j].x + v[j].y * v[j].y) + (v[j].z * v[j].z + v[j].w * v[j].w);
        const float rs = 1.0f / sqrtf(wave_sum(s) * (1.0f / DM) + 1e-6f);
        unsigned long long* o8 = (unsigned long long*)((HNS && m >= MP) ? HNS + (size_t)(m - MP) * DMS : HN + (size_t)m * DM) + C.lane;
#pragma unroll
        for (int j = 0; j < 8; ++j) o8[64 * j] = (unsigned long long)pk2(v[j].x * rs, v[j].y * rs) | ((unsigned long long)pk2(v[j].z * rs, v[j].w * rs) << 32);
#pragma unroll
        for (int j = 0; j < 8; ++j) v[j] = nx[j];
    }
}
__device__ __forceinline__ void fold_split_rows(const Ctx& C, float* X, const float* S) {
    const int gw = C.bid * NWAVES + C.wave, NGW = C.G * NWAVES;
    for (int r = gw; r < NS; r += NGW) { f32x4* xr = (f32x4*)(X + (size_t)(MP + r) * DM) + C.lane; const f32x4* s0 = (const f32x4*)(S + (size_t)r * DM) + C.lane; const f32x4* s1 = (const f32x4*)(S + (size_t)(NS + r) * DM) + C.lane;
#pragma unroll
        for (int j = 0; j < 8; ++j) xr[64 * j] = xr[64 * j] + (s0[64 * j] + s1[64 * j]); }
    asm volatile("s_waitcnt vmcnt(0)" ::: "memory");
}
__device__ __forceinline__ void final_norm_phase(const Ctx& C, const float* X, const float* g, float* out) {
    const int gw = C.bid * NWAVES + C.wave, NGW = C.G * NWAVES;
    for (int m = gw; m < MT; m += NGW) {
        const f32x4* xr = (const f32x4*)(X + (size_t)m * DM) + C.lane; const f32x4* gr = (const f32x4*)g + C.lane;
        f32x4 v[8]; float s = 0.f;
#pragma unroll
        for (int j = 0; j < 8; ++j) { v[j] = xr[64 * j]; s += (v[j].x * v[j].x + v[j].y * v[j].y) + (v[j].z * v[j].z + v[j].w * v[j].w); }
        const float rs = 1.0f / sqrtf(wave_sum(s) * (1.0f / DM) + 1e-6f);
        f32x4* orow = (f32x4*)(out + (size_t)m * DM) + C.lane;
#pragma unroll
        for (int j = 0; j < 8; ++j) orow[64 * j] = v[j] * rs * gr[64 * j];
    }
}
#ifndef LATE_EXTRA
#define LATE_EXTRA 0
#endif
struct TDesc { const float* W; const float* gain; bf16* WT; int K, N, ldk, row_off, item; };
__device__ __forceinline__ TDesc p0_desc(const Ax& a, int it, int G) {
    constexpr int I_IN = 32 * 100, I_SQ = 32 * 32, I_UP = 32 * 128, I_DN = 128 * 32, I_L64 = 8, I_L128 = 16;
    constexpr int PER_LAYER = I_IN + 5 * I_SQ + I_UP + I_DN + 2 * I_L64 + I_L128;
    const int l = it / PER_LAYER; int r = it - l * PER_LAYER; unsigned char* wl = a.ws + WS_WL + (size_t)l * LW_STRIDE; bf16* wkv = (bf16*)(a.ws + WS_WKV);
    TDesc d; d.row_off = 0; d.gain = nullptr; const bool late = G == 256 && DEPTH == 2, late1 = late && l == 1 && LATE_EXTRA;
    if (r < I_IN) { d.W = a.in(I_WIN) + (size_t)l * DM * PIN; d.K = DM; d.N = PIN; d.WT = (bf16*)(wl + LW_IN); d.ldk = -PIN; d.gain = a.in(I_GMIX) + l * DM; d.item = r; return d; } r -= I_IN;
    if (r < I_SQ) { d.W = a.in(I_WOUT) + (size_t)l * DM * DM; d.K = DM; d.N = DM; d.WT = (bf16*)(wl + LW_OUT); d.ldk = -DM; d.item = late1 ? -1 : r; return d; } r -= I_SQ;
    if (r < I_SQ) { d.W = a.in(I_WQ) + (size_t)l * DM * DM; d.K = DM; d.N = DM; d.WT = (bf16*)(wl + LW_Q); d.ldk = -DM; d.gain = a.in(I_GXA) + l * DM; d.item = late1 ? -1 : r; return d; } r -= I_SQ;
    if (r < I_SQ) { d.W = a.in(I_WO) + (size_t)l * DM * DM; d.K = DM; d.N = DM; d.WT = (bf16*)(wl + LW_O); d.ldk = -DM; d.item = late1 ? -1 : r; return d; } r -= I_SQ;
    if (r < I_SQ) { d.W = a.in(I_WK) + (size_t)l * DM * DM; d.K = DM; d.N = DM; d.WT = wkv; d.ldk = -8192; d.row_off = l * 4096; d.gain = a.in(I_GMEM) + l * DM; d.item = late1 ? -1 : r; return d; } r -= I_SQ;
    if (r < I_SQ) { d.W = a.in(I_WV) + (size_t)l * DM * DM; d.K = DM; d.N = DM; d.WT = wkv; d.ldk = -8192; d.row_off = l * 4096 + 2048; d.gain = a.in(I_GMEM) + l * DM; d.item = late1 ? -1 : r; return d; } r -= I_SQ;
    if (r < I_UP) { d.W = a.in(I_WUP) + (size_t)l * DM * DFF; d.K = DM; d.N = DFF; d.WT = (bf16*)(wl + LW_UP); d.ldk = -DFF; d.gain = a.in(I_GMLP) + l * DM; d.item = late ? -1 : r; return d; } r -= I_UP;
    if (r < I_DN) { d.W = a.in(I_WDN) + (size_t)l * DFF * DM; d.K = DFF; d.N = DM; d.WT = (bf16*)(wl + LW_DN); d.ldk = -DM; d.item = late ? -1 : r; return d; } r -= I_DN;
    if (r < I_L64) { d.W = a.in(I_W2) + (size_t)l * 64 * 512; d.K = 64; d.N = 512; d.WT = (bf16*)(wl + LW_W2); d.ldk = 64; d.item = r; return d; } r -= I_L64;
    if (r < I_L64) { d.W = a.in(I_A2) + (size_t)l * 64 * 512; d.K = 64; d.N = 512; d.WT = (bf16*)(wl + LW_A2); d.ldk = 64; d.item = r; return d; } r -= I_L64;
    d.W = a.in(I_G2) + (size_t)l * 128 * 512; d.K = 128; d.N = 512; d.WT = (bf16*)(wl + LW_G2); d.ldk = 128; d.item = r; return d;
}
__device__ __forceinline__ void p0_load(const TDesc& d, int lane, f32x4 (&v)[16], float (&g)[16]) {
    if (d.item < 0) return;
    const int nblk = d.N / 64, kb = d.item / nblk, nb = d.item - kb * nblk, k0 = 64 * kb, n0 = 64 * nb, lr = lane >> 4, lc = (lane & 15) * 4;
#pragma unroll
    for (int i = 0; i < 16; ++i) { const int kk = 4 * i + lr; g[i] = d.gain ? d.gain[k0 + kk] : 1.0f; v[i] = __builtin_nontemporal_load((const f32x4*)(d.W + (size_t)(k0 + kk) * d.N + n0 + lc)); }
}
__device__ __forceinline__ void p0_finish(const TDesc& d, LAS float* scr, int lane, const f32x4 (&v)[16], const float (&g)[16]) {
    if (d.item < 0) return;
    const int nblk = d.N / 64, kb = d.item / nblk, nb = d.item - kb * nblk, k0 = 64 * kb, n0 = 64 * nb, lr = lane >> 4, lc = (lane & 15) * 4;
#pragma unroll
    for (int i = 0; i < 16; ++i) { const int kk = 4 * i + lr; LAS float* p = scr + kk * 65 + lc; p[0] = v[i].x * g[i]; p[1] = v[i].y * g[i]; p[2] = v[i].z * g[i]; p[3] = v[i].w * g[i]; }
    LDS_WAIT(); asm volatile("" ::: "memory");
    const int c = lane & 7;
#pragma unroll
    for (int j = 0; j < 8; ++j) { const int n = (lane >> 3) + 8 * j; const LAS float* s = scr + (8 * c) * 65 + n;
        v4u o; o.x = pk2(s[0 * 65], s[1 * 65]); o.y = pk2(s[2 * 65], s[3 * 65]); o.z = pk2(s[4 * 65], s[5 * 65]); o.w = pk2(s[6 * 65], s[7 * 65]);
        if (d.ldk > 0) *(v4u*)(d.WT + (size_t)(d.row_off + n0 + n) * d.ldk + k0 + 8 * c) = o;
        else *(v4u*)(d.WT + ((size_t)kb * (size_t)(-d.ldk) + d.row_off + n0 + n) * 64 + 8 * c) = o; }
    LDS_WAIT(); asm volatile("" ::: "memory");
}
__device__ __forceinline__ void p0_prologue(const Ctx& C, const Ax& a) {
    LAS float* scr = (LAS float*)(C.lds + C.wave * 16640);
    const int gw = C.bid * NWAVES + C.wave, NGW = C.G * NWAVES;
    constexpr int I_IN = 32 * 100, I_SQ = 32 * 32, I_UP = 32 * 128, I_DN = 128 * 32, I_L64 = 8, I_L128 = 16;
    constexpr int PER_LAYER = I_IN + 5 * I_SQ + I_UP + I_DN + 2 * I_L64 + I_L128;
    TDesc cur = p0_desc(a, gw, C.G), nxt; f32x4 va[16], vb[16]; float ga[16], gb[16];
    const int NITEMS = DEPTH * PER_LAYER;
    if (gw < NITEMS) p0_load(cur, C.lane, va, ga);
    for (int it = gw; it < NITEMS; it += 2 * NGW) {
        const int it1 = it + NGW, it2 = it + 2 * NGW;
        if (it1 < NITEMS) { nxt = p0_desc(a, it1, C.G); p0_load(nxt, C.lane, vb, gb); }
        p0_finish(cur, scr, C.lane, va, ga);
        if (it1 < NITEMS) { if (it2 < NITEMS) { cur = p0_desc(a, it2, C.G); p0_load(cur, C.lane, va, ga); }
            p0_finish(nxt, scr, C.lane, vb, gb); }
    }
    { float* cs = (float*)(a.ws + WS_ROPE); const int gt = C.bid * (NWAVES * 64) + C.tid, NT = C.G * NWAVES * 64;
      for (int idx = gt; idx < 2049 * 64; idx += NT) { const int p = idx >> 6, i = idx & 63; const double pos = (p == 2048) ? 16384.0 : (double)p;
          const double inv = exp(-(double)i * (9.210340371976184 / 64.0)); double r = pos * inv; r -= 6.283185307179586 * rint(r * 0.15915494309189535);
          cs[2 * idx] = (float)cos(r); cs[2 * idx + 1] = (float)sin(r); } }
    float* XF = (float*)(a.ws + WS_XF); bf16* HN = (bf16*)(a.ws + WS_HN); bf16* MN = (bf16*)(a.ws + WS_MN);
    for (int m = gw; m < MT; m += NGW) { const float* src = (m < MP) ? a.in(I_XP) + (size_t)m * DM : a.in(I_XS) + (size_t)(m - MP) * DM; rms_row(src, HN + (size_t)m * DM, nullptr, C.lane); }
    for (int m = gw; m < MMEM; m += NGW) rms_row(a.in(I_MEM) + (size_t)m * DM, MN + (size_t)m * DM, nullptr, C.lane);
}

__device__ __forceinline__ TDesc lc_desc(const Ax& a, int l, int it) {
    constexpr int I_UP = 32 * 128, I_DN = 128 * 32, I_SQ = 32 * 32;
    unsigned char* wl = a.ws + WS_WL + (size_t)l * LW_STRIDE; TDesc d; d.row_off = 0; d.gain = nullptr;
    if (it < I_UP) { d.W = a.in(I_WUP) + (size_t)l * DM * DFF; d.K = DM; d.N = DFF; d.WT = (bf16*)(wl + LW_UP); d.ldk = -DFF; d.gain = a.in(I_GMLP) + l * DM; d.item = it; return d; }
    int r = it - I_UP;
    if (r < I_DN) { d.W = a.in(I_WDN) + (size_t)l * DFF * DM; d.K = DFF; d.N = DM; d.WT = (bf16*)(wl + LW_DN); d.ldk = -DM; d.item = r; return d; } r -= I_DN;
    d.K = DM; d.N = DM; d.item = r & (I_SQ - 1); const int q = r >> 10;
    if (l == 0) { const int l1 = 1; d.W = a.in(q == 0 ? I_WK : I_WV) + (size_t)l1 * DM * DM; d.WT = (bf16*)(a.ws + WS_WKV); d.ldk = -8192; d.row_off = l1 * 4096 + q * 2048; d.gain = a.in(I_GMEM) + l1 * DM; return d; }
    d.ldk = -DM;
    if (q == 0) { d.W = a.in(I_WOUT) + (size_t)l * DM * DM; d.WT = (bf16*)(wl + LW_OUT); }
    else if (q == 1) { d.W = a.in(I_WQ) + (size_t)l * DM * DM; d.WT = (bf16*)(wl + LW_Q); d.gain = a.in(I_GXA) + l * DM; }
    else { d.W = a.in(I_WO) + (size_t)l * DM * DM; d.WT = (bf16*)(wl + LW_O); }
    return d;
}
__device__ __forceinline__ void late_convert(const Ctx& C, const Ax& a, int l, int rank, int nrank) {
    LAS float* scr = (LAS float*)(C.lds + C.wave * 16640);
    const int NITEMS = 32 * 128 + 128 * 32 + (LATE_EXTRA ? (l == 0 ? 2 : 3) * 1024 : 0);
    const int gw = rank * NWAVES + C.wave, NGW = nrank * NWAVES;
    TDesc cur, nxt; f32x4 va[16], vb[16]; float ga[16], gb[16];
    if (gw < NITEMS) { cur = lc_desc(a, l, gw); p0_load(cur, C.lane, va, ga); }
    for (int it = gw; it < NITEMS; it += 2 * NGW) {
        const int it1 = it + NGW, it2 = it + 2 * NGW;
        if (it1 < NITEMS) { nxt = lc_desc(a, l, it1); p0_load(nxt, C.lane, vb, gb); }
        p0_finish(cur, scr, C.lane, va, ga);
        if (it1 < NITEMS) { if (it2 < NITEMS) { cur = lc_desc(a, l, it2); p0_load(cur, C.lane, va, ga); }
            p0_finish(nxt, scr, C.lane, vb, gb); }
    }
}
__device__ __forceinline__ void ad_prompt_item(const Ctx& C, const Ax& a, int l, int item) {
    const bf16* P = (const bf16*)(a.ws + WS_P); bf16* YC = (bf16*)(a.ws + WS_YC);
    const int b = item >> 6, t0 = (item & 63) * 32; const size_t rbase = (size_t)b * SEQ;
    LAS float* UD = (LAS float*)C.lds;
    { v4u r1[8], r2[8];
#pragma unroll
      for (int u = 0; u < 8; ++u) { const int it = C.tid + u * (NWAVES * 64), r = it >> 6, cc = it & 63, t = t0 - 30 + r; r1[u] = (v4u){0u, 0u, 0u, 0u}; r2[u] = r1[u];
        if (it < 62 * 64 && t >= 0) { const bf16* pr = P + (rbase + t) * PIN + PD_ + cc * 8; r1[u] = *(const v4u*)pr; r2[u] = *(const v4u*)(pr + 512); } }
      __builtin_amdgcn_sched_barrier(0);
#pragma unroll
      for (int u = 0; u < 8; ++u) { const int it = C.tid + u * (NWAVES * 64), r = it >> 6, cc = it & 63;
        if (it < 62 * 64) { float d1[8], d2[8], uu[8]; unpack8(r1[u], d1); unpack8(r2[u], d2);
#pragma unroll
            for (int j = 0; j < 8; ++j) uu[j] = d1[j] * sigm(d2[j]);
            *(LAS f32x4*)(UD + r * 512 + cc * 8) = (f32x4){uu[0], uu[1], uu[2], uu[3]}; *(LAS f32x4*)(UD + r * 512 + cc * 8 + 4) = (f32x4){uu[4], uu[5], uu[6], uu[7]}; } } }
    __builtin_amdgcn_sched_barrier(0);
    { const int cc = C.tid & 63; const float* cw = a.in(I_CAW) + (size_t)l * 3 * 512 + cc * 8;
      const f32x4 w0a = *(const f32x4*)cw, w0b = *(const f32x4*)(cw + 4), w1a = *(const f32x4*)(cw + 512), w1b = *(const f32x4*)(cw + 516), w2a = *(const f32x4*)(cw + 1024), w2b = *(const f32x4*)(cw + 1028);
      const float k0[8] = {w0a.x, w0a.y, w0a.z, w0a.w, w0b.x, w0b.y, w0b.z, w0b.w}, k1[8] = {w1a.x, w1a.y, w1a.z, w1a.w, w1b.x, w1b.y, w1b.z, w1b.w}, k2[8] = {w2a.x, w2a.y, w2a.z, w2a.w, w2b.x, w2b.y, w2b.z, w2b.w};
#pragma unroll
      for (int hb = 0; hb < 2; ++hb) { v4u q[2][7];
#pragma unroll
        for (int u = 0; u < 2; ++u) { const int r = (C.tid >> 6) + (hb * 2 + u) * NWAVES, t = t0 + r; const bf16* pr = P + (rbase + t) * PIN + cc * 8;
#pragma unroll
            for (int z = 0; z < 7; ++z) q[u][z] = (v4u){0u, 0u, 0u, 0u};
            q[u][0] = *(const v4u*)pr; q[u][1] = *(const v4u*)(pr + 512); q[u][2] = *(const v4u*)(pr + 1024);
            if (t >= 1) { q[u][3] = *(const v4u*)(pr - PIN + 512); q[u][4] = *(const v4u*)(pr - PIN + 1024); }
            if (t >= 2) { q[u][5] = *(const v4u*)(pr - 2 * PIN + 512); q[u][6] = *(const v4u*)(pr - 2 * PIN + 1024); } }
        __builtin_amdgcn_sched_barrier(0);
#pragma unroll
        for (int u = 0; u < 2; ++u) { const int r = (C.tid >> 6) + (hb * 2 + u) * NWAVES, t = t0 + r;
            float ab[8], u0[8], u1[8], u2[8], x[8], y[8];
            unpack8(q[u][0], ab); unpack8(q[u][1], x); unpack8(q[u][2], y);
#pragma unroll
            for (int j = 0; j < 8; ++j) u2[j] = x[j] * y[j];
            unpack8(q[u][3], x); unpack8(q[u][4], y);
#pragma unroll
            for (int j = 0; j < 8; ++j) u1[j] = x[j] * y[j];
            unpack8(q[u][5], x); unpack8(q[u][6], y);
#pragma unroll
            for (int j = 0; j < 8; ++j) u0[j] = x[j] * y[j];
            float o[8];
#pragma unroll
            for (int j = 0; j < 8; ++j) o[j] = ab[j] * (k0[j] * u0[j] + k1[j] * u1[j] + k2[j] * u2[j]);
            *(v4u*)(YC + (rbase + t) * DM + cc * 8) = pack8(o);
            if (t >= SEQ - 2) { float* st = a.out + O_CAP + (((size_t)l * NB + b) * 2 + (t - (SEQ - 2))) * 512 + cc * 8; *(f32x4*)st = (f32x4){u2[0], u2[1], u2[2], u2[3]}; *(f32x4*)(st + 4) = (f32x4){u2[4], u2[5], u2[6], u2[7]}; } }
        __builtin_amdgcn_sched_barrier(0); } }
    __syncthreads();
    const int c = C.tid;
    if (t0 == SEQ - 32) { float* st = a.out + O_CDP + ((size_t)l * NB + b) * 30 * 512 + c;
        for (int j = 0; j < 30; ++j) st[(size_t)j * 512] = UD[(32 + j) * 512 + c]; }
    float cv[32];
    { const char* cwb = (const char*)(a.in(I_CDW) + (size_t)l * 31 * 512); const unsigned cof = (unsigned)c * 4u; const float bias = a.in(I_CDB)[l * 512 + c];
      float wt[31];
#pragma unroll
      for (int j = 0; j < 31; ++j) wt[j] = *(const float*)(cwb + (cof + (unsigned)j * 2048u));
      __builtin_amdgcn_sched_barrier(0);
#pragma unroll
      for (int t = 0; t < 32; ++t) cv[t] = bias;
#pragma unroll
      for (int r = 0; r < 62; ++r) { const float ur = UD[r * 512 + c];
#pragma unroll
          for (int t = 0; t < 32; ++t) { const int j = r - t; if (j >= 0 && j < 31) cv[t] += wt[j] * ur; } } }
    __syncthreads();
#pragma unroll
    for (int t = 0; t < 32; ++t) UD[t * 512 + c] = cv[t];
    __syncthreads();
    { const float* lg = a.in(I_LNDG) + l * 512 + C.lane * 8; const float* lb = a.in(I_LNDB) + l * 512 + C.lane * 8;
      const f32x4 g0 = *(const f32x4*)lg, g1 = *(const f32x4*)(lg + 4), b0 = *(const f32x4*)lb, b1 = *(const f32x4*)(lb + 4);
#pragma unroll
      for (int q = 0; q < 4; ++q) { const int t = C.wave * 4 + q; const f32x4 x0 = *(LAS f32x4*)(UD + t * 512 + C.lane * 8), x1 = *(LAS f32x4*)(UD + t * 512 + C.lane * 8 + 4);
        const float mu = wave_sum((x0.x + x0.y) + (x0.z + x0.w) + (x1.x + x1.y) + (x1.z + x1.w)) * (1.0f / 512.0f);
        const f32x4 d0 = x0 - mu, d1 = x1 - mu;
        const float var = wave_sum((d0.x * d0.x + d0.y * d0.y) + (d0.z * d0.z + d0.w * d0.w) + (d1.x * d1.x + d1.y * d1.y) + (d1.z * d1.z + d1.w * d1.w)) * (1.0f / 512.0f);
        const float rstd = 1.0f / sqrtf(var + 1e-6f);
        const f32x4 y0 = d0 * rstd * g0 + b0, y1 = d1 * rstd * g1 + b1; float o[8];
        o[0] = y0.x * sigm(y0.x); o[1] = y0.y * sigm(y0.y); o[2] = y0.z * sigm(y0.z); o[3] = y0.w * sigm(y0.w);
        o[4] = y1.x * sigm(y1.x); o[5] = y1.y * sigm(y1.y); o[6] = y1.z * sigm(y1.z); o[7] = y1.w * sigm(y1.w);
        *(v4u*)(YC + (rbase + t0 + t) * DM + 1536 + C.lane * 8) = pack8(o); } }
    __syncthreads();
}
__device__ __forceinline__ void ad_sample_item(const Ctx& C, const Ax& a, int l, int n) {
    const bf16* P = (const bf16*)(a.ws + WS_P); bf16* YC = (bf16*)(a.ws + WS_YC);
    const int c = C.tid; const bf16* pr = P + (size_t)(MP + n) * PIN;
    LAS float* red = (LAS float*)C.lds;
    { const float* st = a.in(I_SCA) + (((size_t)l * NS + n) * 2) * 512 + c; const float s0 = st[0], s1 = st[512];
      const float ua = bf1(pr[512 + c]) * bf1(pr[1024 + c]); const float* cw = a.in(I_CAW) + (size_t)l * 3 * 512 + c;
      const float y = bf1(pr[c]) * (cw[0] * s0 + cw[512] * s1 + cw[1024] * ua);
      YC[(size_t)(MP + n) * DM + c] = (bf16)(pk2(y, 0.f) & 0xffffu);
      float* o = a.out + O_CAS + (((size_t)l * NS + n) * 2) * 512 + c; o[0] = s1; o[512] = ua; }
    const float* st = a.in(I_SCD) + (((size_t)l * NS + n) * 30) * 512 + c; const float* cw = a.in(I_CDW) + (size_t)l * 31 * 512 + c;
    const float ud = bf1(pr[PD_ + c]) * sigm(bf1(pr[PD_ + 512 + c]));
    float cv = a.in(I_CDB)[l * 512 + c] + cw[30 * 512] * ud;
    float* os = a.out + O_CDS + (((size_t)l * NS + n) * 30) * 512 + c;
#pragma unroll 6
    for (int j = 0; j < 30; ++j) { const float s = st[(size_t)j * 512]; cv += cw[(size_t)j * 512] * s; if (j > 0) os[(size_t)(j - 1) * 512] = s; }
    os[29 * 512] = ud;
    float s = wave_sum(cv); if (C.lane == 0) red[C.wave] = s; __syncthreads();
    float mu = 0.f;
#pragma unroll
    for (int w = 0; w < 8; ++w) mu += red[w];
    mu *= (1.0f / 512.0f); const float d = cv - mu;
    s = wave_sum(d * d); if (C.lane == 0) red[8 + C.wave] = s; __syncthreads();
    float var = 0.f;
#pragma unroll
    for (int w = 0; w < 8; ++w) var += red[8 + w];
    const float rstd = 1.0f / sqrtf(var * (1.0f / 512.0f) + 1e-6f);
    const float y = d * rstd * a.in(I_LNDG)[l * 512 + c] + a.in(I_LNDB)[l * 512 + c];
    YC[(size_t)(MP + n) * DM + 1536 + c] = (bf16)(pk2(y * sigm(y), 0.f) & 0xffffu);
    __syncthreads();
}

__device__ __forceinline__ void shift8(const bf16* cur, const bf16* prevb, const float* prevf, const float* mu, float (&xs)[8]) {
    float pc[8], pv[8]; unpack8(*(const v4u*)cur, pc);
    if (prevb) unpack8(*(const v4u*)prevb, pv);
    else if (prevf) { const f32x4 p0 = *(const f32x4*)prevf, p1 = *(const f32x4*)(prevf + 4); pv[0] = p0.x; pv[1] = p0.y; pv[2] = p0.z; pv[3] = p0.w; pv[4] = p1.x; pv[5] = p1.y; pv[6] = p1.z; pv[7] = p1.w; }
    else {
#pragma unroll
        for (int j = 0; j < 8; ++j) pv[j] = 0.f; }
    const f32x4 m0 = *(const f32x4*)mu, m1 = *(const f32x4*)(mu + 4); const float m[8] = {m0.x, m0.y, m0.z, m0.w, m1.x, m1.y, m1.z, m1.w};
#pragma unroll
    for (int j = 0; j < 8; ++j) xs[j] = pc[j] + (pv[j] - pc[j]) * m[j];
}
__device__ __forceinline__ void shift4(const bf16* cur, const bf16* prevb, const float* prevf, const float* mu, float (&xs)[4]) {
    float pc[4], pv[4]; unpack4(*(const v2u*)cur, pc);
    if (prevb) unpack4(*(const v2u*)prevb, pv);
    else if (prevf) { const f32x4 p0 = *(const f32x4*)prevf; pv[0] = p0.x; pv[1] = p0.y; pv[2] = p0.z; pv[3] = p0.w; }
    else { pv[0] = pv[1] = pv[2] = pv[3] = 0.f; }
    const f32x4 m0 = *(const f32x4*)mu;
    xs[0] = pc[0] + (pv[0] - pc[0]) * m0.x; xs[1] = pc[1] + (pv[1] - pc[1]) * m0.y; xs[2] = pc[2] + (pv[2] - pc[2]) * m0.z; xs[3] = pc[3] + (pv[3] - pc[3]) * m0.w;
}
constexpr int PTS = 1544;
__device__ __forceinline__ void shift4_lds(const LAS bf16* cur, const float* mu, float (&xs)[4]) {
    float pc[4], pv[4]; unpack4(*(const LAS v2u*)cur, pc); unpack4(*(const LAS v2u*)(cur - PTS), pv);
    const f32x4 m0 = *(const f32x4*)mu;
    xs[0] = pc[0] + (pv[0] - pc[0]) * m0.x; xs[1] = pc[1] + (pv[1] - pc[1]) * m0.y; xs[2] = pc[2] + (pv[2] - pc[2]) * m0.z; xs[3] = pc[3] + (pv[3] - pc[3]) * m0.w;
}
constexpr int RWB = 896, RW_KK = 256, RW_KB = 384, RW_K = 512, RW_R = 640, RW_V = 768;
__device__ __forceinline__ void rw_st4(unsigned char* rec, int off, int cl, const f32x4 v) { v2u w; w.x = pk2(v[0], v[1]); w.y = pk2(v[2], v[3]); *(v2u*)(rec + off + cl * 2) = w; }
__device__ __forceinline__ f32x4 rw_ld4(const unsigned char* rec, int off, int cl) { float f[4]; unpack4(*(const v2u*)(rec + off + cl * 2), f); return (f32x4){f[0], f[1], f[2], f[3]}; }
#ifndef DUP_SUB
#define DUP_SUB 0u
#endif
#define PREP_REP(k) for (int prep_rep_ = 0; prep_rep_ < 1 + (int)((DUP_SUB >> (k)) & 1u); ++prep_rep_)
__device__ __forceinline__ void rwkv_prep_item(const Ctx& C, const Ax& a, int l, int item, int t2sel = -1) {
    const bf16* P = (const bf16*)(a.ws + WS_P); float* RW = (float*)(a.ws + WS_RW); float* GATE = (float*)(a.ws + WS_GATE);
    const bool smp = item >= 256; const int row0 = smp ? MP + (item - 256) * 32 : (item >> 6) * SEQ + (item & 63) * 32; const int t0 = smp ? 0 : (item & 63) * 32;
    const float* mu = a.in(I_MU) + (size_t)l * SHW; const float* sst = a.in(I_SSH) + (size_t)l * NS * SHW;
    LAS bf16* AW = (LAS bf16*)C.lds; LAS bf16* AA = AW + 32 * 72; LAS bf16* AG = AA + 32 * 72; LAS bf16* PT = AG + 32 * 136;
    for (int it = C.tid; it < 32 * 32; it += NWAVES * 64) { const int r = it >> 5, cc = it & 31, col = 1536 + cc * 8, row = row0 + r; const bf16* cur = P + (size_t)row * PIN + PC_ + col;
        float xs[8];
        if (smp) shift8(cur, nullptr, sst + (size_t)(row - MP) * SHW + col, mu + col, xs);
        else shift8(cur, (t0 + r > 0) ? cur - PIN : nullptr, nullptr, mu + col, xs);
        if (cc < 8) {
#pragma unroll
            for (int j = 0; j < 8; ++j) xs[j] = tanhf(xs[j]);
            *(LAS v4u*)(AW + r * 72 + cc * 8) = pack8(xs); }
        else if (cc < 16) *(LAS v4u*)(AA + r * 72 + (cc - 8) * 8) = pack8(xs);
        else {
#pragma unroll
            for (int j = 0; j < 8; ++j) xs[j] = sigm(xs[j]);
            *(LAS v4u*)(AG + r * 136 + (cc - 16) * 8) = pack8(xs); } }
    if (!smp) { for (int it = C.tid; it < 33 * 192; it += NWAVES * 64) { const int r = it / 192, cc = it - r * 192; v4u v = (v4u){0u, 0u, 0u, 0u};
            if (t0 + r > 0) v = *(const v4u*)(P + (size_t)(row0 + r - 1) * PIN + PC_ + cc * 8);
            *(LAS v4u*)(PT + r * PTS + cc * 8) = v; } }
    if (smp) { float* o = a.out + O_SHS + ((size_t)l * NS + (row0 - MP)) * SHW;
        for (int it = C.tid + (t2sel > 0 ? 16 * 224 : 0); it < (t2sel == 0 ? 16 : 32) * 224; it += NWAVES * 64) { const int r = it / 224, cc = it % 224; float f[8]; unpack8(*(const v4u*)(P + (size_t)(row0 + r) * PIN + PC_ + cc * 8), f);
            float* op = o + (size_t)r * SHW + cc * 8; *(f32x4*)op = (f32x4){f[0], f[1], f[2], f[3]}; *(f32x4*)(op + 4) = (f32x4){f[4], f[5], f[6], f[7]}; } }
    else if (t0 == SEQ - 32) { float* o = a.out + O_SHP + ((size_t)l * NB + (item >> 6)) * SHW;
        for (int cc = C.tid; cc < 224; cc += NWAVES * 64) { float f[8]; unpack8(*(const v4u*)(P + (size_t)(row0 + 31) * PIN + PC_ + cc * 8), f);
            *(f32x4*)(o + cc * 8) = (f32x4){f[0], f[1], f[2], f[3]}; *(f32x4*)(o + cc * 8 + 4) = (f32x4){f[4], f[5], f[6], f[7]}; } }
    __syncthreads();
    const int h = C.wave, fr = C.lane & 15, fq = C.lane >> 4;
    const unsigned char* wl = a.ws + WS_WL + (size_t)l * LW_STRIDE;
    const bf16* W2t = (const bf16*)(wl + LW_W2); const bf16* A2t = (const bf16*)(wl + LW_A2); const bf16* G2t = (const bf16*)(wl + LW_G2);
    PREP_REP(23) { constexpr int tp = 0;
        f32x4 acc[4][2];
#pragma unroll
        for (int ct = 0; ct < 4; ++ct)
#pragma unroll
            for (int t2 = 0; t2 < 2; ++t2) acc[ct][t2] = zero4();
#pragma unroll
        for (int ks = 0; ks < 2; ++ks) { bf16x8 af[2], wf[4];
#pragma unroll
            for (int t2 = 0; t2 < 2; ++t2) af[t2] = *(const LAS bf16x8*)(AA + (tp * 32 + t2 * 16 + fr) * 72 + ks * 32 + fq * 8);
#pragma unroll
            for (int ct = 0; ct < 4; ++ct) wf[ct] = *(const bf16x8*)(A2t + (size_t)(h * 64 + ct * 16 + fr) * 64 + ks * 32 + fq * 8);
#pragma unroll
            for (int ct = 0; ct < 4; ++ct)
#pragma unroll
                for (int t2 = 0; t2 < 2; ++t2) acc[ct][t2] = __builtin_amdgcn_mfma_f32_16x16x32_bf16(wf[ct], af[t2], acc[ct][t2], 0, 0, 0); }
        const float* a0 = a.in(I_A0) + l * 512; const float* kkw = a.in(I_KK) + l * 512; const float* kaw = a.in(I_KA) + l * 512;
#pragma unroll
        for (int t2 = 0; t2 < 2; ++t2) { if (t2sel >= 0 && t2 != t2sel) continue; const int r = tp * 32 + t2 * 16 + fr, row = row0 + r; const bf16* prow = P + (size_t)row * PIN + PC_;
            const float* pf = smp ? sst + (size_t)(row - MP) * SHW : nullptr;
            float kkr[4][4], av[4][4], kc[4][4]; float ss = 0.f;
#pragma unroll
            for (int ct = 0; ct < 4; ++ct) { const int ch = h * 64 + ct * 16 + fq * 4; const f32x4 a0v = *(const f32x4*)(a0 + ch), kkv = *(const f32x4*)(kkw + ch);
                float xs[4]; if (smp) shift4(prow + 512 + ch, nullptr, pf + 512 + ch, mu + 512 + ch, xs); else shift4_lds(PT + (r + 1) * PTS + 512 + ch, mu + 512 + ch, xs);
#pragma unroll
                for (int j = 0; j < 4; ++j) { av[ct][j] = sigm(a0v[j] + acc[ct][t2][j]); kc[ct][j] = xs[j]; kkr[ct][j] = xs[j] * kkv[j]; ss += kkr[ct][j] * kkr[ct][j]; } }
            ss += __shfl_xor(ss, 16); ss += __shfl_xor(ss, 32);
            const float inv = 1.0f / fmaxf(sqrtf(ss), 1e-12f);
            unsigned char* rw = (unsigned char*)RW + ((size_t)row * 8 + h) * RWB;
#pragma unroll
            for (int ct = 0; ct < 4; ++ct) { const int ch = h * 64 + ct * 16 + fq * 4, cl = ct * 16 + fq * 4; const f32x4 kav = *(const f32x4*)(kaw + ch);
                f32x4 kk, kb, k4;
#pragma unroll
                for (int j = 0; j < 4; ++j) { kk[j] = kkr[ct][j] * inv; kb[j] = kk[j] * av[ct][j]; k4[j] = kc[ct][j] * (1.0f + (av[ct][j] - 1.0f) * kav[j]); }
                rw_st4(rw, RW_KK, cl, kk); rw_st4(rw, RW_KB, cl, kb); rw_st4(rw, RW_K, cl, k4);
                float xr[4], xv[4];
                if (smp) { shift4(prow + ch, nullptr, pf + ch, mu + ch, xr); shift4(prow + 1024 + ch, nullptr, pf + 1024 + ch, mu + 1024 + ch, xv); }
                else { shift4_lds(PT + (r + 1) * PTS + ch, mu + ch, xr); shift4_lds(PT + (r + 1) * PTS + 1024 + ch, mu + 1024 + ch, xv); }
                rw_st4(rw, RW_R, cl, (f32x4){xr[0], xr[1], xr[2], xr[3]}); rw_st4(rw, RW_V, cl, (f32x4){xv[0], xv[1], xv[2], xv[3]}); } }
    }
    PREP_REP(24) { constexpr int tp = 0;
        f32x4 acc[4][2];
#pragma unroll
        for (int ct = 0; ct < 4; ++ct)
#pragma unroll
            for (int t2 = 0; t2 < 2; ++t2) acc[ct][t2] = zero4();
#pragma unroll
        for (int ks = 0; ks < 2; ++ks) { bf16x8 af[2], wf[4];
#pragma unroll
            for (int t2 = 0; t2 < 2; ++t2) af[t2] = *(const LAS bf16x8*)(AW + (tp * 32 + t2 * 16 + fr) * 72 + ks * 32 + fq * 8);
#pragma unroll
            for (int ct = 0; ct < 4; ++ct) wf[ct] = *(const bf16x8*)(W2t + (size_t)(h * 64 + ct * 16 + fr) * 64 + ks * 32 + fq * 8);
#pragma unroll
            for (int ct = 0; ct < 4; ++ct)
#pragma unroll
                for (int t2 = 0; t2 < 2; ++t2) acc[ct][t2] = __builtin_amdgcn_mfma_f32_16x16x32_bf16(wf[ct], af[t2], acc[ct][t2], 0, 0, 0); }
        const float* w0 = a.in(I_W0) + l * 512;
#pragma unroll
        for (int t2 = 0; t2 < 2; ++t2) { if (t2sel >= 0 && t2 != t2sel) continue; const int row = row0 + tp * 32 + t2 * 16 + fr; float* rw = (float*)((unsigned char*)RW + ((size_t)row * 8 + h) * RWB);
#pragma unroll
            for (int ct = 0; ct < 4; ++ct) { const int ch = h * 64 + ct * 16 + fq * 4, cl = ct * 16 + fq * 4; const f32x4 w0v = *(const f32x4*)(w0 + ch); f32x4 d;
#pragma unroll
                for (int j = 0; j < 4; ++j) { const float z = -(w0v[j] + acc[ct][t2][j]); const float sp = fmaxf(z, 0.f) + __logf(1.0f + __expf(-fabsf(z))); const float w = -sp - 0.5f; d[j] = -__expf(w); }
                *(f32x4*)(rw + cl) = d; } }
    }
    PREP_REP(25) { constexpr int tp = 0;
        f32x4 acc[4][2];
#pragma unroll
        for (int ct = 0; ct < 4; ++ct)
#pragma unroll
            for (int t2 = 0; t2 < 2; ++t2) acc[ct][t2] = zero4();
#pragma unroll
        for (int ks = 0; ks < 4; ++ks) { bf16x8 af[2], wf[4];
#pragma unroll
            for (int t2 = 0; t2 < 2; ++t2) af[t2] = *(const LAS bf16x8*)(AG + (tp * 32 + t2 * 16 + fr) * 136 + ks * 32 + fq * 8);
#pragma unroll
            for (int ct = 0; ct < 4; ++ct) wf[ct] = *(const bf16x8*)(G2t + (size_t)(h * 64 + ct * 16 + fr) * 128 + ks * 32 + fq * 8);
#pragma unroll
            for (int ct = 0; ct < 4; ++ct)
#pragma unroll
                for (int t2 = 0; t2 < 2; ++t2) acc[ct][t2] = __builtin_amdgcn_mfma_f32_16x16x32_bf16(wf[ct], af[t2], acc[ct][t2], 0, 0, 0); }
#pragma unroll
        for (int t2 = 0; t2 < 2; ++t2) { if (t2sel >= 0 && t2 != t2sel) continue; const int row = row0 + tp * 32 + t2 * 16 + fr;
#pragma unroll
            for (int ct = 0; ct < 4; ++ct) *(f32x4*)(GATE + (size_t)row * 512 + h * 64 + ct * 16 + fq * 4) = acc[ct][t2]; }
    }
    __syncthreads();
}

#define PACK8(arr, o) ((v4u){pk2((arr)[(o)], (arr)[(o) + 1]), pk2((arr)[(o) + 2], (arr)[(o) + 3]), pk2((arr)[(o) + 4], (arr)[(o) + 5]), pk2((arr)[(o) + 6], (arr)[(o) + 7])})
constexpr int WK_LDS = 18432, WK_SHR = 6912, WK_PRV = 3072;
__device__ __forceinline__ f32x4 mfma16(bf16x4 a, bf16x4 b, f32x4 c) { return __builtin_amdgcn_mfma_f32_16x16x16bf16_1k(a, b, c, 0, 0, 0); }
__device__ __forceinline__ bf16 bfr1(float x) { return (bf16)(pk2(x, 0.f) & 0xffffu); }
__device__ __forceinline__ void wkv_chunk_witem(const Ctx& C, const Ax& a, int ci) {
    const float* RW = (const float*)(a.ws + WS_RW);
    unsigned char* CK = a.ws + WS_CK + (size_t)ci * WK_SHR; unsigned char* CP = a.ws + WS_CP + (size_t)ci * 4 * WK_PRV;
    const int bh = ci >> 7, c = ci & 127, b = bh >> 3, h = bh & 7, lane = C.lane, fr = lane & 15, fq = lane >> 4;
    LAS unsigned char* Lb = C.lds + C.wave * WK_LDS;
    LAS bf16* TA = (LAS bf16*)Lb; LAS bf16* TB = TA + 16 * 72; LAS bf16* TK = TB + 16 * 72; LAS bf16* TR = TK + 16 * 72; LAS bf16* VT = TR + 16 * 72;
    LAS float* M1 = (LAS float*)(Lb + 12288); LAS float* M2 = M1 + 320; LAS float* N1 = M2 + 320; LAS float* N2 = N1 + 320;
    LAS bf16* TG = TA; LAS bf16* PST = TK;
    const unsigned char* rw = (const unsigned char*)RW + (((size_t)b * SEQ + c * 16) * 8 + h) * RWB;
#define RWF(t) (*(const float*)(rw + (size_t)(t) * (8 * RWB) + lane * 4))
#define RWH(t, off) bf1(*(const bf16*)(rw + (size_t)(t) * (8 * RWB) + (off) + lane * 2))
    float lam[16];
#pragma unroll
    for (int t = 0; t < 16; ++t) lam[t] = RWF(t);
    __builtin_amdgcn_sched_barrier(0);
#pragma unroll
    for (int t = 1; t < 16; ++t) lam[t] += lam[t - 1];
    const float lamT = lam[15];
    ((float*)CK)[lane] = __expf(lamT);
    float Bp[16], Kp[16], al[16], ro[16];
    bf16* ATg = (bf16*)(CK + 256); bf16* OMg = (bf16*)(CK + 256 + 2304);
#define RWR(t, off) (*(const bf16*)(rw + (size_t)(t) * (8 * RWB) + (off) + lane * 2))
    bf16 wkk[4], wbb[4], wkx[4], wrr[4], wvv[4];
#pragma unroll
    for (int t = 0; t < 4; ++t) { wkk[t] = RWR(t, RW_KK); wbb[t] = RWR(t, RW_KB); wkx[t] = RWR(t, RW_K); wrr[t] = RWR(t, RW_R); wvv[t] = RWR(t, RW_V); }
    __builtin_amdgcn_sched_barrier(0);
#pragma unroll
    for (int t = 0; t < 16; ++t) { const float kk = bf1(wkk[t & 3]), bb = bf1(wbb[t & 3]), kx = bf1(wkx[t & 3]), rr = bf1(wrr[t & 3]), vv = bf1(wvv[t & 3]);
        if (t + 4 < 16) { wkk[t & 3] = RWR(t + 4, RW_KK); wbb[t & 3] = RWR(t + 4, RW_KB); wkx[t & 3] = RWR(t + 4, RW_K); wrr[t & 3] = RWR(t + 4, RW_R); wvv[t & 3] = RWR(t + 4, RW_V); }
        const float ein = __expf(-lam[t]), eprev = (t ? __expf(lam[t - 1]) : 1.0f), ecur = __expf(lam[t]), erest = __expf(lamT - lam[t]);
        al[t] = kk * eprev; ro[t] = rr * ecur; Bp[t] = bb * erest; Kp[t] = kx * erest;
        const bf16 ab = bfr1(al[t]);
        TA[t * 72 + lane] = ab; TB[t * 72 + lane] = bfr1(bb * ein); TK[t * 72 + lane] = bfr1(kx * ein); TR[t * 72 + lane] = bfr1(ro[t]); VT[lane * 24 + t] = bfr1(vv);
        ATg[t * 72 + lane] = ab;
        asm volatile("" ::: "memory"); __builtin_amdgcn_sched_barrier(0); }
    LDS_WAIT(); asm volatile("" ::: "memory");
    { f32x4 g1 = zero4(), g2 = zero4(), n1 = zero4(), n2 = zero4();
#pragma unroll
      for (int ks = 0; ks < 2; ++ks) { const int o = fr * 72 + ks * 32 + fq * 8;
        const bf16x8 bf_ = *(const LAS bf16x8*)(TB + o), kf_ = *(const LAS bf16x8*)(TK + o), af_ = *(const LAS bf16x8*)(TA + o), rf_ = *(const LAS bf16x8*)(TR + o);
        g1 = __builtin_amdgcn_mfma_f32_16x16x32_bf16(bf_, af_, g1, 0, 0, 0); g2 = __builtin_amdgcn_mfma_f32_16x16x32_bf16(kf_, af_, g2, 0, 0, 0);
        n1 = __builtin_amdgcn_mfma_f32_16x16x32_bf16(bf_, rf_, n1, 0, 0, 0); n2 = __builtin_amdgcn_mfma_f32_16x16x32_bf16(kf_, rf_, n2, 0, 0, 0); }
#pragma unroll
      for (int r = 0; r < 4; ++r) { const int s_ = 4 * fq + r, o = s_ * 20 + fr;
        M1[o] = (s_ < fr) ? g1[r] : 0.f; M2[o] = (s_ < fr) ? g2[r] : 0.f; N1[o] = (s_ <= fr) ? n1[r] : 0.f; N2[o] = (s_ <= fr) ? n2[r] : 0.f; } }
    LDS_WAIT(); asm volatile("" ::: "memory");
    __builtin_amdgcn_sched_barrier(0);
#pragma unroll
    for (int s_ = 14; s_ >= 0; --s_) { float m[16];
#pragma unroll
        for (int q = 0; q < 4; ++q) { const f32x4 v = *(const LAS f32x4*)(M1 + s_ * 20 + 4 * q); m[4 * q] = v.x; m[4 * q + 1] = v.y; m[4 * q + 2] = v.z; m[4 * q + 3] = v.w; }
        float acc = Bp[s_];
#pragma unroll
        for (int t = s_ + 1; t < 16; ++t) acc -= m[t] * Bp[t];
        asm volatile("" : "+v"(acc) :: "memory"); Bp[s_] = acc; __builtin_amdgcn_sched_barrier(0); }
#pragma unroll
    for (int s_ = 0; s_ < 15; ++s_) { float m[16];
#pragma unroll
        for (int q = 0; q < 4; ++q) { const f32x4 v = *(const LAS f32x4*)(M2 + s_ * 20 + 4 * q); m[4 * q] = v.x; m[4 * q + 1] = v.y; m[4 * q + 2] = v.z; m[4 * q + 3] = v.w; }
        float acc = Kp[s_];
#pragma unroll
        for (int t = s_ + 1; t < 16; ++t) acc -= m[t] * Bp[t];
        asm volatile("" : "+v"(acc) :: "memory"); Kp[s_] = acc; __builtin_amdgcn_sched_barrier(0); }
    __builtin_amdgcn_sched_barrier(0);
    { float ng[16];
#pragma unroll
      for (int t = 0; t < 16; ++t) ng[t] = -Bp[t];
      *(v4u*)(CK + 256 + 4608 + lane * 32) = PACK8(ng, 0); *(v4u*)(CK + 256 + 4608 + lane * 32 + 16) = PACK8(ng, 8); }
    *(LAS v4u*)(TG + lane * 24) = PACK8(Kp, 0); *(LAS v4u*)(TG + lane * 24 + 8) = PACK8(Kp, 8);
    __builtin_amdgcn_sched_barrier(0);
    { float hh[16], ps[16];
#pragma unroll
      for (int s_ = 0; s_ < 16; ++s_) { hh[s_] = N1[s_ * 20 + fr]; ps[s_] = N2[s_ * 20 + fr]; }
#pragma unroll
      for (int s_ = 14; s_ >= 0; --s_) { float m[16];
#pragma unroll
        for (int q = 0; q < 4; ++q) { const f32x4 v = *(const LAS f32x4*)(M1 + s_ * 20 + 4 * q); m[4 * q] = v.x; m[4 * q + 1] = v.y; m[4 * q + 2] = v.z; m[4 * q + 3] = v.w; }
        float acc = hh[s_];
#pragma unroll
        for (int u = s_ + 1; u < 16; ++u) acc -= m[u] * hh[u];
        asm volatile("" : "+v"(acc) :: "memory"); hh[s_] = acc; __builtin_amdgcn_sched_barrier(0); }
#pragma unroll
      for (int s_ = 0; s_ < 15; ++s_) { float m[16];
#pragma unroll
        for (int q = 0; q < 4; ++q) { const f32x4 v = *(const LAS f32x4*)(M2 + s_ * 20 + 4 * q); m[4 * q] = v.x; m[4 * q + 1] = v.y; m[4 * q + 2] = v.z; m[4 * q + 3] = v.w; }
        float acc = ps[s_];
#pragma unroll
        for (int u = s_ + 1; u < 16; ++u) acc -= m[u] * hh[u];
        asm volatile("" : "+v"(acc) :: "memory"); ps[s_] = acc; __builtin_amdgcn_sched_barrier(0); }
      LDS_WAIT(); asm volatile("" ::: "memory");
#pragma unroll
      for (int s_ = 0; s_ < 16; ++s_) N1[s_ * 20 + fr] = hh[s_];
      *(LAS v4u*)(PST + fr * 24) = PACK8(ps, 0); *(LAS v4u*)(PST + fr * 24 + 8) = PACK8(ps, 8); }
    LDS_WAIT(); asm volatile("" ::: "memory");
    __builtin_amdgcn_sched_barrier(0);
#pragma unroll
    for (int s_ = 0; s_ < 16; ++s_) { float m[16];
#pragma unroll
        for (int q = 0; q < 4; ++q) { const f32x4 v = *(const LAS f32x4*)(N1 + s_ * 20 + 4 * q); m[4 * q] = v.x; m[4 * q + 1] = v.y; m[4 * q + 2] = v.z; m[4 * q + 3] = v.w; }
#pragma unroll
        for (int t = s_; t < 16; ++t) ro[t] -= m[t] * al[s_];
        asm volatile("" ::: "memory"); __builtin_amdgcn_sched_barrier(0); }
#pragma unroll
    for (int t = 0; t < 16; ++t) OMg[t * 72 + lane] = bfr1(ro[t]);
    LDS_WAIT(); asm volatile("" ::: "memory");
    __builtin_amdgcn_sched_barrier(0);
    { bf16x4 vf[4];
#pragma unroll
      for (int it = 0; it < 4; ++it) vf[it] = *(const LAS bf16x4*)(VT + (it * 16 + fr) * 24 + fq * 4);
#pragma unroll
      for (int kt = 0; kt < 4; ++kt) { const bf16x4 gf = *(const LAS bf16x4*)(TG + (kt * 16 + fr) * 24 + fq * 4);
#pragma unroll
        for (int it = 0; it < 4; ++it) { const f32x4 d = mfma16(gf, vf[it], zero4()); v2u dw; dw.x = pk2(d[0], d[1]); dw.y = pk2(d[2], d[3]); *(v2u*)(CP + it * WK_PRV + kt * 512 + lane * 8) = dw; } }
      const bf16x4 pf = *(const LAS bf16x4*)(PST + fr * 24 + fq * 4);
#pragma unroll
      for (int it = 0; it < 4; ++it) { const f32x4 o = mfma16(pf, vf[it], zero4()); *(f32x4*)(CP + it * WK_PRV + 2048 + lane * 16) = o; } }
    LDS_WAIT(); asm volatile("" ::: "memory");
}
constexpr int WQ_CH = WK_PRV + WK_SHR, WQ_SLOT = 4 * WQ_CH, WQ_PCS = WQ_CH / 16, WQ_NWL = 4 * WQ_PCS / 64;
__device__ __forceinline__ void wkv_seq_chunk(const LAS unsigned char* sp, f32x4 (&acc)[4], float* orow, int lane, int fr, int fq) {
    const LAS unsigned char* sh = sp + WK_PRV;
    bf16x8 af[2], of[2]; bf16x4 gf[4]; f32x4 wt[4], dt[4];
#pragma unroll
    for (int s = 0; s < 2; ++s) { const LAS bf16* ap = (const LAS bf16*)(sh + 256) + fr * 72 + 32 * s + 4 * fq; const v2u lo = *(const LAS v2u*)ap, hi = *(const LAS v2u*)(ap + 16);
        af[s] = __builtin_bit_cast(bf16x8, (v4u){lo.x, lo.y, hi.x, hi.y});
        const LAS bf16* op = (const LAS bf16*)(sh + 256 + 2304) + fr * 72 + 32 * s + 4 * fq; const v2u lo2 = *(const LAS v2u*)op, hi2 = *(const LAS v2u*)(op + 16);
        of[s] = __builtin_bit_cast(bf16x8, (v4u){lo2.x, lo2.y, hi2.x, hi2.y}); }
#pragma unroll
    for (int kt = 0; kt < 4; ++kt) { gf[kt] = *(const LAS bf16x4*)((const LAS bf16*)(sh + 256 + 4608) + (kt * 16 + fr) * 16 + 4 * fq);
        wt[kt] = *(const LAS f32x4*)(sh + (16 * kt + 4 * fq) * 4); { float f_[4]; unpack4(*(const LAS v2u*)(sp + kt * 512 + lane * 8), f_); dt[kt] = (f32x4){f_[0], f_[1], f_[2], f_[3]}; } }
    const f32x4 ov = *(const LAS f32x4*)(sp + 2048 + lane * 16);
    bf16x8 sbf[2];
#pragma unroll
    for (int s = 0; s < 2; ++s) { v4u w; w.x = pk2(acc[2 * s][0], acc[2 * s][1]); w.y = pk2(acc[2 * s][2], acc[2 * s][3]); w.z = pk2(acc[2 * s + 1][0], acc[2 * s + 1][1]); w.w = pk2(acc[2 * s + 1][2], acc[2 * s + 1][3]);
        sbf[s] = __builtin_bit_cast(bf16x8, w); }
    f32x4 x = zero4();
    x = __builtin_amdgcn_mfma_f32_16x16x32_bf16(af[0], sbf[0], x, 0, 0, 0); x = __builtin_amdgcn_mfma_f32_16x16x32_bf16(af[1], sbf[1], x, 0, 0, 0);
    f32x4 o = __builtin_amdgcn_mfma_f32_16x16x32_bf16(of[0], sbf[0], ov, 0, 0, 0); o = __builtin_amdgcn_mfma_f32_16x16x32_bf16(of[1], sbf[1], o, 0, 0, 0);
    v2u xw; xw.x = pk2(x[0], x[1]); xw.y = pk2(x[2], x[3]); const bf16x4 xb = __builtin_bit_cast(bf16x4, xw);
#pragma unroll
    for (int kt = 0; kt < 4; ++kt) acc[kt] = mfma16(gf[kt], xb, acc[kt] * wt[kt] + dt[kt]);
    orow[0] = o[0]; orow[512] = o[1]; orow[1024] = o[2]; orow[1536] = o[3];
}
__device__ __forceinline__ void wkv_seq_item(const Ctx& C, const Ax& a, int l, int item) {
    const int bh = item >> 2, rg = item & 3, b = bh >> 3, h = bh & 7, lane = C.lane, fr = lane & 15, fq = lane >> 4;
    const unsigned char* CK = a.ws + WS_CK + (size_t)bh * 128 * WK_SHR; const unsigned char* CP = a.ws + WS_CP + ((size_t)bh * 128 * 4 + rg) * WK_PRV;
    float* OC = (float*)(a.ws + WS_OC) + ((size_t)b * SEQ) * 512 + h * 64 + rg * 16 + fr;
#define WQ_COMPUTE(blk) do { const LAS unsigned char* sbp = C.lds + ((blk) % 3) * WQ_SLOT; \
            _Pragma("unroll 2") for (int cq = 0; cq < 4; ++cq) wkv_seq_chunk(sbp + cq * WQ_CH, acc, OC + (size_t)(((blk) * 4 + cq) * 16 + 4 * fq) * 512, lane, fr, fq); } while (0)
    static_assert(4 * WQ_PCS == WQ_NWL * 64 && WQ_NWL > 35 && WQ_NWL <= 42 && 3 * WQ_SLOT <= SCR_BYTES, "ring geometry");
    if (C.wave == 0) {
        f32x4 acc[4];
#pragma unroll
        for (int kt = 0; kt < 4; ++kt) acc[kt] = zero4();
        __builtin_amdgcn_s_barrier(); asm volatile("" ::: "memory");
        for (int blk = 0; blk < 32; ++blk) { WQ_COMPUTE(blk); asm volatile("s_waitcnt lgkmcnt(0)" ::: "memory"); __builtin_amdgcn_s_barrier(); asm volatile("" ::: "memory"); }
        float* so = a.out + O_WKVP + ((((size_t)l * NB + b) * 8 + h) * 64 + rg * 16 + fr) * 64 + 4 * fq;
#pragma unroll
        for (int kt = 0; kt < 4; ++kt) *(f32x4*)(so + 16 * kt) = acc[kt];
    } else {
        const int w1 = C.wave - 1; const bool seven = (w1 + 35) < WQ_NWL;
        const unsigned char* wsb = a.ws; unsigned qoff[6], qstr[6];
#pragma unroll
        for (int i = 0; i < 6; ++i) { const int p = (w1 + 7 * i) * 64 + lane, cq = p / WQ_PCS, q = p - cq * WQ_PCS; const bool pr = q < WK_PRV / 16;
            qoff[i] = pr ? (unsigned)(WS_CP + ((size_t)bh * 128 * 4 + rg) * WK_PRV) + (unsigned)(cq * 4 * WK_PRV + q * 16) : (unsigned)(WS_CK + (size_t)bh * 128 * WK_SHR) + (unsigned)(cq * WK_SHR + (q - WK_PRV / 16) * 16);
            qstr[i] = pr ? (unsigned)(16 * WK_PRV) : (unsigned)(4 * WK_SHR); }
#define WQ_DMA(blk) do { _Pragma("unroll") for (int i = 0; i < 6; ++i) if (i < 5 || seven) \
            __builtin_amdgcn_global_load_lds((const unsigned*)(wsb + (qoff[i] + (unsigned)(blk) * qstr[i])), (LAS unsigned*)(C.lds + ((blk) % 3) * WQ_SLOT + (w1 + 7 * i) * 1024), 16, 0, 0); } while (0)
#define WQ_WAIT_OLDER() do { if (seven) asm volatile("s_waitcnt vmcnt(6)" ::: "memory"); else asm volatile("s_waitcnt vmcnt(5)" ::: "memory"); } while (0)
        WQ_DMA(0); WQ_DMA(1); WQ_WAIT_OLDER();
        __builtin_amdgcn_s_barrier(); asm volatile("" ::: "memory");
        for (int blk = 0; blk < 32; ++blk) {
            if (blk + 2 < 32) { WQ_DMA(blk + 2); WQ_WAIT_OLDER(); }
            else asm volatile("s_waitcnt vmcnt(0)" ::: "memory");
            __builtin_amdgcn_s_barrier(); asm volatile("" ::: "memory");
        }
#undef WQ_DMA
#undef WQ_WAIT_OLDER
    }
#undef WQ_COMPUTE
    __syncthreads();
}
__device__ __forceinline__ void rwkv_sample_witem(const Ctx& C, const Ax& a, int l, int witem) {
    const float* RW = (const float*)(a.ws + WS_RW); float* OC = (float*)(a.ws + WS_OC);
    const int n = witem >> 4, h = (witem >> 1) & 7, half = witem & 1, g = C.lane & 15, rq = C.lane >> 4;
    const unsigned char* p = (const unsigned char*)RW + ((size_t)(MP + n) * 8 + h) * RWB;
    const f32x4 lw4 = *(const f32x4*)(p + 16 * g), kk4 = rw_ld4(p, RW_KK, 4 * g), b4 = rw_ld4(p, RW_KB, 4 * g), k4 = rw_ld4(p, RW_K, 4 * g), r4 = rw_ld4(p, RW_R, 4 * g);
    const f32x4 w4 = (f32x4){__expf(lw4.x), __expf(lw4.y), __expf(lw4.z), __expf(lw4.w)};
    const float* sin_ = a.in(I_SWKV) + (((size_t)l * NS + n) * 8 + h) * 4096; float* sout = a.out + O_WKVS + (((size_t)l * NS + n) * 8 + h) * 4096;
#pragma unroll 4
    for (int it = 0; it < 8; ++it) { const int i = half * 32 + it * 4 + rq; const f32x4 S = __builtin_nontemporal_load((const f32x4*)(sin_ + i * 64 + 4 * g)); const float vi = bf1(*(const bf16*)(p + RW_V + i * 2));
        const float sa = -rowsum16((S.x * kk4.x + S.y * kk4.y) + (S.z * kk4.z + S.w * kk4.w));
        f32x4 T; T.x = S.x * w4.x + (sa * b4.x + vi * k4.x); T.y = S.y * w4.y + (sa * b4.y + vi * k4.y); T.z = S.z * w4.z + (sa * b4.z + vi * k4.z); T.w = S.w * w4.w + (sa * b4.w + vi * k4.w);
        const float o = rowsum16((T.x * r4.x + T.y * r4.y) + (T.z * r4.z + T.w * r4.w));
        __builtin_nontemporal_store(T, (f32x4*)(sout + i * 64 + 4 * g));
        if (g == 0) OC[(size_t)(MP + n) * 512 + h * 64 + i] = o; }
}
__device__ __forceinline__ void rwkv_post_phase(const Ctx& C, const Ax& a, int l) {
    const float* RW = (const float*)(a.ws + WS_RW); const float* OC = (const float*)(a.ws + WS_OC); const float* GATE = (const float*)(a.ws + WS_GATE); bf16* YC = (bf16*)(a.ws + WS_YC);
    const int gw = C.bid * NWAVES + C.wave, NGW = C.G * NWAVES, g = C.lane & 15, rq = C.lane >> 4;
    const float* lg = a.in(I_LNXG) + l * 512; const float* lb = a.in(I_LNXB) + l * 512; const float* rk = a.in(I_RK) + l * 512;
    const int h = (gw * 4 + rq) & 7, ch = h * 64 + 4 * g;
    const f32x4 rkv = *(const f32x4*)(rk + ch), lgv = *(const f32x4*)(lg + ch), lbv = *(const f32x4*)(lb + ch);
    constexpr int NIT = MT * 8 / 4;
    for (int it0 = gw; it0 < NIT; it0 += 3 * NGW) {
        f32x4 po[3], pg[3]; v2u pk[3], pr[3], pv[3];
#pragma unroll
        for (int u = 0; u < 3; ++u) { const int it = it0 + u * NGW; if (it < NIT) { const int row = (it * 4 + rq) >> 3; const unsigned char* rw = (const unsigned char*)RW + ((size_t)row * 8 + h) * RWB + 8 * g;
            po[u] = *(const f32x4*)(OC + (size_t)row * 512 + ch); pg[u] = *(const f32x4*)(GATE + (size_t)row * 512 + ch);
            pk[u] = *(const v2u*)(rw + RW_K); pr[u] = *(const v2u*)(rw + RW_R); pv[u] = *(const v2u*)(rw + RW_V); } }
        __builtin_amdgcn_sched_barrier(0);
#pragma unroll
        for (int u = 0; u < 3; ++u) { const int it = it0 + u * NGW; if (it < NIT) { const int row = (it * 4 + rq) >> 3; const f32x4 o = po[u];
            const float mu = rowsum16((o.x + o.y) + (o.z + o.w)) * (1.0f / 64.0f); const f32x4 d = o - mu;
            const float var = rowsum16((d.x * d.x + d.y * d.y) + (d.z * d.z + d.w * d.w)) * (1.0f / 64.0f); const float rstd = 1.0f / sqrtf(var + 64e-5f);
            float kf[4], rf[4], vf[4]; unpack4(pk[u], kf); unpack4(pr[u], rf); unpack4(pv[u], vf);
            const float bs = rowsum16((rf[0] * kf[0] * rkv.x + rf[1] * kf[1] * rkv.y) + (rf[2] * kf[2] * rkv.z + rf[3] * kf[3] * rkv.w));
            const f32x4 v4 = (f32x4){vf[0], vf[1], vf[2], vf[3]};
            const f32x4 y = (d * rstd * lgv + lbv + bs * v4) * pg[u];
            v2u w; w.x = pk2(y.x, y.y); w.y = pk2(y.z, y.w); *(v2u*)(YC + (size_t)row * DM + 1024 + ch) = w; } }
        __builtin_amdgcn_sched_barrier(0);
    }
}

__device__ __forceinline__ float ret_lg(int h) { return log1pf(-exp2f(-5.0f - (float)h)); }
constexpr int RS = 136;
__device__ __forceinline__ void rot8(const bf16* src, const float* cs, int c8, float scale, float (&lo)[8], float (&hi)[8]) {
    float x1[8], x2[8]; unpack8(*(const v4u*)(src + c8 * 8), x1); unpack8(*(const v4u*)(src + 64 + c8 * 8), x2);
    const f32x4* cp = (const f32x4*)(cs + 16 * c8); const f32x4 t0 = cp[0], t1 = cp[1], t2 = cp[2], t3 = cp[3];
    const float cc[8] = {t0.x, t0.z, t1.x, t1.z, t2.x, t2.z, t3.x, t3.z}, sn[8] = {t0.y, t0.w, t1.y, t1.w, t2.y, t2.w, t3.y, t3.w};
#pragma unroll
    for (int j = 0; j < 8; ++j) { lo[j] = (x1[j] * cc[j] - x2[j] * sn[j]) * scale; hi[j] = (x2[j] * cc[j] + x1[j] * sn[j]) * scale; }
}
struct RotX { v4u a, b; }; struct RotT { f32x4 t0, t1, t2, t3; };
__device__ __forceinline__ RotX rot_ldx(const bf16* src, int c8) { RotX r; r.a = *(const v4u*)(src + c8 * 8); r.b = *(const v4u*)(src + 64 + c8 * 8); return r; }
__device__ __forceinline__ RotT rot_ldt(const float* cs, int c8) { const f32x4* cp = (const f32x4*)(cs + 16 * c8); RotT r; r.t0 = cp[0]; r.t1 = cp[1]; r.t2 = cp[2]; r.t3 = cp[3]; return r; }
__device__ __forceinline__ void rot_ap(const RotX& x, const RotT& t, float scale, float (&lo)[8], float (&hi)[8]) {
    float x1[8], x2[8]; unpack8(x.a, x1); unpack8(x.b, x2);
    const float cc[8] = {t.t0.x, t.t0.z, t.t1.x, t.t1.z, t.t2.x, t.t2.z, t.t3.x, t.t3.z}, sn[8] = {t.t0.y, t.t0.w, t.t1.y, t.t1.w, t.t2.y, t.t2.w, t.t3.y, t.t3.w};
#pragma unroll
    for (int j = 0; j < 8; ++j) { lo[j] = (x1[j] * cc[j] - x2[j] * sn[j]) * scale; hi[j] = (x2[j] * cc[j] + x1[j] * sn[j]) * scale; }
}
__device__ __forceinline__ void ret_pass1_item(const Ctx& C, const Ax& a, int item) {
    const bf16* P = (const bf16*)(a.ws + WS_P); const float* CS = (const float*)(a.ws + WS_ROPE); float* KVT = (float*)(a.ws + WS_KVT);
    const int b = item >> 6, h = (item >> 4) & 3, c = item & 15; const size_t row0 = (size_t)b * SEQ + c * 128; const float lg = ret_lg(h);
    LAS bf16* KT = (LAS bf16*)C.lds; LAS bf16* VT = KT + 128 * RS;
    { RotX kx[2]; RotT kt[2]; v4u vw[4];
#pragma unroll
      for (int u = 0; u < 2; ++u) { const int it = C.tid + u * (NWAVES * 64), tt = it & 127, c8 = it >> 7; kx[u] = rot_ldx(P + (row0 + tt) * PIN + PB_ + 512 + h * 128, c8); kt[u] = rot_ldt(CS + (size_t)(c * 128 + tt) * 128, c8); }
#pragma unroll
      for (int u = 0; u < 4; ++u) { const int it = C.tid + u * (NWAVES * 64), tt = it & 127, c8 = it >> 7; vw[u] = *(const v4u*)(P + (row0 + tt) * PIN + PB_ + 1024 + h * 128 + c8 * 8); }
      __builtin_amdgcn_sched_barrier(0);
#pragma unroll
      for (int u = 0; u < 2; ++u) { const int it = C.tid + u * (NWAVES * 64), tt = it & 127, c8 = it >> 7; float lo[8], hi[8];
        rot_ap(kx[u], kt[u], 0.08838834764831845f * __expf(lg * (float)(127 - tt)), lo, hi);
#pragma unroll
        for (int j = 0; j < 8; ++j) { KT[(c8 * 8 + j) * RS + tt] = (bf16)(pk2(lo[j], 0.f) & 0xffffu); KT[(64 + c8 * 8 + j) * RS + tt] = (bf16)(pk2(hi[j], 0.f) & 0xffffu); } }
#pragma unroll
      for (int u = 0; u < 4; ++u) { const int it = C.tid + u * (NWAVES * 64), tt = it & 127, c8 = it >> 7; const unsigned ww[4] = {vw[u].x, vw[u].y, vw[u].z, vw[u].w};
#pragma unroll
        for (int j = 0; j < 4; ++j) { VT[(c8 * 8 + 2 * j) * RS + tt] = (bf16)(ww[j] & 0xffffu); VT[(c8 * 8 + 2 * j + 1) * RS + tt] = (bf16)(ww[j] >> 16); } } }
    __syncthreads();
    const int fr = C.lane & 15, fq = C.lane >> 4, w = C.wave;
    f32x4 acc[8];
#pragma unroll
    for (int et = 0; et < 8; ++et) acc[et] = zero4();
#pragma unroll
    for (int ks = 0; ks < 4; ++ks) { const bf16x8 kf = *(const LAS bf16x8*)(KT + (16 * w + fr) * RS + ks * 32 + fq * 8);
#pragma unroll
        for (int et = 0; et < 8; ++et) { const bf16x8 vf = *(const LAS bf16x8*)(VT + (16 * et + fr) * RS + ks * 32 + fq * 8); acc[et] = __builtin_amdgcn_mfma_f32_16x16x32_bf16(kf, vf, acc[et], 0, 0, 0); } }
    float* o = KVT + (size_t)item * 16384;
#pragma unroll
    for (int et = 0; et < 8; ++et) *(f32x4*)(o + (size_t)(16 * et + fr) * 128 + 16 * w + 4 * fq) = acc[et];
    __syncthreads();
}
__device__ __forceinline__ void ret_prefix_phase(const Ctx& C, const Ax& a, int l) {
    const float* KVT = (const float*)(a.ws + WS_KVT); bf16* STB = (bf16*)(a.ws + WS_STB);
    const int gt = C.bid * (NWAVES * 64) + C.tid, NT = C.G * NWAVES * 64;
    for (int idx = gt; idx < 16 * 4096; idx += NT) { const int bh = idx >> 12, r = idx & 4095, e = r >> 5, d4 = (r & 31) * 4; const int h = bh & 3;
        const float g128 = __expf(ret_lg(h) * 128.0f); const size_t base = (size_t)bh * 16 * 16384 + e * 128 + d4;
        f32x4 kv[16];
#pragma unroll
        for (int c = 0; c < 16; ++c) kv[c] = *(const f32x4*)(KVT + base + (size_t)c * 16384);
        f32x4 S = zero4();
#pragma unroll
        for (int c = 0; c < 16; ++c) { v2u w; w.x = pk2(S.x, S.y); w.y = pk2(S.z, S.w); *(v2u*)(STB + base + (size_t)c * 16384) = w; S = S * g128 + kv[c]; }
        float* o = a.out + O_RETP + ((size_t)l * 16 + bh) * 16384 + e;
        o[(size_t)d4 * 128] = S.x; o[(size_t)(d4 + 1) * 128] = S.y; o[(size_t)(d4 + 2) * 128] = S.z; o[(size_t)(d4 + 3) * 128] = S.w; }
}
__device__ __forceinline__ void ret_pass2_item(const Ctx& C, const Ax& a, int l, int item) {
    const bf16* P = (const bf16*)(a.ws + WS_P); const float* CS = (const float*)(a.ws + WS_ROPE); bf16* YC = (bf16*)(a.ws + WS_YC);
    const int b = item >> 6, h = (item >> 4) & 3, c = item & 15; const size_t row0 = (size_t)b * SEQ + c * 128; const float lg = ret_lg(h);
    LAS bf16* QL = (LAS bf16*)C.lds; LAS bf16* KL = QL + 128 * RS; LAS bf16* VT = KL + 128 * RS; LAS bf16* ST = VT + 128 * RS;
    { RotX qx[2], kx[2]; RotT kt[2]; v4u vw[4], sw[4]; const bf16* stb = (const bf16*)(a.ws + WS_STB) + (size_t)item * 16384;
#pragma unroll
      for (int u = 0; u < 2; ++u) { const int it = C.tid + u * (NWAVES * 64), tt = it & 127, c8 = it >> 7; const bf16* pr = P + (row0 + tt) * PIN + PB_ + h * 128;
        qx[u] = rot_ldx(pr, c8); kx[u] = rot_ldx(pr + 512, c8); kt[u] = rot_ldt(CS + (size_t)(c * 128 + tt) * 128, c8); }
#pragma unroll
      for (int u = 0; u < 4; ++u) { const int it = C.tid + u * (NWAVES * 64), tt = it & 127, c8 = it >> 7; vw[u] = *(const v4u*)(P + (row0 + tt) * PIN + PB_ + 1024 + h * 128 + c8 * 8);
        sw[u] = *(const v4u*)(stb + (it >> 4) * 128 + (it & 15) * 8); }
      __builtin_amdgcn_sched_barrier(0);
#pragma unroll
      for (int u = 0; u < 2; ++u) { const int it = C.tid + u * (NWAVES * 64), tt = it & 127, c8 = it >> 7; float lo[8], hi[8];
        rot_ap(qx[u], kt[u], __expf(lg * (float)(tt + 1)), lo, hi);
        *(LAS v4u*)(QL + tt * RS + c8 * 8) = pack8(lo); *(LAS v4u*)(QL + tt * RS + 64 + c8 * 8) = pack8(hi);
        rot_ap(kx[u], kt[u], 0.08838834764831845f * __expf(-lg * (float)(tt + 1)), lo, hi);
        *(LAS v4u*)(KL + tt * RS + c8 * 8) = pack8(lo); *(LAS v4u*)(KL + tt * RS + 64 + c8 * 8) = pack8(hi); }
#pragma unroll
      for (int u = 0; u < 4; ++u) { const int it = C.tid + u * (NWAVES * 64), tt = it & 127, c8 = it >> 7; const unsigned ww[4] = {vw[u].x, vw[u].y, vw[u].z, vw[u].w};
#pragma unroll
        for (int j = 0; j < 4; ++j) { VT[(c8 * 8 + 2 * j) * RS + tt] = (bf16)(ww[j] & 0xffffu); VT[(c8 * 8 + 2 * j + 1) * RS + tt] = (bf16)(ww[j] >> 16); }
        *(LAS v4u*)(ST + (it >> 4) * RS + (it & 15) * 8) = sw[u]; } }
    __syncthreads();
    const int fr = C.lane & 15, fq = C.lane >> 4, w = C.wave, i0 = 16 * w;
    bf16x8 qf[4];
#pragma unroll
    for (int ks = 0; ks < 4; ++ks) qf[ks] = *(const LAS bf16x8*)(QL + (i0 + fr) * RS + ks * 32 + fq * 8);
    f32x4 sc[8];
#pragma unroll
    for (int jt = 0; jt < 8; ++jt) { sc[jt] = zero4();
        if (jt <= w) {
#pragma unroll
            for (int ks = 0; ks < 4; ++ks) { const bf16x8 kf = *(const LAS bf16x8*)(KL + (16 * jt + fr) * RS + ks * 32 + fq * 8); sc[jt] = __builtin_amdgcn_mfma_f32_16x16x32_bf16(kf, qf[ks], sc[jt], 0, 0, 0); }
            if (jt == w) {
#pragma unroll
                for (int r = 0; r < 4; ++r) if (4 * fq + r > fr) sc[jt][r] = 0.f; } } }
    __syncthreads();
    LAS bf16* PL = KL;
#pragma unroll
    for (int jt = 0; jt < 8; ++jt) { v2u pw; pw.x = pk2(sc[jt][0], sc[jt][1]); pw.y = pk2(sc[jt][2], sc[jt][3]); *(LAS v2u*)(PL + (i0 + fr) * RS + 16 * jt + 4 * fq) = pw; }
    LDS_WAIT(); asm volatile("" ::: "memory");
    f32x4 acc[8];
#pragma unroll
    for (int et = 0; et < 8; ++et) acc[et] = zero4();
#pragma unroll
    for (int ks = 0; ks < 4; ++ks) { if (2 * ks <= w) { const bf16x8 pf = *(const LAS bf16x8*)(PL + (i0 + fr) * RS + ks * 32 + fq * 8);
#pragma unroll
            for (int et = 0; et < 8; ++et) { const bf16x8 vf = *(const LAS bf16x8*)(VT + (16 * et + fr) * RS + ks * 32 + fq * 8); acc[et] = __builtin_amdgcn_mfma_f32_16x16x32_bf16(vf, pf, acc[et], 0, 0, 0); } } }
    if (c > 0) {
#pragma unroll
        for (int ks = 0; ks < 4; ++ks)
#pragma unroll
            for (int et = 0; et < 8; ++et) { const bf16x8 sf = *(const LAS bf16x8*)(ST + (16 * et + fr) * RS + ks * 32 + fq * 8); acc[et] = __builtin_amdgcn_mfma_f32_16x16x32_bf16(sf, qf[ks], acc[et], 0, 0, 0); } }
    float s = 0.f;
#pragma unroll
    for (int et = 0; et < 8; ++et) s += (acc[et][0] + acc[et][1]) + (acc[et][2] + acc[et][3]);
    s += __shfl_xor(s, 16); s += __shfl_xor(s, 32); const float mu = s * (1.0f / 128.0f);
    float q = 0.f;
#pragma unroll
    for (int et = 0; et < 8; ++et) { acc[et] = acc[et] - mu; q += (acc[et][0] * acc[et][0] + acc[et][1] * acc[et][1]) + (acc[et][2] * acc[et][2] + acc[et][3] * acc[et][3]); }
    q += __shfl_xor(q, 16); q += __shfl_xor(q, 32); const float rstd = 1.0f / sqrtf(q * (1.0f / 128.0f) + 1e-6f);
    const size_t row = row0 + i0 + fr;
#pragma unroll
    for (int et = 0; et < 8; ++et) { const int e = 16 * et + 4 * fq; float gg[4]; unpack4(*(const v2u*)(P + row * PIN + PB_ + 1536 + h * 128 + e), gg);
        v2u wv; wv.x = pk2(gg[0] * sigm(gg[0]) * acc[et][0] * rstd, gg[1] * sigm(gg[1]) * acc[et][1] * rstd); wv.y = pk2(gg[2] * sigm(gg[2]) * acc[et][2] * rstd, gg[3] * sigm(gg[3]) * acc[et][3] * rstd);
        *(v2u*)(YC + row * DM + 512 + h * 128 + e) = wv; }
    __syncthreads();
}
__device__ __forceinline__ void ret_sample_witem(const Ctx& C, const Ax& a, int l, int witem) {
    const bf16* P = (const bf16*)(a.ws + WS_P); const float* CS = (const float*)(a.ws + WS_ROPE) + (size_t)2048 * 128; bf16* YC = (bf16*)(a.ws + WS_YC);
    const int n = witem >> 2, h = witem & 3, lane = C.lane; const float gam = 1.0f - exp2f(-5.0f - (float)h);
    LAS float* qk = (LAS float*)(C.lds + C.wave * 1024);
    const bf16* pr = P + (size_t)(MP + n) * PIN + PB_ + h * 128;
    { const float co = CS[2 * lane], si = CS[2 * lane + 1]; const float q1 = bf1(pr[lane]), q2 = bf1(pr[64 + lane]), k1 = bf1(pr[512 + lane]), k2 = bf1(pr[512 + 64 + lane]);
      qk[lane] = q1 * co - q2 * si; qk[64 + lane] = q2 * co + q1 * si; qk[128 + lane] = (k1 * co - k2 * si) * 0.08838834764831845f; qk[192 + lane] = (k2 * co + k1 * si) * 0.08838834764831845f; }
    LDS_WAIT(); asm volatile("" ::: "memory");
    const float dotp = wave_sum(qk[lane] * qk[128 + lane] + qk[64 + lane] * qk[192 + lane]);
    const int half = lane >> 5, el = lane & 31;
    float vv[4]; unpack4(*(const v2u*)(pr + 1024 + 4 * el), vv); const f32x4 v4 = (f32x4){vv[0], vv[1], vv[2], vv[3]};
    const float* sin_ = a.in(I_SRET) + (((size_t)l * NS + n) * 4 + h) * 16384; float* sout = a.out + O_RETS + (((size_t)l * NS + n) * 4 + h) * 16384;
    f32x4 oa = zero4();
    unsigned lof = (unsigned)(half * 128 + 4 * el) * 4u; asm volatile("" : "+v"(lof));
    f32x4 sa[4], sb[4];
#define RS_LOAD(buf, blk) do { _Pragma("unroll") for (int j = 0; j < 4; ++j) buf[j] = __builtin_nontemporal_load((const f32x4*)((const char*)sin_ + (lof + (unsigned)(2 * ((blk) * 4 + j)) * 512u))); } while (0)
#define RS_USE(buf, blk) do { _Pragma("unroll") for (int j = 0; j < 4; ++j) { const int d = 2 * ((blk) * 4 + j) + half; const float qd = qk[d], kd = qk[128 + d]; oa += qd * buf[j]; \
        __builtin_nontemporal_store(gam * buf[j] + kd * v4, (f32x4*)((char*)sout + (lof + (unsigned)(2 * ((blk) * 4 + j)) * 512u))); } } while (0)
    RS_LOAD(sa, 0);
#pragma unroll
    for (int blk = 0; blk < 16; blk += 2) {
        RS_LOAD(sb, blk + 1); __builtin_amdgcn_sched_barrier(0);
        RS_USE(sa, blk); __builtin_amdgcn_sched_barrier(0);
        if (blk + 2 < 16) RS_LOAD(sa, blk + 2);
        __builtin_amdgcn_sched_barrier(0);
        RS_USE(sb, blk + 1); __builtin_amdgcn_sched_barrier(0); }
#undef RS_LOAD
#undef RS_USE
    oa.x += __shfl_xor(oa.x, 32); oa.y += __shfl_xor(oa.y, 32); oa.z += __shfl_xor(oa.z, 32); oa.w += __shfl_xor(oa.w, 32);
    f32x4 o = gam * oa + dotp * v4;
    float s = (o.x + o.y) + (o.z + o.w);
#pragma unroll
    for (int m = 1; m < 32; m <<= 1) s += __shfl_xor(s, m);
    const float mu = s * (1.0f / 128.0f); o = o - mu; float q = (o.x * o.x + o.y * o.y) + (o.z * o.z + o.w * o.w);
#pragma unroll
    for (int m = 1; m < 32; m <<= 1) q += __shfl_xor(q, m);
    const float rstd = 1.0f / sqrtf(q * (1.0f / 128.0f) + 1e-6f);
    if (half == 0) { float gg[4]; unpack4(*(const v2u*)(pr + 1536 + 4 * el), gg);
        v2u wv; wv.x = pk2(gg[0] * sigm(gg[0]) * o.x * rstd, gg[1] * sigm(gg[1]) * o.y * rstd); wv.y = pk2(gg[2] * sigm(gg[2]) * o.z * rstd, gg[3] * sigm(gg[3]) * o.w * rstd);
        *(v2u*)(YC + (size_t)(MP + n) * DM + 512 + h * 128 + 4 * el) = wv; }
    LDS_WAIT(); asm volatile("" ::: "memory");
}

constexpr int XV_RS = 264;
__device__ __forceinline__ void xattn_prompt_unit(const Ctx& C, const Ax& a, int l, int unit) {
    const bf16* Q = (const bf16*)(a.ws + WS_Q); const bf16* MK = (const bf16*)(a.ws + WS_MK) + (size_t)l * MMEM * DM; const bf16* MVT = (const bf16*)(a.ws + WS_MVT) + (size_t)l * MMEM * DM; bf16* O = (bf16*)(a.ws + WS_O);
    const int b = unit >> 6, h = (unit >> 4) & 3, qt = unit & 15, fr = C.lane & 15, fq = C.lane >> 4;
    const size_t row = (size_t)b * SEQ + qt * 128 + C.wave * 16 + fr;
    LAS bf16* SB = (LAS bf16*)C.lds;
    v4u st[8];
    const bf16* kbase = MK + ((size_t)b * 256) * DM + h * 512; const bf16* vbase = MVT + (((size_t)b * 4 + h) * 512) * 256;
    unsigned kof[4], vof[8], sof[8];
#pragma unroll
    for (int i = 0; i < 8; ++i) { const int idx = C.tid + 512 * i, r = idx >> 5, c16 = idx & 31; vof[i] = (unsigned)(r * 256 + c16 * 8) * 2u; sof[i] = (unsigned)(r * XV_RS + c16 * 8) * 2u; if (i < 4) kof[i] = (unsigned)(r * DM + c16 * 8) * 2u; }
    const char* kb8 = (const char*)kbase; const char* vb8 = (const char*)vbase; LAS char* sb8 = (LAS char*)SB;
#define XK_LOAD(q) do { const char* pb_ = kb8 + ((size_t)(((q) & 3) * 64) * DM + ((q) >> 2) * 256) * 2; _Pragma("unroll") for (int i = 0; i < 4; ++i) st[i] = *(const v4u*)(pb_ + kof[i]); } while (0)
#define XK_STORE() do { _Pragma("unroll") for (int i = 0; i < 4; ++i) *(LAS v4u*)(sb8 + sof[i]) = st[i]; } while (0)
#define XV_LOAD(p) do { const char* pb_ = vb8 + (size_t)((p) * 128) * 256 * 2; _Pragma("unroll") for (int i = 0; i < 8; ++i) st[i] = *(const v4u*)(pb_ + vof[i]); } while (0)
#define XV_STORE() do { _Pragma("unroll") for (int i = 0; i < 8; ++i) *(LAS v4u*)(sb8 + sof[i]) = st[i]; } while (0)
    XK_LOAD(0);
    f32x4 sc[16];
#pragma unroll
    for (int jt = 0; jt < 16; ++jt) sc[jt] = zero4();
#pragma unroll
    for (int dh = 0; dh < 2; ++dh) {
        bf16x8 qf[8];
#pragma unroll
        for (int ks = 0; ks < 8; ++ks) qf[ks] = *(const bf16x8*)(Q + row * DM + h * 512 + dh * 256 + ks * 32 + fq * 8);
#pragma unroll
        for (int p = 0; p < 4; ++p) {
            __syncthreads(); XK_STORE(); __syncthreads();
            if (dh * 4 + p < 7) XK_LOAD(dh * 4 + p + 1); else XV_LOAD(0);
#pragma unroll
            for (int j4 = 0; j4 < 4; ++j4) {
#pragma unroll
                for (int ks = 0; ks < 8; ++ks) { const bf16x8 kf = *(const LAS bf16x8*)(SB + (j4 * 16 + fr) * XV_RS + ks * 32 + fq * 8); sc[p * 4 + j4] = __builtin_amdgcn_mfma_f32_16x16x32_bf16(kf, qf[ks], sc[p * 4 + j4], 0, 0, 0); }
                __builtin_amdgcn_sched_barrier(0); }
        }
    }
    float mx = -3.0e38f;
#pragma unroll
    for (int jt = 0; jt < 16; ++jt) mx = fmaxf(mx, fmaxf(fmaxf(sc[jt][0], sc[jt][1]), fmaxf(sc[jt][2], sc[jt][3])));
    mx = fmaxf(mx, __shfl_xor(mx, 16)); mx = fmaxf(mx, __shfl_xor(mx, 32));
    const float scale = 0.04419417382415922f; float sum = 0.f;
    bf16x8 pf[8];
#pragma unroll
    for (int s = 0; s < 8; ++s) { float p[8];
#pragma unroll
        for (int j = 0; j < 4; ++j) { p[j] = __expf((sc[2 * s][j] - mx) * scale); p[4 + j] = __expf((sc[2 * s + 1][j] - mx) * scale); }
        sum += ((p[0] + p[1]) + (p[2] + p[3])) + ((p[4] + p[5]) + (p[6] + p[7]));
        const v4u w = pack8(p); pf[s] = __builtin_bit_cast(bf16x8, w); }
    sum += __shfl_xor(sum, 16); sum += __shfl_xor(sum, 32); const float inv = 1.0f / sum;
#pragma unroll
    for (int p = 0; p < 4; ++p) {
        __syncthreads(); XV_STORE(); __syncthreads();
        if (p < 3) XV_LOAD(p + 1);
#pragma unroll
        for (int et = 0; et < 8; ++et) { f32x4 s4 = zero4(); const LAS bf16* vp = SB + (et * 16 + fr) * XV_RS + 4 * fq;
#pragma unroll
            for (int s = 0; s < 8; ++s) { const v2u lo = *(const LAS v2u*)(vp + 32 * s), hi = *(const LAS v2u*)(vp + 32 * s + 16); const v4u w = (v4u){lo.x, lo.y, hi.x, hi.y};
                s4 = __builtin_amdgcn_mfma_f32_16x16x32_bf16(__builtin_bit_cast(bf16x8, w), pf[s], s4, 0, 0, 0); }
            v2u w; w.x = pk2(s4[0] * inv, s4[1] * inv); w.y = pk2(s4[2] * inv, s4[3] * inv);
            *(v2u*)(O + row * DM + h * 512 + p * 128 + et * 16 + 4 * fq) = w;
            __builtin_amdgcn_sched_barrier(0); }
    }
    __syncthreads();
#undef XK_LOAD
#undef XK_STORE
#undef XV_LOAD
#undef XV_STORE
}
__device__ __forceinline__ void xattn_sample_item(const Ctx& C, const Ax& a, int l, int item) {
    bf16* O = (bf16*)(a.ws + WS_OS);
    const int n = item >> 2, h = item & 3, lane = C.lane, w = C.wave;
    LAS float* red = (LAS float*)C.lds; LAS float* part = red + 64;
    float q[8]; { const float* s0 = (const float*)(a.ws + WS_SPL) + (size_t)n * DM + h * 512 + 4 * lane; const float* s1 = s0 + (size_t)NS * DM;
                  const f32x4 a0 = *(const f32x4*)s0 + *(const f32x4*)s1, a1 = *(const f32x4*)(s0 + 256) + *(const f32x4*)(s1 + 256);
                  q[0] = a0.x; q[1] = a0.y; q[2] = a0.z; q[3] = a0.w; q[4] = a1.x; q[5] = a1.y; q[6] = a1.z; q[7] = a1.w; }
    const size_t base = ((((size_t)l * NS + n) * 256 + 32 * w) * 4 + h) * 512 + 4 * lane;
    const float* kp = a.in(I_CMK) + base; const float* vp = a.in(I_CMV) + base;
#define XS_LOAD(buf0, buf1, ptr, k8) do { _Pragma("unroll") for (int j = 0; j < 8; ++j) { buf0[j] = __builtin_nontemporal_load((const f32x4*)((ptr) + (size_t)((k8) * 8 + j) * 2048)); buf1[j] = __builtin_nontemporal_load((const f32x4*)((ptr) + (size_t)((k8) * 8 + j) * 2048 + 256)); } } while (0)
#define XS_DOT(buf0, buf1, k8) do { _Pragma("unroll") for (int j = 0; j < 8; ++j) { float d = (buf0[j].x * q[0] + buf0[j].y * q[1]) + (buf0[j].z * q[2] + buf0[j].w * q[3]) + (buf1[j].x * q[4] + buf1[j].y * q[5]) + (buf1[j].z * q[6] + buf1[j].w * q[7]); \
        d = rowsum16(d); d += __shfl_xor(d, 16); d += __shfl_xor(d, 32); if (lane == (k8) * 8 + j) myscore = d; } } while (0)
#define XS_ACC(buf0, buf1, k8) do { _Pragma("unroll") for (int j = 0; j < 8; ++j) { const float pj = __builtin_bit_cast(float, __builtin_amdgcn_readlane(__builtin_bit_cast(int, p), (k8) * 8 + j)); o0 += pj * buf0[j]; o1 += pj * buf1[j]; } } while (0)
    float myscore = 0.f;
    f32x4 xa0[8], xa1[8], xb0[8], xb1[8];
    XS_LOAD(xa0, xa1, kp, 0);
    XS_LOAD(xb0, xb1, kp, 1); XS_DOT(xa0, xa1, 0);
    XS_LOAD(xa0, xa1, kp, 2); XS_DOT(xb0, xb1, 1);
    XS_LOAD(xb0, xb1, kp, 3); XS_DOT(xa0, xa1, 2);
    XS_LOAD(xa0, xa1, vp, 0); XS_DOT(xb0, xb1, 3);
    const float scale = 0.04419417382415922f;
    float mx = wave_max(lane < 32 ? myscore : -3.0e38f); if (lane == 0) red[w] = mx; __syncthreads();
    mx = red[0];
#pragma unroll
    for (int i = 1; i < 8; ++i) mx = fmaxf(mx, red[i]);
    const float p = lane < 32 ? __expf((myscore - mx) * scale) : 0.f;
    const float ps = wave_sum(p); if (lane == 0) red[8 + w] = ps;
    f32x4 o0 = zero4(), o1 = zero4();
    XS_LOAD(xb0, xb1, vp, 1); XS_ACC(xa0, xa1, 0);
    XS_LOAD(xa0, xa1, vp, 2); XS_ACC(xb0, xb1, 1);
    XS_LOAD(xb0, xb1, vp, 3); XS_ACC(xa0, xa1, 2);
    XS_ACC(xb0, xb1, 3);
#undef XS_LOAD
#undef XS_DOT
#undef XS_ACC
    *(LAS f32x4*)(part + w * 512 + 4 * lane) = o0; *(LAS f32x4*)(part + w * 512 + 256 + 4 * lane) = o1;
    __syncthreads();
    float tot = 0.f;
#pragma unroll
    for (int i = 0; i < 8; ++i) tot += red[8 + i];
    { const int d = C.tid; float s = 0.f;
#pragma unroll
      for (int i = 0; i < 8; ++i) s += part[i * 512 + d];
      O[(size_t)n * DMS + h * 512 + d] = (bf16)(pk2(s / tot, 0.f) & 0xffffu); }
    __syncthreads();
}

#ifndef PHASE_MASK
#define PHASE_MASK 0xffffffffu
#endif
#define PM(k) ((PHASE_MASK >> (k)) & 1u)
#ifndef DUP_SUB
#define DUP_SUB 0u
#endif
#define REP(k) for (int rep_ = 0; rep_ < 1 + (int)((DUP_SUB >> (k)) & 1u); ++rep_)
#ifndef DUP_MASK
#define DUP_MASK 0
#endif
#ifndef MK_ONE_LAUNCH
#define MK_ONE_LAUNCH 1
#endif
constexpr int PH_PER_LAYER = 14, NPH = 1 + DEPTH * PH_PER_LAYER;
__global__ void __launch_bounds__(NWAVES * 64, 2) fwd_kernel(Args args) {
    extern __shared__ __attribute__((aligned(16))) unsigned char lds_raw[];
    LAS unsigned char* const lds = (LAS unsigned char*)lds_raw;
    const int wave_s = __builtin_amdgcn_readfirstlane((int)threadIdx.x >> 6);
    volatile LAS unsigned* MISC = (volatile LAS unsigned*)(lds + MISC_OFF);
    for (int u = threadIdx.x; u < (LDS_BYTES - MISC_OFF) / 4; u += NWAVES * 64) ((LAS unsigned*)(lds + MISC_OFF))[u] = 0u;
    __syncthreads();
    XcdBarrier bar; bar.bar = (unsigned*)(args.ws + WS_CTL) + CW_BAR; bar.x = 0; bar.st = nullptr;
    if (MK_ONE_LAUNCH) bar = xcd_barrier_post((unsigned*)(args.ws + WS_CTL) + CW_BAR, MISC + 8);
    bar.wave = wave_s;
    const int lo = args.ph_lo, hi = args.ph_hi;
#define IN(k) (lo <= (k) && (k) < hi)
#define SEAM(k) do { if (MK_ONE_LAUNCH && IN((k) + 1)) xcd_barrier(bar); } while (0)
#define SEAM2(k) do { if (MK_ONE_LAUNCH && IN((k) + 2)) xcd_barrier(bar); } while (0)
#define PHASE_CTX const Ctx C = mk_ctx(lds, wave_s); const Ax a = mk_ax(); unsigned char* const ws = a.ws; const int G = C.G, bid = C.bid; (void)ws; (void)G; (void)bid; \
    float* const XF = (float*)(ws + WS_XF); bf16* const HN = (bf16*)(ws + WS_HN); bf16* const PBUF = (bf16*)(ws + WS_P); bf16* const YC = (bf16*)(ws + WS_YC); bf16* const QB = (bf16*)(ws + WS_Q); \
    bf16* const OB = (bf16*)(ws + WS_O); bf16* const UB = (bf16*)(ws + WS_U); (void)XF; (void)HN; (void)PBUF; (void)YC; (void)QB; (void)OB; (void)UB

    if (IN(0)) { PHASE_CTX; if (PM(0)) p0_prologue(C, a); SEAM(0); }

    for (int l = 0; l < DEPTH; ++l) {
        const int pb = 1 + l * PH_PER_LAYER;
        if (IN(pb + 0)) { PHASE_CTX; const unsigned char* wl = ws + WS_WL + (size_t)l * LW_STRIDE;
            if (PM(1)) { pg8::Gemm g{HN, (const bf16*)(wl + LW_IN), MPAD, PIN, DM, DM, 64, (size_t)PIN * 128}; pg8::StaticOrder S; S.init(MPAD, PIN, G, bid); pg8::EpiBf16A<0> E{PBUF, PIN, nullptr};
              pg8::gemm_phase<pg8::EpiBf16A<0>, pg8::StaticOrder, true, true>(lds, g, S, E, C.tid); }
            if (G == 256) { const int nfull = (MPAD / 256) * (PIN / 256) - 3 * G;
                if ((bid >= nfull && bid < 64) || bid >= 128) { __syncthreads(); late_convert(C, a, l, bid < 64 ? bid - nfull : bid - 128 + (64 - nfull), (64 - nfull) + (G - 128)); } }
            if (PM(2)) { pg8::Gemm g{(const bf16*)(ws + WS_MN), (const bf16*)(ws + WS_WKV) + (size_t)l * 4096 * 64, MMEM, 4096, DM, DM, 64, (size_t)8192 * 128}; pg8::StaticOrder S; S.init(MMEM, 4096, G, (bid + G - (64 % G)) % G);
              pg8::EpiMemKV E{a.out + O_MKP + (size_t)l * MMEM * DM, (bf16*)(ws + WS_MK) + (size_t)l * MMEM * DM, (bf16*)(ws + WS_MVT) + (size_t)l * MMEM * DM};
              pg8::gemm_phase<pg8::EpiMemKV, pg8::StaticOrder, true, true>(lds, g, S, E, C.tid); }
            SEAM(pb + 0);
        }
        if (IN(pb + 1)) { PHASE_CTX;
#ifdef DEBUG_P
            { const int gt = bid * 512 + C.tid, NT = G * 512;
              for (int idx = gt + (DEBUG_P == 2 ? MP * 2048 : 0); idx < (DEBUG_P == 1 ? MP : MT) * 2048; idx += NT) { const int row = idx >> 11, c = idx & 2047; const bf16* pr = PBUF + (size_t)row * PIN;
                  float s = bf1(pr[c]) + bf1(pr[c + 2048]) + bf1(pr[c + 4096]); if (c < 256) s += bf1(pr[c + 6144]); a.out[O_YP + idx] = s; } }
#endif
            if ((bid >> 3) & 1) { if (PM(8)) REP(8) for (int it = bid * NWAVES + C.wave; it < NS * 4; it += G * NWAVES) ret_sample_witem(C, a, l, it); __syncthreads(); }
            if (PM(4)) REP(4) for (int it = bid; it < 256; it += G) ad_prompt_item(C, a, l, it);
            if (PM(5)) REP(5) for (int it = bid; it < 256; it += G) ret_pass1_item(C, a, it);
            if (PM(6)) REP(6) for (int it = bid; it < 256; it += G) rwkv_prep_item(C, a, l, it);
            if (PM(6)) for (int it = bid - 64; it >= 0 && it < 8; it += G) rwkv_prep_item(C, a, l, 256 + (it >> 1), it & 1);
            if (PM(7)) REP(7) for (int it = G - 1 - bid; it < NS; it += G) ad_sample_item(C, a, l, it);
            if (!((bid >> 3) & 1)) { if (PM(8)) REP(8) for (int it = bid * NWAVES + C.wave; it < NS * 4; it += G * NWAVES) ret_sample_witem(C, a, l, it); }
            __syncthreads();
            SEAM(pb + 1);
        }
        if (IN(pb + 2)) { PHASE_CTX;
            if ((bid >> 3) & 1) { if (PM(10)) REP(10) for (int it = bid * NWAVES + C.wave; it < NS * 16; it += G * NWAVES) rwkv_sample_witem(C, a, l, it); }
            if (PM(9)) REP(9) for (int it = bid * NWAVES + C.wave; it < 4096; it += G * NWAVES) wkv_chunk_witem(C, a, it);
            if (!((bid >> 3) & 1)) { if (PM(10)) REP(10) for (int it = bid * NWAVES + C.wave; it < NS * 16; it += G * NWAVES) rwkv_sample_witem(C, a, l, it); }
            if (PM(11)) ret_prefix_phase(C, a, l);
            SEAM(pb + 2);
        }
        if (IN(pb + 3)) { PHASE_CTX; const int hg = G / 2;
            if (PM(22)) REP(22) for (int it = bid; it < 128; it += (bid < hg ? hg : 1 << 20)) wkv_seq_item(C, a, l, it);
            if (PM(11)) REP(11) if (bid >= hg || G < 2) for (int it = bid - hg; it < 256; it += G - hg) ret_pass2_item(C, a, l, it);
            SEAM(pb + 3);
        }
        if (IN(pb + 4)) { PHASE_CTX;
            if (PM(12)) REP(12) rwkv_post_phase(C, a, l);
            SEAM(pb + 4);
        }
        if (IN(pb + 5)) { PHASE_CTX; const unsigned char* wl = ws + WS_WL + (size_t)l * LW_STRIDE;
            pg8::Gemm g{YC, (const bf16*)(wl + LW_OUT), MP, DM, DM, DM, 64, (size_t)DM * 128}; pg8::StaticOrder S; S.init(MP, DM, G, bid); pg8::EpiRes E{XF, DM, ((DUP_MASK >> 5) & 1) ? 0.5f : 1.0f, (l == 0 && !((DUP_MASK >> 5) & 1)) ? a.in(I_XP) : (const float*)XF};
            if (PM(15)) pg8::gemm_phase<pg8::EpiRes, pg8::StaticOrder, true, true>(lds, g, S, E, C.tid);
            if (PM(20)) sample_gemm(lds, C.tid, YC + (size_t)MP * DM, DM, (const bf16*)(wl + LW_OUT), DM, DM, DM, G, bid, SEpiRes{XF + (size_t)MP * DM, DM, ((DUP_MASK >> 5) & 1) ? 0.5f : 1.0f, (l == 0 && !((DUP_MASK >> 5) & 1)) ? a.in(I_XS) : (const float*)(XF + (size_t)MP * DM)});
            SEAM(pb + 5);
        }
        if (IN(pb + 6)) { PHASE_CTX; if (PM(21)) REP(21) rms_phase(C, XF, HN, (bf16*)(ws + WS_HNS)); SEAM(pb + 6);
#ifdef XBAR_PROBE
            if (MK_ONE_LAUNCH) for (int i_ = 0; i_ < XBAR_PROBE; ++i_) xcd_barrier(bar);
#endif
        }
        if (IN(pb + 7)) { PHASE_CTX; const unsigned char* wl = ws + WS_WL + (size_t)l * LW_STRIDE;
            pg8::Gemm g{HN, (const bf16*)(wl + LW_Q), MP, DM, DM, DM, 64, (size_t)DM * 128}; pg8::StaticOrder S; S.init(MP, DM, G, bid); pg8::EpiBf16A<0> E{QB, DM, nullptr};
            if (PM(16)) REP(16) pg8::gemm_phase<pg8::EpiBf16A<0>, pg8::StaticOrder, true, true>(lds, g, S, E, C.tid);
            if (PM(20)) { sample_gemm(lds, C.tid, (const bf16*)(ws + WS_HNS), DMS, (const bf16*)(wl + LW_Q), DM, DM, DM, G, bid, SEpiPart{(float*)(ws + WS_SPL), DM}, 2); if ((DUP_SUB >> 24) & 1u) { const Ctx C2 = mk_ctx(lds, wave_s); sample_gemm(lds, C2.tid, (const bf16*)(ws + WS_HNS), DMS, (const bf16*)(wl + LW_Q), DM, DM, DM, G, bid, SEpiPart{(float*)(ws + WS_SPL), DM}, 2); } }
            SEAM(pb + 7);
        }
        if (IN(pb + 8)) { PHASE_CTX;
            { const int g3 = (bid >> 3) % 3;
              if (g3 == 0) { if (PM(13)) REP(13) for (int it = bid; it < 256; it += G) xattn_prompt_unit(C, a, l, it); }
              if (PM(14)) REP(14) for (int it = bid; it < NS * 4; it += 2 * G) xattn_sample_item(C, a, l, it);
              if (g3 == 1) { if (PM(13)) REP(13) for (int it = bid; it < 256; it += G) xattn_prompt_unit(C, a, l, it); }
              if (PM(14)) REP(14) for (int it = bid + G; it < NS * 4; it += 2 * G) xattn_sample_item(C, a, l, it);
              if (g3 == 2) { if (PM(13)) REP(13) for (int it = bid; it < 256; it += G) xattn_prompt_unit(C, a, l, it); } }
            SEAM(pb + 8);
        }
        if (IN(pb + 9)) { PHASE_CTX; const unsigned char* wl = ws + WS_WL + (size_t)l * LW_STRIDE;
            pg8::Gemm g{OB, (const bf16*)(wl + LW_O), MP, DM, DM, DM, 64, (size_t)DM * 128}; pg8::StaticOrder S; S.init(MP, DM, G, bid); pg8::EpiRes E{XF, DM, ((DUP_MASK >> 9) & 1) ? 0.5f : 1.0f, XF};
            if (PM(17)) pg8::gemm_phase<pg8::EpiRes, pg8::StaticOrder, true, true>(lds, g, S, E, C.tid);
            if (PM(20)) sample_gemm(lds, C.tid, (const bf16*)(ws + WS_OS), DMS, (const bf16*)(wl + LW_O), DM, DM, DM, G, bid, SEpiRes{XF + (size_t)MP * DM, DM, ((DUP_MASK >> 9) & 1) ? 0.5f : 1.0f, XF + (size_t)MP * DM});
            SEAM(pb + 9);
        }
        if (IN(pb + 10)) { PHASE_CTX; if (PM(21)) REP(21) rms_phase(C, XF, HN, (bf16*)(ws + WS_HNS)); SEAM(pb + 10); }
        if (IN(pb + 11)) { PHASE_CTX; const unsigned char* wl = ws + WS_WL + (size_t)l * LW_STRIDE;
            pg8::Gemm g{HN, (const bf16*)(wl + LW_UP), MP, DFF, DM, DM, 64, (size_t)DFF * 128}; pg8::StaticOrder S; S.init(MP, DFF, G, bid); pg8::EpiBf16A<3> E{UB, LDU, nullptr};
            if (PM(18)) REP(18) pg8::gemm_phase<pg8::EpiBf16A<3>, pg8::StaticOrder, true, true>(lds, g, S, E, C.tid);
            if (PM(20)) { sample_gemm(lds, C.tid, (const bf16*)(ws + WS_HNS), DMS, (const bf16*)(wl + LW_UP), DFF, DFF, DM, G, bid, SEpiBf16{(bf16*)(ws + WS_US), LDUS, 3, nullptr}); if ((DUP_SUB >> 23) & 1u) { const Ctx C2 = mk_ctx(lds, wave_s); sample_gemm(lds, C2.tid, (const bf16*)(ws + WS_HNS), DMS, (const bf16*)(wl + LW_UP), DFF, DFF, DM, G, bid, SEpiBf16{(bf16*)(ws + WS_US), LDUS, 3, nullptr}); } }
            SEAM(pb + 11);
        }
        if (IN(pb + 12)) { PHASE_CTX; const unsigned char* wl = ws + WS_WL + (size_t)l * LW_STRIDE;
            pg8::Gemm g{UB, (const bf16*)(wl + LW_DN), MP, DM, DFF, LDU, 64, (size_t)DM * 128}; pg8::StaticOrder S; S.init(MP, DM, G, bid); pg8::EpiRes E{XF, DM, ((DUP_MASK >> 12) & 1) ? 0.5f : 1.0f, XF};
            if (PM(19)) pg8::gemm_phase<pg8::EpiRes, pg8::StaticOrder, true, true>(lds, g, S, E, C.tid);
            if (PM(20)) { sample_gemm(lds, C.tid, (const bf16*)(ws + WS_US), LDUS, (const bf16*)(wl + LW_DN), DM, DM, DFF, G, bid, SEpiPart{(float*)(ws + WS_SPL), DM}, 2); if ((DUP_SUB >> 25) & 1u) { const Ctx C2 = mk_ctx(lds, wave_s); sample_gemm(lds, C2.tid, (const bf16*)(ws + WS_US), LDUS, (const bf16*)(wl + LW_DN), DM, DM, DFF, G, bid, SEpiPart{(float*)(ws + WS_SPL), DM}, 2); } }
            SEAM(pb + 12);
        }
        if (IN(pb + 13)) { PHASE_CTX;
            fold_split_rows(C, XF, (const float*)(ws + WS_SPL));
            if (!PM(21)) {} else if (l + 1 < DEPTH) REP(21) rms_phase(C, XF, HN, nullptr); else final_norm_phase(C, XF, a.in(I_GFIN), a.out + O_YP);
            SEAM(pb + 13);
        }
    }
#undef IN
#undef SEAM
#undef SEAM2
#undef PHASE_CTX
}

extern "C" void kernel_launch(void* const* d_in, const int* in_sizes, int n_in, void* d_out, int out_size, void* d_ws, size_t ws_size, hipStream_t stream) {
    static int grid = 0;
    if (grid == 0) {
        if (n_in != NIN || (size_t)out_size != O_END || ws_size < WS_END) { fprintf(stderr, "kernel_launch: unexpected shapes (n_in %d, out %d, ws %zu); nothing launched\n", n_in, out_size, ws_size); grid = -1; return; }
        int dev = 0, cus = 0, per_cu = 0;
        if (hipGetDevice(&dev) != hipSuccess || hipDeviceGetAttribute(&cus, hipDeviceAttributeMultiprocessorCount, dev) != hipSuccess) { grid = -1; return; }
        if (hipFuncSetAttribute((const void*)fwd_kernel, hipFuncAttributeMaxDynamicSharedMemorySize, LDS_BYTES) != hipSuccess) { fprintf(stderr, "kernel_launch: hipFuncSetAttribute failed\n"); grid = -1; return; }
        if (hipOccupancyMaxActiveBlocksPerMultiprocessor(&per_cu, (const void*)fwd_kernel, NWAVES * 64, LDS_BYTES) != hipSuccess || per_cu < 1) { fprintf(stderr, "kernel_launch: occupancy query reports %d\n", per_cu); }
        (void)hipGetLastError();
        grid = cus;
    }
    if (grid < 0) return;
    if (hipMemsetAsync((char*)d_ws + WS_CTL, 0, CTL_ZERO_BYTES, stream) != hipSuccess) return;
    Args a{};
    for (int i = 0; i < NIN; ++i) a.in[i] = (const float*)d_in[i];
    a.out = (float*)d_out; a.ws = (unsigned char*)d_ws;
#if MK_ONE_LAUNCH
    a.ph_lo = 0; a.ph_hi = NPH;
    hipLaunchKernelGGL(fwd_kernel, dim3(grid), dim3(NWAVES * 64), LDS_BYTES, stream, a);
#else
#ifndef NPH_RUN
#define NPH_RUN NPH
#endif
    for (int ph = 0; ph < NPH_RUN; ++ph) { a.ph_lo = ph; a.ph_hi = ph + 1; hipLaunchKernelGGL(fwd_kernel, dim3(grid), dim3(NWAVES * 64), LDS_BYTES, stream, a);
        const int dbit = (ph == 0) ? 13 : (ph - 1) % PH_PER_LAYER;
        if ((DUP_MASK >> dbit) & 1) hipLaunchKernelGGL(fwd_kernel, dim3(grid), dim3(NWAVES * 64), LDS_BYTES, stream, a); }
#endif
}
```

```cpp
#include <hip/hip_runtime.h>
#include <cstdio>
#include <cstdint>
namespace pg8 {
#define PG8_LAS __attribute__((address_space(3)))
typedef unsigned short bf16_t;
typedef short bf16x8 __attribute__((ext_vector_type(8)));
typedef float f32x4 __attribute__((ext_vector_type(4)));
typedef unsigned u32x4 __attribute__((ext_vector_type(4)));
constexpr int BM = 256, BK = 64, HALF = 128, HTB = HALF * BK * 2  , STAGE_BYTES = 8 * HTB, NXCD = 8, WGM = 8;

__host__ __device__ __forceinline__ int lds_byte(int r, int c) { const int st = (r >> 4) * 2 + (c >> 5), rr = r & 15, cc = c & 31, ob = rr * 64 + cc * 2; return st * 1024 + (ob ^ (((ob >> 9) & 1) << 5)); }
__host__ __device__ __forceinline__ void stage_rc(int b, int& R, int& C) { const int st = b / 1024, sb = b % 1024, swz = sb ^ (((sb >> 9) & 1) << 5); R = (st >> 1) * 16 + swz / 64; C = (st & 1) * 32 + (swz % 64) / 2; }
__host__ __device__ __forceinline__ int perm32(int rho) { const int n = rho >> 4, i = rho & 15; return 8 * (i >> 2) + 4 * n + (i & 3); }

struct Unit { int pm, pn; };
struct Gemm { const bf16_t* A; const bf16_t* Bt; int M, N, K, lda, ldb; size_t ksb; };

struct StaticOrder {
    int nM, nN, nwg, G, c;
    __host__ __device__ void init(int M, int N, int G_, int c_) { nM = M / BM; nN = N / BM; nwg = nM * nN; G = G_; c = c_; }
    __host__ __device__ bool next(int i, Unit& u) const {
        const long L = (long)i * G + c; if (L >= nwg) return false;
        int wgid = (int)L; { const int q = nwg / NXCD, r = nwg % NXCD, xcd = wgid % NXCD, off = wgid / NXCD; wgid = (xcd < r ? xcd * (q + 1) : r * (q + 1) + (xcd - r) * q) + off; }
        const int nig = WGM * nN, gid = wgid / nig, fm = gid * WGM, gsz = (nM - fm) < WGM ? (nM - fm) : WGM;
        u.pm = fm + ((wgid % nig) % gsz); u.pn = (wgid % nig) / gsz; return true;
    }
    __device__ __forceinline__ void a_ready(const Unit&) const {}
    __device__ __forceinline__ void done(const Unit&) const {}
};

typedef float f32x2_cv __attribute__((ext_vector_type(2)));
typedef __bf16 bf16x2_cv __attribute__((ext_vector_type(2)));
__device__ __forceinline__ unsigned cvt_pk_bf16(float lo, float hi) { const f32x2_cv v = {lo, hi}; return __builtin_bit_cast(unsigned, __builtin_convertvector(v, bf16x2_cv)); }
typedef float f32x2 __attribute__((ext_vector_type(2)));
template <class Epi, class Sched, bool ALIGN_EPI = false, bool SP2 = false>
__device__ __forceinline__ void gemm_phase(PG8_LAS unsigned char* lds, const Gemm g, const Sched& S, const Epi& E, int tid_in) {
    int tid_ = tid_in; asm volatile("" : "+v"(tid_));
    const int tid = tid_, wid = __builtin_amdgcn_readfirstlane(tid >> 6), lane = tid & 63, wr = wid >> 2, wc = wid & 3, fr = lane & 15, fq = lane >> 4;
    const int K = g.K, nt = K / BK;
    unsigned voffA[2], voffB[2];
#pragma unroll
    for (int i = 0; i < 2; ++i) { int R, C; stage_rc(tid * 16 + i * 8192, R, C); const int Rb = Epi::PERM ? ((R & ~31) + perm32(R & 31)) : R;
        voffA[i] = (unsigned)(R * g.lda + C) * 2u; voffB[i] = (unsigned)(Rb * g.ldb + C) * 2u; }
    const size_t kstep = (size_t)(BK * 2), kstepB = g.ksb;
    const size_t hstepA = (size_t)HALF * g.lda * 2, hstepB = (size_t)HALF * g.ldb * 2;
    const size_t tstepA = 2 * hstepA, tstepB = 2 * hstepB;
    const unsigned ldsw = (unsigned)wid * 1024u;
    const int aoff = lds_byte(wr * 64 + fr, fq * 8), boff = lds_byte(wc * 32 + fr, fq * 8);
#define PG8_SA(b, h) (((b) * 2 + (h)) * HTB)
#define PG8_SB(b, h) ((4 + (b) * 2 + (h)) * HTB)
#define PG8_STAGE(bufoff, gbase, voff) do { _Pragma("unroll") for (int _i = 0; _i < 2; ++_i) \
        __builtin_amdgcn_global_load_lds((const unsigned*)((const char*)(gbase) + (voff)[_i]), (PG8_LAS unsigned*)(lds + (bufoff) + ldsw + _i * 8192), 16, 0, 0); } while (0)
#define PG8_LDA(dst, b, h) do { _Pragma("unroll") for (int m = 0; m < 4; ++m) _Pragma("unroll") for (int k = 0; k < 2; ++k) dst[m][k] = *(const PG8_LAS bf16x8*)(lds + PG8_SA(b, h) + aoff + m * 2048 + k * 1024); } while (0)
#define PG8_LDB(dst, b, h) do { _Pragma("unroll") for (int n = 0; n < 2; ++n) _Pragma("unroll") for (int k = 0; k < 2; ++k) dst[n][k] = *(const PG8_LAS bf16x8*)(lds + PG8_SB(b, h) + boff + n * 2048 + k * 1024); } while (0)
#define PG8_MMA(ai, bj, At, Bt) do { __builtin_amdgcn_s_setprio(1); _Pragma("unroll") for (int m = 0; m < 4; ++m) _Pragma("unroll") for (int n = 0; n < 2; ++n) _Pragma("unroll") for (int k = 0; k < 2; ++k) \
        acc[ai][bj][m][n] = __builtin_amdgcn_mfma_f32_16x16x32_bf16(Bt[n][k], At[m][k], acc[ai][bj][m][n], 0, 0, 0); __builtin_amdgcn_s_setprio(0); } while (0)
#define PG8_WAIT_V(n) asm volatile("s_waitcnt vmcnt(" #n ")" ::: "memory")
#define PG8_WAIT_L(n) asm volatile("s_waitcnt lgkmcnt(" #n ")" ::: "memory")
#define PG8_BAR __builtin_amdgcn_s_barrier()
#define PG8_SCHED __builtin_amdgcn_sched_barrier(0)
    Unit cur, nxt; int ui = 0;
    if (!S.next(0, cur)) return;
    f32x4 acc[2][2][4][2];
#pragma unroll
    for (int a = 0; a < 2; ++a)
#pragma unroll
        for (int b = 0; b < 2; ++b)
#pragma unroll
            for (int m = 0; m < 4; ++m)
#pragma unroll
                for (int n = 0; n < 2; ++n) acc[a][b][m][n] = (f32x4){0.f, 0.f, 0.f, 0.f};
    bf16x8 At[4][2], B0[2][2], B1[2][2];
    const char* cA = (const char*)g.A + (size_t)cur.pm * tstepA; const char* cB = (const char*)g.Bt + (size_t)cur.pn * tstepB;
    S.a_ready(cur);
    if constexpr (SP2) {
        PG8_STAGE(PG8_SB(0, 0), cB, voffB); PG8_STAGE(PG8_SB(0, 1), cB + hstepB, voffB); PG8_STAGE(PG8_SA(0, 0), cA, voffA); PG8_STAGE(PG8_SA(0, 1), cA + hstepA, voffA);
        if (wr == 1) PG8_BAR;
        PG8_WAIT_V(2); PG8_BAR;
        PG8_STAGE(PG8_SB(1, 0), cB + kstepB, voffB); PG8_STAGE(PG8_SA(1, 0), cA + kstep, voffA); PG8_STAGE(PG8_SB(1, 1), cB + hstepB + kstepB, voffB);
        PG8_WAIT_V(6); PG8_BAR;
    } else {
        PG8_STAGE(PG8_SB(0, 0), cB, voffB); PG8_STAGE(PG8_SA(0, 0), cA, voffA); PG8_STAGE(PG8_SB(0, 1), cB + hstepB, voffB); PG8_STAGE(PG8_SA(0, 1), cA + hstepA, voffA);
        if (wr == 1) PG8_BAR;
        PG8_WAIT_V(4); PG8_BAR;
        PG8_STAGE(PG8_SB(1, 0), cB + kstepB, voffB); PG8_STAGE(PG8_SA(1, 0), cA + kstep, voffA); PG8_STAGE(PG8_SB(1, 1), cB + hstepB + kstepB, voffB);
        PG8_WAIT_V(6); PG8_BAR;
    }
    for (;;) {
        const bool has_next = S.next(ui + 1, nxt);
        const char* nA = has_next ? (const char*)g.A + (size_t)nxt.pm * tstepA : cA; const char* nB = has_next ? (const char*)g.Bt + (size_t)nxt.pn * tstepB : cB;
        for (int t = 0; t < nt; t += 2) {
            const bool last = (t == nt - 2);
            const char* a1 = cA + (size_t)(t + 1) * kstep;
            const char* a2 = last ? nA : cA + (size_t)(t + 2) * kstep; const char* b2 = last ? nB : cB + (size_t)(t + 2) * kstepB;
            const char* a3 = a2 + kstep; const char* b3 = b2 + kstepB;
            if (last && has_next) S.a_ready(nxt);
            if constexpr (SP2) {
            PG8_LDB(B0, 0, 0); PG8_LDB(B1, 0, 1); PG8_SCHED; PG8_LDA(At, 0, 0); PG8_STAGE(PG8_SA(1, 1), a1 + hstepA, voffA);
            PG8_WAIT_V(8); PG8_WAIT_L(0); PG8_BAR; PG8_MMA(0, 0, At, B0); PG8_MMA(0, 1, At, B1); PG8_BAR; PG8_SCHED;
            PG8_LDA(At, 0, 1); PG8_STAGE(PG8_SB(0, 0), b2, voffB); PG8_STAGE(PG8_SB(0, 1), b2 + hstepB, voffB); PG8_STAGE(PG8_SA(0, 0), a2, voffA);
            PG8_WAIT_V(8); PG8_WAIT_L(0); PG8_BAR; PG8_MMA(1, 0, At, B0); PG8_MMA(1, 1, At, B1); PG8_BAR; PG8_SCHED;
            PG8_LDB(B0, 1, 0); PG8_LDB(B1, 1, 1); PG8_SCHED; PG8_LDA(At, 1, 0); PG8_STAGE(PG8_SA(0, 1), a2 + hstepA, voffA);
            PG8_WAIT_V(8); PG8_WAIT_L(0); PG8_BAR; PG8_MMA(0, 0, At, B0); PG8_MMA(0, 1, At, B1); PG8_BAR; PG8_SCHED;
            PG8_LDA(At, 1, 1); PG8_STAGE(PG8_SB(1, 0), b3, voffB); PG8_STAGE(PG8_SB(1, 1), b3 + hstepB, voffB); PG8_STAGE(PG8_SA(1, 0), a3, voffA);
            PG8_WAIT_V(8); PG8_WAIT_L(0); PG8_BAR; PG8_MMA(1, 0, At, B0); PG8_MMA(1, 1, At, B1); PG8_BAR; PG8_SCHED;
            } else {
            PG8_LDB(B0, 0, 0); PG8_SCHED; PG8_LDA(At, 0, 0); PG8_STAGE(PG8_SA(1, 1), a1 + hstepA, voffA);
            PG8_WAIT_L(8); PG8_BAR; PG8_WAIT_L(0); PG8_MMA(0, 0, At, B0); PG8_BAR; PG8_SCHED;
            PG8_LDB(B1, 0, 1); PG8_STAGE(PG8_SB(0, 0), b2, voffB);
            PG8_BAR; PG8_WAIT_L(0); PG8_MMA(0, 1, At, B1); PG8_BAR;
            PG8_LDA(At, 0, 1); PG8_STAGE(PG8_SA(0, 0), a2, voffA);
            PG8_BAR; PG8_WAIT_L(0); PG8_MMA(1, 0, At, B0); PG8_BAR; PG8_SCHED;
            PG8_STAGE(PG8_SB(0, 1), b2 + hstepB, voffB);
            PG8_WAIT_V(6); PG8_BAR; PG8_MMA(1, 1, At, B1); PG8_BAR;
            PG8_LDB(B0, 1, 0); PG8_SCHED; PG8_LDA(At, 1, 0); PG8_STAGE(PG8_SA(0, 1), a2 + hstepA, voffA);
            PG8_WAIT_L(8); PG8_BAR; PG8_WAIT_L(0); PG8_MMA(0, 0, At, B0); PG8_BAR; PG8_SCHED;
            PG8_LDB(B1, 1, 1); PG8_STAGE(PG8_SB(1, 0), b3, voffB);
            PG8_BAR; PG8_WAIT_L(0); PG8_MMA(0, 1, At, B1); PG8_BAR;
            PG8_LDA(At, 1, 1); PG8_STAGE(PG8_SA(1, 0), a3, voffA);
            PG8_BAR; PG8_WAIT_L(0); PG8_MMA(1, 0, At, B0); PG8_BAR; PG8_SCHED;
            PG8_STAGE(PG8_SB(1, 1), b3 + hstepB, voffB);
            PG8_WAIT_V(6); PG8_BAR; PG8_MMA(1, 1, At, B1); PG8_BAR;
            }
        }
        if constexpr (ALIGN_EPI) { if (wr == 0) PG8_BAR; }
        if constexpr (!Epi::AFTER_DRAIN) { E(acc, cur, wr, wc, fr, fq); S.done(cur); }
        if (!has_next) break;
#pragma unroll
        for (int a = 0; a < 2; ++a)
#pragma unroll
            for (int b = 0; b < 2; ++b)
#pragma unroll
                for (int m = 0; m < 4; ++m)
#pragma unroll
                    for (int n = 0; n < 2; ++n) acc[a][b][m][n] = (f32x4){0.f, 0.f, 0.f, 0.f};
        cur = nxt; cA = nA; cB = nB; ++ui;
        if constexpr (ALIGN_EPI) { if (wr == 1) PG8_BAR; }
    }
    PG8_WAIT_V(0);
    if constexpr (!ALIGN_EPI) { if (wr == 0) PG8_BAR; }
    PG8_BAR;
    if constexpr (Epi::AFTER_DRAIN) { E.fused(acc, cur, wr, wc, fr, fq, lds, wid, lane); S.done(cur); }
#undef PG8_SA
#undef PG8_SB
#undef PG8_STAGE
#undef PG8_LDA
#undef PG8_LDB
#undef PG8_MMA
#undef PG8_WAIT_V
#undef PG8_WAIT_L
#undef PG8_BAR
#undef PG8_SCHED
}
}

constexpr int DM = 2048, SEQ = 2048, NB = 4, NS = 128, DEPTH = 2;
constexpr int MP = NB * SEQ;
constexpr int MT = MP + NS;
constexpr int MPAD = MP + 256;
constexpr int PIN = 6400, DFF = 8192, NMEM = 256, MMEM = NB * NMEM;
constexpr int PB_ = 1536, PC_ = 3584, PD_ = 5376;
constexpr int SHW = 1792;
constexpr int LDU = 8192;
constexpr int NWAVES = 8;
constexpr int NIN = 39;

constexpr size_t O_YP = 0, O_YS = O_YP + (size_t)MP * DM, O_CAP = O_YS + (size_t)NS * DM, O_CAS = O_CAP + (size_t)DEPTH * NB * 2 * 512,
    O_RETP = O_CAS + (size_t)DEPTH * NS * 2 * 512, O_RETS = O_RETP + (size_t)DEPTH * NB * 4 * 128 * 128, O_SHP = O_RETS + (size_t)DEPTH * NS * 4 * 128 * 128,
    O_SHS = O_SHP + (size_t)DEPTH * NB * SHW, O_WKVP = O_SHS + (size_t)DEPTH * NS * SHW, O_WKVS = O_WKVP + (size_t)DEPTH * NB * 8 * 64 * 64,
    O_CDP = O_WKVS + (size_t)DEPTH * NS * 8 * 64 * 64, O_CDS = O_CDP + (size_t)DEPTH * NB * 30 * 512, O_MKP = O_CDS + (size_t)DEPTH * NS * 30 * 512,
    O_MVP = O_MKP + (size_t)DEPTH * MMEM * DM, O_END = O_MVP + (size_t)DEPTH * MMEM * DM;
static_assert(O_END == 56178688, "d_out size");

constexpr size_t MiB = 1u << 20;
constexpr size_t al256(size_t x) { return (x + 255) & ~(size_t)255; }
constexpr size_t WS_CTL = 0, CTL_ZERO_BYTES = 1 * MiB;
constexpr size_t WS_ROPE = 1 * MiB;
constexpr size_t SZ_WIN = (size_t)PIN * DM * 2, SZ_SQ = (size_t)DM * DM * 2, SZ_WUP = (size_t)DFF * DM * 2, SZ_WDN = (size_t)DM * LDU * 2;
constexpr size_t LW_IN = 0, LW_OUT = LW_IN + SZ_WIN, LW_Q = LW_OUT + SZ_SQ, LW_O = LW_Q + SZ_SQ, LW_UP = LW_O + SZ_SQ, LW_DN = LW_UP + SZ_WUP,
    LW_W2 = LW_DN + SZ_WDN, LW_A2 = LW_W2 + 512 * 64 * 2, LW_G2 = LW_A2 + 512 * 64 * 2, LW_STRIDE = LW_G2 + 512 * 128 * 2;
constexpr size_t WS_WL = 4 * MiB;
constexpr size_t WS_WKV = al256(WS_WL + 2 * LW_STRIDE);
constexpr size_t WS_XF = al256(WS_WKV + (size_t)8192 * DM * 2);
constexpr size_t WS_HN = al256(WS_XF + (size_t)MT * DM * 4);
constexpr size_t WS_MN = al256(WS_HN + (size_t)MPAD * DM * 2);
constexpr size_t WS_MK = al256(WS_MN + (size_t)MMEM * DM * 2);
constexpr size_t WS_MVT = al256(WS_MK + (size_t)2 * MMEM * DM * 2);
constexpr size_t WS_P = al256(WS_MVT + (size_t)2 * MMEM * DM * 2);
constexpr size_t WS_YC = al256(WS_P + (size_t)MPAD * PIN * 2);
constexpr size_t WS_Q = al256(WS_YC + (size_t)MT * DM * 2);
constexpr size_t WS_O = al256(WS_Q + (size_t)MT * DM * 2);
constexpr size_t WS_U = al256(WS_O + (size_t)MT * DM * 2);
constexpr size_t WS_RW = al256(WS_U + (size_t)MT * LDU * 2);
constexpr size_t WS_GATE = al256(WS_RW + (size_t)MT * 8 * 896);
constexpr size_t WS_OC = al256(WS_GATE + (size_t)MT * 512 * 4);
constexpr size_t WS_KVT = al256(WS_OC + (size_t)MT * 512 * 4);
constexpr size_t WS_SSQ = al256(WS_KVT + (size_t)16 * 16 * 128 * 128 * 4);
constexpr size_t WS_SPL = al256(WS_SSQ + (size_t)MP * 8 * 4);
constexpr size_t WS_STB = al256(WS_SPL + (size_t)2 * NS * DM * 4);
constexpr size_t WS_CK = al256(WS_STB + (size_t)16 * 16 * 128 * 128 * 2);
constexpr size_t WS_CP = al256(WS_CK + (size_t)4096 * 6912);
constexpr int DMS = DM + 128, LDUS = LDU + 128;
constexpr size_t WS_HNS = al256(WS_CP + (size_t)4096 * 4 * 3072);
constexpr size_t WS_OS = al256(WS_HNS + (size_t)NS * DMS * 2);
constexpr size_t WS_US = al256(WS_OS + (size_t)NS * DMS * 2);
constexpr size_t WS_END = al256(WS_US + (size_t)NS * LDUS * 2);
static_assert(WS_END < (size_t)1700 * MiB, "d_ws map");
constexpr int CW_BAR = 4096;

constexpr int SCR_BYTES = 147456;
constexpr int MISC_OFF = SCR_BYTES;
constexpr int LDS_BYTES = SCR_BYTES + 1024;

#define GAS __attribute__((address_space(1)))
#define LAS __attribute__((address_space(3)))
typedef unsigned short bf16;
typedef unsigned v4u __attribute__((ext_vector_type(4)));
typedef unsigned v2u __attribute__((ext_vector_type(2)));
typedef float f32x4 __attribute__((ext_vector_type(4)));
typedef float f32x2 __attribute__((ext_vector_type(2)));
typedef short bf16x8 __attribute__((ext_vector_type(8)));
typedef short bf16x4 __attribute__((ext_vector_type(4)));
typedef GAS unsigned gu32;
#define RLX_AGENT __ATOMIC_RELAXED, __HIP_MEMORY_SCOPE_AGENT
#define LDS_WAIT() asm volatile("s_waitcnt lgkmcnt(0)" ::: "memory")
#define VM_WAIT() asm volatile("s_waitcnt vmcnt(0)" ::: "memory")
__device__ __forceinline__ unsigned pk2(float lo, float hi) { return pg8::cvt_pk_bf16(lo, hi); }
__device__ __forceinline__ float bflo(unsigned w) { return __uint_as_float(w << 16); }
__device__ __forceinline__ float bfhi(unsigned w) { return __uint_as_float(w & 0xffff0000u); }
__device__ __forceinline__ float bf1(bf16 h) { return __uint_as_float(((unsigned)h) << 16); }
__device__ __forceinline__ void unpack8(const v4u w, float (&f)[8]) { f[0] = bflo(w.x); f[1] = bfhi(w.x); f[2] = bflo(w.y); f[3] = bfhi(w.y); f[4] = bflo(w.z); f[5] = bfhi(w.z); f[6] = bflo(w.w); f[7] = bfhi(w.w); }
__device__ __forceinline__ void unpack4(const v2u w, float (&f)[4]) { f[0] = bflo(w.x); f[1] = bfhi(w.x); f[2] = bflo(w.y); f[3] = bfhi(w.y); }
__device__ __forceinline__ v4u pack8(const float (&f)[8]) { v4u w; w.x = pk2(f[0], f[1]); w.y = pk2(f[2], f[3]); w.z = pk2(f[4], f[5]); w.w = pk2(f[6], f[7]); return w; }
__device__ __forceinline__ float sigm(float x) { return 1.0f / (1.0f + __expf(-x)); }
__device__ __forceinline__ float wave_sum(float v) {
#pragma unroll
    for (int o = 1; o < 64; o <<= 1) v += __shfl_xor(v, o);
    return v;
}
__device__ __forceinline__ float wave_max(float v) {
#pragma unroll
    for (int o = 1; o < 64; o <<= 1) v = fmaxf(v, __shfl_xor(v, o));
    return v;
}
template <int CTRL> __device__ __forceinline__ float dpp_f(float v) { return __builtin_bit_cast(float, __builtin_amdgcn_update_dpp(0, __builtin_bit_cast(int, v), CTRL, 0xf, 0xf, false)); }
__device__ __forceinline__ f32x4 zero4() { float z0, z1, z2, z3; asm volatile("v_mov_b32 %0, 0\n\tv_mov_b32 %1, 0\n\tv_mov_b32 %2, 0\n\tv_mov_b32 %3, 0\n\ts_nop 1" : "=v"(z0), "=v"(z1), "=v"(z2), "=v"(z3)); return (f32x4){z0, z1, z2, z3}; }
__device__ __forceinline__ float rowsum16(float v) { v += dpp_f<0x128>(v); v += dpp_f<0x124>(v); v += dpp_f<0x122>(v); v += dpp_f<0x121>(v); return v; }

namespace pg8 {
template <int ACT> struct EpiBf16A {
    static constexpr bool PERM = true, AFTER_DRAIN = false;
    bf16_t* O; int ldc; const float* ssq;
    __device__ __forceinline__ void operator()(const f32x4 (&acc)[2][2][4][2], const Unit& u, int wr, int wc, int fr, int fq) const {
        const int row0 = u.pm * BM + wr * 64 + fr, col0 = u.pn * BM + wc * 32 + 8 * fq;
#pragma unroll
        for (int ai = 0; ai < 2; ++ai)
#pragma unroll
            for (int m = 0; m < 4; ++m) { bf16_t* rowp = O + (size_t)(row0 + ai * HALF + m * 16) * ldc + col0;
                const float rs = ssq ? 1.0f / sqrtf(ssq[row0 + ai * HALF + m * 16] * (1.0f / 2048.0f) + 1e-6f) : 1.0f;
#pragma unroll
                for (int bj = 0; bj < 2; ++bj) { f32x4 v0 = acc[ai][bj][m][0] * rs, v1 = acc[ai][bj][m][1] * rs;
                    if (ACT == 3) {
#pragma unroll
                        for (int j = 0; j < 4; ++j) { const float a = fmaxf(v0[j], 0.f), b = fmaxf(v1[j], 0.f); v0[j] = a * a; v1[j] = b * b; } }
                    u32x4 w; w.x = cvt_pk_bf16(v0[0], v0[1]); w.y = cvt_pk_bf16(v0[2], v0[3]); w.z = cvt_pk_bf16(v1[0], v1[1]); w.w = cvt_pk_bf16(v1[2], v1[3]);
                    *(u32x4*)(rowp + bj * HALF) = w; } }
    }
};
struct EpiRes {
    static constexpr bool PERM = false, AFTER_DRAIN = false;
    float* X; int ldc; float sc; const float* Xin;
    __device__ __forceinline__ void operator()(const f32x4 (&acc)[2][2][4][2], const Unit& u, int wr, int wc, int fr, int fq) const {
        const int row0 = u.pm * BM + wr * 64 + fr, col0 = u.pn * BM + wc * 32 + 4 * fq;
#pragma unroll
        for (int ai = 0; ai < 2; ++ai)
#pragma unroll
            for (int m = 0; m < 4; ++m) { float* rowp = X + (size_t)(row0 + ai * HALF + m * 16) * ldc + col0; const float* inp = Xin + (size_t)(row0 + ai * HALF + m * 16) * ldc + col0;
                f32x4 o[2][2];
#pragma unroll
                for (int bj = 0; bj < 2; ++bj)
#pragma unroll
                    for (int n = 0; n < 2; ++n) o[bj][n] = *(const f32x4*)(inp + bj * HALF + n * 16);
#pragma unroll
                for (int bj = 0; bj < 2; ++bj)
#pragma unroll
                    for (int n = 0; n < 2; ++n) *(f32x4*)(rowp + bj * HALF + n * 16) = o[bj][n] + acc[ai][bj][m][n] * sc; }
    }
};
struct EpiMemKV {
    static constexpr bool PERM = false, AFTER_DRAIN = false;
    float* outK; bf16_t* MKb; bf16_t* MVT;
    __device__ __forceinline__ void operator()(const f32x4 (&acc)[2][2][4][2], const Unit& u, int wr, int wc, int fr, int fq) const {
        const int cbase = u.pn * BM, lyr = cbase >> 12, cc = cbase & 4095; const bool isV = cc >= 2048; const int colt = cc & 2047;
        const int row0 = u.pm * BM + wr * 64 + fr, col0 = colt + wc * 32 + 4 * fq;
        float* outp = outK + (isV ? (size_t)(O_MVP - O_MKP) : (size_t)0);
#pragma unroll
        for (int ai = 0; ai < 2; ++ai)
#pragma unroll
            for (int m = 0; m < 4; ++m) { const int r = row0 + ai * HALF + m * 16;
#pragma unroll
                for (int bj = 0; bj < 2; ++bj)
#pragma unroll
                    for (int n = 0; n < 2; ++n) { const int col = col0 + bj * HALF + n * 16; const f32x4 v = acc[ai][bj][m][n];
                        *(f32x4*)(outp + ((size_t)lyr * 1024 + r) * 2048 + col) = v;
                        if (!isV) { unsigned lo = cvt_pk_bf16(v[0], v[1]), hi = cvt_pk_bf16(v[2], v[3]); *(unsigned long long*)(MKb + ((size_t)lyr * 1024 + r) * 2048 + col) = ((unsigned long long)hi << 32) | lo; }
                        else { const int b = r >> 8, j = r & 255, h = col >> 9, e = col & 511; bf16_t* tp = MVT + ((((size_t)lyr * 4 + b) * 4 + h) * 512 + e) * 256 + j;
                            const unsigned lo = cvt_pk_bf16(v[0], v[1]), hi = cvt_pk_bf16(v[2], v[3]);
                            tp[0] = (bf16_t)(lo & 0xffffu); tp[256] = (bf16_t)(lo >> 16); tp[512] = (bf16_t)(hi & 0xffffu); tp[768] = (bf16_t)(hi >> 16); } } }
    }
};
}

struct SEpiBf16 { bf16* O; int ldc; int act; const float* ssq;
    __device__ __forceinline__ void operator()(int row, int col0, f32x4 v, int) const {
        if (ssq) v = v * (1.0f / sqrtf(ssq[row] * (1.0f / 2048.0f) + 1e-6f));
        if (act == 3) {
#pragma unroll
            for (int j = 0; j < 4; ++j) { const float a = fmaxf(v[j], 0.f); v[j] = a * a; } }
        v2u w; w.x = pk2(v[0], v[1]); w.y = pk2(v[2], v[3]); *(v2u*)(O + (size_t)row * ldc + col0) = w; } };
struct SEpiRes { float* X; int ldc; float sc; const float* Xin;
    __device__ __forceinline__ void operator()(int row, int col0, f32x4 v, int) const { *(f32x4*)(X + (size_t)row * ldc + col0) = *(const f32x4*)(Xin + (size_t)row * ldc + col0) + v * sc; } };
struct SEpiPart { float* S; int ldc;
    __device__ __forceinline__ void operator()(int row, int col0, f32x4 v, int kp) const { *(f32x4*)(S + ((size_t)kp * NS + row) * ldc + col0) = v; } };
template <class F> __device__ __forceinline__ void sample_gemm(LAS unsigned char* lds, int tid_in, const bf16* A, int lda, const bf16* Bt, int ntot, int N, int K, int G, int bid, const F& epi, int nks = 1) {
    int tid_ = tid_in; asm volatile("" : "+v"(tid_));
    const int lane = tid_ & 63, wave = __builtin_amdgcn_readfirstlane(tid_ >> 6), fr = lane & 15, fq = lane >> 4;
    const int KS = (K / nks) >> 3, ncu = N / 16;
    LAS f32x4* red = (LAS f32x4*)lds;
    const unsigned voffa = (unsigned)(fr * lda + fq * 8) * 2u, voffb = (unsigned)(fr * 64 + fq * 8) * 2u;
    for (int uu = bid; uu < ncu * nks; uu += G) { const int kp = uu / ncu, u = uu - kp * ncu, kbeg = kp * (K / nks) + wave * KS;
        const char* bp = (const char*)(Bt + ((size_t)(kbeg >> 6) * ntot + u * 16) * 64);
        const char* ap = (const char*)(A + kbeg);
        f32x4 acc[8];
#pragma unroll
        for (int rt = 0; rt < 8; ++rt) acc[rt] = zero4();
        bf16x8 b0[2], a0[2][8], b1[2], a1[2][8];
#define SG_LOAD(bb, aa, kq) do { _Pragma("unroll") for (int s = 0; s < 2; ++s) { bb[s] = *(const bf16x8*)(bp + ((size_t)((kq) >> 6) * ntot * 64 + 32 * s) * 2 + voffb); \
            _Pragma("unroll") for (int rt = 0; rt < 8; ++rt) aa[s][rt] = *(const bf16x8*)(ap + ((size_t)rt * 16 * lda + (kq) + 32 * s) * 2 + voffa); } } while (0)
#define SG_MMA(bb, aa) do { _Pragma("unroll") for (int s = 0; s < 2; ++s) _Pragma("unroll") for (int rt = 0; rt < 8; ++rt) acc[rt] = __builtin_amdgcn_mfma_f32_16x16x32_bf16(bb[s], aa[s][rt], acc[rt], 0, 0, 0); } while (0)
        SG_LOAD(b0, a0, 0);
        for (int k0 = 0; k0 < KS; k0 += 128) {
            __builtin_amdgcn_sched_barrier(0);
            SG_LOAD(b1, a1, k0 + 64);
            __builtin_amdgcn_sched_barrier(0);
            SG_MMA(b0, a0);
            __builtin_amdgcn_sched_barrier(0);
            if (k0 + 128 < KS) SG_LOAD(b0, a0, k0 + 128);
            __builtin_amdgcn_sched_barrier(0);
            SG_MMA(b1, a1);
        }
        __builtin_amdgcn_sched_barrier(0);
#undef SG_LOAD
#undef SG_MMA
#pragma unroll
        for (int rt = 0; rt < 8; ++rt) red[(wave * 8 + rt) * 64 + lane] = acc[rt];
        __syncthreads();
        f32x4 sum = red[wave * 64 + lane];
#pragma unroll
        for (int ks = 1; ks < 8; ++ks) sum += red[(ks * 8 + wave) * 64 + lane];
        epi(wave * 16 + fr, u * 16 + 4 * fq, sum, kp);
        __syncthreads();
    }
}
#define XB_TMO      128
#define XB_XCNT(j)  (256  + 64 * (j))
#define XB_XSUB(j)  (1280 + 64 * (j))
#define XB_XGEN(j)  (2304 + 64 * (j))
#define XB_TOP      3328
#define XB_TOPGEN   3392
#define XCD_BAR_WORDS 3456
#define XB_SPIN_CAP (1u << 18)

__device__ __forceinline__ unsigned xb_ld(unsigned* p)              { return __hip_atomic_load(p, __ATOMIC_RELAXED, __HIP_MEMORY_SCOPE_AGENT); }
__device__ __forceinline__ unsigned xb_add(unsigned* p, unsigned v) { return __hip_atomic_fetch_add(p, v, __ATOMIC_RELAXED, __HIP_MEMORY_SCOPE_AGENT); }
__device__ __forceinline__ unsigned xb_xcc_id() { return (unsigned)__builtin_amdgcn_s_getreg((3 << 11) | 20) & 0xFu; }
#define XB_SPIN(cond, bar) do { unsigned _sp = 0; while (cond) { __builtin_amdgcn_s_sleep(1); \
    if ((++_sp & 255u) == 0u) { if (xb_ld(&(bar)[XB_TMO])) break; if (_sp > XB_SPIN_CAP) { atomicAdd(&(bar)[XB_TMO], 1u); break; } } } } while (0)

struct XcdBarrier {
    int wave;
    unsigned* bar; unsigned x;
    volatile LAS unsigned* st;
};

__device__ __forceinline__ XcdBarrier xcd_barrier_post(unsigned* bar, volatile LAS unsigned* st) {
    XcdBarrier b; b.bar = bar; b.x = xb_xcc_id(); b.st = st;
    if (threadIdx.x == 0) (void)xb_add(&bar[XB_XCNT(b.x)], 1u);
    return b;
}
__device__ __forceinline__ void xcd_barrier_complete(unsigned* bar, unsigned x, unsigned& nloc, unsigned& nx) {
    const unsigned G = gridDim.x * gridDim.y * gridDim.z;
    unsigned sum, cnt, mine, sp = 0u;
    for (;;) {
        sum = 0u; cnt = 0u; mine = 0u;
#pragma unroll
        for (unsigned j = 0; j < 16; ++j) { const unsigned c = xb_ld(&bar[XB_XCNT(j)]); sum += c; cnt += (c > 0u) ? 1u : 0u; mine = (j == x) ? c : mine; }
        if (sum == G) break;
        __builtin_amdgcn_s_sleep(1);
        if ((++sp & 255u) == 0u) { if (xb_ld(&bar[XB_TMO])) break; if (sp > XB_SPIN_CAP) { atomicAdd(&bar[XB_TMO], 1u); break; } }
    }
    nloc = mine > 0u ? mine : 1u; nx = cnt > 0u ? cnt : 1u;
}

__device__ __forceinline__ void xcd_barrier(const XcdBarrier& b) {
    asm volatile("s_waitcnt vmcnt(0)" ::: "memory");
    __syncthreads();
    unsigned xbz = 0u; asm volatile("" : "+v"(xbz));
    if (b.wave == 0 && __builtin_amdgcn_mbcnt_hi(~0u, __builtin_amdgcn_mbcnt_lo(~0u, xbz)) == 0u) {
        unsigned* bar = b.bar;
        __builtin_amdgcn_s_waitcnt(0);
        unsigned nloc = b.st[0], nx = b.st[1];
        if (nloc == 0u) { xcd_barrier_complete(bar, b.x, nloc, nx); b.st[0] = nloc; b.st[1] = nx; }
        const unsigned old = xb_add(&bar[XB_XSUB(b.x)], 1u);
        const unsigned gen = old / nloc;
        if (old + 1u == (gen + 1u) * nloc) {
            __builtin_amdgcn_fence(__ATOMIC_RELEASE, "agent");
            asm volatile("s_waitcnt vmcnt(0)" ::: "memory");
            const unsigned og = xb_add(&bar[XB_TOP], 1u);
            const unsigned tg = og / nx;
            if (og + 1u == (tg + 1u) * nx) xb_add(&bar[XB_TOPGEN], 1u);
            else XB_SPIN(xb_ld(&bar[XB_TOPGEN]) == tg, bar);
            __builtin_amdgcn_fence(__ATOMIC_ACQUIRE, "agent");
            xb_add(&bar[XB_XGEN(b.x)], 1u);
            asm volatile("s_waitcnt vmcnt(0)" ::: "memory");
        } else {
            XB_SPIN(xb_ld(&bar[XB_XGEN(b.x)]) == gen, bar);
            __builtin_amdgcn_fence(__ATOMIC_ACQUIRE, "agent");
            asm volatile("s_waitcnt vmcnt(0)" ::: "memory");
        }
    }
    __syncthreads();
}

struct Args { const float* in[NIN]; float* out; unsigned char* ws; int ph_lo, ph_hi; };
enum { I_XP = 0, I_XS, I_MEM, I_SCA, I_SRET, I_SSH, I_SWKV, I_SCD, I_CMK, I_CMV, I_GMIX, I_WIN, I_CAW, I_MU, I_W0, I_W2, I_A0, I_A2, I_G2, I_KK, I_KA, I_RK, I_LNXG, I_LNXB,
       I_CDW, I_CDB, I_LNDG, I_LNDB, I_WOUT, I_GXA, I_GMEM, I_WQ, I_WK, I_WV, I_WO, I_GMLP, I_WUP, I_WDN, I_GFIN };

struct Ctx { LAS unsigned char* lds; int tid, lane, wave, G, bid; };
typedef const GAS float* gcfp;
#define CAS __attribute__((address_space(4)))
struct Ax { const CAS gcfp* kp; float* out; unsigned char* ws;
    __device__ __forceinline__ const float* in(int i) const { return (const float*)kp[i]; } };
__device__ __forceinline__ Ax mk_ax() { const CAS gcfp* kp = (const CAS gcfp*)__builtin_amdgcn_kernarg_segment_ptr(); asm volatile("" : "+s"(kp)); Ax a; a.kp = kp;
    a.out = (float*)(GAS float*)kp[NIN]; a.ws = (unsigned char*)(GAS unsigned char*)kp[NIN + 1]; return a; }
__device__ __forceinline__ Ctx mk_ctx(LAS unsigned char* lds, int wave_s) { unsigned z = 0u; asm volatile("" : "+v"(z)); int t = wave_s * 64 + (int)__builtin_amdgcn_mbcnt_hi(~0u, __builtin_amdgcn_mbcnt_lo(~0u, z)); Ctx C; C.lds = lds; C.tid = t; C.lane = t & 63; C.wave = __builtin_amdgcn_readfirstlane(t >> 6); C.G = gridDim.x; C.bid = blockIdx.x; return C; }

__device__ __forceinline__ void p0_transpose_item(const float* W, int K, int N, bf16* WT, int ldk, int row_off, LAS float* scr, int item, int lane, const float* gain) {
    const int nblk = N / 64, kb = item / nblk, nb = item - kb * nblk, k0 = 64 * kb, n0 = 64 * nb;
    const int lr = lane >> 4, lc = (lane & 15) * 4;
#pragma unroll 8
    for (int i = 0; i < 16; ++i) { const int kk = 4 * i + lr; const float g = gain ? gain[k0 + kk] : 1.0f; const f32x4 v = *(const f32x4*)(W + (size_t)(k0 + kk) * N + n0 + lc);
        LAS float* d = scr + kk * 65 + lc; d[0] = v.x * g; d[1] = v.y * g; d[2] = v.z * g; d[3] = v.w * g; }
    LDS_WAIT(); asm volatile("" ::: "memory");
    const int c = lane & 7;
#pragma unroll
    for (int j = 0; j < 8; ++j) { const int n = (lane >> 3) + 8 * j; const LAS float* s = scr + (8 * c) * 65 + n;
        v4u o; o.x = pk2(s[0 * 65], s[1 * 65]); o.y = pk2(s[2 * 65], s[3 * 65]); o.z = pk2(s[4 * 65], s[5 * 65]); o.w = pk2(s[6 * 65], s[7 * 65]);
        if (ldk > 0) *(v4u*)(WT + (size_t)(row_off + n0 + n) * ldk + k0 + 8 * c) = o;
        else *(v4u*)(WT + ((size_t)kb * (size_t)(-ldk) + row_off + n0 + n) * 64 + 8 * c) = o; }
    LDS_WAIT(); asm volatile("" ::: "memory");
}
__device__ __forceinline__ void rms_row(const float* xrow, bf16* orow, float* xcopy, int lane) {
    const f32x4* xr = (const f32x4*)xrow + lane;
    f32x4 v[8]; float s = 0.f;
#pragma unroll
    for (int j = 0; j < 8; ++j) { v[j] = xr[64 * j]; s += (v[j].x * v[j].x + v[j].y * v[j].y) + (v[j].z * v[j].z + v[j].w * v[j].w); }
    const float rs = 1.0f / sqrtf(wave_sum(s) * (1.0f / DM) + 1e-6f);
    if (xcopy) {
#pragma unroll
        for (int j = 0; j < 8; ++j) ((f32x4*)xcopy + lane)[64 * j] = v[j]; }
    unsigned long long* o8 = (unsigned long long*)orow + lane;
#pragma unroll
    for (int j = 0; j < 8; ++j) o8[64 * j] = (unsigned long long)pk2(v[j].x * rs, v[j].y * rs) | ((unsigned long long)pk2(v[j].z * rs, v[j].w * rs) << 32);
}
__device__ __forceinline__ void rms_phase(const Ctx& C, const float* X, bf16* HN, bf16* HNS) {
    const int gw = C.bid * NWAVES + C.wave, NGW = C.G * NWAVES;
    f32x4 v[8], nx[8]; int m = gw;
    if (m < MT) { const f32x4* xr = (const f32x4*)(X + (size_t)m * DM) + C.lane;
#pragma unroll
        for (int j = 0; j < 8; ++j) v[j] = xr[64 * j]; }
    for (; m < MT; m += NGW) {
        const int mn = m + NGW;
        if (mn < MT) { const f32x4* xr = (const f32x4*)(X + (size_t)mn * DM) + C.lane;
#pragma unroll
            for (int j = 0; j < 8; ++j) nx[j] = xr[64 * j]; }
        float s = 0.f;
#pragma unroll
        for (int j = 0; j < 8; ++j) s += (v[j].x * v[j].x + v[j].y * v[j].y) + (v[j].z * v[j].z + v[j].w * v[j].w);
        const float rs = 1.0f / sqrtf(wave_sum(s) * (1.0f / DM) + 1e-6f);
        unsigned long long* o8 = (unsigned long long*)((HNS && m >= MP) ? HNS + (size_t)(m - MP) * DMS : HN + (size_t)m * DM) + C.lane;
#pragma unroll
        for (int j = 0; j < 8; ++j) o8[64 * j] = (unsigned long long)pk2(v[j].x * rs, v[j].y * rs) | ((unsigned long long)pk2(v[j].z * rs, v[j].w * rs) << 32);
#pragma unroll
        for (int j = 0; j < 8; ++j) v[j] = nx[j];
    }
}
__device__ __forceinline__ void fold_split_rows(const Ctx& C, float* X, const float* S) {
    const int gw = C.bid * NWAVES + C.wave, NGW = C.G * NWAVES;
    for (int r = gw; r < NS; r += NGW) { f32x4* xr = (f32x4*)(X + (size_t)(MP + r) * DM) + C.lane; const f32x4* s0 = (const f32x4*)(S + (size_t)r * DM) + C.lane; const f32x4* s1 = (const f32x4*)(S + (size_t)(NS + r) * DM) + C.lane;
#pragma unroll
        for (int j = 0; j < 8; ++j) xr[64 * j] = xr[64 * j] + (s0[64 * j] + s1[64 * j]); }
    asm volatile("s_waitcnt vmcnt(0)" ::: "memory");
}
__device__ __forceinline__ void final_norm_phase(const Ctx& C, const float* X, const float* g, float* out) {
    const int gw = C.bid * NWAVES + C.wave, NGW = C.G * NWAVES;
    for (int m = gw; m < MT; m += NGW) {
        const f32x4* xr = (const f32x4*)(X + (size_t)m * DM) + C.lane; const f32x4* gr = (const f32x4*)g + C.lane;
        f32x4 v[8]; float s = 0.f;
#pragma unroll
        for (int j = 0; j < 8; ++j) { v[j] = xr[64 * j]; s += (v[j].x * v[j].x + v[j].y * v[j].y) + (v[j].z * v[j].z + v[j].w * v[j].w); }
        const float rs = 1.0f / sqrtf(wave_sum(s) * (1.0f / DM) + 1e-6f);
        f32x4* orow = (f32x4*)(out + (size_t)m * DM) + C.lane;
#pragma unroll
        for (int j = 0; j < 8; ++j) orow[64 * j] = v[j] * rs * gr[64 * j];
    }
}
#ifndef LATE_EXTRA
#define LATE_EXTRA 0
#endif
struct TDesc { const float* W; const float* gain; bf16* WT; int K, N, ldk, row_off, item; };
__device__ __forceinline__ TDesc p0_desc(const Ax& a, int it, int G) {
    constexpr int I_IN = 32 * 100, I_SQ = 32 * 32, I_UP = 32 * 128, I_DN = 128 * 32, I_L64 = 8, I_L128 = 16;
    constexpr int PER_LAYER = I_IN + 5 * I_SQ + I_UP + I_DN + 2 * I_L64 + I_L128;
    const int l = it / PER_LAYER; int r = it - l * PER_LAYER; unsigned char* wl = a.ws + WS_WL + (size_t)l * LW_STRIDE; bf16* wkv = (bf16*)(a.ws + WS_WKV);
    TDesc d; d.row_off = 0; d.gain = nullptr; const bool late = G == 256 && DEPTH == 2, late1 = late && l == 1 && LATE_EXTRA;
    if (r < I_IN) { d.W = a.in(I_WIN) + (size_t)l * DM * PIN; d.K = DM; d.N = PIN; d.WT = (bf16*)(wl + LW_IN); d.ldk = -PIN; d.gain = a.in(I_GMIX) + l * DM; d.item = r; return d; } r -= I_IN;
    if (r < I_SQ) { d.W = a.in(I_WOUT) + (size_t)l * DM * DM; d.K = DM; d.N = DM; d.WT = (bf16*)(wl + LW_OUT); d.ldk = -DM; d.item = late1 ? -1 : r; return d; } r -= I_SQ;
    if (r < I_SQ) { d.W = a.in(I_WQ) + (size_t)l * DM * DM; d.K = DM; d.N = DM; d.WT = (bf16*)(wl + LW_Q); d.ldk = -DM; d.gain = a.in(I_GXA) + l * DM; d.item = late1 ? -1 : r; return d; } r -= I_SQ;
    if (r < I_SQ) { d.W = a.in(I_WO) + (size_t)l * DM * DM; d.K = DM; d.N = DM; d.WT = (bf16*)(wl + LW_O); d.ldk = -DM; d.item = late1 ? -1 : r; return d; } r -= I_SQ;
    if (r < I_SQ) { d.W = a.in(I_WK) + (size_t)l * DM * DM; d.K = DM; d.N = DM; d.WT = wkv; d.ldk = -8192; d.row_off = l * 4096; d.gain = a.in(I_GMEM) + l * DM; d.item = late1 ? -1 : r; return d; } r -= I_SQ;
    if (r < I_SQ) { d.W = a.in(I_WV) + (size_t)l * DM * DM; d.K = DM; d.N = DM; d.WT = wkv; d.ldk = -8192; d.row_off = l * 4096 + 2048; d.gain = a.in(I_GMEM) + l * DM; d.item = late1 ? -1 : r; return d; } r -= I_SQ;
    if (r < I_UP) { d.W = a.in(I_WUP) + (size_t)l * DM * DFF; d.K = DM; d.N = DFF; d.WT = (bf16*)(wl + LW_UP); d.ldk = -DFF; d.gain = a.in(I_GMLP) + l * DM; d.item = late ? -1 : r; return d; } r -= I_UP;
    if (r < I_DN) { d.W = a.in(I_WDN) + (size_t)l * DFF * DM; d.K = DFF; d.N = DM; d.WT = (bf16*)(wl + LW_DN); d.ldk = -DM; d.item = late ? -1 : r; return d; } r -= I_DN;
    if (r < I_L64) { d.W = a.in(I_W2) + (size_t)l * 64 * 512; d.K = 64; d.N = 512; d.WT = (bf16*)(wl + LW_W2); d.ldk = 64; d.item = r; return d; } r -= I_L64;
    if (r < I_L64) { d.W = a.in(I_A2) + (size_t)l * 64 * 512; d.K = 64; d.N = 512; d.WT = (bf16*)(wl + LW_A2); d.ldk = 64; d.item = r; return d; } r -= I_L64;
    d.W = a.in(I_G2) + (size_t)l * 128 * 512; d.K = 128; d.N = 512; d.WT = (bf16*)(wl + LW_G2); d.ldk = 128; d.item = r; return d;
}
__device__ __forceinline__ void p0_load(const TDesc& d, int lane, f32x4 (&v)[16], float (&g)[16]) {
    if (d.item < 0) return;
    const int nblk = d.N / 64, kb = d.item / nblk, nb = d.item - kb * nblk, k0 = 64 * kb, n0 = 64 * nb, lr = lane >> 4, lc = (lane & 15) * 4;
#pragma unroll
    for (int i = 0; i < 16; ++i) { const int kk = 4 * i + lr; g[i] = d.gain ? d.gain[k0 + kk] : 1.0f; v[i] = __builtin_nontemporal_load((const f32x4*)(d.W + (size_t)(k0 + kk) * d.N + n0 + lc)); }
}
__device__ __forceinline__ void p0_finish(const TDesc& d, LAS float* scr, int lane, const f32x4 (&v)[16], const float (&g)[16]) {
    if (d.item < 0) return;
    const int nblk = d.N / 64, kb = d.item / nblk, nb = d.item - kb * nblk, k0 = 64 * kb, n0 = 64 * nb, lr = lane >> 4, lc = (lane & 15) * 4;
#pragma unroll
    for (int i = 0; i < 16; ++i) { const int kk = 4 * i + lr; LAS float* p = scr + kk * 65 + lc; p[0] = v[i].x * g[i]; p[1] = v[i].y * g[i]; p[2] = v[i].z * g[i]; p[3] = v[i].w * g[i]; }
    LDS_WAIT(); asm volatile("" ::: "memory");
    const int c = lane & 7;
#pragma unroll
    for (int j = 0; j < 8; ++j) { const int n = (lane >> 3) + 8 * j; const LAS float* s = scr + (8 * c) * 65 + n;
        v4u o; o.x = pk2(s[0 * 65], s[1 * 65]); o.y = pk2(s[2 * 65], s[3 * 65]); o.z = pk2(s[4 * 65], s[5 * 65]); o.w = pk2(s[6 * 65], s[7 * 65]);
        if (d.ldk > 0) *(v4u*)(d.WT + (size_t)(d.row_off + n0 + n) * d.ldk + k0 + 8 * c) = o;
        else *(v4u*)(d.WT + ((size_t)kb * (size_t)(-d.ldk) + d.row_off + n0 + n) * 64 + 8 * c) = o; }
    LDS_WAIT(); asm volatile("" ::: "memory");
}
__device__ __forceinline__ void p0_prologue(const Ctx& C, const Ax& a) {
    LAS float* scr = (LAS float*)(C.lds + C.wave * 16640);
    const int gw = C.bid * NWAVES + C.wave, NGW = C.G * NWAVES;
    constexpr int I_IN = 32 * 100, I_SQ = 32 * 32, I_UP = 32 * 128, I_DN = 128 * 32, I_L64 = 8, I_L128 = 16;
    constexpr int PER_LAYER = I_IN + 5 * I_SQ + I_UP + I_DN + 2 * I_L64 + I_L128;
    TDesc cur = p0_desc(a, gw, C.G), nxt; f32x4 va[16], vb[16]; float ga[16], gb[16];
    const int NITEMS = DEPTH * PER_LAYER;
    if (gw < NITEMS) p0_load(cur, C.lane, va, ga);
    for (int it = gw; it < NITEMS; it += 2 * NGW) {
        const int it1 = it + NGW, it2 = it + 2 * NGW;
        if (it1 < NITEMS) { nxt = p0_desc(a, it1, C.G); p0_load(nxt, C.lane, vb, gb); }
        p0_finish(cur, scr, C.lane, va, ga);
        if (it1 < NITEMS) { if (it2 < NITEMS) { cur = p0_desc(a, it2, C.G); p0_load(cur, C.lane, va, ga); }
            p0_finish(nxt, scr, C.lane, vb, gb); }
    }
    { float* cs = (float*)(a.ws + WS_ROPE); const int gt = C.bid * (NWAVES * 64) + C.tid, NT = C.G * NWAVES * 64;
      for (int idx = gt; idx < 2049 * 64; idx += NT) { const int p = idx >> 6, i = idx & 63; const double pos = (p == 2048) ? 16384.0 : (double)p;
          const double inv = exp(-(double)i * (9.210340371976184 / 64.0)); double r = pos * inv; r -= 6.283185307179586 * rint(r * 0.15915494309189535);
          cs[2 * idx] = (float)cos(r); cs[2 * idx + 1] = (float)sin(r); } }
    float* XF = (float*)(a.ws + WS_XF); bf16* HN = (bf16*)(a.ws + WS_HN); bf16* MN = (bf16*)(a.ws + WS_MN);
    for (int m = gw; m < MT; m += NGW) { const float* src = (m < MP) ? a.in(I_XP) + (size_t)m * DM : a.in(I_XS) + (size_t)(m - MP) * DM; rms_row(src, HN + (size_t)m * DM, nullptr, C.lane); }
    for (int m = gw; m < MMEM; m += NGW) rms_row(a.in(I_MEM) + (size_t)m * DM, MN + (size_t)m * DM, nullptr, C.lane);
}

__device__ __forceinline__ TDesc lc_desc(const Ax& a, int l, int it) {
    constexpr int I_UP = 32 * 128, I_DN = 128 * 32, I_SQ = 32 * 32;
    unsigned char* wl = a.ws + WS_WL + (size_t)l * LW_STRIDE; TDesc d; d.row_off = 0; d.gain = nullptr;
    if (it < I_UP) { d.W = a.in(I_WUP) + (size_t)l * DM * DFF; d.K = DM; d.N = DFF; d.WT = (bf16*)(wl + LW_UP); d.ldk = -DFF; d.gain = a.in(I_GMLP) + l * DM; d.item = it; return d; }
    int r = it - I_UP;
    if (r < I_DN) { d.W = a.in(I_WDN) + (size_t)l * DFF * DM; d.K = DFF; d.N = DM; d.WT = (bf16*)(wl + LW_DN); d.ldk = -DM; d.item = r; return d; } r -= I_DN;
    d.K = DM; d.N = DM; d.item = r & (I_SQ - 1); const int q = r >> 10;
    if (l == 0) { const int l1 = 1; d.W = a.in(q == 0 ? I_WK : I_WV) + (size_t)l1 * DM * DM; d.WT = (bf16*)(a.ws + WS_WKV); d.ldk = -8192; d.row_off = l1 * 4096 + q * 2048; d.gain = a.in(I_GMEM) + l1 * DM; return d; }
    d.ldk = -DM;
    if (q == 0) { d.W = a.in(I_WOUT) + (size_t)l * DM * DM; d.WT = (bf16*)(wl + LW_OUT); }
    else if (q == 1) { d.W = a.in(I_WQ) + (size_t)l * DM * DM; d.WT = (bf16*)(wl + LW_Q); d.gain = a.in(I_GXA) + l * DM; }
    else { d.W = a.in(I_WO) + (size_t)l * DM * DM; d.WT = (bf16*)(wl + LW_O); }
    return d;
}
__device__ __forceinline__ void late_convert(const Ctx& C, const Ax& a, int l, int rank, int nrank) {
    LAS float* scr = (LAS float*)(C.lds + C.wave * 16640);
    const int NITEMS = 32 * 128 + 128 * 32 + (LATE_EXTRA ? (l == 0 ? 2 : 3) * 1024 : 0);
    const int gw = rank * NWAVES + C.wave, NGW = nrank * NWAVES;
    TDesc cur, nxt; f32x4 va[16], vb[16]; float ga[16], gb[16];
    if (gw < NITEMS) { cur = lc_desc(a, l, gw); p0_load(cur, C.lane, va, ga); }
    for (int it = gw; it < NITEMS; it += 2 * NGW) {
        const int it1 = it + NGW, it2 = it + 2 * NGW;
        if (it1 < NITEMS) { nxt = lc_desc(a, l, it1); p0_load(nxt, C.lane, vb, gb); }
        p0_finish(cur, scr, C.lane, va, ga);
        if (it1 < NITEMS) { if (it2 < NITEMS) { cur = lc_desc(a, l, it2); p0_load(cur, C.lane, va, ga); }
            p0_finish(nxt, scr, C.lane, vb, gb); }
    }
}
__device__ __forceinline__ void ad_prompt_item(const Ctx& C, const Ax& a, int l, int item) {
    const bf16* P = (const bf16*)(a.ws + WS_P); bf16* YC = (bf16*)(a.ws + WS_YC);
    const int b = item >> 6, t0 = (item & 63) * 32; const size_t rbase = (size_t)b * SEQ;
    LAS float* UD = (LAS float*)C.lds;
    { v4u r1[8], r2[8];
#pragma unroll
      for (int u = 0; u < 8; ++u) { const int it = C.tid + u * (NWAVES * 64), r = it >> 6, cc = it & 63, t = t0 - 30 + r; r1[u] = (v4u){0u, 0u, 0u, 0u}; r2[u] = r1[u];
        if (it < 62 * 64 && t >= 0) { const bf16* pr = P + (rbase + t) * PIN + PD_ + cc * 8; r1[u] = *(const v4u*)pr; r2[u] = *(const v4u*)(pr + 512); } }
      __builtin_amdgcn_sched_barrier(0);
#pragma unroll
      for (int u = 0; u < 8; ++u) { const int it = C.tid + u * (NWAVES * 64), r = it >> 6, cc = it & 63;
        if (it < 62 * 64) { float d1[8], d2[8], uu[8]; unpack8(r1[u], d1); unpack8(r2[u], d2);
#pragma unroll
            for (int j = 0; j < 8; ++j) uu[j] = d1[j] * sigm(d2[j]);
            *(LAS f32x4*)(UD + r * 512 + cc * 8) = (f32x4){uu[0], uu[1], uu[2], uu[3]}; *(LAS f32x4*)(UD + r * 512 + cc * 8 + 4) = (f32x4){uu[4], uu[5], uu[6], uu[7]}; } } }
    __builtin_amdgcn_sched_barrier(0);
    { const int cc = C.tid & 63; const float* cw = a.in(I_CAW) + (size_t)l * 3 * 512 + cc * 8;
      const f32x4 w0a = *(const f32x4*)cw, w0b = *(const f32x4*)(cw + 4), w1a = *(const f32x4*)(cw + 512), w1b = *(const f32x4*)(cw + 516), w2a = *(const f32x4*)(cw + 1024), w2b = *(const f32x4*)(cw + 1028);
      const float k0[8] = {w0a.x, w0a.y, w0a.z, w0a.w, w0b.x, w0b.y, w0b.z, w0b.w}, k1[8] = {w1a.x, w1a.y, w1a.z, w1a.w, w1b.x, w1b.y, w1b.z, w1b.w}, k2[8] = {w2a.x, w2a.y, w2a.z, w2a.w, w2b.x, w2b.y, w2b.z, w2b.w};
#pragma unroll
      for (int hb = 0; hb < 2; ++hb) { v4u q[2][7];
#pragma unroll
        for (int u = 0; u < 2; ++u) { const int r = (C.tid >> 6) + (hb * 2 + u) * NWAVES, t = t0 + r; const bf16* pr = P + (rbase + t) * PIN + cc * 8;
#pragma unroll
            for (int z = 0; z < 7; ++z) q[u][z] = (v4u){0u, 0u, 0u, 0u};
            q[u][0] = *(const v4u*)pr; q[u][1] = *(const v4u*)(pr + 512); q[u][2] = *(const v4u*)(pr + 1024);
            if (t >= 1) { q[u][3] = *(const v4u*)(pr - PIN + 512); q[u][4] = *(const v4u*)(pr - PIN + 1024); }
            if (t >= 2) { q[u][5] = *(const v4u*)(pr - 2 * PIN + 512); q[u][6] = *(const v4u*)(pr - 2 * PIN + 1024); } }
        __builtin_amdgcn_sched_barrier(0);
#pragma unroll
        for (int u = 0; u < 2; ++u) { const int r = (C.tid >> 6) + (hb * 2 + u) * NWAVES, t = t0 + r;
            float ab[8], u0[8], u1[8], u2[8], x[8], y[8];
            unpack8(q[u][0], ab); unpack8(q[u][1], x); unpack8(q[u][2], y);
#pragma unroll
            for (int j = 0; j < 8; ++j) u2[j] = x[j] * y[j];
            unpack8(q[u][3], x); unpack8(q[u][4], y);
#pragma unroll
            for (int j = 0; j < 8; ++j) u1[j] = x[j] * y[j];
            unpack8(q[u][5], x); unpack8(q[u][6], y);
#pragma unroll
            for (int j = 0; j < 8; ++j) u0[j] = x[j] * y[j];
            float o[8];
#pragma unroll
            for (int j = 0; j < 8; ++j) o[j] = ab[j] * (k0[j] * u0[j] + k1[j] * u1[j] + k2[j] * u2[j]);
            *(v4u*)(YC + (rbase + t) * DM + cc * 8) = pack8(o);
            if (t >= SEQ - 2) { float* st = a.out + O_CAP + (((size_t)l * NB + b) * 2 + (t - (SEQ - 2))) * 512 + cc * 8; *(f32x4*)st = (f32x4){u2[0], u2[1], u2[2], u2[3]}; *(f32x4*)(st + 4) = (f32x4){u2[4], u2[5], u2[6], u2[7]}; } }
        __builtin_amdgcn_sched_barrier(0); } }
    __syncthreads();
    const int c = C.tid;
    if (t0 == SEQ - 32) { float* st = a.out + O_CDP + ((size_t)l * NB + b) * 30 * 512 + c;
        for (int j = 0; j < 30; ++j) st[(size_t)j * 512] = UD[(32 + j) * 512 + c]; }
    float cv[32];
    { const char* cwb = (const char*)(a.in(I_CDW) + (size_t)l * 31 * 512); const unsigned cof = (unsigned)c * 4u; const float bias = a.in(I_CDB)[l * 512 + c];
      float wt[31];
#pragma unroll
      for (int j = 0; j < 31; ++j) wt[j] = *(const float*)(cwb + (cof + (unsigned)j * 2048u));
      __builtin_amdgcn_sched_barrier(0);
#pragma unroll
      for (int t = 0; t < 32; ++t) cv[t] = bias;
#pragma unroll
      for (int r = 0; r < 62; ++r) { const float ur = UD[r * 512 + c];
#pragma unroll
          for (int t = 0; t < 32; ++t) { const int j = r - t; if (j >= 0 && j < 31) cv[t] += wt[j] * ur; } } }
    __syncthreads();
#pragma unroll
    for (int t = 0; t < 32; ++t) UD[t * 512 + c] = cv[t];
    __syncthreads();
    { const float* lg = a.in(I_LNDG) + l * 512 + C.lane * 8; const float* lb = a.in(I_LNDB) + l * 512 + C.lane * 8;
      const f32x4 g0 = *(const f32x4*)lg, g1 = *(const f32x4*)(lg + 4), b0 = *(const f32x4*)lb, b1 = *(const f32x4*)(lb + 4);
#pragma unroll
      for (int q = 0; q < 4; ++q) { const int t = C.wave * 4 + q; const f32x4 x0 = *(LAS f32x4*)(UD + t * 512 + C.lane * 8), x1 = *(LAS f32x4*)(UD + t * 512 + C.lane * 8 + 4);
        const float mu = wave_sum((x0.x + x0.y) + (x0.z + x0.w) + (x1.x + x1.y) + (x1.z + x1.w)) * (1.0f / 512.0f);
        const f32x4 d0 = x0 - mu, d1 = x1 - mu;
        const float var = wave_sum((d0.x * d0.x + d0.y * d0.y) + (d0.z * d0.z + d0.w * d0.w) + (d1.x * d1.x + d1.y * d1.y) + (d1.z * d1.z + d1.w * d1.w)) * (1.0f / 512.0f);
        const float rstd = 1.0f / sqrtf(var + 1e-6f);
        const f32x4 y0 = d0 * rstd * g0 + b0, y1 = d1 * rstd * g1 + b1; float o[8];
        o[0] = y0.x * sigm(y0.x); o[1] = y0.y * sigm(y0.y); o[2] = y0.z * sigm(y0.z); o[3] = y0.w * sigm(y0.w);
        o[4] = y1.x * sigm(y1.x); o[5] = y1.y * sigm(y1.y); o[6] = y1.z * sigm(y1.z); o[7] = y1.w * sigm(y1.w);
        *(v4u*)(YC + (rbase + t0 + t) * DM + 1536 + C.lane * 8) = pack8(o); } }
    __syncthreads();
}
__device__ __forceinline__ void ad_sample_item(const Ctx& C, const Ax& a, int l, int n) {
    const bf16* P = (const bf16*)(a.ws + WS_P); bf16* YC = (bf16*)(a.ws + WS_YC);
    const int c = C.tid; const bf16* pr = P + (size_t)(MP + n) * PIN;
    LAS float* red = (LAS float*)C.lds;
    { const float* st = a.in(I_SCA) + (((size_t)l * NS + n) * 2) * 512 + c; const float s0 = st[0], s1 = st[512];
      const float ua = bf1(pr[512 + c]) * bf1(pr[1024 + c]); const float* cw = a.in(I_CAW) + (size_t)l * 3 * 512 + c;
      const float y = bf1(pr[c]) * (cw[0] * s0 + cw[512] * s1 + cw[1024] * ua);
      YC[(size_t)(MP + n) * DM + c] = (bf16)(pk2(y, 0.f) & 0xffffu);
      float* o = a.out + O_CAS + (((size_t)l * NS + n) * 2) * 512 + c; o[0] = s1; o[512] = ua; }
    const float* st = a.in(I_SCD) + (((size_t)l * NS + n) * 30) * 512 + c; const float* cw = a.in(I_CDW) + (size_t)l * 31 * 512 + c;
    const float ud = bf1(pr[PD_ + c]) * sigm(bf1(pr[PD_ + 512 + c]));
    float cv = a.in(I_CDB)[l * 512 + c] + cw[30 * 512] * ud;
    float* os = a.out + O_CDS + (((size_t)l * NS + n) * 30) * 512 + c;
#pragma unroll 6
    for (int j = 0; j < 30; ++j) { const float s = st[(size_t)j * 512]; cv += cw[(size_t)j * 512] * s; if (j > 0) os[(size_t)(j - 1) * 512] = s; }
    os[29 * 512] = ud;
    float s = wave_sum(cv); if (C.lane == 0) red[C.wave] = s; __syncthreads();
    float mu = 0.f;
#pragma unroll
    for (int w = 0; w < 8; ++w) mu += red[w];
    mu *= (1.0f / 512.0f); const float d = cv - mu;
    s = wave_sum(d * d); if (C.lane == 0) red[8 + C.wave] = s; __syncthreads();
    float var = 0.f;
#pragma unroll
    for (int w = 0; w < 8; ++w) var += red[8 + w];
    const float rstd = 1.0f / sqrtf(var * (1.0f / 512.0f) + 1e-6f);
    const float y = d * rstd * a.in(I_LNDG)[l * 512 + c] + a.in(I_LNDB)[l * 512 + c];
    YC[(size_t)(MP + n) * DM + 1536 + c] = (bf16)(pk2(y * sigm(y), 0.f) & 0xffffu);
    __syncthreads();
}

__device__ __forceinline__ void shift8(const bf16* cur, const bf16* prevb, const float* prevf, const float* mu, float (&xs)[8]) {
    float pc[8], pv[8]; unpack8(*(const v4u*)cur, pc);
    if (prevb) unpack8(*(const v4u*)prevb, pv);
    else if (prevf) { const f32x4 p0 = *(const f32x4*)prevf, p1 = *(const f32x4*)(prevf + 4); pv[0] = p0.x; pv[1] = p0.y; pv[2] = p0.z; pv[3] = p0.w; pv[4] = p1.x; pv[5] = p1.y; pv[6] = p1.z; pv[7] = p1.w; }
    else {
#pragma unroll
        for (int j = 0; j < 8; ++j) pv[j] = 0.f; }
    const f32x4 m0 = *(const f32x4*)mu, m1 = *(const f32x4*)(mu + 4); const float m[8] = {m0.x, m0.y, m0.z, m0.w, m1.x, m1.y, m1.z, m1.w};
#pragma unroll
    for (int j = 0; j < 8; ++j) xs[j] = pc[j] + (pv[j] - pc[j]) * m[j];
}
__device__ __forceinline__ void shift4(const bf16* cur, const bf16* prevb, const float* prevf, const float* mu, float (&xs)[4]) {
    float pc[4], pv[4]; unpack4(*(const v2u*)cur, pc);
    if (prevb) unpack4(*(const v2u*)prevb, pv);
    else if (prevf) { const f32x4 p0 = *(const f32x4*)prevf; pv[0] = p0.x; pv[1] = p0.y; pv[2] = p0.z; pv[3] = p0.w; }
    else { pv[0] = pv[1] = pv[2] = pv[3] = 0.f; }
    const f32x4 m0 = *(const f32x4*)mu;
    xs[0] = pc[0] + (pv[0] - pc[0]) * m0.x; xs[1] = pc[1] + (pv[1] - pc[1]) * m0.y; xs[2] = pc[2] + (pv[2] - pc[2]) * m0.z; xs[3] = pc[3] + (pv[3] - pc[3]) * m0.w;
}
constexpr int PTS = 1544;
__device__ __forceinline__ void shift4_lds(const LAS bf16* cur, const float* mu, float (&xs)[4]) {
    float pc[4], pv[4]; unpack4(*(const LAS v2u*)cur, pc); unpack4(*(const LAS v2u*)(cur - PTS), pv);
    const f32x4 m0 = *(const f32x4*)mu;
    xs[0] = pc[0] + (pv[0] - pc[0]) * m0.x; xs[1] = pc[1] + (pv[1] - pc[1]) * m0.y; xs[2] = pc[2] + (pv[2] - pc[2]) * m0.z; xs[3] = pc[3] + (pv[3] - pc[3]) * m0.w;
}
constexpr int RWB = 896, RW_KK = 256, RW_KB = 384, RW_K = 512, RW_R = 640, RW_V = 768;
__device__ __forceinline__ void rw_st4(unsigned char* rec, int off, int cl, const f32x4 v) { v2u w; w.x = pk2(v[0], v[1]); w.y = pk2(v[2], v[3]); *(v2u*)(rec + off + cl * 2) = w; }
__device__ __forceinline__ f32x4 rw_ld4(const unsigned char* rec, int off, int cl) { float f[4]; unpack4(*(const v2u*)(rec + off + cl * 2), f); return (f32x4){f[0], f[1], f[2], f[3]}; }
#ifndef DUP_SUB
#define DUP_SUB 0u
#endif
#define PREP_REP(k) for (int prep_rep_ = 0; prep_rep_ < 1 + (int)((DUP_SUB >> (k)) & 1u); ++prep_rep_)
__device__ __forceinline__ void rwkv_prep_item(const Ctx& C, const Ax& a, int l, int item, int t2sel = -1) {
    const bf16* P = (const bf16*)(a.ws + WS_P); float* RW = (float*)(a.ws + WS_RW); float* GATE = (float*)(a.ws + WS_GATE);
    const bool smp = item >= 256; const int row0 = smp ? MP + (item - 256) * 32 : (item >> 6) * SEQ + (item & 63) * 32; const int t0 = smp ? 0 : (item & 63) * 32;
    const float* mu = a.in(I_MU) + (size_t)l * SHW; const float* sst = a.in(I_SSH) + (size_t)l * NS * SHW;
    LAS bf16* AW = (LAS bf16*)C.lds; LAS bf16* AA = AW + 32 * 72; LAS bf16* AG = AA + 32 * 72; LAS bf16* PT = AG + 32 * 136;
    for (int it = C.tid; it < 32 * 32; it += NWAVES * 64) { const int r = it >> 5, cc = it & 31, col = 1536 + cc * 8, row = row0 + r; const bf16* cur = P + (size_t)row * PIN + PC_ + col;
        float xs[8];
        if (smp) shift8(cur, nullptr, sst + (size_t)(row - MP) * SHW + col, mu + col, xs);
        else shift8(cur, (t0 + r > 0) ? cur - PIN : nullptr, nullptr, mu + col, xs);
        if (cc < 8) {
#pragma unroll
            for (int j = 0; j < 8; ++j) xs[j] = tanhf(xs[j]);
            *(LAS v4u*)(AW + r * 72 + cc * 8) = pack8(xs); }
        else if (cc < 16) *(LAS v4u*)(AA + r * 72 + (cc - 8) * 8) = pack8(xs);
        else {
#pragma unroll
            for (int j = 0; j < 8; ++j) xs[j] = sigm(xs[j]);
            *(LAS v4u*)(AG + r * 136 + (cc - 16) * 8) = pack8(xs); } }
    if (!smp) { for (int it = C.tid; it < 33 * 192; it += NWAVES * 64) { const int r = it / 192, cc = it - r * 192; v4u v = (v4u){0u, 0u, 0u, 0u};
            if (t0 + r > 0) v = *(const v4u*)(P + (size_t)(row0 + r - 1) * PIN + PC_ + cc * 8);
            *(LAS v4u*)(PT + r * PTS + cc * 8) = v; } }
    else { const int rb = row0 + 16 * t2sel;
        for (int it = C.tid; it < 16 * 192; it += NWAVES * 64) { const int q = it / 192, cc = it - q * 192;
            const v4u v = *(const v4u*)(P + (size_t)(rb + q) * PIN + PC_ + cc * 8); const float* sp = sst + (size_t)(rb + q - MP) * SHW + cc * 8; const f32x4 s0 = *(const f32x4*)sp, s1 = *(const f32x4*)(sp + 4);
            const float sf[8] = {s0.x, s0.y, s0.z, s0.w, s1.x, s1.y, s1.z, s1.w};
            *(LAS v4u*)(PT + (2 * q + 1) * PTS + cc * 8) = v; *(LAS v4u*)(PT + (2 * q) * PTS + cc * 8) = pack8(sf); } }
    if (smp) { float* o = a.out + O_SHS + ((size_t)l * NS + (row0 - MP)) * SHW;
        for (int it = C.tid + (t2sel > 0 ? 16 * 224 : 0); it < (t2sel == 0 ? 16 : 32) * 224; it += NWAVES * 64) { const int r = it / 224, cc = it % 224; float f[8]; unpack8(*(const v4u*)(P + (size_t)(row0 + r) * PIN + PC_ + cc * 8), f);
            float* op = o + (size_t)r * SHW + cc * 8; *(f32x4*)op = (f32x4){f[0], f[1], f[2], f[3]}; *(f32x4*)(op + 4) = (f32x4){f[4], f[5], f[6], f[7]}; } }
    else if (t0 == SEQ - 32) { float* o = a.out + O_SHP + ((size_t)l * NB + (item >> 6)) * SHW;
        for (int cc = C.tid; cc < 224; cc += NWAVES * 64) { float f[8]; unpack8(*(const v4u*)(P + (size_t)(row0 + 31) * PIN + PC_ + cc * 8), f);
            *(f32x4*)(o + cc * 8) = (f32x4){f[0], f[1], f[2], f[3]}; *(f32x4*)(o + cc * 8 + 4) = (f32x4){f[4], f[5], f[6], f[7]}; } }
    __syncthreads();
    const int h = C.wave, fr = C.lane & 15, fq = C.lane >> 4;
    const unsigned char* wl = a.ws + WS_WL + (size_t)l * LW_STRIDE;
    const bf16* W2t = (const bf16*)(wl + LW_W2); const bf16* A2t = (const bf16*)(wl + LW_A2); const bf16* G2t = (const bf16*)(wl + LW_G2);
    PREP_REP(23) { constexpr int tp = 0;
        f32x4 acc[4][2];
#pragma unroll
        for (int ct = 0; ct < 4; ++ct)
#pragma unroll
            for (int t2 = 0; t2 < 2; ++t2) acc[ct][t2] = zero4();
#pragma unroll
        for (int ks = 0; ks < 2; ++ks) { bf16x8 af[2], wf[4];
#pragma unroll
            for (int t2 = 0; t2 < 2; ++t2) af[t2] = *(const LAS bf16x8*)(AA + (tp * 32 + t2 * 16 + fr) * 72 + ks * 32 + fq * 8);
#pragma unroll
            for (int ct = 0; ct < 4; ++ct) wf[ct] = *(const bf16x8*)(A2t + (size_t)(h * 64 + ct * 16 + fr) * 64 + ks * 32 + fq * 8);
#pragma unroll
            for (int ct = 0; ct < 4; ++ct)
#pragma unroll
                for (int t2 = 0; t2 < 2; ++t2) acc[ct][t2] = __builtin_amdgcn_mfma_f32_16x16x32_bf16(wf[ct], af[t2], acc[ct][t2], 0, 0, 0); }
        const float* a0 = a.in(I_A0) + l * 512; const float* kkw = a.in(I_KK) + l * 512; const float* kaw = a.in(I_KA) + l * 512;
#pragma unroll
        for (int t2 = 0; t2 < 2; ++t2) { if (t2sel >= 0 && t2 != t2sel) continue; const int r = tp * 32 + t2 * 16 + fr, row = row0 + r;
            const LAS bf16* ptr_ = PT + (smp ? 2 * fr + 1 : r + 1) * PTS;
            float kkr[4][4], av[4][4], kc[4][4]; float ss = 0.f;
#pragma unroll
            for (int ct = 0; ct < 4; ++ct) { const int ch = h * 64 + ct * 16 + fq * 4; const f32x4 a0v = *(const f32x4*)(a0 + ch), kkv = *(const f32x4*)(kkw + ch);
                float xs[4]; shift4_lds(ptr_ + 512 + ch, mu + 512 + ch, xs);
#pragma unroll
                for (int j = 0; j < 4; ++j) { av[ct][j] = sigm(a0v[j] + acc[ct][t2][j]); kc[ct][j] = xs[j]; kkr[ct][j] = xs[j] * kkv[j]; ss += kkr[ct][j] * kkr[ct][j]; } }
            ss += __shfl_xor(ss, 16); ss += __shfl_xor(ss, 32);
            const float inv = 1.0f / fmaxf(sqrtf(ss), 1e-12f);
            unsigned char* rw = (unsigned char*)RW + ((size_t)row * 8 + h) * RWB;
#pragma unroll
            for (int ct = 0; ct < 4; ++ct) { const int ch = h * 64 + ct * 16 + fq * 4, cl = ct * 16 + fq * 4; const f32x4 kav = *(const f32x4*)(kaw + ch);
                f32x4 kk, kb, k4;
#pragma unroll
                for (int j = 0; j < 4; ++j) { kk[j] = kkr[ct][j] * inv; kb[j] = kk[j] * av[ct][j]; k4[j] = kc[ct][j] * (1.0f + (av[ct][j] - 1.0f) * kav[j]); }
                rw_st4(rw, RW_KK, cl, kk); rw_st4(rw, RW_KB, cl, kb); rw_st4(rw, RW_K, cl, k4);
                float xr[4], xv[4];
                shift4_lds(ptr_ + ch, mu + ch, xr); shift4_lds(ptr_ + 1024 + ch, mu + 1024 + ch, xv);
                rw_st4(rw, RW_R, cl, (f32x4){xr[0], xr[1], xr[2], xr[3]}); rw_st4(rw, RW_V, cl, (f32x4){xv[0], xv[1], xv[2], xv[3]}); } }
    }
    PREP_REP(24) { constexpr int tp = 0;
        f32x4 acc[4][2];
#pragma unroll
        for (int ct = 0; ct < 4; ++ct)
#pragma unroll
            for (int t2 = 0; t2 < 2; ++t2) acc[ct][t2] = zero4();
#pragma unroll
        for (int ks = 0; ks < 2; ++ks) { bf16x8 af[2], wf[4];
#pragma unroll
            for (int t2 = 0; t2 < 2; ++t2) af[t2] = *(const LAS bf16x8*)(AW + (tp * 32 + t2 * 16 + fr) * 72 + ks * 32 + fq * 8);
#pragma unroll
            for (int ct = 0; ct < 4; ++ct) wf[ct] = *(const bf16x8*)(W2t + (size_t)(h * 64 + ct * 16 + fr) * 64 + ks * 32 + fq * 8);
#pragma unroll
            for (int ct = 0; ct < 4; ++ct)
#pragma unroll
                for (int t2 = 0; t2 < 2; ++t2) acc[ct][t2] = __builtin_amdgcn_mfma_f32_16x16x32_bf16(wf[ct], af[t2], acc[ct][t2], 0, 0, 0); }
        const float* w0 = a.in(I_W0) + l * 512;
#pragma unroll
        for (int t2 = 0; t2 < 2; ++t2) { if (t2sel >= 0 && t2 != t2sel) continue; const int row = row0 + tp * 32 + t2 * 16 + fr; float* rw = (float*)((unsigned char*)RW + ((size_t)row * 8 + h) * RWB);
#pragma unroll
            for (int ct = 0; ct < 4; ++ct) { const int ch = h * 64 + ct * 16 + fq * 4, cl = ct * 16 + fq * 4; const f32x4 w0v = *(const f32x4*)(w0 + ch); f32x4 d;
#pragma unroll
                for (int j = 0; j < 4; ++j) { const float z = -(w0v[j] + acc[ct][t2][j]); const float sp = fmaxf(z, 0.f) + __logf(1.0f + __expf(-fabsf(z))); const float w = -sp - 0.5f; d[j] = -__expf(w); }
                *(f32x4*)(rw + cl) = d; } }
    }
    PREP_REP(25) { constexpr int tp = 0;
        f32x4 acc[4][2];
#pragma unroll
        for (int ct = 0; ct < 4; ++ct)
#pragma unroll
            for (int t2 = 0; t2 < 2; ++t2) acc[ct][t2] = zero4();
#pragma unroll
        for (int ks = 0; ks < 4; ++ks) { bf16x8 af[2], wf[4];
#pragma unroll
            for (int t2 = 0; t2 < 2; ++t2) af[t2] = *(const LAS bf16x8*)(AG + (tp * 32 + t2 * 16 + fr) * 136 + ks * 32 + fq * 8);
#pragma unroll
            for (int ct = 0; ct < 4; ++ct) wf[ct] = *(const bf16x8*)(G2t + (size_t)(h * 64 + ct * 16 + fr) * 128 + ks * 32 + fq * 8);
#pragma unroll
            for (int ct = 0; ct < 4; ++ct)
#pragma unroll
                for (int t2 = 0; t2 < 2; ++t2) acc[ct][t2] = __builtin_amdgcn_mfma_f32_16x16x32_bf16(wf[ct], af[t2], acc[ct][t2], 0, 0, 0); }
#pragma unroll
        for (int t2 = 0; t2 < 2; ++t2) { if (t2sel >= 0 && t2 != t2sel) continue; const int row = row0 + tp * 32 + t2 * 16 + fr;
#pragma unroll
            for (int ct = 0; ct < 4; ++ct) *(f32x4*)(GATE + (size_t)row * 512 + h * 64 + ct * 16 + fq * 4) = acc[ct][t2]; }
    }
    __syncthreads();
}

#define PACK8(arr, o) ((v4u){pk2((arr)[(o)], (arr)[(o) + 1]), pk2((arr)[(o) + 2], (arr)[(o) + 3]), pk2((arr)[(o) + 4], (arr)[(o) + 5]), pk2((arr)[(o) + 6], (arr)[(o) + 7])})
constexpr int WK_LDS = 18432, WK_SHR = 6912, WK_PRV = 3072;
__device__ __forceinline__ f32x4 mfma16(bf16x4 a, bf16x4 b, f32x4 c) { return __builtin_amdgcn_mfma_f32_16x16x16bf16_1k(a, b, c, 0, 0, 0); }
__device__ __forceinline__ bf16 bfr1(float x) { return (bf16)(pk2(x, 0.f) & 0xffffu); }
__device__ __forceinline__ void wkv_chunk_witem(const Ctx& C, const Ax& a, int ci) {
    const float* RW = (const float*)(a.ws + WS_RW);
    unsigned char* CK = a.ws + WS_CK + (size_t)ci * WK_SHR; unsigned char* CP = a.ws + WS_CP + (size_t)ci * 4 * WK_PRV;
    const int bh = ci >> 7, c = ci & 127, b = bh >> 3, h = bh & 7, lane = C.lane, fr = lane & 15, fq = lane >> 4;
    LAS unsigned char* Lb = C.lds + C.wave * WK_LDS;
    LAS bf16* TA = (LAS bf16*)Lb; LAS bf16* TB = TA + 16 * 72; LAS bf16* TK = TB + 16 * 72; LAS bf16* TR = TK + 16 * 72; LAS bf16* VT = TR + 16 * 72;
    LAS float* M1 = (LAS float*)(Lb + 12288); LAS float* M2 = M1 + 320; LAS float* N1 = M2 + 320; LAS float* N2 = N1 + 320;
    LAS bf16* TG = TA; LAS bf16* PST = TK;
    const unsigned char* rw = (const unsigned char*)RW + (((size_t)b * SEQ + c * 16) * 8 + h) * RWB;
#define RWF(t) (*(const float*)(rw + (size_t)(t) * (8 * RWB) + lane * 4))
#define RWH(t, off) bf1(*(const bf16*)(rw + (size_t)(t) * (8 * RWB) + (off) + lane * 2))
    float lam[16];
#pragma unroll
    for (int t = 0; t < 16; ++t) lam[t] = RWF(t);
    __builtin_amdgcn_sched_barrier(0);
#pragma unroll
    for (int t = 1; t < 16; ++t) lam[t] += lam[t - 1];
    const float lamT = lam[15];
    ((float*)CK)[lane] = __expf(lamT);
    float Bp[16], Kp[16], al[16], ro[16];
    bf16* ATg = (bf16*)(CK + 256); bf16* OMg = (bf16*)(CK + 256 + 2304);
#define RWR(t, off) (*(const bf16*)(rw + (size_t)(t) * (8 * RWB) + (off) + lane * 2))
    bf16 wkk[4], wbb[4], wkx[4], wrr[4], wvv[4];
#pragma unroll
    for (int t = 0; t < 4; ++t) { wkk[t] = RWR(t, RW_KK); wbb[t] = RWR(t, RW_KB); wkx[t] = RWR(t, RW_K); wrr[t] = RWR(t, RW_R); wvv[t] = RWR(t, RW_V); }
    __builtin_amdgcn_sched_barrier(0);
#pragma unroll
    for (int t = 0; t < 16; ++t) { const float kk = bf1(wkk[t & 3]), bb = bf1(wbb[t & 3]), kx = bf1(wkx[t & 3]), rr = bf1(wrr[t & 3]), vv = bf1(wvv[t & 3]);
        if (t + 4 < 16) { wkk[t & 3] = RWR(t + 4, RW_KK); wbb[t & 3] = RWR(t + 4, RW_KB); wkx[t & 3] = RWR(t + 4, RW_K); wrr[t & 3] = RWR(t + 4, RW_R); wvv[t & 3] = RWR(t + 4, RW_V); }
        const float ein = __expf(-lam[t]), eprev = (t ? __expf(lam[t - 1]) : 1.0f), ecur = __expf(lam[t]), erest = __expf(lamT - lam[t]);
        al[t] = kk * eprev; ro[t] = rr * ecur; Bp[t] = bb * erest; Kp[t] = kx * erest;
        const bf16 ab = bfr1(al[t]);
        TA[t * 72 + lane] = ab; TB[t * 72 + lane] = bfr1(bb * ein); TK[t * 72 + lane] = bfr1(kx * ein); TR[t * 72 + lane] = bfr1(ro[t]); VT[lane * 24 + t] = bfr1(vv);
        ATg[t * 72 + lane] = ab;
        asm volatile("" ::: "memory"); __builtin_amdgcn_sched_barrier(0); }
    LDS_WAIT(); asm volatile("" ::: "memory");
    { f32x4 g1 = zero4(), g2 = zero4(), n1 = zero4(), n2 = zero4();
#pragma unroll
      for (int ks = 0; ks < 2; ++ks) { const int o = fr * 72 + ks * 32 + fq * 8;
        const bf16x8 bf_ = *(const LAS bf16x8*)(TB + o), kf_ = *(const LAS bf16x8*)(TK + o), af_ = *(const LAS bf16x8*)(TA + o), rf_ = *(const LAS bf16x8*)(TR + o);
        g1 = __builtin_amdgcn_mfma_f32_16x16x32_bf16(bf_, af_, g1, 0, 0, 0); g2 = __builtin_amdgcn_mfma_f32_16x16x32_bf16(kf_, af_, g2, 0, 0, 0);
        n1 = __builtin_amdgcn_mfma_f32_16x16x32_bf16(bf_, rf_, n1, 0, 0, 0); n2 = __builtin_amdgcn_mfma_f32_16x16x32_bf16(kf_, rf_, n2, 0, 0, 0); }
#pragma unroll
      for (int r = 0; r < 4; ++r) { const int s_ = 4 * fq + r, o = s_ * 20 + fr;
        M1[o] = (s_ < fr) ? g1[r] : 0.f; M2[o] = (s_ < fr) ? g2[r] : 0.f; N1[o] = (s_ <= fr) ? n1[r] : 0.f; N2[o] = (s_ <= fr) ? n2[r] : 0.f; } }
    LDS_WAIT(); asm volatile("" ::: "memory");
    __builtin_amdgcn_sched_barrier(0);
#pragma unroll
    for (int s_ = 14; s_ >= 0; --s_) { float m[16];
#pragma unroll
        for (int q = 0; q < 4; ++q) { const f32x4 v = *(const LAS f32x4*)(M1 + s_ * 20 + 4 * q); m[4 * q] = v.x; m[4 * q + 1] = v.y; m[4 * q + 2] = v.z; m[4 * q + 3] = v.w; }
        float acc = Bp[s_];
#pragma unroll
        for (int t = s_ + 1; t < 16; ++t) acc -= m[t] * Bp[t];
        asm volatile("" : "+v"(acc) :: "memory"); Bp[s_] = acc; __builtin_amdgcn_sched_barrier(0); }
#pragma unroll
    for (int s_ = 0; s_ < 15; ++s_) { float m[16];
#pragma unroll
        for (int q = 0; q < 4; ++q) { const f32x4 v = *(const LAS f32x4*)(M2 + s_ * 20 + 4 * q); m[4 * q] = v.x; m[4 * q + 1] = v.y; m[4 * q + 2] = v.z; m[4 * q + 3] = v.w; }
        float acc = Kp[s_];
#pragma unroll
        for (int t = s_ + 1; t < 16; ++t) acc -= m[t] * Bp[t];
        asm volatile("" : "+v"(acc) :: "memory"); Kp[s_] = acc; __builtin_amdgcn_sched_barrier(0); }
    __builtin_amdgcn_sched_barrier(0);
    { float ng[16];
#pragma unroll
      for (int t = 0; t < 16; ++t) ng[t] = -Bp[t];
      *(v4u*)(CK + 256 + 4608 + lane * 32) = PACK8(ng, 0); *(v4u*)(CK + 256 + 4608 + lane * 32 + 16) = PACK8(ng, 8); }
    *(LAS v4u*)(TG + lane * 24) = PACK8(Kp, 0); *(LAS v4u*)(TG + lane * 24 + 8) = PACK8(Kp, 8);
    __builtin_amdgcn_sched_barrier(0);
    { float hh[16], ps[16];
#pragma unroll
      for (int s_ = 0; s_ < 16; ++s_) { hh[s_] = N1[s_ * 20 + fr]; ps[s_] = N2[s_ * 20 + fr]; }
#pragma unroll
      for (int s_ = 14; s_ >= 0; --s_) { float m[16];
#pragma unroll
        for (int q = 0; q < 4; ++q) { const f32x4 v = *(const LAS f32x4*)(M1 + s_ * 20 + 4 * q); m[4 * q] = v.x; m[4 * q + 1] = v.y; m[4 * q + 2] = v.z; m[4 * q + 3] = v.w; }
        float acc = hh[s_];
#pragma unroll
        for (int u = s_ + 1; u < 16; ++u) acc -= m[u] * hh[u];
        asm volatile("" : "+v"(acc) :: "memory"); hh[s_] = acc; __builtin_amdgcn_sched_barrier(0); }
#pragma unroll
      for (int s_ = 0; s_ < 15; ++s_) { float m[16];
#pragma unroll
        for (int q = 0; q < 4; ++q) { const f32x4 v = *(const LAS f32x4*)(M2 + s_ * 20 + 4 * q); m[4 * q] = v.x; m[4 * q + 1] = v.y; m[4 * q + 2] = v.z; m[4 * q + 3] = v.w; }
        float acc = ps[s_];
#pragma unroll
        for (int u = s_ + 1; u < 16; ++u) acc -= m[u] * hh[u];
        asm volatile("" : "+v"(acc) :: "memory"); ps[s_] = acc; __builtin_amdgcn_sched_barrier(0); }
      LDS_WAIT(); asm volatile("" ::: "memory");
#pragma unroll
      for (int s_ = 0; s_ < 16; ++s_) N1[s_ * 20 + fr] = hh[s_];
      *(LAS v4u*)(PST + fr * 24) = PACK8(ps, 0); *(LAS v4u*)(PST + fr * 24 + 8) = PACK8(ps, 8); }
    LDS_WAIT(); asm volatile("" ::: "memory");
    __builtin_amdgcn_sched_barrier(0);
#pragma unroll
    for (int s_ = 0; s_ < 16; ++s_) { float m[16];
#pragma unroll
        for (int q = 0; q < 4; ++q) { const f32x4 v = *(const LAS f32x4*)(N1 + s_ * 20 + 4 * q); m[4 * q] = v.x; m[4 * q + 1] = v.y; m[4 * q + 2] = v.z; m[4 * q + 3] = v.w; }
#pragma unroll
        for (int t = s_; t < 16; ++t) ro[t] -= m[t] * al[s_];
        asm volatile("" ::: "memory"); __builtin_amdgcn_sched_barrier(0); }
#pragma unroll
    for (int t = 0; t < 16; ++t) OMg[t * 72 + lane] = bfr1(ro[t]);
    LDS_WAIT(); asm volatile("" ::: "memory");
    __builtin_amdgcn_sched_barrier(0);
    { bf16x4 vf[4];
#pragma unroll
      for (int it = 0; it < 4; ++it) vf[it] = *(const LAS bf16x4*)(VT + (it * 16 + fr) * 24 + fq * 4);
#pragma unroll
      for (int kt = 0; kt < 4; ++kt) { const bf16x4 gf = *(const LAS bf16x4*)(TG + (kt * 16 + fr) * 24 + fq * 4);
#pragma unroll
        for (int it = 0; it < 4; ++it) { const f32x4 d = mfma16(gf, vf[it], zero4()); v2u dw; dw.x = pk2(d[0], d[1]); dw.y = pk2(d[2], d[3]); *(v2u*)(CP + it * WK_PRV + kt * 512 + lane * 8) = dw; } }
      const bf16x4 pf = *(const LAS bf16x4*)(PST + fr * 24 + fq * 4);
#pragma unroll
      for (int it = 0; it < 4; ++it) { const f32x4 o = mfma16(pf, vf[it], zero4()); *(f32x4*)(CP + it * WK_PRV + 2048 + lane * 16) = o; } }
    LDS_WAIT(); asm volatile("" ::: "memory");
}
constexpr int WQ_CH = WK_PRV + WK_SHR, WQ_SLOT = 4 * WQ_CH, WQ_PCS = WQ_CH / 16, WQ_NWL = 4 * WQ_PCS / 64;
__device__ __forceinline__ void wkv_seq_chunk(const LAS unsigned char* sp, f32x4 (&acc)[4], float* orow, int lane, int fr, int fq) {
    const LAS unsigned char* sh = sp + WK_PRV;
    bf16x8 af[2], of[2]; bf16x4 gf[4]; f32x4 wt[4], dt[4];
#pragma unroll
    for (int s = 0; s < 2; ++s) { const LAS bf16* ap = (const LAS bf16*)(sh + 256) + fr * 72 + 32 * s + 4 * fq; const v2u lo = *(const LAS v2u*)ap, hi = *(const LAS v2u*)(ap + 16);
        af[s] = __builtin_bit_cast(bf16x8, (v4u){lo.x, lo.y, hi.x, hi.y});
        const LAS bf16* op = (const LAS bf16*)(sh + 256 + 2304) + fr * 72 + 32 * s + 4 * fq; const v2u lo2 = *(const LAS v2u*)op, hi2 = *(const LAS v2u*)(op + 16);
        of[s] = __builtin_bit_cast(bf16x8, (v4u){lo2.x, lo2.y, hi2.x, hi2.y}); }
#pragma unroll
    for (int kt = 0; kt < 4; ++kt) { gf[kt] = *(const LAS bf16x4*)((const LAS bf16*)(sh + 256 + 4608) + (kt * 16 + fr) * 16 + 4 * fq);
        wt[kt] = *(const LAS f32x4*)(sh + (16 * kt + 4 * fq) * 4); { float f_[4]; unpack4(*(const LAS v2u*)(sp + kt * 512 + lane * 8), f_); dt[kt] = (f32x4){f_[0], f_[1], f_[2], f_[3]}; } }
    const f32x4 ov = *(const LAS f32x4*)(sp + 2048 + lane * 16);
    bf16x8 sbf[2];
#pragma unroll
    for (int s = 0; s < 2; ++s) { v4u w; w.x = pk2(acc[2 * s][0], acc[2 * s][1]); w.y = pk2(acc[2 * s][2], acc[2 * s][3]); w.z = pk2(acc[2 * s + 1][0], acc[2 * s + 1][1]); w.w = pk2(acc[2 * s + 1][2], acc[2 * s + 1][3]);
        sbf[s] = __builtin_bit_cast(bf16x8, w); }
    f32x4 x = zero4();
    x = __builtin_amdgcn_mfma_f32_16x16x32_bf16(af[0], sbf[0], x, 0, 0, 0); x = __builtin_amdgcn_mfma_f32_16x16x32_bf16(af[1], sbf[1], x, 0, 0, 0);
    f32x4 o = __builtin_amdgcn_mfma_f32_16x16x32_bf16(of[0], sbf[0], ov, 0, 0, 0); o = __builtin_amdgcn_mfma_f32_16x16x32_bf16(of[1], sbf[1], o, 0, 0, 0);
    v2u xw; xw.x = pk2(x[0], x[1]); xw.y = pk2(x[2], x[3]); const bf16x4 xb = __builtin_bit_cast(bf16x4, xw);
#pragma unroll
    for (int kt = 0; kt < 4; ++kt) acc[kt] = mfma16(gf[kt], xb, acc[kt] * wt[kt] + dt[kt]);
    orow[0] = o[0]; orow[512] = o[1]; orow[1024] = o[2]; orow[1536] = o[3];
}
__device__ __forceinline__ void wkv_seq_item(const Ctx& C, const Ax& a, int l, int item) {
    const int bh = item >> 2, rg = item & 3, b = bh >> 3, h = bh & 7, lane = C.lane, fr = lane & 15, fq = lane >> 4;
    const unsigned char* CK = a.ws + WS_CK + (size_t)bh * 128 * WK_SHR; const unsigned char* CP = a.ws + WS_CP + ((size_t)bh * 128 * 4 + rg) * WK_PRV;
    float* OC = (float*)(a.ws + WS_OC) + ((size_t)b * SEQ) * 512 + h * 64 + rg * 16 + fr;
#define WQ_COMPUTE(blk) do { const LAS unsigned char* sbp = C.lds + ((blk) % 3) * WQ_SLOT; \
            _Pragma("unroll 2") for (int cq = 0; cq < 4; ++cq) wkv_seq_chunk(sbp + cq * WQ_CH, acc, OC + (size_t)(((blk) * 4 + cq) * 16 + 4 * fq) * 512, lane, fr, fq); } while (0)
    static_assert(4 * WQ_PCS == WQ_NWL * 64 && WQ_NWL > 35 && WQ_NWL <= 42 && 3 * WQ_SLOT <= SCR_BYTES, "ring geometry");
    if (C.wave == 0) {
        f32x4 acc[4];
#pragma unroll
        for (int kt = 0; kt < 4; ++kt) acc[kt] = zero4();
        __builtin_amdgcn_s_barrier(); asm volatile("" ::: "memory");
        for (int blk = 0; blk < 32; ++blk) { WQ_COMPUTE(blk); asm volatile("s_waitcnt lgkmcnt(0)" ::: "memory"); __builtin_amdgcn_s_barrier(); asm volatile("" ::: "memory"); }
        float* so = a.out + O_WKVP + ((((size_t)l * NB + b) * 8 + h) * 64 + rg * 16 + fr) * 64 + 4 * fq;
#pragma unroll
        for (int kt = 0; kt < 4; ++kt) *(f32x4*)(so + 16 * kt) = acc[kt];
    } else {
        const int w1 = C.wave - 1; const bool seven = (w1 + 35) < WQ_NWL;
        const unsigned char* wsb = a.ws; unsigned qoff[6], qstr[6];
#pragma unroll
        for (int i = 0; i < 6; ++i) { const int p = (w1 + 7 * i) * 64 + lane, cq = p / WQ_PCS, q = p - cq * WQ_PCS; const bool pr = q < WK_PRV / 16;
            qoff[i] = pr ? (unsigned)(WS_CP + ((size_t)bh * 128 * 4 + rg) * WK_PRV) + (unsigned)(cq * 4 * WK_PRV + q * 16) : (unsigned)(WS_CK + (size_t)bh * 128 * WK_SHR) + (unsigned)(cq * WK_SHR + (q - WK_PRV / 16) * 16);
            qstr[i] = pr ? (unsigned)(16 * WK_PRV) : (unsigned)(4 * WK_SHR); }
#define WQ_DMA(blk) do { _Pragma("unroll") for (int i = 0; i < 6; ++i) if (i < 5 || seven) \
            __builtin_amdgcn_global_load_lds((const unsigned*)(wsb + (qoff[i] + (unsigned)(blk) * qstr[i])), (LAS unsigned*)(C.lds + ((blk) % 3) * WQ_SLOT + (w1 + 7 * i) * 1024), 16, 0, 0); } while (0)
#define WQ_WAIT_OLDER() do { if (seven) asm volatile("s_waitcnt vmcnt(6)" ::: "memory"); else asm volatile("s_waitcnt vmcnt(5)" ::: "memory"); } while (0)
        WQ_DMA(0); WQ_DMA(1); WQ_WAIT_OLDER();
        __builtin_amdgcn_s_barrier(); asm volatile("" ::: "memory");
        for (int blk = 0; blk < 32; ++blk) {
            if (blk + 2 < 32) { WQ_DMA(blk + 2); WQ_WAIT_OLDER(); }
            else asm volatile("s_waitcnt vmcnt(0)" ::: "memory");
            __builtin_amdgcn_s_barrier(); asm volatile("" ::: "memory");
        }
#undef WQ_DMA
#undef WQ_WAIT_OLDER
    }
#undef WQ_COMPUTE
    __syncthreads();
}
__device__ __forceinline__ void rwkv_sample_witem(const Ctx& C, const Ax& a, int l, int witem) {
    const float* RW = (const float*)(a.ws + WS_RW); float* OC = (float*)(a.ws + WS_OC);
    const int n = witem >> 4, h = (witem >> 1) & 7, half = witem & 1, g = C.lane & 15, rq = C.lane >> 4;
    const unsigned char* p = (const unsigned char*)RW + ((size_t)(MP + n) * 8 + h) * RWB;
    const f32x4 lw4 = *(const f32x4*)(p + 16 * g), kk4 = rw_ld4(p, RW_KK, 4 * g), b4 = rw_ld4(p, RW_KB, 4 * g), k4 = rw_ld4(p, RW_K, 4 * g), r4 = rw_ld4(p, RW_R, 4 * g);
    const f32x4 w4 = (f32x4){__expf(lw4.x), __expf(lw4.y), __expf(lw4.z), __expf(lw4.w)};
    const float* sin_ = a.in(I_SWKV) + (((size_t)l * NS + n) * 8 + h) * 4096; float* sout = a.out + O_WKVS + (((size_t)l * NS + n) * 8 + h) * 4096;
#pragma unroll 4
    for (int it = 0; it < 8; ++it) { const int i = half * 32 + it * 4 + rq; const f32x4 S = __builtin_nontemporal_load((const f32x4*)(sin_ + i * 64 + 4 * g)); const float vi = bf1(*(const bf16*)(p + RW_V + i * 2));
        const float sa = -rowsum16((S.x * kk4.x + S.y * kk4.y) + (S.z * kk4.z + S.w * kk4.w));
        f32x4 T; T.x = S.x * w4.x + (sa * b4.x + vi * k4.x); T.y = S.y * w4.y + (sa * b4.y + vi * k4.y); T.z = S.z * w4.z + (sa * b4.z + vi * k4.z); T.w = S.w * w4.w + (sa * b4.w + vi * k4.w);
        const float o = rowsum16((T.x * r4.x + T.y * r4.y) + (T.z * r4.z + T.w * r4.w));
        __builtin_nontemporal_store(T, (f32x4*)(sout + i * 64 + 4 * g));
        if (g == 0) OC[(size_t)(MP + n) * 512 + h * 64 + i] = o; }
}
__device__ __forceinline__ void rwkv_post_phase(const Ctx& C, const Ax& a, int l) {
    const float* RW = (const float*)(a.ws + WS_RW); const float* OC = (const float*)(a.ws + WS_OC); const float* GATE = (const float*)(a.ws + WS_GATE); bf16* YC = (bf16*)(a.ws + WS_YC);
    const int gw = C.bid * NWAVES + C.wave, NGW = C.G * NWAVES, g = C.lane & 15, rq = C.lane >> 4;
    const float* lg = a.in(I_LNXG) + l * 512; const float* lb = a.in(I_LNXB) + l * 512; const float* rk = a.in(I_RK) + l * 512;
    const int h = (gw * 4 + rq) & 7, ch = h * 64 + 4 * g;
    const f32x4 rkv = *(const f32x4*)(rk + ch), lgv = *(const f32x4*)(lg + ch), lbv = *(const f32x4*)(lb + ch);
    constexpr int NIT = MT * 8 / 4;
    for (int it0 = gw; it0 < NIT; it0 += 3 * NGW) {
        f32x4 po[3], pg[3]; v2u pk[3], pr[3], pv[3];
#pragma unroll
        for (int u = 0; u < 3; ++u) { const int it = it0 + u * NGW; if (it < NIT) { const int row = (it * 4 + rq) >> 3; const unsigned char* rw = (const unsigned char*)RW + ((size_t)row * 8 + h) * RWB + 8 * g;
            po[u] = *(const f32x4*)(OC + (size_t)row * 512 + ch); pg[u] = *(const f32x4*)(GATE + (size_t)row * 512 + ch);
            pk[u] = *(const v2u*)(rw + RW_K); pr[u] = *(const v2u*)(rw + RW_R); pv[u] = *(const v2u*)(rw + RW_V); } }
        __builtin_amdgcn_sched_barrier(0);
#pragma unroll
        for (int u = 0; u < 3; ++u) { const int it = it0 + u * NGW; if (it < NIT) { const int row = (it * 4 + rq) >> 3; const f32x4 o = po[u];
            const float mu = rowsum16((o.x + o.y) + (o.z + o.w)) * (1.0f / 64.0f); const f32x4 d = o - mu;
            const float var = rowsum16((d.x * d.x + d.y * d.y) + (d.z * d.z + d.w * d.w)) * (1.0f / 64.0f); const float rstd = 1.0f / sqrtf(var + 64e-5f);
            float kf[4], rf[4], vf[4]; unpack4(pk[u], kf); unpack4(pr[u], rf); unpack4(pv[u], vf);
            const float bs = rowsum16((rf[0] * kf[0] * rkv.x + rf[1] * kf[1] * rkv.y) + (rf[2] * kf[2] * rkv.z + rf[3] * kf[3] * rkv.w));
            const f32x4 v4 = (f32x4){vf[0], vf[1], vf[2], vf[3]};
            const f32x4 y = (d * rstd * lgv + lbv + bs * v4) * pg[u];
            v2u w; w.x = pk2(y.x, y.y); w.y = pk2(y.z, y.w); *(v2u*)(YC + (size_t)row * DM + 1024 + ch) = w; } }
        __builtin_amdgcn_sched_barrier(0);
    }
}

__device__ __forceinline__ float ret_lg(int h) { return log1pf(-exp2f(-5.0f - (float)h)); }
constexpr int RS = 136;
__device__ __forceinline__ void rot8(const bf16* src, const float* cs, int c8, float scale, float (&lo)[8], float (&hi)[8]) {
    float x1[8], x2[8]; unpack8(*(const v4u*)(src + c8 * 8), x1); unpack8(*(const v4u*)(src + 64 + c8 * 8), x2);
    const f32x4* cp = (const f32x4*)(cs + 16 * c8); const f32x4 t0 = cp[0], t1 = cp[1], t2 = cp[2], t3 = cp[3];
    const float cc[8] = {t0.x, t0.z, t1.x, t1.z, t2.x, t2.z, t3.x, t3.z}, sn[8] = {t0.y, t0.w, t1.y, t1.w, t2.y, t2.w, t3.y, t3.w};
#pragma unroll
    for (int j = 0; j < 8; ++j) { lo[j] = (x1[j] * cc[j] - x2[j] * sn[j]) * scale; hi[j] = (x2[j] * cc[j] + x1[j] * sn[j]) * scale; }
}
struct RotX { v4u a, b; }; struct RotT { f32x4 t0, t1, t2, t3; };
__device__ __forceinline__ RotX rot_ldx(const bf16* src, int c8) { RotX r; r.a = *(const v4u*)(src + c8 * 8); r.b = *(const v4u*)(src + 64 + c8 * 8); return r; }
__device__ __forceinline__ RotT rot_ldt(const float* cs, int c8) { const f32x4* cp = (const f32x4*)(cs + 16 * c8); RotT r; r.t0 = cp[0]; r.t1 = cp[1]; r.t2 = cp[2]; r.t3 = cp[3]; return r; }
__device__ __forceinline__ void rot_ap(const RotX& x, const RotT& t, float scale, float (&lo)[8], float (&hi)[8]) {
    float x1[8], x2[8]; unpack8(x.a, x1); unpack8(x.b, x2);
    const float cc[8] = {t.t0.x, t.t0.z, t.t1.x, t.t1.z, t.t2.x, t.t2.z, t.t3.x, t.t3.z}, sn[8] = {t.t0.y, t.t0.w, t.t1.y, t.t1.w, t.t2.y, t.t2.w, t.t3.y, t.t3.w};
#pragma unroll
    for (int j = 0; j < 8; ++j) { lo[j] = (x1[j] * cc[j] - x2[j] * sn[j]) * scale; hi[j] = (x2[j] * cc[j] + x1[j] * sn[j]) * scale; }
}
__device__ __forceinline__ void ret_pass1_item(const Ctx& C, const Ax& a, int item) {
    const bf16* P = (const bf16*)(a.ws + WS_P); const float* CS = (const float*)(a.ws + WS_ROPE); float* KVT = (float*)(a.ws + WS_KVT);
    const int b = item >> 6, h = (item >> 4) & 3, c = item & 15; const size_t row0 = (size_t)b * SEQ + c * 128; const float lg = ret_lg(h);
    LAS bf16* KT = (LAS bf16*)C.lds; LAS bf16* VT = KT + 128 * RS;
    { RotX kx[2]; RotT kt[2]; v4u vw[4];
#pragma unroll
      for (int u = 0; u < 2; ++u) { const int it = C.tid + u * (NWAVES * 64), tt = it & 127, c8 = it >> 7; kx[u] = rot_ldx(P + (row0 + tt) * PIN + PB_ + 512 + h * 128, c8); kt[u] = rot_ldt(CS + (size_t)(c * 128 + tt) * 128, c8); }
#pragma unroll
      for (int u = 0; u < 4; ++u) { const int it = C.tid + u * (NWAVES * 64), tt = it & 127, c8 = it >> 7; vw[u] = *(const v4u*)(P + (row0 + tt) * PIN + PB_ + 1024 + h * 128 + c8 * 8); }
      __builtin_amdgcn_sched_barrier(0);
#pragma unroll
      for (int u = 0; u < 2; ++u) { const int it = C.tid + u * (NWAVES * 64), tt = it & 127, c8 = it >> 7; float lo[8], hi[8];
        rot_ap(kx[u], kt[u], 0.08838834764831845f * __expf(lg * (float)(127 - tt)), lo, hi);
#pragma unroll
        for (int j = 0; j < 8; ++j) { KT[(c8 * 8 + j) * RS + tt] = (bf16)(pk2(lo[j], 0.f) & 0xffffu); KT[(64 + c8 * 8 + j) * RS + tt] = (bf16)(pk2(hi[j], 0.f) & 0xffffu); } }
#pragma unroll
      for (int u = 0; u < 4; ++u) { const int it = C.tid + u * (NWAVES * 64), tt = it & 127, c8 = it >> 7; const unsigned ww[4] = {vw[u].x, vw[u].y, vw[u].z, vw[u].w};
#pragma unroll
        for (int j = 0; j < 4; ++j) { VT[(c8 * 8 + 2 * j) * RS + tt] = (bf16)(ww[j] & 0xffffu); VT[(c8 * 8 + 2 * j + 1) * RS + tt] = (bf16)(ww[j] >> 16); } } }
    __syncthreads();
    const int fr = C.lane & 15, fq = C.lane >> 4, w = C.wave;
    f32x4 acc[8];
#pragma unroll
    for (int et = 0; et < 8; ++et) acc[et] = zero4();
#pragma unroll
    for (int ks = 0; ks < 4; ++ks) { const bf16x8 kf = *(const LAS bf16x8*)(KT + (16 * w + fr) * RS + ks * 32 + fq * 8);
#pragma unroll
        for (int et = 0; et < 8; ++et) { const bf16x8 vf = *(const LAS bf16x8*)(VT + (16 * et + fr) * RS + ks * 32 + fq * 8); acc[et] = __builtin_amdgcn_mfma_f32_16x16x32_bf16(kf, vf, acc[et], 0, 0, 0); } }
    float* o = KVT + (size_t)item * 16384;
#pragma unroll
    for (int et = 0; et < 8; ++et) *(f32x4*)(o + (size_t)(16 * et + fr) * 128 + 16 * w + 4 * fq) = acc[et];
    __syncthreads();
}
__device__ __forceinline__ void ret_prefix_phase(const Ctx& C, const Ax& a, int l) {
    const float* KVT = (const float*)(a.ws + WS_KVT); bf16* STB = (bf16*)(a.ws + WS_STB);
    const int gt = C.bid * (NWAVES * 64) + C.tid, NT = C.G * NWAVES * 64;
    for (int idx = gt; idx < 16 * 4096; idx += NT) { const int bh = idx >> 12, r = idx & 4095, e = r >> 5, d4 = (r & 31) * 4; const int h = bh & 3;
        const float g128 = __expf(ret_lg(h) * 128.0f); const size_t base = (size_t)bh * 16 * 16384 + e * 128 + d4;
        f32x4 kv[16];
#pragma unroll
        for (int c = 0; c < 16; ++c) kv[c] = *(const f32x4*)(KVT + base + (size_t)c * 16384);
        f32x4 S = zero4();
#pragma unroll
        for (int c = 0; c < 16; ++c) { v2u w; w.x = pk2(S.x, S.y); w.y = pk2(S.z, S.w); *(v2u*)(STB + base + (size_t)c * 16384) = w; S = S * g128 + kv[c]; }
        float* o = a.out + O_RETP + ((size_t)l * 16 + bh) * 16384 + e;
        o[(size_t)d4 * 128] = S.x; o[(size_t)(d4 + 1) * 128] = S.y; o[(size_t)(d4 + 2) * 128] = S.z; o[(size_t)(d4 + 3) * 128] = S.w; }
}
__device__ __forceinline__ void ret_pass2_item(const Ctx& C, const Ax& a, int l, int item) {
    const bf16* P = (const bf16*)(a.ws + WS_P); const float* CS = (const float*)(a.ws + WS_ROPE); bf16* YC = (bf16*)(a.ws + WS_YC);
    const int b = item >> 6, h = (item >> 4) & 3, c = item & 15; const size_t row0 = (size_t)b * SEQ + c * 128; const float lg = ret_lg(h);
    LAS bf16* QL = (LAS bf16*)C.lds; LAS bf16* KL = QL + 128 * RS; LAS bf16* VT = KL + 128 * RS; LAS bf16* ST = VT + 128 * RS;
    { RotX qx[2], kx[2]; RotT kt[2]; v4u vw[4], sw[4]; const bf16* stb = (const bf16*)(a.ws + WS_STB) + (size_t)item * 16384;
#pragma unroll
      for (int u = 0; u < 2; ++u) { const int it = C.tid + u * (NWAVES * 64), tt = it & 127, c8 = it >> 7; const bf16* pr = P + (row0 + tt) * PIN + PB_ + h * 128;
        qx[u] = rot_ldx(pr, c8); kx[u] = rot_ldx(pr + 512, c8); kt[u] = rot_ldt(CS + (size_t)(c * 128 + tt) * 128, c8); }
#pragma unroll
      for (int u = 0; u < 4; ++u) { const int it = C.tid + u * (NWAVES * 64), tt = it & 127, c8 = it >> 7; vw[u] = *(const v4u*)(P + (row0 + tt) * PIN + PB_ + 1024 + h * 128 + c8 * 8);
        sw[u] = *(const v4u*)(stb + (it >> 4) * 128 + (it & 15) * 8); }
      __builtin_amdgcn_sched_barrier(0);
#pragma unroll
      for (int u = 0; u < 2; ++u) { const int it = C.tid + u * (NWAVES * 64), tt = it & 127, c8 = it >> 7; float lo[8], hi[8];
        rot_ap(qx[u], kt[u], __expf(lg * (float)(tt + 1)), lo, hi);
        *(LAS v4u*)(QL + tt * RS + c8 * 8) = pack8(lo); *(LAS v4u*)(QL + tt * RS + 64 + c8 * 8) = pack8(hi);
        rot_ap(kx[u], kt[u], 0.08838834764831845f * __expf(-lg * (float)(tt + 1)), lo, hi);
        *(LAS v4u*)(KL + tt * RS + c8 * 8) = pack8(lo); *(LAS v4u*)(KL + tt * RS + 64 + c8 * 8) = pack8(hi); }
#pragma unroll
      for (int u = 0; u < 4; ++u) { const int it = C.tid + u * (NWAVES * 64), tt = it & 127, c8 = it >> 7; const unsigned ww[4] = {vw[u].x, vw[u].y, vw[u].z, vw[u].w};
#pragma unroll
        for (int j = 0; j < 4; ++j) { VT[(c8 * 8 + 2 * j) * RS + tt] = (bf16)(ww[j] & 0xffffu); VT[(c8 * 8 + 2 * j + 1) * RS + tt] = (bf16)(ww[j] >> 16); }
        *(LAS v4u*)(ST + (it >> 4) * RS + (it & 15) * 8) = sw[u]; } }
    __syncthreads();
    const int fr = C.lane & 15, fq = C.lane >> 4, w = C.wave, i0 = 16 * w;
    bf16x8 qf[4];
#pragma unroll
    for (int ks = 0; ks < 4; ++ks) qf[ks] = *(const LAS bf16x8*)(QL + (i0 + fr) * RS + ks * 32 + fq * 8);
    f32x4 sc[8];
#pragma unroll
    for (int jt = 0; jt < 8; ++jt) { sc[jt] = zero4();
        if (jt <= w) {
#pragma unroll
            for (int ks = 0; ks < 4; ++ks) { const bf16x8 kf = *(const LAS bf16x8*)(KL + (16 * jt + fr) * RS + ks * 32 + fq * 8); sc[jt] = __builtin_amdgcn_mfma_f32_16x16x32_bf16(kf, qf[ks], sc[jt], 0, 0, 0); }
            if (jt == w) {
#pragma unroll
                for (int r = 0; r < 4; ++r) if (4 * fq + r > fr) sc[jt][r] = 0.f; } } }
    __syncthreads();
    LAS bf16* PL = KL;
#pragma unroll
    for (int jt = 0; jt < 8; ++jt) { v2u pw; pw.x = pk2(sc[jt][0], sc[jt][1]); pw.y = pk2(sc[jt][2], sc[jt][3]); *(LAS v2u*)(PL + (i0 + fr) * RS + 16 * jt + 4 * fq) = pw; }
    LDS_WAIT(); asm volatile("" ::: "memory");
    f32x4 acc[8];
#pragma unroll
    for (int et = 0; et < 8; ++et) acc[et] = zero4();
#pragma unroll
    for (int ks = 0; ks < 4; ++ks) { if (2 * ks <= w) { const bf16x8 pf = *(const LAS bf16x8*)(PL + (i0 + fr) * RS + ks * 32 + fq * 8);
#pragma unroll
            for (int et = 0; et < 8; ++et) { const bf16x8 vf = *(const LAS bf16x8*)(VT + (16 * et + fr) * RS + ks * 32 + fq * 8); acc[et] = __builtin_amdgcn_mfma_f32_16x16x32_bf16(vf, pf, acc[et], 0, 0, 0); } } }
    if (c > 0) {
#pragma unroll
        for (int ks = 0; ks < 4; ++ks)
#pragma unroll
            for (int et = 0; et < 8; ++et) { const bf16x8 sf = *(const LAS bf16x8*)(ST + (16 * et + fr) * RS + ks * 32 + fq * 8); acc[et] = __builtin_amdgcn_mfma_f32_16x16x32_bf16(sf, qf[ks], acc[et], 0, 0, 0); } }
    float s = 0.f;
#pragma unroll
    for (int et = 0; et < 8; ++et) s += (acc[et][0] + acc[et][1]) + (acc[et][2] + acc[et][3]);
    s += __shfl_xor(s, 16); s += __shfl_xor(s, 32); const float mu = s * (1.0f / 128.0f);
    float q = 0.f;
#pragma unroll
    for (int et = 0; et < 8; ++et) { acc[et] = acc[et] - mu; q += (acc[et][0] * acc[et][0] + acc[et][1] * acc[et][1]) + (acc[et][2] * acc[et][2] + acc[et][3] * acc[et][3]); }
    q += __shfl_xor(q, 16); q += __shfl_xor(q, 32); const float rstd = 1.0f / sqrtf(q * (1.0f / 128.0f) + 1e-6f);
    const size_t row = row0 + i0 + fr;
#pragma unroll
    for (int et = 0; et < 8; ++et) { const int e = 16 * et + 4 * fq; float gg[4]; unpack4(*(const v2u*)(P + row * PIN + PB_ + 1536 + h * 128 + e), gg);
        v2u wv; wv.x = pk2(gg[0] * sigm(gg[0]) * acc[et][0] * rstd, gg[1] * sigm(gg[1]) * acc[et][1] * rstd); wv.y = pk2(gg[2] * sigm(gg[2]) * acc[et][2] * rstd, gg[3] * sigm(gg[3]) * acc[et][3] * rstd);
        *(v2u*)(YC + row * DM + 512 + h * 128 + e) = wv; }
    __syncthreads();
}
__device__ __forceinline__ void ret_sample_witem(const Ctx& C, const Ax& a, int l, int witem) {
    const bf16* P = (const bf16*)(a.ws + WS_P); const float* CS = (const float*)(a.ws + WS_ROPE) + (size_t)2048 * 128; bf16* YC = (bf16*)(a.ws + WS_YC);
    const int n = witem >> 2, h = witem & 3, lane = C.lane; const float gam = 1.0f - exp2f(-5.0f - (float)h);
    LAS float* qk = (LAS float*)(C.lds + C.wave * 1024);
    const bf16* pr = P + (size_t)(MP + n) * PIN + PB_ + h * 128;
    { const float co = CS[2 * lane], si = CS[2 * lane + 1]; const float q1 = bf1(pr[lane]), q2 = bf1(pr[64 + lane]), k1 = bf1(pr[512 + lane]), k2 = bf1(pr[512 + 64 + lane]);
      qk[lane] = q1 * co - q2 * si; qk[64 + lane] = q2 * co + q1 * si; qk[128 + lane] = (k1 * co - k2 * si) * 0.08838834764831845f; qk[192 + lane] = (k2 * co + k1 * si) * 0.08838834764831845f; }
    LDS_WAIT(); asm volatile("" ::: "memory");
    const float dotp = wave_sum(qk[lane] * qk[128 + lane] + qk[64 + lane] * qk[192 + lane]);
    const int half = lane >> 5, el = lane & 31;
    float vv[4]; unpack4(*(const v2u*)(pr + 1024 + 4 * el), vv); const f32x4 v4 = (f32x4){vv[0], vv[1], vv[2], vv[3]};
    const float* sin_ = a.in(I_SRET) + (((size_t)l * NS + n) * 4 + h) * 16384; float* sout = a.out + O_RETS + (((size_t)l * NS + n) * 4 + h) * 16384;
    f32x4 oa = zero4();
    unsigned lof = (unsigned)(half * 128 + 4 * el) * 4u; asm volatile("" : "+v"(lof));
    f32x4 sa[4], sb[4];
#define RS_LOAD(buf, blk) do { _Pragma("unroll") for (int j = 0; j < 4; ++j) buf[j] = __builtin_nontemporal_load((const f32x4*)((const char*)sin_ + (lof + (unsigned)(2 * ((blk) * 4 + j)) * 512u))); } while (0)
#define RS_USE(buf, blk) do { _Pragma("unroll") for (int j = 0; j < 4; ++j) { const int d = 2 * ((blk) * 4 + j) + half; const float qd = qk[d], kd = qk[128 + d]; oa += qd * buf[j]; \
        __builtin_nontemporal_store(gam * buf[j] + kd * v4, (f32x4*)((char*)sout + (lof + (unsigned)(2 * ((blk) * 4 + j)) * 512u))); } } while (0)
    RS_LOAD(sa, 0);
#pragma unroll
    for (int blk = 0; blk < 16; blk += 2) {
        RS_LOAD(sb, blk + 1); __builtin_amdgcn_sched_barrier(0);
        RS_USE(sa, blk); __builtin_amdgcn_sched_barrier(0);
        if (blk + 2 < 16) RS_LOAD(sa, blk + 2);
        __builtin_amdgcn_sched_barrier(0);
        RS_USE(sb, blk + 1); __builtin_amdgcn_sched_barrier(0); }
#undef RS_LOAD
#undef RS_USE
    oa.x += __shfl_xor(oa.x, 32); oa.y += __shfl_xor(oa.y, 32); oa.z += __shfl_xor(oa.z, 32); oa.w += __shfl_xor(oa.w, 32);
    f32x4 o = gam * oa + dotp * v4;
    float s = (o.x + o.y) + (o.z + o.w);
#pragma unroll
    for (int m = 1; m < 32; m <<= 1) s += __shfl_xor(s, m);
    const float mu = s * (1.0f / 128.0f); o = o - mu; float q = (o.x * o.x + o.y * o.y) + (o.z * o.z + o.w * o.w);
#pragma unroll
    for (int m = 1; m < 32; m <<= 1) q += __shfl_xor(q, m);
    const float rstd = 1.0f / sqrtf(q * (1.0f / 128.0f) + 1e-6f);
    if (half == 0) { float gg[4]; unpack4(*(const v2u*)(pr + 1536 + 4 * el), gg);
        v2u wv; wv.x = pk2(gg[0] * sigm(gg[0]) * o.x * rstd, gg[1] * sigm(gg[1]) * o.y * rstd); wv.y = pk2(gg[2] * sigm(gg[2]) * o.z * rstd, gg[3] * sigm(gg[3]) * o.w * rstd);
        *(v2u*)(YC + (size_t)(MP + n) * DM + 512 + h * 128 + 4 * el) = wv; }
    LDS_WAIT(); asm volatile("" ::: "memory");
}

constexpr int XV_RS = 264;
__device__ __forceinline__ void xattn_prompt_unit(const Ctx& C, const Ax& a, int l, int unit) {
    const bf16* Q = (const bf16*)(a.ws + WS_Q); const bf16* MK = (const bf16*)(a.ws + WS_MK) + (size_t)l * MMEM * DM; const bf16* MVT = (const bf16*)(a.ws + WS_MVT) + (size_t)l * MMEM * DM; bf16* O = (bf16*)(a.ws + WS_O);
    const int b = unit >> 6, h = (unit >> 4) & 3, qt = unit & 15, fr = C.lane & 15, fq = C.lane >> 4;
    const size_t row = (size_t)b * SEQ + qt * 128 + C.wave * 16 + fr;
    LAS bf16* SB = (LAS bf16*)C.lds;
    v4u st[8];
    const bf16* kbase = MK + ((size_t)b * 256) * DM + h * 512; const bf16* vbase = MVT + (((size_t)b * 4 + h) * 512) * 256;
    unsigned kof[4], vof[8], sof[8];
#pragma unroll
    for (int i = 0; i < 8; ++i) { const int idx = C.tid + 512 * i, r = idx >> 5, c16 = idx & 31; vof[i] = (unsigned)(r * 256 + c16 * 8) * 2u; sof[i] = (unsigned)(r * XV_RS + c16 * 8) * 2u; if (i < 4) kof[i] = (unsigned)(r * DM + c16 * 8) * 2u; }
    const char* kb8 = (const char*)kbase; const char* vb8 = (const char*)vbase; LAS char* sb8 = (LAS char*)SB;
#define XK_LOAD(q) do { const char* pb_ = kb8 + ((size_t)(((q) & 3) * 64) * DM + ((q) >> 2) * 256) * 2; _Pragma("unroll") for (int i = 0; i < 4; ++i) st[i] = *(const v4u*)(pb_ + kof[i]); } while (0)
#define XK_STORE() do { _Pragma("unroll") for (int i = 0; i < 4; ++i) *(LAS v4u*)(sb8 + sof[i]) = st[i]; } while (0)
#define XV_LOAD(p) do { const char* pb_ = vb8 + (size_t)((p) * 128) * 256 * 2; _Pragma("unroll") for (int i = 0; i < 8; ++i) st[i] = *(const v4u*)(pb_ + vof[i]); } while (0)
#define XV_STORE() do { _Pragma("unroll") for (int i = 0; i < 8; ++i) *(LAS v4u*)(sb8 + sof[i]) = st[i]; } while (0)
    XK_LOAD(0);
    f32x4 sc[16];
#pragma unroll
    for (int jt = 0; jt < 16; ++jt) sc[jt] = zero4();
#pragma unroll
    for (int dh = 0; dh < 2; ++dh) {
        bf16x8 qf[8];
#pragma unroll
        for (int ks = 0; ks < 8; ++ks) qf[ks] = *(const bf16x8*)(Q + row * DM + h * 512 + dh * 256 + ks * 32 + fq * 8);
#pragma unroll
        for (int p = 0; p < 4; ++p) {
            __syncthreads(); XK_STORE(); __syncthreads();
            if (dh * 4 + p < 7) XK_LOAD(dh * 4 + p + 1); else XV_LOAD(0);
#pragma unroll
            for (int j4 = 0; j4 < 4; ++j4) {
#pragma unroll
                for (int ks = 0; ks < 8; ++ks) { const bf16x8 kf = *(const LAS bf16x8*)(SB + (j4 * 16 + fr) * XV_RS + ks * 32 + fq * 8); sc[p * 4 + j4] = __builtin_amdgcn_mfma_f32_16x16x32_bf16(kf, qf[ks], sc[p * 4 + j4], 0, 0, 0); }
                __builtin_amdgcn_sched_barrier(0); }
        }
    }
    float mx = -3.0e38f;
#pragma unroll
    for (int jt = 0; jt < 16; ++jt) mx = fmaxf(mx, fmaxf(fmaxf(sc[jt][0], sc[jt][1]), fmaxf(sc[jt][2], sc[jt][3])));
    mx = fmaxf(mx, __shfl_xor(mx, 16)); mx = fmaxf(mx, __shfl_xor(mx, 32));
    const float scale = 0.04419417382415922f; float sum = 0.f;
    bf16x8 pf[8];
#pragma unroll
    for (int s = 0; s < 8; ++s) { float p[8];
#pragma unroll
        for (int j = 0; j < 4; ++j) { p[j] = __expf((sc[2 * s][j] - mx) * scale); p[4 + j] = __expf((sc[2 * s + 1][j] - mx) * scale); }
        sum += ((p[0] + p[1]) + (p[2] + p[3])) + ((p[4] + p[5]) + (p[6] + p[7]));
        const v4u w = pack8(p); pf[s] = __builtin_bit_cast(bf16x8, w); }
    sum += __shfl_xor(sum, 16); sum += __shfl_xor(sum, 32); const float inv = 1.0f / sum;
#pragma unroll
    for (int p = 0; p < 4; ++p) {
        __syncthreads(); XV_STORE(); __syncthreads();
        if (p < 3) XV_LOAD(p + 1);
#pragma unroll
        for (int et = 0; et < 8; ++et) { f32x4 s4 = zero4(); const LAS bf16* vp = SB + (et * 16 + fr) * XV_RS + 4 * fq;
#pragma unroll
            for (int s = 0; s < 8; ++s) { const v2u lo = *(const LAS v2u*)(vp + 32 * s), hi = *(const LAS v2u*)(vp + 32 * s + 16); const v4u w = (v4u){lo.x, lo.y, hi.x, hi.y};
                s4 = __builtin_amdgcn_mfma_f32_16x16x32_bf16(__builtin_bit_cast(bf16x8, w), pf[s], s4, 0, 0, 0); }
            v2u w; w.x = pk2(s4[0] * inv, s4[1] * inv); w.y = pk2(s4[2] * inv, s4[3] * inv);
            *(v2u*)(O + row * DM + h * 512 + p * 128 + et * 16 + 4 * fq) = w;
            __builtin_amdgcn_sched_barrier(0); }
    }
    __syncthreads();
#undef XK_LOAD
#undef XK_STORE
#undef XV_LOAD
#undef XV_STORE
}
__device__ __forceinline__ void xattn_sample_item(const Ctx& C, const Ax& a, int l, int item) {
    bf16* O = (bf16*)(a.ws + WS_OS);
    const int n = item >> 2, h = item & 3, lane = C.lane, w = C.wave;
    LAS float* red = (LAS float*)C.lds; LAS float* part = red + 64;
    float q[8]; { const float* s0 = (const float*)(a.ws + WS_SPL) + (size_t)n * DM + h * 512 + 4 * lane; const float* s1 = s0 + (size_t)NS * DM;
                  const f32x4 a0 = *(const f32x4*)s0 + *(const f32x4*)s1, a1 = *(const f32x4*)(s0 + 256) + *(const f32x4*)(s1 + 256);
                  q[0] = a0.x; q[1] = a0.y; q[2] = a0.z; q[3] = a0.w; q[4] = a1.x; q[5] = a1.y; q[6] = a1.z; q[7] = a1.w; }
    const size_t base = ((((size_t)l * NS + n) * 256 + 32 * w) * 4 + h) * 512 + 4 * lane;
    const float* kp = a.in(I_CMK) + base; const float* vp = a.in(I_CMV) + base;
#define XS_LOAD(buf0, buf1, ptr, k8) do { _Pragma("unroll") for (int j = 0; j < 8; ++j) { buf0[j] = __builtin_nontemporal_load((const f32x4*)((ptr) + (size_t)((k8) * 8 + j) * 2048)); buf1[j] = __builtin_nontemporal_load((const f32x4*)((ptr) + (size_t)((k8) * 8 + j) * 2048 + 256)); } } while (0)
#define XS_DOT(buf0, buf1, k8) do { _Pragma("unroll") for (int j = 0; j < 8; ++j) { float d = (buf0[j].x * q[0] + buf0[j].y * q[1]) + (buf0[j].z * q[2] + buf0[j].w * q[3]) + (buf1[j].x * q[4] + buf1[j].y * q[5]) + (buf1[j].z * q[6] + buf1[j].w * q[7]); \
        d = rowsum16(d); d += __shfl_xor(d, 16); d += __shfl_xor(d, 32); if (lane == (k8) * 8 + j) myscore = d; } } while (0)
#define XS_ACC(buf0, buf1, k8) do { _Pragma("unroll") for (int j = 0; j < 8; ++j) { const float pj = __builtin_bit_cast(float, __builtin_amdgcn_readlane(__builtin_bit_cast(int, p), (k8) * 8 + j)); o0 += pj * buf0[j]; o1 += pj * buf1[j]; } } while (0)
    float myscore = 0.f;
    f32x4 xa0[8], xa1[8], xb0[8], xb1[8];
    XS_LOAD(xa0, xa1, kp, 0);
    XS_LOAD(xb0, xb1, kp, 1); XS_DOT(xa0, xa1, 0);
    XS_LOAD(xa0, xa1, kp, 2); XS_DOT(xb0, xb1, 1);
    XS_LOAD(xb0, xb1, kp, 3); XS_DOT(xa0, xa1, 2);
    XS_LOAD(xa0, xa1, vp, 0); XS_DOT(xb0, xb1, 3);
    const float scale = 0.04419417382415922f;
    float mx = wave_max(lane < 32 ? myscore : -3.0e38f); if (lane == 0) red[w] = mx; __syncthreads();
    mx = red[0];
#pragma unroll
    for (int i = 1; i < 8; ++i) mx = fmaxf(mx, red[i]);
    const float p = lane < 32 ? __expf((myscore - mx) * scale) : 0.f;
    const float ps = wave_sum(p); if (lane == 0) red[8 + w] = ps;
    f32x4 o0 = zero4(), o1 = zero4();
    XS_LOAD(xb0, xb1, vp, 1); XS_ACC(xa0, xa1, 0);
    XS_LOAD(xa0, xa1, vp, 2); XS_ACC(xb0, xb1, 1);
    XS_LOAD(xb0, xb1, vp, 3); XS_ACC(xa0, xa1, 2);
    XS_ACC(xb0, xb1, 3);
#undef XS_LOAD
#undef XS_DOT
#undef XS_ACC
    *(LAS f32x4*)(part + w * 512 + 4 * lane) = o0; *(LAS f32x4*)(part + w * 512 + 256 + 4 * lane) = o1;
    __syncthreads();
    float tot = 0.f;
#pragma unroll
    for (int i = 0; i < 8; ++i) tot += red[8 + i];
    { const int d = C.tid; float s = 0.f;
#pragma unroll
      for (int i = 0; i < 8; ++i) s += part[i * 512 + d];
      O[(size_t)n * DMS + h * 512 + d] = (bf16)(pk2(s / tot, 0.f) & 0xffffu); }
    __syncthreads();
}

#ifndef PHASE_MASK
#define PHASE_MASK 0xffffffffu
#endif
#define PM(k) ((PHASE_MASK >> (k)) & 1u)
#ifndef DUP_SUB
#define DUP_SUB 0u
#endif
#define REP(k) for (int rep_ = 0; rep_ < 1 + (int)((DUP_SUB >> (k)) & 1u); ++rep_)
#ifndef DUP_MASK
#define DUP_MASK 0
#endif
#ifndef MK_ONE_LAUNCH
#define MK_ONE_LAUNCH 1
#endif
constexpr int PH_PER_LAYER = 14, NPH = 1 + DEPTH * PH_PER_LAYER;
__global__ void __launch_bounds__(NWAVES * 64, 2) fwd_kernel(Args args) {
    extern __shared__ __attribute__((aligned(16))) unsigned char lds_raw[];
    LAS unsigned char* const lds = (LAS unsigned char*)lds_raw;
    const int wave_s = __builtin_amdgcn_readfirstlane((int)threadIdx.x >> 6);
    volatile LAS unsigned* MISC = (volatile LAS unsigned*)(lds + MISC_OFF);
    for (int u = threadIdx.x; u < (LDS_BYTES - MISC_OFF) / 4; u += NWAVES * 64) ((LAS unsigned*)(lds + MISC_OFF))[u] = 0u;
    __syncthreads();
    XcdBarrier bar; bar.bar = (unsigned*)(args.ws + WS_CTL) + CW_BAR; bar.x = 0; bar.st = nullptr;
    if (MK_ONE_LAUNCH) bar = xcd_barrier_post((unsigned*)(args.ws + WS_CTL) + CW_BAR, MISC + 8);
    bar.wave = wave_s;
    const int lo = args.ph_lo, hi = args.ph_hi;
#define IN(k) (lo <= (k) && (k) < hi)
#define SEAM(k) do { if (MK_ONE_LAUNCH && IN((k) + 1)) xcd_barrier(bar); } while (0)
#define SEAM2(k) do { if (MK_ONE_LAUNCH && IN((k) + 2)) xcd_barrier(bar); } while (0)
#define PHASE_CTX const Ctx C = mk_ctx(lds, wave_s); const Ax a = mk_ax(); unsigned char* const ws = a.ws; const int G = C.G, bid = C.bid; (void)ws; (void)G; (void)bid; \
    float* const XF = (float*)(ws + WS_XF); bf16* const HN = (bf16*)(ws + WS_HN); bf16* const PBUF = (bf16*)(ws + WS_P); bf16* const YC = (bf16*)(ws + WS_YC); bf16* const QB = (bf16*)(ws + WS_Q); \
    bf16* const OB = (bf16*)(ws + WS_O); bf16* const UB = (bf16*)(ws + WS_U); (void)XF; (void)HN; (void)PBUF; (void)YC; (void)QB; (void)OB; (void)UB

    if (IN(0)) { PHASE_CTX; if (PM(0)) p0_prologue(C, a); SEAM(0); }

    for (int l = 0; l < DEPTH; ++l) {
        const int pb = 1 + l * PH_PER_LAYER;
        if (IN(pb + 0)) { PHASE_CTX; const unsigned char* wl = ws + WS_WL + (size_t)l * LW_STRIDE;
            if (PM(1)) { pg8::Gemm g{HN, (const bf16*)(wl + LW_IN), MPAD, PIN, DM, DM, 64, (size_t)PIN * 128}; pg8::StaticOrder S; S.init(MPAD, PIN, G, bid); pg8::EpiBf16A<0> E{PBUF, PIN, nullptr};
              pg8::gemm_phase<pg8::EpiBf16A<0>, pg8::StaticOrder, true, true>(lds, g, S, E, C.tid); }
            if (G == 256) { const int nfull = (MPAD / 256) * (PIN / 256) - 3 * G;
                if ((bid >= nfull && bid < 64) || bid >= 128) { __syncthreads(); late_convert(C, a, l, bid < 64 ? bid - nfull : bid - 128 + (64 - nfull), (64 - nfull) + (G - 128)); } }
            if (PM(2)) { pg8::Gemm g{(const bf16*)(ws + WS_MN), (const bf16*)(ws + WS_WKV) + (size_t)l * 4096 * 64, MMEM, 4096, DM, DM, 64, (size_t)8192 * 128}; pg8::StaticOrder S; S.init(MMEM, 4096, G, (bid + G - (64 % G)) % G);
              pg8::EpiMemKV E{a.out + O_MKP + (size_t)l * MMEM * DM, (bf16*)(ws + WS_MK) + (size_t)l * MMEM * DM, (bf16*)(ws + WS_MVT) + (size_t)l * MMEM * DM};
              pg8::gemm_phase<pg8::EpiMemKV, pg8::StaticOrder, true, true>(lds, g, S, E, C.tid); }
            SEAM(pb + 0);
        }
        if (IN(pb + 1)) { PHASE_CTX;
#ifdef DEBUG_P
            { const int gt = bid * 512 + C.tid, NT = G * 512;
              for (int idx = gt + (DEBUG_P == 2 ? MP * 2048 : 0); idx < (DEBUG_P == 1 ? MP : MT) * 2048; idx += NT) { const int row = idx >> 11, c = idx & 2047; const bf16* pr = PBUF + (size_t)row * PIN;
                  float s = bf1(pr[c]) + bf1(pr[c + 2048]) + bf1(pr[c + 4096]); if (c < 256) s += bf1(pr[c + 6144]); a.out[O_YP + idx] = s; } }
#endif
            if ((bid >> 3) & 1) { if (PM(8)) REP(8) for (int it = bid * NWAVES + C.wave; it < NS * 4; it += G * NWAVES) ret_sample_witem(C, a, l, it); __syncthreads(); }
            if (PM(4)) REP(4) for (int it = bid; it < 256; it += G) ad_prompt_item(C, a, l, it);
            if (PM(5)) REP(5) for (int it = bid; it < 256; it += G) ret_pass1_item(C, a, it);
            if (PM(6)) REP(6) for (int it = bid; it < 256; it += G) rwkv_prep_item(C, a, l, it);
            if (PM(6)) for (int it = bid - 64; it >= 0 && it < 8; it += G) rwkv_prep_item(C, a, l, 256 + (it >> 1), it & 1);
            if (PM(7)) REP(7) for (int it = G - 1 - bid; it < NS; it += G) ad_sample_item(C, a, l, it);
            if (!((bid >> 3) & 1)) { if (PM(8)) REP(8) for (int it = bid * NWAVES + C.wave; it < NS * 4; it += G * NWAVES) ret_sample_witem(C, a, l, it); }
            __syncthreads();
            SEAM(pb + 1);
        }
        if (IN(pb + 2)) { PHASE_CTX;
            if ((bid >> 3) & 1) { if (PM(10)) REP(10) for (int it = bid * NWAVES + C.wave; it < NS * 16; it += G * NWAVES) rwkv_sample_witem(C, a, l, it); }
            if (PM(9)) REP(9) for (int it = bid * NWAVES + C.wave; it < 4096; it += G * NWAVES) wkv_chunk_witem(C, a, it);
            if (!((bid >> 3) & 1)) { if (PM(10)) REP(10) for (int it = bid * NWAVES + C.wave; it < NS * 16; it += G * NWAVES) rwkv_sample_witem(C, a, l, it); }
            if (PM(11)) ret_prefix_phase(C, a, l);
            SEAM(pb + 2);
        }
        if (IN(pb + 3)) { PHASE_CTX; const int hg = G / 2;
            if (PM(22)) REP(22) for (int it = bid; it < 128; it += (bid < hg ? hg : 1 << 20)) wkv_seq_item(C, a, l, it);
            if (PM(11)) REP(11) if (bid >= hg || G < 2) for (int it = bid - hg; it < 256; it += G - hg) ret_pass2_item(C, a, l, it);
            SEAM(pb + 3);
        }
        if (IN(pb + 4)) { PHASE_CTX;
            if (PM(12)) REP(12) rwkv_post_phase(C, a, l);
            SEAM(pb + 4);
        }
        if (IN(pb + 5)) { PHASE_CTX; const unsigned char* wl = ws + WS_WL + (size_t)l * LW_STRIDE;
            pg8::Gemm g{YC, (const bf16*)(wl + LW_OUT), MP, DM, DM, DM, 64, (size_t)DM * 128}; pg8::StaticOrder S; S.init(MP, DM, G, bid); pg8::EpiRes E{XF, DM, ((DUP_MASK >> 5) & 1) ? 0.5f : 1.0f, (l == 0 && !((DUP_MASK >> 5) & 1)) ? a.in(I_XP) : (const float*)XF};
            if (PM(15)) pg8::gemm_phase<pg8::EpiRes, pg8::StaticOrder, true, true>(lds, g, S, E, C.tid);
            if (PM(20)) sample_gemm(lds, C.tid, YC + (size_t)MP * DM, DM, (const bf16*)(wl + LW_OUT), DM, DM, DM, G, bid, SEpiRes{XF + (size_t)MP * DM, DM, ((DUP_MASK >> 5) & 1) ? 0.5f : 1.0f, (l == 0 && !((DUP_MASK >> 5) & 1)) ? a.in(I_XS) : (const float*)(XF + (size_t)MP * DM)});
            SEAM(pb + 5);
        }
        if (IN(pb + 6)) { PHASE_CTX; if (PM(21)) REP(21) rms_phase(C, XF, HN, (bf16*)(ws + WS_HNS)); SEAM(pb + 6);
#ifdef XBAR_PROBE
            if (MK_ONE_LAUNCH) for (int i_ = 0; i_ < XBAR_PROBE; ++i_) xcd_barrier(bar);
#endif
        }
        if (IN(pb + 7)) { PHASE_CTX; const unsigned char* wl = ws + WS_WL + (size_t)l * LW_STRIDE;
            pg8::Gemm g{HN, (const bf16*)(wl + LW_Q), MP, DM, DM, DM, 64, (size_t)DM * 128}; pg8::StaticOrder S; S.init(MP, DM, G, bid); pg8::EpiBf16A<0> E{QB, DM, nullptr};
            if (PM(16)) REP(16) pg8::gemm_phase<pg8::EpiBf16A<0>, pg8::StaticOrder, true, true>(lds, g, S, E, C.tid);
            if (PM(20)) { sample_gemm(lds, C.tid, (const bf16*)(ws + WS_HNS), DMS, (const bf16*)(wl + LW_Q), DM, DM, DM, G, bid, SEpiPart{(float*)(ws + WS_SPL), DM}, 2); if ((DUP_SUB >> 24) & 1u) { const Ctx C2 = mk_ctx(lds, wave_s); sample_gemm(lds, C2.tid, (const bf16*)(ws + WS_HNS), DMS, (const bf16*)(wl + LW_Q), DM, DM, DM, G, bid, SEpiPart{(float*)(ws + WS_SPL), DM}, 2); } }
            SEAM(pb + 7);
        }
        if (IN(pb + 8)) { PHASE_CTX;
            { const int g3 = (bid >> 3) % 3;
              if (g3 == 0) { if (PM(13)) REP(13) for (int it = bid; it < 256; it += G) xattn_prompt_unit(C, a, l, it); }
              if (PM(14)) REP(14) for (int it = bid; it < NS * 4; it += 2 * G) xattn_sample_item(C, a, l, it);
              if (g3 == 1) { if (PM(13)) REP(13) for (int it = bid; it < 256; it += G) xattn_prompt_unit(C, a, l, it); }
              if (PM(14)) REP(14) for (int it = bid + G; it < NS * 4; it += 2 * G) xattn_sample_item(C, a, l, it);
              if (g3 == 2) { if (PM(13)) REP(13) for (int it = bid; it < 256; it += G) xattn_prompt_unit(C, a, l, it); } }
            SEAM(pb + 8);
        }
        if (IN(pb + 9)) { PHASE_CTX; const unsigned char* wl = ws + WS_WL + (size_t)l * LW_STRIDE;
            pg8::Gemm g{OB, (const bf16*)(wl + LW_O), MP, DM, DM, DM, 64, (size_t)DM * 128}; pg8::StaticOrder S; S.init(MP, DM, G, bid); pg8::EpiRes E{XF, DM, ((DUP_MASK >> 9) & 1) ? 0.5f : 1.0f, XF};
            if (PM(17)) pg8::gemm_phase<pg8::EpiRes, pg8::StaticOrder, true, true>(lds, g, S, E, C.tid);
            if (PM(20)) sample_gemm(lds, C.tid, (const bf16*)(ws + WS_OS), DMS, (const bf16*)(wl + LW_O), DM, DM, DM, G, bid, SEpiRes{XF + (size_t)MP * DM, DM, ((DUP_MASK >> 9) & 1) ? 0.5f : 1.0f, XF + (size_t)MP * DM});
            SEAM(pb + 9);
        }
        if (IN(pb + 10)) { PHASE_CTX; if (PM(21)) REP(21) rms_phase(C, XF, HN, (bf16*)(ws + WS_HNS)); SEAM(pb + 10); }
        if (IN(pb + 11)) { PHASE_CTX; const unsigned char* wl = ws + WS_WL + (size_t)l * LW_STRIDE;
            pg8::Gemm g{HN, (const bf16*)(wl + LW_UP), MP, DFF, DM, DM, 64, (size_t)DFF * 128}; pg8::StaticOrder S; S.init(MP, DFF, G, bid); pg8::EpiBf16A<3> E{UB, LDU, nullptr};
            if (PM(18)) REP(18) pg8::gemm_phase<pg8::EpiBf16A<3>, pg8::StaticOrder, true, true>(lds, g, S, E, C.tid);
            if (PM(20)) { sample_gemm(lds, C.tid, (const bf16*)(ws + WS_HNS), DMS, (const bf16*)(wl + LW_UP), DFF, DFF, DM, G, bid, SEpiBf16{(bf16*)(ws + WS_US), LDUS, 3, nullptr}); if ((DUP_SUB >> 23) & 1u) { const Ctx C2 = mk_ctx(lds, wave_s); sample_gemm(lds, C2.tid, (const bf16*)(ws + WS_HNS), DMS, (const bf16*)(wl + LW_UP), DFF, DFF, DM, G, bid, SEpiBf16{(bf16*)(ws + WS_US), LDUS, 3, nullptr}); } }
            SEAM(pb + 11);
        }
        if (IN(pb + 12)) { PHASE_CTX; const unsigned char* wl = ws + WS_WL + (size_t)l * LW_STRIDE;
            pg8::Gemm g{UB, (const bf16*)(wl + LW_DN), MP, DM, DFF, LDU, 64, (size_t)DM * 128}; pg8::StaticOrder S; S.init(MP, DM, G, bid); pg8::EpiRes E{XF, DM, ((DUP_MASK >> 12) & 1) ? 0.5f : 1.0f, XF};
            if (PM(19)) pg8::gemm_phase<pg8::EpiRes, pg8::StaticOrder, true, true>(lds, g, S, E, C.tid);
            if (PM(20)) { sample_gemm(lds, C.tid, (const bf16*)(ws + WS_US), LDUS, (const bf16*)(wl + LW_DN), DM, DM, DFF, G, bid, SEpiPart{(float*)(ws + WS_SPL), DM}, 2); if ((DUP_SUB >> 25) & 1u) { const Ctx C2 = mk_ctx(lds, wave_s); sample_gemm(lds, C2.tid, (const bf16*)(ws + WS_US), LDUS, (const bf16*)(wl + LW_DN), DM, DM, DFF, G, bid, SEpiPart{(float*)(ws + WS_SPL), DM}, 2); } }
            SEAM(pb + 12);
        }
        if (IN(pb + 13)) { PHASE_CTX;
            fold_split_rows(C, XF, (const float*)(ws + WS_SPL));
            if (!PM(21)) {} else if (l + 1 < DEPTH) REP(21) rms_phase(C, XF, HN, nullptr); else final_norm_phase(C, XF, a.in(I_GFIN), a.out + O_YP);
            SEAM(pb + 13);
        }
    }
#undef IN
#undef SEAM
#undef SEAM2
#undef PHASE_CTX
}

extern "C" void kernel_launch(void* const* d_in, const int* in_sizes, int n_in, void* d_out, int out_size, void* d_ws, size_t ws_size, hipStream_t stream) {
    static int grid = 0;
    if (grid == 0) {
        if (n_in != NIN || (size_t)out_size != O_END || ws_size < WS_END) { fprintf(stderr, "kernel_launch: unexpected shapes (n_in %d, out %d, ws %zu); nothing launched\n", n_in, out_size, ws_size); grid = -1; return; }
        int dev = 0, cus = 0, per_cu = 0;
        if (hipGetDevice(&dev) != hipSuccess || hipDeviceGetAttribute(&cus, hipDeviceAttributeMultiprocessorCount, dev) != hipSuccess) { grid = -1; return; }
        if (hipFuncSetAttribute((const void*)fwd_kernel, hipFuncAttributeMaxDynamicSharedMemorySize, LDS_BYTES) != hipSuccess) { fprintf(stderr, "kernel_launch: hipFuncSetAttribute failed\n"); grid = -1; return; }
        if (hipOccupancyMaxActiveBlocksPerMultiprocessor(&per_cu, (const void*)fwd_kernel, NWAVES * 64, LDS_BYTES) != hipSuccess || per_cu < 1) { fprintf(stderr, "kernel_launch: occupancy query reports %d\n", per_cu); }
        (void)hipGetLastError();
        grid = cus;
    }
    if (grid < 0) return;
    if (hipMemsetAsync((char*)d_ws + WS_CTL, 0, CTL_ZERO_BYTES, stream) != hipSuccess) return;
    Args a{};
    for (int i = 0; i < NIN; ++i) a.in[i] = (const float*)d_in[i];
    a.out = (float*)d_out; a.ws = (unsigned char*)d_ws;
#if MK_ONE_LAUNCH
    a.ph_lo = 0; a.ph_hi = NPH;
    hipLaunchKernelGGL(fwd_kernel, dim3(grid), dim3(NWAVES * 64), LDS_BYTES, stream, a);
#else
#ifndef NPH_RUN
#define NPH_RUN NPH
#endif
    for (int ph = 0; ph < NPH_RUN; ++ph) { a.ph_lo = ph; a.ph_hi = ph + 1; hipLaunchKernelGGL(fwd_kernel, dim3(grid), dim3(NWAVES * 64), LDS_BYTES, stream, a);
        const int dbit = (ph == 0) ? 13 : (ph - 1) % PH_PER_LAYER;
        if ((DUP_MASK >> dbit) & 1) hipLaunchKernelGGL(fwd_kernel, dim3(grid), dim3(NWAVES * 64), LDS_BYTES, stream, a); }
#endif
}
```

```cpp
#include <hip/hip_runtime.h>
#include <cstdio>
#include <cstdint>
namespace pg8 {
#define PG8_LAS __attribute__((address_space(3)))
typedef unsigned short bf16_t;
typedef short bf16x8 __attribute__((ext_vector_type(8)));
typedef float f32x4 __attribute__((ext_vector_type(4)));
typedef unsigned u32x4 __attribute__((ext_vector_type(4)));
constexpr int BM = 256, BK = 64, HALF = 128, HTB = HALF * BK * 2  , STAGE_BYTES = 8 * HTB, NXCD = 8, WGM = 8;

__host__ __device__ __forceinline__ int lds_byte(int r, int c) { const int st = (r >> 4) * 2 + (c >> 5), rr = r & 15, cc = c & 31, ob = rr * 64 + cc * 2; return st * 1024 + (ob ^ (((ob >> 9) & 1) << 5)); }
__host__ __device__ __forceinline__ void stage_rc(int b, int& R, int& C) { const int st = b / 1024, sb = b % 1024, swz = sb ^ (((sb >> 9) & 1) << 5); R = (st >> 1) * 16 + swz / 64; C = (st & 1) * 32 + (swz % 64) / 2; }
__host__ __device__ __forceinline__ int perm32(int rho) { const int n = rho >> 4, i = rho & 15; return 8 * (i >> 2) + 4 * n + (i & 3); }

struct Unit { int pm, pn; };
struct Gemm { const bf16_t* A; const bf16_t* Bt; int M, N, K, lda, ldb; size_t ksb; };

struct StaticOrder {
    int nM, nN, nwg, G, c;
    __host__ __device__ void init(int M, int N, int G_, int c_) { nM = M / BM; nN = N / BM; nwg = nM * nN; G = G_; c = c_; }
    __host__ __device__ bool next(int i, Unit& u) const {
        const long L = (long)i * G + c; if (L >= nwg) return false;
        int wgid = (int)L; { const int q = nwg / NXCD, r = nwg % NXCD, xcd = wgid % NXCD, off = wgid / NXCD; wgid = (xcd < r ? xcd * (q + 1) : r * (q + 1) + (xcd - r) * q) + off; }
        const int nig = WGM * nN, gid = wgid / nig, fm = gid * WGM, gsz = (nM - fm) < WGM ? (nM - fm) : WGM;
        u.pm = fm + ((wgid % nig) % gsz); u.pn = (wgid % nig) / gsz; return true;
    }
    __device__ __forceinline__ void a_ready(const Unit&) const {}
    __device__ __forceinline__ void done(const Unit&) const {}
};

typedef float f32x2_cv __attribute__((ext_vector_type(2)));
typedef __bf16 bf16x2_cv __attribute__((ext_vector_type(2)));
__device__ __forceinline__ unsigned cvt_pk_bf16(float lo, float hi) { const f32x2_cv v = {lo, hi}; return __builtin_bit_cast(unsigned, __builtin_convertvector(v, bf16x2_cv)); }
typedef float f32x2 __attribute__((ext_vector_type(2)));
template <class Epi, class Sched, bool ALIGN_EPI = false, bool SP2 = false>
__device__ __forceinline__ void gemm_phase(PG8_LAS unsigned char* lds, const Gemm g, const Sched& S, const Epi& E, int tid_in) {
    int tid_ = tid_in; asm volatile("" : "+v"(tid_));
    const int tid = tid_, wid = __builtin_amdgcn_readfirstlane(tid >> 6), lane = tid & 63, wr = wid >> 2, wc = wid & 3, fr = lane & 15, fq = lane >> 4;
    const int K = g.K, nt = K / BK;
    unsigned voffA[2], voffB[2];
#pragma unroll
    for (int i = 0; i < 2; ++i) { int R, C; stage_rc(tid * 16 + i * 8192, R, C); const int Rb = Epi::PERM ? ((R & ~31) + perm32(R & 31)) : R;
        voffA[i] = (unsigned)(R * g.lda + C) * 2u; voffB[i] = (unsigned)(Rb * g.ldb + C) * 2u; }
    const size_t kstep = (size_t)(BK * 2), kstepB = g.ksb;
    const size_t hstepA = (size_t)HALF * g.lda * 2, hstepB = (size_t)HALF * g.ldb * 2;
    const size_t tstepA = 2 * hstepA, tstepB = 2 * hstepB;
    const unsigned ldsw = (unsigned)wid * 1024u;
    const int aoff = lds_byte(wr * 64 + fr, fq * 8), boff = lds_byte(wc * 32 + fr, fq * 8);
#define PG8_SA(b, h) (((b) * 2 + (h)) * HTB)
#define PG8_SB(b, h) ((4 + (b) * 2 + (h)) * HTB)
#define PG8_STAGE(bufoff, gbase, voff) do { _Pragma("unroll") for (int _i = 0; _i < 2; ++_i) \
        __builtin_amdgcn_global_load_lds((const unsigned*)((const char*)(gbase) + (voff)[_i]), (PG8_LAS unsigned*)(lds + (bufoff) + ldsw + _i * 8192), 16, 0, 0); } while (0)
#define PG8_LDA(dst, b, h) do { _Pragma("unroll") for (int m = 0; m < 4; ++m) _Pragma("unroll") for (int k = 0; k < 2; ++k) dst[m][k] = *(const PG8_LAS bf16x8*)(lds + PG8_SA(b, h) + aoff + m * 2048 + k * 1024); } while (0)
#define PG8_LDB(dst, b, h) do { _Pragma("unroll") for (int n = 0; n < 2; ++n) _Pragma("unroll") for (int k = 0; k < 2; ++k) dst[n][k] = *(const PG8_LAS bf16x8*)(lds + PG8_SB(b, h) + boff + n * 2048 + k * 1024); } while (0)
#define PG8_MMA(ai, bj, At, Bt) do { __builtin_amdgcn_s_setprio(1); _Pragma("unroll") for (int m = 0; m < 4; ++m) _Pragma("unroll") for (int n = 0; n < 2; ++n) _Pragma("unroll") for (int k = 0; k < 2; ++k) \
        acc[ai][bj][m][n] = __builtin_amdgcn_mfma_f32_16x16x32_bf16(Bt[n][k], At[m][k], acc[ai][bj][m][n], 0, 0, 0); __builtin_amdgcn_s_setprio(0); } while (0)
#define PG8_WAIT_V(n) asm volatile("s_waitcnt vmcnt(" #n ")" ::: "memory")
#define PG8_WAIT_L(n) asm volatile("s_waitcnt lgkmcnt(" #n ")" ::: "memory")
#define PG8_BAR __builtin_amdgcn_s_barrier()
#define PG8_SCHED __builtin_amdgcn_sched_barrier(0)
    Unit cur, nxt; int ui = 0;
    if (!S.next(0, cur)) return;
    f32x4 acc[2][2][4][2];
#pragma unroll
    for (int a = 0; a < 2; ++a)
#pragma unroll
        for (int b = 0; b < 2; ++b)
#pragma unroll
            for (int m = 0; m < 4; ++m)
#pragma unroll
                for (int n = 0; n < 2; ++n) acc[a][b][m][n] = (f32x4){0.f, 0.f, 0.f, 0.f};
    bf16x8 At[4][2], B0[2][2], B1[2][2];
    const char* cA = (const char*)g.A + (size_t)cur.pm * tstepA; const char* cB = (const char*)g.Bt + (size_t)cur.pn * tstepB;
    S.a_ready(cur);
    if constexpr (SP2) {
        PG8_STAGE(PG8_SB(0, 0), cB, voffB); PG8_STAGE(PG8_SB(0, 1), cB + hstepB, voffB); PG8_STAGE(PG8_SA(0, 0), cA, voffA); PG8_STAGE(PG8_SA(0, 1), cA + hstepA, voffA);
        if (wr == 1) PG8_BAR;
        PG8_WAIT_V(2); PG8_BAR;
        PG8_STAGE(PG8_SB(1, 0), cB + kstepB, voffB); PG8_STAGE(PG8_SA(1, 0), cA + kstep, voffA); PG8_STAGE(PG8_SB(1, 1), cB + hstepB + kstepB, voffB);
        PG8_WAIT_V(6); PG8_BAR;
    } else {
        PG8_STAGE(PG8_SB(0, 0), cB, voffB); PG8_STAGE(PG8_SA(0, 0), cA, voffA); PG8_STAGE(PG8_SB(0, 1), cB + hstepB, voffB); PG8_STAGE(PG8_SA(0, 1), cA + hstepA, voffA);
        if (wr == 1) PG8_BAR;
        PG8_WAIT_V(4); PG8_BAR;
        PG8_STAGE(PG8_SB(1, 0), cB + kstepB, voffB); PG8_STAGE(PG8_SA(1, 0), cA + kstep, voffA); PG8_STAGE(PG8_SB(1, 1), cB + hstepB + kstepB, voffB);
        PG8_WAIT_V(6); PG8_BAR;
    }
    for (;;) {
        const bool has_next = S.next(ui + 1, nxt);
        const char* nA = has_next ? (const char*)g.A + (size_t)nxt.pm * tstepA : cA; const char* nB = has_next ? (const char*)g.Bt + (size_t)nxt.pn * tstepB : cB;
        for (int t = 0; t < nt; t += 2) {
            const bool last = (t == nt - 2);
            const char* a1 = cA + (size_t)(t + 1) * kstep;
            const char* a2 = last ? nA : cA + (size_t)(t + 2) * kstep; const char* b2 = last ? nB : cB + (size_t)(t + 2) * kstepB;
            const char* a3 = a2 + kstep; const char* b3 = b2 + kstepB;
            if (last && has_next) S.a_ready(nxt);
            if constexpr (SP2) {
            PG8_LDB(B0, 0, 0); PG8_LDB(B1, 0, 1); PG8_SCHED; PG8_LDA(At, 0, 0); PG8_STAGE(PG8_SA(1, 1), a1 + hstepA, voffA);
            PG8_WAIT_V(8); PG8_WAIT_L(0); PG8_BAR; PG8_MMA(0, 0, At, B0); PG8_MMA(0, 1, At, B1); PG8_BAR; PG8_SCHED;
            PG8_LDA(At, 0, 1); PG8_STAGE(PG8_SB(0, 0), b2, voffB); PG8_STAGE(PG8_SB(0, 1), b2 + hstepB, voffB); PG8_STAGE(PG8_SA(0, 0), a2, voffA);
            PG8_WAIT_V(8); PG8_WAIT_L(0); PG8_BAR; PG8_MMA(1, 0, At, B0); PG8_MMA(1, 1, At, B1); PG8_BAR; PG8_SCHED;
            PG8_LDB(B0, 1, 0); PG8_LDB(B1, 1, 1); PG8_SCHED; PG8_LDA(At, 1, 0); PG8_STAGE(PG8_SA(0, 1), a2 + hstepA, voffA);
            PG8_WAIT_V(8); PG8_WAIT_L(0); PG8_BAR; PG8_MMA(0, 0, At, B0); PG8_MMA(0, 1, At, B1); PG8_BAR; PG8_SCHED;
            PG8_LDA(At, 1, 1); PG8_STAGE(PG8_SB(1, 0), b3, voffB); PG8_STAGE(PG8_SB(1, 1), b3 + hstepB, voffB); PG8_STAGE(PG8_SA(1, 0), a3, voffA);
            PG8_WAIT_V(8); PG8_WAIT_L(0); PG8_BAR; PG8_MMA(1, 0, At, B0); PG8_MMA(1, 1, At, B1); PG8_BAR; PG8_SCHED;
            } else {
            PG8_LDB(B0, 0, 0); PG8_SCHED; PG8_LDA(At, 0, 0); PG8_STAGE(PG8_SA(1, 1), a1 + hstepA, voffA);
            PG8_WAIT_L(8); PG8_BAR; PG8_WAIT_L(0); PG8_MMA(0, 0, At, B0); PG8_BAR; PG8_SCHED;
            PG8_LDB(B1, 0, 1); PG8_STAGE(PG8_SB(0, 0), b2, voffB);
            PG8_BAR; PG8_WAIT_L(0); PG8_MMA(0, 1, At, B1); PG8_BAR;
            PG8_LDA(At, 0, 1); PG8_STAGE(PG8_SA(0, 0), a2, voffA);
            PG8_BAR; PG8_WAIT_L(0); PG8_MMA(1, 0, At, B0); PG8_BAR; PG8_SCHED;
            PG8_STAGE(PG8_SB(0, 1), b2 + hstepB, voffB);
            PG8_WAIT_V(6); PG8_BAR; PG8_MMA(1, 1, At, B1); PG8_BAR;
            PG8_LDB(B0, 1, 0); PG8_SCHED; PG8_LDA(At, 1, 0); PG8_STAGE(PG8_SA(0, 1), a2 + hstepA, voffA);
            PG8_WAIT_L(8); PG8_BAR; PG8_WAIT_L(0); PG8_MMA(0, 0, At, B0); PG8_BAR; PG8_SCHED;
            PG8_LDB(B1, 1, 1); PG8_STAGE(PG8_SB(1, 0), b3, voffB);
            PG8_BAR; PG8_WAIT_L(0); PG8_MMA(0, 1, At, B1); PG8_BAR;
            PG8_LDA(At, 1, 1); PG8_STAGE(PG8_SA(1, 0), a3, voffA);
            PG8_BAR; PG8_WAIT_L(0); PG8_MMA(1, 0, At, B0); PG8_BAR; PG8_SCHED;
            PG8_STAGE(PG8_SB(1, 1), b3 + hstepB, voffB);
            PG8_WAIT_V(6); PG8_BAR; PG8_MMA(1, 1, At, B1); PG8_BAR;
            }
        }
        if constexpr (ALIGN_EPI) { if (wr == 0) PG8_BAR; }
        if constexpr (!Epi::AFTER_DRAIN) { E(acc, cur, wr, wc, fr, fq); S.done(cur); }
        if (!has_next) break;
#pragma unroll
        for (int a = 0; a < 2; ++a)
#pragma unroll
            for (int b = 0; b < 2; ++b)
#pragma unroll
                for (int m = 0; m < 4; ++m)
#pragma unroll
                    for (int n = 0; n < 2; ++n) acc[a][b][m][n] = (f32x4){0.f, 0.f, 0.f, 0.f};
        cur = nxt; cA = nA; cB = nB; ++ui;
        if constexpr (ALIGN_EPI) { if (wr == 1) PG8_BAR; }
    }
    PG8_WAIT_V(0);
    if constexpr (!ALIGN_EPI) { if (wr == 0) PG8_BAR; }
    PG8_BAR;
    if constexpr (Epi::AFTER_DRAIN) { E.fused(acc, cur, wr, wc, fr, fq, lds, wid, lane); S.done(cur); }
#undef PG8_SA
#undef PG8_SB
#undef PG8_STAGE
#undef PG8_LDA
#undef PG8_LDB
#undef PG8_MMA
#undef PG8_WAIT_V
#undef PG8_WAIT_L
#undef PG8_BAR
#undef PG8_SCHED
}
}

constexpr int DM = 2048, SEQ = 2048, NB = 4, NS = 128, DEPTH = 2;
constexpr int MP = NB * SEQ;
constexpr int MT = MP + NS;
constexpr int MPAD = MP + 256;
constexpr int PIN = 6400, DFF = 8192, NMEM = 256, MMEM = NB * NMEM;
constexpr int PB_ = 1536, PC_ = 3584, PD_ = 5376;
constexpr int SHW = 1792;
constexpr int LDU = 8192;
constexpr int NWAVES = 8;
constexpr int NIN = 39;

constexpr size_t O_YP = 0, O_YS = O_YP + (size_t)MP * DM, O_CAP = O_YS + (size_t)NS * DM, O_CAS = O_CAP + (size_t)DEPTH * NB * 2 * 512,
    O_RETP = O_CAS + (size_t)DEPTH * NS * 2 * 512, O_RETS = O_RETP + (size_t)DEPTH * NB * 4 * 128 * 128, O_SHP = O_RETS + (size_t)DEPTH * NS * 4 * 128 * 128,
    O_SHS = O_SHP + (size_t)DEPTH * NB * SHW, O_WKVP = O_SHS + (size_t)DEPTH * NS * SHW, O_WKVS = O_WKVP + (size_t)DEPTH * NB * 8 * 64 * 64,
    O_CDP = O_WKVS + (size_t)DEPTH * NS * 8 * 64 * 64, O_CDS = O_CDP + (size_t)DEPTH * NB * 30 * 512, O_MKP = O_CDS + (size_t)DEPTH * NS * 30 * 512,
    O_MVP = O_MKP + (size_t)DEPTH * MMEM * DM, O_END = O_MVP + (size_t)DEPTH * MMEM * DM;
static_assert(O_END == 56178688, "d_out size");

constexpr size_t MiB = 1u << 20;
constexpr size_t al256(size_t x) { return (x + 255) & ~(size_t)255; }
constexpr size_t WS_CTL = 0, CTL_ZERO_BYTES = 1 * MiB;
constexpr size_t WS_ROPE = 1 * MiB;
constexpr size_t SZ_WIN = (size_t)PIN * DM * 2, SZ_SQ = (size_t)DM * DM * 2, SZ_WUP = (size_t)DFF * DM * 2, SZ_WDN = (size_t)DM * LDU * 2;
constexpr size_t LW_IN = 0, LW_OUT = LW_IN + SZ_WIN, LW_Q = LW_OUT + SZ_SQ, LW_O = LW_Q + SZ_SQ, LW_UP = LW_O + SZ_SQ, LW_DN = LW_UP + SZ_WUP,
    LW_W2 = LW_DN + SZ_WDN, LW_A2 = LW_W2 + 512 * 64 * 2, LW_G2 = LW_A2 + 512 * 64 * 2, LW_STRIDE = LW_G2 + 512 * 128 * 2;
constexpr size_t WS_WL = 4 * MiB;
constexpr size_t WS_WKV = al256(WS_WL + 2 * LW_STRIDE);
constexpr size_t WS_XF = al256(WS_WKV + (size_t)8192 * DM * 2);
constexpr size_t WS_HN = al256(WS_XF + (size_t)MT * DM * 4);
constexpr size_t WS_MN = al256(WS_HN + (size_t)MPAD * DM * 2);
constexpr size_t WS_MK = al256(WS_MN + (size_t)MMEM * DM * 2);
constexpr size_t WS_MVT = al256(WS_MK + (size_t)2 * MMEM * DM * 2);
constexpr size_t WS_P = al256(WS_MVT + (size_t)2 * MMEM * DM * 2);
constexpr size_t WS_YC = al256(WS_P + (size_t)MPAD * PIN * 2);
constexpr size_t WS_Q = al256(WS_YC + (size_t)MT * DM * 2);
constexpr size_t WS_O = al256(WS_Q + (size_t)MT * DM * 2);
constexpr size_t WS_U = al256(WS_O + (size_t)MT * DM * 2);
constexpr size_t WS_RW = al256(WS_U + (size_t)MT * LDU * 2);
constexpr size_t WS_GATE = al256(WS_RW + (size_t)MT * 8 * 896);
constexpr size_t WS_OC = al256(WS_GATE + (size_t)MT * 512 * 4);
constexpr size_t WS_KVT = al256(WS_OC + (size_t)MT * 512 * 4);
constexpr size_t WS_SSQ = al256(WS_KVT + (size_t)16 * 16 * 128 * 128 * 4);
constexpr size_t WS_SPL = al256(WS_SSQ + (size_t)MP * 8 * 4);
constexpr size_t WS_STB = al256(WS_SPL + (size_t)2 * NS * DM * 4);
constexpr size_t WS_CK = al256(WS_STB + (size_t)16 * 16 * 128 * 128 * 2);
constexpr size_t WS_CP = al256(WS_CK + (size_t)4096 * 6912);
constexpr int DMS = DM + 128, LDUS = LDU + 128;
constexpr size_t WS_HNS = al256(WS_CP + (size_t)4096 * 4 * 3072);
constexpr size_t WS_OS = al256(WS_HNS + (size_t)NS * DMS * 2);
constexpr size_t WS_US = al256(WS_OS + (size_t)NS * DMS * 2);
constexpr size_t WS_END = al256(WS_US + (size_t)NS * LDUS * 2);
static_assert(WS_END < (size_t)1700 * MiB, "d_ws map");
constexpr int CW_BAR = 4096;

constexpr int SCR_BYTES = 147456;
constexpr int MISC_OFF = SCR_BYTES;
constexpr int LDS_BYTES = SCR_BYTES + 1024;

#define GAS __attribute__((address_space(1)))
#define LAS __attribute__((address_space(3)))
typedef unsigned short bf16;
typedef unsigned v4u __attribute__((ext_vector_type(4)));
typedef unsigned v2u __attribute__((ext_vector_type(2)));
typedef float f32x4 __attribute__((ext_vector_type(4)));
typedef float f32x2 __attribute__((ext_vector_type(2)));
typedef short bf16x8 __attribute__((ext_vector_type(8)));
typedef short bf16x4 __attribute__((ext_vector_type(4)));
typedef GAS unsigned gu32;
#define RLX_AGENT __ATOMIC_RELAXED, __HIP_MEMORY_SCOPE_AGENT
#define LDS_WAIT() asm volatile("s_waitcnt lgkmcnt(0)" ::: "memory")
#define VM_WAIT() asm volatile("s_waitcnt vmcnt(0)" ::: "memory")
__device__ __forceinline__ unsigned pk2(float lo, float hi) { return pg8::cvt_pk_bf16(lo, hi); }
__device__ __forceinline__ float bflo(unsigned w) { return __uint_as_float(w << 16); }
__device__ __forceinline__ float bfhi(unsigned w) { return __uint_as_float(w & 0xffff0000u); }
__device__ __forceinline__ float bf1(bf16 h) { return __uint_as_float(((unsigned)h) << 16); }
__device__ __forceinline__ void unpack8(const v4u w, float (&f)[8]) { f[0] = bflo(w.x); f[1] = bfhi(w.x); f[2] = bflo(w.y); f[3] = bfhi(w.y); f[4] = bflo(w.z); f[5] = bfhi(w.z); f[6] = bflo(w.w); f[7] = bfhi(w.w); }
__device__ __forceinline__ void unpack4(const v2u w, float (&f)[4]) { f[0] = bflo(w.x); f[1] = bfhi(w.x); f[2] = bflo(w.y); f[3] = bfhi(w.y); }
__device__ __forceinline__ v4u pack8(const float (&f)[8]) { v4u w; w.x = pk2(f[0], f[1]); w.y = pk2(f[2], f[3]); w.z = pk2(f[4], f[5]); w.w = pk2(f[6], f[7]); return w; }
__device__ __forceinline__ float sigm(float x) { return 1.0f / (1.0f + __expf(-x)); }
__device__ __forceinline__ float wave_sum(float v) {
#pragma unroll
    for (int o = 1; o < 64; o <<= 1) v += __shfl_xor(v, o);
    return v;
}
__device__ __forceinline__ float wave_max(float v) {
#pragma unroll
    for (int o = 1; o < 64; o <<= 1) v = fmaxf(v, __shfl_xor(v, o));
    return v;
}
template <int CTRL> __device__ __forceinline__ float dpp_f(float v) { return __builtin_bit_cast(float, __builtin_amdgcn_update_dpp(0, __builtin_bit_cast(int, v), CTRL, 0xf, 0xf, false)); }
__device__ __forceinline__ f32x4 zero4() { float z0, z1, z2, z3; asm volatile("v_mov_b32 %0, 0\n\tv_mov_b32 %1, 0\n\tv_mov_b32 %2, 0\n\tv_mov_b32 %3, 0\n\ts_nop 1" : "=v"(z0), "=v"(z1), "=v"(z2), "=v"(z3)); return (f32x4){z0, z1, z2, z3}; }
__device__ __forceinline__ float rowsum16(float v) { v += dpp_f<0x128>(v); v += dpp_f<0x124>(v); v += dpp_f<0x122>(v); v += dpp_f<0x121>(v); return v; }

namespace pg8 {
template <int ACT> struct EpiBf16A {
    static constexpr bool PERM = true, AFTER_DRAIN = false;
    bf16_t* O; int ldc; const float* ssq;
    __device__ __forceinline__ void operator()(const f32x4 (&acc)[2][2][4][2], const Unit& u, int wr, int wc, int fr, int fq) const {
        const int row0 = u.pm * BM + wr * 64 + fr, col0 = u.pn * BM + wc * 32 + 8 * fq;
#pragma unroll
        for (int ai = 0; ai < 2; ++ai)
#pragma unroll
            for (int m = 0; m < 4; ++m) { bf16_t* rowp = O + (size_t)(row0 + ai * HALF + m * 16) * ldc + col0;
                const float rs = ssq ? 1.0f / sqrtf(ssq[row0 + ai * HALF + m * 16] * (1.0f / 2048.0f) + 1e-6f) : 1.0f;
#pragma unroll
                for (int bj = 0; bj < 2; ++bj) { f32x4 v0 = acc[ai][bj][m][0] * rs, v1 = acc[ai][bj][m][1] * rs;
                    if (ACT == 3) {
#pragma unroll
                        for (int j = 0; j < 4; ++j) { const float a = fmaxf(v0[j], 0.f), b = fmaxf(v1[j], 0.f); v0[j] = a * a; v1[j] = b * b; } }
                    u32x4 w; w.x = cvt_pk_bf16(v0[0], v0[1]); w.y = cvt_pk_bf16(v0[2], v0[3]); w.z = cvt_pk_bf16(v1[0], v1[1]); w.w = cvt_pk_bf16(v1[2], v1[3]);
                    *(u32x4*)(rowp + bj * HALF) = w; } }
    }
};
struct EpiRes {
    static constexpr bool PERM = false, AFTER_DRAIN = false;
    float* X; int ldc; float sc; const float* Xin;
    __device__ __forceinline__ void operator()(const f32x4 (&acc)[2][2][4][2], const Unit& u, int wr, int wc, int fr, int fq) const {
        const int row0 = u.pm * BM + wr * 64 + fr, col0 = u.pn * BM + wc * 32 + 4 * fq;
#pragma unroll
        for (int ai = 0; ai < 2; ++ai)
#pragma unroll
            for (int m = 0; m < 4; ++m) { float* rowp = X + (size_t)(row0 + ai * HALF + m * 16) * ldc + col0; const float* inp = Xin + (size_t)(row0 + ai * HALF + m * 16) * ldc + col0;
                f32x4 o[2][2];
#pragma unroll
                for (int bj = 0; bj < 2; ++bj)
#pragma unroll
                    for (int n = 0; n < 2; ++n) o[bj][n] = *(const f32x4*)(inp + bj * HALF + n * 16);
#pragma unroll
                for (int bj = 0; bj < 2; ++bj)
#pragma unroll
                    for (int n = 0; n < 2; ++n) *(f32x4*)(rowp + bj * HALF + n * 16) = o[bj][n] + acc[ai][bj][m][n] * sc; }
    }
};
struct EpiMemKV {
    static constexpr bool PERM = false, AFTER_DRAIN = false;
    float* outK; bf16_t* MKb; bf16_t* MVT;
    __device__ __forceinline__ void operator()(const f32x4 (&acc)[2][2][4][2], const Unit& u, int wr, int wc, int fr, int fq) const {
        const int cbase = u.pn * BM, lyr = cbase >> 12, cc = cbase & 4095; const bool isV = cc >= 2048; const int colt = cc & 2047;
        const int row0 = u.pm * BM + wr * 64 + fr, col0 = colt + wc * 32 + 4 * fq;
        float* outp = outK + (isV ? (size_t)(O_MVP - O_MKP) : (size_t)0);
#pragma unroll
        for (int ai = 0; ai < 2; ++ai)
#pragma unroll
            for (int m = 0; m < 4; ++m) { const int r = row0 + ai * HALF + m * 16;
#pragma unroll
                for (int bj = 0; bj < 2; ++bj)
#pragma unroll
                    for (int n = 0; n < 2; ++n) { const int col = col0 + bj * HALF + n * 16; const f32x4 v = acc[ai][bj][m][n];
                        *(f32x4*)(outp + ((size_t)lyr * 1024 + r) * 2048 + col) = v;
                        if (!isV) { unsigned lo = cvt_pk_bf16(v[0], v[1]), hi = cvt_pk_bf16(v[2], v[3]); *(unsigned long long*)(MKb + ((size_t)lyr * 1024 + r) * 2048 + col) = ((unsigned long long)hi << 32) | lo; }
                        else { const int b = r >> 8, j = r & 255, h = col >> 9, e = col & 511; bf16_t* tp = MVT + ((((size_t)lyr * 4 + b) * 4 + h) * 512 + e) * 256 + j;
                            const unsigned lo = cvt_pk_bf16(v[0], v[1]), hi = cvt_pk_bf16(v[2], v[3]);
                            tp[0] = (bf16_t)(lo & 0xffffu); tp[256] = (bf16_t)(lo >> 16); tp[512] = (bf16_t)(hi & 0xffffu); tp[768] = (bf16_t)(hi >> 16); } } }
    }
};
}

struct SEpiBf16 { bf16* O; int ldc; int act; const float* ssq;
    __device__ __forceinline__ void operator()(int row, int col0, f32x4 v, int) const {
        if (ssq) v = v * (1.0f / sqrtf(ssq[row] * (1.0f / 2048.0f) + 1e-6f));
        if (act == 3) {
#pragma unroll
            for (int j = 0; j < 4; ++j) { const float a = fmaxf(v[j], 0.f); v[j] = a * a; } }
        v2u w; w.x = pk2(v[0], v[1]); w.y = pk2(v[2], v[3]); *(v2u*)(O + (size_t)row * ldc + col0) = w; } };
struct SEpiRes { float* X; int ldc; float sc; const float* Xin;
    __device__ __forceinline__ void operator()(int row, int col0, f32x4 v, int) const { *(f32x4*)(X + (size_t)row * ldc + col0) = *(const f32x4*)(Xin + (size_t)row * ldc + col0) + v * sc; } };
struct SEpiPart { float* S; int ldc;
    __device__ __forceinline__ void operator()(int row, int col0, f32x4 v, int kp) const { *(f32x4*)(S + ((size_t)kp * NS + row) * ldc + col0) = v; } };
template <class F> __device__ __forceinline__ void sample_gemm(LAS unsigned char* lds, int tid_in, const bf16* A, int lda, const bf16* Bt, int ntot, int N, int K, int G, int bid, const F& epi, int nks = 1) {
    int tid_ = tid_in; asm volatile("" : "+v"(tid_));
    const int lane = tid_ & 63, wave = __builtin_amdgcn_readfirstlane(tid_ >> 6), fr = lane & 15, fq = lane >> 4;
    const int KS = (K / nks) >> 3, ncu = N / 16;
    LAS f32x4* red = (LAS f32x4*)lds;
    const unsigned voffa = (unsigned)(fr * lda + fq * 8) * 2u, voffb = (unsigned)(fr * 64 + fq * 8) * 2u;
    for (int uu = bid; uu < ncu * nks; uu += G) { const int kp = uu / ncu, u = uu - kp * ncu, kbeg = kp * (K / nks) + wave * KS;
        const char* bp = (const char*)(Bt + ((size_t)(kbeg >> 6) * ntot + u * 16) * 64);
        const char* ap = (const char*)(A + kbeg);
        f32x4 acc[8];
#pragma unroll
        for (int rt = 0; rt < 8; ++rt) acc[rt] = zero4();
        bf16x8 b0[2], a0[2][8], b1[2], a1[2][8];
#define SG_LOAD(bb, aa, kq) do { _Pragma("unroll") for (int s = 0; s < 2; ++s) { bb[s] = *(const bf16x8*)(bp + ((size_t)((kq) >> 6) * ntot * 64 + 32 * s) * 2 + voffb); \
            _Pragma("unroll") for (int rt = 0; rt < 8; ++rt) aa[s][rt] = *(const bf16x8*)(ap + ((size_t)rt * 16 * lda + (kq) + 32 * s) * 2 + voffa); } } while (0)
#define SG_MMA(bb, aa) do { _Pragma("unroll") for (int s = 0; s < 2; ++s) _Pragma("unroll") for (int rt = 0; rt < 8; ++rt) acc[rt] = __builtin_amdgcn_mfma_f32_16x16x32_bf16(bb[s], aa[s][rt], acc[rt], 0, 0, 0); } while (0)
        SG_LOAD(b0, a0, 0);
        for (int k0 = 0; k0 < KS; k0 += 128) {
            __builtin_amdgcn_sched_barrier(0);
            SG_LOAD(b1, a1, k0 + 64);
            __builtin_amdgcn_sched_barrier(0);
            SG_MMA(b0, a0);
            __builtin_amdgcn_sched_barrier(0);
            if (k0 + 128 < KS) SG_LOAD(b0, a0, k0 + 128);
            __builtin_amdgcn_sched_barrier(0);
            SG_MMA(b1, a1);
        }
        __builtin_amdgcn_sched_barrier(0);
#undef SG_LOAD
#undef SG_MMA
#pragma unroll
        for (int rt = 0; rt < 8; ++rt) red[(wave * 8 + rt) * 64 + lane] = acc[rt];
        __syncthreads();
        f32x4 sum = red[wave * 64 + lane];
#pragma unroll
        for (int ks = 1; ks < 8; ++ks) sum += red[(ks * 8 + wave) * 64 + lane];
        epi(wave * 16 + fr, u * 16 + 4 * fq, sum, kp);
        __syncthreads();
    }
}
#define XB_TMO      128
#define XB_XCNT(j)  (256  + 64 * (j))
#define XB_XSUB(j)  (1280 + 64 * (j))
#define XB_XGEN(j)  (2304 + 64 * (j))
#define XB_TOP      3328
#define XB_TOPGEN   3392
#define XCD_BAR_WORDS 3456
#define XB_SPIN_CAP (1u << 18)

__device__ __forceinline__ unsigned xb_ld(unsigned* p)              { return __hip_atomic_load(p, __ATOMIC_RELAXED, __HIP_MEMORY_SCOPE_AGENT); }
__device__ __forceinline__ unsigned xb_add(unsigned* p, unsigned v) { return __hip_atomic_fetch_add(p, v, __ATOMIC_RELAXED, __HIP_MEMORY_SCOPE_AGENT); }
__device__ __forceinline__ unsigned xb_xcc_id() { return (unsigned)__builtin_amdgcn_s_getreg((3 << 11) | 20) & 0xFu; }
#define XB_SPIN(cond, bar) do { unsigned _sp = 0; while (cond) { __builtin_amdgcn_s_sleep(1); \
    if ((++_sp & 255u) == 0u) { if (xb_ld(&(bar)[XB_TMO])) break; if (_sp > XB_SPIN_CAP) { atomicAdd(&(bar)[XB_TMO], 1u); break; } } } } while (0)

struct XcdBarrier {
    int wave;
    unsigned* bar; unsigned x;
    volatile LAS unsigned* st;
};

__device__ __forceinline__ XcdBarrier xcd_barrier_post(unsigned* bar, volatile LAS unsigned* st) {
    XcdBarrier b; b.bar = bar; b.x = xb_xcc_id(); b.st = st;
    if (threadIdx.x == 0) (void)xb_add(&bar[XB_XCNT(b.x)], 1u);
    return b;
}
__device__ __forceinline__ void xcd_barrier_complete(unsigned* bar, unsigned x, unsigned& nloc, unsigned& nx) {
    const unsigned G = gridDim.x * gridDim.y * gridDim.z;
    unsigned sum, cnt, mine, sp = 0u;
    for (;;) {
        sum = 0u; cnt = 0u; mine = 0u;
#pragma unroll
        for (unsigned j = 0; j < 16; ++j) { const unsigned c = xb_ld(&bar[XB_XCNT(j)]); sum += c; cnt += (c > 0u) ? 1u : 0u; mine = (j == x) ? c : mine; }
        if (sum == G) break;
        __builtin_amdgcn_s_sleep(1);
        if ((++sp & 255u) == 0u) { if (xb_ld(&bar[XB_TMO])) break; if (sp > XB_SPIN_CAP) { atomicAdd(&bar[XB_TMO], 1u); break; } }
    }
    nloc = mine > 0u ? mine : 1u; nx = cnt > 0u ? cnt : 1u;
}

__device__ __forceinline__ void xcd_barrier(const XcdBarrier& b) {
    asm volatile("s_waitcnt vmcnt(0)" ::: "memory");
    __syncthreads();
    unsigned xbz = 0u; asm volatile("" : "+v"(xbz));
    if (b.wave == 0 && __builtin_amdgcn_mbcnt_hi(~0u, __builtin_amdgcn_mbcnt_lo(~0u, xbz)) == 0u) {
        unsigned* bar = b.bar;
        __builtin_amdgcn_s_waitcnt(0);
        unsigned nloc = b.st[0], nx = b.st[1];
        if (nloc == 0u) { xcd_barrier_complete(bar, b.x, nloc, nx); b.st[0] = nloc; b.st[1] = nx; }
        const unsigned old = xb_add(&bar[XB_XSUB(b.x)], 1u);
        const unsigned gen = old / nloc;
        if (old + 1u == (gen + 1u) * nloc) {
            __builtin_amdgcn_fence(__ATOMIC_RELEASE, "agent");
            asm volatile("s_waitcnt vmcnt(0)" ::: "memory");
            const unsigned og = xb_add(&bar[XB_TOP], 1u);
            const unsigned tg = og / nx;
            if (og + 1u == (tg + 1u) * nx) xb_add(&bar[XB_TOPGEN], 1u);
            else XB_SPIN(xb_ld(&bar[XB_TOPGEN]) == tg, bar);
            __builtin_amdgcn_fence(__ATOMIC_ACQUIRE, "agent");
            xb_add(&bar[XB_XGEN(b.x)], 1u);
            asm volatile("s_waitcnt vmcnt(0)" ::: "memory");
        } else {
            XB_SPIN(xb_ld(&bar[XB_XGEN(b.x)]) == gen, bar);
            __builtin_amdgcn_fence(__ATOMIC_ACQUIRE, "agent");
            asm volatile("s_waitcnt vmcnt(0)" ::: "memory");
        }
    }
    __syncthreads();
}

struct Args { const float* in[NIN]; float* out; unsigned char* ws; int ph_lo, ph_hi; };
enum { I_XP = 0, I_XS, I_MEM, I_SCA, I_SRET, I_SSH, I_SWKV, I_SCD, I_CMK, I_CMV, I_GMIX, I_WIN, I_CAW, I_MU, I_W0, I_W2, I_A0, I_A2, I_G2, I_KK, I_KA, I_RK, I_LNXG, I_LNXB,
       I_CDW, I_CDB, I_LNDG, I_LNDB, I_WOUT, I_GXA, I_GMEM, I_WQ, I_WK, I_WV, I_WO, I_GMLP, I_WUP, I_WDN, I_GFIN };

struct Ctx { LAS unsigned char* lds; int tid, lane, wave, G, bid; };
typedef const GAS float* gcfp;
#define CAS __attribute__((address_space(4)))
struct Ax { const CAS gcfp* kp; float* out; unsigned char* ws;
    __device__ __forceinline__ const float* in(int i) const { return (const float*)kp[i]; } };
__device__ __forceinline__ Ax mk_ax() { const CAS gcfp* kp = (const CAS gcfp*)__builtin_amdgcn_kernarg_segment_ptr(); asm volatile("" : "+s"(kp)); Ax a; a.kp = kp;
    a.out = (float*)(GAS float*)kp[NIN]; a.ws = (unsigned char*)(GAS unsigned char*)kp[NIN + 1]; return a; }
__device__ __forceinline__ Ctx mk_ctx(LAS unsigned char* lds, int wave_s) { unsigned z = 0u; asm volatile("" : "+v"(z)); int t = wave_s * 64 + (int)__builtin_amdgcn_mbcnt_hi(~0u, __builtin_amdgcn_mbcnt_lo(~0u, z)); Ctx C; C.lds = lds; C.tid = t; C.lane = t & 63; C.wave = __builtin_amdgcn_readfirstlane(t >> 6); C.G = gridDim.x; C.bid = blockIdx.x; return C; }

__device__ __forceinline__ void p0_transpose_item(const float* W, int K, int N, bf16* WT, int ldk, int row_off, LAS float* scr, int item, int lane, const float* gain) {
    const int nblk = N / 64, kb = item / nblk, nb = item - kb * nblk, k0 = 64 * kb, n0 = 64 * nb;
    const int lr = lane >> 4, lc = (lane & 15) * 4;
#pragma unroll 8
    for (int i = 0; i < 16; ++i) { const int kk = 4 * i + lr; const float g = gain ? gain[k0 + kk] : 1.0f; const f32x4 v = *(const f32x4*)(W + (size_t)(k0 + kk) * N + n0 + lc);
        LAS float* d = scr + kk * 65 + lc; d[0] = v.x * g; d[1] = v.y * g; d[2] = v.z * g; d[3] = v.w * g; }
    LDS_WAIT(); asm volatile("" ::: "memory");
    const int c = lane & 7;
#pragma unroll
    for (int j = 0; j < 8; ++j) { const int n = (lane >> 3) + 8 * j; const LAS float* s = scr + (8 * c) * 65 + n;
        v4u o; o.x = pk2(s[0 * 65], s[1 * 65]); o.y = pk2(s[2 * 65], s[3 * 65]); o.z = pk2(s[4 * 65], s[5 * 65]); o.w = pk2(s[6 * 65], s[7 * 65]);
        if (ldk > 0) *(v4u*)(WT + (size_t)(row_off + n0 + n) * ldk + k0 + 8 * c) = o;
        else *(v4u*)(WT + ((size_t)kb * (size_t)(-ldk) + row_off + n0 + n) * 64 + 8 * c) = o; }
    LDS_WAIT(); asm volatile("" ::: "memory");
}
__device__ __forceinline__ void rms_row(const float* xrow, bf16* orow, float* xcopy, int lane) {
    const f32x4* xr = (const f32x4*)xrow + lane;
    f32x4 v[8]; float s = 0.f;
#pragma unroll
    for (int j = 0; j < 8; ++j) { v[j] = xr[64 * j]; s += (v[j].x * v[j].x + v[j].y * v[j].y) + (v[j].z * v[j].z + v[j].w * v[j].w); }
    const float rs = 1.0f / sqrtf(wave_sum(s) * (1.0f / DM) + 1e-6f);
    if (xcopy) {
#pragma unroll
        for (int j = 0; j < 8; ++j) ((f32x4*)xcopy + lane)[64 * j] = v[j]; }
    unsigned long long* o8 = (unsigned long long*)orow + lane;
#pragma unroll
    for (int j = 0; j < 8; ++j) o8[64 * j] = (unsigned long long)pk2(v[j].x * rs, v[j].y * rs) | ((unsigned long long)pk2(v[j].z * rs, v[j].w * rs) << 32);
}
__device__ __forceinline__ void rms_phase(const Ctx& C, const float* X, bf16* HN, bf16* HNS) {
    const int gw = C.bid * NWAVES + C.wave, NGW = C.G * NWAVES;
    f32x4 v[8], nx[8]; int m = gw;
    if (m < MT) { const f32x4* xr = (const f32x4*)(X + (size_t)m * DM) + C.lane;
#pragma unroll
        for (int j = 0; j < 8; ++j) v[j] = xr[64 * j]; }
    for (; m < MT; m += NGW) {
        const int mn = m + NGW;
        if (mn < MT) { const f32x4* xr = (const f32x4*)(X + (size_t)mn * DM) + C.lane;
#pragma unroll
            for (int j = 0; j < 8; ++j) nx[j] = xr[64 * j]; }
        float s = 0.f;
#pragma unroll
        for (int j = 0; j < 8; ++j) s += (v[j].x * v[j].x + v[j].y * v[j].y) + (v[j].z * v[j].z + v[j].w * v[j].w);
        const float rs = 1.0f / sqrtf(wave_sum(s) * (1.0f / DM) + 1e-6f);
        unsigned long long* o8 = (unsigned long long*)((HNS && m >= MP) ? HNS + (size_t)(m - MP) * DMS : HN + (size_t)m * DM) + C.lane;
#pragma unroll
        for (int j = 0; j < 8; ++j) o8[64 * j] = (unsigned long long)pk2(v[j].x * rs, v[j].y * rs) | ((unsigned long long)pk2(v[j].z * rs, v[j].w * rs) << 32);
#pragma unroll
        for (int j = 0; j < 8; ++j) v[j] = nx[j];
    }
}
__device__ __forceinline__ void fold_split_rows(const Ctx& C, float* X, const float* S) {
    const int gw = C.bid * NWAVES + C.wave, NGW = C.G * NWAVES;
    for (int r = gw; r < NS; r += NGW) { f32x4* xr = (f32x4*)(X + (size_t)(MP + r) * DM) + C.lane; const f32x4* s0 = (const f32x4*)(S + (size_t)r * DM) + C.lane; const f32x4* s1 = (const f32x4*)(S + (size_t)(NS + r) * DM) + C.lane;
#pragma unroll
        for (int j = 0; j < 8; ++j) xr[64 * j] = xr[64 * j] + (s0[64 * j] + s1[64 * j]); }
    asm volatile("s_waitcnt vmcnt(0)" ::: "memory");
}
__device__ __forceinline__ void final_norm_phase(const Ctx& C, const float* X, const float* g, float* out) {
    const int gw = C.bid * NWAVES + C.wave, NGW = C.G * NWAVES;
    for (int m = gw; m < MT; m += NGW) {
        const f32x4* xr = (const f32x4*)(X + (size_t)m * DM) + C.lane; const f32x4* gr = (const f32x4*)g + C.lane;
        f32x4 v[8]; float s = 0.f;
#pragma unroll
        for (int j = 0; j < 8; ++j) { v[j] = xr[64 * j]; s += (v[j].x * v[j].x + v[j].y * v[j].y) + (v[j].z * v[j].z + v[j].w * v[j].w); }
        const float rs = 1.0f / sqrtf(wave_sum(s) * (1.0f / DM) + 1e-6f);
        f32x4* orow = (f32x4*)(out + (size_t)m * DM) + C.lane;
#pragma unroll
        for (int j = 0; j < 8; ++j) orow[64 * j] = v[j] * rs * gr[64 * j];
    }
}
#ifndef LATE_EXTRA
#define LATE_EXTRA 0
#endif
struct TDesc { const float* W; const float* gain; bf16* WT; int K, N, ldk, row_off, item; };
__device__ __forceinline__ TDesc p0_desc(const Ax& a, int it, int G) {
    constexpr int I_IN = 32 * 100, I_SQ = 32 * 32, I_UP = 32 * 128, I_DN = 128 * 32, I_L64 = 8, I_L128 = 16;
    constexpr int PER_LAYER = I_IN + 5 * I_SQ + I_UP + I_DN + 2 * I_L64 + I_L128;
    const int l = it / PER_LAYER; int r = it - l * PER_LAYER; unsigned char* wl = a.ws + WS_WL + (size_t)l * LW_STRIDE; bf16* wkv = (bf16*)(a.ws + WS_WKV);
    TDesc d; d.row_off = 0; d.gain = nullptr; const bool late = G == 256 && DEPTH == 2, late1 = late && l == 1 && LATE_EXTRA;
    if (r < I_IN) { d.W = a.in(I_WIN) + (size_t)l * DM * PIN; d.K = DM; d.N = PIN; d.WT = (bf16*)(wl + LW_IN); d.ldk = -PIN; d.gain = a.in(I_GMIX) + l * DM; d.item = r; return d; } r -= I_IN;
    if (r < I_SQ) { d.W = a.in(I_WOUT) + (size_t)l * DM * DM; d.K = DM; d.N = DM; d.WT = (bf16*)(wl + LW_OUT); d.ldk = -DM; d.item = late1 ? -1 : r; return d; } r -= I_SQ;
    if (r < I_SQ) { d.W = a.in(I_WQ) + (size_t)l * DM * DM; d.K = DM; d.N = DM; d.WT = (bf16*)(wl + LW_Q); d.ldk = -DM; d.gain = a.in(I_GXA) + l * DM; d.item = late1 ? -1 : r; return d; } r -= I_SQ;
    if (r < I_SQ) { d.W = a.in(I_WO) + (size_t)l * DM * DM; d.K = DM; d.N = DM; d.WT = (bf16*)(wl + LW_O); d.ldk = -DM; d.item = late1 ? -1 : r; return d; } r -= I_SQ;
    if (r < I_SQ) { d.W = a.in(I_WK) + (size_t)l * DM * DM; d.K = DM; d.N = DM; d.WT = wkv; d.ldk = -8192; d.row_off = l * 4096; d.gain = a.in(I_GMEM) + l * DM; d.item = late1 ? -1 : r; return d; } r -= I_SQ;
    if (r < I_SQ) { d.W = a.in(I_WV) + (size_t)l * DM * DM; d.K = DM; d.N = DM; d.WT = wkv; d.ldk = -8192; d.row_off = l * 4096 + 2048; d.gain = a.in(I_GMEM) + l * DM; d.item = late1 ? -1 : r; return d; } r -= I_SQ;
    if (r < I_UP) { d.W = a.in(I_WUP) + (size_t)l * DM * DFF; d.K = DM; d.N = DFF; d.WT = (bf16*)(wl + LW_UP); d.ldk = -DFF; d.gain = a.in(I_GMLP) + l * DM; d.item = late ? -1 : r; return d; } r -= I_UP;
    if (r < I_DN) { d.W = a.in(I_WDN) + (size_t)l * DFF * DM; d.K = DFF; d.N = DM; d.WT = (bf16*)(wl + LW_DN); d.ldk = -DM; d.item = late ? -1 : r; return d; } r -= I_DN;
    if (r < I_L64) { d.W = a.in(I_W2) + (size_t)l * 64 * 512; d.K = 64; d.N = 512; d.WT = (bf16*)(wl + LW_W2); d.ldk = 64; d.item = r; return d; } r -= I_L64;
    if (r < I_L64) { d.W = a.in(I_A2) + (size_t)l * 64 * 512; d.K = 64; d.N = 512; d.WT = (bf16*)(wl + LW_A2); d.ldk = 64; d.item = r; return d; } r -= I_L64;
    d.W = a.in(I_G2) + (size_t)l * 128 * 512; d.K = 128; d.N = 512; d.WT = (bf16*)(wl + LW_G2); d.ldk = 128; d.item = r; return d;
}
__device__ __forceinline__ void p0_load(const TDesc& d, int lane, f32x4 (&v)[16], float (&g)[16]) {
    if (d.item < 0) return;
    const int nblk = d.N / 64, kb = d.item / nblk, nb = d.item - kb * nblk, k0 = 64 * kb, n0 = 64 * nb, lr = lane >> 4, lc = (lane & 15) * 4;
#pragma unroll
    for (int i = 0; i < 16; ++i) { const int kk = 4 * i + lr; g[i] = d.gain ? d.gain[k0 + kk] : 1.0f; v[i] = __builtin_nontemporal_load((const f32x4*)(d.W + (size_t)(k0 + kk) * d.N + n0 + lc)); }
}
__device__ __forceinline__ void p0_finish(const TDesc& d, LAS float* scr, int lane, const f32x4 (&v)[16], const float (&g)[16]) {
    if (d.item < 0) return;
    const int nblk = d.N / 64, kb = d.item / nblk, nb = d.item - kb * nblk, k0 = 64 * kb, n0 = 64 * nb, lr = lane >> 4, lc = (lane & 15) * 4;
#pragma unroll
    for (int i = 0; i < 16; ++i) { const int kk = 4 * i + lr; LAS float* p = scr + kk * 65 + lc; p[0] = v[i].x * g[i]; p[1] = v[i].y * g[i]; p[2] = v[i].z * g[i]; p[3] = v[i].w * g[i]; }
    LDS_WAIT(); asm volatile("" ::: "memory");
    const int c = lane & 7;
#pragma unroll
    for (int j = 0; j < 8; ++j) { const int n = (lane >> 3) + 8 * j; const LAS float* s = scr + (8 * c) * 65 + n;
        v4u o; o.x = pk2(s[0 * 65], s[1 * 65]); o.y = pk2(s[2 * 65], s[3 * 65]); o.z = pk2(s[4 * 65], s[5 * 65]); o.w = pk2(s[6 * 65], s[7 * 65]);
        if (d.ldk > 0) *(v4u*)(d.WT + (size_t)(d.row_off + n0 + n) * d.ldk + k0 + 8 * c) = o;
        else *(v4u*)(d.WT + ((size_t)kb * (size_t)(-d.ldk) + d.row_off + n0 + n) * 64 + 8 * c) = o; }
    LDS_WAIT(); asm volatile("" ::: "memory");
}
__device__ __forceinline__ void p0_prologue(const Ctx& C, const Ax& a) {
    LAS float* scr = (LAS float*)(C.lds + C.wave * 16640);
    const int gw = C.bid * NWAVES + C.wave, NGW = C.G * NWAVES;
    constexpr int I_IN = 32 * 100, I_SQ = 32 * 32, I_UP = 32 * 128, I_DN = 128 * 32, I_L64 = 8, I_L128 = 16;
    constexpr int PER_LAYER = I_IN + 5 * I_SQ + I_UP + I_DN + 2 * I_L64 + I_L128;
    TDesc cur = p0_desc(a, gw, C.G), nxt; f32x4 va[16], vb[16]; float ga[16], gb[16];
    const int NITEMS = DEPTH * PER_LAYER;
    if (gw < NITEMS) p0_load(cur, C.lane, va, ga);
    for (int it = gw; it < NITEMS; it += 2 * NGW) {
        const int it1 = it + NGW, it2 = it + 2 * NGW;
        if (it1 < NITEMS) { nxt = p0_desc(a, it1, C.G); p0_load(nxt, C.lane, vb, gb); }
        p0_finish(cur, scr, C.lane, va, ga);
        if (it1 < NITEMS) { if (it2 < NITEMS) { cur = p0_desc(a, it2, C.G); p0_load(cur, C.lane, va, ga); }
            p0_finish(nxt, scr, C.lane, vb, gb); }
    }
    { float* cs = (float*)(a.ws + WS_ROPE); const int gt = C.bid * (NWAVES * 64) + C.tid, NT = C.G * NWAVES * 64;
      for (int idx = gt; idx < 2049 * 64; idx += NT) { const int p = idx >> 6, i = idx & 63; const double pos = (p == 2048) ? 16384.0 : (double)p;
          const double inv = exp(-(double)i * (9.210340371976184 / 64.0)); double r = pos * inv; r -= 6.283185307179586 * rint(r * 0.15915494309189535);
          cs[2 * idx] = (float)cos(r); cs[2 * idx + 1] = (float)sin(r); } }
    float* XF = (float*)(a.ws + WS_XF); bf16* HN = (bf16*)(a.ws + WS_HN); bf16* MN = (bf16*)(a.ws + WS_MN);
    for (int m = gw; m < MT; m += NGW) { const float* src = (m < MP) ? a.in(I_XP) + (size_t)m * DM : a.in(I_XS) + (size_t)(m - MP) * DM; rms_row(src, HN + (size_t)m * DM, nullptr, C.lane); }
    for (int m = gw; m < MMEM; m += NGW) rms_row(a.in(I_MEM) + (size_t)m * DM, MN + (size_t)m * DM, nullptr, C.lane);
}

__device__ __forceinline__ TDesc lc_desc(const Ax& a, int l, int it) {
    constexpr int I_UP = 32 * 128, I_DN = 128 * 32, I_SQ = 32 * 32;
    unsigned char* wl = a.ws + WS_WL + (size_t)l * LW_STRIDE; TDesc d; d.row_off = 0; d.gain = nullptr;
    if (it < I_UP) { d.W = a.in(I_WUP) + (size_t)l * DM * DFF; d.K = DM; d.N = DFF; d.WT = (bf16*)(wl + LW_UP); d.ldk = -DFF; d.gain = a.in(I_GMLP) + l * DM; d.item = it; return d; }
    int r = it - I_UP;
    if (r < I_DN) { d.W = a.in(I_WDN) + (size_t)l * DFF * DM; d.K = DFF; d.N = DM; d.WT = (bf16*)(wl + LW_DN); d.ldk = -DM; d.item = r; return d; } r -= I_DN;
    d.K = DM; d.N = DM; d.item = r & (I_SQ - 1); const int q = r >> 10;
    if (l == 0) { const int l1 = 1; d.W = a.in(q == 0 ? I_WK : I_WV) + (size_t)l1 * DM * DM; d.WT = (bf16*)(a.ws + WS_WKV); d.ldk = -8192; d.row_off = l1 * 4096 + q * 2048; d.gain = a.in(I_GMEM) + l1 * DM; return d; }
    d.ldk = -DM;
    if (q == 0) { d.W = a.in(I_WOUT) + (size_t)l * DM * DM; d.WT = (bf16*)(wl + LW_OUT); }
    else if (q == 1) { d.W = a.in(I_WQ) + (size_t)l * DM * DM; d.WT = (bf16*)(wl + LW_Q); d.gain = a.in(I_GXA) + l * DM; }
    else { d.W = a.in(I_WO) + (size_t)l * DM * DM; d.WT = (bf16*)(wl + LW_O); }
    return d;
}
__device__ __forceinline__ void late_convert(const Ctx& C, const Ax& a, int l, int rank, int nrank) {
    LAS float* scr = (LAS float*)(C.lds + C.wave * 16640);
    const int NITEMS = 32 * 128 + 128 * 32 + (LATE_EXTRA ? (l == 0 ? 2 : 3) * 1024 : 0);
    const int gw = rank * NWAVES + C.wave, NGW = nrank * NWAVES;
    TDesc cur, nxt; f32x4 va[16], vb[16]; float ga[16], gb[16];
    if (gw < NITEMS) { cur = lc_desc(a, l, gw); p0_load(cur, C.lane, va, ga); }
    for (int it = gw; it < NITEMS; it += 2 * NGW) {
        const int it1 = it + NGW, it2 = it + 2 * NGW;
        if (it1 < NITEMS) { nxt = lc_desc(a, l, it1); p0_load(nxt, C.lane, vb, gb); }
        p0_finish(cur, scr, C.lane, va, ga);
        if (it1 < NITEMS) { if (it2 < NITEMS) { cur = lc_desc(a, l, it2); p0_load(cur, C.lane, va, ga); }
            p0_finish(nxt, scr, C.lane, vb, gb); }
    }
}
__device__ __forceinline__ void ad_prompt_item(const Ctx& C, const Ax& a, int l, int item) {
    const bf16* P = (const bf16*)(a.ws + WS_P); bf16* YC = (bf16*)(a.ws + WS_YC);
    const int b = item >> 6, t0 = (item & 63) * 32; const size_t rbase = (size_t)b * SEQ;
    LAS float* UD = (LAS float*)C.lds;
    { v4u r1[8], r2[8];
#pragma unroll
      for (int u = 0; u < 8; ++u) { const int it = C.tid + u * (NWAVES * 64), r = it >> 6, cc = it & 63, t = t0 - 30 + r; r1[u] = (v4u){0u, 0u, 0u, 0u}; r2[u] = r1[u];
        if (it < 62 * 64 && t >= 0) { const bf16* pr = P + (rbase + t) * PIN + PD_ + cc * 8; r1[u] = *(const v4u*)pr; r2[u] = *(const v4u*)(pr + 512); } }
      __builtin_amdgcn_sched_barrier(0);
#pragma unroll
      for (int u = 0; u < 8; ++u) { const int it = C.tid + u * (NWAVES * 64), r = it >> 6, cc = it & 63;
        if (it < 62 * 64) { float d1[8], d2[8], uu[8]; unpack8(r1[u], d1); unpack8(r2[u], d2);
#pragma unroll
            for (int j = 0; j < 8; ++j) uu[j] = d1[j] * sigm(d2[j]);
            *(LAS f32x4*)(UD + r * 512 + cc * 8) = (f32x4){uu[0], uu[1], uu[2], uu[3]}; *(LAS f32x4*)(UD + r * 512 + cc * 8 + 4) = (f32x4){uu[4], uu[5], uu[6], uu[7]}; } } }
    __builtin_amdgcn_sched_barrier(0);
    { const int cc = C.tid & 63; const float* cw = a.in(I_CAW) + (size_t)l * 3 * 512 + cc * 8;
      const f32x4 w0a = *(const f32x4*)cw, w0b = *(const f32x4*)(cw + 4), w1a = *(const f32x4*)(cw + 512), w1b = *(const f32x4*)(cw + 516), w2a = *(const f32x4*)(cw + 1024), w2b = *(const f32x4*)(cw + 1028);
      const float k0[8] = {w0a.x, w0a.y, w0a.z, w0a.w, w0b.x, w0b.y, w0b.z, w0b.w}, k1[8] = {w1a.x, w1a.y, w1a.z, w1a.w, w1b.x, w1b.y, w1b.z, w1b.w}, k2[8] = {w2a.x, w2a.y, w2a.z, w2a.w, w2b.x, w2b.y, w2b.z, w2b.w};
#pragma unroll
      for (int hb = 0; hb < 2; ++hb) { v4u q[2][7];
#pragma unroll
        for (int u = 0; u < 2; ++u) { const int r = (C.tid >> 6) + (hb * 2 + u) * NWAVES, t = t0 + r; const bf16* pr = P + (rbase + t) * PIN + cc * 8;
#pragma unroll
            for (int z = 0; z < 7; ++z) q[u][z] = (v4u){0u, 0u, 0u, 0u};
            q[u][0] = *(const v4u*)pr; q[u][1] = *(const v4u*)(pr + 512); q[u][2] = *(const v4u*)(pr + 1024);
            if (t >= 1) { q[u][3] = *(const v4u*)(pr - PIN + 512); q[u][4] = *(const v4u*)(pr - PIN + 1024); }
            if (t >= 2) { q[u][5] = *(const v4u*)(pr - 2 * PIN + 512); q[u][6] = *(const v4u*)(pr - 2 * PIN + 1024); } }
        __builtin_amdgcn_sched_barrier(0);
#pragma unroll
        for (int u = 0; u < 2; ++u) { const int r = (C.tid >> 6) + (hb * 2 + u) * NWAVES, t = t0 + r;
            float ab[8], u0[8], u1[8], u2[8], x[8], y[8];
            unpack8(q[u][0], ab); unpack8(q[u][1], x); unpack8(q[u][2], y);
#pragma unroll
            for (int j = 0; j < 8; ++j) u2[j] = x[j] * y[j];
            unpack8(q[u][3], x); unpack8(q[u][4], y);
#pragma unroll
            for (int j = 0; j < 8; ++j) u1[j] = x[j] * y[j];
            unpack8(q[u][5], x); unpack8(q[u][6], y);
#pragma unroll
            for (int j = 0; j < 8; ++j) u0[j] = x[j] * y[j];
            float o[8];
#pragma unroll
            for (int j = 0; j < 8; ++j) o[j] = ab[j] * (k0[j] * u0[j] + k1[j] * u1[j] + k2[j] * u2[j]);
            *(v4u*)(YC + (rbase + t) * DM + cc * 8) = pack8(o);
            if (t >= SEQ - 2) { float* st = a.out + O_CAP + (((size_t)l * NB + b) * 2 + (t - (SEQ - 2))) * 512 + cc * 8; *(f32x4*)st = (f32x4){u2[0], u2[1], u2[2], u2[3]}; *(f32x4*)(st + 4) = (f32x4){u2[4], u2[5], u2[6], u2[7]}; } }
        __builtin_amdgcn_sched_barrier(0); } }
    __syncthreads();
    const int c = C.tid;
    if (t0 == SEQ - 32) { float* st = a.out + O_CDP + ((size_t)l * NB + b) * 30 * 512 + c;
        for (int j = 0; j < 30; ++j) st[(size_t)j * 512] = UD[(32 + j) * 512 + c]; }
    float cv[32];
    { const char* cwb = (const char*)(a.in(I_CDW) + (size_t)l * 31 * 512); const unsigned cof = (unsigned)c * 4u; const float bias = a.in(I_CDB)[l * 512 + c];
      float wt[31];
#pragma unroll
      for (int j = 0; j < 31; ++j) wt[j] = *(const float*)(cwb + (cof + (unsigned)j * 2048u));
      __builtin_amdgcn_sched_barrier(0);
#pragma unroll
      for (int t = 0; t < 32; ++t) cv[t] = bias;
#pragma unroll
      for (int r = 0; r < 62; ++r) { const float ur = UD[r * 512 + c];
#pragma unroll
          for (int t = 0; t < 32; ++t) { const int j = r - t; if (j >= 0 && j < 31) cv[t] += wt[j] * ur; } } }
    __syncthreads();
#pragma unroll
    for (int t = 0; t < 32; ++t) UD[t * 512 + c] = cv[t];
    __syncthreads();
    { const float* lg = a.in(I_LNDG) + l * 512 + C.lane * 8; const float* lb = a.in(I_LNDB) + l * 512 + C.lane * 8;
      const f32x4 g0 = *(const f32x4*)lg, g1 = *(const f32x4*)(lg + 4), b0 = *(const f32x4*)lb, b1 = *(const f32x4*)(lb + 4);
#pragma unroll
      for (int q = 0; q < 4; ++q) { const int t = C.wave * 4 + q; const f32x4 x0 = *(LAS f32x4*)(UD + t * 512 + C.lane * 8), x1 = *(LAS f32x4*)(UD + t * 512 + C.lane * 8 + 4);
        const float mu = wave_sum((x0.x + x0.y) + (x0.z + x0.w) + (x1.x + x1.y) + (x1.z + x1.w)) * (1.0f / 512.0f);
        const f32x4 d0 = x0 - mu, d1 = x1 - mu;
        const float var = wave_sum((d0.x * d0.x + d0.y * d0.y) + (d0.z * d0.z + d0.w * d0.w) + (d1.x * d1.x + d1.y * d1.y) + (d1.z * d1.z + d1.w * d1.w)) * (1.0f / 512.0f);
        const float rstd = 1.0f / sqrtf(var + 1e-6f);
        const f32x4 y0 = d0 * rstd * g0 + b0, y1 = d1 * rstd * g1 + b1; float o[8];
        o[0] = y0.x * sigm(y0.x); o[1] = y0.y * sigm(y0.y); o[2] = y0.z * sigm(y0.z); o[3] = y0.w * sigm(y0.w);
        o[4] = y1.x * sigm(y1.x); o[5] = y1.y * sigm(y1.y); o[6] = y1.z * sigm(y1.z); o[7] = y1.w * sigm(y1.w);
        *(v4u*)(YC + (rbase + t0 + t) * DM + 1536 + C.lane * 8) = pack8(o); } }
    __syncthreads();
}
__device__ __forceinline__ void ad_sample_item(const Ctx& C, const Ax& a, int l, int n) {
    const bf16* P = (const bf16*)(a.ws + WS_P); bf16* YC = (bf16*)(a.ws + WS_YC);
    const int c = C.tid; const bf16* pr = P + (size_t)(MP + n) * PIN;
    LAS float* red = (LAS float*)C.lds;
    { const float* st = a.in(I_SCA) + (((size_t)l * NS + n) * 2) * 512 + c; const float s0 = st[0], s1 = st[512];
      const float ua = bf1(pr[512 + c]) * bf1(pr[1024 + c]); const float* cw = a.in(I_CAW) + (size_t)l * 3 * 512 + c;
      const float y = bf1(pr[c]) * (cw[0] * s0 + cw[512] * s1 + cw[1024] * ua);
      YC[(size_t)(MP + n) * DM + c] = (bf16)(pk2(y, 0.f) & 0xffffu);
      float* o = a.out + O_CAS + (((size_t)l * NS + n) * 2) * 512 + c; o[0] = s1; o[512] = ua; }
    const float* st = a.in(I_SCD) + (((size_t)l * NS + n) * 30) * 512 + c; const float* cw = a.in(I_CDW) + (size_t)l * 31 * 512 + c;
    const float ud = bf1(pr[PD_ + c]) * sigm(bf1(pr[PD_ + 512 + c]));
    float cv = a.in(I_CDB)[l * 512 + c] + cw[30 * 512] * ud;
    float* os = a.out + O_CDS + (((size_t)l * NS + n) * 30) * 512 + c;
#pragma unroll 6
    for (int j = 0; j < 30; ++j) { const float s = st[(size_t)j * 512]; cv += cw[(size_t)j * 512] * s; if (j > 0) os[(size_t)(j - 1) * 512] = s; }
    os[29 * 512] = ud;
    float s = wave_sum(cv); if (C.lane == 0) red[C.wave] = s; __syncthreads();
    float mu = 0.f;
#pragma unroll
    for (int w = 0; w < 8; ++w) mu += red[w];
    mu *= (1.0f / 512.0f); const float d = cv - mu;
    s = wave_sum(d * d); if (C.lane == 0) red[8 + C.wave] = s; __syncthreads();
    float var = 0.f;
#pragma unroll
    for (int w = 0; w < 8; ++w) var += red[8 + w];
    const float rstd = 1.0f / sqrtf(var * (1.0f / 512.0f) + 1e-6f);
    const float y = d * rstd * a.in(I_LNDG)[l * 512 + c] + a.in(I_LNDB)[l * 512 + c];
    YC[(size_t)(MP + n) * DM + 1536 + c] = (bf16)(pk2(y * sigm(y), 0.f) & 0xffffu);
    __syncthreads();
}

__device__ __forceinline__ void shift8(const bf16* cur, const bf16* prevb, const float* prevf, const float* mu, float (&xs)[8]) {
    float pc[8], pv[8]; unpack8(*(const v4u*)cur, pc);
    if (prevb) unpack8(*(const v4u*)prevb, pv);
    else if (prevf) { const f32x4 p0 = *(const f32x4*)prevf, p1 = *(const f32x4*)(prevf + 4); pv[0] = p0.x; pv[1] = p0.y; pv[2] = p0.z; pv[3] = p0.w; pv[4] = p1.x; pv[5] = p1.y; pv[6] = p1.z; pv[7] = p1.w; }
    else {
#pragma unroll
        for (int j = 0; j < 8; ++j) pv[j] = 0.f; }
    const f32x4 m0 = *(const f32x4*)mu, m1 = *(const f32x4*)(mu + 4); const float m[8] = {m0.x, m0.y, m0.z, m0.w, m1.x, m1.y, m1.z, m1.w};
#pragma unroll
    for (int j = 0; j < 8; ++j) xs[j] = pc[j] + (pv[j] - pc[j]) * m[j];
}
__device__ __forceinline__ void shift4(const bf16* cur, const bf16* prevb, const float* prevf, const float* mu, float (&xs)[4]) {
    float pc[4], pv[4]; unpack4(*(const v2u*)cur, pc);
    if (prevb) unpack4(*(const v2u*)prevb, pv);
    else if (prevf) { const f32x4 p0 = *(const f32x4*)prevf; pv[0] = p0.x; pv[1] = p0.y; pv[2] = p0.z; pv[3] = p0.w; }
    else { pv[0] = pv[1] = pv[2] = pv[3] = 0.f; }
    const f32x4 m0 = *(const f32x4*)mu;
    xs[0] = pc[0] + (pv[0] - pc[0]) * m0.x; xs[1] = pc[1] + (pv[1] - pc[1]) * m0.y; xs[2] = pc[2] + (pv[2] - pc[2]) * m0.z; xs[3] = pc[3] + (pv[3] - pc[3]) * m0.w;
}
constexpr int PTS = 1544;
__device__ __forceinline__ void shift4_lds(const LAS bf16* cur, const float* mu, float (&xs)[4]) {
    float pc[4], pv[4]; unpack4(*(const LAS v2u*)cur, pc); unpack4(*(const LAS v2u*)(cur - PTS), pv);
    const f32x4 m0 = *(const f32x4*)mu;
    xs[0] = pc[0] + (pv[0] - pc[0]) * m0.x; xs[1] = pc[1] + (pv[1] - pc[1]) * m0.y; xs[2] = pc[2] + (pv[2] - pc[2]) * m0.z; xs[3] = pc[3] + (pv[3] - pc[3]) * m0.w;
}
constexpr int RWB = 896, RW_KK = 256, RW_KB = 384, RW_K = 512, RW_R = 640, RW_V = 768;
__device__ __forceinline__ void rw_st4(unsigned char* rec, int off, int cl, const f32x4 v) { v2u w; w.x = pk2(v[0], v[1]); w.y = pk2(v[2], v[3]); *(v2u*)(rec + off + cl * 2) = w; }
__device__ __forceinline__ f32x4 rw_ld4(const unsigned char* rec, int off, int cl) { float f[4]; unpack4(*(const v2u*)(rec + off + cl * 2), f); return (f32x4){f[0], f[1], f[2], f[3]}; }
#ifndef DUP_SUB
#define DUP_SUB 0u
#endif
#define PREP_REP(k) for (int prep_rep_ = 0; prep_rep_ < 1 + (int)((DUP_SUB >> (k)) & 1u); ++prep_rep_)
__device__ __forceinline__ void rwkv_prep_item(const Ctx& C, const Ax& a, int l, int item, int t2sel = -1) {
    const bf16* P = (const bf16*)(a.ws + WS_P); float* RW = (float*)(a.ws + WS_RW); float* GATE = (float*)(a.ws + WS_GATE);
    const bool smp = item >= 256; const int row0 = smp ? MP + (item - 256) * 32 : (item >> 6) * SEQ + (item & 63) * 32; const int t0 = smp ? 0 : (item & 63) * 32;
    const float* mu = a.in(I_MU) + (size_t)l * SHW; const float* sst = a.in(I_SSH) + (size_t)l * NS * SHW;
    LAS bf16* AW = (LAS bf16*)C.lds; LAS bf16* AA = AW + 32 * 72; LAS bf16* AG = AA + 32 * 72; LAS bf16* PT = AG + 32 * 136;
    for (int it = C.tid; it < 32 * 32; it += NWAVES * 64) { const int r = it >> 5, cc = it & 31, col = 1536 + cc * 8, row = row0 + r; const bf16* cur = P + (size_t)row * PIN + PC_ + col;
        float xs[8];
        if (smp) shift8(cur, nullptr, sst + (size_t)(row - MP) * SHW + col, mu + col, xs);
        else shift8(cur, (t0 + r > 0) ? cur - PIN : nullptr, nullptr, mu + col, xs);
        if (cc < 8) {
#pragma unroll
            for (int j = 0; j < 8; ++j) xs[j] = tanhf(xs[j]);
            *(LAS v4u*)(AW + r * 72 + cc * 8) = pack8(xs); }
        else if (cc < 16) *(LAS v4u*)(AA + r * 72 + (cc - 8) * 8) = pack8(xs);
        else {
#pragma unroll
            for (int j = 0; j < 8; ++j) xs[j] = sigm(xs[j]);
            *(LAS v4u*)(AG + r * 136 + (cc - 16) * 8) = pack8(xs); } }
    if (!smp) { for (int it = C.tid; it < 33 * 192; it += NWAVES * 64) { const int r = it / 192, cc = it - r * 192; v4u v = (v4u){0u, 0u, 0u, 0u};
            if (t0 + r > 0) v = *(const v4u*)(P + (size_t)(row0 + r - 1) * PIN + PC_ + cc * 8);
            *(LAS v4u*)(PT + r * PTS + cc * 8) = v; } }
    else { const int rb = row0 + 16 * t2sel;
        for (int it = C.tid; it < 16 * 192; it += NWAVES * 64) { const int q = it / 192, cc = it - q * 192;
            const v4u v = *(const v4u*)(P + (size_t)(rb + q) * PIN + PC_ + cc * 8); const float* sp = sst + (size_t)(rb + q - MP) * SHW + cc * 8; const f32x4 s0 = *(const f32x4*)sp, s1 = *(const f32x4*)(sp + 4);
            const float sf[8] = {s0.x, s0.y, s0.z, s0.w, s1.x, s1.y, s1.z, s1.w};
            *(LAS v4u*)(PT + (2 * q + 1) * PTS + cc * 8) = v; *(LAS v4u*)(PT + (2 * q) * PTS + cc * 8) = pack8(sf); } }
    if (smp) { float* o = a.out + O_SHS + ((size_t)l * NS + (row0 - MP)) * SHW;
        for (int it = C.tid + (t2sel > 0 ? 16 * 224 : 0); it < (t2sel == 0 ? 16 : 32) * 224; it += NWAVES * 64) { const int r = it / 224, cc = it % 224; float f[8]; unpack8(*(const v4u*)(P + (size_t)(row0 + r) * PIN + PC_ + cc * 8), f);
            float* op = o + (size_t)r * SHW + cc * 8; *(f32x4*)op = (f32x4){f[0], f[1], f[2], f[3]}; *(f32x4*)(op + 4) = (f32x4){f[4], f[5], f[6], f[7]}; } }
    else if (t0 == SEQ - 32) { float* o = a.out + O_SHP + ((size_t)l * NB + (item >> 6)) * SHW;
        for (int cc = C.tid; cc < 224; cc += NWAVES * 64) { float f[8]; unpack8(*(const v4u*)(P + (size_t)(row0 + 31) * PIN + PC_ + cc * 8), f);
            *(f32x4*)(o + cc * 8) = (f32x4){f[0], f[1], f[2], f[3]}; *(f32x4*)(o + cc * 8 + 4) = (f32x4){f[4], f[5], f[6], f[7]}; } }
    __syncthreads();
    const int h = C.wave, fr = C.lane & 15, fq = C.lane >> 4;
    const unsigned char* wl = a.ws + WS_WL + (size_t)l * LW_STRIDE;
    const bf16* W2t = (const bf16*)(wl + LW_W2); const bf16* A2t = (const bf16*)(wl + LW_A2); const bf16* G2t = (const bf16*)(wl + LW_G2);
    PREP_REP(23) { constexpr int tp = 0;
        f32x4 acc[4][2];
#pragma unroll
        for (int ct = 0; ct < 4; ++ct)
#pragma unroll
            for (int t2 = 0; t2 < 2; ++t2) acc[ct][t2] = zero4();
#pragma unroll
        for (int ks = 0; ks < 2; ++ks) { bf16x8 af[2], wf[4];
#pragma unroll
            for (int t2 = 0; t2 < 2; ++t2) af[t2] = *(const LAS bf16x8*)(AA + (tp * 32 + t2 * 16 + fr) * 72 + ks * 32 + fq * 8);
#pragma unroll
            for (int ct = 0; ct < 4; ++ct) wf[ct] = *(const bf16x8*)(A2t + (size_t)(h * 64 + ct * 16 + fr) * 64 + ks * 32 + fq * 8);
#pragma unroll
            for (int ct = 0; ct < 4; ++ct)
#pragma unroll
                for (int t2 = 0; t2 < 2; ++t2) acc[ct][t2] = __builtin_amdgcn_mfma_f32_16x16x32_bf16(wf[ct], af[t2], acc[ct][t2], 0, 0, 0); }
        const float* a0 = a.in(I_A0) + l * 512; const float* kkw = a.in(I_KK) + l * 512; const float* kaw = a.in(I_KA) + l * 512;
#pragma unroll
        for (int t2 = 0; t2 < 2; ++t2) { if (t2sel >= 0 && t2 != t2sel) continue; const int r = tp * 32 + t2 * 16 + fr, row = row0 + r;
            const LAS bf16* ptr_ = PT + (smp ? 2 * fr + 1 : r + 1) * PTS;
            float kkr[4][4], av[4][4], kc[4][4]; float ss = 0.f;
#pragma unroll
            for (int ct = 0; ct < 4; ++ct) { const int ch = h * 64 + ct * 16 + fq * 4; const f32x4 a0v = *(const f32x4*)(a0 + ch), kkv = *(const f32x4*)(kkw + ch);
                float xs[4]; shift4_lds(ptr_ + 512 + ch, mu + 512 + ch, xs);
#pragma unroll
                for (int j = 0; j < 4; ++j) { av[ct][j] = sigm(a0v[j] + acc[ct][t2][j]); kc[ct][j] = xs[j]; kkr[ct][j] = xs[j] * kkv[j]; ss += kkr[ct][j] * kkr[ct][j]; } }
            ss += __shfl_xor(ss, 16); ss += __shfl_xor(ss, 32);
            const float inv = 1.0f / fmaxf(sqrtf(ss), 1e-12f);
            unsigned char* rw = (unsigned char*)RW + ((size_t)row * 8 + h) * RWB;
#pragma unroll
            for (int ct = 0; ct < 4; ++ct) { const int ch = h * 64 + ct * 16 + fq * 4, cl = ct * 16 + fq * 4; const f32x4 kav = *(const f32x4*)(kaw + ch);
                f32x4 kk, kb, k4;
#pragma unroll
                for (int j = 0; j < 4; ++j) { kk[j] = kkr[ct][j] * inv; kb[j] = kk[j] * av[ct][j]; k4[j] = kc[ct][j] * (1.0f + (av[ct][j] - 1.0f) * kav[j]); }
                rw_st4(rw, RW_KK, cl, kk); rw_st4(rw, RW_KB, cl, kb); rw_st4(rw, RW_K, cl, k4);
                float xr[4], xv[4];
                shift4_lds(ptr_ + ch, mu + ch, xr); shift4_lds(ptr_ + 1024 + ch, mu + 1024 + ch, xv);
                rw_st4(rw, RW_R, cl, (f32x4){xr[0], xr[1], xr[2], xr[3]}); rw_st4(rw, RW_V, cl, (f32x4){xv[0], xv[1], xv[2], xv[3]}); } }
    }
    PREP_REP(24) { constexpr int tp = 0;
        f32x4 acc[4][2];
#pragma unroll
        for (int ct = 0; ct < 4; ++ct)
#pragma unroll
            for (int t2 = 0; t2 < 2; ++t2) acc[ct][t2] = zero4();
#pragma unroll
        for (int ks = 0; ks < 2; ++ks) { bf16x8 af[2], wf[4];
#pragma unroll
            for (int t2 = 0; t2 < 2; ++t2) af[t2] = *(const LAS bf16x8*)(AW + (tp * 32 + t2 * 16 + fr) * 72 + ks * 32 + fq * 8);
#pragma unroll
            for (int ct = 0; ct < 4; ++ct) wf[ct] = *(const bf16x8*)(W2t + (size_t)(h * 64 + ct * 16 + fr) * 64 + ks * 32 + fq * 8);
#pragma unroll
            for (int ct = 0; ct < 4; ++ct)
#pragma unroll
                for (int t2 = 0; t2 < 2; ++t2) acc[ct][t2] = __builtin_amdgcn_mfma_f32_16x16x32_bf16(wf[ct], af[t2], acc[ct][t2], 0, 0, 0); }
        const float* w0 = a.in(I_W0) + l * 512;
#pragma unroll
        for (int t2 = 0; t2 < 2; ++t2) { if (t2sel >= 0 && t2 != t2sel) continue; const int row = row0 + tp * 32 + t2 * 16 + fr; float* rw = (float*)((unsigned char*)RW + ((size_t)row * 8 + h) * RWB);
#pragma unroll
            for (int ct = 0; ct < 4; ++ct) { const int ch = h * 64 + ct * 16 + fq * 4, cl = ct * 16 + fq * 4; const f32x4 w0v = *(const f32x4*)(w0 + ch); f32x4 d;
#pragma unroll
                for (int j = 0; j < 4; ++j) { const float z = -(w0v[j] + acc[ct][t2][j]); const float sp = fmaxf(z, 0.f) + __logf(1.0f + __expf(-fabsf(z))); const float w = -sp - 0.5f; d[j] = -__expf(w); }
                *(f32x4*)(rw + cl) = d; } }
    }
    PREP_REP(25) { constexpr int tp = 0;
        f32x4 acc[4][2];
#pragma unroll
        for (int ct = 0; ct < 4; ++ct)
#pragma unroll
            for (int t2 = 0; t2 < 2; ++t2) acc[ct][t2] = zero4();
#pragma unroll
        for (int ks = 0; ks < 4; ++ks) { bf16x8 af[2], wf[4];
#pragma unroll
            for (int t2 = 0; t2 < 2; ++t2) af[t2] = *(const LAS bf16x8*)(AG + (tp * 32 + t2 * 16 + fr) * 136 + ks * 32 + fq * 8);
#pragma unroll
            for (int ct = 0; ct < 4; ++ct) wf[ct] = *(const bf16x8*)(G2t + (size_t)(h * 64 + ct * 16 + fr) * 128 + ks * 32 + fq * 8);
#pragma unroll
            for (int ct = 0; ct < 4; ++ct)
#pragma unroll
                for (int t2 = 0; t2 < 2; ++t2) acc[ct][t2] = __builtin_amdgcn_mfma_f32_16x16x32_bf16(wf[ct], af[t2], acc[ct][t2], 0, 0, 0); }
#pragma unroll
        for (int t2 = 0; t2 < 2; ++t2) { if (t2sel >= 0 && t2 != t2sel) continue; const int row = row0 + tp * 32 + t2 * 16 + fr;
#pragma unroll
            for (int ct = 0; ct < 4; ++ct) *(f32x4*)(GATE + (size_t)row * 512 + h * 64 + ct * 16 + fq * 4) = acc[ct][t2]; }
    }
    __syncthreads();
}

#define PACK8(arr, o) ((v4u){pk2((arr)[(o)], (arr)[(o) + 1]), pk2((arr)[(o) + 2], (arr)[(o) + 3]), pk2((arr)[(o) + 4], (arr)[(o) + 5]), pk2((arr)[(o) + 6], (arr)[(o) + 7])})
constexpr int WK_LDS = 18432, WK_SHR = 6912, WK_PRV = 3072;
__device__ __forceinline__ f32x4 mfma16(bf16x4 a, bf16x4 b, f32x4 c) { return __builtin_amdgcn_mfma_f32_16x16x16bf16_1k(a, b, c, 0, 0, 0); }
__device__ __forceinline__ bf16 bfr1(float x) { return (bf16)(pk2(x, 0.f) & 0xffffu); }
__device__ __forceinline__ void wkv_chunk_witem(const Ctx& C, const Ax& a, int ci) {
    const float* RW = (const float*)(a.ws + WS_RW);
    unsigned char* CK = a.ws + WS_CK + (size_t)ci * WK_SHR; unsigned char* CP = a.ws + WS_CP + (size_t)ci * 4 * WK_PRV;
    const int bh = ci >> 7, c = ci & 127, b = bh >> 3, h = bh & 7, lane = C.lane, fr = lane & 15, fq = lane >> 4;
    LAS unsigned char* Lb = C.lds + C.wave * WK_LDS;
    LAS bf16* TA = (LAS bf16*)Lb; LAS bf16* TB = TA + 16 * 72; LAS bf16* TK = TB + 16 * 72; LAS bf16* TR = TK + 16 * 72; LAS bf16* VT = TR + 16 * 72;
    LAS float* M1 = (LAS float*)(Lb + 12288); LAS float* M2 = M1 + 320; LAS float* N1 = M2 + 320; LAS float* N2 = N1 + 320;
    LAS bf16* TG = TA; LAS bf16* PST = TK;
    const unsigned char* rw = (const unsigned char*)RW + (((size_t)b * SEQ + c * 16) * 8 + h) * RWB;
#define RWF(t) (*(const float*)(rw + (size_t)(t) * (8 * RWB) + lane * 4))
#define RWH(t, off) bf1(*(const bf16*)(rw + (size_t)(t) * (8 * RWB) + (off) + lane * 2))
    float lam[16];
#pragma unroll
    for (int t = 0; t < 16; ++t) lam[t] = RWF(t);
    __builtin_amdgcn_sched_barrier(0);
#pragma unroll
    for (int t = 1; t < 16; ++t) lam[t] += lam[t - 1];
    const float lamT = lam[15];
    ((float*)CK)[lane] = __expf(lamT);
    float Bp[16], Kp[16], al[16], ro[16];
    bf16* ATg = (bf16*)(CK + 256); bf16* OMg = (bf16*)(CK + 256 + 2304);
#define RWR(t, off) (*(const bf16*)(rw + (size_t)(t) * (8 * RWB) + (off) + lane * 2))
    bf16 wkk[4], wbb[4], wkx[4], wrr[4], wvv[4];
#pragma unroll
    for (int t = 0; t < 4; ++t) { wkk[t] = RWR(t, RW_KK); wbb[t] = RWR(t, RW_KB); wkx[t] = RWR(t, RW_K); wrr[t] = RWR(t, RW_R); wvv[t] = RWR(t, RW_V); }
    __builtin_amdgcn_sched_barrier(0);
#pragma unroll
    for (int t = 0; t < 16; ++t) { const float kk = bf1(wkk[t & 3]), bb = bf1(wbb[t & 3]), kx = bf1(wkx[t & 3]), rr = bf1(wrr[t & 3]), vv = bf1(wvv[t & 3]);
        if (t + 4 < 16) { wkk[t & 3] = RWR(t + 4, RW_KK); wbb[t & 3] = RWR(t + 4, RW_KB); wkx[t & 3] = RWR(t + 4, RW_K); wrr[t & 3] = RWR(t + 4, RW_R); wvv[t & 3] = RWR(t + 4, RW_V); }
        const float ein = __expf(-lam[t]), eprev = (t ? __expf(lam[t - 1]) : 1.0f), ecur = __expf(lam[t]), erest = __expf(lamT - lam[t]);
        al[t] = kk * eprev; ro[t] = rr * ecur; Bp[t] = bb * erest; Kp[t] = kx * erest;
        const bf16 ab = bfr1(al[t]);
        TA[t * 72 + lane] = ab; TB[t * 72 + lane] = bfr1(bb * ein); TK[t * 72 + lane] = bfr1(kx * ein); TR[t * 72 + lane] = bfr1(ro[t]); VT[lane * 24 + t] = bfr1(vv);
        ATg[t * 72 + lane] = ab;
        asm volatile("" ::: "memory"); __builtin_amdgcn_sched_barrier(0); }
    LDS_WAIT(); asm volatile("" ::: "memory");
    { f32x4 g1 = zero4(), g2 = zero4(), n1 = zero4(), n2 = zero4();
#pragma unroll
      for (int ks = 0; ks < 2; ++ks) { const int o = fr * 72 + ks * 32 + fq * 8;
        const bf16x8 bf_ = *(const LAS bf16x8*)(TB + o), kf_ = *(const LAS bf16x8*)(TK + o), af_ = *(const LAS bf16x8*)(TA + o), rf_ = *(const LAS bf16x8*)(TR + o);
        g1 = __builtin_amdgcn_mfma_f32_16x16x32_bf16(bf_, af_, g1, 0, 0, 0); g2 = __builtin_amdgcn_mfma_f32_16x16x32_bf16(kf_, af_, g2, 0, 0, 0);
        n1 = __builtin_amdgcn_mfma_f32_16x16x32_bf16(bf_, rf_, n1, 0, 0, 0); n2 = __builtin_amdgcn_mfma_f32_16x16x32_bf16(kf_, rf_, n2, 0, 0, 0); }
#pragma unroll
      for (int r = 0; r < 4; ++r) { const int s_ = 4 * fq + r, o = s_ * 20 + fr;
        M1[o] = (s_ < fr) ? g1[r] : 0.f; M2[o] = (s_ < fr) ? g2[r] : 0.f; N1[o] = (s_ <= fr) ? n1[r] : 0.f; N2[o] = (s_ <= fr) ? n2[r] : 0.f; } }
    LDS_WAIT(); asm volatile("" ::: "memory");
    __builtin_amdgcn_sched_barrier(0);
#pragma unroll
    for (int s_ = 14; s_ >= 0; --s_) { float m[16];
#pragma unroll
        for (int q = 0; q < 4; ++q) { const f32x4 v = *(const LAS f32x4*)(M1 + s_ * 20 + 4 * q); m[4 * q] = v.x; m[4 * q + 1] = v.y; m[4 * q + 2] = v.z; m[4 * q + 3] = v.w; }
        float acc = Bp[s_];
#pragma unroll
        for (int t = s_ + 1; t < 16; ++t) acc -= m[t] * Bp[t];
        asm volatile("" : "+v"(acc) :: "memory"); Bp[s_] = acc; __builtin_amdgcn_sched_barrier(0); }
#pragma unroll
    for (int s_ = 0; s_ < 15; ++s_) { float m[16];
#pragma unroll
        for (int q = 0; q < 4; ++q) { const f32x4 v = *(const LAS f32x4*)(M2 + s_ * 20 + 4 * q); m[4 * q] = v.x; m[4 * q + 1] = v.y; m[4 * q + 2] = v.z; m[4 * q + 3] = v.w; }
        float acc = Kp[s_];
#pragma unroll
        for (int t = s_ + 1; t < 16; ++t) acc -= m[t] * Bp[t];
        asm volatile("" : "+v"(acc) :: "memory"); Kp[s_] = acc; __builtin_amdgcn_sched_barrier(0); }
    __builtin_amdgcn_sched_barrier(0);
    { float ng[16];
#pragma unroll
      for (int t = 0; t < 16; ++t) ng[t] = -Bp[t];
      *(v4u*)(CK + 256 + 4608 + lane * 32) = PACK8(ng, 0); *(v4u*)(CK + 256 + 4608 + lane * 32 + 16) = PACK8(ng, 8); }
    *(LAS v4u*)(TG + lane * 24) = PACK8(Kp, 0); *(LAS v4u*)(TG + lane * 24 + 8) = PACK8(Kp, 8);
    __builtin_amdgcn_sched_barrier(0);
    { float hh[16], ps[16];
#pragma unroll
      for (int s_ = 0; s_ < 16; ++s_) { hh[s_] = N1[s_ * 20 + fr]; ps[s_] = N2[s_ * 20 + fr]; }
#pragma unroll
      for (int s_ = 14; s_ >= 0; --s_) { float m[16];
#pragma unroll
        for (int q = 0; q < 4; ++q) { const f32x4 v = *(const LAS f32x4*)(M1 + s_ * 20 + 4 * q); m[4 * q] = v.x; m[4 * q + 1] = v.y; m[4 * q + 2] = v.z; m[4 * q + 3] = v.w; }
        float acc = hh[s_];
#pragma unroll
        for (int u = s_ + 1; u < 16; ++u) acc -= m[u] * hh[u];
        asm volatile("" : "+v"(acc) :: "memory"); hh[s_] = acc; __builtin_amdgcn_sched_barrier(0); }
#pragma unroll
      for (int s_ = 0; s_ < 15; ++s_) { float m[16];
#pragma unroll
        for (int q = 0; q < 4; ++q) { const f32x4 v = *(const LAS f32x4*)(M2 + s_ * 20 + 4 * q); m[4 * q] = v.x; m[4 * q + 1] = v.y; m[4 * q + 2] = v.z; m[4 * q + 3] = v.w; }
        float acc = ps[s_];
#pragma unroll
        for (int u = s_ + 1; u < 16; ++u) acc -= m[u] * hh[u];
        asm volatile("" : "+v"(acc) :: "memory"); ps[s_] = acc; __builtin_amdgcn_sched_barrier(0); }
      LDS_WAIT(); asm volatile("" ::: "memory");
#pragma unroll
      for (int s_ = 0; s_ < 16; ++s_) N1[s_ * 20 + fr] = hh[s_];
      *(LAS v4u*)(PST + fr * 24) = PACK8(ps, 0); *(LAS v4u*)(PST + fr * 24 + 8) = PACK8(ps, 8); }
    LDS_WAIT(); asm volatile("" ::: "memory");
    __builtin_amdgcn_sched_barrier(0);
#pragma unroll
    for (int s_ = 0; s_ < 16; ++s_) { float m[16];
#pragma unroll
        for (int q = 0; q < 4; ++q) { const f32x4 v = *(const LAS f32x4*)(N1 + s_ * 20 + 4 * q); m[4 * q] = v.x; m[4 * q + 1] = v.y; m[4 * q + 2] = v.z; m[4 * q + 3] = v.w; }
#pragma unroll
        for (int t = s_; t < 16; ++t) ro[t] -= m[t] * al[s_];
        asm volatile("" ::: "memory"); __builtin_amdgcn_sched_barrier(0); }
#pragma unroll
    for (int t = 0; t < 16; ++t) OMg[t * 72 + lane] = bfr1(ro[t]);
    LDS_WAIT(); asm volatile("" ::: "memory");
    __builtin_amdgcn_sched_barrier(0);
    { bf16x4 vf[4];
#pragma unroll
      for (int it = 0; it < 4; ++it) vf[it] = *(const LAS bf16x4*)(VT + (it * 16 + fr) * 24 + fq * 4);
#pragma unroll
      for (int kt = 0; kt < 4; ++kt) { const bf16x4 gf = *(const LAS bf16x4*)(TG + (kt * 16 + fr) * 24 + fq * 4);
#pragma unroll
        for (int it = 0; it < 4; ++it) { const f32x4 d = mfma16(gf, vf[it], zero4()); v2u dw; dw.x = pk2(d[0], d[1]); dw.y = pk2(d[2], d[3]); *(v2u*)(CP + it * WK_PRV + kt * 512 + lane * 8) = dw; } }
      const bf16x4 pf = *(const LAS bf16x4*)(PST + fr * 24 + fq * 4);
#pragma unroll
      for (int it = 0; it < 4; ++it) { const f32x4 o = mfma16(pf, vf[it], zero4()); *(f32x4*)(CP + it * WK_PRV + 2048 + lane * 16) = o; } }
    LDS_WAIT(); asm volatile("" ::: "memory");
}
constexpr int WQ_CH = WK_PRV + WK_SHR, WQ_SLOT = 4 * WQ_CH, WQ_PCS = WQ_CH / 16, WQ_NWL = 4 * WQ_PCS / 64;
__device__ __forceinline__ void wkv_seq_chunk(const LAS unsigned char* sp, f32x4 (&acc)[4], float* orow, int lane, int fr, int fq) {
    const LAS unsigned char* sh = sp + WK_PRV;
    bf16x8 af[2], of[2]; bf16x4 gf[4]; f32x4 wt[4], dt[4];
#pragma unroll
    for (int s = 0; s < 2; ++s) { const LAS bf16* ap = (const LAS bf16*)(sh + 256) + fr * 72 + 32 * s + 4 * fq; const v2u lo = *(const LAS v2u*)ap, hi = *(const LAS v2u*)(ap + 16);
        af[s] = __builtin_bit_cast(bf16x8, (v4u){lo.x, lo.y, hi.x, hi.y});
        const LAS bf16* op = (const LAS bf16*)(sh + 256 + 2304) + fr * 72 + 32 * s + 4 * fq; const v2u lo2 = *(const LAS v2u*)op, hi2 = *(const LAS v2u*)(op + 16);
        of[s] = __builtin_bit_cast(bf16x8, (v4u){lo2.x, lo2.y, hi2.x, hi2.y}); }
#pragma unroll
    for (int kt = 0; kt < 4; ++kt) { gf[kt] = *(const LAS bf16x4*)((const LAS bf16*)(sh + 256 + 4608) + (kt * 16 + fr) * 16 + 4 * fq);
        wt[kt] = *(const LAS f32x4*)(sh + (16 * kt + 4 * fq) * 4); { float f_[4]; unpack4(*(const LAS v2u*)(sp + kt * 512 + lane * 8), f_); dt[kt] = (f32x4){f_[0], f_[1], f_[2], f_[3]}; } }
    const f32x4 ov = *(const LAS f32x4*)(sp + 2048 + lane * 16);
    bf16x8 sbf[2];
#pragma unroll
    for (int s = 0; s < 2; ++s) { v4u w; w.x = pk2(acc[2 * s][0], acc[2 * s][1]); w.y = pk2(acc[2 * s][2], acc[2 * s][3]); w.z = pk2(acc[2 * s + 1][0], acc[2 * s + 1][1]); w.w = pk2(acc[2 * s + 1][2], acc[2 * s + 1][3]);
        sbf[s] = __builtin_bit_cast(bf16x8, w); }
    f32x4 x = zero4();
    x = __builtin_amdgcn_mfma_f32_16x16x32_bf16(af[0], sbf[0], x, 0, 0, 0); x = __builtin_amdgcn_mfma_f32_16x16x32_bf16(af[1], sbf[1], x, 0, 0, 0);
    f32x4 o = __builtin_amdgcn_mfma_f32_16x16x32_bf16(of[0], sbf[0], ov, 0, 0, 0); o = __builtin_amdgcn_mfma_f32_16x16x32_bf16(of[1], sbf[1], o, 0, 0, 0);
    v2u xw; xw.x = pk2(x[0], x[1]); xw.y = pk2(x[2], x[3]); const bf16x4 xb = __builtin_bit_cast(bf16x4, xw);
#pragma unroll
    for (int kt = 0; kt < 4; ++kt) acc[kt] = mfma16(gf[kt], xb, acc[kt] * wt[kt] + dt[kt]);
    orow[0] = o[0]; orow[512] = o[1]; orow[1024] = o[2]; orow[1536] = o[3];
}
__device__ __forceinline__ void wkv_seq_item(const Ctx& C, const Ax& a, int l, int item) {
    const int bh = item >> 2, rg = item & 3, b = bh >> 3, h = bh & 7, lane = C.lane, fr = lane & 15, fq = lane >> 4;
    const unsigned char* CK = a.ws + WS_CK + (size_t)bh * 128 * WK_SHR; const unsigned char* CP = a.ws + WS_CP + ((size_t)bh * 128 * 4 + rg) * WK_PRV;
    float* OC = (float*)(a.ws + WS_OC) + ((size_t)b * SEQ) * 512 + h * 64 + rg * 16 + fr;
#define WQ_COMPUTE(blk) do { const LAS unsigned char* sbp = C.lds + ((blk) % 3) * WQ_SLOT; \
            _Pragma("unroll 2") for (int cq = 0; cq < 4; ++cq) wkv_seq_chunk(sbp + cq * WQ_CH, acc, OC + (size_t)(((blk) * 4 + cq) * 16 + 4 * fq) * 512, lane, fr, fq); } while (0)
    static_assert(4 * WQ_PCS == WQ_NWL * 64 && WQ_NWL > 35 && WQ_NWL <= 42 && 3 * WQ_SLOT <= SCR_BYTES, "ring geometry");
    if (C.wave == 0) {
        f32x4 acc[4];
#pragma unroll
        for (int kt = 0; kt < 4; ++kt) acc[kt] = zero4();
        __builtin_amdgcn_s_barrier(); asm volatile("" ::: "memory");
        for (int blk = 0; blk < 32; ++blk) { WQ_COMPUTE(blk); asm volatile("s_waitcnt lgkmcnt(0)" ::: "memory"); __builtin_amdgcn_s_barrier(); asm volatile("" ::: "memory"); }
        float* so = a.out + O_WKVP + ((((size_t)l * NB + b) * 8 + h) * 64 + rg * 16 + fr) * 64 + 4 * fq;
#pragma unroll
        for (int kt = 0; kt < 4; ++kt) *(f32x4*)(so + 16 * kt) = acc[kt];
    } else {
        const int w1 = C.wave - 1; const bool seven = (w1 + 35) < WQ_NWL;
        const unsigned char* wsb = a.ws; unsigned qoff[6], qstr[6];
#pragma unroll
        for (int i = 0; i < 6; ++i) { const int p = (w1 + 7 * i) * 64 + lane, cq = p / WQ_PCS, q = p - cq * WQ_PCS; const bool pr = q < WK_PRV / 16;
            qoff[i] = pr ? (unsigned)(WS_CP + ((size_t)bh * 128 * 4 + rg) * WK_PRV) + (unsigned)(cq * 4 * WK_PRV + q * 16) : (unsigned)(WS_CK + (size_t)bh * 128 * WK_SHR) + (unsigned)(cq * WK_SHR + (q - WK_PRV / 16) * 16);
            qstr[i] = pr ? (unsigned)(16 * WK_PRV) : (unsigned)(4 * WK_SHR); }
#define WQ_DMA(blk) do { _Pragma("unroll") for (int i = 0; i < 6; ++i) if (i < 5 || seven) \
            __builtin_amdgcn_global_load_lds((const unsigned*)(wsb + (qoff[i] + (unsigned)(blk) * qstr[i])), (LAS unsigned*)(C.lds + ((blk) % 3) * WQ_SLOT + (w1 + 7 * i) * 1024), 16, 0, 0); } while (0)
#define WQ_WAIT_OLDER() do { if (seven) asm volatile("s_waitcnt vmcnt(6)" ::: "memory"); else asm volatile("s_waitcnt vmcnt(5)" ::: "memory"); } while (0)
        WQ_DMA(0); WQ_DMA(1); WQ_WAIT_OLDER();
        __builtin_amdgcn_s_barrier(); asm volatile("" ::: "memory");
        for (int blk = 0; blk < 32; ++blk) {
            if (blk + 2 < 32) { WQ_DMA(blk + 2); WQ_WAIT_OLDER(); }
            else asm volatile("s_waitcnt vmcnt(0)" ::: "memory");
            __builtin_amdgcn_s_barrier(); asm volatile("" ::: "memory");
        }
#undef WQ_DMA
#undef WQ_WAIT_OLDER
    }
#undef WQ_COMPUTE
    __syncthreads();
}
__device__ __forceinline__ void rwkv_sample_witem(const Ctx& C, const Ax& a, int l, int witem) {
    const float* RW = (const float*)(a.ws + WS_RW); float* OC = (float*)(a.ws + WS_OC);
    const int n = witem >> 4, h = (witem >> 1) & 7, half = witem & 1, g = C.lane & 15, rq = C.lane >> 4;
    const unsigned char* p = (const unsigned char*)RW + ((size_t)(MP + n) * 8 + h) * RWB;
    const f32x4 lw4 = *(const f32x4*)(p + 16 * g), kk4 = rw_ld4(p, RW_KK, 4 * g), b4 = rw_ld4(p, RW_KB, 4 * g), k4 = rw_ld4(p, RW_K, 4 * g), r4 = rw_ld4(p, RW_R, 4 * g);
    const f32x4 w4 = (f32x4){__expf(lw4.x), __expf(lw4.y), __expf(lw4.z), __expf(lw4.w)};
    const float* sin_ = a.in(I_SWKV) + (((size_t)l * NS + n) * 8 + h) * 4096; float* sout = a.out + O_WKVS + (((size_t)l * NS + n) * 8 + h) * 4096;
#pragma unroll 4
    for (int it = 0; it < 8; ++it) { const int i = half * 32 + it * 4 + rq; const f32x4 S = __builtin_nontemporal_load((const f32x4*)(sin_ + i * 64 + 4 * g)); const float vi = bf1(*(const bf16*)(p + RW_V + i * 2));
        const float sa = -rowsum16((S.x * kk4.x + S.y * kk4.y) + (S.z * kk4.z + S.w * kk4.w));
        f32x4 T; T.x = S.x * w4.x + (sa * b4.x + vi * k4.x); T.y = S.y * w4.y + (sa * b4.y + vi * k4.y); T.z = S.z * w4.z + (sa * b4.z + vi * k4.z); T.w = S.w * w4.w + (sa * b4.w + vi * k4.w);
        const float o = rowsum16((T.x * r4.x + T.y * r4.y) + (T.z * r4.z + T.w * r4.w));
        __builtin_nontemporal_store(T, (f32x4*)(sout + i * 64 + 4 * g));
        if (g == 0) OC[(size_t)(MP + n) * 512 + h * 64 + i] = o; }
}
__device__ __forceinline__ void rwkv_post_phase(const Ctx& C, const Ax& a, int l) {
    const float* RW = (const float*)(a.ws + WS_RW); const float* OC = (const float*)(a.ws + WS_OC); const float* GATE = (const float*)(a.ws + WS_GATE); bf16* YC = (bf16*)(a.ws + WS_YC);
    const int gw = C.bid * NWAVES + C.wave, NGW = C.G * NWAVES, g = C.lane & 15, rq = C.lane >> 4;
    const float* lg = a.in(I_LNXG) + l * 512; const float* lb = a.in(I_LNXB) + l * 512; const float* rk = a.in(I_RK) + l * 512;
    const int h = (gw * 4 + rq) & 7, ch = h * 64 + 4 * g;
    const f32x4 rkv = *(const f32x4*)(rk + ch), lgv = *(const f32x4*)(lg + ch), lbv = *(const f32x4*)(lb + ch);
    constexpr int NIT = MT * 8 / 4;
    for (int it0 = gw; it0 < NIT; it0 += 3 * NGW) {
        f32x4 po[3], pg[3]; v2u pk[3], pr[3], pv[3];
#pragma unroll
        for (int u = 0; u < 3; ++u) { const int it = it0 + u * NGW; if (it < NIT) { const int row = (it * 4 + rq) >> 3; const unsigned char* rw = (const unsigned char*)RW + ((size_t)row * 8 + h) * RWB + 8 * g;
            po[u] = *(const f32x4*)(OC + (size_t)row * 512 + ch); pg[u] = *(const f32x4*)(GATE + (size_t)row * 512 + ch);
            pk[u] = *(const v2u*)(rw + RW_K); pr[u] = *(const v2u*)(rw + RW_R); pv[u] = *(const v2u*)(rw + RW_V); } }
        __builtin_amdgcn_sched_barrier(0);
#pragma unroll
        for (int u = 0; u < 3; ++u) { const int it = it0 + u * NGW; if (it < NIT) { const int row = (it * 4 + rq) >> 3; const f32x4 o = po[u];
            const float mu = rowsum16((o.x + o.y) + (o.z + o.w)) * (1.0f / 64.0f); const f32x4 d = o - mu;
            const float var = rowsum16((d.x * d.x + d.y * d.y) + (d.z * d.z + d.w * d.w)) * (1.0f / 64.0f); const float rstd = 1.0f / sqrtf(var + 64e-5f);
            float kf[4], rf[4], vf[4]; unpack4(pk[u], kf); unpack4(pr[u], rf); unpack4(pv[u], vf);
            const float bs = rowsum16((rf[0] * kf[0] * rkv.x + rf[1] * kf[1] * rkv.y) + (rf[2] * kf[2] * rkv.z + rf[3] * kf[3] * rkv.w));
            const f32x4 v4 = (f32x4){vf[0], vf[1], vf[2], vf[3]};
            const f32x4 y = (d * rstd * lgv + lbv + bs * v4) * pg[u];
            v2u w; w.x = pk2(y.x, y.y); w.y = pk2(y.z, y.w); *(v2u*)(YC + (size_t)row * DM + 1024 + ch) = w; } }
        __builtin_amdgcn_sched_barrier(0);
    }
}

__device__ __forceinline__ float ret_lg(int h) { return log1pf(-exp2f(-5.0f - (float)h)); }
constexpr int RS = 136;
__device__ __forceinline__ void rot8(const bf16* src, const float* cs, int c8, float scale, float (&lo)[8], float (&hi)[8]) {
    float x1[8], x2[8]; unpack8(*(const v4u*)(src + c8 * 8), x1); unpack8(*(const v4u*)(src + 64 + c8 * 8), x2);
    const f32x4* cp = (const f32x4*)(cs + 16 * c8); const f32x4 t0 = cp[0], t1 = cp[1], t2 = cp[2], t3 = cp[3];
    const float cc[8] = {t0.x, t0.z, t1.x, t1.z, t2.x, t2.z, t3.x, t3.z}, sn[8] = {t0.y, t0.w, t1.y, t1.w, t2.y, t2.w, t3.y, t3.w};
#pragma unroll
    for (int j = 0; j < 8; ++j) { lo[j] = (x1[j] * cc[j] - x2[j] * sn[j]) * scale; hi[j] = (x2[j] * cc[j] + x1[j] * sn[j]) * scale; }
}
struct RotX { v4u a, b; }; struct RotT { f32x4 t0, t1, t2, t3; };
__device__ __forceinline__ RotX rot_ldx(const bf16* src, int c8) { RotX r; r.a = *(const v4u*)(src + c8 * 8); r.b = *(const v4u*)(src + 64 + c8 * 8); return r; }
__device__ __forceinline__ RotT rot_ldt(const float* cs, int c8) { const f32x4* cp = (const f32x4*)(cs + 16 * c8); RotT r; r.t0 = cp[0]; r.t1 = cp[1]; r.t2 = cp[2]; r.t3 = cp[3]; return r; }
__device__ __forceinline__ void rot_ap(const RotX& x, const RotT& t, float scale, float (&lo)[8], float (&hi)[8]) {
    float x1[8], x2[8]; unpack8(x.a, x1); unpack8(x.b, x2);
    const float cc[8] = {t.t0.x, t.t0.z, t.t1.x, t.t1.z, t.t2.x, t.t2.z, t.t3.x, t.t3.z}, sn[8] = {t.t0.y, t.t0.w, t.t1.y, t.t1.w, t.t2.y, t.t2.w, t.t3.y, t.t3.w};
#pragma unroll
    for (int j = 0; j < 8; ++j) { lo[j] = (x1[j] * cc[j] - x2[j] * sn[j]) * scale; hi[j] = (x2[j] * cc[j] + x1[j] * sn[j]) * scale; }
}
__device__ __forceinline__ void ret_pass1_item(const Ctx& C, const Ax& a, int item) {
    const bf16* P = (const bf16*)(a.ws + WS_P); const float* CS = (const float*)(a.ws + WS_ROPE); float* KVT = (float*)(a.ws + WS_KVT);
    const int b = item >> 6, h = (item >> 4) & 3, c = item & 15; const size_t row0 = (size_t)b * SEQ + c * 128; const float lg = ret_lg(h);
    LAS bf16* KT = (LAS bf16*)C.lds; LAS bf16* VT = KT + 128 * RS;
    { RotX kx[2]; RotT kt[2]; v4u vw[4];
#pragma unroll
      for (int u = 0; u < 2; ++u) { const int it = C.tid + u * (NWAVES * 64), tt = it & 127, c8 = it >> 7; kx[u] = rot_ldx(P + (row0 + tt) * PIN + PB_ + 512 + h * 128, c8); kt[u] = rot_ldt(CS + (size_t)(c * 128 + tt) * 128, c8); }
#pragma unroll
      for (int u = 0; u < 4; ++u) { const int it = C.tid + u * (NWAVES * 64), tt = it & 127, c8 = it >> 7; vw[u] = *(const v4u*)(P + (row0 + tt) * PIN + PB_ + 1024 + h * 128 + c8 * 8); }
      __builtin_amdgcn_sched_barrier(0);
#pragma unroll
      for (int u = 0; u < 2; ++u) { const int it = C.tid + u * (NWAVES * 64), tt = it & 127, c8 = it >> 7; float lo[8], hi[8];
        rot_ap(kx[u], kt[u], 0.08838834764831845f * __expf(lg * (float)(127 - tt)), lo, hi);
#pragma unroll
        for (int j = 0; j < 8; ++j) { KT[(c8 * 8 + j) * RS + tt] = (bf16)(pk2(lo[j], 0.f) & 0xffffu); KT[(64 + c8 * 8 + j) * RS + tt] = (bf16)(pk2(hi[j], 0.f) & 0xffffu); } }
#pragma unroll
      for (int u = 0; u < 4; ++u) { const int it = C.tid + u * (NWAVES * 64), tt = it & 127, c8 = it >> 7; const unsigned ww[4] = {vw[u].x, vw[u].y, vw[u].z, vw[u].w};
#pragma unroll
        for (int j = 0; j < 4; ++j) { VT[(c8 * 8 + 2 * j) * RS + tt] = (bf16)(ww[j] & 0xffffu); VT[(c8 * 8 + 2 * j + 1) * RS + tt] = (bf16)(ww[j] >> 16); } } }
    __syncthreads();
    const int fr = C.lane & 15, fq = C.lane >> 4, w = C.wave;
    f32x4 acc[8];
#pragma unroll
    for (int et = 0; et < 8; ++et) acc[et] = zero4();
#pragma unroll
    for (int ks = 0; ks < 4; ++ks) { const bf16x8 kf = *(const LAS bf16x8*)(KT + (16 * w + fr) * RS + ks * 32 + fq * 8);
#pragma unroll
        for (int et = 0; et < 8; ++et) { const bf16x8 vf = *(const LAS bf16x8*)(VT + (16 * et + fr) * RS + ks * 32 + fq * 8); acc[et] = __builtin_amdgcn_mfma_f32_16x16x32_bf16(kf, vf, acc[et], 0, 0, 0); } }
    float* o = KVT + (size_t)item * 16384;
#pragma unroll
    for (int et = 0; et < 8; ++et) *(f32x4*)(o + (size_t)(16 * et + fr) * 128 + 16 * w + 4 * fq) = acc[et];
    __syncthreads();
}
__device__ __forceinline__ void ret_prefix_phase(const Ctx& C, const Ax& a, int l) {
    const float* KVT = (const float*)(a.ws + WS_KVT); bf16* STB = (bf16*)(a.ws + WS_STB);
    const int gt = C.bid * (NWAVES * 64) + C.tid, NT = C.G * NWAVES * 64;
    for (int idx = gt; idx < 16 * 4096; idx += NT) { const int bh = idx >> 12, r = idx & 4095, e = r >> 5, d4 = (r & 31) * 4; const int h = bh & 3;
        const float g128 = __expf(ret_lg(h) * 128.0f); const size_t base = (size_t)bh * 16 * 16384 + e * 128 + d4;
        f32x4 kv[16];
#pragma unroll
        for (int c = 0; c < 16; ++c) kv[c] = *(const f32x4*)(KVT + base + (size_t)c * 16384);
        f32x4 S = zero4();
#pragma unroll
        for (int c = 0; c < 16; ++c) { v2u w; w.x = pk2(S.x, S.y); w.y = pk2(S.z, S.w); *(v2u*)(STB + base + (size_t)c * 16384) = w; S = S * g128 + kv[c]; }
        float* o = a.out + O_RETP + ((size_t)l * 16 + bh) * 16384 + e;
        o[(size_t)d4 * 128] = S.x; o[(size_t)(d4 + 1) * 128] = S.y; o[(size_t)(d4 + 2) * 128] = S.z; o[(size_t)(d4 + 3) * 128] = S.w; }
}
__device__ __forceinline__ void ret_pass2_item(const Ctx& C, const Ax& a, int l, int item) {
    const bf16* P = (const bf16*)(a.ws + WS_P); const float* CS = (const float*)(a.ws + WS_ROPE); bf16* YC = (bf16*)(a.ws + WS_YC);
    const int b = item >> 6, h = (item >> 4) & 3, c = item & 15; const size_t row0 = (size_t)b * SEQ + c * 128; const float lg = ret_lg(h);
    LAS bf16* QL = (LAS bf16*)C.lds; LAS bf16* KL = QL + 128 * RS; LAS bf16* VT = KL + 128 * RS; LAS bf16* ST = VT + 128 * RS;
    { RotX qx[2], kx[2]; RotT kt[2]; v4u vw[4], sw[4]; const bf16* stb = (const bf16*)(a.ws + WS_STB) + (size_t)item * 16384;
#pragma unroll
      for (int u = 0; u < 2; ++u) { const int it = C.tid + u * (NWAVES * 64), tt = it & 127, c8 = it >> 7; const bf16* pr = P + (row0 + tt) * PIN + PB_ + h * 128;
        qx[u] = rot_ldx(pr, c8); kx[u] = rot_ldx(pr + 512, c8); kt[u] = rot_ldt(CS + (size_t)(c * 128 + tt) * 128, c8); }
#pragma unroll
      for (int u = 0; u < 4; ++u) { const int it = C.tid + u * (NWAVES * 64), tt = it & 127, c8 = it >> 7; vw[u] = *(const v4u*)(P + (row0 + tt) * PIN + PB_ + 1024 + h * 128 + c8 * 8);
        sw[u] = *(const v4u*)(stb + (it >> 4) * 128 + (it & 15) * 8); }
      __builtin_amdgcn_sched_barrier(0);
#pragma unroll
      for (int u = 0; u < 2; ++u) { const int it = C.tid + u * (NWAVES * 64), tt = it & 127, c8 = it >> 7; float lo[8], hi[8];
        rot_ap(qx[u], kt[u], __expf(lg * (float)(tt + 1)), lo, hi);
        *(LAS v4u*)(QL + tt * RS + c8 * 8) = pack8(lo); *(LAS v4u*)(QL + tt * RS + 64 + c8 * 8) = pack8(hi);
        rot_ap(kx[u], kt[u], 0.08838834764831845f * __expf(-lg * (float)(tt + 1)), lo, hi);
        *(LAS v4u*)(KL + tt * RS + c8 * 8) = pack8(lo); *(LAS v4u*)(KL + tt * RS + 64 + c8 * 8) = pack8(hi); }
#pragma unroll
      for (int u = 0; u < 4; ++u) { const int it = C.tid + u * (NWAVES * 64), tt = it & 127, c8 = it >> 7; const unsigned ww[4] = {vw[u].x, vw[u].y, vw[u].z, vw[u].w};
#pragma unroll
        for (int j = 0; j < 4; ++j) { VT[(c8 * 8 + 2 * j) * RS + tt] = (bf16)(ww[j] & 0xffffu); VT[(c8 * 8 + 2 * j + 1) * RS + tt] = (bf16)(ww[j] >> 16); }
        *(LAS v4u*)(ST + (it >> 4) * RS + (it & 15) * 8) = sw[u]; } }
    __syncthreads();
    const int fr = C.lane & 15, fq = C.lane >> 4, w = C.wave, i0 = 16 * w;
    bf16x8 qf[4];
#pragma unroll
    for (int ks = 0; ks < 4; ++ks) qf[ks] = *(const LAS bf16x8*)(QL + (i0 + fr) * RS + ks * 32 + fq * 8);
    f32x4 sc[8];
#pragma unroll
    for (int jt = 0; jt < 8; ++jt) { sc[jt] = zero4();
        if (jt <= w) {
#pragma unroll
            for (int ks = 0; ks < 4; ++ks) { const bf16x8 kf = *(const LAS bf16x8*)(KL + (16 * jt + fr) * RS + ks * 32 + fq * 8); sc[jt] = __builtin_amdgcn_mfma_f32_16x16x32_bf16(kf, qf[ks], sc[jt], 0, 0, 0); }
            if (jt == w) {
#pragma unroll
                for (int r = 0; r < 4; ++r) if (4 * fq + r > fr) sc[jt][r] = 0.f; } } }
    __syncthreads();
    LAS bf16* PL = KL;
#pragma unroll
    for (int jt = 0; jt < 8; ++jt) { v2u pw; pw.x = pk2(sc[jt][0], sc[jt][1]); pw.y = pk2(sc[jt][2], sc[jt][3]); *(LAS v2u*)(PL + (i0 + fr) * RS + 16 * jt + 4 * fq) = pw; }
    LDS_WAIT(); asm volatile("" ::: "memory");
    f32x4 acc[8];
#pragma unroll
    for (int et = 0; et < 8; ++et) acc[et] = zero4();
#pragma unroll
    for (int ks = 0; ks < 4; ++ks) { if (2 * ks <= w) { const bf16x8 pf = *(const LAS bf16x8*)(PL + (i0 + fr) * RS + ks * 32 + fq * 8);
#pragma unroll
            for (int et = 0; et < 8; ++et) { const bf16x8 vf = *(const LAS bf16x8*)(VT + (16 * et + fr) * RS + ks * 32 + fq * 8); acc[et] = __builtin_amdgcn_mfma_f32_16x16x32_bf16(vf, pf, acc[et], 0, 0, 0); } } }
    if (c > 0) {
#pragma unroll
        for (int ks = 0; ks < 4; ++ks)
#pragma unroll
            for (int et = 0; et < 8; ++et) { const bf16x8 sf = *(const LAS bf16x8*)(ST + (16 * et + fr) * RS + ks * 32 + fq * 8); acc[et] = __builtin_amdgcn_mfma_f32_16x16x32_bf16(sf, qf[ks], acc[et], 0, 0, 0); } }
    float s = 0.f;
#pragma unroll
    for (int et = 0; et < 8; ++et) s += (acc[et][0] + acc[et][1]) + (acc[et][2] + acc[et][3]);
    s += __shfl_xor(s, 16); s += __shfl_xor(s, 32); const float mu = s * (1.0f / 128.0f);
    float q = 0.f;
#pragma unroll
    for (int et = 0; et < 8; ++et) { acc[et] = acc[et] - mu; q += (acc[et][0] * acc[et][0] + acc[et][1] * acc[et][1]) + (acc[et][2] * acc[et][2] + acc[et][3] * acc[et][3]); }
    q += __shfl_xor(q, 16); q += __shfl_xor(q, 32); const float rstd = 1.0f / sqrtf(q * (1.0f / 128.0f) + 1e-6f);
    const size_t row = row0 + i0 + fr;
#pragma unroll
    for (int et = 0; et < 8; ++et) { const int e = 16 * et + 4 * fq; float gg[4]; unpack4(*(const v2u*)(P + row * PIN + PB_ + 1536 + h * 128 + e), gg);
        v2u wv; wv.x = pk2(gg[0] * sigm(gg[0]) * acc[et][0] * rstd, gg[1] * sigm(gg[1]) * acc[et][1] * rstd); wv.y = pk2(gg[2] * sigm(gg[2]) * acc[et][2] * rstd, gg[3] * sigm(gg[3]) * acc[et][3] * rstd);
        *(v2u*)(YC + row * DM + 512 + h * 128 + e) = wv; }
    __syncthreads();
}
__device__ __forceinline__ void ret_sample_witem(const Ctx& C, const Ax& a, int l, int witem) {
    const bf16* P = (const bf16*)(a.ws + WS_P); const float* CS = (const float*)(a.ws + WS_ROPE) + (size_t)2048 * 128; bf16* YC = (bf16*)(a.ws + WS_YC);
    const int n = witem >> 2, h = witem & 3, lane = C.lane; const float gam = 1.0f - exp2f(-5.0f - (float)h);
    LAS float* qk = (LAS float*)(C.lds + C.wave * 1024);
    const bf16* pr = P + (size_t)(MP + n) * PIN + PB_ + h * 128;
    { const float co = CS[2 * lane], si = CS[2 * lane + 1]; const float q1 = bf1(pr[lane]), q2 = bf1(pr[64 + lane]), k1 = bf1(pr[512 + lane]), k2 = bf1(pr[512 + 64 + lane]);
      qk[lane] = q1 * co - q2 * si; qk[64 + lane] = q2 * co + q1 * si; qk[128 + lane] = (k1 * co - k2 * si) * 0.08838834764831845f; qk[192 + lane] = (k2 * co + k1 * si) * 0.08838834764831845f; }
    LDS_WAIT(); asm volatile("" ::: "memory");
    const float dotp = wave_sum(qk[lane] * qk[128 + lane] + qk[64 + lane] * qk[192 + lane]);
    const int half = lane >> 5, el = lane & 31;
    float vv[4]; unpack4(*(const v2u*)(pr + 1024 + 4 * el), vv); const f32x4 v4 = (f32x4){vv[0], vv[1], vv[2], vv[3]};
    const float* sin_ = a.in(I_SRET) + (((size_t)l * NS + n) * 4 + h) * 16384; float* sout = a.out + O_RETS + (((size_t)l * NS + n) * 4 + h) * 16384;
    f32x4 oa = zero4();
    unsigned lof = (unsigned)(half * 128 + 4 * el) * 4u; asm volatile("" : "+v"(lof));
    f32x4 sa[8], sb[8];
#define RS_LOAD(buf, blk) do { _Pragma("unroll") for (int j = 0; j < 8; ++j) buf[j] = __builtin_nontemporal_load((const f32x4*)((const char*)sin_ + (lof + (unsigned)(2 * ((blk) * 8 + j)) * 512u))); } while (0)
#define RS_USE(buf, blk) do { _Pragma("unroll") for (int j = 0; j < 8; ++j) { const int d = 2 * ((blk) * 8 + j) + half; const float qd = qk[d], kd = qk[128 + d]; oa += qd * buf[j]; \
        __builtin_nontemporal_store(gam * buf[j] + kd * v4, (f32x4*)((char*)sout + (lof + (unsigned)(2 * ((blk) * 8 + j)) * 512u))); } } while (0)
    RS_LOAD(sa, 0);
#pragma unroll
    for (int blk = 0; blk < 8; blk += 2) {
        RS_LOAD(sb, blk + 1); __builtin_amdgcn_sched_barrier(0);
        RS_USE(sa, blk); __builtin_amdgcn_sched_barrier(0);
        if (blk + 2 < 8) RS_LOAD(sa, blk + 2);
        __builtin_amdgcn_sched_barrier(0);
        RS_USE(sb, blk + 1); __builtin_amdgcn_sched_barrier(0); }
#undef RS_LOAD
#undef RS_USE
    oa.x += __shfl_xor(oa.x, 32); oa.y += __shfl_xor(oa.y, 32); oa.z += __shfl_xor(oa.z, 32); oa.w += __shfl_xor(oa.w, 32);
    f32x4 o = gam * oa + dotp * v4;
    float s = (o.x + o.y) + (o.z + o.w);
#pragma unroll
    for (int m = 1; m < 32; m <<= 1) s += __shfl_xor(s, m);
    const float mu = s * (1.0f / 128.0f); o = o - mu; float q = (o.x * o.x + o.y * o.y) + (o.z * o.z + o.w * o.w);
#pragma unroll
    for (int m = 1; m < 32; m <<= 1) q += __shfl_xor(q, m);
    const float rstd = 1.0f / sqrtf(q * (1.0f / 128.0f) + 1e-6f);
    if (half == 0) { float gg[4]; unpack4(*(const v2u*)(pr + 1536 + 4 * el), gg);
        v2u wv; wv.x = pk2(gg[0] * sigm(gg[0]) * o.x * rstd, gg[1] * sigm(gg[1]) * o.y * rstd); wv.y = pk2(gg[2] * sigm(gg[2]) * o.z * rstd, gg[3] * sigm(gg[3]) * o.w * rstd);
        *(v2u*)(YC + (size_t)(MP + n) * DM + 512 + h * 128 + 4 * el) = wv; }
    LDS_WAIT(); asm volatile("" ::: "memory");
}

constexpr int XV_RS = 264;
__device__ __forceinline__ void xattn_prompt_unit(const Ctx& C, const Ax& a, int l, int unit) {
    const bf16* Q = (const bf16*)(a.ws + WS_Q); const bf16* MK = (const bf16*)(a.ws + WS_MK) + (size_t)l * MMEM * DM; const bf16* MVT = (const bf16*)(a.ws + WS_MVT) + (size_t)l * MMEM * DM; bf16* O = (bf16*)(a.ws + WS_O);
    const int b = unit >> 6, h = (unit >> 4) & 3, qt = unit & 15, fr = C.lane & 15, fq = C.lane >> 4;
    const size_t row = (size_t)b * SEQ + qt * 128 + C.wave * 16 + fr;
    LAS bf16* SB = (LAS bf16*)C.lds;
    v4u st[8];
    const bf16* kbase = MK + ((size_t)b * 256) * DM + h * 512; const bf16* vbase = MVT + (((size_t)b * 4 + h) * 512) * 256;
    unsigned kof[4], vof[8], sof[8];
#pragma unroll
    for (int i = 0; i < 8; ++i) { const int idx = C.tid + 512 * i, r = idx >> 5, c16 = idx & 31; vof[i] = (unsigned)(r * 256 + c16 * 8) * 2u; sof[i] = (unsigned)(r * XV_RS + c16 * 8) * 2u; if (i < 4) kof[i] = (unsigned)(r * DM + c16 * 8) * 2u; }
    const char* kb8 = (const char*)kbase; const char* vb8 = (const char*)vbase; LAS char* sb8 = (LAS char*)SB;
#define XK_LOAD(q) do { const char* pb_ = kb8 + ((size_t)(((q) & 3) * 64) * DM + ((q) >> 2) * 256) * 2; _Pragma("unroll") for (int i = 0; i < 4; ++i) st[i] = *(const v4u*)(pb_ + kof[i]); } while (0)
#define XK_STORE() do { _Pragma("unroll") for (int i = 0; i < 4; ++i) *(LAS v4u*)(sb8 + sof[i]) = st[i]; } while (0)
#define XV_LOAD(p) do { const char* pb_ = vb8 + (size_t)((p) * 128) * 256 * 2; _Pragma("unroll") for (int i = 0; i < 8; ++i) st[i] = *(const v4u*)(pb_ + vof[i]); } while (0)
#define XV_STORE() do { _Pragma("unroll") for (int i = 0; i < 8; ++i) *(LAS v4u*)(sb8 + sof[i]) = st[i]; } while (0)
    XK_LOAD(0);
    f32x4 sc[16];
#pragma unroll
    for (int jt = 0; jt < 16; ++jt) sc[jt] = zero4();
#pragma unroll
    for (int dh = 0; dh < 2; ++dh) {
        bf16x8 qf[8];
#pragma unroll
        for (int ks = 0; ks < 8; ++ks) qf[ks] = *(const bf16x8*)(Q + row * DM + h * 512 + dh * 256 + ks * 32 + fq * 8);
#pragma unroll
        for (int p = 0; p < 4; ++p) {
            __syncthreads(); XK_STORE(); __syncthreads();
            if (dh * 4 + p < 7) XK_LOAD(dh * 4 + p + 1); else XV_LOAD(0);
#pragma unroll
            for (int j4 = 0; j4 < 4; ++j4) {
#pragma unroll
                for (int ks = 0; ks < 8; ++ks) { const bf16x8 kf = *(const LAS bf16x8*)(SB + (j4 * 16 + fr) * XV_RS + ks * 32 + fq * 8); sc[p * 4 + j4] = __builtin_amdgcn_mfma_f32_16x16x32_bf16(kf, qf[ks], sc[p * 4 + j4], 0, 0, 0); }
                __builtin_amdgcn_sched_barrier(0); }
        }
    }
    float mx = -3.0e38f;
#pragma unroll
    for (int jt = 0; jt < 16; ++jt) mx = fmaxf(mx, fmaxf(fmaxf(sc[jt][0], sc[jt][1]), fmaxf(sc[jt][2], sc[jt][3])));
    mx = fmaxf(mx, __shfl_xor(mx, 16)); mx = fmaxf(mx, __shfl_xor(mx, 32));
    const float scale = 0.04419417382415922f; float sum = 0.f;
    bf16x8 pf[8];
#pragma unroll
    for (int s = 0; s < 8; ++s) { float p[8];
#pragma unroll
        for (int j = 0; j < 4; ++j) { p[j] = __expf((sc[2 * s][j] - mx) * scale); p[4 + j] = __expf((sc[2 * s + 1][j] - mx) * scale); }
        sum += ((p[0] + p[1]) + (p[2] + p[3])) + ((p[4] + p[5]) + (p[6] + p[7]));
        const v4u w = pack8(p); pf[s] = __builtin_bit_cast(bf16x8, w); }
    sum += __shfl_xor(sum, 16); sum += __shfl_xor(sum, 32); const float inv = 1.0f / sum;
#pragma unroll
    for (int p = 0; p < 4; ++p) {
        __syncthreads(); XV_STORE(); __syncthreads();
        if (p < 3) XV_LOAD(p + 1);
#pragma unroll
        for (int et = 0; et < 8; ++et) { f32x4 s4 = zero4(); const LAS bf16* vp = SB + (et * 16 + fr) * XV_RS + 4 * fq;
#pragma unroll
            for (int s = 0; s < 8; ++s) { const v2u lo = *(const LAS v2u*)(vp + 32 * s), hi = *(const LAS v2u*)(vp + 32 * s + 16); const v4u w = (v4u){lo.x, lo.y, hi.x, hi.y};
                s4 = __builtin_amdgcn_mfma_f32_16x16x32_bf16(__builtin_bit_cast(bf16x8, w), pf[s], s4, 0, 0, 0); }
            v2u w; w.x = pk2(s4[0] * inv, s4[1] * inv); w.y = pk2(s4[2] * inv, s4[3] * inv);
            *(v2u*)(O + row * DM + h * 512 + p * 128 + et * 16 + 4 * fq) = w;
            __builtin_amdgcn_sched_barrier(0); }
    }
    __syncthreads();
#undef XK_LOAD
#undef XK_STORE
#undef XV_LOAD
#undef XV_STORE
}
__device__ __forceinline__ void xattn_sample_item(const Ctx& C, const Ax& a, int l, int item) {
    bf16* O = (bf16*)(a.ws + WS_OS);
    const int n = item >> 2, h = item & 3, lane = C.lane, w = C.wave;
    LAS float* red = (LAS float*)C.lds; LAS float* part = red + 64;
    float q[8]; { const float* s0 = (const float*)(a.ws + WS_SPL) + (size_t)n * DM + h * 512 + 4 * lane; const float* s1 = s0 + (size_t)NS * DM;
                  const f32x4 a0 = *(const f32x4*)s0 + *(const f32x4*)s1, a1 = *(const f32x4*)(s0 + 256) + *(const f32x4*)(s1 + 256);
                  q[0] = a0.x; q[1] = a0.y; q[2] = a0.z; q[3] = a0.w; q[4] = a1.x; q[5] = a1.y; q[6] = a1.z; q[7] = a1.w; }
    const size_t base = ((((size_t)l * NS + n) * 256 + 32 * w) * 4 + h) * 512 + 4 * lane;
    const float* kp = a.in(I_CMK) + base; const float* vp = a.in(I_CMV) + base;
#define XS_LOAD(buf0, buf1, ptr, k8) do { _Pragma("unroll") for (int j = 0; j < 8; ++j) { buf0[j] = __builtin_nontemporal_load((const f32x4*)((ptr) + (size_t)((k8) * 8 + j) * 2048)); buf1[j] = __builtin_nontemporal_load((const f32x4*)((ptr) + (size_t)((k8) * 8 + j) * 2048 + 256)); } } while (0)
#define XS_DOT(buf0, buf1, k8) do { _Pragma("unroll") for (int j = 0; j < 8; ++j) { float d = (buf0[j].x * q[0] + buf0[j].y * q[1]) + (buf0[j].z * q[2] + buf0[j].w * q[3]) + (buf1[j].x * q[4] + buf1[j].y * q[5]) + (buf1[j].z * q[6] + buf1[j].w * q[7]); \
        d = rowsum16(d); d += __shfl_xor(d, 16); d += __shfl_xor(d, 32); if (lane == (k8) * 8 + j) myscore = d; } } while (0)
#define XS_ACC(buf0, buf1, k8) do { _Pragma("unroll") for (int j = 0; j < 8; ++j) { const float pj = __builtin_bit_cast(float, __builtin_amdgcn_readlane(__builtin_bit_cast(int, p), (k8) * 8 + j)); o0 += pj * buf0[j]; o1 += pj * buf1[j]; } } while (0)
    float myscore = 0.f;
    f32x4 xa0[8], xa1[8], xb0[8], xb1[8];
    XS_LOAD(xa0, xa1, kp, 0);
    XS_LOAD(xb0, xb1, kp, 1); XS_DOT(xa0, xa1, 0);
    XS_LOAD(xa0, xa1, kp, 2); XS_DOT(xb0, xb1, 1);
    XS_LOAD(xb0, xb1, kp, 3); XS_DOT(xa0, xa1, 2);
    XS_LOAD(xa0, xa1, vp, 0); XS_DOT(xb0, xb1, 3);
    const float scale = 0.04419417382415922f;
    float mx = wave_max(lane < 32 ? myscore : -3.0e38f); if (lane == 0) red[w] = mx; __syncthreads();
    mx = red[0];
#pragma unroll
    for (int i = 1; i < 8; ++i) mx = fmaxf(mx, red[i]);
    const float p = lane < 32 ? __expf((myscore - mx) * scale) : 0.f;
    const float ps = wave_sum(p); if (lane == 0) red[8 + w] = ps;
    f32x4 o0 = zero4(), o1 = zero4();
    XS_LOAD(xb0, xb1, vp, 1); XS_ACC(xa0, xa1, 0);
    XS_LOAD(xa0, xa1, vp, 2); XS_ACC(xb0, xb1, 1);
    XS_LOAD(xb0, xb1, vp, 3); XS_ACC(xa0, xa1, 2);
    XS_ACC(xb0, xb1, 3);
#undef XS_LOAD
#undef XS_DOT
#undef XS_ACC
    *(LAS f32x4*)(part + w * 512 + 4 * lane) = o0; *(LAS f32x4*)(part + w * 512 + 256 + 4 * lane) = o1;
    __syncthreads();
    float tot = 0.f;
#pragma unroll
    for (int i = 0; i < 8; ++i) tot += red[8 + i];
    { const int d = C.tid; float s = 0.f;
#pragma unroll
      for (int i = 0; i < 8; ++i) s += part[i * 512 + d];
      O[(size_t)n * DMS + h * 512 + d] = (bf16)(pk2(s / tot, 0.f) & 0xffffu); }
    __syncthreads();
}

#ifndef PHASE_MASK
#define PHASE_MASK 0xffffffffu
#endif
#define PM(k) ((PHASE_MASK >> (k)) & 1u)
#ifndef DUP_SUB
#define DUP_SUB 0u
#endif
#define REP(k) for (int rep_ = 0; rep_ < 1 + (int)((DUP_SUB >> (k)) & 1u); ++rep_)
#ifndef DUP_MASK
#define DUP_MASK 0
#endif
#ifndef MK_ONE_LAUNCH
#define MK_ONE_LAUNCH 1
#endif
constexpr int PH_PER_LAYER = 14, NPH = 1 + DEPTH * PH_PER_LAYER;
__global__ void __launch_bounds__(NWAVES * 64, 2) fwd_kernel(Args args) {
    extern __shared__ __attribute__((aligned(16))) unsigned char lds_raw[];
    LAS unsigned char* const lds = (LAS unsigned char*)lds_raw;
    const int wave_s = __builtin_amdgcn_readfirstlane((int)threadIdx.x >> 6);
    volatile LAS unsigned* MISC = (volatile LAS unsigned*)(lds + MISC_OFF);
    for (int u = threadIdx.x; u < (LDS_BYTES - MISC_OFF) / 4; u += NWAVES * 64) ((LAS unsigned*)(lds + MISC_OFF))[u] = 0u;
    __syncthreads();
    XcdBarrier bar; bar.bar = (unsigned*)(args.ws + WS_CTL) + CW_BAR; bar.x = 0; bar.st = nullptr;
    if (MK_ONE_LAUNCH) bar = xcd_barrier_post((unsigned*)(args.ws + WS_CTL) + CW_BAR, MISC + 8);
    bar.wave = wave_s;
    const int lo = args.ph_lo, hi = args.ph_hi;
#define IN(k) (lo <= (k) && (k) < hi)
#define SEAM(k) do { if (MK_ONE_LAUNCH && IN((k) + 1)) xcd_barrier(bar); } while (0)
#define SEAM2(k) do { if (MK_ONE_LAUNCH && IN((k) + 2)) xcd_barrier(bar); } while (0)
#define PHASE_CTX const Ctx C = mk_ctx(lds, wave_s); const Ax a = mk_ax(); unsigned char* const ws = a.ws; const int G = C.G, bid = C.bid; (void)ws; (void)G; (void)bid; \
    float* const XF = (float*)(ws + WS_XF); bf16* const HN = (bf16*)(ws + WS_HN); bf16* const PBUF = (bf16*)(ws + WS_P); bf16* const YC = (bf16*)(ws + WS_YC); bf16* const QB = (bf16*)(ws + WS_Q); \
    bf16* const OB = (bf16*)(ws + WS_O); bf16* const UB = (bf16*)(ws + WS_U); (void)XF; (void)HN; (void)PBUF; (void)YC; (void)QB; (void)OB; (void)UB

    if (IN(0)) { PHASE_CTX; if (PM(0)) p0_prologue(C, a); SEAM(0); }

    for (int l = 0; l < DEPTH; ++l) {
        const int pb = 1 + l * PH_PER_LAYER;
        if (IN(pb + 0)) { PHASE_CTX; const unsigned char* wl = ws + WS_WL + (size_t)l * LW_STRIDE;
            if (PM(1)) { pg8::Gemm g{HN, (const bf16*)(wl + LW_IN), MPAD, PIN, DM, DM, 64, (size_t)PIN * 128}; pg8::StaticOrder S; S.init(MPAD, PIN, G, bid); pg8::EpiBf16A<0> E{PBUF, PIN, nullptr};
              pg8::gemm_phase<pg8::EpiBf16A<0>, pg8::StaticOrder, true, true>(lds, g, S, E, C.tid); }
            if (G == 256) { const int nfull = (MPAD / 256) * (PIN / 256) - 3 * G;
                if ((bid >= nfull && bid < 64) || bid >= 128) { __syncthreads(); late_convert(C, a, l, bid < 64 ? bid - nfull : bid - 128 + (64 - nfull), (64 - nfull) + (G - 128)); } }
            if (PM(2)) { pg8::Gemm g{(const bf16*)(ws + WS_MN), (const bf16*)(ws + WS_WKV) + (size_t)l * 4096 * 64, MMEM, 4096, DM, DM, 64, (size_t)8192 * 128}; pg8::StaticOrder S; S.init(MMEM, 4096, G, (bid + G - (64 % G)) % G);
              pg8::EpiMemKV E{a.out + O_MKP + (size_t)l * MMEM * DM, (bf16*)(ws + WS_MK) + (size_t)l * MMEM * DM, (bf16*)(ws + WS_MVT) + (size_t)l * MMEM * DM};
              pg8::gemm_phase<pg8::EpiMemKV, pg8::StaticOrder, true, true>(lds, g, S, E, C.tid); }
            SEAM(pb + 0);
        }
        if (IN(pb + 1)) { PHASE_CTX;
#ifdef DEBUG_P
            { const int gt = bid * 512 + C.tid, NT = G * 512;
              for (int idx = gt + (DEBUG_P == 2 ? MP * 2048 : 0); idx < (DEBUG_P == 1 ? MP : MT) * 2048; idx += NT) { const int row = idx >> 11, c = idx & 2047; const bf16* pr = PBUF + (size_t)row * PIN;
                  float s = bf1(pr[c]) + bf1(pr[c + 2048]) + bf1(pr[c + 4096]); if (c < 256) s += bf1(pr[c + 6144]); a.out[O_YP + idx] = s; } }
#endif
            if ((bid >> 3) & 1) { if (PM(8)) REP(8) for (int it = bid * NWAVES + C.wave; it < NS * 4; it += G * NWAVES) ret_sample_witem(C, a, l, it); __syncthreads(); }
            if (PM(4)) REP(4) for (int it = bid; it < 256; it += G) ad_prompt_item(C, a, l, it);
            if (PM(5)) REP(5) for (int it = bid; it < 256; it += G) ret_pass1_item(C, a, it);
            if (PM(6)) REP(6) for (int it = bid; it < 256; it += G) rwkv_prep_item(C, a, l, it);
            if (PM(6)) for (int it = bid - 64; it >= 0 && it < 8; it += G) rwkv_prep_item(C, a, l, 256 + (it >> 1), it & 1);
            if (PM(7)) REP(7) for (int it = G - 1 - bid; it < NS; it += G) ad_sample_item(C, a, l, it);
            if (!((bid >> 3) & 1)) { if (PM(8)) REP(8) for (int it = bid * NWAVES + C.wave; it < NS * 4; it += G * NWAVES) ret_sample_witem(C, a, l, it); }
            __syncthreads();
            SEAM(pb + 1);
        }
        if (IN(pb + 2)) { PHASE_CTX;
            if ((bid >> 3) & 1) { if (PM(10)) REP(10) for (int it = bid * NWAVES + C.wave; it < NS * 16; it += G * NWAVES) rwkv_sample_witem(C, a, l, it); }
            if (PM(9)) REP(9) for (int it = bid * NWAVES + C.wave; it < 4096; it += G * NWAVES) wkv_chunk_witem(C, a, it);
            if (!((bid >> 3) & 1)) { if (PM(10)) REP(10) for (int it = bid * NWAVES + C.wave; it < NS * 16; it += G * NWAVES) rwkv_sample_witem(C, a, l, it); }
            if (PM(11)) ret_prefix_phase(C, a, l);
            SEAM(pb + 2);
        }
        if (IN(pb + 3)) { PHASE_CTX; const int hg = G / 2;
            if (PM(22)) REP(22) for (int it = bid; it < 128; it += (bid < hg ? hg : 1 << 20)) wkv_seq_item(C, a, l, it);
            if (PM(11)) REP(11) if (bid >= hg || G < 2) for (int it = bid - hg; it < 256; it += G - hg) ret_pass2_item(C, a, l, it);
            SEAM(pb + 3);
        }
        if (IN(pb + 4)) { PHASE_CTX;
            if (PM(12)) REP(12) rwkv_post_phase(C, a, l);
            SEAM(pb + 4);
        }
        if (IN(pb + 5)) { PHASE_CTX; const unsigned char* wl = ws + WS_WL + (size_t)l * LW_STRIDE;
            pg8::Gemm g{YC, (const bf16*)(wl + LW_OUT), MP, DM, DM, DM, 64, (size_t)DM * 128}; pg8::StaticOrder S; S.init(MP, DM, G, bid); pg8::EpiRes E{XF, DM, ((DUP_MASK >> 5) & 1) ? 0.5f : 1.0f, (l == 0 && !((DUP_MASK >> 5) & 1)) ? a.in(I_XP) : (const float*)XF};
            if (PM(15)) pg8::gemm_phase<pg8::EpiRes, pg8::StaticOrder, true, true>(lds, g, S, E, C.tid);
            if (PM(20)) sample_gemm(lds, C.tid, YC + (size_t)MP * DM, DM, (const bf16*)(wl + LW_OUT), DM, DM, DM, G, bid, SEpiRes{XF + (size_t)MP * DM, DM, ((DUP_MASK >> 5) & 1) ? 0.5f : 1.0f, (l == 0 && !((DUP_MASK >> 5) & 1)) ? a.in(I_XS) : (const float*)(XF + (size_t)MP * DM)});
            SEAM(pb + 5);
        }
        if (IN(pb + 6)) { PHASE_CTX; if (PM(21)) REP(21) rms_phase(C, XF, HN, (bf16*)(ws + WS_HNS)); SEAM(pb + 6);
#ifdef XBAR_PROBE
            if (MK_ONE_LAUNCH) for (int i_ = 0; i_ < XBAR_PROBE; ++i_) xcd_barrier(bar);
#endif
        }
        if (IN(pb + 7)) { PHASE_CTX; const unsigned char* wl = ws + WS_WL + (size_t)l * LW_STRIDE;
            pg8::Gemm g{HN, (const bf16*)(wl + LW_Q), MP, DM, DM, DM, 64, (size_t)DM * 128}; pg8::StaticOrder S; S.init(MP, DM, G, bid); pg8::EpiBf16A<0> E{QB, DM, nullptr};
            if (PM(16)) REP(16) pg8::gemm_phase<pg8::EpiBf16A<0>, pg8::StaticOrder, true, true>(lds, g, S, E, C.tid);
            if (PM(20)) { sample_gemm(lds, C.tid, (const bf16*)(ws + WS_HNS), DMS, (const bf16*)(wl + LW_Q), DM, DM, DM, G, bid, SEpiPart{(float*)(ws + WS_SPL), DM}, 2); if ((DUP_SUB >> 24) & 1u) { const Ctx C2 = mk_ctx(lds, wave_s); sample_gemm(lds, C2.tid, (const bf16*)(ws + WS_HNS), DMS, (const bf16*)(wl + LW_Q), DM, DM, DM, G, bid, SEpiPart{(float*)(ws + WS_SPL), DM}, 2); } }
            SEAM(pb + 7);
        }
        if (IN(pb + 8)) { PHASE_CTX;
            { const int g3 = (bid >> 3) % 3;
              if (g3 == 0) { if (PM(13)) REP(13) for (int it = bid; it < 256; it += G) xattn_prompt_unit(C, a, l, it); }
              if (PM(14)) REP(14) for (int it = bid; it < NS * 4; it += 2 * G) xattn_sample_item(C, a, l, it);
              if (g3 == 1) { if (PM(13)) REP(13) for (int it = bid; it < 256; it += G) xattn_prompt_unit(C, a, l, it); }
              if (PM(14)) REP(14) for (int it = bid + G; it < NS * 4; it += 2 * G) xattn_sample_item(C, a, l, it);
              if (g3 == 2) { if (PM(13)) REP(13) for (int it = bid; it < 256; it += G) xattn_prompt_unit(C, a, l, it); } }
            SEAM(pb + 8);
        }
        if (IN(pb + 9)) { PHASE_CTX; const unsigned char* wl = ws + WS_WL + (size_t)l * LW_STRIDE;
            pg8::Gemm g{OB, (const bf16*)(wl + LW_O), MP, DM, DM, DM, 64, (size_t)DM * 128}; pg8::StaticOrder S; S.init(MP, DM, G, bid); pg8::EpiRes E{XF, DM, ((DUP_MASK >> 9) & 1) ? 0.5f : 1.0f, XF};
            if (PM(17)) pg8::gemm_phase<pg8::EpiRes, pg8::StaticOrder, true, true>(lds, g, S, E, C.tid);
            if (PM(20)) sample_gemm(lds, C.tid, (const bf16*)(ws + WS_OS), DMS, (const bf16*)(wl + LW_O), DM, DM, DM, G, bid, SEpiRes{XF + (size_t)MP * DM, DM, ((DUP_MASK >> 9) & 1) ? 0.5f : 1.0f, XF + (size_t)MP * DM});
            SEAM(pb + 9);
        }
        if (IN(pb + 10)) { PHASE_CTX; if (PM(21)) REP(21) rms_phase(C, XF, HN, (bf16*)(ws + WS_HNS)); SEAM(pb + 10); }
        if (IN(pb + 11)) { PHASE_CTX; const unsigned char* wl = ws + WS_WL + (size_t)l * LW_STRIDE;
            pg8::Gemm g{HN, (const bf16*)(wl + LW_UP), MP, DFF, DM, DM, 64, (size_t)DFF * 128}; pg8::StaticOrder S; S.init(MP, DFF, G, bid); pg8::EpiBf16A<3> E{UB, LDU, nullptr};
            if (PM(18)) REP(18) pg8::gemm_phase<pg8::EpiBf16A<3>, pg8::StaticOrder, true, true>(lds, g, S, E, C.tid);
            if (PM(20)) { sample_gemm(lds, C.tid, (const bf16*)(ws + WS_HNS), DMS, (const bf16*)(wl + LW_UP), DFF, DFF, DM, G, bid, SEpiBf16{(bf16*)(ws + WS_US), LDUS, 3, nullptr}); if ((DUP_SUB >> 23) & 1u) { const Ctx C2 = mk_ctx(lds, wave_s); sample_gemm(lds, C2.tid, (const bf16*)(ws + WS_HNS), DMS, (const bf16*)(wl + LW_UP), DFF, DFF, DM, G, bid, SEpiBf16{(bf16*)(ws + WS_US), LDUS, 3, nullptr}); } }
            SEAM(pb + 11);
        }
        if (IN(pb + 12)) { PHASE_CTX; const unsigned char* wl = ws + WS_WL + (size_t)l * LW_STRIDE;
            pg8::Gemm g{UB, (const bf16*)(wl + LW_DN), MP, DM, DFF, LDU, 64, (size_t)DM * 128}; pg8::StaticOrder S; S.init(MP, DM, G, bid); pg8::EpiRes E{XF, DM, ((DUP_MASK >> 12) & 1) ? 0.5f : 1.0f, XF};
            if (PM(19)) pg8::gemm_phase<pg8::EpiRes, pg8::StaticOrder, true, true>(lds, g, S, E, C.tid);
            if (PM(20)) { sample_gemm(lds, C.tid, (const bf16*)(ws + WS_US), LDUS, (const bf16*)(wl + LW_DN), DM, DM, DFF, G, bid, SEpiPart{(float*)(ws + WS_SPL), DM}, 2); if ((DUP_SUB >> 25) & 1u) { const Ctx C2 = mk_ctx(lds, wave_s); sample_gemm(lds, C2.tid, (const bf16*)(ws + WS_US), LDUS, (const bf16*)(wl + LW_DN), DM, DM, DFF, G, bid, SEpiPart{(float*)(ws + WS_SPL), DM}, 2); } }
            SEAM(pb + 12);
        }
        if (IN(pb + 13)) { PHASE_CTX;
            fold_split_rows(C, XF, (const float*)(ws + WS_SPL));
            if (!PM(21)) {} else if (l + 1 < DEPTH) REP(21) rms_phase(C, XF, HN, nullptr); else final_norm_phase(C, XF, a.in(I_GFIN), a.out + O_YP);
            SEAM(pb + 13);
        }
    }
#undef IN
#undef SEAM
#undef SEAM2
#undef PHASE_CTX
}

extern "C" void kernel_launch(void* const* d_in, const int* in_sizes, int n_in, void* d_out, int out_size, void* d_ws, size_t ws_size, hipStream_t stream) {
    static int grid = 0;
    if (grid == 0) {
        if (n_in != NIN || (size_t)out_size != O_END || ws_size < WS_END) { fprintf(stderr, "kernel_launch: unexpected shapes (n_in %d, out %d, ws %zu); nothing launched\n", n_in, out_size, ws_size); grid = -1; return; }
        int dev = 0, cus = 0, per_cu = 0;
        if (hipGetDevice(&dev) != hipSuccess || hipDeviceGetAttribute(&cus, hipDeviceAttributeMultiprocessorCount, dev) != hipSuccess) { grid = -1; return; }
        if (hipFuncSetAttribute((const void*)fwd_kernel, hipFuncAttributeMaxDynamicSharedMemorySize, LDS_BYTES) != hipSuccess) { fprintf(stderr, "kernel_launch: hipFuncSetAttribute failed\n"); grid = -1; return; }
        if (hipOccupancyMaxActiveBlocksPerMultiprocessor(&per_cu, (const void*)fwd_kernel, NWAVES * 64, LDS_BYTES) != hipSuccess || per_cu < 1) { fprintf(stderr, "kernel_launch: occupancy query reports %d\n", per_cu); }
        (void)hipGetLastError();
        grid = cus;
    }
    if (grid < 0) return;
    if (hipMemsetAsync((char*)d_ws + WS_CTL, 0, CTL_ZERO_BYTES, stream) != hipSuccess) return;
    Args a{};
    for (int i = 0; i < NIN; ++i) a.in[i] = (const float*)d_in[i];
    a.out = (float*)d_out; a.ws = (unsigned char*)d_ws;
#if MK_ONE_LAUNCH
    a.ph_lo = 0; a.ph_hi = NPH;
    hipLaunchKernelGGL(fwd_kernel, dim3(grid), dim3(NWAVES * 64), LDS_BYTES, stream, a);
#else
#ifndef NPH_RUN
#define NPH_RUN NPH
#endif
    for (int ph = 0; ph < NPH_RUN; ++ph) { a.ph_lo = ph; a.ph_hi = ph + 1; hipLaunchKernelGGL(fwd_kernel, dim3(grid), dim3(NWAVES * 64), LDS_BYTES, stream, a);
        const int dbit = (ph == 0) ? 13 : (ph - 1) % PH_PER_LAYER;
        if ((DUP_MASK >> dbit) & 1) hipLaunchKernelGGL(fwd_kernel, dim3(grid), dim3(NWAVES * 64), LDS_BYTES, stream, a); }
#endif
}
```

```cpp
#include <hip/hip_runtime.h>
#include <cstdio>
#include <cstdint>
namespace pg8 {
#define PG8_LAS __attribute__((address_space(3)))
typedef unsigned short bf16_t;
typedef short bf16x8 __attribute__((ext_vector_type(8)));
typedef float f32x4 __attribute__((ext_vector_type(4)));
typedef unsigned u32x4 __attribute__((ext_vector_type(4)));
constexpr int BM = 256, BK = 64, HALF = 128, HTB = HALF * BK * 2  , STAGE_BYTES = 8 * HTB, NXCD = 8, WGM = 8;

__host__ __device__ __forceinline__ int lds_byte(int r, int c) { const int st = (r >> 4) * 2 + (c >> 5), rr = r & 15, cc = c & 31, ob = rr * 64 + cc * 2; return st * 1024 + (ob ^ (((ob >> 9) & 1) << 5)); }
__host__ __device__ __forceinline__ void stage_rc(int b, int& R, int& C) { const int st = b / 1024, sb = b % 1024, swz = sb ^ (((sb >> 9) & 1) << 5); R = (st >> 1) * 16 + swz / 64; C = (st & 1) * 32 + (swz % 64) / 2; }
__host__ __device__ __forceinline__ int perm32(int rho) { const int n = rho >> 4, i = rho & 15; return 8 * (i >> 2) + 4 * n + (i & 3); }

struct Unit { int pm, pn; };
struct Gemm { const bf16_t* A; const bf16_t* Bt; int M, N, K, lda, ldb; size_t ksb; };

struct StaticOrder {
    int nM, nN, nwg, G, c;
    __host__ __device__ void init(int M, int N, int G_, int c_) { nM = M / BM; nN = N / BM; nwg = nM * nN; G = G_; c = c_; }
    __host__ __device__ bool next(int i, Unit& u) const {
        const long L = (long)i * G + c; if (L >= nwg) return false;
        int wgid = (int)L; { const int q = nwg / NXCD, r = nwg % NXCD, xcd = wgid % NXCD, off = wgid / NXCD; wgid = (xcd < r ? xcd * (q + 1) : r * (q + 1) + (xcd - r) * q) + off; }
        const int nig = WGM * nN, gid = wgid / nig, fm = gid * WGM, gsz = (nM - fm) < WGM ? (nM - fm) : WGM;
        u.pm = fm + ((wgid % nig) % gsz); u.pn = (wgid % nig) / gsz; return true;
    }
    __device__ __forceinline__ void a_ready(const Unit&) const {}
    __device__ __forceinline__ void done(const Unit&) const {}
};

typedef float f32x2_cv __attribute__((ext_vector_type(2)));
typedef __bf16 bf16x2_cv __attribute__((ext_vector_type(2)));
__device__ __forceinline__ unsigned cvt_pk_bf16(float lo, float hi) { const f32x2_cv v = {lo, hi}; return __builtin_bit_cast(unsigned, __builtin_convertvector(v, bf16x2_cv)); }
typedef float f32x2 __attribute__((ext_vector_type(2)));
template <class Epi, class Sched, bool ALIGN_EPI = false, bool SP2 = false>
__device__ __forceinline__ void gemm_phase(PG8_LAS unsigned char* lds, const Gemm g, const Sched& S, const Epi& E, int tid_in) {
    int tid_ = tid_in; asm volatile("" : "+v"(tid_));
    const int tid = tid_, wid = __builtin_amdgcn_readfirstlane(tid >> 6), lane = tid & 63, wr = wid >> 2, wc = wid & 3, fr = lane & 15, fq = lane >> 4;
    const int K = g.K, nt = K / BK;
    unsigned voffA[2], voffB[2];
#pragma unroll
    for (int i = 0; i < 2; ++i) { int R, C; stage_rc(tid * 16 + i * 8192, R, C); const int Rb = Epi::PERM ? ((R & ~31) + perm32(R & 31)) : R;
        voffA[i] = (unsigned)(R * g.lda + C) * 2u; voffB[i] = (unsigned)(Rb * g.ldb + C) * 2u; }
    const size_t kstep = (size_t)(BK * 2), kstepB = g.ksb;
    const size_t hstepA = (size_t)HALF * g.lda * 2, hstepB = (size_t)HALF * g.ldb * 2;
    const size_t tstepA = 2 * hstepA, tstepB = 2 * hstepB;
    const unsigned ldsw = (unsigned)wid * 1024u;
    const int aoff = lds_byte(wr * 64 + fr, fq * 8), boff = lds_byte(wc * 32 + fr, fq * 8);
#define PG8_SA(b, h) (((b) * 2 + (h)) * HTB)
#define PG8_SB(b, h) ((4 + (b) * 2 + (h)) * HTB)
#define PG8_STAGE(bufoff, gbase, voff) do { _Pragma("unroll") for (int _i = 0; _i < 2; ++_i) \
        __builtin_amdgcn_global_load_lds((const unsigned*)((const char*)(gbase) + (voff)[_i]), (PG8_LAS unsigned*)(lds + (bufoff) + ldsw + _i * 8192), 16, 0, 0); } while (0)
#define PG8_LDA(dst, b, h) do { _Pragma("unroll") for (int m = 0; m < 4; ++m) _Pragma("unroll") for (int k = 0; k < 2; ++k) dst[m][k] = *(const PG8_LAS bf16x8*)(lds + PG8_SA(b, h) + aoff + m * 2048 + k * 1024); } while (0)
#define PG8_LDB(dst, b, h) do { _Pragma("unroll") for (int n = 0; n < 2; ++n) _Pragma("unroll") for (int k = 0; k < 2; ++k) dst[n][k] = *(const PG8_LAS bf16x8*)(lds + PG8_SB(b, h) + boff + n * 2048 + k * 1024); } while (0)
#define PG8_MMA(ai, bj, At, Bt) do { __builtin_amdgcn_s_setprio(1); _Pragma("unroll") for (int m = 0; m < 4; ++m) _Pragma("unroll") for (int n = 0; n < 2; ++n) _Pragma("unroll") for (int k = 0; k < 2; ++k) \
        acc[ai][bj][m][n] = __builtin_amdgcn_mfma_f32_16x16x32_bf16(Bt[n][k], At[m][k], acc[ai][bj][m][n], 0, 0, 0); __builtin_amdgcn_s_setprio(0); } while (0)
#define PG8_WAIT_V(n) asm volatile("s_waitcnt vmcnt(" #n ")" ::: "memory")
#define PG8_WAIT_L(n) asm volatile("s_waitcnt lgkmcnt(" #n ")" ::: "memory")
#define PG8_BAR __builtin_amdgcn_s_barrier()
#define PG8_SCHED __builtin_amdgcn_sched_barrier(0)
    Unit cur, nxt; int ui = 0;
    if (!S.next(0, cur)) return;
    f32x4 acc[2][2][4][2];
#pragma unroll
    for (int a = 0; a < 2; ++a)
#pragma unroll
        for (int b = 0; b < 2; ++b)
#pragma unroll
            for (int m = 0; m < 4; ++m)
#pragma unroll
                for (int n = 0; n < 2; ++n) acc[a][b][m][n] = (f32x4){0.f, 0.f, 0.f, 0.f};
    bf16x8 At[4][2], B0[2][2], B1[2][2];
    const char* cA = (const char*)g.A + (size_t)cur.pm * tstepA; const char* cB = (const char*)g.Bt + (size_t)cur.pn * tstepB;
    S.a_ready(cur);
    if constexpr (SP2) {
        PG8_STAGE(PG8_SB(0, 0), cB, voffB); PG8_STAGE(PG8_SB(0, 1), cB + hstepB, voffB); PG8_STAGE(PG8_SA(0, 0), cA, voffA); PG8_STAGE(PG8_SA(0, 1), cA + hstepA, voffA);
        if (wr == 1) PG8_BAR;
        PG8_WAIT_V(2); PG8_BAR;
        PG8_STAGE(PG8_SB(1, 0), cB + kstepB, voffB); PG8_STAGE(PG8_SA(1, 0), cA + kstep, voffA); PG8_STAGE(PG8_SB(1, 1), cB + hstepB + kstepB, voffB);
        PG8_WAIT_V(6); PG8_BAR;
    } else {
        PG8_STAGE(PG8_SB(0, 0), cB, voffB); PG8_STAGE(PG8_SA(0, 0), cA, voffA); PG8_STAGE(PG8_SB(0, 1), cB + hstepB, voffB); PG8_STAGE(PG8_SA(0, 1), cA + hstepA, voffA);
        if (wr == 1) PG8_BAR;
        PG8_WAIT_V(4); PG8_BAR;
        PG8_STAGE(PG8_SB(1, 0), cB + kstepB, voffB); PG8_STAGE(PG8_SA(1, 0), cA + kstep, voffA); PG8_STAGE(PG8_SB(1, 1), cB + hstepB + kstepB, voffB);
        PG8_WAIT_V(6); PG8_BAR;
    }
    for (;;) {
        const bool has_next = S.next(ui + 1, nxt);
        const char* nA = has_next ? (const char*)g.A + (size_t)nxt.pm * tstepA : cA; const char* nB = has_next ? (const char*)g.Bt + (size_t)nxt.pn * tstepB : cB;
        for (int t = 0; t < nt; t += 2) {
            const bool last = (t == nt - 2);
            const char* a1 = cA + (size_t)(t + 1) * kstep;
            const char* a2 = last ? nA : cA + (size_t)(t + 2) * kstep; const char* b2 = last ? nB : cB + (size_t)(t + 2) * kstepB;
            const char* a3 = a2 + kstep; const char* b3 = b2 + kstepB;
            if (last && has_next) S.a_ready(nxt);
            if constexpr (SP2) {
            PG8_LDB(B0, 0, 0); PG8_LDB(B1, 0, 1); PG8_SCHED; PG8_LDA(At, 0, 0); PG8_STAGE(PG8_SA(1, 1), a1 + hstepA, voffA);
            PG8_WAIT_V(8); PG8_WAIT_L(0); PG8_BAR; PG8_MMA(0, 0, At, B0); PG8_MMA(0, 1, At, B1); PG8_BAR; PG8_SCHED;
            PG8_LDA(At, 0, 1); PG8_STAGE(PG8_SB(0, 0), b2, voffB); PG8_STAGE(PG8_SB(0, 1), b2 + hstepB, voffB); PG8_STAGE(PG8_SA(0, 0), a2, voffA);
            PG8_WAIT_V(8); PG8_WAIT_L(0); PG8_BAR; PG8_MMA(1, 0, At, B0); PG8_MMA(1, 1, At, B1); PG8_BAR; PG8_SCHED;
            PG8_LDB(B0, 1, 0); PG8_LDB(B1, 1, 1); PG8_SCHED; PG8_LDA(At, 1, 0); PG8_STAGE(PG8_SA(0, 1), a2 + hstepA, voffA);
            PG8_WAIT_V(8); PG8_WAIT_L(0); PG8_BAR; PG8_MMA(0, 0, At, B0); PG8_MMA(0, 1, At, B1); PG8_BAR; PG8_SCHED;
            PG8_LDA(At, 1, 1); PG8_STAGE(PG8_SB(1, 0), b3, voffB); PG8_STAGE(PG8_SB(1, 1), b3 + hstepB, voffB); PG8_STAGE(PG8_SA(1, 0), a3, voffA);
            PG8_WAIT_V(8); PG8_WAIT_L(0); PG8_BAR; PG8_MMA(1, 0, At, B0); PG8_MMA(1, 1, At, B1); PG8_BAR; PG8_SCHED;
            } else {
            PG8_LDB(B0, 0, 0); PG8_SCHED; PG8_LDA(At, 0, 0); PG8_STAGE(PG8_SA(1, 1), a1 + hstepA, voffA);
            PG8_WAIT_L(8); PG8_BAR; PG8_WAIT_L(0); PG8_MMA(0, 0, At, B0); PG8_BAR; PG8_SCHED;
            PG8_LDB(B1, 0, 1); PG8_STAGE(PG8_SB(0, 0), b2, voffB);
            PG8_BAR; PG8_WAIT_L(0); PG8_MMA(0, 1, At, B1); PG8_BAR;
            PG8_LDA(At, 0, 1); PG8_STAGE(PG8_SA(0, 0), a2, voffA);
            PG8_BAR; PG8_WAIT_L(0); PG8_MMA(1, 0, At, B0); PG8_BAR; PG8_SCHED;
            PG8_STAGE(PG8_SB(0, 1), b2 + hstepB, voffB);
            PG8_WAIT_V(6); PG8_BAR; PG8_MMA(1, 1, At, B1); PG8_BAR;
            PG8_LDB(B0, 1, 0); PG8_SCHED; PG8_LDA(At, 1, 0); PG8_STAGE(PG8_SA(0, 1), a2 + hstepA, voffA);
            PG8_WAIT_L(8); PG8_BAR; PG8_WAIT_L(0); PG8_MMA(0, 0, At, B0); PG8_BAR; PG8_SCHED;
            PG8_LDB(B1, 1, 1); PG8_STAGE(PG8_SB(1, 0), b3, voffB);
            PG8_BAR; PG8_WAIT_L(0); PG8_MMA(0, 1, At, B1); PG8_BAR;
            PG8_LDA(At, 1, 1); PG8_STAGE(PG8_SA(1, 0), a3, voffA);
            PG8_BAR; PG8_WAIT_L(0); PG8_MMA(1, 0, At, B0); PG8_BAR; PG8_SCHED;
            PG8_STAGE(PG8_SB(1, 1), b3 + hstepB, voffB);
            PG8_WAIT_V(6); PG8_BAR; PG8_MMA(1, 1, At, B1); PG8_BAR;
            }
        }
        if constexpr (ALIGN_EPI) { if (wr == 0) PG8_BAR; }
        if constexpr (!Epi::AFTER_DRAIN) { E(acc, cur, wr, wc, fr, fq); S.done(cur); }
        if (!has_next) break;
#pragma unroll
        for (int a = 0; a < 2; ++a)
#pragma unroll
            for (int b = 0; b < 2; ++b)
#pragma unroll
                for (int m = 0; m < 4; ++m)
#pragma unroll
                    for (int n = 0; n < 2; ++n) acc[a][b][m][n] = (f32x4){0.f, 0.f, 0.f, 0.f};
        cur = nxt; cA = nA; cB = nB; ++ui;
        if constexpr (ALIGN_EPI) { if (wr == 1) PG8_BAR; }
    }
    PG8_WAIT_V(0);
    if constexpr (!ALIGN_EPI) { if (wr == 0) PG8_BAR; }
    PG8_BAR;
    if constexpr (Epi::AFTER_DRAIN) { E.fused(acc, cur, wr, wc, fr, fq, lds, wid, lane); S.done(cur); }
#undef PG8_SA
#undef PG8_SB
#undef PG8_STAGE
#undef PG8_LDA
#undef PG8_LDB
#undef PG8_MMA
#undef PG8_WAIT_V
#undef PG8_WAIT_L
#undef PG8_BAR
#undef PG8_SCHED
}
}

constexpr int DM = 2048, SEQ = 2048, NB = 4, NS = 128, DEPTH = 2;
constexpr int MP = NB * SEQ;
constexpr int MT = MP + NS;
constexpr int MPAD = MP + 256;
constexpr int PIN = 6400, DFF = 8192, NMEM = 256, MMEM = NB * NMEM;
constexpr int PB_ = 1536, PC_ = 3584, PD_ = 5376;
constexpr int SHW = 1792;
constexpr int LDU = 8192;
constexpr int NWAVES = 8;
constexpr int NIN = 39;

constexpr size_t O_YP = 0, O_YS = O_YP + (size_t)MP * DM, O_CAP = O_YS + (size_t)NS * DM, O_CAS = O_CAP + (size_t)DEPTH * NB * 2 * 512,
    O_RETP = O_CAS + (size_t)DEPTH * NS * 2 * 512, O_RETS = O_RETP + (size_t)DEPTH * NB * 4 * 128 * 128, O_SHP = O_RETS + (size_t)DEPTH * NS * 4 * 128 * 128,
    O_SHS = O_SHP + (size_t)DEPTH * NB * SHW, O_WKVP = O_SHS + (size_t)DEPTH * NS * SHW, O_WKVS = O_WKVP + (size_t)DEPTH * NB * 8 * 64 * 64,
    O_CDP = O_WKVS + (size_t)DEPTH * NS * 8 * 64 * 64, O_CDS = O_CDP + (size_t)DEPTH * NB * 30 * 512, O_MKP = O_CDS + (size_t)DEPTH * NS * 30 * 512,
    O_MVP = O_MKP + (size_t)DEPTH * MMEM * DM, O_END = O_MVP + (size_t)DEPTH * MMEM * DM;
static_assert(O_END == 56178688, "d_out size");

constexpr size_t MiB = 1u << 20;
constexpr size_t al256(size_t x) { return (x + 255) & ~(size_t)255; }
constexpr size_t WS_CTL = 0, CTL_ZERO_BYTES = 1 * MiB;
constexpr size_t WS_ROPE = 1 * MiB;
constexpr size_t SZ_WIN = (size_t)PIN * DM * 2, SZ_SQ = (size_t)DM * DM * 2, SZ_WUP = (size_t)DFF * DM * 2, SZ_WDN = (size_t)DM * LDU * 2;
constexpr size_t LW_IN = 0, LW_OUT = LW_IN + SZ_WIN, LW_Q = LW_OUT + SZ_SQ, LW_O = LW_Q + SZ_SQ, LW_UP = LW_O + SZ_SQ, LW_DN = LW_UP + SZ_WUP,
    LW_W2 = LW_DN + SZ_WDN, LW_A2 = LW_W2 + 512 * 64 * 2, LW_G2 = LW_A2 + 512 * 64 * 2, LW_STRIDE = LW_G2 + 512 * 128 * 2;
constexpr size_t WS_WL = 4 * MiB;
constexpr size_t WS_WKV = al256(WS_WL + 2 * LW_STRIDE);
constexpr size_t WS_XF = al256(WS_WKV + (size_t)8192 * DM * 2);
constexpr size_t WS_HN = al256(WS_XF + (size_t)MT * DM * 4);
constexpr size_t WS_MN = al256(WS_HN + (size_t)MPAD * DM * 2);
constexpr size_t WS_MK = al256(WS_MN + (size_t)MMEM * DM * 2);
constexpr size_t WS_MVT = al256(WS_MK + (size_t)2 * MMEM * DM * 2);
constexpr size_t WS_P = al256(WS_MVT + (size_t)2 * MMEM * DM * 2);
constexpr size_t WS_YC = al256(WS_P + (size_t)MPAD * PIN * 2);
constexpr size_t WS_Q = al256(WS_YC + (size_t)MT * DM * 2);
constexpr size_t WS_O = al256(WS_Q + (size_t)MT * DM * 2);
constexpr size_t WS_U = al256(WS_O + (size_t)MT * DM * 2);
constexpr size_t WS_RW = al256(WS_U + (size_t)MT * LDU * 2);
constexpr size_t WS_GATE = al256(WS_RW + (size_t)MT * 8 * 896);
constexpr size_t WS_OC = al256(WS_GATE + (size_t)MT * 512 * 4);
constexpr size_t WS_KVT = al256(WS_OC + (size_t)MT * 512 * 4);
constexpr size_t WS_SSQ = al256(WS_KVT + (size_t)16 * 16 * 128 * 128 * 4);
constexpr size_t WS_SPL = al256(WS_SSQ + (size_t)MP * 8 * 4);
constexpr size_t WS_STB = al256(WS_SPL + (size_t)2 * NS * DM * 4);
constexpr size_t WS_CK = al256(WS_STB + (size_t)16 * 16 * 128 * 128 * 2);
constexpr size_t WS_CP = al256(WS_CK + (size_t)4096 * 6912);
constexpr int DMS = DM + 128, LDUS = LDU + 128;
constexpr size_t WS_HNS = al256(WS_CP + (size_t)4096 * 4 * 3072);
constexpr size_t WS_OS = al256(WS_HNS + (size_t)NS * DMS * 2);
constexpr size_t WS_US = al256(WS_OS + (size_t)NS * DMS * 2);
constexpr size_t WS_END = al256(WS_US + (size_t)NS * LDUS * 2);
static_assert(WS_END < (size_t)1700 * MiB, "d_ws map");
constexpr int CW_BAR = 4096;

constexpr int SCR_BYTES = 147456;
constexpr int MISC_OFF = SCR_BYTES;
constexpr int LDS_BYTES = SCR_BYTES + 1024;

#define GAS __attribute__((address_space(1)))
#define LAS __attribute__((address_space(3)))
typedef unsigned short bf16;
typedef unsigned v4u __attribute__((ext_vector_type(4)));
typedef unsigned v2u __attribute__((ext_vector_type(2)));
typedef float f32x4 __attribute__((ext_vector_type(4)));
typedef float f32x2 __attribute__((ext_vector_type(2)));
typedef short bf16x8 __attribute__((ext_vector_type(8)));
typedef short bf16x4 __attribute__((ext_vector_type(4)));
typedef GAS unsigned gu32;
#define RLX_AGENT __ATOMIC_RELAXED, __HIP_MEMORY_SCOPE_AGENT
#define LDS_WAIT() asm volatile("s_waitcnt lgkmcnt(0)" ::: "memory")
#define VM_WAIT() asm volatile("s_waitcnt vmcnt(0)" ::: "memory")
__device__ __forceinline__ unsigned pk2(float lo, float hi) { return pg8::cvt_pk_bf16(lo, hi); }
__device__ __forceinline__ float bflo(unsigned w) { return __uint_as_float(w << 16); }
__device__ __forceinline__ float bfhi(unsigned w) { return __uint_as_float(w & 0xffff0000u); }
__device__ __forceinline__ float bf1(bf16 h) { return __uint_as_float(((unsigned)h) << 16); }
__device__ __forceinline__ void unpack8(const v4u w, float (&f)[8]) { f[0] = bflo(w.x); f[1] = bfhi(w.x); f[2] = bflo(w.y); f[3] = bfhi(w.y); f[4] = bflo(w.z); f[5] = bfhi(w.z); f[6] = bflo(w.w); f[7] = bfhi(w.w); }
__device__ __forceinline__ void unpack4(const v2u w, float (&f)[4]) { f[0] = bflo(w.x); f[1] = bfhi(w.x); f[2] = bflo(w.y); f[3] = bfhi(w.y); }
__device__ __forceinline__ v4u pack8(const float (&f)[8]) { v4u w; w.x = pk2(f[0], f[1]); w.y = pk2(f[2], f[3]); w.z = pk2(f[4], f[5]); w.w = pk2(f[6], f[7]); return w; }
__device__ __forceinline__ float sigm(float x) { return 1.0f / (1.0f + __expf(-x)); }
__device__ __forceinline__ float wave_sum(float v) {
#pragma unroll
    for (int o = 1; o < 64; o <<= 1) v += __shfl_xor(v, o);
    return v;
}
__device__ __forceinline__ float wave_max(float v) {
#pragma unroll
    for (int o = 1; o < 64; o <<= 1) v = fmaxf(v, __shfl_xor(v, o));
    return v;
}
template <int CTRL> __device__ __forceinline__ float dpp_f(float v) { return __builtin_bit_cast(float, __builtin_amdgcn_update_dpp(0, __builtin_bit_cast(int, v), CTRL, 0xf, 0xf, false)); }
__device__ __forceinline__ f32x4 zero4() { float z0, z1, z2, z3; asm volatile("v_mov_b32 %0, 0\n\tv_mov_b32 %1, 0\n\tv_mov_b32 %2, 0\n\tv_mov_b32 %3, 0\n\ts_nop 1" : "=v"(z0), "=v"(z1), "=v"(z2), "=v"(z3)); return (f32x4){z0, z1, z2, z3}; }
__device__ __forceinline__ float rowsum16(float v) { v += dpp_f<0x128>(v); v += dpp_f<0x124>(v); v += dpp_f<0x122>(v); v += dpp_f<0x121>(v); return v; }

namespace pg8 {
template <int ACT> struct EpiBf16A {
    static constexpr bool PERM = true, AFTER_DRAIN = false;
    bf16_t* O; int ldc; const float* ssq;
    __device__ __forceinline__ void operator()(const f32x4 (&acc)[2][2][4][2], const Unit& u, int wr, int wc, int fr, int fq) const {
        const int row0 = u.pm * BM + wr * 64 + fr, col0 = u.pn * BM + wc * 32 + 8 * fq;
#pragma unroll
        for (int ai = 0; ai < 2; ++ai)
#pragma unroll
            for (int m = 0; m < 4; ++m) { bf16_t* rowp = O + (size_t)(row0 + ai * HALF + m * 16) * ldc + col0;
                const float rs = ssq ? 1.0f / sqrtf(ssq[row0 + ai * HALF + m * 16] * (1.0f / 2048.0f) + 1e-6f) : 1.0f;
#pragma unroll
                for (int bj = 0; bj < 2; ++bj) { f32x4 v0 = acc[ai][bj][m][0] * rs, v1 = acc[ai][bj][m][1] * rs;
                    if (ACT == 3) {
#pragma unroll
                        for (int j = 0; j < 4; ++j) { const float a = fmaxf(v0[j], 0.f), b = fmaxf(v1[j], 0.f); v0[j] = a * a; v1[j] = b * b; } }
                    u32x4 w; w.x = cvt_pk_bf16(v0[0], v0[1]); w.y = cvt_pk_bf16(v0[2], v0[3]); w.z = cvt_pk_bf16(v1[0], v1[1]); w.w = cvt_pk_bf16(v1[2], v1[3]);
                    *(u32x4*)(rowp + bj * HALF) = w; } }
    }
};
struct EpiRes {
    static constexpr bool PERM = false, AFTER_DRAIN = false;
    float* X; int ldc; float sc; const float* Xin;
    __device__ __forceinline__ void operator()(const f32x4 (&acc)[2][2][4][2], const Unit& u, int wr, int wc, int fr, int fq) const {
        const int row0 = u.pm * BM + wr * 64 + fr, col0 = u.pn * BM + wc * 32 + 4 * fq;
#pragma unroll
        for (int ai = 0; ai < 2; ++ai)
#pragma unroll
            for (int m = 0; m < 4; ++m) { float* rowp = X + (size_t)(row0 + ai * HALF + m * 16) * ldc + col0; const float* inp = Xin + (size_t)(row0 + ai * HALF + m * 16) * ldc + col0;
                f32x4 o[2][2];
#pragma unroll
                for (int bj = 0; bj < 2; ++bj)
#pragma unroll
                    for (int n = 0; n < 2; ++n) o[bj][n] = *(const f32x4*)(inp + bj * HALF + n * 16);
#pragma unroll
                for (int bj = 0; bj < 2; ++bj)
#pragma unroll
                    for (int n = 0; n < 2; ++n) *(f32x4*)(rowp + bj * HALF + n * 16) = o[bj][n] + acc[ai][bj][m][n] * sc; }
    }
};
struct EpiMemKV {
    static constexpr bool PERM = false, AFTER_DRAIN = false;
    float* outK; bf16_t* MKb; bf16_t* MVT;
    __device__ __forceinline__ void operator()(const f32x4 (&acc)[2][2][4][2], const Unit& u, int wr, int wc, int fr, int fq) const {
        const int cbase = u.pn * BM, lyr = cbase >> 12, cc = cbase & 4095; const bool isV = cc >= 2048; const int colt = cc & 2047;
        const int row0 = u.pm * BM + wr * 64 + fr, col0 = colt + wc * 32 + 4 * fq;
        float* outp = outK + (isV ? (size_t)(O_MVP - O_MKP) : (size_t)0);
#pragma unroll
        for (int ai = 0; ai < 2; ++ai)
#pragma unroll
            for (int m = 0; m < 4; ++m) { const int r = row0 + ai * HALF + m * 16;
#pragma unroll
                for (int bj = 0; bj < 2; ++bj)
#pragma unroll
                    for (int n = 0; n < 2; ++n) { const int col = col0 + bj * HALF + n * 16; const f32x4 v = acc[ai][bj][m][n];
                        *(f32x4*)(outp + ((size_t)lyr * 1024 + r) * 2048 + col) = v;
                        if (!isV) { unsigned lo = cvt_pk_bf16(v[0], v[1]), hi = cvt_pk_bf16(v[2], v[3]); *(unsigned long long*)(MKb + ((size_t)lyr * 1024 + r) * 2048 + col) = ((unsigned long long)hi << 32) | lo; }
                        else { const int b = r >> 8, j = r & 255, h = col >> 9, e = col & 511; bf16_t* tp = MVT + ((((size_t)lyr * 4 + b) * 4 + h) * 512 + e) * 256 + j;
                            const unsigned lo = cvt_pk_bf16(v[0], v[1]), hi = cvt_pk_bf16(v[2], v[3]);
                            tp[0] = (bf16_t)(lo & 0xffffu); tp[256] = (bf16_t)(lo >> 16); tp[512] = (bf16_t)(hi & 0xffffu); tp[768] = (bf16_t)(hi >> 16); } } }
    }
};
}

struct SEpiBf16 { bf16* O; int ldc; int act; const float* ssq;
    __device__ __forceinline__ void operator()(int row, int col0, f32x4 v, int) const {
        if (ssq) v = v * (1.0f / sqrtf(ssq[row] * (1.0f / 2048.0f) + 1e-6f));
        if (act == 3) {
#pragma unroll
            for (int j = 0; j < 4; ++j) { const float a = fmaxf(v[j], 0.f); v[j] = a * a; } }
        v2u w; w.x = pk2(v[0], v[1]); w.y = pk2(v[2], v[3]); *(v2u*)(O + (size_t)row * ldc + col0) = w; } };
struct SEpiRes { float* X; int ldc; float sc; const float* Xin;
    __device__ __forceinline__ void operator()(int row, int col0, f32x4 v, int) const { *(f32x4*)(X + (size_t)row * ldc + col0) = *(const f32x4*)(Xin + (size_t)row * ldc + col0) + v * sc; } };
struct SEpiPart { float* S; int ldc;
    __device__ __forceinline__ void operator()(int row, int col0, f32x4 v, int kp) const { *(f32x4*)(S + ((size_t)kp * NS + row) * ldc + col0) = v; } };
template <class F> __device__ __forceinline__ void sample_gemm(LAS unsigned char* lds, int tid_in, const bf16* A, int lda, const bf16* Bt, int ntot, int N, int K, int G, int bid, const F& epi, int nks = 1) {
    int tid_ = tid_in; asm volatile("" : "+v"(tid_));
    const int lane = tid_ & 63, wave = __builtin_amdgcn_readfirstlane(tid_ >> 6), fr = lane & 15, fq = lane >> 4;
    const int KS = (K / nks) >> 3, ncu = N / 16;
    LAS f32x4* red = (LAS f32x4*)lds;
    const unsigned voffa = (unsigned)(fr * lda + fq * 8) * 2u, voffb = (unsigned)(fr * 64 + fq * 8) * 2u;
    for (int uu = bid; uu < ncu * nks; uu += G) { const int kp = uu / ncu, u = uu - kp * ncu, kbeg = kp * (K / nks) + wave * KS;
        const char* bp = (const char*)(Bt + ((size_t)(kbeg >> 6) * ntot + u * 16) * 64);
        const char* ap = (const char*)(A + kbeg);
        f32x4 acc[8];
#pragma unroll
        for (int rt = 0; rt < 8; ++rt) acc[rt] = zero4();
        bf16x8 b0[2], a0[2][8], b1[2], a1[2][8];
#define SG_LOAD(bb, aa, kq) do { _Pragma("unroll") for (int s = 0; s < 2; ++s) { bb[s] = *(const bf16x8*)(bp + ((size_t)((kq) >> 6) * ntot * 64 + 32 * s) * 2 + voffb); \
            _Pragma("unroll") for (int rt = 0; rt < 8; ++rt) aa[s][rt] = *(const bf16x8*)(ap + ((size_t)rt * 16 * lda + (kq) + 32 * s) * 2 + voffa); } } while (0)
#define SG_MMA(bb, aa) do { _Pragma("unroll") for (int s = 0; s < 2; ++s) _Pragma("unroll") for (int rt = 0; rt < 8; ++rt) acc[rt] = __builtin_amdgcn_mfma_f32_16x16x32_bf16(bb[s], aa[s][rt], acc[rt], 0, 0, 0); } while (0)
        SG_LOAD(b0, a0, 0);
        for (int k0 = 0; k0 < KS; k0 += 128) {
            __builtin_amdgcn_sched_barrier(0);
            SG_LOAD(b1, a1, k0 + 64);
            __builtin_amdgcn_sched_barrier(0);
            SG_MMA(b0, a0);
            __builtin_amdgcn_sched_barrier(0);
            if (k0 + 128 < KS) SG_LOAD(b0, a0, k0 + 128);
            __builtin_amdgcn_sched_barrier(0);
            SG_MMA(b1, a1);
        }
        __builtin_amdgcn_sched_barrier(0);
#undef SG_LOAD
#undef SG_MMA
#pragma unroll
        for (int rt = 0; rt < 8; ++rt) red[(wave * 8 + rt) * 64 + lane] = acc[rt];
        __syncthreads();
        f32x4 sum = red[wave * 64 + lane];
#pragma unroll
        for (int ks = 1; ks < 8; ++ks) sum += red[(ks * 8 + wave) * 64 + lane];
        epi(wave * 16 + fr, u * 16 + 4 * fq, sum, kp);
        __syncthreads();
    }
}
#define XB_TMO      128
#define XB_XCNT(j)  (256  + 64 * (j))
#define XB_XSUB(j)  (1280 + 64 * (j))
#define XB_XGEN(j)  (2304 + 64 * (j))
#define XB_TOP      3328
#define XB_TOPGEN   3392
#define XCD_BAR_WORDS 3456
#define XB_SPIN_CAP (1u << 18)

__device__ __forceinline__ unsigned xb_ld(unsigned* p)              { return __hip_atomic_load(p, __ATOMIC_RELAXED, __HIP_MEMORY_SCOPE_AGENT); }
__device__ __forceinline__ unsigned xb_add(unsigned* p, unsigned v) { return __hip_atomic_fetch_add(p, v, __ATOMIC_RELAXED, __HIP_MEMORY_SCOPE_AGENT); }
__device__ __forceinline__ unsigned xb_xcc_id() { return (unsigned)__builtin_amdgcn_s_getreg((3 << 11) | 20) & 0xFu; }
#define XB_SPIN(cond, bar) do { unsigned _sp = 0; while (cond) { __builtin_amdgcn_s_sleep(1); \
    if ((++_sp & 255u) == 0u) { if (xb_ld(&(bar)[XB_TMO])) break; if (_sp > XB_SPIN_CAP) { atomicAdd(&(bar)[XB_TMO], 1u); break; } } } } while (0)

struct XcdBarrier {
    int wave;
    unsigned* bar; unsigned x;
    volatile LAS unsigned* st;
};

__device__ __forceinline__ XcdBarrier xcd_barrier_post(unsigned* bar, volatile LAS unsigned* st) {
    XcdBarrier b; b.bar = bar; b.x = xb_xcc_id(); b.st = st;
    if (threadIdx.x == 0) (void)xb_add(&bar[XB_XCNT(b.x)], 1u);
    return b;
}
__device__ __forceinline__ void xcd_barrier_complete(unsigned* bar, unsigned x, unsigned& nloc, unsigned& nx) {
    const unsigned G = gridDim.x * gridDim.y * gridDim.z;
    unsigned sum, cnt, mine, sp = 0u;
    for (;;) {
        sum = 0u; cnt = 0u; mine = 0u;
#pragma unroll
        for (unsigned j = 0; j < 16; ++j) { const unsigned c = xb_ld(&bar[XB_XCNT(j)]); sum += c; cnt += (c > 0u) ? 1u : 0u; mine = (j == x) ? c : mine; }
        if (sum == G) break;
        __builtin_amdgcn_s_sleep(1);
        if ((++sp & 255u) == 0u) { if (xb_ld(&bar[XB_TMO])) break; if (sp > XB_SPIN_CAP) { atomicAdd(&bar[XB_TMO], 1u); break; } }
    }
    nloc = mine > 0u ? mine : 1u; nx = cnt > 0u ? cnt : 1u;
}

__device__ __forceinline__ void xcd_barrier(const XcdBarrier& b) {
    asm volatile("s_waitcnt vmcnt(0)" ::: "memory");
    __syncthreads();
    unsigned xbz = 0u; asm volatile("" : "+v"(xbz));
    if (b.wave == 0 && __builtin_amdgcn_mbcnt_hi(~0u, __builtin_amdgcn_mbcnt_lo(~0u, xbz)) == 0u) {
        unsigned* bar = b.bar;
        __builtin_amdgcn_s_waitcnt(0);
        unsigned nloc = b.st[0], nx = b.st[1];
        if (nloc == 0u) { xcd_barrier_complete(bar, b.x, nloc, nx); b.st[0] = nloc; b.st[1] = nx; }
        const unsigned old = xb_add(&bar[XB_XSUB(b.x)], 1u);
        const unsigned gen = old / nloc;
        if (old + 1u == (gen + 1u) * nloc) {
            __builtin_amdgcn_fence(__ATOMIC_RELEASE, "agent");
            asm volatile("s_waitcnt vmcnt(0)" ::: "memory");
            const unsigned og = xb_add(&bar[XB_TOP], 1u);
            const unsigned tg = og / nx;
            if (og + 1u == (tg + 1u) * nx) xb_add(&bar[XB_TOPGEN], 1u);
            else XB_SPIN(xb_ld(&bar[XB_TOPGEN]) == tg, bar);
            __builtin_amdgcn_fence(__ATOMIC_ACQUIRE, "agent");
            xb_add(&bar[XB_XGEN(b.x)], 1u);
            asm volatile("s_waitcnt vmcnt(0)" ::: "memory");
        } else {
            XB_SPIN(xb_ld(&bar[XB_XGEN(b.x)]) == gen, bar);
            __builtin_amdgcn_fence(__ATOMIC_ACQUIRE, "agent");
            asm volatile("s_waitcnt vmcnt(0)" ::: "memory");
        }
    }
    __syncthreads();
}

struct Args { const float* in[NIN]; float* out; unsigned char* ws; int ph_lo, ph_hi; };
enum { I_XP = 0, I_XS, I_MEM, I_SCA, I_SRET, I_SSH, I_SWKV, I_SCD, I_CMK, I_CMV, I_GMIX, I_WIN, I_CAW, I_MU, I_W0, I_W2, I_A0, I_A2, I_G2, I_KK, I_KA, I_RK, I_LNXG, I_LNXB,
       I_CDW, I_CDB, I_LNDG, I_LNDB, I_WOUT, I_GXA, I_GMEM, I_WQ, I_WK, I_WV, I_WO, I_GMLP, I_WUP, I_WDN, I_GFIN };

struct Ctx { LAS unsigned char* lds; int tid, lane, wave, G, bid; };
typedef const GAS float* gcfp;
#define CAS __attribute__((address_space(4)))
struct Ax { const CAS gcfp* kp; float* out; unsigned char* ws;
    __device__ __forceinline__ const float* in(int i) const { return (const float*)kp[i]; } };
__device__ __forceinline__ Ax mk_ax() { const CAS gcfp* kp = (const CAS gcfp*)__builtin_amdgcn_kernarg_segment_ptr(); asm volatile("" : "+s"(kp)); Ax a; a.kp = kp;
    a.out = (float*)(GAS float*)kp[NIN]; a.ws = (unsigned char*)(GAS unsigned char*)kp[NIN + 1]; return a; }
__device__ __forceinline__ Ctx mk_ctx(LAS unsigned char* lds, int wave_s) { unsigned z = 0u; asm volatile("" : "+v"(z)); int t = wave_s * 64 + (int)__builtin_amdgcn_mbcnt_hi(~0u, __builtin_amdgcn_mbcnt_lo(~0u, z)); Ctx C; C.lds = lds; C.tid = t; C.lane = t & 63; C.wave = __builtin_amdgcn_readfirstlane(t >> 6); C.G = gridDim.x; C.bid = blockIdx.x; return C; }

__device__ __forceinline__ void p0_transpose_item(const float* W, int K, int N, bf16* WT, int ldk, int row_off, LAS float* scr, int item, int lane, const float* gain) {
    const int nblk = N / 64, kb = item / nblk, nb = item - kb * nblk, k0 = 64 * kb, n0 = 64 * nb;
    const int lr = lane >> 4, lc = (lane & 15) * 4;
#pragma unroll 8
    for (int i = 0; i < 16; ++i) { const int kk = 4 * i + lr; const float g = gain ? gain[k0 + kk] : 1.0f; const f32x4 v = *(const f32x4*)(W + (size_t)(k0 + kk) * N + n0 + lc);
        LAS float* d = scr + kk * 65 + lc; d[0] = v.x * g; d[1] = v.y * g; d[2] = v.z * g; d[3] = v.w * g; }
    LDS_WAIT(); asm volatile("" ::: "memory");
    const int c = lane & 7;
#pragma unroll
    for (int j = 0; j < 8; ++j) { const int n = (lane >> 3) + 8 * j; const LAS float* s = scr + (8 * c) * 65 + n;
        v4u o; o.x = pk2(s[0 * 65], s[1 * 65]); o.y = pk2(s[2 * 65], s[3 * 65]); o.z = pk2(s[4 * 65], s[5 * 65]); o.w = pk2(s[6 * 65], s[7 * 65]);
        if (ldk > 0) *(v4u*)(WT + (size_t)(row_off + n0 + n) * ldk + k0 + 8 * c) = o;
        else *(v4u*)(WT + ((size_t)kb * (size_t)(-ldk) + row_off + n0 + n) * 64 + 8 * c) = o; }
    LDS_WAIT(); asm volatile("" ::: "memory");
}
__device__ __forceinline__ void rms_row(const float* xrow, bf16* orow, float* xcopy, int lane) {
    const f32x4* xr = (const f32x4*)xrow + lane;
    f32x4 v[8]; float s = 0.f;
#pragma unroll
    for (int j = 0; j < 8; ++j) { v[j] = xr[64 * j]; s += (v[j].x * v[j].x + v[j].y * v[j].y) + (v[j].z * v[j].z + v[j].w * v[j].w); }
    const float rs = 1.0f / sqrtf(wave_sum(s) * (1.0f / DM) + 1e-6f);
    if (xcopy) {
#pragma unroll
        for (int j = 0; j < 8; ++j) ((f32x4*)xcopy + lane)[64 * j] = v[j]; }
    unsigned long long* o8 = (unsigned long long*)orow + lane;
#pragma unroll
    for (int j = 0; j < 8; ++j) o8[64 * j] = (unsigned long long)pk2(v[j].x * rs, v[j].y * rs) | ((unsigned long long)pk2(v[j].z * rs, v[j].w * rs) << 32);
}
__device__ __forceinline__ void rms_phase(const Ctx& C, const float* X, bf16* HN, bf16* HNS) {
    const int gw = C.bid * NWAVES + C.wave, NGW = C.G * NWAVES;
    f32x4 v[8], nx[8]; int m = gw;
    if (m < MT) { const f32x4* xr = (const f32x4*)(X + (size_t)m * DM) + C.lane;
#pragma unroll
        for (int j = 0; j < 8; ++j) v[j] = xr[64 * j]; }
    for (; m < MT; m += NGW) {
        const int mn = m + NGW;
        if (mn < MT) { const f32x4* xr = (const f32x4*)(X + (size_t)mn * DM) + C.lane;
#pragma unroll
            for (int j = 0; j < 8; ++j) nx[j] = xr[64 * j]; }
        float s = 0.f;
#pragma unroll
        for (int j = 0; j < 8; ++j) s += (v[j].x * v[j].x + v[j].y * v[j].y) + (v[j].z * v[j].z + v[j].w * v[j].w);
        const float rs = 1.0f / sqrtf(wave_sum(s) * (1.0f / DM) + 1e-6f);
        unsigned long long* o8 = (unsigned long long*)((HNS && m >= MP) ? HNS + (size_t)(m - MP) * DMS : HN + (size_t)m * DM) + C.lane;
#pragma unroll
        for (int j = 0; j < 8; ++j) o8[64 * j] = (unsigned long long)pk2(v[j].x * rs, v[j].y * rs) | ((unsigned long long)pk2(v[j].z * rs, v[j].w * rs) << 32);
#pragma unroll
        for (int j = 0; j < 8; ++j) v[j] = nx[j];
    }
}
__device__ __forceinline__ void fold_split_rows(const Ctx& C, float* X, const float* S) {
    const int gw = C.bid * NWAVES + C.wave, NGW = C.G * NWAVES;
    for (int r = gw; r < NS; r += NGW) { f32x4* xr = (f32x4*)(X + (size_t)(MP + r) * DM) + C.lane; const f32x4* s0 = (const f32x4*)(S + (size_t)r * DM) + C.lane; const f32x4* s1 = (const f32x4*)(S + (size_t)(NS + r) * DM) + C.lane;
#pragma unroll
        for (int j = 0; j < 8; ++j) xr[64 * j] = xr[64 * j] + (s0[64 * j] + s1[64 * j]); }
    asm volatile("s_waitcnt vmcnt(0)" ::: "memory");
}
__device__ __forceinline__ void final_norm_phase(const Ctx& C, const float* X, const float* g, float* out) {
    const int gw = C.bid * NWAVES + C.wave, NGW = C.G * NWAVES;
    for (int m = gw; m < MT; m += NGW) {
        const f32x4* xr = (const f32x4*)(X + (size_t)m * DM) + C.lane; const f32x4* gr = (const f32x4*)g + C.lane;
        f32x4 v[8]; float s = 0.f;
#pragma unroll
        for (int j = 0; j < 8; ++j) { v[j] = xr[64 * j]; s += (v[j].x * v[j].x + v[j].y * v[j].y) + (v[j].z * v[j].z + v[j].w * v[j].w); }
        const float rs = 1.0f / sqrtf(wave_sum(s) * (1.0f / DM) + 1e-6f);
        f32x4* orow = (f32x4*)(out + (size_t)m * DM) + C.lane;
#pragma unroll
        for (int j = 0; j < 8; ++j) orow[64 * j] = v[j] * rs * gr[64 * j];
    }
}
#ifndef LATE_EXTRA
#define LATE_EXTRA 0
#endif
struct TDesc { const float* W; const float* gain; bf16* WT; int K, N, ldk, row_off, item; };
__device__ __forceinline__ TDesc p0_desc(const Ax& a, int it, int G) {
    constexpr int I_IN = 32 * 100, I_SQ = 32 * 32, I_UP = 32 * 128, I_DN = 128 * 32, I_L64 = 8, I_L128 = 16;
    constexpr int PER_LAYER = I_IN + 5 * I_SQ + I_UP + I_DN + 2 * I_L64 + I_L128;
    const int l = it / PER_LAYER; int r = it - l * PER_LAYER; unsigned char* wl = a.ws + WS_WL + (size_t)l * LW_STRIDE; bf16* wkv = (bf16*)(a.ws + WS_WKV);
    TDesc d; d.row_off = 0; d.gain = nullptr; const bool late = G == 256 && DEPTH == 2, late1 = late && l == 1 && LATE_EXTRA;
    if (r < I_IN) { d.W = a.in(I_WIN) + (size_t)l * DM * PIN; d.K = DM; d.N = PIN; d.WT = (bf16*)(wl + LW_IN); d.ldk = -PIN; d.gain = a.in(I_GMIX) + l * DM; d.item = r; return d; } r -= I_IN;
    if (r < I_SQ) { d.W = a.in(I_WOUT) + (size_t)l * DM * DM; d.K = DM; d.N = DM; d.WT = (bf16*)(wl + LW_OUT); d.ldk = -DM; d.item = late1 ? -1 : r; return d; } r -= I_SQ;
    if (r < I_SQ) { d.W = a.in(I_WQ) + (size_t)l * DM * DM; d.K = DM; d.N = DM; d.WT = (bf16*)(wl + LW_Q); d.ldk = -DM; d.gain = a.in(I_GXA) + l * DM; d.item = late1 ? -1 : r; return d; } r -= I_SQ;
    if (r < I_SQ) { d.W = a.in(I_WO) + (size_t)l * DM * DM; d.K = DM; d.N = DM; d.WT = (bf16*)(wl + LW_O); d.ldk = -DM; d.item = late1 ? -1 : r; return d; } r -= I_SQ;
    if (r < I_SQ) { d.W = a.in(I_WK) + (size_t)l * DM * DM; d.K = DM; d.N = DM; d.WT = wkv; d.ldk = -8192; d.row_off = l * 4096; d.gain = a.in(I_GMEM) + l * DM; d.item = late1 ? -1 : r; return d; } r -= I_SQ;
    if (r < I_SQ) { d.W = a.in(I_WV) + (size_t)l * DM * DM; d.K = DM; d.N = DM; d.WT = wkv; d.ldk = -8192; d.row_off = l * 4096 + 2048; d.gain = a.in(I_GMEM) + l * DM; d.item = late1 ? -1 : r; return d; } r -= I_SQ;
    if (r < I_UP) { d.W = a.in(I_WUP) + (size_t)l * DM * DFF; d.K = DM; d.N = DFF; d.WT = (bf16*)(wl + LW_UP); d.ldk = -DFF; d.gain = a.in(I_GMLP) + l * DM; d.item = late ? -1 : r; return d; } r -= I_UP;
    if (r < I_DN) { d.W = a.in(I_WDN) + (size_t)l * DFF * DM; d.K = DFF; d.N = DM; d.WT = (bf16*)(wl + LW_DN); d.ldk = -DM; d.item = late ? -1 : r; return d; } r -= I_DN;
    if (r < I_L64) { d.W = a.in(I_W2) + (size_t)l * 64 * 512; d.K = 64; d.N = 512; d.WT = (bf16*)(wl + LW_W2); d.ldk = 64; d.item = r; return d; } r -= I_L64;
    if (r < I_L64) { d.W = a.in(I_A2) + (size_t)l * 64 * 512; d.K = 64; d.N = 512; d.WT = (bf16*)(wl + LW_A2); d.ldk = 64; d.item = r; return d; } r -= I_L64;
    d.W = a.in(I_G2) + (size_t)l * 128 * 512; d.K = 128; d.N = 512; d.WT = (bf16*)(wl + LW_G2); d.ldk = 128; d.item = r; return d;
}
__device__ __forceinline__ void p0_load(const TDesc& d, int lane, f32x4 (&v)[16], float (&g)[16]) {
    if (d.item < 0) return;
    const int nblk = d.N / 64, kb = d.item / nblk, nb = d.item - kb * nblk, k0 = 64 * kb, n0 = 64 * nb, lr = lane >> 4, lc = (lane & 15) * 4;
#pragma unroll
    for (int i = 0; i < 16; ++i) { const int kk = 4 * i + lr; g[i] = d.gain ? d.gain[k0 + kk] : 1.0f; v[i] = __builtin_nontemporal_load((const f32x4*)(d.W + (size_t)(k0 + kk) * d.N + n0 + lc)); }
}
__device__ __forceinline__ void p0_finish(const TDesc& d, LAS float* scr, int lane, const f32x4 (&v)[16], const float (&g)[16]) {
    if (d.item < 0) return;
    const int nblk = d.N / 64, kb = d.item / nblk, nb = d.item - kb * nblk, k0 = 64 * kb, n0 = 64 * nb, lr = lane >> 4, lc = (lane & 15) * 4;
#pragma unroll
    for (int i = 0; i < 16; ++i) { const int kk = 4 * i + lr; LAS float* p = scr + kk * 65 + lc; p[0] = v[i].x * g[i]; p[1] = v[i].y * g[i]; p[2] = v[i].z * g[i]; p[3] = v[i].w * g[i]; }
    LDS_WAIT(); asm volatile("" ::: "memory");
    const int c = lane & 7;
#pragma unroll
    for (int j = 0; j < 8; ++j) { const int n = (lane >> 3) + 8 * j; const LAS float* s = scr + (8 * c) * 65 + n;
        v4u o; o.x = pk2(s[0 * 65], s[1 * 65]); o.y = pk2(s[2 * 65], s[3 * 65]); o.z = pk2(s[4 * 65], s[5 * 65]); o.w = pk2(s[6 * 65], s[7 * 65]);
        if (d.ldk > 0) *(v4u*)(d.WT + (size_t)(d.row_off + n0 + n) * d.ldk + k0 + 8 * c) = o;
        else *(v4u*)(d.WT + ((size_t)kb * (size_t)(-d.ldk) + d.row_off + n0 + n) * 64 + 8 * c) = o; }
    LDS_WAIT(); asm volatile("" ::: "memory");
}
__device__ __forceinline__ void p0_prologue(const Ctx& C, const Ax& a) {
    LAS float* scr = (LAS float*)(C.lds + C.wave * 16640);
    const int gw = C.bid * NWAVES + C.wave, NGW = C.G * NWAVES;
    constexpr int I_IN = 32 * 100, I_SQ = 32 * 32, I_UP = 32 * 128, I_DN = 128 * 32, I_L64 = 8, I_L128 = 16;
    constexpr int PER_LAYER = I_IN + 5 * I_SQ + I_UP + I_DN + 2 * I_L64 + I_L128;
    TDesc cur = p0_desc(a, gw, C.G), nxt; f32x4 va[16], vb[16]; float ga[16], gb[16];
    const int NITEMS = DEPTH * PER_LAYER;
    if (gw < NITEMS) p0_load(cur, C.lane, va, ga);
    for (int it = gw; it < NITEMS; it += 2 * NGW) {
        const int it1 = it + NGW, it2 = it + 2 * NGW;
        if (it1 < NITEMS) { nxt = p0_desc(a, it1, C.G); p0_load(nxt, C.lane, vb, gb); }
        p0_finish(cur, scr, C.lane, va, ga);
        if (it1 < NITEMS) { if (it2 < NITEMS) { cur = p0_desc(a, it2, C.G); p0_load(cur, C.lane, va, ga); }
            p0_finish(nxt, scr, C.lane, vb, gb); }
    }
    { float* cs = (float*)(a.ws + WS_ROPE); const int gt = C.bid * (NWAVES * 64) + C.tid, NT = C.G * NWAVES * 64;
      for (int idx = gt; idx < 2049 * 64; idx += NT) { const int p = idx >> 6, i = idx & 63; const double pos = (p == 2048) ? 16384.0 : (double)p;
          const double inv = exp(-(double)i * (9.210340371976184 / 64.0)); double r = pos * inv; r -= 6.283185307179586 * rint(r * 0.15915494309189535);
          cs[2 * idx] = (float)cos(r); cs[2 * idx + 1] = (float)sin(r); } }
    float* XF = (float*)(a.ws + WS_XF); bf16* HN = (bf16*)(a.ws + WS_HN); bf16* MN = (bf16*)(a.ws + WS_MN);
    for (int m = gw; m < MT; m += NGW) { const float* src = (m < MP) ? a.in(I_XP) + (size_t)m * DM : a.in(I_XS) + (size_t)(m - MP) * DM; rms_row(src, HN + (size_t)m * DM, nullptr, C.lane); }
    for (int m = gw; m < MMEM; m += NGW) rms_row(a.in(I_MEM) + (size_t)m * DM, MN + (size_t)m * DM, nullptr, C.lane);
}

__device__ __forceinline__ TDesc lc_desc(const Ax& a, int l, int it) {
    constexpr int I_UP = 32 * 128, I_DN = 128 * 32, I_SQ = 32 * 32;
    unsigned char* wl = a.ws + WS_WL + (size_t)l * LW_STRIDE; TDesc d; d.row_off = 0; d.gain = nullptr;
    if (it < I_UP) { d.W = a.in(I_WUP) + (size_t)l * DM * DFF; d.K = DM; d.N = DFF; d.WT = (bf16*)(wl + LW_UP); d.ldk = -DFF; d.gain = a.in(I_GMLP) + l * DM; d.item = it; return d; }
    int r = it - I_UP;
    if (r < I_DN) { d.W = a.in(I_WDN) + (size_t)l * DFF * DM; d.K = DFF; d.N = DM; d.WT = (bf16*)(wl + LW_DN); d.ldk = -DM; d.item = r; return d; } r -= I_DN;
    d.K = DM; d.N = DM; d.item = r & (I_SQ - 1); const int q = r >> 10;
    if (l == 0) { const int l1 = 1; d.W = a.in(q == 0 ? I_WK : I_WV) + (size_t)l1 * DM * DM; d.WT = (bf16*)(a.ws + WS_WKV); d.ldk = -8192; d.row_off = l1 * 4096 + q * 2048; d.gain = a.in(I_GMEM) + l1 * DM; return d; }
    d.ldk = -DM;
    if (q == 0) { d.W = a.in(I_WOUT) + (size_t)l * DM * DM; d.WT = (bf16*)(wl + LW_OUT); }
    else if (q == 1) { d.W = a.in(I_WQ) + (size_t)l * DM * DM; d.WT = (bf16*)(wl + LW_Q); d.gain = a.in(I_GXA) + l * DM; }
    else { d.W = a.in(I_WO) + (size_t)l * DM * DM; d.WT = (bf16*)(wl + LW_O); }
    return d;
}
__device__ __forceinline__ void late_convert(const Ctx& C, const Ax& a, int l, int rank, int nrank) {
    LAS float* scr = (LAS float*)(C.lds + C.wave * 16640);
    const int NITEMS = 32 * 128 + 128 * 32 + (LATE_EXTRA ? (l == 0 ? 2 : 3) * 1024 : 0);
    const int gw = rank * NWAVES + C.wave, NGW = nrank * NWAVES;
    TDesc cur, nxt; f32x4 va[16], vb[16]; float ga[16], gb[16];
    if (gw < NITEMS) { cur = lc_desc(a, l, gw); p0_load(cur, C.lane, va, ga); }
    for (int it = gw; it < NITEMS; it += 2 * NGW) {
        const int it1 = it + NGW, it2 = it + 2 * NGW;
        if (it1 < NITEMS) { nxt = lc_desc(a, l, it1); p0_load(nxt, C.lane, vb, gb); }
        p0_finish(cur, scr, C.lane, va, ga);
        if (it1 < NITEMS) { if (it2 < NITEMS) { cur = lc_desc(a, l, it2); p0_load(cur, C.lane, va, ga); }
            p0_finish(nxt, scr, C.lane, vb, gb); }
    }
}
__device__ __forceinline__ void ad_prompt_item(const Ctx& C, const Ax& a, int l, int item) {
    const bf16* P = (const bf16*)(a.ws + WS_P); bf16* YC = (bf16*)(a.ws + WS_YC);
    const int b = item >> 6, t0 = (item & 63) * 32; const size_t rbase = (size_t)b * SEQ;
    LAS float* UD = (LAS float*)C.lds;
    { v4u r1[8], r2[8];
#pragma unroll
      for (int u = 0; u < 8; ++u) { const int it = C.tid + u * (NWAVES * 64), r = it >> 6, cc = it & 63, t = t0 - 30 + r; r1[u] = (v4u){0u, 0u, 0u, 0u}; r2[u] = r1[u];
        if (it < 62 * 64 && t >= 0) { const bf16* pr = P + (rbase + t) * PIN + PD_ + cc * 8; r1[u] = *(const v4u*)pr; r2[u] = *(const v4u*)(pr + 512); } }
      __builtin_amdgcn_sched_barrier(0);
#pragma unroll
      for (int u = 0; u < 8; ++u) { const int it = C.tid + u * (NWAVES * 64), r = it >> 6, cc = it & 63;
        if (it < 62 * 64) { float d1[8], d2[8], uu[8]; unpack8(r1[u], d1); unpack8(r2[u], d2);
#pragma unroll
            for (int j = 0; j < 8; ++j) uu[j] = d1[j] * sigm(d2[j]);
            *(LAS f32x4*)(UD + r * 512 + cc * 8) = (f32x4){uu[0], uu[1], uu[2], uu[3]}; *(LAS f32x4*)(UD + r * 512 + cc * 8 + 4) = (f32x4){uu[4], uu[5], uu[6], uu[7]}; } } }
    __builtin_amdgcn_sched_barrier(0);
    { const int cc = C.tid & 63; const float* cw = a.in(I_CAW) + (size_t)l * 3 * 512 + cc * 8;
      const f32x4 w0a = *(const f32x4*)cw, w0b = *(const f32x4*)(cw + 4), w1a = *(const f32x4*)(cw + 512), w1b = *(const f32x4*)(cw + 516), w2a = *(const f32x4*)(cw + 1024), w2b = *(const f32x4*)(cw + 1028);
      const float k0[8] = {w0a.x, w0a.y, w0a.z, w0a.w, w0b.x, w0b.y, w0b.z, w0b.w}, k1[8] = {w1a.x, w1a.y, w1a.z, w1a.w, w1b.x, w1b.y, w1b.z, w1b.w}, k2[8] = {w2a.x, w2a.y, w2a.z, w2a.w, w2b.x, w2b.y, w2b.z, w2b.w};
#pragma unroll
      for (int hb = 0; hb < 2; ++hb) { v4u q[2][7];
#pragma unroll
        for (int u = 0; u < 2; ++u) { const int r = (C.tid >> 6) + (hb * 2 + u) * NWAVES, t = t0 + r; const bf16* pr = P + (rbase + t) * PIN + cc * 8;
#pragma unroll
            for (int z = 0; z < 7; ++z) q[u][z] = (v4u){0u, 0u, 0u, 0u};
            q[u][0] = *(const v4u*)pr; q[u][1] = *(const v4u*)(pr + 512); q[u][2] = *(const v4u*)(pr + 1024);
            if (t >= 1) { q[u][3] = *(const v4u*)(pr - PIN + 512); q[u][4] = *(const v4u*)(pr - PIN + 1024); }
            if (t >= 2) { q[u][5] = *(const v4u*)(pr - 2 * PIN + 512); q[u][6] = *(const v4u*)(pr - 2 * PIN + 1024); } }
        __builtin_amdgcn_sched_barrier(0);
#pragma unroll
        for (int u = 0; u < 2; ++u) { const int r = (C.tid >> 6) + (hb * 2 + u) * NWAVES, t = t0 + r;
            float ab[8], u0[8], u1[8], u2[8], x[8], y[8];
            unpack8(q[u][0], ab); unpack8(q[u][1], x); unpack8(q[u][2], y);
#pragma unroll
            for (int j = 0; j < 8; ++j) u2[j] = x[j] * y[j];
            unpack8(q[u][3], x); unpack8(q[u][4], y);
#pragma unroll
            for (int j = 0; j < 8; ++j) u1[j] = x[j] * y[j];
            unpack8(q[u][5], x); unpack8(q[u][6], y);
#pragma unroll
            for (int j = 0; j < 8; ++j) u0[j] = x[j] * y[j];
            float o[8];
#pragma unroll
            for (int j = 0; j < 8; ++j) o[j] = ab[j] * (k0[j] * u0[j] + k1[j] * u1[j] + k2[j] * u2[j]);
            *(v4u*)(YC + (rbase + t) * DM + cc * 8) = pack8(o);
            if (t >= SEQ - 2) { float* st = a.out + O_CAP + (((size_t)l * NB + b) * 2 + (t - (SEQ - 2))) * 512 + cc * 8; *(f32x4*)st = (f32x4){u2[0], u2[1], u2[2], u2[3]}; *(f32x4*)(st + 4) = (f32x4){u2[4], u2[5], u2[6], u2[7]}; } }
        __builtin_amdgcn_sched_barrier(0); } }
    __syncthreads();
    const int c = C.tid;
    if (t0 == SEQ - 32) { float* st = a.out + O_CDP + ((size_t)l * NB + b) * 30 * 512 + c;
        for (int j = 0; j < 30; ++j) st[(size_t)j * 512] = UD[(32 + j) * 512 + c]; }
    float cv[32];
    { const char* cwb = (const char*)(a.in(I_CDW) + (size_t)l * 31 * 512); const unsigned cof = (unsigned)c * 4u; const float bias = a.in(I_CDB)[l * 512 + c];
      float wt[31];
#pragma unroll
      for (int j = 0; j < 31; ++j) wt[j] = *(const float*)(cwb + (cof + (unsigned)j * 2048u));
      __builtin_amdgcn_sched_barrier(0);
#pragma unroll
      for (int t = 0; t < 32; ++t) cv[t] = bias;
#pragma unroll
      for (int r = 0; r < 62; ++r) { const float ur = UD[r * 512 + c];
#pragma unroll
          for (int t = 0; t < 32; ++t) { const int j = r - t; if (j >= 0 && j < 31) cv[t] += wt[j] * ur; } } }
    __syncthreads();
#pragma unroll
    for (int t = 0; t < 32; ++t) UD[t * 512 + c] = cv[t];
    __syncthreads();
    { const float* lg = a.in(I_LNDG) + l * 512 + C.lane * 8; const float* lb = a.in(I_LNDB) + l * 512 + C.lane * 8;
      const f32x4 g0 = *(const f32x4*)lg, g1 = *(const f32x4*)(lg + 4), b0 = *(const f32x4*)lb, b1 = *(const f32x4*)(lb + 4);
#pragma unroll
      for (int q = 0; q < 4; ++q) { const int t = C.wave * 4 + q; const f32x4 x0 = *(LAS f32x4*)(UD + t * 512 + C.lane * 8), x1 = *(LAS f32x4*)(UD + t * 512 + C.lane * 8 + 4);
        const float mu = wave_sum((x0.x + x0.y) + (x0.z + x0.w) + (x1.x + x1.y) + (x1.z + x1.w)) * (1.0f / 512.0f);
        const f32x4 d0 = x0 - mu, d1 = x1 - mu;
        const float var = wave_sum((d0.x * d0.x + d0.y * d0.y) + (d0.z * d0.z + d0.w * d0.w) + (d1.x * d1.x + d1.y * d1.y) + (d1.z * d1.z + d1.w * d1.w)) * (1.0f / 512.0f);
        const float rstd = 1.0f / sqrtf(var + 1e-6f);
        const f32x4 y0 = d0 * rstd * g0 + b0, y1 = d1 * rstd * g1 + b1; float o[8];
        o[0] = y0.x * sigm(y0.x); o[1] = y0.y * sigm(y0.y); o[2] = y0.z * sigm(y0.z); o[3] = y0.w * sigm(y0.w);
        o[4] = y1.x * sigm(y1.x); o[5] = y1.y * sigm(y1.y); o[6] = y1.z * sigm(y1.z); o[7] = y1.w * sigm(y1.w);
        *(v4u*)(YC + (rbase + t0 + t) * DM + 1536 + C.lane * 8) = pack8(o); } }
    __syncthreads();
}
__device__ __forceinline__ void ad_sample_item(const Ctx& C, const Ax& a, int l, int n) {
    const bf16* P = (const bf16*)(a.ws + WS_P); bf16* YC = (bf16*)(a.ws + WS_YC);
    const int c = C.tid; const bf16* pr = P + (size_t)(MP + n) * PIN;
    LAS float* red = (LAS float*)C.lds;
    { const float* st = a.in(I_SCA) + (((size_t)l * NS + n) * 2) * 512 + c; const float s0 = st[0], s1 = st[512];
      const float ua = bf1(pr[512 + c]) * bf1(pr[1024 + c]); const float* cw = a.in(I_CAW) + (size_t)l * 3 * 512 + c;
      const float y = bf1(pr[c]) * (cw[0] * s0 + cw[512] * s1 + cw[1024] * ua);
      YC[(size_t)(MP + n) * DM + c] = (bf16)(pk2(y, 0.f) & 0xffffu);
      float* o = a.out + O_CAS + (((size_t)l * NS + n) * 2) * 512 + c; o[0] = s1; o[512] = ua; }
    const float* st = a.in(I_SCD) + (((size_t)l * NS + n) * 30) * 512 + c; const float* cw = a.in(I_CDW) + (size_t)l * 31 * 512 + c;
    const float ud = bf1(pr[PD_ + c]) * sigm(bf1(pr[PD_ + 512 + c]));
    float cv = a.in(I_CDB)[l * 512 + c] + cw[30 * 512] * ud;
    float* os = a.out + O_CDS + (((size_t)l * NS + n) * 30) * 512 + c;
#pragma unroll 6
    for (int j = 0; j < 30; ++j) { const float s = st[(size_t)j * 512]; cv += cw[(size_t)j * 512] * s; if (j > 0) os[(size_t)(j - 1) * 512] = s; }
    os[29 * 512] = ud;
    float s = wave_sum(cv); if (C.lane == 0) red[C.wave] = s; __syncthreads();
    float mu = 0.f;
#pragma unroll
    for (int w = 0; w < 8; ++w) mu += red[w];
    mu *= (1.0f / 512.0f); const float d = cv - mu;
    s = wave_sum(d * d); if (C.lane == 0) red[8 + C.wave] = s; __syncthreads();
    float var = 0.f;
#pragma unroll
    for (int w = 0; w < 8; ++w) var += red[8 + w];
    const float rstd = 1.0f / sqrtf(var * (1.0f / 512.0f) + 1e-6f);
    const float y = d * rstd * a.in(I_LNDG)[l * 512 + c] + a.in(I_LNDB)[l * 512 + c];
    YC[(size_t)(MP + n) * DM + 1536 + c] = (bf16)(pk2(y * sigm(y), 0.f) & 0xffffu);
    __syncthreads();
}

__device__ __forceinline__ void shift8(const bf16* cur, const bf16* prevb, const float* prevf, const float* mu, float (&xs)[8]) {
    float pc[8], pv[8]; unpack8(*(const v4u*)cur, pc);
    if (prevb) unpack8(*(const v4u*)prevb, pv);
    else if (prevf) { const f32x4 p0 = *(const f32x4*)prevf, p1 = *(const f32x4*)(prevf + 4); pv[0] = p0.x; pv[1] = p0.y; pv[2] = p0.z; pv[3] = p0.w; pv[4] = p1.x; pv[5] = p1.y; pv[6] = p1.z; pv[7] = p1.w; }
    else {
#pragma unroll
        for (int j = 0; j < 8; ++j) pv[j] = 0.f; }
    const f32x4 m0 = *(const f32x4*)mu, m1 = *(const f32x4*)(mu + 4); const float m[8] = {m0.x, m0.y, m0.z, m0.w, m1.x, m1.y, m1.z, m1.w};
#pragma unroll
    for (int j = 0; j < 8; ++j) xs[j] = pc[j] + (pv[j] - pc[j]) * m[j];
}
__device__ __forceinline__ void shift4(const bf16* cur, const bf16* prevb, const float* prevf, const float* mu, float (&xs)[4]) {
    float pc[4], pv[4]; unpack4(*(const v2u*)cur, pc);
    if (prevb) unpack4(*(const v2u*)prevb, pv);
    else if (prevf) { const f32x4 p0 = *(const f32x4*)prevf; pv[0] = p0.x; pv[1] = p0.y; pv[2] = p0.z; pv[3] = p0.w; }
    else { pv[0] = pv[1] = pv[2] = pv[3] = 0.f; }
    const f32x4 m0 = *(const f32x4*)mu;
    xs[0] = pc[0] + (pv[0] - pc[0]) * m0.x; xs[1] = pc[1] + (pv[1] - pc[1]) * m0.y; xs[2] = pc[2] + (pv[2] - pc[2]) * m0.z; xs[3] = pc[3] + (pv[3] - pc[3]) * m0.w;
}
constexpr int PTS = 1544;
__device__ __forceinline__ void shift4_lds(const LAS bf16* cur, const float* mu, float (&xs)[4]) {
    float pc[4], pv[4]; unpack4(*(const LAS v2u*)cur, pc); unpack4(*(const LAS v2u*)(cur - PTS), pv);
    const f32x4 m0 = *(const f32x4*)mu;
    xs[0] = pc[0] + (pv[0] - pc[0]) * m0.x; xs[1] = pc[1] + (pv[1] - pc[1]) * m0.y; xs[2] = pc[2] + (pv[2] - pc[2]) * m0.z; xs[3] = pc[3] + (pv[3] - pc[3]) * m0.w;
}
constexpr int RWB = 896, RW_KK = 256, RW_KB = 384, RW_K = 512, RW_R = 640, RW_V = 768;
__device__ __forceinline__ void rw_st4(unsigned char* rec, int off, int cl, const f32x4 v) { v2u w; w.x = pk2(v[0], v[1]); w.y = pk2(v[2], v[3]); *(v2u*)(rec + off + cl * 2) = w; }
__device__ __forceinline__ f32x4 rw_ld4(const unsigned char* rec, int off, int cl) { float f[4]; unpack4(*(const v2u*)(rec + off + cl * 2), f); return (f32x4){f[0], f[1], f[2], f[3]}; }
#ifndef DUP_SUB
#define DUP_SUB 0u
#endif
#define PREP_REP(k) for (int prep_rep_ = 0; prep_rep_ < 1 + (int)((DUP_SUB >> (k)) & 1u); ++prep_rep_)
__device__ __forceinline__ void rwkv_prep_item(const Ctx& C, const Ax& a, int l, int item, int t2sel = -1) {
    const bf16* P = (const bf16*)(a.ws + WS_P); float* RW = (float*)(a.ws + WS_RW); float* GATE = (float*)(a.ws + WS_GATE);
    const bool smp = item >= 256; const int row0 = smp ? MP + (item - 256) * 32 : (item >> 6) * SEQ + (item & 63) * 32; const int t0 = smp ? 0 : (item & 63) * 32;
    const float* mu = a.in(I_MU) + (size_t)l * SHW; const float* sst = a.in(I_SSH) + (size_t)l * NS * SHW;
    LAS bf16* AW = (LAS bf16*)C.lds; LAS bf16* AA = AW + 32 * 72; LAS bf16* AG = AA + 32 * 72; LAS bf16* PT = AG + 32 * 136;
    for (int it = C.tid; it < 32 * 32; it += NWAVES * 64) { const int r = it >> 5, cc = it & 31, col = 1536 + cc * 8, row = row0 + r; const bf16* cur = P + (size_t)row * PIN + PC_ + col;
        float xs[8];
        if (smp) shift8(cur, nullptr, sst + (size_t)(row - MP) * SHW + col, mu + col, xs);
        else shift8(cur, (t0 + r > 0) ? cur - PIN : nullptr, nullptr, mu + col, xs);
        if (cc < 8) {
#pragma unroll
            for (int j = 0; j < 8; ++j) xs[j] = tanhf(xs[j]);
            *(LAS v4u*)(AW + r * 72 + cc * 8) = pack8(xs); }
        else if (cc < 16) *(LAS v4u*)(AA + r * 72 + (cc - 8) * 8) = pack8(xs);
        else {
#pragma unroll
            for (int j = 0; j < 8; ++j) xs[j] = sigm(xs[j]);
            *(LAS v4u*)(AG + r * 136 + (cc - 16) * 8) = pack8(xs); } }
    if (!smp) { for (int it = C.tid; it < 33 * 192; it += NWAVES * 64) { const int r = it / 192, cc = it - r * 192; v4u v = (v4u){0u, 0u, 0u, 0u};
            if (t0 + r > 0) v = *(const v4u*)(P + (size_t)(row0 + r - 1) * PIN + PC_ + cc * 8);
            *(LAS v4u*)(PT + r * PTS + cc * 8) = v; } }
    else { const int rb = row0 + 16 * t2sel;
        for (int it = C.tid; it < 16 * 192; it += NWAVES * 64) { const int q = it / 192, cc = it - q * 192;
            const v4u v = *(const v4u*)(P + (size_t)(rb + q) * PIN + PC_ + cc * 8); const float* sp = sst + (size_t)(rb + q - MP) * SHW + cc * 8; const f32x4 s0 = *(const f32x4*)sp, s1 = *(const f32x4*)(sp + 4);
            const float sf[8] = {s0.x, s0.y, s0.z, s0.w, s1.x, s1.y, s1.z, s1.w};
            *(LAS v4u*)(PT + (2 * q + 1) * PTS + cc * 8) = v; *(LAS v4u*)(PT + (2 * q) * PTS + cc * 8) = pack8(sf); } }
    if (smp) { float* o = a.out + O_SHS + ((size_t)l * NS + (row0 - MP)) * SHW;
        for (int it = C.tid + (t2sel > 0 ? 16 * 224 : 0); it < (t2sel == 0 ? 16 : 32) * 224; it += NWAVES * 64) { const int r = it / 224, cc = it % 224; float f[8]; unpack8(*(const v4u*)(P + (size_t)(row0 + r) * PIN + PC_ + cc * 8), f);
            float* op = o + (size_t)r * SHW + cc * 8; *(f32x4*)op = (f32x4){f[0], f[1], f[2], f[3]}; *(f32x4*)(op + 4) = (f32x4){f[4], f[5], f[6], f[7]}; } }
    else if (t0 == SEQ - 32) { float* o = a.out + O_SHP + ((size_t)l * NB + (item >> 6)) * SHW;
        for (int cc = C.tid; cc < 224; cc += NWAVES * 64) { float f[8]; unpack8(*(const v4u*)(P + (size_t)(row0 + 31) * PIN + PC_ + cc * 8), f);
            *(f32x4*)(o + cc * 8) = (f32x4){f[0], f[1], f[2], f[3]}; *(f32x4*)(o + cc * 8 + 4) = (f32x4){f[4], f[5], f[6], f[7]}; } }
    __syncthreads();
    const int h = C.wave, fr = C.lane & 15, fq = C.lane >> 4;
    const unsigned char* wl = a.ws + WS_WL + (size_t)l * LW_STRIDE;
    const bf16* W2t = (const bf16*)(wl + LW_W2); const bf16* A2t = (const bf16*)(wl + LW_A2); const bf16* G2t = (const bf16*)(wl + LW_G2);
    PREP_REP(23) { constexpr int tp = 0;
        f32x4 acc[4][2];
#pragma unroll
        for (int ct = 0; ct < 4; ++ct)
#pragma unroll
            for (int t2 = 0; t2 < 2; ++t2) acc[ct][t2] = zero4();
#pragma unroll
        for (int ks = 0; ks < 2; ++ks) { bf16x8 af[2], wf[4];
#pragma unroll
            for (int t2 = 0; t2 < 2; ++t2) af[t2] = *(const LAS bf16x8*)(AA + (tp * 32 + t2 * 16 + fr) * 72 + ks * 32 + fq * 8);
#pragma unroll
            for (int ct = 0; ct < 4; ++ct) wf[ct] = *(const bf16x8*)(A2t + (size_t)(h * 64 + ct * 16 + fr) * 64 + ks * 32 + fq * 8);
#pragma unroll
            for (int ct = 0; ct < 4; ++ct)
#pragma unroll
                for (int t2 = 0; t2 < 2; ++t2) acc[ct][t2] = __builtin_amdgcn_mfma_f32_16x16x32_bf16(wf[ct], af[t2], acc[ct][t2], 0, 0, 0); }
        const float* a0 = a.in(I_A0) + l * 512; const float* kkw = a.in(I_KK) + l * 512; const float* kaw = a.in(I_KA) + l * 512;
#pragma unroll
        for (int t2 = 0; t2 < 2; ++t2) { if (t2sel >= 0 && t2 != t2sel) continue; const int r = tp * 32 + t2 * 16 + fr, row = row0 + r;
            const LAS bf16* ptr_ = PT + (smp ? 2 * fr + 1 : r + 1) * PTS;
            float kkr[4][4], av[4][4], kc[4][4]; float ss = 0.f;
#pragma unroll
            for (int ct = 0; ct < 4; ++ct) { const int ch = h * 64 + ct * 16 + fq * 4; const f32x4 a0v = *(const f32x4*)(a0 + ch), kkv = *(const f32x4*)(kkw + ch);
                float xs[4]; shift4_lds(ptr_ + 512 + ch, mu + 512 + ch, xs);
#pragma unroll
                for (int j = 0; j < 4; ++j) { av[ct][j] = sigm(a0v[j] + acc[ct][t2][j]); kc[ct][j] = xs[j]; kkr[ct][j] = xs[j] * kkv[j]; ss += kkr[ct][j] * kkr[ct][j]; } }
            ss += __shfl_xor(ss, 16); ss += __shfl_xor(ss, 32);
            const float inv = 1.0f / fmaxf(sqrtf(ss), 1e-12f);
            unsigned char* rw = (unsigned char*)RW + ((size_t)row * 8 + h) * RWB;
#pragma unroll
            for (int ct = 0; ct < 4; ++ct) { const int ch = h * 64 + ct * 16 + fq * 4, cl = ct * 16 + fq * 4; const f32x4 kav = *(const f32x4*)(kaw + ch);
                f32x4 kk, kb, k4;
#pragma unroll
                for (int j = 0; j < 4; ++j) { kk[j] = kkr[ct][j] * inv; kb[j] = kk[j] * av[ct][j]; k4[j] = kc[ct][j] * (1.0f + (av[ct][j] - 1.0f) * kav[j]); }
                rw_st4(rw, RW_KK, cl, kk); rw_st4(rw, RW_KB, cl, kb); rw_st4(rw, RW_K, cl, k4);
                float xr[4], xv[4];
                shift4_lds(ptr_ + ch, mu + ch, xr); shift4_lds(ptr_ + 1024 + ch, mu + 1024 + ch, xv);
                rw_st4(rw, RW_R, cl, (f32x4){xr[0], xr[1], xr[2], xr[3]}); rw_st4(rw, RW_V, cl, (f32x4){xv[0], xv[1], xv[2], xv[3]}); } }
    }
    PREP_REP(24) { constexpr int tp = 0;
        f32x4 acc[4][2];
#pragma unroll
        for (int ct = 0; ct < 4; ++ct)
#pragma unroll
            for (int t2 = 0; t2 < 2; ++t2) acc[ct][t2] = zero4();
#pragma unroll
        for (int ks = 0; ks < 2; ++ks) { bf16x8 af[2], wf[4];
#pragma unroll
            for (int t2 = 0; t2 < 2; ++t2) af[t2] = *(const LAS bf16x8*)(AW + (tp * 32 + t2 * 16 + fr) * 72 + ks * 32 + fq * 8);
#pragma unroll
            for (int ct = 0; ct < 4; ++ct) wf[ct] = *(const bf16x8*)(W2t + (size_t)(h * 64 + ct * 16 + fr) * 64 + ks * 32 + fq * 8);
#pragma unroll
            for (int ct = 0; ct < 4; ++ct)
#pragma unroll
                for (int t2 = 0; t2 < 2; ++t2) acc[ct][t2] = __builtin_amdgcn_mfma_f32_16x16x32_bf16(wf[ct], af[t2], acc[ct][t2], 0, 0, 0); }
        const float* w0 = a.in(I_W0) + l * 512;
#pragma unroll
        for (int t2 = 0; t2 < 2; ++t2) { if (t2sel >= 0 && t2 != t2sel) continue; const int row = row0 + tp * 32 + t2 * 16 + fr; float* rw = (float*)((unsigned char*)RW + ((size_t)row * 8 + h) * RWB);
#pragma unroll
            for (int ct = 0; ct < 4; ++ct) { const int ch = h * 64 + ct * 16 + fq * 4, cl = ct * 16 + fq * 4; const f32x4 w0v = *(const f32x4*)(w0 + ch); f32x4 d;
#pragma unroll
                for (int j = 0; j < 4; ++j) { const float z = -(w0v[j] + acc[ct][t2][j]); const float sp = fmaxf(z, 0.f) + __logf(1.0f + __expf(-fabsf(z))); const float w = -sp - 0.5f; d[j] = -__expf(w); }
                *(f32x4*)(rw + cl) = d; } }
    }
    PREP_REP(25) { constexpr int tp = 0;
        f32x4 acc[4][2];
#pragma unroll
        for (int ct = 0; ct < 4; ++ct)
#pragma unroll
            for (int t2 = 0; t2 < 2; ++t2) acc[ct][t2] = zero4();
#pragma unroll
        for (int ks = 0; ks < 4; ++ks) { bf16x8 af[2], wf[4];
#pragma unroll
            for (int t2 = 0; t2 < 2; ++t2) af[t2] = *(const LAS bf16x8*)(AG + (tp * 32 + t2 * 16 + fr) * 136 + ks * 32 + fq * 8);
#pragma unroll
            for (int ct = 0; ct < 4; ++ct) wf[ct] = *(const bf16x8*)(G2t + (size_t)(h * 64 + ct * 16 + fr) * 128 + ks * 32 + fq * 8);
#pragma unroll
            for (int ct = 0; ct < 4; ++ct)
#pragma unroll
                for (int t2 = 0; t2 < 2; ++t2) acc[ct][t2] = __builtin_amdgcn_mfma_f32_16x16x32_bf16(wf[ct], af[t2], acc[ct][t2], 0, 0, 0); }
#pragma unroll
        for (int t2 = 0; t2 < 2; ++t2) { if (t2sel >= 0 && t2 != t2sel) continue; const int row = row0 + tp * 32 + t2 * 16 + fr;
#pragma unroll
            for (int ct = 0; ct < 4; ++ct) *(f32x4*)(GATE + (size_t)row * 512 + h * 64 + ct * 16 + fq * 4) = acc[ct][t2]; }
    }
    __syncthreads();
}

#define PACK8(arr, o) ((v4u){pk2((arr)[(o)], (arr)[(o) + 1]), pk2((arr)[(o) + 2], (arr)[(o) + 3]), pk2((arr)[(o) + 4], (arr)[(o) + 5]), pk2((arr)[(o) + 6], (arr)[(o) + 7])})
constexpr int WK_LDS = 18432, WK_SHR = 6912, WK_PRV = 3072;
__device__ __forceinline__ f32x4 mfma16(bf16x4 a, bf16x4 b, f32x4 c) { return __builtin_amdgcn_mfma_f32_16x16x16bf16_1k(a, b, c, 0, 0, 0); }
__device__ __forceinline__ bf16 bfr1(float x) { return (bf16)(pk2(x, 0.f) & 0xffffu); }
__device__ __forceinline__ void wkv_chunk_witem(const Ctx& C, const Ax& a, int ci) {
    const float* RW = (const float*)(a.ws + WS_RW);
    unsigned char* CK = a.ws + WS_CK + (size_t)ci * WK_SHR; unsigned char* CP = a.ws + WS_CP + (size_t)ci * 4 * WK_PRV;
    const int bh = ci >> 7, c = ci & 127, b = bh >> 3, h = bh & 7, lane = C.lane, fr = lane & 15, fq = lane >> 4;
    LAS unsigned char* Lb = C.lds + C.wave * WK_LDS;
    LAS bf16* TA = (LAS bf16*)Lb; LAS bf16* TB = TA + 16 * 72; LAS bf16* TK = TB + 16 * 72; LAS bf16* TR = TK + 16 * 72; LAS bf16* VT = TR + 16 * 72;
    LAS float* M1 = (LAS float*)(Lb + 12288); LAS float* M2 = M1 + 320; LAS float* N1 = M2 + 320; LAS float* N2 = N1 + 320;
    LAS bf16* TG = TA; LAS bf16* PST = TK;
    const unsigned char* rw = (const unsigned char*)RW + (((size_t)b * SEQ + c * 16) * 8 + h) * RWB;
#define RWF(t) (*(const float*)(rw + (size_t)(t) * (8 * RWB) + lane * 4))
#define RWH(t, off) bf1(*(const bf16*)(rw + (size_t)(t) * (8 * RWB) + (off) + lane * 2))
    float lam[16];
#pragma unroll
    for (int t = 0; t < 16; ++t) lam[t] = RWF(t);
    __builtin_amdgcn_sched_barrier(0);
#pragma unroll
    for (int t = 1; t < 16; ++t) lam[t] += lam[t - 1];
    const float lamT = lam[15];
    ((float*)CK)[lane] = __expf(lamT);
    float Bp[16], Kp[16], al[16], ro[16];
    bf16* ATg = (bf16*)(CK + 256); bf16* OMg = (bf16*)(CK + 256 + 2304);
#define RWR(t, off) (*(const bf16*)(rw + (size_t)(t) * (8 * RWB) + (off) + lane * 2))
    bf16 wkk[4], wbb[4], wkx[4], wrr[4], wvv[4];
#pragma unroll
    for (int t = 0; t < 4; ++t) { wkk[t] = RWR(t, RW_KK); wbb[t] = RWR(t, RW_KB); wkx[t] = RWR(t, RW_K); wrr[t] = RWR(t, RW_R); wvv[t] = RWR(t, RW_V); }
    __builtin_amdgcn_sched_barrier(0);
#pragma unroll
    for (int t = 0; t < 16; ++t) { const float kk = bf1(wkk[t & 3]), bb = bf1(wbb[t & 3]), kx = bf1(wkx[t & 3]), rr = bf1(wrr[t & 3]), vv = bf1(wvv[t & 3]);
        if (t + 4 < 16) { wkk[t & 3] = RWR(t + 4, RW_KK); wbb[t & 3] = RWR(t + 4, RW_KB); wkx[t & 3] = RWR(t + 4, RW_K); wrr[t & 3] = RWR(t + 4, RW_R); wvv[t & 3] = RWR(t + 4, RW_V); }
        const float ein = __expf(-lam[t]), eprev = (t ? __expf(lam[t - 1]) : 1.0f), ecur = __expf(lam[t]), erest = __expf(lamT - lam[t]);
        al[t] = kk * eprev; ro[t] = rr * ecur; Bp[t] = bb * erest; Kp[t] = kx * erest;
        const bf16 ab = bfr1(al[t]);
        TA[t * 72 + lane] = ab; TB[t * 72 + lane] = bfr1(bb * ein); TK[t * 72 + lane] = bfr1(kx * ein); TR[t * 72 + lane] = bfr1(ro[t]); VT[lane * 24 + t] = bfr1(vv);
        ATg[t * 72 + lane] = ab;
        asm volatile("" ::: "memory"); __builtin_amdgcn_sched_barrier(0); }
    LDS_WAIT(); asm volatile("" ::: "memory");
    { f32x4 g1 = zero4(), g2 = zero4(), n1 = zero4(), n2 = zero4();
#pragma unroll
      for (int ks = 0; ks < 2; ++ks) { const int o = fr * 72 + ks * 32 + fq * 8;
        const bf16x8 bf_ = *(const LAS bf16x8*)(TB + o), kf_ = *(const LAS bf16x8*)(TK + o), af_ = *(const LAS bf16x8*)(TA + o), rf_ = *(const LAS bf16x8*)(TR + o);
        g1 = __builtin_amdgcn_mfma_f32_16x16x32_bf16(bf_, af_, g1, 0, 0, 0); g2 = __builtin_amdgcn_mfma_f32_16x16x32_bf16(kf_, af_, g2, 0, 0, 0);
        n1 = __builtin_amdgcn_mfma_f32_16x16x32_bf16(bf_, rf_, n1, 0, 0, 0); n2 = __builtin_amdgcn_mfma_f32_16x16x32_bf16(kf_, rf_, n2, 0, 0, 0); }
#pragma unroll
      for (int r = 0; r < 4; ++r) { const int s_ = 4 * fq + r, o = s_ * 20 + fr;
        M1[o] = (s_ < fr) ? g1[r] : 0.f; M2[o] = (s_ < fr) ? g2[r] : 0.f; N1[o] = (s_ <= fr) ? n1[r] : 0.f; N2[o] = (s_ <= fr) ? n2[r] : 0.f; } }
    LDS_WAIT(); asm volatile("" ::: "memory");
    __builtin_amdgcn_sched_barrier(0);
#pragma unroll
    for (int s_ = 14; s_ >= 0; --s_) { float m[16];
#pragma unroll
        for (int q = 0; q < 4; ++q) { const f32x4 v = *(const LAS f32x4*)(M1 + s_ * 20 + 4 * q); m[4 * q] = v.x; m[4 * q + 1] = v.y; m[4 * q + 2] = v.z; m[4 * q + 3] = v.w; }
        float acc = Bp[s_];
#pragma unroll
        for (int t = s_ + 1; t < 16; ++t) acc -= m[t] * Bp[t];
        asm volatile("" : "+v"(acc) :: "memory"); Bp[s_] = acc; __builtin_amdgcn_sched_barrier(0); }
#pragma unroll
    for (int s_ = 0; s_ < 15; ++s_) { float m[16];
#pragma unroll
        for (int q = 0; q < 4; ++q) { const f32x4 v = *(const LAS f32x4*)(M2 + s_ * 20 + 4 * q); m[4 * q] = v.x; m[4 * q + 1] = v.y; m[4 * q + 2] = v.z; m[4 * q + 3] = v.w; }
        float acc = Kp[s_];
#pragma unroll
        for (int t = s_ + 1; t < 16; ++t) acc -= m[t] * Bp[t];
        asm volatile("" : "+v"(acc) :: "memory"); Kp[s_] = acc; __builtin_amdgcn_sched_barrier(0); }
    __builtin_amdgcn_sched_barrier(0);
    { float ng[16];
#pragma unroll
      for (int t = 0; t < 16; ++t) ng[t] = -Bp[t];
      *(v4u*)(CK + 256 + 4608 + lane * 32) = PACK8(ng, 0); *(v4u*)(CK + 256 + 4608 + lane * 32 + 16) = PACK8(ng, 8); }
    *(LAS v4u*)(TG + lane * 24) = PACK8(Kp, 0); *(LAS v4u*)(TG + lane * 24 + 8) = PACK8(Kp, 8);
    __builtin_amdgcn_sched_barrier(0);
    { float hh[16], ps[16];
#pragma unroll
      for (int s_ = 0; s_ < 16; ++s_) { hh[s_] = N1[s_ * 20 + fr]; ps[s_] = N2[s_ * 20 + fr]; }
#pragma unroll
      for (int s_ = 14; s_ >= 0; --s_) { float m[16];
#pragma unroll
        for (int q = 0; q < 4; ++q) { const f32x4 v = *(const LAS f32x4*)(M1 + s_ * 20 + 4 * q); m[4 * q] = v.x; m[4 * q + 1] = v.y; m[4 * q + 2] = v.z; m[4 * q + 3] = v.w; }
        float acc = hh[s_];
#pragma unroll
        for (int u = s_ + 1; u < 16; ++u) acc -= m[u] * hh[u];
        asm volatile("" : "+v"(acc) :: "memory"); hh[s_] = acc; __builtin_amdgcn_sched_barrier(0); }
#pragma unroll
      for (int s_ = 0; s_ < 15; ++s_) { float m[16];
#pragma unroll
        for (int q = 0; q < 4; ++q) { const f32x4 v = *(const LAS f32x4*)(M2 + s_ * 20 + 4 * q); m[4 * q] = v.x; m[4 * q + 1] = v.y; m[4 * q + 2] = v.z; m[4 * q + 3] = v.w; }
        float acc = ps[s_];
#pragma unroll
        for (int u = s_ + 1; u < 16; ++u) acc -= m[u] * hh[u];
        asm volatile("" : "+v"(acc) :: "memory"); ps[s_] = acc; __builtin_amdgcn_sched_barrier(0); }
      LDS_WAIT(); asm volatile("" ::: "memory");
#pragma unroll
      for (int s_ = 0; s_ < 16; ++s_) N1[s_ * 20 + fr] = hh[s_];
      *(LAS v4u*)(PST + fr * 24) = PACK8(ps, 0); *(LAS v4u*)(PST + fr * 24 + 8) = PACK8(ps, 8); }
    LDS_WAIT(); asm volatile("" ::: "memory");
    __builtin_amdgcn_sched_barrier(0);
#pragma unroll
    for (int s_ = 0; s_ < 16; ++s_) { float m[16];
#pragma unroll
        for (int q = 0; q < 4; ++q) { const f32x4 v = *(const LAS f32x4*)(N1 + s_ * 20 + 4 * q); m[4 * q] = v.x; m[4 * q + 1] = v.y; m[4 * q + 2] = v.z; m[4 * q + 3] = v.w; }
#pragma unroll
        for (int t = s_; t < 16; ++t) ro[t] -= m[t] * al[s_];
        asm volatile("" ::: "memory"); __builtin_amdgcn_sched_barrier(0); }
#pragma unroll
    for (int t = 0; t < 16; ++t) OMg[t * 72 + lane] = bfr1(ro[t]);
    LDS_WAIT(); asm volatile("" ::: "memory");
    __builtin_amdgcn_sched_barrier(0);
    { bf16x4 vf[4];
#pragma unroll
      for (int it = 0; it < 4; ++it) vf[it] = *(const LAS bf16x4*)(VT + (it * 16 + fr) * 24 + fq * 4);
#pragma unroll
      for (int kt = 0; kt < 4; ++kt) { const bf16x4 gf = *(const LAS bf16x4*)(TG + (kt * 16 + fr) * 24 + fq * 4);
#pragma unroll
        for (int it = 0; it < 4; ++it) { const f32x4 d = mfma16(gf, vf[it], zero4()); v2u dw; dw.x = pk2(d[0], d[1]); dw.y = pk2(d[2], d[3]); *(v2u*)(CP + it * WK_PRV + kt * 512 + lane * 8) = dw; } }
      const bf16x4 pf = *(const LAS bf16x4*)(PST + fr * 24 + fq * 4);
#pragma unroll
      for (int it = 0; it < 4; ++it) { const f32x4 o = mfma16(pf, vf[it], zero4()); *(f32x4*)(CP + it * WK_PRV + 2048 + lane * 16) = o; } }
    LDS_WAIT(); asm volatile("" ::: "memory");
}
constexpr int WQ_CH = WK_PRV + WK_SHR, WQ_SLOT = 4 * WQ_CH, WQ_PCS = WQ_CH / 16, WQ_NWL = 4 * WQ_PCS / 64;
__device__ __forceinline__ void wkv_seq_chunk(const LAS unsigned char* sp, f32x4 (&acc)[4], float* orow, int lane, int fr, int fq) {
    const LAS unsigned char* sh = sp + WK_PRV;
    bf16x8 af[2], of[2]; bf16x4 gf[4]; f32x4 wt[4], dt[4];
#pragma unroll
    for (int s = 0; s < 2; ++s) { const LAS bf16* ap = (const LAS bf16*)(sh + 256) + fr * 72 + 32 * s + 4 * fq; const v2u lo = *(const LAS v2u*)ap, hi = *(const LAS v2u*)(ap + 16);
        af[s] = __builtin_bit_cast(bf16x8, (v4u){lo.x, lo.y, hi.x, hi.y});
        const LAS bf16* op = (const LAS bf16*)(sh + 256 + 2304) + fr * 72 + 32 * s + 4 * fq; const v2u lo2 = *(const LAS v2u*)op, hi2 = *(const LAS v2u*)(op + 16);
        of[s] = __builtin_bit_cast(bf16x8, (v4u){lo2.x, lo2.y, hi2.x, hi2.y}); }
#pragma unroll
    for (int kt = 0; kt < 4; ++kt) { gf[kt] = *(const LAS bf16x4*)((const LAS bf16*)(sh + 256 + 4608) + (kt * 16 + fr) * 16 + 4 * fq);
        wt[kt] = *(const LAS f32x4*)(sh + (16 * kt + 4 * fq) * 4); { float f_[4]; unpack4(*(const LAS v2u*)(sp + kt * 512 + lane * 8), f_); dt[kt] = (f32x4){f_[0], f_[1], f_[2], f_[3]}; } }
    const f32x4 ov = *(const LAS f32x4*)(sp + 2048 + lane * 16);
    bf16x8 sbf[2];
#pragma unroll
    for (int s = 0; s < 2; ++s) { v4u w; w.x = pk2(acc[2 * s][0], acc[2 * s][1]); w.y = pk2(acc[2 * s][2], acc[2 * s][3]); w.z = pk2(acc[2 * s + 1][0], acc[2 * s + 1][1]); w.w = pk2(acc[2 * s + 1][2], acc[2 * s + 1][3]);
        sbf[s] = __builtin_bit_cast(bf16x8, w); }
    f32x4 x = zero4();
    x = __builtin_amdgcn_mfma_f32_16x16x32_bf16(af[0], sbf[0], x, 0, 0, 0); x = __builtin_amdgcn_mfma_f32_16x16x32_bf16(af[1], sbf[1], x, 0, 0, 0);
    f32x4 o = __builtin_amdgcn_mfma_f32_16x16x32_bf16(of[0], sbf[0], ov, 0, 0, 0); o = __builtin_amdgcn_mfma_f32_16x16x32_bf16(of[1], sbf[1], o, 0, 0, 0);
    v2u xw; xw.x = pk2(x[0], x[1]); xw.y = pk2(x[2], x[3]); const bf16x4 xb = __builtin_bit_cast(bf16x4, xw);
#pragma unroll
    for (int kt = 0; kt < 4; ++kt) acc[kt] = mfma16(gf[kt], xb, acc[kt] * wt[kt] + dt[kt]);
    orow[0] = o[0]; orow[512] = o[1]; orow[1024] = o[2]; orow[1536] = o[3];
}
__device__ __forceinline__ void wkv_seq_item(const Ctx& C, const Ax& a, int l, int item) {
    const int bh = item >> 2, rg = item & 3, b = bh >> 3, h = bh & 7, lane = C.lane, fr = lane & 15, fq = lane >> 4;
    const unsigned char* CK = a.ws + WS_CK + (size_t)bh * 128 * WK_SHR; const unsigned char* CP = a.ws + WS_CP + ((size_t)bh * 128 * 4 + rg) * WK_PRV;
    float* OC = (float*)(a.ws + WS_OC) + ((size_t)b * SEQ) * 512 + h * 64 + rg * 16 + fr;
#define WQ_COMPUTE(blk) do { const LAS unsigned char* sbp = C.lds + ((blk) % 3) * WQ_SLOT; \
            _Pragma("unroll 2") for (int cq = 0; cq < 4; ++cq) wkv_seq_chunk(sbp + cq * WQ_CH, acc, OC + (size_t)(((blk) * 4 + cq) * 16 + 4 * fq) * 512, lane, fr, fq); } while (0)
    static_assert(4 * WQ_PCS == WQ_NWL * 64 && WQ_NWL > 35 && WQ_NWL <= 42 && 3 * WQ_SLOT <= SCR_BYTES, "ring geometry");
    if (C.wave == 0) {
        f32x4 acc[4];
#pragma unroll
        for (int kt = 0; kt < 4; ++kt) acc[kt] = zero4();
        __builtin_amdgcn_s_barrier(); asm volatile("" ::: "memory");
        for (int blk = 0; blk < 32; ++blk) { WQ_COMPUTE(blk); asm volatile("s_waitcnt lgkmcnt(0)" ::: "memory"); __builtin_amdgcn_s_barrier(); asm volatile("" ::: "memory"); }
        float* so = a.out + O_WKVP + ((((size_t)l * NB + b) * 8 + h) * 64 + rg * 16 + fr) * 64 + 4 * fq;
#pragma unroll
        for (int kt = 0; kt < 4; ++kt) *(f32x4*)(so + 16 * kt) = acc[kt];
    } else {
        const int w1 = C.wave - 1; const bool seven = (w1 + 35) < WQ_NWL;
        const unsigned char* wsb = a.ws; unsigned qoff[6], qstr[6];
#pragma unroll
        for (int i = 0; i < 6; ++i) { const int p = (w1 + 7 * i) * 64 + lane, cq = p / WQ_PCS, q = p - cq * WQ_PCS; const bool pr = q < WK_PRV / 16;
            qoff[i] = pr ? (unsigned)(WS_CP + ((size_t)bh * 128 * 4 + rg) * WK_PRV) + (unsigned)(cq * 4 * WK_PRV + q * 16) : (unsigned)(WS_CK + (size_t)bh * 128 * WK_SHR) + (unsigned)(cq * WK_SHR + (q - WK_PRV / 16) * 16);
            qstr[i] = pr ? (unsigned)(16 * WK_PRV) : (unsigned)(4 * WK_SHR); }
#define WQ_DMA(blk) do { _Pragma("unroll") for (int i = 0; i < 6; ++i) if (i < 5 || seven) \
            __builtin_amdgcn_global_load_lds((const unsigned*)(wsb + (qoff[i] + (unsigned)(blk) * qstr[i])), (LAS unsigned*)(C.lds + ((blk) % 3) * WQ_SLOT + (w1 + 7 * i) * 1024), 16, 0, 0); } while (0)
#define WQ_WAIT_OLDER() do { if (seven) asm volatile("s_waitcnt vmcnt(6)" ::: "memory"); else asm volatile("s_waitcnt vmcnt(5)" ::: "memory"); } while (0)
        WQ_DMA(0); WQ_DMA(1); WQ_WAIT_OLDER();
        __builtin_amdgcn_s_barrier(); asm volatile("" ::: "memory");
        for (int blk = 0; blk < 32; ++blk) {
            if (blk + 2 < 32) { WQ_DMA(blk + 2); WQ_WAIT_OLDER(); }
            else asm volatile("s_waitcnt vmcnt(0)" ::: "memory");
            __builtin_amdgcn_s_barrier(); asm volatile("" ::: "memory");
        }
#undef WQ_DMA
#undef WQ_WAIT_OLDER
    }
#undef WQ_COMPUTE
    __syncthreads();
}
__device__ __forceinline__ void rwkv_sample_witem(const Ctx& C, const Ax& a, int l, int witem) {
    const float* RW = (const float*)(a.ws + WS_RW); float* OC = (float*)(a.ws + WS_OC);
    const int n = witem >> 4, h = (witem >> 1) & 7, half = witem & 1, g = C.lane & 15, rq = C.lane >> 4;
    const unsigned char* p = (const unsigned char*)RW + ((size_t)(MP + n) * 8 + h) * RWB;
    const f32x4 lw4 = *(const f32x4*)(p + 16 * g), kk4 = rw_ld4(p, RW_KK, 4 * g), b4 = rw_ld4(p, RW_KB, 4 * g), k4 = rw_ld4(p, RW_K, 4 * g), r4 = rw_ld4(p, RW_R, 4 * g);
    const f32x4 w4 = (f32x4){__expf(lw4.x), __expf(lw4.y), __expf(lw4.z), __expf(lw4.w)};
    const float* sin_ = a.in(I_SWKV) + (((size_t)l * NS + n) * 8 + h) * 4096; float* sout = a.out + O_WKVS + (((size_t)l * NS + n) * 8 + h) * 4096;
    f32x4 Sv[8]; bf16 vr[8];
#pragma unroll
    for (int it = 0; it < 8; ++it) { const int i = half * 32 + it * 4 + rq; Sv[it] = __builtin_nontemporal_load((const f32x4*)(sin_ + i * 64 + 4 * g)); vr[it] = *(const bf16*)(p + RW_V + i * 2); }
    __builtin_amdgcn_sched_barrier(0);
#pragma unroll
    for (int it = 0; it < 8; ++it) { const int i = half * 32 + it * 4 + rq; const f32x4 S = Sv[it]; const float vi = bf1(vr[it]);
        const float sa = -rowsum16((S.x * kk4.x + S.y * kk4.y) + (S.z * kk4.z + S.w * kk4.w));
        f32x4 T; T.x = S.x * w4.x + (sa * b4.x + vi * k4.x); T.y = S.y * w4.y + (sa * b4.y + vi * k4.y); T.z = S.z * w4.z + (sa * b4.z + vi * k4.z); T.w = S.w * w4.w + (sa * b4.w + vi * k4.w);
        const float o = rowsum16((T.x * r4.x + T.y * r4.y) + (T.z * r4.z + T.w * r4.w));
        __builtin_nontemporal_store(T, (f32x4*)(sout + i * 64 + 4 * g));
        if (g == 0) OC[(size_t)(MP + n) * 512 + h * 64 + i] = o; }
}
__device__ __forceinline__ void rwkv_post_phase(const Ctx& C, const Ax& a, int l) {
    const float* RW = (const float*)(a.ws + WS_RW); const float* OC = (const float*)(a.ws + WS_OC); const float* GATE = (const float*)(a.ws + WS_GATE); bf16* YC = (bf16*)(a.ws + WS_YC);
    const int gw = C.bid * NWAVES + C.wave, NGW = C.G * NWAVES, g = C.lane & 15, rq = C.lane >> 4;
    const float* lg = a.in(I_LNXG) + l * 512; const float* lb = a.in(I_LNXB) + l * 512; const float* rk = a.in(I_RK) + l * 512;
    const int h = (gw * 4 + rq) & 7, ch = h * 64 + 4 * g;
    const f32x4 rkv = *(const f32x4*)(rk + ch), lgv = *(const f32x4*)(lg + ch), lbv = *(const f32x4*)(lb + ch);
    constexpr int NIT = MT * 8 / 4;
    for (int it0 = gw; it0 < NIT; it0 += 3 * NGW) {
        f32x4 po[3], pg[3]; v2u pk[3], pr[3], pv[3];
#pragma unroll
        for (int u = 0; u < 3; ++u) { const int it = it0 + u * NGW; if (it < NIT) { const int row = (it * 4 + rq) >> 3; const unsigned char* rw = (const unsigned char*)RW + ((size_t)row * 8 + h) * RWB + 8 * g;
            po[u] = *(const f32x4*)(OC + (size_t)row * 512 + ch); pg[u] = *(const f32x4*)(GATE + (size_t)row * 512 + ch);
            pk[u] = *(const v2u*)(rw + RW_K); pr[u] = *(const v2u*)(rw + RW_R); pv[u] = *(const v2u*)(rw + RW_V); } }
        __builtin_amdgcn_sched_barrier(0);
#pragma unroll
        for (int u = 0; u < 3; ++u) { const int it = it0 + u * NGW; if (it < NIT) { const int row = (it * 4 + rq) >> 3; const f32x4 o = po[u];
            const float mu = rowsum16((o.x + o.y) + (o.z + o.w)) * (1.0f / 64.0f); const f32x4 d = o - mu;
            const float var = rowsum16((d.x * d.x + d.y * d.y) + (d.z * d.z + d.w * d.w)) * (1.0f / 64.0f); const float rstd = 1.0f / sqrtf(var + 64e-5f);
            float kf[4], rf[4], vf[4]; unpack4(pk[u], kf); unpack4(pr[u], rf); unpack4(pv[u], vf);
            const float bs = rowsum16((rf[0] * kf[0] * rkv.x + rf[1] * kf[1] * rkv.y) + (rf[2] * kf[2] * rkv.z + rf[3] * kf[3] * rkv.w));
            const f32x4 v4 = (f32x4){vf[0], vf[1], vf[2], vf[3]};
            const f32x4 y = (d * rstd * lgv + lbv + bs * v4) * pg[u];
            v2u w; w.x = pk2(y.x, y.y); w.y = pk2(y.z, y.w); *(v2u*)(YC + (size_t)row * DM + 1024 + ch) = w; } }
        __builtin_amdgcn_sched_barrier(0);
    }
}

__device__ __forceinline__ float ret_lg(int h) { return log1pf(-exp2f(-5.0f - (float)h)); }
constexpr int RS = 136;
__device__ __forceinline__ void rot8(const bf16* src, const float* cs, int c8, float scale, float (&lo)[8], float (&hi)[8]) {
    float x1[8], x2[8]; unpack8(*(const v4u*)(src + c8 * 8), x1); unpack8(*(const v4u*)(src + 64 + c8 * 8), x2);
    const f32x4* cp = (const f32x4*)(cs + 16 * c8); const f32x4 t0 = cp[0], t1 = cp[1], t2 = cp[2], t3 = cp[3];
    const float cc[8] = {t0.x, t0.z, t1.x, t1.z, t2.x, t2.z, t3.x, t3.z}, sn[8] = {t0.y, t0.w, t1.y, t1.w, t2.y, t2.w, t3.y, t3.w};
#pragma unroll
    for (int j = 0; j < 8; ++j) { lo[j] = (x1[j] * cc[j] - x2[j] * sn[j]) * scale; hi[j] = (x2[j] * cc[j] + x1[j] * sn[j]) * scale; }
}
struct RotX { v4u a, b; }; struct RotT { f32x4 t0, t1, t2, t3; };
__device__ __forceinline__ RotX rot_ldx(const bf16* src, int c8) { RotX r; r.a = *(const v4u*)(src + c8 * 8); r.b = *(const v4u*)(src + 64 + c8 * 8); return r; }
__device__ __forceinline__ RotT rot_ldt(const float* cs, int c8) { const f32x4* cp = (const f32x4*)(cs + 16 * c8); RotT r; r.t0 = cp[0]; r.t1 = cp[1]; r.t2 = cp[2]; r.t3 = cp[3]; return r; }
__device__ __forceinline__ void rot_ap(const RotX& x, const RotT& t, float scale, float (&lo)[8], float (&hi)[8]) {
    float x1[8], x2[8]; unpack8(x.a, x1); unpack8(x.b, x2);
    const float cc[8] = {t.t0.x, t.t0.z, t.t1.x, t.t1.z, t.t2.x, t.t2.z, t.t3.x, t.t3.z}, sn[8] = {t.t0.y, t.t0.w, t.t1.y, t.t1.w, t.t2.y, t.t2.w, t.t3.y, t.t3.w};
#pragma unroll
    for (int j = 0; j < 8; ++j) { lo[j] = (x1[j] * cc[j] - x2[j] * sn[j]) * scale; hi[j] = (x2[j] * cc[j] + x1[j] * sn[j]) * scale; }
}
__device__ __forceinline__ void ret_pass1_item(const Ctx& C, const Ax& a, int item) {
    const bf16* P = (const bf16*)(a.ws + WS_P); const float* CS = (const float*)(a.ws + WS_ROPE); float* KVT = (float*)(a.ws + WS_KVT);
    const int b = item >> 6, h = (item >> 4) & 3, c = item & 15; const size_t row0 = (size_t)b * SEQ + c * 128; const float lg = ret_lg(h);
    LAS bf16* KT = (LAS bf16*)C.lds; LAS bf16* VT = KT + 128 * RS;
    { RotX kx[2]; RotT kt[2]; v4u vw[4];
#pragma unroll
      for (int u = 0; u < 2; ++u) { const int it = C.tid + u * (NWAVES * 64), tt = it & 127, c8 = it >> 7; kx[u] = rot_ldx(P + (row0 + tt) * PIN + PB_ + 512 + h * 128, c8); kt[u] = rot_ldt(CS + (size_t)(c * 128 + tt) * 128, c8); }
#pragma unroll
      for (int u = 0; u < 4; ++u) { const int it = C.tid + u * (NWAVES * 64), tt = it & 127, c8 = it >> 7; vw[u] = *(const v4u*)(P + (row0 + tt) * PIN + PB_ + 1024 + h * 128 + c8 * 8); }
      __builtin_amdgcn_sched_barrier(0);
#pragma unroll
      for (int u = 0; u < 2; ++u) { const int it = C.tid + u * (NWAVES * 64), tt = it & 127, c8 = it >> 7; float lo[8], hi[8];
        rot_ap(kx[u], kt[u], 0.08838834764831845f * __expf(lg * (float)(127 - tt)), lo, hi);
#pragma unroll
        for (int j = 0; j < 8; ++j) { KT[(c8 * 8 + j) * RS + tt] = (bf16)(pk2(lo[j], 0.f) & 0xffffu); KT[(64 + c8 * 8 + j) * RS + tt] = (bf16)(pk2(hi[j], 0.f) & 0xffffu); } }
#pragma unroll
      for (int u = 0; u < 4; ++u) { const int it = C.tid + u * (NWAVES * 64), tt = it & 127, c8 = it >> 7; const unsigned ww[4] = {vw[u].x, vw[u].y, vw[u].z, vw[u].w};
#pragma unroll
        for (int j = 0; j < 4; ++j) { VT[(c8 * 8 + 2 * j) * RS + tt] = (bf16)(ww[j] & 0xffffu); VT[(c8 * 8 + 2 * j + 1) * RS + tt] = (bf16)(ww[j] >> 16); } } }
    __syncthreads();
    const int fr = C.lane & 15, fq = C.lane >> 4, w = C.wave;
    f32x4 acc[8];
#pragma unroll
    for (int et = 0; et < 8; ++et) acc[et] = zero4();
#pragma unroll
    for (int ks = 0; ks < 4; ++ks) { const bf16x8 kf = *(const LAS bf16x8*)(KT + (16 * w + fr) * RS + ks * 32 + fq * 8);
#pragma unroll
        for (int et = 0; et < 8; ++et) { const bf16x8 vf = *(const LAS bf16x8*)(VT + (16 * et + fr) * RS + ks * 32 + fq * 8); acc[et] = __builtin_amdgcn_mfma_f32_16x16x32_bf16(kf, vf, acc[et], 0, 0, 0); } }
    float* o = KVT + (size_t)item * 16384;
#pragma unroll
    for (int et = 0; et < 8; ++et) *(f32x4*)(o + (size_t)(16 * et + fr) * 128 + 16 * w + 4 * fq) = acc[et];
    __syncthreads();
}
__device__ __forceinline__ void ret_prefix_phase(const Ctx& C, const Ax& a, int l) {
    const float* KVT = (const float*)(a.ws + WS_KVT); bf16* STB = (bf16*)(a.ws + WS_STB);
    const int gt = C.bid * (NWAVES * 64) + C.tid, NT = C.G * NWAVES * 64;
    for (int idx = gt; idx < 16 * 4096; idx += NT) { const int bh = idx >> 12, r = idx & 4095, e = r >> 5, d4 = (r & 31) * 4; const int h = bh & 3;
        const float g128 = __expf(ret_lg(h) * 128.0f); const size_t base = (size_t)bh * 16 * 16384 + e * 128 + d4;
        f32x4 kv[16];
#pragma unroll
        for (int c = 0; c < 16; ++c) kv[c] = *(const f32x4*)(KVT + base + (size_t)c * 16384);
        f32x4 S = zero4();
#pragma unroll
        for (int c = 0; c < 16; ++c) { v2u w; w.x = pk2(S.x, S.y); w.y = pk2(S.z, S.w); *(v2u*)(STB + base + (size_t)c * 16384) = w; S = S * g128 + kv[c]; }
        float* o = a.out + O_RETP + ((size_t)l * 16 + bh) * 16384 + e;
        o[(size_t)d4 * 128] = S.x; o[(size_t)(d4 + 1) * 128] = S.y; o[(size_t)(d4 + 2) * 128] = S.z; o[(size_t)(d4 + 3) * 128] = S.w; }
}
__device__ __forceinline__ void ret_pass2_item(const Ctx& C, const Ax& a, int l, int item) {
    const bf16* P = (const bf16*)(a.ws + WS_P); const float* CS = (const float*)(a.ws + WS_ROPE); bf16* YC = (bf16*)(a.ws + WS_YC);
    const int b = item >> 6, h = (item >> 4) & 3, c = item & 15; const size_t row0 = (size_t)b * SEQ + c * 128; const float lg = ret_lg(h);
    LAS bf16* QL = (LAS bf16*)C.lds; LAS bf16* KL = QL + 128 * RS; LAS bf16* VT = KL + 128 * RS; LAS bf16* ST = VT + 128 * RS;
    { RotX qx[2], kx[2]; RotT kt[2]; v4u vw[4], sw[4]; const bf16* stb = (const bf16*)(a.ws + WS_STB) + (size_t)item * 16384;
#pragma unroll
      for (int u = 0; u < 2; ++u) { const int it = C.tid + u * (NWAVES * 64), tt = it & 127, c8 = it >> 7; const bf16* pr = P + (row0 + tt) * PIN + PB_ + h * 128;
        qx[u] = rot_ldx(pr, c8); kx[u] = rot_ldx(pr + 512, c8); kt[u] = rot_ldt(CS + (size_t)(c * 128 + tt) * 128, c8); }
#pragma unroll
      for (int u = 0; u < 4; ++u) { const int it = C.tid + u * (NWAVES * 64), tt = it & 127, c8 = it >> 7; vw[u] = *(const v4u*)(P + (row0 + tt) * PIN + PB_ + 1024 + h * 128 + c8 * 8);
        sw[u] = *(const v4u*)(stb + (it >> 4) * 128 + (it & 15) * 8); }
      __builtin_amdgcn_sched_barrier(0);
#pragma unroll
      for (int u = 0; u < 2; ++u) { const int it = C.tid + u * (NWAVES * 64), tt = it & 127, c8 = it >> 7; float lo[8], hi[8];
        rot_ap(qx[u], kt[u], __expf(lg * (float)(tt + 1)), lo, hi);
        *(LAS v4u*)(QL + tt * RS + c8 * 8) = pack8(lo); *(LAS v4u*)(QL + tt * RS + 64 + c8 * 8) = pack8(hi);
        rot_ap(kx[u], kt[u], 0.08838834764831845f * __expf(-lg * (float)(tt + 1)), lo, hi);
        *(LAS v4u*)(KL + tt * RS + c8 * 8) = pack8(lo); *(LAS v4u*)(KL + tt * RS + 64 + c8 * 8) = pack8(hi); }
#pragma unroll
      for (int u = 0; u < 4; ++u) { const int it = C.tid + u * (NWAVES * 64), tt = it & 127, c8 = it >> 7; const unsigned ww[4] = {vw[u].x, vw[u].y, vw[u].z, vw[u].w};
#pragma unroll
        for (int j = 0; j < 4; ++j) { VT[(c8 * 8 + 2 * j) * RS + tt] = (bf16)(ww[j] & 0xffffu); VT[(c8 * 8 + 2 * j + 1) * RS + tt] = (bf16)(ww[j] >> 16); }
        *(LAS v4u*)(ST + (it >> 4) * RS + (it & 15) * 8) = sw[u]; } }
    __syncthreads();
    const int fr = C.lane & 15, fq = C.lane >> 4, w = C.wave, i0 = 16 * w;
    bf16x8 qf[4];
#pragma unroll
    for (int ks = 0; ks < 4; ++ks) qf[ks] = *(const LAS bf16x8*)(QL + (i0 + fr) * RS + ks * 32 + fq * 8);
    f32x4 sc[8];
#pragma unroll
    for (int jt = 0; jt < 8; ++jt) { sc[jt] = zero4();
        if (jt <= w) {
#pragma unroll
            for (int ks = 0; ks < 4; ++ks) { const bf16x8 kf = *(const LAS bf16x8*)(KL + (16 * jt + fr) * RS + ks * 32 + fq * 8); sc[jt] = __builtin_amdgcn_mfma_f32_16x16x32_bf16(kf, qf[ks], sc[jt], 0, 0, 0); }
            if (jt == w) {
#pragma unroll
                for (int r = 0; r < 4; ++r) if (4 * fq + r > fr) sc[jt][r] = 0.f; } } }
    __syncthreads();
    LAS bf16* PL = KL;
#pragma unroll
    for (int jt = 0; jt < 8; ++jt) { v2u pw; pw.x = pk2(sc[jt][0], sc[jt][1]); pw.y = pk2(sc[jt][2], sc[jt][3]); *(LAS v2u*)(PL + (i0 + fr) * RS + 16 * jt + 4 * fq) = pw; }
    LDS_WAIT(); asm volatile("" ::: "memory");
    f32x4 acc[8];
#pragma unroll
    for (int et = 0; et < 8; ++et) acc[et] = zero4();
#pragma unroll
    for (int ks = 0; ks < 4; ++ks) { if (2 * ks <= w) { const bf16x8 pf = *(const LAS bf16x8*)(PL + (i0 + fr) * RS + ks * 32 + fq * 8);
#pragma unroll
            for (int et = 0; et < 8; ++et) { const bf16x8 vf = *(const LAS bf16x8*)(VT + (16 * et + fr) * RS + ks * 32 + fq * 8); acc[et] = __builtin_amdgcn_mfma_f32_16x16x32_bf16(vf, pf, acc[et], 0, 0, 0); } } }
    if (c > 0) {
#pragma unroll
        for (int ks = 0; ks < 4; ++ks)
#pragma unroll
            for (int et = 0; et < 8; ++et) { const bf16x8 sf = *(const LAS bf16x8*)(ST + (16 * et + fr) * RS + ks * 32 + fq * 8); acc[et] = __builtin_amdgcn_mfma_f32_16x16x32_bf16(sf, qf[ks], acc[et], 0, 0, 0); } }
    float s = 0.f;
#pragma unroll
    for (int et = 0; et < 8; ++et) s += (acc[et][0] + acc[et][1]) + (acc[et][2] + acc[et][3]);
    s += __shfl_xor(s, 16); s += __shfl_xor(s, 32); const float mu = s * (1.0f / 128.0f);
    float q = 0.f;
#pragma unroll
    for (int et = 0; et < 8; ++et) { acc[et] = acc[et] - mu; q += (acc[et][0] * acc[et][0] + acc[et][1] * acc[et][1]) + (acc[et][2] * acc[et][2] + acc[et][3] * acc[et][3]); }
    q += __shfl_xor(q, 16); q += __shfl_xor(q, 32); const float rstd = 1.0f / sqrtf(q * (1.0f / 128.0f) + 1e-6f);
    const size_t row = row0 + i0 + fr;
#pragma unroll
    for (int et = 0; et < 8; ++et) { const int e = 16 * et + 4 * fq; float gg[4]; unpack4(*(const v2u*)(P + row * PIN + PB_ + 1536 + h * 128 + e), gg);
        v2u wv; wv.x = pk2(gg[0] * sigm(gg[0]) * acc[et][0] * rstd, gg[1] * sigm(gg[1]) * acc[et][1] * rstd); wv.y = pk2(gg[2] * sigm(gg[2]) * acc[et][2] * rstd, gg[3] * sigm(gg[3]) * acc[et][3] * rstd);
        *(v2u*)(YC + row * DM + 512 + h * 128 + e) = wv; }
    __syncthreads();
}
__device__ __forceinline__ void ret_sample_witem(const Ctx& C, const Ax& a, int l, int witem) {
    const bf16* P = (const bf16*)(a.ws + WS_P); const float* CS = (const float*)(a.ws + WS_ROPE) + (size_t)2048 * 128; bf16* YC = (bf16*)(a.ws + WS_YC);
    const int n = witem >> 2, h = witem & 3, lane = C.lane; const float gam = 1.0f - exp2f(-5.0f - (float)h);
    LAS float* qk = (LAS float*)(C.lds + C.wave * 1024);
    const bf16* pr = P + (size_t)(MP + n) * PIN + PB_ + h * 128;
    { const float co = CS[2 * lane], si = CS[2 * lane + 1]; const float q1 = bf1(pr[lane]), q2 = bf1(pr[64 + lane]), k1 = bf1(pr[512 + lane]), k2 = bf1(pr[512 + 64 + lane]);
      qk[lane] = q1 * co - q2 * si; qk[64 + lane] = q2 * co + q1 * si; qk[128 + lane] = (k1 * co - k2 * si) * 0.08838834764831845f; qk[192 + lane] = (k2 * co + k1 * si) * 0.08838834764831845f; }
    LDS_WAIT(); asm volatile("" ::: "memory");
    const float dotp = wave_sum(qk[lane] * qk[128 + lane] + qk[64 + lane] * qk[192 + lane]);
    const int half = lane >> 5, el = lane & 31;
    float vv[4]; unpack4(*(const v2u*)(pr + 1024 + 4 * el), vv); const f32x4 v4 = (f32x4){vv[0], vv[1], vv[2], vv[3]};
    const float* sin_ = a.in(I_SRET) + (((size_t)l * NS + n) * 4 + h) * 16384; float* sout = a.out + O_RETS + (((size_t)l * NS + n) * 4 + h) * 16384;
    f32x4 oa = zero4();
    unsigned lof = (unsigned)(half * 128 + 4 * el) * 4u; asm volatile("" : "+v"(lof));
    f32x4 sa[8], sb[8];
#define RS_LOAD(buf, blk) do { _Pragma("unroll") for (int j = 0; j < 8; ++j) buf[j] = __builtin_nontemporal_load((const f32x4*)((const char*)sin_ + (lof + (unsigned)(2 * ((blk) * 8 + j)) * 512u))); } while (0)
#define RS_USE(buf, blk) do { _Pragma("unroll") for (int j = 0; j < 8; ++j) { const int d = 2 * ((blk) * 8 + j) + half; const float qd = qk[d], kd = qk[128 + d]; oa += qd * buf[j]; \
        __builtin_nontemporal_store(gam * buf[j] + kd * v4, (f32x4*)((char*)sout + (lof + (unsigned)(2 * ((blk) * 8 + j)) * 512u))); } } while (0)
    RS_LOAD(sa, 0);
#pragma unroll
    for (int blk = 0; blk < 8; blk += 2) {
        RS_LOAD(sb, blk + 1); __builtin_amdgcn_sched_barrier(0);
        RS_USE(sa, blk); __builtin_amdgcn_sched_barrier(0);
        if (blk + 2 < 8) RS_LOAD(sa, blk + 2);
        __builtin_amdgcn_sched_barrier(0);
        RS_USE(sb, blk + 1); __builtin_amdgcn_sched_barrier(0); }
#undef RS_LOAD
#undef RS_USE
    oa.x += __shfl_xor(oa.x, 32); oa.y += __shfl_xor(oa.y, 32); oa.z += __shfl_xor(oa.z, 32); oa.w += __shfl_xor(oa.w, 32);
    f32x4 o = gam * oa + dotp * v4;
    float s = (o.x + o.y) + (o.z + o.w);
#pragma unroll
    for (int m = 1; m < 32; m <<= 1) s += __shfl_xor(s, m);
    const float mu = s * (1.0f / 128.0f); o = o - mu; float q = (o.x * o.x + o.y * o.y) + (o.z * o.z + o.w * o.w);
#pragma unroll
    for (int m = 1; m < 32; m <<= 1) q += __shfl_xor(q, m);
    const float rstd = 1.0f / sqrtf(q * (1.0f / 128.0f) + 1e-6f);
    if (half == 0) { float gg[4]; unpack4(*(const v2u*)(pr + 1536 + 4 * el), gg);
        v2u wv; wv.x = pk2(gg[0] * sigm(gg[0]) * o.x * rstd, gg[1] * sigm(gg[1]) * o.y * rstd); wv.y = pk2(gg[2] * sigm(gg[2]) * o.z * rstd, gg[3] * sigm(gg[3]) * o.w * rstd);
        *(v2u*)(YC + (size_t)(MP + n) * DM + 512 + h * 128 + 4 * el) = wv; }
    LDS_WAIT(); asm volatile("" ::: "memory");
}

constexpr int XV_RS = 264;
__device__ __forceinline__ void xattn_prompt_unit(const Ctx& C, const Ax& a, int l, int unit) {
    const bf16* Q = (const bf16*)(a.ws + WS_Q); const bf16* MK = (const bf16*)(a.ws + WS_MK) + (size_t)l * MMEM * DM; const bf16* MVT = (const bf16*)(a.ws + WS_MVT) + (size_t)l * MMEM * DM; bf16* O = (bf16*)(a.ws + WS_O);
    const int b = unit >> 6, h = (unit >> 4) & 3, qt = unit & 15, fr = C.lane & 15, fq = C.lane >> 4;
    const size_t row = (size_t)b * SEQ + qt * 128 + C.wave * 16 + fr;
    LAS bf16* SB = (LAS bf16*)C.lds;
    v4u st[8];
    const bf16* kbase = MK + ((size_t)b * 256) * DM + h * 512; const bf16* vbase = MVT + (((size_t)b * 4 + h) * 512) * 256;
    unsigned kof[4], vof[8], sof[8];
#pragma unroll
    for (int i = 0; i < 8; ++i) { const int idx = C.tid + 512 * i, r = idx >> 5, c16 = idx & 31; vof[i] = (unsigned)(r * 256 + c16 * 8) * 2u; sof[i] = (unsigned)(r * XV_RS + c16 * 8) * 2u; if (i < 4) kof[i] = (unsigned)(r * DM + c16 * 8) * 2u; }
    const char* kb8 = (const char*)kbase; const char* vb8 = (const char*)vbase; LAS char* sb8 = (LAS char*)SB;
#define XK_LOAD(q) do { const char* pb_ = kb8 + ((size_t)(((q) & 3) * 64) * DM + ((q) >> 2) * 256) * 2; _Pragma("unroll") for (int i = 0; i < 4; ++i) st[i] = *(const v4u*)(pb_ + kof[i]); } while (0)
#define XK_STORE() do { _Pragma("unroll") for (int i = 0; i < 4; ++i) *(LAS v4u*)(sb8 + sof[i]) = st[i]; } while (0)
#define XV_LOAD(p) do { const char* pb_ = vb8 + (size_t)((p) * 128) * 256 * 2; _Pragma("unroll") for (int i = 0; i < 8; ++i) st[i] = *(const v4u*)(pb_ + vof[i]); } while (0)
#define XV_STORE() do { _Pragma("unroll") for (int i = 0; i < 8; ++i) *(LAS v4u*)(sb8 + sof[i]) = st[i]; } while (0)
    XK_LOAD(0);
    f32x4 sc[16];
#pragma unroll
    for (int jt = 0; jt < 16; ++jt) sc[jt] = zero4();
#pragma unroll
    for (int dh = 0; dh < 2; ++dh) {
        bf16x8 qf[8];
#pragma unroll
        for (int ks = 0; ks < 8; ++ks) qf[ks] = *(const bf16x8*)(Q + row * DM + h * 512 + dh * 256 + ks * 32 + fq * 8);
#pragma unroll
        for (int p = 0; p < 4; ++p) {
            __syncthreads(); XK_STORE(); __syncthreads();
            if (dh * 4 + p < 7) XK_LOAD(dh * 4 + p + 1); else XV_LOAD(0);
#pragma unroll
            for (int j4 = 0; j4 < 4; ++j4) {
#pragma unroll
                for (int ks = 0; ks < 8; ++ks) { const bf16x8 kf = *(const LAS bf16x8*)(SB + (j4 * 16 + fr) * XV_RS + ks * 32 + fq * 8); sc[p * 4 + j4] = __builtin_amdgcn_mfma_f32_16x16x32_bf16(kf, qf[ks], sc[p * 4 + j4], 0, 0, 0); }
                __builtin_amdgcn_sched_barrier(0); }
        }
    }
    float mx = -3.0e38f;
#pragma unroll
    for (int jt = 0; jt < 16; ++jt) mx = fmaxf(mx, fmaxf(fmaxf(sc[jt][0], sc[jt][1]), fmaxf(sc[jt][2], sc[jt][3])));
    mx = fmaxf(mx, __shfl_xor(mx, 16)); mx = fmaxf(mx, __shfl_xor(mx, 32));
    const float scale = 0.04419417382415922f; float sum = 0.f;
    bf16x8 pf[8];
#pragma unroll
    for (int s = 0; s < 8; ++s) { float p[8];
#pragma unroll
        for (int j = 0; j < 4; ++j) { p[j] = __expf((sc[2 * s][j] - mx) * scale); p[4 + j] = __expf((sc[2 * s + 1][j] - mx) * scale); }
        sum += ((p[0] + p[1]) + (p[2] + p[3])) + ((p[4] + p[5]) + (p[6] + p[7]));
        const v4u w = pack8(p); pf[s] = __builtin_bit_cast(bf16x8, w); }
    sum += __shfl_xor(sum, 16); sum += __shfl_xor(sum, 32); const float inv = 1.0f / sum;
#pragma unroll
    for (int p = 0; p < 4; ++p) {
        __syncthreads(); XV_STORE(); __syncthreads();
        if (p < 3) XV_LOAD(p + 1);
#pragma unroll
        for (int et = 0; et < 8; ++et) { f32x4 s4 = zero4(); const LAS bf16* vp = SB + (et * 16 + fr) * XV_RS + 4 * fq;
#pragma unroll
            for (int s = 0; s < 8; ++s) { const v2u lo = *(const LAS v2u*)(vp + 32 * s), hi = *(const LAS v2u*)(vp + 32 * s + 16); const v4u w = (v4u){lo.x, lo.y, hi.x, hi.y};
                s4 = __builtin_amdgcn_mfma_f32_16x16x32_bf16(__builtin_bit_cast(bf16x8, w), pf[s], s4, 0, 0, 0); }
            v2u w; w.x = pk2(s4[0] * inv, s4[1] * inv); w.y = pk2(s4[2] * inv, s4[3] * inv);
            *(v2u*)(O + row * DM + h * 512 + p * 128 + et * 16 + 4 * fq) = w;
            __builtin_amdgcn_sched_barrier(0); }
    }
    __syncthreads();
#undef XK_LOAD
#undef XK_STORE
#undef XV_LOAD
#undef XV_STORE
}
__device__ __forceinline__ void xattn_sample_item(const Ctx& C, const Ax& a, int l, int item) {
    bf16* O = (bf16*)(a.ws + WS_OS);
    const int n = item >> 2, h = item & 3, lane = C.lane, w = C.wave;
    LAS float* red = (LAS float*)C.lds; LAS float* part = red + 64;
    float q[8]; { const float* s0 = (const float*)(a.ws + WS_SPL) + (size_t)n * DM + h * 512 + 4 * lane; const float* s1 = s0 + (size_t)NS * DM;
                  const f32x4 a0 = *(const f32x4*)s0 + *(const f32x4*)s1, a1 = *(const f32x4*)(s0 + 256) + *(const f32x4*)(s1 + 256);
                  q[0] = a0.x; q[1] = a0.y; q[2] = a0.z; q[3] = a0.w; q[4] = a1.x; q[5] = a1.y; q[6] = a1.z; q[7] = a1.w; }
    const size_t base = ((((size_t)l * NS + n) * 256 + 32 * w) * 4 + h) * 512 + 4 * lane;
    const float* kp = a.in(I_CMK) + base; const float* vp = a.in(I_CMV) + base;
#define XS_LOAD(buf0, buf1, ptr, k8) do { _Pragma("unroll") for (int j = 0; j < 8; ++j) { buf0[j] = __builtin_nontemporal_load((const f32x4*)((ptr) + (size_t)((k8) * 8 + j) * 2048)); buf1[j] = __builtin_nontemporal_load((const f32x4*)((ptr) + (size_t)((k8) * 8 + j) * 2048 + 256)); } } while (0)
#define XS_DOT(buf0, buf1, k8) do { _Pragma("unroll") for (int j = 0; j < 8; ++j) { float d = (buf0[j].x * q[0] + buf0[j].y * q[1]) + (buf0[j].z * q[2] + buf0[j].w * q[3]) + (buf1[j].x * q[4] + buf1[j].y * q[5]) + (buf1[j].z * q[6] + buf1[j].w * q[7]); \
        d = rowsum16(d); d += __shfl_xor(d, 16); d += __shfl_xor(d, 32); if (lane == (k8) * 8 + j) myscore = d; } } while (0)
#define XS_ACC(buf0, buf1, k8) do { _Pragma("unroll") for (int j = 0; j < 8; ++j) { const float pj = __builtin_bit_cast(float, __builtin_amdgcn_readlane(__builtin_bit_cast(int, p), (k8) * 8 + j)); o0 += pj * buf0[j]; o1 += pj * buf1[j]; } } while (0)
    float myscore = 0.f;
    f32x4 xa0[8], xa1[8], xb0[8], xb1[8];
    XS_LOAD(xa0, xa1, kp, 0);
    XS_LOAD(xb0, xb1, kp, 1); XS_DOT(xa0, xa1, 0);
    XS_LOAD(xa0, xa1, kp, 2); XS_DOT(xb0, xb1, 1);
    XS_LOAD(xb0, xb1, kp, 3); XS_DOT(xa0, xa1, 2);
    XS_LOAD(xa0, xa1, vp, 0); XS_DOT(xb0, xb1, 3);
    const float scale = 0.04419417382415922f;
    float mx = wave_max(lane < 32 ? myscore : -3.0e38f); if (lane == 0) red[w] = mx; __syncthreads();
    mx = red[0];
#pragma unroll
    for (int i = 1; i < 8; ++i) mx = fmaxf(mx, red[i]);
    const float p = lane < 32 ? __expf((myscore - mx) * scale) : 0.f;
    const float ps = wave_sum(p); if (lane == 0) red[8 + w] = ps;
    f32x4 o0 = zero4(), o1 = zero4();
    XS_LOAD(xb0, xb1, vp, 1); XS_ACC(xa0, xa1, 0);
    XS_LOAD(xa0, xa1, vp, 2); XS_ACC(xb0, xb1, 1);
    XS_LOAD(xb0, xb1, vp, 3); XS_ACC(xa0, xa1, 2);
    XS_ACC(xb0, xb1, 3);
#undef XS_LOAD
#undef XS_DOT
#undef XS_ACC
    *(LAS f32x4*)(part + w * 512 + 4 * lane) = o0; *(LAS f32x4*)(part + w * 512 + 256 + 4 * lane) = o1;
    __syncthreads();
    float tot = 0.f;
#pragma unroll
    for (int i = 0; i < 8; ++i) tot += red[8 + i];
    { const int d = C.tid; float s = 0.f;
#pragma unroll
      for (int i = 0; i < 8; ++i) s += part[i * 512 + d];
      O[(size_t)n * DMS + h * 512 + d] = (bf16)(pk2(s / tot, 0.f) & 0xffffu); }
    __syncthreads();
}

#ifndef PHASE_MASK
#define PHASE_MASK 0xffffffffu
#endif
#define PM(k) ((PHASE_MASK >> (k)) & 1u)
#ifndef DUP_SUB
#define DUP_SUB 0u
#endif
#define REP(k) for (int rep_ = 0; rep_ < 1 + (int)((DUP_SUB >> (k)) & 1u); ++rep_)
#ifndef DUP_MASK
#define DUP_MASK 0
#endif
#ifndef MK_ONE_LAUNCH
#define MK_ONE_LAUNCH 1
#endif
constexpr int PH_PER_LAYER = 14, NPH = 1 + DEPTH * PH_PER_LAYER;
__global__ void __launch_bounds__(NWAVES * 64, 2) fwd_kernel(Args args) {
    extern __shared__ __attribute__((aligned(16))) unsigned char lds_raw[];
    LAS unsigned char* const lds = (LAS unsigned char*)lds_raw;
    const int wave_s = __builtin_amdgcn_readfirstlane((int)threadIdx.x >> 6);
    volatile LAS unsigned* MISC = (volatile LAS unsigned*)(lds + MISC_OFF);
    for (int u = threadIdx.x; u < (LDS_BYTES - MISC_OFF) / 4; u += NWAVES * 64) ((LAS unsigned*)(lds + MISC_OFF))[u] = 0u;
    __syncthreads();
    XcdBarrier bar; bar.bar = (unsigned*)(args.ws + WS_CTL) + CW_BAR; bar.x = 0; bar.st = nullptr;
    if (MK_ONE_LAUNCH) bar = xcd_barrier_post((unsigned*)(args.ws + WS_CTL) + CW_BAR, MISC + 8);
    bar.wave = wave_s;
    const int lo = args.ph_lo, hi = args.ph_hi;
#define IN(k) (lo <= (k) && (k) < hi)
#define SEAM(k) do { if (MK_ONE_LAUNCH && IN((k) + 1)) xcd_barrier(bar); } while (0)
#define SEAM2(k) do { if (MK_ONE_LAUNCH && IN((k) + 2)) xcd_barrier(bar); } while (0)
#define PHASE_CTX const Ctx C = mk_ctx(lds, wave_s); const Ax a = mk_ax(); unsigned char* const ws = a.ws; const int G = C.G, bid = C.bid; (void)ws; (void)G; (void)bid; \
    float* const XF = (float*)(ws + WS_XF); bf16* const HN = (bf16*)(ws + WS_HN); bf16* const PBUF = (bf16*)(ws + WS_P); bf16* const YC = (bf16*)(ws + WS_YC); bf16* const QB = (bf16*)(ws + WS_Q); \
    bf16* const OB = (bf16*)(ws + WS_O); bf16* const UB = (bf16*)(ws + WS_U); (void)XF; (void)HN; (void)PBUF; (void)YC; (void)QB; (void)OB; (void)UB

    if (IN(0)) { PHASE_CTX; if (PM(0)) p0_prologue(C, a); SEAM(0); }

    for (int l = 0; l < DEPTH; ++l) {
        const int pb = 1 + l * PH_PER_LAYER;
        if (IN(pb + 0)) { PHASE_CTX; const unsigned char* wl = ws + WS_WL + (size_t)l * LW_STRIDE;
            if (PM(1)) { pg8::Gemm g{HN, (const bf16*)(wl + LW_IN), MPAD, PIN, DM, DM, 64, (size_t)PIN * 128}; pg8::StaticOrder S; S.init(MPAD, PIN, G, bid); pg8::EpiBf16A<0> E{PBUF, PIN, nullptr};
              pg8::gemm_phase<pg8::EpiBf16A<0>, pg8::StaticOrder, true, true>(lds, g, S, E, C.tid); }
            if (G == 256) { const int nfull = (MPAD / 256) * (PIN / 256) - 3 * G;
                if ((bid >= nfull && bid < 64) || bid >= 128) { __syncthreads(); late_convert(C, a, l, bid < 64 ? bid - nfull : bid - 128 + (64 - nfull), (64 - nfull) + (G - 128)); } }
            if (PM(2)) { pg8::Gemm g{(const bf16*)(ws + WS_MN), (const bf16*)(ws + WS_WKV) + (size_t)l * 4096 * 64, MMEM, 4096, DM, DM, 64, (size_t)8192 * 128}; pg8::StaticOrder S; S.init(MMEM, 4096, G, (bid + G - (64 % G)) % G);
              pg8::EpiMemKV E{a.out + O_MKP + (size_t)l * MMEM * DM, (bf16*)(ws + WS_MK) + (size_t)l * MMEM * DM, (bf16*)(ws + WS_MVT) + (size_t)l * MMEM * DM};
              pg8::gemm_phase<pg8::EpiMemKV, pg8::StaticOrder, true, true>(lds, g, S, E, C.tid); }
            SEAM(pb + 0);
        }
        if (IN(pb + 1)) { PHASE_CTX;
#ifdef DEBUG_P
            { const int gt = bid * 512 + C.tid, NT = G * 512;
              for (int idx = gt + (DEBUG_P == 2 ? MP * 2048 : 0); idx < (DEBUG_P == 1 ? MP : MT) * 2048; idx += NT) { const int row = idx >> 11, c = idx & 2047; const bf16* pr = PBUF + (size_t)row * PIN;
                  float s = bf1(pr[c]) + bf1(pr[c + 2048]) + bf1(pr[c + 4096]); if (c < 256) s += bf1(pr[c + 6144]); a.out[O_YP + idx] = s; } }
#endif
            if ((bid >> 3) & 1) { if (PM(8)) REP(8) for (int it = bid * NWAVES + C.wave; it < NS * 4; it += G * NWAVES) ret_sample_witem(C, a, l, it); __syncthreads(); }
            if (PM(4)) REP(4) for (int it = bid; it < 256; it += G) ad_prompt_item(C, a, l, it);
            if (PM(5)) REP(5) for (int it = bid; it < 256; it += G) ret_pass1_item(C, a, it);
            if (PM(6)) REP(6) for (int it = bid; it < 256; it += G) rwkv_prep_item(C, a, l, it);
            if (PM(6)) for (int it = bid - 64; it >= 0 && it < 8; it += G) rwkv_prep_item(C, a, l, 256 + (it >> 1), it & 1);
            if (PM(7)) REP(7) for (int it = G - 1 - bid; it < NS; it += G) ad_sample_item(C, a, l, it);
            if (!((bid >> 3) & 1)) { if (PM(8)) REP(8) for (int it = bid * NWAVES + C.wave; it < NS * 4; it += G * NWAVES) ret_sample_witem(C, a, l, it); }
            __syncthreads();
            SEAM(pb + 1);
        }
        if (IN(pb + 2)) { PHASE_CTX;
            if ((bid >> 3) & 1) { if (PM(10)) REP(10) for (int it = bid * NWAVES + C.wave; it < NS * 16; it += G * NWAVES) rwkv_sample_witem(C, a, l, it); }
            if (PM(9)) REP(9) for (int it = bid * NWAVES + C.wave; it < 4096; it += G * NWAVES) wkv_chunk_witem(C, a, it);
            if (!((bid >> 3) & 1)) { if (PM(10)) REP(10) for (int it = bid * NWAVES + C.wave; it < NS * 16; it += G * NWAVES) rwkv_sample_witem(C, a, l, it); }
            if (PM(11)) ret_prefix_phase(C, a, l);
            SEAM(pb + 2);
        }
        if (IN(pb + 3)) { PHASE_CTX; const int hg = G / 2;
            if (PM(22)) REP(22) for (int it = bid; it < 128; it += (bid < hg ? hg : 1 << 20)) wkv_seq_item(C, a, l, it);
            if (PM(11)) REP(11) if (bid >= hg || G < 2) for (int it = bid - hg; it < 256; it += G - hg) ret_pass2_item(C, a, l, it);
            SEAM(pb + 3);
        }
        if (IN(pb + 4)) { PHASE_CTX;
            if (PM(12)) REP(12) rwkv_post_phase(C, a, l);
            SEAM(pb + 4);
        }
        if (IN(pb + 5)) { PHASE_CTX; const unsigned char* wl = ws + WS_WL + (size_t)l * LW_STRIDE;
            pg8::Gemm g{YC, (const bf16*)(wl + LW_OUT), MP, DM, DM, DM, 64, (size_t)DM * 128}; pg8::StaticOrder S; S.init(MP, DM, G, bid); pg8::EpiRes E{XF, DM, ((DUP_MASK >> 5) & 1) ? 0.5f : 1.0f, (l == 0 && !((DUP_MASK >> 5) & 1)) ? a.in(I_XP) : (const float*)XF};
            if (PM(15)) pg8::gemm_phase<pg8::EpiRes, pg8::StaticOrder, true, true>(lds, g, S, E, C.tid);
            if (PM(20)) sample_gemm(lds, C.tid, YC + (size_t)MP * DM, DM, (const bf16*)(wl + LW_OUT), DM, DM, DM, G, bid, SEpiRes{XF + (size_t)MP * DM, DM, ((DUP_MASK >> 5) & 1) ? 0.5f : 1.0f, (l == 0 && !((DUP_MASK >> 5) & 1)) ? a.in(I_XS) : (const float*)(XF + (size_t)MP * DM)});
            SEAM(pb + 5);
        }
        if (IN(pb + 6)) { PHASE_CTX; if (PM(21)) REP(21) rms_phase(C, XF, HN, (bf16*)(ws + WS_HNS)); SEAM(pb + 6);
#ifdef XBAR_PROBE
            if (MK_ONE_LAUNCH) for (int i_ = 0; i_ < XBAR_PROBE; ++i_) xcd_barrier(bar);
#endif
        }
        if (IN(pb + 7)) { PHASE_CTX; const unsigned char* wl = ws + WS_WL + (size_t)l * LW_STRIDE;
            pg8::Gemm g{HN, (const bf16*)(wl + LW_Q), MP, DM, DM, DM, 64, (size_t)DM * 128}; pg8::StaticOrder S; S.init(MP, DM, G, bid); pg8::EpiBf16A<0> E{QB, DM, nullptr};
            if (PM(16)) REP(16) pg8::gemm_phase<pg8::EpiBf16A<0>, pg8::StaticOrder, true, true>(lds, g, S, E, C.tid);
            if (PM(20)) { sample_gemm(lds, C.tid, (const bf16*)(ws + WS_HNS), DMS, (const bf16*)(wl + LW_Q), DM, DM, DM, G, bid, SEpiPart{(float*)(ws + WS_SPL), DM}, 2); if ((DUP_SUB >> 24) & 1u) { const Ctx C2 = mk_ctx(lds, wave_s); sample_gemm(lds, C2.tid, (const bf16*)(ws + WS_HNS), DMS, (const bf16*)(wl + LW_Q), DM, DM, DM, G, bid, SEpiPart{(float*)(ws + WS_SPL), DM}, 2); } }
            SEAM(pb + 7);
        }
        if (IN(pb + 8)) { PHASE_CTX;
            { const int g3 = (bid >> 3) % 3;
              if (g3 == 0) { if (PM(13)) REP(13) for (int it = bid; it < 256; it += G) xattn_prompt_unit(C, a, l, it); }
              if (PM(14)) REP(14) for (int it = bid; it < NS * 4; it += 2 * G) xattn_sample_item(C, a, l, it);
              if (g3 == 1) { if (PM(13)) REP(13) for (int it = bid; it < 256; it += G) xattn_prompt_unit(C, a, l, it); }
              if (PM(14)) REP(14) for (int it = bid + G; it < NS * 4; it += 2 * G) xattn_sample_item(C, a, l, it);
              if (g3 == 2) { if (PM(13)) REP(13) for (int it = bid; it < 256; it += G) xattn_prompt_unit(C, a, l, it); } }
            SEAM(pb + 8);
        }
        if (IN(pb + 9)) { PHASE_CTX; const unsigned char* wl = ws + WS_WL + (size_t)l * LW_STRIDE;
            pg8::Gemm g{OB, (const bf16*)(wl + LW_O), MP, DM, DM, DM, 64, (size_t)DM * 128}; pg8::StaticOrder S; S.init(MP, DM, G, bid); pg8::EpiRes E{XF, DM, ((DUP_MASK >> 9) & 1) ? 0.5f : 1.0f, XF};
            if (PM(17)) pg8::gemm_phase<pg8::EpiRes, pg8::StaticOrder, true, true>(lds, g, S, E, C.tid);
            if (PM(20)) sample_gemm(lds, C.tid, (const bf16*)(ws + WS_OS), DMS, (const bf16*)(wl + LW_O), DM, DM, DM, G, bid, SEpiRes{XF + (size_t)MP * DM, DM, ((DUP_MASK >> 9) & 1) ? 0.5f : 1.0f, XF + (size_t)MP * DM});
            SEAM(pb + 9);
        }
        if (IN(pb + 10)) { PHASE_CTX; if (PM(21)) REP(21) rms_phase(C, XF, HN, (bf16*)(ws + WS_HNS)); SEAM(pb + 10); }
        if (IN(pb + 11)) { PHASE_CTX; const unsigned char* wl = ws + WS_WL + (size_t)l * LW_STRIDE;
            pg8::Gemm g{HN, (const bf16*)(wl + LW_UP), MP, DFF, DM, DM, 64, (size_t)DFF * 128}; pg8::StaticOrder S; S.init(MP, DFF, G, bid); pg8::EpiBf16A<3> E{UB, LDU, nullptr};
            if (PM(18)) REP(18) pg8::gemm_phase<pg8::EpiBf16A<3>, pg8::StaticOrder, true, true>(lds, g, S, E, C.tid);
            if (PM(20)) { sample_gemm(lds, C.tid, (const bf16*)(ws + WS_HNS), DMS, (const bf16*)(wl + LW_UP), DFF, DFF, DM, G, bid, SEpiBf16{(bf16*)(ws + WS_US), LDUS, 3, nullptr}); if ((DUP_SUB >> 23) & 1u) { const Ctx C2 = mk_ctx(lds, wave_s); sample_gemm(lds, C2.tid, (const bf16*)(ws + WS_HNS), DMS, (const bf16*)(wl + LW_UP), DFF, DFF, DM, G, bid, SEpiBf16{(bf16*)(ws + WS_US), LDUS, 3, nullptr}); } }
            SEAM(pb + 11);
        }
        if (IN(pb + 12)) { PHASE_CTX; const unsigned char* wl = ws + WS_WL + (size_t)l * LW_STRIDE;
            pg8::Gemm g{UB, (const bf16*)(wl + LW_DN), MP, DM, DFF, LDU, 64, (size_t)DM * 128}; pg8::StaticOrder S; S.init(MP, DM, G, bid); pg8::EpiRes E{XF, DM, ((DUP_MASK >> 12) & 1) ? 0.5f : 1.0f, XF};
            if (PM(19)) pg8::gemm_phase<pg8::EpiRes, pg8::StaticOrder, true, true>(lds, g, S, E, C.tid);
            if (PM(20)) { sample_gemm(lds, C.tid, (const bf16*)(ws + WS_US), LDUS, (const bf16*)(wl + LW_DN), DM, DM, DFF, G, bid, SEpiPart{(float*)(ws + WS_SPL), DM}, 2); if ((DUP_SUB >> 25) & 1u) { const Ctx C2 = mk_ctx(lds, wave_s); sample_gemm(lds, C2.tid, (const bf16*)(ws + WS_US), LDUS, (const bf16*)(wl + LW_DN), DM, DM, DFF, G, bid, SEpiPart{(float*)(ws + WS_SPL), DM}, 2); } }
            SEAM(pb + 12);
        }
        if (IN(pb + 13)) { PHASE_CTX;
            fold_split_rows(C, XF, (const float*)(ws + WS_SPL));
            if (!PM(21)) {} else if (l + 1 < DEPTH) REP(21) rms_phase(C, XF, HN, nullptr); else final_norm_phase(C, XF, a.in(I_GFIN), a.out + O_YP);
            SEAM(pb + 13);
        }
    }
#undef IN
#undef SEAM
#undef SEAM2
#undef PHASE_CTX
}

extern "C" void kernel_launch(void* const* d_in, const int* in_sizes, int n_in, void* d_out, int out_size, void* d_ws, size_t ws_size, hipStream_t stream) {
    static int grid = 0;
    if (grid == 0) {
        if (n_in != NIN || (size_t)out_size != O_END || ws_size < WS_END) { fprintf(stderr, "kernel_launch: unexpected shapes (n_in %d, out %d, ws %zu); nothing launched\n", n_in, out_size, ws_size); grid = -1; return; }
        int dev = 0, cus = 0, per_cu = 0;
        if (hipGetDevice(&dev) != hipSuccess || hipDeviceGetAttribute(&cus, hipDeviceAttributeMultiprocessorCount, dev) != hipSuccess) { grid = -1; return; }
        if (hipFuncSetAttribute((const void*)fwd_kernel, hipFuncAttributeMaxDynamicSharedMemorySize, LDS_BYTES) != hipSuccess) { fprintf(stderr, "kernel_launch: hipFuncSetAttribute failed\n"); grid = -1; return; }
        if (hipOccupancyMaxActiveBlocksPerMultiprocessor(&per_cu, (const void*)fwd_kernel, NWAVES * 64, LDS_BYTES) != hipSuccess || per_cu < 1) { fprintf(stderr, "kernel_launch: occupancy query reports %d\n", per_cu); }
        (void)hipGetLastError();
        grid = cus;
    }
    if (grid < 0) return;
    if (hipMemsetAsync((char*)d_ws + WS_CTL, 0, CTL_ZERO_BYTES, stream) != hipSuccess) return;
    Args a{};
    for (int i = 0; i < NIN; ++i) a.in[i] = (const float*)d_in[i];
    a.out = (float*)d_out; a.ws = (unsigned char*)d_ws;
#if MK_ONE_LAUNCH
    a.ph_lo = 0; a.ph_hi = NPH;
    hipLaunchKernelGGL(fwd_kernel, dim3(grid), dim3(NWAVES * 64), LDS_BYTES, stream, a);
#else
#ifndef NPH_RUN
#define NPH_RUN NPH
#endif
    for (int ph = 0; ph < NPH_RUN; ++ph) { a.ph_lo = ph; a.ph_hi = ph + 1; hipLaunchKernelGGL(fwd_kernel, dim3(grid), dim3(NWAVES * 64), LDS_BYTES, stream, a);
        const int dbit = (ph == 0) ? 13 : (ph - 1) % PH_PER_LAYER;
        if ((DUP_MASK >> dbit) & 1) hipLaunchKernelGGL(fwd_kernel, dim3(grid), dim3(NWAVES * 64), LDS_BYTES, stream, a); }
#endif
}
```
